# Optimizing an MI355X kernel written in HIP

```python
import math
import jax, jax.numpy as jnp
from jax import lax
import numpy as np


D_MODEL = 1024
BATCH = 8
SEQ = 4096
DEPTH = 4

HEAD_DIM = 64
S5_CH = D_MODEL // 4
S5_GROUP = 16
S5_NGROUPS = S5_CH // S5_GROUP
S5_STATE = 64
S5_DT_MIN = 1e-3
S5_DT_MAX = 1e-1
MOBA_HEADS = D_MODEL // 128
MOBA_W = MOBA_HEADS * HEAD_DIM
MOBA_BLOCK = 256
MOBA_TOPK = 3
MOBA_QCHUNK = 32
ROPE_THETA = 500000.0
ROPE_DIMS = HEAD_DIM // 4
RET_HEADS = D_MODEL // 256
RET_W = RET_HEADS * HEAD_DIM
RET_CHUNK = 128
RET_ANGLE_BASE = 10000.0
MIX_W = S5_CH + MOBA_W + RET_W
SPLIT_SIZES = (S5_CH, MOBA_W, MOBA_W, MOBA_W, RET_W, RET_W, RET_W, RET_W)
IN_W = sum(SPLIT_SIZES)
SPLIT_POINTS = tuple(sum(SPLIT_SIZES[:i + 1]) for i in range(len(SPLIT_SIZES) - 1))
PEER_KEYS = 128
PEER_EXPERTS = PEER_KEYS * PEER_KEYS
PEER_HEADS = 8
PEER_TOPK = 16
PEER_QDIM = 128
PEER_CHUNK = 128
EPS = 1e-6

kernel_name = 'hymba_s5_moba_retnet_peer'


def rms_unit(x):
    xf = x.astype(jnp.float32)
    return xf * lax.rsqrt(jnp.mean(xf * xf, axis=-1, keepdims=True) + EPS)


def rms_norm(x, g):
    return (rms_unit(x) * g.astype(jnp.float32)).astype(x.dtype)


def rotate(x, cos, sin):
    m = x.shape[-1] // 2
    x1, x2 = x[..., :m], x[..., m:]
    c = cos[None, :, None, :]
    s = sin[None, :, None, :]
    return jnp.concatenate([x1 * c - x2 * s, x2 * c + x1 * s], axis=-1)


def partial_rope(x, cos, sin):
    return jnp.concatenate([rotate(x[..., :ROPE_DIMS], cos, sin), x[..., ROPE_DIMS:]], axis=-1)


def _ssm_combine(e1, e2):
    a1r, a1i, b1r, b1i = e1
    a2r, a2i, b2r, b2i = e2
    return (a1r * a2r - a1i * a2i,
            a1r * a2i + a1i * a2r,
            a2r * b1r - a2i * b1i + b2r,
            a2r * b1i + a2i * b1r + b2i)


def s5_mixer(u, lam_re, lam_im, log_dt, b_re, b_im, c_re, c_im, d_skip, w_glu):
    bsz, s, _ = u.shape
    uf = u.astype(jnp.float32).reshape(bsz, s, S5_NGROUPS, S5_GROUP)
    lr = lam_re.astype(jnp.float32)
    li = lam_im.astype(jnp.float32)
    dt = jnp.exp(log_dt.astype(jnp.float32))[:, None]
    mag = jnp.exp(lr * dt)
    ar = mag * jnp.cos(li * dt)
    ai = mag * jnp.sin(li * dt)
    den = lr * lr + li * li
    fr = ((ar - 1.0) * lr + ai * li) / den
    fi = (ai * lr - (ar - 1.0) * li) / den
    br = b_re.astype(jnp.float32)
    bi = b_im.astype(jnp.float32)
    bbr = fr[..., None] * br - fi[..., None] * bi
    bbi = fr[..., None] * bi + fi[..., None] * br
    bu_r = jnp.einsum('bsgh,gph->bsgp', uf, bbr)
    bu_i = jnp.einsum('bsgh,gph->bsgp', uf, bbi)
    a_r = jnp.broadcast_to(ar, bu_r.shape)
    a_i = jnp.broadcast_to(ai, bu_i.shape)
    _, _, st_r, st_i = lax.associative_scan(_ssm_combine, (a_r, a_i, bu_r, bu_i), axis=1)
    y = (jnp.einsum('bsgp,ghp->bsgh', st_r, c_re.astype(jnp.float32))
         - jnp.einsum('bsgp,ghp->bsgh', st_i, c_im.astype(jnp.float32))
         + uf * d_skip.astype(jnp.float32).reshape(S5_NGROUPS, S5_GROUP))
    y = jax.nn.gelu(y.reshape(bsz, s, S5_CH))
    y = y * jax.nn.sigmoid(y @ w_glu.astype(jnp.float32))
    return y.astype(u.dtype)


def moba_mixer(q, k, v, gq, gk, cos, sin):
    bsz, s, _ = q.shape
    dtype = v.dtype
    hs = (bsz, s, MOBA_HEADS, HEAD_DIM)
    q = partial_rope(rms_unit(q.reshape(hs)) * gq.astype(jnp.float32), cos, sin).astype(dtype)
    k = partial_rope(rms_unit(k.reshape(hs)) * gk.astype(jnp.float32), cos, sin).astype(dtype)
    q = q.transpose(0, 2, 1, 3)
    k = k.transpose(0, 2, 1, 3)
    v = v.reshape(hs).transpose(0, 2, 1, 3)
    nb = -(-s // MOBA_BLOCK)
    pad = nb * MOBA_BLOCK - s
    padw = ((0, 0), (0, 0), (0, pad), (0, 0))
    kb = jnp.pad(k, padw).reshape(bsz, MOBA_HEADS, nb, MOBA_BLOCK, HEAD_DIM)
    vb = jnp.pad(v, padw).reshape(bsz, MOBA_HEADS, nb, MOBA_BLOCK, HEAD_DIM)
    kmean = jnp.mean(kb, axis=3)
    topk = min(MOBA_TOPK, nb)
    scale = HEAD_DIM ** -0.5
    gather = jax.vmap(jax.vmap(lambda blocks, ix: blocks[ix]))

    def chunk(c):
        start = c * MOBA_QCHUNK
        blk = start // MOBA_BLOCK
        qc = lax.dynamic_slice_in_dim(q, start, MOBA_QCHUNK, axis=2)
        gate = jnp.einsum('bhqd,bhnd->bhqn', qc, kmean).astype(jnp.float32)
        gate = jnp.where(jnp.arange(nb) < blk, gate, -jnp.inf)
        _, idx = lax.top_k(gate, topk)
        valid = jnp.arange(topk) < blk
        sk = gather(kb, idx)
        sv = gather(vb, idx)
        s_sel = jnp.einsum('bhqd,bhqjkd->bhqjk', qc, sk).astype(jnp.float32) * scale
        s_sel = jnp.where(valid[:, None], s_sel, -jnp.inf)
        s_sel = s_sel.reshape(bsz, MOBA_HEADS, MOBA_QCHUNK, topk * MOBA_BLOCK)
        ok = lax.dynamic_index_in_dim(kb, blk, axis=2, keepdims=False)
        ov = lax.dynamic_index_in_dim(vb, blk, axis=2, keepdims=False)
        s_own = jnp.einsum('bhqd,bhkd->bhqk', qc, ok).astype(jnp.float32) * scale
        qpos = start + jnp.arange(MOBA_QCHUNK)
        kpos = blk * MOBA_BLOCK + jnp.arange(MOBA_BLOCK)
        s_own = jnp.where(kpos[None, :] <= qpos[:, None], s_own, -jnp.inf)
        p = jax.nn.softmax(jnp.concatenate([s_sel, s_own], axis=-1), axis=-1)
        p_sel = p[..., :topk * MOBA_BLOCK].reshape(bsz, MOBA_HEADS, MOBA_QCHUNK, topk, MOBA_BLOCK).astype(dtype)
        p_own = p[..., topk * MOBA_BLOCK:].astype(dtype)
        return (jnp.einsum('bhqjk,bhqjkd->bhqd', p_sel, sv)
                + jnp.einsum('bhqk,bhkd->bhqd', p_own, ov))

    out = lax.map(chunk, jnp.arange(s // MOBA_QCHUNK))
    return out.transpose(1, 0, 3, 2, 4).reshape(hs)


def retention_mixer(q, k, v, g, cos, sin):
    bsz, s, _ = q.shape
    dtype = v.dtype
    hs = (bsz, s, RET_HEADS, HEAD_DIM)
    q = rotate(q.astype(jnp.float32).reshape(hs), cos, sin)
    k = rotate(k.astype(jnp.float32).reshape(hs), cos, sin) * (HEAD_DIM ** -0.5)
    v = v.astype(jnp.float32).reshape(hs)
    log_g = jnp.log(1.0 - 2.0 ** (-5.0 - jnp.arange(RET_HEADS, dtype=jnp.float32)))
    n = s // RET_CHUNK
    cs = (bsz, n, RET_CHUNK, RET_HEADS, HEAD_DIM)
    qc, kc, vc = q.reshape(cs), k.reshape(cs), v.reshape(cs)
    i = jnp.arange(RET_CHUNK, dtype=jnp.float32)
    diff = i[:, None] - i[None, :]
    dmask = jnp.where(diff >= 0, jnp.exp(jnp.maximum(diff, 0.0)[None] * log_g[:, None, None]), 0.0)
    inner = jnp.einsum('bnihd,bnjhd->bnhij', qc, kc) * dmask
    inner = jnp.einsum('bnhij,bnjhe->bnihe', inner, vc)
    zeta = jnp.exp((RET_CHUNK - 1.0 - i)[None, :] * log_g[:, None])
    kv = jnp.einsum('bnjhd,hj,bnjhe->nbhde', kc, zeta, vc)
    chunk_decay = jnp.exp(RET_CHUNK * log_g)[None, :, None, None]

    def step(state, kv_n):
        return chunk_decay * state + kv_n, state

    _, r_prev = lax.scan(step, jnp.zeros((bsz, RET_HEADS, HEAD_DIM, HEAD_DIM), jnp.float32), kv)
    xi = jnp.exp((i + 1.0)[None, :] * log_g[:, None])
    cross = jnp.einsum('bnihd,nbhde,hi->bnihe', qc, r_prev, xi)
    o = rms_unit((inner + cross).reshape(hs)).reshape(bsz, s, RET_W)
    return (jax.nn.silu(g.astype(jnp.float32)) * o).astype(dtype)


def peer_layer(h, w_q, sub_keys, u_emb, v_emb):
    bsz, s, d = h.shape
    t = bsz * s
    hf = h.reshape(t, d)
    q = (hf @ w_q).reshape(t, PEER_HEADS, 2, PEER_QDIM // 2)
    sc = jnp.einsum('thcd,hcnd->thcn', q, sub_keys).astype(jnp.float32)
    sv, si = lax.top_k(sc, PEER_TOPK)
    cand_s = (sv[:, :, 0, :, None] + sv[:, :, 1, None, :]).reshape(t, PEER_HEADS, PEER_TOPK * PEER_TOPK)
    cand_i = (si[:, :, 0, :, None] * PEER_KEYS + si[:, :, 1, None, :]).reshape(t, PEER_HEADS, PEER_TOPK * PEER_TOPK)
    fs, fp = lax.top_k(cand_s, PEER_TOPK)
    eidx = jnp.take_along_axis(cand_i, fp, axis=-1)
    gates = jax.nn.softmax(fs, axis=-1).astype(h.dtype)
    nch = t // PEER_CHUNK

    def chunk(args):
        xc, ic, gc = args
        ue = u_emb[ic]
        act = jax.nn.gelu(jnp.einsum('cd,chkd->chk', xc, ue))
        ve = v_emb[ic]
        return jnp.einsum('chk,chkd->cd', gc * act, ve)

    out = lax.map(chunk, (hf.reshape(nch, PEER_CHUNK, d),
                          eidx.reshape(nch, PEER_CHUNK, PEER_HEADS, PEER_TOPK),
                          gates.reshape(nch, PEER_CHUNK, PEER_HEADS, PEER_TOPK)))
    return out.reshape(bsz, s, d)


def setup_inputs(seed: int = 0) -> dict:
    key = jax.random.key(seed)
    ks = jax.random.split(key, 24)
    L, D, f32 = DEPTH, D_MODEL, jnp.float32
    nrm = lambda k, shp, sc: jax.random.normal(k, shp, f32) * sc
    gain = lambda k, n: 1.0 + 0.02 * jax.random.normal(k, (L, n), f32)
    return {
        'x': jax.random.normal(ks[0], (BATCH, SEQ, D), f32),
        'norm1_g': gain(ks[1], D),
        'w_in': nrm(ks[2], (L, D, IN_W), D ** -0.5),
        's5_lam_re': -0.5 + nrm(ks[3], (L, S5_NGROUPS, S5_STATE), 0.01),
        's5_lam_im': math.pi * jnp.arange(S5_STATE, dtype=f32) + nrm(ks[4], (L, S5_NGROUPS, S5_STATE), 0.01),
        's5_log_dt': jax.random.uniform(ks[5], (L, S5_NGROUPS), f32, math.log(S5_DT_MIN), math.log(S5_DT_MAX)),
        's5_b_re': nrm(ks[6], (L, S5_NGROUPS, S5_STATE, S5_GROUP), (2 * S5_GROUP) ** -0.5),
        's5_b_im': nrm(ks[7], (L, S5_NGROUPS, S5_STATE, S5_GROUP), (2 * S5_GROUP) ** -0.5),
        's5_c_re': nrm(ks[8], (L, S5_NGROUPS, S5_GROUP, S5_STATE), (2 * S5_STATE) ** -0.5),
        's5_c_im': nrm(ks[9], (L, S5_NGROUPS, S5_GROUP, S5_STATE), (2 * S5_STATE) ** -0.5),
        's5_d': nrm(ks[10], (L, S5_CH), 1.0),
        's5_w_glu': nrm(ks[11], (L, S5_CH, S5_CH), S5_CH ** -0.5),
        'moba_q_g': gain(ks[12], HEAD_DIM),
        'moba_k_g': gain(ks[13], HEAD_DIM),
        'mix_out_g': gain(ks[14], MIX_W),
        'w_out': nrm(ks[15], (L, MIX_W, D), 0.5 * MIX_W ** -0.5),
        'norm2_g': gain(ks[16], D),
        'peer_w_q': nrm(ks[17], (L, D, PEER_HEADS * PEER_QDIM), D ** -0.5),
        'peer_sub_keys': nrm(ks[18], (L, PEER_HEADS, 2, PEER_KEYS, PEER_QDIM // 2), (PEER_QDIM // 2) ** -0.5),
        'peer_u': nrm(ks[19], (L, PEER_EXPERTS, D), D ** -0.5),
        'peer_v': nrm(ks[20], (L, PEER_EXPERTS, D), D ** -0.5),
    }


def reference(x, norm1_g, w_in, s5_lam_re, s5_lam_im, s5_log_dt, s5_b_re, s5_b_im, s5_c_re, s5_c_im,
              s5_d, s5_w_glu, moba_q_g, moba_k_g, mix_out_g, w_out, norm2_g, peer_w_q, peer_sub_keys,
              peer_u, peer_v):
    s = x.shape[1]
    pos = jnp.arange(s, dtype=jnp.float32)
    inv = ROPE_THETA ** (-jnp.arange(0, ROPE_DIMS, 2, dtype=jnp.float32) / ROPE_DIMS)
    ang = pos[:, None] * inv[None, :]
    rope_cos, rope_sin = jnp.cos(ang), jnp.sin(ang)
    ret_inv = RET_ANGLE_BASE ** (-jnp.linspace(0.0, 1.0, HEAD_DIM // 2, dtype=jnp.float32))
    ret_ang = pos[:, None] * ret_inv[None, :]
    ret_cos, ret_sin = jnp.cos(ret_ang), jnp.sin(ret_ang)
    bsz = x.shape[0]
    for l in range(DEPTH):
        h = rms_norm(x, norm1_g[l])
        proj = h @ w_in[l]
        ua, qb, kb, vb, qc, kc, vc, gc = jnp.split(proj, SPLIT_POINTS, axis=-1)
        ya = s5_mixer(ua, s5_lam_re[l], s5_lam_im[l], s5_log_dt[l], s5_b_re[l], s5_b_im[l],
                      s5_c_re[l], s5_c_im[l], s5_d[l], s5_w_glu[l])
        ya = rms_unit(ya)
        yb = rms_unit(moba_mixer(qb, kb, vb, moba_q_g[l], moba_k_g[l], rope_cos, rope_sin))
        yb = yb.reshape(bsz, s, MOBA_W)
        yc = retention_mixer(qc, kc, vc, gc, ret_cos, ret_sin).astype(jnp.float32)
        y = jnp.concatenate([ya, yb, yc], axis=-1) * mix_out_g[l].astype(jnp.float32)
        x = x + (y.astype(x.dtype) @ w_out[l])
        h2 = rms_norm(x, norm2_g[l])
        x = x + peer_layer(h2, peer_w_q[l], peer_sub_keys[l], peer_u[l], peer_v[l])
    return x
```

```cpp
#include <hip/hip_runtime.h>
#include <math.h>
#include <stdint.h>

namespace {
constexpr int NB = 8, S = 4096, D = 1024, NL = 4, T = NB * S;
constexpr int INW = 2816;
constexpr int OFF_U = 0, OFF_QM = 256, OFF_KM = 768, OFF_VM = 1280, OFF_QR = 1792, OFF_KR = 2048, OFF_VR = 2304, OFF_GR = 2560;
constexpr float EPS = 1e-6f;

__device__ __forceinline__ float wave_sum(float v) {
#pragma unroll
  for (int o = 32; o > 0; o >>= 1) v += __shfl_xor(v, o);
  return v;
}
__device__ __forceinline__ float wave_max(float v) {
#pragma unroll
  for (int o = 32; o > 0; o >>= 1) v = fmaxf(v, __shfl_xor(v, o));
  return v;
}
__device__ __forceinline__ float gelu_tanh(float x) {
  const float k0 = 0.7978845608028654f, k1 = 0.044715f;
  float u = k0 * (x + k1 * x * x * x);
  return 0.5f * x * (1.0f + tanhf(u));
}
__device__ __forceinline__ float sigmoidf_(float x) { return 1.0f / (1.0f + expf(-x)); }

__global__ void k_tables(float* cosm, float* sinm, float* cosr, float* sinr) {
  int idx = blockIdx.x * blockDim.x + threadIdx.x;
  if (idx >= S * 40) return;
  int s = idx / 40, i = idx % 40;
  if (i < 8) {
    float inv = powf(500000.0f, -(float)(2 * i) / 16.0f);
    float ang = (float)s * inv;
    cosm[s * 8 + i] = (float)cos((double)ang);
    sinm[s * 8 + i] = (float)sin((double)ang);
  } else {
    int j = i - 8;
    float lin = (float)j / 31.0f;
    float inv = powf(10000.0f, -lin);
    float ang = (float)s * inv;
    cosr[s * 32 + j] = (float)cos((double)ang);
    sinr[s * 32 + j] = (float)sin((double)ang);
  }
}

__global__ void k_copy4(const float4* __restrict__ a, float4* __restrict__ b, size_t n4) {
  size_t i = (size_t)blockIdx.x * blockDim.x + threadIdx.x;
  size_t st = (size_t)gridDim.x * blockDim.x;
  for (; i < n4; i += st) b[i] = a[i];
}

__global__ void k_rstd(const float* __restrict__ x, float* __restrict__ rstd) {
  int t = blockIdx.x * 4 + (threadIdx.x >> 6);
  int lane = threadIdx.x & 63;
  const float4* p = (const float4*)(x + (size_t)t * D);
  float ss = 0.f;
#pragma unroll
  for (int i = 0; i < 4; ++i) { float4 v = p[lane + i * 64]; ss += v.x * v.x + v.y * v.y + v.z * v.z + v.w * v.w; }
  ss = wave_sum(ss);
  if (lane == 0) rstd[t] = rsqrtf(ss / (float)D + EPS);
}

template <int MODE>
__global__ void __launch_bounds__(256) k_gemm(const float* __restrict__ A, int lda, const float* __restrict__ cg,
                                              const float* __restrict__ W, int ldw, float* __restrict__ C, int ldc,
                                              const float* __restrict__ rs, int K) {
  __shared__ float As[16][128 + 4];
  __shared__ float Ws[16][128 + 4];
  const int tid = threadIdx.x;
  const int m0 = blockIdx.y * 128, n0 = blockIdx.x * 128;
  const int ty = tid >> 4, tx = tid & 15;
  float acc[8][8];
#pragma unroll
  for (int i = 0; i < 8; ++i)
#pragma unroll
    for (int j = 0; j < 8; ++j) acc[i][j] = 0.f;
  const int ar = tid >> 1, ak = (tid & 1) * 8;
  const int wk = tid >> 4, wn = (tid & 15) * 8;
  for (int k0 = 0; k0 < K; k0 += 16) {
    float4 a0 = *(const float4*)(A + (size_t)(m0 + ar) * lda + k0 + ak);
    float4 a1 = *(const float4*)(A + (size_t)(m0 + ar) * lda + k0 + ak + 4);
    if (cg) {
      float4 g0 = *(const float4*)(cg + k0 + ak), g1 = *(const float4*)(cg + k0 + ak + 4);
      a0.x *= g0.x; a0.y *= g0.y; a0.z *= g0.z; a0.w *= g0.w;
      a1.x *= g1.x; a1.y *= g1.y; a1.z *= g1.z; a1.w *= g1.w;
    }
    float4 w0 = *(const float4*)(W + (size_t)(k0 + wk) * ldw + n0 + wn);
    float4 w1 = *(const float4*)(W + (size_t)(k0 + wk) * ldw + n0 + wn + 4);
    __syncthreads();
    As[ak + 0][ar] = a0.x; As[ak + 1][ar] = a0.y; As[ak + 2][ar] = a0.z; As[ak + 3][ar] = a0.w;
    As[ak + 4][ar] = a1.x; As[ak + 5][ar] = a1.y; As[ak + 6][ar] = a1.z; As[ak + 7][ar] = a1.w;
    *(float4*)&Ws[wk][wn] = w0; *(float4*)&Ws[wk][wn + 4] = w1;
    __syncthreads();
#pragma unroll
    for (int k = 0; k < 16; ++k) {
      float a[8], b[8];
      float4 t0 = *(const float4*)&As[k][ty * 4], t1 = *(const float4*)&As[k][64 + ty * 4];
      a[0] = t0.x; a[1] = t0.y; a[2] = t0.z; a[3] = t0.w; a[4] = t1.x; a[5] = t1.y; a[6] = t1.z; a[7] = t1.w;
      float4 u0 = *(const float4*)&Ws[k][tx * 4], u1 = *(const float4*)&Ws[k][64 + tx * 4];
      b[0] = u0.x; b[1] = u0.y; b[2] = u0.z; b[3] = u0.w; b[4] = u1.x; b[5] = u1.y; b[6] = u1.z; b[7] = u1.w;
#pragma unroll
      for (int i = 0; i < 8; ++i)
#pragma unroll
        for (int j = 0; j < 8; ++j) acc[i][j] = fmaf(a[i], b[j], acc[i][j]);
    }
  }
#pragma unroll
  for (int i = 0; i < 8; ++i) {
    int m = m0 + (i < 4 ? ty * 4 + i : 64 + ty * 4 + (i - 4));
    float r = (MODE == 0 && rs) ? rs[m] : 1.0f;
#pragma unroll
    for (int jh = 0; jh < 2; ++jh) {
      int n = n0 + jh * 64 + tx * 4;
      float* cp = C + (size_t)m * ldc + n;
      float4 v;
      if (MODE == 1) {
        v = *(float4*)cp;
        v.x += acc[i][jh * 4 + 0]; v.y += acc[i][jh * 4 + 1]; v.z += acc[i][jh * 4 + 2]; v.w += acc[i][jh * 4 + 3];
      } else {
        v.x = r * acc[i][jh * 4 + 0]; v.y = r * acc[i][jh * 4 + 1]; v.z = r * acc[i][jh * 4 + 2]; v.w = r * acc[i][jh * 4 + 3];
      }
      *(float4*)cp = v;
    }
  }
}

__global__ void k_postproj(float* __restrict__ proj, const float* __restrict__ gq, const float* __restrict__ gk,
                           const float* __restrict__ cosm, const float* __restrict__ sinm,
                           const float* __restrict__ cosr, const float* __restrict__ sinr) {
  int w = blockIdx.x * 4 + (threadIdx.x >> 6);
  int lane = threadIdx.x & 63;
  int t = w / 24, slot = w % 24;
  int s = t % S;
  float* row = proj + (size_t)t * INW;
  if (slot < 16) {
    int h = slot & 7;
    float* p = row + (slot < 8 ? OFF_QM : OFF_KM) + h * 64;
    const float* g = slot < 8 ? gq : gk;
    float v = p[lane];
    float ss = wave_sum(v * v);
    float u = v * rsqrtf(ss / 64.0f + EPS) * g[lane];
    int partner = lane < 8 ? lane + 8 : lane - 8;
    float pu = __shfl(u, partner & 63);
    float out = u;
    if (lane < 16) {
      int i = lane & 7;
      float c = cosm[s * 8 + i], sn = sinm[s * 8 + i];
      out = lane < 8 ? (u * c - pu * sn) : (u * c + pu * sn);
    }
    p[lane] = out;
  } else {
    int h = (slot - 16) & 3;
    bool isk = slot >= 20;
    float* p = row + (isk ? OFF_KR : OFF_QR) + h * 64;
    float v = p[lane];
    float pv = __shfl(v, lane ^ 32);
    int i = lane & 31;
    float c = cosr[s * 32 + i], sn = sinr[s * 32 + i];
    float out = lane < 32 ? (v * c - pv * sn) : (v * c + pv * sn);
    if (isk) out *= 0.125f;
    p[lane] = out;
  }
}

__global__ void k_kmean(const float* __restrict__ proj, float* __restrict__ kmean) {
  int idx = blockIdx.x * blockDim.x + threadIdx.x;
  int d = idx & 63, j = (idx >> 6) & 15, h = (idx >> 10) & 7, b = idx >> 13;
  const float* p = proj + ((size_t)(b * S + j * 256)) * INW + OFF_KM + h * 64 + d;
  float acc = 0.f;
  for (int i = 0; i < 256; ++i) acc += p[(size_t)i * INW];
  kmean[idx] = acc / 256.0f;
}

__global__ void __launch_bounds__(64) k_s5(const float* __restrict__ proj, const float* __restrict__ lam_re, const float* __restrict__ lam_im,
                                           const float* __restrict__ log_dt, const float* __restrict__ b_re, const float* __restrict__ b_im,
                                           const float* __restrict__ c_re, const float* __restrict__ c_im, const float* __restrict__ dskip,
                                           float* __restrict__ yg) {
  __shared__ float red[16][65];
  const int b = blockIdx.x >> 4, g = blockIdx.x & 15, p = threadIdx.x;
  float lr = lam_re[g * 64 + p], li = lam_im[g * 64 + p];
  float dt = expf(log_dt[g]);
  float mag = expf(lr * dt);
  float ar = mag * cosf(li * dt), ai = mag * sinf(li * dt);
  float den = lr * lr + li * li;
  float fr = ((ar - 1.0f) * lr + ai * li) / den;
  float fi = (ai * lr - (ar - 1.0f) * li) / den;
  float bbr[16], bbi[16], cr[16], ci[16];
#pragma unroll
  for (int h = 0; h < 16; ++h) {
    float br = b_re[(g * 64 + p) * 16 + h], bi = b_im[(g * 64 + p) * 16 + h];
    bbr[h] = fr * br - fi * bi;
    bbi[h] = fr * bi + fi * br;
    cr[h] = c_re[(g * 16 + h) * 64 + p];
    ci[h] = c_im[(g * 16 + h) * 64 + p];
  }
  const int hq = p >> 2, qq = p & 3;
  float dsk = dskip[g * 16 + hq];
  float sr = 0.f, si = 0.f;
  for (int t = 0; t < S; ++t) {
    const float* up = proj + (size_t)(b * S + t) * INW + OFF_U + g * 16;
    float u[16];
#pragma unroll
    for (int h4 = 0; h4 < 4; ++h4) { float4 v = *(const float4*)(up + h4 * 4); u[h4 * 4] = v.x; u[h4 * 4 + 1] = v.y; u[h4 * 4 + 2] = v.z; u[h4 * 4 + 3] = v.w; }
    float bur = 0.f, bui = 0.f;
#pragma unroll
    for (int h = 0; h < 16; ++h) { bur = fmaf(u[h], bbr[h], bur); bui = fmaf(u[h], bbi[h], bui); }
    float nr = ar * sr - ai * si + bur;
    float ni = ar * si + ai * sr + bui;
    sr = nr; si = ni;
    __syncthreads();
#pragma unroll
    for (int h = 0; h < 16; ++h) red[h][p] = sr * cr[h] - si * ci[h];
    __syncthreads();
    float acc = 0.f;
#pragma unroll
    for (int i = 0; i < 16; ++i) acc += red[hq][qq * 16 + i];
    acc += __shfl_xor(acc, 1);
    acc += __shfl_xor(acc, 2);
    if (qq == 0) {
      float y = acc + up[hq] * dsk;
      yg[(size_t)(b * S + t) * 256 + g * 16 + hq] = gelu_tanh(y);
    }
  }
}

__global__ void __launch_bounds__(256) k_s5glu(const float* __restrict__ yg, const float* __restrict__ wglu, const float* __restrict__ mixg,
                                               float* __restrict__ ybuf) {
  __shared__ float ys[256];
  __shared__ float red[4];
  const int t = blockIdx.x, n = threadIdx.x;
  float yv = yg[(size_t)t * 256 + n];
  ys[n] = yv;
  __syncthreads();
  float z = 0.f;
  for (int k = 0; k < 256; ++k) z = fmaf(ys[k], wglu[k * 256 + n], z);
  float o = yv * sigmoidf_(z);
  float ss = wave_sum(o * o);
  if ((n & 63) == 0) red[n >> 6] = ss;
  __syncthreads();
  float tot = red[0] + red[1] + red[2] + red[3];
  ybuf[(size_t)t * D + n] = o * rsqrtf(tot / 256.0f + EPS) * mixg[n];
}

__global__ void __launch_bounds__(256) k_moba(const float* __restrict__ proj, const float* __restrict__ kmean, const float* __restrict__ mixg,
                                              float* __restrict__ ybuf) {
  __shared__ float qs[4][64];
  const int wv = threadIdx.x >> 6, lane = threadIdx.x & 63;
  const int w = blockIdx.x * 4 + wv;
  const int s = w % S, h = (w / S) & 7, b = w / (S * 8);
  const int blk = s >> 8;
  const float* base = proj + (size_t)(b * S) * INW;
  const float q = base[(size_t)s * INW + OFF_QM + h * 64 + lane];
  qs[wv][lane] = q;
  __syncthreads();
  float gate = -INFINITY;
  for (int j = 0; j < blk; ++j) {
    float v = wave_sum(q * kmean[((b * 8 + h) * 16 + j) * 64 + lane]);
    if (lane == j) gate = v;
  }
  int sel0 = 0, sel1 = 0, sel2 = 0; int nsel = blk < 3 ? blk : 3;
#pragma unroll
  for (int r = 0; r < 3; ++r) {
    float mx = wave_max(gate);
    unsigned long long bal = __ballot(gate == mx && gate > -INFINITY);
    int idx = bal ? (__ffsll((long long)bal) - 1) : 0;
    if (r == 0) sel0 = idx; else if (r == 1) sel1 = idx; else sel2 = idx;
    if (lane == idx) gate = -INFINITY;
  }
  float m = -INFINITY, l = 0.f, O = 0.f;
  const float scale = 0.125f;
  for (int r = 0; r <= nsel; ++r) {
    const bool own = (r == nsel);
    const int kb = own ? blk : (r == 0 ? sel0 : (r == 1 ? sel1 : sel2));
    const int nch = own ? (((s & 255) >> 6) + 1) : 4;
    for (int c = 0; c < nch; ++c) {
      const int key = kb * 256 + c * 64 + lane;
      const bool valid = own ? (key <= s) : true;
      const float* kp = base + (size_t)key * INW + OFF_KM + h * 64;
      float sc = 0.f;
#pragma unroll
      for (int d4 = 0; d4 < 16; ++d4) {
        float4 kv = *(const float4*)(kp + d4 * 4);
        sc = fmaf(qs[wv][d4 * 4 + 0], kv.x, sc); sc = fmaf(qs[wv][d4 * 4 + 1], kv.y, sc);
        sc = fmaf(qs[wv][d4 * 4 + 2], kv.z, sc); sc = fmaf(qs[wv][d4 * 4 + 3], kv.w, sc);
      }
      sc = valid ? sc * scale : -INFINITY;
      float mn = fmaxf(m, wave_max(sc));
      float pz = valid ? expf(sc - mn) : 0.f;
      float corr = expf(m - mn);
      l = l * corr + wave_sum(pz);
      O *= corr;
      const float* vp = base + (size_t)(kb * 256 + c * 64) * INW + OFF_VM + h * 64 + lane;
      for (int kk = 0; kk < 64; ++kk) {
        float pk = __shfl(pz, kk);
        O = fmaf(pk, vp[(size_t)kk * INW], O);
      }
      m = mn;
    }
  }
  float o = O / l;
  float ss = wave_sum(o * o);
  int col = 256 + h * 64 + lane;
  ybuf[(size_t)(b * S + s) * D + col] = o * rsqrtf(ss / 64.0f + EPS) * mixg[col];
}

__global__ void __launch_bounds__(256) k_ret(const float* __restrict__ proj, const float* __restrict__ mixg, float* __restrict__ ybuf) {
  constexpr int TB = 16;
  __shared__ float qs[TB][64], ks[TB][64], vs[TB][64];
  __shared__ float red[TB][4][64];
  const int b = blockIdx.x >> 2, h = blockIdx.x & 3;
  const int tid = threadIdx.x, e = tid & 63, dg = tid >> 6;
  const float gamma = 1.0f - exp2f(-5.0f - (float)h);
  float St[16];
#pragma unroll
  for (int i = 0; i < 16; ++i) St[i] = 0.f;
  const float* base = proj + (size_t)(b * S) * INW;
  for (int t0 = 0; t0 < S; t0 += TB) {
    __syncthreads();
    for (int i = tid; i < TB * 64; i += 256) {
      int tt = i >> 6, d = i & 63;
      const float* r = base + (size_t)(t0 + tt) * INW;
      qs[tt][d] = r[OFF_QR + h * 64 + d];
      ks[tt][d] = r[OFF_KR + h * 64 + d];
      vs[tt][d] = r[OFF_VR + h * 64 + d];
    }
    __syncthreads();
    for (int tt = 0; tt < TB; ++tt) {
      float ve = vs[tt][e];
      float part = 0.f;
#pragma unroll
      for (int i = 0; i < 16; ++i) {
        St[i] = fmaf(gamma, St[i], ks[tt][dg * 16 + i] * ve);
        part = fmaf(qs[tt][dg * 16 + i], St[i], part);
      }
      red[tt][dg][e] = part;
    }
    __syncthreads();
    for (int k = 0; k < 4; ++k) {
      int tt = dg * 4 + k;
      float o = red[tt][0][e] + red[tt][1][e] + red[tt][2][e] + red[tt][3][e];
      float ss = wave_sum(o * o);
      float gv = base[(size_t)(t0 + tt) * INW + OFF_GR + h * 64 + e];
      float sl = gv * sigmoidf_(gv);
      int col = 768 + h * 64 + e;
      ybuf[(size_t)(b * S + t0 + tt) * D + col] = sl * o * rsqrtf(ss / 64.0f + EPS) * mixg[col];
    }
  }
}

#define INS16(V, I)                                                    \
  {                                                                    \
    float v_ = (V); int i_ = (I);                                      \
    _Pragma("unroll") for (int z_ = 0; z_ < 16; ++z_) {                \
      bool gt_ = v_ > tv[z_];                                          \
      float tvv_ = tv[z_]; int tii_ = ti[z_];                          \
      tv[z_] = gt_ ? v_ : tvv_; ti[z_] = gt_ ? i_ : tii_;              \
      v_ = gt_ ? tvv_ : v_; i_ = gt_ ? tii_ : i_;                      \
    }                                                                  \
  }

__global__ void __launch_bounds__(256) k_peer_topk1(const float* __restrict__ qp, const float* __restrict__ subk,
                                                    float* __restrict__ tvo, int* __restrict__ tio) {
  const int hc = blockIdx.y;
  const int t = blockIdx.x * 256 + threadIdx.x;
  const float* q = qp + (size_t)t * D + hc * 64;
  float qv[64];
#pragma unroll
  for (int i = 0; i < 16; ++i) { float4 v = *(const float4*)(q + i * 4); qv[i * 4] = v.x; qv[i * 4 + 1] = v.y; qv[i * 4 + 2] = v.z; qv[i * 4 + 3] = v.w; }
  float tv[16]; int ti[16];
#pragma unroll
  for (int z = 0; z < 16; ++z) { tv[z] = -INFINITY; ti[z] = 0; }
  const float* kb = subk + (size_t)hc * 128 * 64;
  for (int n = 0; n < 128; ++n) {
    float sc = 0.f;
#pragma unroll
    for (int d = 0; d < 64; ++d) sc = fmaf(qv[d], kb[n * 64 + d], sc);
    INS16(sc, n);
  }
  float* ov = tvo + ((size_t)t * 16 + hc) * 16;
  int* oi = tio + ((size_t)t * 16 + hc) * 16;
#pragma unroll
  for (int z = 0; z < 16; ++z) { ov[z] = tv[z]; oi[z] = ti[z]; }
}

__global__ void __launch_bounds__(256) k_peer_topk2(const float* __restrict__ tvi, const int* __restrict__ tii,
                                                    float* __restrict__ gates, int* __restrict__ eidx) {
  const size_t th = (size_t)blockIdx.x * 256 + threadIdx.x;
  const float* a = tvi + th * 32; const float* bb = a + 16;
  const int* ia = tii + th * 32; const int* ib = ia + 16;
  float av[16], bv[16]; int ai[16], bi[16];
#pragma unroll
  for (int z = 0; z < 16; ++z) { av[z] = a[z]; bv[z] = bb[z]; ai[z] = ia[z]; bi[z] = ib[z]; }
  float tv[16]; int ti[16];
#pragma unroll
  for (int z = 0; z < 16; ++z) { tv[z] = -INFINITY; ti[z] = 0; }
#pragma unroll
  for (int i = 0; i < 16; ++i) {
#pragma unroll
    for (int j = 0; j < 16; ++j) { INS16(av[i] + bv[j], ai[i] * 128 + bi[j]); }
  }
  float mx = tv[0], sum = 0.f, ev[16];
#pragma unroll
  for (int z = 0; z < 16; ++z) { ev[z] = expf(tv[z] - mx); sum += ev[z]; }
  float inv = 1.0f / sum;
#pragma unroll
  for (int z = 0; z < 16; ++z) { gates[th * 16 + z] = ev[z] * inv; eidx[th * 16 + z] = ti[z]; }
}

__global__ void __launch_bounds__(256) k_peer_apply(float* __restrict__ x, const float* __restrict__ rstd, const float* __restrict__ g2,
                                                    const float* __restrict__ gates, const int* __restrict__ eidx,
                                                    const float* __restrict__ U, const float* __restrict__ V) {
  __shared__ float coef[128];
  __shared__ int es[128];
  const int t = blockIdx.x, tid = threadIdx.x, wv = tid >> 6, lane = tid & 63;
  if (tid < 128) es[tid] = eidx[(size_t)t * 128 + tid];
  const float r = rstd[t];
  float4 hv[4];
#pragma unroll
  for (int i = 0; i < 4; ++i) {
    float4 xv = *(const float4*)(x + (size_t)t * D + (lane + i * 64) * 4);
    float4 gv = *(const float4*)(g2 + (lane + i * 64) * 4);
    hv[i].x = xv.x * r * gv.x; hv[i].y = xv.y * r * gv.y; hv[i].z = xv.z * r * gv.z; hv[i].w = xv.w * r * gv.w;
  }
  __syncthreads();
  for (int k = 0; k < 32; ++k) {
    int j = wv * 32 + k;
    const float4* up = (const float4*)(U + (size_t)es[j] * D);
    float dsum = 0.f;
#pragma unroll
    for (int i = 0; i < 4; ++i) {
      float4 uv = up[lane + i * 64];
      dsum += hv[i].x * uv.x + hv[i].y * uv.y + hv[i].z * uv.z + hv[i].w * uv.w;
    }
    dsum = wave_sum(dsum);
    if (lane == 0) coef[j] = gates[(size_t)t * 128 + j] * gelu_tanh(dsum);
  }
  __syncthreads();
  float4 acc = {0.f, 0.f, 0.f, 0.f};
  for (int j = 0; j < 128; ++j) {
    float c = coef[j];
    float4 vv = *(const float4*)(V + (size_t)es[j] * D + tid * 4);
    acc.x = fmaf(c, vv.x, acc.x); acc.y = fmaf(c, vv.y, acc.y); acc.z = fmaf(c, vv.z, acc.z); acc.w = fmaf(c, vv.w, acc.w);
  }
  float4* xp = (float4*)(x + (size_t)t * D + tid * 4);
  float4 xv = *xp;
  xv.x += acc.x; xv.y += acc.y; xv.z += acc.z; xv.w += acc.w;
  *xp = xv;
}

}

extern "C" void kernel_launch(void* const* d_in, const int* in_sizes, int n_in, void* d_out, int out_size, void* d_ws, size_t ws_size,
                              hipStream_t stream) {
  const float* x_in = (const float*)d_in[0];
  const float* norm1_g = (const float*)d_in[1];
  const float* w_in = (const float*)d_in[2];
  const float* lam_re = (const float*)d_in[3];
  const float* lam_im = (const float*)d_in[4];
  const float* log_dt = (const float*)d_in[5];
  const float* b_re = (const float*)d_in[6];
  const float* b_im = (const float*)d_in[7];
  const float* c_re = (const float*)d_in[8];
  const float* c_im = (const float*)d_in[9];
  const float* s5_d = (const float*)d_in[10];
  const float* w_glu = (const float*)d_in[11];
  const float* moba_qg = (const float*)d_in[12];
  const float* moba_kg = (const float*)d_in[13];
  const float* mix_g = (const float*)d_in[14];
  const float* w_out = (const float*)d_in[15];
  const float* norm2_g = (const float*)d_in[16];
  const float* peer_wq = (const float*)d_in[17];
  const float* peer_sk = (const float*)d_in[18];
  const float* peer_u = (const float*)d_in[19];
  const float* peer_v = (const float*)d_in[20];
  float* x = (float*)d_out;

  float* ws = (float*)d_ws;
  size_t o = 0;
  auto take = [&](size_t n) { float* p = ws + o; o += (n + 63) & ~(size_t)63; return p; };
  float* rstd = take(T);
  float* cosm = take(S * 8); float* sinm = take(S * 8);
  float* cosr = take(S * 32); float* sinr = take(S * 32);
  float* kmean = take(NB * 8 * 16 * 64);
  float* proj = take((size_t)T * INW);
  float* ybuf = take((size_t)T * D);
  float* yg = take((size_t)T * 256);
  float* tv1 = take((size_t)T * 256); int* ti1 = (int*)take((size_t)T * 256);
  float* gates = take((size_t)T * 128); int* eidx = (int*)take((size_t)T * 128);
  float* qp = proj;

  k_tables<<<(S * 40 + 255) / 256, 256, 0, stream>>>(cosm, sinm, cosr, sinr);
  k_copy4<<<4096, 256, 0, stream>>>((const float4*)x_in, (float4*)x, (size_t)T * D / 4);

  for (int l = 0; l < NL; ++l) {
    k_rstd<<<T / 4, 256, 0, stream>>>(x, rstd);
    k_gemm<0><<<dim3(INW / 128, T / 128), 256, 0, stream>>>(x, D, norm1_g + l * D, w_in + (size_t)l * D * INW, INW, proj, INW, rstd, D);
    k_postproj<<<T * 24 / 4, 256, 0, stream>>>(proj, moba_qg + l * 64, moba_kg + l * 64, cosm, sinm, cosr, sinr);
    k_kmean<<<NB * 8 * 16 * 64 / 256, 256, 0, stream>>>(proj, kmean);
    k_s5<<<NB * 16, 64, 0, stream>>>(proj, lam_re + l * 1024, lam_im + l * 1024, log_dt + l * 16, b_re + l * 16384, b_im + l * 16384,
                                     c_re + l * 16384, c_im + l * 16384, s5_d + l * 256, yg);
    k_s5glu<<<T, 256, 0, stream>>>(yg, w_glu + (size_t)l * 65536, mix_g + l * D, ybuf);
    k_moba<<<T * 8 / 4, 256, 0, stream>>>(proj, kmean, mix_g + l * D, ybuf);
    k_ret<<<NB * 4, 256, 0, stream>>>(proj, mix_g + l * D, ybuf);
    k_gemm<1><<<dim3(D / 128, T / 128), 256, 0, stream>>>(ybuf, D, nullptr, w_out + (size_t)l * D * D, D, x, D, nullptr, D);
    k_rstd<<<T / 4, 256, 0, stream>>>(x, rstd);
    k_gemm<0><<<dim3(D / 128, T / 128), 256, 0, stream>>>(x, D, norm2_g + l * D, peer_wq + (size_t)l * D * D, D, qp, D, rstd, D);
    k_peer_topk1<<<dim3(T / 256, 16), 256, 0, stream>>>(qp, peer_sk + (size_t)l * 16 * 128 * 64, tv1, ti1);
    k_peer_topk2<<<T * 8 / 256, 256, 0, stream>>>(tv1, ti1, gates, eidx);
    k_peer_apply<<<T, 256, 0, stream>>>(x, rstd, norm2_g + l * D, gates, eidx, peer_u + (size_t)l * 16384 * D, peer_v + (size_t)l * 16384 * D);
  }
}
```

```cpp
#include <hip/hip_runtime.h>
#include <hip/hip_cooperative_groups.h>
#include <math.h>
#include <stdint.h>
#include <stdio.h>
namespace cg = cooperative_groups;

#ifndef PRECISE
#define PRECISE 0
#endif

namespace {
constexpr int NB = 8, S = 4096, D = 1024, NL = 4, T = NB * S;
constexpr int INW = 2816;
constexpr int OFF_U = 0, OFF_QM = 256, OFF_KM = 768, OFF_VM = 1280, OFF_QR = 1792, OFF_KR = 2048, OFF_VR = 2304, OFF_GR = 2560;
constexpr float EPS = 1e-6f;
constexpr int KS = PRECISE ? 3 : 1;
constexpr int KD = D * KS;
constexpr int NTHR = 512, NWAVE = 8;
constexpr int LDS_BYTES = 131072 + 4096 + 1024;

typedef unsigned short bf16_t;
using bf16x8 = __attribute__((ext_vector_type(8))) short;
using f32x4 = __attribute__((ext_vector_type(4))) float;

__device__ __forceinline__ float wave_sum(float v) {
#pragma unroll
  for (int o = 32; o > 0; o >>= 1) v += __shfl_xor(v, o);
  return v;
}
__device__ __forceinline__ float wave_max(float v) {
#pragma unroll
  for (int o = 32; o > 0; o >>= 1) v = fmaxf(v, __shfl_xor(v, o));
  return v;
}
__device__ __forceinline__ float gelu_tanh(float x) {
  const float k0 = 0.7978845608028654f, k1 = 0.044715f;
  float u = k0 * (x + k1 * x * x * x);
  return 0.5f * x * (1.0f + tanhf(u));
}
__device__ __forceinline__ float sigmoidf_(float x) { return 1.0f / (1.0f + expf(-x)); }
__device__ __forceinline__ float fast_sigmoid(float x) { return __builtin_amdgcn_rcpf(1.0f + __builtin_amdgcn_exp2f(-1.4426950408889634f * x)); }
__device__ __forceinline__ float fast_gelu(float x) { const float u = 0.7978845608028654f * (x + 0.044715f * x * x * x); return x * fast_sigmoid(2.0f * u); }
__device__ __forceinline__ bf16_t f2bf(float f) {
  unsigned u = __float_as_uint(f);
  u += 0x7fffu + ((u >> 16) & 1u);
  return (bf16_t)(u >> 16);
}
__device__ __forceinline__ float bf2f(bf16_t h) { return __uint_as_float(((unsigned)h) << 16); }
#define LDS_FENCE() asm volatile("s_waitcnt lgkmcnt(0)" ::: "memory")
__device__ __forceinline__ unsigned pk_bf16(float lo, float hi) { unsigned r; asm("v_cvt_pk_bf16_f32 %0, %1, %2" : "=v"(r) : "v"(lo), "v"(hi)); return r; }
typedef float f32x16 __attribute__((ext_vector_type(16)));

constexpr size_t al256(size_t x) { return (x + 255) & ~(size_t)255; }
constexpr size_t WO_rstd = 0;
constexpr size_t WO_cosm = WO_rstd + al256((size_t)T * 4);
constexpr size_t WO_sinm = WO_cosm + al256((size_t)S * 8 * 4);
constexpr size_t WO_cosr = WO_sinm + al256((size_t)S * 8 * 4);
constexpr size_t WO_sinr = WO_cosr + al256((size_t)S * 32 * 4);
constexpr size_t WO_kmean = WO_sinr + al256((size_t)S * 32 * 4);
constexpr size_t WO_proj = WO_kmean + al256((size_t)NB * 8 * 16 * 64 * 4);
constexpr size_t WO_ybuf = WO_proj + al256((size_t)T * INW * 4);
constexpr size_t WO_yg = WO_ybuf + al256((size_t)T * D * 4);
constexpr size_t WO_skb = WO_yg + al256((size_t)T * 256 * 4);
constexpr size_t WO_Ub = WO_skb + al256((size_t)NL * 16 * 128 * 64 * 2);
constexpr size_t WO_Vb = WO_Ub + al256((size_t)16384 * D * 2);
constexpr size_t WO_gates = WO_Vb + al256((size_t)16384 * D * 2);
constexpr size_t WO_eidx = WO_gates + al256((size_t)T * 128 * 4);
constexpr size_t WO_xb = WO_eidx + al256((size_t)T * 128 * 4);
constexpr size_t WO_Win_t = WO_xb + al256((size_t)T * KD * 2);
constexpr size_t WO_Wout_t = WO_Win_t + al256((size_t)NL * INW * KD * 2);
constexpr size_t WO_Wq_t = WO_Wout_t + al256((size_t)NL * D * KD * 2);
constexpr size_t WO_Qm = WO_Wq_t + al256((size_t)NL * D * KD * 2);
constexpr size_t WO_Km = WO_Qm + al256((size_t)T * 512 * 2);
constexpr size_t WO_Vm = WO_Km + al256((size_t)T * 512 * 2);
constexpr size_t WO_S5a32 = WO_Vm + al256((size_t)T * 512 * 2);
constexpr size_t WO_Wglu_t = WO_S5a32 + al256((size_t)16 * 64 * 2 * 4);
constexpr size_t WS_TOTAL = WO_Wglu_t + al256((size_t)NL * 256 * 256 * 2);
constexpr size_t WO_S5A = WO_gates;
constexpr size_t WO_S5Z = WO_S5A + al256((size_t)16 * 1024 * 640 * 2);
static_assert(WO_S5Z + (size_t)16 * 1024 * 128 * 4 <= WO_gates + 2 * al256((size_t)T * 128 * 4), "S5A/S5Z must fit in gates+eidx");
constexpr size_t WO_S5Wy = WO_Ub;
constexpr size_t WO_S5Wz = WO_S5Wy + al256((size_t)16 * 512 * 640 * 2);
static_assert(WO_S5Wz + (size_t)16 * 256 * 512 * 2 <= WO_Ub + 2 * al256((size_t)16384 * D * 2), "S5 weights must fit in Ub/Vb");
struct Params {
  const float* in[21];
  float* out;
  unsigned char* ws;
  __device__ __forceinline__ float* rstd() const { return (float*)(ws + WO_rstd); }
  __device__ __forceinline__ float* cosm() const { return (float*)(ws + WO_cosm); }
  __device__ __forceinline__ float* sinm() const { return (float*)(ws + WO_sinm); }
  __device__ __forceinline__ float* cosr() const { return (float*)(ws + WO_cosr); }
  __device__ __forceinline__ float* sinr() const { return (float*)(ws + WO_sinr); }
  __device__ __forceinline__ float* kmean() const { return (float*)(ws + WO_kmean); }
  __device__ __forceinline__ float* proj() const { return (float*)(ws + WO_proj); }
  __device__ __forceinline__ float* ybuf() const { return (float*)(ws + WO_ybuf); }
  __device__ __forceinline__ float* yg() const { return (float*)(ws + WO_yg); }
  __device__ __forceinline__ bf16_t* skb() const { return (bf16_t*)(ws + WO_skb); }
  __device__ __forceinline__ bf16_t* Ub() const { return (bf16_t*)(ws + WO_Ub); }
  __device__ __forceinline__ bf16_t* Vb() const { return (bf16_t*)(ws + WO_Vb); }
  __device__ __forceinline__ float* gates() const { return (float*)(ws + WO_gates); }
  __device__ __forceinline__ int* eidx() const { return (int*)(ws + WO_eidx); }
  __device__ __forceinline__ bf16_t* xb() const { return (bf16_t*)(ws + WO_xb); }
  __device__ __forceinline__ bf16_t* Win_t() const { return (bf16_t*)(ws + WO_Win_t); }
  __device__ __forceinline__ bf16_t* Wout_t() const { return (bf16_t*)(ws + WO_Wout_t); }
  __device__ __forceinline__ bf16_t* Wq_t() const { return (bf16_t*)(ws + WO_Wq_t); }
  __device__ __forceinline__ bf16_t* Qm() const { return (bf16_t*)(ws + WO_Qm); }
  __device__ __forceinline__ bf16_t* Km() const { return (bf16_t*)(ws + WO_Km); }
  __device__ __forceinline__ bf16_t* Vm() const { return (bf16_t*)(ws + WO_Vm); }
  __device__ __forceinline__ bf16_t* S5A() const { return (bf16_t*)(ws + WO_S5A); }
  __device__ __forceinline__ bf16_t* S5Wy() const { return (bf16_t*)(ws + WO_S5Wy); }
  __device__ __forceinline__ bf16_t* S5Wz() const { return (bf16_t*)(ws + WO_S5Wz); }
  __device__ __forceinline__ float* S5Z() const { return (float*)(ws + WO_S5Z); }
  __device__ __forceinline__ float* S5a32() const { return (float*)(ws + WO_S5a32); }
  __device__ __forceinline__ bf16_t* Wglu_t() const { return (bf16_t*)(ws + WO_Wglu_t); }
  __device__ __forceinline__ bf16_t* ygb() const { return (bf16_t*)(ws + WO_yg); }
  __device__ __forceinline__ bf16_t* qb() const { return (bf16_t*)(ws + WO_proj); }
};

namespace pg8 {
#define PG8_LAS __attribute__((address_space(3)))
typedef unsigned short bf16_t;
typedef short bf16x8 __attribute__((ext_vector_type(8)));
typedef float f32x4 __attribute__((ext_vector_type(4)));
typedef unsigned u32x4 __attribute__((ext_vector_type(4)));
constexpr int BM = 256, BK = 64, HALF = 128, HTB = HALF * BK * 2  , STAGE_BYTES = 8 * HTB, NXCD = 8, WGM = 8;

__host__ __device__ __forceinline__ int lds_byte(int r, int c) { const int st = (r >> 4) * 2 + (c >> 5), rr = r & 15, cc = c & 31, ob = rr * 64 + cc * 2; return st * 1024 + (ob ^ (((ob >> 9) & 1) << 5)); }
__host__ __device__ __forceinline__ void stage_rc(int b, int& R, int& C) { const int st = b / 1024, sb = b % 1024, swz = sb ^ (((sb >> 9) & 1) << 5); R = (st >> 1) * 16 + swz / 64; C = (st & 1) * 32 + (swz % 64) / 2; }
__host__ __device__ __forceinline__ int perm32(int rho) { const int n = rho >> 4, i = rho & 15; return 8 * (i >> 2) + 4 * n + (i & 3); }

struct Unit { int pm, pn; };
struct Gemm { const bf16_t* A; const bf16_t* Bt; int M, N, K, lda, ldb; };

struct StaticOrder {
    int nM, nN, nwg, G, c;
    __host__ __device__ void init(int M, int N, int G_, int c_) { nM = M / BM; nN = N / BM; nwg = nM * nN; G = G_; c = c_; }
    __host__ __device__ bool next(int i, Unit& u) const {
        const long L = (long)i * G + c; if (L >= nwg) return false;
        int wgid = (int)L; { const int q = nwg / NXCD, r = nwg % NXCD, xcd = wgid % NXCD, off = wgid / NXCD; wgid = (xcd < r ? xcd * (q + 1) : r * (q + 1) + (xcd - r) * q) + off; }
        const int nig = WGM * nN, gid = wgid / nig, fm = gid * WGM, gsz = (nM - fm) < WGM ? (nM - fm) : WGM;
        u.pm = fm + ((wgid % nig) % gsz); u.pn = (wgid % nig) / gsz; return true;
    }
    __device__ __forceinline__ void a_ready(const Unit&) const {}
    __device__ __forceinline__ void done(const Unit&) const {}
};
struct GroupOrder {
    int mt, nt_, nwg, G, c;
    __host__ __device__ void init(int ngroups, int mt__, int nt__, int G_, int c_) { mt = mt__; nt_ = nt__; nwg = ngroups * mt * nt_; G = G_; c = c_; }
    __host__ __device__ bool next(int i, Unit& u) const {
        const long L = (long)i * G + c; if (L >= nwg) return false;
        const int per = mt * nt_, gi = (int)L / per, r = (int)L % per;
        u.pm = gi * mt + r % mt; u.pn = gi * nt_ + r / mt; return true;
    }
    __device__ __forceinline__ void a_ready(const Unit&) const {}
    __device__ __forceinline__ void done(const Unit&) const {}
};
template <class Epi, class Sched, bool ALIGN_EPI = false, bool SP2 = false>
__device__ __forceinline__ void gemm_phase(PG8_LAS unsigned char* lds, const Gemm g, const Sched& S, const Epi& E) {
    int tid_ = threadIdx.x; asm volatile("" : "+v"(tid_));
    const int tid = tid_, wid = __builtin_amdgcn_readfirstlane(tid >> 6), lane = tid & 63, wr = wid >> 2, wc = wid & 3, fr = lane & 15, fq = lane >> 4;
    const int K = g.K, nt = K / BK;
    unsigned voffA[2], voffB[2];
#pragma unroll
    for (int i = 0; i < 2; ++i) { int R, C; stage_rc(tid * 16 + i * 8192, R, C); const int Rb = Epi::PERM ? ((R & ~31) + perm32(R & 31)) : R;
        voffA[i] = (unsigned)(R * g.lda + C) * 2u; voffB[i] = (unsigned)(Rb * g.ldb + C) * 2u; }
    const size_t kstep = (size_t)(BK * 2);
    const size_t hstepA = (size_t)HALF * g.lda * 2, hstepB = (size_t)HALF * g.ldb * 2;
    const size_t tstepA = 2 * hstepA, tstepB = 2 * hstepB;
    const unsigned ldsw = (unsigned)wid * 1024u;
    const int aoff = lds_byte(wr * 64 + fr, fq * 8), boff = lds_byte(wc * 32 + fr, fq * 8);
#define PG8_SA(b, h) (((b) * 2 + (h)) * HTB)
#define PG8_SB(b, h) ((4 + (b) * 2 + (h)) * HTB)
#define PG8_STAGE(bufoff, gbase, voff) do { _Pragma("unroll") for (int _i = 0; _i < 2; ++_i) \
        __builtin_amdgcn_global_load_lds((const unsigned*)((const char*)(gbase) + (voff)[_i]), (PG8_LAS unsigned*)(lds + (bufoff) + ldsw + _i * 8192), 16, 0, 0); } while (0)
#define PG8_LDA(dst, b, h) do { _Pragma("unroll") for (int m = 0; m < 4; ++m) _Pragma("unroll") for (int k = 0; k < 2; ++k) dst[m][k] = *(const PG8_LAS bf16x8*)(lds + PG8_SA(b, h) + aoff + m * 2048 + k * 1024); } while (0)
#define PG8_LDB(dst, b, h) do { _Pragma("unroll") for (int n = 0; n < 2; ++n) _Pragma("unroll") for (int k = 0; k < 2; ++k) dst[n][k] = *(const PG8_LAS bf16x8*)(lds + PG8_SB(b, h) + boff + n * 2048 + k * 1024); } while (0)
#define PG8_MMA(ai, bj, At, Bt) do { __builtin_amdgcn_s_setprio(1); _Pragma("unroll") for (int m = 0; m < 4; ++m) _Pragma("unroll") for (int n = 0; n < 2; ++n) _Pragma("unroll") for (int k = 0; k < 2; ++k) \
        acc[ai][bj][m][n] = __builtin_amdgcn_mfma_f32_16x16x32_bf16(Bt[n][k], At[m][k], acc[ai][bj][m][n], 0, 0, 0); __builtin_amdgcn_s_setprio(0); } while (0)
#define PG8_WAIT_V(n) asm volatile("s_waitcnt vmcnt(" #n ")" ::: "memory")
#define PG8_WAIT_L(n) asm volatile("s_waitcnt lgkmcnt(" #n ")" ::: "memory")
#define PG8_BAR __builtin_amdgcn_s_barrier()
#define PG8_SCHED __builtin_amdgcn_sched_barrier(0)
    Unit cur, nxt; int ui = 0;
    if (!S.next(0, cur)) return;
    f32x4 acc[2][2][4][2];
    E.init(acc, cur, wr, wc, fr, fq);
    bf16x8 At[4][2], B0[2][2], B1[2][2];
    const char* cA = (const char*)g.A + (size_t)cur.pm * tstepA; const char* cB = (const char*)g.Bt + (size_t)cur.pn * tstepB;
    S.a_ready(cur);
    if constexpr (SP2) {
        PG8_STAGE(PG8_SB(0, 0), cB, voffB); PG8_STAGE(PG8_SB(0, 1), cB + hstepB, voffB); PG8_STAGE(PG8_SA(0, 0), cA, voffA); PG8_STAGE(PG8_SA(0, 1), cA + hstepA, voffA);
        if (wr == 1) PG8_BAR;
        PG8_WAIT_V(2); PG8_BAR;
        PG8_STAGE(PG8_SB(1, 0), cB + kstep, voffB); PG8_STAGE(PG8_SA(1, 0), cA + kstep, voffA); PG8_STAGE(PG8_SB(1, 1), cB + hstepB + kstep, voffB);
        PG8_WAIT_V(6); PG8_BAR;
    } else {
        PG8_STAGE(PG8_SB(0, 0), cB, voffB); PG8_STAGE(PG8_SA(0, 0), cA, voffA); PG8_STAGE(PG8_SB(0, 1), cB + hstepB, voffB); PG8_STAGE(PG8_SA(0, 1), cA + hstepA, voffA);
        if (wr == 1) PG8_BAR;
        PG8_WAIT_V(4); PG8_BAR;
        PG8_STAGE(PG8_SB(1, 0), cB + kstep, voffB); PG8_STAGE(PG8_SA(1, 0), cA + kstep, voffA); PG8_STAGE(PG8_SB(1, 1), cB + hstepB + kstep, voffB);
        PG8_WAIT_V(6); PG8_BAR;
    }
    for (;;) {
        const bool has_next = S.next(ui + 1, nxt);
        const char* nA = has_next ? (const char*)g.A + (size_t)nxt.pm * tstepA : cA; const char* nB = has_next ? (const char*)g.Bt + (size_t)nxt.pn * tstepB : cB;
        for (int t = 0; t < nt; t += 2) {
            const bool last = (t == nt - 2);
            const char* a1 = cA + (size_t)(t + 1) * kstep;
            const char* a2 = last ? nA : cA + (size_t)(t + 2) * kstep; const char* b2 = last ? nB : cB + (size_t)(t + 2) * kstep;
            const char* a3 = a2 + kstep; const char* b3 = b2 + kstep;
            if (last && has_next) S.a_ready(nxt);
            if constexpr (SP2) {
            PG8_LDB(B0, 0, 0); PG8_LDB(B1, 0, 1); PG8_SCHED; PG8_LDA(At, 0, 0); PG8_STAGE(PG8_SA(1, 1), a1 + hstepA, voffA);
            PG8_WAIT_V(8); PG8_WAIT_L(0); PG8_BAR; PG8_MMA(0, 0, At, B0); PG8_MMA(0, 1, At, B1); PG8_BAR; PG8_SCHED;
            PG8_LDA(At, 0, 1); PG8_STAGE(PG8_SB(0, 0), b2, voffB); PG8_STAGE(PG8_SB(0, 1), b2 + hstepB, voffB); PG8_STAGE(PG8_SA(0, 0), a2, voffA);
            PG8_WAIT_V(8); PG8_WAIT_L(0); PG8_BAR; PG8_MMA(1, 0, At, B0); PG8_MMA(1, 1, At, B1); PG8_BAR; PG8_SCHED;
            PG8_LDB(B0, 1, 0); PG8_LDB(B1, 1, 1); PG8_SCHED; PG8_LDA(At, 1, 0); PG8_STAGE(PG8_SA(0, 1), a2 + hstepA, voffA);
            PG8_WAIT_V(8); PG8_WAIT_L(0); PG8_BAR; PG8_MMA(0, 0, At, B0); PG8_MMA(0, 1, At, B1); PG8_BAR; PG8_SCHED;
            PG8_LDA(At, 1, 1); PG8_STAGE(PG8_SB(1, 0), b3, voffB); PG8_STAGE(PG8_SB(1, 1), b3 + hstepB, voffB); PG8_STAGE(PG8_SA(1, 0), a3, voffA);
            PG8_WAIT_V(8); PG8_WAIT_L(0); PG8_BAR; PG8_MMA(1, 0, At, B0); PG8_MMA(1, 1, At, B1); PG8_BAR; PG8_SCHED;
            } else {
            PG8_LDB(B0, 0, 0); PG8_SCHED; PG8_LDA(At, 0, 0); PG8_STAGE(PG8_SA(1, 1), a1 + hstepA, voffA);
            PG8_WAIT_L(8); PG8_BAR; PG8_WAIT_L(0); PG8_MMA(0, 0, At, B0); PG8_BAR; PG8_SCHED;
            PG8_LDB(B1, 0, 1); PG8_STAGE(PG8_SB(0, 0), b2, voffB);
            PG8_BAR; PG8_WAIT_L(0); PG8_MMA(0, 1, At, B1); PG8_BAR;
            PG8_LDA(At, 0, 1); PG8_STAGE(PG8_SA(0, 0), a2, voffA);
            PG8_BAR; PG8_WAIT_L(0); PG8_MMA(1, 0, At, B0); PG8_BAR; PG8_SCHED;
            PG8_STAGE(PG8_SB(0, 1), b2 + hstepB, voffB);
            PG8_WAIT_V(6); PG8_BAR; PG8_MMA(1, 1, At, B1); PG8_BAR;
            PG8_LDB(B0, 1, 0); PG8_SCHED; PG8_LDA(At, 1, 0); PG8_STAGE(PG8_SA(0, 1), a2 + hstepA, voffA);
            PG8_WAIT_L(8); PG8_BAR; PG8_WAIT_L(0); PG8_MMA(0, 0, At, B0); PG8_BAR; PG8_SCHED;
            PG8_LDB(B1, 1, 1); PG8_STAGE(PG8_SB(1, 0), b3, voffB);
            PG8_BAR; PG8_WAIT_L(0); PG8_MMA(0, 1, At, B1); PG8_BAR;
            PG8_LDA(At, 1, 1); PG8_STAGE(PG8_SA(1, 0), a3, voffA);
            PG8_BAR; PG8_WAIT_L(0); PG8_MMA(1, 0, At, B0); PG8_BAR; PG8_SCHED;
            PG8_STAGE(PG8_SB(1, 1), b3 + hstepB, voffB);
            PG8_WAIT_V(6); PG8_BAR; PG8_MMA(1, 1, At, B1); PG8_BAR;
            }
        }
        if constexpr (ALIGN_EPI) { if (wr == 0) PG8_BAR; }
        if constexpr (!Epi::AFTER_DRAIN) { E(acc, cur, wr, wc, fr, fq); S.done(cur); }
        if (!has_next) break;
        E.init(acc, nxt, wr, wc, fr, fq);
        cur = nxt; cA = nA; cB = nB; ++ui;
        if constexpr (ALIGN_EPI) { if (wr == 1) PG8_BAR; }
    }
    PG8_WAIT_V(0);
    if constexpr (!ALIGN_EPI) { if (wr == 0) PG8_BAR; }
    PG8_BAR;
    if constexpr (Epi::AFTER_DRAIN) { E.fused(acc, cur, wr, wc, fr, fq, lds, wid, lane); S.done(cur); }
#undef PG8_SA
#undef PG8_SB
#undef PG8_STAGE
#undef PG8_LDA
#undef PG8_LDB
#undef PG8_MMA
#undef PG8_WAIT_V
#undef PG8_WAIT_L
#undef PG8_BAR
#undef PG8_SCHED
}
}
struct EpiScaleStore {
  static constexpr bool PERM = false, AFTER_DRAIN = false;
  float* C; int ldc; const float* rs;
  __device__ __forceinline__ void init(pg8::f32x4 (&acc)[2][2][4][2], const pg8::Unit&, int, int, int, int) const {
#pragma unroll
    for (int a = 0; a < 2; ++a)
#pragma unroll
      for (int b = 0; b < 2; ++b)
#pragma unroll
        for (int m = 0; m < 4; ++m)
#pragma unroll
          for (int n = 0; n < 2; ++n) acc[a][b][m][n] = (pg8::f32x4){0.f, 0.f, 0.f, 0.f};
  }
  __device__ __forceinline__ void operator()(const pg8::f32x4 (&acc)[2][2][4][2], const pg8::Unit& u, int wr, int wc, int fr_in, int fq_in) const {
    int fr = fr_in, fq = fq_in; asm volatile("" : "+v"(fr), "+v"(fq));
#pragma unroll
    for (int ai = 0; ai < 2; ++ai)
#pragma unroll
      for (int m = 0; m < 4; ++m) {
        const int row = u.pm * 256 + ai * 128 + wr * 64 + m * 16 + fr;
        const float r = rs[row];
#pragma unroll
        for (int bj = 0; bj < 2; ++bj)
#pragma unroll
          for (int n = 0; n < 2; ++n) {
            const int col = u.pn * 256 + bj * 128 + wc * 32 + n * 16 + 4 * fq;
            pg8::f32x4 v = acc[ai][bj][m][n] * r;
            *(pg8::f32x4*)(C + (size_t)row * ldc + col) = v;
          }
        asm volatile("" ::: "memory");
      }
  }
};
struct EpiAccum {
  static constexpr bool PERM = false, AFTER_DRAIN = false;
  float* C; int ldc;
  __device__ __forceinline__ void init(pg8::f32x4 (&acc)[2][2][4][2], const pg8::Unit& u, int wr, int wc, int fr, int fq) const {
#pragma unroll
    for (int ai = 0; ai < 2; ++ai)
#pragma unroll
      for (int m = 0; m < 4; ++m) {
        const int row = u.pm * 256 + ai * 128 + wr * 64 + m * 16 + fr;
#pragma unroll
        for (int bj = 0; bj < 2; ++bj)
#pragma unroll
          for (int n = 0; n < 2; ++n) {
            const int col = u.pn * 256 + bj * 128 + wc * 32 + n * 16 + 4 * fq;
            acc[ai][bj][m][n] = *(const pg8::f32x4*)(C + (size_t)row * ldc + col);
          }
      }
  }
  __device__ __forceinline__ void operator()(const pg8::f32x4 (&acc)[2][2][4][2], const pg8::Unit& u, int wr, int wc, int fr_in, int fq_in) const {
    int fr = fr_in, fq = fq_in; asm volatile("" : "+v"(fr), "+v"(fq));
#pragma unroll
    for (int ai = 0; ai < 2; ++ai)
#pragma unroll
      for (int m = 0; m < 4; ++m) {
        const int row = u.pm * 256 + ai * 128 + wr * 64 + m * 16 + fr;
#pragma unroll
        for (int bj = 0; bj < 2; ++bj)
#pragma unroll
          for (int n = 0; n < 2; ++n) {
            const int col = u.pn * 256 + bj * 128 + wc * 32 + n * 16 + 4 * fq;
            *(pg8::f32x4*)(C + (size_t)row * ldc + col) = acc[ai][bj][m][n];
          }
        asm volatile("" ::: "memory");
      }
  }
};
struct EpiScaleStoreBf16 {
  static constexpr bool PERM = false, AFTER_DRAIN = false;
  bf16_t* C; int ldc; const float* rs;
  __device__ __forceinline__ void init(pg8::f32x4 (&acc)[2][2][4][2], const pg8::Unit&, int, int, int, int) const {
#pragma unroll
    for (int a = 0; a < 2; ++a)
#pragma unroll
      for (int b = 0; b < 2; ++b)
#pragma unroll
        for (int m = 0; m < 4; ++m)
#pragma unroll
          for (int n = 0; n < 2; ++n) acc[a][b][m][n] = (pg8::f32x4){0.f, 0.f, 0.f, 0.f};
  }
  __device__ __forceinline__ void operator()(const pg8::f32x4 (&acc)[2][2][4][2], const pg8::Unit& u, int wr, int wc, int fr_in, int fq_in) const {
    int fr = fr_in, fq = fq_in; asm volatile("" : "+v"(fr), "+v"(fq));
#pragma unroll
    for (int ai = 0; ai < 2; ++ai)
#pragma unroll
      for (int m = 0; m < 4; ++m) {
        const int row = u.pm * 256 + ai * 128 + wr * 64 + m * 16 + fr;
        const float r = rs[row];
#pragma unroll
        for (int bj = 0; bj < 2; ++bj)
#pragma unroll
          for (int n = 0; n < 2; ++n) {
            const int col = u.pn * 256 + bj * 128 + wc * 32 + n * 16 + 4 * fq;
            pg8::f32x4 v = acc[ai][bj][m][n] * r;
            uint2 o; o.x = pk_bf16(v[0], v[1]); o.y = pk_bf16(v[2], v[3]);
            *(uint2*)(C + (size_t)row * ldc + col) = o;
          }
        asm volatile("" ::: "memory");
      }
  }
};
template <class Epi>
__device__ __forceinline__ void run_gemm(unsigned char* lds_raw, const bf16_t* A, const bf16_t* Bt, int M, int N, int K, const Epi& e) {
  pg8::Gemm g{A, Bt, M, N, K, K, K}; pg8::StaticOrder So; So.init(M, N, (int)gridDim.x, (int)blockIdx.x);
  pg8::gemm_phase<Epi, pg8::StaticOrder, true, true>((PG8_LAS unsigned char*)lds_raw, g, So, e);
}

__device__ __forceinline__ void transpose_items(const float* __restrict__ W, int K, int N, const float* __restrict__ g, bf16_t* __restrict__ Wt, int gw, int ngw, int lane) {
  const int nkt = K / 64, nnt = N / 64;
  for (int it = gw; it < nkt * nnt; it += ngw) {
    int kt = it % nkt, ntile = it / nkt;
    int k0 = kt * 64, n = ntile * 64 + lane;
    float v[64];
#pragma unroll
    for (int i = 0; i < 64; ++i) v[i] = W[(size_t)(k0 + i) * N + n] * g[k0 + i];
    bf16_t* dst = Wt + (size_t)n * (K * KS) + k0;
#pragma unroll
    for (int c = 0; c < 8; ++c) {
      bf16_t hi[8], lo[8];
#pragma unroll
      for (int e = 0; e < 8; ++e) { hi[e] = f2bf(v[c * 8 + e]); lo[e] = f2bf(v[c * 8 + e] - bf2f(hi[e])); }
      uint4 ph, pl;
      ph.x = hi[0] | ((unsigned)hi[1] << 16); ph.y = hi[2] | ((unsigned)hi[3] << 16); ph.z = hi[4] | ((unsigned)hi[5] << 16); ph.w = hi[6] | ((unsigned)hi[7] << 16);
      pl.x = lo[0] | ((unsigned)lo[1] << 16); pl.y = lo[2] | ((unsigned)lo[3] << 16); pl.z = lo[4] | ((unsigned)lo[5] << 16); pl.w = lo[6] | ((unsigned)lo[7] << 16);
      *(uint4*)(dst + c * 8) = ph;
      if (PRECISE) { *(uint4*)(dst + K + c * 8) = pl; *(uint4*)(dst + 2 * K + c * 8) = ph; }
    }
  }
}

__device__ __forceinline__ void phase_cvt_rows(const float* __restrict__ src, bf16_t* __restrict__ dst, float* __restrict__ rstd, int gw, int ngw, int lane) {
  for (int t = gw; t < T; t += ngw) {
    const float4* p = (const float4*)(src + (size_t)t * D);
    float ss = 0.f;
#pragma unroll
    for (int i = 0; i < 4; ++i) {
      float4 v = p[lane + i * 64];
      ss += v.x * v.x + v.y * v.y + v.z * v.z + v.w * v.w;
      bf16_t h0 = f2bf(v.x), h1 = f2bf(v.y), h2 = f2bf(v.z), h3 = f2bf(v.w);
      uint2 ph; ph.x = h0 | ((unsigned)h1 << 16); ph.y = h2 | ((unsigned)h3 << 16);
      bf16_t* d = dst + (size_t)t * KD + (lane + i * 64) * 4;
      *(uint2*)d = ph;
      if (PRECISE) {
        bf16_t l0 = f2bf(v.x - bf2f(h0)), l1 = f2bf(v.y - bf2f(h1)), l2 = f2bf(v.z - bf2f(h2)), l3 = f2bf(v.w - bf2f(h3));
        uint2 pl; pl.x = l0 | ((unsigned)l1 << 16); pl.y = l2 | ((unsigned)l3 << 16);
        *(uint2*)(d + D) = ph; *(uint2*)(d + 2 * D) = pl;
      }
    }
    if (rstd) { ss = wave_sum(ss); if (lane == 0) rstd[t] = rsqrtf(ss / (float)D + EPS); }
  }
}

__device__ __forceinline__ void phase_prologue(const Params& p, int gtid, int ngt, int gw, int ngw, int lane) {
  for (int idx = gtid; idx < S * 40; idx += ngt) {
    int s = idx / 40, i = idx % 40;
    if (i < 8) {
      float inv = powf(500000.0f, -(float)(2 * i) / 16.0f);
      float ang = (float)s * inv;
      p.cosm()[s * 8 + i] = (float)cos((double)ang); p.sinm()[s * 8 + i] = (float)sin((double)ang);
    } else {
      int j = i - 8;
      float inv = powf(10000.0f, -((float)j / 31.0f));
      float ang = (float)s * inv;
      p.cosr()[s * 32 + j] = (float)cos((double)ang); p.sinr()[s * 32 + j] = (float)sin((double)ang);
    }
  }
  { const float4* a = (const float4*)p.in[0]; float4* b = (float4*)p.out;
    for (size_t i = gtid; i < (size_t)T * D / 4; i += ngt) b[i] = a[i]; }
  for (int idx = gtid; idx < NL * 65536; idx += ngt) { const int l2 = idx >> 16, n2 = (idx >> 8) & 255, k2 = idx & 255; p.Wglu_t()[idx] = f2bf(p.in[11][(size_t)l2 * 65536 + k2 * 256 + n2]); }
  for (int l = 0; l < NL; ++l) {
    transpose_items(p.in[2] + (size_t)l * D * INW, D, INW, p.in[1] + l * D, p.Win_t() + (size_t)l * INW * KD, gw, ngw, lane);
    transpose_items(p.in[15] + (size_t)l * D * D, D, D, p.in[14] + l * D, p.Wout_t() + (size_t)l * D * KD, gw, ngw, lane);
    transpose_items(p.in[17] + (size_t)l * D * D, D, D, p.in[16] + l * D, p.Wq_t() + (size_t)l * D * KD, gw, ngw, lane);
  }
}

__device__ __forceinline__ void phase_postproj(const Params& p, int l, int gw, int ngw, int lane) {
  const float* gq = p.in[12] + l * 64; const float* gk = p.in[13] + l * 64;
  for (int w = gw; w < T * 24; w += ngw) {
    int t = w / 24, slot = w % 24, s = t % S;
    float* row = p.proj() + (size_t)t * INW;
    if (slot < 16) {
      int h = slot & 7;
      float* q = row + (slot < 8 ? OFF_QM : OFF_KM) + h * 64;
      const float* g = slot < 8 ? gq : gk;
      float v = q[lane];
      float ss = wave_sum(v * v);
      float u = v * rsqrtf(ss / 64.0f + EPS) * g[lane];
      int partner = lane < 8 ? lane + 8 : lane - 8;
      float pu = __shfl(u, partner & 63);
      float o = u;
      if (lane < 16) {
        int i = lane & 7;
        float c = p.cosm()[s * 8 + i], sn = p.sinm()[s * 8 + i];
        o = lane < 8 ? (u * c - pu * sn) : (u * c + pu * sn);
      }
      q[lane] = o;
    } else {
      int h = (slot - 16) & 3; bool isk = slot >= 20;
      float* q = row + (isk ? OFF_KR : OFF_QR) + h * 64;
      float v = q[lane];
      float pv = __shfl(v, lane ^ 32);
      int i = lane & 31;
      float c = p.cosr()[s * 32 + i], sn = p.sinr()[s * 32 + i];
      float o = lane < 32 ? (v * c - pv * sn) : (v * c + pv * sn);
      if (isk) o *= 0.125f;
      q[lane] = o;
    }
  }
}

__device__ __forceinline__ void phase_kmean(const Params& p, int gtid, int ngt) {
  for (int idx = gtid; idx < NB * 8 * 16 * 64; idx += ngt) {
    int d = idx & 63, j = (idx >> 6) & 15, h = (idx >> 10) & 7, b = idx >> 13;
    const float* q = p.proj() + ((size_t)(b * S + j * 256)) * INW + OFF_KM + h * 64 + d;
    float acc = 0.f;
    for (int i = 0; i < 256; ++i) acc += q[(size_t)i * INW];
    p.kmean()[idx] = acc / 256.0f;
  }
}

__device__ __forceinline__ void s5_unit(const Params& p, int l, int unit, float* red, int lane) {
  const int b = unit >> 4, g = unit & 15, pp = lane;
  const float* lam_re = p.in[3] + l * 1024; const float* lam_im = p.in[4] + l * 1024; const float* log_dt = p.in[5] + l * 16;
  const float* b_re = p.in[6] + l * 16384; const float* b_im = p.in[7] + l * 16384;
  const float* c_re = p.in[8] + l * 16384; const float* c_im = p.in[9] + l * 16384; const float* dskip = p.in[10] + l * 256;
  float lr = lam_re[g * 64 + pp], li = lam_im[g * 64 + pp];
  float dt = expf(log_dt[g]);
  float mag = expf(lr * dt);
  float ar = mag * cosf(li * dt), ai = mag * sinf(li * dt);
  float den = lr * lr + li * li;
  float fr = ((ar - 1.0f) * lr + ai * li) / den;
  float fi = (ai * lr - (ar - 1.0f) * li) / den;
  float bbr[16], bbi[16], cr[16], ci[16];
#pragma unroll
  for (int h = 0; h < 16; ++h) {
    float br = b_re[(g * 64 + pp) * 16 + h], bi = b_im[(g * 64 + pp) * 16 + h];
    bbr[h] = fr * br - fi * bi; bbi[h] = fr * bi + fi * br;
    cr[h] = c_re[(g * 16 + h) * 64 + pp]; ci[h] = c_im[(g * 16 + h) * 64 + pp];
  }
  const int hq = pp >> 2, qq = pp & 3;
  float dsk = dskip[g * 16 + hq];
  float sr = 0.f, si = 0.f;
  for (int t = 0; t < S; ++t) {
    const float* up = p.proj() + (size_t)(b * S + t) * INW + OFF_U + g * 16;
    float u[16];
#pragma unroll
    for (int h4 = 0; h4 < 4; ++h4) { float4 v = *(const float4*)(up + h4 * 4); u[h4 * 4] = v.x; u[h4 * 4 + 1] = v.y; u[h4 * 4 + 2] = v.z; u[h4 * 4 + 3] = v.w; }
    float bur = 0.f, bui = 0.f;
#pragma unroll
    for (int h = 0; h < 16; ++h) { bur = fmaf(u[h], bbr[h], bur); bui = fmaf(u[h], bbi[h], bui); }
    float nr = ar * sr - ai * si + bur, ni = ar * si + ai * sr + bui;
    sr = nr; si = ni;
    LDS_FENCE();
#pragma unroll
    for (int h = 0; h < 16; ++h) red[h * 65 + pp] = sr * cr[h] - si * ci[h];
    LDS_FENCE();
    float acc = 0.f;
#pragma unroll
    for (int i = 0; i < 16; ++i) acc += red[hq * 65 + qq * 16 + i];
    acc += __shfl_xor(acc, 1);
    acc += __shfl_xor(acc, 2);
    if (qq == 0) p.yg()[(size_t)(b * S + t) * 256 + g * 16 + hq] = gelu_tanh(acc + up[hq] * dsk);
  }
}

__device__ __forceinline__ void ret_units(const Params& p, int l, int unit0, float* lds) {
  constexpr int TB = 16;
  int tx_ = threadIdx.x; asm volatile("" : "+v"(tx_));
  const int vb = tx_ >> 8, tid = tx_ & 255;
  float* base_l = lds + vb * (TB * 64 * 3 + TB * 4 * 64);
  float* qs = base_l; float* ks = qs + TB * 64; float* vs = ks + TB * 64; float* red = vs + TB * 64;
  const int unit = unit0 + vb;
  const int b = unit >> 2, h = unit & 3;
  const int e = tid & 63, dg = tid >> 6;
  const float gamma = 1.0f - exp2f(-5.0f - (float)h);
  float St[16];
#pragma unroll
  for (int i = 0; i < 16; ++i) St[i] = 0.f;
  const float* base = p.proj() + (size_t)(b * S) * INW;
  for (int t0 = 0; t0 < S; t0 += TB) {
    __syncthreads();
    for (int i = tid; i < TB * 64; i += 256) {
      int tt = i >> 6, d = i & 63;
      const float* r = base + (size_t)(t0 + tt) * INW;
      qs[tt * 64 + d] = r[OFF_QR + h * 64 + d]; ks[tt * 64 + d] = r[OFF_KR + h * 64 + d]; vs[tt * 64 + d] = r[OFF_VR + h * 64 + d];
    }
    __syncthreads();
    for (int tt = 0; tt < TB; ++tt) {
      float ve = vs[tt * 64 + e], part = 0.f;
#pragma unroll
      for (int i = 0; i < 16; ++i) {
        St[i] = fmaf(gamma, St[i], ks[tt * 64 + dg * 16 + i] * ve);
        part = fmaf(qs[tt * 64 + dg * 16 + i], St[i], part);
      }
      red[(tt * 4 + dg) * 64 + e] = part;
    }
    __syncthreads();
    for (int k = 0; k < 4; ++k) {
      int tt = dg * 4 + k;
      float o = red[(tt * 4 + 0) * 64 + e] + red[(tt * 4 + 1) * 64 + e] + red[(tt * 4 + 2) * 64 + e] + red[(tt * 4 + 3) * 64 + e];
      float ss = wave_sum(o * o);
      float gv = base[(size_t)(t0 + tt) * INW + OFF_GR + h * 64 + e];
      float sl = gv * sigmoidf_(gv);
      int col = 768 + h * 64 + e;
      p.ybuf()[(size_t)(b * S + t0 + tt) * D + col] = sl * o * rsqrtf(ss / 64.0f + EPS);
    }
  }
}

__device__ __forceinline__ void phase_s5glu(const Params& p, int l, float* ys, int gw, int ngw, int lane) {
  const float* wglu = p.in[11] + (size_t)l * 65536;
  for (int t = gw; t < T; t += ngw) {
    float yv[4];
    LDS_FENCE();
#pragma unroll
    for (int i = 0; i < 4; ++i) { yv[i] = p.yg()[(size_t)t * 256 + lane + i * 64]; ys[lane + i * 64] = yv[i]; }
    LDS_FENCE();
    float z[4] = {0.f, 0.f, 0.f, 0.f};
    for (int k = 0; k < 256; ++k) {
      float yk = ys[k];
#pragma unroll
      for (int i = 0; i < 4; ++i) z[i] = fmaf(yk, wglu[k * 256 + lane + i * 64], z[i]);
    }
    float o[4], ss = 0.f;
#pragma unroll
    for (int i = 0; i < 4; ++i) { o[i] = yv[i] * sigmoidf_(z[i]); ss += o[i] * o[i]; }
    ss = wave_sum(ss);
    float r = rsqrtf(ss / 256.0f + EPS);
#pragma unroll
    for (int i = 0; i < 4; ++i) p.ybuf()[(size_t)t * D + lane + i * 64] = o[i] * r;
  }
}


struct S5P { float lr, li, dt, fr, fi; };
__device__ __forceinline__ S5P s5p(const Params& p, int l, int g, int pp) {
  S5P r; r.lr = p.in[3][l * 1024 + g * 64 + pp]; r.li = p.in[4][l * 1024 + g * 64 + pp]; r.dt = expf(p.in[5][l * 16 + g]);
  const float mag = expf(r.lr * r.dt); float sn, cs; sincosf(r.li * r.dt, &sn, &cs);
  const float ar = mag * cs, ai = mag * sn, den = r.lr * r.lr + r.li * r.li;
  r.fr = ((ar - 1.0f) * r.lr + ai * r.li) / den; r.fi = (ai * r.lr - (ar - 1.0f) * r.li) / den;
  return r;
}
__device__ __forceinline__ void s5pow(const S5P& s, int k, float& re, float& im) {
  const float m = expf((float)k * s.lr * s.dt); float sn, cs; sincosf((float)k * s.li * s.dt, &sn, &cs); re = m * cs; im = m * sn;
}
__device__ __forceinline__ void phase_s5_prep(const Params& p, int l, int gtid, int ngt) {
  const float* b_re = p.in[6] + l * 16384; const float* b_im = p.in[7] + l * 16384;
  const float* c_re = p.in[8] + l * 16384; const float* c_im = p.in[9] + l * 16384;
  bf16_t* Wy = p.S5Wy(); bf16_t* Wz = p.S5Wz();
  for (int it = gtid; it < 16 * 32 * 256; it += ngt) {
    const int hp = it & 15, h = (it >> 4) & 15, d = (it >> 8) & 31, g = it >> 13;
    float acc = 0.f;
    for (int pp = 0; pp < 64; ++pp) {
      const S5P s = s5p(p, l, g, pp);
      float pr, pi; s5pow(s, d, pr, pi);
      const float br = b_re[(g * 64 + pp) * 16 + hp], bi = b_im[(g * 64 + pp) * 16 + hp];
      const float bbr = s.fr * br - s.fi * bi, bbi = s.fr * bi + s.fi * br;
      const float tr = pr * bbr - pi * bbi, ti = pr * bbi + pi * bbr;
      acc += c_re[(g * 16 + h) * 64 + pp] * tr - c_im[(g * 16 + h) * 64 + pp] * ti;
    }
    const bf16_t v = f2bf(acc);
    for (int jp = 0; jp + d < 32; ++jp) {
      const int j = jp + d;
      Wy[((size_t)g * 512 + j * 16 + h) * 640 + jp * 16 + hp] = v;
      if (d > 0) Wy[((size_t)g * 512 + jp * 16 + h) * 640 + j * 16 + hp] = 0;
    }
  }
  for (int it = gtid; it < 16 * 32 * 16 * 64; it += ngt) {
    const int pp = it & 63, h = (it >> 6) & 15, j = (it >> 10) & 31, g = it >> 15;
    const S5P s = s5p(p, l, g, pp);
    float pr, pi; s5pow(s, j + 1, pr, pi);
    const float cr = c_re[(g * 16 + h) * 64 + pp], ci = c_im[(g * 16 + h) * 64 + pp];
    const unsigned w = pk_bf16(cr * pr - ci * pi, -(cr * pi + ci * pr));
    *(unsigned*)(Wy + ((size_t)g * 512 + j * 16 + h) * 640 + 512 + 2 * pp) = w;
  }
  for (int it = gtid; it < 16 * 64 * 32; it += ngt) {
    const int j = it & 31, pp = (it >> 5) & 63, g = it >> 11;
    const S5P s = s5p(p, l, g, pp);
    float pr, pi; s5pow(s, 31 - j, pr, pi);
    for (int hp = 0; hp < 16; ++hp) {
      const float br = b_re[(g * 64 + pp) * 16 + hp], bi = b_im[(g * 64 + pp) * 16 + hp];
      const float bbr = s.fr * br - s.fi * bi, bbi = s.fr * bi + s.fi * br;
      Wz[((size_t)g * 256 + 2 * pp) * 512 + j * 16 + hp] = f2bf(pr * bbr - pi * bbi);
      Wz[((size_t)g * 256 + 2 * pp + 1) * 512 + j * 16 + hp] = f2bf(pr * bbi + pi * bbr);
    }
  }
  for (int it = gtid; it < 16 * 64; it += ngt) {
    const S5P s = s5p(p, l, it >> 6, it & 63);
    float pr, pi; s5pow(s, 32, pr, pi);
    p.S5a32()[it * 2] = pr; p.S5a32()[it * 2 + 1] = pi;
  }
}
__device__ __forceinline__ void phase_pack_u(const Params& p, int gtid, int ngt) {
  for (int idx = gtid; idx < T * 32; idx += ngt) {
    const int t = idx >> 5, i = idx & 31, g = i >> 1;
    const float* src = p.proj() + (size_t)t * INW + i * 8;
    float4 a = *(const float4*)src, b4 = *(const float4*)(src + 4);
    uint4 o; o.x = pk_bf16(a.x, a.y); o.y = pk_bf16(a.z, a.w); o.z = pk_bf16(b4.x, b4.y); o.w = pk_bf16(b4.z, b4.w);
    *(uint4*)(p.S5A() + ((size_t)g * 1024 + (t >> 5)) * 640 + (t & 31) * 16 + (i & 1) * 8) = o;
  }
}
__device__ __forceinline__ void phase_s5_scan(const Params& p, int gtid, int ngt) {
  for (int it = gtid; it < NB * 16 * 64; it += ngt) {
    const int pp = it & 63, g = (it >> 6) & 15, b = it >> 10;
    const float er = p.S5a32()[(g * 64 + pp) * 2], ei = p.S5a32()[(g * 64 + pp) * 2 + 1];
    float sr = 0.f, si = 0.f;
    for (int c = 0; c < 128; ++c) {
      const size_t ch = (size_t)g * 1024 + b * 128 + c;
      *(unsigned*)(p.S5A() + ch * 640 + 512 + 2 * pp) = pk_bf16(sr, si);
      const float2 z = *(const float2*)(p.S5Z() + ch * 128 + 2 * pp);
      const float nr = er * sr - ei * si + z.x, ni = er * si + ei * sr + z.y;
      sr = nr; si = ni;
    }
  }
}
#define EPI_ZERO_INIT \
  __device__ __forceinline__ void init(pg8::f32x4 (&acc)[2][2][4][2], const pg8::Unit&, int, int, int, int) const { \
    _Pragma("unroll") for (int a = 0; a < 2; ++a) _Pragma("unroll") for (int b = 0; b < 2; ++b) \
    _Pragma("unroll") for (int m = 0; m < 4; ++m) _Pragma("unroll") for (int n = 0; n < 2; ++n) acc[a][b][m][n] = (pg8::f32x4){0.f, 0.f, 0.f, 0.f}; }
struct EpiS5Z {
  static constexpr bool PERM = false, AFTER_DRAIN = false;
  float* Z;
  EPI_ZERO_INIT
  __device__ __forceinline__ void operator()(const pg8::f32x4 (&acc)[2][2][4][2], const pg8::Unit& u, int wr, int wc, int fr_in, int fq_in) const {
    int fr = fr_in, fq = fq_in; asm volatile("" : "+v"(fr), "+v"(fq));
    const int g = u.pm >> 2;
#pragma unroll
    for (int ai = 0; ai < 2; ++ai)
#pragma unroll
      for (int m = 0; m < 4; ++m) {
        const int chunk = (u.pm & 3) * 256 + ai * 128 + wr * 64 + m * 16 + fr;
#pragma unroll
        for (int n = 0; n < 2; ++n) *(pg8::f32x4*)(Z + ((size_t)g * 1024 + chunk) * 128 + wc * 32 + n * 16 + 4 * fq) = acc[ai][0][m][n];
      }
  }
};
struct EpiS5Y {
  static constexpr bool PERM = false, AFTER_DRAIN = false;
  bf16_t* ygb; const bf16_t* A; const float* dsk;
  EPI_ZERO_INIT
  __device__ __forceinline__ void operator()(const pg8::f32x4 (&acc)[2][2][4][2], const pg8::Unit& u, int wr, int wc, int fr_in, int fq_in) const {
    int fr = fr_in, fq = fq_in; asm volatile("" : "+v"(fr), "+v"(fq));
    const int g = u.pm >> 2;
#pragma unroll
    for (int ai = 0; ai < 2; ++ai)
#pragma unroll
      for (int m = 0; m < 4; ++m) {
        const int chunk = (u.pm & 3) * 256 + ai * 128 + wr * 64 + m * 16 + fr;
#pragma unroll
        for (int bj = 0; bj < 2; ++bj)
#pragma unroll
          for (int n = 0; n < 2; ++n) {
            const int col = (u.pn & 1) * 256 + bj * 128 + wc * 32 + n * 16 + 4 * fq, j = col >> 4, h = col & 15;
            const uint2 uu = *(const uint2*)(A + ((size_t)g * 1024 + chunk) * 640 + col);
            const pg8::f32x4 dv = *(const pg8::f32x4*)(dsk + g * 16 + h);
            const pg8::f32x4 v = acc[ai][bj][m][n];
            const float y0 = fast_gelu(v[0] + dv[0] * __uint_as_float(uu.x << 16)), y1 = fast_gelu(v[1] + dv[1] * __uint_as_float(uu.x & 0xffff0000u));
            const float y2 = fast_gelu(v[2] + dv[2] * __uint_as_float(uu.y << 16)), y3 = fast_gelu(v[3] + dv[3] * __uint_as_float(uu.y & 0xffff0000u));
            uint2 o; o.x = pk_bf16(y0, y1); o.y = pk_bf16(y2, y3);
            *(uint2*)(ygb + ((size_t)chunk * 32 + j) * 256 + g * 16 + h) = o;
          }
        asm volatile("" ::: "memory");
      }
  }
};
struct EpiGlu {
  static constexpr bool PERM = false, AFTER_DRAIN = false;
  float* ybuf; const bf16_t* ygb; float* scr;
  EPI_ZERO_INIT
  __device__ __forceinline__ void operator()(const pg8::f32x4 (&acc_)[2][2][4][2], const pg8::Unit& u, int wr, int wc, int fr_in, int fq_in) const {
    int fr = fr_in, fq = fq_in; asm volatile("" : "+v"(fr), "+v"(fq));
    pg8::f32x4 (&acc)[2][2][4][2] = const_cast<pg8::f32x4 (&)[2][2][4][2]>(acc_);
#pragma unroll
    for (int ai = 0; ai < 2; ++ai)
#pragma unroll
      for (int m = 0; m < 4; ++m) {
        const int rl = ai * 128 + wr * 64 + m * 16 + fr, row = u.pm * 256 + rl;
        float ss = 0.f;
#pragma unroll
        for (int bj = 0; bj < 2; ++bj)
#pragma unroll
          for (int n = 0; n < 2; ++n) {
            const int col = bj * 128 + wc * 32 + n * 16 + 4 * fq;
            const uint2 yy = *(const uint2*)(ygb + (size_t)row * 256 + col);
            const pg8::f32x4 z = acc[ai][bj][m][n];
            pg8::f32x4 r;
            r[0] = __uint_as_float(yy.x << 16) * fast_sigmoid(z[0]); r[1] = __uint_as_float(yy.x & 0xffff0000u) * fast_sigmoid(z[1]);
            r[2] = __uint_as_float(yy.y << 16) * fast_sigmoid(z[2]); r[3] = __uint_as_float(yy.y & 0xffff0000u) * fast_sigmoid(z[3]);
            acc[ai][bj][m][n] = r;
            ss += r[0] * r[0] + r[1] * r[1] + r[2] * r[2] + r[3] * r[3];
          }
        ss += __shfl_xor(ss, 16); ss += __shfl_xor(ss, 32);
        if (fq == 0) scr[rl * 4 + wc] = ss;
        asm volatile("" ::: "memory");
      }
    asm volatile("s_waitcnt lgkmcnt(0)" ::: "memory"); __builtin_amdgcn_s_barrier(); asm volatile("" ::: "memory");
#pragma unroll
    for (int ai = 0; ai < 2; ++ai)
#pragma unroll
      for (int m = 0; m < 4; ++m) {
        const int rl = ai * 128 + wr * 64 + m * 16 + fr, row = u.pm * 256 + rl;
        const pg8::f32x4 s4 = *(const pg8::f32x4*)(scr + rl * 4);
        const float r = rsqrtf((s4[0] + s4[1] + s4[2] + s4[3]) / 256.0f + EPS);
#pragma unroll
        for (int bj = 0; bj < 2; ++bj)
#pragma unroll
          for (int n = 0; n < 2; ++n) *(pg8::f32x4*)(ybuf + (size_t)row * D + bj * 128 + wc * 32 + n * 16 + 4 * fq) = acc[ai][bj][m][n] * r;
        asm volatile("" ::: "memory");
      }
    asm volatile("s_waitcnt lgkmcnt(0)" ::: "memory"); __builtin_amdgcn_s_barrier(); asm volatile("" ::: "memory");
  }
};

constexpr float QSCALE = 0.125f * 1.4426950408889634f;

__device__ __forceinline__ void phase_pack_moba(const Params& p, int gtid, int ngt) {
  for (int idx = gtid; idx < T * 128; idx += ngt) {
    const int t = idx >> 7, c = idx & 127, isk = c >> 6, cc = c & 63, h = cc >> 3, ch = cc & 7;
    const float* src = p.proj() + (size_t)t * INW + (isk ? OFF_KM : OFF_QM) + h * 64 + ch * 8;
    float4 a = *(const float4*)src, b4 = *(const float4*)(src + 4);
    const float sc = isk ? 1.0f : QSCALE;
    uint4 o; o.x = pk_bf16(a.x * sc, a.y * sc); o.y = pk_bf16(a.z * sc, a.w * sc); o.z = pk_bf16(b4.x * sc, b4.y * sc); o.w = pk_bf16(b4.z * sc, b4.w * sc);
    const int b = t / S, s = t % S;
    bf16_t* dst = isk ? p.Km() + ((((size_t)(b * 8 + h) * (S / 32) + (s >> 5)) * 8 + ch) * 32 + (s & 31)) * 8
                      : p.Qm() + ((size_t)(b * 8 + h) * S + s) * 64 + ch * 8;
    *(uint4*)dst = o;
  }
  for (int idx = gtid; idx < NB * 8 * (S / 32) * 256; idx += ngt) {
    const int ln = idx & 63, ks = (idx >> 6) & 1, mb = (idx >> 7) & 1, tile = (idx >> 8) % (S / 32), bh = idx / (256 * (S / 32));
    const int b = bh >> 3, h = bh & 7, hh = ln >> 5, delta = mb * 32 + (ln & 31);
    float v[8];
#pragma unroll
    for (int j = 0; j < 8; ++j) {
      const int kappa = 16 * ks + 8 * (j >> 2) + 4 * hh + (j & 3), s = tile * 32 + kappa;
      v[j] = p.proj()[(size_t)(b * S + s) * INW + OFF_VM + h * 64 + delta];
    }
    uint4 o; o.x = pk_bf16(v[0], v[1]); o.y = pk_bf16(v[2], v[3]); o.z = pk_bf16(v[4], v[5]); o.w = pk_bf16(v[6], v[7]);
    *(uint4*)(p.Vm() + (size_t)idx * 8) = o;
  }
}

__device__ __forceinline__ void phase_moba2(const Params& p, int l, unsigned char* lds, int bid, int G) {
  int tid = threadIdx.x; asm volatile("" : "+v"(tid));
  const int lane = tid & 63, wv = tid >> 6, n = lane & 31, hh = lane >> 5;
  constexpr int OLD = 260;
  bf16_t* Qs = (bf16_t*)lds;
  float* Oaccf = (float*)(lds + 32768);
  float* laccf = (float*)(lds + 32768 + 64 * OLD * 4);
  float* kms = laccf + 256;
  float* gat = kms + 1024;
  unsigned char* lists = (unsigned char*)(gat + 4096);
  int* cnt = (int*)(lists + 4096);
  int* items = cnt + 16;
  int* ctr = items + 160;
  unsigned* selp = (unsigned*)(ctr + 4);
  float* bq = (float*)(selp + 256);
  int* Oacc = (int*)Oaccf; int* lacc = (int*)laccf;
  float kmax = 0.f;
  { const float* gk = p.in[13] + l * 64;
    for (int d = 0; d < 64; ++d) kmax = fmaxf(kmax, fabsf(gk[d]));
    kmax *= 8.0f * 1.01f; }
  for (int u = bid; u < NB * 8 * 16; u += G) {
    const int qblk = 15 - (u >> 6), bh = u & 63, b = bh >> 3, h = bh & 7;
    __syncthreads();
    { const uint4* src = (const uint4*)(p.Qm() + ((size_t)bh * S + qblk * 256) * 64);
      uint4* dst = (uint4*)Qs;
      for (int i = tid; i < 256 * 64 * 2 / 16; i += NTHR) dst[i] = src[i]; }
    for (int i = tid; i < qblk * 64; i += NTHR) kms[i] = p.kmean()[(size_t)bh * 1024 + i];
    for (int i = tid; i < 64 * OLD; i += NTHR) Oacc[i] = 0;
    if (tid < 256) lacc[tid] = 0;
    if (tid < 16) cnt[tid] = 0;
    __syncthreads();
    { const int q = tid & 255, par = tid >> 8;
      float qv[64];
#pragma unroll
      for (int c = 0; c < 8; ++c) {
        uint4 w = *(const uint4*)(Qs + q * 64 + c * 8);
        qv[c * 8 + 0] = __uint_as_float(w.x << 16); qv[c * 8 + 1] = __uint_as_float(w.x & 0xffff0000u);
        qv[c * 8 + 2] = __uint_as_float(w.y << 16); qv[c * 8 + 3] = __uint_as_float(w.y & 0xffff0000u);
        qv[c * 8 + 4] = __uint_as_float(w.z << 16); qv[c * 8 + 5] = __uint_as_float(w.z & 0xffff0000u);
        qv[c * 8 + 6] = __uint_as_float(w.w << 16); qv[c * 8 + 7] = __uint_as_float(w.w & 0xffff0000u);
      }
      if (par == 0) { float qq = 0.f;
#pragma unroll
        for (int d = 0; d < 64; ++d) qq = fmaf(qv[d], qv[d], qq);
        bq[q] = sqrtf(qq) * kmax; }
      for (int j = par; j < qblk; j += 2) {
        float g = 0.f;
#pragma unroll
        for (int d = 0; d < 64; ++d) g = fmaf(qv[d], kms[j * 64 + d], g);
        gat[q * 16 + j] = g;
      }
    }
    __syncthreads();
    if (tid < 256) {
      float b0 = -INFINITY, b1 = -INFINITY, b2 = -INFINITY; int i0 = 0, i1 = 0, i2 = 0;
      for (int j = 0; j < qblk; ++j) {
        float g = gat[tid * 16 + j];
        if (g > b0) { b2 = b1; i2 = i1; b1 = b0; i1 = i0; b0 = g; i0 = j; }
        else if (g > b1) { b2 = b1; i2 = i1; b1 = g; i1 = j; }
        else if (g > b2) { b2 = g; i2 = j; }
      }
      const int nsel = qblk < 3 ? qblk : 3;
      selp[tid] = (unsigned)i0 | ((unsigned)i1 << 4) | ((unsigned)i2 << 8) | ((unsigned)nsel << 12);
    }
    __syncthreads();
    for (int j = wv; j < qblk; j += 8) {
      int base = 0;
      for (int c = 0; c < 4; ++c) {
        const int q = c * 64 + lane;
        const unsigned sp = selp[q];
        const int ns = sp >> 12;
        const bool f = (ns > 0 && (int)(sp & 15) == j) || (ns > 1 && (int)((sp >> 4) & 15) == j) || (ns > 2 && (int)((sp >> 8) & 15) == j);
        const unsigned long long bal = __ballot(f);
        const int pos = base + __popcll(bal & ((1ull << lane) - 1ull));
        if (f) lists[j * 256 + pos] = (unsigned char)q;
        base += __popcll(bal);
      }
      if (lane == 0) cnt[j] = base;
    }
    __syncthreads();
    if (tid == 0) {
      int ni = 0;
#pragma unroll 1
      for (int g = 7; g >= 0; --g) items[ni++] = (16 << 8) | g;
      for (int j = 0; j < qblk; ++j) { const int ng = (cnt[j] + 31) >> 5; for (int g = 0; g < ng; ++g) items[ni++] = (j << 8) | g; }
      ctr[0] = ni; ctr[1] = 0;
    }
    __syncthreads();
    const int nitems = ctr[0];
    for (;;) {
      int it = 0;
      if (lane == 0) it = atomicAdd(&ctr[1], 1);
      it = __builtin_amdgcn_readfirstlane(it);
      if (it >= nitems) break;
      const int item = items[it];
      const int j = item >> 8, g = item & 255;
      const bool own = (j == 16);
      const int kb = own ? qblk : j;
      const int ntile = own ? (g + 1) : 8;
      int qi; bool valid;
      if (own) { qi = g * 32 + n; valid = true; }
      else { const int pos = g * 32 + n; valid = pos < cnt[j]; qi = lists[j * 256 + (valid ? pos : 0)]; }
      bf16x8 qf[4];
#pragma unroll
      for (int s = 0; s < 4; ++s) qf[s] = *(const bf16x8*)(Qs + qi * 64 + (2 * s + hh) * 8);
      const bf16_t* kt0 = p.Km() + ((size_t)bh * (S / 32) + kb * 8) * 2048 + lane * 8;
      const bf16_t* vt0 = p.Vm() + ((size_t)bh * (S / 32) + kb * 8) * 2048 + lane * 8;
      f32x16 O0, O1;
#pragma unroll
      for (int r = 0; r < 16; ++r) { O0[r] = 0.f; O1[r] = 0.f; }
      float lsum = 0.f;
      const float nbq = -bq[qi];
      bf16x8 kf[4], vf[4];
#pragma unroll
      for (int s = 0; s < 4; ++s) { kf[s] = *(const bf16x8*)(kt0 + s * 512); vf[s] = *(const bf16x8*)(vt0 + s * 512); }
      for (int kt = 0; kt < ntile; ++kt) {
        bf16x8 kn[4], vn[4];
        const int ktn = (kt + 1 < ntile) ? kt + 1 : kt;
#pragma unroll
        for (int s = 0; s < 4; ++s) { kn[s] = *(const bf16x8*)(kt0 + (size_t)ktn * 2048 + s * 512); vn[s] = *(const bf16x8*)(vt0 + (size_t)ktn * 2048 + s * 512); }
        f32x16 X;
#pragma unroll
        for (int r = 0; r < 16; ++r) X[r] = nbq;
#pragma unroll
        for (int s = 0; s < 4; ++s) X = __builtin_amdgcn_mfma_f32_32x32x16_bf16(kf[s], qf[s], X, 0, 0, 0);
        const bool diag = own && (kt == g);
        unsigned pw[8];
#pragma unroll
        for (int r = 0; r < 16; r += 2) {
          float e0 = __builtin_amdgcn_exp2f(X[r]), e1 = __builtin_amdgcn_exp2f(X[r + 1]);
          if (diag) {
            const int k0 = (r & 3) + 8 * (r >> 2) + 4 * hh, k1 = ((r + 1) & 3) + 8 * ((r + 1) >> 2) + 4 * hh;
            e0 = (k0 <= n) ? e0 : 0.f; e1 = (k1 <= n) ? e1 : 0.f;
          }
          lsum += e0 + e1;
          pw[r >> 1] = pk_bf16(e0, e1);
        }
        bf16x8 pf0, pf1;
        { uint4 t0 = make_uint4(pw[0], pw[1], pw[2], pw[3]), t1 = make_uint4(pw[4], pw[5], pw[6], pw[7]);
          pf0 = *(bf16x8*)&t0; pf1 = *(bf16x8*)&t1; }
        O0 = __builtin_amdgcn_mfma_f32_32x32x16_bf16(vf[0], pf0, O0, 0, 0, 0);
        O0 = __builtin_amdgcn_mfma_f32_32x32x16_bf16(vf[1], pf1, O0, 0, 0, 0);
        O1 = __builtin_amdgcn_mfma_f32_32x32x16_bf16(vf[2], pf0, O1, 0, 0, 0);
        O1 = __builtin_amdgcn_mfma_f32_32x32x16_bf16(vf[3], pf1, O1, 0, 0, 0);
#pragma unroll
        for (int s = 0; s < 4; ++s) { kf[s] = kn[s]; vf[s] = vn[s]; }
      }
      lsum += __shfl_xor(lsum, 32);
      if (valid) {
        if (hh == 0) atomicAdd(&lacc[qi], __float2int_rn(lsum * 1048576.0f));
#pragma unroll
        for (int r = 0; r < 16; ++r) {
          const int dim = (r & 3) + 8 * (r >> 2) + 4 * hh;
          atomicAdd(&Oacc[dim * OLD + qi], __float2int_rn(O0[r] * 1048576.0f));
          atomicAdd(&Oacc[(dim + 32) * OLD + qi], __float2int_rn(O1[r] * 1048576.0f));
        }
      }
    }
    __syncthreads();
    { const int q = tid >> 1, half = tid & 1;
      const float inv = 1.0f / (float)lacc[q];
      float o[32], ss = 0.f;
#pragma unroll
      for (int d = 0; d < 32; ++d) { o[d] = (float)Oacc[(half * 32 + d) * OLD + q] * inv; ss += o[d] * o[d]; }
      ss += __shfl_xor(ss, 1);
      const float r = rsqrtf(ss / 64.0f + EPS);
      float* dst = p.ybuf() + (size_t)(b * S + qblk * 256 + q) * D + 256 + h * 64 + half * 32;
#pragma unroll
      for (int d = 0; d < 32; d += 4) *(float4*)(dst + d) = make_float4(o[d] * r, o[d + 1] * r, o[d + 2] * r, o[d + 3] * r);
    }
  }
}


__device__ __forceinline__ void cvt_f32_bf16(const float* __restrict__ src, bf16_t* __restrict__ dst, size_t n8, int gtid, int ngt) {
  for (size_t i = gtid; i < n8; i += ngt) {
    float4 a = *(const float4*)(src + i * 8), b4 = *(const float4*)(src + i * 8 + 4);
    uint4 o; o.x = pk_bf16(a.x, a.y); o.y = pk_bf16(a.z, a.w); o.z = pk_bf16(b4.x, b4.y); o.w = pk_bf16(b4.z, b4.w);
    *(uint4*)(dst + i * 8) = o;
  }
}
__device__ __forceinline__ int f2key(float f) { int b = __float_as_int(f); return b ^ ((b >> 31) & 0x7fffffff); }
__device__ __forceinline__ float key2f(int k) { return __int_as_float(k ^ ((k >> 31) & 0x7fffffff)); }
#define CASD(a_, b_) { int mx_ = max(a_, b_), mn_ = min(a_, b_); a_ = mx_; b_ = mn_; }
__device__ __forceinline__ void sort16_desc(int (&v)[16]) {
#pragma unroll
  for (int k = 2; k <= 16; k <<= 1)
#pragma unroll
    for (int j = k >> 1; j > 0; j >>= 1)
#pragma unroll
      for (int i = 0; i < 16; ++i) { const int l2 = i ^ j; if (l2 > i) { if ((i & k) == 0) CASD(v[i], v[l2]) else CASD(v[l2], v[i]) } }
}
__device__ __forceinline__ void merge_top16(int (&a)[16], const int (&b)[16]) {
#pragma unroll
  for (int i = 0; i < 16; ++i) a[i] = max(a[i], b[15 - i]);
#pragma unroll
  for (int j = 8; j > 0; j >>= 1)
#pragma unroll
    for (int i = 0; i < 16; ++i) { const int l2 = i ^ j; if (l2 > i) CASD(a[i], a[l2]) }
}
__device__ __forceinline__ int lut4(int w0, int w1, int w2, int w3, int i) {
  const int w = i >> 2; const int d = (w == 0) ? w0 : (w == 1) ? w1 : (w == 2) ? w2 : w3;
  return (d >> ((i & 3) * 8)) & 127;
}

__device__ __forceinline__ void phase_peer_topk(const Params& p, int l, int gw, int ngw, int lane) {
  const int n = lane & 31, hh = lane >> 5;
  const bf16_t* skl = p.skb() + (size_t)l * 16 * 128 * 64;
  for (int w = gw; w < (T / 32) * 8; w += ngw) {
    const int tg = w >> 3, h = w & 7, t = tg * 32 + n;
    int L0[16], L1[16];
#pragma unroll
    for (int c = 0; c < 2; ++c) {
      const int hc = 2 * h + c;
      bf16x8 qf[4];
#pragma unroll
      for (int s = 0; s < 4; ++s) qf[s] = *(const bf16x8*)(p.qb() + (size_t)t * D + hc * 64 + 16 * s + 8 * hh);
      int A[16], Bq[16];
#pragma unroll
      for (int mb = 0; mb < 4; ++mb) {
        f32x16 X;
#pragma unroll
        for (int r = 0; r < 16; ++r) X[r] = 0.f;
#pragma unroll
        for (int s = 0; s < 4; ++s) {
          const bf16x8 kf = *(const bf16x8*)(skl + ((size_t)(hc * 128 + mb * 32 + n)) * 64 + 16 * s + 8 * hh);
          X = __builtin_amdgcn_mfma_f32_32x32x16_bf16(kf, qf[s], X, 0, 0, 0);
        }
        int Gk[16];
#pragma unroll
        for (int r = 0; r < 16; ++r) Gk[r] = (f2key(X[r]) & ~127) | (mb * 32 + (r & 3) + 8 * (r >> 2) + 4 * hh);
        sort16_desc(Gk);
        if (mb == 0) {
#pragma unroll
          for (int r = 0; r < 16; ++r) A[r] = Gk[r];
        } else merge_top16(A, Gk);
      }
#pragma unroll
      for (int r = 0; r < 16; ++r) Bq[r] = __shfl_xor(A[r], 32);
      merge_top16(A, Bq);
#pragma unroll
      for (int r = 0; r < 16; ++r) { if (c == 0) L0[r] = A[r]; else L1[r] = A[r]; }
    }
    float av[16], bv[16];
#pragma unroll
    for (int r = 0; r < 16; ++r) { av[r] = key2f(L0[r] & ~127); bv[r] = key2f(L1[r] & ~127); }
#define CAND(i_, j_) ((f2key(av[i_] + bv[j_]) & ~255) | ((i_) << 4) | (j_))
    int R[16], G1[16], G2[16];
#pragma unroll
    for (int j = 0; j < 16; ++j) R[j] = CAND(0, j);
    G1[0] = CAND(1, 0); G1[1] = CAND(1, 1); G1[2] = CAND(1, 2); G1[3] = CAND(1, 3); G1[4] = CAND(1, 4); G1[5] = CAND(1, 5); G1[6] = CAND(1, 6); G1[7] = CAND(1, 7);
    G1[8] = CAND(2, 0); G1[9] = CAND(2, 1); G1[10] = CAND(2, 2); G1[11] = CAND(2, 3); G1[12] = CAND(2, 4); G1[13] = CAND(3, 0); G1[14] = CAND(3, 1); G1[15] = CAND(3, 2);
    G2[0] = CAND(3, 3); G2[1] = CAND(4, 0); G2[2] = CAND(4, 1); G2[3] = CAND(4, 2); G2[4] = CAND(5, 0); G2[5] = CAND(5, 1); G2[6] = CAND(6, 0); G2[7] = CAND(6, 1);
    G2[8] = CAND(7, 0); G2[9] = CAND(7, 1); G2[10] = CAND(8, 0); G2[11] = CAND(9, 0); G2[12] = CAND(10, 0); G2[13] = CAND(11, 0); G2[14] = CAND(12, 0); G2[15] = CAND(13, 0);
    sort16_desc(G1); merge_top16(R, G1);
    sort16_desc(G2); merge_top16(R, G2);
    { int x0 = CAND(14, 0), x1 = CAND(15, 0);
#pragma unroll
      for (int i = 0; i < 16; ++i) CASD(R[i], x0)
#pragma unroll
      for (int i = 0; i < 16; ++i) CASD(R[i], x1)
    }
#undef CAND
    int pa0 = 0, pa1 = 0, pa2 = 0, pa3 = 0, pb0 = 0, pb1 = 0, pb2 = 0, pb3 = 0;
#pragma unroll
    for (int q = 0; q < 4; ++q) {
      pa0 |= (L0[q] & 127) << (8 * q); pa1 |= (L0[4 + q] & 127) << (8 * q); pa2 |= (L0[8 + q] & 127) << (8 * q); pa3 |= (L0[12 + q] & 127) << (8 * q);
      pb0 |= (L1[q] & 127) << (8 * q); pb1 |= (L1[4 + q] & 127) << (8 * q); pb2 |= (L1[8 + q] & 127) << (8 * q); pb3 |= (L1[12 + q] & 127) << (8 * q);
    }
    float ev[16], sum = 0.f; int ei[16];
    const float mx = key2f(R[0] & ~255);
#pragma unroll
    for (int z = 0; z < 16; ++z) {
      const float v = key2f(R[z] & ~255);
      ev[z] = __expf(v - mx); sum += ev[z];
      const int pay = R[z] & 255;
      ei[z] = lut4(pa0, pa1, pa2, pa3, pay >> 4) * 128 + lut4(pb0, pb1, pb2, pb3, pay & 15);
    }
    const float inv = 1.0f / sum;
    if (hh == 0) {
      float* go = p.gates() + ((size_t)t * 8 + h) * 16; int* eo = p.eidx() + ((size_t)t * 8 + h) * 16;
#pragma unroll
      for (int z = 0; z < 16; z += 4) {
        *(float4*)(go + z) = make_float4(ev[z] * inv, ev[z + 1] * inv, ev[z + 2] * inv, ev[z + 3] * inv);
        *(int4*)(eo + z) = make_int4(ei[z], ei[z + 1], ei[z + 2], ei[z + 3]);
      }
    }
  }
}

__device__ __forceinline__ void phase_peer_apply2(const Params& p, int l, float* coef, int gw, int ngw, int lane) {
  const float* g2 = p.in[16] + l * D;
  for (int t = gw; t < T; t += ngw) {
    const float r = p.rstd()[t];
    float hv[16];
#pragma unroll
    for (int i = 0; i < 2; ++i) {
      const float* xp = p.out + (size_t)t * D + i * 512 + lane * 8; const float* gp = g2 + i * 512 + lane * 8;
      float4 x0 = *(const float4*)xp, x1 = *(const float4*)(xp + 4), g0 = *(const float4*)gp, g1 = *(const float4*)(gp + 4);
      hv[i * 8 + 0] = x0.x * r * g0.x; hv[i * 8 + 1] = x0.y * r * g0.y; hv[i * 8 + 2] = x0.z * r * g0.z; hv[i * 8 + 3] = x0.w * r * g0.w;
      hv[i * 8 + 4] = x1.x * r * g1.x; hv[i * 8 + 5] = x1.y * r * g1.y; hv[i * 8 + 6] = x1.z * r * g1.z; hv[i * 8 + 7] = x1.w * r * g1.w;
    }
    const int e_lo = p.eidx()[(size_t)t * 128 + lane], e_hi = p.eidx()[(size_t)t * 128 + 64 + lane];
    const float g_lo = p.gates()[(size_t)t * 128 + lane], g_hi = p.gates()[(size_t)t * 128 + 64 + lane];
    LDS_FENCE();
#pragma unroll 1
    for (int half = 0; half < 2; ++half) {
      const int ev = half ? e_hi : e_lo;
      float mine = 0.f;
#pragma unroll 4
      for (int j = 0; j < 64; ++j) {
        const int e = __shfl(ev, j);
        const bf16_t* up = p.Ub() + (size_t)e * D + lane * 8;
        uint4 u0 = *(const uint4*)up, u1 = *(const uint4*)(up + 512);
        float d = 0.f;
        d = fmaf(hv[0], __uint_as_float(u0.x << 16), d); d = fmaf(hv[1], __uint_as_float(u0.x & 0xffff0000u), d);
        d = fmaf(hv[2], __uint_as_float(u0.y << 16), d); d = fmaf(hv[3], __uint_as_float(u0.y & 0xffff0000u), d);
        d = fmaf(hv[4], __uint_as_float(u0.z << 16), d); d = fmaf(hv[5], __uint_as_float(u0.z & 0xffff0000u), d);
        d = fmaf(hv[6], __uint_as_float(u0.w << 16), d); d = fmaf(hv[7], __uint_as_float(u0.w & 0xffff0000u), d);
        d = fmaf(hv[8], __uint_as_float(u1.x << 16), d); d = fmaf(hv[9], __uint_as_float(u1.x & 0xffff0000u), d);
        d = fmaf(hv[10], __uint_as_float(u1.y << 16), d); d = fmaf(hv[11], __uint_as_float(u1.y & 0xffff0000u), d);
        d = fmaf(hv[12], __uint_as_float(u1.z << 16), d); d = fmaf(hv[13], __uint_as_float(u1.z & 0xffff0000u), d);
        d = fmaf(hv[14], __uint_as_float(u1.w << 16), d); d = fmaf(hv[15], __uint_as_float(u1.w & 0xffff0000u), d);
        d = wave_sum(d);
        if (lane == j) mine = d;
      }
      coef[half * 64 + lane] = (half ? g_hi : g_lo) * gelu_tanh(mine);
    }
    LDS_FENCE();
    float acc[16];
#pragma unroll
    for (int i = 0; i < 16; ++i) acc[i] = 0.f;
#pragma unroll 1
    for (int half = 0; half < 2; ++half) {
      const int ev = half ? e_hi : e_lo;
#pragma unroll 4
      for (int j = 0; j < 64; ++j) {
        const int e = __shfl(ev, j);
        const float c = coef[half * 64 + j];
        const bf16_t* vp = p.Vb() + (size_t)e * D + lane * 8;
        uint4 v0 = *(const uint4*)vp, v1 = *(const uint4*)(vp + 512);
        acc[0] = fmaf(c, __uint_as_float(v0.x << 16), acc[0]); acc[1] = fmaf(c, __uint_as_float(v0.x & 0xffff0000u), acc[1]);
        acc[2] = fmaf(c, __uint_as_float(v0.y << 16), acc[2]); acc[3] = fmaf(c, __uint_as_float(v0.y & 0xffff0000u), acc[3]);
        acc[4] = fmaf(c, __uint_as_float(v0.z << 16), acc[4]); acc[5] = fmaf(c, __uint_as_float(v0.z & 0xffff0000u), acc[5]);
        acc[6] = fmaf(c, __uint_as_float(v0.w << 16), acc[6]); acc[7] = fmaf(c, __uint_as_float(v0.w & 0xffff0000u), acc[7]);
        acc[8] = fmaf(c, __uint_as_float(v1.x << 16), acc[8]); acc[9] = fmaf(c, __uint_as_float(v1.x & 0xffff0000u), acc[9]);
        acc[10] = fmaf(c, __uint_as_float(v1.y << 16), acc[10]); acc[11] = fmaf(c, __uint_as_float(v1.y & 0xffff0000u), acc[11]);
        acc[12] = fmaf(c, __uint_as_float(v1.z << 16), acc[12]); acc[13] = fmaf(c, __uint_as_float(v1.z & 0xffff0000u), acc[13]);
        acc[14] = fmaf(c, __uint_as_float(v1.w << 16), acc[14]); acc[15] = fmaf(c, __uint_as_float(v1.w & 0xffff0000u), acc[15]);
      }
    }
#pragma unroll
    for (int i = 0; i < 2; ++i) {
      float* xp = p.out + (size_t)t * D + i * 512 + lane * 8;
      float4 x0 = *(float4*)xp, x1 = *(float4*)(xp + 4);
      x0.x += acc[i * 8 + 0]; x0.y += acc[i * 8 + 1]; x0.z += acc[i * 8 + 2]; x0.w += acc[i * 8 + 3];
      x1.x += acc[i * 8 + 4]; x1.y += acc[i * 8 + 5]; x1.z += acc[i * 8 + 6]; x1.w += acc[i * 8 + 7];
      *(float4*)xp = x0; *(float4*)(xp + 4) = x1;
    }
  }
}

__device__ __forceinline__ Params fresh(const Params& p) {
  Params q = p;
  asm volatile("" : "+s"(q.ws), "+s"(q.out));
#pragma unroll
  for (int i = 0; i < 21; ++i) asm volatile("" : "+s"(q.in[i]));
  return q;
}
#define PHASE_IDS int tid = threadIdx.x; asm volatile("" : "+v"(tid)); int bid = blockIdx.x; asm volatile("" : "+s"(bid)); int G = gridDim.x; asm volatile("" : "+s"(G)); \
  const int lane = tid & 63, wv = tid >> 6; const int ngt = G * NTHR, ngw = G * NWAVE; \
  const int gtid = bid * NTHR + tid, gw = bid * NWAVE + wv; (void)lane; (void)wv; (void)gtid; (void)gw; (void)ngt; (void)ngw; \
  const Params q = fresh(p);
__global__ void __launch_bounds__(NTHR) mega(Params p) {
  extern __shared__ __attribute__((aligned(16))) unsigned char lds_raw[];
  cg::grid_group grid = cg::this_grid();
  float* ldsf = (float*)lds_raw;

  { PHASE_IDS; phase_prologue(q, gtid, ngt, gw, ngw, lane); cvt_f32_bf16(q.in[18], q.skb(), (size_t)NL * 16 * 128 * 64 / 8, gtid, ngt);
    for (size_t i = gtid; i < (size_t)16 * 256 * 512 / 8; i += ngt) ((uint4*)q.S5Wz())[i] = make_uint4(0u, 0u, 0u, 0u); }
  grid.sync();
  { constexpr int l = 0;
    { PHASE_IDS; phase_cvt_rows(q.out, q.xb(), q.rstd(), gw, ngw, lane);
      phase_s5_prep(q, l, gtid, ngt);
 }
    grid.sync();
    { const Params q = fresh(p); EpiScaleStore e{q.proj(), INW, q.rstd()};
      run_gemm(lds_raw, q.xb(), q.Win_t() + (size_t)l * INW * KD, T, INW, KD, e); }
    grid.sync();
    { PHASE_IDS; phase_postproj(q, l, gw, ngw, lane); }
    grid.sync();
    { PHASE_IDS;
      if (bid < 16) ret_units(q, l, bid * 2, ldsf);
      else { const int g2 = (bid - 16) * NTHR + tid, n2 = (G - 16) * NTHR; phase_kmean(q, g2, n2); phase_pack_moba(q, g2, n2); phase_pack_u(q, g2, n2); } }
    grid.sync();
    { const Params q = fresh(p); EpiS5Z e{q.S5Z()};
      pg8::Gemm g{q.S5A(), q.S5Wz(), 16 * 1024, 16 * 256, 512, 640, 512}; pg8::GroupOrder So; So.init(16, 4, 1, (int)gridDim.x, (int)blockIdx.x);
      pg8::gemm_phase<EpiS5Z, pg8::GroupOrder, true, true>((PG8_LAS unsigned char*)lds_raw, g, So, e); }
    __syncthreads();
    { PHASE_IDS; phase_moba2(q, l, lds_raw, bid, G); }
    grid.sync();
    { PHASE_IDS; phase_s5_scan(q, gtid, ngt); }
    grid.sync();
    { const Params q = fresh(p); EpiS5Y e{q.ygb(), q.S5A(), q.in[10] + l * 256};
      pg8::Gemm g{q.S5A(), q.S5Wy(), 16 * 1024, 16 * 512, 640, 640, 640}; pg8::GroupOrder So; So.init(16, 4, 2, (int)gridDim.x, (int)blockIdx.x);
      pg8::gemm_phase<EpiS5Y, pg8::GroupOrder, true, true>((PG8_LAS unsigned char*)lds_raw, g, So, e); }
    grid.sync();
    { const Params q = fresh(p); EpiGlu e{q.ybuf(), q.ygb(), (float*)(lds_raw + 131072)};
      run_gemm(lds_raw, q.ygb(), q.Wglu_t() + (size_t)l * 65536, T, 256, 256, e); }
    grid.sync();
    { PHASE_IDS; phase_cvt_rows(q.ybuf(), q.xb(), nullptr, gw, ngw, lane); }
    grid.sync();
    { const Params q = fresh(p); EpiAccum e{q.out, D};
      run_gemm(lds_raw, q.xb(), q.Wout_t() + (size_t)l * D * KD, T, D, KD, e); }
    grid.sync();
    { PHASE_IDS; phase_cvt_rows(q.out, q.xb(), q.rstd(), gw, ngw, lane);
      cvt_f32_bf16(q.in[19] + (size_t)l * 16384 * D, q.Ub(), (size_t)16384 * D / 8, gtid, ngt);
      cvt_f32_bf16(q.in[20] + (size_t)l * 16384 * D, q.Vb(), (size_t)16384 * D / 8, gtid, ngt); }
    grid.sync();
    { const Params q = fresh(p); EpiScaleStoreBf16 e{q.qb(), D, q.rstd()};
      run_gemm(lds_raw, q.xb(), q.Wq_t() + (size_t)l * D * KD, T, D, KD, e); }
    grid.sync();
    { PHASE_IDS; phase_peer_topk(q, l, gw, ngw, lane); }
    grid.sync();
    { PHASE_IDS; phase_peer_apply2(q, l, ldsf + wv * 128, gw, ngw, lane); }
    grid.sync();
  }
  { constexpr int l = 1;
    { PHASE_IDS; phase_cvt_rows(q.out, q.xb(), q.rstd(), gw, ngw, lane);
      phase_s5_prep(q, l, gtid, ngt);
 }
    grid.sync();
    { const Params q = fresh(p); EpiScaleStore e{q.proj(), INW, q.rstd()};
      run_gemm(lds_raw, q.xb(), q.Win_t() + (size_t)l * INW * KD, T, INW, KD, e); }
    grid.sync();
    { PHASE_IDS; phase_postproj(q, l, gw, ngw, lane); }
    grid.sync();
    { PHASE_IDS;
      if (bid < 16) ret_units(q, l, bid * 2, ldsf);
      else { const int g2 = (bid - 16) * NTHR + tid, n2 = (G - 16) * NTHR; phase_kmean(q, g2, n2); phase_pack_moba(q, g2, n2); phase_pack_u(q, g2, n2); } }
    grid.sync();
    { const Params q = fresh(p); EpiS5Z e{q.S5Z()};
      pg8::Gemm g{q.S5A(), q.S5Wz(), 16 * 1024, 16 * 256, 512, 640, 512}; pg8::GroupOrder So; So.init(16, 4, 1, (int)gridDim.x, (int)blockIdx.x);
      pg8::gemm_phase<EpiS5Z, pg8::GroupOrder, true, true>((PG8_LAS unsigned char*)lds_raw, g, So, e); }
    __syncthreads();
    { PHASE_IDS; phase_moba2(q, l, lds_raw, bid, G); }
    grid.sync();
    { PHASE_IDS; phase_s5_scan(q, gtid, ngt); }
    grid.sync();
    { const Params q = fresh(p); EpiS5Y e{q.ygb(), q.S5A(), q.in[10] + l * 256};
      pg8::Gemm g{q.S5A(), q.S5Wy(), 16 * 1024, 16 * 512, 640, 640, 640}; pg8::GroupOrder So; So.init(16, 4, 2, (int)gridDim.x, (int)blockIdx.x);
      pg8::gemm_phase<EpiS5Y, pg8::GroupOrder, true, true>((PG8_LAS unsigned char*)lds_raw, g, So, e); }
    grid.sync();
    { const Params q = fresh(p); EpiGlu e{q.ybuf(), q.ygb(), (float*)(lds_raw + 131072)};
      run_gemm(lds_raw, q.ygb(), q.Wglu_t() + (size_t)l * 65536, T, 256, 256, e); }
    grid.sync();
    { PHASE_IDS; phase_cvt_rows(q.ybuf(), q.xb(), nullptr, gw, ngw, lane); }
    grid.sync();
    { const Params q = fresh(p); EpiAccum e{q.out, D};
      run_gemm(lds_raw, q.xb(), q.Wout_t() + (size_t)l * D * KD, T, D, KD, e); }
    grid.sync();
    { PHASE_IDS; phase_cvt_rows(q.out, q.xb(), q.rstd(), gw, ngw, lane);
      cvt_f32_bf16(q.in[19] + (size_t)l * 16384 * D, q.Ub(), (size_t)16384 * D / 8, gtid, ngt);
      cvt_f32_bf16(q.in[20] + (size_t)l * 16384 * D, q.Vb(), (size_t)16384 * D / 8, gtid, ngt); }
    grid.sync();
    { const Params q = fresh(p); EpiScaleStoreBf16 e{q.qb(), D, q.rstd()};
      run_gemm(lds_raw, q.xb(), q.Wq_t() + (size_t)l * D * KD, T, D, KD, e); }
    grid.sync();
    { PHASE_IDS; phase_peer_topk(q, l, gw, ngw, lane); }
    grid.sync();
    { PHASE_IDS; phase_peer_apply2(q, l, ldsf + wv * 128, gw, ngw, lane); }
    grid.sync();
  }
  { constexpr int l = 2;
    { PHASE_IDS; phase_cvt_rows(q.out, q.xb(), q.rstd(), gw, ngw, lane);
      phase_s5_prep(q, l, gtid, ngt);
 }
    grid.sync();
    { const Params q = fresh(p); EpiScaleStore e{q.proj(), INW, q.rstd()};
      run_gemm(lds_raw, q.xb(), q.Win_t() + (size_t)l * INW * KD, T, INW, KD, e); }
    grid.sync();
    { PHASE_IDS; phase_postproj(q, l, gw, ngw, lane); }
    grid.sync();
    { PHASE_IDS;
      if (bid < 16) ret_units(q, l, bid * 2, ldsf);
      else { const int g2 = (bid - 16) * NTHR + tid, n2 = (G - 16) * NTHR; phase_kmean(q, g2, n2); phase_pack_moba(q, g2, n2); phase_pack_u(q, g2, n2); } }
    grid.sync();
    { const Params q = fresh(p); EpiS5Z e{q.S5Z()};
      pg8::Gemm g{q.S5A(), q.S5Wz(), 16 * 1024, 16 * 256, 512, 640, 512}; pg8::GroupOrder So; So.init(16, 4, 1, (int)gridDim.x, (int)blockIdx.x);
      pg8::gemm_phase<EpiS5Z, pg8::GroupOrder, true, true>((PG8_LAS unsigned char*)lds_raw, g, So, e); }
    __syncthreads();
    { PHASE_IDS; phase_moba2(q, l, lds_raw, bid, G); }
    grid.sync();
    { PHASE_IDS; phase_s5_scan(q, gtid, ngt); }
    grid.sync();
    { const Params q = fresh(p); EpiS5Y e{q.ygb(), q.S5A(), q.in[10] + l * 256};
      pg8::Gemm g{q.S5A(), q.S5Wy(), 16 * 1024, 16 * 512, 640, 640, 640}; pg8::GroupOrder So; So.init(16, 4, 2, (int)gridDim.x, (int)blockIdx.x);
      pg8::gemm_phase<EpiS5Y, pg8::GroupOrder, true, true>((PG8_LAS unsigned char*)lds_raw, g, So, e); }
    grid.sync();
    { const Params q = fresh(p); EpiGlu e{q.ybuf(), q.ygb(), (float*)(lds_raw + 131072)};
      run_gemm(lds_raw, q.ygb(), q.Wglu_t() + (size_t)l * 65536, T, 256, 256, e); }
    grid.sync();
    { PHASE_IDS; phase_cvt_rows(q.ybuf(), q.xb(), nullptr, gw, ngw, lane); }
    grid.sync();
    { const Params q = fresh(p); EpiAccum e{q.out, D};
      run_gemm(lds_raw, q.xb(), q.Wout_t() + (size_t)l * D * KD, T, D, KD, e); }
    grid.sync();
    { PHASE_IDS; phase_cvt_rows(q.out, q.xb(), q.rstd(), gw, ngw, lane);
      cvt_f32_bf16(q.in[19] + (size_t)l * 16384 * D, q.Ub(), (size_t)16384 * D / 8, gtid, ngt);
      cvt_f32_bf16(q.in[20] + (size_t)l * 16384 * D, q.Vb(), (size_t)16384 * D / 8, gtid, ngt); }
    grid.sync();
    { const Params q = fresh(p); EpiScaleStoreBf16 e{q.qb(), D, q.rstd()};
      run_gemm(lds_raw, q.xb(), q.Wq_t() + (size_t)l * D * KD, T, D, KD, e); }
    grid.sync();
    { PHASE_IDS; phase_peer_topk(q, l, gw, ngw, lane); }
    grid.sync();
    { PHASE_IDS; phase_peer_apply2(q, l, ldsf + wv * 128, gw, ngw, lane); }
    grid.sync();
  }
  { constexpr int l = 3;
    { PHASE_IDS; phase_cvt_rows(q.out, q.xb(), q.rstd(), gw, ngw, lane);
      phase_s5_prep(q, l, gtid, ngt);
 }
    grid.sync();
    { const Params q = fresh(p); EpiScaleStore e{q.proj(), INW, q.rstd()};
      run_gemm(lds_raw, q.xb(), q.Win_t() + (size_t)l * INW * KD, T, INW, KD, e); }
    grid.sync();
    { PHASE_IDS; phase_postproj(q, l, gw, ngw, lane); }
    grid.sync();
    { PHASE_IDS;
      if (bid < 16) ret_units(q, l, bid * 2, ldsf);
      else { const int g2 = (bid - 16) * NTHR + tid, n2 = (G - 16) * NTHR; phase_kmean(q, g2, n2); phase_pack_moba(q, g2, n2); phase_pack_u(q, g2, n2); } }
    grid.sync();
    { const Params q = fresh(p); EpiS5Z e{q.S5Z()};
      pg8::Gemm g{q.S5A(), q.S5Wz(), 16 * 1024, 16 * 256, 512, 640, 512}; pg8::GroupOrder So; So.init(16, 4, 1, (int)gridDim.x, (int)blockIdx.x);
      pg8::gemm_phase<EpiS5Z, pg8::GroupOrder, true, true>((PG8_LAS unsigned char*)lds_raw, g, So, e); }
    __syncthreads();
    { PHASE_IDS; phase_moba2(q, l, lds_raw, bid, G); }
    grid.sync();
    { PHASE_IDS; phase_s5_scan(q, gtid, ngt); }
    grid.sync();
    { const Params q = fresh(p); EpiS5Y e{q.ygb(), q.S5A(), q.in[10] + l * 256};
      pg8::Gemm g{q.S5A(), q.S5Wy(), 16 * 1024, 16 * 512, 640, 640, 640}; pg8::GroupOrder So; So.init(16, 4, 2, (int)gridDim.x, (int)blockIdx.x);
      pg8::gemm_phase<EpiS5Y, pg8::GroupOrder, true, true>((PG8_LAS unsigned char*)lds_raw, g, So, e); }
    grid.sync();
    { const Params q = fresh(p); EpiGlu e{q.ybuf(), q.ygb(), (float*)(lds_raw + 131072)};
      run_gemm(lds_raw, q.ygb(), q.Wglu_t() + (size_t)l * 65536, T, 256, 256, e); }
    grid.sync();
    { PHASE_IDS; phase_cvt_rows(q.ybuf(), q.xb(), nullptr, gw, ngw, lane); }
    grid.sync();
    { const Params q = fresh(p); EpiAccum e{q.out, D};
      run_gemm(lds_raw, q.xb(), q.Wout_t() + (size_t)l * D * KD, T, D, KD, e); }
    grid.sync();
    { PHASE_IDS; phase_cvt_rows(q.out, q.xb(), q.rstd(), gw, ngw, lane);
      cvt_f32_bf16(q.in[19] + (size_t)l * 16384 * D, q.Ub(), (size_t)16384 * D / 8, gtid, ngt);
      cvt_f32_bf16(q.in[20] + (size_t)l * 16384 * D, q.Vb(), (size_t)16384 * D / 8, gtid, ngt); }
    grid.sync();
    { const Params q = fresh(p); EpiScaleStoreBf16 e{q.qb(), D, q.rstd()};
      run_gemm(lds_raw, q.xb(), q.Wq_t() + (size_t)l * D * KD, T, D, KD, e); }
    grid.sync();
    { PHASE_IDS; phase_peer_topk(q, l, gw, ngw, lane); }
    grid.sync();
    { PHASE_IDS; phase_peer_apply2(q, l, ldsf + wv * 128, gw, ngw, lane); }
    grid.sync();
  }
}

}

extern "C" void kernel_launch(void* const* d_in, const int* in_sizes, int n_in, void* d_out, int out_size, void* d_ws, size_t ws_size,
                              hipStream_t stream) {
  static int grid_blocks = 0;
  if (!grid_blocks) {
    int dev = 0, cus = 0, per_cu = 0;
    hipGetDevice(&dev);
    hipDeviceGetAttribute(&cus, hipDeviceAttributeMultiprocessorCount, dev);
    hipFuncSetAttribute((const void*)mega, hipFuncAttributeMaxDynamicSharedMemorySize, LDS_BYTES);
    hipOccupancyMaxActiveBlocksPerMultiprocessor(&per_cu, (const void*)mega, NTHR, LDS_BYTES);
    if (per_cu < 1) { fprintf(stderr, "occupancy query returned %d\n", per_cu); per_cu = 1; }
    grid_blocks = cus * 1;
    if (grid_blocks < 64) fprintf(stderr, "unexpected CU count %d\n", cus);
  }
  Params p{};
  for (int i = 0; i < 21; ++i) p.in[i] = (const float*)d_in[i];
  p.out = (float*)d_out;
  p.ws = (unsigned char*)d_ws;
  if (WS_TOTAL > ws_size) { fprintf(stderr, "workspace too small: need %zu have %zu\n", (size_t)WS_TOTAL, ws_size); return; }
  void* args[] = {&p};
  hipError_t e = hipLaunchCooperativeKernel((const void*)mega, dim3(grid_blocks), dim3(NTHR), args, LDS_BYTES, stream);
  if (e != hipSuccess) fprintf(stderr, "cooperative launch failed: %s (grid %d)\n", hipGetErrorString(e), grid_blocks);
}
```

```cpp
#include <hip/hip_runtime.h>
#include <hip/hip_cooperative_groups.h>
#include <math.h>
#include <stdint.h>
#include <stdio.h>
namespace cg = cooperative_groups;

#ifndef PEER_CHECK
#define PEER_CHECK 0
#endif
#ifndef PROBE_DUP
#define PROBE_DUP 0
#endif
#define DUP(bit) for (int rep_ = 0; rep_ < ((PROBE_DUP >> (bit)) & 1) + 1; ++rep_)
#ifndef PROBE_SKIP
#define PROBE_SKIP 0
#endif
#ifndef PRECISE
#define PRECISE 0
#endif

namespace {
constexpr int NB = 8, S = 4096, D = 1024, NL = 4, T = NB * S;
constexpr int INW = 2816;
constexpr int OFF_U = 0, OFF_QM = 256, OFF_KM = 768, OFF_VM = 1280, OFF_QR = 1792, OFF_KR = 2048, OFF_VR = 2304, OFF_GR = 2560;
constexpr float EPS = 1e-6f;
constexpr int KS = PRECISE ? 3 : 1;
constexpr int KD = D * KS;
constexpr int NTHR = 512, NWAVE = 8;
constexpr int LDS_BYTES = 131072 + 4096 + 1024;

typedef unsigned short bf16_t;
using bf16x8 = __attribute__((ext_vector_type(8))) short;
using f32x4 = __attribute__((ext_vector_type(4))) float;

__device__ __forceinline__ float wave_sum(float v) {
#pragma unroll
  for (int o = 32; o > 0; o >>= 1) v += __shfl_xor(v, o);
  return v;
}
__device__ __forceinline__ float wave_max(float v) {
#pragma unroll
  for (int o = 32; o > 0; o >>= 1) v = fmaxf(v, __shfl_xor(v, o));
  return v;
}
__device__ __forceinline__ float gelu_tanh(float x) {
  const float k0 = 0.7978845608028654f, k1 = 0.044715f;
  float u = k0 * (x + k1 * x * x * x);
  return 0.5f * x * (1.0f + tanhf(u));
}
__device__ __forceinline__ float sigmoidf_(float x) { return 1.0f / (1.0f + expf(-x)); }
__device__ __forceinline__ float fast_sigmoid(float x) { return __builtin_amdgcn_rcpf(1.0f + __builtin_amdgcn_exp2f(-1.4426950408889634f * x)); }
__device__ __forceinline__ float fast_gelu(float x) { const float u = 0.7978845608028654f * (x + 0.044715f * x * x * x); return x * fast_sigmoid(2.0f * u); }
__device__ __forceinline__ bf16_t f2bf(float f) {
  unsigned u = __float_as_uint(f);
  u += 0x7fffu + ((u >> 16) & 1u);
  return (bf16_t)(u >> 16);
}
__device__ __forceinline__ float bf2f(bf16_t h) { return __uint_as_float(((unsigned)h) << 16); }
#define LDS_FENCE() asm volatile("s_waitcnt lgkmcnt(0)" ::: "memory")
typedef __bf16 bf16x2_hw __attribute__((ext_vector_type(2)));
typedef float f32x2_hw __attribute__((ext_vector_type(2)));
__device__ __forceinline__ unsigned pk_bf16(float lo, float hi) { const f32x2_hw f = {lo, hi}; const bf16x2_hw b = __builtin_convertvector(f, bf16x2_hw); return __builtin_bit_cast(unsigned, b); }
typedef float f32x16 __attribute__((ext_vector_type(16)));

constexpr size_t al256(size_t x) { return (x + 255) & ~(size_t)255; }
constexpr size_t WO_rstd = 0;
constexpr size_t WO_cosm = WO_rstd + al256((size_t)T * 4);
constexpr size_t WO_sinm = WO_cosm + al256((size_t)S * 8 * 4);
constexpr size_t WO_cosr = WO_sinm + al256((size_t)S * 8 * 4);
constexpr size_t WO_sinr = WO_cosr + al256((size_t)S * 32 * 4);
constexpr size_t WO_kmean = WO_sinr + al256((size_t)S * 32 * 4);
constexpr size_t WO_proj = WO_kmean + al256((size_t)NB * 8 * 16 * 64 * 4);
constexpr size_t WO_ybuf = WO_proj + al256((size_t)T * INW * 4);
constexpr size_t WO_yg = WO_ybuf + al256((size_t)T * D * 4);
constexpr size_t WO_skb = WO_yg + al256((size_t)T * 256 * 4);
constexpr size_t WO_Ub = WO_skb + al256((size_t)NL * 16 * 128 * 64 * 2);
constexpr size_t WO_Vb = WO_Ub + al256((size_t)16384 * D * 2);
constexpr size_t WO_gates = WO_Vb + al256((size_t)16384 * D * 2);
constexpr size_t WO_eidx = WO_gates + al256((size_t)T * 128 * 4);
constexpr size_t WO_xb = WO_eidx + al256((size_t)T * 128 * 4);
constexpr size_t WO_Win_t = WO_xb + al256((size_t)T * KD * 2);
constexpr size_t WO_Wout_t = WO_Win_t + al256((size_t)NL * INW * KD * 2);
constexpr size_t WO_Wq_t = WO_Wout_t + al256((size_t)NL * D * KD * 2);
constexpr size_t WO_Qm = WO_Wq_t + al256((size_t)NL * D * KD * 2);
constexpr size_t WO_Km = WO_Qm + al256((size_t)T * 512 * 2);
constexpr size_t WO_Vm = WO_Km + al256((size_t)T * 512 * 2);
constexpr size_t WO_S5a32 = WO_Vm + al256((size_t)T * 512 * 2);
constexpr size_t WO_Wglu_t = WO_S5a32 + al256((size_t)16 * 64 * 2 * 4);
constexpr size_t WO_Qr = WO_Wglu_t + al256((size_t)NL * 256 * 256 * 2);
constexpr size_t WO_Kr = WO_Qr + al256((size_t)T * 256 * 2);
constexpr size_t WO_Krv = WO_Kr + al256((size_t)T * 256 * 2);
constexpr size_t WO_Vr = WO_Krv + al256((size_t)T * 256 * 2);
constexpr size_t WO_KVr = WO_Vr + al256((size_t)T * 256 * 2);
constexpr size_t WO_Rb = WO_KVr + al256((size_t)32 * 32 * 4096 * 4);
constexpr size_t WO_qctr = WO_Rb + al256((size_t)32 * 32 * 4096 * 2);
constexpr size_t WS_TOTAL = WO_qctr + al256(1024);
constexpr size_t WO_S5A = WO_gates;
constexpr size_t WO_S5Z = WO_S5A + al256((size_t)16 * 1024 * 640 * 2);
static_assert(WO_S5Z + (size_t)16 * 1024 * 128 * 4 <= WO_gates + 2 * al256((size_t)T * 128 * 4), "S5A/S5Z must fit in gates+eidx");
constexpr size_t WO_S5Wy = WO_Ub;
constexpr size_t WO_S5Wz = WO_S5Wy + al256((size_t)16 * 512 * 640 * 2);
static_assert(WO_S5Wz + (size_t)16 * 256 * 512 * 2 <= WO_Ub + 2 * al256((size_t)16384 * D * 2), "S5 weights must fit in Ub/Vb");
struct Params {
  const float* in[21];
  float* out;
  unsigned char* ws;
  __device__ __forceinline__ float* rstd() const { return (float*)(ws + WO_rstd); }
  __device__ __forceinline__ float* cosm() const { return (float*)(ws + WO_cosm); }
  __device__ __forceinline__ float* sinm() const { return (float*)(ws + WO_sinm); }
  __device__ __forceinline__ float* cosr() const { return (float*)(ws + WO_cosr); }
  __device__ __forceinline__ float* sinr() const { return (float*)(ws + WO_sinr); }
  __device__ __forceinline__ float* kmean() const { return (float*)(ws + WO_kmean); }
  __device__ __forceinline__ float* proj() const { return (float*)(ws + WO_proj); }
  __device__ __forceinline__ float* ybuf() const { return (float*)(ws + WO_ybuf); }
  __device__ __forceinline__ float* yg() const { return (float*)(ws + WO_yg); }
  __device__ __forceinline__ bf16_t* skb() const { return (bf16_t*)(ws + WO_skb); }
  __device__ __forceinline__ bf16_t* Ub() const { return (bf16_t*)(ws + WO_Ub); }
  __device__ __forceinline__ bf16_t* Vb() const { return (bf16_t*)(ws + WO_Vb); }
  __device__ __forceinline__ float* gates() const { return (float*)(ws + WO_gates); }
  __device__ __forceinline__ int* eidx() const { return (int*)(ws + WO_eidx); }
  __device__ __forceinline__ bf16_t* xb() const { return (bf16_t*)(ws + WO_xb); }
  __device__ __forceinline__ bf16_t* Win_t() const { return (bf16_t*)(ws + WO_Win_t); }
  __device__ __forceinline__ bf16_t* Wout_t() const { return (bf16_t*)(ws + WO_Wout_t); }
  __device__ __forceinline__ bf16_t* Wq_t() const { return (bf16_t*)(ws + WO_Wq_t); }
  __device__ __forceinline__ bf16_t* Qm() const { return (bf16_t*)(ws + WO_Qm); }
  __device__ __forceinline__ bf16_t* Km() const { return (bf16_t*)(ws + WO_Km); }
  __device__ __forceinline__ bf16_t* Vm() const { return (bf16_t*)(ws + WO_Vm); }
  __device__ __forceinline__ bf16_t* S5A() const { return (bf16_t*)(ws + WO_S5A); }
  __device__ __forceinline__ bf16_t* S5Wy() const { return (bf16_t*)(ws + WO_S5Wy); }
  __device__ __forceinline__ bf16_t* S5Wz() const { return (bf16_t*)(ws + WO_S5Wz); }
  __device__ __forceinline__ float* S5Z() const { return (float*)(ws + WO_S5Z); }
  __device__ __forceinline__ float* S5a32() const { return (float*)(ws + WO_S5a32); }
  __device__ __forceinline__ bf16_t* Wglu_t() const { return (bf16_t*)(ws + WO_Wglu_t); }
  __device__ __forceinline__ bf16_t* ygb() const { return (bf16_t*)(ws + WO_yg); }
  __device__ __forceinline__ int* qctr() const { return (int*)(ws + WO_qctr); }
  __device__ __forceinline__ unsigned char* U8s() const { return ws + WO_Ub; }
  __device__ __forceinline__ float* su() const { return (float*)(ws + WO_Ub + (size_t)16384 * D); }
  __device__ __forceinline__ unsigned char* V8s() const { return ws + WO_Vb; }
  __device__ __forceinline__ float* sv() const { return (float*)(ws + WO_Vb + (size_t)16384 * D); }
  __device__ __forceinline__ unsigned char* h8hi() const { return ws + WO_ybuf + ((size_t)4 << 20); }
  __device__ __forceinline__ unsigned char* h8lo() const { return ws + WO_ybuf + ((size_t)4 << 20) + (size_t)T * D; }
  __device__ __forceinline__ float* sh() const { return (float*)(ws + WO_ybuf + ((size_t)4 << 20) + (size_t)2 * T * D); }
  __device__ __forceinline__ float* ppart() const { return (float*)(ws + WO_proj + (size_t)T * D * 2); }
  __device__ __forceinline__ bf16_t* Qr() const { return (bf16_t*)(ws + WO_Qr); }
  __device__ __forceinline__ bf16_t* Kr() const { return (bf16_t*)(ws + WO_Kr); }
  __device__ __forceinline__ bf16_t* Krv() const { return (bf16_t*)(ws + WO_Krv); }
  __device__ __forceinline__ bf16_t* Vr() const { return (bf16_t*)(ws + WO_Vr); }
  __device__ __forceinline__ float* KVr() const { return (float*)(ws + WO_KVr); }
  __device__ __forceinline__ bf16_t* Rb() const { return (bf16_t*)(ws + WO_Rb); }
  __device__ __forceinline__ bf16_t* qb() const { return (bf16_t*)(ws + WO_proj); }
};

namespace pg8 {
#define PG8_LAS __attribute__((address_space(3)))
typedef unsigned short bf16_t;
typedef short bf16x8 __attribute__((ext_vector_type(8)));
typedef float f32x4 __attribute__((ext_vector_type(4)));
typedef unsigned u32x4 __attribute__((ext_vector_type(4)));
constexpr int BM = 256, BK = 64, HALF = 128, HTB = HALF * BK * 2  , STAGE_BYTES = 8 * HTB, NXCD = 8, WGM = 8;

__host__ __device__ __forceinline__ int lds_byte(int r, int c) { const int st = (r >> 4) * 2 + (c >> 5), rr = r & 15, cc = c & 31, ob = rr * 64 + cc * 2; return st * 1024 + (ob ^ (((ob >> 9) & 1) << 5)); }
__host__ __device__ __forceinline__ void stage_rc(int b, int& R, int& C) { const int st = b / 1024, sb = b % 1024, swz = sb ^ (((sb >> 9) & 1) << 5); R = (st >> 1) * 16 + swz / 64; C = (st & 1) * 32 + (swz % 64) / 2; }
__host__ __device__ __forceinline__ int perm32(int rho) { const int n = rho >> 4, i = rho & 15; return 8 * (i >> 2) + 4 * n + (i & 3); }

struct Unit { int pm, pn; };
struct Gemm { const bf16_t* A; const bf16_t* Bt; int M, N, K, lda, ldb; };

struct StaticOrder {
    int nM, nN, nwg, G, c;
    __host__ __device__ void init(int M, int N, int G_, int c_) { nM = M / BM; nN = N / BM; nwg = nM * nN; G = G_; c = c_; }
    __host__ __device__ bool next(int i, Unit& u) const {
        const long L = (long)i * G + c; if (L >= nwg) return false;
        int wgid = (int)L; { const int q = nwg / NXCD, r = nwg % NXCD, xcd = wgid % NXCD, off = wgid / NXCD; wgid = (xcd < r ? xcd * (q + 1) : r * (q + 1) + (xcd - r) * q) + off; }
        const int nig = WGM * nN, gid = wgid / nig, fm = gid * WGM, gsz = (nM - fm) < WGM ? (nM - fm) : WGM;
        u.pm = fm + ((wgid % nig) % gsz); u.pn = (wgid % nig) / gsz; return true;
    }
    __device__ __forceinline__ void a_ready(const Unit&) const {}
    __device__ __forceinline__ void done(const Unit&) const {}
};
struct GroupOrder {
    int mt, nt_, nwg, G, c;
    __host__ __device__ void init(int ngroups, int mt__, int nt__, int G_, int c_) { mt = mt__; nt_ = nt__; nwg = ngroups * mt * nt_; G = G_; c = c_; }
    __host__ __device__ bool next(int i, Unit& u) const {
        const long L = (long)i * G + c; if (L >= nwg) return false;
        const int per = mt * nt_, gi = (int)L / per, r = (int)L % per;
        u.pm = gi * mt + r % mt; u.pn = gi * nt_ + r / mt; return true;
    }
    __device__ __forceinline__ void a_ready(const Unit&) const {}
    __device__ __forceinline__ void done(const Unit&) const {}
};
template <class Epi, class Sched, bool ALIGN_EPI = false, bool SP2 = false>
__device__ __forceinline__ void gemm_phase(PG8_LAS unsigned char* lds, const Gemm g, const Sched& S, const Epi& E) {
    int tid_ = threadIdx.x; asm volatile("" : "+v"(tid_));
    const int tid = tid_, wid = __builtin_amdgcn_readfirstlane(tid >> 6), lane = tid & 63, wr = wid >> 2, wc = wid & 3, fr = lane & 15, fq = lane >> 4;
    const int K = g.K, nt = K / BK;
    unsigned voffA[2], voffB[2];
#pragma unroll
    for (int i = 0; i < 2; ++i) { int R, C; stage_rc(tid * 16 + i * 8192, R, C); const int Rb = Epi::PERM ? ((R & ~31) + perm32(R & 31)) : R;
        voffA[i] = (unsigned)(R * g.lda + C) * 2u; voffB[i] = (unsigned)(Rb * g.ldb + C) * 2u; }
    const size_t kstep = (size_t)(BK * 2);
    const size_t hstepA = (size_t)HALF * g.lda * 2, hstepB = (size_t)HALF * g.ldb * 2;
    const size_t tstepA = 2 * hstepA, tstepB = 2 * hstepB;
    const unsigned ldsw = (unsigned)wid * 1024u;
    const int aoff = lds_byte(wr * 64 + fr, fq * 8), boff = lds_byte(wc * 32 + fr, fq * 8);
#define PG8_SA(b, h) (((b) * 2 + (h)) * HTB)
#define PG8_SB(b, h) ((4 + (b) * 2 + (h)) * HTB)
#define PG8_STAGE(bufoff, gbase, voff) do { _Pragma("unroll") for (int _i = 0; _i < 2; ++_i) \
        __builtin_amdgcn_global_load_lds((const unsigned*)((const char*)(gbase) + (voff)[_i]), (PG8_LAS unsigned*)(lds + (bufoff) + ldsw + _i * 8192), 16, 0, 0); } while (0)
#define PG8_LDA(dst, b, h) do { _Pragma("unroll") for (int m = 0; m < 4; ++m) _Pragma("unroll") for (int k = 0; k < 2; ++k) dst[m][k] = *(const PG8_LAS bf16x8*)(lds + PG8_SA(b, h) + aoff + m * 2048 + k * 1024); } while (0)
#define PG8_LDB(dst, b, h) do { _Pragma("unroll") for (int n = 0; n < 2; ++n) _Pragma("unroll") for (int k = 0; k < 2; ++k) dst[n][k] = *(const PG8_LAS bf16x8*)(lds + PG8_SB(b, h) + boff + n * 2048 + k * 1024); } while (0)
#define PG8_MMA(ai, bj, At, Bt) do { __builtin_amdgcn_s_setprio(1); _Pragma("unroll") for (int m = 0; m < 4; ++m) _Pragma("unroll") for (int n = 0; n < 2; ++n) _Pragma("unroll") for (int k = 0; k < 2; ++k) \
        acc[ai][bj][m][n] = __builtin_amdgcn_mfma_f32_16x16x32_bf16(Bt[n][k], At[m][k], acc[ai][bj][m][n], 0, 0, 0); __builtin_amdgcn_s_setprio(0); } while (0)
#define PG8_WAIT_V(n) asm volatile("s_waitcnt vmcnt(" #n ")" ::: "memory")
#define PG8_WAIT_L(n) asm volatile("s_waitcnt lgkmcnt(" #n ")" ::: "memory")
#define PG8_BAR __builtin_amdgcn_s_barrier()
#define PG8_SCHED __builtin_amdgcn_sched_barrier(0)
    Unit cur, nxt; int ui = 0;
    if (!S.next(0, cur)) return;
    f32x4 acc[2][2][4][2];
    E.init(acc, cur, wr, wc, fr, fq);
    bf16x8 At[4][2], B0[2][2], B1[2][2];
    const char* cA = (const char*)g.A + (size_t)cur.pm * tstepA; const char* cB = (const char*)g.Bt + (size_t)cur.pn * tstepB;
    S.a_ready(cur);
    if constexpr (SP2) {
        PG8_STAGE(PG8_SB(0, 0), cB, voffB); PG8_STAGE(PG8_SB(0, 1), cB + hstepB, voffB); PG8_STAGE(PG8_SA(0, 0), cA, voffA); PG8_STAGE(PG8_SA(0, 1), cA + hstepA, voffA);
        if (wr == 1) PG8_BAR;
        PG8_WAIT_V(2); PG8_BAR;
        PG8_STAGE(PG8_SB(1, 0), cB + kstep, voffB); PG8_STAGE(PG8_SA(1, 0), cA + kstep, voffA); PG8_STAGE(PG8_SB(1, 1), cB + hstepB + kstep, voffB);
        PG8_WAIT_V(6); PG8_BAR;
    } else {
        PG8_STAGE(PG8_SB(0, 0), cB, voffB); PG8_STAGE(PG8_SA(0, 0), cA, voffA); PG8_STAGE(PG8_SB(0, 1), cB + hstepB, voffB); PG8_STAGE(PG8_SA(0, 1), cA + hstepA, voffA);
        if (wr == 1) PG8_BAR;
        PG8_WAIT_V(4); PG8_BAR;
        PG8_STAGE(PG8_SB(1, 0), cB + kstep, voffB); PG8_STAGE(PG8_SA(1, 0), cA + kstep, voffA); PG8_STAGE(PG8_SB(1, 1), cB + hstepB + kstep, voffB);
        PG8_WAIT_V(6); PG8_BAR;
    }
    for (;;) {
        const bool has_next = S.next(ui + 1, nxt);
        const char* nA = has_next ? (const char*)g.A + (size_t)nxt.pm * tstepA : cA; const char* nB = has_next ? (const char*)g.Bt + (size_t)nxt.pn * tstepB : cB;
        for (int t = 0; t < nt; t += 2) {
            const bool last = (t == nt - 2);
            const char* a1 = cA + (size_t)(t + 1) * kstep;
            const char* a2 = last ? nA : cA + (size_t)(t + 2) * kstep; const char* b2 = last ? nB : cB + (size_t)(t + 2) * kstep;
            const char* a3 = a2 + kstep; const char* b3 = b2 + kstep;
            if (last && has_next) S.a_ready(nxt);
            if constexpr (SP2) {
            PG8_LDB(B0, 0, 0); PG8_LDB(B1, 0, 1); PG8_SCHED; PG8_LDA(At, 0, 0); PG8_STAGE(PG8_SA(1, 1), a1 + hstepA, voffA);
            PG8_WAIT_V(8); PG8_WAIT_L(0); PG8_BAR; PG8_MMA(0, 0, At, B0); PG8_MMA(0, 1, At, B1); PG8_BAR; PG8_SCHED;
            PG8_LDA(At, 0, 1); PG8_STAGE(PG8_SB(0, 0), b2, voffB); PG8_STAGE(PG8_SB(0, 1), b2 + hstepB, voffB); PG8_STAGE(PG8_SA(0, 0), a2, voffA);
            PG8_WAIT_V(8); PG8_WAIT_L(0); PG8_BAR; PG8_MMA(1, 0, At, B0); PG8_MMA(1, 1, At, B1); PG8_BAR; PG8_SCHED;
            PG8_LDB(B0, 1, 0); PG8_LDB(B1, 1, 1); PG8_SCHED; PG8_LDA(At, 1, 0); PG8_STAGE(PG8_SA(0, 1), a2 + hstepA, voffA);
            PG8_WAIT_V(8); PG8_WAIT_L(0); PG8_BAR; PG8_MMA(0, 0, At, B0); PG8_MMA(0, 1, At, B1); PG8_BAR; PG8_SCHED;
            PG8_LDA(At, 1, 1); PG8_STAGE(PG8_SB(1, 0), b3, voffB); PG8_STAGE(PG8_SB(1, 1), b3 + hstepB, voffB); PG8_STAGE(PG8_SA(1, 0), a3, voffA);
            PG8_WAIT_V(8); PG8_WAIT_L(0); PG8_BAR; PG8_MMA(1, 0, At, B0); PG8_MMA(1, 1, At, B1); PG8_BAR; PG8_SCHED;
            } else {
            PG8_LDB(B0, 0, 0); PG8_SCHED; PG8_LDA(At, 0, 0); PG8_STAGE(PG8_SA(1, 1), a1 + hstepA, voffA);
            PG8_WAIT_L(8); PG8_BAR; PG8_WAIT_L(0); PG8_MMA(0, 0, At, B0); PG8_BAR; PG8_SCHED;
            PG8_LDB(B1, 0, 1); PG8_STAGE(PG8_SB(0, 0), b2, voffB);
            PG8_BAR; PG8_WAIT_L(0); PG8_MMA(0, 1, At, B1); PG8_BAR;
            PG8_LDA(At, 0, 1); PG8_STAGE(PG8_SA(0, 0), a2, voffA);
            PG8_BAR; PG8_WAIT_L(0); PG8_MMA(1, 0, At, B0); PG8_BAR; PG8_SCHED;
            PG8_STAGE(PG8_SB(0, 1), b2 + hstepB, voffB);
            PG8_WAIT_V(6); PG8_BAR; PG8_MMA(1, 1, At, B1); PG8_BAR;
            PG8_LDB(B0, 1, 0); PG8_SCHED; PG8_LDA(At, 1, 0); PG8_STAGE(PG8_SA(0, 1), a2 + hstepA, voffA);
            PG8_WAIT_L(8); PG8_BAR; PG8_WAIT_L(0); PG8_MMA(0, 0, At, B0); PG8_BAR; PG8_SCHED;
            PG8_LDB(B1, 1, 1); PG8_STAGE(PG8_SB(1, 0), b3, voffB);
            PG8_BAR; PG8_WAIT_L(0); PG8_MMA(0, 1, At, B1); PG8_BAR;
            PG8_LDA(At, 1, 1); PG8_STAGE(PG8_SA(1, 0), a3, voffA);
            PG8_BAR; PG8_WAIT_L(0); PG8_MMA(1, 0, At, B0); PG8_BAR; PG8_SCHED;
            PG8_STAGE(PG8_SB(1, 1), b3 + hstepB, voffB);
            PG8_WAIT_V(6); PG8_BAR; PG8_MMA(1, 1, At, B1); PG8_BAR;
            }
        }
        if constexpr (ALIGN_EPI) { if (wr == 0) PG8_BAR; }
        if constexpr (!Epi::AFTER_DRAIN) { E(acc, cur, wr, wc, fr, fq); S.done(cur); }
        if (!has_next) break;
        E.init(acc, nxt, wr, wc, fr, fq);
        cur = nxt; cA = nA; cB = nB; ++ui;
        if constexpr (ALIGN_EPI) { if (wr == 1) PG8_BAR; }
    }
    PG8_WAIT_V(0);
    if constexpr (!ALIGN_EPI) { if (wr == 0) PG8_BAR; }
    PG8_BAR;
    if constexpr (Epi::AFTER_DRAIN) { E.fused(acc, cur, wr, wc, fr, fq, lds, wid, lane); S.done(cur); }
#undef PG8_SA
#undef PG8_SB
#undef PG8_STAGE
#undef PG8_LDA
#undef PG8_LDB
#undef PG8_MMA
#undef PG8_WAIT_V
#undef PG8_WAIT_L
#undef PG8_BAR
#undef PG8_SCHED
}
}
struct EpiScaleStore {
  static constexpr bool PERM = false, AFTER_DRAIN = false;
  float* C; int ldc; const float* rs;
  __device__ __forceinline__ void init(pg8::f32x4 (&acc)[2][2][4][2], const pg8::Unit&, int, int, int, int) const {
#pragma unroll
    for (int a = 0; a < 2; ++a)
#pragma unroll
      for (int b = 0; b < 2; ++b)
#pragma unroll
        for (int m = 0; m < 4; ++m)
#pragma unroll
          for (int n = 0; n < 2; ++n) acc[a][b][m][n] = (pg8::f32x4){0.f, 0.f, 0.f, 0.f};
  }
  __device__ __forceinline__ void operator()(const pg8::f32x4 (&acc)[2][2][4][2], const pg8::Unit& u, int wr, int wc, int fr_in, int fq_in) const {
    int fr = fr_in, fq = fq_in; asm volatile("" : "+v"(fr), "+v"(fq));
#pragma unroll
    for (int ai = 0; ai < 2; ++ai)
#pragma unroll
      for (int m = 0; m < 4; ++m) {
        const int row = u.pm * 256 + ai * 128 + wr * 64 + m * 16 + fr;
        const float r = rs[row];
#pragma unroll
        for (int bj = 0; bj < 2; ++bj)
#pragma unroll
          for (int n = 0; n < 2; ++n) {
            const int col = u.pn * 256 + bj * 128 + wc * 32 + n * 16 + 4 * fq;
            pg8::f32x4 v = acc[ai][bj][m][n] * r;
            *(pg8::f32x4*)(C + (size_t)row * ldc + col) = v;
          }
        asm volatile("" ::: "memory");
      }
  }
};
struct EpiAccum {
  static constexpr bool PERM = false, AFTER_DRAIN = false;
  float* C; int ldc;
  __device__ __forceinline__ void init(pg8::f32x4 (&acc)[2][2][4][2], const pg8::Unit& u, int wr, int wc, int fr, int fq) const {
#pragma unroll
    for (int ai = 0; ai < 2; ++ai)
#pragma unroll
      for (int m = 0; m < 4; ++m) {
        const int row = u.pm * 256 + ai * 128 + wr * 64 + m * 16 + fr;
#pragma unroll
        for (int bj = 0; bj < 2; ++bj)
#pragma unroll
          for (int n = 0; n < 2; ++n) {
            const int col = u.pn * 256 + bj * 128 + wc * 32 + n * 16 + 4 * fq;
            acc[ai][bj][m][n] = *(const pg8::f32x4*)(C + (size_t)row * ldc + col);
          }
      }
  }
  __device__ __forceinline__ void operator()(const pg8::f32x4 (&acc)[2][2][4][2], const pg8::Unit& u, int wr, int wc, int fr_in, int fq_in) const {
    int fr = fr_in, fq = fq_in; asm volatile("" : "+v"(fr), "+v"(fq));
#pragma unroll
    for (int ai = 0; ai < 2; ++ai)
#pragma unroll
      for (int m = 0; m < 4; ++m) {
        const int row = u.pm * 256 + ai * 128 + wr * 64 + m * 16 + fr;
#pragma unroll
        for (int bj = 0; bj < 2; ++bj)
#pragma unroll
          for (int n = 0; n < 2; ++n) {
            const int col = u.pn * 256 + bj * 128 + wc * 32 + n * 16 + 4 * fq;
            *(pg8::f32x4*)(C + (size_t)row * ldc + col) = acc[ai][bj][m][n];
          }
        asm volatile("" ::: "memory");
      }
  }
};
struct EpiScaleStoreBf16 {
  static constexpr bool PERM = false, AFTER_DRAIN = false;
  bf16_t* C; int ldc; const float* rs;
  __device__ __forceinline__ void init(pg8::f32x4 (&acc)[2][2][4][2], const pg8::Unit&, int, int, int, int) const {
#pragma unroll
    for (int a = 0; a < 2; ++a)
#pragma unroll
      for (int b = 0; b < 2; ++b)
#pragma unroll
        for (int m = 0; m < 4; ++m)
#pragma unroll
          for (int n = 0; n < 2; ++n) acc[a][b][m][n] = (pg8::f32x4){0.f, 0.f, 0.f, 0.f};
  }
  __device__ __forceinline__ void operator()(const pg8::f32x4 (&acc)[2][2][4][2], const pg8::Unit& u, int wr, int wc, int fr_in, int fq_in) const {
    int fr = fr_in, fq = fq_in; asm volatile("" : "+v"(fr), "+v"(fq));
#pragma unroll
    for (int ai = 0; ai < 2; ++ai)
#pragma unroll
      for (int m = 0; m < 4; ++m) {
        const int row = u.pm * 256 + ai * 128 + wr * 64 + m * 16 + fr;
        const float r = rs[row];
#pragma unroll
        for (int bj = 0; bj < 2; ++bj)
#pragma unroll
          for (int n = 0; n < 2; ++n) {
            const int col = u.pn * 256 + bj * 128 + wc * 32 + n * 16 + 4 * fq;
            pg8::f32x4 v = acc[ai][bj][m][n] * r;
            uint2 o; o.x = pk_bf16(v[0], v[1]); o.y = pk_bf16(v[2], v[3]);
            *(uint2*)(C + (size_t)row * ldc + col) = o;
          }
        asm volatile("" ::: "memory");
      }
  }
};
template <class Epi>
__device__ __forceinline__ void run_gemm(unsigned char* lds_raw, const bf16_t* A, const bf16_t* Bt, int M, int N, int K, const Epi& e) {
  pg8::Gemm g{A, Bt, M, N, K, K, K}; pg8::StaticOrder So; So.init(M, N, (int)gridDim.x, (int)blockIdx.x);
  pg8::gemm_phase<Epi, pg8::StaticOrder, true, true>((PG8_LAS unsigned char*)lds_raw, g, So, e);
}

__device__ __forceinline__ void transpose_items(const float* __restrict__ W, int K, int N, const float* __restrict__ g, bf16_t* __restrict__ Wt, int gw, int ngw, int lane) {
  const int nkt = K / 64, nnt = N / 64;
  for (int it = gw; it < nkt * nnt; it += ngw) {
    int kt = it % nkt, ntile = it / nkt;
    int k0 = kt * 64, n = ntile * 64 + lane;
    float v[64];
#pragma unroll
    for (int i = 0; i < 64; ++i) v[i] = W[(size_t)(k0 + i) * N + n] * g[k0 + i];
    bf16_t* dst = Wt + (size_t)n * (K * KS) + k0;
#pragma unroll
    for (int c = 0; c < 8; ++c) {
      bf16_t hi[8], lo[8];
#pragma unroll
      for (int e = 0; e < 8; ++e) { hi[e] = f2bf(v[c * 8 + e]); lo[e] = f2bf(v[c * 8 + e] - bf2f(hi[e])); }
      uint4 ph, pl;
      ph.x = hi[0] | ((unsigned)hi[1] << 16); ph.y = hi[2] | ((unsigned)hi[3] << 16); ph.z = hi[4] | ((unsigned)hi[5] << 16); ph.w = hi[6] | ((unsigned)hi[7] << 16);
      pl.x = lo[0] | ((unsigned)lo[1] << 16); pl.y = lo[2] | ((unsigned)lo[3] << 16); pl.z = lo[4] | ((unsigned)lo[5] << 16); pl.w = lo[6] | ((unsigned)lo[7] << 16);
      *(uint4*)(dst + c * 8) = ph;
      if (PRECISE) { *(uint4*)(dst + K + c * 8) = pl; *(uint4*)(dst + 2 * K + c * 8) = ph; }
    }
  }
}

__device__ __forceinline__ void phase_cvt_rows(const float* __restrict__ src, bf16_t* __restrict__ dst, float* __restrict__ rstd, int gw, int ngw, int lane) {
  for (int t = gw; t < T; t += ngw) {
    const float4* p = (const float4*)(src + (size_t)t * D);
    float ss = 0.f;
#pragma unroll
    for (int i = 0; i < 4; ++i) {
      float4 v = p[lane + i * 64];
      ss += v.x * v.x + v.y * v.y + v.z * v.z + v.w * v.w;
      bf16_t h0 = f2bf(v.x), h1 = f2bf(v.y), h2 = f2bf(v.z), h3 = f2bf(v.w);
      uint2 ph; ph.x = h0 | ((unsigned)h1 << 16); ph.y = h2 | ((unsigned)h3 << 16);
      bf16_t* d = dst + (size_t)t * KD + (lane + i * 64) * 4;
      *(uint2*)d = ph;
      if (PRECISE) {
        bf16_t l0 = f2bf(v.x - bf2f(h0)), l1 = f2bf(v.y - bf2f(h1)), l2 = f2bf(v.z - bf2f(h2)), l3 = f2bf(v.w - bf2f(h3));
        uint2 pl; pl.x = l0 | ((unsigned)l1 << 16); pl.y = l2 | ((unsigned)l3 << 16);
        *(uint2*)(d + D) = ph; *(uint2*)(d + 2 * D) = pl;
      }
    }
    if (rstd) { ss = wave_sum(ss); if (lane == 0) rstd[t] = rsqrtf(ss / (float)D + EPS); }
  }
}

__device__ __forceinline__ void phase_prologue(const Params& p, int gtid, int ngt, int gw, int ngw, int lane) {
  for (int idx = gtid; idx < S * 40; idx += ngt) {
    int s = idx / 40, i = idx % 40;
    if (i < 8) {
      float inv = powf(500000.0f, -(float)(2 * i) / 16.0f);
      float ang = (float)s * inv;
      p.cosm()[s * 8 + i] = (float)cos((double)ang); p.sinm()[s * 8 + i] = (float)sin((double)ang);
    } else {
      int j = i - 8;
      float inv = powf(10000.0f, -((float)j / 31.0f));
      float ang = (float)s * inv;
      p.cosr()[s * 32 + j] = (float)cos((double)ang); p.sinr()[s * 32 + j] = (float)sin((double)ang);
    }
  }
  { const float4* a = (const float4*)p.in[0]; float4* b = (float4*)p.out;
    for (size_t i = gtid; i < (size_t)T * D / 4; i += ngt) b[i] = a[i]; }
  for (int idx = gtid; idx < NL * 65536; idx += ngt) { const int l2 = idx >> 16, n2 = (idx >> 8) & 255, k2 = idx & 255; p.Wglu_t()[idx] = f2bf(p.in[11][(size_t)l2 * 65536 + k2 * 256 + n2]); }
  for (int l = 0; l < NL; ++l) {
    transpose_items(p.in[2] + (size_t)l * D * INW, D, INW, p.in[1] + l * D, p.Win_t() + (size_t)l * INW * KD, gw, ngw, lane);
    transpose_items(p.in[15] + (size_t)l * D * D, D, D, p.in[14] + l * D, p.Wout_t() + (size_t)l * D * KD, gw, ngw, lane);
    transpose_items(p.in[17] + (size_t)l * D * D, D, D, p.in[16] + l * D, p.Wq_t() + (size_t)l * D * KD, gw, ngw, lane);
  }
}

__device__ __forceinline__ void phase_postproj(const Params& p, int l, int gw, int ngw, int lane) {
  const float* gq = p.in[12] + l * 64; const float* gk = p.in[13] + l * 64;
  for (int w = gw; w < T * 24; w += ngw) {
    int t = w / 24, slot = w % 24, s = t % S;
    float* row = p.proj() + (size_t)t * INW;
    if (slot < 16) {
      int h = slot & 7;
      float* q = row + (slot < 8 ? OFF_QM : OFF_KM) + h * 64;
      const float* g = slot < 8 ? gq : gk;
      float v = q[lane];
      float ss = wave_sum(v * v);
      float u = v * rsqrtf(ss / 64.0f + EPS) * g[lane];
      int partner = lane < 8 ? lane + 8 : lane - 8;
      float pu = __shfl(u, partner & 63);
      float o = u;
      if (lane < 16) {
        int i = lane & 7;
        float c = p.cosm()[s * 8 + i], sn = p.sinm()[s * 8 + i];
        o = lane < 8 ? (u * c - pu * sn) : (u * c + pu * sn);
      }
      q[lane] = o;
    } else {
      int h = (slot - 16) & 3; bool isk = slot >= 20;
      float* q = row + (isk ? OFF_KR : OFF_QR) + h * 64;
      float v = q[lane];
      float pv = __shfl(v, lane ^ 32);
      int i = lane & 31;
      float c = p.cosr()[s * 32 + i], sn = p.sinr()[s * 32 + i];
      float o = lane < 32 ? (v * c - pv * sn) : (v * c + pv * sn);
      if (isk) o *= 0.125f;
      q[lane] = o;
    }
  }
}

__device__ __forceinline__ void phase_kmean(const Params& p, int gtid, int ngt) {
  for (int idx = gtid; idx < NB * 8 * 16 * 64; idx += ngt) {
    int d = idx & 63, j = (idx >> 6) & 15, h = (idx >> 10) & 7, b = idx >> 13;
    const float* q = p.proj() + ((size_t)(b * S + j * 256)) * INW + OFF_KM + h * 64 + d;
    float acc = 0.f;
    for (int i = 0; i < 256; ++i) acc += q[(size_t)i * INW];
    p.kmean()[idx] = acc / 256.0f;
  }
}

__device__ __forceinline__ void s5_unit(const Params& p, int l, int unit, float* red, int lane) {
  const int b = unit >> 4, g = unit & 15, pp = lane;
  const float* lam_re = p.in[3] + l * 1024; const float* lam_im = p.in[4] + l * 1024; const float* log_dt = p.in[5] + l * 16;
  const float* b_re = p.in[6] + l * 16384; const float* b_im = p.in[7] + l * 16384;
  const float* c_re = p.in[8] + l * 16384; const float* c_im = p.in[9] + l * 16384; const float* dskip = p.in[10] + l * 256;
  float lr = lam_re[g * 64 + pp], li = lam_im[g * 64 + pp];
  float dt = expf(log_dt[g]);
  float mag = expf(lr * dt);
  float ar = mag * cosf(li * dt), ai = mag * sinf(li * dt);
  float den = lr * lr + li * li;
  float fr = ((ar - 1.0f) * lr + ai * li) / den;
  float fi = (ai * lr - (ar - 1.0f) * li) / den;
  float bbr[16], bbi[16], cr[16], ci[16];
#pragma unroll
  for (int h = 0; h < 16; ++h) {
    float br = b_re[(g * 64 + pp) * 16 + h], bi = b_im[(g * 64 + pp) * 16 + h];
    bbr[h] = fr * br - fi * bi; bbi[h] = fr * bi + fi * br;
    cr[h] = c_re[(g * 16 + h) * 64 + pp]; ci[h] = c_im[(g * 16 + h) * 64 + pp];
  }
  const int hq = pp >> 2, qq = pp & 3;
  float dsk = dskip[g * 16 + hq];
  float sr = 0.f, si = 0.f;
  for (int t = 0; t < S; ++t) {
    const float* up = p.proj() + (size_t)(b * S + t) * INW + OFF_U + g * 16;
    float u[16];
#pragma unroll
    for (int h4 = 0; h4 < 4; ++h4) { float4 v = *(const float4*)(up + h4 * 4); u[h4 * 4] = v.x; u[h4 * 4 + 1] = v.y; u[h4 * 4 + 2] = v.z; u[h4 * 4 + 3] = v.w; }
    float bur = 0.f, bui = 0.f;
#pragma unroll
    for (int h = 0; h < 16; ++h) { bur = fmaf(u[h], bbr[h], bur); bui = fmaf(u[h], bbi[h], bui); }
    float nr = ar * sr - ai * si + bur, ni = ar * si + ai * sr + bui;
    sr = nr; si = ni;
    LDS_FENCE();
#pragma unroll
    for (int h = 0; h < 16; ++h) red[h * 65 + pp] = sr * cr[h] - si * ci[h];
    LDS_FENCE();
    float acc = 0.f;
#pragma unroll
    for (int i = 0; i < 16; ++i) acc += red[hq * 65 + qq * 16 + i];
    acc += __shfl_xor(acc, 1);
    acc += __shfl_xor(acc, 2);
    if (qq == 0) p.yg()[(size_t)(b * S + t) * 256 + g * 16 + hq] = gelu_tanh(acc + up[hq] * dsk);
  }
}

__device__ __forceinline__ void ret_units(const Params& p, int l, int unit0, float* lds) {
  constexpr int TB = 16;
  int tx_ = threadIdx.x; asm volatile("" : "+v"(tx_));
  const int vb = tx_ >> 8, tid = tx_ & 255;
  float* base_l = lds + vb * (TB * 64 * 3 + TB * 4 * 64);
  float* qs = base_l; float* ks = qs + TB * 64; float* vs = ks + TB * 64; float* red = vs + TB * 64;
  const int unit = unit0 + vb;
  const int b = unit >> 2, h = unit & 3;
  const int e = tid & 63, dg = tid >> 6;
  const float gamma = 1.0f - exp2f(-5.0f - (float)h);
  float St[16];
#pragma unroll
  for (int i = 0; i < 16; ++i) St[i] = 0.f;
  const float* base = p.proj() + (size_t)(b * S) * INW;
  for (int t0 = 0; t0 < S; t0 += TB) {
    __syncthreads();
    for (int i = tid; i < TB * 64; i += 256) {
      int tt = i >> 6, d = i & 63;
      const float* r = base + (size_t)(t0 + tt) * INW;
      qs[tt * 64 + d] = r[OFF_QR + h * 64 + d]; ks[tt * 64 + d] = r[OFF_KR + h * 64 + d]; vs[tt * 64 + d] = r[OFF_VR + h * 64 + d];
    }
    __syncthreads();
    for (int tt = 0; tt < TB; ++tt) {
      float ve = vs[tt * 64 + e], part = 0.f;
#pragma unroll
      for (int i = 0; i < 16; ++i) {
        St[i] = fmaf(gamma, St[i], ks[tt * 64 + dg * 16 + i] * ve);
        part = fmaf(qs[tt * 64 + dg * 16 + i], St[i], part);
      }
      red[(tt * 4 + dg) * 64 + e] = part;
    }
    __syncthreads();
    for (int k = 0; k < 4; ++k) {
      int tt = dg * 4 + k;
      float o = red[(tt * 4 + 0) * 64 + e] + red[(tt * 4 + 1) * 64 + e] + red[(tt * 4 + 2) * 64 + e] + red[(tt * 4 + 3) * 64 + e];
      float ss = wave_sum(o * o);
      float gv = base[(size_t)(t0 + tt) * INW + OFF_GR + h * 64 + e];
      float sl = gv * sigmoidf_(gv);
      int col = 768 + h * 64 + e;
      p.ybuf()[(size_t)(b * S + t0 + tt) * D + col] = sl * o * rsqrtf(ss / 64.0f + EPS);
    }
  }
}

__device__ __forceinline__ void phase_s5glu(const Params& p, int l, float* ys, int gw, int ngw, int lane) {
  const float* wglu = p.in[11] + (size_t)l * 65536;
  for (int t = gw; t < T; t += ngw) {
    float yv[4];
    LDS_FENCE();
#pragma unroll
    for (int i = 0; i < 4; ++i) { yv[i] = p.yg()[(size_t)t * 256 + lane + i * 64]; ys[lane + i * 64] = yv[i]; }
    LDS_FENCE();
    float z[4] = {0.f, 0.f, 0.f, 0.f};
    for (int k = 0; k < 256; ++k) {
      float yk = ys[k];
#pragma unroll
      for (int i = 0; i < 4; ++i) z[i] = fmaf(yk, wglu[k * 256 + lane + i * 64], z[i]);
    }
    float o[4], ss = 0.f;
#pragma unroll
    for (int i = 0; i < 4; ++i) { o[i] = yv[i] * sigmoidf_(z[i]); ss += o[i] * o[i]; }
    ss = wave_sum(ss);
    float r = rsqrtf(ss / 256.0f + EPS);
#pragma unroll
    for (int i = 0; i < 4; ++i) p.ybuf()[(size_t)t * D + lane + i * 64] = o[i] * r;
  }
}


struct S5P { float lr, li, dt, fr, fi; };
__device__ __forceinline__ S5P s5p(const Params& p, int l, int g, int pp) {
  S5P r; r.lr = p.in[3][l * 1024 + g * 64 + pp]; r.li = p.in[4][l * 1024 + g * 64 + pp]; r.dt = expf(p.in[5][l * 16 + g]);
  const float mag = expf(r.lr * r.dt); float sn, cs; sincosf(r.li * r.dt, &sn, &cs);
  const float ar = mag * cs, ai = mag * sn, den = r.lr * r.lr + r.li * r.li;
  r.fr = ((ar - 1.0f) * r.lr + ai * r.li) / den; r.fi = (ai * r.lr - (ar - 1.0f) * r.li) / den;
  return r;
}
__device__ __forceinline__ void s5pow(const S5P& s, int k, float& re, float& im) {
  const float m = expf((float)k * s.lr * s.dt); float sn, cs; sincosf((float)k * s.li * s.dt, &sn, &cs); re = m * cs; im = m * sn;
}
__device__ __forceinline__ void phase_s5_prep(const Params& p, int l, int gtid, int ngt) {
  const float* b_re = p.in[6] + l * 16384; const float* b_im = p.in[7] + l * 16384;
  const float* c_re = p.in[8] + l * 16384; const float* c_im = p.in[9] + l * 16384;
  bf16_t* Wy = p.S5Wy(); bf16_t* Wz = p.S5Wz();
  for (int it = gtid; it < 16 * 32 * 256; it += ngt) {
    const int hp = it & 15, h = (it >> 4) & 15, d = (it >> 8) & 31, g = it >> 13;
    float acc = 0.f;
    for (int pp = 0; pp < 64; ++pp) {
      const S5P s = s5p(p, l, g, pp);
      float pr, pi; s5pow(s, d, pr, pi);
      const float br = b_re[(g * 64 + pp) * 16 + hp], bi = b_im[(g * 64 + pp) * 16 + hp];
      const float bbr = s.fr * br - s.fi * bi, bbi = s.fr * bi + s.fi * br;
      const float tr = pr * bbr - pi * bbi, ti = pr * bbi + pi * bbr;
      acc += c_re[(g * 16 + h) * 64 + pp] * tr - c_im[(g * 16 + h) * 64 + pp] * ti;
    }
    const bf16_t v = f2bf(acc);
    for (int jp = 0; jp + d < 32; ++jp) {
      const int j = jp + d;
      Wy[((size_t)g * 512 + j * 16 + h) * 640 + jp * 16 + hp] = v;
      if (d > 0) Wy[((size_t)g * 512 + jp * 16 + h) * 640 + j * 16 + hp] = 0;
    }
  }
  for (int it = gtid; it < 16 * 32 * 16 * 64; it += ngt) {
    const int pp = it & 63, h = (it >> 6) & 15, j = (it >> 10) & 31, g = it >> 15;
    const S5P s = s5p(p, l, g, pp);
    float pr, pi; s5pow(s, j + 1, pr, pi);
    const float cr = c_re[(g * 16 + h) * 64 + pp], ci = c_im[(g * 16 + h) * 64 + pp];
    const unsigned w = pk_bf16(cr * pr - ci * pi, -(cr * pi + ci * pr));
    *(unsigned*)(Wy + ((size_t)g * 512 + j * 16 + h) * 640 + 512 + 2 * pp) = w;
  }
  for (int it = gtid; it < 16 * 64 * 32; it += ngt) {
    const int j = it & 31, pp = (it >> 5) & 63, g = it >> 11;
    const S5P s = s5p(p, l, g, pp);
    float pr, pi; s5pow(s, 31 - j, pr, pi);
    for (int hp = 0; hp < 16; ++hp) {
      const float br = b_re[(g * 64 + pp) * 16 + hp], bi = b_im[(g * 64 + pp) * 16 + hp];
      const float bbr = s.fr * br - s.fi * bi, bbi = s.fr * bi + s.fi * br;
      Wz[((size_t)g * 256 + 2 * pp) * 512 + j * 16 + hp] = f2bf(pr * bbr - pi * bbi);
      Wz[((size_t)g * 256 + 2 * pp + 1) * 512 + j * 16 + hp] = f2bf(pr * bbi + pi * bbr);
    }
  }
  for (int it = gtid; it < 16 * 64; it += ngt) {
    const S5P s = s5p(p, l, it >> 6, it & 63);
    float pr, pi; s5pow(s, 32, pr, pi);
    p.S5a32()[it * 2] = pr; p.S5a32()[it * 2 + 1] = pi;
  }
}
__device__ __forceinline__ void phase_pack_u(const Params& p, int gtid, int ngt) {
  for (int idx = gtid; idx < T * 32; idx += ngt) {
    const int t = idx >> 5, i = idx & 31, g = i >> 1;
    const float* src = p.proj() + (size_t)t * INW + i * 8;
    float4 a = *(const float4*)src, b4 = *(const float4*)(src + 4);
    uint4 o; o.x = pk_bf16(a.x, a.y); o.y = pk_bf16(a.z, a.w); o.z = pk_bf16(b4.x, b4.y); o.w = pk_bf16(b4.z, b4.w);
    *(uint4*)(p.S5A() + ((size_t)g * 1024 + (t >> 5)) * 640 + (t & 31) * 16 + (i & 1) * 8) = o;
  }
}
__device__ __forceinline__ void phase_s5_scan(const Params& p, int gtid, int ngt) {
  for (int it = gtid; it < NB * 16 * 64; it += ngt) {
    const int pp = it & 63, g = (it >> 6) & 15, b = it >> 10;
    const float er = p.S5a32()[(g * 64 + pp) * 2], ei = p.S5a32()[(g * 64 + pp) * 2 + 1];
    float sr = 0.f, si = 0.f;
    for (int c = 0; c < 128; ++c) {
      const size_t ch = (size_t)g * 1024 + b * 128 + c;
      *(unsigned*)(p.S5A() + ch * 640 + 512 + 2 * pp) = pk_bf16(sr, si);
      const float2 z = *(const float2*)(p.S5Z() + ch * 128 + 2 * pp);
      const float nr = er * sr - ei * si + z.x, ni = er * si + ei * sr + z.y;
      sr = nr; si = ni;
    }
  }
}
#define EPI_ZERO_INIT \
  __device__ __forceinline__ void init(pg8::f32x4 (&acc)[2][2][4][2], const pg8::Unit&, int, int, int, int) const { \
    _Pragma("unroll") for (int a = 0; a < 2; ++a) _Pragma("unroll") for (int b = 0; b < 2; ++b) \
    _Pragma("unroll") for (int m = 0; m < 4; ++m) _Pragma("unroll") for (int n = 0; n < 2; ++n) acc[a][b][m][n] = (pg8::f32x4){0.f, 0.f, 0.f, 0.f}; }
struct EpiS5Z {
  static constexpr bool PERM = false, AFTER_DRAIN = false;
  float* Z;
  EPI_ZERO_INIT
  __device__ __forceinline__ void operator()(const pg8::f32x4 (&acc)[2][2][4][2], const pg8::Unit& u, int wr, int wc, int fr_in, int fq_in) const {
    int fr = fr_in, fq = fq_in; asm volatile("" : "+v"(fr), "+v"(fq));
    const int g = u.pm >> 2;
#pragma unroll
    for (int ai = 0; ai < 2; ++ai)
#pragma unroll
      for (int m = 0; m < 4; ++m) {
        const int chunk = (u.pm & 3) * 256 + ai * 128 + wr * 64 + m * 16 + fr;
#pragma unroll
        for (int n = 0; n < 2; ++n) *(pg8::f32x4*)(Z + ((size_t)g * 1024 + chunk) * 128 + wc * 32 + n * 16 + 4 * fq) = acc[ai][0][m][n];
      }
  }
};
struct EpiS5Y {
  static constexpr bool PERM = false, AFTER_DRAIN = false;
  bf16_t* ygb; const bf16_t* A; const float* dsk;
  EPI_ZERO_INIT
  __device__ __forceinline__ void operator()(const pg8::f32x4 (&acc)[2][2][4][2], const pg8::Unit& u, int wr, int wc, int fr_in, int fq_in) const {
    int fr = fr_in, fq = fq_in; asm volatile("" : "+v"(fr), "+v"(fq));
    const int g = u.pm >> 2;
#pragma unroll
    for (int ai = 0; ai < 2; ++ai)
#pragma unroll
      for (int m = 0; m < 4; ++m) {
        const int chunk = (u.pm & 3) * 256 + ai * 128 + wr * 64 + m * 16 + fr;
#pragma unroll
        for (int bj = 0; bj < 2; ++bj)
#pragma unroll
          for (int n = 0; n < 2; ++n) {
            const int col = (u.pn & 1) * 256 + bj * 128 + wc * 32 + n * 16 + 4 * fq, j = col >> 4, h = col & 15;
            const uint2 uu = *(const uint2*)(A + ((size_t)g * 1024 + chunk) * 640 + col);
            const pg8::f32x4 dv = *(const pg8::f32x4*)(dsk + g * 16 + h);
            const pg8::f32x4 v = acc[ai][bj][m][n];
            const float y0 = fast_gelu(v[0] + dv[0] * __uint_as_float(uu.x << 16)), y1 = fast_gelu(v[1] + dv[1] * __uint_as_float(uu.x & 0xffff0000u));
            const float y2 = fast_gelu(v[2] + dv[2] * __uint_as_float(uu.y << 16)), y3 = fast_gelu(v[3] + dv[3] * __uint_as_float(uu.y & 0xffff0000u));
            uint2 o; o.x = pk_bf16(y0, y1); o.y = pk_bf16(y2, y3);
            *(uint2*)(ygb + ((size_t)chunk * 32 + j) * 256 + g * 16 + h) = o;
          }
        asm volatile("" ::: "memory");
      }
  }
};
struct EpiGlu {
  static constexpr bool PERM = false, AFTER_DRAIN = false;
  float* ybuf; const bf16_t* ygb; float* scr;
  EPI_ZERO_INIT
  __device__ __forceinline__ void operator()(const pg8::f32x4 (&acc_)[2][2][4][2], const pg8::Unit& u, int wr, int wc, int fr_in, int fq_in) const {
    int fr = fr_in, fq = fq_in; asm volatile("" : "+v"(fr), "+v"(fq));
    pg8::f32x4 (&acc)[2][2][4][2] = const_cast<pg8::f32x4 (&)[2][2][4][2]>(acc_);
#pragma unroll
    for (int ai = 0; ai < 2; ++ai)
#pragma unroll
      for (int m = 0; m < 4; ++m) {
        const int rl = ai * 128 + wr * 64 + m * 16 + fr, row = u.pm * 256 + rl;
        float ss = 0.f;
#pragma unroll
        for (int bj = 0; bj < 2; ++bj)
#pragma unroll
          for (int n = 0; n < 2; ++n) {
            const int col = bj * 128 + wc * 32 + n * 16 + 4 * fq;
            const uint2 yy = *(const uint2*)(ygb + (size_t)row * 256 + col);
            const pg8::f32x4 z = acc[ai][bj][m][n];
            pg8::f32x4 r;
            r[0] = __uint_as_float(yy.x << 16) * fast_sigmoid(z[0]); r[1] = __uint_as_float(yy.x & 0xffff0000u) * fast_sigmoid(z[1]);
            r[2] = __uint_as_float(yy.y << 16) * fast_sigmoid(z[2]); r[3] = __uint_as_float(yy.y & 0xffff0000u) * fast_sigmoid(z[3]);
            acc[ai][bj][m][n] = r;
            ss += r[0] * r[0] + r[1] * r[1] + r[2] * r[2] + r[3] * r[3];
          }
        ss += __shfl_xor(ss, 16); ss += __shfl_xor(ss, 32);
        if (fq == 0) scr[rl * 4 + wc] = ss;
        asm volatile("" ::: "memory");
      }
    asm volatile("s_waitcnt lgkmcnt(0)" ::: "memory"); __builtin_amdgcn_s_barrier(); asm volatile("" ::: "memory");
#pragma unroll
    for (int ai = 0; ai < 2; ++ai)
#pragma unroll
      for (int m = 0; m < 4; ++m) {
        const int rl = ai * 128 + wr * 64 + m * 16 + fr, row = u.pm * 256 + rl;
        const pg8::f32x4 s4 = *(const pg8::f32x4*)(scr + rl * 4);
        const float r = rsqrtf((s4[0] + s4[1] + s4[2] + s4[3]) / 256.0f + EPS);
#pragma unroll
        for (int bj = 0; bj < 2; ++bj)
#pragma unroll
          for (int n = 0; n < 2; ++n) *(pg8::f32x4*)(ybuf + (size_t)row * D + bj * 128 + wc * 32 + n * 16 + 4 * fq) = acc[ai][bj][m][n] * r;
        asm volatile("" ::: "memory");
      }
    asm volatile("s_waitcnt lgkmcnt(0)" ::: "memory"); __builtin_amdgcn_s_barrier(); asm volatile("" ::: "memory");
  }
};

constexpr float QSCALE = 0.125f * 1.4426950408889634f;

__device__ __forceinline__ void phase_pack_moba(const Params& p, int gtid, int ngt) {
  for (int idx = gtid; idx < T * 128; idx += ngt) {
    const int t = idx >> 7, c = idx & 127, isk = c >> 6, cc = c & 63, h = cc >> 3, ch = cc & 7;
    const float* src = p.proj() + (size_t)t * INW + (isk ? OFF_KM : OFF_QM) + h * 64 + ch * 8;
    float4 a = *(const float4*)src, b4 = *(const float4*)(src + 4);
    const float sc = isk ? 1.0f : QSCALE;
    uint4 o; o.x = pk_bf16(a.x * sc, a.y * sc); o.y = pk_bf16(a.z * sc, a.w * sc); o.z = pk_bf16(b4.x * sc, b4.y * sc); o.w = pk_bf16(b4.z * sc, b4.w * sc);
    const int b = t / S, s = t % S;
    bf16_t* dst = isk ? p.Km() + ((((size_t)(b * 8 + h) * (S / 32) + (s >> 5)) * 8 + ch) * 32 + (s & 31)) * 8
                      : p.Qm() + ((size_t)(b * 8 + h) * S + s) * 64 + ch * 8;
    *(uint4*)dst = o;
  }
  for (int idx = gtid; idx < NB * 8 * (S / 32) * 256; idx += ngt) {
    const int ln = idx & 63, ks = (idx >> 6) & 1, mb = (idx >> 7) & 1, tile = (idx >> 8) % (S / 32), bh = idx / (256 * (S / 32));
    const int b = bh >> 3, h = bh & 7, hh = ln >> 5, delta = mb * 32 + (ln & 31);
    float v[8];
#pragma unroll
    for (int j = 0; j < 8; ++j) {
      const int kappa = 16 * ks + 8 * (j >> 2) + 4 * hh + (j & 3), s = tile * 32 + kappa;
      v[j] = p.proj()[(size_t)(b * S + s) * INW + OFF_VM + h * 64 + delta];
    }
    uint4 o; o.x = pk_bf16(v[0], v[1]); o.y = pk_bf16(v[2], v[3]); o.z = pk_bf16(v[4], v[5]); o.w = pk_bf16(v[6], v[7]);
    *(uint4*)(p.Vm() + (size_t)idx * 8) = o;
  }
}

__device__ __forceinline__ void phase_moba2(const Params& p, int l, unsigned char* lds, int bid, int G) {
  int tid = threadIdx.x; asm volatile("" : "+v"(tid));
  const int lane = tid & 63, wv = tid >> 6, n = lane & 31, hh = lane >> 5;
  constexpr int OLD = 260;
  bf16_t* Qs = (bf16_t*)lds;
  float* Oaccf = (float*)(lds + 32768);
  float* laccf = (float*)(lds + 32768 + 64 * OLD * 4);
  float* kms = laccf + 256;
  float* gat = kms + 1024;
  unsigned char* lists = (unsigned char*)(gat + 4096);
  int* cnt = (int*)(lists + 4096);
  int* items = cnt + 16;
  int* ctr = items + 160;
  unsigned* selp = (unsigned*)(ctr + 4);
  float* bq = (float*)(selp + 256);
  int* Oacc = (int*)Oaccf; int* lacc = (int*)laccf;
  float kmax = 0.f;
  { const float* gk = p.in[13] + l * 64;
    for (int d = 0; d < 64; ++d) kmax = fmaxf(kmax, fabsf(gk[d]));
    kmax *= 8.0f * 1.01f; }
  for (int u = bid; u < NB * 8 * 16; u += G) {
    const int qblk = 15 - (u >> 6), bh = u & 63, b = bh >> 3, h = bh & 7;
    __syncthreads();
    { const uint4* src = (const uint4*)(p.Qm() + ((size_t)bh * S + qblk * 256) * 64);
      uint4* dst = (uint4*)Qs;
      for (int i = tid; i < 256 * 64 * 2 / 16; i += NTHR) dst[i] = src[i]; }
    for (int i = tid; i < qblk * 64; i += NTHR) kms[i] = p.kmean()[(size_t)bh * 1024 + i];
    for (int i = tid; i < 64 * OLD; i += NTHR) Oacc[i] = 0;
    if (tid < 256) lacc[tid] = 0;
    if (tid < 16) cnt[tid] = 0;
    __syncthreads();
    { const int q = tid & 255, par = tid >> 8;
      float qv[64];
#pragma unroll
      for (int c = 0; c < 8; ++c) {
        uint4 w = *(const uint4*)(Qs + q * 64 + c * 8);
        qv[c * 8 + 0] = __uint_as_float(w.x << 16); qv[c * 8 + 1] = __uint_as_float(w.x & 0xffff0000u);
        qv[c * 8 + 2] = __uint_as_float(w.y << 16); qv[c * 8 + 3] = __uint_as_float(w.y & 0xffff0000u);
        qv[c * 8 + 4] = __uint_as_float(w.z << 16); qv[c * 8 + 5] = __uint_as_float(w.z & 0xffff0000u);
        qv[c * 8 + 6] = __uint_as_float(w.w << 16); qv[c * 8 + 7] = __uint_as_float(w.w & 0xffff0000u);
      }
      if (par == 0) { float qq = 0.f;
#pragma unroll
        for (int d = 0; d < 64; ++d) qq = fmaf(qv[d], qv[d], qq);
        bq[q] = sqrtf(qq) * kmax; }
      for (int j = par; j < qblk; j += 2) {
        float g = 0.f;
#pragma unroll
        for (int d = 0; d < 64; ++d) g = fmaf(qv[d], kms[j * 64 + d], g);
        gat[q * 16 + j] = g;
      }
    }
    __syncthreads();
    if (tid < 256) {
      float b0 = -INFINITY, b1 = -INFINITY, b2 = -INFINITY; int i0 = 0, i1 = 0, i2 = 0;
      for (int j = 0; j < qblk; ++j) {
        float g = gat[tid * 16 + j];
        if (g > b0) { b2 = b1; i2 = i1; b1 = b0; i1 = i0; b0 = g; i0 = j; }
        else if (g > b1) { b2 = b1; i2 = i1; b1 = g; i1 = j; }
        else if (g > b2) { b2 = g; i2 = j; }
      }
      const int nsel = qblk < 3 ? qblk : 3;
      selp[tid] = (unsigned)i0 | ((unsigned)i1 << 4) | ((unsigned)i2 << 8) | ((unsigned)nsel << 12);
    }
    __syncthreads();
    for (int j = wv; j < qblk; j += 8) {
      int base = 0;
      for (int c = 0; c < 4; ++c) {
        const int q = c * 64 + lane;
        const unsigned sp = selp[q];
        const int ns = sp >> 12;
        const bool f = (ns > 0 && (int)(sp & 15) == j) || (ns > 1 && (int)((sp >> 4) & 15) == j) || (ns > 2 && (int)((sp >> 8) & 15) == j);
        const unsigned long long bal = __ballot(f);
        const int pos = base + __popcll(bal & ((1ull << lane) - 1ull));
        if (f) lists[j * 256 + pos] = (unsigned char)q;
        base += __popcll(bal);
      }
      if (lane == 0) cnt[j] = base;
    }
    __syncthreads();
    if (tid == 0) {
      int ni = 0;
#pragma unroll 1
      for (int g = 7; g >= 0; --g) items[ni++] = (16 << 8) | g;
      for (int j = 0; j < qblk; ++j) { const int ng = (cnt[j] + 31) >> 5; for (int g = 0; g < ng; ++g) items[ni++] = (j << 8) | g; }
      ctr[0] = ni; ctr[1] = 0;
    }
    __syncthreads();
    const int nitems = ctr[0];
    for (;;) {
      int it = 0;
      if (lane == 0) it = atomicAdd(&ctr[1], 1);
      it = __builtin_amdgcn_readfirstlane(it);
      if (it >= nitems) break;
      const int item = items[it];
      const int j = item >> 8, g = item & 255;
      const bool own = (j == 16);
      const int kb = own ? qblk : j;
      const int ntile = own ? (g + 1) : 8;
      int qi; bool valid;
      if (own) { qi = g * 32 + n; valid = true; }
      else { const int pos = g * 32 + n; valid = pos < cnt[j]; qi = lists[j * 256 + (valid ? pos : 0)]; }
      bf16x8 qf[4];
#pragma unroll
      for (int s = 0; s < 4; ++s) qf[s] = *(const bf16x8*)(Qs + qi * 64 + (2 * s + hh) * 8);
      const bf16_t* kt0 = p.Km() + ((size_t)bh * (S / 32) + kb * 8) * 2048 + lane * 8;
      const bf16_t* vt0 = p.Vm() + ((size_t)bh * (S / 32) + kb * 8) * 2048 + lane * 8;
      f32x16 O0, O1;
#pragma unroll
      for (int r = 0; r < 16; ++r) { O0[r] = 0.f; O1[r] = 0.f; }
      float lsum = 0.f;
      const float nbq = -bq[qi];
      bf16x8 kf[4], vf[4];
#pragma unroll
      for (int s = 0; s < 4; ++s) { kf[s] = *(const bf16x8*)(kt0 + s * 512); vf[s] = *(const bf16x8*)(vt0 + s * 512); }
      for (int kt = 0; kt < ntile; ++kt) {
        bf16x8 kn[4], vn[4];
        const int ktn = (kt + 1 < ntile) ? kt + 1 : kt;
#pragma unroll
        for (int s = 0; s < 4; ++s) { kn[s] = *(const bf16x8*)(kt0 + (size_t)ktn * 2048 + s * 512); vn[s] = *(const bf16x8*)(vt0 + (size_t)ktn * 2048 + s * 512); }
        f32x16 X;
#pragma unroll
        for (int r = 0; r < 16; ++r) X[r] = nbq;
#pragma unroll
        for (int s = 0; s < 4; ++s) X = __builtin_amdgcn_mfma_f32_32x32x16_bf16(kf[s], qf[s], X, 0, 0, 0);
        const bool diag = own && (kt == g);
        unsigned pw[8];
#pragma unroll
        for (int r = 0; r < 16; r += 2) {
          float e0 = __builtin_amdgcn_exp2f(X[r]), e1 = __builtin_amdgcn_exp2f(X[r + 1]);
          if (diag) {
            const int k0 = (r & 3) + 8 * (r >> 2) + 4 * hh, k1 = ((r + 1) & 3) + 8 * ((r + 1) >> 2) + 4 * hh;
            e0 = (k0 <= n) ? e0 : 0.f; e1 = (k1 <= n) ? e1 : 0.f;
          }
          lsum += e0 + e1;
          pw[r >> 1] = pk_bf16(e0, e1);
        }
        bf16x8 pf0, pf1;
        { uint4 t0 = make_uint4(pw[0], pw[1], pw[2], pw[3]), t1 = make_uint4(pw[4], pw[5], pw[6], pw[7]);
          pf0 = *(bf16x8*)&t0; pf1 = *(bf16x8*)&t1; }
        O0 = __builtin_amdgcn_mfma_f32_32x32x16_bf16(vf[0], pf0, O0, 0, 0, 0);
        O0 = __builtin_amdgcn_mfma_f32_32x32x16_bf16(vf[1], pf1, O0, 0, 0, 0);
        O1 = __builtin_amdgcn_mfma_f32_32x32x16_bf16(vf[2], pf0, O1, 0, 0, 0);
        O1 = __builtin_amdgcn_mfma_f32_32x32x16_bf16(vf[3], pf1, O1, 0, 0, 0);
#pragma unroll
        for (int s = 0; s < 4; ++s) { kf[s] = kn[s]; vf[s] = vn[s]; }
      }
      lsum += __shfl_xor(lsum, 32);
      if (valid) {
        if (hh == 0) atomicAdd(&lacc[qi], __float2int_rn(lsum * 1048576.0f));
#pragma unroll
        for (int r = 0; r < 16; ++r) {
          const int dim = (r & 3) + 8 * (r >> 2) + 4 * hh;
          atomicAdd(&Oacc[dim * OLD + qi], __float2int_rn(O0[r] * 1048576.0f));
          atomicAdd(&Oacc[(dim + 32) * OLD + qi], __float2int_rn(O1[r] * 1048576.0f));
        }
      }
    }
    __syncthreads();
    { const int q = tid >> 1, half = tid & 1;
      const float inv = 1.0f / (float)lacc[q];
      float o[32], ss = 0.f;
#pragma unroll
      for (int d = 0; d < 32; ++d) { o[d] = (float)Oacc[(half * 32 + d) * OLD + q] * inv; ss += o[d] * o[d]; }
      ss += __shfl_xor(ss, 1);
      const float r = rsqrtf(ss / 64.0f + EPS);
      float* dst = p.ybuf() + (size_t)(b * S + qblk * 256 + q) * D + 256 + h * 64 + half * 32;
#pragma unroll
      for (int d = 0; d < 32; d += 4) *(float4*)(dst + d) = make_float4(o[d] * r, o[d + 1] * r, o[d + 2] * r, o[d + 3] * r);
    }
  }
}


__device__ __forceinline__ float ret_log2g(int h) { return log2f(1.0f - exp2f(-5.0f - (float)h)); }
__device__ __forceinline__ void phase_pack_ret(const Params& p, int gtid, int ngt) {
  for (int idx = gtid; idx < T * 64; idx += ngt) {
    const int t = idx >> 6, c = idx & 63, isk = c >> 5, cc = c & 31, h = cc >> 3, ch = cc & 7;
    const int b = t / S, s = t % S, i = s & 127;
    const float* src = p.proj() + (size_t)t * INW + (isk ? OFF_KR : OFF_QR) + h * 64 + ch * 8;
    float4 a = *(const float4*)src, b4 = *(const float4*)(src + 4);
    const float sc = exp2f((isk ? -(float)i : (float)i) * ret_log2g(h));
    uint4 o; o.x = pk_bf16(a.x * sc, a.y * sc); o.y = pk_bf16(a.z * sc, a.w * sc); o.z = pk_bf16(b4.x * sc, b4.y * sc); o.w = pk_bf16(b4.z * sc, b4.w * sc);
    const int bh = b * 4 + h;
    bf16_t* dst = isk ? p.Kr() + ((((size_t)bh * (S / 32) + (s >> 5)) * 8 + ch) * 32 + (s & 31)) * 8
                      : p.Qr() + ((size_t)bh * S + s) * 64 + ch * 8;
    *(uint4*)dst = o;
  }
  for (int idx = gtid; idx < 2 * NB * 4 * (S / 32) * 256; idx += ngt) {
    const int ln = idx & 63, ks = (idx >> 6) & 1, blk = (idx >> 7) & 1, tile = (idx >> 8) % (S / 32), rest = idx / (256 * (S / 32)), bh = rest % (NB * 4), which = rest / (NB * 4);
    const int b = bh >> 2, h = bh & 3, hh = ln >> 5, delta = blk * 32 + (ln & 31);
    const float l2g = ret_log2g(h);
    float v[8];
#pragma unroll
    for (int j = 0; j < 8; ++j) {
      const int kappa = 16 * ks + 8 * (j >> 2) + 4 * hh + (j & 3), s = tile * 32 + kappa;
      float x = p.proj()[(size_t)(b * S + s) * INW + (which ? OFF_KR : OFF_VR) + h * 64 + delta];
      if (which) x *= exp2f(-(float)(s & 127) * l2g);
      v[j] = x;
    }
    uint4 o; o.x = pk_bf16(v[0], v[1]); o.y = pk_bf16(v[2], v[3]); o.z = pk_bf16(v[4], v[5]); o.w = pk_bf16(v[6], v[7]);
    *(uint4*)((which ? p.Krv() : p.Vr()) + ((size_t)(idx % (NB * 4 * (S / 32) * 256))) * 8) = o;
  }
}
__device__ __forceinline__ void phase_ret_kv(const Params& p, int gw, int ngw, int lane) {
  const int n = lane & 31, hh = lane >> 5;
  for (int w = gw; w < NB * 4 * 32; w += ngw) {
    const int bh = w >> 5, cn = w & 31;
    const bf16_t* vt = p.Vr() + ((size_t)bh * (S / 32) + cn * 4) * 2048 + lane * 8;
    const bf16_t* kt = p.Krv() + ((size_t)bh * (S / 32) + cn * 4) * 2048 + lane * 8;
    f32x16 acc[2][2];
#pragma unroll
    for (int a = 0; a < 2; ++a)
#pragma unroll
      for (int b2 = 0; b2 < 2; ++b2)
#pragma unroll
        for (int r = 0; r < 16; ++r) acc[a][b2][r] = 0.f;
#pragma unroll 1
    for (int tl = 0; tl < 4; ++tl)
#pragma unroll
      for (int ks = 0; ks < 2; ++ks) {
        bf16x8 vf[2], kf[2];
#pragma unroll
        for (int x = 0; x < 2; ++x) { vf[x] = *(const bf16x8*)(vt + tl * 2048 + (x * 2 + ks) * 512); kf[x] = *(const bf16x8*)(kt + tl * 2048 + (x * 2 + ks) * 512); }
#pragma unroll
        for (int mb = 0; mb < 2; ++mb)
#pragma unroll
          for (int nb = 0; nb < 2; ++nb) acc[mb][nb] = __builtin_amdgcn_mfma_f32_32x32x16_bf16(vf[mb], kf[nb], acc[mb][nb], 0, 0, 0);
      }
    float* dst = p.KVr() + ((size_t)bh * 32 + cn) * 4096;
#pragma unroll
    for (int mb = 0; mb < 2; ++mb)
#pragma unroll
      for (int nb = 0; nb < 2; ++nb)
#pragma unroll
        for (int r = 0; r < 16; ++r) dst[(mb * 32 + (r & 3) + 8 * (r >> 2) + 4 * hh) * 64 + nb * 32 + n] = acc[mb][nb][r];
  }
}
__device__ __forceinline__ void phase_ret_scan(const Params& p, int gtid, int ngt) {
  for (int it = gtid; it < NB * 4 * 4096; it += ngt) {
    const int e = it & 4095, bh = it >> 12, h = bh & 3;
    const float l2g = ret_log2g(h), g1 = exp2f(l2g), g127 = exp2f(127.0f * l2g), g128 = exp2f(128.0f * l2g);
    float R = 0.f;
    for (int cn = 0; cn < 32; ++cn) {
      const size_t o = ((size_t)bh * 32 + cn) * 4096 + e;
      p.Rb()[o] = f2bf(g1 * R);
      R = g128 * R + g127 * p.KVr()[o];
    }
  }
}
__device__ __forceinline__ void phase_ret_out(const Params& p, int gw, int ngw, int lane) {
  const int n = lane & 31, hh = lane >> 5;
  for (int w = gw; w < NB * 4 * 32 * 4; w += ngw) {
    const int qg = 3 - (w & 3), cn = (w >> 2) & 31, bh = w >> 7, b = bh >> 2, h = bh & 3;
    const int s0 = cn * 128 + qg * 32;
    bf16x8 qf[4];
#pragma unroll
    for (int s = 0; s < 4; ++s) qf[s] = *(const bf16x8*)(p.Qr() + ((size_t)bh * S + s0 + n) * 64 + (2 * s + hh) * 8);
    f32x16 O0, O1;
#pragma unroll
    for (int r = 0; r < 16; ++r) { O0[r] = 0.f; O1[r] = 0.f; }
    { const bf16_t* rb = p.Rb() + ((size_t)bh * 32 + cn) * 4096 + (size_t)n * 64 + hh * 8;
#pragma unroll
      for (int s = 0; s < 4; ++s) {
        const bf16x8 r0 = *(const bf16x8*)(rb + s * 16), r1 = *(const bf16x8*)(rb + 32 * 64 + s * 16);
        O0 = __builtin_amdgcn_mfma_f32_32x32x16_bf16(r0, qf[s], O0, 0, 0, 0);
        O1 = __builtin_amdgcn_mfma_f32_32x32x16_bf16(r1, qf[s], O1, 0, 0, 0);
      } }
    const bf16_t* kt0 = p.Kr() + ((size_t)bh * (S / 32) + cn * 4) * 2048 + lane * 8;
    const bf16_t* vt0 = p.Vr() + ((size_t)bh * (S / 32) + cn * 4) * 2048 + lane * 8;
    for (int kt = 0; kt <= qg; ++kt) {
      bf16x8 kf[4], vf[4];
#pragma unroll
      for (int s = 0; s < 4; ++s) { kf[s] = *(const bf16x8*)(kt0 + (size_t)kt * 2048 + s * 512); vf[s] = *(const bf16x8*)(vt0 + (size_t)kt * 2048 + s * 512); }
      f32x16 X;
#pragma unroll
      for (int r = 0; r < 16; ++r) X[r] = 0.f;
#pragma unroll
      for (int s = 0; s < 4; ++s) X = __builtin_amdgcn_mfma_f32_32x32x16_bf16(kf[s], qf[s], X, 0, 0, 0);
      const bool diag = (kt == qg);
      unsigned pw[8];
#pragma unroll
      for (int r = 0; r < 16; r += 2) {
        float e0 = X[r], e1 = X[r + 1];
        if (diag) {
          const int k0 = (r & 3) + 8 * (r >> 2) + 4 * hh, k1 = ((r + 1) & 3) + 8 * ((r + 1) >> 2) + 4 * hh;
          e0 = (k0 <= n) ? e0 : 0.f; e1 = (k1 <= n) ? e1 : 0.f;
        }
        pw[r >> 1] = pk_bf16(e0, e1);
      }
      bf16x8 pf0, pf1;
      { uint4 t0 = make_uint4(pw[0], pw[1], pw[2], pw[3]), t1 = make_uint4(pw[4], pw[5], pw[6], pw[7]);
        pf0 = *(bf16x8*)&t0; pf1 = *(bf16x8*)&t1; }
      O0 = __builtin_amdgcn_mfma_f32_32x32x16_bf16(vf[0], pf0, O0, 0, 0, 0);
      O0 = __builtin_amdgcn_mfma_f32_32x32x16_bf16(vf[1], pf1, O0, 0, 0, 0);
      O1 = __builtin_amdgcn_mfma_f32_32x32x16_bf16(vf[2], pf0, O1, 0, 0, 0);
      O1 = __builtin_amdgcn_mfma_f32_32x32x16_bf16(vf[3], pf1, O1, 0, 0, 0);
    }
    float ss = 0.f;
#pragma unroll
    for (int r = 0; r < 16; ++r) ss += O0[r] * O0[r] + O1[r] * O1[r];
    ss += __shfl_xor(ss, 32);
    const float rn = rsqrtf(ss / 64.0f + EPS);
    const size_t t = (size_t)b * S + s0 + n;
    const float* gp = p.proj() + t * INW + OFF_GR + h * 64;
    float* yo = p.ybuf() + t * D + 768 + h * 64;
#pragma unroll
    for (int q4 = 0; q4 < 4; ++q4) {
#pragma unroll
      for (int mb = 0; mb < 2; ++mb) {
        const int d0 = mb * 32 + 8 * q4 + 4 * hh;
        const float4 g = *(const float4*)(gp + d0);
        float4 o;
        const f32x16& Oa = mb ? O1 : O0;
        o.x = Oa[q4 * 4 + 0] * rn * g.x * fast_sigmoid(g.x); o.y = Oa[q4 * 4 + 1] * rn * g.y * fast_sigmoid(g.y);
        o.z = Oa[q4 * 4 + 2] * rn * g.z * fast_sigmoid(g.z); o.w = Oa[q4 * 4 + 3] * rn * g.w * fast_sigmoid(g.w);
        *(float4*)(yo + d0) = o;
      }
    }
  }
}

__device__ __forceinline__ void cvt_f32_bf16(const float* __restrict__ src, bf16_t* __restrict__ dst, size_t n8, int gtid, int ngt) {
  for (size_t i = gtid; i < n8; i += ngt) {
    float4 a = *(const float4*)(src + i * 8), b4 = *(const float4*)(src + i * 8 + 4);
    uint4 o; o.x = pk_bf16(a.x, a.y); o.y = pk_bf16(a.z, a.w); o.z = pk_bf16(b4.x, b4.y); o.w = pk_bf16(b4.z, b4.w);
    *(uint4*)(dst + i * 8) = o;
  }
}
__device__ __forceinline__ int f2key(float f) { int b = __float_as_int(f); return b ^ ((b >> 31) & 0x7fffffff); }
__device__ __forceinline__ float key2f(int k) { return __int_as_float(k ^ ((k >> 31) & 0x7fffffff)); }
#define CASD(a_, b_) { int mx_ = max(a_, b_), mn_ = min(a_, b_); a_ = mx_; b_ = mn_; }
__device__ __forceinline__ void sort16_desc(int (&v)[16]) {
#pragma unroll
  for (int k = 2; k <= 16; k <<= 1)
#pragma unroll
    for (int j = k >> 1; j > 0; j >>= 1)
#pragma unroll
      for (int i = 0; i < 16; ++i) { const int l2 = i ^ j; if (l2 > i) { if ((i & k) == 0) CASD(v[i], v[l2]) else CASD(v[l2], v[i]) } }
}
__device__ __forceinline__ void merge_top16(int (&a)[16], const int (&b)[16]) {
#pragma unroll
  for (int i = 0; i < 16; ++i) a[i] = max(a[i], b[15 - i]);
#pragma unroll
  for (int j = 8; j > 0; j >>= 1)
#pragma unroll
    for (int i = 0; i < 16; ++i) { const int l2 = i ^ j; if (l2 > i) CASD(a[i], a[l2]) }
}
__device__ __forceinline__ int lut4(int w0, int w1, int w2, int w3, int i) {
  const int w = i >> 2; const int d = (w == 0) ? w0 : (w == 1) ? w1 : (w == 2) ? w2 : w3;
  return (d >> ((i & 3) * 8)) & 127;
}

__device__ __forceinline__ void phase_peer_topk(const Params& p, int l, int gw, int ngw, int lane) {
  const int n = lane & 31, hh = lane >> 5;
  const bf16_t* skl = p.skb() + (size_t)l * 16 * 128 * 64;
  for (int w = gw; w < (T / 32) * 8; w += ngw) {
    const int tg = w >> 3, h = w & 7, t = tg * 32 + n;
    int L0[16], L1[16];
#pragma unroll
    for (int c = 0; c < 2; ++c) {
      const int hc = 2 * h + c;
      bf16x8 qf[4];
#pragma unroll
      for (int s = 0; s < 4; ++s) qf[s] = *(const bf16x8*)(p.qb() + (size_t)t * D + hc * 64 + 16 * s + 8 * hh);
      int A[16], Bq[16];
#pragma unroll
      for (int mb = 0; mb < 4; ++mb) {
        f32x16 X;
#pragma unroll
        for (int r = 0; r < 16; ++r) X[r] = 0.f;
#pragma unroll
        for (int s = 0; s < 4; ++s) {
          const bf16x8 kf = *(const bf16x8*)(skl + ((size_t)(hc * 128 + mb * 32 + n)) * 64 + 16 * s + 8 * hh);
          X = __builtin_amdgcn_mfma_f32_32x32x16_bf16(kf, qf[s], X, 0, 0, 0);
        }
        int Gk[16];
#pragma unroll
        for (int r = 0; r < 16; ++r) Gk[r] = (f2key(X[r]) & ~127) | (mb * 32 + (r & 3) + 8 * (r >> 2) + 4 * hh);
        sort16_desc(Gk);
        if (mb == 0) {
#pragma unroll
          for (int r = 0; r < 16; ++r) A[r] = Gk[r];
        } else merge_top16(A, Gk);
      }
#pragma unroll
      for (int r = 0; r < 16; ++r) Bq[r] = __shfl_xor(A[r], 32);
      merge_top16(A, Bq);
#pragma unroll
      for (int r = 0; r < 16; ++r) { if (c == 0) L0[r] = A[r]; else L1[r] = A[r]; }
    }
    float av[16], bv[16];
#pragma unroll
    for (int r = 0; r < 16; ++r) { av[r] = key2f(L0[r] & ~127); bv[r] = key2f(L1[r] & ~127); }
#define CAND(i_, j_) ((f2key(av[i_] + bv[j_]) & ~255) | ((i_) << 4) | (j_))
    int R[16], G1[16], G2[16];
#pragma unroll
    for (int j = 0; j < 16; ++j) R[j] = CAND(0, j);
    G1[0] = CAND(1, 0); G1[1] = CAND(1, 1); G1[2] = CAND(1, 2); G1[3] = CAND(1, 3); G1[4] = CAND(1, 4); G1[5] = CAND(1, 5); G1[6] = CAND(1, 6); G1[7] = CAND(1, 7);
    G1[8] = CAND(2, 0); G1[9] = CAND(2, 1); G1[10] = CAND(2, 2); G1[11] = CAND(2, 3); G1[12] = CAND(2, 4); G1[13] = CAND(3, 0); G1[14] = CAND(3, 1); G1[15] = CAND(3, 2);
    G2[0] = CAND(3, 3); G2[1] = CAND(4, 0); G2[2] = CAND(4, 1); G2[3] = CAND(4, 2); G2[4] = CAND(5, 0); G2[5] = CAND(5, 1); G2[6] = CAND(6, 0); G2[7] = CAND(6, 1);
    G2[8] = CAND(7, 0); G2[9] = CAND(7, 1); G2[10] = CAND(8, 0); G2[11] = CAND(9, 0); G2[12] = CAND(10, 0); G2[13] = CAND(11, 0); G2[14] = CAND(12, 0); G2[15] = CAND(13, 0);
    sort16_desc(G1); merge_top16(R, G1);
    sort16_desc(G2); merge_top16(R, G2);
    { int x0 = CAND(14, 0), x1 = CAND(15, 0);
#pragma unroll
      for (int i = 0; i < 16; ++i) CASD(R[i], x0)
#pragma unroll
      for (int i = 0; i < 16; ++i) CASD(R[i], x1)
    }
#undef CAND
    int pa0 = 0, pa1 = 0, pa2 = 0, pa3 = 0, pb0 = 0, pb1 = 0, pb2 = 0, pb3 = 0;
#pragma unroll
    for (int q = 0; q < 4; ++q) {
      pa0 |= (L0[q] & 127) << (8 * q); pa1 |= (L0[4 + q] & 127) << (8 * q); pa2 |= (L0[8 + q] & 127) << (8 * q); pa3 |= (L0[12 + q] & 127) << (8 * q);
      pb0 |= (L1[q] & 127) << (8 * q); pb1 |= (L1[4 + q] & 127) << (8 * q); pb2 |= (L1[8 + q] & 127) << (8 * q); pb3 |= (L1[12 + q] & 127) << (8 * q);
    }
    float ev[16], sum = 0.f; int ei[16];
    const float mx = key2f(R[0] & ~255);
#pragma unroll
    for (int z = 0; z < 16; ++z) {
      const float v = key2f(R[z] & ~255);
      ev[z] = __expf(v - mx); sum += ev[z];
      const int pay = R[z] & 255;
      ei[z] = lut4(pa0, pa1, pa2, pa3, pay >> 4) * 128 + lut4(pb0, pb1, pb2, pb3, pay & 15);
    }
    const float inv = 1.0f / sum;
    if (hh == 0) {
      float* go = p.gates() + ((size_t)t * 8 + h) * 16; int* eo = p.eidx() + ((size_t)t * 8 + h) * 16;
#pragma unroll
      for (int z = 0; z < 16; z += 4) {
        *(float4*)(go + z) = make_float4(ev[z] * inv, ev[z + 1] * inv, ev[z + 2] * inv, ev[z + 3] * inv);
        *(int4*)(eo + z) = make_int4(ei[z], ei[z + 1], ei[z + 2], ei[z + 3]);
      }
    }
  }
}

__device__ __forceinline__ void phase_peer_apply2(const Params& p, int l, float* coef, int gw, int ngw, int lane) {
  const float* g2 = p.in[16] + l * D;
  for (int t = gw; t < T; t += ngw) {
    const float r = p.rstd()[t];
    float hv[16];
#pragma unroll
    for (int i = 0; i < 2; ++i) {
      const float* xp = p.out + (size_t)t * D + i * 512 + lane * 8; const float* gp = g2 + i * 512 + lane * 8;
      float4 x0 = *(const float4*)xp, x1 = *(const float4*)(xp + 4), g0 = *(const float4*)gp, g1 = *(const float4*)(gp + 4);
      hv[i * 8 + 0] = x0.x * r * g0.x; hv[i * 8 + 1] = x0.y * r * g0.y; hv[i * 8 + 2] = x0.z * r * g0.z; hv[i * 8 + 3] = x0.w * r * g0.w;
      hv[i * 8 + 4] = x1.x * r * g1.x; hv[i * 8 + 5] = x1.y * r * g1.y; hv[i * 8 + 6] = x1.z * r * g1.z; hv[i * 8 + 7] = x1.w * r * g1.w;
    }
    const int e_lo = p.eidx()[(size_t)t * 128 + lane], e_hi = p.eidx()[(size_t)t * 128 + 64 + lane];
    const float g_lo = p.gates()[(size_t)t * 128 + lane], g_hi = p.gates()[(size_t)t * 128 + 64 + lane];
    LDS_FENCE();
#pragma unroll 1
    for (int half = 0; half < 2; ++half) {
      const int ev = half ? e_hi : e_lo;
      float mine = 0.f;
#pragma unroll 4
      for (int j = 0; j < 64; ++j) {
        const int e = __shfl(ev, j);
        const bf16_t* up = p.Ub() + (size_t)e * D + lane * 8;
        uint4 u0 = *(const uint4*)up, u1 = *(const uint4*)(up + 512);
        float d = 0.f;
        d = fmaf(hv[0], __uint_as_float(u0.x << 16), d); d = fmaf(hv[1], __uint_as_float(u0.x & 0xffff0000u), d);
        d = fmaf(hv[2], __uint_as_float(u0.y << 16), d); d = fmaf(hv[3], __uint_as_float(u0.y & 0xffff0000u), d);
        d = fmaf(hv[4], __uint_as_float(u0.z << 16), d); d = fmaf(hv[5], __uint_as_float(u0.z & 0xffff0000u), d);
        d = fmaf(hv[6], __uint_as_float(u0.w << 16), d); d = fmaf(hv[7], __uint_as_float(u0.w & 0xffff0000u), d);
        d = fmaf(hv[8], __uint_as_float(u1.x << 16), d); d = fmaf(hv[9], __uint_as_float(u1.x & 0xffff0000u), d);
        d = fmaf(hv[10], __uint_as_float(u1.y << 16), d); d = fmaf(hv[11], __uint_as_float(u1.y & 0xffff0000u), d);
        d = fmaf(hv[12], __uint_as_float(u1.z << 16), d); d = fmaf(hv[13], __uint_as_float(u1.z & 0xffff0000u), d);
        d = fmaf(hv[14], __uint_as_float(u1.w << 16), d); d = fmaf(hv[15], __uint_as_float(u1.w & 0xffff0000u), d);
        d = wave_sum(d);
        if (lane == j) mine = d;
      }
      coef[half * 64 + lane] = (half ? g_hi : g_lo) * gelu_tanh(mine);
    }
    LDS_FENCE();
    float acc[16];
#pragma unroll
    for (int i = 0; i < 16; ++i) acc[i] = 0.f;
#pragma unroll 1
    for (int half = 0; half < 2; ++half) {
      const int ev = half ? e_hi : e_lo;
#pragma unroll 4
      for (int j = 0; j < 64; ++j) {
        const int e = __shfl(ev, j);
        const float c = coef[half * 64 + j];
        const bf16_t* vp = p.Vb() + (size_t)e * D + lane * 8;
        uint4 v0 = *(const uint4*)vp, v1 = *(const uint4*)(vp + 512);
        acc[0] = fmaf(c, __uint_as_float(v0.x << 16), acc[0]); acc[1] = fmaf(c, __uint_as_float(v0.x & 0xffff0000u), acc[1]);
        acc[2] = fmaf(c, __uint_as_float(v0.y << 16), acc[2]); acc[3] = fmaf(c, __uint_as_float(v0.y & 0xffff0000u), acc[3]);
        acc[4] = fmaf(c, __uint_as_float(v0.z << 16), acc[4]); acc[5] = fmaf(c, __uint_as_float(v0.z & 0xffff0000u), acc[5]);
        acc[6] = fmaf(c, __uint_as_float(v0.w << 16), acc[6]); acc[7] = fmaf(c, __uint_as_float(v0.w & 0xffff0000u), acc[7]);
        acc[8] = fmaf(c, __uint_as_float(v1.x << 16), acc[8]); acc[9] = fmaf(c, __uint_as_float(v1.x & 0xffff0000u), acc[9]);
        acc[10] = fmaf(c, __uint_as_float(v1.y << 16), acc[10]); acc[11] = fmaf(c, __uint_as_float(v1.y & 0xffff0000u), acc[11]);
        acc[12] = fmaf(c, __uint_as_float(v1.z << 16), acc[12]); acc[13] = fmaf(c, __uint_as_float(v1.z & 0xffff0000u), acc[13]);
        acc[14] = fmaf(c, __uint_as_float(v1.w << 16), acc[14]); acc[15] = fmaf(c, __uint_as_float(v1.w & 0xffff0000u), acc[15]);
      }
    }
#pragma unroll
    for (int i = 0; i < 2; ++i) {
      float* xp = p.out + (size_t)t * D + i * 512 + lane * 8;
      float4 x0 = *(float4*)xp, x1 = *(float4*)(xp + 4);
      x0.x += acc[i * 8 + 0]; x0.y += acc[i * 8 + 1]; x0.z += acc[i * 8 + 2]; x0.w += acc[i * 8 + 3];
      x1.x += acc[i * 8 + 4]; x1.y += acc[i * 8 + 5]; x1.z += acc[i * 8 + 6]; x1.w += acc[i * 8 + 7];
      *(float4*)xp = x0; *(float4*)(xp + 4) = x1;
    }
  }
}

typedef int v8i __attribute__((ext_vector_type(8)));
__device__ __forceinline__ unsigned xcc_id() { return (unsigned)__builtin_amdgcn_s_getreg((3 << 11) | 20) & 7u; }
__device__ __forceinline__ float pow2_scale(float amax) {
  if (!(amax > 0.f)) return 1.0f;
  const int e = (int)floorf(log2f(240.0f / amax));
  return exp2f((float)(e < 60 ? (e > -60 ? e : -60) : 60));
}
__device__ __forceinline__ unsigned pack4_fp8(float a, float b, float c, float d) {
  int v = __builtin_amdgcn_cvt_pk_fp8_f32(a, b, 0, false);
  v = __builtin_amdgcn_cvt_pk_fp8_f32(c, d, v, true);
  return (unsigned)v;
}
__device__ __forceinline__ void cvt_table_fp8(const float* __restrict__ src, unsigned char* __restrict__ dst, float* __restrict__ scl, int gw, int ngw, int lane) {
  for (int e = gw; e < 16384; e += ngw) {
    float4 v[4]; float am = 0.f;
#pragma unroll
    for (int k = 0; k < 4; ++k) { v[k] = *(const float4*)(src + (size_t)e * D + k * 256 + lane * 4);
      am = fmaxf(am, fmaxf(fmaxf(fabsf(v[k].x), fabsf(v[k].y)), fmaxf(fabsf(v[k].z), fabsf(v[k].w)))); }
    am = wave_max(am);
    const float s = pow2_scale(am);
    if (lane == 0) scl[e] = s;
#pragma unroll
    for (int k = 0; k < 4; ++k) {
      const int slice = 2 * k + (lane >> 5), off = (lane & 31) * 4;
      *(unsigned*)(dst + ((size_t)slice * 16384 + e) * 128 + off) = pack4_fp8(v[k].x * s, v[k].y * s, v[k].z * s, v[k].w * s);
    }
  }
}
__device__ __forceinline__ void phase_cvt_rows_h8(const Params& p, int l, int gw, int ngw, int lane) {
  const float* g2 = p.in[16] + l * D;
  for (int t = gw; t < T; t += ngw) {
    float4 v[4]; float ss = 0.f;
#pragma unroll
    for (int k = 0; k < 4; ++k) {
      v[k] = *(const float4*)(p.out + (size_t)t * D + k * 256 + lane * 4);
      ss += v[k].x * v[k].x + v[k].y * v[k].y + v[k].z * v[k].z + v[k].w * v[k].w;
      uint2 ph; ph.x = pk_bf16(v[k].x, v[k].y); ph.y = pk_bf16(v[k].z, v[k].w);
      bf16_t* d = p.xb() + (size_t)t * KD + k * 256 + lane * 4;
      *(uint2*)d = ph;
      if (PRECISE) {
        uint2 pl; pl.x = pk_bf16(v[k].x - __uint_as_float(ph.x << 16), v[k].y - __uint_as_float(ph.x & 0xffff0000u));
        pl.y = pk_bf16(v[k].z - __uint_as_float(ph.y << 16), v[k].w - __uint_as_float(ph.y & 0xffff0000u));
        *(uint2*)(d + D) = ph; *(uint2*)(d + 2 * D) = pl;
      }
    }
    ss = wave_sum(ss);
    const float r = rsqrtf(ss / (float)D + EPS);
    if (lane == 0) p.rstd()[t] = r;
    float am = 0.f;
#pragma unroll
    for (int k = 0; k < 4; ++k) {
      const float4 g = *(const float4*)(g2 + k * 256 + lane * 4);
      v[k].x *= r * g.x; v[k].y *= r * g.y; v[k].z *= r * g.z; v[k].w *= r * g.w;
      am = fmaxf(am, fmaxf(fmaxf(fabsf(v[k].x), fabsf(v[k].y)), fmaxf(fabsf(v[k].z), fabsf(v[k].w))));
    }
    am = wave_max(am);
    const float s = pow2_scale(am);
    if (lane == 0) p.sh()[t] = s;
#pragma unroll
    for (int k = 0; k < 4; ++k) {
      const int slice = 2 * k + (lane >> 5), off = (lane & 31) * 4;
      const float a0 = v[k].x * s, a1 = v[k].y * s, a2 = v[k].z * s, a3 = v[k].w * s;
      const unsigned hi = pack4_fp8(a0, a1, a2, a3);
      const auto f01 = __builtin_amdgcn_cvt_pk_f32_fp8((int)hi, false); const auto f23 = __builtin_amdgcn_cvt_pk_f32_fp8((int)hi, true);
      const unsigned lo = pack4_fp8((a0 - f01[0]) * 16.0f, (a1 - f01[1]) * 16.0f, (a2 - f23[0]) * 16.0f, (a3 - f23[1]) * 16.0f);
      *(unsigned*)(p.h8hi() + ((size_t)slice * T + t) * 128 + off) = hi;
      *(unsigned*)(p.h8lo() + ((size_t)slice * T + t) * 128 + off) = lo;
    }
  }
}
__device__ __forceinline__ int q_pull(int* head, int nitems, int* bc, int tid) {
  __syncthreads();
  if (tid == 0) bc[0] = atomicAdd(head, 1);
  __syncthreads();
  const int v = bc[0];
  return v < nitems ? v : -1;
}
__device__ __forceinline__ void phase_peer_u(const Params& p, int* heads, int* bc, int tid) {
  const int lane = tid & 63, wv = tid >> 6, i16 = lane & 15, kg = lane >> 4;
  const int myx = (int)xcc_id();
  for (int pass = 0; pass < 8; ++pass) {
    const int s = (myx + pass) & 7;
    const unsigned char* Us = p.U8s() + (size_t)s * 16384 * 128 + kg * 32;
    for (;;) {
      const int item = q_pull(heads + s, T / 64, bc, tid);
      if (item < 0) break;
#pragma unroll 1
      for (int k = 0; k < 8; ++k) {
        const int t = item * 64 + wv * 8 + k;
        const v8i bh = *(const v8i*)(p.h8hi() + ((size_t)s * T + t) * 128 + kg * 32);
        const v8i bl = *(const v8i*)(p.h8lo() + ((size_t)s * T + t) * 128 + kg * 32);
        int ev[8];
#pragma unroll
        for (int eb = 0; eb < 8; ++eb) ev[eb] = p.eidx()[(size_t)t * 128 + eb * 16 + i16];
        float* po = p.ppart() + ((size_t)s * T + t) * 128 + kg * 4;
#pragma unroll
        for (int eb = 0; eb < 8; ++eb) {
          const v8i a = *(const v8i*)(Us + (size_t)ev[eb] * 128);
          pg8::f32x4 ch = {0.f, 0.f, 0.f, 0.f}, cl = {0.f, 0.f, 0.f, 0.f};
          ch = __builtin_amdgcn_mfma_scale_f32_16x16x128_f8f6f4(a, bh, ch, 0, 0, 0, 127, 0, 127);
          cl = __builtin_amdgcn_mfma_scale_f32_16x16x128_f8f6f4(a, bl, cl, 0, 0, 0, 127, 0, 127);
          if (i16 == 0) *(pg8::f32x4*)(po + eb * 16) = ch + cl * 0.0625f;
        }
      }
    }
  }
}
__device__ __forceinline__ void phase_peer_r(const Params& p, int gtid, int ngt) {
  for (int idx = gtid; idx < T * 128; idx += ngt) {
    const int t = idx >> 7;
    float d = 0.f;
#pragma unroll
    for (int s = 0; s < 8; ++s) d += p.ppart()[(size_t)s * T * 128 + idx];
    const int e = p.eidx()[idx];
    d = d / (p.su()[e] * p.sh()[t]);
    p.gates()[idx] = p.gates()[idx] * gelu_tanh(d) / p.sv()[e];
  }
}
__device__ __forceinline__ void phase_peer_v(const Params& p, int* heads, int* bc, int tid) {
  const int lane = tid & 63, wv = tid >> 6, r8 = lane >> 3, c8 = lane & 7;
  const int myx = (int)xcc_id();
  for (int pass = 0; pass < 8; ++pass) {
    const int s = (myx + pass) & 7;
    const unsigned char* Vs = p.V8s() + (size_t)s * 16384 * 128 + c8 * 16;
    for (;;) {
      const int item = q_pull(heads + s, T / 64, bc, tid);
      if (item < 0) break;
#pragma unroll 1
      for (int k = 0; k < 8; ++k) {
        const int t = item * 64 + wv * 8 + k;
        float acc[16];
#pragma unroll
        for (int z = 0; z < 16; ++z) acc[z] = 0.f;
#pragma unroll 4
        for (int eb = 0; eb < 16; ++eb) {
          const int e = p.eidx()[(size_t)t * 128 + eb * 8 + r8];
          const float cf = p.gates()[(size_t)t * 128 + eb * 8 + r8];
          const uint4 w = *(const uint4*)(Vs + (size_t)e * 128);
          const unsigned ww[4] = {w.x, w.y, w.z, w.w};
#pragma unroll
          for (int q4 = 0; q4 < 4; ++q4) {
            const auto f01 = __builtin_amdgcn_cvt_pk_f32_fp8((int)ww[q4], false); const auto f23 = __builtin_amdgcn_cvt_pk_f32_fp8((int)ww[q4], true);
            acc[q4 * 4 + 0] = fmaf(cf, f01[0], acc[q4 * 4 + 0]); acc[q4 * 4 + 1] = fmaf(cf, f01[1], acc[q4 * 4 + 1]);
            acc[q4 * 4 + 2] = fmaf(cf, f23[0], acc[q4 * 4 + 2]); acc[q4 * 4 + 3] = fmaf(cf, f23[1], acc[q4 * 4 + 3]);
          }
        }
#pragma unroll
        for (int z = 0; z < 16; ++z) { acc[z] += __shfl_xor(acc[z], 8); acc[z] += __shfl_xor(acc[z], 16); acc[z] += __shfl_xor(acc[z], 32); }
        if (r8 == 0) {
          float* xp = p.out + (size_t)t * D + s * 128 + c8 * 16;
#pragma unroll
          for (int q4 = 0; q4 < 4; ++q4) {
            float4 xv = *(float4*)(xp + q4 * 4);
            xv.x += acc[q4 * 4 + 0]; xv.y += acc[q4 * 4 + 1]; xv.z += acc[q4 * 4 + 2]; xv.w += acc[q4 * 4 + 3];
            *(float4*)(xp + q4 * 4) = xv;
          }
        }
      }
    }
  }
}

#if PEER_CHECK
constexpr int CHK_N = 512;
__device__ __forceinline__ float* chk_x(const Params& p) { return (float*)(p.ws + WO_ybuf); }
__device__ __forceinline__ float* chk_m(const Params& p) { return (float*)(p.ws + WO_ybuf + (size_t)CHK_N * D * 4); }
__device__ __forceinline__ float* chk_g(const Params& p) { return (float*)(p.ws + WO_ybuf + (size_t)CHK_N * D * 4 + 4096); }
__device__ __forceinline__ void chk_save(const Params& p, int gtid, int ngt) {
  for (int i = gtid; i < CHK_N * D; i += ngt) chk_x(p)[i] = p.out[(size_t)(i / D) * 64 * D + (i % D)];
  for (int i = gtid; i < CHK_N * 128; i += ngt) chk_g(p)[i] = p.gates()[(size_t)(i / 128) * 64 * 128 + (i % 128)];
  if (gtid < 16) chk_m(p)[gtid] = 0.f;
}
__device__ __forceinline__ void chk_apply(const Params& p, int l, float* coef, int gw, int ngw, int lane) {
  const float* g2 = p.in[16] + l * D;
  const float* U = p.in[19] + (size_t)l * 16384 * D; const float* V = p.in[20] + (size_t)l * 16384 * D;
  for (int i = gw; i < CHK_N; i += ngw) {
    const int t = i * 64;
    const float r = p.rstd()[t];
    float4 hv[4];
#pragma unroll
    for (int k = 0; k < 4; ++k) {
      float4 xv = *(const float4*)(chk_x(p) + (size_t)i * D + (lane + k * 64) * 4);
      float4 gv = *(const float4*)(g2 + (lane + k * 64) * 4);
      hv[k].x = xv.x * r * gv.x; hv[k].y = xv.y * r * gv.y; hv[k].z = xv.z * r * gv.z; hv[k].w = xv.w * r * gv.w;
    }
    LDS_FENCE();
    for (int j = 0; j < 128; ++j) {
      const int e = p.eidx()[(size_t)t * 128 + j];
      const float4* up = (const float4*)(U + (size_t)e * D);
      float dsum = 0.f;
#pragma unroll
      for (int k = 0; k < 4; ++k) { float4 uv = up[lane + k * 64]; dsum += hv[k].x * uv.x + hv[k].y * uv.y + hv[k].z * uv.z + hv[k].w * uv.w; }
      dsum = wave_sum(dsum);
      if (lane == 0) coef[j] = chk_g(p)[(size_t)i * 128 + j] * gelu_tanh(dsum);
    }
    LDS_FENCE();
    float4 acc[4];
#pragma unroll
    for (int k = 0; k < 4; ++k) acc[k] = make_float4(0.f, 0.f, 0.f, 0.f);
    for (int j = 0; j < 128; ++j) {
      const int e = p.eidx()[(size_t)t * 128 + j];
      const float c = coef[j];
      const float4* vp = (const float4*)(V + (size_t)e * D);
#pragma unroll
      for (int k = 0; k < 4; ++k) { float4 vv = vp[lane + k * 64]; acc[k].x = fmaf(c, vv.x, acc[k].x); acc[k].y = fmaf(c, vv.y, acc[k].y); acc[k].z = fmaf(c, vv.z, acc[k].z); acc[k].w = fmaf(c, vv.w, acc[k].w); }
    }
    float d2 = 0.f, r2 = 0.f;
#pragma unroll
    for (int k = 0; k < 4; ++k) {
      float4 xa = *(const float4*)(p.out + (size_t)t * D + (lane + k * 64) * 4);
      float4 xb4 = *(const float4*)(chk_x(p) + (size_t)i * D + (lane + k * 64) * 4);
      float e0 = (xa.x - xb4.x) - acc[k].x, e1 = (xa.y - xb4.y) - acc[k].y, e2 = (xa.z - xb4.z) - acc[k].z, e3 = (xa.w - xb4.w) - acc[k].w;
      d2 += e0 * e0 + e1 * e1 + e2 * e2 + e3 * e3;
      r2 += acc[k].x * acc[k].x + acc[k].y * acc[k].y + acc[k].z * acc[k].z + acc[k].w * acc[k].w;
    }
    d2 = wave_sum(d2); r2 = wave_sum(r2);
    if (lane == 0) { atomicAdd((unsigned long long*)&chk_m(p)[8], (unsigned long long)(d2 * 1099511627776.0f)); atomicAdd((unsigned long long*)&chk_m(p)[10], (unsigned long long)(r2 * 1099511627776.0f)); }
  }
}
__device__ __forceinline__ void chk_topk(const Params& p, int l, int gtid, int ngt) {
  const float* subk = p.in[18] + (size_t)l * 16 * 128 * 64;
  for (int it = gtid; it < CHK_N * 8; it += ngt) {
    const int i = it >> 3, h = it & 7, t = i * 64;
    float tva[16], tvb[16]; int tia[16], tib[16];
#pragma unroll 1
    for (int c = 0; c < 2; ++c) {
      float tv[16]; int ti[16];
#pragma unroll
      for (int z = 0; z < 16; ++z) { tv[z] = -INFINITY; ti[z] = 0; }
      const bf16_t* q = p.qb() + (size_t)t * D + (2 * h + c) * 64;
      const float* kb = subk + (size_t)(2 * h + c) * 128 * 64;
#pragma unroll 1
      for (int n = 0; n < 128; ++n) {
        float sc = 0.f;
        for (int d = 0; d < 64; ++d) sc = fmaf(bf2f(q[d]), kb[n * 64 + d], sc);
        float v_ = sc; int i_ = n;
#pragma unroll
        for (int z = 0; z < 16; ++z) { bool gt = v_ > tv[z]; float a = tv[z]; int b = ti[z]; tv[z] = gt ? v_ : a; ti[z] = gt ? i_ : b; v_ = gt ? a : v_; i_ = gt ? b : i_; }
      }
#pragma unroll
      for (int z = 0; z < 16; ++z) { if (c == 0) { tva[z] = tv[z]; tia[z] = ti[z]; } else { tvb[z] = tv[z]; tib[z] = ti[z]; } }
    }
    float tv[16]; int ti[16];
#pragma unroll
    for (int z = 0; z < 16; ++z) { tv[z] = -INFINITY; ti[z] = 0; }
#pragma unroll 1
    for (int a = 0; a < 16; ++a)
#pragma unroll 1
      for (int b = 0; b < 16; ++b) {
        float av = 0.f, bv = 0.f; int ai = 0, bi = 0;
#pragma unroll
        for (int z = 0; z < 16; ++z) { if (z == a) { av = tva[z]; ai = tia[z]; } if (z == b) { bv = tvb[z]; bi = tib[z]; } }
        float v_ = av + bv; int i_ = ai * 128 + bi;
#pragma unroll
        for (int z = 0; z < 16; ++z) { bool gt = v_ > tv[z]; float x = tv[z]; int y = ti[z]; tv[z] = gt ? v_ : x; ti[z] = gt ? i_ : y; v_ = gt ? x : v_; i_ = gt ? y : i_; }
      }
    float sum = 0.f, ev[16];
#pragma unroll
    for (int z = 0; z < 16; ++z) { ev[z] = expf(tv[z] - tv[0]); sum += ev[z]; }
    int miss = 0; float gerr = 0.f;
    for (int z = 0; z < 16; ++z) {
      const int ef = p.eidx()[((size_t)t * 8 + h) * 16 + z]; const float gf = p.gates()[((size_t)t * 8 + h) * 16 + z];
      bool found = false;
#pragma unroll
      for (int y = 0; y < 16; ++y) if (ti[y] == ef) { found = true; gerr = fmaxf(gerr, fabsf(ev[y] / sum - gf)); }
      if (!found) ++miss;
    }
    atomicAdd(&chk_m(p)[3], (float)miss);
    atomicMax((int*)&chk_m(p)[4], __float_as_int(gerr));
  }
}
__device__ __forceinline__ void chk_emit(const Params& p) {
  float v = 0.f;
  if (PEER_CHECK == 1) v = sqrtf((float)((double)*(unsigned long long*)&chk_m(p)[8] / (double)*(unsigned long long*)&chk_m(p)[10]));
  if (PEER_CHECK == 2) v = chk_m(p)[3] / (float)(CHK_N * 8 * 16);
  if (PEER_CHECK == 3) v = chk_m(p)[4];
  p.out[0] += 1.0e4f * v + 100.0f;
}
#endif

__device__ __forceinline__ Params fresh(const Params& p) {
  Params q = p;
  asm volatile("" : "+s"(q.ws), "+s"(q.out));
#pragma unroll
  for (int i = 0; i < 21; ++i) asm volatile("" : "+s"(q.in[i]));
  return q;
}
#define PHASE_IDS int tid = threadIdx.x; asm volatile("" : "+v"(tid)); int bid = blockIdx.x; asm volatile("" : "+s"(bid)); int G = gridDim.x; asm volatile("" : "+s"(G)); \
  const int lane = tid & 63, wv = tid >> 6; const int ngt = G * NTHR, ngw = G * NWAVE; \
  const int gtid = bid * NTHR + tid, gw = bid * NWAVE + wv; (void)lane; (void)wv; (void)gtid; (void)gw; (void)ngt; (void)ngw; \
  const Params q = fresh(p);
__global__ void __launch_bounds__(NTHR) mega(Params p) {
  extern __shared__ __attribute__((aligned(16))) unsigned char lds_raw[];
  cg::grid_group grid = cg::this_grid();
  float* ldsf = (float*)lds_raw;

  { PHASE_IDS; phase_prologue(q, gtid, ngt, gw, ngw, lane); cvt_f32_bf16(q.in[18], q.skb(), (size_t)NL * 16 * 128 * 64 / 8, gtid, ngt);
    for (size_t i = gtid; i < (size_t)16 * 256 * 512 / 8; i += ngt) ((uint4*)q.S5Wz())[i] = make_uint4(0u, 0u, 0u, 0u);
    if (gtid < 256) q.qctr()[gtid] = 0; }
  grid.sync();
  { constexpr int l = 0;
    DUP(6) {
    { PHASE_IDS; phase_cvt_rows(q.out, q.xb(), q.rstd(), gw, ngw, lane);
      phase_s5_prep(q, l, gtid, ngt);
 }
    grid.sync();
    }
    DUP(5) {
    { const Params q = fresh(p); EpiScaleStore e{q.proj(), INW, q.rstd()};
      run_gemm(lds_raw, q.xb(), q.Win_t() + (size_t)l * INW * KD, T, INW, KD, e); }
    grid.sync();
    }
    { PHASE_IDS; phase_postproj(q, l, gw, ngw, lane); }
    grid.sync();
    DUP(0) {
    { PHASE_IDS; phase_kmean(q, gtid, ngt); phase_pack_moba(q, gtid, ngt); phase_pack_u(q, gtid, ngt); phase_pack_ret(q, gtid, ngt); }
    grid.sync();
    }
    DUP(1) {
    { const Params q = fresh(p); EpiS5Z e{q.S5Z()};
      pg8::Gemm g{q.S5A(), q.S5Wz(), 16 * 1024, 16 * 256, 512, 640, 512}; pg8::GroupOrder So; So.init(16, 4, 1, (int)gridDim.x, (int)blockIdx.x);
      pg8::gemm_phase<EpiS5Z, pg8::GroupOrder, true, true>((PG8_LAS unsigned char*)lds_raw, g, So, e); }
    __syncthreads();
    { PHASE_IDS; phase_moba2(q, l, lds_raw, bid, G); }
    { PHASE_IDS; phase_ret_kv(q, gw, ngw, lane); }
    grid.sync();
    }
    DUP(2) {
    { PHASE_IDS; phase_s5_scan(q, gtid, ngt); phase_ret_scan(q, gtid, ngt); }
    grid.sync();
    }
    DUP(3) {
    { const Params q = fresh(p); EpiS5Y e{q.ygb(), q.S5A(), q.in[10] + l * 256};
      pg8::Gemm g{q.S5A(), q.S5Wy(), 16 * 1024, 16 * 512, 640, 640, 640}; pg8::GroupOrder So; So.init(16, 4, 2, (int)gridDim.x, (int)blockIdx.x);
      pg8::gemm_phase<EpiS5Y, pg8::GroupOrder, true, true>((PG8_LAS unsigned char*)lds_raw, g, So, e); }
    __syncthreads();
    { PHASE_IDS; phase_ret_out(q, gw, ngw, lane); }
    grid.sync();
    }
    DUP(4) {
    { const Params q = fresh(p); EpiGlu e{q.ybuf(), q.ygb(), (float*)(lds_raw + 131072)};
      run_gemm(lds_raw, q.ygb(), q.Wglu_t() + (size_t)l * 65536, T, 256, 256, e); }
    grid.sync();
    }
    DUP(9) {
    { PHASE_IDS; phase_cvt_rows(q.ybuf(), q.xb(), nullptr, gw, ngw, lane); }
    grid.sync();
    }
    { const Params q = fresh(p); EpiAccum e{q.out, D};
      run_gemm(lds_raw, q.xb(), q.Wout_t() + (size_t)l * D * KD, T, D, KD, e); }
    grid.sync();
    { PHASE_IDS; phase_cvt_rows_h8(q, l, gw, ngw, lane);
      cvt_table_fp8(q.in[19] + (size_t)l * 16384 * D, q.U8s(), q.su(), gw, ngw, lane);
      cvt_table_fp8(q.in[20] + (size_t)l * 16384 * D, q.V8s(), q.sv(), gw, ngw, lane); }
    grid.sync();
    DUP(7) {
    { const Params q = fresh(p); EpiScaleStoreBf16 e{q.qb(), D, q.rstd()};
      run_gemm(lds_raw, q.xb(), q.Wq_t() + (size_t)l * D * KD, T, D, KD, e); }
    grid.sync();
    }
    if (!(PROBE_SKIP & 2)) {
    { PHASE_IDS; phase_peer_topk(q, l, gw, ngw, lane); }
    grid.sync();
    }
#if PEER_CHECK
    if (l == 0) { { PHASE_IDS; chk_save(q, gtid, ngt); } grid.sync(); { PHASE_IDS; chk_topk(q, l, gtid, ngt); } grid.sync(); }
#endif
    if (!(PROBE_SKIP & 1)) {
    { PHASE_IDS; phase_peer_u(q, q.qctr() + (l * 2 + 0) * 8, (int*)lds_raw, tid); }
    grid.sync();
    { PHASE_IDS; phase_peer_r(q, gtid, ngt); }
    grid.sync();
    { PHASE_IDS; phase_peer_v(q, q.qctr() + (l * 2 + 1) * 8, (int*)lds_raw, tid); }
    grid.sync();
    }
#if PEER_CHECK
    if (l == 0) { { PHASE_IDS; chk_apply(q, l, ldsf + wv * 128, gw, ngw, lane); } grid.sync();
      if (blockIdx.x == 0 && threadIdx.x == 0) { const Params q = fresh(p); chk_emit(q); } grid.sync(); }
#endif
  }
  { constexpr int l = 1;
    DUP(6) {
    { PHASE_IDS; phase_cvt_rows(q.out, q.xb(), q.rstd(), gw, ngw, lane);
      phase_s5_prep(q, l, gtid, ngt);
 }
    grid.sync();
    }
    DUP(5) {
    { const Params q = fresh(p); EpiScaleStore e{q.proj(), INW, q.rstd()};
      run_gemm(lds_raw, q.xb(), q.Win_t() + (size_t)l * INW * KD, T, INW, KD, e); }
    grid.sync();
    }
    { PHASE_IDS; phase_postproj(q, l, gw, ngw, lane); }
    grid.sync();
    DUP(0) {
    { PHASE_IDS; phase_kmean(q, gtid, ngt); phase_pack_moba(q, gtid, ngt); phase_pack_u(q, gtid, ngt); phase_pack_ret(q, gtid, ngt); }
    grid.sync();
    }
    DUP(1) {
    { const Params q = fresh(p); EpiS5Z e{q.S5Z()};
      pg8::Gemm g{q.S5A(), q.S5Wz(), 16 * 1024, 16 * 256, 512, 640, 512}; pg8::GroupOrder So; So.init(16, 4, 1, (int)gridDim.x, (int)blockIdx.x);
      pg8::gemm_phase<EpiS5Z, pg8::GroupOrder, true, true>((PG8_LAS unsigned char*)lds_raw, g, So, e); }
    __syncthreads();
    { PHASE_IDS; phase_moba2(q, l, lds_raw, bid, G); }
    { PHASE_IDS; phase_ret_kv(q, gw, ngw, lane); }
    grid.sync();
    }
    DUP(2) {
    { PHASE_IDS; phase_s5_scan(q, gtid, ngt); phase_ret_scan(q, gtid, ngt); }
    grid.sync();
    }
    DUP(3) {
    { const Params q = fresh(p); EpiS5Y e{q.ygb(), q.S5A(), q.in[10] + l * 256};
      pg8::Gemm g{q.S5A(), q.S5Wy(), 16 * 1024, 16 * 512, 640, 640, 640}; pg8::GroupOrder So; So.init(16, 4, 2, (int)gridDim.x, (int)blockIdx.x);
      pg8::gemm_phase<EpiS5Y, pg8::GroupOrder, true, true>((PG8_LAS unsigned char*)lds_raw, g, So, e); }
    __syncthreads();
    { PHASE_IDS; phase_ret_out(q, gw, ngw, lane); }
    grid.sync();
    }
    DUP(4) {
    { const Params q = fresh(p); EpiGlu e{q.ybuf(), q.ygb(), (float*)(lds_raw + 131072)};
      run_gemm(lds_raw, q.ygb(), q.Wglu_t() + (size_t)l * 65536, T, 256, 256, e); }
    grid.sync();
    }
    DUP(9) {
    { PHASE_IDS; phase_cvt_rows(q.ybuf(), q.xb(), nullptr, gw, ngw, lane); }
    grid.sync();
    }
    { const Params q = fresh(p); EpiAccum e{q.out, D};
      run_gemm(lds_raw, q.xb(), q.Wout_t() + (size_t)l * D * KD, T, D, KD, e); }
    grid.sync();
    { PHASE_IDS; phase_cvt_rows_h8(q, l, gw, ngw, lane);
      cvt_table_fp8(q.in[19] + (size_t)l * 16384 * D, q.U8s(), q.su(), gw, ngw, lane);
      cvt_table_fp8(q.in[20] + (size_t)l * 16384 * D, q.V8s(), q.sv(), gw, ngw, lane); }
    grid.sync();
    DUP(7) {
    { const Params q = fresh(p); EpiScaleStoreBf16 e{q.qb(), D, q.rstd()};
      run_gemm(lds_raw, q.xb(), q.Wq_t() + (size_t)l * D * KD, T, D, KD, e); }
    grid.sync();
    }
    if (!(PROBE_SKIP & 2)) {
    { PHASE_IDS; phase_peer_topk(q, l, gw, ngw, lane); }
    grid.sync();
    }
#if PEER_CHECK
    if (l == 0) { { PHASE_IDS; chk_save(q, gtid, ngt); } grid.sync(); { PHASE_IDS; chk_topk(q, l, gtid, ngt); } grid.sync(); }
#endif
    if (!(PROBE_SKIP & 1)) {
    { PHASE_IDS; phase_peer_u(q, q.qctr() + (l * 2 + 0) * 8, (int*)lds_raw, tid); }
    grid.sync();
    { PHASE_IDS; phase_peer_r(q, gtid, ngt); }
    grid.sync();
    { PHASE_IDS; phase_peer_v(q, q.qctr() + (l * 2 + 1) * 8, (int*)lds_raw, tid); }
    grid.sync();
    }
#if PEER_CHECK
    if (l == 0) { { PHASE_IDS; chk_apply(q, l, ldsf + wv * 128, gw, ngw, lane); } grid.sync();
      if (blockIdx.x == 0 && threadIdx.x == 0) { const Params q = fresh(p); chk_emit(q); } grid.sync(); }
#endif
  }
  { constexpr int l = 2;
    DUP(6) {
    { PHASE_IDS; phase_cvt_rows(q.out, q.xb(), q.rstd(), gw, ngw, lane);
      phase_s5_prep(q, l, gtid, ngt);
 }
    grid.sync();
    }
    DUP(5) {
    { const Params q = fresh(p); EpiScaleStore e{q.proj(), INW, q.rstd()};
      run_gemm(lds_raw, q.xb(), q.Win_t() + (size_t)l * INW * KD, T, INW, KD, e); }
    grid.sync();
    }
    { PHASE_IDS; phase_postproj(q, l, gw, ngw, lane); }
    grid.sync();
    DUP(0) {
    { PHASE_IDS; phase_kmean(q, gtid, ngt); phase_pack_moba(q, gtid, ngt); phase_pack_u(q, gtid, ngt); phase_pack_ret(q, gtid, ngt); }
    grid.sync();
    }
    DUP(1) {
    { const Params q = fresh(p); EpiS5Z e{q.S5Z()};
      pg8::Gemm g{q.S5A(), q.S5Wz(), 16 * 1024, 16 * 256, 512, 640, 512}; pg8::GroupOrder So; So.init(16, 4, 1, (int)gridDim.x, (int)blockIdx.x);
      pg8::gemm_phase<EpiS5Z, pg8::GroupOrder, true, true>((PG8_LAS unsigned char*)lds_raw, g, So, e); }
    __syncthreads();
    { PHASE_IDS; phase_moba2(q, l, lds_raw, bid, G); }
    { PHASE_IDS; phase_ret_kv(q, gw, ngw, lane); }
    grid.sync();
    }
    DUP(2) {
    { PHASE_IDS; phase_s5_scan(q, gtid, ngt); phase_ret_scan(q, gtid, ngt); }
    grid.sync();
    }
    DUP(3) {
    { const Params q = fresh(p); EpiS5Y e{q.ygb(), q.S5A(), q.in[10] + l * 256};
      pg8::Gemm g{q.S5A(), q.S5Wy(), 16 * 1024, 16 * 512, 640, 640, 640}; pg8::GroupOrder So; So.init(16, 4, 2, (int)gridDim.x, (int)blockIdx.x);
      pg8::gemm_phase<EpiS5Y, pg8::GroupOrder, true, true>((PG8_LAS unsigned char*)lds_raw, g, So, e); }
    __syncthreads();
    { PHASE_IDS; phase_ret_out(q, gw, ngw, lane); }
    grid.sync();
    }
    DUP(4) {
    { const Params q = fresh(p); EpiGlu e{q.ybuf(), q.ygb(), (float*)(lds_raw + 131072)};
      run_gemm(lds_raw, q.ygb(), q.Wglu_t() + (size_t)l * 65536, T, 256, 256, e); }
    grid.sync();
    }
    DUP(9) {
    { PHASE_IDS; phase_cvt_rows(q.ybuf(), q.xb(), nullptr, gw, ngw, lane); }
    grid.sync();
    }
    { const Params q = fresh(p); EpiAccum e{q.out, D};
      run_gemm(lds_raw, q.xb(), q.Wout_t() + (size_t)l * D * KD, T, D, KD, e); }
    grid.sync();
    { PHASE_IDS; phase_cvt_rows_h8(q, l, gw, ngw, lane);
      cvt_table_fp8(q.in[19] + (size_t)l * 16384 * D, q.U8s(), q.su(), gw, ngw, lane);
      cvt_table_fp8(q.in[20] + (size_t)l * 16384 * D, q.V8s(), q.sv(), gw, ngw, lane); }
    grid.sync();
    DUP(7) {
    { const Params q = fresh(p); EpiScaleStoreBf16 e{q.qb(), D, q.rstd()};
      run_gemm(lds_raw, q.xb(), q.Wq_t() + (size_t)l * D * KD, T, D, KD, e); }
    grid.sync();
    }
    if (!(PROBE_SKIP & 2)) {
    { PHASE_IDS; phase_peer_topk(q, l, gw, ngw, lane); }
    grid.sync();
    }
#if PEER_CHECK
    if (l == 0) { { PHASE_IDS; chk_save(q, gtid, ngt); } grid.sync(); { PHASE_IDS; chk_topk(q, l, gtid, ngt); } grid.sync(); }
#endif
    if (!(PROBE_SKIP & 1)) {
    { PHASE_IDS; phase_peer_u(q, q.qctr() + (l * 2 + 0) * 8, (int*)lds_raw, tid); }
    grid.sync();
    { PHASE_IDS; phase_peer_r(q, gtid, ngt); }
    grid.sync();
    { PHASE_IDS; phase_peer_v(q, q.qctr() + (l * 2 + 1) * 8, (int*)lds_raw, tid); }
    grid.sync();
    }
#if PEER_CHECK
    if (l == 0) { { PHASE_IDS; chk_apply(q, l, ldsf + wv * 128, gw, ngw, lane); } grid.sync();
      if (blockIdx.x == 0 && threadIdx.x == 0) { const Params q = fresh(p); chk_emit(q); } grid.sync(); }
#endif
  }
  { constexpr int l = 3;
    DUP(6) {
    { PHASE_IDS; phase_cvt_rows(q.out, q.xb(), q.rstd(), gw, ngw, lane);
      phase_s5_prep(q, l, gtid, ngt);
 }
    grid.sync();
    }
    DUP(5) {
    { const Params q = fresh(p); EpiScaleStore e{q.proj(), INW, q.rstd()};
      run_gemm(lds_raw, q.xb(), q.Win_t() + (size_t)l * INW * KD, T, INW, KD, e); }
    grid.sync();
    }
    { PHASE_IDS; phase_postproj(q, l, gw, ngw, lane); }
    grid.sync();
    DUP(0) {
    { PHASE_IDS; phase_kmean(q, gtid, ngt); phase_pack_moba(q, gtid, ngt); phase_pack_u(q, gtid, ngt); phase_pack_ret(q, gtid, ngt); }
    grid.sync();
    }
    DUP(1) {
    { const Params q = fresh(p); EpiS5Z e{q.S5Z()};
      pg8::Gemm g{q.S5A(), q.S5Wz(), 16 * 1024, 16 * 256, 512, 640, 512}; pg8::GroupOrder So; So.init(16, 4, 1, (int)gridDim.x, (int)blockIdx.x);
      pg8::gemm_phase<EpiS5Z, pg8::GroupOrder, true, true>((PG8_LAS unsigned char*)lds_raw, g, So, e); }
    __syncthreads();
    { PHASE_IDS; phase_moba2(q, l, lds_raw, bid, G); }
    { PHASE_IDS; phase_ret_kv(q, gw, ngw, lane); }
    grid.sync();
    }
    DUP(2) {
    { PHASE_IDS; phase_s5_scan(q, gtid, ngt); phase_ret_scan(q, gtid, ngt); }
    grid.sync();
    }
    DUP(3) {
    { const Params q = fresh(p); EpiS5Y e{q.ygb(), q.S5A(), q.in[10] + l * 256};
      pg8::Gemm g{q.S5A(), q.S5Wy(), 16 * 1024, 16 * 512, 640, 640, 640}; pg8::GroupOrder So; So.init(16, 4, 2, (int)gridDim.x, (int)blockIdx.x);
      pg8::gemm_phase<EpiS5Y, pg8::GroupOrder, true, true>((PG8_LAS unsigned char*)lds_raw, g, So, e); }
    __syncthreads();
    { PHASE_IDS; phase_ret_out(q, gw, ngw, lane); }
    grid.sync();
    }
    DUP(4) {
    { const Params q = fresh(p); EpiGlu e{q.ybuf(), q.ygb(), (float*)(lds_raw + 131072)};
      run_gemm(lds_raw, q.ygb(), q.Wglu_t() + (size_t)l * 65536, T, 256, 256, e); }
    grid.sync();
    }
    DUP(9) {
    { PHASE_IDS; phase_cvt_rows(q.ybuf(), q.xb(), nullptr, gw, ngw, lane); }
    grid.sync();
    }
    { const Params q = fresh(p); EpiAccum e{q.out, D};
      run_gemm(lds_raw, q.xb(), q.Wout_t() + (size_t)l * D * KD, T, D, KD, e); }
    grid.sync();
    { PHASE_IDS; phase_cvt_rows_h8(q, l, gw, ngw, lane);
      cvt_table_fp8(q.in[19] + (size_t)l * 16384 * D, q.U8s(), q.su(), gw, ngw, lane);
      cvt_table_fp8(q.in[20] + (size_t)l * 16384 * D, q.V8s(), q.sv(), gw, ngw, lane); }
    grid.sync();
    DUP(7) {
    { const Params q = fresh(p); EpiScaleStoreBf16 e{q.qb(), D, q.rstd()};
      run_gemm(lds_raw, q.xb(), q.Wq_t() + (size_t)l * D * KD, T, D, KD, e); }
    grid.sync();
    }
    if (!(PROBE_SKIP & 2)) {
    { PHASE_IDS; phase_peer_topk(q, l, gw, ngw, lane); }
    grid.sync();
    }
#if PEER_CHECK
    if (l == 0) { { PHASE_IDS; chk_save(q, gtid, ngt); } grid.sync(); { PHASE_IDS; chk_topk(q, l, gtid, ngt); } grid.sync(); }
#endif
    if (!(PROBE_SKIP & 1)) {
    { PHASE_IDS; phase_peer_u(q, q.qctr() + (l * 2 + 0) * 8, (int*)lds_raw, tid); }
    grid.sync();
    { PHASE_IDS; phase_peer_r(q, gtid, ngt); }
    grid.sync();
    { PHASE_IDS; phase_peer_v(q, q.qctr() + (l * 2 + 1) * 8, (int*)lds_raw, tid); }
    grid.sync();
    }
#if PEER_CHECK
    if (l == 0) { { PHASE_IDS; chk_apply(q, l, ldsf + wv * 128, gw, ngw, lane); } grid.sync();
      if (blockIdx.x == 0 && threadIdx.x == 0) { const Params q = fresh(p); chk_emit(q); } grid.sync(); }
#endif
  }
}

}

extern "C" void kernel_launch(void* const* d_in, const int* in_sizes, int n_in, void* d_out, int out_size, void* d_ws, size_t ws_size,
                              hipStream_t stream) {
  static int grid_blocks = 0;
  if (!grid_blocks) {
    int dev = 0, cus = 0, per_cu = 0;
    hipGetDevice(&dev);
    hipDeviceGetAttribute(&cus, hipDeviceAttributeMultiprocessorCount, dev);
    hipFuncSetAttribute((const void*)mega, hipFuncAttributeMaxDynamicSharedMemorySize, LDS_BYTES);
    hipOccupancyMaxActiveBlocksPerMultiprocessor(&per_cu, (const void*)mega, NTHR, LDS_BYTES);
    if (per_cu < 1) { fprintf(stderr, "occupancy query returned %d\n", per_cu); per_cu = 1; }
    grid_blocks = cus * 1;
    if (grid_blocks < 64) fprintf(stderr, "unexpected CU count %d\n", cus);
  }
  Params p{};
  for (int i = 0; i < 21; ++i) p.in[i] = (const float*)d_in[i];
  p.out = (float*)d_out;
  p.ws = (unsigned char*)d_ws;
  if (WS_TOTAL > ws_size) { fprintf(stderr, "workspace too small: need %zu have %zu\n", (size_t)WS_TOTAL, ws_size); return; }
  void* args[] = {&p};
  hipError_t e = hipLaunchCooperativeKernel((const void*)mega, dim3(grid_blocks), dim3(NTHR), args, LDS_BYTES, stream);
  if (e != hipSuccess) fprintf(stderr, "cooperative launch failed: %s (grid %d)\n", hipGetErrorString(e), grid_blocks);
}
```

```cpp
#include <hip/hip_runtime.h>
#include <hip/hip_cooperative_groups.h>
#include <math.h>
#include <stdint.h>
#include <stdio.h>
namespace cg = cooperative_groups;

#ifndef PEER_CHECK
#define PEER_CHECK 0
#endif
#ifndef PROBE_DUP
#define PROBE_DUP 0
#endif
#define DUP(bit) for (int rep_ = 0; rep_ < ((PROBE_DUP >> (bit)) & 1) + 1; ++rep_)
#ifndef PROBE_SKIP
#define PROBE_SKIP 0
#endif
#ifndef PRECISE
#define PRECISE 0
#endif

namespace {
constexpr int NB = 8, S = 4096, D = 1024, NL = 4, T = NB * S;
constexpr int INW = 2816;
constexpr int OFF_U = 0, OFF_QM = 256, OFF_KM = 768, OFF_VM = 1280, OFF_QR = 1792, OFF_KR = 2048, OFF_VR = 2304, OFF_GR = 2560;
constexpr float EPS = 1e-6f;
constexpr int KS = PRECISE ? 3 : 1;
constexpr int KD = D * KS;
constexpr int NTHR = 512, NWAVE = 8;
constexpr int LDS_BYTES = 131072 + 4096 + 1024;

typedef unsigned short bf16_t;
using bf16x8 = __attribute__((ext_vector_type(8))) short;
using f32x4 = __attribute__((ext_vector_type(4))) float;

__device__ __forceinline__ float wave_sum(float v) {
#pragma unroll
  for (int o = 32; o > 0; o >>= 1) v += __shfl_xor(v, o);
  return v;
}
__device__ __forceinline__ float wave_max(float v) {
#pragma unroll
  for (int o = 32; o > 0; o >>= 1) v = fmaxf(v, __shfl_xor(v, o));
  return v;
}
__device__ __forceinline__ float gelu_tanh(float x) {
  const float k0 = 0.7978845608028654f, k1 = 0.044715f;
  float u = k0 * (x + k1 * x * x * x);
  return 0.5f * x * (1.0f + tanhf(u));
}
__device__ __forceinline__ float sigmoidf_(float x) { return 1.0f / (1.0f + expf(-x)); }
__device__ __forceinline__ float fast_sigmoid(float x) { return __builtin_amdgcn_rcpf(1.0f + __builtin_amdgcn_exp2f(-1.4426950408889634f * x)); }
__device__ __forceinline__ float fast_gelu(float x) { const float u = 0.7978845608028654f * (x + 0.044715f * x * x * x); return x * fast_sigmoid(2.0f * u); }
__device__ __forceinline__ bf16_t f2bf(float f) {
  unsigned u = __float_as_uint(f);
  u += 0x7fffu + ((u >> 16) & 1u);
  return (bf16_t)(u >> 16);
}
__device__ __forceinline__ float bf2f(bf16_t h) { return __uint_as_float(((unsigned)h) << 16); }
#define LDS_FENCE() asm volatile("s_waitcnt lgkmcnt(0)" ::: "memory")
typedef __bf16 bf16x2_hw __attribute__((ext_vector_type(2)));
typedef float f32x2_hw __attribute__((ext_vector_type(2)));
__device__ __forceinline__ unsigned pk_bf16(float lo, float hi) { const f32x2_hw f = {lo, hi}; const bf16x2_hw b = __builtin_convertvector(f, bf16x2_hw); return __builtin_bit_cast(unsigned, b); }
typedef float f32x16 __attribute__((ext_vector_type(16)));

constexpr size_t al256(size_t x) { return (x + 255) & ~(size_t)255; }
constexpr size_t WO_rstd = 0;
constexpr size_t WO_cosm = WO_rstd + al256((size_t)T * 4);
constexpr size_t WO_sinm = WO_cosm + al256((size_t)S * 8 * 4);
constexpr size_t WO_cosr = WO_sinm + al256((size_t)S * 8 * 4);
constexpr size_t WO_sinr = WO_cosr + al256((size_t)S * 32 * 4);
constexpr size_t WO_kmean = WO_sinr + al256((size_t)S * 32 * 4);
constexpr size_t WO_proj = WO_kmean + al256((size_t)NB * 8 * 16 * 64 * 4);
constexpr size_t WO_ybuf = WO_proj + al256((size_t)T * INW * 4);
constexpr size_t WO_yg = WO_ybuf + al256((size_t)T * D * 4);
constexpr size_t WO_skb = WO_yg + al256((size_t)T * 256 * 4);
constexpr size_t WO_Ub = WO_skb + al256((size_t)NL * 16 * 128 * 64 * 2);
constexpr size_t WO_Vb = WO_Ub + al256((size_t)16384 * D * 2);
constexpr size_t WO_gates = WO_Vb + al256((size_t)16384 * D * 2);
constexpr size_t WO_eidx = WO_gates + al256((size_t)T * 128 * 4);
constexpr size_t WO_xb = WO_eidx + al256((size_t)T * 128 * 4);
constexpr size_t WO_Win_t = WO_xb + al256((size_t)T * KD * 2);
constexpr size_t WO_Wout_t = WO_Win_t + al256((size_t)NL * INW * KD * 2);
constexpr size_t WO_Wq_t = WO_Wout_t + al256((size_t)NL * D * KD * 2);
constexpr size_t WO_Qm = WO_Wq_t + al256((size_t)NL * D * KD * 2);
constexpr size_t WO_Km = WO_Qm + al256((size_t)T * 512 * 2);
constexpr size_t WO_Vm = WO_Km + al256((size_t)T * 512 * 2);
constexpr size_t WO_S5a32 = WO_Vm + al256((size_t)T * 512 * 2);
constexpr size_t WO_Wglu_t = WO_S5a32 + al256((size_t)16 * 64 * 2 * 4);
constexpr size_t WO_Qr = WO_Wglu_t + al256((size_t)NL * 256 * 256 * 2);
constexpr size_t WO_Kr = WO_Qr + al256((size_t)T * 256 * 2);
constexpr size_t WO_Krv = WO_Kr + al256((size_t)T * 256 * 2);
constexpr size_t WO_Vr = WO_Krv + al256((size_t)T * 256 * 2);
constexpr size_t WO_KVr = WO_Vr + al256((size_t)T * 256 * 2);
constexpr size_t WO_Rb = WO_KVr + al256((size_t)32 * 32 * 4096 * 4);
constexpr size_t WO_qctr = WO_Rb + al256((size_t)32 * 32 * 4096 * 2);
constexpr size_t WO_bar = WO_qctr + al256(1024);
constexpr size_t WS_TOTAL = WO_bar + al256(16384);
constexpr size_t WO_S5A = WO_gates;
constexpr size_t WO_S5Z = WO_S5A + al256((size_t)16 * 1024 * 640 * 2);
static_assert(WO_S5Z + (size_t)16 * 1024 * 128 * 4 <= WO_gates + 2 * al256((size_t)T * 128 * 4), "S5A/S5Z must fit in gates+eidx");
constexpr size_t WO_S5Wy = WO_Ub;
constexpr size_t WO_S5Wz = WO_S5Wy + al256((size_t)16 * 512 * 640 * 2);
static_assert(WO_S5Wz + (size_t)16 * 256 * 512 * 2 <= WO_Ub + 2 * al256((size_t)16384 * D * 2), "S5 weights must fit in Ub/Vb");
struct Params {
  const float* in[21];
  float* out;
  unsigned char* ws;
  __device__ __forceinline__ float* rstd() const { return (float*)(ws + WO_rstd); }
  __device__ __forceinline__ float* cosm() const { return (float*)(ws + WO_cosm); }
  __device__ __forceinline__ float* sinm() const { return (float*)(ws + WO_sinm); }
  __device__ __forceinline__ float* cosr() const { return (float*)(ws + WO_cosr); }
  __device__ __forceinline__ float* sinr() const { return (float*)(ws + WO_sinr); }
  __device__ __forceinline__ float* kmean() const { return (float*)(ws + WO_kmean); }
  __device__ __forceinline__ float* proj() const { return (float*)(ws + WO_proj); }
  __device__ __forceinline__ float* ybuf() const { return (float*)(ws + WO_ybuf); }
  __device__ __forceinline__ float* yg() const { return (float*)(ws + WO_yg); }
  __device__ __forceinline__ bf16_t* skb() const { return (bf16_t*)(ws + WO_skb); }
  __device__ __forceinline__ bf16_t* Ub() const { return (bf16_t*)(ws + WO_Ub); }
  __device__ __forceinline__ bf16_t* Vb() const { return (bf16_t*)(ws + WO_Vb); }
  __device__ __forceinline__ float* gates() const { return (float*)(ws + WO_gates); }
  __device__ __forceinline__ int* eidx() const { return (int*)(ws + WO_eidx); }
  __device__ __forceinline__ bf16_t* xb() const { return (bf16_t*)(ws + WO_xb); }
  __device__ __forceinline__ bf16_t* Win_t() const { return (bf16_t*)(ws + WO_Win_t); }
  __device__ __forceinline__ bf16_t* Wout_t() const { return (bf16_t*)(ws + WO_Wout_t); }
  __device__ __forceinline__ bf16_t* Wq_t() const { return (bf16_t*)(ws + WO_Wq_t); }
  __device__ __forceinline__ bf16_t* Qm() const { return (bf16_t*)(ws + WO_Qm); }
  __device__ __forceinline__ bf16_t* Km() const { return (bf16_t*)(ws + WO_Km); }
  __device__ __forceinline__ bf16_t* Vm() const { return (bf16_t*)(ws + WO_Vm); }
  __device__ __forceinline__ bf16_t* S5A() const { return (bf16_t*)(ws + WO_S5A); }
  __device__ __forceinline__ bf16_t* S5Wy() const { return (bf16_t*)(ws + WO_S5Wy); }
  __device__ __forceinline__ bf16_t* S5Wz() const { return (bf16_t*)(ws + WO_S5Wz); }
  __device__ __forceinline__ float* S5Z() const { return (float*)(ws + WO_S5Z); }
  __device__ __forceinline__ float* S5a32() const { return (float*)(ws + WO_S5a32); }
  __device__ __forceinline__ bf16_t* Wglu_t() const { return (bf16_t*)(ws + WO_Wglu_t); }
  __device__ __forceinline__ bf16_t* ygb() const { return (bf16_t*)(ws + WO_yg); }
  __device__ __forceinline__ int* qctr() const { return (int*)(ws + WO_qctr); }
  __device__ __forceinline__ unsigned char* U8s() const { return ws + WO_Ub; }
  __device__ __forceinline__ float* su() const { return (float*)(ws + WO_Ub + (size_t)16384 * D); }
  __device__ __forceinline__ unsigned char* V8s() const { return ws + WO_Vb; }
  __device__ __forceinline__ float* sv() const { return (float*)(ws + WO_Vb + (size_t)16384 * D); }
  __device__ __forceinline__ unsigned char* h8hi() const { return ws + WO_ybuf + ((size_t)4 << 20); }
  __device__ __forceinline__ unsigned char* h8lo() const { return ws + WO_ybuf + ((size_t)4 << 20) + (size_t)T * D; }
  __device__ __forceinline__ float* sh() const { return (float*)(ws + WO_ybuf + ((size_t)4 << 20) + (size_t)2 * T * D); }
  __device__ __forceinline__ float* ppart() const { return (float*)(ws + WO_proj + (size_t)T * D * 2); }
  __device__ __forceinline__ bf16_t* Qr() const { return (bf16_t*)(ws + WO_Qr); }
  __device__ __forceinline__ bf16_t* Kr() const { return (bf16_t*)(ws + WO_Kr); }
  __device__ __forceinline__ bf16_t* Krv() const { return (bf16_t*)(ws + WO_Krv); }
  __device__ __forceinline__ bf16_t* Vr() const { return (bf16_t*)(ws + WO_Vr); }
  __device__ __forceinline__ float* KVr() const { return (float*)(ws + WO_KVr); }
  __device__ __forceinline__ bf16_t* Rb() const { return (bf16_t*)(ws + WO_Rb); }
  __device__ __forceinline__ unsigned* bar() const { return (unsigned*)(ws + WO_bar); }
  __device__ __forceinline__ bf16_t* qb() const { return (bf16_t*)(ws + WO_proj); }
};

namespace pg8 {
#define PG8_LAS __attribute__((address_space(3)))
typedef unsigned short bf16_t;
typedef short bf16x8 __attribute__((ext_vector_type(8)));
typedef float f32x4 __attribute__((ext_vector_type(4)));
typedef unsigned u32x4 __attribute__((ext_vector_type(4)));
constexpr int BM = 256, BK = 64, HALF = 128, HTB = HALF * BK * 2  , STAGE_BYTES = 8 * HTB, NXCD = 8, WGM = 8;

__host__ __device__ __forceinline__ int lds_byte(int r, int c) { const int st = (r >> 4) * 2 + (c >> 5), rr = r & 15, cc = c & 31, ob = rr * 64 + cc * 2; return st * 1024 + (ob ^ (((ob >> 9) & 1) << 5)); }
__host__ __device__ __forceinline__ void stage_rc(int b, int& R, int& C) { const int st = b / 1024, sb = b % 1024, swz = sb ^ (((sb >> 9) & 1) << 5); R = (st >> 1) * 16 + swz / 64; C = (st & 1) * 32 + (swz % 64) / 2; }
__host__ __device__ __forceinline__ int perm32(int rho) { const int n = rho >> 4, i = rho & 15; return 8 * (i >> 2) + 4 * n + (i & 3); }

struct Unit { int pm, pn; };
struct Gemm { const bf16_t* A; const bf16_t* Bt; int M, N, K, lda, ldb; };

struct StaticOrder {
    int nM, nN, nwg, G, c;
    __host__ __device__ void init(int M, int N, int G_, int c_) { nM = M / BM; nN = N / BM; nwg = nM * nN; G = G_; c = c_; }
    __host__ __device__ bool next(int i, Unit& u) const {
        const long L = (long)i * G + c; if (L >= nwg) return false;
        int wgid = (int)L; { const int q = nwg / NXCD, r = nwg % NXCD, xcd = wgid % NXCD, off = wgid / NXCD; wgid = (xcd < r ? xcd * (q + 1) : r * (q + 1) + (xcd - r) * q) + off; }
        const int nig = WGM * nN, gid = wgid / nig, fm = gid * WGM, gsz = (nM - fm) < WGM ? (nM - fm) : WGM;
        u.pm = fm + ((wgid % nig) % gsz); u.pn = (wgid % nig) / gsz; return true;
    }
    __device__ __forceinline__ void a_ready(const Unit&) const {}
    __device__ __forceinline__ void done(const Unit&) const {}
};
struct GroupOrder {
    int mt, nt_, nwg, G, c;
    __host__ __device__ void init(int ngroups, int mt__, int nt__, int G_, int c_) { mt = mt__; nt_ = nt__; nwg = ngroups * mt * nt_; G = G_; c = c_; }
    __host__ __device__ bool next(int i, Unit& u) const {
        const long L = (long)i * G + c; if (L >= nwg) return false;
        const int per = mt * nt_, gi = (int)L / per, r = (int)L % per;
        u.pm = gi * mt + r % mt; u.pn = gi * nt_ + r / mt; return true;
    }
    __device__ __forceinline__ void a_ready(const Unit&) const {}
    __device__ __forceinline__ void done(const Unit&) const {}
};
template <class Epi, class Sched, bool ALIGN_EPI = false, bool SP2 = false>
__device__ __forceinline__ void gemm_phase(PG8_LAS unsigned char* lds, const Gemm g, const Sched& S, const Epi& E) {
    int tid_ = threadIdx.x; asm volatile("" : "+v"(tid_));
    const int tid = tid_, wid = __builtin_amdgcn_readfirstlane(tid >> 6), lane = tid & 63, wr = wid >> 2, wc = wid & 3, fr = lane & 15, fq = lane >> 4;
    const int K = g.K, nt = K / BK;
    unsigned voffA[2], voffB[2];
#pragma unroll
    for (int i = 0; i < 2; ++i) { int R, C; stage_rc(tid * 16 + i * 8192, R, C); const int Rb = Epi::PERM ? ((R & ~31) + perm32(R & 31)) : R;
        voffA[i] = (unsigned)(R * g.lda + C) * 2u; voffB[i] = (unsigned)(Rb * g.ldb + C) * 2u; }
    const size_t kstep = (size_t)(BK * 2);
    const size_t hstepA = (size_t)HALF * g.lda * 2, hstepB = (size_t)HALF * g.ldb * 2;
    const size_t tstepA = 2 * hstepA, tstepB = 2 * hstepB;
    const unsigned ldsw = (unsigned)wid * 1024u;
    const int aoff = lds_byte(wr * 64 + fr, fq * 8), boff = lds_byte(wc * 32 + fr, fq * 8);
#define PG8_SA(b, h) (((b) * 2 + (h)) * HTB)
#define PG8_SB(b, h) ((4 + (b) * 2 + (h)) * HTB)
#define PG8_STAGE(bufoff, gbase, voff) do { _Pragma("unroll") for (int _i = 0; _i < 2; ++_i) \
        __builtin_amdgcn_global_load_lds((const unsigned*)((const char*)(gbase) + (voff)[_i]), (PG8_LAS unsigned*)(lds + (bufoff) + ldsw + _i * 8192), 16, 0, 0); } while (0)
#define PG8_LDA(dst, b, h) do { _Pragma("unroll") for (int m = 0; m < 4; ++m) _Pragma("unroll") for (int k = 0; k < 2; ++k) dst[m][k] = *(const PG8_LAS bf16x8*)(lds + PG8_SA(b, h) + aoff + m * 2048 + k * 1024); } while (0)
#define PG8_LDB(dst, b, h) do { _Pragma("unroll") for (int n = 0; n < 2; ++n) _Pragma("unroll") for (int k = 0; k < 2; ++k) dst[n][k] = *(const PG8_LAS bf16x8*)(lds + PG8_SB(b, h) + boff + n * 2048 + k * 1024); } while (0)
#define PG8_MMA(ai, bj, At, Bt) do { __builtin_amdgcn_s_setprio(1); _Pragma("unroll") for (int m = 0; m < 4; ++m) _Pragma("unroll") for (int n = 0; n < 2; ++n) _Pragma("unroll") for (int k = 0; k < 2; ++k) \
        acc[ai][bj][m][n] = __builtin_amdgcn_mfma_f32_16x16x32_bf16(Bt[n][k], At[m][k], acc[ai][bj][m][n], 0, 0, 0); __builtin_amdgcn_s_setprio(0); } while (0)
#define PG8_WAIT_V(n) asm volatile("s_waitcnt vmcnt(" #n ")" ::: "memory")
#define PG8_WAIT_L(n) asm volatile("s_waitcnt lgkmcnt(" #n ")" ::: "memory")
#define PG8_BAR __builtin_amdgcn_s_barrier()
#define PG8_SCHED __builtin_amdgcn_sched_barrier(0)
    Unit cur, nxt; int ui = 0;
    if (!S.next(0, cur)) return;
    f32x4 acc[2][2][4][2];
    E.init(acc, cur, wr, wc, fr, fq);
    bf16x8 At[4][2], B0[2][2], B1[2][2];
    const char* cA = (const char*)g.A + (size_t)cur.pm * tstepA; const char* cB = (const char*)g.Bt + (size_t)cur.pn * tstepB;
    S.a_ready(cur);
    if constexpr (SP2) {
        PG8_STAGE(PG8_SB(0, 0), cB, voffB); PG8_STAGE(PG8_SB(0, 1), cB + hstepB, voffB); PG8_STAGE(PG8_SA(0, 0), cA, voffA); PG8_STAGE(PG8_SA(0, 1), cA + hstepA, voffA);
        if (wr == 1) PG8_BAR;
        PG8_WAIT_V(2); PG8_BAR;
        PG8_STAGE(PG8_SB(1, 0), cB + kstep, voffB); PG8_STAGE(PG8_SA(1, 0), cA + kstep, voffA); PG8_STAGE(PG8_SB(1, 1), cB + hstepB + kstep, voffB);
        PG8_WAIT_V(6); PG8_BAR;
    } else {
        PG8_STAGE(PG8_SB(0, 0), cB, voffB); PG8_STAGE(PG8_SA(0, 0), cA, voffA); PG8_STAGE(PG8_SB(0, 1), cB + hstepB, voffB); PG8_STAGE(PG8_SA(0, 1), cA + hstepA, voffA);
        if (wr == 1) PG8_BAR;
        PG8_WAIT_V(4); PG8_BAR;
        PG8_STAGE(PG8_SB(1, 0), cB + kstep, voffB); PG8_STAGE(PG8_SA(1, 0), cA + kstep, voffA); PG8_STAGE(PG8_SB(1, 1), cB + hstepB + kstep, voffB);
        PG8_WAIT_V(6); PG8_BAR;
    }
    for (;;) {
        const bool has_next = S.next(ui + 1, nxt);
        const char* nA = has_next ? (const char*)g.A + (size_t)nxt.pm * tstepA : cA; const char* nB = has_next ? (const char*)g.Bt + (size_t)nxt.pn * tstepB : cB;
        for (int t = 0; t < nt; t += 2) {
            const bool last = (t == nt - 2);
            const char* a1 = cA + (size_t)(t + 1) * kstep;
            const char* a2 = last ? nA : cA + (size_t)(t + 2) * kstep; const char* b2 = last ? nB : cB + (size_t)(t + 2) * kstep;
            const char* a3 = a2 + kstep; const char* b3 = b2 + kstep;
            if (last && has_next) S.a_ready(nxt);
            if constexpr (SP2) {
            PG8_LDB(B0, 0, 0); PG8_LDB(B1, 0, 1); PG8_SCHED; PG8_LDA(At, 0, 0); PG8_STAGE(PG8_SA(1, 1), a1 + hstepA, voffA);
            PG8_WAIT_V(8); PG8_WAIT_L(0); PG8_BAR; PG8_MMA(0, 0, At, B0); PG8_MMA(0, 1, At, B1); PG8_BAR; PG8_SCHED;
            PG8_LDA(At, 0, 1); PG8_STAGE(PG8_SB(0, 0), b2, voffB); PG8_STAGE(PG8_SB(0, 1), b2 + hstepB, voffB); PG8_STAGE(PG8_SA(0, 0), a2, voffA);
            PG8_WAIT_V(8); PG8_WAIT_L(0); PG8_BAR; PG8_MMA(1, 0, At, B0); PG8_MMA(1, 1, At, B1); PG8_BAR; PG8_SCHED;
            PG8_LDB(B0, 1, 0); PG8_LDB(B1, 1, 1); PG8_SCHED; PG8_LDA(At, 1, 0); PG8_STAGE(PG8_SA(0, 1), a2 + hstepA, voffA);
            PG8_WAIT_V(8); PG8_WAIT_L(0); PG8_BAR; PG8_MMA(0, 0, At, B0); PG8_MMA(0, 1, At, B1); PG8_BAR; PG8_SCHED;
            PG8_LDA(At, 1, 1); PG8_STAGE(PG8_SB(1, 0), b3, voffB); PG8_STAGE(PG8_SB(1, 1), b3 + hstepB, voffB); PG8_STAGE(PG8_SA(1, 0), a3, voffA);
            PG8_WAIT_V(8); PG8_WAIT_L(0); PG8_BAR; PG8_MMA(1, 0, At, B0); PG8_MMA(1, 1, At, B1); PG8_BAR; PG8_SCHED;
            } else {
            PG8_LDB(B0, 0, 0); PG8_SCHED; PG8_LDA(At, 0, 0); PG8_STAGE(PG8_SA(1, 1), a1 + hstepA, voffA);
            PG8_WAIT_L(8); PG8_BAR; PG8_WAIT_L(0); PG8_MMA(0, 0, At, B0); PG8_BAR; PG8_SCHED;
            PG8_LDB(B1, 0, 1); PG8_STAGE(PG8_SB(0, 0), b2, voffB);
            PG8_BAR; PG8_WAIT_L(0); PG8_MMA(0, 1, At, B1); PG8_BAR;
            PG8_LDA(At, 0, 1); PG8_STAGE(PG8_SA(0, 0), a2, voffA);
            PG8_BAR; PG8_WAIT_L(0); PG8_MMA(1, 0, At, B0); PG8_BAR; PG8_SCHED;
            PG8_STAGE(PG8_SB(0, 1), b2 + hstepB, voffB);
            PG8_WAIT_V(6); PG8_BAR; PG8_MMA(1, 1, At, B1); PG8_BAR;
            PG8_LDB(B0, 1, 0); PG8_SCHED; PG8_LDA(At, 1, 0); PG8_STAGE(PG8_SA(0, 1), a2 + hstepA, voffA);
            PG8_WAIT_L(8); PG8_BAR; PG8_WAIT_L(0); PG8_MMA(0, 0, At, B0); PG8_BAR; PG8_SCHED;
            PG8_LDB(B1, 1, 1); PG8_STAGE(PG8_SB(1, 0), b3, voffB);
            PG8_BAR; PG8_WAIT_L(0); PG8_MMA(0, 1, At, B1); PG8_BAR;
            PG8_LDA(At, 1, 1); PG8_STAGE(PG8_SA(1, 0), a3, voffA);
            PG8_BAR; PG8_WAIT_L(0); PG8_MMA(1, 0, At, B0); PG8_BAR; PG8_SCHED;
            PG8_STAGE(PG8_SB(1, 1), b3 + hstepB, voffB);
            PG8_WAIT_V(6); PG8_BAR; PG8_MMA(1, 1, At, B1); PG8_BAR;
            }
        }
        if constexpr (ALIGN_EPI) { if (wr == 0) PG8_BAR; }
        if constexpr (!Epi::AFTER_DRAIN) { E(acc, cur, wr, wc, fr, fq); S.done(cur); }
        if (!has_next) break;
        E.init(acc, nxt, wr, wc, fr, fq);
        cur = nxt; cA = nA; cB = nB; ++ui;
        if constexpr (ALIGN_EPI) { if (wr == 1) PG8_BAR; }
    }
    PG8_WAIT_V(0);
    if constexpr (!ALIGN_EPI) { if (wr == 0) PG8_BAR; }
    PG8_BAR;
    if constexpr (Epi::AFTER_DRAIN) { E.fused(acc, cur, wr, wc, fr, fq, lds, wid, lane); S.done(cur); }
#undef PG8_SA
#undef PG8_SB
#undef PG8_STAGE
#undef PG8_LDA
#undef PG8_LDB
#undef PG8_MMA
#undef PG8_WAIT_V
#undef PG8_WAIT_L
#undef PG8_BAR
#undef PG8_SCHED
}
}
struct EpiScaleStore {
  static constexpr bool PERM = false, AFTER_DRAIN = false;
  float* C; int ldc; const float* rs;
  __device__ __forceinline__ void init(pg8::f32x4 (&acc)[2][2][4][2], const pg8::Unit&, int, int, int, int) const {
#pragma unroll
    for (int a = 0; a < 2; ++a)
#pragma unroll
      for (int b = 0; b < 2; ++b)
#pragma unroll
        for (int m = 0; m < 4; ++m)
#pragma unroll
          for (int n = 0; n < 2; ++n) acc[a][b][m][n] = (pg8::f32x4){0.f, 0.f, 0.f, 0.f};
  }
  __device__ __forceinline__ void operator()(const pg8::f32x4 (&acc)[2][2][4][2], const pg8::Unit& u, int wr, int wc, int fr_in, int fq_in) const {
    int fr = fr_in, fq = fq_in; asm volatile("" : "+v"(fr), "+v"(fq));
#pragma unroll
    for (int ai = 0; ai < 2; ++ai)
#pragma unroll
      for (int m = 0; m < 4; ++m) {
        const int row = u.pm * 256 + ai * 128 + wr * 64 + m * 16 + fr;
        const float r = rs[row];
#pragma unroll
        for (int bj = 0; bj < 2; ++bj)
#pragma unroll
          for (int n = 0; n < 2; ++n) {
            const int col = u.pn * 256 + bj * 128 + wc * 32 + n * 16 + 4 * fq;
            pg8::f32x4 v = acc[ai][bj][m][n] * r;
            *(pg8::f32x4*)(C + (size_t)row * ldc + col) = v;
          }
        asm volatile("" ::: "memory");
      }
  }
};
struct EpiAccum {
  static constexpr bool PERM = false, AFTER_DRAIN = false;
  float* C; int ldc;
  __device__ __forceinline__ void init(pg8::f32x4 (&acc)[2][2][4][2], const pg8::Unit& u, int wr, int wc, int fr, int fq) const {
#pragma unroll
    for (int ai = 0; ai < 2; ++ai)
#pragma unroll
      for (int m = 0; m < 4; ++m) {
        const int row = u.pm * 256 + ai * 128 + wr * 64 + m * 16 + fr;
#pragma unroll
        for (int bj = 0; bj < 2; ++bj)
#pragma unroll
          for (int n = 0; n < 2; ++n) {
            const int col = u.pn * 256 + bj * 128 + wc * 32 + n * 16 + 4 * fq;
            acc[ai][bj][m][n] = *(const pg8::f32x4*)(C + (size_t)row * ldc + col);
          }
      }
  }
  __device__ __forceinline__ void operator()(const pg8::f32x4 (&acc)[2][2][4][2], const pg8::Unit& u, int wr, int wc, int fr_in, int fq_in) const {
    int fr = fr_in, fq = fq_in; asm volatile("" : "+v"(fr), "+v"(fq));
#pragma unroll
    for (int ai = 0; ai < 2; ++ai)
#pragma unroll
      for (int m = 0; m < 4; ++m) {
        const int row = u.pm * 256 + ai * 128 + wr * 64 + m * 16 + fr;
#pragma unroll
        for (int bj = 0; bj < 2; ++bj)
#pragma unroll
          for (int n = 0; n < 2; ++n) {
            const int col = u.pn * 256 + bj * 128 + wc * 32 + n * 16 + 4 * fq;
            *(pg8::f32x4*)(C + (size_t)row * ldc + col) = acc[ai][bj][m][n];
          }
        asm volatile("" ::: "memory");
      }
  }
};
struct EpiScaleStoreBf16 {
  static constexpr bool PERM = false, AFTER_DRAIN = false;
  bf16_t* C; int ldc; const float* rs;
  __device__ __forceinline__ void init(pg8::f32x4 (&acc)[2][2][4][2], const pg8::Unit&, int, int, int, int) const {
#pragma unroll
    for (int a = 0; a < 2; ++a)
#pragma unroll
      for (int b = 0; b < 2; ++b)
#pragma unroll
        for (int m = 0; m < 4; ++m)
#pragma unroll
          for (int n = 0; n < 2; ++n) acc[a][b][m][n] = (pg8::f32x4){0.f, 0.f, 0.f, 0.f};
  }
  __device__ __forceinline__ void operator()(const pg8::f32x4 (&acc)[2][2][4][2], const pg8::Unit& u, int wr, int wc, int fr_in, int fq_in) const {
    int fr = fr_in, fq = fq_in; asm volatile("" : "+v"(fr), "+v"(fq));
#pragma unroll
    for (int ai = 0; ai < 2; ++ai)
#pragma unroll
      for (int m = 0; m < 4; ++m) {
        const int row = u.pm * 256 + ai * 128 + wr * 64 + m * 16 + fr;
        const float r = rs[row];
#pragma unroll
        for (int bj = 0; bj < 2; ++bj)
#pragma unroll
          for (int n = 0; n < 2; ++n) {
            const int col = u.pn * 256 + bj * 128 + wc * 32 + n * 16 + 4 * fq;
            pg8::f32x4 v = acc[ai][bj][m][n] * r;
            uint2 o; o.x = pk_bf16(v[0], v[1]); o.y = pk_bf16(v[2], v[3]);
            *(uint2*)(C + (size_t)row * ldc + col) = o;
          }
        asm volatile("" ::: "memory");
      }
  }
};
template <class Epi>
__device__ __forceinline__ void run_gemm(unsigned char* lds_raw, const bf16_t* A, const bf16_t* Bt, int M, int N, int K, const Epi& e) {
  pg8::Gemm g{A, Bt, M, N, K, K, K}; pg8::StaticOrder So; So.init(M, N, (int)gridDim.x, (int)blockIdx.x);
  pg8::gemm_phase<Epi, pg8::StaticOrder, true, true>((PG8_LAS unsigned char*)lds_raw, g, So, e);
}

__device__ __forceinline__ void transpose_items(const float* __restrict__ W, int K, int N, const float* __restrict__ g, bf16_t* __restrict__ Wt, int gw, int ngw, int lane) {
  const int nkt = K / 64, nnt = N / 64;
  for (int it = gw; it < nkt * nnt; it += ngw) {
    int kt = it % nkt, ntile = it / nkt;
    int k0 = kt * 64, n = ntile * 64 + lane;
    float v[64];
#pragma unroll
    for (int i = 0; i < 64; ++i) v[i] = W[(size_t)(k0 + i) * N + n] * g[k0 + i];
    bf16_t* dst = Wt + (size_t)n * (K * KS) + k0;
#pragma unroll
    for (int c = 0; c < 8; ++c) {
      bf16_t hi[8], lo[8];
#pragma unroll
      for (int e = 0; e < 8; ++e) { hi[e] = f2bf(v[c * 8 + e]); lo[e] = f2bf(v[c * 8 + e] - bf2f(hi[e])); }
      uint4 ph, pl;
      ph.x = hi[0] | ((unsigned)hi[1] << 16); ph.y = hi[2] | ((unsigned)hi[3] << 16); ph.z = hi[4] | ((unsigned)hi[5] << 16); ph.w = hi[6] | ((unsigned)hi[7] << 16);
      pl.x = lo[0] | ((unsigned)lo[1] << 16); pl.y = lo[2] | ((unsigned)lo[3] << 16); pl.z = lo[4] | ((unsigned)lo[5] << 16); pl.w = lo[6] | ((unsigned)lo[7] << 16);
      *(uint4*)(dst + c * 8) = ph;
      if (PRECISE) { *(uint4*)(dst + K + c * 8) = pl; *(uint4*)(dst + 2 * K + c * 8) = ph; }
    }
  }
}

__device__ __forceinline__ void phase_cvt_rows(const float* __restrict__ src, bf16_t* __restrict__ dst, float* __restrict__ rstd, int gw, int ngw, int lane) {
  for (int t = gw; t < T; t += ngw) {
    const float4* p = (const float4*)(src + (size_t)t * D);
    float ss = 0.f;
#pragma unroll
    for (int i = 0; i < 4; ++i) {
      float4 v = p[lane + i * 64];
      ss += v.x * v.x + v.y * v.y + v.z * v.z + v.w * v.w;
      bf16_t h0 = f2bf(v.x), h1 = f2bf(v.y), h2 = f2bf(v.z), h3 = f2bf(v.w);
      uint2 ph; ph.x = h0 | ((unsigned)h1 << 16); ph.y = h2 | ((unsigned)h3 << 16);
      bf16_t* d = dst + (size_t)t * KD + (lane + i * 64) * 4;
      *(uint2*)d = ph;
      if (PRECISE) {
        bf16_t l0 = f2bf(v.x - bf2f(h0)), l1 = f2bf(v.y - bf2f(h1)), l2 = f2bf(v.z - bf2f(h2)), l3 = f2bf(v.w - bf2f(h3));
        uint2 pl; pl.x = l0 | ((unsigned)l1 << 16); pl.y = l2 | ((unsigned)l3 << 16);
        *(uint2*)(d + D) = ph; *(uint2*)(d + 2 * D) = pl;
      }
    }
    if (rstd) { ss = wave_sum(ss); if (lane == 0) rstd[t] = rsqrtf(ss / (float)D + EPS); }
  }
}

__device__ __forceinline__ void phase_prologue(const Params& p, int gtid, int ngt, int gw, int ngw, int lane) {
  for (int idx = gtid; idx < S * 40; idx += ngt) {
    int s = idx / 40, i = idx % 40;
    if (i < 8) {
      float inv = powf(500000.0f, -(float)(2 * i) / 16.0f);
      float ang = (float)s * inv;
      p.cosm()[s * 8 + i] = (float)cos((double)ang); p.sinm()[s * 8 + i] = (float)sin((double)ang);
    } else {
      int j = i - 8;
      float inv = powf(10000.0f, -((float)j / 31.0f));
      float ang = (float)s * inv;
      p.cosr()[s * 32 + j] = (float)cos((double)ang); p.sinr()[s * 32 + j] = (float)sin((double)ang);
    }
  }
  { const float4* a = (const float4*)p.in[0]; float4* b = (float4*)p.out;
    for (size_t i = gtid; i < (size_t)T * D / 4; i += ngt) b[i] = a[i]; }
  for (int idx = gtid; idx < NL * 65536; idx += ngt) { const int l2 = idx >> 16, n2 = (idx >> 8) & 255, k2 = idx & 255; p.Wglu_t()[idx] = f2bf(p.in[11][(size_t)l2 * 65536 + k2 * 256 + n2]); }
  for (int l = 0; l < NL; ++l) {
    transpose_items(p.in[2] + (size_t)l * D * INW, D, INW, p.in[1] + l * D, p.Win_t() + (size_t)l * INW * KD, gw, ngw, lane);
    transpose_items(p.in[15] + (size_t)l * D * D, D, D, p.in[14] + l * D, p.Wout_t() + (size_t)l * D * KD, gw, ngw, lane);
    transpose_items(p.in[17] + (size_t)l * D * D, D, D, p.in[16] + l * D, p.Wq_t() + (size_t)l * D * KD, gw, ngw, lane);
  }
}

__device__ __forceinline__ void phase_postproj(const Params& p, int l, int gw, int ngw, int lane) {
  const float* gq = p.in[12] + l * 64; const float* gk = p.in[13] + l * 64;
  for (int w = gw; w < T * 24; w += ngw) {
    int t = w / 24, slot = w % 24, s = t % S;
    float* row = p.proj() + (size_t)t * INW;
    if (slot < 16) {
      int h = slot & 7;
      float* q = row + (slot < 8 ? OFF_QM : OFF_KM) + h * 64;
      const float* g = slot < 8 ? gq : gk;
      float v = q[lane];
      float ss = wave_sum(v * v);
      float u = v * rsqrtf(ss / 64.0f + EPS) * g[lane];
      int partner = lane < 8 ? lane + 8 : lane - 8;
      float pu = __shfl(u, partner & 63);
      float o = u;
      if (lane < 16) {
        int i = lane & 7;
        float c = p.cosm()[s * 8 + i], sn = p.sinm()[s * 8 + i];
        o = lane < 8 ? (u * c - pu * sn) : (u * c + pu * sn);
      }
      q[lane] = o;
    } else {
      int h = (slot - 16) & 3; bool isk = slot >= 20;
      float* q = row + (isk ? OFF_KR : OFF_QR) + h * 64;
      float v = q[lane];
      float pv = __shfl(v, lane ^ 32);
      int i = lane & 31;
      float c = p.cosr()[s * 32 + i], sn = p.sinr()[s * 32 + i];
      float o = lane < 32 ? (v * c - pv * sn) : (v * c + pv * sn);
      if (isk) o *= 0.125f;
      q[lane] = o;
    }
  }
}

__device__ __forceinline__ void phase_kmean(const Params& p, int gtid, int ngt) {
  for (int idx = gtid; idx < NB * 8 * 16 * 64; idx += ngt) {
    int d = idx & 63, j = (idx >> 6) & 15, h = (idx >> 10) & 7, b = idx >> 13;
    const float* q = p.proj() + ((size_t)(b * S + j * 256)) * INW + OFF_KM + h * 64 + d;
    float acc = 0.f;
    for (int i = 0; i < 256; ++i) acc += q[(size_t)i * INW];
    p.kmean()[idx] = acc / 256.0f;
  }
}

__device__ __forceinline__ void s5_unit(const Params& p, int l, int unit, float* red, int lane) {
  const int b = unit >> 4, g = unit & 15, pp = lane;
  const float* lam_re = p.in[3] + l * 1024; const float* lam_im = p.in[4] + l * 1024; const float* log_dt = p.in[5] + l * 16;
  const float* b_re = p.in[6] + l * 16384; const float* b_im = p.in[7] + l * 16384;
  const float* c_re = p.in[8] + l * 16384; const float* c_im = p.in[9] + l * 16384; const float* dskip = p.in[10] + l * 256;
  float lr = lam_re[g * 64 + pp], li = lam_im[g * 64 + pp];
  float dt = expf(log_dt[g]);
  float mag = expf(lr * dt);
  float ar = mag * cosf(li * dt), ai = mag * sinf(li * dt);
  float den = lr * lr + li * li;
  float fr = ((ar - 1.0f) * lr + ai * li) / den;
  float fi = (ai * lr - (ar - 1.0f) * li) / den;
  float bbr[16], bbi[16], cr[16], ci[16];
#pragma unroll
  for (int h = 0; h < 16; ++h) {
    float br = b_re[(g * 64 + pp) * 16 + h], bi = b_im[(g * 64 + pp) * 16 + h];
    bbr[h] = fr * br - fi * bi; bbi[h] = fr * bi + fi * br;
    cr[h] = c_re[(g * 16 + h) * 64 + pp]; ci[h] = c_im[(g * 16 + h) * 64 + pp];
  }
  const int hq = pp >> 2, qq = pp & 3;
  float dsk = dskip[g * 16 + hq];
  float sr = 0.f, si = 0.f;
  for (int t = 0; t < S; ++t) {
    const float* up = p.proj() + (size_t)(b * S + t) * INW + OFF_U + g * 16;
    float u[16];
#pragma unroll
    for (int h4 = 0; h4 < 4; ++h4) { float4 v = *(const float4*)(up + h4 * 4); u[h4 * 4] = v.x; u[h4 * 4 + 1] = v.y; u[h4 * 4 + 2] = v.z; u[h4 * 4 + 3] = v.w; }
    float bur = 0.f, bui = 0.f;
#pragma unroll
    for (int h = 0; h < 16; ++h) { bur = fmaf(u[h], bbr[h], bur); bui = fmaf(u[h], bbi[h], bui); }
    float nr = ar * sr - ai * si + bur, ni = ar * si + ai * sr + bui;
    sr = nr; si = ni;
    LDS_FENCE();
#pragma unroll
    for (int h = 0; h < 16; ++h) red[h * 65 + pp] = sr * cr[h] - si * ci[h];
    LDS_FENCE();
    float acc = 0.f;
#pragma unroll
    for (int i = 0; i < 16; ++i) acc += red[hq * 65 + qq * 16 + i];
    acc += __shfl_xor(acc, 1);
    acc += __shfl_xor(acc, 2);
    if (qq == 0) p.yg()[(size_t)(b * S + t) * 256 + g * 16 + hq] = gelu_tanh(acc + up[hq] * dsk);
  }
}

__device__ __forceinline__ void ret_units(const Params& p, int l, int unit0, float* lds) {
  constexpr int TB = 16;
  int tx_ = threadIdx.x; asm volatile("" : "+v"(tx_));
  const int vb = tx_ >> 8, tid = tx_ & 255;
  float* base_l = lds + vb * (TB * 64 * 3 + TB * 4 * 64);
  float* qs = base_l; float* ks = qs + TB * 64; float* vs = ks + TB * 64; float* red = vs + TB * 64;
  const int unit = unit0 + vb;
  const int b = unit >> 2, h = unit & 3;
  const int e = tid & 63, dg = tid >> 6;
  const float gamma = 1.0f - exp2f(-5.0f - (float)h);
  float St[16];
#pragma unroll
  for (int i = 0; i < 16; ++i) St[i] = 0.f;
  const float* base = p.proj() + (size_t)(b * S) * INW;
  for (int t0 = 0; t0 < S; t0 += TB) {
    __syncthreads();
    for (int i = tid; i < TB * 64; i += 256) {
      int tt = i >> 6, d = i & 63;
      const float* r = base + (size_t)(t0 + tt) * INW;
      qs[tt * 64 + d] = r[OFF_QR + h * 64 + d]; ks[tt * 64 + d] = r[OFF_KR + h * 64 + d]; vs[tt * 64 + d] = r[OFF_VR + h * 64 + d];
    }
    __syncthreads();
    for (int tt = 0; tt < TB; ++tt) {
      float ve = vs[tt * 64 + e], part = 0.f;
#pragma unroll
      for (int i = 0; i < 16; ++i) {
        St[i] = fmaf(gamma, St[i], ks[tt * 64 + dg * 16 + i] * ve);
        part = fmaf(qs[tt * 64 + dg * 16 + i], St[i], part);
      }
      red[(tt * 4 + dg) * 64 + e] = part;
    }
    __syncthreads();
    for (int k = 0; k < 4; ++k) {
      int tt = dg * 4 + k;
      float o = red[(tt * 4 + 0) * 64 + e] + red[(tt * 4 + 1) * 64 + e] + red[(tt * 4 + 2) * 64 + e] + red[(tt * 4 + 3) * 64 + e];
      float ss = wave_sum(o * o);
      float gv = base[(size_t)(t0 + tt) * INW + OFF_GR + h * 64 + e];
      float sl = gv * sigmoidf_(gv);
      int col = 768 + h * 64 + e;
      p.ybuf()[(size_t)(b * S + t0 + tt) * D + col] = sl * o * rsqrtf(ss / 64.0f + EPS);
    }
  }
}

__device__ __forceinline__ void phase_s5glu(const Params& p, int l, float* ys, int gw, int ngw, int lane) {
  const float* wglu = p.in[11] + (size_t)l * 65536;
  for (int t = gw; t < T; t += ngw) {
    float yv[4];
    LDS_FENCE();
#pragma unroll
    for (int i = 0; i < 4; ++i) { yv[i] = p.yg()[(size_t)t * 256 + lane + i * 64]; ys[lane + i * 64] = yv[i]; }
    LDS_FENCE();
    float z[4] = {0.f, 0.f, 0.f, 0.f};
    for (int k = 0; k < 256; ++k) {
      float yk = ys[k];
#pragma unroll
      for (int i = 0; i < 4; ++i) z[i] = fmaf(yk, wglu[k * 256 + lane + i * 64], z[i]);
    }
    float o[4], ss = 0.f;
#pragma unroll
    for (int i = 0; i < 4; ++i) { o[i] = yv[i] * sigmoidf_(z[i]); ss += o[i] * o[i]; }
    ss = wave_sum(ss);
    float r = rsqrtf(ss / 256.0f + EPS);
#pragma unroll
    for (int i = 0; i < 4; ++i) p.ybuf()[(size_t)t * D + lane + i * 64] = o[i] * r;
  }
}


struct S5P { float lr, li, dt, fr, fi; };
__device__ __forceinline__ S5P s5p(const Params& p, int l, int g, int pp) {
  S5P r; r.lr = p.in[3][l * 1024 + g * 64 + pp]; r.li = p.in[4][l * 1024 + g * 64 + pp]; r.dt = expf(p.in[5][l * 16 + g]);
  const float mag = expf(r.lr * r.dt); float sn, cs; sincosf(r.li * r.dt, &sn, &cs);
  const float ar = mag * cs, ai = mag * sn, den = r.lr * r.lr + r.li * r.li;
  r.fr = ((ar - 1.0f) * r.lr + ai * r.li) / den; r.fi = (ai * r.lr - (ar - 1.0f) * r.li) / den;
  return r;
}
__device__ __forceinline__ void s5pow(const S5P& s, int k, float& re, float& im) {
  const float m = expf((float)k * s.lr * s.dt); float sn, cs; sincosf((float)k * s.li * s.dt, &sn, &cs); re = m * cs; im = m * sn;
}
__device__ __forceinline__ void phase_s5_prep(const Params& p, int l, int gtid, int ngt) {
  const float* b_re = p.in[6] + l * 16384; const float* b_im = p.in[7] + l * 16384;
  const float* c_re = p.in[8] + l * 16384; const float* c_im = p.in[9] + l * 16384;
  bf16_t* Wy = p.S5Wy(); bf16_t* Wz = p.S5Wz();
  for (int it = gtid; it < 16 * 32 * 256; it += ngt) {
    const int hp = it & 15, h = (it >> 4) & 15, d = (it >> 8) & 31, g = it >> 13;
    float acc = 0.f;
    for (int pp = 0; pp < 64; ++pp) {
      const S5P s = s5p(p, l, g, pp);
      float pr, pi; s5pow(s, d, pr, pi);
      const float br = b_re[(g * 64 + pp) * 16 + hp], bi = b_im[(g * 64 + pp) * 16 + hp];
      const float bbr = s.fr * br - s.fi * bi, bbi = s.fr * bi + s.fi * br;
      const float tr = pr * bbr - pi * bbi, ti = pr * bbi + pi * bbr;
      acc += c_re[(g * 16 + h) * 64 + pp] * tr - c_im[(g * 16 + h) * 64 + pp] * ti;
    }
    const bf16_t v = f2bf(acc);
    for (int jp = 0; jp + d < 32; ++jp) {
      const int j = jp + d;
      Wy[((size_t)g * 512 + j * 16 + h) * 640 + jp * 16 + hp] = v;
      if (d > 0) Wy[((size_t)g * 512 + jp * 16 + h) * 640 + j * 16 + hp] = 0;
    }
  }
  for (int it = gtid; it < 16 * 32 * 16 * 64; it += ngt) {
    const int pp = it & 63, h = (it >> 6) & 15, j = (it >> 10) & 31, g = it >> 15;
    const S5P s = s5p(p, l, g, pp);
    float pr, pi; s5pow(s, j + 1, pr, pi);
    const float cr = c_re[(g * 16 + h) * 64 + pp], ci = c_im[(g * 16 + h) * 64 + pp];
    const unsigned w = pk_bf16(cr * pr - ci * pi, -(cr * pi + ci * pr));
    *(unsigned*)(Wy + ((size_t)g * 512 + j * 16 + h) * 640 + 512 + 2 * pp) = w;
  }
  for (int it = gtid; it < 16 * 64 * 32; it += ngt) {
    const int j = it & 31, pp = (it >> 5) & 63, g = it >> 11;
    const S5P s = s5p(p, l, g, pp);
    float pr, pi; s5pow(s, 31 - j, pr, pi);
    for (int hp = 0; hp < 16; ++hp) {
      const float br = b_re[(g * 64 + pp) * 16 + hp], bi = b_im[(g * 64 + pp) * 16 + hp];
      const float bbr = s.fr * br - s.fi * bi, bbi = s.fr * bi + s.fi * br;
      Wz[((size_t)g * 256 + 2 * pp) * 512 + j * 16 + hp] = f2bf(pr * bbr - pi * bbi);
      Wz[((size_t)g * 256 + 2 * pp + 1) * 512 + j * 16 + hp] = f2bf(pr * bbi + pi * bbr);
    }
  }
  for (int it = gtid; it < 16 * 64; it += ngt) {
    const S5P s = s5p(p, l, it >> 6, it & 63);
    float pr, pi; s5pow(s, 32, pr, pi);
    p.S5a32()[it * 2] = pr; p.S5a32()[it * 2 + 1] = pi;
  }
}
__device__ __forceinline__ void phase_pack_u(const Params& p, int gtid, int ngt) {
  for (int idx = gtid; idx < T * 32; idx += ngt) {
    const int t = idx >> 5, i = idx & 31, g = i >> 1;
    const float* src = p.proj() + (size_t)t * INW + i * 8;
    float4 a = *(const float4*)src, b4 = *(const float4*)(src + 4);
    uint4 o; o.x = pk_bf16(a.x, a.y); o.y = pk_bf16(a.z, a.w); o.z = pk_bf16(b4.x, b4.y); o.w = pk_bf16(b4.z, b4.w);
    *(uint4*)(p.S5A() + ((size_t)g * 1024 + (t >> 5)) * 640 + (t & 31) * 16 + (i & 1) * 8) = o;
  }
}
__device__ __forceinline__ void phase_s5_scan(const Params& p, int gtid, int ngt) {
  for (int it = gtid; it < NB * 16 * 64; it += ngt) {
    const int pp = it & 63, g = (it >> 6) & 15, b = it >> 10;
    const float er = p.S5a32()[(g * 64 + pp) * 2], ei = p.S5a32()[(g * 64 + pp) * 2 + 1];
    float sr = 0.f, si = 0.f;
    for (int c = 0; c < 128; ++c) {
      const size_t ch = (size_t)g * 1024 + b * 128 + c;
      *(unsigned*)(p.S5A() + ch * 640 + 512 + 2 * pp) = pk_bf16(sr, si);
      const float2 z = *(const float2*)(p.S5Z() + ch * 128 + 2 * pp);
      const float nr = er * sr - ei * si + z.x, ni = er * si + ei * sr + z.y;
      sr = nr; si = ni;
    }
  }
}
#define EPI_ZERO_INIT \
  __device__ __forceinline__ void init(pg8::f32x4 (&acc)[2][2][4][2], const pg8::Unit&, int, int, int, int) const { \
    _Pragma("unroll") for (int a = 0; a < 2; ++a) _Pragma("unroll") for (int b = 0; b < 2; ++b) \
    _Pragma("unroll") for (int m = 0; m < 4; ++m) _Pragma("unroll") for (int n = 0; n < 2; ++n) acc[a][b][m][n] = (pg8::f32x4){0.f, 0.f, 0.f, 0.f}; }
struct EpiS5Z {
  static constexpr bool PERM = false, AFTER_DRAIN = false;
  float* Z;
  EPI_ZERO_INIT
  __device__ __forceinline__ void operator()(const pg8::f32x4 (&acc)[2][2][4][2], const pg8::Unit& u, int wr, int wc, int fr_in, int fq_in) const {
    int fr = fr_in, fq = fq_in; asm volatile("" : "+v"(fr), "+v"(fq));
    const int g = u.pm >> 2;
#pragma unroll
    for (int ai = 0; ai < 2; ++ai)
#pragma unroll
      for (int m = 0; m < 4; ++m) {
        const int chunk = (u.pm & 3) * 256 + ai * 128 + wr * 64 + m * 16 + fr;
#pragma unroll
        for (int n = 0; n < 2; ++n) *(pg8::f32x4*)(Z + ((size_t)g * 1024 + chunk) * 128 + wc * 32 + n * 16 + 4 * fq) = acc[ai][0][m][n];
      }
  }
};
struct EpiS5Y {
  static constexpr bool PERM = false, AFTER_DRAIN = false;
  bf16_t* ygb; const bf16_t* A; const float* dsk;
  EPI_ZERO_INIT
  __device__ __forceinline__ void operator()(const pg8::f32x4 (&acc)[2][2][4][2], const pg8::Unit& u, int wr, int wc, int fr_in, int fq_in) const {
    int fr = fr_in, fq = fq_in; asm volatile("" : "+v"(fr), "+v"(fq));
    const int g = u.pm >> 2;
#pragma unroll
    for (int ai = 0; ai < 2; ++ai)
#pragma unroll
      for (int m = 0; m < 4; ++m) {
        const int chunk = (u.pm & 3) * 256 + ai * 128 + wr * 64 + m * 16 + fr;
#pragma unroll
        for (int bj = 0; bj < 2; ++bj)
#pragma unroll
          for (int n = 0; n < 2; ++n) {
            const int col = (u.pn & 1) * 256 + bj * 128 + wc * 32 + n * 16 + 4 * fq, j = col >> 4, h = col & 15;
            const uint2 uu = *(const uint2*)(A + ((size_t)g * 1024 + chunk) * 640 + col);
            const pg8::f32x4 dv = *(const pg8::f32x4*)(dsk + g * 16 + h);
            const pg8::f32x4 v = acc[ai][bj][m][n];
            const float y0 = fast_gelu(v[0] + dv[0] * __uint_as_float(uu.x << 16)), y1 = fast_gelu(v[1] + dv[1] * __uint_as_float(uu.x & 0xffff0000u));
            const float y2 = fast_gelu(v[2] + dv[2] * __uint_as_float(uu.y << 16)), y3 = fast_gelu(v[3] + dv[3] * __uint_as_float(uu.y & 0xffff0000u));
            uint2 o; o.x = pk_bf16(y0, y1); o.y = pk_bf16(y2, y3);
            *(uint2*)(ygb + ((size_t)chunk * 32 + j) * 256 + g * 16 + h) = o;
          }
        asm volatile("" ::: "memory");
      }
  }
};
struct EpiGlu {
  static constexpr bool PERM = false, AFTER_DRAIN = false;
  float* ybuf; const bf16_t* ygb; float* scr;
  EPI_ZERO_INIT
  __device__ __forceinline__ void operator()(const pg8::f32x4 (&acc_)[2][2][4][2], const pg8::Unit& u, int wr, int wc, int fr_in, int fq_in) const {
    int fr = fr_in, fq = fq_in; asm volatile("" : "+v"(fr), "+v"(fq));
    pg8::f32x4 (&acc)[2][2][4][2] = const_cast<pg8::f32x4 (&)[2][2][4][2]>(acc_);
#pragma unroll
    for (int ai = 0; ai < 2; ++ai)
#pragma unroll
      for (int m = 0; m < 4; ++m) {
        const int rl = ai * 128 + wr * 64 + m * 16 + fr, row = u.pm * 256 + rl;
        float ss = 0.f;
#pragma unroll
        for (int bj = 0; bj < 2; ++bj)
#pragma unroll
          for (int n = 0; n < 2; ++n) {
            const int col = bj * 128 + wc * 32 + n * 16 + 4 * fq;
            const uint2 yy = *(const uint2*)(ygb + (size_t)row * 256 + col);
            const pg8::f32x4 z = acc[ai][bj][m][n];
            pg8::f32x4 r;
            r[0] = __uint_as_float(yy.x << 16) * fast_sigmoid(z[0]); r[1] = __uint_as_float(yy.x & 0xffff0000u) * fast_sigmoid(z[1]);
            r[2] = __uint_as_float(yy.y << 16) * fast_sigmoid(z[2]); r[3] = __uint_as_float(yy.y & 0xffff0000u) * fast_sigmoid(z[3]);
            acc[ai][bj][m][n] = r;
            ss += r[0] * r[0] + r[1] * r[1] + r[2] * r[2] + r[3] * r[3];
          }
        ss += __shfl_xor(ss, 16); ss += __shfl_xor(ss, 32);
        if (fq == 0) scr[rl * 4 + wc] = ss;
        asm volatile("" ::: "memory");
      }
    asm volatile("s_waitcnt lgkmcnt(0)" ::: "memory"); __builtin_amdgcn_s_barrier(); asm volatile("" ::: "memory");
#pragma unroll
    for (int ai = 0; ai < 2; ++ai)
#pragma unroll
      for (int m = 0; m < 4; ++m) {
        const int rl = ai * 128 + wr * 64 + m * 16 + fr, row = u.pm * 256 + rl;
        const pg8::f32x4 s4 = *(const pg8::f32x4*)(scr + rl * 4);
        const float r = rsqrtf((s4[0] + s4[1] + s4[2] + s4[3]) / 256.0f + EPS);
#pragma unroll
        for (int bj = 0; bj < 2; ++bj)
#pragma unroll
          for (int n = 0; n < 2; ++n) *(pg8::f32x4*)(ybuf + (size_t)row * D + bj * 128 + wc * 32 + n * 16 + 4 * fq) = acc[ai][bj][m][n] * r;
        asm volatile("" ::: "memory");
      }
    asm volatile("s_waitcnt lgkmcnt(0)" ::: "memory"); __builtin_amdgcn_s_barrier(); asm volatile("" ::: "memory");
  }
};

constexpr float QSCALE = 0.125f * 1.4426950408889634f;

__device__ __forceinline__ void phase_pack_moba(const Params& p, int gtid, int ngt) {
  for (int idx = gtid; idx < T * 128; idx += ngt) {
    const int t = idx >> 7, c = idx & 127, isk = c >> 6, cc = c & 63, h = cc >> 3, ch = cc & 7;
    const float* src = p.proj() + (size_t)t * INW + (isk ? OFF_KM : OFF_QM) + h * 64 + ch * 8;
    float4 a = *(const float4*)src, b4 = *(const float4*)(src + 4);
    const float sc = isk ? 1.0f : QSCALE;
    uint4 o; o.x = pk_bf16(a.x * sc, a.y * sc); o.y = pk_bf16(a.z * sc, a.w * sc); o.z = pk_bf16(b4.x * sc, b4.y * sc); o.w = pk_bf16(b4.z * sc, b4.w * sc);
    const int b = t / S, s = t % S;
    bf16_t* dst = isk ? p.Km() + ((((size_t)(b * 8 + h) * (S / 32) + (s >> 5)) * 8 + ch) * 32 + (s & 31)) * 8
                      : p.Qm() + ((size_t)(b * 8 + h) * S + s) * 64 + ch * 8;
    *(uint4*)dst = o;
  }
  for (int idx = gtid; idx < NB * 8 * (S / 32) * 256; idx += ngt) {
    const int ln = idx & 63, ks = (idx >> 6) & 1, mb = (idx >> 7) & 1, tile = (idx >> 8) % (S / 32), bh = idx / (256 * (S / 32));
    const int b = bh >> 3, h = bh & 7, hh = ln >> 5, delta = mb * 32 + (ln & 31);
    float v[8];
#pragma unroll
    for (int j = 0; j < 8; ++j) {
      const int kappa = 16 * ks + 8 * (j >> 2) + 4 * hh + (j & 3), s = tile * 32 + kappa;
      v[j] = p.proj()[(size_t)(b * S + s) * INW + OFF_VM + h * 64 + delta];
    }
    uint4 o; o.x = pk_bf16(v[0], v[1]); o.y = pk_bf16(v[2], v[3]); o.z = pk_bf16(v[4], v[5]); o.w = pk_bf16(v[6], v[7]);
    *(uint4*)(p.Vm() + (size_t)idx * 8) = o;
  }
}

__device__ __forceinline__ void phase_moba2(const Params& p, int l, unsigned char* lds, int bid, int G) {
  int tid = threadIdx.x; asm volatile("" : "+v"(tid));
  const int lane = tid & 63, wv = tid >> 6, n = lane & 31, hh = lane >> 5;
  constexpr int OLD = 260;
  bf16_t* Qs = (bf16_t*)lds;
  float* Oaccf = (float*)(lds + 32768);
  float* laccf = (float*)(lds + 32768 + 64 * OLD * 4);
  float* kms = laccf + 256;
  float* gat = kms + 1024;
  unsigned char* lists = (unsigned char*)(gat + 4096);
  int* cnt = (int*)(lists + 4096);
  int* items = cnt + 16;
  int* ctr = items + 160;
  unsigned* selp = (unsigned*)(ctr + 4);
  float* bq = (float*)(selp + 256);
  int* Oacc = (int*)Oaccf; int* lacc = (int*)laccf;
  float kmax = 0.f;
  { const float* gk = p.in[13] + l * 64;
    for (int d = 0; d < 64; ++d) kmax = fmaxf(kmax, fabsf(gk[d]));
    kmax *= 8.0f * 1.01f; }
  for (int u = bid; u < NB * 8 * 16; u += G) {
    const int qblk = 15 - (u >> 6), bh = u & 63, b = bh >> 3, h = bh & 7;
    __syncthreads();
    { const uint4* src = (const uint4*)(p.Qm() + ((size_t)bh * S + qblk * 256) * 64);
      uint4* dst = (uint4*)Qs;
      for (int i = tid; i < 256 * 64 * 2 / 16; i += NTHR) dst[i] = src[i]; }
    for (int i = tid; i < qblk * 64; i += NTHR) kms[i] = p.kmean()[(size_t)bh * 1024 + i];
    for (int i = tid; i < 64 * OLD; i += NTHR) Oacc[i] = 0;
    if (tid < 256) lacc[tid] = 0;
    if (tid < 16) cnt[tid] = 0;
    __syncthreads();
    { const int q = tid & 255, par = tid >> 8;
      float qv[64];
#pragma unroll
      for (int c = 0; c < 8; ++c) {
        uint4 w = *(const uint4*)(Qs + q * 64 + c * 8);
        qv[c * 8 + 0] = __uint_as_float(w.x << 16); qv[c * 8 + 1] = __uint_as_float(w.x & 0xffff0000u);
        qv[c * 8 + 2] = __uint_as_float(w.y << 16); qv[c * 8 + 3] = __uint_as_float(w.y & 0xffff0000u);
        qv[c * 8 + 4] = __uint_as_float(w.z << 16); qv[c * 8 + 5] = __uint_as_float(w.z & 0xffff0000u);
        qv[c * 8 + 6] = __uint_as_float(w.w << 16); qv[c * 8 + 7] = __uint_as_float(w.w & 0xffff0000u);
      }
      if (par == 0) { float qq = 0.f;
#pragma unroll
        for (int d = 0; d < 64; ++d) qq = fmaf(qv[d], qv[d], qq);
        bq[q] = sqrtf(qq) * kmax; }
      for (int j = par; j < qblk; j += 2) {
        float g = 0.f;
#pragma unroll
        for (int d = 0; d < 64; ++d) g = fmaf(qv[d], kms[j * 64 + d], g);
        gat[q * 16 + j] = g;
      }
    }
    __syncthreads();
    if (tid < 256) {
      float b0 = -INFINITY, b1 = -INFINITY, b2 = -INFINITY; int i0 = 0, i1 = 0, i2 = 0;
      for (int j = 0; j < qblk; ++j) {
        float g = gat[tid * 16 + j];
        if (g > b0) { b2 = b1; i2 = i1; b1 = b0; i1 = i0; b0 = g; i0 = j; }
        else if (g > b1) { b2 = b1; i2 = i1; b1 = g; i1 = j; }
        else if (g > b2) { b2 = g; i2 = j; }
      }
      const int nsel = qblk < 3 ? qblk : 3;
      selp[tid] = (unsigned)i0 | ((unsigned)i1 << 4) | ((unsigned)i2 << 8) | ((unsigned)nsel << 12);
    }
    __syncthreads();
    for (int j = wv; j < qblk; j += 8) {
      int base = 0;
      for (int c = 0; c < 4; ++c) {
        const int q = c * 64 + lane;
        const unsigned sp = selp[q];
        const int ns = sp >> 12;
        const bool f = (ns > 0 && (int)(sp & 15) == j) || (ns > 1 && (int)((sp >> 4) & 15) == j) || (ns > 2 && (int)((sp >> 8) & 15) == j);
        const unsigned long long bal = __ballot(f);
        const int pos = base + __popcll(bal & ((1ull << lane) - 1ull));
        if (f) lists[j * 256 + pos] = (unsigned char)q;
        base += __popcll(bal);
      }
      if (lane == 0) cnt[j] = base;
    }
    __syncthreads();
    if (tid == 0) {
      int ni = 0;
#pragma unroll 1
      for (int g = 7; g >= 0; --g) items[ni++] = (16 << 8) | g;
      for (int j = 0; j < qblk; ++j) { const int ng = (cnt[j] + 31) >> 5; for (int g = 0; g < ng; ++g) items[ni++] = (j << 8) | g; }
      ctr[0] = ni; ctr[1] = 0;
    }
    __syncthreads();
    const int nitems = ctr[0];
    for (;;) {
      int it = 0;
      if (lane == 0) it = atomicAdd(&ctr[1], 1);
      it = __builtin_amdgcn_readfirstlane(it);
      if (it >= nitems) break;
      const int item = items[it];
      const int j = item >> 8, g = item & 255;
      const bool own = (j == 16);
      const int kb = own ? qblk : j;
      const int ntile = own ? (g + 1) : 8;
      int qi; bool valid;
      if (own) { qi = g * 32 + n; valid = true; }
      else { const int pos = g * 32 + n; valid = pos < cnt[j]; qi = lists[j * 256 + (valid ? pos : 0)]; }
      bf16x8 qf[4];
#pragma unroll
      for (int s = 0; s < 4; ++s) qf[s] = *(const bf16x8*)(Qs + qi * 64 + (2 * s + hh) * 8);
      const bf16_t* kt0 = p.Km() + ((size_t)bh * (S / 32) + kb * 8) * 2048 + lane * 8;
      const bf16_t* vt0 = p.Vm() + ((size_t)bh * (S / 32) + kb * 8) * 2048 + lane * 8;
      f32x16 O0, O1;
#pragma unroll
      for (int r = 0; r < 16; ++r) { O0[r] = 0.f; O1[r] = 0.f; }
      float lsum = 0.f;
      const float nbq = -bq[qi];
      bf16x8 kf[4], vf[4];
#pragma unroll
      for (int s = 0; s < 4; ++s) { kf[s] = *(const bf16x8*)(kt0 + s * 512); vf[s] = *(const bf16x8*)(vt0 + s * 512); }
      for (int kt = 0; kt < ntile; ++kt) {
        bf16x8 kn[4], vn[4];
        const int ktn = (kt + 1 < ntile) ? kt + 1 : kt;
#pragma unroll
        for (int s = 0; s < 4; ++s) { kn[s] = *(const bf16x8*)(kt0 + (size_t)ktn * 2048 + s * 512); vn[s] = *(const bf16x8*)(vt0 + (size_t)ktn * 2048 + s * 512); }
        f32x16 X;
#pragma unroll
        for (int r = 0; r < 16; ++r) X[r] = nbq;
#pragma unroll
        for (int s = 0; s < 4; ++s) X = __builtin_amdgcn_mfma_f32_32x32x16_bf16(kf[s], qf[s], X, 0, 0, 0);
        const bool diag = own && (kt == g);
        unsigned pw[8];
#pragma unroll
        for (int r = 0; r < 16; r += 2) {
          float e0 = __builtin_amdgcn_exp2f(X[r]), e1 = __builtin_amdgcn_exp2f(X[r + 1]);
          if (diag) {
            const int k0 = (r & 3) + 8 * (r >> 2) + 4 * hh, k1 = ((r + 1) & 3) + 8 * ((r + 1) >> 2) + 4 * hh;
            e0 = (k0 <= n) ? e0 : 0.f; e1 = (k1 <= n) ? e1 : 0.f;
          }
          lsum += e0 + e1;
          pw[r >> 1] = pk_bf16(e0, e1);
        }
        bf16x8 pf0, pf1;
        { uint4 t0 = make_uint4(pw[0], pw[1], pw[2], pw[3]), t1 = make_uint4(pw[4], pw[5], pw[6], pw[7]);
          pf0 = *(bf16x8*)&t0; pf1 = *(bf16x8*)&t1; }
        O0 = __builtin_amdgcn_mfma_f32_32x32x16_bf16(vf[0], pf0, O0, 0, 0, 0);
        O0 = __builtin_amdgcn_mfma_f32_32x32x16_bf16(vf[1], pf1, O0, 0, 0, 0);
        O1 = __builtin_amdgcn_mfma_f32_32x32x16_bf16(vf[2], pf0, O1, 0, 0, 0);
        O1 = __builtin_amdgcn_mfma_f32_32x32x16_bf16(vf[3], pf1, O1, 0, 0, 0);
#pragma unroll
        for (int s = 0; s < 4; ++s) { kf[s] = kn[s]; vf[s] = vn[s]; }
      }
      lsum += __shfl_xor(lsum, 32);
      if (valid) {
        if (hh == 0) atomicAdd(&lacc[qi], __float2int_rn(lsum * 1048576.0f));
#pragma unroll
        for (int r = 0; r < 16; ++r) {
          const int dim = (r & 3) + 8 * (r >> 2) + 4 * hh;
          atomicAdd(&Oacc[dim * OLD + qi], __float2int_rn(O0[r] * 1048576.0f));
          atomicAdd(&Oacc[(dim + 32) * OLD + qi], __float2int_rn(O1[r] * 1048576.0f));
        }
      }
    }
    __syncthreads();
    { const int q = tid >> 1, half = tid & 1;
      const float inv = 1.0f / (float)lacc[q];
      float o[32], ss = 0.f;
#pragma unroll
      for (int d = 0; d < 32; ++d) { o[d] = (float)Oacc[(half * 32 + d) * OLD + q] * inv; ss += o[d] * o[d]; }
      ss += __shfl_xor(ss, 1);
      const float r = rsqrtf(ss / 64.0f + EPS);
      float* dst = p.ybuf() + (size_t)(b * S + qblk * 256 + q) * D + 256 + h * 64 + half * 32;
#pragma unroll
      for (int d = 0; d < 32; d += 4) *(float4*)(dst + d) = make_float4(o[d] * r, o[d + 1] * r, o[d + 2] * r, o[d + 3] * r);
    }
  }
}


__device__ __forceinline__ float ret_log2g(int h) { return log2f(1.0f - exp2f(-5.0f - (float)h)); }
__device__ __forceinline__ void phase_pack_ret(const Params& p, int gtid, int ngt) {
  for (int idx = gtid; idx < T * 64; idx += ngt) {
    const int t = idx >> 6, c = idx & 63, isk = c >> 5, cc = c & 31, h = cc >> 3, ch = cc & 7;
    const int b = t / S, s = t % S, i = s & 127;
    const float* src = p.proj() + (size_t)t * INW + (isk ? OFF_KR : OFF_QR) + h * 64 + ch * 8;
    float4 a = *(const float4*)src, b4 = *(const float4*)(src + 4);
    const float sc = exp2f((isk ? -(float)i : (float)i) * ret_log2g(h));
    uint4 o; o.x = pk_bf16(a.x * sc, a.y * sc); o.y = pk_bf16(a.z * sc, a.w * sc); o.z = pk_bf16(b4.x * sc, b4.y * sc); o.w = pk_bf16(b4.z * sc, b4.w * sc);
    const int bh = b * 4 + h;
    bf16_t* dst = isk ? p.Kr() + ((((size_t)bh * (S / 32) + (s >> 5)) * 8 + ch) * 32 + (s & 31)) * 8
                      : p.Qr() + ((size_t)bh * S + s) * 64 + ch * 8;
    *(uint4*)dst = o;
  }
  for (int idx = gtid; idx < 2 * NB * 4 * (S / 32) * 256; idx += ngt) {
    const int ln = idx & 63, ks = (idx >> 6) & 1, blk = (idx >> 7) & 1, tile = (idx >> 8) % (S / 32), rest = idx / (256 * (S / 32)), bh = rest % (NB * 4), which = rest / (NB * 4);
    const int b = bh >> 2, h = bh & 3, hh = ln >> 5, delta = blk * 32 + (ln & 31);
    const float l2g = ret_log2g(h);
    float v[8];
#pragma unroll
    for (int j = 0; j < 8; ++j) {
      const int kappa = 16 * ks + 8 * (j >> 2) + 4 * hh + (j & 3), s = tile * 32 + kappa;
      float x = p.proj()[(size_t)(b * S + s) * INW + (which ? OFF_KR : OFF_VR) + h * 64 + delta];
      if (which) x *= exp2f(-(float)(s & 127) * l2g);
      v[j] = x;
    }
    uint4 o; o.x = pk_bf16(v[0], v[1]); o.y = pk_bf16(v[2], v[3]); o.z = pk_bf16(v[4], v[5]); o.w = pk_bf16(v[6], v[7]);
    *(uint4*)((which ? p.Krv() : p.Vr()) + ((size_t)(idx % (NB * 4 * (S / 32) * 256))) * 8) = o;
  }
}
__device__ __forceinline__ void phase_ret_kv(const Params& p, int gw, int ngw, int lane) {
  const int n = lane & 31, hh = lane >> 5;
  for (int w = gw; w < NB * 4 * 32; w += ngw) {
    const int bh = w >> 5, cn = w & 31;
    const bf16_t* vt = p.Vr() + ((size_t)bh * (S / 32) + cn * 4) * 2048 + lane * 8;
    const bf16_t* kt = p.Krv() + ((size_t)bh * (S / 32) + cn * 4) * 2048 + lane * 8;
    f32x16 acc[2][2];
#pragma unroll
    for (int a = 0; a < 2; ++a)
#pragma unroll
      for (int b2 = 0; b2 < 2; ++b2)
#pragma unroll
        for (int r = 0; r < 16; ++r) acc[a][b2][r] = 0.f;
#pragma unroll 1
    for (int tl = 0; tl < 4; ++tl)
#pragma unroll
      for (int ks = 0; ks < 2; ++ks) {
        bf16x8 vf[2], kf[2];
#pragma unroll
        for (int x = 0; x < 2; ++x) { vf[x] = *(const bf16x8*)(vt + tl * 2048 + (x * 2 + ks) * 512); kf[x] = *(const bf16x8*)(kt + tl * 2048 + (x * 2 + ks) * 512); }
#pragma unroll
        for (int mb = 0; mb < 2; ++mb)
#pragma unroll
          for (int nb = 0; nb < 2; ++nb) acc[mb][nb] = __builtin_amdgcn_mfma_f32_32x32x16_bf16(vf[mb], kf[nb], acc[mb][nb], 0, 0, 0);
      }
    float* dst = p.KVr() + ((size_t)bh * 32 + cn) * 4096;
#pragma unroll
    for (int mb = 0; mb < 2; ++mb)
#pragma unroll
      for (int nb = 0; nb < 2; ++nb)
#pragma unroll
        for (int r = 0; r < 16; ++r) dst[(mb * 32 + (r & 3) + 8 * (r >> 2) + 4 * hh) * 64 + nb * 32 + n] = acc[mb][nb][r];
  }
}
__device__ __forceinline__ void phase_ret_scan(const Params& p, int gtid, int ngt) {
  for (int it = gtid; it < NB * 4 * 4096; it += ngt) {
    const int e = it & 4095, bh = it >> 12, h = bh & 3;
    const float l2g = ret_log2g(h), g1 = exp2f(l2g), g127 = exp2f(127.0f * l2g), g128 = exp2f(128.0f * l2g);
    float R = 0.f;
    for (int cn = 0; cn < 32; ++cn) {
      const size_t o = ((size_t)bh * 32 + cn) * 4096 + e;
      p.Rb()[o] = f2bf(g1 * R);
      R = g128 * R + g127 * p.KVr()[o];
    }
  }
}
__device__ __forceinline__ void phase_ret_out(const Params& p, int gw, int ngw, int lane) {
  const int n = lane & 31, hh = lane >> 5;
  for (int w = gw; w < NB * 4 * 32 * 4; w += ngw) {
    const int qg = 3 - (w & 3), cn = (w >> 2) & 31, bh = w >> 7, b = bh >> 2, h = bh & 3;
    const int s0 = cn * 128 + qg * 32;
    bf16x8 qf[4];
#pragma unroll
    for (int s = 0; s < 4; ++s) qf[s] = *(const bf16x8*)(p.Qr() + ((size_t)bh * S + s0 + n) * 64 + (2 * s + hh) * 8);
    f32x16 O0, O1;
#pragma unroll
    for (int r = 0; r < 16; ++r) { O0[r] = 0.f; O1[r] = 0.f; }
    { const bf16_t* rb = p.Rb() + ((size_t)bh * 32 + cn) * 4096 + (size_t)n * 64 + hh * 8;
#pragma unroll
      for (int s = 0; s < 4; ++s) {
        const bf16x8 r0 = *(const bf16x8*)(rb + s * 16), r1 = *(const bf16x8*)(rb + 32 * 64 + s * 16);
        O0 = __builtin_amdgcn_mfma_f32_32x32x16_bf16(r0, qf[s], O0, 0, 0, 0);
        O1 = __builtin_amdgcn_mfma_f32_32x32x16_bf16(r1, qf[s], O1, 0, 0, 0);
      } }
    const bf16_t* kt0 = p.Kr() + ((size_t)bh * (S / 32) + cn * 4) * 2048 + lane * 8;
    const bf16_t* vt0 = p.Vr() + ((size_t)bh * (S / 32) + cn * 4) * 2048 + lane * 8;
    for (int kt = 0; kt <= qg; ++kt) {
      bf16x8 kf[4], vf[4];
#pragma unroll
      for (int s = 0; s < 4; ++s) { kf[s] = *(const bf16x8*)(kt0 + (size_t)kt * 2048 + s * 512); vf[s] = *(const bf16x8*)(vt0 + (size_t)kt * 2048 + s * 512); }
      f32x16 X;
#pragma unroll
      for (int r = 0; r < 16; ++r) X[r] = 0.f;
#pragma unroll
      for (int s = 0; s < 4; ++s) X = __builtin_amdgcn_mfma_f32_32x32x16_bf16(kf[s], qf[s], X, 0, 0, 0);
      const bool diag = (kt == qg);
      unsigned pw[8];
#pragma unroll
      for (int r = 0; r < 16; r += 2) {
        float e0 = X[r], e1 = X[r + 1];
        if (diag) {
          const int k0 = (r & 3) + 8 * (r >> 2) + 4 * hh, k1 = ((r + 1) & 3) + 8 * ((r + 1) >> 2) + 4 * hh;
          e0 = (k0 <= n) ? e0 : 0.f; e1 = (k1 <= n) ? e1 : 0.f;
        }
        pw[r >> 1] = pk_bf16(e0, e1);
      }
      bf16x8 pf0, pf1;
      { uint4 t0 = make_uint4(pw[0], pw[1], pw[2], pw[3]), t1 = make_uint4(pw[4], pw[5], pw[6], pw[7]);
        pf0 = *(bf16x8*)&t0; pf1 = *(bf16x8*)&t1; }
      O0 = __builtin_amdgcn_mfma_f32_32x32x16_bf16(vf[0], pf0, O0, 0, 0, 0);
      O0 = __builtin_amdgcn_mfma_f32_32x32x16_bf16(vf[1], pf1, O0, 0, 0, 0);
      O1 = __builtin_amdgcn_mfma_f32_32x32x16_bf16(vf[2], pf0, O1, 0, 0, 0);
      O1 = __builtin_amdgcn_mfma_f32_32x32x16_bf16(vf[3], pf1, O1, 0, 0, 0);
    }
    float ss = 0.f;
#pragma unroll
    for (int r = 0; r < 16; ++r) ss += O0[r] * O0[r] + O1[r] * O1[r];
    ss += __shfl_xor(ss, 32);
    const float rn = rsqrtf(ss / 64.0f + EPS);
    const size_t t = (size_t)b * S + s0 + n;
    const float* gp = p.proj() + t * INW + OFF_GR + h * 64;
    float* yo = p.ybuf() + t * D + 768 + h * 64;
#pragma unroll
    for (int q4 = 0; q4 < 4; ++q4) {
#pragma unroll
      for (int mb = 0; mb < 2; ++mb) {
        const int d0 = mb * 32 + 8 * q4 + 4 * hh;
        const float4 g = *(const float4*)(gp + d0);
        float4 o;
        const f32x16& Oa = mb ? O1 : O0;
        o.x = Oa[q4 * 4 + 0] * rn * g.x * fast_sigmoid(g.x); o.y = Oa[q4 * 4 + 1] * rn * g.y * fast_sigmoid(g.y);
        o.z = Oa[q4 * 4 + 2] * rn * g.z * fast_sigmoid(g.z); o.w = Oa[q4 * 4 + 3] * rn * g.w * fast_sigmoid(g.w);
        *(float4*)(yo + d0) = o;
      }
    }
  }
}

__device__ __forceinline__ void cvt_f32_bf16(const float* __restrict__ src, bf16_t* __restrict__ dst, size_t n8, int gtid, int ngt) {
  for (size_t i = gtid; i < n8; i += ngt) {
    float4 a = *(const float4*)(src + i * 8), b4 = *(const float4*)(src + i * 8 + 4);
    uint4 o; o.x = pk_bf16(a.x, a.y); o.y = pk_bf16(a.z, a.w); o.z = pk_bf16(b4.x, b4.y); o.w = pk_bf16(b4.z, b4.w);
    *(uint4*)(dst + i * 8) = o;
  }
}
__device__ __forceinline__ int f2key(float f) { int b = __float_as_int(f); return b ^ ((b >> 31) & 0x7fffffff); }
__device__ __forceinline__ float key2f(int k) { return __int_as_float(k ^ ((k >> 31) & 0x7fffffff)); }
#define CASD(a_, b_) { int mx_ = max(a_, b_), mn_ = min(a_, b_); a_ = mx_; b_ = mn_; }
__device__ __forceinline__ void sort16_desc(int (&v)[16]) {
#pragma unroll
  for (int k = 2; k <= 16; k <<= 1)
#pragma unroll
    for (int j = k >> 1; j > 0; j >>= 1)
#pragma unroll
      for (int i = 0; i < 16; ++i) { const int l2 = i ^ j; if (l2 > i) { if ((i & k) == 0) CASD(v[i], v[l2]) else CASD(v[l2], v[i]) } }
}
__device__ __forceinline__ void merge_top16(int (&a)[16], const int (&b)[16]) {
#pragma unroll
  for (int i = 0; i < 16; ++i) a[i] = max(a[i], b[15 - i]);
#pragma unroll
  for (int j = 8; j > 0; j >>= 1)
#pragma unroll
    for (int i = 0; i < 16; ++i) { const int l2 = i ^ j; if (l2 > i) CASD(a[i], a[l2]) }
}
__device__ __forceinline__ int lut4(int w0, int w1, int w2, int w3, int i) {
  const int w = i >> 2; const int d = (w == 0) ? w0 : (w == 1) ? w1 : (w == 2) ? w2 : w3;
  return (d >> ((i & 3) * 8)) & 127;
}

__device__ __forceinline__ void phase_peer_topk(const Params& p, int l, int gw, int ngw, int lane) {
  const int n = lane & 31, hh = lane >> 5;
  const bf16_t* skl = p.skb() + (size_t)l * 16 * 128 * 64;
  for (int w = gw; w < (T / 32) * 8; w += ngw) {
    const int tg = w >> 3, h = w & 7, t = tg * 32 + n;
    int L0[16], L1[16];
#pragma unroll
    for (int c = 0; c < 2; ++c) {
      const int hc = 2 * h + c;
      bf16x8 qf[4];
#pragma unroll
      for (int s = 0; s < 4; ++s) qf[s] = *(const bf16x8*)(p.qb() + (size_t)t * D + hc * 64 + 16 * s + 8 * hh);
      int A[16], Bq[16];
#pragma unroll
      for (int mb = 0; mb < 4; ++mb) {
        f32x16 X;
#pragma unroll
        for (int r = 0; r < 16; ++r) X[r] = 0.f;
#pragma unroll
        for (int s = 0; s < 4; ++s) {
          const bf16x8 kf = *(const bf16x8*)(skl + ((size_t)(hc * 128 + mb * 32 + n)) * 64 + 16 * s + 8 * hh);
          X = __builtin_amdgcn_mfma_f32_32x32x16_bf16(kf, qf[s], X, 0, 0, 0);
        }
        int Gk[16];
#pragma unroll
        for (int r = 0; r < 16; ++r) Gk[r] = (f2key(X[r]) & ~127) | (mb * 32 + (r & 3) + 8 * (r >> 2) + 4 * hh);
        sort16_desc(Gk);
        if (mb == 0) {
#pragma unroll
          for (int r = 0; r < 16; ++r) A[r] = Gk[r];
        } else merge_top16(A, Gk);
      }
#pragma unroll
      for (int r = 0; r < 16; ++r) Bq[r] = __shfl_xor(A[r], 32);
      merge_top16(A, Bq);
#pragma unroll
      for (int r = 0; r < 16; ++r) { if (c == 0) L0[r] = A[r]; else L1[r] = A[r]; }
    }
    float av[16], bv[16];
#pragma unroll
    for (int r = 0; r < 16; ++r) { av[r] = key2f(L0[r] & ~127); bv[r] = key2f(L1[r] & ~127); }
#define CAND(i_, j_) ((f2key(av[i_] + bv[j_]) & ~255) | ((i_) << 4) | (j_))
    int R[16], G1[16], G2[16];
#pragma unroll
    for (int j = 0; j < 16; ++j) R[j] = CAND(0, j);
    G1[0] = CAND(1, 0); G1[1] = CAND(1, 1); G1[2] = CAND(1, 2); G1[3] = CAND(1, 3); G1[4] = CAND(1, 4); G1[5] = CAND(1, 5); G1[6] = CAND(1, 6); G1[7] = CAND(1, 7);
    G1[8] = CAND(2, 0); G1[9] = CAND(2, 1); G1[10] = CAND(2, 2); G1[11] = CAND(2, 3); G1[12] = CAND(2, 4); G1[13] = CAND(3, 0); G1[14] = CAND(3, 1); G1[15] = CAND(3, 2);
    G2[0] = CAND(3, 3); G2[1] = CAND(4, 0); G2[2] = CAND(4, 1); G2[3] = CAND(4, 2); G2[4] = CAND(5, 0); G2[5] = CAND(5, 1); G2[6] = CAND(6, 0); G2[7] = CAND(6, 1);
    G2[8] = CAND(7, 0); G2[9] = CAND(7, 1); G2[10] = CAND(8, 0); G2[11] = CAND(9, 0); G2[12] = CAND(10, 0); G2[13] = CAND(11, 0); G2[14] = CAND(12, 0); G2[15] = CAND(13, 0);
    sort16_desc(G1); merge_top16(R, G1);
    sort16_desc(G2); merge_top16(R, G2);
    { int x0 = CAND(14, 0), x1 = CAND(15, 0);
#pragma unroll
      for (int i = 0; i < 16; ++i) CASD(R[i], x0)
#pragma unroll
      for (int i = 0; i < 16; ++i) CASD(R[i], x1)
    }
#undef CAND
    int pa0 = 0, pa1 = 0, pa2 = 0, pa3 = 0, pb0 = 0, pb1 = 0, pb2 = 0, pb3 = 0;
#pragma unroll
    for (int q = 0; q < 4; ++q) {
      pa0 |= (L0[q] & 127) << (8 * q); pa1 |= (L0[4 + q] & 127) << (8 * q); pa2 |= (L0[8 + q] & 127) << (8 * q); pa3 |= (L0[12 + q] & 127) << (8 * q);
      pb0 |= (L1[q] & 127) << (8 * q); pb1 |= (L1[4 + q] & 127) << (8 * q); pb2 |= (L1[8 + q] & 127) << (8 * q); pb3 |= (L1[12 + q] & 127) << (8 * q);
    }
    float ev[16], sum = 0.f; int ei[16];
    const float mx = key2f(R[0] & ~255);
#pragma unroll
    for (int z = 0; z < 16; ++z) {
      const float v = key2f(R[z] & ~255);
      ev[z] = __expf(v - mx); sum += ev[z];
      const int pay = R[z] & 255;
      ei[z] = lut4(pa0, pa1, pa2, pa3, pay >> 4) * 128 + lut4(pb0, pb1, pb2, pb3, pay & 15);
    }
    const float inv = 1.0f / sum;
    if (hh == 0) {
      float* go = p.gates() + ((size_t)t * 8 + h) * 16; int* eo = p.eidx() + ((size_t)t * 8 + h) * 16;
#pragma unroll
      for (int z = 0; z < 16; z += 4) {
        *(float4*)(go + z) = make_float4(ev[z] * inv, ev[z + 1] * inv, ev[z + 2] * inv, ev[z + 3] * inv);
        *(int4*)(eo + z) = make_int4(ei[z], ei[z + 1], ei[z + 2], ei[z + 3]);
      }
    }
  }
}

__device__ __forceinline__ void phase_peer_apply2(const Params& p, int l, float* coef, int gw, int ngw, int lane) {
  const float* g2 = p.in[16] + l * D;
  for (int t = gw; t < T; t += ngw) {
    const float r = p.rstd()[t];
    float hv[16];
#pragma unroll
    for (int i = 0; i < 2; ++i) {
      const float* xp = p.out + (size_t)t * D + i * 512 + lane * 8; const float* gp = g2 + i * 512 + lane * 8;
      float4 x0 = *(const float4*)xp, x1 = *(const float4*)(xp + 4), g0 = *(const float4*)gp, g1 = *(const float4*)(gp + 4);
      hv[i * 8 + 0] = x0.x * r * g0.x; hv[i * 8 + 1] = x0.y * r * g0.y; hv[i * 8 + 2] = x0.z * r * g0.z; hv[i * 8 + 3] = x0.w * r * g0.w;
      hv[i * 8 + 4] = x1.x * r * g1.x; hv[i * 8 + 5] = x1.y * r * g1.y; hv[i * 8 + 6] = x1.z * r * g1.z; hv[i * 8 + 7] = x1.w * r * g1.w;
    }
    const int e_lo = p.eidx()[(size_t)t * 128 + lane], e_hi = p.eidx()[(size_t)t * 128 + 64 + lane];
    const float g_lo = p.gates()[(size_t)t * 128 + lane], g_hi = p.gates()[(size_t)t * 128 + 64 + lane];
    LDS_FENCE();
#pragma unroll 1
    for (int half = 0; half < 2; ++half) {
      const int ev = half ? e_hi : e_lo;
      float mine = 0.f;
#pragma unroll 4
      for (int j = 0; j < 64; ++j) {
        const int e = __shfl(ev, j);
        const bf16_t* up = p.Ub() + (size_t)e * D + lane * 8;
        uint4 u0 = *(const uint4*)up, u1 = *(const uint4*)(up + 512);
        float d = 0.f;
        d = fmaf(hv[0], __uint_as_float(u0.x << 16), d); d = fmaf(hv[1], __uint_as_float(u0.x & 0xffff0000u), d);
        d = fmaf(hv[2], __uint_as_float(u0.y << 16), d); d = fmaf(hv[3], __uint_as_float(u0.y & 0xffff0000u), d);
        d = fmaf(hv[4], __uint_as_float(u0.z << 16), d); d = fmaf(hv[5], __uint_as_float(u0.z & 0xffff0000u), d);
        d = fmaf(hv[6], __uint_as_float(u0.w << 16), d); d = fmaf(hv[7], __uint_as_float(u0.w & 0xffff0000u), d);
        d = fmaf(hv[8], __uint_as_float(u1.x << 16), d); d = fmaf(hv[9], __uint_as_float(u1.x & 0xffff0000u), d);
        d = fmaf(hv[10], __uint_as_float(u1.y << 16), d); d = fmaf(hv[11], __uint_as_float(u1.y & 0xffff0000u), d);
        d = fmaf(hv[12], __uint_as_float(u1.z << 16), d); d = fmaf(hv[13], __uint_as_float(u1.z & 0xffff0000u), d);
        d = fmaf(hv[14], __uint_as_float(u1.w << 16), d); d = fmaf(hv[15], __uint_as_float(u1.w & 0xffff0000u), d);
        d = wave_sum(d);
        if (lane == j) mine = d;
      }
      coef[half * 64 + lane] = (half ? g_hi : g_lo) * gelu_tanh(mine);
    }
    LDS_FENCE();
    float acc[16];
#pragma unroll
    for (int i = 0; i < 16; ++i) acc[i] = 0.f;
#pragma unroll 1
    for (int half = 0; half < 2; ++half) {
      const int ev = half ? e_hi : e_lo;
#pragma unroll 4
      for (int j = 0; j < 64; ++j) {
        const int e = __shfl(ev, j);
        const float c = coef[half * 64 + j];
        const bf16_t* vp = p.Vb() + (size_t)e * D + lane * 8;
        uint4 v0 = *(const uint4*)vp, v1 = *(const uint4*)(vp + 512);
        acc[0] = fmaf(c, __uint_as_float(v0.x << 16), acc[0]); acc[1] = fmaf(c, __uint_as_float(v0.x & 0xffff0000u), acc[1]);
        acc[2] = fmaf(c, __uint_as_float(v0.y << 16), acc[2]); acc[3] = fmaf(c, __uint_as_float(v0.y & 0xffff0000u), acc[3]);
        acc[4] = fmaf(c, __uint_as_float(v0.z << 16), acc[4]); acc[5] = fmaf(c, __uint_as_float(v0.z & 0xffff0000u), acc[5]);
        acc[6] = fmaf(c, __uint_as_float(v0.w << 16), acc[6]); acc[7] = fmaf(c, __uint_as_float(v0.w & 0xffff0000u), acc[7]);
        acc[8] = fmaf(c, __uint_as_float(v1.x << 16), acc[8]); acc[9] = fmaf(c, __uint_as_float(v1.x & 0xffff0000u), acc[9]);
        acc[10] = fmaf(c, __uint_as_float(v1.y << 16), acc[10]); acc[11] = fmaf(c, __uint_as_float(v1.y & 0xffff0000u), acc[11]);
        acc[12] = fmaf(c, __uint_as_float(v1.z << 16), acc[12]); acc[13] = fmaf(c, __uint_as_float(v1.z & 0xffff0000u), acc[13]);
        acc[14] = fmaf(c, __uint_as_float(v1.w << 16), acc[14]); acc[15] = fmaf(c, __uint_as_float(v1.w & 0xffff0000u), acc[15]);
      }
    }
#pragma unroll
    for (int i = 0; i < 2; ++i) {
      float* xp = p.out + (size_t)t * D + i * 512 + lane * 8;
      float4 x0 = *(float4*)xp, x1 = *(float4*)(xp + 4);
      x0.x += acc[i * 8 + 0]; x0.y += acc[i * 8 + 1]; x0.z += acc[i * 8 + 2]; x0.w += acc[i * 8 + 3];
      x1.x += acc[i * 8 + 4]; x1.y += acc[i * 8 + 5]; x1.z += acc[i * 8 + 6]; x1.w += acc[i * 8 + 7];
      *(float4*)xp = x0; *(float4*)(xp + 4) = x1;
    }
  }
}

typedef int v8i __attribute__((ext_vector_type(8)));
__device__ __forceinline__ unsigned xcc_id() { return (unsigned)__builtin_amdgcn_s_getreg((3 << 11) | 20) & 7u; }
__device__ __forceinline__ float pow2_scale(float amax) {
  if (!(amax > 0.f)) return 1.0f;
  const int e = (int)floorf(log2f(240.0f / amax));
  return exp2f((float)(e < 60 ? (e > -60 ? e : -60) : 60));
}
__device__ __forceinline__ unsigned pack4_fp8(float a, float b, float c, float d) {
  int v = __builtin_amdgcn_cvt_pk_fp8_f32(a, b, 0, false);
  v = __builtin_amdgcn_cvt_pk_fp8_f32(c, d, v, true);
  return (unsigned)v;
}
__device__ __forceinline__ void cvt_table_fp8(const float* __restrict__ src, unsigned char* __restrict__ dst, float* __restrict__ scl, int gw, int ngw, int lane) {
  for (int e = gw; e < 16384; e += ngw) {
    float4 v[4]; float am = 0.f;
#pragma unroll
    for (int k = 0; k < 4; ++k) { v[k] = *(const float4*)(src + (size_t)e * D + k * 256 + lane * 4);
      am = fmaxf(am, fmaxf(fmaxf(fabsf(v[k].x), fabsf(v[k].y)), fmaxf(fabsf(v[k].z), fabsf(v[k].w)))); }
    am = wave_max(am);
    const float s = pow2_scale(am);
    if (lane == 0) scl[e] = s;
#pragma unroll
    for (int k = 0; k < 4; ++k) {
      const int slice = 2 * k + (lane >> 5), off = (lane & 31) * 4;
      *(unsigned*)(dst + ((size_t)slice * 16384 + e) * 128 + off) = pack4_fp8(v[k].x * s, v[k].y * s, v[k].z * s, v[k].w * s);
    }
  }
}
__device__ __forceinline__ void phase_cvt_rows_h8(const Params& p, int l, int gw, int ngw, int lane) {
  const float* g2 = p.in[16] + l * D;
  for (int t = gw; t < T; t += ngw) {
    float4 v[4]; float ss = 0.f;
#pragma unroll
    for (int k = 0; k < 4; ++k) {
      v[k] = *(const float4*)(p.out + (size_t)t * D + k * 256 + lane * 4);
      ss += v[k].x * v[k].x + v[k].y * v[k].y + v[k].z * v[k].z + v[k].w * v[k].w;
      uint2 ph; ph.x = pk_bf16(v[k].x, v[k].y); ph.y = pk_bf16(v[k].z, v[k].w);
      bf16_t* d = p.xb() + (size_t)t * KD + k * 256 + lane * 4;
      *(uint2*)d = ph;
      if (PRECISE) {
        uint2 pl; pl.x = pk_bf16(v[k].x - __uint_as_float(ph.x << 16), v[k].y - __uint_as_float(ph.x & 0xffff0000u));
        pl.y = pk_bf16(v[k].z - __uint_as_float(ph.y << 16), v[k].w - __uint_as_float(ph.y & 0xffff0000u));
        *(uint2*)(d + D) = ph; *(uint2*)(d + 2 * D) = pl;
      }
    }
    ss = wave_sum(ss);
    const float r = rsqrtf(ss / (float)D + EPS);
    if (lane == 0) p.rstd()[t] = r;
    float am = 0.f;
#pragma unroll
    for (int k = 0; k < 4; ++k) {
      const float4 g = *(const float4*)(g2 + k * 256 + lane * 4);
      v[k].x *= r * g.x; v[k].y *= r * g.y; v[k].z *= r * g.z; v[k].w *= r * g.w;
      am = fmaxf(am, fmaxf(fmaxf(fabsf(v[k].x), fabsf(v[k].y)), fmaxf(fabsf(v[k].z), fabsf(v[k].w))));
    }
    am = wave_max(am);
    const float s = pow2_scale(am);
    if (lane == 0) p.sh()[t] = s;
#pragma unroll
    for (int k = 0; k < 4; ++k) {
      const int slice = 2 * k + (lane >> 5), off = (lane & 31) * 4;
      const float a0 = v[k].x * s, a1 = v[k].y * s, a2 = v[k].z * s, a3 = v[k].w * s;
      const unsigned hi = pack4_fp8(a0, a1, a2, a3);
      const auto f01 = __builtin_amdgcn_cvt_pk_f32_fp8((int)hi, false); const auto f23 = __builtin_amdgcn_cvt_pk_f32_fp8((int)hi, true);
      const unsigned lo = pack4_fp8((a0 - f01[0]) * 16.0f, (a1 - f01[1]) * 16.0f, (a2 - f23[0]) * 16.0f, (a3 - f23[1]) * 16.0f);
      *(unsigned*)(p.h8hi() + ((size_t)slice * T + t) * 128 + off) = hi;
      *(unsigned*)(p.h8lo() + ((size_t)slice * T + t) * 128 + off) = lo;
    }
  }
}
__device__ __forceinline__ int q_pull(int* head, int nitems, int* bc, int tid) {
  __syncthreads();
  if (tid == 0) bc[0] = atomicAdd(head, 1);
  __syncthreads();
  const int v = bc[0];
  return v < nitems ? v : -1;
}
__device__ __forceinline__ void phase_peer_u(const Params& p, int* heads, unsigned char* lds, int tid) {
  const int lane = tid & 63, wv = tid >> 6, i16 = lane & 15, kg = lane >> 4;
  int* bc = (int*)lds;
  int* eW = (int*)(lds + 1024 + wv * 4096);
  const int myx = (int)xcc_id();
  for (int pass = 0; pass < 8; ++pass) {
    const int s = (myx + pass) & 7;
    const unsigned char* Us = p.U8s() + (size_t)s * 16384 * 128 + kg * 32;
    for (;;) {
      const int item = q_pull(heads + s, T / 64, bc, tid);
      if (item < 0) break;
      const int t0 = item * 64 + wv * 8;
      LDS_FENCE();
#pragma unroll
      for (int k = 0; k < 8; ++k) *(uint2*)(eW + k * 128 + lane * 2) = *(const uint2*)(p.eidx() + (size_t)(t0 + k) * 128 + lane * 2);
      LDS_FENCE();
      v8i A[2][8], Bh[2], Bl[2];
      { const unsigned char* hb = p.h8hi() + ((size_t)s * T + t0) * 128 + kg * 32; const unsigned char* lb = p.h8lo() + ((size_t)s * T + t0) * 128 + kg * 32;
        Bh[0] = *(const v8i*)hb; Bl[0] = *(const v8i*)lb;
#pragma unroll
        for (int eb = 0; eb < 8; ++eb) A[0][eb] = *(const v8i*)(Us + (size_t)eW[eb * 16 + i16] * 128); }
#define PEER_U_STEP(K_, CUR_, NXT_, HASNEXT_)                                                                                         \
      {                                                                                                                                   \
        if (HASNEXT_) {                                                                                                                   \
          const int t1 = t0 + (K_) + 1;                                                                                                    \
          Bh[NXT_] = *(const v8i*)(p.h8hi() + ((size_t)s * T + t1) * 128 + kg * 32); Bl[NXT_] = *(const v8i*)(p.h8lo() + ((size_t)s * T + t1) * 128 + kg * 32); \
          _Pragma("unroll") for (int eb = 0; eb < 8; ++eb) A[NXT_][eb] = *(const v8i*)(Us + (size_t)eW[((K_) + 1) * 128 + eb * 16 + i16] * 128);  \
        }                                                                                                                                 \
        float* po = p.ppart() + ((size_t)s * T + t0 + (K_)) * 128 + kg * 4;                                                                \
        _Pragma("unroll") for (int eb = 0; eb < 8; ++eb) {                                                                                \
          pg8::f32x4 ch = {0.f, 0.f, 0.f, 0.f}, cl = {0.f, 0.f, 0.f, 0.f};                                                                 \
          ch = __builtin_amdgcn_mfma_scale_f32_16x16x128_f8f6f4(A[CUR_][eb], Bh[CUR_], ch, 0, 0, 0, 127, 0, 127);                           \
          cl = __builtin_amdgcn_mfma_scale_f32_16x16x128_f8f6f4(A[CUR_][eb], Bl[CUR_], cl, 0, 0, 0, 127, 0, 127);                           \
          if (i16 == 0) *(pg8::f32x4*)(po + eb * 16) = ch + cl * 0.0625f;                                                                  \
        }                                                                                                                                 \
      }
#pragma unroll 1
      for (int kk = 0; kk < 4; ++kk) {
        PEER_U_STEP(2 * kk, 0, 1, true)
        PEER_U_STEP(2 * kk + 1, 1, 0, kk < 3)
      }
#undef PEER_U_STEP
    }
  }
}
__device__ __forceinline__ void phase_peer_r(const Params& p, int gtid, int ngt) {
  for (int idx = gtid; idx < T * 128; idx += ngt) {
    const int t = idx >> 7;
    float d = 0.f;
#pragma unroll
    for (int s = 0; s < 8; ++s) d += p.ppart()[(size_t)s * T * 128 + idx];
    const int e = p.eidx()[idx];
    d = d / (p.su()[e] * p.sh()[t]);
    p.gates()[idx] = p.gates()[idx] * gelu_tanh(d) / p.sv()[e];
  }
}
__device__ __forceinline__ void phase_peer_v(const Params& p, int* heads, unsigned char* lds, int tid) {
  const int lane = tid & 63, wv = tid >> 6, r8 = lane >> 3, c8 = lane & 7;
  int* bc = (int*)lds;
  uint2* pW = (uint2*)(lds + 1024 + wv * 8192);
  const int myx = (int)xcc_id();
  for (int pass = 0; pass < 8; ++pass) {
    const int s = (myx + pass) & 7;
    const unsigned char* Vs = p.V8s() + (size_t)s * 16384 * 128 + c8 * 16;
    for (;;) {
      const int item = q_pull(heads + s, T / 64, bc, tid);
      if (item < 0) break;
      const int t0 = item * 64 + wv * 8;
      LDS_FENCE();
#pragma unroll
      for (int k = 0; k < 8; ++k) {
        const uint2 e2 = *(const uint2*)(p.eidx() + (size_t)(t0 + k) * 128 + lane * 2);
        const uint2 g2 = *(const uint2*)(p.gates() + (size_t)(t0 + k) * 128 + lane * 2);
        *(uint4*)(pW + k * 128 + lane * 2) = make_uint4(e2.x, g2.x, e2.y, g2.y);
      }
      LDS_FENCE();
      uint4 R[2][8];
#pragma unroll
      for (int eb = 0; eb < 8; ++eb) R[0][eb] = *(const uint4*)(Vs + (size_t)pW[eb * 8 + r8].x * 128);
      float acc[16];
      const int xoff = s * 128 + c8 * 16 + (r8 & 3) * 4;
      float4 xo = *(const float4*)(p.out + (size_t)t0 * D + xoff);
#define PEER_V_HALF(M_, CUR_, NXT_, HASNEXT_)                                                                  \
      {                                                                                                                                   \
        if (HASNEXT_) {                                                                                                                   \
          _Pragma("unroll") for (int eb = 0; eb < 8; ++eb) R[NXT_][eb] = *(const uint4*)(Vs + (size_t)pW[((M_) + 1) * 64 + eb * 8 + r8].x * 128); \
        }                                                                                                                                 \
        if ((CUR_) == 0) { _Pragma("unroll") for (int z = 0; z < 16; ++z) acc[z] = 0.f; }                                                 \
        _Pragma("unroll") for (int eb = 0; eb < 8; ++eb) {                                                                                \
          const float c = __uint_as_float(pW[(M_) * 64 + eb * 8 + r8].y);                                                                 \
          const unsigned ww[4] = {R[CUR_][eb].x, R[CUR_][eb].y, R[CUR_][eb].z, R[CUR_][eb].w};                                            \
          _Pragma("unroll") for (int q4 = 0; q4 < 4; ++q4) {                                                                              \
            const auto f01 = __builtin_amdgcn_cvt_pk_f32_fp8((int)ww[q4], false); const auto f23 = __builtin_amdgcn_cvt_pk_f32_fp8((int)ww[q4], true); \
            acc[q4 * 4 + 0] = fmaf(c, f01[0], acc[q4 * 4 + 0]); acc[q4 * 4 + 1] = fmaf(c, f01[1], acc[q4 * 4 + 1]);                       \
            acc[q4 * 4 + 2] = fmaf(c, f23[0], acc[q4 * 4 + 2]); acc[q4 * 4 + 3] = fmaf(c, f23[1], acc[q4 * 4 + 3]);                       \
          }                                                                                                                               \
        }                                                                                                                                 \
        if ((CUR_) == 1) {                                                                                                                \
          _Pragma("unroll") for (int z = 0; z < 16; ++z) { acc[z] += __shfl_xor(acc[z], 8); acc[z] += __shfl_xor(acc[z], 16); acc[z] += __shfl_xor(acc[z], 32); } \
          const int sel = r8 & 3;                                                                                                         \
          float4 dl;                                                                                                                      \
          dl.x = sel == 0 ? acc[0] : sel == 1 ? acc[4] : sel == 2 ? acc[8] : acc[12];                                                     \
          dl.y = sel == 0 ? acc[1] : sel == 1 ? acc[5] : sel == 2 ? acc[9] : acc[13];                                                     \
          dl.z = sel == 0 ? acc[2] : sel == 1 ? acc[6] : sel == 2 ? acc[10] : acc[14];                                                    \
          dl.w = sel == 0 ? acc[3] : sel == 1 ? acc[7] : sel == 2 ? acc[11] : acc[15];                                                    \
          float* xp = p.out + (size_t)(t0 + ((M_) >> 1)) * D + xoff;                                                                      \
          if (r8 < 4) *(float4*)xp = make_float4(xo.x + dl.x, xo.y + dl.y, xo.z + dl.z, xo.w + dl.w);                                     \
          if (HASNEXT_) xo = *(const float4*)(xp + D);                                                                                    \
        }                                                                                                                                 \
      }
#pragma unroll 1
      for (int k = 0; k < 8; ++k) {
        PEER_V_HALF(2 * k, 0, 1, true)
        PEER_V_HALF(2 * k + 1, 1, 0, k < 7)
      }
#undef PEER_V_HALF
    }
  }
}

#if PEER_CHECK
constexpr int CHK_N = 512;
__device__ __forceinline__ float* chk_x(const Params& p) { return (float*)(p.ws + WO_ybuf); }
__device__ __forceinline__ float* chk_m(const Params& p) { return (float*)(p.ws + WO_ybuf + (size_t)CHK_N * D * 4); }
__device__ __forceinline__ float* chk_g(const Params& p) { return (float*)(p.ws + WO_ybuf + (size_t)CHK_N * D * 4 + 4096); }
__device__ __forceinline__ void chk_save(const Params& p, int gtid, int ngt) {
  for (int i = gtid; i < CHK_N * D; i += ngt) chk_x(p)[i] = p.out[(size_t)(i / D) * 64 * D + (i % D)];
  for (int i = gtid; i < CHK_N * 128; i += ngt) chk_g(p)[i] = p.gates()[(size_t)(i / 128) * 64 * 128 + (i % 128)];
  if (gtid < 16) chk_m(p)[gtid] = 0.f;
}
__device__ __forceinline__ void chk_apply(const Params& p, int l, float* coef, int gw, int ngw, int lane) {
  const float* g2 = p.in[16] + l * D;
  const float* U = p.in[19] + (size_t)l * 16384 * D; const float* V = p.in[20] + (size_t)l * 16384 * D;
  for (int i = gw; i < CHK_N; i += ngw) {
    const int t = i * 64;
    const float r = p.rstd()[t];
    float4 hv[4];
#pragma unroll
    for (int k = 0; k < 4; ++k) {
      float4 xv = *(const float4*)(chk_x(p) + (size_t)i * D + (lane + k * 64) * 4);
      float4 gv = *(const float4*)(g2 + (lane + k * 64) * 4);
      hv[k].x = xv.x * r * gv.x; hv[k].y = xv.y * r * gv.y; hv[k].z = xv.z * r * gv.z; hv[k].w = xv.w * r * gv.w;
    }
    LDS_FENCE();
    for (int j = 0; j < 128; ++j) {
      const int e = p.eidx()[(size_t)t * 128 + j];
      const float4* up = (const float4*)(U + (size_t)e * D);
      float dsum = 0.f;
#pragma unroll
      for (int k = 0; k < 4; ++k) { float4 uv = up[lane + k * 64]; dsum += hv[k].x * uv.x + hv[k].y * uv.y + hv[k].z * uv.z + hv[k].w * uv.w; }
      dsum = wave_sum(dsum);
      if (lane == 0) coef[j] = chk_g(p)[(size_t)i * 128 + j] * gelu_tanh(dsum);
    }
    LDS_FENCE();
    float4 acc[4];
#pragma unroll
    for (int k = 0; k < 4; ++k) acc[k] = make_float4(0.f, 0.f, 0.f, 0.f);
    for (int j = 0; j < 128; ++j) {
      const int e = p.eidx()[(size_t)t * 128 + j];
      const float c = coef[j];
      const float4* vp = (const float4*)(V + (size_t)e * D);
#pragma unroll
      for (int k = 0; k < 4; ++k) { float4 vv = vp[lane + k * 64]; acc[k].x = fmaf(c, vv.x, acc[k].x); acc[k].y = fmaf(c, vv.y, acc[k].y); acc[k].z = fmaf(c, vv.z, acc[k].z); acc[k].w = fmaf(c, vv.w, acc[k].w); }
    }
    float d2 = 0.f, r2 = 0.f;
#pragma unroll
    for (int k = 0; k < 4; ++k) {
      float4 xa = *(const float4*)(p.out + (size_t)t * D + (lane + k * 64) * 4);
      float4 xb4 = *(const float4*)(chk_x(p) + (size_t)i * D + (lane + k * 64) * 4);
      float e0 = (xa.x - xb4.x) - acc[k].x, e1 = (xa.y - xb4.y) - acc[k].y, e2 = (xa.z - xb4.z) - acc[k].z, e3 = (xa.w - xb4.w) - acc[k].w;
      d2 += e0 * e0 + e1 * e1 + e2 * e2 + e3 * e3;
      r2 += acc[k].x * acc[k].x + acc[k].y * acc[k].y + acc[k].z * acc[k].z + acc[k].w * acc[k].w;
    }
    d2 = wave_sum(d2); r2 = wave_sum(r2);
    if (lane == 0) { atomicAdd((unsigned long long*)&chk_m(p)[8], (unsigned long long)(d2 * 1099511627776.0f)); atomicAdd((unsigned long long*)&chk_m(p)[10], (unsigned long long)(r2 * 1099511627776.0f)); }
  }
}
__device__ __forceinline__ void chk_topk(const Params& p, int l, int gtid, int ngt) {
  const float* subk = p.in[18] + (size_t)l * 16 * 128 * 64;
  for (int it = gtid; it < CHK_N * 8; it += ngt) {
    const int i = it >> 3, h = it & 7, t = i * 64;
    float tva[16], tvb[16]; int tia[16], tib[16];
#pragma unroll 1
    for (int c = 0; c < 2; ++c) {
      float tv[16]; int ti[16];
#pragma unroll
      for (int z = 0; z < 16; ++z) { tv[z] = -INFINITY; ti[z] = 0; }
      const bf16_t* q = p.qb() + (size_t)t * D + (2 * h + c) * 64;
      const float* kb = subk + (size_t)(2 * h + c) * 128 * 64;
#pragma unroll 1
      for (int n = 0; n < 128; ++n) {
        float sc = 0.f;
        for (int d = 0; d < 64; ++d) sc = fmaf(bf2f(q[d]), kb[n * 64 + d], sc);
        float v_ = sc; int i_ = n;
#pragma unroll
        for (int z = 0; z < 16; ++z) { bool gt = v_ > tv[z]; float a = tv[z]; int b = ti[z]; tv[z] = gt ? v_ : a; ti[z] = gt ? i_ : b; v_ = gt ? a : v_; i_ = gt ? b : i_; }
      }
#pragma unroll
      for (int z = 0; z < 16; ++z) { if (c == 0) { tva[z] = tv[z]; tia[z] = ti[z]; } else { tvb[z] = tv[z]; tib[z] = ti[z]; } }
    }
    float tv[16]; int ti[16];
#pragma unroll
    for (int z = 0; z < 16; ++z) { tv[z] = -INFINITY; ti[z] = 0; }
#pragma unroll 1
    for (int a = 0; a < 16; ++a)
#pragma unroll 1
      for (int b = 0; b < 16; ++b) {
        float av = 0.f, bv = 0.f; int ai = 0, bi = 0;
#pragma unroll
        for (int z = 0; z < 16; ++z) { if (z == a) { av = tva[z]; ai = tia[z]; } if (z == b) { bv = tvb[z]; bi = tib[z]; } }
        float v_ = av + bv; int i_ = ai * 128 + bi;
#pragma unroll
        for (int z = 0; z < 16; ++z) { bool gt = v_ > tv[z]; float x = tv[z]; int y = ti[z]; tv[z] = gt ? v_ : x; ti[z] = gt ? i_ : y; v_ = gt ? x : v_; i_ = gt ? y : i_; }
      }
    float sum = 0.f, ev[16];
#pragma unroll
    for (int z = 0; z < 16; ++z) { ev[z] = expf(tv[z] - tv[0]); sum += ev[z]; }
    int miss = 0; float gerr = 0.f;
    for (int z = 0; z < 16; ++z) {
      const int ef = p.eidx()[((size_t)t * 8 + h) * 16 + z]; const float gf = p.gates()[((size_t)t * 8 + h) * 16 + z];
      bool found = false;
#pragma unroll
      for (int y = 0; y < 16; ++y) if (ti[y] == ef) { found = true; gerr = fmaxf(gerr, fabsf(ev[y] / sum - gf)); }
      if (!found) ++miss;
    }
    atomicAdd(&chk_m(p)[3], (float)miss);
    atomicMax((int*)&chk_m(p)[4], __float_as_int(gerr));
  }
}
__device__ __forceinline__ void chk_emit(const Params& p) {
  float v = 0.f;
  if (PEER_CHECK == 1) v = sqrtf((float)((double)*(unsigned long long*)&chk_m(p)[8] / (double)*(unsigned long long*)&chk_m(p)[10]));
  if (PEER_CHECK == 2) v = chk_m(p)[3] / (float)(CHK_N * 8 * 16);
  if (PEER_CHECK == 3) v = chk_m(p)[4];
  p.out[0] += 1.0e4f * v + 100.0f;
}
#endif

#define XB_TMO      128
#define XB_XCNT(j)  (256  + 64 * (j))
#define XB_XSUB(j)  (1280 + 64 * (j))
#define XB_XGEN(j)  (2304 + 64 * (j))
#define XB_TOP      3328
#define XB_TOPGEN   3392
#define XCD_BAR_WORDS 3456
#define XB_SPIN_CAP (1u << 18)
#define LAS __attribute__((address_space(3)))

__device__ __forceinline__ unsigned xb_ld(unsigned* p)              { return __hip_atomic_load(p, __ATOMIC_RELAXED, __HIP_MEMORY_SCOPE_AGENT); }
__device__ __forceinline__ unsigned xb_add(unsigned* p, unsigned v) { return __hip_atomic_fetch_add(p, v, __ATOMIC_RELAXED, __HIP_MEMORY_SCOPE_AGENT); }
__device__ __forceinline__ unsigned xb_xcc_id() { return (unsigned)__builtin_amdgcn_s_getreg((3 << 11) | 20) & 0xFu; }
#define XB_SPIN(cond, bar) do { unsigned _sp = 0; while (cond) { __builtin_amdgcn_s_sleep(1); \
    if ((++_sp & 255u) == 0u) { if (xb_ld(&(bar)[XB_TMO])) break; if (_sp > XB_SPIN_CAP) { atomicAdd(&(bar)[XB_TMO], 1u); break; } } } } while (0)

struct XcdBarrier {
    unsigned* bar; unsigned x;
    volatile LAS unsigned* st;
};

__device__ __forceinline__ XcdBarrier xcd_barrier_post(unsigned* bar, volatile LAS unsigned* st) {
    XcdBarrier b; b.bar = bar; b.x = xb_xcc_id(); b.st = st;
    if (threadIdx.x == 0) (void)xb_add(&bar[XB_XCNT(b.x)], 1u);
    return b;
}
__device__ __forceinline__ void xcd_barrier_complete(unsigned* bar, unsigned x, unsigned& nloc, unsigned& nx) {
    const unsigned G = gridDim.x * gridDim.y * gridDim.z;
    unsigned sum, cnt, mine, sp = 0u;
    for (;;) {
        sum = 0u; cnt = 0u; mine = 0u;
#pragma unroll
        for (unsigned j = 0; j < 16; ++j) { const unsigned c = xb_ld(&bar[XB_XCNT(j)]); sum += c; cnt += (c > 0u) ? 1u : 0u; mine = (j == x) ? c : mine; }
        if (sum == G) break;
        __builtin_amdgcn_s_sleep(1);
        if ((++sp & 255u) == 0u) { if (xb_ld(&bar[XB_TMO])) break; if (sp > XB_SPIN_CAP) { atomicAdd(&bar[XB_TMO], 1u); break; } }
    }
    nloc = mine > 0u ? mine : 1u; nx = cnt > 0u ? cnt : 1u;
}

__device__ __forceinline__ void xcd_barrier(const XcdBarrier& b) {
    asm volatile("s_waitcnt vmcnt(0)" ::: "memory");
    __syncthreads();
    if (threadIdx.x == 0) {
        unsigned* bar = b.bar;
        __builtin_amdgcn_s_waitcnt(0);
        unsigned nloc = b.st[0], nx = b.st[1];
        if (nloc == 0u) { xcd_barrier_complete(bar, b.x, nloc, nx); b.st[0] = nloc; b.st[1] = nx; }
        const unsigned old = xb_add(&bar[XB_XSUB(b.x)], 1u);
        const unsigned gen = old / nloc;
        if (old + 1u == (gen + 1u) * nloc) {
            __builtin_amdgcn_fence(__ATOMIC_RELEASE, "agent");
            asm volatile("s_waitcnt vmcnt(0)" ::: "memory");
            const unsigned og = xb_add(&bar[XB_TOP], 1u);
            const unsigned tg = og / nx;
            if (og + 1u == (tg + 1u) * nx) xb_add(&bar[XB_TOPGEN], 1u);
            else XB_SPIN(xb_ld(&bar[XB_TOPGEN]) == tg, bar);
            __builtin_amdgcn_fence(__ATOMIC_ACQUIRE, "agent");
            xb_add(&bar[XB_XGEN(b.x)], 1u);
            asm volatile("s_waitcnt vmcnt(0)" ::: "memory");
        } else {
            XB_SPIN(xb_ld(&bar[XB_XGEN(b.x)]) == gen, bar);
            __builtin_amdgcn_fence(__ATOMIC_ACQUIRE, "agent");
            asm volatile("s_waitcnt vmcnt(0)" ::: "memory");
        }
    }
    __syncthreads();
}

__device__ __forceinline__ Params fresh(const Params& p) {
  Params q = p;
  asm volatile("" : "+s"(q.ws), "+s"(q.out));
#pragma unroll
  for (int i = 0; i < 21; ++i) asm volatile("" : "+s"(q.in[i]));
  return q;
}
#define PHASE_IDS int tid = threadIdx.x; asm volatile("" : "+v"(tid)); int bid = blockIdx.x; asm volatile("" : "+s"(bid)); int G = gridDim.x; asm volatile("" : "+s"(G)); \
  const int lane = tid & 63, wv = tid >> 6; const int ngt = G * NTHR, ngw = G * NWAVE; \
  const int gtid = bid * NTHR + tid, gw = bid * NWAVE + wv; (void)lane; (void)wv; (void)gtid; (void)gw; (void)ngt; (void)ngw; \
  const Params q = fresh(p);
__global__ void __launch_bounds__(NTHR) mega(Params p) {
  extern __shared__ __attribute__((aligned(16))) unsigned char lds_raw[];
  cg::grid_group grid = cg::this_grid();
  float* ldsf = (float*)lds_raw;
  if (threadIdx.x == 0) { *(uint4*)(lds_raw + LDS_BYTES - 16) = make_uint4(0u, 0u, 0u, 0u); }
  __syncthreads();
  XcdBarrier xb = xcd_barrier_post(p.bar(), (volatile LAS unsigned*)(lds_raw + LDS_BYTES - 16));

  { PHASE_IDS; phase_prologue(q, gtid, ngt, gw, ngw, lane); cvt_f32_bf16(q.in[18], q.skb(), (size_t)NL * 16 * 128 * 64 / 8, gtid, ngt);
    for (size_t i = gtid; i < (size_t)16 * 256 * 512 / 8; i += ngt) ((uint4*)q.S5Wz())[i] = make_uint4(0u, 0u, 0u, 0u);
    if (gtid < 256) q.qctr()[gtid] = 0; }
  grid.sync();
  { constexpr int l = 0;
    DUP(6) {
    { PHASE_IDS; phase_cvt_rows(q.out, q.xb(), q.rstd(), gw, ngw, lane);
      phase_s5_prep(q, l, gtid, ngt);
 }
    xcd_barrier(xb);
    }
    DUP(5) {
    { const Params q = fresh(p); EpiScaleStore e{q.proj(), INW, q.rstd()};
      run_gemm(lds_raw, q.xb(), q.Win_t() + (size_t)l * INW * KD, T, INW, KD, e); }
    xcd_barrier(xb);
    }
    { PHASE_IDS; phase_postproj(q, l, gw, ngw, lane); }
    xcd_barrier(xb);
    DUP(0) {
    { PHASE_IDS; phase_kmean(q, gtid, ngt); phase_pack_moba(q, gtid, ngt); phase_pack_u(q, gtid, ngt); phase_pack_ret(q, gtid, ngt); }
    xcd_barrier(xb);
    }
    DUP(1) {
    { const Params q = fresh(p); EpiS5Z e{q.S5Z()};
      pg8::Gemm g{q.S5A(), q.S5Wz(), 16 * 1024, 16 * 256, 512, 640, 512}; pg8::GroupOrder So; So.init(16, 4, 1, (int)gridDim.x, (int)blockIdx.x);
      pg8::gemm_phase<EpiS5Z, pg8::GroupOrder, true, true>((PG8_LAS unsigned char*)lds_raw, g, So, e); }
    __syncthreads();
    { PHASE_IDS; phase_moba2(q, l, lds_raw, bid, G); }
    { PHASE_IDS; phase_ret_kv(q, gw, ngw, lane); }
    xcd_barrier(xb);
    }
    DUP(2) {
    { PHASE_IDS; phase_s5_scan(q, gtid, ngt); phase_ret_scan(q, gtid, ngt); }
    xcd_barrier(xb);
    }
    DUP(3) {
    { const Params q = fresh(p); EpiS5Y e{q.ygb(), q.S5A(), q.in[10] + l * 256};
      pg8::Gemm g{q.S5A(), q.S5Wy(), 16 * 1024, 16 * 512, 640, 640, 640}; pg8::GroupOrder So; So.init(16, 4, 2, (int)gridDim.x, (int)blockIdx.x);
      pg8::gemm_phase<EpiS5Y, pg8::GroupOrder, true, true>((PG8_LAS unsigned char*)lds_raw, g, So, e); }
    __syncthreads();
    { PHASE_IDS; phase_ret_out(q, gw, ngw, lane); }
    xcd_barrier(xb);
    }
    DUP(4) {
    { const Params q = fresh(p); EpiGlu e{q.ybuf(), q.ygb(), (float*)(lds_raw + 131072)};
      run_gemm(lds_raw, q.ygb(), q.Wglu_t() + (size_t)l * 65536, T, 256, 256, e); }
    xcd_barrier(xb);
    }
    DUP(9) {
    { PHASE_IDS; phase_cvt_rows(q.ybuf(), q.xb(), nullptr, gw, ngw, lane); }
    xcd_barrier(xb);
    }
    { const Params q = fresh(p); EpiAccum e{q.out, D};
      run_gemm(lds_raw, q.xb(), q.Wout_t() + (size_t)l * D * KD, T, D, KD, e); }
    xcd_barrier(xb);
    { PHASE_IDS; phase_cvt_rows_h8(q, l, gw, ngw, lane);
      cvt_table_fp8(q.in[19] + (size_t)l * 16384 * D, q.U8s(), q.su(), gw, ngw, lane);
      cvt_table_fp8(q.in[20] + (size_t)l * 16384 * D, q.V8s(), q.sv(), gw, ngw, lane); }
    xcd_barrier(xb);
    DUP(7) {
    { const Params q = fresh(p); EpiScaleStoreBf16 e{q.qb(), D, q.rstd()};
      run_gemm(lds_raw, q.xb(), q.Wq_t() + (size_t)l * D * KD, T, D, KD, e); }
    xcd_barrier(xb);
    }
    if (!(PROBE_SKIP & 2)) {
    { PHASE_IDS; phase_peer_topk(q, l, gw, ngw, lane); }
    xcd_barrier(xb);
    }
#if PEER_CHECK
    if (l == 0) { { PHASE_IDS; chk_save(q, gtid, ngt); } xcd_barrier(xb); { PHASE_IDS; chk_topk(q, l, gtid, ngt); } xcd_barrier(xb); }
#endif
    if (!(PROBE_SKIP & 1)) {
    { PHASE_IDS; phase_peer_u(q, q.qctr() + (l * 2 + 0) * 8, lds_raw, tid); }
    xcd_barrier(xb);
    { PHASE_IDS; phase_peer_r(q, gtid, ngt); }
    xcd_barrier(xb);
    if (!(PROBE_SKIP & 32)) {
    { PHASE_IDS; phase_peer_v(q, q.qctr() + (l * 2 + 1) * 8, lds_raw, tid); }
    xcd_barrier(xb);
    }
    }
#if PEER_CHECK
    if (l == 0) { { PHASE_IDS; chk_apply(q, l, ldsf + wv * 128, gw, ngw, lane); } xcd_barrier(xb);
      if (blockIdx.x == 0 && threadIdx.x == 0) { const Params q = fresh(p); chk_emit(q); } xcd_barrier(xb); }
#endif
  }
  { constexpr int l = 1;
    DUP(6) {
    { PHASE_IDS; phase_cvt_rows(q.out, q.xb(), q.rstd(), gw, ngw, lane);
      phase_s5_prep(q, l, gtid, ngt);
 }
    xcd_barrier(xb);
    }
    DUP(5) {
    { const Params q = fresh(p); EpiScaleStore e{q.proj(), INW, q.rstd()};
      run_gemm(lds_raw, q.xb(), q.Win_t() + (size_t)l * INW * KD, T, INW, KD, e); }
    xcd_barrier(xb);
    }
    { PHASE_IDS; phase_postproj(q, l, gw, ngw, lane); }
    xcd_barrier(xb);
    DUP(0) {
    { PHASE_IDS; phase_kmean(q, gtid, ngt); phase_pack_moba(q, gtid, ngt); phase_pack_u(q, gtid, ngt); phase_pack_ret(q, gtid, ngt); }
    xcd_barrier(xb);
    }
    DUP(1) {
    { const Params q = fresh(p); EpiS5Z e{q.S5Z()};
      pg8::Gemm g{q.S5A(), q.S5Wz(), 16 * 1024, 16 * 256, 512, 640, 512}; pg8::GroupOrder So; So.init(16, 4, 1, (int)gridDim.x, (int)blockIdx.x);
      pg8::gemm_phase<EpiS5Z, pg8::GroupOrder, true, true>((PG8_LAS unsigned char*)lds_raw, g, So, e); }
    __syncthreads();
    { PHASE_IDS; phase_moba2(q, l, lds_raw, bid, G); }
    { PHASE_IDS; phase_ret_kv(q, gw, ngw, lane); }
    xcd_barrier(xb);
    }
    DUP(2) {
    { PHASE_IDS; phase_s5_scan(q, gtid, ngt); phase_ret_scan(q, gtid, ngt); }
    xcd_barrier(xb);
    }
    DUP(3) {
    { const Params q = fresh(p); EpiS5Y e{q.ygb(), q.S5A(), q.in[10] + l * 256};
      pg8::Gemm g{q.S5A(), q.S5Wy(), 16 * 1024, 16 * 512, 640, 640, 640}; pg8::GroupOrder So; So.init(16, 4, 2, (int)gridDim.x, (int)blockIdx.x);
      pg8::gemm_phase<EpiS5Y, pg8::GroupOrder, true, true>((PG8_LAS unsigned char*)lds_raw, g, So, e); }
    __syncthreads();
    { PHASE_IDS; phase_ret_out(q, gw, ngw, lane); }
    xcd_barrier(xb);
    }
    DUP(4) {
    { const Params q = fresh(p); EpiGlu e{q.ybuf(), q.ygb(), (float*)(lds_raw + 131072)};
      run_gemm(lds_raw, q.ygb(), q.Wglu_t() + (size_t)l * 65536, T, 256, 256, e); }
    xcd_barrier(xb);
    }
    DUP(9) {
    { PHASE_IDS; phase_cvt_rows(q.ybuf(), q.xb(), nullptr, gw, ngw, lane); }
    xcd_barrier(xb);
    }
    { const Params q = fresh(p); EpiAccum e{q.out, D};
      run_gemm(lds_raw, q.xb(), q.Wout_t() + (size_t)l * D * KD, T, D, KD, e); }
    xcd_barrier(xb);
    { PHASE_IDS; phase_cvt_rows_h8(q, l, gw, ngw, lane);
      cvt_table_fp8(q.in[19] + (size_t)l * 16384 * D, q.U8s(), q.su(), gw, ngw, lane);
      cvt_table_fp8(q.in[20] + (size_t)l * 16384 * D, q.V8s(), q.sv(), gw, ngw, lane); }
    xcd_barrier(xb);
    DUP(7) {
    { const Params q = fresh(p); EpiScaleStoreBf16 e{q.qb(), D, q.rstd()};
      run_gemm(lds_raw, q.xb(), q.Wq_t() + (size_t)l * D * KD, T, D, KD, e); }
    xcd_barrier(xb);
    }
    if (!(PROBE_SKIP & 2)) {
    { PHASE_IDS; phase_peer_topk(q, l, gw, ngw, lane); }
    xcd_barrier(xb);
    }
#if PEER_CHECK
    if (l == 0) { { PHASE_IDS; chk_save(q, gtid, ngt); } xcd_barrier(xb); { PHASE_IDS; chk_topk(q, l, gtid, ngt); } xcd_barrier(xb); }
#endif
    if (!(PROBE_SKIP & 1)) {
    { PHASE_IDS; phase_peer_u(q, q.qctr() + (l * 2 + 0) * 8, lds_raw, tid); }
    xcd_barrier(xb);
    { PHASE_IDS; phase_peer_r(q, gtid, ngt); }
    xcd_barrier(xb);
    if (!(PROBE_SKIP & 32)) {
    { PHASE_IDS; phase_peer_v(q, q.qctr() + (l * 2 + 1) * 8, lds_raw, tid); }
    xcd_barrier(xb);
    }
    }
#if PEER_CHECK
    if (l == 0) { { PHASE_IDS; chk_apply(q, l, ldsf + wv * 128, gw, ngw, lane); } xcd_barrier(xb);
      if (blockIdx.x == 0 && threadIdx.x == 0) { const Params q = fresh(p); chk_emit(q); } xcd_barrier(xb); }
#endif
  }
  { constexpr int l = 2;
    DUP(6) {
    { PHASE_IDS; phase_cvt_rows(q.out, q.xb(), q.rstd(), gw, ngw, lane);
      phase_s5_prep(q, l, gtid, ngt);
 }
    xcd_barrier(xb);
    }
    DUP(5) {
    { const Params q = fresh(p); EpiScaleStore e{q.proj(), INW, q.rstd()};
      run_gemm(lds_raw, q.xb(), q.Win_t() + (size_t)l * INW * KD, T, INW, KD, e); }
    xcd_barrier(xb);
    }
    { PHASE_IDS; phase_postproj(q, l, gw, ngw, lane); }
    xcd_barrier(xb);
    DUP(0) {
    { PHASE_IDS; phase_kmean(q, gtid, ngt); phase_pack_moba(q, gtid, ngt); phase_pack_u(q, gtid, ngt); phase_pack_ret(q, gtid, ngt); }
    xcd_barrier(xb);
    }
    DUP(1) {
    { const Params q = fresh(p); EpiS5Z e{q.S5Z()};
      pg8::Gemm g{q.S5A(), q.S5Wz(), 16 * 1024, 16 * 256, 512, 640, 512}; pg8::GroupOrder So; So.init(16, 4, 1, (int)gridDim.x, (int)blockIdx.x);
      pg8::gemm_phase<EpiS5Z, pg8::GroupOrder, true, true>((PG8_LAS unsigned char*)lds_raw, g, So, e); }
    __syncthreads();
    { PHASE_IDS; phase_moba2(q, l, lds_raw, bid, G); }
    { PHASE_IDS; phase_ret_kv(q, gw, ngw, lane); }
    xcd_barrier(xb);
    }
    DUP(2) {
    { PHASE_IDS; phase_s5_scan(q, gtid, ngt); phase_ret_scan(q, gtid, ngt); }
    xcd_barrier(xb);
    }
    DUP(3) {
    { const Params q = fresh(p); EpiS5Y e{q.ygb(), q.S5A(), q.in[10] + l * 256};
      pg8::Gemm g{q.S5A(), q.S5Wy(), 16 * 1024, 16 * 512, 640, 640, 640}; pg8::GroupOrder So; So.init(16, 4, 2, (int)gridDim.x, (int)blockIdx.x);
      pg8::gemm_phase<EpiS5Y, pg8::GroupOrder, true, true>((PG8_LAS unsigned char*)lds_raw, g, So, e); }
    __syncthreads();
    { PHASE_IDS; phase_ret_out(q, gw, ngw, lane); }
    xcd_barrier(xb);
    }
    DUP(4) {
    { const Params q = fresh(p); EpiGlu e{q.ybuf(), q.ygb(), (float*)(lds_raw + 131072)};
      run_gemm(lds_raw, q.ygb(), q.Wglu_t() + (size_t)l * 65536, T, 256, 256, e); }
    xcd_barrier(xb);
    }
    DUP(9) {
    { PHASE_IDS; phase_cvt_rows(q.ybuf(), q.xb(), nullptr, gw, ngw, lane); }
    xcd_barrier(xb);
    }
    { const Params q = fresh(p); EpiAccum e{q.out, D};
      run_gemm(lds_raw, q.xb(), q.Wout_t() + (size_t)l * D * KD, T, D, KD, e); }
    xcd_barrier(xb);
    { PHASE_IDS; phase_cvt_rows_h8(q, l, gw, ngw, lane);
      cvt_table_fp8(q.in[19] + (size_t)l * 16384 * D, q.U8s(), q.su(), gw, ngw, lane);
      cvt_table_fp8(q.in[20] + (size_t)l * 16384 * D, q.V8s(), q.sv(), gw, ngw, lane); }
    xcd_barrier(xb);
    DUP(7) {
    { const Params q = fresh(p); EpiScaleStoreBf16 e{q.qb(), D, q.rstd()};
      run_gemm(lds_raw, q.xb(), q.Wq_t() + (size_t)l * D * KD, T, D, KD, e); }
    xcd_barrier(xb);
    }
    if (!(PROBE_SKIP & 2)) {
    { PHASE_IDS; phase_peer_topk(q, l, gw, ngw, lane); }
    xcd_barrier(xb);
    }
#if PEER_CHECK
    if (l == 0) { { PHASE_IDS; chk_save(q, gtid, ngt); } xcd_barrier(xb); { PHASE_IDS; chk_topk(q, l, gtid, ngt); } xcd_barrier(xb); }
#endif
    if (!(PROBE_SKIP & 1)) {
    { PHASE_IDS; phase_peer_u(q, q.qctr() + (l * 2 + 0) * 8, lds_raw, tid); }
    xcd_barrier(xb);
    { PHASE_IDS; phase_peer_r(q, gtid, ngt); }
    xcd_barrier(xb);
    if (!(PROBE_SKIP & 32)) {
    { PHASE_IDS; phase_peer_v(q, q.qctr() + (l * 2 + 1) * 8, lds_raw, tid); }
    xcd_barrier(xb);
    }
    }
#if PEER_CHECK
    if (l == 0) { { PHASE_IDS; chk_apply(q, l, ldsf + wv * 128, gw, ngw, lane); } xcd_barrier(xb);
      if (blockIdx.x == 0 && threadIdx.x == 0) { const Params q = fresh(p); chk_emit(q); } xcd_barrier(xb); }
#endif
  }
  { constexpr int l = 3;
    DUP(6) {
    { PHASE_IDS; phase_cvt_rows(q.out, q.xb(), q.rstd(), gw, ngw, lane);
      phase_s5_prep(q, l, gtid, ngt);
 }
    xcd_barrier(xb);
    }
    DUP(5) {
    { const Params q = fresh(p); EpiScaleStore e{q.proj(), INW, q.rstd()};
      run_gemm(lds_raw, q.xb(), q.Win_t() + (size_t)l * INW * KD, T, INW, KD, e); }
    xcd_barrier(xb);
    }
    { PHASE_IDS; phase_postproj(q, l, gw, ngw, lane); }
    xcd_barrier(xb);
    DUP(0) {
    { PHASE_IDS; phase_kmean(q, gtid, ngt); phase_pack_moba(q, gtid, ngt); phase_pack_u(q, gtid, ngt); phase_pack_ret(q, gtid, ngt); }
    xcd_barrier(xb);
    }
    DUP(1) {
    { const Params q = fresh(p); EpiS5Z e{q.S5Z()};
      pg8::Gemm g{q.S5A(), q.S5Wz(), 16 * 1024, 16 * 256, 512, 640, 512}; pg8::GroupOrder So; So.init(16, 4, 1, (int)gridDim.x, (int)blockIdx.x);
      pg8::gemm_phase<EpiS5Z, pg8::GroupOrder, true, true>((PG8_LAS unsigned char*)lds_raw, g, So, e); }
    __syncthreads();
    { PHASE_IDS; phase_moba2(q, l, lds_raw, bid, G); }
    { PHASE_IDS; phase_ret_kv(q, gw, ngw, lane); }
    xcd_barrier(xb);
    }
    DUP(2) {
    { PHASE_IDS; phase_s5_scan(q, gtid, ngt); phase_ret_scan(q, gtid, ngt); }
    xcd_barrier(xb);
    }
    DUP(3) {
    { const Params q = fresh(p); EpiS5Y e{q.ygb(), q.S5A(), q.in[10] + l * 256};
      pg8::Gemm g{q.S5A(), q.S5Wy(), 16 * 1024, 16 * 512, 640, 640, 640}; pg8::GroupOrder So; So.init(16, 4, 2, (int)gridDim.x, (int)blockIdx.x);
      pg8::gemm_phase<EpiS5Y, pg8::GroupOrder, true, true>((PG8_LAS unsigned char*)lds_raw, g, So, e); }
    __syncthreads();
    { PHASE_IDS; phase_ret_out(q, gw, ngw, lane); }
    xcd_barrier(xb);
    }
    DUP(4) {
    { const Params q = fresh(p); EpiGlu e{q.ybuf(), q.ygb(), (float*)(lds_raw + 131072)};
      run_gemm(lds_raw, q.ygb(), q.Wglu_t() + (size_t)l * 65536, T, 256, 256, e); }
    xcd_barrier(xb);
    }
    DUP(9) {
    { PHASE_IDS; phase_cvt_rows(q.ybuf(), q.xb(), nullptr, gw, ngw, lane); }
    xcd_barrier(xb);
    }
    { const Params q = fresh(p); EpiAccum e{q.out, D};
      run_gemm(lds_raw, q.xb(), q.Wout_t() + (size_t)l * D * KD, T, D, KD, e); }
    xcd_barrier(xb);
    { PHASE_IDS; phase_cvt_rows_h8(q, l, gw, ngw, lane);
      cvt_table_fp8(q.in[19] + (size_t)l * 16384 * D, q.U8s(), q.su(), gw, ngw, lane);
      cvt_table_fp8(q.in[20] + (size_t)l * 16384 * D, q.V8s(), q.sv(), gw, ngw, lane); }
    xcd_barrier(xb);
    DUP(7) {
    { const Params q = fresh(p); EpiScaleStoreBf16 e{q.qb(), D, q.rstd()};
      run_gemm(lds_raw, q.xb(), q.Wq_t() + (size_t)l * D * KD, T, D, KD, e); }
    xcd_barrier(xb);
    }
    if (!(PROBE_SKIP & 2)) {
    { PHASE_IDS; phase_peer_topk(q, l, gw, ngw, lane); }
    xcd_barrier(xb);
    }
#if PEER_CHECK
    if (l == 0) { { PHASE_IDS; chk_save(q, gtid, ngt); } xcd_barrier(xb); { PHASE_IDS; chk_topk(q, l, gtid, ngt); } xcd_barrier(xb); }
#endif
    if (!(PROBE_SKIP & 1)) {
    { PHASE_IDS; phase_peer_u(q, q.qctr() + (l * 2 + 0) * 8, lds_raw, tid); }
    xcd_barrier(xb);
    { PHASE_IDS; phase_peer_r(q, gtid, ngt); }
    xcd_barrier(xb);
    if (!(PROBE_SKIP & 32)) {
    { PHASE_IDS; phase_peer_v(q, q.qctr() + (l * 2 + 1) * 8, lds_raw, tid); }
    xcd_barrier(xb);
    }
    }
#if PEER_CHECK
    if (l == 0) { { PHASE_IDS; chk_apply(q, l, ldsf + wv * 128, gw, ngw, lane); } xcd_barrier(xb);
      if (blockIdx.x == 0 && threadIdx.x == 0) { const Params q = fresh(p); chk_emit(q); } xcd_barrier(xb); }
#endif
  }
}

}

extern "C" void kernel_launch(void* const* d_in, const int* in_sizes, int n_in, void* d_out, int out_size, void* d_ws, size_t ws_size,
                              hipStream_t stream) {
  static int grid_blocks = 0;
  if (!grid_blocks) {
    int dev = 0, cus = 0, per_cu = 0;
    hipGetDevice(&dev);
    hipDeviceGetAttribute(&cus, hipDeviceAttributeMultiprocessorCount, dev);
    hipFuncSetAttribute((const void*)mega, hipFuncAttributeMaxDynamicSharedMemorySize, LDS_BYTES);
    hipOccupancyMaxActiveBlocksPerMultiprocessor(&per_cu, (const void*)mega, NTHR, LDS_BYTES);
    if (per_cu < 1) { fprintf(stderr, "occupancy query returned %d\n", per_cu); per_cu = 1; }
    grid_blocks = cus * 1;
    if (grid_blocks < 64) fprintf(stderr, "unexpected CU count %d\n", cus);
  }
  Params p{};
  for (int i = 0; i < 21; ++i) p.in[i] = (const float*)d_in[i];
  p.out = (float*)d_out;
  p.ws = (unsigned char*)d_ws;
  if (WS_TOTAL > ws_size) { fprintf(stderr, "workspace too small: need %zu have %zu\n", (size_t)WS_TOTAL, ws_size); return; }
  hipMemsetAsync((unsigned char*)d_ws + WO_bar, 0, 16384, stream);
  void* args[] = {&p};
  hipError_t e = hipLaunchCooperativeKernel((const void*)mega, dim3(grid_blocks), dim3(NTHR), args, LDS_BYTES, stream);
  if (e != hipSuccess) fprintf(stderr, "cooperative launch failed: %s (grid %d)\n", hipGetErrorString(e), grid_blocks);
}
```

```cpp
#include <hip/hip_runtime.h>
#include <hip/hip_cooperative_groups.h>
#include <math.h>
#include <stdint.h>
#include <stdio.h>
namespace cg = cooperative_groups;

#ifndef PEER_CHECK
#define PEER_CHECK 0
#endif
#ifndef PROBE_DUP
#define PROBE_DUP 0
#endif
#define DUP(bit) for (int rep_ = 0; rep_ < ((PROBE_DUP >> (bit)) & 1) + 1; ++rep_)
#ifndef PROBE_SKIP
#define PROBE_SKIP 0
#endif
#ifndef PRECISE
#define PRECISE 0
#endif

namespace {
constexpr int NB = 8, S = 4096, D = 1024, NL = 4, T = NB * S;
constexpr int INW = 2816;
constexpr int OFF_U = 0, OFF_QM = 256, OFF_KM = 768, OFF_VM = 1280, OFF_QR = 1792, OFF_KR = 2048, OFF_VR = 2304, OFF_GR = 2560;
constexpr float EPS = 1e-6f;
constexpr int KS = PRECISE ? 3 : 1;
constexpr int KD = D * KS;
constexpr int NTHR = 512, NWAVE = 8;
constexpr int LDS_BYTES = 131072 + 4096 + 1024;

typedef unsigned short bf16_t;
using bf16x8 = __attribute__((ext_vector_type(8))) short;
using f32x4 = __attribute__((ext_vector_type(4))) float;

__device__ __forceinline__ float wave_sum(float v) {
#pragma unroll
  for (int o = 32; o > 0; o >>= 1) v += __shfl_xor(v, o);
  return v;
}
__device__ __forceinline__ float wave_max(float v) {
#pragma unroll
  for (int o = 32; o > 0; o >>= 1) v = fmaxf(v, __shfl_xor(v, o));
  return v;
}
__device__ __forceinline__ float gelu_tanh(float x) {
  const float k0 = 0.7978845608028654f, k1 = 0.044715f;
  float u = k0 * (x + k1 * x * x * x);
  return 0.5f * x * (1.0f + tanhf(u));
}
__device__ __forceinline__ float sigmoidf_(float x) { return 1.0f / (1.0f + expf(-x)); }
__device__ __forceinline__ float fast_sigmoid(float x) { return __builtin_amdgcn_rcpf(1.0f + __builtin_amdgcn_exp2f(-1.4426950408889634f * x)); }
__device__ __forceinline__ float fast_gelu(float x) { const float u = 0.7978845608028654f * (x + 0.044715f * x * x * x); return x * fast_sigmoid(2.0f * u); }
__device__ __forceinline__ bf16_t f2bf(float f) {
  unsigned u = __float_as_uint(f);
  u += 0x7fffu + ((u >> 16) & 1u);
  return (bf16_t)(u >> 16);
}
__device__ __forceinline__ float bf2f(bf16_t h) { return __uint_as_float(((unsigned)h) << 16); }
#define LDS_FENCE() asm volatile("s_waitcnt lgkmcnt(0)" ::: "memory")
typedef __bf16 bf16x2_hw __attribute__((ext_vector_type(2)));
typedef float f32x2_hw __attribute__((ext_vector_type(2)));
__device__ __forceinline__ unsigned pk_bf16(float lo, float hi) { const f32x2_hw f = {lo, hi}; const bf16x2_hw b = __builtin_convertvector(f, bf16x2_hw); return __builtin_bit_cast(unsigned, b); }
typedef float f32x16 __attribute__((ext_vector_type(16)));

constexpr size_t al256(size_t x) { return (x + 255) & ~(size_t)255; }
constexpr size_t WO_rstd = 0;
constexpr size_t WO_cosm = WO_rstd + al256((size_t)T * 4);
constexpr size_t WO_sinm = WO_cosm + al256((size_t)S * 8 * 4);
constexpr size_t WO_cosr = WO_sinm + al256((size_t)S * 8 * 4);
constexpr size_t WO_sinr = WO_cosr + al256((size_t)S * 32 * 4);
constexpr size_t WO_kmean = WO_sinr + al256((size_t)S * 32 * 4);
constexpr size_t WO_proj = WO_kmean + al256((size_t)NB * 8 * 16 * 64 * 4);
constexpr size_t WO_ybuf = WO_proj + al256((size_t)T * INW * 4);
constexpr size_t WO_yg = WO_ybuf + al256((size_t)T * D * 4);
constexpr size_t WO_skb = WO_yg + al256((size_t)T * 256 * 4);
constexpr size_t WO_Ub = WO_skb + al256((size_t)NL * 16 * 128 * 64 * 2);
constexpr size_t WO_Vb = WO_Ub + al256((size_t)16384 * D * 2);
constexpr size_t WO_gates = WO_Vb + al256((size_t)16384 * D * 2);
constexpr size_t WO_eidx = WO_gates + al256((size_t)T * 128 * 4);
constexpr size_t WO_xb = WO_eidx + al256((size_t)T * 128 * 4);
constexpr size_t WO_Win_t = WO_xb + al256((size_t)T * KD * 2);
constexpr size_t WO_Wout_t = WO_Win_t + al256((size_t)NL * INW * KD * 2);
constexpr size_t WO_Wq_t = WO_Wout_t + al256((size_t)NL * D * KD * 2);
constexpr size_t WO_Qm = WO_Wq_t + al256((size_t)NL * D * KD * 2);
constexpr size_t WO_Km = WO_Qm + al256((size_t)T * 512 * 2);
constexpr size_t WO_Vm = WO_Km + al256((size_t)T * 512 * 2);
constexpr size_t WO_S5a32 = WO_Vm + al256((size_t)T * 512 * 2);
constexpr size_t WO_Wglu_t = WO_S5a32 + al256((size_t)16 * 64 * 2 * 4);
constexpr size_t WO_Qr = WO_Wglu_t + al256((size_t)NL * 256 * 256 * 2);
constexpr size_t WO_Kr = WO_Qr + al256((size_t)T * 256 * 2);
constexpr size_t WO_Krv = WO_Kr + al256((size_t)T * 256 * 2);
constexpr size_t WO_Vr = WO_Krv + al256((size_t)T * 256 * 2);
constexpr size_t WO_KVr = WO_Vr + al256((size_t)T * 256 * 2);
constexpr size_t WO_Rb = WO_KVr + al256((size_t)32 * 32 * 4096 * 4);
constexpr size_t WO_qctr = WO_Rb + al256((size_t)32 * 32 * 4096 * 2);
constexpr size_t WO_bar = WO_qctr + al256(1024);
constexpr size_t WS_TOTAL = WO_bar + al256(16384);
constexpr size_t WO_S5A = WO_gates;
constexpr size_t WO_S5Z = WO_S5A + al256((size_t)16 * 1024 * 640 * 2);
static_assert(WO_S5Z + (size_t)16 * 1024 * 128 * 4 <= WO_gates + 2 * al256((size_t)T * 128 * 4), "S5A/S5Z must fit in gates+eidx");
constexpr size_t WO_S5Wy = WO_Ub;
constexpr size_t WO_S5Wz = WO_S5Wy + al256((size_t)16 * 512 * 640 * 2);
static_assert(WO_S5Wz + (size_t)16 * 256 * 512 * 2 <= WO_Ub + 2 * al256((size_t)16384 * D * 2), "S5 weights must fit in Ub/Vb");
struct Params {
  const float* in[21];
  float* out;
  unsigned char* ws;
  __device__ __forceinline__ float* rstd() const { return (float*)(ws + WO_rstd); }
  __device__ __forceinline__ float* cosm() const { return (float*)(ws + WO_cosm); }
  __device__ __forceinline__ float* sinm() const { return (float*)(ws + WO_sinm); }
  __device__ __forceinline__ float* cosr() const { return (float*)(ws + WO_cosr); }
  __device__ __forceinline__ float* sinr() const { return (float*)(ws + WO_sinr); }
  __device__ __forceinline__ float* kmean() const { return (float*)(ws + WO_kmean); }
  __device__ __forceinline__ float* proj() const { return (float*)(ws + WO_proj); }
  __device__ __forceinline__ float* ybuf() const { return (float*)(ws + WO_ybuf); }
  __device__ __forceinline__ float* yg() const { return (float*)(ws + WO_yg); }
  __device__ __forceinline__ bf16_t* skb() const { return (bf16_t*)(ws + WO_skb); }
  __device__ __forceinline__ bf16_t* Ub() const { return (bf16_t*)(ws + WO_Ub); }
  __device__ __forceinline__ bf16_t* Vb() const { return (bf16_t*)(ws + WO_Vb); }
  __device__ __forceinline__ float* gates() const { return (float*)(ws + WO_gates); }
  __device__ __forceinline__ int* eidx() const { return (int*)(ws + WO_eidx); }
  __device__ __forceinline__ bf16_t* xb() const { return (bf16_t*)(ws + WO_xb); }
  __device__ __forceinline__ bf16_t* Win_t() const { return (bf16_t*)(ws + WO_Win_t); }
  __device__ __forceinline__ bf16_t* Wout_t() const { return (bf16_t*)(ws + WO_Wout_t); }
  __device__ __forceinline__ bf16_t* Wq_t() const { return (bf16_t*)(ws + WO_Wq_t); }
  __device__ __forceinline__ bf16_t* Qm() const { return (bf16_t*)(ws + WO_Qm); }
  __device__ __forceinline__ bf16_t* Km() const { return (bf16_t*)(ws + WO_Km); }
  __device__ __forceinline__ bf16_t* Vm() const { return (bf16_t*)(ws + WO_Vm); }
  __device__ __forceinline__ bf16_t* S5A() const { return (bf16_t*)(ws + WO_S5A); }
  __device__ __forceinline__ bf16_t* S5Wy() const { return (bf16_t*)(ws + WO_S5Wy); }
  __device__ __forceinline__ bf16_t* S5Wz() const { return (bf16_t*)(ws + WO_S5Wz); }
  __device__ __forceinline__ float* S5Z() const { return (float*)(ws + WO_S5Z); }
  __device__ __forceinline__ float* S5a32() const { return (float*)(ws + WO_S5a32); }
  __device__ __forceinline__ bf16_t* Wglu_t() const { return (bf16_t*)(ws + WO_Wglu_t); }
  __device__ __forceinline__ bf16_t* ygb() const { return (bf16_t*)(ws + WO_yg); }
  __device__ __forceinline__ int* qctr() const { return (int*)(ws + WO_qctr); }
  __device__ __forceinline__ unsigned char* U8s() const { return ws + WO_Ub; }
  __device__ __forceinline__ float* su() const { return (float*)(ws + WO_Ub + (size_t)16384 * D); }
  __device__ __forceinline__ unsigned char* V8s() const { return ws + WO_Vb; }
  __device__ __forceinline__ float* sv() const { return (float*)(ws + WO_Vb + (size_t)16384 * D); }
  __device__ __forceinline__ bf16_t* hb() const { return (bf16_t*)(ws + WO_ybuf + ((size_t)4 << 20)); }
  __device__ __forceinline__ unsigned char* h8lo() const { return ws + WO_ybuf + ((size_t)4 << 20) + (size_t)T * D; }
  __device__ __forceinline__ float* sh() const { return (float*)(ws + WO_ybuf + ((size_t)4 << 20) + (size_t)2 * T * D); }
  __device__ __forceinline__ float* ppart() const { return (float*)(ws + WO_proj + (size_t)T * D * 2); }
  __device__ __forceinline__ bf16_t* Qr() const { return (bf16_t*)(ws + WO_Qr); }
  __device__ __forceinline__ bf16_t* Kr() const { return (bf16_t*)(ws + WO_Kr); }
  __device__ __forceinline__ bf16_t* Krv() const { return (bf16_t*)(ws + WO_Krv); }
  __device__ __forceinline__ bf16_t* Vr() const { return (bf16_t*)(ws + WO_Vr); }
  __device__ __forceinline__ float* KVr() const { return (float*)(ws + WO_KVr); }
  __device__ __forceinline__ bf16_t* Rb() const { return (bf16_t*)(ws + WO_Rb); }
  __device__ __forceinline__ unsigned* bar() const { return (unsigned*)(ws + WO_bar); }
  __device__ __forceinline__ bf16_t* qb() const { return (bf16_t*)(ws + WO_proj); }
};

namespace pg8 {
#define PG8_LAS __attribute__((address_space(3)))
typedef unsigned short bf16_t;
typedef short bf16x8 __attribute__((ext_vector_type(8)));
typedef float f32x4 __attribute__((ext_vector_type(4)));
typedef unsigned u32x4 __attribute__((ext_vector_type(4)));
constexpr int BM = 256, BK = 64, HALF = 128, HTB = HALF * BK * 2  , STAGE_BYTES = 8 * HTB, NXCD = 8, WGM = 8;

__host__ __device__ __forceinline__ int lds_byte(int r, int c) { const int st = (r >> 4) * 2 + (c >> 5), rr = r & 15, cc = c & 31, ob = rr * 64 + cc * 2; return st * 1024 + (ob ^ (((ob >> 9) & 1) << 5)); }
__host__ __device__ __forceinline__ void stage_rc(int b, int& R, int& C) { const int st = b / 1024, sb = b % 1024, swz = sb ^ (((sb >> 9) & 1) << 5); R = (st >> 1) * 16 + swz / 64; C = (st & 1) * 32 + (swz % 64) / 2; }
__host__ __device__ __forceinline__ int perm32(int rho) { const int n = rho >> 4, i = rho & 15; return 8 * (i >> 2) + 4 * n + (i & 3); }

struct Unit { int pm, pn; };
struct Gemm { const bf16_t* A; const bf16_t* Bt; int M, N, K, lda, ldb; };

struct StaticOrder {
    int nM, nN, nwg, G, c;
    __host__ __device__ void init(int M, int N, int G_, int c_) { nM = M / BM; nN = N / BM; nwg = nM * nN; G = G_; c = c_; }
    __host__ __device__ bool next(int i, Unit& u) const {
        const long L = (long)i * G + c; if (L >= nwg) return false;
        int wgid = (int)L; { const int q = nwg / NXCD, r = nwg % NXCD, xcd = wgid % NXCD, off = wgid / NXCD; wgid = (xcd < r ? xcd * (q + 1) : r * (q + 1) + (xcd - r) * q) + off; }
        const int nig = WGM * nN, gid = wgid / nig, fm = gid * WGM, gsz = (nM - fm) < WGM ? (nM - fm) : WGM;
        u.pm = fm + ((wgid % nig) % gsz); u.pn = (wgid % nig) / gsz; return true;
    }
    __device__ __forceinline__ void a_ready(const Unit&) const {}
    __device__ __forceinline__ void done(const Unit&) const {}
};
struct GroupOrder {
    int mt, nt_, nwg, G, c;
    __host__ __device__ void init(int ngroups, int mt__, int nt__, int G_, int c_) { mt = mt__; nt_ = nt__; nwg = ngroups * mt * nt_; G = G_; c = c_; }
    __host__ __device__ bool next(int i, Unit& u) const {
        const long L = (long)i * G + c; if (L >= nwg) return false;
        const int per = mt * nt_, gi = (int)L / per, r = (int)L % per;
        u.pm = gi * mt + r % mt; u.pn = gi * nt_ + r / mt; return true;
    }
    __device__ __forceinline__ void a_ready(const Unit&) const {}
    __device__ __forceinline__ void done(const Unit&) const {}
};
template <class Epi, class Sched, bool ALIGN_EPI = false, bool SP2 = false>
__device__ __forceinline__ void gemm_phase(PG8_LAS unsigned char* lds, const Gemm g, const Sched& S, const Epi& E) {
    int tid_ = threadIdx.x; asm volatile("" : "+v"(tid_));
    const int tid = tid_, wid = __builtin_amdgcn_readfirstlane(tid >> 6), lane = tid & 63, wr = wid >> 2, wc = wid & 3, fr = lane & 15, fq = lane >> 4;
    const int K = g.K, nt = K / BK;
    unsigned voffA[2], voffB[2];
#pragma unroll
    for (int i = 0; i < 2; ++i) { int R, C; stage_rc(tid * 16 + i * 8192, R, C); const int Rb = Epi::PERM ? ((R & ~31) + perm32(R & 31)) : R;
        voffA[i] = (unsigned)(R * g.lda + C) * 2u; voffB[i] = (unsigned)(Rb * g.ldb + C) * 2u; }
    const size_t kstep = (size_t)(BK * 2);
    const size_t hstepA = (size_t)HALF * g.lda * 2, hstepB = (size_t)HALF * g.ldb * 2;
    const size_t tstepA = 2 * hstepA, tstepB = 2 * hstepB;
    const unsigned ldsw = (unsigned)wid * 1024u;
    const int aoff = lds_byte(wr * 64 + fr, fq * 8), boff = lds_byte(wc * 32 + fr, fq * 8);
#define PG8_SA(b, h) (((b) * 2 + (h)) * HTB)
#define PG8_SB(b, h) ((4 + (b) * 2 + (h)) * HTB)
#define PG8_STAGE(bufoff, gbase, voff) do { _Pragma("unroll") for (int _i = 0; _i < 2; ++_i) \
        __builtin_amdgcn_global_load_lds((const unsigned*)((const char*)(gbase) + (voff)[_i]), (PG8_LAS unsigned*)(lds + (bufoff) + ldsw + _i * 8192), 16, 0, 0); } while (0)
#define PG8_LDA(dst, b, h) do { _Pragma("unroll") for (int m = 0; m < 4; ++m) _Pragma("unroll") for (int k = 0; k < 2; ++k) dst[m][k] = *(const PG8_LAS bf16x8*)(lds + PG8_SA(b, h) + aoff + m * 2048 + k * 1024); } while (0)
#define PG8_LDB(dst, b, h) do { _Pragma("unroll") for (int n = 0; n < 2; ++n) _Pragma("unroll") for (int k = 0; k < 2; ++k) dst[n][k] = *(const PG8_LAS bf16x8*)(lds + PG8_SB(b, h) + boff + n * 2048 + k * 1024); } while (0)
#define PG8_MMA(ai, bj, At, Bt) do { __builtin_amdgcn_s_setprio(1); _Pragma("unroll") for (int m = 0; m < 4; ++m) _Pragma("unroll") for (int n = 0; n < 2; ++n) _Pragma("unroll") for (int k = 0; k < 2; ++k) \
        acc[ai][bj][m][n] = __builtin_amdgcn_mfma_f32_16x16x32_bf16(Bt[n][k], At[m][k], acc[ai][bj][m][n], 0, 0, 0); __builtin_amdgcn_s_setprio(0); } while (0)
#define PG8_WAIT_V(n) asm volatile("s_waitcnt vmcnt(" #n ")" ::: "memory")
#define PG8_WAIT_L(n) asm volatile("s_waitcnt lgkmcnt(" #n ")" ::: "memory")
#define PG8_BAR __builtin_amdgcn_s_barrier()
#define PG8_SCHED __builtin_amdgcn_sched_barrier(0)
    Unit cur, nxt; int ui = 0;
    if (!S.next(0, cur)) return;
    f32x4 acc[2][2][4][2];
    E.init(acc, cur, wr, wc, fr, fq);
    bf16x8 At[4][2], B0[2][2], B1[2][2];
    const char* cA = (const char*)g.A + (size_t)cur.pm * tstepA; const char* cB = (const char*)g.Bt + (size_t)cur.pn * tstepB;
    S.a_ready(cur);
    if constexpr (SP2) {
        PG8_STAGE(PG8_SB(0, 0), cB, voffB); PG8_STAGE(PG8_SB(0, 1), cB + hstepB, voffB); PG8_STAGE(PG8_SA(0, 0), cA, voffA); PG8_STAGE(PG8_SA(0, 1), cA + hstepA, voffA);
        if (wr == 1) PG8_BAR;
        PG8_WAIT_V(2); PG8_BAR;
        PG8_STAGE(PG8_SB(1, 0), cB + kstep, voffB); PG8_STAGE(PG8_SA(1, 0), cA + kstep, voffA); PG8_STAGE(PG8_SB(1, 1), cB + hstepB + kstep, voffB);
        PG8_WAIT_V(6); PG8_BAR;
    } else {
        PG8_STAGE(PG8_SB(0, 0), cB, voffB); PG8_STAGE(PG8_SA(0, 0), cA, voffA); PG8_STAGE(PG8_SB(0, 1), cB + hstepB, voffB); PG8_STAGE(PG8_SA(0, 1), cA + hstepA, voffA);
        if (wr == 1) PG8_BAR;
        PG8_WAIT_V(4); PG8_BAR;
        PG8_STAGE(PG8_SB(1, 0), cB + kstep, voffB); PG8_STAGE(PG8_SA(1, 0), cA + kstep, voffA); PG8_STAGE(PG8_SB(1, 1), cB + hstepB + kstep, voffB);
        PG8_WAIT_V(6); PG8_BAR;
    }
    for (;;) {
        const bool has_next = S.next(ui + 1, nxt);
        const char* nA = has_next ? (const char*)g.A + (size_t)nxt.pm * tstepA : cA; const char* nB = has_next ? (const char*)g.Bt + (size_t)nxt.pn * tstepB : cB;
        for (int t = 0; t < nt; t += 2) {
            const bool last = (t == nt - 2);
            const char* a1 = cA + (size_t)(t + 1) * kstep;
            const char* a2 = last ? nA : cA + (size_t)(t + 2) * kstep; const char* b2 = last ? nB : cB + (size_t)(t + 2) * kstep;
            const char* a3 = a2 + kstep; const char* b3 = b2 + kstep;
            if (last && has_next) S.a_ready(nxt);
            if constexpr (SP2) {
            PG8_LDB(B0, 0, 0); PG8_LDB(B1, 0, 1); PG8_SCHED; PG8_LDA(At, 0, 0); PG8_STAGE(PG8_SA(1, 1), a1 + hstepA, voffA);
            PG8_WAIT_V(8); PG8_WAIT_L(0); PG8_BAR; PG8_MMA(0, 0, At, B0); PG8_MMA(0, 1, At, B1); PG8_BAR; PG8_SCHED;
            PG8_LDA(At, 0, 1); PG8_STAGE(PG8_SB(0, 0), b2, voffB); PG8_STAGE(PG8_SB(0, 1), b2 + hstepB, voffB); PG8_STAGE(PG8_SA(0, 0), a2, voffA);
            PG8_WAIT_V(8); PG8_WAIT_L(0); PG8_BAR; PG8_MMA(1, 0, At, B0); PG8_MMA(1, 1, At, B1); PG8_BAR; PG8_SCHED;
            PG8_LDB(B0, 1, 0); PG8_LDB(B1, 1, 1); PG8_SCHED; PG8_LDA(At, 1, 0); PG8_STAGE(PG8_SA(0, 1), a2 + hstepA, voffA);
            PG8_WAIT_V(8); PG8_WAIT_L(0); PG8_BAR; PG8_MMA(0, 0, At, B0); PG8_MMA(0, 1, At, B1); PG8_BAR; PG8_SCHED;
            PG8_LDA(At, 1, 1); PG8_STAGE(PG8_SB(1, 0), b3, voffB); PG8_STAGE(PG8_SB(1, 1), b3 + hstepB, voffB); PG8_STAGE(PG8_SA(1, 0), a3, voffA);
            PG8_WAIT_V(8); PG8_WAIT_L(0); PG8_BAR; PG8_MMA(1, 0, At, B0); PG8_MMA(1, 1, At, B1); PG8_BAR; PG8_SCHED;
            } else {
            PG8_LDB(B0, 0, 0); PG8_SCHED; PG8_LDA(At, 0, 0); PG8_STAGE(PG8_SA(1, 1), a1 + hstepA, voffA);
            PG8_WAIT_L(8); PG8_BAR; PG8_WAIT_L(0); PG8_MMA(0, 0, At, B0); PG8_BAR; PG8_SCHED;
            PG8_LDB(B1, 0, 1); PG8_STAGE(PG8_SB(0, 0), b2, voffB);
            PG8_BAR; PG8_WAIT_L(0); PG8_MMA(0, 1, At, B1); PG8_BAR;
            PG8_LDA(At, 0, 1); PG8_STAGE(PG8_SA(0, 0), a2, voffA);
            PG8_BAR; PG8_WAIT_L(0); PG8_MMA(1, 0, At, B0); PG8_BAR; PG8_SCHED;
            PG8_STAGE(PG8_SB(0, 1), b2 + hstepB, voffB);
            PG8_WAIT_V(6); PG8_BAR; PG8_MMA(1, 1, At, B1); PG8_BAR;
            PG8_LDB(B0, 1, 0); PG8_SCHED; PG8_LDA(At, 1, 0); PG8_STAGE(PG8_SA(0, 1), a2 + hstepA, voffA);
            PG8_WAIT_L(8); PG8_BAR; PG8_WAIT_L(0); PG8_MMA(0, 0, At, B0); PG8_BAR; PG8_SCHED;
            PG8_LDB(B1, 1, 1); PG8_STAGE(PG8_SB(1, 0), b3, voffB);
            PG8_BAR; PG8_WAIT_L(0); PG8_MMA(0, 1, At, B1); PG8_BAR;
            PG8_LDA(At, 1, 1); PG8_STAGE(PG8_SA(1, 0), a3, voffA);
            PG8_BAR; PG8_WAIT_L(0); PG8_MMA(1, 0, At, B0); PG8_BAR; PG8_SCHED;
            PG8_STAGE(PG8_SB(1, 1), b3 + hstepB, voffB);
            PG8_WAIT_V(6); PG8_BAR; PG8_MMA(1, 1, At, B1); PG8_BAR;
            }
        }
        if constexpr (ALIGN_EPI) { if (wr == 0) PG8_BAR; }
        if constexpr (!Epi::AFTER_DRAIN) { E(acc, cur, wr, wc, fr, fq); S.done(cur); }
        if (!has_next) break;
        E.init(acc, nxt, wr, wc, fr, fq);
        cur = nxt; cA = nA; cB = nB; ++ui;
        if constexpr (ALIGN_EPI) { if (wr == 1) PG8_BAR; }
    }
    PG8_WAIT_V(0);
    if constexpr (!ALIGN_EPI) { if (wr == 0) PG8_BAR; }
    PG8_BAR;
    if constexpr (Epi::AFTER_DRAIN) { E.fused(acc, cur, wr, wc, fr, fq, lds, wid, lane); S.done(cur); }
#undef PG8_SA
#undef PG8_SB
#undef PG8_STAGE
#undef PG8_LDA
#undef PG8_LDB
#undef PG8_MMA
#undef PG8_WAIT_V
#undef PG8_WAIT_L
#undef PG8_BAR
#undef PG8_SCHED
}
}
struct EpiScaleStore {
  static constexpr bool PERM = false, AFTER_DRAIN = false;
  float* C; int ldc; const float* rs;
  __device__ __forceinline__ void init(pg8::f32x4 (&acc)[2][2][4][2], const pg8::Unit&, int, int, int, int) const {
#pragma unroll
    for (int a = 0; a < 2; ++a)
#pragma unroll
      for (int b = 0; b < 2; ++b)
#pragma unroll
        for (int m = 0; m < 4; ++m)
#pragma unroll
          for (int n = 0; n < 2; ++n) acc[a][b][m][n] = (pg8::f32x4){0.f, 0.f, 0.f, 0.f};
  }
  __device__ __forceinline__ void operator()(const pg8::f32x4 (&acc)[2][2][4][2], const pg8::Unit& u, int wr, int wc, int fr_in, int fq_in) const {
    int fr = fr_in, fq = fq_in; asm volatile("" : "+v"(fr), "+v"(fq));
#pragma unroll
    for (int ai = 0; ai < 2; ++ai)
#pragma unroll
      for (int m = 0; m < 4; ++m) {
        const int row = u.pm * 256 + ai * 128 + wr * 64 + m * 16 + fr;
        const float r = rs[row];
#pragma unroll
        for (int bj = 0; bj < 2; ++bj)
#pragma unroll
          for (int n = 0; n < 2; ++n) {
            const int col = u.pn * 256 + bj * 128 + wc * 32 + n * 16 + 4 * fq;
            pg8::f32x4 v = acc[ai][bj][m][n] * r;
            *(pg8::f32x4*)(C + (size_t)row * ldc + col) = v;
          }
        asm volatile("" ::: "memory");
      }
  }
};
struct EpiAccum {
  static constexpr bool PERM = false, AFTER_DRAIN = false;
  float* C; int ldc;
  __device__ __forceinline__ void init(pg8::f32x4 (&acc)[2][2][4][2], const pg8::Unit& u, int wr, int wc, int fr, int fq) const {
#pragma unroll
    for (int ai = 0; ai < 2; ++ai)
#pragma unroll
      for (int m = 0; m < 4; ++m) {
        const int row = u.pm * 256 + ai * 128 + wr * 64 + m * 16 + fr;
#pragma unroll
        for (int bj = 0; bj < 2; ++bj)
#pragma unroll
          for (int n = 0; n < 2; ++n) {
            const int col = u.pn * 256 + bj * 128 + wc * 32 + n * 16 + 4 * fq;
            acc[ai][bj][m][n] = *(const pg8::f32x4*)(C + (size_t)row * ldc + col);
          }
      }
  }
  __device__ __forceinline__ void operator()(const pg8::f32x4 (&acc)[2][2][4][2], const pg8::Unit& u, int wr, int wc, int fr_in, int fq_in) const {
    int fr = fr_in, fq = fq_in; asm volatile("" : "+v"(fr), "+v"(fq));
#pragma unroll
    for (int ai = 0; ai < 2; ++ai)
#pragma unroll
      for (int m = 0; m < 4; ++m) {
        const int row = u.pm * 256 + ai * 128 + wr * 64 + m * 16 + fr;
#pragma unroll
        for (int bj = 0; bj < 2; ++bj)
#pragma unroll
          for (int n = 0; n < 2; ++n) {
            const int col = u.pn * 256 + bj * 128 + wc * 32 + n * 16 + 4 * fq;
            *(pg8::f32x4*)(C + (size_t)row * ldc + col) = acc[ai][bj][m][n];
          }
        asm volatile("" ::: "memory");
      }
  }
};
struct EpiScaleStoreBf16 {
  static constexpr bool PERM = false, AFTER_DRAIN = false;
  bf16_t* C; int ldc; const float* rs;
  __device__ __forceinline__ void init(pg8::f32x4 (&acc)[2][2][4][2], const pg8::Unit&, int, int, int, int) const {
#pragma unroll
    for (int a = 0; a < 2; ++a)
#pragma unroll
      for (int b = 0; b < 2; ++b)
#pragma unroll
        for (int m = 0; m < 4; ++m)
#pragma unroll
          for (int n = 0; n < 2; ++n) acc[a][b][m][n] = (pg8::f32x4){0.f, 0.f, 0.f, 0.f};
  }
  __device__ __forceinline__ void operator()(const pg8::f32x4 (&acc)[2][2][4][2], const pg8::Unit& u, int wr, int wc, int fr_in, int fq_in) const {
    int fr = fr_in, fq = fq_in; asm volatile("" : "+v"(fr), "+v"(fq));
#pragma unroll
    for (int ai = 0; ai < 2; ++ai)
#pragma unroll
      for (int m = 0; m < 4; ++m) {
        const int row = u.pm * 256 + ai * 128 + wr * 64 + m * 16 + fr;
        const float r = rs[row];
#pragma unroll
        for (int bj = 0; bj < 2; ++bj)
#pragma unroll
          for (int n = 0; n < 2; ++n) {
            const int col = u.pn * 256 + bj * 128 + wc * 32 + n * 16 + 4 * fq;
            pg8::f32x4 v = acc[ai][bj][m][n] * r;
            uint2 o; o.x = pk_bf16(v[0], v[1]); o.y = pk_bf16(v[2], v[3]);
            *(uint2*)(C + (size_t)row * ldc + col) = o;
          }
        asm volatile("" ::: "memory");
      }
  }
};
template <class Epi>
__device__ __forceinline__ void run_gemm(unsigned char* lds_raw, const bf16_t* A, const bf16_t* Bt, int M, int N, int K, const Epi& e) {
  pg8::Gemm g{A, Bt, M, N, K, K, K}; pg8::StaticOrder So; So.init(M, N, (int)gridDim.x, (int)blockIdx.x);
  pg8::gemm_phase<Epi, pg8::StaticOrder, true, true>((PG8_LAS unsigned char*)lds_raw, g, So, e);
}

__device__ __forceinline__ void transpose_items(const float* __restrict__ W, int K, int N, const float* __restrict__ g, bf16_t* __restrict__ Wt, int gw, int ngw, int lane) {
  const int nkt = K / 64, nnt = N / 64;
  for (int it = gw; it < nkt * nnt; it += ngw) {
    int kt = it % nkt, ntile = it / nkt;
    int k0 = kt * 64, n = ntile * 64 + lane;
    float v[64];
#pragma unroll
    for (int i = 0; i < 64; ++i) v[i] = W[(size_t)(k0 + i) * N + n] * g[k0 + i];
    bf16_t* dst = Wt + (size_t)n * (K * KS) + k0;
#pragma unroll
    for (int c = 0; c < 8; ++c) {
      bf16_t hi[8], lo[8];
#pragma unroll
      for (int e = 0; e < 8; ++e) { hi[e] = f2bf(v[c * 8 + e]); lo[e] = f2bf(v[c * 8 + e] - bf2f(hi[e])); }
      uint4 ph, pl;
      ph.x = hi[0] | ((unsigned)hi[1] << 16); ph.y = hi[2] | ((unsigned)hi[3] << 16); ph.z = hi[4] | ((unsigned)hi[5] << 16); ph.w = hi[6] | ((unsigned)hi[7] << 16);
      pl.x = lo[0] | ((unsigned)lo[1] << 16); pl.y = lo[2] | ((unsigned)lo[3] << 16); pl.z = lo[4] | ((unsigned)lo[5] << 16); pl.w = lo[6] | ((unsigned)lo[7] << 16);
      *(uint4*)(dst + c * 8) = ph;
      if (PRECISE) { *(uint4*)(dst + K + c * 8) = pl; *(uint4*)(dst + 2 * K + c * 8) = ph; }
    }
  }
}

__device__ __forceinline__ void phase_cvt_rows(const float* __restrict__ src, bf16_t* __restrict__ dst, float* __restrict__ rstd, int gw, int ngw, int lane) {
  for (int t = gw; t < T; t += ngw) {
    const float4* p = (const float4*)(src + (size_t)t * D);
    float ss = 0.f;
#pragma unroll
    for (int i = 0; i < 4; ++i) {
      float4 v = p[lane + i * 64];
      ss += v.x * v.x + v.y * v.y + v.z * v.z + v.w * v.w;
      bf16_t h0 = f2bf(v.x), h1 = f2bf(v.y), h2 = f2bf(v.z), h3 = f2bf(v.w);
      uint2 ph; ph.x = h0 | ((unsigned)h1 << 16); ph.y = h2 | ((unsigned)h3 << 16);
      bf16_t* d = dst + (size_t)t * KD + (lane + i * 64) * 4;
      *(uint2*)d = ph;
      if (PRECISE) {
        bf16_t l0 = f2bf(v.x - bf2f(h0)), l1 = f2bf(v.y - bf2f(h1)), l2 = f2bf(v.z - bf2f(h2)), l3 = f2bf(v.w - bf2f(h3));
        uint2 pl; pl.x = l0 | ((unsigned)l1 << 16); pl.y = l2 | ((unsigned)l3 << 16);
        *(uint2*)(d + D) = ph; *(uint2*)(d + 2 * D) = pl;
      }
    }
    if (rstd) { ss = wave_sum(ss); if (lane == 0) rstd[t] = rsqrtf(ss / (float)D + EPS); }
  }
}

__device__ __forceinline__ void phase_prologue(const Params& p, int gtid, int ngt, int gw, int ngw, int lane) {
  for (int idx = gtid; idx < S * 40; idx += ngt) {
    int s = idx / 40, i = idx % 40;
    if (i < 8) {
      float inv = powf(500000.0f, -(float)(2 * i) / 16.0f);
      float ang = (float)s * inv;
      p.cosm()[s * 8 + i] = (float)cos((double)ang); p.sinm()[s * 8 + i] = (float)sin((double)ang);
    } else {
      int j = i - 8;
      float inv = powf(10000.0f, -((float)j / 31.0f));
      float ang = (float)s * inv;
      p.cosr()[s * 32 + j] = (float)cos((double)ang); p.sinr()[s * 32 + j] = (float)sin((double)ang);
    }
  }
  { const float4* a = (const float4*)p.in[0]; float4* b = (float4*)p.out;
    for (size_t i = gtid; i < (size_t)T * D / 4; i += ngt) b[i] = a[i]; }
  for (int idx = gtid; idx < NL * 65536; idx += ngt) { const int l2 = idx >> 16, n2 = (idx >> 8) & 255, k2 = idx & 255; p.Wglu_t()[idx] = f2bf(p.in[11][(size_t)l2 * 65536 + k2 * 256 + n2]); }
  for (int l = 0; l < NL; ++l) {
    transpose_items(p.in[2] + (size_t)l * D * INW, D, INW, p.in[1] + l * D, p.Win_t() + (size_t)l * INW * KD, gw, ngw, lane);
    transpose_items(p.in[15] + (size_t)l * D * D, D, D, p.in[14] + l * D, p.Wout_t() + (size_t)l * D * KD, gw, ngw, lane);
    transpose_items(p.in[17] + (size_t)l * D * D, D, D, p.in[16] + l * D, p.Wq_t() + (size_t)l * D * KD, gw, ngw, lane);
  }
}

__device__ __forceinline__ void phase_postproj(const Params& p, int l, int gw, int ngw, int lane) {
  const float* gq = p.in[12] + l * 64; const float* gk = p.in[13] + l * 64;
  for (int w = gw; w < T * 24; w += ngw) {
    int t = w / 24, slot = w % 24, s = t % S;
    float* row = p.proj() + (size_t)t * INW;
    if (slot < 16) {
      int h = slot & 7;
      float* q = row + (slot < 8 ? OFF_QM : OFF_KM) + h * 64;
      const float* g = slot < 8 ? gq : gk;
      float v = q[lane];
      float ss = wave_sum(v * v);
      float u = v * rsqrtf(ss / 64.0f + EPS) * g[lane];
      int partner = lane < 8 ? lane + 8 : lane - 8;
      float pu = __shfl(u, partner & 63);
      float o = u;
      if (lane < 16) {
        int i = lane & 7;
        float c = p.cosm()[s * 8 + i], sn = p.sinm()[s * 8 + i];
        o = lane < 8 ? (u * c - pu * sn) : (u * c + pu * sn);
      }
      q[lane] = o;
    } else {
      int h = (slot - 16) & 3; bool isk = slot >= 20;
      float* q = row + (isk ? OFF_KR : OFF_QR) + h * 64;
      float v = q[lane];
      float pv = __shfl(v, lane ^ 32);
      int i = lane & 31;
      float c = p.cosr()[s * 32 + i], sn = p.sinr()[s * 32 + i];
      float o = lane < 32 ? (v * c - pv * sn) : (v * c + pv * sn);
      if (isk) o *= 0.125f;
      q[lane] = o;
    }
  }
}

__device__ __forceinline__ void phase_kmean(const Params& p, int gtid, int ngt) {
  for (int idx = gtid; idx < NB * 8 * 16 * 64; idx += ngt) {
    int d = idx & 63, j = (idx >> 6) & 15, h = (idx >> 10) & 7, b = idx >> 13;
    const float* q = p.proj() + ((size_t)(b * S + j * 256)) * INW + OFF_KM + h * 64 + d;
    float acc = 0.f;
    for (int i = 0; i < 256; ++i) acc += q[(size_t)i * INW];
    p.kmean()[idx] = acc / 256.0f;
  }
}

__device__ __forceinline__ void s5_unit(const Params& p, int l, int unit, float* red, int lane) {
  const int b = unit >> 4, g = unit & 15, pp = lane;
  const float* lam_re = p.in[3] + l * 1024; const float* lam_im = p.in[4] + l * 1024; const float* log_dt = p.in[5] + l * 16;
  const float* b_re = p.in[6] + l * 16384; const float* b_im = p.in[7] + l * 16384;
  const float* c_re = p.in[8] + l * 16384; const float* c_im = p.in[9] + l * 16384; const float* dskip = p.in[10] + l * 256;
  float lr = lam_re[g * 64 + pp], li = lam_im[g * 64 + pp];
  float dt = expf(log_dt[g]);
  float mag = expf(lr * dt);
  float ar = mag * cosf(li * dt), ai = mag * sinf(li * dt);
  float den = lr * lr + li * li;
  float fr = ((ar - 1.0f) * lr + ai * li) / den;
  float fi = (ai * lr - (ar - 1.0f) * li) / den;
  float bbr[16], bbi[16], cr[16], ci[16];
#pragma unroll
  for (int h = 0; h < 16; ++h) {
    float br = b_re[(g * 64 + pp) * 16 + h], bi = b_im[(g * 64 + pp) * 16 + h];
    bbr[h] = fr * br - fi * bi; bbi[h] = fr * bi + fi * br;
    cr[h] = c_re[(g * 16 + h) * 64 + pp]; ci[h] = c_im[(g * 16 + h) * 64 + pp];
  }
  const int hq = pp >> 2, qq = pp & 3;
  float dsk = dskip[g * 16 + hq];
  float sr = 0.f, si = 0.f;
  for (int t = 0; t < S; ++t) {
    const float* up = p.proj() + (size_t)(b * S + t) * INW + OFF_U + g * 16;
    float u[16];
#pragma unroll
    for (int h4 = 0; h4 < 4; ++h4) { float4 v = *(const float4*)(up + h4 * 4); u[h4 * 4] = v.x; u[h4 * 4 + 1] = v.y; u[h4 * 4 + 2] = v.z; u[h4 * 4 + 3] = v.w; }
    float bur = 0.f, bui = 0.f;
#pragma unroll
    for (int h = 0; h < 16; ++h) { bur = fmaf(u[h], bbr[h], bur); bui = fmaf(u[h], bbi[h], bui); }
    float nr = ar * sr - ai * si + bur, ni = ar * si + ai * sr + bui;
    sr = nr; si = ni;
    LDS_FENCE();
#pragma unroll
    for (int h = 0; h < 16; ++h) red[h * 65 + pp] = sr * cr[h] - si * ci[h];
    LDS_FENCE();
    float acc = 0.f;
#pragma unroll
    for (int i = 0; i < 16; ++i) acc += red[hq * 65 + qq * 16 + i];
    acc += __shfl_xor(acc, 1);
    acc += __shfl_xor(acc, 2);
    if (qq == 0) p.yg()[(size_t)(b * S + t) * 256 + g * 16 + hq] = gelu_tanh(acc + up[hq] * dsk);
  }
}

__device__ __forceinline__ void ret_units(const Params& p, int l, int unit0, float* lds) {
  constexpr int TB = 16;
  int tx_ = threadIdx.x; asm volatile("" : "+v"(tx_));
  const int vb = tx_ >> 8, tid = tx_ & 255;
  float* base_l = lds + vb * (TB * 64 * 3 + TB * 4 * 64);
  float* qs = base_l; float* ks = qs + TB * 64; float* vs = ks + TB * 64; float* red = vs + TB * 64;
  const int unit = unit0 + vb;
  const int b = unit >> 2, h = unit & 3;
  const int e = tid & 63, dg = tid >> 6;
  const float gamma = 1.0f - exp2f(-5.0f - (float)h);
  float St[16];
#pragma unroll
  for (int i = 0; i < 16; ++i) St[i] = 0.f;
  const float* base = p.proj() + (size_t)(b * S) * INW;
  for (int t0 = 0; t0 < S; t0 += TB) {
    __syncthreads();
    for (int i = tid; i < TB * 64; i += 256) {
      int tt = i >> 6, d = i & 63;
      const float* r = base + (size_t)(t0 + tt) * INW;
      qs[tt * 64 + d] = r[OFF_QR + h * 64 + d]; ks[tt * 64 + d] = r[OFF_KR + h * 64 + d]; vs[tt * 64 + d] = r[OFF_VR + h * 64 + d];
    }
    __syncthreads();
    for (int tt = 0; tt < TB; ++tt) {
      float ve = vs[tt * 64 + e], part = 0.f;
#pragma unroll
      for (int i = 0; i < 16; ++i) {
        St[i] = fmaf(gamma, St[i], ks[tt * 64 + dg * 16 + i] * ve);
        part = fmaf(qs[tt * 64 + dg * 16 + i], St[i], part);
      }
      red[(tt * 4 + dg) * 64 + e] = part;
    }
    __syncthreads();
    for (int k = 0; k < 4; ++k) {
      int tt = dg * 4 + k;
      float o = red[(tt * 4 + 0) * 64 + e] + red[(tt * 4 + 1) * 64 + e] + red[(tt * 4 + 2) * 64 + e] + red[(tt * 4 + 3) * 64 + e];
      float ss = wave_sum(o * o);
      float gv = base[(size_t)(t0 + tt) * INW + OFF_GR + h * 64 + e];
      float sl = gv * sigmoidf_(gv);
      int col = 768 + h * 64 + e;
      p.ybuf()[(size_t)(b * S + t0 + tt) * D + col] = sl * o * rsqrtf(ss / 64.0f + EPS);
    }
  }
}

__device__ __forceinline__ void phase_s5glu(const Params& p, int l, float* ys, int gw, int ngw, int lane) {
  const float* wglu = p.in[11] + (size_t)l * 65536;
  for (int t = gw; t < T; t += ngw) {
    float yv[4];
    LDS_FENCE();
#pragma unroll
    for (int i = 0; i < 4; ++i) { yv[i] = p.yg()[(size_t)t * 256 + lane + i * 64]; ys[lane + i * 64] = yv[i]; }
    LDS_FENCE();
    float z[4] = {0.f, 0.f, 0.f, 0.f};
    for (int k = 0; k < 256; ++k) {
      float yk = ys[k];
#pragma unroll
      for (int i = 0; i < 4; ++i) z[i] = fmaf(yk, wglu[k * 256 + lane + i * 64], z[i]);
    }
    float o[4], ss = 0.f;
#pragma unroll
    for (int i = 0; i < 4; ++i) { o[i] = yv[i] * sigmoidf_(z[i]); ss += o[i] * o[i]; }
    ss = wave_sum(ss);
    float r = rsqrtf(ss / 256.0f + EPS);
#pragma unroll
    for (int i = 0; i < 4; ++i) p.ybuf()[(size_t)t * D + lane + i * 64] = o[i] * r;
  }
}


struct S5P { float lr, li, dt, fr, fi; };
__device__ __forceinline__ S5P s5p(const Params& p, int l, int g, int pp) {
  S5P r; r.lr = p.in[3][l * 1024 + g * 64 + pp]; r.li = p.in[4][l * 1024 + g * 64 + pp]; r.dt = expf(p.in[5][l * 16 + g]);
  const float mag = expf(r.lr * r.dt); float sn, cs; sincosf(r.li * r.dt, &sn, &cs);
  const float ar = mag * cs, ai = mag * sn, den = r.lr * r.lr + r.li * r.li;
  r.fr = ((ar - 1.0f) * r.lr + ai * r.li) / den; r.fi = (ai * r.lr - (ar - 1.0f) * r.li) / den;
  return r;
}
__device__ __forceinline__ void s5pow(const S5P& s, int k, float& re, float& im) {
  const float m = expf((float)k * s.lr * s.dt); float sn, cs; sincosf((float)k * s.li * s.dt, &sn, &cs); re = m * cs; im = m * sn;
}
__device__ __forceinline__ void phase_s5_prep(const Params& p, int l, int gtid, int ngt) {
  const float* b_re = p.in[6] + l * 16384; const float* b_im = p.in[7] + l * 16384;
  const float* c_re = p.in[8] + l * 16384; const float* c_im = p.in[9] + l * 16384;
  bf16_t* Wy = p.S5Wy(); bf16_t* Wz = p.S5Wz();
  for (int it = gtid; it < 16 * 32 * 256; it += ngt) {
    const int hp = it & 15, h = (it >> 4) & 15, d = (it >> 8) & 31, g = it >> 13;
    float acc = 0.f;
    for (int pp = 0; pp < 64; ++pp) {
      const S5P s = s5p(p, l, g, pp);
      float pr, pi; s5pow(s, d, pr, pi);
      const float br = b_re[(g * 64 + pp) * 16 + hp], bi = b_im[(g * 64 + pp) * 16 + hp];
      const float bbr = s.fr * br - s.fi * bi, bbi = s.fr * bi + s.fi * br;
      const float tr = pr * bbr - pi * bbi, ti = pr * bbi + pi * bbr;
      acc += c_re[(g * 16 + h) * 64 + pp] * tr - c_im[(g * 16 + h) * 64 + pp] * ti;
    }
    const bf16_t v = f2bf(acc);
    for (int jp = 0; jp + d < 32; ++jp) {
      const int j = jp + d;
      Wy[((size_t)g * 512 + j * 16 + h) * 640 + jp * 16 + hp] = v;
      if (d > 0) Wy[((size_t)g * 512 + jp * 16 + h) * 640 + j * 16 + hp] = 0;
    }
  }
  for (int it = gtid; it < 16 * 32 * 16 * 64; it += ngt) {
    const int pp = it & 63, h = (it >> 6) & 15, j = (it >> 10) & 31, g = it >> 15;
    const S5P s = s5p(p, l, g, pp);
    float pr, pi; s5pow(s, j + 1, pr, pi);
    const float cr = c_re[(g * 16 + h) * 64 + pp], ci = c_im[(g * 16 + h) * 64 + pp];
    const unsigned w = pk_bf16(cr * pr - ci * pi, -(cr * pi + ci * pr));
    *(unsigned*)(Wy + ((size_t)g * 512 + j * 16 + h) * 640 + 512 + 2 * pp) = w;
  }
  for (int it = gtid; it < 16 * 64 * 32; it += ngt) {
    const int j = it & 31, pp = (it >> 5) & 63, g = it >> 11;
    const S5P s = s5p(p, l, g, pp);
    float pr, pi; s5pow(s, 31 - j, pr, pi);
    for (int hp = 0; hp < 16; ++hp) {
      const float br = b_re[(g * 64 + pp) * 16 + hp], bi = b_im[(g * 64 + pp) * 16 + hp];
      const float bbr = s.fr * br - s.fi * bi, bbi = s.fr * bi + s.fi * br;
      Wz[((size_t)g * 256 + 2 * pp) * 512 + j * 16 + hp] = f2bf(pr * bbr - pi * bbi);
      Wz[((size_t)g * 256 + 2 * pp + 1) * 512 + j * 16 + hp] = f2bf(pr * bbi + pi * bbr);
    }
  }
  for (int it = gtid; it < 16 * 64; it += ngt) {
    const S5P s = s5p(p, l, it >> 6, it & 63);
    float pr, pi; s5pow(s, 32, pr, pi);
    p.S5a32()[it * 2] = pr; p.S5a32()[it * 2 + 1] = pi;
  }
}
__device__ __forceinline__ void phase_pack_u(const Params& p, int gtid, int ngt) {
  for (int idx = gtid; idx < T * 32; idx += ngt) {
    const int t = idx >> 5, i = idx & 31, g = i >> 1;
    const float* src = p.proj() + (size_t)t * INW + i * 8;
    float4 a = *(const float4*)src, b4 = *(const float4*)(src + 4);
    uint4 o; o.x = pk_bf16(a.x, a.y); o.y = pk_bf16(a.z, a.w); o.z = pk_bf16(b4.x, b4.y); o.w = pk_bf16(b4.z, b4.w);
    *(uint4*)(p.S5A() + ((size_t)g * 1024 + (t >> 5)) * 640 + (t & 31) * 16 + (i & 1) * 8) = o;
  }
}
__device__ __forceinline__ void phase_s5_scan(const Params& p, int gtid, int ngt) {
  for (int it = gtid; it < NB * 16 * 64; it += ngt) {
    const int pp = it & 63, g = (it >> 6) & 15, b = it >> 10;
    const float er = p.S5a32()[(g * 64 + pp) * 2], ei = p.S5a32()[(g * 64 + pp) * 2 + 1];
    float sr = 0.f, si = 0.f;
    for (int c = 0; c < 128; ++c) {
      const size_t ch = (size_t)g * 1024 + b * 128 + c;
      *(unsigned*)(p.S5A() + ch * 640 + 512 + 2 * pp) = pk_bf16(sr, si);
      const float2 z = *(const float2*)(p.S5Z() + ch * 128 + 2 * pp);
      const float nr = er * sr - ei * si + z.x, ni = er * si + ei * sr + z.y;
      sr = nr; si = ni;
    }
  }
}
#define EPI_ZERO_INIT \
  __device__ __forceinline__ void init(pg8::f32x4 (&acc)[2][2][4][2], const pg8::Unit&, int, int, int, int) const { \
    _Pragma("unroll") for (int a = 0; a < 2; ++a) _Pragma("unroll") for (int b = 0; b < 2; ++b) \
    _Pragma("unroll") for (int m = 0; m < 4; ++m) _Pragma("unroll") for (int n = 0; n < 2; ++n) acc[a][b][m][n] = (pg8::f32x4){0.f, 0.f, 0.f, 0.f}; }
struct EpiS5Z {
  static constexpr bool PERM = false, AFTER_DRAIN = false;
  float* Z;
  EPI_ZERO_INIT
  __device__ __forceinline__ void operator()(const pg8::f32x4 (&acc)[2][2][4][2], const pg8::Unit& u, int wr, int wc, int fr_in, int fq_in) const {
    int fr = fr_in, fq = fq_in; asm volatile("" : "+v"(fr), "+v"(fq));
    const int g = u.pm >> 2;
#pragma unroll
    for (int ai = 0; ai < 2; ++ai)
#pragma unroll
      for (int m = 0; m < 4; ++m) {
        const int chunk = (u.pm & 3) * 256 + ai * 128 + wr * 64 + m * 16 + fr;
#pragma unroll
        for (int n = 0; n < 2; ++n) *(pg8::f32x4*)(Z + ((size_t)g * 1024 + chunk) * 128 + wc * 32 + n * 16 + 4 * fq) = acc[ai][0][m][n];
      }
  }
};
struct EpiS5Y {
  static constexpr bool PERM = false, AFTER_DRAIN = false;
  bf16_t* ygb; const bf16_t* A; const float* dsk;
  EPI_ZERO_INIT
  __device__ __forceinline__ void operator()(const pg8::f32x4 (&acc)[2][2][4][2], const pg8::Unit& u, int wr, int wc, int fr_in, int fq_in) const {
    int fr = fr_in, fq = fq_in; asm volatile("" : "+v"(fr), "+v"(fq));
    const int g = u.pm >> 2;
#pragma unroll
    for (int ai = 0; ai < 2; ++ai)
#pragma unroll
      for (int m = 0; m < 4; ++m) {
        const int chunk = (u.pm & 3) * 256 + ai * 128 + wr * 64 + m * 16 + fr;
#pragma unroll
        for (int bj = 0; bj < 2; ++bj)
#pragma unroll
          for (int n = 0; n < 2; ++n) {
            const int col = (u.pn & 1) * 256 + bj * 128 + wc * 32 + n * 16 + 4 * fq, j = col >> 4, h = col & 15;
            const uint2 uu = *(const uint2*)(A + ((size_t)g * 1024 + chunk) * 640 + col);
            const pg8::f32x4 dv = *(const pg8::f32x4*)(dsk + g * 16 + h);
            const pg8::f32x4 v = acc[ai][bj][m][n];
            const float y0 = fast_gelu(v[0] + dv[0] * __uint_as_float(uu.x << 16)), y1 = fast_gelu(v[1] + dv[1] * __uint_as_float(uu.x & 0xffff0000u));
            const float y2 = fast_gelu(v[2] + dv[2] * __uint_as_float(uu.y << 16)), y3 = fast_gelu(v[3] + dv[3] * __uint_as_float(uu.y & 0xffff0000u));
            uint2 o; o.x = pk_bf16(y0, y1); o.y = pk_bf16(y2, y3);
            *(uint2*)(ygb + ((size_t)chunk * 32 + j) * 256 + g * 16 + h) = o;
          }
        asm volatile("" ::: "memory");
      }
  }
};
struct EpiGlu {
  static constexpr bool PERM = false, AFTER_DRAIN = false;
  float* ybuf; const bf16_t* ygb; float* scr;
  EPI_ZERO_INIT
  __device__ __forceinline__ void operator()(const pg8::f32x4 (&acc_)[2][2][4][2], const pg8::Unit& u, int wr, int wc, int fr_in, int fq_in) const {
    int fr = fr_in, fq = fq_in; asm volatile("" : "+v"(fr), "+v"(fq));
    pg8::f32x4 (&acc)[2][2][4][2] = const_cast<pg8::f32x4 (&)[2][2][4][2]>(acc_);
#pragma unroll
    for (int ai = 0; ai < 2; ++ai)
#pragma unroll
      for (int m = 0; m < 4; ++m) {
        const int rl = ai * 128 + wr * 64 + m * 16 + fr, row = u.pm * 256 + rl;
        float ss = 0.f;
#pragma unroll
        for (int bj = 0; bj < 2; ++bj)
#pragma unroll
          for (int n = 0; n < 2; ++n) {
            const int col = bj * 128 + wc * 32 + n * 16 + 4 * fq;
            const uint2 yy = *(const uint2*)(ygb + (size_t)row * 256 + col);
            const pg8::f32x4 z = acc[ai][bj][m][n];
            pg8::f32x4 r;
            r[0] = __uint_as_float(yy.x << 16) * fast_sigmoid(z[0]); r[1] = __uint_as_float(yy.x & 0xffff0000u) * fast_sigmoid(z[1]);
            r[2] = __uint_as_float(yy.y << 16) * fast_sigmoid(z[2]); r[3] = __uint_as_float(yy.y & 0xffff0000u) * fast_sigmoid(z[3]);
            acc[ai][bj][m][n] = r;
            ss += r[0] * r[0] + r[1] * r[1] + r[2] * r[2] + r[3] * r[3];
          }
        ss += __shfl_xor(ss, 16); ss += __shfl_xor(ss, 32);
        if (fq == 0) scr[rl * 4 + wc] = ss;
        asm volatile("" ::: "memory");
      }
    asm volatile("s_waitcnt lgkmcnt(0)" ::: "memory"); __builtin_amdgcn_s_barrier(); asm volatile("" ::: "memory");
#pragma unroll
    for (int ai = 0; ai < 2; ++ai)
#pragma unroll
      for (int m = 0; m < 4; ++m) {
        const int rl = ai * 128 + wr * 64 + m * 16 + fr, row = u.pm * 256 + rl;
        const pg8::f32x4 s4 = *(const pg8::f32x4*)(scr + rl * 4);
        const float r = rsqrtf((s4[0] + s4[1] + s4[2] + s4[3]) / 256.0f + EPS);
#pragma unroll
        for (int bj = 0; bj < 2; ++bj)
#pragma unroll
          for (int n = 0; n < 2; ++n) *(pg8::f32x4*)(ybuf + (size_t)row * D + bj * 128 + wc * 32 + n * 16 + 4 * fq) = acc[ai][bj][m][n] * r;
        asm volatile("" ::: "memory");
      }
    asm volatile("s_waitcnt lgkmcnt(0)" ::: "memory"); __builtin_amdgcn_s_barrier(); asm volatile("" ::: "memory");
  }
};

constexpr float QSCALE = 0.125f * 1.4426950408889634f;

__device__ __forceinline__ void phase_pack_moba(const Params& p, int gtid, int ngt) {
  for (int idx = gtid; idx < T * 128; idx += ngt) {
    const int t = idx >> 7, c = idx & 127, isk = c >> 6, cc = c & 63, h = cc >> 3, ch = cc & 7;
    const float* src = p.proj() + (size_t)t * INW + (isk ? OFF_KM : OFF_QM) + h * 64 + ch * 8;
    float4 a = *(const float4*)src, b4 = *(const float4*)(src + 4);
    const float sc = isk ? 1.0f : QSCALE;
    uint4 o; o.x = pk_bf16(a.x * sc, a.y * sc); o.y = pk_bf16(a.z * sc, a.w * sc); o.z = pk_bf16(b4.x * sc, b4.y * sc); o.w = pk_bf16(b4.z * sc, b4.w * sc);
    const int b = t / S, s = t % S;
    bf16_t* dst = isk ? p.Km() + ((((size_t)(b * 8 + h) * (S / 32) + (s >> 5)) * 8 + ch) * 32 + (s & 31)) * 8
                      : p.Qm() + ((size_t)(b * 8 + h) * S + s) * 64 + ch * 8;
    *(uint4*)dst = o;
  }
  for (int idx = gtid; idx < NB * 8 * (S / 32) * 256; idx += ngt) {
    const int ln = idx & 63, ks = (idx >> 6) & 1, mb = (idx >> 7) & 1, tile = (idx >> 8) % (S / 32), bh = idx / (256 * (S / 32));
    const int b = bh >> 3, h = bh & 7, hh = ln >> 5, delta = mb * 32 + (ln & 31);
    float v[8];
#pragma unroll
    for (int j = 0; j < 8; ++j) {
      const int kappa = 16 * ks + 8 * (j >> 2) + 4 * hh + (j & 3), s = tile * 32 + kappa;
      v[j] = p.proj()[(size_t)(b * S + s) * INW + OFF_VM + h * 64 + delta];
    }
    uint4 o; o.x = pk_bf16(v[0], v[1]); o.y = pk_bf16(v[2], v[3]); o.z = pk_bf16(v[4], v[5]); o.w = pk_bf16(v[6], v[7]);
    *(uint4*)(p.Vm() + (size_t)idx * 8) = o;
  }
}

__device__ __forceinline__ void phase_moba2(const Params& p, int l, unsigned char* lds, int bid, int G) {
  int tid = threadIdx.x; asm volatile("" : "+v"(tid));
  const int lane = tid & 63, wv = tid >> 6, n = lane & 31, hh = lane >> 5;
  constexpr int OLD = 260;
  bf16_t* Qs = (bf16_t*)lds;
  float* Oaccf = (float*)(lds + 32768);
  float* laccf = (float*)(lds + 32768 + 64 * OLD * 4);
  float* kms = laccf + 256;
  float* gat = kms + 1024;
  unsigned char* lists = (unsigned char*)(gat + 4096);
  int* cnt = (int*)(lists + 4096);
  int* items = cnt + 16;
  int* ctr = items + 160;
  unsigned* selp = (unsigned*)(ctr + 4);
  float* bq = (float*)(selp + 256);
  int* Oacc = (int*)Oaccf; int* lacc = (int*)laccf;
  float kmax = 0.f;
  { const float* gk = p.in[13] + l * 64;
    for (int d = 0; d < 64; ++d) kmax = fmaxf(kmax, fabsf(gk[d]));
    kmax *= 8.0f * 1.01f; }
  for (int u = bid; u < NB * 8 * 16; u += G) {
    const int qblk = 15 - (u >> 6), bh = u & 63, b = bh >> 3, h = bh & 7;
    __syncthreads();
    { const uint4* src = (const uint4*)(p.Qm() + ((size_t)bh * S + qblk * 256) * 64);
      uint4* dst = (uint4*)Qs;
      for (int i = tid; i < 256 * 64 * 2 / 16; i += NTHR) dst[i] = src[i]; }
    for (int i = tid; i < qblk * 64; i += NTHR) kms[i] = p.kmean()[(size_t)bh * 1024 + i];
    for (int i = tid; i < 64 * OLD; i += NTHR) Oacc[i] = 0;
    if (tid < 256) lacc[tid] = 0;
    if (tid < 16) cnt[tid] = 0;
    __syncthreads();
    { const int q = tid & 255, par = tid >> 8;
      float qv[64];
#pragma unroll
      for (int c = 0; c < 8; ++c) {
        uint4 w = *(const uint4*)(Qs + q * 64 + c * 8);
        qv[c * 8 + 0] = __uint_as_float(w.x << 16); qv[c * 8 + 1] = __uint_as_float(w.x & 0xffff0000u);
        qv[c * 8 + 2] = __uint_as_float(w.y << 16); qv[c * 8 + 3] = __uint_as_float(w.y & 0xffff0000u);
        qv[c * 8 + 4] = __uint_as_float(w.z << 16); qv[c * 8 + 5] = __uint_as_float(w.z & 0xffff0000u);
        qv[c * 8 + 6] = __uint_as_float(w.w << 16); qv[c * 8 + 7] = __uint_as_float(w.w & 0xffff0000u);
      }
      if (par == 0) { float qq = 0.f;
#pragma unroll
        for (int d = 0; d < 64; ++d) qq = fmaf(qv[d], qv[d], qq);
        bq[q] = sqrtf(qq) * kmax; }
      for (int j = par; j < qblk; j += 2) {
        float g = 0.f;
#pragma unroll
        for (int d = 0; d < 64; ++d) g = fmaf(qv[d], kms[j * 64 + d], g);
        gat[q * 16 + j] = g;
      }
    }
    __syncthreads();
    if (tid < 256) {
      float b0 = -INFINITY, b1 = -INFINITY, b2 = -INFINITY; int i0 = 0, i1 = 0, i2 = 0;
      for (int j = 0; j < qblk; ++j) {
        float g = gat[tid * 16 + j];
        if (g > b0) { b2 = b1; i2 = i1; b1 = b0; i1 = i0; b0 = g; i0 = j; }
        else if (g > b1) { b2 = b1; i2 = i1; b1 = g; i1 = j; }
        else if (g > b2) { b2 = g; i2 = j; }
      }
      const int nsel = qblk < 3 ? qblk : 3;
      selp[tid] = (unsigned)i0 | ((unsigned)i1 << 4) | ((unsigned)i2 << 8) | ((unsigned)nsel << 12);
    }
    __syncthreads();
    for (int j = wv; j < qblk; j += 8) {
      int base = 0;
      for (int c = 0; c < 4; ++c) {
        const int q = c * 64 + lane;
        const unsigned sp = selp[q];
        const int ns = sp >> 12;
        const bool f = (ns > 0 && (int)(sp & 15) == j) || (ns > 1 && (int)((sp >> 4) & 15) == j) || (ns > 2 && (int)((sp >> 8) & 15) == j);
        const unsigned long long bal = __ballot(f);
        const int pos = base + __popcll(bal & ((1ull << lane) - 1ull));
        if (f) lists[j * 256 + pos] = (unsigned char)q;
        base += __popcll(bal);
      }
      if (lane == 0) cnt[j] = base;
    }
    __syncthreads();
    if (tid == 0) {
      int ni = 0;
#pragma unroll 1
      for (int g = 7; g >= 0; --g) items[ni++] = (16 << 8) | g;
      for (int j = 0; j < qblk; ++j) { const int ng = (cnt[j] + 31) >> 5; for (int g = 0; g < ng; ++g) items[ni++] = (j << 8) | g; }
      ctr[0] = ni; ctr[1] = 0;
    }
    __syncthreads();
    const int nitems = ctr[0];
    for (;;) {
      int it = 0;
      if (lane == 0) it = atomicAdd(&ctr[1], 1);
      it = __builtin_amdgcn_readfirstlane(it);
      if (it >= nitems) break;
      const int item = items[it];
      const int j = item >> 8, g = item & 255;
      const bool own = (j == 16);
      const int kb = own ? qblk : j;
      const int ntile = own ? (g + 1) : 8;
      int qi; bool valid;
      if (own) { qi = g * 32 + n; valid = true; }
      else { const int pos = g * 32 + n; valid = pos < cnt[j]; qi = lists[j * 256 + (valid ? pos : 0)]; }
      bf16x8 qf[4];
#pragma unroll
      for (int s = 0; s < 4; ++s) qf[s] = *(const bf16x8*)(Qs + qi * 64 + (2 * s + hh) * 8);
      const bf16_t* kt0 = p.Km() + ((size_t)bh * (S / 32) + kb * 8) * 2048 + lane * 8;
      const bf16_t* vt0 = p.Vm() + ((size_t)bh * (S / 32) + kb * 8) * 2048 + lane * 8;
      f32x16 O0, O1;
#pragma unroll
      for (int r = 0; r < 16; ++r) { O0[r] = 0.f; O1[r] = 0.f; }
      float lsum = 0.f;
      const float nbq = -bq[qi];
      bf16x8 kf[4], vf[4];
#pragma unroll
      for (int s = 0; s < 4; ++s) { kf[s] = *(const bf16x8*)(kt0 + s * 512); vf[s] = *(const bf16x8*)(vt0 + s * 512); }
      for (int kt = 0; kt < ntile; ++kt) {
        bf16x8 kn[4], vn[4];
        const int ktn = (kt + 1 < ntile) ? kt + 1 : kt;
#pragma unroll
        for (int s = 0; s < 4; ++s) { kn[s] = *(const bf16x8*)(kt0 + (size_t)ktn * 2048 + s * 512); vn[s] = *(const bf16x8*)(vt0 + (size_t)ktn * 2048 + s * 512); }
        f32x16 X;
#pragma unroll
        for (int r = 0; r < 16; ++r) X[r] = nbq;
#pragma unroll
        for (int s = 0; s < 4; ++s) X = __builtin_amdgcn_mfma_f32_32x32x16_bf16(kf[s], qf[s], X, 0, 0, 0);
        const bool diag = own && (kt == g);
        unsigned pw[8];
#pragma unroll
        for (int r = 0; r < 16; r += 2) {
          float e0 = __builtin_amdgcn_exp2f(X[r]), e1 = __builtin_amdgcn_exp2f(X[r + 1]);
          if (diag) {
            const int k0 = (r & 3) + 8 * (r >> 2) + 4 * hh, k1 = ((r + 1) & 3) + 8 * ((r + 1) >> 2) + 4 * hh;
            e0 = (k0 <= n) ? e0 : 0.f; e1 = (k1 <= n) ? e1 : 0.f;
          }
          lsum += e0 + e1;
          pw[r >> 1] = pk_bf16(e0, e1);
        }
        bf16x8 pf0, pf1;
        { uint4 t0 = make_uint4(pw[0], pw[1], pw[2], pw[3]), t1 = make_uint4(pw[4], pw[5], pw[6], pw[7]);
          pf0 = *(bf16x8*)&t0; pf1 = *(bf16x8*)&t1; }
        O0 = __builtin_amdgcn_mfma_f32_32x32x16_bf16(vf[0], pf0, O0, 0, 0, 0);
        O0 = __builtin_amdgcn_mfma_f32_32x32x16_bf16(vf[1], pf1, O0, 0, 0, 0);
        O1 = __builtin_amdgcn_mfma_f32_32x32x16_bf16(vf[2], pf0, O1, 0, 0, 0);
        O1 = __builtin_amdgcn_mfma_f32_32x32x16_bf16(vf[3], pf1, O1, 0, 0, 0);
#pragma unroll
        for (int s = 0; s < 4; ++s) { kf[s] = kn[s]; vf[s] = vn[s]; }
      }
      lsum += __shfl_xor(lsum, 32);
      if (valid) {
        if (hh == 0) atomicAdd(&lacc[qi], __float2int_rn(lsum * 1048576.0f));
#pragma unroll
        for (int r = 0; r < 16; ++r) {
          const int dim = (r & 3) + 8 * (r >> 2) + 4 * hh;
          atomicAdd(&Oacc[dim * OLD + qi], __float2int_rn(O0[r] * 1048576.0f));
          atomicAdd(&Oacc[(dim + 32) * OLD + qi], __float2int_rn(O1[r] * 1048576.0f));
        }
      }
    }
    __syncthreads();
    { const int q = tid >> 1, half = tid & 1;
      const float inv = 1.0f / (float)lacc[q];
      float o[32], ss = 0.f;
#pragma unroll
      for (int d = 0; d < 32; ++d) { o[d] = (float)Oacc[(half * 32 + d) * OLD + q] * inv; ss += o[d] * o[d]; }
      ss += __shfl_xor(ss, 1);
      const float r = rsqrtf(ss / 64.0f + EPS);
      float* dst = p.ybuf() + (size_t)(b * S + qblk * 256 + q) * D + 256 + h * 64 + half * 32;
#pragma unroll
      for (int d = 0; d < 32; d += 4) *(float4*)(dst + d) = make_float4(o[d] * r, o[d + 1] * r, o[d + 2] * r, o[d + 3] * r);
    }
  }
}


__device__ __forceinline__ float ret_log2g(int h) { return log2f(1.0f - exp2f(-5.0f - (float)h)); }
__device__ __forceinline__ void phase_pack_ret(const Params& p, int gtid, int ngt) {
  for (int idx = gtid; idx < T * 64; idx += ngt) {
    const int t = idx >> 6, c = idx & 63, isk = c >> 5, cc = c & 31, h = cc >> 3, ch = cc & 7;
    const int b = t / S, s = t % S, i = s & 127;
    const float* src = p.proj() + (size_t)t * INW + (isk ? OFF_KR : OFF_QR) + h * 64 + ch * 8;
    float4 a = *(const float4*)src, b4 = *(const float4*)(src + 4);
    const float sc = exp2f((isk ? -(float)i : (float)i) * ret_log2g(h));
    uint4 o; o.x = pk_bf16(a.x * sc, a.y * sc); o.y = pk_bf16(a.z * sc, a.w * sc); o.z = pk_bf16(b4.x * sc, b4.y * sc); o.w = pk_bf16(b4.z * sc, b4.w * sc);
    const int bh = b * 4 + h;
    bf16_t* dst = isk ? p.Kr() + ((((size_t)bh * (S / 32) + (s >> 5)) * 8 + ch) * 32 + (s & 31)) * 8
                      : p.Qr() + ((size_t)bh * S + s) * 64 + ch * 8;
    *(uint4*)dst = o;
  }
  for (int idx = gtid; idx < 2 * NB * 4 * (S / 32) * 256; idx += ngt) {
    const int ln = idx & 63, ks = (idx >> 6) & 1, blk = (idx >> 7) & 1, tile = (idx >> 8) % (S / 32), rest = idx / (256 * (S / 32)), bh = rest % (NB * 4), which = rest / (NB * 4);
    const int b = bh >> 2, h = bh & 3, hh = ln >> 5, delta = blk * 32 + (ln & 31);
    const float l2g = ret_log2g(h);
    float v[8];
#pragma unroll
    for (int j = 0; j < 8; ++j) {
      const int kappa = 16 * ks + 8 * (j >> 2) + 4 * hh + (j & 3), s = tile * 32 + kappa;
      float x = p.proj()[(size_t)(b * S + s) * INW + (which ? OFF_KR : OFF_VR) + h * 64 + delta];
      if (which) x *= exp2f(-(float)(s & 127) * l2g);
      v[j] = x;
    }
    uint4 o; o.x = pk_bf16(v[0], v[1]); o.y = pk_bf16(v[2], v[3]); o.z = pk_bf16(v[4], v[5]); o.w = pk_bf16(v[6], v[7]);
    *(uint4*)((which ? p.Krv() : p.Vr()) + ((size_t)(idx % (NB * 4 * (S / 32) * 256))) * 8) = o;
  }
}
__device__ __forceinline__ void phase_ret_kv(const Params& p, int gw, int ngw, int lane) {
  const int n = lane & 31, hh = lane >> 5;
  for (int w = gw; w < NB * 4 * 32; w += ngw) {
    const int bh = w >> 5, cn = w & 31;
    const bf16_t* vt = p.Vr() + ((size_t)bh * (S / 32) + cn * 4) * 2048 + lane * 8;
    const bf16_t* kt = p.Krv() + ((size_t)bh * (S / 32) + cn * 4) * 2048 + lane * 8;
    f32x16 acc[2][2];
#pragma unroll
    for (int a = 0; a < 2; ++a)
#pragma unroll
      for (int b2 = 0; b2 < 2; ++b2)
#pragma unroll
        for (int r = 0; r < 16; ++r) acc[a][b2][r] = 0.f;
#pragma unroll 1
    for (int tl = 0; tl < 4; ++tl)
#pragma unroll
      for (int ks = 0; ks < 2; ++ks) {
        bf16x8 vf[2], kf[2];
#pragma unroll
        for (int x = 0; x < 2; ++x) { vf[x] = *(const bf16x8*)(vt + tl * 2048 + (x * 2 + ks) * 512); kf[x] = *(const bf16x8*)(kt + tl * 2048 + (x * 2 + ks) * 512); }
#pragma unroll
        for (int mb = 0; mb < 2; ++mb)
#pragma unroll
          for (int nb = 0; nb < 2; ++nb) acc[mb][nb] = __builtin_amdgcn_mfma_f32_32x32x16_bf16(vf[mb], kf[nb], acc[mb][nb], 0, 0, 0);
      }
    float* dst = p.KVr() + ((size_t)bh * 32 + cn) * 4096;
#pragma unroll
    for (int mb = 0; mb < 2; ++mb)
#pragma unroll
      for (int nb = 0; nb < 2; ++nb)
#pragma unroll
        for (int r = 0; r < 16; ++r) dst[(mb * 32 + (r & 3) + 8 * (r >> 2) + 4 * hh) * 64 + nb * 32 + n] = acc[mb][nb][r];
  }
}
__device__ __forceinline__ void phase_ret_scan(const Params& p, int gtid, int ngt) {
  for (int it = gtid; it < NB * 4 * 4096; it += ngt) {
    const int e = it & 4095, bh = it >> 12, h = bh & 3;
    const float l2g = ret_log2g(h), g1 = exp2f(l2g), g127 = exp2f(127.0f * l2g), g128 = exp2f(128.0f * l2g);
    float R = 0.f;
    for (int cn = 0; cn < 32; ++cn) {
      const size_t o = ((size_t)bh * 32 + cn) * 4096 + e;
      p.Rb()[o] = f2bf(g1 * R);
      R = g128 * R + g127 * p.KVr()[o];
    }
  }
}
__device__ __forceinline__ void phase_ret_out(const Params& p, int gw, int ngw, int lane) {
  const int n = lane & 31, hh = lane >> 5;
  for (int w = gw; w < NB * 4 * 32 * 4; w += ngw) {
    const int qg = 3 - (w & 3), cn = (w >> 2) & 31, bh = w >> 7, b = bh >> 2, h = bh & 3;
    const int s0 = cn * 128 + qg * 32;
    bf16x8 qf[4];
#pragma unroll
    for (int s = 0; s < 4; ++s) qf[s] = *(const bf16x8*)(p.Qr() + ((size_t)bh * S + s0 + n) * 64 + (2 * s + hh) * 8);
    f32x16 O0, O1;
#pragma unroll
    for (int r = 0; r < 16; ++r) { O0[r] = 0.f; O1[r] = 0.f; }
    { const bf16_t* rb = p.Rb() + ((size_t)bh * 32 + cn) * 4096 + (size_t)n * 64 + hh * 8;
#pragma unroll
      for (int s = 0; s < 4; ++s) {
        const bf16x8 r0 = *(const bf16x8*)(rb + s * 16), r1 = *(const bf16x8*)(rb + 32 * 64 + s * 16);
        O0 = __builtin_amdgcn_mfma_f32_32x32x16_bf16(r0, qf[s], O0, 0, 0, 0);
        O1 = __builtin_amdgcn_mfma_f32_32x32x16_bf16(r1, qf[s], O1, 0, 0, 0);
      } }
    const bf16_t* kt0 = p.Kr() + ((size_t)bh * (S / 32) + cn * 4) * 2048 + lane * 8;
    const bf16_t* vt0 = p.Vr() + ((size_t)bh * (S / 32) + cn * 4) * 2048 + lane * 8;
    for (int kt = 0; kt <= qg; ++kt) {
      bf16x8 kf[4], vf[4];
#pragma unroll
      for (int s = 0; s < 4; ++s) { kf[s] = *(const bf16x8*)(kt0 + (size_t)kt * 2048 + s * 512); vf[s] = *(const bf16x8*)(vt0 + (size_t)kt * 2048 + s * 512); }
      f32x16 X;
#pragma unroll
      for (int r = 0; r < 16; ++r) X[r] = 0.f;
#pragma unroll
      for (int s = 0; s < 4; ++s) X = __builtin_amdgcn_mfma_f32_32x32x16_bf16(kf[s], qf[s], X, 0, 0, 0);
      const bool diag = (kt == qg);
      unsigned pw[8];
#pragma unroll
      for (int r = 0; r < 16; r += 2) {
        float e0 = X[r], e1 = X[r + 1];
        if (diag) {
          const int k0 = (r & 3) + 8 * (r >> 2) + 4 * hh, k1 = ((r + 1) & 3) + 8 * ((r + 1) >> 2) + 4 * hh;
          e0 = (k0 <= n) ? e0 : 0.f; e1 = (k1 <= n) ? e1 : 0.f;
        }
        pw[r >> 1] = pk_bf16(e0, e1);
      }
      bf16x8 pf0, pf1;
      { uint4 t0 = make_uint4(pw[0], pw[1], pw[2], pw[3]), t1 = make_uint4(pw[4], pw[5], pw[6], pw[7]);
        pf0 = *(bf16x8*)&t0; pf1 = *(bf16x8*)&t1; }
      O0 = __builtin_amdgcn_mfma_f32_32x32x16_bf16(vf[0], pf0, O0, 0, 0, 0);
      O0 = __builtin_amdgcn_mfma_f32_32x32x16_bf16(vf[1], pf1, O0, 0, 0, 0);
      O1 = __builtin_amdgcn_mfma_f32_32x32x16_bf16(vf[2], pf0, O1, 0, 0, 0);
      O1 = __builtin_amdgcn_mfma_f32_32x32x16_bf16(vf[3], pf1, O1, 0, 0, 0);
    }
    float ss = 0.f;
#pragma unroll
    for (int r = 0; r < 16; ++r) ss += O0[r] * O0[r] + O1[r] * O1[r];
    ss += __shfl_xor(ss, 32);
    const float rn = rsqrtf(ss / 64.0f + EPS);
    const size_t t = (size_t)b * S + s0 + n;
    const float* gp = p.proj() + t * INW + OFF_GR + h * 64;
    float* yo = p.ybuf() + t * D + 768 + h * 64;
#pragma unroll
    for (int q4 = 0; q4 < 4; ++q4) {
#pragma unroll
      for (int mb = 0; mb < 2; ++mb) {
        const int d0 = mb * 32 + 8 * q4 + 4 * hh;
        const float4 g = *(const float4*)(gp + d0);
        float4 o;
        const f32x16& Oa = mb ? O1 : O0;
        o.x = Oa[q4 * 4 + 0] * rn * g.x * fast_sigmoid(g.x); o.y = Oa[q4 * 4 + 1] * rn * g.y * fast_sigmoid(g.y);
        o.z = Oa[q4 * 4 + 2] * rn * g.z * fast_sigmoid(g.z); o.w = Oa[q4 * 4 + 3] * rn * g.w * fast_sigmoid(g.w);
        *(float4*)(yo + d0) = o;
      }
    }
  }
}

__device__ __forceinline__ void cvt_f32_bf16(const float* __restrict__ src, bf16_t* __restrict__ dst, size_t n8, int gtid, int ngt) {
  for (size_t i = gtid; i < n8; i += ngt) {
    float4 a = *(const float4*)(src + i * 8), b4 = *(const float4*)(src + i * 8 + 4);
    uint4 o; o.x = pk_bf16(a.x, a.y); o.y = pk_bf16(a.z, a.w); o.z = pk_bf16(b4.x, b4.y); o.w = pk_bf16(b4.z, b4.w);
    *(uint4*)(dst + i * 8) = o;
  }
}
__device__ __forceinline__ int f2key(float f) { int b = __float_as_int(f); return b ^ ((b >> 31) & 0x7fffffff); }
__device__ __forceinline__ float key2f(int k) { return __int_as_float(k ^ ((k >> 31) & 0x7fffffff)); }
#define CASD(a_, b_) { int mx_ = max(a_, b_), mn_ = min(a_, b_); a_ = mx_; b_ = mn_; }
__device__ __forceinline__ void sort16_desc(int (&v)[16]) {
#pragma unroll
  for (int k = 2; k <= 16; k <<= 1)
#pragma unroll
    for (int j = k >> 1; j > 0; j >>= 1)
#pragma unroll
      for (int i = 0; i < 16; ++i) { const int l2 = i ^ j; if (l2 > i) { if ((i & k) == 0) CASD(v[i], v[l2]) else CASD(v[l2], v[i]) } }
}
__device__ __forceinline__ void merge_top16(int (&a)[16], const int (&b)[16]) {
#pragma unroll
  for (int i = 0; i < 16; ++i) a[i] = max(a[i], b[15 - i]);
#pragma unroll
  for (int j = 8; j > 0; j >>= 1)
#pragma unroll
    for (int i = 0; i < 16; ++i) { const int l2 = i ^ j; if (l2 > i) CASD(a[i], a[l2]) }
}
__device__ __forceinline__ int lut4(int w0, int w1, int w2, int w3, int i) {
  const int w = i >> 2; const int d = (w == 0) ? w0 : (w == 1) ? w1 : (w == 2) ? w2 : w3;
  return (d >> ((i & 3) * 8)) & 127;
}

__device__ __forceinline__ void phase_peer_topk(const Params& p, int l, int gw, int ngw, int lane) {
  const int n = lane & 31, hh = lane >> 5;
  const bf16_t* skl = p.skb() + (size_t)l * 16 * 128 * 64;
  for (int w = gw; w < (T / 32) * 8; w += ngw) {
    const int tg = w >> 3, h = w & 7, t = tg * 32 + n;
    int L0[16], L1[16];
#pragma unroll
    for (int c = 0; c < 2; ++c) {
      const int hc = 2 * h + c;
      bf16x8 qf[4];
#pragma unroll
      for (int s = 0; s < 4; ++s) qf[s] = *(const bf16x8*)(p.qb() + (size_t)t * D + hc * 64 + 16 * s + 8 * hh);
      int A[16], Bq[16];
#pragma unroll
      for (int mb = 0; mb < 4; ++mb) {
        f32x16 X;
#pragma unroll
        for (int r = 0; r < 16; ++r) X[r] = 0.f;
#pragma unroll
        for (int s = 0; s < 4; ++s) {
          const bf16x8 kf = *(const bf16x8*)(skl + ((size_t)(hc * 128 + mb * 32 + n)) * 64 + 16 * s + 8 * hh);
          X = __builtin_amdgcn_mfma_f32_32x32x16_bf16(kf, qf[s], X, 0, 0, 0);
        }
        int Gk[16];
#pragma unroll
        for (int r = 0; r < 16; ++r) Gk[r] = (f2key(X[r]) & ~127) | (mb * 32 + (r & 3) + 8 * (r >> 2) + 4 * hh);
        sort16_desc(Gk);
        if (mb == 0) {
#pragma unroll
          for (int r = 0; r < 16; ++r) A[r] = Gk[r];
        } else merge_top16(A, Gk);
      }
#pragma unroll
      for (int r = 0; r < 16; ++r) Bq[r] = __shfl_xor(A[r], 32);
      merge_top16(A, Bq);
#pragma unroll
      for (int r = 0; r < 16; ++r) { if (c == 0) L0[r] = A[r]; else L1[r] = A[r]; }
    }
    float av[16], bv[16];
#pragma unroll
    for (int r = 0; r < 16; ++r) { av[r] = key2f(L0[r] & ~127); bv[r] = key2f(L1[r] & ~127); }
#define CAND(i_, j_) ((f2key(av[i_] + bv[j_]) & ~255) | ((i_) << 4) | (j_))
    int R[16], G1[16], G2[16];
#pragma unroll
    for (int j = 0; j < 16; ++j) R[j] = CAND(0, j);
    G1[0] = CAND(1, 0); G1[1] = CAND(1, 1); G1[2] = CAND(1, 2); G1[3] = CAND(1, 3); G1[4] = CAND(1, 4); G1[5] = CAND(1, 5); G1[6] = CAND(1, 6); G1[7] = CAND(1, 7);
    G1[8] = CAND(2, 0); G1[9] = CAND(2, 1); G1[10] = CAND(2, 2); G1[11] = CAND(2, 3); G1[12] = CAND(2, 4); G1[13] = CAND(3, 0); G1[14] = CAND(3, 1); G1[15] = CAND(3, 2);
    G2[0] = CAND(3, 3); G2[1] = CAND(4, 0); G2[2] = CAND(4, 1); G2[3] = CAND(4, 2); G2[4] = CAND(5, 0); G2[5] = CAND(5, 1); G2[6] = CAND(6, 0); G2[7] = CAND(6, 1);
    G2[8] = CAND(7, 0); G2[9] = CAND(7, 1); G2[10] = CAND(8, 0); G2[11] = CAND(9, 0); G2[12] = CAND(10, 0); G2[13] = CAND(11, 0); G2[14] = CAND(12, 0); G2[15] = CAND(13, 0);
    sort16_desc(G1); merge_top16(R, G1);
    sort16_desc(G2); merge_top16(R, G2);
    { int x0 = CAND(14, 0), x1 = CAND(15, 0);
#pragma unroll
      for (int i = 0; i < 16; ++i) CASD(R[i], x0)
#pragma unroll
      for (int i = 0; i < 16; ++i) CASD(R[i], x1)
    }
#undef CAND
    int pa0 = 0, pa1 = 0, pa2 = 0, pa3 = 0, pb0 = 0, pb1 = 0, pb2 = 0, pb3 = 0;
#pragma unroll
    for (int q = 0; q < 4; ++q) {
      pa0 |= (L0[q] & 127) << (8 * q); pa1 |= (L0[4 + q] & 127) << (8 * q); pa2 |= (L0[8 + q] & 127) << (8 * q); pa3 |= (L0[12 + q] & 127) << (8 * q);
      pb0 |= (L1[q] & 127) << (8 * q); pb1 |= (L1[4 + q] & 127) << (8 * q); pb2 |= (L1[8 + q] & 127) << (8 * q); pb3 |= (L1[12 + q] & 127) << (8 * q);
    }
    float ev[16], sum = 0.f; int ei[16];
    const float mx = key2f(R[0] & ~255);
#pragma unroll
    for (int z = 0; z < 16; ++z) {
      const float v = key2f(R[z] & ~255);
      ev[z] = __expf(v - mx); sum += ev[z];
      const int pay = R[z] & 255;
      ei[z] = lut4(pa0, pa1, pa2, pa3, pay >> 4) * 128 + lut4(pb0, pb1, pb2, pb3, pay & 15);
    }
    const float inv = 1.0f / sum;
    if (hh == 0) {
      float* go = p.gates() + ((size_t)t * 8 + h) * 16; int* eo = p.eidx() + ((size_t)t * 8 + h) * 16;
#pragma unroll
      for (int z = 0; z < 16; z += 4) {
        *(float4*)(go + z) = make_float4(ev[z] * inv, ev[z + 1] * inv, ev[z + 2] * inv, ev[z + 3] * inv);
        *(int4*)(eo + z) = make_int4(ei[z], ei[z + 1], ei[z + 2], ei[z + 3]);
      }
    }
  }
}

__device__ __forceinline__ void phase_peer_apply2(const Params& p, int l, float* coef, int gw, int ngw, int lane) {
  const float* g2 = p.in[16] + l * D;
  for (int t = gw; t < T; t += ngw) {
    const float r = p.rstd()[t];
    float hv[16];
#pragma unroll
    for (int i = 0; i < 2; ++i) {
      const float* xp = p.out + (size_t)t * D + i * 512 + lane * 8; const float* gp = g2 + i * 512 + lane * 8;
      float4 x0 = *(const float4*)xp, x1 = *(const float4*)(xp + 4), g0 = *(const float4*)gp, g1 = *(const float4*)(gp + 4);
      hv[i * 8 + 0] = x0.x * r * g0.x; hv[i * 8 + 1] = x0.y * r * g0.y; hv[i * 8 + 2] = x0.z * r * g0.z; hv[i * 8 + 3] = x0.w * r * g0.w;
      hv[i * 8 + 4] = x1.x * r * g1.x; hv[i * 8 + 5] = x1.y * r * g1.y; hv[i * 8 + 6] = x1.z * r * g1.z; hv[i * 8 + 7] = x1.w * r * g1.w;
    }
    const int e_lo = p.eidx()[(size_t)t * 128 + lane], e_hi = p.eidx()[(size_t)t * 128 + 64 + lane];
    const float g_lo = p.gates()[(size_t)t * 128 + lane], g_hi = p.gates()[(size_t)t * 128 + 64 + lane];
    LDS_FENCE();
#pragma unroll 1
    for (int half = 0; half < 2; ++half) {
      const int ev = half ? e_hi : e_lo;
      float mine = 0.f;
#pragma unroll 4
      for (int j = 0; j < 64; ++j) {
        const int e = __shfl(ev, j);
        const bf16_t* up = p.Ub() + (size_t)e * D + lane * 8;
        uint4 u0 = *(const uint4*)up, u1 = *(const uint4*)(up + 512);
        float d = 0.f;
        d = fmaf(hv[0], __uint_as_float(u0.x << 16), d); d = fmaf(hv[1], __uint_as_float(u0.x & 0xffff0000u), d);
        d = fmaf(hv[2], __uint_as_float(u0.y << 16), d); d = fmaf(hv[3], __uint_as_float(u0.y & 0xffff0000u), d);
        d = fmaf(hv[4], __uint_as_float(u0.z << 16), d); d = fmaf(hv[5], __uint_as_float(u0.z & 0xffff0000u), d);
        d = fmaf(hv[6], __uint_as_float(u0.w << 16), d); d = fmaf(hv[7], __uint_as_float(u0.w & 0xffff0000u), d);
        d = fmaf(hv[8], __uint_as_float(u1.x << 16), d); d = fmaf(hv[9], __uint_as_float(u1.x & 0xffff0000u), d);
        d = fmaf(hv[10], __uint_as_float(u1.y << 16), d); d = fmaf(hv[11], __uint_as_float(u1.y & 0xffff0000u), d);
        d = fmaf(hv[12], __uint_as_float(u1.z << 16), d); d = fmaf(hv[13], __uint_as_float(u1.z & 0xffff0000u), d);
        d = fmaf(hv[14], __uint_as_float(u1.w << 16), d); d = fmaf(hv[15], __uint_as_float(u1.w & 0xffff0000u), d);
        d = wave_sum(d);
        if (lane == j) mine = d;
      }
      coef[half * 64 + lane] = (half ? g_hi : g_lo) * gelu_tanh(mine);
    }
    LDS_FENCE();
    float acc[16];
#pragma unroll
    for (int i = 0; i < 16; ++i) acc[i] = 0.f;
#pragma unroll 1
    for (int half = 0; half < 2; ++half) {
      const int ev = half ? e_hi : e_lo;
#pragma unroll 4
      for (int j = 0; j < 64; ++j) {
        const int e = __shfl(ev, j);
        const float c = coef[half * 64 + j];
        const bf16_t* vp = p.Vb() + (size_t)e * D + lane * 8;
        uint4 v0 = *(const uint4*)vp, v1 = *(const uint4*)(vp + 512);
        acc[0] = fmaf(c, __uint_as_float(v0.x << 16), acc[0]); acc[1] = fmaf(c, __uint_as_float(v0.x & 0xffff0000u), acc[1]);
        acc[2] = fmaf(c, __uint_as_float(v0.y << 16), acc[2]); acc[3] = fmaf(c, __uint_as_float(v0.y & 0xffff0000u), acc[3]);
        acc[4] = fmaf(c, __uint_as_float(v0.z << 16), acc[4]); acc[5] = fmaf(c, __uint_as_float(v0.z & 0xffff0000u), acc[5]);
        acc[6] = fmaf(c, __uint_as_float(v0.w << 16), acc[6]); acc[7] = fmaf(c, __uint_as_float(v0.w & 0xffff0000u), acc[7]);
        acc[8] = fmaf(c, __uint_as_float(v1.x << 16), acc[8]); acc[9] = fmaf(c, __uint_as_float(v1.x & 0xffff0000u), acc[9]);
        acc[10] = fmaf(c, __uint_as_float(v1.y << 16), acc[10]); acc[11] = fmaf(c, __uint_as_float(v1.y & 0xffff0000u), acc[11]);
        acc[12] = fmaf(c, __uint_as_float(v1.z << 16), acc[12]); acc[13] = fmaf(c, __uint_as_float(v1.z & 0xffff0000u), acc[13]);
        acc[14] = fmaf(c, __uint_as_float(v1.w << 16), acc[14]); acc[15] = fmaf(c, __uint_as_float(v1.w & 0xffff0000u), acc[15]);
      }
    }
#pragma unroll
    for (int i = 0; i < 2; ++i) {
      float* xp = p.out + (size_t)t * D + i * 512 + lane * 8;
      float4 x0 = *(float4*)xp, x1 = *(float4*)(xp + 4);
      x0.x += acc[i * 8 + 0]; x0.y += acc[i * 8 + 1]; x0.z += acc[i * 8 + 2]; x0.w += acc[i * 8 + 3];
      x1.x += acc[i * 8 + 4]; x1.y += acc[i * 8 + 5]; x1.z += acc[i * 8 + 6]; x1.w += acc[i * 8 + 7];
      *(float4*)xp = x0; *(float4*)(xp + 4) = x1;
    }
  }
}

typedef int v8i __attribute__((ext_vector_type(8)));
__device__ __forceinline__ unsigned xcc_id() { return (unsigned)__builtin_amdgcn_s_getreg((3 << 11) | 20) & 7u; }
__device__ __forceinline__ float pow2_scale(float amax) {
  if (!(amax > 0.f)) return 1.0f;
  const int e = (int)floorf(log2f(240.0f / amax));
  return exp2f((float)(e < 60 ? (e > -60 ? e : -60) : 60));
}
__device__ __forceinline__ unsigned pack4_fp8(float a, float b, float c, float d) {
  int v = __builtin_amdgcn_cvt_pk_fp8_f32(a, b, 0, false);
  v = __builtin_amdgcn_cvt_pk_fp8_f32(c, d, v, true);
  return (unsigned)v;
}
__device__ __forceinline__ void cvt_table_fp8(const float* __restrict__ src, unsigned char* __restrict__ dst, float* __restrict__ scl, int gw, int ngw, int lane) {
  for (int e = gw; e < 16384; e += ngw) {
    float4 v[4]; float am = 0.f;
#pragma unroll
    for (int k = 0; k < 4; ++k) { v[k] = *(const float4*)(src + (size_t)e * D + k * 256 + lane * 4);
      am = fmaxf(am, fmaxf(fmaxf(fabsf(v[k].x), fabsf(v[k].y)), fmaxf(fabsf(v[k].z), fabsf(v[k].w)))); }
    am = wave_max(am);
    const float s = pow2_scale(am);
    if (lane == 0) scl[e] = s;
#pragma unroll
    for (int k = 0; k < 4; ++k) {
      const int slice = 2 * k + (lane >> 5), off = (lane & 31) * 4;
      *(unsigned*)(dst + ((size_t)slice * 16384 + e) * 128 + off) = pack4_fp8(v[k].x * s, v[k].y * s, v[k].z * s, v[k].w * s);
    }
  }
}
__device__ __forceinline__ void phase_cvt_rows_h8(const Params& p, int l, int gw, int ngw, int lane) {
  const float* g2 = p.in[16] + l * D;
  for (int t = gw; t < T; t += ngw) {
    float4 v[4]; float ss = 0.f;
#pragma unroll
    for (int k = 0; k < 4; ++k) {
      v[k] = *(const float4*)(p.out + (size_t)t * D + k * 256 + lane * 4);
      ss += v[k].x * v[k].x + v[k].y * v[k].y + v[k].z * v[k].z + v[k].w * v[k].w;
      uint2 ph; ph.x = pk_bf16(v[k].x, v[k].y); ph.y = pk_bf16(v[k].z, v[k].w);
      bf16_t* d = p.xb() + (size_t)t * KD + k * 256 + lane * 4;
      *(uint2*)d = ph;
      if (PRECISE) {
        uint2 pl; pl.x = pk_bf16(v[k].x - __uint_as_float(ph.x << 16), v[k].y - __uint_as_float(ph.x & 0xffff0000u));
        pl.y = pk_bf16(v[k].z - __uint_as_float(ph.y << 16), v[k].w - __uint_as_float(ph.y & 0xffff0000u));
        *(uint2*)(d + D) = ph; *(uint2*)(d + 2 * D) = pl;
      }
    }
    ss = wave_sum(ss);
    const float r = rsqrtf(ss / (float)D + EPS);
    if (lane == 0) p.rstd()[t] = r;
#pragma unroll
    for (int k = 0; k < 4; ++k) {
      const float4 g = *(const float4*)(g2 + k * 256 + lane * 4);
      const int slice = 2 * k + (lane >> 5), off = (lane & 31) * 4;
      uint2 o; o.x = pk_bf16(v[k].x * r * g.x, v[k].y * r * g.y); o.y = pk_bf16(v[k].z * r * g.z, v[k].w * r * g.w);
      *(uint2*)(p.hb() + ((size_t)slice * T + t) * 128 + off) = o;
    }
  }
}
#define DPP_ADD(v_, ctrl_) ((v_) + __builtin_bit_cast(float, __builtin_amdgcn_update_dpp(0, __builtin_bit_cast(int, (v_)), (ctrl_), 0xF, 0xF, true)))
__device__ __forceinline__ float sum_xor16(float x) { float a = x, b = x; asm volatile("v_nop\n\tv_nop\n\tv_permlane16_swap_b32 %0, %1" : "+v"(a), "+v"(b)); return a + b; }
__device__ __forceinline__ float sum_xor32(float x) { float a = x, b = x; asm volatile("v_nop\n\tv_nop\n\tv_permlane32_swap_b32 %0, %1" : "+v"(a), "+v"(b)); return a + b; }
__device__ __forceinline__ int q_pull(int* head, int nitems, int* bc, int tid) {
  __syncthreads();
  if (tid == 0) bc[0] = atomicAdd(head, 1);
  __syncthreads();
  const int v = bc[0];
  return v < nitems ? v : -1;
}
__device__ __forceinline__ void phase_peer_u(const Params& p, int* heads, unsigned char* lds, int tid) {
  const int lane = tid & 63, wv = tid >> 6, r8 = lane >> 3, c8 = lane & 7;
  int* bc = (int*)lds;
  int* eW = (int*)(lds + 1024 + wv * 4096);
  const int myx = (int)xcc_id();
  for (int pass = 0; pass < 8; ++pass) {
    const int s = (myx + pass) & 7;
    const unsigned char* Us = p.U8s() + (size_t)s * 16384 * 128 + c8 * 16;
    for (;;) {
      const int item = q_pull(heads + s, T / 64, bc, tid);
      if (item < 0) break;
      const int t0 = item * 64 + wv * 8;
      LDS_FENCE();
#pragma unroll
      for (int k = 0; k < 8; ++k) *(uint2*)(eW + k * 128 + lane * 2) = *(const uint2*)(p.eidx() + (size_t)(t0 + k) * 128 + lane * 2);
      LDS_FENCE();
      uint4 R[2][8];
#pragma unroll
      for (int eb = 0; eb < 8; ++eb) R[0][eb] = *(const uint4*)(Us + (size_t)eW[eb * 8 + r8] * 128);
      float hv[16]; float res0 = 0.f, res1 = 0.f;
      { const bf16_t* hp = p.hb() + ((size_t)s * T + t0) * 128 + c8 * 16; const uint4 a = *(const uint4*)hp, b4 = *(const uint4*)(hp + 8);
        const unsigned w8[8] = {a.x, a.y, a.z, a.w, b4.x, b4.y, b4.z, b4.w};
#pragma unroll
        for (int z = 0; z < 8; ++z) { hv[2 * z] = __uint_as_float(w8[z] << 16); hv[2 * z + 1] = __uint_as_float(w8[z] & 0xffff0000u); } }
#define PEER_U_HALF(M_, CUR_, NXT_, HASNEXT_)                                                                  \
      {                                                                                                                                   \
        if (HASNEXT_) {                                                                                                                   \
          _Pragma("unroll") for (int eb = 0; eb < 8; ++eb) R[NXT_][eb] = *(const uint4*)(Us + (size_t)eW[((M_) + 1) * 64 + eb * 8 + r8] * 128); \
        }                                                                                                                                 \
        _Pragma("unroll") for (int eb = 0; eb < 8; ++eb) {                                                                                \
          const unsigned ww[4] = {R[CUR_][eb].x, R[CUR_][eb].y, R[CUR_][eb].z, R[CUR_][eb].w};                                            \
          float d = 0.f;                                                                                                                  \
          _Pragma("unroll") for (int q4 = 0; q4 < 4; ++q4) {                                                                              \
            const auto f01 = __builtin_amdgcn_cvt_pk_f32_fp8((int)ww[q4], false); const auto f23 = __builtin_amdgcn_cvt_pk_f32_fp8((int)ww[q4], true); \
            d = fmaf(hv[q4 * 4 + 0], f01[0], d); d = fmaf(hv[q4 * 4 + 1], f01[1], d); d = fmaf(hv[q4 * 4 + 2], f23[0], d); d = fmaf(hv[q4 * 4 + 3], f23[1], d); \
          }                                                                                                                               \
          d = DPP_ADD(d, 0xB1); d = DPP_ADD(d, 0x4E); d = DPP_ADD(d, 0x141);     \
          if ((CUR_) == 0) { if (c8 == eb) res0 = d; } else { if (c8 == eb) res1 = d; }                                                   \
        }                                                                                                                                 \
        if ((CUR_) == 1) {                                                                                                                \
          float* po = p.ppart() + ((size_t)s * T + t0 + ((M_) >> 1)) * 128;                                                               \
          po[c8 * 8 + r8] = res0; po[64 + c8 * 8 + r8] = res1;                                                                            \
          if (HASNEXT_) {                                                                                                                 \
            const bf16_t* hp = p.hb() + ((size_t)s * T + t0 + ((M_) >> 1) + 1) * 128 + c8 * 16; const uint4 a = *(const uint4*)hp, b4 = *(const uint4*)(hp + 8); \
            const unsigned w8[8] = {a.x, a.y, a.z, a.w, b4.x, b4.y, b4.z, b4.w};                                                          \
            _Pragma("unroll") for (int z = 0; z < 8; ++z) { hv[2 * z] = __uint_as_float(w8[z] << 16); hv[2 * z + 1] = __uint_as_float(w8[z] & 0xffff0000u); } \
          }                                                                                                                               \
        }                                                                                                                                 \
      }
#pragma unroll 1
      for (int k = 0; k < 8; ++k) {
        PEER_U_HALF(2 * k, 0, 1, true)
        PEER_U_HALF(2 * k + 1, 1, 0, k < 7)
      }
#undef PEER_U_HALF
    }
  }
}
__device__ __forceinline__ void phase_peer_r(const Params& p, int gtid, int ngt) {
  for (int idx = gtid; idx < T * 128; idx += ngt) {
    float d = 0.f;
#pragma unroll
    for (int s = 0; s < 8; ++s) d += p.ppart()[(size_t)s * T * 128 + idx];
    const int e = p.eidx()[idx];
    d = d / p.su()[e];
    p.gates()[idx] = p.gates()[idx] * gelu_tanh(d) / p.sv()[e];
  }
}
__device__ __forceinline__ void phase_peer_v(const Params& p, int* heads, unsigned char* lds, int tid) {
  const int lane = tid & 63, wv = tid >> 6, r8 = lane >> 3, c8 = lane & 7;
  int* bc = (int*)lds;
  uint2* pW = (uint2*)(lds + 1024 + wv * 8192);
  const int myx = (int)xcc_id();
  for (int pass = 0; pass < 8; ++pass) {
    const int s = (myx + pass) & 7;
    const unsigned char* Vs = p.V8s() + (size_t)s * 16384 * 128 + c8 * 16;
    for (;;) {
      const int item = q_pull(heads + s, T / 64, bc, tid);
      if (item < 0) break;
      const int t0 = item * 64 + wv * 8;
      LDS_FENCE();
#pragma unroll
      for (int k = 0; k < 8; ++k) {
        const uint2 e2 = *(const uint2*)(p.eidx() + (size_t)(t0 + k) * 128 + lane * 2);
        const uint2 g2 = *(const uint2*)(p.gates() + (size_t)(t0 + k) * 128 + lane * 2);
        *(uint4*)(pW + k * 128 + lane * 2) = make_uint4(e2.x, g2.x, e2.y, g2.y);
      }
      LDS_FENCE();
      uint4 R[2][8];
#pragma unroll
      for (int eb = 0; eb < 8; ++eb) R[0][eb] = *(const uint4*)(Vs + (size_t)pW[eb * 8 + r8].x * 128);
      float acc[16];
      const int xoff = s * 128 + c8 * 16 + (r8 & 3) * 4;
      float4 xo = *(const float4*)(p.out + (size_t)t0 * D + xoff);
#define PEER_V_HALF(M_, CUR_, NXT_, HASNEXT_)                                                                  \
      {                                                                                                                                   \
        if (HASNEXT_) {                                                                                                                   \
          _Pragma("unroll") for (int eb = 0; eb < 8; ++eb) R[NXT_][eb] = *(const uint4*)(Vs + (size_t)pW[((M_) + 1) * 64 + eb * 8 + r8].x * 128); \
        }                                                                                                                                 \
        if ((CUR_) == 0) { _Pragma("unroll") for (int z = 0; z < 16; ++z) acc[z] = 0.f; }                                                 \
        _Pragma("unroll") for (int eb = 0; eb < 8; ++eb) {                                                                                \
          const float c = __uint_as_float(pW[(M_) * 64 + eb * 8 + r8].y);                                                                 \
          const unsigned ww[4] = {R[CUR_][eb].x, R[CUR_][eb].y, R[CUR_][eb].z, R[CUR_][eb].w};                                            \
          _Pragma("unroll") for (int q4 = 0; q4 < 4; ++q4) {                                                                              \
            const auto f01 = __builtin_amdgcn_cvt_pk_f32_fp8((int)ww[q4], false); const auto f23 = __builtin_amdgcn_cvt_pk_f32_fp8((int)ww[q4], true); \
            acc[q4 * 4 + 0] = fmaf(c, f01[0], acc[q4 * 4 + 0]); acc[q4 * 4 + 1] = fmaf(c, f01[1], acc[q4 * 4 + 1]);                       \
            acc[q4 * 4 + 2] = fmaf(c, f23[0], acc[q4 * 4 + 2]); acc[q4 * 4 + 3] = fmaf(c, f23[1], acc[q4 * 4 + 3]);                       \
          }                                                                                                                               \
        }                                                                                                                                 \
        if ((CUR_) == 1) {                                                                                                                \
          _Pragma("unroll") for (int z = 0; z < 16; ++z) { acc[z] = DPP_ADD(acc[z], 0x128); acc[z] = sum_xor16(acc[z]); acc[z] = sum_xor32(acc[z]); }     \
          const int sel = r8 & 3;                                                                                                         \
          float4 dl;                                                                                                                      \
          dl.x = sel == 0 ? acc[0] : sel == 1 ? acc[4] : sel == 2 ? acc[8] : acc[12];                                                     \
          dl.y = sel == 0 ? acc[1] : sel == 1 ? acc[5] : sel == 2 ? acc[9] : acc[13];                                                     \
          dl.z = sel == 0 ? acc[2] : sel == 1 ? acc[6] : sel == 2 ? acc[10] : acc[14];                                                    \
          dl.w = sel == 0 ? acc[3] : sel == 1 ? acc[7] : sel == 2 ? acc[11] : acc[15];                                                    \
          float* xp = p.out + (size_t)(t0 + ((M_) >> 1)) * D + xoff;                                                                      \
          if (r8 < 4) *(float4*)xp = make_float4(xo.x + dl.x, xo.y + dl.y, xo.z + dl.z, xo.w + dl.w);                                     \
          if (HASNEXT_) xo = *(const float4*)(xp + D);                                                                                    \
        }                                                                                                                                 \
      }
#pragma unroll 1
      for (int k = 0; k < 8; ++k) {
        PEER_V_HALF(2 * k, 0, 1, true)
        PEER_V_HALF(2 * k + 1, 1, 0, k < 7)
      }
#undef PEER_V_HALF
    }
  }
}

#if PEER_CHECK
constexpr int CHK_N = 512;
__device__ __forceinline__ float* chk_x(const Params& p) { return (float*)(p.ws + WO_ybuf); }
__device__ __forceinline__ float* chk_m(const Params& p) { return (float*)(p.ws + WO_ybuf + (size_t)CHK_N * D * 4); }
__device__ __forceinline__ float* chk_g(const Params& p) { return (float*)(p.ws + WO_ybuf + (size_t)CHK_N * D * 4 + 4096); }
__device__ __forceinline__ void chk_save(const Params& p, int gtid, int ngt) {
  for (int i = gtid; i < CHK_N * D; i += ngt) chk_x(p)[i] = p.out[(size_t)(i / D) * 64 * D + (i % D)];
  for (int i = gtid; i < CHK_N * 128; i += ngt) chk_g(p)[i] = p.gates()[(size_t)(i / 128) * 64 * 128 + (i % 128)];
  if (gtid < 16) chk_m(p)[gtid] = 0.f;
}
__device__ __forceinline__ void chk_apply(const Params& p, int l, float* coef, int gw, int ngw, int lane) {
  const float* g2 = p.in[16] + l * D;
  const float* U = p.in[19] + (size_t)l * 16384 * D; const float* V = p.in[20] + (size_t)l * 16384 * D;
  for (int i = gw; i < CHK_N; i += ngw) {
    const int t = i * 64;
    const float r = p.rstd()[t];
    float4 hv[4];
#pragma unroll
    for (int k = 0; k < 4; ++k) {
      float4 xv = *(const float4*)(chk_x(p) + (size_t)i * D + (lane + k * 64) * 4);
      float4 gv = *(const float4*)(g2 + (lane + k * 64) * 4);
      hv[k].x = xv.x * r * gv.x; hv[k].y = xv.y * r * gv.y; hv[k].z = xv.z * r * gv.z; hv[k].w = xv.w * r * gv.w;
    }
    LDS_FENCE();
    for (int j = 0; j < 128; ++j) {
      const int e = p.eidx()[(size_t)t * 128 + j];
      const float4* up = (const float4*)(U + (size_t)e * D);
      float dsum = 0.f;
#pragma unroll
      for (int k = 0; k < 4; ++k) { float4 uv = up[lane + k * 64]; dsum += hv[k].x * uv.x + hv[k].y * uv.y + hv[k].z * uv.z + hv[k].w * uv.w; }
      dsum = wave_sum(dsum);
      if (lane == 0) coef[j] = chk_g(p)[(size_t)i * 128 + j] * gelu_tanh(dsum);
    }
    LDS_FENCE();
    float4 acc[4];
#pragma unroll
    for (int k = 0; k < 4; ++k) acc[k] = make_float4(0.f, 0.f, 0.f, 0.f);
    for (int j = 0; j < 128; ++j) {
      const int e = p.eidx()[(size_t)t * 128 + j];
      const float c = coef[j];
      const float4* vp = (const float4*)(V + (size_t)e * D);
#pragma unroll
      for (int k = 0; k < 4; ++k) { float4 vv = vp[lane + k * 64]; acc[k].x = fmaf(c, vv.x, acc[k].x); acc[k].y = fmaf(c, vv.y, acc[k].y); acc[k].z = fmaf(c, vv.z, acc[k].z); acc[k].w = fmaf(c, vv.w, acc[k].w); }
    }
    float d2 = 0.f, r2 = 0.f;
#pragma unroll
    for (int k = 0; k < 4; ++k) {
      float4 xa = *(const float4*)(p.out + (size_t)t * D + (lane + k * 64) * 4);
      float4 xb4 = *(const float4*)(chk_x(p) + (size_t)i * D + (lane + k * 64) * 4);
      float e0 = (xa.x - xb4.x) - acc[k].x, e1 = (xa.y - xb4.y) - acc[k].y, e2 = (xa.z - xb4.z) - acc[k].z, e3 = (xa.w - xb4.w) - acc[k].w;
      d2 += e0 * e0 + e1 * e1 + e2 * e2 + e3 * e3;
      r2 += acc[k].x * acc[k].x + acc[k].y * acc[k].y + acc[k].z * acc[k].z + acc[k].w * acc[k].w;
    }
    d2 = wave_sum(d2); r2 = wave_sum(r2);
    if (lane == 0) { atomicAdd((unsigned long long*)&chk_m(p)[8], (unsigned long long)(d2 * 1099511627776.0f)); atomicAdd((unsigned long long*)&chk_m(p)[10], (unsigned long long)(r2 * 1099511627776.0f)); }
  }
}
__device__ __forceinline__ void chk_topk(const Params& p, int l, int gtid, int ngt) {
  const float* subk = p.in[18] + (size_t)l * 16 * 128 * 64;
  for (int it = gtid; it < CHK_N * 8; it += ngt) {
    const int i = it >> 3, h = it & 7, t = i * 64;
    float tva[16], tvb[16]; int tia[16], tib[16];
#pragma unroll 1
    for (int c = 0; c < 2; ++c) {
      float tv[16]; int ti[16];
#pragma unroll
      for (int z = 0; z < 16; ++z) { tv[z] = -INFINITY; ti[z] = 0; }
      const bf16_t* q = p.qb() + (size_t)t * D + (2 * h + c) * 64;
      const float* kb = subk + (size_t)(2 * h + c) * 128 * 64;
#pragma unroll 1
      for (int n = 0; n < 128; ++n) {
        float sc = 0.f;
        for (int d = 0; d < 64; ++d) sc = fmaf(bf2f(q[d]), kb[n * 64 + d], sc);
        float v_ = sc; int i_ = n;
#pragma unroll
        for (int z = 0; z < 16; ++z) { bool gt = v_ > tv[z]; float a = tv[z]; int b = ti[z]; tv[z] = gt ? v_ : a; ti[z] = gt ? i_ : b; v_ = gt ? a : v_; i_ = gt ? b : i_; }
      }
#pragma unroll
      for (int z = 0; z < 16; ++z) { if (c == 0) { tva[z] = tv[z]; tia[z] = ti[z]; } else { tvb[z] = tv[z]; tib[z] = ti[z]; } }
    }
    float tv[16]; int ti[16];
#pragma unroll
    for (int z = 0; z < 16; ++z) { tv[z] = -INFINITY; ti[z] = 0; }
#pragma unroll 1
    for (int a = 0; a < 16; ++a)
#pragma unroll 1
      for (int b = 0; b < 16; ++b) {
        float av = 0.f, bv = 0.f; int ai = 0, bi = 0;
#pragma unroll
        for (int z = 0; z < 16; ++z) { if (z == a) { av = tva[z]; ai = tia[z]; } if (z == b) { bv = tvb[z]; bi = tib[z]; } }
        float v_ = av + bv; int i_ = ai * 128 + bi;
#pragma unroll
        for (int z = 0; z < 16; ++z) { bool gt = v_ > tv[z]; float x = tv[z]; int y = ti[z]; tv[z] = gt ? v_ : x; ti[z] = gt ? i_ : y; v_ = gt ? x : v_; i_ = gt ? y : i_; }
      }
    float sum = 0.f, ev[16];
#pragma unroll
    for (int z = 0; z < 16; ++z) { ev[z] = expf(tv[z] - tv[0]); sum += ev[z]; }
    int miss = 0; float gerr = 0.f;
    for (int z = 0; z < 16; ++z) {
      const int ef = p.eidx()[((size_t)t * 8 + h) * 16 + z]; const float gf = p.gates()[((size_t)t * 8 + h) * 16 + z];
      bool found = false;
#pragma unroll
      for (int y = 0; y < 16; ++y) if (ti[y] == ef) { found = true; gerr = fmaxf(gerr, fabsf(ev[y] / sum - gf)); }
      if (!found) ++miss;
    }
    atomicAdd(&chk_m(p)[3], (float)miss);
    atomicMax((int*)&chk_m(p)[4], __float_as_int(gerr));
  }
}
__device__ __forceinline__ void chk_emit(const Params& p) {
  float v = 0.f;
  if (PEER_CHECK == 1) v = sqrtf((float)((double)*(unsigned long long*)&chk_m(p)[8] / (double)*(unsigned long long*)&chk_m(p)[10]));
  if (PEER_CHECK == 2) v = chk_m(p)[3] / (float)(CHK_N * 8 * 16);
  if (PEER_CHECK == 3) v = chk_m(p)[4];
  p.out[0] += 1.0e4f * v + 100.0f;
}
#endif

#define XB_TMO      128
#define XB_XCNT(j)  (256  + 64 * (j))
#define XB_XSUB(j)  (1280 + 64 * (j))
#define XB_XGEN(j)  (2304 + 64 * (j))
#define XB_TOP      3328
#define XB_TOPGEN   3392
#define XCD_BAR_WORDS 3456
#define XB_SPIN_CAP (1u << 18)
#define LAS __attribute__((address_space(3)))

__device__ __forceinline__ unsigned xb_ld(unsigned* p)              { return __hip_atomic_load(p, __ATOMIC_RELAXED, __HIP_MEMORY_SCOPE_AGENT); }
__device__ __forceinline__ unsigned xb_add(unsigned* p, unsigned v) { return __hip_atomic_fetch_add(p, v, __ATOMIC_RELAXED, __HIP_MEMORY_SCOPE_AGENT); }
__device__ __forceinline__ unsigned xb_xcc_id() { return (unsigned)__builtin_amdgcn_s_getreg((3 << 11) | 20) & 0xFu; }
#define XB_SPIN(cond, bar) do { unsigned _sp = 0; while (cond) { __builtin_amdgcn_s_sleep(1); \
    if ((++_sp & 255u) == 0u) { if (xb_ld(&(bar)[XB_TMO])) break; if (_sp > XB_SPIN_CAP) { atomicAdd(&(bar)[XB_TMO], 1u); break; } } } } while (0)

struct XcdBarrier {
    unsigned* bar; unsigned x;
    volatile LAS unsigned* st;
};

__device__ __forceinline__ XcdBarrier xcd_barrier_post(unsigned* bar, volatile LAS unsigned* st) {
    XcdBarrier b; b.bar = bar; b.x = xb_xcc_id(); b.st = st;
    if (threadIdx.x == 0) (void)xb_add(&bar[XB_XCNT(b.x)], 1u);
    return b;
}
__device__ __forceinline__ void xcd_barrier_complete(unsigned* bar, unsigned x, unsigned& nloc, unsigned& nx) {
    const unsigned G = gridDim.x * gridDim.y * gridDim.z;
    unsigned sum, cnt, mine, sp = 0u;
    for (;;) {
        sum = 0u; cnt = 0u; mine = 0u;
#pragma unroll
        for (unsigned j = 0; j < 16; ++j) { const unsigned c = xb_ld(&bar[XB_XCNT(j)]); sum += c; cnt += (c > 0u) ? 1u : 0u; mine = (j == x) ? c : mine; }
        if (sum == G) break;
        __builtin_amdgcn_s_sleep(1);
        if ((++sp & 255u) == 0u) { if (xb_ld(&bar[XB_TMO])) break; if (sp > XB_SPIN_CAP) { atomicAdd(&bar[XB_TMO], 1u); break; } }
    }
    nloc = mine > 0u ? mine : 1u; nx = cnt > 0u ? cnt : 1u;
}

__device__ __forceinline__ void xcd_barrier(const XcdBarrier& b) {
    asm volatile("s_waitcnt vmcnt(0)" ::: "memory");
    __syncthreads();
    if (threadIdx.x == 0) {
        unsigned* bar = b.bar;
        __builtin_amdgcn_s_waitcnt(0);
        unsigned nloc = b.st[0], nx = b.st[1];
        if (nloc == 0u) { xcd_barrier_complete(bar, b.x, nloc, nx); b.st[0] = nloc; b.st[1] = nx; }
        const unsigned old = xb_add(&bar[XB_XSUB(b.x)], 1u);
        const unsigned gen = old / nloc;
        if (old + 1u == (gen + 1u) * nloc) {
            __builtin_amdgcn_fence(__ATOMIC_RELEASE, "agent");
            asm volatile("s_waitcnt vmcnt(0)" ::: "memory");
            const unsigned og = xb_add(&bar[XB_TOP], 1u);
            const unsigned tg = og / nx;
            if (og + 1u == (tg + 1u) * nx) xb_add(&bar[XB_TOPGEN], 1u);
            else XB_SPIN(xb_ld(&bar[XB_TOPGEN]) == tg, bar);
            __builtin_amdgcn_fence(__ATOMIC_ACQUIRE, "agent");
            xb_add(&bar[XB_XGEN(b.x)], 1u);
            asm volatile("s_waitcnt vmcnt(0)" ::: "memory");
        } else {
            XB_SPIN(xb_ld(&bar[XB_XGEN(b.x)]) == gen, bar);
            __builtin_amdgcn_fence(__ATOMIC_ACQUIRE, "agent");
            asm volatile("s_waitcnt vmcnt(0)" ::: "memory");
        }
    }
    __syncthreads();
}

__device__ __forceinline__ Params fresh(const Params& p) {
  Params q = p;
  asm volatile("" : "+s"(q.ws), "+s"(q.out));
#pragma unroll
  for (int i = 0; i < 21; ++i) asm volatile("" : "+s"(q.in[i]));
  return q;
}
#define PHASE_IDS int tid = threadIdx.x; asm volatile("" : "+v"(tid)); int bid = blockIdx.x; asm volatile("" : "+s"(bid)); int G = gridDim.x; asm volatile("" : "+s"(G)); \
  const int lane = tid & 63, wv = tid >> 6; const int ngt = G * NTHR, ngw = G * NWAVE; \
  const int gtid = bid * NTHR + tid, gw = bid * NWAVE + wv; (void)lane; (void)wv; (void)gtid; (void)gw; (void)ngt; (void)ngw; \
  const Params q = fresh(p);
__global__ void __launch_bounds__(NTHR) mega(Params p) {
  extern __shared__ __attribute__((aligned(16))) unsigned char lds_raw[];
  cg::grid_group grid = cg::this_grid();
  float* ldsf = (float*)lds_raw;
  if (threadIdx.x == 0) { *(uint4*)(lds_raw + LDS_BYTES - 16) = make_uint4(0u, 0u, 0u, 0u); }
  __syncthreads();
  XcdBarrier xb = xcd_barrier_post(p.bar(), (volatile LAS unsigned*)(lds_raw + LDS_BYTES - 16));

  { PHASE_IDS; phase_prologue(q, gtid, ngt, gw, ngw, lane); cvt_f32_bf16(q.in[18], q.skb(), (size_t)NL * 16 * 128 * 64 / 8, gtid, ngt);
    for (size_t i = gtid; i < (size_t)16 * 256 * 512 / 8; i += ngt) ((uint4*)q.S5Wz())[i] = make_uint4(0u, 0u, 0u, 0u);
    if (gtid < 256) q.qctr()[gtid] = 0; }
  grid.sync();
  { constexpr int l = 0;
    DUP(6) {
    { PHASE_IDS; phase_cvt_rows(q.out, q.xb(), q.rstd(), gw, ngw, lane);
      phase_s5_prep(q, l, gtid, ngt);
 }
    xcd_barrier(xb);
    }
    DUP(5) {
    { const Params q = fresh(p); EpiScaleStore e{q.proj(), INW, q.rstd()};
      run_gemm(lds_raw, q.xb(), q.Win_t() + (size_t)l * INW * KD, T, INW, KD, e); }
    xcd_barrier(xb);
    }
    { PHASE_IDS; phase_postproj(q, l, gw, ngw, lane); }
    xcd_barrier(xb);
    DUP(0) {
    { PHASE_IDS; phase_kmean(q, gtid, ngt); phase_pack_moba(q, gtid, ngt); phase_pack_u(q, gtid, ngt); phase_pack_ret(q, gtid, ngt); }
    xcd_barrier(xb);
    }
    DUP(1) {
    { const Params q = fresh(p); EpiS5Z e{q.S5Z()};
      pg8::Gemm g{q.S5A(), q.S5Wz(), 16 * 1024, 16 * 256, 512, 640, 512}; pg8::GroupOrder So; So.init(16, 4, 1, (int)gridDim.x, (int)blockIdx.x);
      pg8::gemm_phase<EpiS5Z, pg8::GroupOrder, true, true>((PG8_LAS unsigned char*)lds_raw, g, So, e); }
    __syncthreads();
    { PHASE_IDS; phase_moba2(q, l, lds_raw, bid, G); }
    { PHASE_IDS; phase_ret_kv(q, gw, ngw, lane); }
    xcd_barrier(xb);
    }
    DUP(2) {
    { PHASE_IDS; phase_s5_scan(q, gtid, ngt); phase_ret_scan(q, gtid, ngt); }
    xcd_barrier(xb);
    }
    DUP(3) {
    { const Params q = fresh(p); EpiS5Y e{q.ygb(), q.S5A(), q.in[10] + l * 256};
      pg8::Gemm g{q.S5A(), q.S5Wy(), 16 * 1024, 16 * 512, 640, 640, 640}; pg8::GroupOrder So; So.init(16, 4, 2, (int)gridDim.x, (int)blockIdx.x);
      pg8::gemm_phase<EpiS5Y, pg8::GroupOrder, true, true>((PG8_LAS unsigned char*)lds_raw, g, So, e); }
    __syncthreads();
    { PHASE_IDS; phase_ret_out(q, gw, ngw, lane); }
    xcd_barrier(xb);
    }
    DUP(4) {
    { const Params q = fresh(p); EpiGlu e{q.ybuf(), q.ygb(), (float*)(lds_raw + 131072)};
      run_gemm(lds_raw, q.ygb(), q.Wglu_t() + (size_t)l * 65536, T, 256, 256, e); }
    xcd_barrier(xb);
    }
    DUP(9) {
    { PHASE_IDS; phase_cvt_rows(q.ybuf(), q.xb(), nullptr, gw, ngw, lane); }
    xcd_barrier(xb);
    }
    { const Params q = fresh(p); EpiAccum e{q.out, D};
      run_gemm(lds_raw, q.xb(), q.Wout_t() + (size_t)l * D * KD, T, D, KD, e); }
    xcd_barrier(xb);
    { PHASE_IDS; phase_cvt_rows_h8(q, l, gw, ngw, lane);
      cvt_table_fp8(q.in[19] + (size_t)l * 16384 * D, q.U8s(), q.su(), gw, ngw, lane);
      cvt_table_fp8(q.in[20] + (size_t)l * 16384 * D, q.V8s(), q.sv(), gw, ngw, lane); }
    xcd_barrier(xb);
    DUP(7) {
    { const Params q = fresh(p); EpiScaleStoreBf16 e{q.qb(), D, q.rstd()};
      run_gemm(lds_raw, q.xb(), q.Wq_t() + (size_t)l * D * KD, T, D, KD, e); }
    xcd_barrier(xb);
    }
    if (!(PROBE_SKIP & 2)) {
    { PHASE_IDS; phase_peer_topk(q, l, gw, ngw, lane); }
    xcd_barrier(xb);
    }
#if PEER_CHECK
    if (l == 0) { { PHASE_IDS; chk_save(q, gtid, ngt); } xcd_barrier(xb); { PHASE_IDS; chk_topk(q, l, gtid, ngt); } xcd_barrier(xb); }
#endif
    if (!(PROBE_SKIP & 1)) {
    { PHASE_IDS; phase_peer_u(q, q.qctr() + (l * 2 + 0) * 8, lds_raw, tid); }
    xcd_barrier(xb);
    { PHASE_IDS; phase_peer_r(q, gtid, ngt); }
    xcd_barrier(xb);
    if (!(PROBE_SKIP & 32)) {
    { PHASE_IDS; phase_peer_v(q, q.qctr() + (l * 2 + 1) * 8, lds_raw, tid); }
    xcd_barrier(xb);
    }
    }
#if PEER_CHECK
    if (l == 0) { { PHASE_IDS; chk_apply(q, l, ldsf + wv * 128, gw, ngw, lane); } xcd_barrier(xb);
      if (blockIdx.x == 0 && threadIdx.x == 0) { const Params q = fresh(p); chk_emit(q); } xcd_barrier(xb); }
#endif
  }
  { constexpr int l = 1;
    DUP(6) {
    { PHASE_IDS; phase_cvt_rows(q.out, q.xb(), q.rstd(), gw, ngw, lane);
      phase_s5_prep(q, l, gtid, ngt);
 }
    xcd_barrier(xb);
    }
    DUP(5) {
    { const Params q = fresh(p); EpiScaleStore e{q.proj(), INW, q.rstd()};
      run_gemm(lds_raw, q.xb(), q.Win_t() + (size_t)l * INW * KD, T, INW, KD, e); }
    xcd_barrier(xb);
    }
    { PHASE_IDS; phase_postproj(q, l, gw, ngw, lane); }
    xcd_barrier(xb);
    DUP(0) {
    { PHASE_IDS; phase_kmean(q, gtid, ngt); phase_pack_moba(q, gtid, ngt); phase_pack_u(q, gtid, ngt); phase_pack_ret(q, gtid, ngt); }
    xcd_barrier(xb);
    }
    DUP(1) {
    { const Params q = fresh(p); EpiS5Z e{q.S5Z()};
      pg8::Gemm g{q.S5A(), q.S5Wz(), 16 * 1024, 16 * 256, 512, 640, 512}; pg8::GroupOrder So; So.init(16, 4, 1, (int)gridDim.x, (int)blockIdx.x);
      pg8::gemm_phase<EpiS5Z, pg8::GroupOrder, true, true>((PG8_LAS unsigned char*)lds_raw, g, So, e); }
    __syncthreads();
    { PHASE_IDS; phase_moba2(q, l, lds_raw, bid, G); }
    { PHASE_IDS; phase_ret_kv(q, gw, ngw, lane); }
    xcd_barrier(xb);
    }
    DUP(2) {
    { PHASE_IDS; phase_s5_scan(q, gtid, ngt); phase_ret_scan(q, gtid, ngt); }
    xcd_barrier(xb);
    }
    DUP(3) {
    { const Params q = fresh(p); EpiS5Y e{q.ygb(), q.S5A(), q.in[10] + l * 256};
      pg8::Gemm g{q.S5A(), q.S5Wy(), 16 * 1024, 16 * 512, 640, 640, 640}; pg8::GroupOrder So; So.init(16, 4, 2, (int)gridDim.x, (int)blockIdx.x);
      pg8::gemm_phase<EpiS5Y, pg8::GroupOrder, true, true>((PG8_LAS unsigned char*)lds_raw, g, So, e); }
    __syncthreads();
    { PHASE_IDS; phase_ret_out(q, gw, ngw, lane); }
    xcd_barrier(xb);
    }
    DUP(4) {
    { const Params q = fresh(p); EpiGlu e{q.ybuf(), q.ygb(), (float*)(lds_raw + 131072)};
      run_gemm(lds_raw, q.ygb(), q.Wglu_t() + (size_t)l * 65536, T, 256, 256, e); }
    xcd_barrier(xb);
    }
    DUP(9) {
    { PHASE_IDS; phase_cvt_rows(q.ybuf(), q.xb(), nullptr, gw, ngw, lane); }
    xcd_barrier(xb);
    }
    { const Params q = fresh(p); EpiAccum e{q.out, D};
      run_gemm(lds_raw, q.xb(), q.Wout_t() + (size_t)l * D * KD, T, D, KD, e); }
    xcd_barrier(xb);
    { PHASE_IDS; phase_cvt_rows_h8(q, l, gw, ngw, lane);
      cvt_table_fp8(q.in[19] + (size_t)l * 16384 * D, q.U8s(), q.su(), gw, ngw, lane);
      cvt_table_fp8(q.in[20] + (size_t)l * 16384 * D, q.V8s(), q.sv(), gw, ngw, lane); }
    xcd_barrier(xb);
    DUP(7) {
    { const Params q = fresh(p); EpiScaleStoreBf16 e{q.qb(), D, q.rstd()};
      run_gemm(lds_raw, q.xb(), q.Wq_t() + (size_t)l * D * KD, T, D, KD, e); }
    xcd_barrier(xb);
    }
    if (!(PROBE_SKIP & 2)) {
    { PHASE_IDS; phase_peer_topk(q, l, gw, ngw, lane); }
    xcd_barrier(xb);
    }
#if PEER_CHECK
    if (l == 0) { { PHASE_IDS; chk_save(q, gtid, ngt); } xcd_barrier(xb); { PHASE_IDS; chk_topk(q, l, gtid, ngt); } xcd_barrier(xb); }
#endif
    if (!(PROBE_SKIP & 1)) {
    { PHASE_IDS; phase_peer_u(q, q.qctr() + (l * 2 + 0) * 8, lds_raw, tid); }
    xcd_barrier(xb);
    { PHASE_IDS; phase_peer_r(q, gtid, ngt); }
    xcd_barrier(xb);
    if (!(PROBE_SKIP & 32)) {
    { PHASE_IDS; phase_peer_v(q, q.qctr() + (l * 2 + 1) * 8, lds_raw, tid); }
    xcd_barrier(xb);
    }
    }
#if PEER_CHECK
    if (l == 0) { { PHASE_IDS; chk_apply(q, l, ldsf + wv * 128, gw, ngw, lane); } xcd_barrier(xb);
      if (blockIdx.x == 0 && threadIdx.x == 0) { const Params q = fresh(p); chk_emit(q); } xcd_barrier(xb); }
#endif
  }
  { constexpr int l = 2;
    DUP(6) {
    { PHASE_IDS; phase_cvt_rows(q.out, q.xb(), q.rstd(), gw, ngw, lane);
      phase_s5_prep(q, l, gtid, ngt);
 }
    xcd_barrier(xb);
    }
    DUP(5) {
    { const Params q = fresh(p); EpiScaleStore e{q.proj(), INW, q.rstd()};
      run_gemm(lds_raw, q.xb(), q.Win_t() + (size_t)l * INW * KD, T, INW, KD, e); }
    xcd_barrier(xb);
    }
    { PHASE_IDS; phase_postproj(q, l, gw, ngw, lane); }
    xcd_barrier(xb);
    DUP(0) {
    { PHASE_IDS; phase_kmean(q, gtid, ngt); phase_pack_moba(q, gtid, ngt); phase_pack_u(q, gtid, ngt); phase_pack_ret(q, gtid, ngt); }
    xcd_barrier(xb);
    }
    DUP(1) {
    { const Params q = fresh(p); EpiS5Z e{q.S5Z()};
      pg8::Gemm g{q.S5A(), q.S5Wz(), 16 * 1024, 16 * 256, 512, 640, 512}; pg8::GroupOrder So; So.init(16, 4, 1, (int)gridDim.x, (int)blockIdx.x);
      pg8::gemm_phase<EpiS5Z, pg8::GroupOrder, true, true>((PG8_LAS unsigned char*)lds_raw, g, So, e); }
    __syncthreads();
    { PHASE_IDS; phase_moba2(q, l, lds_raw, bid, G); }
    { PHASE_IDS; phase_ret_kv(q, gw, ngw, lane); }
    xcd_barrier(xb);
    }
    DUP(2) {
    { PHASE_IDS; phase_s5_scan(q, gtid, ngt); phase_ret_scan(q, gtid, ngt); }
    xcd_barrier(xb);
    }
    DUP(3) {
    { const Params q = fresh(p); EpiS5Y e{q.ygb(), q.S5A(), q.in[10] + l * 256};
      pg8::Gemm g{q.S5A(), q.S5Wy(), 16 * 1024, 16 * 512, 640, 640, 640}; pg8::GroupOrder So; So.init(16, 4, 2, (int)gridDim.x, (int)blockIdx.x);
      pg8::gemm_phase<EpiS5Y, pg8::GroupOrder, true, true>((PG8_LAS unsigned char*)lds_raw, g, So, e); }
    __syncthreads();
    { PHASE_IDS; phase_ret_out(q, gw, ngw, lane); }
    xcd_barrier(xb);
    }
    DUP(4) {
    { const Params q = fresh(p); EpiGlu e{q.ybuf(), q.ygb(), (float*)(lds_raw + 131072)};
      run_gemm(lds_raw, q.ygb(), q.Wglu_t() + (size_t)l * 65536, T, 256, 256, e); }
    xcd_barrier(xb);
    }
    DUP(9) {
    { PHASE_IDS; phase_cvt_rows(q.ybuf(), q.xb(), nullptr, gw, ngw, lane); }
    xcd_barrier(xb);
    }
    { const Params q = fresh(p); EpiAccum e{q.out, D};
      run_gemm(lds_raw, q.xb(), q.Wout_t() + (size_t)l * D * KD, T, D, KD, e); }
    xcd_barrier(xb);
    { PHASE_IDS; phase_cvt_rows_h8(q, l, gw, ngw, lane);
      cvt_table_fp8(q.in[19] + (size_t)l * 16384 * D, q.U8s(), q.su(), gw, ngw, lane);
      cvt_table_fp8(q.in[20] + (size_t)l * 16384 * D, q.V8s(), q.sv(), gw, ngw, lane); }
    xcd_barrier(xb);
    DUP(7) {
    { const Params q = fresh(p); EpiScaleStoreBf16 e{q.qb(), D, q.rstd()};
      run_gemm(lds_raw, q.xb(), q.Wq_t() + (size_t)l * D * KD, T, D, KD, e); }
    xcd_barrier(xb);
    }
    if (!(PROBE_SKIP & 2)) {
    { PHASE_IDS; phase_peer_topk(q, l, gw, ngw, lane); }
    xcd_barrier(xb);
    }
#if PEER_CHECK
    if (l == 0) { { PHASE_IDS; chk_save(q, gtid, ngt); } xcd_barrier(xb); { PHASE_IDS; chk_topk(q, l, gtid, ngt); } xcd_barrier(xb); }
#endif
    if (!(PROBE_SKIP & 1)) {
    { PHASE_IDS; phase_peer_u(q, q.qctr() + (l * 2 + 0) * 8, lds_raw, tid); }
    xcd_barrier(xb);
    { PHASE_IDS; phase_peer_r(q, gtid, ngt); }
    xcd_barrier(xb);
    if (!(PROBE_SKIP & 32)) {
    { PHASE_IDS; phase_peer_v(q, q.qctr() + (l * 2 + 1) * 8, lds_raw, tid); }
    xcd_barrier(xb);
    }
    }
#if PEER_CHECK
    if (l == 0) { { PHASE_IDS; chk_apply(q, l, ldsf + wv * 128, gw, ngw, lane); } xcd_barrier(xb);
      if (blockIdx.x == 0 && threadIdx.x == 0) { const Params q = fresh(p); chk_emit(q); } xcd_barrier(xb); }
#endif
  }
  { constexpr int l = 3;
    DUP(6) {
    { PHASE_IDS; phase_cvt_rows(q.out, q.xb(), q.rstd(), gw, ngw, lane);
      phase_s5_prep(q, l, gtid, ngt);
 }
    xcd_barrier(xb);
    }
    DUP(5) {
    { const Params q = fresh(p); EpiScaleStore e{q.proj(), INW, q.rstd()};
      run_gemm(lds_raw, q.xb(), q.Win_t() + (size_t)l * INW * KD, T, INW, KD, e); }
    xcd_barrier(xb);
    }
    { PHASE_IDS; phase_postproj(q, l, gw, ngw, lane); }
    xcd_barrier(xb);
    DUP(0) {
    { PHASE_IDS; phase_kmean(q, gtid, ngt); phase_pack_moba(q, gtid, ngt); phase_pack_u(q, gtid, ngt); phase_pack_ret(q, gtid, ngt); }
    xcd_barrier(xb);
    }
    DUP(1) {
    { const Params q = fresh(p); EpiS5Z e{q.S5Z()};
      pg8::Gemm g{q.S5A(), q.S5Wz(), 16 * 1024, 16 * 256, 512, 640, 512}; pg8::GroupOrder So; So.init(16, 4, 1, (int)gridDim.x, (int)blockIdx.x);
      pg8::gemm_phase<EpiS5Z, pg8::GroupOrder, true, true>((PG8_LAS unsigned char*)lds_raw, g, So, e); }
    __syncthreads();
    { PHASE_IDS; phase_moba2(q, l, lds_raw, bid, G); }
    { PHASE_IDS; phase_ret_kv(q, gw, ngw, lane); }
    xcd_barrier(xb);
    }
    DUP(2) {
    { PHASE_IDS; phase_s5_scan(q, gtid, ngt); phase_ret_scan(q, gtid, ngt); }
    xcd_barrier(xb);
    }
    DUP(3) {
    { const Params q = fresh(p); EpiS5Y e{q.ygb(), q.S5A(), q.in[10] + l * 256};
      pg8::Gemm g{q.S5A(), q.S5Wy(), 16 * 1024, 16 * 512, 640, 640, 640}; pg8::GroupOrder So; So.init(16, 4, 2, (int)gridDim.x, (int)blockIdx.x);
      pg8::gemm_phase<EpiS5Y, pg8::GroupOrder, true, true>((PG8_LAS unsigned char*)lds_raw, g, So, e); }
    __syncthreads();
    { PHASE_IDS; phase_ret_out(q, gw, ngw, lane); }
    xcd_barrier(xb);
    }
    DUP(4) {
    { const Params q = fresh(p); EpiGlu e{q.ybuf(), q.ygb(), (float*)(lds_raw + 131072)};
      run_gemm(lds_raw, q.ygb(), q.Wglu_t() + (size_t)l * 65536, T, 256, 256, e); }
    xcd_barrier(xb);
    }
    DUP(9) {
    { PHASE_IDS; phase_cvt_rows(q.ybuf(), q.xb(), nullptr, gw, ngw, lane); }
    xcd_barrier(xb);
    }
    { const Params q = fresh(p); EpiAccum e{q.out, D};
      run_gemm(lds_raw, q.xb(), q.Wout_t() + (size_t)l * D * KD, T, D, KD, e); }
    xcd_barrier(xb);
    { PHASE_IDS; phase_cvt_rows_h8(q, l, gw, ngw, lane);
      cvt_table_fp8(q.in[19] + (size_t)l * 16384 * D, q.U8s(), q.su(), gw, ngw, lane);
      cvt_table_fp8(q.in[20] + (size_t)l * 16384 * D, q.V8s(), q.sv(), gw, ngw, lane); }
    xcd_barrier(xb);
    DUP(7) {
    { const Params q = fresh(p); EpiScaleStoreBf16 e{q.qb(), D, q.rstd()};
      run_gemm(lds_raw, q.xb(), q.Wq_t() + (size_t)l * D * KD, T, D, KD, e); }
    xcd_barrier(xb);
    }
    if (!(PROBE_SKIP & 2)) {
    { PHASE_IDS; phase_peer_topk(q, l, gw, ngw, lane); }
    xcd_barrier(xb);
    }
#if PEER_CHECK
    if (l == 0) { { PHASE_IDS; chk_save(q, gtid, ngt); } xcd_barrier(xb); { PHASE_IDS; chk_topk(q, l, gtid, ngt); } xcd_barrier(xb); }
#endif
    if (!(PROBE_SKIP & 1)) {
    { PHASE_IDS; phase_peer_u(q, q.qctr() + (l * 2 + 0) * 8, lds_raw, tid); }
    xcd_barrier(xb);
    { PHASE_IDS; phase_peer_r(q, gtid, ngt); }
    xcd_barrier(xb);
    if (!(PROBE_SKIP & 32)) {
    { PHASE_IDS; phase_peer_v(q, q.qctr() + (l * 2 + 1) * 8, lds_raw, tid); }
    xcd_barrier(xb);
    }
    }
#if PEER_CHECK
    if (l == 0) { { PHASE_IDS; chk_apply(q, l, ldsf + wv * 128, gw, ngw, lane); } xcd_barrier(xb);
      if (blockIdx.x == 0 && threadIdx.x == 0) { const Params q = fresh(p); chk_emit(q); } xcd_barrier(xb); }
#endif
  }
}

}

extern "C" void kernel_launch(void* const* d_in, const int* in_sizes, int n_in, void* d_out, int out_size, void* d_ws, size_t ws_size,
                              hipStream_t stream) {
  static int grid_blocks = 0;
  if (!grid_blocks) {
    int dev = 0, cus = 0, per_cu = 0;
    hipGetDevice(&dev);
    hipDeviceGetAttribute(&cus, hipDeviceAttributeMultiprocessorCount, dev);
    hipFuncSetAttribute((const void*)mega, hipFuncAttributeMaxDynamicSharedMemorySize, LDS_BYTES);
    hipOccupancyMaxActiveBlocksPerMultiprocessor(&per_cu, (const void*)mega, NTHR, LDS_BYTES);
    if (per_cu < 1) { fprintf(stderr, "occupancy query returned %d\n", per_cu); per_cu = 1; }
    grid_blocks = cus * 1;
    if (grid_blocks < 64) fprintf(stderr, "unexpected CU count %d\n", cus);
  }
  Params p{};
  for (int i = 0; i < 21; ++i) p.in[i] = (const float*)d_in[i];
  p.out = (float*)d_out;
  p.ws = (unsigned char*)d_ws;
  if (WS_TOTAL > ws_size) { fprintf(stderr, "workspace too small: need %zu have %zu\n", (size_t)WS_TOTAL, ws_size); return; }
  hipMemsetAsync((unsigned char*)d_ws + WO_bar, 0, 16384, stream);
  void* args[] = {&p};
  hipError_t e = hipLaunchCooperativeKernel((const void*)mega, dim3(grid_blocks), dim3(NTHR), args, LDS_BYTES, stream);
  if (e != hipSuccess) fprintf(stderr, "cooperative launch failed: %s (grid %d)\n", hipGetErrorString(e), grid_blocks);
}
```

```cpp
#include <hip/hip_runtime.h>
#include <hip/hip_cooperative_groups.h>
#include <math.h>
#include <stdint.h>
#include <stdio.h>
namespace cg = cooperative_groups;

#ifndef PEER_CHECK
#define PEER_CHECK 0
#endif
#ifndef PROBE_DUP
#define PROBE_DUP 0
#endif
__device__ __forceinline__ int dup_n(int n) { asm volatile("" : "+s"(n)); return n; }
#define DUP(bit) _Pragma("unroll 1") for (int rep_ = 0, repn_ = (((PROBE_DUP >> (bit)) & 1) ? dup_n(2) : 1); rep_ < repn_; ++rep_)
#ifndef PROBE_SKIP
#define PROBE_SKIP 0
#endif
#ifndef PRECISE
#define PRECISE 0
#endif

namespace {
constexpr int NB = 8, S = 4096, D = 1024, NL = 4, T = NB * S;
constexpr int INW = 2816;
constexpr int OFF_U = 0, OFF_QM = 256, OFF_KM = 768, OFF_VM = 1280, OFF_QR = 1792, OFF_KR = 2048, OFF_VR = 2304, OFF_GR = 2560;
constexpr float EPS = 1e-6f;
static_assert(PRECISE == 0, "PRECISE builds are retired");
constexpr int KS = PRECISE ? 3 : 1;
constexpr int KD = D * KS;
constexpr int NTHR = 512, NWAVE = 8;
constexpr int LDS_BYTES = 131072 + 4096 + 1024;

typedef unsigned short bf16_t;
using bf16x8 = __attribute__((ext_vector_type(8))) short;
using f32x4 = __attribute__((ext_vector_type(4))) float;

__device__ __forceinline__ float wave_sum(float v) {
#pragma unroll
  for (int o = 32; o > 0; o >>= 1) v += __shfl_xor(v, o);
  return v;
}
__device__ __forceinline__ float wave_max(float v) {
#pragma unroll
  for (int o = 32; o > 0; o >>= 1) v = fmaxf(v, __shfl_xor(v, o));
  return v;
}
__device__ __forceinline__ float gelu_tanh(float x) {
  const float k0 = 0.7978845608028654f, k1 = 0.044715f;
  float u = k0 * (x + k1 * x * x * x);
  return 0.5f * x * (1.0f + tanhf(u));
}
__device__ __forceinline__ float sigmoidf_(float x) { return 1.0f / (1.0f + expf(-x)); }
__device__ __forceinline__ float fast_sigmoid(float x) { return __builtin_amdgcn_rcpf(1.0f + __builtin_amdgcn_exp2f(-1.4426950408889634f * x)); }
__device__ __forceinline__ float fast_gelu(float x) { const float u = 0.7978845608028654f * (x + 0.044715f * x * x * x); return x * fast_sigmoid(2.0f * u); }
__device__ __forceinline__ bf16_t f2bf(float f) {
  unsigned u = __float_as_uint(f);
  u += 0x7fffu + ((u >> 16) & 1u);
  return (bf16_t)(u >> 16);
}
__device__ __forceinline__ float bf2f(bf16_t h) { return __uint_as_float(((unsigned)h) << 16); }
#define LDS_FENCE() asm volatile("s_waitcnt lgkmcnt(0)" ::: "memory")
typedef __bf16 bf16x2_hw __attribute__((ext_vector_type(2)));
typedef float f32x2_hw __attribute__((ext_vector_type(2)));
__device__ __forceinline__ unsigned pk_bf16(float lo, float hi) { const f32x2_hw f = {lo, hi}; const bf16x2_hw b = __builtin_convertvector(f, bf16x2_hw); return __builtin_bit_cast(unsigned, b); }
typedef float f32x16 __attribute__((ext_vector_type(16)));

constexpr size_t al256(size_t x) { return (x + 255) & ~(size_t)255; }
constexpr size_t WO_rstd = 0;
constexpr size_t WO_cosm = WO_rstd + al256((size_t)T * 4);
constexpr size_t WO_sinm = WO_cosm + al256((size_t)S * 8 * 4);
constexpr size_t WO_cosr = WO_sinm + al256((size_t)S * 8 * 4);
constexpr size_t WO_sinr = WO_cosr + al256((size_t)S * 32 * 4);
constexpr size_t WO_kmean = WO_sinr + al256((size_t)S * 32 * 4);
constexpr size_t WO_proj = WO_kmean + al256((size_t)NB * 8 * 16 * 64 * 4);
constexpr size_t WO_ybuf = WO_proj + al256((size_t)T * INW * 4);
constexpr size_t WO_yg = WO_ybuf + al256((size_t)T * D * 4);
constexpr size_t WO_skb = WO_yg + al256((size_t)T * 256 * 4);
constexpr size_t WO_Ub = WO_skb + al256((size_t)NL * 16 * 128 * 64 * 2);
constexpr size_t WO_Vb = WO_Ub + al256((size_t)16384 * D * 2);
constexpr size_t WO_gates = WO_Vb + al256((size_t)16384 * D * 2);
constexpr size_t WO_eidx = WO_gates + al256((size_t)T * 128 * 4);
constexpr size_t WO_xb = WO_eidx + al256((size_t)T * 128 * 4);
constexpr size_t WO_Win_t = WO_xb + al256((size_t)T * KD * 2);
constexpr size_t WO_Wout_t = WO_Win_t + al256((size_t)NL * INW * KD * 2);
constexpr size_t WO_Wq_t = WO_Wout_t + al256((size_t)NL * D * KD * 2);
constexpr size_t WO_Qm = WO_Wq_t + al256((size_t)NL * D * KD * 2);
constexpr size_t WO_Km = WO_Qm + al256((size_t)T * 512 * 2);
constexpr size_t WO_Vm = WO_Km + al256((size_t)T * 512 * 2);
constexpr size_t WO_S5a32 = WO_Vm + al256((size_t)T * 512 * 2);
constexpr size_t WO_Wglu_t = WO_S5a32 + al256((size_t)16 * 64 * 2 * 4);
constexpr size_t WO_Qr = WO_Wglu_t + al256((size_t)NL * 256 * 256 * 2);
constexpr size_t WO_Kr = WO_Qr + al256((size_t)T * 256 * 2);
constexpr size_t WO_Krv = WO_Kr + al256((size_t)T * 256 * 2);
constexpr size_t WO_Vr = WO_Krv + al256((size_t)T * 256 * 2);
constexpr size_t WO_KVr = WO_Vr + al256((size_t)T * 256 * 2);
constexpr size_t WO_Rb = WO_KVr + al256((size_t)32 * 32 * 4096 * 4);
constexpr size_t WO_qctr = WO_Rb + al256((size_t)32 * 32 * 4096 * 2);
constexpr size_t WO_bar = WO_qctr + al256(1024);
constexpr size_t WS_TOTAL = WO_bar + al256(16384);
constexpr size_t WO_S5A = WO_gates;
constexpr size_t WO_S5Z = WO_S5A + al256((size_t)16 * 1024 * 640 * 2);
static_assert(WO_S5Z + (size_t)16 * 1024 * 128 * 4 <= WO_gates + 2 * al256((size_t)T * 128 * 4), "S5A/S5Z must fit in gates+eidx");
constexpr size_t WO_S5Wy = WO_Ub;
constexpr size_t WO_S5Wz = WO_S5Wy + al256((size_t)16 * 512 * 640 * 2);
static_assert(WO_S5Wz + (size_t)16 * 256 * 512 * 2 <= WO_Ub + 2 * al256((size_t)16384 * D * 2), "S5 weights must fit in Ub/Vb");
struct Params {
  const float* in[21];
  float* out;
  unsigned char* ws;
  __device__ __forceinline__ float* rstd() const { return (float*)(ws + WO_rstd); }
  __device__ __forceinline__ float* cosm() const { return (float*)(ws + WO_cosm); }
  __device__ __forceinline__ float* sinm() const { return (float*)(ws + WO_sinm); }
  __device__ __forceinline__ float* cosr() const { return (float*)(ws + WO_cosr); }
  __device__ __forceinline__ float* sinr() const { return (float*)(ws + WO_sinr); }
  __device__ __forceinline__ float* kmean() const { return (float*)(ws + WO_kmean); }
  __device__ __forceinline__ float* proj() const { return (float*)(ws + WO_proj); }
  __device__ __forceinline__ float* ybuf() const { return (float*)(ws + WO_ybuf); }
  __device__ __forceinline__ float* yg() const { return (float*)(ws + WO_yg); }
  __device__ __forceinline__ bf16_t* skb() const { return (bf16_t*)(ws + WO_skb); }
  __device__ __forceinline__ bf16_t* Ub() const { return (bf16_t*)(ws + WO_Ub); }
  __device__ __forceinline__ bf16_t* Vb() const { return (bf16_t*)(ws + WO_Vb); }
  __device__ __forceinline__ float* gates() const { return (float*)(ws + WO_gates); }
  __device__ __forceinline__ int* eidx() const { return (int*)(ws + WO_eidx); }
  __device__ __forceinline__ bf16_t* xb() const { return (bf16_t*)(ws + WO_xb); }
  __device__ __forceinline__ bf16_t* Win_t() const { return (bf16_t*)(ws + WO_Win_t); }
  __device__ __forceinline__ bf16_t* Wout_t() const { return (bf16_t*)(ws + WO_Wout_t); }
  __device__ __forceinline__ bf16_t* Wq_t() const { return (bf16_t*)(ws + WO_Wq_t); }
  __device__ __forceinline__ bf16_t* Qm() const { return (bf16_t*)(ws + WO_Qm); }
  __device__ __forceinline__ bf16_t* Km() const { return (bf16_t*)(ws + WO_Km); }
  __device__ __forceinline__ bf16_t* Vm() const { return (bf16_t*)(ws + WO_Vm); }
  __device__ __forceinline__ bf16_t* S5A() const { return (bf16_t*)(ws + WO_S5A); }
  __device__ __forceinline__ bf16_t* S5Wy() const { return (bf16_t*)(ws + WO_S5Wy); }
  __device__ __forceinline__ bf16_t* S5Wz() const { return (bf16_t*)(ws + WO_S5Wz); }
  __device__ __forceinline__ float* S5Z() const { return (float*)(ws + WO_S5Z); }
  __device__ __forceinline__ float* S5a32() const { return (float*)(ws + WO_S5a32); }
  __device__ __forceinline__ bf16_t* Wglu_t() const { return (bf16_t*)(ws + WO_Wglu_t); }
  __device__ __forceinline__ bf16_t* ygb() const { return (bf16_t*)(ws + WO_yg); }
  __device__ __forceinline__ int* qctr() const { return (int*)(ws + WO_qctr); }
  __device__ __forceinline__ unsigned char* U8s() const { return ws + WO_Ub; }
  __device__ __forceinline__ float* su() const { return (float*)(ws + WO_Ub + (size_t)16384 * D); }
  __device__ __forceinline__ unsigned char* V8s() const { return ws + WO_Vb; }
  __device__ __forceinline__ float* sv() const { return (float*)(ws + WO_Vb + (size_t)16384 * D); }
  __device__ __forceinline__ bf16_t* hb() const { return (bf16_t*)(ws + WO_ybuf + ((size_t)4 << 20)); }
  __device__ __forceinline__ unsigned char* h8lo() const { return ws + WO_ybuf + ((size_t)4 << 20) + (size_t)T * D; }
  __device__ __forceinline__ float* sh() const { return (float*)(ws + WO_ybuf + ((size_t)4 << 20) + (size_t)2 * T * D); }
  __device__ __forceinline__ float* ppart() const { return (float*)(ws + WO_proj + (size_t)T * D * 2); }
  __device__ __forceinline__ bf16_t* Qr() const { return (bf16_t*)(ws + WO_Qr); }
  __device__ __forceinline__ bf16_t* Kr() const { return (bf16_t*)(ws + WO_Kr); }
  __device__ __forceinline__ bf16_t* Krv() const { return (bf16_t*)(ws + WO_Krv); }
  __device__ __forceinline__ bf16_t* Vr() const { return (bf16_t*)(ws + WO_Vr); }
  __device__ __forceinline__ float* KVr() const { return (float*)(ws + WO_KVr); }
  __device__ __forceinline__ bf16_t* Rb() const { return (bf16_t*)(ws + WO_Rb); }
  __device__ __forceinline__ unsigned* bar() const { return (unsigned*)(ws + WO_bar); }
  __device__ __forceinline__ bf16_t* qb() const { return (bf16_t*)(ws + WO_proj); }
};

namespace pg8 {
#define PG8_LAS __attribute__((address_space(3)))
typedef unsigned short bf16_t;
typedef short bf16x8 __attribute__((ext_vector_type(8)));
typedef float f32x4 __attribute__((ext_vector_type(4)));
typedef unsigned u32x4 __attribute__((ext_vector_type(4)));
constexpr int BM = 256, BK = 64, HALF = 128, HTB = HALF * BK * 2  , STAGE_BYTES = 8 * HTB, NXCD = 8, WGM = 8;

__host__ __device__ __forceinline__ int lds_byte(int r, int c) { const int st = (r >> 4) * 2 + (c >> 5), rr = r & 15, cc = c & 31, ob = rr * 64 + cc * 2; return st * 1024 + (ob ^ (((ob >> 9) & 1) << 5)); }
__host__ __device__ __forceinline__ void stage_rc(int b, int& R, int& C) { const int st = b / 1024, sb = b % 1024, swz = sb ^ (((sb >> 9) & 1) << 5); R = (st >> 1) * 16 + swz / 64; C = (st & 1) * 32 + (swz % 64) / 2; }
__host__ __device__ __forceinline__ int perm32(int rho) { const int n = rho >> 4, i = rho & 15; return 8 * (i >> 2) + 4 * n + (i & 3); }

struct Unit { int pm, pn; };
struct Gemm { const bf16_t* A; const bf16_t* Bt; int M, N, K, lda, ldb; };

struct StaticOrder {
    int nM, nN, nwg, G, c;
    __host__ __device__ void init(int M, int N, int G_, int c_) { nM = M / BM; nN = N / BM; nwg = nM * nN; G = G_; c = c_; }
    __host__ __device__ bool next(int i, Unit& u) const {
        const long L = (long)i * G + c; if (L >= nwg) return false;
        int wgid = (int)L; { const int q = nwg / NXCD, r = nwg % NXCD, xcd = wgid % NXCD, off = wgid / NXCD; wgid = (xcd < r ? xcd * (q + 1) : r * (q + 1) + (xcd - r) * q) + off; }
        const int nig = WGM * nN, gid = wgid / nig, fm = gid * WGM, gsz = (nM - fm) < WGM ? (nM - fm) : WGM;
        u.pm = fm + ((wgid % nig) % gsz); u.pn = (wgid % nig) / gsz; return true;
    }
    __device__ __forceinline__ void a_ready(const Unit&) const {}
    __device__ __forceinline__ void done(const Unit&) const {}
};
struct GroupOrder {
    int mt, nt_, nwg, G, c;
    __host__ __device__ void init(int ngroups, int mt__, int nt__, int G_, int c_) { mt = mt__; nt_ = nt__; nwg = ngroups * mt * nt_; G = G_; c = c_; }
    __host__ __device__ bool next(int i, Unit& u) const {
        const long L = (long)i * G + c; if (L >= nwg) return false;
        const int per = mt * nt_, gi = (int)L / per, r = (int)L % per;
        u.pm = gi * mt + r % mt; u.pn = gi * nt_ + r / mt; return true;
    }
    __device__ __forceinline__ void a_ready(const Unit&) const {}
    __device__ __forceinline__ void done(const Unit&) const {}
};
template <class Epi, class Sched, bool ALIGN_EPI = false, bool SP2 = false>
__device__ __forceinline__ void gemm_phase(PG8_LAS unsigned char* lds, const Gemm g, const Sched& S, const Epi& E) {
    int tid_ = threadIdx.x; asm volatile("" : "+v"(tid_));
    const int tid = tid_, wid = __builtin_amdgcn_readfirstlane(tid >> 6), lane = tid & 63, wr = wid >> 2, wc = wid & 3, fr = lane & 15, fq = lane >> 4;
    const int K = g.K, nt = K / BK;
    unsigned voffA[2], voffB[2];
#pragma unroll
    for (int i = 0; i < 2; ++i) { int R, C; stage_rc(tid * 16 + i * 8192, R, C); const int Rb = Epi::PERM ? ((R & ~31) + perm32(R & 31)) : R;
        voffA[i] = (unsigned)(R * g.lda + C) * 2u; voffB[i] = (unsigned)(Rb * g.ldb + C) * 2u; }
    const size_t kstep = (size_t)(BK * 2);
    const size_t hstepA = (size_t)HALF * g.lda * 2, hstepB = (size_t)HALF * g.ldb * 2;
    const size_t tstepA = 2 * hstepA, tstepB = 2 * hstepB;
    const unsigned ldsw = (unsigned)wid * 1024u;
    const int aoff = lds_byte(wr * 64 + fr, fq * 8), boff = lds_byte(wc * 32 + fr, fq * 8);
#define PG8_SA(b, h) (((b) * 2 + (h)) * HTB)
#define PG8_SB(b, h) ((4 + (b) * 2 + (h)) * HTB)
#define PG8_STAGE(bufoff, gbase, voff) do { _Pragma("unroll") for (int _i = 0; _i < 2; ++_i) \
        __builtin_amdgcn_global_load_lds((const unsigned*)((const char*)(gbase) + (voff)[_i]), (PG8_LAS unsigned*)(lds + (bufoff) + ldsw + _i * 8192), 16, 0, 0); } while (0)
#define PG8_LDA(dst, b, h) do { _Pragma("unroll") for (int m = 0; m < 4; ++m) _Pragma("unroll") for (int k = 0; k < 2; ++k) dst[m][k] = *(const PG8_LAS bf16x8*)(lds + PG8_SA(b, h) + aoff + m * 2048 + k * 1024); } while (0)
#define PG8_LDB(dst, b, h) do { _Pragma("unroll") for (int n = 0; n < 2; ++n) _Pragma("unroll") for (int k = 0; k < 2; ++k) dst[n][k] = *(const PG8_LAS bf16x8*)(lds + PG8_SB(b, h) + boff + n * 2048 + k * 1024); } while (0)
#define PG8_MMA(ai, bj, At, Bt) do { __builtin_amdgcn_s_setprio(1); _Pragma("unroll") for (int m = 0; m < 4; ++m) _Pragma("unroll") for (int n = 0; n < 2; ++n) _Pragma("unroll") for (int k = 0; k < 2; ++k) \
        acc[ai][bj][m][n] = __builtin_amdgcn_mfma_f32_16x16x32_bf16(Bt[n][k], At[m][k], acc[ai][bj][m][n], 0, 0, 0); __builtin_amdgcn_s_setprio(0); } while (0)
#define PG8_WAIT_V(n) asm volatile("s_waitcnt vmcnt(" #n ")" ::: "memory")
#define PG8_WAIT_L(n) asm volatile("s_waitcnt lgkmcnt(" #n ")" ::: "memory")
#define PG8_BAR __builtin_amdgcn_s_barrier()
#define PG8_SCHED __builtin_amdgcn_sched_barrier(0)
    Unit cur, nxt; int ui = 0;
    if (!S.next(0, cur)) return;
    f32x4 acc[2][2][4][2];
    E.init(acc, cur, wr, wc, fr, fq);
    bf16x8 At[4][2], B0[2][2], B1[2][2];
    const char* cA = (const char*)g.A + (size_t)cur.pm * tstepA; const char* cB = (const char*)g.Bt + (size_t)cur.pn * tstepB;
    S.a_ready(cur);
    if constexpr (SP2) {
        PG8_STAGE(PG8_SB(0, 0), cB, voffB); PG8_STAGE(PG8_SB(0, 1), cB + hstepB, voffB); PG8_STAGE(PG8_SA(0, 0), cA, voffA); PG8_STAGE(PG8_SA(0, 1), cA + hstepA, voffA);
        if (wr == 1) PG8_BAR;
        PG8_WAIT_V(2); PG8_BAR;
        PG8_STAGE(PG8_SB(1, 0), cB + kstep, voffB); PG8_STAGE(PG8_SA(1, 0), cA + kstep, voffA); PG8_STAGE(PG8_SB(1, 1), cB + hstepB + kstep, voffB);
        PG8_WAIT_V(6); PG8_BAR;
    } else {
        PG8_STAGE(PG8_SB(0, 0), cB, voffB); PG8_STAGE(PG8_SA(0, 0), cA, voffA); PG8_STAGE(PG8_SB(0, 1), cB + hstepB, voffB); PG8_STAGE(PG8_SA(0, 1), cA + hstepA, voffA);
        if (wr == 1) PG8_BAR;
        PG8_WAIT_V(4); PG8_BAR;
        PG8_STAGE(PG8_SB(1, 0), cB + kstep, voffB); PG8_STAGE(PG8_SA(1, 0), cA + kstep, voffA); PG8_STAGE(PG8_SB(1, 1), cB + hstepB + kstep, voffB);
        PG8_WAIT_V(6); PG8_BAR;
    }
    for (;;) {
        const bool has_next = S.next(ui + 1, nxt);
        const char* nA = has_next ? (const char*)g.A + (size_t)nxt.pm * tstepA : cA; const char* nB = has_next ? (const char*)g.Bt + (size_t)nxt.pn * tstepB : cB;
        for (int t = 0; t < nt; t += 2) {
            const bool last = (t == nt - 2);
            const char* a1 = cA + (size_t)(t + 1) * kstep;
            const char* a2 = last ? nA : cA + (size_t)(t + 2) * kstep; const char* b2 = last ? nB : cB + (size_t)(t + 2) * kstep;
            const char* a3 = a2 + kstep; const char* b3 = b2 + kstep;
            if (last && has_next) S.a_ready(nxt);
            if constexpr (SP2) {
            PG8_LDB(B0, 0, 0); PG8_LDB(B1, 0, 1); PG8_SCHED; PG8_LDA(At, 0, 0); PG8_STAGE(PG8_SA(1, 1), a1 + hstepA, voffA);
            PG8_WAIT_V(8); PG8_WAIT_L(0); PG8_BAR; PG8_MMA(0, 0, At, B0); PG8_MMA(0, 1, At, B1); PG8_BAR; PG8_SCHED;
            PG8_LDA(At, 0, 1); PG8_STAGE(PG8_SB(0, 0), b2, voffB); PG8_STAGE(PG8_SB(0, 1), b2 + hstepB, voffB); PG8_STAGE(PG8_SA(0, 0), a2, voffA);
            PG8_WAIT_V(8); PG8_WAIT_L(0); PG8_BAR; PG8_MMA(1, 0, At, B0); PG8_MMA(1, 1, At, B1); PG8_BAR; PG8_SCHED;
            PG8_LDB(B0, 1, 0); PG8_LDB(B1, 1, 1); PG8_SCHED; PG8_LDA(At, 1, 0); PG8_STAGE(PG8_SA(0, 1), a2 + hstepA, voffA);
            PG8_WAIT_V(8); PG8_WAIT_L(0); PG8_BAR; PG8_MMA(0, 0, At, B0); PG8_MMA(0, 1, At, B1); PG8_BAR; PG8_SCHED;
            PG8_LDA(At, 1, 1); PG8_STAGE(PG8_SB(1, 0), b3, voffB); PG8_STAGE(PG8_SB(1, 1), b3 + hstepB, voffB); PG8_STAGE(PG8_SA(1, 0), a3, voffA);
            PG8_WAIT_V(8); PG8_WAIT_L(0); PG8_BAR; PG8_MMA(1, 0, At, B0); PG8_MMA(1, 1, At, B1); PG8_BAR; PG8_SCHED;
            } else {
            PG8_LDB(B0, 0, 0); PG8_SCHED; PG8_LDA(At, 0, 0); PG8_STAGE(PG8_SA(1, 1), a1 + hstepA, voffA);
            PG8_WAIT_L(8); PG8_BAR; PG8_WAIT_L(0); PG8_MMA(0, 0, At, B0); PG8_BAR; PG8_SCHED;
            PG8_LDB(B1, 0, 1); PG8_STAGE(PG8_SB(0, 0), b2, voffB);
            PG8_BAR; PG8_WAIT_L(0); PG8_MMA(0, 1, At, B1); PG8_BAR;
            PG8_LDA(At, 0, 1); PG8_STAGE(PG8_SA(0, 0), a2, voffA);
            PG8_BAR; PG8_WAIT_L(0); PG8_MMA(1, 0, At, B0); PG8_BAR; PG8_SCHED;
            PG8_STAGE(PG8_SB(0, 1), b2 + hstepB, voffB);
            PG8_WAIT_V(6); PG8_BAR; PG8_MMA(1, 1, At, B1); PG8_BAR;
            PG8_LDB(B0, 1, 0); PG8_SCHED; PG8_LDA(At, 1, 0); PG8_STAGE(PG8_SA(0, 1), a2 + hstepA, voffA);
            PG8_WAIT_L(8); PG8_BAR; PG8_WAIT_L(0); PG8_MMA(0, 0, At, B0); PG8_BAR; PG8_SCHED;
            PG8_LDB(B1, 1, 1); PG8_STAGE(PG8_SB(1, 0), b3, voffB);
            PG8_BAR; PG8_WAIT_L(0); PG8_MMA(0, 1, At, B1); PG8_BAR;
            PG8_LDA(At, 1, 1); PG8_STAGE(PG8_SA(1, 0), a3, voffA);
            PG8_BAR; PG8_WAIT_L(0); PG8_MMA(1, 0, At, B0); PG8_BAR; PG8_SCHED;
            PG8_STAGE(PG8_SB(1, 1), b3 + hstepB, voffB);
            PG8_WAIT_V(6); PG8_BAR; PG8_MMA(1, 1, At, B1); PG8_BAR;
            }
        }
        if constexpr (ALIGN_EPI) { if (wr == 0) PG8_BAR; }
        if constexpr (!Epi::AFTER_DRAIN) { E(acc, cur, wr, wc, fr, fq); S.done(cur); }
        if (!has_next) break;
        E.init(acc, nxt, wr, wc, fr, fq);
        cur = nxt; cA = nA; cB = nB; ++ui;
        if constexpr (ALIGN_EPI) { if (wr == 1) PG8_BAR; }
    }
    PG8_WAIT_V(0);
    if constexpr (!ALIGN_EPI) { if (wr == 0) PG8_BAR; }
    PG8_BAR;
    if constexpr (Epi::AFTER_DRAIN) { E.fused(acc, cur, wr, wc, fr, fq, lds, wid, lane); S.done(cur); }
#undef PG8_SA
#undef PG8_SB
#undef PG8_STAGE
#undef PG8_LDA
#undef PG8_LDB
#undef PG8_MMA
#undef PG8_WAIT_V
#undef PG8_WAIT_L
#undef PG8_BAR
#undef PG8_SCHED
}
}
struct EpiScaleStore {
  static constexpr bool PERM = false, AFTER_DRAIN = false;
  float* C; int ldc; const float* rs;
  __device__ __forceinline__ void init(pg8::f32x4 (&acc)[2][2][4][2], const pg8::Unit&, int, int, int, int) const {
#pragma unroll
    for (int a = 0; a < 2; ++a)
#pragma unroll
      for (int b = 0; b < 2; ++b)
#pragma unroll
        for (int m = 0; m < 4; ++m)
#pragma unroll
          for (int n = 0; n < 2; ++n) acc[a][b][m][n] = (pg8::f32x4){0.f, 0.f, 0.f, 0.f};
  }
  __device__ __forceinline__ void operator()(const pg8::f32x4 (&acc)[2][2][4][2], const pg8::Unit& u, int wr, int wc, int fr_in, int fq_in) const {
    int fr = fr_in, fq = fq_in; asm volatile("" : "+v"(fr), "+v"(fq));
#pragma unroll
    for (int ai = 0; ai < 2; ++ai)
#pragma unroll
      for (int m = 0; m < 4; ++m) {
        const int row = u.pm * 256 + ai * 128 + wr * 64 + m * 16 + fr;
        const float r = rs[row];
#pragma unroll
        for (int bj = 0; bj < 2; ++bj)
#pragma unroll
          for (int n = 0; n < 2; ++n) {
            const int col = u.pn * 256 + bj * 128 + wc * 32 + n * 16 + 4 * fq;
            pg8::f32x4 v = acc[ai][bj][m][n] * r;
            *(pg8::f32x4*)(C + (size_t)row * ldc + col) = v;
          }
        asm volatile("" ::: "memory");
      }
  }
};
struct EpiAccum {
  static constexpr bool PERM = false, AFTER_DRAIN = false;
  float* C; int ldc;
  __device__ __forceinline__ void init(pg8::f32x4 (&acc)[2][2][4][2], const pg8::Unit& u, int wr, int wc, int fr, int fq) const {
#pragma unroll
    for (int ai = 0; ai < 2; ++ai)
#pragma unroll
      for (int m = 0; m < 4; ++m) {
        const int row = u.pm * 256 + ai * 128 + wr * 64 + m * 16 + fr;
#pragma unroll
        for (int bj = 0; bj < 2; ++bj)
#pragma unroll
          for (int n = 0; n < 2; ++n) {
            const int col = u.pn * 256 + bj * 128 + wc * 32 + n * 16 + 4 * fq;
            acc[ai][bj][m][n] = *(const pg8::f32x4*)(C + (size_t)row * ldc + col);
          }
      }
  }
  __device__ __forceinline__ void operator()(const pg8::f32x4 (&acc)[2][2][4][2], const pg8::Unit& u, int wr, int wc, int fr_in, int fq_in) const {
    int fr = fr_in, fq = fq_in; asm volatile("" : "+v"(fr), "+v"(fq));
#pragma unroll
    for (int ai = 0; ai < 2; ++ai)
#pragma unroll
      for (int m = 0; m < 4; ++m) {
        const int row = u.pm * 256 + ai * 128 + wr * 64 + m * 16 + fr;
#pragma unroll
        for (int bj = 0; bj < 2; ++bj)
#pragma unroll
          for (int n = 0; n < 2; ++n) {
            const int col = u.pn * 256 + bj * 128 + wc * 32 + n * 16 + 4 * fq;
            *(pg8::f32x4*)(C + (size_t)row * ldc + col) = acc[ai][bj][m][n];
          }
        asm volatile("" ::: "memory");
      }
  }
};
struct EpiScaleStoreBf16 {
  static constexpr bool PERM = false, AFTER_DRAIN = false;
  bf16_t* C; int ldc; const float* rs;
  __device__ __forceinline__ void init(pg8::f32x4 (&acc)[2][2][4][2], const pg8::Unit&, int, int, int, int) const {
#pragma unroll
    for (int a = 0; a < 2; ++a)
#pragma unroll
      for (int b = 0; b < 2; ++b)
#pragma unroll
        for (int m = 0; m < 4; ++m)
#pragma unroll
          for (int n = 0; n < 2; ++n) acc[a][b][m][n] = (pg8::f32x4){0.f, 0.f, 0.f, 0.f};
  }
  __device__ __forceinline__ void operator()(const pg8::f32x4 (&acc)[2][2][4][2], const pg8::Unit& u, int wr, int wc, int fr_in, int fq_in) const {
    int fr = fr_in, fq = fq_in; asm volatile("" : "+v"(fr), "+v"(fq));
#pragma unroll
    for (int ai = 0; ai < 2; ++ai)
#pragma unroll
      for (int m = 0; m < 4; ++m) {
        const int row = u.pm * 256 + ai * 128 + wr * 64 + m * 16 + fr;
        const float r = rs[row];
#pragma unroll
        for (int bj = 0; bj < 2; ++bj)
#pragma unroll
          for (int n = 0; n < 2; ++n) {
            const int col = u.pn * 256 + bj * 128 + wc * 32 + n * 16 + 4 * fq;
            pg8::f32x4 v = acc[ai][bj][m][n] * r;
            uint2 o; o.x = pk_bf16(v[0], v[1]); o.y = pk_bf16(v[2], v[3]);
            *(uint2*)(C + (size_t)row * ldc + col) = o;
          }
        asm volatile("" ::: "memory");
      }
  }
};
template <class Epi>
__device__ __forceinline__ void run_gemm(unsigned char* lds_raw, const bf16_t* A, const bf16_t* Bt, int M, int N, int K, const Epi& e) {
  pg8::Gemm g{A, Bt, M, N, K, K, K}; pg8::StaticOrder So; So.init(M, N, (int)gridDim.x, (int)blockIdx.x);
  pg8::gemm_phase<Epi, pg8::StaticOrder, true, true>((PG8_LAS unsigned char*)lds_raw, g, So, e);
}

__device__ __forceinline__ void transpose_items(const float* __restrict__ W, int K, int N, const float* __restrict__ g, bf16_t* __restrict__ Wt, int gw, int ngw, int lane) {
  const int nkt = K / 64, nnt = N / 64;
  for (int it = gw; it < nkt * nnt; it += ngw) {
    int kt = it % nkt, ntile = it / nkt;
    int k0 = kt * 64, n = ntile * 64 + lane;
    float v[64];
#pragma unroll
    for (int i = 0; i < 64; ++i) v[i] = W[(size_t)(k0 + i) * N + n] * g[k0 + i];
    bf16_t* dst = Wt + (size_t)n * (K * KS) + k0;
#pragma unroll
    for (int c = 0; c < 8; ++c) {
      bf16_t hi[8], lo[8];
#pragma unroll
      for (int e = 0; e < 8; ++e) { hi[e] = f2bf(v[c * 8 + e]); lo[e] = f2bf(v[c * 8 + e] - bf2f(hi[e])); }
      uint4 ph, pl;
      ph.x = hi[0] | ((unsigned)hi[1] << 16); ph.y = hi[2] | ((unsigned)hi[3] << 16); ph.z = hi[4] | ((unsigned)hi[5] << 16); ph.w = hi[6] | ((unsigned)hi[7] << 16);
      pl.x = lo[0] | ((unsigned)lo[1] << 16); pl.y = lo[2] | ((unsigned)lo[3] << 16); pl.z = lo[4] | ((unsigned)lo[5] << 16); pl.w = lo[6] | ((unsigned)lo[7] << 16);
      *(uint4*)(dst + c * 8) = ph;
      if (PRECISE) { *(uint4*)(dst + K + c * 8) = pl; *(uint4*)(dst + 2 * K + c * 8) = ph; }
    }
  }
}

__device__ __forceinline__ void phase_cvt_rows(const float* __restrict__ src, bf16_t* __restrict__ dst, float* __restrict__ rstd, int gw, int ngw, int lane) {
  for (int t = gw; t < T; t += ngw) {
    const float4* p = (const float4*)(src + (size_t)t * D);
    float ss = 0.f;
#pragma unroll
    for (int i = 0; i < 4; ++i) {
      float4 v = p[lane + i * 64];
      ss += v.x * v.x + v.y * v.y + v.z * v.z + v.w * v.w;
      bf16_t h0 = f2bf(v.x), h1 = f2bf(v.y), h2 = f2bf(v.z), h3 = f2bf(v.w);
      uint2 ph; ph.x = h0 | ((unsigned)h1 << 16); ph.y = h2 | ((unsigned)h3 << 16);
      bf16_t* d = dst + (size_t)t * KD + (lane + i * 64) * 4;
      *(uint2*)d = ph;
      if (PRECISE) {
        bf16_t l0 = f2bf(v.x - bf2f(h0)), l1 = f2bf(v.y - bf2f(h1)), l2 = f2bf(v.z - bf2f(h2)), l3 = f2bf(v.w - bf2f(h3));
        uint2 pl; pl.x = l0 | ((unsigned)l1 << 16); pl.y = l2 | ((unsigned)l3 << 16);
        *(uint2*)(d + D) = ph; *(uint2*)(d + 2 * D) = pl;
      }
    }
    if (rstd) { ss = wave_sum(ss); if (lane == 0) rstd[t] = rsqrtf(ss / (float)D + EPS); }
  }
}

__device__ __forceinline__ void phase_prologue(const Params& p, int gtid, int ngt, int gw, int ngw, int lane) {
  for (int idx = gtid; idx < S * 40; idx += ngt) {
    int s = idx / 40, i = idx % 40;
    if (i < 8) {
      float inv = powf(500000.0f, -(float)(2 * i) / 16.0f);
      float ang = (float)s * inv;
      p.cosm()[s * 8 + i] = (float)cos((double)ang); p.sinm()[s * 8 + i] = (float)sin((double)ang);
    } else {
      int j = i - 8;
      float inv = powf(10000.0f, -((float)j / 31.0f));
      float ang = (float)s * inv;
      p.cosr()[s * 32 + j] = (float)cos((double)ang); p.sinr()[s * 32 + j] = (float)sin((double)ang);
    }
  }
  { const float4* a = (const float4*)p.in[0]; float4* b = (float4*)p.out;
    for (size_t i = gtid; i < (size_t)T * D / 4; i += ngt) b[i] = a[i]; }
  for (int idx = gtid; idx < NL * 65536; idx += ngt) { const int l2 = idx >> 16, n2 = (idx >> 8) & 255, k2 = idx & 255; p.Wglu_t()[idx] = f2bf(p.in[11][(size_t)l2 * 65536 + k2 * 256 + n2]); }
  for (int l = 0; l < NL; ++l) {
    transpose_items(p.in[2] + (size_t)l * D * INW, D, INW, p.in[1] + l * D, p.Win_t() + (size_t)l * INW * KD, gw, ngw, lane);
    transpose_items(p.in[15] + (size_t)l * D * D, D, D, p.in[14] + l * D, p.Wout_t() + (size_t)l * D * KD, gw, ngw, lane);
    transpose_items(p.in[17] + (size_t)l * D * D, D, D, p.in[16] + l * D, p.Wq_t() + (size_t)l * D * KD, gw, ngw, lane);
  }
}

__device__ __forceinline__ void phase_postproj(const Params& p, int l, int gw, int ngw, int lane) {
  const float* gq = p.in[12] + l * 64; const float* gk = p.in[13] + l * 64;
  for (int w = gw; w < T * 24; w += ngw) {
    int t = w / 24, slot = w % 24, s = t % S;
    float* row = p.proj() + (size_t)t * INW;
    if (slot < 16) {
      int h = slot & 7;
      float* q = row + (slot < 8 ? OFF_QM : OFF_KM) + h * 64;
      const float* g = slot < 8 ? gq : gk;
      float v = q[lane];
      float ss = wave_sum(v * v);
      float u = v * rsqrtf(ss / 64.0f + EPS) * g[lane];
      int partner = lane < 8 ? lane + 8 : lane - 8;
      float pu = __shfl(u, partner & 63);
      float o = u;
      if (lane < 16) {
        int i = lane & 7;
        float c = p.cosm()[s * 8 + i], sn = p.sinm()[s * 8 + i];
        o = lane < 8 ? (u * c - pu * sn) : (u * c + pu * sn);
      }
      q[lane] = o;
    } else {
      int h = (slot - 16) & 3; bool isk = slot >= 20;
      float* q = row + (isk ? OFF_KR : OFF_QR) + h * 64;
      float v = q[lane];
      float pv = __shfl(v, lane ^ 32);
      int i = lane & 31;
      float c = p.cosr()[s * 32 + i], sn = p.sinr()[s * 32 + i];
      float o = lane < 32 ? (v * c - pv * sn) : (v * c + pv * sn);
      if (isk) o *= 0.125f;
      q[lane] = o;
    }
  }
}

__device__ __forceinline__ void phase_kmean(const Params& p, int gtid, int ngt) {
  for (int idx = gtid; idx < NB * 8 * 16 * 64; idx += ngt) {
    int d = idx & 63, j = (idx >> 6) & 15, h = (idx >> 10) & 7, b = idx >> 13;
    const float* q = p.proj() + ((size_t)(b * S + j * 256)) * INW + OFF_KM + h * 64 + d;
    float acc = 0.f;
    for (int i = 0; i < 256; ++i) acc += q[(size_t)i * INW];
    p.kmean()[idx] = acc / 256.0f;
  }
}

__device__ __forceinline__ void s5_unit(const Params& p, int l, int unit, float* red, int lane) {
  const int b = unit >> 4, g = unit & 15, pp = lane;
  const float* lam_re = p.in[3] + l * 1024; const float* lam_im = p.in[4] + l * 1024; const float* log_dt = p.in[5] + l * 16;
  const float* b_re = p.in[6] + l * 16384; const float* b_im = p.in[7] + l * 16384;
  const float* c_re = p.in[8] + l * 16384; const float* c_im = p.in[9] + l * 16384; const float* dskip = p.in[10] + l * 256;
  float lr = lam_re[g * 64 + pp], li = lam_im[g * 64 + pp];
  float dt = expf(log_dt[g]);
  float mag = expf(lr * dt);
  float ar = mag * cosf(li * dt), ai = mag * sinf(li * dt);
  float den = lr * lr + li * li;
  float fr = ((ar - 1.0f) * lr + ai * li) / den;
  float fi = (ai * lr - (ar - 1.0f) * li) / den;
  float bbr[16], bbi[16], cr[16], ci[16];
#pragma unroll
  for (int h = 0; h < 16; ++h) {
    float br = b_re[(g * 64 + pp) * 16 + h], bi = b_im[(g * 64 + pp) * 16 + h];
    bbr[h] = fr * br - fi * bi; bbi[h] = fr * bi + fi * br;
    cr[h] = c_re[(g * 16 + h) * 64 + pp]; ci[h] = c_im[(g * 16 + h) * 64 + pp];
  }
  const int hq = pp >> 2, qq = pp & 3;
  float dsk = dskip[g * 16 + hq];
  float sr = 0.f, si = 0.f;
  for (int t = 0; t < S; ++t) {
    const float* up = p.proj() + (size_t)(b * S + t) * INW + OFF_U + g * 16;
    float u[16];
#pragma unroll
    for (int h4 = 0; h4 < 4; ++h4) { float4 v = *(const float4*)(up + h4 * 4); u[h4 * 4] = v.x; u[h4 * 4 + 1] = v.y; u[h4 * 4 + 2] = v.z; u[h4 * 4 + 3] = v.w; }
    float bur = 0.f, bui = 0.f;
#pragma unroll
    for (int h = 0; h < 16; ++h) { bur = fmaf(u[h], bbr[h], bur); bui = fmaf(u[h], bbi[h], bui); }
    float nr = ar * sr - ai * si + bur, ni = ar * si + ai * sr + bui;
    sr = nr; si = ni;
    LDS_FENCE();
#pragma unroll
    for (int h = 0; h < 16; ++h) red[h * 65 + pp] = sr * cr[h] - si * ci[h];
    LDS_FENCE();
    float acc = 0.f;
#pragma unroll
    for (int i = 0; i < 16; ++i) acc += red[hq * 65 + qq * 16 + i];
    acc += __shfl_xor(acc, 1);
    acc += __shfl_xor(acc, 2);
    if (qq == 0) p.yg()[(size_t)(b * S + t) * 256 + g * 16 + hq] = gelu_tanh(acc + up[hq] * dsk);
  }
}

__device__ __forceinline__ void ret_units(const Params& p, int l, int unit0, float* lds) {
  constexpr int TB = 16;
  int tx_ = threadIdx.x; asm volatile("" : "+v"(tx_));
  const int vb = tx_ >> 8, tid = tx_ & 255;
  float* base_l = lds + vb * (TB * 64 * 3 + TB * 4 * 64);
  float* qs = base_l; float* ks = qs + TB * 64; float* vs = ks + TB * 64; float* red = vs + TB * 64;
  const int unit = unit0 + vb;
  const int b = unit >> 2, h = unit & 3;
  const int e = tid & 63, dg = tid >> 6;
  const float gamma = 1.0f - exp2f(-5.0f - (float)h);
  float St[16];
#pragma unroll
  for (int i = 0; i < 16; ++i) St[i] = 0.f;
  const float* base = p.proj() + (size_t)(b * S) * INW;
  for (int t0 = 0; t0 < S; t0 += TB) {
    __syncthreads();
    for (int i = tid; i < TB * 64; i += 256) {
      int tt = i >> 6, d = i & 63;
      const float* r = base + (size_t)(t0 + tt) * INW;
      qs[tt * 64 + d] = r[OFF_QR + h * 64 + d]; ks[tt * 64 + d] = r[OFF_KR + h * 64 + d]; vs[tt * 64 + d] = r[OFF_VR + h * 64 + d];
    }
    __syncthreads();
    for (int tt = 0; tt < TB; ++tt) {
      float ve = vs[tt * 64 + e], part = 0.f;
#pragma unroll
      for (int i = 0; i < 16; ++i) {
        St[i] = fmaf(gamma, St[i], ks[tt * 64 + dg * 16 + i] * ve);
        part = fmaf(qs[tt * 64 + dg * 16 + i], St[i], part);
      }
      red[(tt * 4 + dg) * 64 + e] = part;
    }
    __syncthreads();
    for (int k = 0; k < 4; ++k) {
      int tt = dg * 4 + k;
      float o = red[(tt * 4 + 0) * 64 + e] + red[(tt * 4 + 1) * 64 + e] + red[(tt * 4 + 2) * 64 + e] + red[(tt * 4 + 3) * 64 + e];
      float ss = wave_sum(o * o);
      float gv = base[(size_t)(t0 + tt) * INW + OFF_GR + h * 64 + e];
      float sl = gv * sigmoidf_(gv);
      int col = 768 + h * 64 + e;
      p.ybuf()[(size_t)(b * S + t0 + tt) * D + col] = sl * o * rsqrtf(ss / 64.0f + EPS);
    }
  }
}

__device__ __forceinline__ void phase_s5glu(const Params& p, int l, float* ys, int gw, int ngw, int lane) {
  const float* wglu = p.in[11] + (size_t)l * 65536;
  for (int t = gw; t < T; t += ngw) {
    float yv[4];
    LDS_FENCE();
#pragma unroll
    for (int i = 0; i < 4; ++i) { yv[i] = p.yg()[(size_t)t * 256 + lane + i * 64]; ys[lane + i * 64] = yv[i]; }
    LDS_FENCE();
    float z[4] = {0.f, 0.f, 0.f, 0.f};
    for (int k = 0; k < 256; ++k) {
      float yk = ys[k];
#pragma unroll
      for (int i = 0; i < 4; ++i) z[i] = fmaf(yk, wglu[k * 256 + lane + i * 64], z[i]);
    }
    float o[4], ss = 0.f;
#pragma unroll
    for (int i = 0; i < 4; ++i) { o[i] = yv[i] * sigmoidf_(z[i]); ss += o[i] * o[i]; }
    ss = wave_sum(ss);
    float r = rsqrtf(ss / 256.0f + EPS);
#pragma unroll
    for (int i = 0; i < 4; ++i) p.ybuf()[(size_t)t * D + lane + i * 64] = o[i] * r;
  }
}


struct S5P { float lr, li, dt, fr, fi; };
__device__ __forceinline__ S5P s5p(const Params& p, int l, int g, int pp) {
  S5P r; r.lr = p.in[3][l * 1024 + g * 64 + pp]; r.li = p.in[4][l * 1024 + g * 64 + pp]; r.dt = expf(p.in[5][l * 16 + g]);
  const float mag = expf(r.lr * r.dt); float sn, cs; sincosf(r.li * r.dt, &sn, &cs);
  const float ar = mag * cs, ai = mag * sn, den = r.lr * r.lr + r.li * r.li;
  r.fr = ((ar - 1.0f) * r.lr + ai * r.li) / den; r.fi = (ai * r.lr - (ar - 1.0f) * r.li) / den;
  return r;
}
__device__ __forceinline__ void s5pow(const S5P& s, int k, float& re, float& im) {
  const float m = expf((float)k * s.lr * s.dt); float sn, cs; sincosf((float)k * s.li * s.dt, &sn, &cs); re = m * cs; im = m * sn;
}
__device__ __forceinline__ void phase_s5_prep(const Params& p, int l, int gtid, int ngt) {
  const float* b_re = p.in[6] + l * 16384; const float* b_im = p.in[7] + l * 16384;
  const float* c_re = p.in[8] + l * 16384; const float* c_im = p.in[9] + l * 16384;
  bf16_t* Wy = p.S5Wy(); bf16_t* Wz = p.S5Wz();
  for (int it = gtid; it < 16 * 32 * 256; it += ngt) {
    const int hp = it & 15, h = (it >> 4) & 15, d = (it >> 8) & 31, g = it >> 13;
    float acc = 0.f;
    for (int pp = 0; pp < 64; ++pp) {
      const S5P s = s5p(p, l, g, pp);
      float pr, pi; s5pow(s, d, pr, pi);
      const float br = b_re[(g * 64 + pp) * 16 + hp], bi = b_im[(g * 64 + pp) * 16 + hp];
      const float bbr = s.fr * br - s.fi * bi, bbi = s.fr * bi + s.fi * br;
      const float tr = pr * bbr - pi * bbi, ti = pr * bbi + pi * bbr;
      acc += c_re[(g * 16 + h) * 64 + pp] * tr - c_im[(g * 16 + h) * 64 + pp] * ti;
    }
    const bf16_t v = f2bf(acc);
    for (int jp = 0; jp + d < 32; ++jp) {
      const int j = jp + d;
      Wy[((size_t)g * 512 + j * 16 + h) * 640 + jp * 16 + hp] = v;
      if (d > 0) Wy[((size_t)g * 512 + jp * 16 + h) * 640 + j * 16 + hp] = 0;
    }
  }
  for (int it = gtid; it < 16 * 32 * 16 * 64; it += ngt) {
    const int pp = it & 63, h = (it >> 6) & 15, j = (it >> 10) & 31, g = it >> 15;
    const S5P s = s5p(p, l, g, pp);
    float pr, pi; s5pow(s, j + 1, pr, pi);
    const float cr = c_re[(g * 16 + h) * 64 + pp], ci = c_im[(g * 16 + h) * 64 + pp];
    const unsigned w = pk_bf16(cr * pr - ci * pi, -(cr * pi + ci * pr));
    *(unsigned*)(Wy + ((size_t)g * 512 + j * 16 + h) * 640 + 512 + 2 * pp) = w;
  }
  for (int it = gtid; it < 16 * 64 * 32; it += ngt) {
    const int j = it & 31, pp = (it >> 5) & 63, g = it >> 11;
    const S5P s = s5p(p, l, g, pp);
    float pr, pi; s5pow(s, 31 - j, pr, pi);
    for (int hp = 0; hp < 16; ++hp) {
      const float br = b_re[(g * 64 + pp) * 16 + hp], bi = b_im[(g * 64 + pp) * 16 + hp];
      const float bbr = s.fr * br - s.fi * bi, bbi = s.fr * bi + s.fi * br;
      Wz[((size_t)g * 256 + 2 * pp) * 512 + j * 16 + hp] = f2bf(pr * bbr - pi * bbi);
      Wz[((size_t)g * 256 + 2 * pp + 1) * 512 + j * 16 + hp] = f2bf(pr * bbi + pi * bbr);
    }
  }
  for (int it = gtid; it < 16 * 64; it += ngt) {
    const S5P s = s5p(p, l, it >> 6, it & 63);
    float pr, pi; s5pow(s, 32, pr, pi);
    p.S5a32()[it * 2] = pr; p.S5a32()[it * 2 + 1] = pi;
  }
}
__device__ __forceinline__ void phase_pack_u(const Params& p, int gtid, int ngt) {
  for (int idx = gtid; idx < T * 32; idx += ngt) {
    const int t = idx >> 5, i = idx & 31, g = i >> 1;
    const float* src = p.proj() + (size_t)t * INW + i * 8;
    float4 a = *(const float4*)src, b4 = *(const float4*)(src + 4);
    uint4 o; o.x = pk_bf16(a.x, a.y); o.y = pk_bf16(a.z, a.w); o.z = pk_bf16(b4.x, b4.y); o.w = pk_bf16(b4.z, b4.w);
    *(uint4*)(p.S5A() + ((size_t)g * 1024 + (t >> 5)) * 640 + (t & 31) * 16 + (i & 1) * 8) = o;
  }
}
__device__ __forceinline__ void phase_s5_scan(const Params& p, int gtid, int ngt) {
  for (int it = gtid; it < NB * 16 * 64; it += ngt) {
    const int pp = it & 63, g = (it >> 6) & 15, b = it >> 10;
    const float er = p.S5a32()[(g * 64 + pp) * 2], ei = p.S5a32()[(g * 64 + pp) * 2 + 1];
    float sr = 0.f, si = 0.f;
#pragma unroll 1
    for (int c0 = 0; c0 < 128; c0 += 16) {
      float2 z[16];
#pragma unroll
      for (int k = 0; k < 16; ++k) z[k] = *(const float2*)(p.S5Z() + ((size_t)g * 1024 + b * 128 + c0 + k) * 128 + 2 * pp);
#pragma unroll
      for (int k = 0; k < 16; ++k) {
        const size_t ch = (size_t)g * 1024 + b * 128 + c0 + k;
        *(unsigned*)(p.S5A() + ch * 640 + 512 + 2 * pp) = pk_bf16(sr, si);
        const float nr = er * sr - ei * si + z[k].x, ni = er * si + ei * sr + z[k].y;
        sr = nr; si = ni;
      }
    }
  }
}
#define EPI_ZERO_INIT \
  __device__ __forceinline__ void init(pg8::f32x4 (&acc)[2][2][4][2], const pg8::Unit&, int, int, int, int) const { \
    _Pragma("unroll") for (int a = 0; a < 2; ++a) _Pragma("unroll") for (int b = 0; b < 2; ++b) \
    _Pragma("unroll") for (int m = 0; m < 4; ++m) _Pragma("unroll") for (int n = 0; n < 2; ++n) acc[a][b][m][n] = (pg8::f32x4){0.f, 0.f, 0.f, 0.f}; }
struct EpiS5Z {
  static constexpr bool PERM = false, AFTER_DRAIN = false;
  float* Z;
  EPI_ZERO_INIT
  __device__ __forceinline__ void operator()(const pg8::f32x4 (&acc)[2][2][4][2], const pg8::Unit& u, int wr, int wc, int fr_in, int fq_in) const {
    int fr = fr_in, fq = fq_in; asm volatile("" : "+v"(fr), "+v"(fq));
    const int g = u.pm >> 2;
#pragma unroll
    for (int ai = 0; ai < 2; ++ai)
#pragma unroll
      for (int m = 0; m < 4; ++m) {
        const int chunk = (u.pm & 3) * 256 + ai * 128 + wr * 64 + m * 16 + fr;
#pragma unroll
        for (int n = 0; n < 2; ++n) *(pg8::f32x4*)(Z + ((size_t)g * 1024 + chunk) * 128 + wc * 32 + n * 16 + 4 * fq) = acc[ai][0][m][n];
      }
  }
};
struct EpiS5Y {
  static constexpr bool PERM = false, AFTER_DRAIN = false;
  bf16_t* ygb; const bf16_t* A; const float* dsk;
  EPI_ZERO_INIT
  __device__ __forceinline__ void operator()(const pg8::f32x4 (&acc)[2][2][4][2], const pg8::Unit& u, int wr, int wc, int fr_in, int fq_in) const {
    int fr = fr_in, fq = fq_in; asm volatile("" : "+v"(fr), "+v"(fq));
    const int g = u.pm >> 2;
#pragma unroll
    for (int ai = 0; ai < 2; ++ai)
#pragma unroll
      for (int m = 0; m < 4; ++m) {
        const int chunk = (u.pm & 3) * 256 + ai * 128 + wr * 64 + m * 16 + fr;
#pragma unroll
        for (int bj = 0; bj < 2; ++bj)
#pragma unroll
          for (int n = 0; n < 2; ++n) {
            const int col = (u.pn & 1) * 256 + bj * 128 + wc * 32 + n * 16 + 4 * fq, j = col >> 4, h = col & 15;
            const uint2 uu = *(const uint2*)(A + ((size_t)g * 1024 + chunk) * 640 + col);
            const pg8::f32x4 dv = *(const pg8::f32x4*)(dsk + g * 16 + h);
            const pg8::f32x4 v = acc[ai][bj][m][n];
            const float y0 = fast_gelu(v[0] + dv[0] * __uint_as_float(uu.x << 16)), y1 = fast_gelu(v[1] + dv[1] * __uint_as_float(uu.x & 0xffff0000u));
            const float y2 = fast_gelu(v[2] + dv[2] * __uint_as_float(uu.y << 16)), y3 = fast_gelu(v[3] + dv[3] * __uint_as_float(uu.y & 0xffff0000u));
            uint2 o; o.x = pk_bf16(y0, y1); o.y = pk_bf16(y2, y3);
            *(uint2*)(ygb + ((size_t)chunk * 32 + j) * 256 + g * 16 + h) = o;
          }
        asm volatile("" ::: "memory");
      }
  }
};
struct EpiGlu {
  static constexpr bool PERM = false, AFTER_DRAIN = false;
  bf16_t* yb; const bf16_t* ygb; float* scr;
  EPI_ZERO_INIT
  __device__ __forceinline__ void operator()(const pg8::f32x4 (&acc_)[2][2][4][2], const pg8::Unit& u, int wr, int wc, int fr_in, int fq_in) const {
    int fr = fr_in, fq = fq_in; asm volatile("" : "+v"(fr), "+v"(fq));
    pg8::f32x4 (&acc)[2][2][4][2] = const_cast<pg8::f32x4 (&)[2][2][4][2]>(acc_);
#pragma unroll
    for (int ai = 0; ai < 2; ++ai)
#pragma unroll
      for (int m = 0; m < 4; ++m) {
        const int rl = ai * 128 + wr * 64 + m * 16 + fr, row = u.pm * 256 + rl;
        float ss = 0.f;
#pragma unroll
        for (int bj = 0; bj < 2; ++bj)
#pragma unroll
          for (int n = 0; n < 2; ++n) {
            const int col = bj * 128 + wc * 32 + n * 16 + 4 * fq;
            const uint2 yy = *(const uint2*)(ygb + (size_t)row * 256 + col);
            const pg8::f32x4 z = acc[ai][bj][m][n];
            pg8::f32x4 r;
            r[0] = __uint_as_float(yy.x << 16) * fast_sigmoid(z[0]); r[1] = __uint_as_float(yy.x & 0xffff0000u) * fast_sigmoid(z[1]);
            r[2] = __uint_as_float(yy.y << 16) * fast_sigmoid(z[2]); r[3] = __uint_as_float(yy.y & 0xffff0000u) * fast_sigmoid(z[3]);
            acc[ai][bj][m][n] = r;
            ss += r[0] * r[0] + r[1] * r[1] + r[2] * r[2] + r[3] * r[3];
          }
        ss += __shfl_xor(ss, 16); ss += __shfl_xor(ss, 32);
        if (fq == 0) scr[rl * 4 + wc] = ss;
        asm volatile("" ::: "memory");
      }
    asm volatile("s_waitcnt lgkmcnt(0)" ::: "memory"); __builtin_amdgcn_s_barrier(); asm volatile("" ::: "memory");
#pragma unroll
    for (int ai = 0; ai < 2; ++ai)
#pragma unroll
      for (int m = 0; m < 4; ++m) {
        const int rl = ai * 128 + wr * 64 + m * 16 + fr, row = u.pm * 256 + rl;
        const pg8::f32x4 s4 = *(const pg8::f32x4*)(scr + rl * 4);
        const float r = rsqrtf((s4[0] + s4[1] + s4[2] + s4[3]) / 256.0f + EPS);
#pragma unroll
        for (int bj = 0; bj < 2; ++bj)
#pragma unroll
          for (int n = 0; n < 2; ++n) { const pg8::f32x4 v = acc[ai][bj][m][n] * r; *(uint2*)(yb + (size_t)row * KD + bj * 128 + wc * 32 + n * 16 + 4 * fq) = make_uint2(pk_bf16(v[0], v[1]), pk_bf16(v[2], v[3])); }
        asm volatile("" ::: "memory");
      }
    asm volatile("s_waitcnt lgkmcnt(0)" ::: "memory"); __builtin_amdgcn_s_barrier(); asm volatile("" ::: "memory");
  }
};

constexpr float QSCALE = 0.125f * 1.4426950408889634f;

__device__ __forceinline__ void phase_pack_moba(const Params& p, int gtid, int ngt) {
  for (int idx = gtid; idx < T * 128; idx += ngt) {
    const int t = idx >> 7, c = idx & 127, isk = c >> 6, cc = c & 63, h = cc >> 3, ch = cc & 7;
    const float* src = p.proj() + (size_t)t * INW + (isk ? OFF_KM : OFF_QM) + h * 64 + ch * 8;
    float4 a = *(const float4*)src, b4 = *(const float4*)(src + 4);
    const float sc = isk ? 1.0f : QSCALE;
    uint4 o; o.x = pk_bf16(a.x * sc, a.y * sc); o.y = pk_bf16(a.z * sc, a.w * sc); o.z = pk_bf16(b4.x * sc, b4.y * sc); o.w = pk_bf16(b4.z * sc, b4.w * sc);
    const int b = t / S, s = t % S;
    bf16_t* dst = isk ? p.Km() + ((((size_t)(b * 8 + h) * (S / 32) + (s >> 5)) * 8 + ch) * 32 + (s & 31)) * 8
                      : p.Qm() + ((size_t)(b * 8 + h) * S + s) * 64 + ch * 8;
    *(uint4*)dst = o;
  }
  for (int idx = gtid; idx < NB * 8 * (S / 32) * 256; idx += ngt) {
    const int ln = idx & 63, ks = (idx >> 6) & 1, mb = (idx >> 7) & 1, tile = (idx >> 8) % (S / 32), bh = idx / (256 * (S / 32));
    const int b = bh >> 3, h = bh & 7, hh = ln >> 5, delta = mb * 32 + (ln & 31);
    float v[8];
#pragma unroll
    for (int j = 0; j < 8; ++j) {
      const int kappa = 16 * ks + 8 * (j >> 2) + 4 * hh + (j & 3), s = tile * 32 + kappa;
      v[j] = p.proj()[(size_t)(b * S + s) * INW + OFF_VM + h * 64 + delta];
    }
    uint4 o; o.x = pk_bf16(v[0], v[1]); o.y = pk_bf16(v[2], v[3]); o.z = pk_bf16(v[4], v[5]); o.w = pk_bf16(v[6], v[7]);
    *(uint4*)(p.Vm() + (size_t)idx * 8) = o;
  }
}

__device__ __forceinline__ void phase_moba2(const Params& p, int l, unsigned char* lds, int bid, int G) {
  constexpr int OLD = 260;
  bf16_t* Qs = (bf16_t*)lds;
  float* Oaccf = (float*)(lds + 32768);
  float* laccf = (float*)(lds + 32768 + 64 * OLD * 4);
  float* kms = laccf + 256;
  float* gat = kms + 1024;
  unsigned char* lists = (unsigned char*)(gat + 4096);
  int* cnt = (int*)(lists + 4096);
  int* items = cnt + 16;
  int* ctr = items + 160;
  unsigned* selp = (unsigned*)(ctr + 4);
  float* bq = (float*)(selp + 256);
  int* Oacc = (int*)Oaccf; int* lacc = (int*)laccf;
  float kmax = 0.f;
  { const float* gk = p.in[13] + l * 64;
    for (int d = 0; d < 64; ++d) kmax = fmaxf(kmax, fabsf(gk[d]));
    kmax *= 8.0f * 1.01f; }
  for (int u = bid; u < NB * 8 * 16; u += G) {
    const int qblk = 15 - (u >> 6), bh = u & 63, b = bh >> 3, h = bh & 7;
    int tid = threadIdx.x; asm volatile("" : "+v"(tid));
    const int lane = tid & 63, wv = tid >> 6, n = lane & 31, hh = lane >> 5;
    __syncthreads();
    { const uint4* src = (const uint4*)(p.Qm() + ((size_t)bh * S + qblk * 256) * 64);
      uint4* dst = (uint4*)Qs;
      for (int i = tid; i < 256 * 64 * 2 / 16; i += NTHR) dst[i] = src[i]; }
    for (int i = tid; i < qblk * 64; i += NTHR) kms[i] = p.kmean()[(size_t)bh * 1024 + i];
    for (int i = tid; i < 64 * OLD; i += NTHR) Oacc[i] = 0;
    if (tid < 256) lacc[tid] = 0;
    if (tid < 16) cnt[tid] = 0;
    __syncthreads();
    { const int q = tid & 255, par = tid >> 8;
      float qv[64];
#pragma unroll
      for (int c = 0; c < 8; ++c) {
        uint4 w = *(const uint4*)(Qs + q * 64 + c * 8);
        qv[c * 8 + 0] = __uint_as_float(w.x << 16); qv[c * 8 + 1] = __uint_as_float(w.x & 0xffff0000u);
        qv[c * 8 + 2] = __uint_as_float(w.y << 16); qv[c * 8 + 3] = __uint_as_float(w.y & 0xffff0000u);
        qv[c * 8 + 4] = __uint_as_float(w.z << 16); qv[c * 8 + 5] = __uint_as_float(w.z & 0xffff0000u);
        qv[c * 8 + 6] = __uint_as_float(w.w << 16); qv[c * 8 + 7] = __uint_as_float(w.w & 0xffff0000u);
      }
      if (par == 0) { float qq = 0.f;
#pragma unroll
        for (int d = 0; d < 64; ++d) qq = fmaf(qv[d], qv[d], qq);
        bq[q] = sqrtf(qq) * kmax; }
      for (int j = par; j < qblk; j += 2) {
        float g = 0.f;
#pragma unroll
        for (int d = 0; d < 64; ++d) g = fmaf(qv[d], kms[j * 64 + d], g);
        gat[q * 16 + j] = g;
      }
    }
    __syncthreads();
    if (tid < 256) {
      float b0 = -INFINITY, b1 = -INFINITY, b2 = -INFINITY; int i0 = 0, i1 = 0, i2 = 0;
      for (int j = 0; j < qblk; ++j) {
        float g = gat[tid * 16 + j];
        if (g > b0) { b2 = b1; i2 = i1; b1 = b0; i1 = i0; b0 = g; i0 = j; }
        else if (g > b1) { b2 = b1; i2 = i1; b1 = g; i1 = j; }
        else if (g > b2) { b2 = g; i2 = j; }
      }
      const int nsel = qblk < 3 ? qblk : 3;
      selp[tid] = (unsigned)i0 | ((unsigned)i1 << 4) | ((unsigned)i2 << 8) | ((unsigned)nsel << 12);
    }
    __syncthreads();
    for (int j = wv; j < qblk; j += 8) {
      int base = 0;
      for (int c = 0; c < 4; ++c) {
        const int q = c * 64 + lane;
        const unsigned sp = selp[q];
        const int ns = sp >> 12;
        const bool f = (ns > 0 && (int)(sp & 15) == j) || (ns > 1 && (int)((sp >> 4) & 15) == j) || (ns > 2 && (int)((sp >> 8) & 15) == j);
        const unsigned long long bal = __ballot(f);
        const int pos = base + __popcll(bal & ((1ull << lane) - 1ull));
        if (f) lists[j * 256 + pos] = (unsigned char)q;
        base += __popcll(bal);
      }
      if (lane == 0) cnt[j] = base;
    }
    __syncthreads();
    if (tid == 0) {
      int ni = 0;
#pragma unroll 1
      for (int g = 7; g >= 0; --g) items[ni++] = (16 << 8) | g;
      for (int j = 0; j < qblk; ++j) { const int ng = (cnt[j] + 31) >> 5; for (int g = 0; g < ng; ++g) items[ni++] = (j << 8) | g; }
      ctr[0] = ni; ctr[1] = 0;
    }
    __syncthreads();
    const int nitems = ctr[0];
    for (;;) {
      int it = 0;
      if (lane == 0) it = atomicAdd(&ctr[1], 1);
      it = __builtin_amdgcn_readfirstlane(it);
      if (it >= nitems) break;
      const int item = items[it];
      const int j = item >> 8, g = item & 255;
      const bool own = (j == 16);
      const int kb = own ? qblk : j;
      const int ntile = own ? (g + 1) : 8;
      int qi; bool valid;
      if (own) { qi = g * 32 + n; valid = true; }
      else { const int pos = g * 32 + n; valid = pos < cnt[j]; qi = lists[j * 256 + (valid ? pos : 0)]; }
      const bf16_t* kt0 = p.Km() + ((size_t)bh * (S / 32) + kb * 8) * 2048 + lane * 8;
      const bf16_t* vt0 = p.Vm() + ((size_t)bh * (S / 32) + kb * 8) * 2048 + lane * 8;
      f32x16 O0, O1;
#pragma unroll
      for (int r = 0; r < 16; ++r) { O0[r] = 0.f; O1[r] = 0.f; }
      float lsum = 0.f;
      const float nbq = -bq[qi];
      bf16x8 kf[3][4], vf[3][4];
#define MOBA_LOAD(KT_, BUF_) { _Pragma("unroll") for (int s = 0; s < 4; ++s) { kf[BUF_][s] = *(const bf16x8*)(kt0 + (size_t)(KT_) * 2048 + s * 512); vf[BUF_][s] = *(const bf16x8*)(vt0 + (size_t)(KT_) * 2048 + s * 512); } }
#define MOBA_STEP(KT_, BUF_)                                                                                                           \
      if ((KT_) < ntile) {                                                                                                               \
        if ((KT_) + 2 < ntile) MOBA_LOAD((KT_) + 2, ((BUF_) + 2) % 3)                                                                     \
        f32x16 X;                                                                                                                         \
        _Pragma("unroll") for (int r = 0; r < 16; ++r) X[r] = nbq;                                                                        \
        _Pragma("unroll") for (int s = 0; s < 4; ++s) X = __builtin_amdgcn_mfma_f32_32x32x16_bf16(kf[BUF_][s], *(const bf16x8*)(Qs + qi * 64 + (2 * s + hh) * 8), X, 0, 0, 0);     \
        const bool diag = own && ((KT_) == g);                                                                                            \
        unsigned pw[8];                                                                                                                   \
        _Pragma("unroll") for (int r = 0; r < 16; r += 2) {                                                                               \
          float e0 = __builtin_amdgcn_exp2f(X[r]), e1 = __builtin_amdgcn_exp2f(X[r + 1]);                                                 \
          if (diag) {                                                                                                                     \
            const int k0 = (r & 3) + 8 * (r >> 2) + 4 * hh, k1 = ((r + 1) & 3) + 8 * ((r + 1) >> 2) + 4 * hh;                             \
            e0 = (k0 <= n) ? e0 : 0.f; e1 = (k1 <= n) ? e1 : 0.f;                                                                         \
          }                                                                                                                               \
          lsum += e0 + e1;                                                                                                                \
          pw[r >> 1] = pk_bf16(e0, e1);                                                                                                   \
        }                                                                                                                                 \
        bf16x8 pf0, pf1;                                                                                                                  \
        { uint4 t0 = make_uint4(pw[0], pw[1], pw[2], pw[3]), t1 = make_uint4(pw[4], pw[5], pw[6], pw[7]);                                 \
          pf0 = *(bf16x8*)&t0; pf1 = *(bf16x8*)&t1; }                                                                                     \
        O0 = __builtin_amdgcn_mfma_f32_32x32x16_bf16(vf[BUF_][0], pf0, O0, 0, 0, 0);                                                      \
        O0 = __builtin_amdgcn_mfma_f32_32x32x16_bf16(vf[BUF_][1], pf1, O0, 0, 0, 0);                                                      \
        O1 = __builtin_amdgcn_mfma_f32_32x32x16_bf16(vf[BUF_][2], pf0, O1, 0, 0, 0);                                                      \
        O1 = __builtin_amdgcn_mfma_f32_32x32x16_bf16(vf[BUF_][3], pf1, O1, 0, 0, 0);                                                      \
      }
      MOBA_LOAD(0, 0)
      if (ntile > 1) MOBA_LOAD(1, 1)
#pragma unroll 1
      for (int kt3 = 0; kt3 < ntile; kt3 += 3) {
        MOBA_STEP(kt3, 0) MOBA_STEP(kt3 + 1, 1) MOBA_STEP(kt3 + 2, 2)
      }
#undef MOBA_STEP
#undef MOBA_LOAD
      lsum += __shfl_xor(lsum, 32);
      if (valid) {
        if (hh == 0) atomicAdd(&lacc[qi], __float2int_rn(lsum * 1048576.0f));
#pragma unroll
        for (int r = 0; r < 16; ++r) {
          const int dim = (r & 3) + 8 * (r >> 2) + 4 * hh;
          atomicAdd(&Oacc[dim * OLD + qi], __float2int_rn(O0[r] * 1048576.0f));
          atomicAdd(&Oacc[(dim + 32) * OLD + qi], __float2int_rn(O1[r] * 1048576.0f));
        }
      }
    }
    __syncthreads();
    { const int q = tid >> 1, half = tid & 1;
      const float inv = 1.0f / (float)lacc[q];
      float o[32], ss = 0.f;
#pragma unroll
      for (int d = 0; d < 32; ++d) { o[d] = (float)Oacc[(half * 32 + d) * OLD + q] * inv; ss += o[d] * o[d]; }
      ss += __shfl_xor(ss, 1);
      const float r = rsqrtf(ss / 64.0f + EPS);
      bf16_t* dst = p.xb() + (size_t)(b * S + qblk * 256 + q) * KD + 256 + h * 64 + half * 32;
#pragma unroll
      for (int d = 0; d < 32; d += 8) *(uint4*)(dst + d) = make_uint4(pk_bf16(o[d] * r, o[d + 1] * r), pk_bf16(o[d + 2] * r, o[d + 3] * r), pk_bf16(o[d + 4] * r, o[d + 5] * r), pk_bf16(o[d + 6] * r, o[d + 7] * r));
    }
  }
}


__device__ __forceinline__ float ret_log2g(int h) { return log2f(1.0f - exp2f(-5.0f - (float)h)); }
__device__ __forceinline__ void phase_pack_ret(const Params& p, int gtid, int ngt) {
  for (int idx = gtid; idx < T * 64; idx += ngt) {
    const int t = idx >> 6, c = idx & 63, isk = c >> 5, cc = c & 31, h = cc >> 3, ch = cc & 7;
    const int b = t / S, s = t % S, i = s & 127;
    const float* src = p.proj() + (size_t)t * INW + (isk ? OFF_KR : OFF_QR) + h * 64 + ch * 8;
    float4 a = *(const float4*)src, b4 = *(const float4*)(src + 4);
    const float sc = exp2f((isk ? -(float)i : (float)i) * ret_log2g(h));
    uint4 o; o.x = pk_bf16(a.x * sc, a.y * sc); o.y = pk_bf16(a.z * sc, a.w * sc); o.z = pk_bf16(b4.x * sc, b4.y * sc); o.w = pk_bf16(b4.z * sc, b4.w * sc);
    const int bh = b * 4 + h;
    bf16_t* dst = isk ? p.Kr() + ((((size_t)bh * (S / 32) + (s >> 5)) * 8 + ch) * 32 + (s & 31)) * 8
                      : p.Qr() + ((size_t)bh * S + s) * 64 + ch * 8;
    *(uint4*)dst = o;
  }
  for (int idx = gtid; idx < 2 * NB * 4 * (S / 32) * 256; idx += ngt) {
    const int ln = idx & 63, ks = (idx >> 6) & 1, blk = (idx >> 7) & 1, tile = (idx >> 8) % (S / 32), rest = idx / (256 * (S / 32)), bh = rest % (NB * 4), which = rest / (NB * 4);
    const int b = bh >> 2, h = bh & 3, hh = ln >> 5, delta = blk * 32 + (ln & 31);
    const float l2g = ret_log2g(h);
    float v[8];
#pragma unroll
    for (int j = 0; j < 8; ++j) {
      const int kappa = 16 * ks + 8 * (j >> 2) + 4 * hh + (j & 3), s = tile * 32 + kappa;
      float x = p.proj()[(size_t)(b * S + s) * INW + (which ? OFF_KR : OFF_VR) + h * 64 + delta];
      if (which) x *= exp2f(-(float)(s & 127) * l2g);
      v[j] = x;
    }
    uint4 o; o.x = pk_bf16(v[0], v[1]); o.y = pk_bf16(v[2], v[3]); o.z = pk_bf16(v[4], v[5]); o.w = pk_bf16(v[6], v[7]);
    *(uint4*)((which ? p.Krv() : p.Vr()) + ((size_t)(idx % (NB * 4 * (S / 32) * 256))) * 8) = o;
  }
}
__device__ __forceinline__ void phase_ret_kv(const Params& p, int gw, int ngw, int lane) {
  const int n = lane & 31, hh = lane >> 5;
  for (int w = gw; w < NB * 4 * 32; w += ngw) {
    const int bh = w >> 5, cn = w & 31;
    const bf16_t* vt = p.Vr() + ((size_t)bh * (S / 32) + cn * 4) * 2048 + lane * 8;
    const bf16_t* kt = p.Krv() + ((size_t)bh * (S / 32) + cn * 4) * 2048 + lane * 8;
    f32x16 acc[2][2];
#pragma unroll
    for (int a = 0; a < 2; ++a)
#pragma unroll
      for (int b2 = 0; b2 < 2; ++b2)
#pragma unroll
        for (int r = 0; r < 16; ++r) acc[a][b2][r] = 0.f;
#pragma unroll 1
    for (int tl = 0; tl < 4; ++tl)
#pragma unroll
      for (int ks = 0; ks < 2; ++ks) {
        bf16x8 vf[2], kf[2];
#pragma unroll
        for (int x = 0; x < 2; ++x) { vf[x] = *(const bf16x8*)(vt + tl * 2048 + (x * 2 + ks) * 512); kf[x] = *(const bf16x8*)(kt + tl * 2048 + (x * 2 + ks) * 512); }
#pragma unroll
        for (int mb = 0; mb < 2; ++mb)
#pragma unroll
          for (int nb = 0; nb < 2; ++nb) acc[mb][nb] = __builtin_amdgcn_mfma_f32_32x32x16_bf16(vf[mb], kf[nb], acc[mb][nb], 0, 0, 0);
      }
    float* dst = p.KVr() + ((size_t)bh * 32 + cn) * 4096;
#pragma unroll
    for (int mb = 0; mb < 2; ++mb)
#pragma unroll
      for (int nb = 0; nb < 2; ++nb)
#pragma unroll
        for (int r = 0; r < 16; ++r) dst[(mb * 32 + (r & 3) + 8 * (r >> 2) + 4 * hh) * 64 + nb * 32 + n] = acc[mb][nb][r];
  }
}
__device__ __forceinline__ void phase_ret_scan(const Params& p, int gtid, int ngt) {
  for (int it = gtid; it < NB * 4 * 4096; it += ngt) {
    const int e = it & 4095, bh = it >> 12, h = bh & 3;
    const float l2g = ret_log2g(h), g1 = exp2f(l2g), g127 = exp2f(127.0f * l2g), g128 = exp2f(128.0f * l2g);
    float R = 0.f; float kv[32];
#pragma unroll
    for (int cn = 0; cn < 32; ++cn) kv[cn] = p.KVr()[((size_t)bh * 32 + cn) * 4096 + e];
#pragma unroll
    for (int cn = 0; cn < 32; ++cn) {
      p.Rb()[((size_t)bh * 32 + cn) * 4096 + e] = f2bf(g1 * R);
      R = g128 * R + g127 * kv[cn];
    }
  }
}
__device__ __forceinline__ void phase_ret_out(const Params& p, int gw, int ngw, int lane) {
  const int n = lane & 31, hh = lane >> 5;
  for (int w = gw; w < NB * 4 * 32 * 4; w += ngw) {
    const int qg = 3 - (w & 3), cn = (w >> 2) & 31, bh = w >> 7, b = bh >> 2, h = bh & 3;
    const int s0 = cn * 128 + qg * 32;
    bf16x8 qf[4];
#pragma unroll
    for (int s = 0; s < 4; ++s) qf[s] = *(const bf16x8*)(p.Qr() + ((size_t)bh * S + s0 + n) * 64 + (2 * s + hh) * 8);
    f32x16 O0, O1;
#pragma unroll
    for (int r = 0; r < 16; ++r) { O0[r] = 0.f; O1[r] = 0.f; }
    { const bf16_t* rb = p.Rb() + ((size_t)bh * 32 + cn) * 4096 + (size_t)n * 64 + hh * 8;
#pragma unroll
      for (int s = 0; s < 4; ++s) {
        const bf16x8 r0 = *(const bf16x8*)(rb + s * 16), r1 = *(const bf16x8*)(rb + 32 * 64 + s * 16);
        O0 = __builtin_amdgcn_mfma_f32_32x32x16_bf16(r0, qf[s], O0, 0, 0, 0);
        O1 = __builtin_amdgcn_mfma_f32_32x32x16_bf16(r1, qf[s], O1, 0, 0, 0);
      } }
    const bf16_t* kt0 = p.Kr() + ((size_t)bh * (S / 32) + cn * 4) * 2048 + lane * 8;
    const bf16_t* vt0 = p.Vr() + ((size_t)bh * (S / 32) + cn * 4) * 2048 + lane * 8;
    for (int kt = 0; kt <= qg; ++kt) {
      bf16x8 kf[4], vf[4];
#pragma unroll
      for (int s = 0; s < 4; ++s) { kf[s] = *(const bf16x8*)(kt0 + (size_t)kt * 2048 + s * 512); vf[s] = *(const bf16x8*)(vt0 + (size_t)kt * 2048 + s * 512); }
      f32x16 X;
#pragma unroll
      for (int r = 0; r < 16; ++r) X[r] = 0.f;
#pragma unroll
      for (int s = 0; s < 4; ++s) X = __builtin_amdgcn_mfma_f32_32x32x16_bf16(kf[s], qf[s], X, 0, 0, 0);
      const bool diag = (kt == qg);
      unsigned pw[8];
#pragma unroll
      for (int r = 0; r < 16; r += 2) {
        float e0 = X[r], e1 = X[r + 1];
        if (diag) {
          const int k0 = (r & 3) + 8 * (r >> 2) + 4 * hh, k1 = ((r + 1) & 3) + 8 * ((r + 1) >> 2) + 4 * hh;
          e0 = (k0 <= n) ? e0 : 0.f; e1 = (k1 <= n) ? e1 : 0.f;
        }
        pw[r >> 1] = pk_bf16(e0, e1);
      }
      bf16x8 pf0, pf1;
      { uint4 t0 = make_uint4(pw[0], pw[1], pw[2], pw[3]), t1 = make_uint4(pw[4], pw[5], pw[6], pw[7]);
        pf0 = *(bf16x8*)&t0; pf1 = *(bf16x8*)&t1; }
      O0 = __builtin_amdgcn_mfma_f32_32x32x16_bf16(vf[0], pf0, O0, 0, 0, 0);
      O0 = __builtin_amdgcn_mfma_f32_32x32x16_bf16(vf[1], pf1, O0, 0, 0, 0);
      O1 = __builtin_amdgcn_mfma_f32_32x32x16_bf16(vf[2], pf0, O1, 0, 0, 0);
      O1 = __builtin_amdgcn_mfma_f32_32x32x16_bf16(vf[3], pf1, O1, 0, 0, 0);
    }
    float ss = 0.f;
#pragma unroll
    for (int r = 0; r < 16; ++r) ss += O0[r] * O0[r] + O1[r] * O1[r];
    ss += __shfl_xor(ss, 32);
    const float rn = rsqrtf(ss / 64.0f + EPS);
    const size_t t = (size_t)b * S + s0 + n;
    const float* gp = p.proj() + t * INW + OFF_GR + h * 64;
    bf16_t* yo = p.xb() + t * KD + 768 + h * 64;
#pragma unroll
    for (int q4 = 0; q4 < 4; ++q4) {
#pragma unroll
      for (int mb = 0; mb < 2; ++mb) {
        const int d0 = mb * 32 + 8 * q4 + 4 * hh;
        const float4 g = *(const float4*)(gp + d0);
        float4 o;
        const f32x16& Oa = mb ? O1 : O0;
        o.x = Oa[q4 * 4 + 0] * rn * g.x * fast_sigmoid(g.x); o.y = Oa[q4 * 4 + 1] * rn * g.y * fast_sigmoid(g.y);
        o.z = Oa[q4 * 4 + 2] * rn * g.z * fast_sigmoid(g.z); o.w = Oa[q4 * 4 + 3] * rn * g.w * fast_sigmoid(g.w);
        *(uint2*)(yo + d0) = make_uint2(pk_bf16(o.x, o.y), pk_bf16(o.z, o.w));
      }
    }
  }
}

__device__ __forceinline__ void phase_post_pack(const Params& p, int l, int gtid, int ngt, int gw, int ngw, int lane) {
  const float* gq = p.in[12] + l * 64; const float* gk = p.in[13] + l * 64;
  for (int t = gw; t < T; t += ngw) {
    const int s = t % S, b = t / S;
    const float* row = p.proj() + (size_t)t * INW;
    float vin[24];
#pragma unroll
    for (int sl = 0; sl < 16; ++sl) vin[sl] = row[(sl < 8 ? OFF_QM : OFF_KM) + (sl & 7) * 64 + lane];
#pragma unroll
    for (int sl = 0; sl < 8; ++sl) vin[16 + sl] = row[(sl < 4 ? OFF_QR : OFF_KR) + (sl & 3) * 64 + lane];
    const float cm = p.cosm()[s * 8 + (lane & 7)], sm = p.sinm()[s * 8 + (lane & 7)];
    const float cr = p.cosr()[s * 32 + (lane & 31)], sr = p.sinr()[s * 32 + (lane & 31)];
    const float gqv = gq[lane], gkv = gk[lane];
#pragma unroll
    for (int slot = 0; slot < 16; ++slot) {
      const int h = slot & 7, bh = b * 8 + h; const bool isk = slot >= 8;
      const float v = vin[slot];
      const float ss = wave_sum(v * v);
      const float u = v * rsqrtf(ss / 64.0f + EPS) * (isk ? gkv : gqv);
      const float pu = __shfl(u, (lane < 8 ? lane + 8 : lane - 8) & 63);
      float o = u;
      if (lane < 16) o = lane < 8 ? (u * cm - pu * sm) : (u * cm + pu * sm);
      if (!isk) p.Qm()[((size_t)bh * S + s) * 64 + lane] = f2bf(o * QSCALE);
      else p.Km()[((((size_t)bh * (S / 32) + (s >> 5)) * 8 + (lane >> 3)) * 32 + (s & 31)) * 8 + (lane & 7)] = f2bf(o);
    }
#pragma unroll
    for (int slot = 16; slot < 24; ++slot) {
      const int h = (slot - 16) & 3, bh = b * 4 + h; const bool isk = slot >= 20;
      const float v = vin[slot];
      const float pv = __shfl(v, lane ^ 32);
      const float o = lane < 32 ? (v * cr - pv * sr) : (v * cr + pv * sr);
      const float l2g = ret_log2g(h); const int pos = s & 127;
      if (!isk) p.Qr()[((size_t)bh * S + s) * 64 + lane] = f2bf(o * exp2f((float)pos * l2g));
      else p.Kr()[((((size_t)bh * (S / 32) + (s >> 5)) * 8 + (lane >> 3)) * 32 + (s & 31)) * 8 + (lane & 7)] = f2bf(o * 0.125f * exp2f(-(float)pos * l2g));
    }
  }
  for (int idx = gtid; idx < NB * 8 * (S / 32) * 256; idx += ngt) {
    const int ln = idx & 63, ks = (idx >> 6) & 1, mb = (idx >> 7) & 1, tile = (idx >> 8) % (S / 32), bh = idx / (256 * (S / 32));
    const int b = bh >> 3, h = bh & 7, hh = ln >> 5, delta = mb * 32 + (ln & 31);
    float v[8];
#pragma unroll
    for (int j = 0; j < 8; ++j) { const int kappa = 16 * ks + 8 * (j >> 2) + 4 * hh + (j & 3), s = tile * 32 + kappa; v[j] = p.proj()[(size_t)(b * S + s) * INW + OFF_VM + h * 64 + delta]; }
    uint4 o; o.x = pk_bf16(v[0], v[1]); o.y = pk_bf16(v[2], v[3]); o.z = pk_bf16(v[4], v[5]); o.w = pk_bf16(v[6], v[7]);
    *(uint4*)(p.Vm() + (size_t)idx * 8) = o;
  }
  for (int idx = gtid; idx < 2 * NB * 4 * (S / 32) * 256; idx += ngt) {
    const int ln = idx & 63, ks = (idx >> 6) & 1, blk = (idx >> 7) & 1, tile = (idx >> 8) % (S / 32), rest = idx / (256 * (S / 32)), bh = rest % (NB * 4), which = rest / (NB * 4);
    const int b = bh >> 2, h = bh & 3, hh = ln >> 5, delta = blk * 32 + (ln & 31);
    const float l2g = ret_log2g(h);
    float v[8];
#pragma unroll
    for (int j = 0; j < 8; ++j) {
      const int kappa = 16 * ks + 8 * (j >> 2) + 4 * hh + (j & 3), s = tile * 32 + kappa;
      const float* row = p.proj() + (size_t)(b * S + s) * INW;
      float x;
      if (which) {
        const float a = row[OFF_KR + h * 64 + delta], pa = row[OFF_KR + h * 64 + (delta ^ 32)];
        const int i = delta & 31; const float c = p.cosr()[s * 32 + i], sn = p.sinr()[s * 32 + i];
        x = (delta < 32 ? (a * c - pa * sn) : (a * c + pa * sn)) * 0.125f * exp2f(-(float)(s & 127) * l2g);
      } else x = row[OFF_VR + h * 64 + delta];
      v[j] = x;
    }
    uint4 o; o.x = pk_bf16(v[0], v[1]); o.y = pk_bf16(v[2], v[3]); o.z = pk_bf16(v[4], v[5]); o.w = pk_bf16(v[6], v[7]);
    *(uint4*)((which ? p.Krv() : p.Vr()) + ((size_t)(idx % (NB * 4 * (S / 32) * 256))) * 8) = o;
  }
}
__device__ __forceinline__ void phase_kmean2(const Params& p, int gtid, int ngt) {
  for (int idx = gtid; idx < NB * 8 * 16 * 64; idx += ngt) {
    const int d = idx & 63, j = (idx >> 6) & 15, bh = idx >> 10, c = d >> 3, dj = d & 7;
    float acc = 0.f;
    for (int tl = 0; tl < 8; ++tl) {
      const bf16_t* kp = p.Km() + (((size_t)bh * (S / 32) + j * 8 + tl) * 8 + c) * 256 + dj;
#pragma unroll 8
      for (int key = 0; key < 32; ++key) acc += bf2f(kp[key * 8]);
    }
    p.kmean()[idx] = acc * (1.0f / 256.0f);
  }
}

__device__ __forceinline__ void cvt_f32_bf16(const float* __restrict__ src, bf16_t* __restrict__ dst, size_t n8, int gtid, int ngt) {
  for (size_t i = gtid; i < n8; i += ngt) {
    float4 a = *(const float4*)(src + i * 8), b4 = *(const float4*)(src + i * 8 + 4);
    uint4 o; o.x = pk_bf16(a.x, a.y); o.y = pk_bf16(a.z, a.w); o.z = pk_bf16(b4.x, b4.y); o.w = pk_bf16(b4.z, b4.w);
    *(uint4*)(dst + i * 8) = o;
  }
}
__device__ __forceinline__ int f2key(float f) { int b = __float_as_int(f); return b ^ ((b >> 31) & 0x7fffffff); }
__device__ __forceinline__ float key2f(int k) { return __int_as_float(k ^ ((k >> 31) & 0x7fffffff)); }
#define CASD(a_, b_) { int mx_ = max(a_, b_), mn_ = min(a_, b_); a_ = mx_; b_ = mn_; }
__device__ __forceinline__ void sort16_desc(int (&v)[16]) {
#pragma unroll
  for (int k = 2; k <= 16; k <<= 1)
#pragma unroll
    for (int j = k >> 1; j > 0; j >>= 1)
#pragma unroll
      for (int i = 0; i < 16; ++i) { const int l2 = i ^ j; if (l2 > i) { if ((i & k) == 0) CASD(v[i], v[l2]) else CASD(v[l2], v[i]) } }
}
__device__ __forceinline__ void merge_top16(int (&a)[16], const int (&b)[16]) {
#pragma unroll
  for (int i = 0; i < 16; ++i) a[i] = max(a[i], b[15 - i]);
#pragma unroll
  for (int j = 8; j > 0; j >>= 1)
#pragma unroll
    for (int i = 0; i < 16; ++i) { const int l2 = i ^ j; if (l2 > i) CASD(a[i], a[l2]) }
}
__device__ __forceinline__ int lut4(int w0, int w1, int w2, int w3, int i) {
  const int w = i >> 2; const int d = (w == 0) ? w0 : (w == 1) ? w1 : (w == 2) ? w2 : w3;
  return (d >> ((i & 3) * 8)) & 127;
}

__device__ __forceinline__ void phase_peer_topk(const Params& p, int l, int gw, int ngw, int lane) {
  const int n = lane & 31, hh = lane >> 5;
  const bf16_t* skl = p.skb() + (size_t)l * 16 * 128 * 64;
  for (int w = gw; w < (T / 32) * 8; w += ngw) {
    const int tg = w >> 3, h = w & 7, t = tg * 32 + n;
    int L0[16], L1[16];
#pragma unroll
    for (int c = 0; c < 2; ++c) {
      const int hc = 2 * h + c;
      bf16x8 qf[4];
#pragma unroll
      for (int s = 0; s < 4; ++s) qf[s] = *(const bf16x8*)(p.qb() + (size_t)t * D + hc * 64 + 16 * s + 8 * hh);
      int A[16], Bq[16];
#pragma unroll
      for (int mb = 0; mb < 4; ++mb) {
        f32x16 X;
#pragma unroll
        for (int r = 0; r < 16; ++r) X[r] = 0.f;
#pragma unroll
        for (int s = 0; s < 4; ++s) {
          const bf16x8 kf = *(const bf16x8*)(skl + ((size_t)(hc * 128 + mb * 32 + n)) * 64 + 16 * s + 8 * hh);
          X = __builtin_amdgcn_mfma_f32_32x32x16_bf16(kf, qf[s], X, 0, 0, 0);
        }
        int Gk[16];
#pragma unroll
        for (int r = 0; r < 16; ++r) Gk[r] = (f2key(X[r]) & ~127) | (mb * 32 + (r & 3) + 8 * (r >> 2) + 4 * hh);
        sort16_desc(Gk);
        if (mb == 0) {
#pragma unroll
          for (int r = 0; r < 16; ++r) A[r] = Gk[r];
        } else merge_top16(A, Gk);
      }
#pragma unroll
      for (int r = 0; r < 16; ++r) Bq[r] = __shfl_xor(A[r], 32);
      merge_top16(A, Bq);
#pragma unroll
      for (int r = 0; r < 16; ++r) { if (c == 0) L0[r] = A[r]; else L1[r] = A[r]; }
    }
    float av[16], bv[16];
#pragma unroll
    for (int r = 0; r < 16; ++r) { av[r] = key2f(L0[r] & ~127); bv[r] = key2f(L1[r] & ~127); }
#define CAND(i_, j_) ((f2key(av[i_] + bv[j_]) & ~255) | ((i_) << 4) | (j_))
    int R[16], G1[16], G2[16];
#pragma unroll
    for (int j = 0; j < 16; ++j) R[j] = CAND(0, j);
    G1[0] = CAND(1, 0); G1[1] = CAND(1, 1); G1[2] = CAND(1, 2); G1[3] = CAND(1, 3); G1[4] = CAND(1, 4); G1[5] = CAND(1, 5); G1[6] = CAND(1, 6); G1[7] = CAND(1, 7);
    G1[8] = CAND(2, 0); G1[9] = CAND(2, 1); G1[10] = CAND(2, 2); G1[11] = CAND(2, 3); G1[12] = CAND(2, 4); G1[13] = CAND(3, 0); G1[14] = CAND(3, 1); G1[15] = CAND(3, 2);
    G2[0] = CAND(3, 3); G2[1] = CAND(4, 0); G2[2] = CAND(4, 1); G2[3] = CAND(4, 2); G2[4] = CAND(5, 0); G2[5] = CAND(5, 1); G2[6] = CAND(6, 0); G2[7] = CAND(6, 1);
    G2[8] = CAND(7, 0); G2[9] = CAND(7, 1); G2[10] = CAND(8, 0); G2[11] = CAND(9, 0); G2[12] = CAND(10, 0); G2[13] = CAND(11, 0); G2[14] = CAND(12, 0); G2[15] = CAND(13, 0);
    sort16_desc(G1); merge_top16(R, G1);
    sort16_desc(G2); merge_top16(R, G2);
    { int x0 = CAND(14, 0), x1 = CAND(15, 0);
#pragma unroll
      for (int i = 0; i < 16; ++i) CASD(R[i], x0)
#pragma unroll
      for (int i = 0; i < 16; ++i) CASD(R[i], x1)
    }
#undef CAND
    int pa0 = 0, pa1 = 0, pa2 = 0, pa3 = 0, pb0 = 0, pb1 = 0, pb2 = 0, pb3 = 0;
#pragma unroll
    for (int q = 0; q < 4; ++q) {
      pa0 |= (L0[q] & 127) << (8 * q); pa1 |= (L0[4 + q] & 127) << (8 * q); pa2 |= (L0[8 + q] & 127) << (8 * q); pa3 |= (L0[12 + q] & 127) << (8 * q);
      pb0 |= (L1[q] & 127) << (8 * q); pb1 |= (L1[4 + q] & 127) << (8 * q); pb2 |= (L1[8 + q] & 127) << (8 * q); pb3 |= (L1[12 + q] & 127) << (8 * q);
    }
    float ev[16], sum = 0.f; int ei[16];
    const float mx = key2f(R[0] & ~255);
#pragma unroll
    for (int z = 0; z < 16; ++z) {
      const float v = key2f(R[z] & ~255);
      ev[z] = __expf(v - mx); sum += ev[z];
      const int pay = R[z] & 255;
      ei[z] = lut4(pa0, pa1, pa2, pa3, pay >> 4) * 128 + lut4(pb0, pb1, pb2, pb3, pay & 15);
    }
    const float inv = 1.0f / sum;
    if (hh == 0) {
      float* go = p.gates() + ((size_t)t * 8 + h) * 16; int* eo = p.eidx() + ((size_t)t * 8 + h) * 16;
#pragma unroll
      for (int z = 0; z < 16; z += 4) {
        *(float4*)(go + z) = make_float4(ev[z] * inv, ev[z + 1] * inv, ev[z + 2] * inv, ev[z + 3] * inv);
        *(int4*)(eo + z) = make_int4(ei[z], ei[z + 1], ei[z + 2], ei[z + 3]);
      }
    }
  }
}

__device__ __forceinline__ void phase_peer_apply2(const Params& p, int l, float* coef, int gw, int ngw, int lane) {
  const float* g2 = p.in[16] + l * D;
  for (int t = gw; t < T; t += ngw) {
    const float r = p.rstd()[t];
    float hv[16];
#pragma unroll
    for (int i = 0; i < 2; ++i) {
      const float* xp = p.out + (size_t)t * D + i * 512 + lane * 8; const float* gp = g2 + i * 512 + lane * 8;
      float4 x0 = *(const float4*)xp, x1 = *(const float4*)(xp + 4), g0 = *(const float4*)gp, g1 = *(const float4*)(gp + 4);
      hv[i * 8 + 0] = x0.x * r * g0.x; hv[i * 8 + 1] = x0.y * r * g0.y; hv[i * 8 + 2] = x0.z * r * g0.z; hv[i * 8 + 3] = x0.w * r * g0.w;
      hv[i * 8 + 4] = x1.x * r * g1.x; hv[i * 8 + 5] = x1.y * r * g1.y; hv[i * 8 + 6] = x1.z * r * g1.z; hv[i * 8 + 7] = x1.w * r * g1.w;
    }
    const int e_lo = p.eidx()[(size_t)t * 128 + lane], e_hi = p.eidx()[(size_t)t * 128 + 64 + lane];
    const float g_lo = p.gates()[(size_t)t * 128 + lane], g_hi = p.gates()[(size_t)t * 128 + 64 + lane];
    LDS_FENCE();
#pragma unroll 1
    for (int half = 0; half < 2; ++half) {
      const int ev = half ? e_hi : e_lo;
      float mine = 0.f;
#pragma unroll 4
      for (int j = 0; j < 64; ++j) {
        const int e = __shfl(ev, j);
        const bf16_t* up = p.Ub() + (size_t)e * D + lane * 8;
        uint4 u0 = *(const uint4*)up, u1 = *(const uint4*)(up + 512);
        float d = 0.f;
        d = fmaf(hv[0], __uint_as_float(u0.x << 16), d); d = fmaf(hv[1], __uint_as_float(u0.x & 0xffff0000u), d);
        d = fmaf(hv[2], __uint_as_float(u0.y << 16), d); d = fmaf(hv[3], __uint_as_float(u0.y & 0xffff0000u), d);
        d = fmaf(hv[4], __uint_as_float(u0.z << 16), d); d = fmaf(hv[5], __uint_as_float(u0.z & 0xffff0000u), d);
        d = fmaf(hv[6], __uint_as_float(u0.w << 16), d); d = fmaf(hv[7], __uint_as_float(u0.w & 0xffff0000u), d);
        d = fmaf(hv[8], __uint_as_float(u1.x << 16), d); d = fmaf(hv[9], __uint_as_float(u1.x & 0xffff0000u), d);
        d = fmaf(hv[10], __uint_as_float(u1.y << 16), d); d = fmaf(hv[11], __uint_as_float(u1.y & 0xffff0000u), d);
        d = fmaf(hv[12], __uint_as_float(u1.z << 16), d); d = fmaf(hv[13], __uint_as_float(u1.z & 0xffff0000u), d);
        d = fmaf(hv[14], __uint_as_float(u1.w << 16), d); d = fmaf(hv[15], __uint_as_float(u1.w & 0xffff0000u), d);
        d = wave_sum(d);
        if (lane == j) mine = d;
      }
      coef[half * 64 + lane] = (half ? g_hi : g_lo) * gelu_tanh(mine);
    }
    LDS_FENCE();
    float acc[16];
#pragma unroll
    for (int i = 0; i < 16; ++i) acc[i] = 0.f;
#pragma unroll 1
    for (int half = 0; half < 2; ++half) {
      const int ev = half ? e_hi : e_lo;
#pragma unroll 4
      for (int j = 0; j < 64; ++j) {
        const int e = __shfl(ev, j);
        const float c = coef[half * 64 + j];
        const bf16_t* vp = p.Vb() + (size_t)e * D + lane * 8;
        uint4 v0 = *(const uint4*)vp, v1 = *(const uint4*)(vp + 512);
        acc[0] = fmaf(c, __uint_as_float(v0.x << 16), acc[0]); acc[1] = fmaf(c, __uint_as_float(v0.x & 0xffff0000u), acc[1]);
        acc[2] = fmaf(c, __uint_as_float(v0.y << 16), acc[2]); acc[3] = fmaf(c, __uint_as_float(v0.y & 0xffff0000u), acc[3]);
        acc[4] = fmaf(c, __uint_as_float(v0.z << 16), acc[4]); acc[5] = fmaf(c, __uint_as_float(v0.z & 0xffff0000u), acc[5]);
        acc[6] = fmaf(c, __uint_as_float(v0.w << 16), acc[6]); acc[7] = fmaf(c, __uint_as_float(v0.w & 0xffff0000u), acc[7]);
        acc[8] = fmaf(c, __uint_as_float(v1.x << 16), acc[8]); acc[9] = fmaf(c, __uint_as_float(v1.x & 0xffff0000u), acc[9]);
        acc[10] = fmaf(c, __uint_as_float(v1.y << 16), acc[10]); acc[11] = fmaf(c, __uint_as_float(v1.y & 0xffff0000u), acc[11]);
        acc[12] = fmaf(c, __uint_as_float(v1.z << 16), acc[12]); acc[13] = fmaf(c, __uint_as_float(v1.z & 0xffff0000u), acc[13]);
        acc[14] = fmaf(c, __uint_as_float(v1.w << 16), acc[14]); acc[15] = fmaf(c, __uint_as_float(v1.w & 0xffff0000u), acc[15]);
      }
    }
#pragma unroll
    for (int i = 0; i < 2; ++i) {
      float* xp = p.out + (size_t)t * D + i * 512 + lane * 8;
      float4 x0 = *(float4*)xp, x1 = *(float4*)(xp + 4);
      x0.x += acc[i * 8 + 0]; x0.y += acc[i * 8 + 1]; x0.z += acc[i * 8 + 2]; x0.w += acc[i * 8 + 3];
      x1.x += acc[i * 8 + 4]; x1.y += acc[i * 8 + 5]; x1.z += acc[i * 8 + 6]; x1.w += acc[i * 8 + 7];
      *(float4*)xp = x0; *(float4*)(xp + 4) = x1;
    }
  }
}

typedef int v8i __attribute__((ext_vector_type(8)));
__device__ __forceinline__ unsigned xcc_id() { return (unsigned)__builtin_amdgcn_s_getreg((3 << 11) | 20) & 7u; }
__device__ __forceinline__ float pow2_scale(float amax) {
  if (!(amax > 0.f)) return 1.0f;
  const int e = (int)floorf(log2f(240.0f / amax));
  return exp2f((float)(e < 60 ? (e > -60 ? e : -60) : 60));
}
__device__ __forceinline__ unsigned pack4_fp8(float a, float b, float c, float d) {
  int v = __builtin_amdgcn_cvt_pk_fp8_f32(a, b, 0, false);
  v = __builtin_amdgcn_cvt_pk_fp8_f32(c, d, v, true);
  return (unsigned)v;
}
__device__ __forceinline__ void cvt_table_fp8(const float* __restrict__ src, unsigned char* __restrict__ dst, float* __restrict__ scl, int gw, int ngw, int lane) {
  for (int e = gw; e < 16384; e += ngw) {
    float4 v[4]; float am = 0.f;
#pragma unroll
    for (int k = 0; k < 4; ++k) { v[k] = *(const float4*)(src + (size_t)e * D + k * 256 + lane * 4);
      am = fmaxf(am, fmaxf(fmaxf(fabsf(v[k].x), fabsf(v[k].y)), fmaxf(fabsf(v[k].z), fabsf(v[k].w)))); }
    am = wave_max(am);
    const float s = pow2_scale(am);
    if (lane == 0) scl[e] = s;
#pragma unroll
    for (int k = 0; k < 4; ++k) {
      const int slice = 2 * k + (lane >> 5), off = (lane & 31) * 4;
      *(unsigned*)(dst + ((size_t)slice * 16384 + e) * 128 + off) = pack4_fp8(v[k].x * s, v[k].y * s, v[k].z * s, v[k].w * s);
    }
  }
}
__device__ __forceinline__ void phase_cvt_rows_h8(const Params& p, int l, int gw, int ngw, int lane) {
  const float* g2 = p.in[16] + l * D;
  for (int t = gw; t < T; t += ngw) {
    float4 v[4]; float ss = 0.f;
#pragma unroll
    for (int k = 0; k < 4; ++k) {
      v[k] = *(const float4*)(p.out + (size_t)t * D + k * 256 + lane * 4);
      ss += v[k].x * v[k].x + v[k].y * v[k].y + v[k].z * v[k].z + v[k].w * v[k].w;
      uint2 ph; ph.x = pk_bf16(v[k].x, v[k].y); ph.y = pk_bf16(v[k].z, v[k].w);
      bf16_t* d = p.xb() + (size_t)t * KD + k * 256 + lane * 4;
      *(uint2*)d = ph;
      if (PRECISE) {
        uint2 pl; pl.x = pk_bf16(v[k].x - __uint_as_float(ph.x << 16), v[k].y - __uint_as_float(ph.x & 0xffff0000u));
        pl.y = pk_bf16(v[k].z - __uint_as_float(ph.y << 16), v[k].w - __uint_as_float(ph.y & 0xffff0000u));
        *(uint2*)(d + D) = ph; *(uint2*)(d + 2 * D) = pl;
      }
    }
    ss = wave_sum(ss);
    const float r = rsqrtf(ss / (float)D + EPS);
    if (lane == 0) p.rstd()[t] = r;
#pragma unroll
    for (int k = 0; k < 4; ++k) {
      const float4 g = *(const float4*)(g2 + k * 256 + lane * 4);
      const int slice = 2 * k + (lane >> 5), off = (lane & 31) * 4;
      uint2 o; o.x = pk_bf16(v[k].x * r * g.x, v[k].y * r * g.y); o.y = pk_bf16(v[k].z * r * g.z, v[k].w * r * g.w);
      *(uint2*)(p.hb() + ((size_t)slice * T + t) * 128 + off) = o;
    }
  }
}
#define DPP_ADD(v_, ctrl_) ((v_) + __builtin_bit_cast(float, __builtin_amdgcn_update_dpp(0, __builtin_bit_cast(int, (v_)), (ctrl_), 0xF, 0xF, true)))
__device__ __forceinline__ float sum_xor16(float x) { float a = x, b = x; asm volatile("v_nop\n\tv_nop\n\tv_permlane16_swap_b32 %0, %1" : "+v"(a), "+v"(b)); return a + b; }
__device__ __forceinline__ float sum_xor32(float x) { float a = x, b = x; asm volatile("v_nop\n\tv_nop\n\tv_permlane32_swap_b32 %0, %1" : "+v"(a), "+v"(b)); return a + b; }
__device__ __forceinline__ int q_pull(int* head, int nitems, int* bc, int tid) {
  __syncthreads();
  if (tid == 0) bc[0] = atomicAdd(head, 1);
  __syncthreads();
  const int v = bc[0];
  return v < nitems ? v : -1;
}
constexpr int PEER_TILE = 128;
__device__ __forceinline__ void phase_peer_u(const Params& p, int* heads, unsigned char* lds, int tid) {
  const int lane = tid & 63, wv = tid >> 6, r8 = lane >> 3, c8 = lane & 7;
  int* bc = (int*)lds;
  int* eW = (int*)(lds + 1024 + wv * 8192);
  const int myx = (int)xcc_id();
  for (int pass = 0; pass < 8; ++pass) {
    const int s = (myx + pass) & 7;
    const unsigned char* Us = p.U8s() + (size_t)s * 16384 * 128 + c8 * 16;
    for (;;) {
      const int item = q_pull(heads + s, T / PEER_TILE, bc, tid);
      if (item < 0) break;
      const int t0 = item * PEER_TILE + wv * 16;
      LDS_FENCE();
#pragma unroll
      for (int k = 0; k < 16; ++k) *(uint2*)(eW + k * 128 + lane * 2) = *(const uint2*)(p.eidx() + (size_t)(t0 + k) * 128 + lane * 2);
      LDS_FENCE();
      uint4 R[4][8];
#define PEER_U_LOAD(M_, BUF_) { _Pragma("unroll") for (int eb = 0; eb < 8; ++eb) R[BUF_][eb] = *(const uint4*)(Us + (size_t)eW[(M_) * 64 + eb * 8 + r8] * 128); }
      PEER_U_LOAD(0, 0) PEER_U_LOAD(1, 1) PEER_U_LOAD(2, 2)
      float hv[16]; float res0 = 0.f, res1 = 0.f;
#define PEER_U_LOADH(TOK_) { const bf16_t* hp = p.hb() + ((size_t)s * T + t0 + (TOK_)) * 128 + c8 * 16; const uint4 a = *(const uint4*)hp, b4 = *(const uint4*)(hp + 8); \
        const unsigned w8[8] = {a.x, a.y, a.z, a.w, b4.x, b4.y, b4.z, b4.w};                                                              \
        _Pragma("unroll") for (int z = 0; z < 8; ++z) { hv[2 * z] = __uint_as_float(w8[z] << 16); hv[2 * z + 1] = __uint_as_float(w8[z] & 0xffff0000u); } }
      PEER_U_LOADH(0)
#define PEER_U_HALF(M_, BUF_, HALF_)                                                                           \
      {                                                                                                                                   \
        if ((M_) + 3 < 32) PEER_U_LOAD((M_) + 3, ((BUF_) + 3) & 3)                                                                        \
        _Pragma("unroll") for (int eb = 0; eb < 8; ++eb) {                                                                                \
          const unsigned ww[4] = {R[BUF_][eb].x, R[BUF_][eb].y, R[BUF_][eb].z, R[BUF_][eb].w};                                            \
          float d = 0.f;                                                                                                                  \
          _Pragma("unroll") for (int q4 = 0; q4 < 4; ++q4) {                                                                              \
            const auto f01 = __builtin_amdgcn_cvt_pk_f32_fp8((int)ww[q4], false); const auto f23 = __builtin_amdgcn_cvt_pk_f32_fp8((int)ww[q4], true); \
            d = fmaf(hv[q4 * 4 + 0], f01[0], d); d = fmaf(hv[q4 * 4 + 1], f01[1], d); d = fmaf(hv[q4 * 4 + 2], f23[0], d); d = fmaf(hv[q4 * 4 + 3], f23[1], d); \
          }                                                                                                                               \
          d = DPP_ADD(d, 0xB1); d = DPP_ADD(d, 0x4E); d = DPP_ADD(d, 0x141);     \
          if ((HALF_) == 0) { if (c8 == eb) res0 = d; } else { if (c8 == eb) res1 = d; }                                                  \
        }                                                                                                                                 \
        if ((HALF_) == 1) {                                                                                                               \
          float* po = p.ppart() + ((size_t)s * T + t0 + ((M_) >> 1)) * 128;                                                               \
          po[c8 * 8 + r8] = res0; po[64 + c8 * 8 + r8] = res1;                                                                            \
          if ((M_) + 1 < 32) PEER_U_LOADH(((M_) >> 1) + 1)                                                                                \
        }                                                                                                                                 \
      }
#pragma unroll 1
      for (int m4 = 0; m4 < 32; m4 += 4) {
        PEER_U_HALF(m4, 0, 0) PEER_U_HALF(m4 + 1, 1, 1) PEER_U_HALF(m4 + 2, 2, 0) PEER_U_HALF(m4 + 3, 3, 1)
      }
#undef PEER_U_HALF
#undef PEER_U_LOADH
#undef PEER_U_LOAD
    }
  }
}
__device__ __forceinline__ void phase_peer_r(const Params& p, int gtid, int ngt) {
  for (int idx0 = gtid; idx0 < T * 128; idx0 += 4 * ngt) {
    float d[4]; int e[4]; float su_[4], sv_[4], g_[4]; bool ok[4];
#pragma unroll
    for (int u = 0; u < 4; ++u) { const int idx = idx0 + u * ngt; ok[u] = idx < T * 128; const int ix = ok[u] ? idx : 0;
      e[u] = p.eidx()[ix]; g_[u] = p.gates()[ix]; float a = 0.f;
#pragma unroll
      for (int s = 0; s < 8; ++s) a += p.ppart()[(size_t)s * T * 128 + ix];
      d[u] = a; }
#pragma unroll
    for (int u = 0; u < 4; ++u) { su_[u] = p.su()[e[u]]; sv_[u] = p.sv()[e[u]]; }
#pragma unroll
    for (int u = 0; u < 4; ++u) if (ok[u]) p.gates()[idx0 + u * ngt] = g_[u] * gelu_tanh(d[u] / su_[u]) / sv_[u];
  }
}
__device__ __forceinline__ void phase_peer_v(const Params& p, int* heads, unsigned char* lds, int tid) {
  const int lane = tid & 63, wv = tid >> 6, r8 = lane >> 3, c8 = lane & 7;
  int* bc = (int*)lds;
  uint2* pW = (uint2*)(lds + 1024 + wv * 16384);
  const int myx = (int)xcc_id();
  for (int pass = 0; pass < 8; ++pass) {
    const int s = (myx + pass) & 7;
    const unsigned char* Vs = p.V8s() + (size_t)s * 16384 * 128 + c8 * 16;
    for (;;) {
      const int item = q_pull(heads + s, T / PEER_TILE, bc, tid);
      if (item < 0) break;
      const int t0 = item * PEER_TILE + wv * 16;
      LDS_FENCE();
#pragma unroll
      for (int k = 0; k < 16; ++k) {
        const uint2 e2 = *(const uint2*)(p.eidx() + (size_t)(t0 + k) * 128 + lane * 2);
        const uint2 g2 = *(const uint2*)(p.gates() + (size_t)(t0 + k) * 128 + lane * 2);
        *(uint4*)(pW + k * 128 + lane * 2) = make_uint4(e2.x, g2.x, e2.y, g2.y);
      }
      LDS_FENCE();
      uint4 R[4][8];
#define PEER_V_LOAD(M_, BUF_) { _Pragma("unroll") for (int eb = 0; eb < 8; ++eb) R[BUF_][eb] = *(const uint4*)(Vs + (size_t)pW[(M_) * 64 + eb * 8 + r8].x * 128); }
      PEER_V_LOAD(0, 0) PEER_V_LOAD(1, 1) PEER_V_LOAD(2, 2)
      float acc[16];
      const int xoff = s * 128 + c8 * 16 + (r8 & 3) * 4;
      float4 xo = *(const float4*)(p.out + (size_t)t0 * D + xoff);
#define PEER_V_HALF(M_, BUF_, HALF_)                                                                           \
      {                                                                                                                                   \
        if ((M_) + 3 < 32) PEER_V_LOAD((M_) + 3, ((BUF_) + 3) & 3)                                                                        \
        if ((HALF_) == 0) { _Pragma("unroll") for (int z = 0; z < 16; ++z) acc[z] = 0.f; }                                                \
        _Pragma("unroll") for (int eb = 0; eb < 8; ++eb) {                                                                                \
          const float c = __uint_as_float(pW[(M_) * 64 + eb * 8 + r8].y);                                                                 \
          const unsigned ww[4] = {R[BUF_][eb].x, R[BUF_][eb].y, R[BUF_][eb].z, R[BUF_][eb].w};                                            \
          _Pragma("unroll") for (int q4 = 0; q4 < 4; ++q4) {                                                                              \
            const auto f01 = __builtin_amdgcn_cvt_pk_f32_fp8((int)ww[q4], false); const auto f23 = __builtin_amdgcn_cvt_pk_f32_fp8((int)ww[q4], true); \
            acc[q4 * 4 + 0] = fmaf(c, f01[0], acc[q4 * 4 + 0]); acc[q4 * 4 + 1] = fmaf(c, f01[1], acc[q4 * 4 + 1]);                       \
            acc[q4 * 4 + 2] = fmaf(c, f23[0], acc[q4 * 4 + 2]); acc[q4 * 4 + 3] = fmaf(c, f23[1], acc[q4 * 4 + 3]);                       \
          }                                                                                                                               \
        }                                                                                                                                 \
        if ((HALF_) == 1) {                                                                                                               \
          _Pragma("unroll") for (int z = 0; z < 16; ++z) { acc[z] = DPP_ADD(acc[z], 0x128); acc[z] = sum_xor16(acc[z]); acc[z] = sum_xor32(acc[z]); }     \
          const int sel = r8 & 3;                                                                                                         \
          float4 dl;                                                                                                                      \
          dl.x = sel == 0 ? acc[0] : sel == 1 ? acc[4] : sel == 2 ? acc[8] : acc[12];                                                     \
          dl.y = sel == 0 ? acc[1] : sel == 1 ? acc[5] : sel == 2 ? acc[9] : acc[13];                                                     \
          dl.z = sel == 0 ? acc[2] : sel == 1 ? acc[6] : sel == 2 ? acc[10] : acc[14];                                                    \
          dl.w = sel == 0 ? acc[3] : sel == 1 ? acc[7] : sel == 2 ? acc[11] : acc[15];                                                    \
          float* xp = p.out + (size_t)(t0 + ((M_) >> 1)) * D + xoff;                                                                      \
          if (r8 < 4) *(float4*)xp = make_float4(xo.x + dl.x, xo.y + dl.y, xo.z + dl.z, xo.w + dl.w);                                     \
          if ((M_) + 1 < 32) xo = *(const float4*)(xp + D);                                                                               \
        }                                                                                                                                 \
      }
#pragma unroll 1
      for (int m4 = 0; m4 < 32; m4 += 4) {
        PEER_V_HALF(m4, 0, 0) PEER_V_HALF(m4 + 1, 1, 1) PEER_V_HALF(m4 + 2, 2, 0) PEER_V_HALF(m4 + 3, 3, 1)
      }
#undef PEER_V_HALF
#undef PEER_V_LOAD
    }
  }
}

#if PEER_CHECK
constexpr int CHK_N = 512;
__device__ __forceinline__ float* chk_x(const Params& p) { return (float*)(p.ws + WO_ybuf); }
__device__ __forceinline__ float* chk_m(const Params& p) { return (float*)(p.ws + WO_ybuf + (size_t)CHK_N * D * 4); }
__device__ __forceinline__ float* chk_g(const Params& p) { return (float*)(p.ws + WO_ybuf + (size_t)CHK_N * D * 4 + 4096); }
__device__ __forceinline__ void chk_save(const Params& p, int gtid, int ngt) {
  for (int i = gtid; i < CHK_N * D; i += ngt) chk_x(p)[i] = p.out[(size_t)(i / D) * 64 * D + (i % D)];
  for (int i = gtid; i < CHK_N * 128; i += ngt) chk_g(p)[i] = p.gates()[(size_t)(i / 128) * 64 * 128 + (i % 128)];
  if (gtid < 16) chk_m(p)[gtid] = 0.f;
}
__device__ __forceinline__ void chk_apply(const Params& p, int l, float* coef, int gw, int ngw, int lane) {
  const float* g2 = p.in[16] + l * D;
  const float* U = p.in[19] + (size_t)l * 16384 * D; const float* V = p.in[20] + (size_t)l * 16384 * D;
  for (int i = gw; i < CHK_N; i += ngw) {
    const int t = i * 64;
    const float r = p.rstd()[t];
    float4 hv[4];
#pragma unroll
    for (int k = 0; k < 4; ++k) {
      float4 xv = *(const float4*)(chk_x(p) + (size_t)i * D + (lane + k * 64) * 4);
      float4 gv = *(const float4*)(g2 + (lane + k * 64) * 4);
      hv[k].x = xv.x * r * gv.x; hv[k].y = xv.y * r * gv.y; hv[k].z = xv.z * r * gv.z; hv[k].w = xv.w * r * gv.w;
    }
    LDS_FENCE();
    for (int j = 0; j < 128; ++j) {
      const int e = p.eidx()[(size_t)t * 128 + j];
      const float4* up = (const float4*)(U + (size_t)e * D);
      float dsum = 0.f;
#pragma unroll
      for (int k = 0; k < 4; ++k) { float4 uv = up[lane + k * 64]; dsum += hv[k].x * uv.x + hv[k].y * uv.y + hv[k].z * uv.z + hv[k].w * uv.w; }
      dsum = wave_sum(dsum);
      if (lane == 0) coef[j] = chk_g(p)[(size_t)i * 128 + j] * gelu_tanh(dsum);
    }
    LDS_FENCE();
    float4 acc[4];
#pragma unroll
    for (int k = 0; k < 4; ++k) acc[k] = make_float4(0.f, 0.f, 0.f, 0.f);
    for (int j = 0; j < 128; ++j) {
      const int e = p.eidx()[(size_t)t * 128 + j];
      const float c = coef[j];
      const float4* vp = (const float4*)(V + (size_t)e * D);
#pragma unroll
      for (int k = 0; k < 4; ++k) { float4 vv = vp[lane + k * 64]; acc[k].x = fmaf(c, vv.x, acc[k].x); acc[k].y = fmaf(c, vv.y, acc[k].y); acc[k].z = fmaf(c, vv.z, acc[k].z); acc[k].w = fmaf(c, vv.w, acc[k].w); }
    }
    float d2 = 0.f, r2 = 0.f;
#pragma unroll
    for (int k = 0; k < 4; ++k) {
      float4 xa = *(const float4*)(p.out + (size_t)t * D + (lane + k * 64) * 4);
      float4 xb4 = *(const float4*)(chk_x(p) + (size_t)i * D + (lane + k * 64) * 4);
      float e0 = (xa.x - xb4.x) - acc[k].x, e1 = (xa.y - xb4.y) - acc[k].y, e2 = (xa.z - xb4.z) - acc[k].z, e3 = (xa.w - xb4.w) - acc[k].w;
      d2 += e0 * e0 + e1 * e1 + e2 * e2 + e3 * e3;
      r2 += acc[k].x * acc[k].x + acc[k].y * acc[k].y + acc[k].z * acc[k].z + acc[k].w * acc[k].w;
    }
    d2 = wave_sum(d2); r2 = wave_sum(r2);
    if (lane == 0) { atomicAdd((unsigned long long*)&chk_m(p)[8], (unsigned long long)(d2 * 1099511627776.0f)); atomicAdd((unsigned long long*)&chk_m(p)[10], (unsigned long long)(r2 * 1099511627776.0f)); }
  }
}
__device__ __forceinline__ void chk_topk(const Params& p, int l, int gtid, int ngt) {
  const float* subk = p.in[18] + (size_t)l * 16 * 128 * 64;
  for (int it = gtid; it < CHK_N * 8; it += ngt) {
    const int i = it >> 3, h = it & 7, t = i * 64;
    float tva[16], tvb[16]; int tia[16], tib[16];
#pragma unroll 1
    for (int c = 0; c < 2; ++c) {
      float tv[16]; int ti[16];
#pragma unroll
      for (int z = 0; z < 16; ++z) { tv[z] = -INFINITY; ti[z] = 0; }
      const bf16_t* q = p.qb() + (size_t)t * D + (2 * h + c) * 64;
      const float* kb = subk + (size_t)(2 * h + c) * 128 * 64;
#pragma unroll 1
      for (int n = 0; n < 128; ++n) {
        float sc = 0.f;
        for (int d = 0; d < 64; ++d) sc = fmaf(bf2f(q[d]), kb[n * 64 + d], sc);
        float v_ = sc; int i_ = n;
#pragma unroll
        for (int z = 0; z < 16; ++z) { bool gt = v_ > tv[z]; float a = tv[z]; int b = ti[z]; tv[z] = gt ? v_ : a; ti[z] = gt ? i_ : b; v_ = gt ? a : v_; i_ = gt ? b : i_; }
      }
#pragma unroll
      for (int z = 0; z < 16; ++z) { if (c == 0) { tva[z] = tv[z]; tia[z] = ti[z]; } else { tvb[z] = tv[z]; tib[z] = ti[z]; } }
    }
    float tv[16]; int ti[16];
#pragma unroll
    for (int z = 0; z < 16; ++z) { tv[z] = -INFINITY; ti[z] = 0; }
#pragma unroll 1
    for (int a = 0; a < 16; ++a)
#pragma unroll 1
      for (int b = 0; b < 16; ++b) {
        float av = 0.f, bv = 0.f; int ai = 0, bi = 0;
#pragma unroll
        for (int z = 0; z < 16; ++z) { if (z == a) { av = tva[z]; ai = tia[z]; } if (z == b) { bv = tvb[z]; bi = tib[z]; } }
        float v_ = av + bv; int i_ = ai * 128 + bi;
#pragma unroll
        for (int z = 0; z < 16; ++z) { bool gt = v_ > tv[z]; float x = tv[z]; int y = ti[z]; tv[z] = gt ? v_ : x; ti[z] = gt ? i_ : y; v_ = gt ? x : v_; i_ = gt ? y : i_; }
      }
    float sum = 0.f, ev[16];
#pragma unroll
    for (int z = 0; z < 16; ++z) { ev[z] = expf(tv[z] - tv[0]); sum += ev[z]; }
    int miss = 0; float gerr = 0.f;
    for (int z = 0; z < 16; ++z) {
      const int ef = p.eidx()[((size_t)t * 8 + h) * 16 + z]; const float gf = p.gates()[((size_t)t * 8 + h) * 16 + z];
      bool found = false;
#pragma unroll
      for (int y = 0; y < 16; ++y) if (ti[y] == ef) { found = true; gerr = fmaxf(gerr, fabsf(ev[y] / sum - gf)); }
      if (!found) ++miss;
    }
    atomicAdd(&chk_m(p)[3], (float)miss);
    atomicMax((int*)&chk_m(p)[4], __float_as_int(gerr));
  }
}
__device__ __forceinline__ void chk_emit(const Params& p) {
  float v = 0.f;
  if (PEER_CHECK == 1) v = sqrtf((float)((double)*(unsigned long long*)&chk_m(p)[8] / (double)*(unsigned long long*)&chk_m(p)[10]));
  if (PEER_CHECK == 2) v = chk_m(p)[3] / (float)(CHK_N * 8 * 16);
  if (PEER_CHECK == 3) v = chk_m(p)[4];
  p.out[0] += 1.0e4f * v + 100.0f;
}
#endif

#define XB_TMO      128
#define XB_XCNT(j)  (256  + 64 * (j))
#define XB_XSUB(j)  (1280 + 64 * (j))
#define XB_XGEN(j)  (2304 + 64 * (j))
#define XB_TOP      3328
#define XB_TOPGEN   3392
#define XCD_BAR_WORDS 3456
#define XB_SPIN_CAP (1u << 18)
#define LAS __attribute__((address_space(3)))

__device__ __forceinline__ unsigned xb_ld(unsigned* p)              { return __hip_atomic_load(p, __ATOMIC_RELAXED, __HIP_MEMORY_SCOPE_AGENT); }
__device__ __forceinline__ unsigned xb_add(unsigned* p, unsigned v) { return __hip_atomic_fetch_add(p, v, __ATOMIC_RELAXED, __HIP_MEMORY_SCOPE_AGENT); }
__device__ __forceinline__ unsigned xb_xcc_id() { return (unsigned)__builtin_amdgcn_s_getreg((3 << 11) | 20) & 0xFu; }
#define XB_SPIN(cond, bar) do { unsigned _sp = 0; while (cond) { __builtin_amdgcn_s_sleep(1); \
    if ((++_sp & 255u) == 0u) { if (xb_ld(&(bar)[XB_TMO])) break; if (_sp > XB_SPIN_CAP) { atomicAdd(&(bar)[XB_TMO], 1u); break; } } } } while (0)

struct XcdBarrier {
    unsigned* bar; unsigned x;
    volatile LAS unsigned* st;
};

__device__ __forceinline__ XcdBarrier xcd_barrier_post(unsigned* bar, volatile LAS unsigned* st) {
    XcdBarrier b; b.bar = bar; b.x = xb_xcc_id(); b.st = st;
    if (threadIdx.x == 0) (void)xb_add(&bar[XB_XCNT(b.x)], 1u);
    return b;
}
__device__ __forceinline__ void xcd_barrier_complete(unsigned* bar, unsigned x, unsigned& nloc, unsigned& nx) {
    const unsigned G = gridDim.x * gridDim.y * gridDim.z;
    unsigned sum, cnt, mine, sp = 0u;
    for (;;) {
        sum = 0u; cnt = 0u; mine = 0u;
#pragma unroll
        for (unsigned j = 0; j < 16; ++j) { const unsigned c = xb_ld(&bar[XB_XCNT(j)]); sum += c; cnt += (c > 0u) ? 1u : 0u; mine = (j == x) ? c : mine; }
        if (sum == G) break;
        __builtin_amdgcn_s_sleep(1);
        if ((++sp & 255u) == 0u) { if (xb_ld(&bar[XB_TMO])) break; if (sp > XB_SPIN_CAP) { atomicAdd(&bar[XB_TMO], 1u); break; } }
    }
    nloc = mine > 0u ? mine : 1u; nx = cnt > 0u ? cnt : 1u;
}

__device__ __forceinline__ void xcd_barrier(const XcdBarrier& b) {
    asm volatile("s_waitcnt vmcnt(0)" ::: "memory");
    __syncthreads();
    if (threadIdx.x == 0) {
        unsigned* bar = b.bar;
        __builtin_amdgcn_s_waitcnt(0);
        unsigned nloc = b.st[0], nx = b.st[1];
        if (nloc == 0u) { xcd_barrier_complete(bar, b.x, nloc, nx); b.st[0] = nloc; b.st[1] = nx; }
        const unsigned old = xb_add(&bar[XB_XSUB(b.x)], 1u);
        const unsigned gen = old / nloc;
        if (old + 1u == (gen + 1u) * nloc) {
            __builtin_amdgcn_fence(__ATOMIC_RELEASE, "agent");
            asm volatile("s_waitcnt vmcnt(0)" ::: "memory");
            const unsigned og = xb_add(&bar[XB_TOP], 1u);
            const unsigned tg = og / nx;
            if (og + 1u == (tg + 1u) * nx) xb_add(&bar[XB_TOPGEN], 1u);
            else XB_SPIN(xb_ld(&bar[XB_TOPGEN]) == tg, bar);
            __builtin_amdgcn_fence(__ATOMIC_ACQUIRE, "agent");
            xb_add(&bar[XB_XGEN(b.x)], 1u);
            asm volatile("s_waitcnt vmcnt(0)" ::: "memory");
        } else {
            XB_SPIN(xb_ld(&bar[XB_XGEN(b.x)]) == gen, bar);
            __builtin_amdgcn_fence(__ATOMIC_ACQUIRE, "agent");
            asm volatile("s_waitcnt vmcnt(0)" ::: "memory");
        }
    }
    __syncthreads();
}

__device__ __forceinline__ Params fresh(const Params& p) {
  Params q = p;
  asm volatile("" : "+s"(q.ws), "+s"(q.out));
#pragma unroll
  for (int i = 0; i < 21; ++i) asm volatile("" : "+s"(q.in[i]));
  return q;
}
#define PHASE_IDS int tid = threadIdx.x; asm volatile("" : "+v"(tid)); int bid = blockIdx.x; asm volatile("" : "+s"(bid)); int G = gridDim.x; asm volatile("" : "+s"(G)); \
  const int lane = tid & 63, wv = tid >> 6; const int ngt = G * NTHR, ngw = G * NWAVE; \
  const int gtid = bid * NTHR + tid, gw = bid * NWAVE + wv; (void)lane; (void)wv; (void)gtid; (void)gw; (void)ngt; (void)ngw; \
  const Params q = fresh(p);
__global__ void __launch_bounds__(NTHR) mega(Params p) {
  extern __shared__ __attribute__((aligned(16))) unsigned char lds_raw[];
  cg::grid_group grid = cg::this_grid();
  float* ldsf = (float*)lds_raw;
  if (threadIdx.x == 0) { *(uint4*)(lds_raw + LDS_BYTES - 16) = make_uint4(0u, 0u, 0u, 0u); }
  __syncthreads();
  XcdBarrier xb = xcd_barrier_post(p.bar(), (volatile LAS unsigned*)(lds_raw + LDS_BYTES - 16));

  { PHASE_IDS; phase_prologue(q, gtid, ngt, gw, ngw, lane); cvt_f32_bf16(q.in[18], q.skb(), (size_t)NL * 16 * 128 * 64 / 8, gtid, ngt);
    for (size_t i = gtid; i < (size_t)16 * 256 * 512 / 8; i += ngt) ((uint4*)q.S5Wz())[i] = make_uint4(0u, 0u, 0u, 0u);
    if (gtid < 256) q.qctr()[gtid] = 0; }
  grid.sync();
  { constexpr int l = 0;
    DUP(6) {
    { PHASE_IDS; phase_cvt_rows(q.out, q.xb(), q.rstd(), gw, ngw, lane);
      phase_s5_prep(q, l, gtid, ngt);
 }
    xcd_barrier(xb);
    }
    DUP(5) {
    { const Params q = fresh(p); EpiScaleStore e{q.proj(), INW, q.rstd()};
      run_gemm(lds_raw, q.xb(), q.Win_t() + (size_t)l * INW * KD, T, INW, KD, e); }
    xcd_barrier(xb);
    }
    DUP(0) {
    { PHASE_IDS; phase_post_pack(q, l, gtid, ngt, gw, ngw, lane); phase_pack_u(q, gtid, ngt); }
    xcd_barrier(xb);
    }
    DUP(1) {
    { const Params q = fresh(p); EpiS5Z e{q.S5Z()};
      pg8::Gemm g{q.S5A(), q.S5Wz(), 16 * 1024, 16 * 256, 512, 640, 512}; pg8::GroupOrder So; So.init(16, 4, 1, (int)gridDim.x, (int)blockIdx.x);
      pg8::gemm_phase<EpiS5Z, pg8::GroupOrder, true, true>((PG8_LAS unsigned char*)lds_raw, g, So, e); }
    { PHASE_IDS; phase_kmean2(q, gtid, ngt); phase_ret_kv(q, gw, ngw, lane); }
    xcd_barrier(xb);
    }
    DUP(2) {
    { PHASE_IDS; phase_s5_scan(q, gtid, ngt); phase_ret_scan(q, gtid, ngt); }
    __syncthreads();
    { PHASE_IDS; phase_moba2(q, l, lds_raw, bid, G); }
    xcd_barrier(xb);
    }
    DUP(3) {
    { const Params q = fresh(p); EpiS5Y e{q.ygb(), q.S5A(), q.in[10] + l * 256};
      pg8::Gemm g{q.S5A(), q.S5Wy(), 16 * 1024, 16 * 512, 640, 640, 640}; pg8::GroupOrder So; So.init(16, 4, 2, (int)gridDim.x, (int)blockIdx.x);
      pg8::gemm_phase<EpiS5Y, pg8::GroupOrder, true, true>((PG8_LAS unsigned char*)lds_raw, g, So, e); }
    __syncthreads();
    { PHASE_IDS; phase_ret_out(q, gw, ngw, lane); }
    xcd_barrier(xb);
    }
    DUP(4) {
    { const Params q = fresh(p); EpiGlu e{q.xb(), q.ygb(), (float*)(lds_raw + 131072)};
      run_gemm(lds_raw, q.ygb(), q.Wglu_t() + (size_t)l * 65536, T, 256, 256, e); }
    xcd_barrier(xb);
    }
    { const Params q = fresh(p); EpiAccum e{q.out, D};
      run_gemm(lds_raw, q.xb(), q.Wout_t() + (size_t)l * D * KD, T, D, KD, e); }
    xcd_barrier(xb);
    DUP(10) {
    { PHASE_IDS; phase_cvt_rows_h8(q, l, gw, ngw, lane);
      cvt_table_fp8(q.in[19] + (size_t)l * 16384 * D, q.U8s(), q.su(), gw, ngw, lane);
      cvt_table_fp8(q.in[20] + (size_t)l * 16384 * D, q.V8s(), q.sv(), gw, ngw, lane); }
    xcd_barrier(xb);
    }
    DUP(7) {
    { const Params q = fresh(p); EpiScaleStoreBf16 e{q.qb(), D, q.rstd()};
      run_gemm(lds_raw, q.xb(), q.Wq_t() + (size_t)l * D * KD, T, D, KD, e); }
    xcd_barrier(xb);
    }
    if (!(PROBE_SKIP & 2)) {
    DUP(8) {
    { PHASE_IDS; phase_peer_topk(q, l, gw, ngw, lane); }
    xcd_barrier(xb);
    }
    }
#if PEER_CHECK
    if (l == 0) { { PHASE_IDS; chk_save(q, gtid, ngt); } xcd_barrier(xb); { PHASE_IDS; chk_topk(q, l, gtid, ngt); } xcd_barrier(xb); }
#endif
    if (!(PROBE_SKIP & 1)) {
    { PHASE_IDS; phase_peer_u(q, q.qctr() + (l * 2 + 0) * 8, lds_raw, tid); }
    xcd_barrier(xb);
    { PHASE_IDS; phase_peer_r(q, gtid, ngt); }
    xcd_barrier(xb);
    if (!(PROBE_SKIP & 32)) {
    { PHASE_IDS; phase_peer_v(q, q.qctr() + (l * 2 + 1) * 8, lds_raw, tid); }
    xcd_barrier(xb);
    }
    }
#if PEER_CHECK
    if (l == 0) { { PHASE_IDS; chk_apply(q, l, ldsf + wv * 128, gw, ngw, lane); } xcd_barrier(xb);
      if (blockIdx.x == 0 && threadIdx.x == 0) { const Params q = fresh(p); chk_emit(q); } xcd_barrier(xb); }
#endif
  }
  { constexpr int l = 1;
    DUP(6) {
    { PHASE_IDS; phase_cvt_rows(q.out, q.xb(), q.rstd(), gw, ngw, lane);
      phase_s5_prep(q, l, gtid, ngt);
 }
    xcd_barrier(xb);
    }
    DUP(5) {
    { const Params q = fresh(p); EpiScaleStore e{q.proj(), INW, q.rstd()};
      run_gemm(lds_raw, q.xb(), q.Win_t() + (size_t)l * INW * KD, T, INW, KD, e); }
    xcd_barrier(xb);
    }
    DUP(0) {
    { PHASE_IDS; phase_post_pack(q, l, gtid, ngt, gw, ngw, lane); phase_pack_u(q, gtid, ngt); }
    xcd_barrier(xb);
    }
    DUP(1) {
    { const Params q = fresh(p); EpiS5Z e{q.S5Z()};
      pg8::Gemm g{q.S5A(), q.S5Wz(), 16 * 1024, 16 * 256, 512, 640, 512}; pg8::GroupOrder So; So.init(16, 4, 1, (int)gridDim.x, (int)blockIdx.x);
      pg8::gemm_phase<EpiS5Z, pg8::GroupOrder, true, true>((PG8_LAS unsigned char*)lds_raw, g, So, e); }
    { PHASE_IDS; phase_kmean2(q, gtid, ngt); phase_ret_kv(q, gw, ngw, lane); }
    xcd_barrier(xb);
    }
    DUP(2) {
    { PHASE_IDS; phase_s5_scan(q, gtid, ngt); phase_ret_scan(q, gtid, ngt); }
    __syncthreads();
    { PHASE_IDS; phase_moba2(q, l, lds_raw, bid, G); }
    xcd_barrier(xb);
    }
    DUP(3) {
    { const Params q = fresh(p); EpiS5Y e{q.ygb(), q.S5A(), q.in[10] + l * 256};
      pg8::Gemm g{q.S5A(), q.S5Wy(), 16 * 1024, 16 * 512, 640, 640, 640}; pg8::GroupOrder So; So.init(16, 4, 2, (int)gridDim.x, (int)blockIdx.x);
      pg8::gemm_phase<EpiS5Y, pg8::GroupOrder, true, true>((PG8_LAS unsigned char*)lds_raw, g, So, e); }
    __syncthreads();
    { PHASE_IDS; phase_ret_out(q, gw, ngw, lane); }
    xcd_barrier(xb);
    }
    DUP(4) {
    { const Params q = fresh(p); EpiGlu e{q.xb(), q.ygb(), (float*)(lds_raw + 131072)};
      run_gemm(lds_raw, q.ygb(), q.Wglu_t() + (size_t)l * 65536, T, 256, 256, e); }
    xcd_barrier(xb);
    }
    { const Params q = fresh(p); EpiAccum e{q.out, D};
      run_gemm(lds_raw, q.xb(), q.Wout_t() + (size_t)l * D * KD, T, D, KD, e); }
    xcd_barrier(xb);
    DUP(10) {
    { PHASE_IDS; phase_cvt_rows_h8(q, l, gw, ngw, lane);
      cvt_table_fp8(q.in[19] + (size_t)l * 16384 * D, q.U8s(), q.su(), gw, ngw, lane);
      cvt_table_fp8(q.in[20] + (size_t)l * 16384 * D, q.V8s(), q.sv(), gw, ngw, lane); }
    xcd_barrier(xb);
    }
    DUP(7) {
    { const Params q = fresh(p); EpiScaleStoreBf16 e{q.qb(), D, q.rstd()};
      run_gemm(lds_raw, q.xb(), q.Wq_t() + (size_t)l * D * KD, T, D, KD, e); }
    xcd_barrier(xb);
    }
    if (!(PROBE_SKIP & 2)) {
    DUP(8) {
    { PHASE_IDS; phase_peer_topk(q, l, gw, ngw, lane); }
    xcd_barrier(xb);
    }
    }
#if PEER_CHECK
    if (l == 0) { { PHASE_IDS; chk_save(q, gtid, ngt); } xcd_barrier(xb); { PHASE_IDS; chk_topk(q, l, gtid, ngt); } xcd_barrier(xb); }
#endif
    if (!(PROBE_SKIP & 1)) {
    { PHASE_IDS; phase_peer_u(q, q.qctr() + (l * 2 + 0) * 8, lds_raw, tid); }
    xcd_barrier(xb);
    { PHASE_IDS; phase_peer_r(q, gtid, ngt); }
    xcd_barrier(xb);
    if (!(PROBE_SKIP & 32)) {
    { PHASE_IDS; phase_peer_v(q, q.qctr() + (l * 2 + 1) * 8, lds_raw, tid); }
    xcd_barrier(xb);
    }
    }
#if PEER_CHECK
    if (l == 0) { { PHASE_IDS; chk_apply(q, l, ldsf + wv * 128, gw, ngw, lane); } xcd_barrier(xb);
      if (blockIdx.x == 0 && threadIdx.x == 0) { const Params q = fresh(p); chk_emit(q); } xcd_barrier(xb); }
#endif
  }
  { constexpr int l = 2;
    DUP(6) {
    { PHASE_IDS; phase_cvt_rows(q.out, q.xb(), q.rstd(), gw, ngw, lane);
      phase_s5_prep(q, l, gtid, ngt);
 }
    xcd_barrier(xb);
    }
    DUP(5) {
    { const Params q = fresh(p); EpiScaleStore e{q.proj(), INW, q.rstd()};
      run_gemm(lds_raw, q.xb(), q.Win_t() + (size_t)l * INW * KD, T, INW, KD, e); }
    xcd_barrier(xb);
    }
    DUP(0) {
    { PHASE_IDS; phase_post_pack(q, l, gtid, ngt, gw, ngw, lane); phase_pack_u(q, gtid, ngt); }
    xcd_barrier(xb);
    }
    DUP(1) {
    { const Params q = fresh(p); EpiS5Z e{q.S5Z()};
      pg8::Gemm g{q.S5A(), q.S5Wz(), 16 * 1024, 16 * 256, 512, 640, 512}; pg8::GroupOrder So; So.init(16, 4, 1, (int)gridDim.x, (int)blockIdx.x);
      pg8::gemm_phase<EpiS5Z, pg8::GroupOrder, true, true>((PG8_LAS unsigned char*)lds_raw, g, So, e); }
    { PHASE_IDS; phase_kmean2(q, gtid, ngt); phase_ret_kv(q, gw, ngw, lane); }
    xcd_barrier(xb);
    }
    DUP(2) {
    { PHASE_IDS; phase_s5_scan(q, gtid, ngt); phase_ret_scan(q, gtid, ngt); }
    __syncthreads();
    { PHASE_IDS; phase_moba2(q, l, lds_raw, bid, G); }
    xcd_barrier(xb);
    }
    DUP(3) {
    { const Params q = fresh(p); EpiS5Y e{q.ygb(), q.S5A(), q.in[10] + l * 256};
      pg8::Gemm g{q.S5A(), q.S5Wy(), 16 * 1024, 16 * 512, 640, 640, 640}; pg8::GroupOrder So; So.init(16, 4, 2, (int)gridDim.x, (int)blockIdx.x);
      pg8::gemm_phase<EpiS5Y, pg8::GroupOrder, true, true>((PG8_LAS unsigned char*)lds_raw, g, So, e); }
    __syncthreads();
    { PHASE_IDS; phase_ret_out(q, gw, ngw, lane); }
    xcd_barrier(xb);
    }
    DUP(4) {
    { const Params q = fresh(p); EpiGlu e{q.xb(), q.ygb(), (float*)(lds_raw + 131072)};
      run_gemm(lds_raw, q.ygb(), q.Wglu_t() + (size_t)l * 65536, T, 256, 256, e); }
    xcd_barrier(xb);
    }
    { const Params q = fresh(p); EpiAccum e{q.out, D};
      run_gemm(lds_raw, q.xb(), q.Wout_t() + (size_t)l * D * KD, T, D, KD, e); }
    xcd_barrier(xb);
    DUP(10) {
    { PHASE_IDS; phase_cvt_rows_h8(q, l, gw, ngw, lane);
      cvt_table_fp8(q.in[19] + (size_t)l * 16384 * D, q.U8s(), q.su(), gw, ngw, lane);
      cvt_table_fp8(q.in[20] + (size_t)l * 16384 * D, q.V8s(), q.sv(), gw, ngw, lane); }
    xcd_barrier(xb);
    }
    DUP(7) {
    { const Params q = fresh(p); EpiScaleStoreBf16 e{q.qb(), D, q.rstd()};
      run_gemm(lds_raw, q.xb(), q.Wq_t() + (size_t)l * D * KD, T, D, KD, e); }
    xcd_barrier(xb);
    }
    if (!(PROBE_SKIP & 2)) {
    DUP(8) {
    { PHASE_IDS; phase_peer_topk(q, l, gw, ngw, lane); }
    xcd_barrier(xb);
    }
    }
#if PEER_CHECK
    if (l == 0) { { PHASE_IDS; chk_save(q, gtid, ngt); } xcd_barrier(xb); { PHASE_IDS; chk_topk(q, l, gtid, ngt); } xcd_barrier(xb); }
#endif
    if (!(PROBE_SKIP & 1)) {
    { PHASE_IDS; phase_peer_u(q, q.qctr() + (l * 2 + 0) * 8, lds_raw, tid); }
    xcd_barrier(xb);
    { PHASE_IDS; phase_peer_r(q, gtid, ngt); }
    xcd_barrier(xb);
    if (!(PROBE_SKIP & 32)) {
    { PHASE_IDS; phase_peer_v(q, q.qctr() + (l * 2 + 1) * 8, lds_raw, tid); }
    xcd_barrier(xb);
    }
    }
#if PEER_CHECK
    if (l == 0) { { PHASE_IDS; chk_apply(q, l, ldsf + wv * 128, gw, ngw, lane); } xcd_barrier(xb);
      if (blockIdx.x == 0 && threadIdx.x == 0) { const Params q = fresh(p); chk_emit(q); } xcd_barrier(xb); }
#endif
  }
  { constexpr int l = 3;
    DUP(6) {
    { PHASE_IDS; phase_cvt_rows(q.out, q.xb(), q.rstd(), gw, ngw, lane);
      phase_s5_prep(q, l, gtid, ngt);
 }
    xcd_barrier(xb);
    }
    DUP(5) {
    { const Params q = fresh(p); EpiScaleStore e{q.proj(), INW, q.rstd()};
      run_gemm(lds_raw, q.xb(), q.Win_t() + (size_t)l * INW * KD, T, INW, KD, e); }
    xcd_barrier(xb);
    }
    DUP(0) {
    { PHASE_IDS; phase_post_pack(q, l, gtid, ngt, gw, ngw, lane); phase_pack_u(q, gtid, ngt); }
    xcd_barrier(xb);
    }
    DUP(1) {
    { const Params q = fresh(p); EpiS5Z e{q.S5Z()};
      pg8::Gemm g{q.S5A(), q.S5Wz(), 16 * 1024, 16 * 256, 512, 640, 512}; pg8::GroupOrder So; So.init(16, 4, 1, (int)gridDim.x, (int)blockIdx.x);
      pg8::gemm_phase<EpiS5Z, pg8::GroupOrder, true, true>((PG8_LAS unsigned char*)lds_raw, g, So, e); }
    { PHASE_IDS; phase_kmean2(q, gtid, ngt); phase_ret_kv(q, gw, ngw, lane); }
    xcd_barrier(xb);
    }
    DUP(2) {
    { PHASE_IDS; phase_s5_scan(q, gtid, ngt); phase_ret_scan(q, gtid, ngt); }
    __syncthreads();
    { PHASE_IDS; phase_moba2(q, l, lds_raw, bid, G); }
    xcd_barrier(xb);
    }
    DUP(3) {
    { const Params q = fresh(p); EpiS5Y e{q.ygb(), q.S5A(), q.in[10] + l * 256};
      pg8::Gemm g{q.S5A(), q.S5Wy(), 16 * 1024, 16 * 512, 640, 640, 640}; pg8::GroupOrder So; So.init(16, 4, 2, (int)gridDim.x, (int)blockIdx.x);
      pg8::gemm_phase<EpiS5Y, pg8::GroupOrder, true, true>((PG8_LAS unsigned char*)lds_raw, g, So, e); }
    __syncthreads();
    { PHASE_IDS; phase_ret_out(q, gw, ngw, lane); }
    xcd_barrier(xb);
    }
    DUP(4) {
    { const Params q = fresh(p); EpiGlu e{q.xb(), q.ygb(), (float*)(lds_raw + 131072)};
      run_gemm(lds_raw, q.ygb(), q.Wglu_t() + (size_t)l * 65536, T, 256, 256, e); }
    xcd_barrier(xb);
    }
    { const Params q = fresh(p); EpiAccum e{q.out, D};
      run_gemm(lds_raw, q.xb(), q.Wout_t() + (size_t)l * D * KD, T, D, KD, e); }
    xcd_barrier(xb);
    DUP(10) {
    { PHASE_IDS; phase_cvt_rows_h8(q, l, gw, ngw, lane);
      cvt_table_fp8(q.in[19] + (size_t)l * 16384 * D, q.U8s(), q.su(), gw, ngw, lane);
      cvt_table_fp8(q.in[20] + (size_t)l * 16384 * D, q.V8s(), q.sv(), gw, ngw, lane); }
    xcd_barrier(xb);
    }
    DUP(7) {
    { const Params q = fresh(p); EpiScaleStoreBf16 e{q.qb(), D, q.rstd()};
      run_gemm(lds_raw, q.xb(), q.Wq_t() + (size_t)l * D * KD, T, D, KD, e); }
    xcd_barrier(xb);
    }
    if (!(PROBE_SKIP & 2)) {
    DUP(8) {
    { PHASE_IDS; phase_peer_topk(q, l, gw, ngw, lane); }
    xcd_barrier(xb);
    }
    }
#if PEER_CHECK
    if (l == 0) { { PHASE_IDS; chk_save(q, gtid, ngt); } xcd_barrier(xb); { PHASE_IDS; chk_topk(q, l, gtid, ngt); } xcd_barrier(xb); }
#endif
    if (!(PROBE_SKIP & 1)) {
    { PHASE_IDS; phase_peer_u(q, q.qctr() + (l * 2 + 0) * 8, lds_raw, tid); }
    xcd_barrier(xb);
    { PHASE_IDS; phase_peer_r(q, gtid, ngt); }
    xcd_barrier(xb);
    if (!(PROBE_SKIP & 32)) {
    { PHASE_IDS; phase_peer_v(q, q.qctr() + (l * 2 + 1) * 8, lds_raw, tid); }
    xcd_barrier(xb);
    }
    }
#if PEER_CHECK
    if (l == 0) { { PHASE_IDS; chk_apply(q, l, ldsf + wv * 128, gw, ngw, lane); } xcd_barrier(xb);
      if (blockIdx.x == 0 && threadIdx.x == 0) { const Params q = fresh(p); chk_emit(q); } xcd_barrier(xb); }
#endif
  }
}

}

extern "C" void kernel_launch(void* const* d_in, const int* in_sizes, int n_in, void* d_out, int out_size, void* d_ws, size_t ws_size,
                              hipStream_t stream) {
  static int grid_blocks = 0;
  if (!grid_blocks) {
    int dev = 0, cus = 0, per_cu = 0;
    hipGetDevice(&dev);
    hipDeviceGetAttribute(&cus, hipDeviceAttributeMultiprocessorCount, dev);
    hipFuncSetAttribute((const void*)mega, hipFuncAttributeMaxDynamicSharedMemorySize, LDS_BYTES);
    hipOccupancyMaxActiveBlocksPerMultiprocessor(&per_cu, (const void*)mega, NTHR, LDS_BYTES);
    if (per_cu < 1) { fprintf(stderr, "occupancy query returned %d\n", per_cu); per_cu = 1; }
    grid_blocks = cus * 1;
    if (grid_blocks < 64) fprintf(stderr, "unexpected CU count %d\n", cus);
  }
  Params p{};
  for (int i = 0; i < 21; ++i) p.in[i] = (const float*)d_in[i];
  p.out = (float*)d_out;
  p.ws = (unsigned char*)d_ws;
  if (WS_TOTAL > ws_size) { fprintf(stderr, "workspace too small: need %zu have %zu\n", (size_t)WS_TOTAL, ws_size); return; }
  hipMemsetAsync((unsigned char*)d_ws + WO_bar, 0, 16384, stream);
  void* args[] = {&p};
  hipError_t e = hipLaunchCooperativeKernel((const void*)mega, dim3(grid_blocks), dim3(NTHR), args, LDS_BYTES, stream);
  if (e != hipSuccess) fprintf(stderr, "cooperative launch failed: %s (grid %d)\n", hipGetErrorString(e), grid_blocks);
}
```

```cpp
#include <hip/hip_runtime.h>
#include <hip/hip_cooperative_groups.h>
#include <math.h>
#include <stdint.h>
#include <stdio.h>
namespace cg = cooperative_groups;

#ifndef PEER_CHECK
#define PEER_CHECK 0
#endif
#ifndef PROBE_DUP
#define PROBE_DUP 0
#endif
__device__ __forceinline__ int dup_n(int n) { asm volatile("" : "+s"(n)); return n; }
#define DUP(bit) _Pragma("unroll 1") for (int rep_ = 0, repn_ = (((PROBE_DUP >> (bit)) & 1) ? dup_n(2) : 1); rep_ < repn_; ++rep_)
#ifndef PROBE_SKIP
#define PROBE_SKIP 0
#endif
#ifndef PRECISE
#define PRECISE 0
#endif

namespace {
constexpr int NB = 8, S = 4096, D = 1024, NL = 4, T = NB * S;
constexpr int INW = 2816;
constexpr int OFF_U = 0, OFF_QM = 256, OFF_KM = 768, OFF_VM = 1280, OFF_QR = 1792, OFF_KR = 2048, OFF_VR = 2304, OFF_GR = 2560;
constexpr float EPS = 1e-6f;
static_assert(PRECISE == 0, "PRECISE builds are retired");
constexpr int KS = PRECISE ? 3 : 1;
constexpr int KD = D * KS;
constexpr int NTHR = 512, NWAVE = 8;
constexpr int LDS_BYTES = 131072 + 4096 + 1024;

typedef unsigned short bf16_t;
using bf16x8 = __attribute__((ext_vector_type(8))) short;
using f32x4 = __attribute__((ext_vector_type(4))) float;

__device__ __forceinline__ float wave_sum(float v) {
#pragma unroll
  for (int o = 32; o > 0; o >>= 1) v += __shfl_xor(v, o);
  return v;
}
__device__ __forceinline__ float wave_max(float v) {
#pragma unroll
  for (int o = 32; o > 0; o >>= 1) v = fmaxf(v, __shfl_xor(v, o));
  return v;
}
__device__ __forceinline__ float gelu_tanh(float x) {
  const float k0 = 0.7978845608028654f, k1 = 0.044715f;
  float u = k0 * (x + k1 * x * x * x);
  return 0.5f * x * (1.0f + tanhf(u));
}
__device__ __forceinline__ float sigmoidf_(float x) { return 1.0f / (1.0f + expf(-x)); }
__device__ __forceinline__ float fast_sigmoid(float x) { return __builtin_amdgcn_rcpf(1.0f + __builtin_amdgcn_exp2f(-1.4426950408889634f * x)); }
__device__ __forceinline__ float fast_gelu(float x) { const float u = 0.7978845608028654f * (x + 0.044715f * x * x * x); return x * fast_sigmoid(2.0f * u); }
__device__ __forceinline__ bf16_t f2bf(float f) {
  unsigned u = __float_as_uint(f);
  u += 0x7fffu + ((u >> 16) & 1u);
  return (bf16_t)(u >> 16);
}
__device__ __forceinline__ float bf2f(bf16_t h) { return __uint_as_float(((unsigned)h) << 16); }
#define LDS_FENCE() asm volatile("s_waitcnt lgkmcnt(0)" ::: "memory")
typedef __bf16 bf16x2_hw __attribute__((ext_vector_type(2)));
typedef float f32x2_hw __attribute__((ext_vector_type(2)));
__device__ __forceinline__ unsigned pk_bf16(float lo, float hi) { const f32x2_hw f = {lo, hi}; const bf16x2_hw b = __builtin_convertvector(f, bf16x2_hw); return __builtin_bit_cast(unsigned, b); }
typedef float f32x16 __attribute__((ext_vector_type(16)));

constexpr size_t al256(size_t x) { return (x + 255) & ~(size_t)255; }
constexpr size_t WO_rstd = 0;
constexpr size_t WO_cosm = WO_rstd + al256((size_t)T * 4);
constexpr size_t WO_sinm = WO_cosm + al256((size_t)S * 8 * 4);
constexpr size_t WO_cosr = WO_sinm + al256((size_t)S * 8 * 4);
constexpr size_t WO_sinr = WO_cosr + al256((size_t)S * 32 * 4);
constexpr size_t WO_kmean = WO_sinr + al256((size_t)S * 32 * 4);
constexpr size_t WO_proj = WO_kmean + al256((size_t)NB * 8 * 16 * 64 * 4);
constexpr size_t WO_ybuf = WO_proj + al256((size_t)T * INW * 4);
constexpr size_t WO_yg = WO_ybuf + al256((size_t)T * D * 4);
constexpr size_t WO_skb = WO_yg + al256((size_t)T * 256 * 4);
constexpr size_t WO_Ub = WO_skb + al256((size_t)NL * 16 * 128 * 64 * 2);
constexpr size_t WO_Vb = WO_Ub + al256((size_t)16384 * D * 2);
constexpr size_t WO_gates = WO_Vb + al256((size_t)16384 * D * 2);
constexpr size_t WO_eidx = WO_gates + al256((size_t)T * 128 * 4);
constexpr size_t WO_xb = WO_eidx + al256((size_t)T * 128 * 4);
constexpr size_t WO_Win_t = WO_xb + al256((size_t)T * KD * 2);
constexpr size_t WO_Wout_t = WO_Win_t + al256((size_t)NL * INW * KD * 2);
constexpr size_t WO_Wq_t = WO_Wout_t + al256((size_t)NL * D * KD * 2);
constexpr size_t WO_Qm = WO_Wq_t + al256((size_t)NL * D * KD * 2);
constexpr size_t WO_Km = WO_Qm + al256((size_t)T * 512 * 2);
constexpr size_t WO_Vm = WO_Km + al256((size_t)T * 512 * 2);
constexpr size_t WO_S5a32 = WO_Vm + al256((size_t)T * 512 * 2);
constexpr size_t WO_Wglu_t = WO_S5a32 + al256((size_t)16 * 64 * 2 * 4);
constexpr size_t WO_Qr = WO_Wglu_t + al256((size_t)NL * 256 * 256 * 2);
constexpr size_t WO_Kr = WO_Qr + al256((size_t)T * 256 * 2);
constexpr size_t WO_Krv = WO_Kr + al256((size_t)T * 256 * 2);
constexpr size_t WO_Vr = WO_Krv + al256((size_t)T * 256 * 2);
constexpr size_t WO_KVr = WO_Vr + al256((size_t)T * 256 * 2);
constexpr size_t WO_Rb = WO_KVr + al256((size_t)32 * 32 * 4096 * 4);
constexpr size_t WO_qctr = WO_Rb + al256((size_t)32 * 32 * 4096 * 2);
constexpr size_t WO_bar = WO_qctr + al256(1024);
constexpr size_t WS_TOTAL = WO_bar + al256(16384);
constexpr size_t WO_S5A = WO_gates;
constexpr size_t WO_S5Z = WO_S5A + al256((size_t)16 * 1024 * 640 * 2);
static_assert(WO_S5Z + (size_t)16 * 1024 * 128 * 4 <= WO_gates + 2 * al256((size_t)T * 128 * 4), "S5A/S5Z must fit in gates+eidx");
constexpr size_t WO_S5Wy = WO_Ub;
constexpr size_t WO_S5Wz = WO_S5Wy + al256((size_t)16 * 512 * 640 * 2);
static_assert(WO_S5Wz + (size_t)16 * 256 * 512 * 2 <= WO_Ub + 2 * al256((size_t)16384 * D * 2), "S5 weights must fit in Ub/Vb");
struct Params {
  const float* in[21];
  float* out;
  unsigned char* ws;
  __device__ __forceinline__ float* rstd() const { return (float*)(ws + WO_rstd); }
  __device__ __forceinline__ float* cosm() const { return (float*)(ws + WO_cosm); }
  __device__ __forceinline__ float* sinm() const { return (float*)(ws + WO_sinm); }
  __device__ __forceinline__ float* cosr() const { return (float*)(ws + WO_cosr); }
  __device__ __forceinline__ float* sinr() const { return (float*)(ws + WO_sinr); }
  __device__ __forceinline__ float* kmean() const { return (float*)(ws + WO_kmean); }
  __device__ __forceinline__ float* proj() const { return (float*)(ws + WO_proj); }
  __device__ __forceinline__ float* ybuf() const { return (float*)(ws + WO_ybuf); }
  __device__ __forceinline__ float* yg() const { return (float*)(ws + WO_yg); }
  __device__ __forceinline__ bf16_t* skb() const { return (bf16_t*)(ws + WO_skb); }
  __device__ __forceinline__ bf16_t* Ub() const { return (bf16_t*)(ws + WO_Ub); }
  __device__ __forceinline__ bf16_t* Vb() const { return (bf16_t*)(ws + WO_Vb); }
  __device__ __forceinline__ float* gates() const { return (float*)(ws + WO_gates); }
  __device__ __forceinline__ int* eidx() const { return (int*)(ws + WO_eidx); }
  __device__ __forceinline__ bf16_t* xb() const { return (bf16_t*)(ws + WO_xb); }
  __device__ __forceinline__ bf16_t* Win_t() const { return (bf16_t*)(ws + WO_Win_t); }
  __device__ __forceinline__ bf16_t* Wout_t() const { return (bf16_t*)(ws + WO_Wout_t); }
  __device__ __forceinline__ bf16_t* Wq_t() const { return (bf16_t*)(ws + WO_Wq_t); }
  __device__ __forceinline__ bf16_t* Qm() const { return (bf16_t*)(ws + WO_Qm); }
  __device__ __forceinline__ bf16_t* Km() const { return (bf16_t*)(ws + WO_Km); }
  __device__ __forceinline__ bf16_t* Vm() const { return (bf16_t*)(ws + WO_Vm); }
  __device__ __forceinline__ bf16_t* S5A() const { return (bf16_t*)(ws + WO_S5A); }
  __device__ __forceinline__ bf16_t* S5Wy() const { return (bf16_t*)(ws + WO_S5Wy); }
  __device__ __forceinline__ bf16_t* S5Wz() const { return (bf16_t*)(ws + WO_S5Wz); }
  __device__ __forceinline__ float* S5Z() const { return (float*)(ws + WO_S5Z); }
  __device__ __forceinline__ float* S5a32() const { return (float*)(ws + WO_S5a32); }
  __device__ __forceinline__ bf16_t* Wglu_t() const { return (bf16_t*)(ws + WO_Wglu_t); }
  __device__ __forceinline__ bf16_t* ygb() const { return (bf16_t*)(ws + WO_yg); }
  __device__ __forceinline__ int* qctr() const { return (int*)(ws + WO_qctr); }
  __device__ __forceinline__ unsigned char* U8s() const { return ws + WO_Ub; }
  __device__ __forceinline__ float* su() const { return (float*)(ws + WO_Ub + (size_t)16384 * D); }
  __device__ __forceinline__ unsigned char* V8s() const { return ws + WO_Vb; }
  __device__ __forceinline__ float* sv() const { return (float*)(ws + WO_Vb + (size_t)16384 * D); }
  __device__ __forceinline__ bf16_t* hb() const { return (bf16_t*)(ws + WO_ybuf + ((size_t)4 << 20)); }
  __device__ __forceinline__ unsigned char* h8lo() const { return ws + WO_ybuf + ((size_t)4 << 20) + (size_t)T * D; }
  __device__ __forceinline__ float* sh() const { return (float*)(ws + WO_ybuf + ((size_t)4 << 20) + (size_t)2 * T * D); }
  __device__ __forceinline__ float* ppart() const { return (float*)(ws + WO_proj + (size_t)T * D * 2); }
  __device__ __forceinline__ bf16_t* Qr() const { return (bf16_t*)(ws + WO_Qr); }
  __device__ __forceinline__ bf16_t* Kr() const { return (bf16_t*)(ws + WO_Kr); }
  __device__ __forceinline__ bf16_t* Krv() const { return (bf16_t*)(ws + WO_Krv); }
  __device__ __forceinline__ bf16_t* Vr() const { return (bf16_t*)(ws + WO_Vr); }
  __device__ __forceinline__ float* KVr() const { return (float*)(ws + WO_KVr); }
  __device__ __forceinline__ bf16_t* Rb() const { return (bf16_t*)(ws + WO_Rb); }
  __device__ __forceinline__ unsigned* bar() const { return (unsigned*)(ws + WO_bar); }
  __device__ __forceinline__ bf16_t* projb() const { return (bf16_t*)(ws + WO_proj); }
  __device__ __forceinline__ bf16_t* qb() const { return (bf16_t*)(ws + WO_proj); }
};

namespace pg8 {
#define PG8_LAS __attribute__((address_space(3)))
typedef unsigned short bf16_t;
typedef short bf16x8 __attribute__((ext_vector_type(8)));
typedef float f32x4 __attribute__((ext_vector_type(4)));
typedef unsigned u32x4 __attribute__((ext_vector_type(4)));
constexpr int BM = 256, BK = 64, HALF = 128, HTB = HALF * BK * 2  , STAGE_BYTES = 8 * HTB, NXCD = 8, WGM = 8;

__host__ __device__ __forceinline__ int lds_byte(int r, int c) { const int st = (r >> 4) * 2 + (c >> 5), rr = r & 15, cc = c & 31, ob = rr * 64 + cc * 2; return st * 1024 + (ob ^ (((ob >> 9) & 1) << 5)); }
__host__ __device__ __forceinline__ void stage_rc(int b, int& R, int& C) { const int st = b / 1024, sb = b % 1024, swz = sb ^ (((sb >> 9) & 1) << 5); R = (st >> 1) * 16 + swz / 64; C = (st & 1) * 32 + (swz % 64) / 2; }
__host__ __device__ __forceinline__ int perm32(int rho) { const int n = rho >> 4, i = rho & 15; return 8 * (i >> 2) + 4 * n + (i & 3); }

struct Unit { int pm, pn; };
struct Gemm { const bf16_t* A; const bf16_t* Bt; int M, N, K, lda, ldb; };

struct StaticOrder {
    int nM, nN, nwg, G, c;
    __host__ __device__ void init(int M, int N, int G_, int c_) { nM = M / BM; nN = N / BM; nwg = nM * nN; G = G_; c = c_; }
    __host__ __device__ bool next(int i, Unit& u) const {
        const long L = (long)i * G + c; if (L >= nwg) return false;
        int wgid = (int)L; { const int q = nwg / NXCD, r = nwg % NXCD, xcd = wgid % NXCD, off = wgid / NXCD; wgid = (xcd < r ? xcd * (q + 1) : r * (q + 1) + (xcd - r) * q) + off; }
        const int nig = WGM * nN, gid = wgid / nig, fm = gid * WGM, gsz = (nM - fm) < WGM ? (nM - fm) : WGM;
        u.pm = fm + ((wgid % nig) % gsz); u.pn = (wgid % nig) / gsz; return true;
    }
    __device__ __forceinline__ void a_ready(const Unit&) const {}
    __device__ __forceinline__ void done(const Unit&) const {}
};
struct GroupOrder {
    int mt, nt_, nwg, G, c;
    __host__ __device__ void init(int ngroups, int mt__, int nt__, int G_, int c_) { mt = mt__; nt_ = nt__; nwg = ngroups * mt * nt_; G = G_; c = c_; }
    __host__ __device__ bool next(int i, Unit& u) const {
        const long L = (long)i * G + c; if (L >= nwg) return false;
        const int per = mt * nt_, gi = (int)L / per, r = (int)L % per;
        u.pm = gi * mt + r % mt; u.pn = gi * nt_ + r / mt; return true;
    }
    __device__ __forceinline__ void a_ready(const Unit&) const {}
    __device__ __forceinline__ void done(const Unit&) const {}
};
template <class Epi, class Sched, bool ALIGN_EPI = false, bool SP2 = false>
__device__ __forceinline__ void gemm_phase(PG8_LAS unsigned char* lds, const Gemm g, const Sched& S, const Epi& E) {
    int tid_ = threadIdx.x; asm volatile("" : "+v"(tid_));
    const int tid = tid_, wid = __builtin_amdgcn_readfirstlane(tid >> 6), lane = tid & 63, wr = wid >> 2, wc = wid & 3, fr = lane & 15, fq = lane >> 4;
    const int K = g.K, nt = K / BK;
    unsigned voffA[2], voffB[2];
#pragma unroll
    for (int i = 0; i < 2; ++i) { int R, C; stage_rc(tid * 16 + i * 8192, R, C); const int Rb = Epi::PERM ? ((R & ~31) + perm32(R & 31)) : R;
        voffA[i] = (unsigned)(R * g.lda + C) * 2u; voffB[i] = (unsigned)(Rb * g.ldb + C) * 2u; }
    const size_t kstep = (size_t)(BK * 2);
    const size_t hstepA = (size_t)HALF * g.lda * 2, hstepB = (size_t)HALF * g.ldb * 2;
    const size_t tstepA = 2 * hstepA, tstepB = 2 * hstepB;
    const unsigned ldsw = (unsigned)wid * 1024u;
    const int aoff = lds_byte(wr * 64 + fr, fq * 8), boff = lds_byte(wc * 32 + fr, fq * 8);
#define PG8_SA(b, h) (((b) * 2 + (h)) * HTB)
#define PG8_SB(b, h) ((4 + (b) * 2 + (h)) * HTB)
#define PG8_STAGE(bufoff, gbase, voff) do { _Pragma("unroll") for (int _i = 0; _i < 2; ++_i) \
        __builtin_amdgcn_global_load_lds((const unsigned*)((const char*)(gbase) + (voff)[_i]), (PG8_LAS unsigned*)(lds + (bufoff) + ldsw + _i * 8192), 16, 0, 0); } while (0)
#define PG8_LDA(dst, b, h) do { _Pragma("unroll") for (int m = 0; m < 4; ++m) _Pragma("unroll") for (int k = 0; k < 2; ++k) dst[m][k] = *(const PG8_LAS bf16x8*)(lds + PG8_SA(b, h) + aoff + m * 2048 + k * 1024); } while (0)
#define PG8_LDB(dst, b, h) do { _Pragma("unroll") for (int n = 0; n < 2; ++n) _Pragma("unroll") for (int k = 0; k < 2; ++k) dst[n][k] = *(const PG8_LAS bf16x8*)(lds + PG8_SB(b, h) + boff + n * 2048 + k * 1024); } while (0)
#define PG8_MMA(ai, bj, At, Bt) do { __builtin_amdgcn_s_setprio(1); _Pragma("unroll") for (int m = 0; m < 4; ++m) _Pragma("unroll") for (int n = 0; n < 2; ++n) _Pragma("unroll") for (int k = 0; k < 2; ++k) \
        acc[ai][bj][m][n] = __builtin_amdgcn_mfma_f32_16x16x32_bf16(Bt[n][k], At[m][k], acc[ai][bj][m][n], 0, 0, 0); __builtin_amdgcn_s_setprio(0); } while (0)
#define PG8_WAIT_V(n) asm volatile("s_waitcnt vmcnt(" #n ")" ::: "memory")
#define PG8_WAIT_L(n) asm volatile("s_waitcnt lgkmcnt(" #n ")" ::: "memory")
#define PG8_BAR __builtin_amdgcn_s_barrier()
#define PG8_SCHED __builtin_amdgcn_sched_barrier(0)
    Unit cur, nxt; int ui = 0;
    if (!S.next(0, cur)) return;
    f32x4 acc[2][2][4][2];
    E.init(acc, cur, wr, wc, fr, fq);
    bf16x8 At[4][2], B0[2][2], B1[2][2];
    const char* cA = (const char*)g.A + (size_t)cur.pm * tstepA; const char* cB = (const char*)g.Bt + (size_t)cur.pn * tstepB;
    S.a_ready(cur);
    if constexpr (SP2) {
        PG8_STAGE(PG8_SB(0, 0), cB, voffB); PG8_STAGE(PG8_SB(0, 1), cB + hstepB, voffB); PG8_STAGE(PG8_SA(0, 0), cA, voffA); PG8_STAGE(PG8_SA(0, 1), cA + hstepA, voffA);
        if (wr == 1) PG8_BAR;
        PG8_WAIT_V(2); PG8_BAR;
        PG8_STAGE(PG8_SB(1, 0), cB + kstep, voffB); PG8_STAGE(PG8_SA(1, 0), cA + kstep, voffA); PG8_STAGE(PG8_SB(1, 1), cB + hstepB + kstep, voffB);
        PG8_WAIT_V(6); PG8_BAR;
    } else {
        PG8_STAGE(PG8_SB(0, 0), cB, voffB); PG8_STAGE(PG8_SA(0, 0), cA, voffA); PG8_STAGE(PG8_SB(0, 1), cB + hstepB, voffB); PG8_STAGE(PG8_SA(0, 1), cA + hstepA, voffA);
        if (wr == 1) PG8_BAR;
        PG8_WAIT_V(4); PG8_BAR;
        PG8_STAGE(PG8_SB(1, 0), cB + kstep, voffB); PG8_STAGE(PG8_SA(1, 0), cA + kstep, voffA); PG8_STAGE(PG8_SB(1, 1), cB + hstepB + kstep, voffB);
        PG8_WAIT_V(6); PG8_BAR;
    }
    for (;;) {
        const bool has_next = S.next(ui + 1, nxt);
        const char* nA = has_next ? (const char*)g.A + (size_t)nxt.pm * tstepA : cA; const char* nB = has_next ? (const char*)g.Bt + (size_t)nxt.pn * tstepB : cB;
        for (int t = 0; t < nt; t += 2) {
            const bool last = (t == nt - 2);
            const char* a1 = cA + (size_t)(t + 1) * kstep;
            const char* a2 = last ? nA : cA + (size_t)(t + 2) * kstep; const char* b2 = last ? nB : cB + (size_t)(t + 2) * kstep;
            const char* a3 = a2 + kstep; const char* b3 = b2 + kstep;
            if (last && has_next) S.a_ready(nxt);
            if constexpr (SP2) {
            PG8_LDB(B0, 0, 0); PG8_LDB(B1, 0, 1); PG8_SCHED; PG8_LDA(At, 0, 0); PG8_STAGE(PG8_SA(1, 1), a1 + hstepA, voffA);
            PG8_WAIT_V(8); PG8_WAIT_L(0); PG8_BAR; PG8_MMA(0, 0, At, B0); PG8_MMA(0, 1, At, B1); PG8_BAR; PG8_SCHED;
            PG8_LDA(At, 0, 1); PG8_STAGE(PG8_SB(0, 0), b2, voffB); PG8_STAGE(PG8_SB(0, 1), b2 + hstepB, voffB); PG8_STAGE(PG8_SA(0, 0), a2, voffA);
            PG8_WAIT_V(8); PG8_WAIT_L(0); PG8_BAR; PG8_MMA(1, 0, At, B0); PG8_MMA(1, 1, At, B1); PG8_BAR; PG8_SCHED;
            PG8_LDB(B0, 1, 0); PG8_LDB(B1, 1, 1); PG8_SCHED; PG8_LDA(At, 1, 0); PG8_STAGE(PG8_SA(0, 1), a2 + hstepA, voffA);
            PG8_WAIT_V(8); PG8_WAIT_L(0); PG8_BAR; PG8_MMA(0, 0, At, B0); PG8_MMA(0, 1, At, B1); PG8_BAR; PG8_SCHED;
            PG8_LDA(At, 1, 1); PG8_STAGE(PG8_SB(1, 0), b3, voffB); PG8_STAGE(PG8_SB(1, 1), b3 + hstepB, voffB); PG8_STAGE(PG8_SA(1, 0), a3, voffA);
            PG8_WAIT_V(8); PG8_WAIT_L(0); PG8_BAR; PG8_MMA(1, 0, At, B0); PG8_MMA(1, 1, At, B1); PG8_BAR; PG8_SCHED;
            } else {
            PG8_LDB(B0, 0, 0); PG8_SCHED; PG8_LDA(At, 0, 0); PG8_STAGE(PG8_SA(1, 1), a1 + hstepA, voffA);
            PG8_WAIT_L(8); PG8_BAR; PG8_WAIT_L(0); PG8_MMA(0, 0, At, B0); PG8_BAR; PG8_SCHED;
            PG8_LDB(B1, 0, 1); PG8_STAGE(PG8_SB(0, 0), b2, voffB);
            PG8_BAR; PG8_WAIT_L(0); PG8_MMA(0, 1, At, B1); PG8_BAR;
            PG8_LDA(At, 0, 1); PG8_STAGE(PG8_SA(0, 0), a2, voffA);
            PG8_BAR; PG8_WAIT_L(0); PG8_MMA(1, 0, At, B0); PG8_BAR; PG8_SCHED;
            PG8_STAGE(PG8_SB(0, 1), b2 + hstepB, voffB);
            PG8_WAIT_V(6); PG8_BAR; PG8_MMA(1, 1, At, B1); PG8_BAR;
            PG8_LDB(B0, 1, 0); PG8_SCHED; PG8_LDA(At, 1, 0); PG8_STAGE(PG8_SA(0, 1), a2 + hstepA, voffA);
            PG8_WAIT_L(8); PG8_BAR; PG8_WAIT_L(0); PG8_MMA(0, 0, At, B0); PG8_BAR; PG8_SCHED;
            PG8_LDB(B1, 1, 1); PG8_STAGE(PG8_SB(1, 0), b3, voffB);
            PG8_BAR; PG8_WAIT_L(0); PG8_MMA(0, 1, At, B1); PG8_BAR;
            PG8_LDA(At, 1, 1); PG8_STAGE(PG8_SA(1, 0), a3, voffA);
            PG8_BAR; PG8_WAIT_L(0); PG8_MMA(1, 0, At, B0); PG8_BAR; PG8_SCHED;
            PG8_STAGE(PG8_SB(1, 1), b3 + hstepB, voffB);
            PG8_WAIT_V(6); PG8_BAR; PG8_MMA(1, 1, At, B1); PG8_BAR;
            }
        }
        if constexpr (ALIGN_EPI) { if (wr == 0) PG8_BAR; }
        if constexpr (!Epi::AFTER_DRAIN) { E(acc, cur, wr, wc, fr, fq); S.done(cur); }
        if (!has_next) break;
        E.init(acc, nxt, wr, wc, fr, fq);
        cur = nxt; cA = nA; cB = nB; ++ui;
        if constexpr (ALIGN_EPI) { if (wr == 1) PG8_BAR; }
    }
    PG8_WAIT_V(0);
    if constexpr (!ALIGN_EPI) { if (wr == 0) PG8_BAR; }
    PG8_BAR;
    if constexpr (Epi::AFTER_DRAIN) { E.fused(acc, cur, wr, wc, fr, fq, lds, wid, lane); S.done(cur); }
#undef PG8_SA
#undef PG8_SB
#undef PG8_STAGE
#undef PG8_LDA
#undef PG8_LDB
#undef PG8_MMA
#undef PG8_WAIT_V
#undef PG8_WAIT_L
#undef PG8_BAR
#undef PG8_SCHED
}
}
struct EpiScaleStore {
  static constexpr bool PERM = false, AFTER_DRAIN = false;
  float* C; int ldc; const float* rs;
  __device__ __forceinline__ void init(pg8::f32x4 (&acc)[2][2][4][2], const pg8::Unit&, int, int, int, int) const {
#pragma unroll
    for (int a = 0; a < 2; ++a)
#pragma unroll
      for (int b = 0; b < 2; ++b)
#pragma unroll
        for (int m = 0; m < 4; ++m)
#pragma unroll
          for (int n = 0; n < 2; ++n) acc[a][b][m][n] = (pg8::f32x4){0.f, 0.f, 0.f, 0.f};
  }
  __device__ __forceinline__ void operator()(const pg8::f32x4 (&acc)[2][2][4][2], const pg8::Unit& u, int wr, int wc, int fr_in, int fq_in) const {
    int fr = fr_in, fq = fq_in; asm volatile("" : "+v"(fr), "+v"(fq));
#pragma unroll
    for (int ai = 0; ai < 2; ++ai)
#pragma unroll
      for (int m = 0; m < 4; ++m) {
        const int row = u.pm * 256 + ai * 128 + wr * 64 + m * 16 + fr;
        const float r = rs[row];
#pragma unroll
        for (int bj = 0; bj < 2; ++bj)
#pragma unroll
          for (int n = 0; n < 2; ++n) {
            const int col = u.pn * 256 + bj * 128 + wc * 32 + n * 16 + 4 * fq;
            pg8::f32x4 v = acc[ai][bj][m][n] * r;
            *(pg8::f32x4*)(C + (size_t)row * ldc + col) = v;
          }
        asm volatile("" ::: "memory");
      }
  }
};
struct EpiAccum {
  static constexpr bool PERM = false, AFTER_DRAIN = false;
  float* C; int ldc;
  __device__ __forceinline__ void init(pg8::f32x4 (&acc)[2][2][4][2], const pg8::Unit& u, int wr, int wc, int fr, int fq) const {
#pragma unroll
    for (int ai = 0; ai < 2; ++ai)
#pragma unroll
      for (int m = 0; m < 4; ++m) {
        const int row = u.pm * 256 + ai * 128 + wr * 64 + m * 16 + fr;
#pragma unroll
        for (int bj = 0; bj < 2; ++bj)
#pragma unroll
          for (int n = 0; n < 2; ++n) {
            const int col = u.pn * 256 + bj * 128 + wc * 32 + n * 16 + 4 * fq;
            acc[ai][bj][m][n] = *(const pg8::f32x4*)(C + (size_t)row * ldc + col);
          }
      }
  }
  __device__ __forceinline__ void operator()(const pg8::f32x4 (&acc)[2][2][4][2], const pg8::Unit& u, int wr, int wc, int fr_in, int fq_in) const {
    int fr = fr_in, fq = fq_in; asm volatile("" : "+v"(fr), "+v"(fq));
#pragma unroll
    for (int ai = 0; ai < 2; ++ai)
#pragma unroll
      for (int m = 0; m < 4; ++m) {
        const int row = u.pm * 256 + ai * 128 + wr * 64 + m * 16 + fr;
#pragma unroll
        for (int bj = 0; bj < 2; ++bj)
#pragma unroll
          for (int n = 0; n < 2; ++n) {
            const int col = u.pn * 256 + bj * 128 + wc * 32 + n * 16 + 4 * fq;
            *(pg8::f32x4*)(C + (size_t)row * ldc + col) = acc[ai][bj][m][n];
          }
        asm volatile("" ::: "memory");
      }
  }
};
struct EpiScaleStoreBf16 {
  static constexpr bool PERM = false, AFTER_DRAIN = false;
  bf16_t* C; int ldc; const float* rs;
  __device__ __forceinline__ void init(pg8::f32x4 (&acc)[2][2][4][2], const pg8::Unit&, int, int, int, int) const {
#pragma unroll
    for (int a = 0; a < 2; ++a)
#pragma unroll
      for (int b = 0; b < 2; ++b)
#pragma unroll
        for (int m = 0; m < 4; ++m)
#pragma unroll
          for (int n = 0; n < 2; ++n) acc[a][b][m][n] = (pg8::f32x4){0.f, 0.f, 0.f, 0.f};
  }
  __device__ __forceinline__ void operator()(const pg8::f32x4 (&acc)[2][2][4][2], const pg8::Unit& u, int wr, int wc, int fr_in, int fq_in) const {
    int fr = fr_in, fq = fq_in; asm volatile("" : "+v"(fr), "+v"(fq));
#pragma unroll
    for (int ai = 0; ai < 2; ++ai)
#pragma unroll
      for (int m = 0; m < 4; ++m) {
        const int row = u.pm * 256 + ai * 128 + wr * 64 + m * 16 + fr;
        const float r = rs[row];
#pragma unroll
        for (int bj = 0; bj < 2; ++bj)
#pragma unroll
          for (int n = 0; n < 2; ++n) {
            const int col = u.pn * 256 + bj * 128 + wc * 32 + n * 16 + 4 * fq;
            pg8::f32x4 v = acc[ai][bj][m][n] * r;
            uint2 o; o.x = pk_bf16(v[0], v[1]); o.y = pk_bf16(v[2], v[3]);
            *(uint2*)(C + (size_t)row * ldc + col) = o;
          }
        asm volatile("" ::: "memory");
      }
  }
};
template <class Epi>
__device__ __forceinline__ void run_gemm(unsigned char* lds_raw, const bf16_t* A, const bf16_t* Bt, int M, int N, int K, const Epi& e) {
  pg8::Gemm g{A, Bt, M, N, K, K, K}; pg8::StaticOrder So; So.init(M, N, (int)gridDim.x, (int)blockIdx.x);
  pg8::gemm_phase<Epi, pg8::StaticOrder, true, true>((PG8_LAS unsigned char*)lds_raw, g, So, e);
}

__device__ __forceinline__ void transpose_items(const float* __restrict__ W, int K, int N, const float* __restrict__ g, bf16_t* __restrict__ Wt, int gw, int ngw, int lane) {
  const int nkt = K / 64, nnt = N / 64;
  for (int it = gw; it < nkt * nnt; it += ngw) {
    int kt = it % nkt, ntile = it / nkt;
    int k0 = kt * 64, n = ntile * 64 + lane;
    float v[64];
#pragma unroll
    for (int i = 0; i < 64; ++i) v[i] = W[(size_t)(k0 + i) * N + n] * g[k0 + i];
    bf16_t* dst = Wt + (size_t)n * (K * KS) + k0;
#pragma unroll
    for (int c = 0; c < 8; ++c) {
      bf16_t hi[8], lo[8];
#pragma unroll
      for (int e = 0; e < 8; ++e) { hi[e] = f2bf(v[c * 8 + e]); lo[e] = f2bf(v[c * 8 + e] - bf2f(hi[e])); }
      uint4 ph, pl;
      ph.x = hi[0] | ((unsigned)hi[1] << 16); ph.y = hi[2] | ((unsigned)hi[3] << 16); ph.z = hi[4] | ((unsigned)hi[5] << 16); ph.w = hi[6] | ((unsigned)hi[7] << 16);
      pl.x = lo[0] | ((unsigned)lo[1] << 16); pl.y = lo[2] | ((unsigned)lo[3] << 16); pl.z = lo[4] | ((unsigned)lo[5] << 16); pl.w = lo[6] | ((unsigned)lo[7] << 16);
      *(uint4*)(dst + c * 8) = ph;
      if (PRECISE) { *(uint4*)(dst + K + c * 8) = pl; *(uint4*)(dst + 2 * K + c * 8) = ph; }
    }
  }
}

__device__ __forceinline__ void phase_cvt_rows(const float* __restrict__ src, bf16_t* __restrict__ dst, float* __restrict__ rstd, int gw, int ngw, int lane) {
  for (int t0 = gw; t0 < T; t0 += 2 * ngw) {
    float4 v[2][4];
#pragma unroll
    for (int u = 0; u < 2; ++u) { const int t = (t0 + u * ngw < T) ? t0 + u * ngw : t0;
#pragma unroll
      for (int i = 0; i < 4; ++i) v[u][i] = ((const float4*)(src + (size_t)t * D))[lane + i * 64]; }
#pragma unroll
    for (int u = 0; u < 2; ++u) {
      const int t = t0 + u * ngw;
      if (t < T) {
        float ss = 0.f;
#pragma unroll
        for (int i = 0; i < 4; ++i) {
          const float4 w = v[u][i];
          ss += w.x * w.x + w.y * w.y + w.z * w.z + w.w * w.w;
          uint2 ph; ph.x = pk_bf16(w.x, w.y); ph.y = pk_bf16(w.z, w.w);
          *(uint2*)(dst + (size_t)t * KD + (lane + i * 64) * 4) = ph;
        }
        if (rstd) { ss = wave_sum(ss); if (lane == 0) rstd[t] = rsqrtf(ss / (float)D + EPS); }
      }
    }
  }
}

__device__ __forceinline__ void phase_prologue(const Params& p, int gtid, int ngt, int gw, int ngw, int lane) {
  for (int idx = gtid; idx < S * 40; idx += ngt) {
    int s = idx / 40, i = idx % 40;
    if (i < 8) {
      float inv = powf(500000.0f, -(float)(2 * i) / 16.0f);
      float ang = (float)s * inv;
      p.cosm()[s * 8 + i] = (float)cos((double)ang); p.sinm()[s * 8 + i] = (float)sin((double)ang);
    } else {
      int j = i - 8;
      float inv = powf(10000.0f, -((float)j / 31.0f));
      float ang = (float)s * inv;
      p.cosr()[s * 32 + j] = (float)cos((double)ang); p.sinr()[s * 32 + j] = (float)sin((double)ang);
    }
  }
  { const float4* a = (const float4*)p.in[0]; float4* b = (float4*)p.out;
    for (size_t i = gtid; i < (size_t)T * D / 4; i += ngt) b[i] = a[i]; }
  for (int idx = gtid; idx < NL * 65536; idx += ngt) { const int l2 = idx >> 16, n2 = (idx >> 8) & 255, k2 = idx & 255; p.Wglu_t()[idx] = f2bf(p.in[11][(size_t)l2 * 65536 + k2 * 256 + n2]); }
  for (int l = 0; l < NL; ++l) {
    transpose_items(p.in[2] + (size_t)l * D * INW, D, INW, p.in[1] + l * D, p.Win_t() + (size_t)l * INW * KD, gw, ngw, lane);
    transpose_items(p.in[15] + (size_t)l * D * D, D, D, p.in[14] + l * D, p.Wout_t() + (size_t)l * D * KD, gw, ngw, lane);
    transpose_items(p.in[17] + (size_t)l * D * D, D, D, p.in[16] + l * D, p.Wq_t() + (size_t)l * D * KD, gw, ngw, lane);
  }
}

__device__ __forceinline__ void phase_postproj(const Params& p, int l, int gw, int ngw, int lane) {
  const float* gq = p.in[12] + l * 64; const float* gk = p.in[13] + l * 64;
  for (int w = gw; w < T * 24; w += ngw) {
    int t = w / 24, slot = w % 24, s = t % S;
    float* row = p.proj() + (size_t)t * INW;
    if (slot < 16) {
      int h = slot & 7;
      float* q = row + (slot < 8 ? OFF_QM : OFF_KM) + h * 64;
      const float* g = slot < 8 ? gq : gk;
      float v = q[lane];
      float ss = wave_sum(v * v);
      float u = v * rsqrtf(ss / 64.0f + EPS) * g[lane];
      int partner = lane < 8 ? lane + 8 : lane - 8;
      float pu = __shfl(u, partner & 63);
      float o = u;
      if (lane < 16) {
        int i = lane & 7;
        float c = p.cosm()[s * 8 + i], sn = p.sinm()[s * 8 + i];
        o = lane < 8 ? (u * c - pu * sn) : (u * c + pu * sn);
      }
      q[lane] = o;
    } else {
      int h = (slot - 16) & 3; bool isk = slot >= 20;
      float* q = row + (isk ? OFF_KR : OFF_QR) + h * 64;
      float v = q[lane];
      float pv = __shfl(v, lane ^ 32);
      int i = lane & 31;
      float c = p.cosr()[s * 32 + i], sn = p.sinr()[s * 32 + i];
      float o = lane < 32 ? (v * c - pv * sn) : (v * c + pv * sn);
      if (isk) o *= 0.125f;
      q[lane] = o;
    }
  }
}

__device__ __forceinline__ void phase_kmean(const Params& p, int gtid, int ngt) {
  for (int idx = gtid; idx < NB * 8 * 16 * 64; idx += ngt) {
    int d = idx & 63, j = (idx >> 6) & 15, h = (idx >> 10) & 7, b = idx >> 13;
    const float* q = p.proj() + ((size_t)(b * S + j * 256)) * INW + OFF_KM + h * 64 + d;
    float acc = 0.f;
    for (int i = 0; i < 256; ++i) acc += q[(size_t)i * INW];
    p.kmean()[idx] = acc / 256.0f;
  }
}

__device__ __forceinline__ void s5_unit(const Params& p, int l, int unit, float* red, int lane) {
  const int b = unit >> 4, g = unit & 15, pp = lane;
  const float* lam_re = p.in[3] + l * 1024; const float* lam_im = p.in[4] + l * 1024; const float* log_dt = p.in[5] + l * 16;
  const float* b_re = p.in[6] + l * 16384; const float* b_im = p.in[7] + l * 16384;
  const float* c_re = p.in[8] + l * 16384; const float* c_im = p.in[9] + l * 16384; const float* dskip = p.in[10] + l * 256;
  float lr = lam_re[g * 64 + pp], li = lam_im[g * 64 + pp];
  float dt = expf(log_dt[g]);
  float mag = expf(lr * dt);
  float ar = mag * cosf(li * dt), ai = mag * sinf(li * dt);
  float den = lr * lr + li * li;
  float fr = ((ar - 1.0f) * lr + ai * li) / den;
  float fi = (ai * lr - (ar - 1.0f) * li) / den;
  float bbr[16], bbi[16], cr[16], ci[16];
#pragma unroll
  for (int h = 0; h < 16; ++h) {
    float br = b_re[(g * 64 + pp) * 16 + h], bi = b_im[(g * 64 + pp) * 16 + h];
    bbr[h] = fr * br - fi * bi; bbi[h] = fr * bi + fi * br;
    cr[h] = c_re[(g * 16 + h) * 64 + pp]; ci[h] = c_im[(g * 16 + h) * 64 + pp];
  }
  const int hq = pp >> 2, qq = pp & 3;
  float dsk = dskip[g * 16 + hq];
  float sr = 0.f, si = 0.f;
  for (int t = 0; t < S; ++t) {
    const float* up = p.proj() + (size_t)(b * S + t) * INW + OFF_U + g * 16;
    float u[16];
#pragma unroll
    for (int h4 = 0; h4 < 4; ++h4) { float4 v = *(const float4*)(up + h4 * 4); u[h4 * 4] = v.x; u[h4 * 4 + 1] = v.y; u[h4 * 4 + 2] = v.z; u[h4 * 4 + 3] = v.w; }
    float bur = 0.f, bui = 0.f;
#pragma unroll
    for (int h = 0; h < 16; ++h) { bur = fmaf(u[h], bbr[h], bur); bui = fmaf(u[h], bbi[h], bui); }
    float nr = ar * sr - ai * si + bur, ni = ar * si + ai * sr + bui;
    sr = nr; si = ni;
    LDS_FENCE();
#pragma unroll
    for (int h = 0; h < 16; ++h) red[h * 65 + pp] = sr * cr[h] - si * ci[h];
    LDS_FENCE();
    float acc = 0.f;
#pragma unroll
    for (int i = 0; i < 16; ++i) acc += red[hq * 65 + qq * 16 + i];
    acc += __shfl_xor(acc, 1);
    acc += __shfl_xor(acc, 2);
    if (qq == 0) p.yg()[(size_t)(b * S + t) * 256 + g * 16 + hq] = gelu_tanh(acc + up[hq] * dsk);
  }
}

__device__ __forceinline__ void ret_units(const Params& p, int l, int unit0, float* lds) {
  constexpr int TB = 16;
  int tx_ = threadIdx.x; asm volatile("" : "+v"(tx_));
  const int vb = tx_ >> 8, tid = tx_ & 255;
  float* base_l = lds + vb * (TB * 64 * 3 + TB * 4 * 64);
  float* qs = base_l; float* ks = qs + TB * 64; float* vs = ks + TB * 64; float* red = vs + TB * 64;
  const int unit = unit0 + vb;
  const int b = unit >> 2, h = unit & 3;
  const int e = tid & 63, dg = tid >> 6;
  const float gamma = 1.0f - exp2f(-5.0f - (float)h);
  float St[16];
#pragma unroll
  for (int i = 0; i < 16; ++i) St[i] = 0.f;
  const float* base = p.proj() + (size_t)(b * S) * INW;
  for (int t0 = 0; t0 < S; t0 += TB) {
    __syncthreads();
    for (int i = tid; i < TB * 64; i += 256) {
      int tt = i >> 6, d = i & 63;
      const float* r = base + (size_t)(t0 + tt) * INW;
      qs[tt * 64 + d] = r[OFF_QR + h * 64 + d]; ks[tt * 64 + d] = r[OFF_KR + h * 64 + d]; vs[tt * 64 + d] = r[OFF_VR + h * 64 + d];
    }
    __syncthreads();
    for (int tt = 0; tt < TB; ++tt) {
      float ve = vs[tt * 64 + e], part = 0.f;
#pragma unroll
      for (int i = 0; i < 16; ++i) {
        St[i] = fmaf(gamma, St[i], ks[tt * 64 + dg * 16 + i] * ve);
        part = fmaf(qs[tt * 64 + dg * 16 + i], St[i], part);
      }
      red[(tt * 4 + dg) * 64 + e] = part;
    }
    __syncthreads();
    for (int k = 0; k < 4; ++k) {
      int tt = dg * 4 + k;
      float o = red[(tt * 4 + 0) * 64 + e] + red[(tt * 4 + 1) * 64 + e] + red[(tt * 4 + 2) * 64 + e] + red[(tt * 4 + 3) * 64 + e];
      float ss = wave_sum(o * o);
      float gv = base[(size_t)(t0 + tt) * INW + OFF_GR + h * 64 + e];
      float sl = gv * sigmoidf_(gv);
      int col = 768 + h * 64 + e;
      p.ybuf()[(size_t)(b * S + t0 + tt) * D + col] = sl * o * rsqrtf(ss / 64.0f + EPS);
    }
  }
}

__device__ __forceinline__ void phase_s5glu(const Params& p, int l, float* ys, int gw, int ngw, int lane) {
  const float* wglu = p.in[11] + (size_t)l * 65536;
  for (int t = gw; t < T; t += ngw) {
    float yv[4];
    LDS_FENCE();
#pragma unroll
    for (int i = 0; i < 4; ++i) { yv[i] = p.yg()[(size_t)t * 256 + lane + i * 64]; ys[lane + i * 64] = yv[i]; }
    LDS_FENCE();
    float z[4] = {0.f, 0.f, 0.f, 0.f};
    for (int k = 0; k < 256; ++k) {
      float yk = ys[k];
#pragma unroll
      for (int i = 0; i < 4; ++i) z[i] = fmaf(yk, wglu[k * 256 + lane + i * 64], z[i]);
    }
    float o[4], ss = 0.f;
#pragma unroll
    for (int i = 0; i < 4; ++i) { o[i] = yv[i] * sigmoidf_(z[i]); ss += o[i] * o[i]; }
    ss = wave_sum(ss);
    float r = rsqrtf(ss / 256.0f + EPS);
#pragma unroll
    for (int i = 0; i < 4; ++i) p.ybuf()[(size_t)t * D + lane + i * 64] = o[i] * r;
  }
}


struct S5P { float lr, li, dt, fr, fi; };
__device__ __forceinline__ S5P s5p(const Params& p, int l, int g, int pp) {
  S5P r; r.lr = p.in[3][l * 1024 + g * 64 + pp]; r.li = p.in[4][l * 1024 + g * 64 + pp]; r.dt = expf(p.in[5][l * 16 + g]);
  const float mag = expf(r.lr * r.dt); float sn, cs; sincosf(r.li * r.dt, &sn, &cs);
  const float ar = mag * cs, ai = mag * sn, den = r.lr * r.lr + r.li * r.li;
  r.fr = ((ar - 1.0f) * r.lr + ai * r.li) / den; r.fi = (ai * r.lr - (ar - 1.0f) * r.li) / den;
  return r;
}
__device__ __forceinline__ void s5pow(const S5P& s, int k, float& re, float& im) {
  const float m = expf((float)k * s.lr * s.dt); float sn, cs; sincosf((float)k * s.li * s.dt, &sn, &cs); re = m * cs; im = m * sn;
}
__device__ __forceinline__ void phase_s5_prep(const Params& p, int l, int gtid, int ngt) {
  const float* b_re = p.in[6] + l * 16384; const float* b_im = p.in[7] + l * 16384;
  const float* c_re = p.in[8] + l * 16384; const float* c_im = p.in[9] + l * 16384;
  bf16_t* Wy = p.S5Wy(); bf16_t* Wz = p.S5Wz();
  for (int it = gtid; it < 16 * 32 * 256; it += ngt) {
    const int hp = it & 15, h = (it >> 4) & 15, d = (it >> 8) & 31, g = it >> 13;
    float acc = 0.f;
    for (int pp = 0; pp < 64; ++pp) {
      const S5P s = s5p(p, l, g, pp);
      float pr, pi; s5pow(s, d, pr, pi);
      const float br = b_re[(g * 64 + pp) * 16 + hp], bi = b_im[(g * 64 + pp) * 16 + hp];
      const float bbr = s.fr * br - s.fi * bi, bbi = s.fr * bi + s.fi * br;
      const float tr = pr * bbr - pi * bbi, ti = pr * bbi + pi * bbr;
      acc += c_re[(g * 16 + h) * 64 + pp] * tr - c_im[(g * 16 + h) * 64 + pp] * ti;
    }
    const bf16_t v = f2bf(acc);
    for (int jp = 0; jp + d < 32; ++jp) {
      const int j = jp + d;
      Wy[((size_t)g * 512 + j * 16 + h) * 640 + jp * 16 + hp] = v;
      if (d > 0) Wy[((size_t)g * 512 + jp * 16 + h) * 640 + j * 16 + hp] = 0;
    }
  }
  for (int it = gtid; it < 16 * 32 * 16 * 64; it += ngt) {
    const int pp = it & 63, h = (it >> 6) & 15, j = (it >> 10) & 31, g = it >> 15;
    const S5P s = s5p(p, l, g, pp);
    float pr, pi; s5pow(s, j + 1, pr, pi);
    const float cr = c_re[(g * 16 + h) * 64 + pp], ci = c_im[(g * 16 + h) * 64 + pp];
    const unsigned w = pk_bf16(cr * pr - ci * pi, -(cr * pi + ci * pr));
    *(unsigned*)(Wy + ((size_t)g * 512 + j * 16 + h) * 640 + 512 + 2 * pp) = w;
  }
  for (int it = gtid; it < 16 * 64 * 32; it += ngt) {
    const int j = it & 31, pp = (it >> 5) & 63, g = it >> 11;
    const S5P s = s5p(p, l, g, pp);
    float pr, pi; s5pow(s, 31 - j, pr, pi);
    for (int hp = 0; hp < 16; ++hp) {
      const float br = b_re[(g * 64 + pp) * 16 + hp], bi = b_im[(g * 64 + pp) * 16 + hp];
      const float bbr = s.fr * br - s.fi * bi, bbi = s.fr * bi + s.fi * br;
      Wz[((size_t)g * 256 + 2 * pp) * 512 + j * 16 + hp] = f2bf(pr * bbr - pi * bbi);
      Wz[((size_t)g * 256 + 2 * pp + 1) * 512 + j * 16 + hp] = f2bf(pr * bbi + pi * bbr);
    }
  }
  for (int it = gtid; it < 16 * 64; it += ngt) {
    const S5P s = s5p(p, l, it >> 6, it & 63);
    float pr, pi; s5pow(s, 32, pr, pi);
    p.S5a32()[it * 2] = pr; p.S5a32()[it * 2 + 1] = pi;
  }
}
__device__ __forceinline__ void phase_pack_u(const Params& p, int gtid, int ngt) {
  for (int idx = gtid; idx < T * 32; idx += ngt) {
    const int t = idx >> 5, i = idx & 31, g = i >> 1;
    *(uint4*)(p.S5A() + ((size_t)g * 1024 + (t >> 5)) * 640 + (t & 31) * 16 + (i & 1) * 8) = *(const uint4*)(p.projb() + (size_t)t * INW + i * 8);
  }
}
__device__ __forceinline__ void phase_s5_scan(const Params& p, int gtid, int ngt) {
  for (int it = gtid; it < NB * 16 * 64; it += ngt) {
    const int pp = it & 63, g = (it >> 6) & 15, b = it >> 10;
    const float er = p.S5a32()[(g * 64 + pp) * 2], ei = p.S5a32()[(g * 64 + pp) * 2 + 1];
    float sr = 0.f, si = 0.f;
#pragma unroll 1
    for (int c0 = 0; c0 < 128; c0 += 16) {
      float2 z[16];
#pragma unroll
      for (int k = 0; k < 16; ++k) z[k] = *(const float2*)(p.S5Z() + ((size_t)g * 1024 + b * 128 + c0 + k) * 128 + 2 * pp);
#pragma unroll
      for (int k = 0; k < 16; ++k) {
        const size_t ch = (size_t)g * 1024 + b * 128 + c0 + k;
        *(unsigned*)(p.S5A() + ch * 640 + 512 + 2 * pp) = pk_bf16(sr, si);
        const float nr = er * sr - ei * si + z[k].x, ni = er * si + ei * sr + z[k].y;
        sr = nr; si = ni;
      }
    }
  }
}
#define EPI_ZERO_INIT \
  __device__ __forceinline__ void init(pg8::f32x4 (&acc)[2][2][4][2], const pg8::Unit&, int, int, int, int) const { \
    _Pragma("unroll") for (int a = 0; a < 2; ++a) _Pragma("unroll") for (int b = 0; b < 2; ++b) \
    _Pragma("unroll") for (int m = 0; m < 4; ++m) _Pragma("unroll") for (int n = 0; n < 2; ++n) acc[a][b][m][n] = (pg8::f32x4){0.f, 0.f, 0.f, 0.f}; }
struct EpiS5Z {
  static constexpr bool PERM = false, AFTER_DRAIN = false;
  float* Z;
  EPI_ZERO_INIT
  __device__ __forceinline__ void operator()(const pg8::f32x4 (&acc)[2][2][4][2], const pg8::Unit& u, int wr, int wc, int fr_in, int fq_in) const {
    int fr = fr_in, fq = fq_in; asm volatile("" : "+v"(fr), "+v"(fq));
    const int g = u.pm >> 2;
#pragma unroll
    for (int ai = 0; ai < 2; ++ai)
#pragma unroll
      for (int m = 0; m < 4; ++m) {
        const int chunk = (u.pm & 3) * 256 + ai * 128 + wr * 64 + m * 16 + fr;
#pragma unroll
        for (int n = 0; n < 2; ++n) *(pg8::f32x4*)(Z + ((size_t)g * 1024 + chunk) * 128 + wc * 32 + n * 16 + 4 * fq) = acc[ai][0][m][n];
      }
  }
};
struct EpiS5Y {
  static constexpr bool PERM = false, AFTER_DRAIN = false;
  bf16_t* ygb; const bf16_t* A; const float* dsk;
  EPI_ZERO_INIT
  __device__ __forceinline__ void operator()(const pg8::f32x4 (&acc)[2][2][4][2], const pg8::Unit& u, int wr, int wc, int fr_in, int fq_in) const {
    int fr = fr_in, fq = fq_in; asm volatile("" : "+v"(fr), "+v"(fq));
    const int g = u.pm >> 2;
#pragma unroll
    for (int ai = 0; ai < 2; ++ai)
#pragma unroll
      for (int m = 0; m < 4; ++m) {
        const int chunk = (u.pm & 3) * 256 + ai * 128 + wr * 64 + m * 16 + fr;
#pragma unroll
        for (int bj = 0; bj < 2; ++bj)
#pragma unroll
          for (int n = 0; n < 2; ++n) {
            const int col = (u.pn & 1) * 256 + bj * 128 + wc * 32 + n * 16 + 4 * fq, j = col >> 4, h = col & 15;
            const uint2 uu = *(const uint2*)(A + ((size_t)g * 1024 + chunk) * 640 + col);
            const pg8::f32x4 dv = *(const pg8::f32x4*)(dsk + g * 16 + h);
            const pg8::f32x4 v = acc[ai][bj][m][n];
            const float y0 = fast_gelu(v[0] + dv[0] * __uint_as_float(uu.x << 16)), y1 = fast_gelu(v[1] + dv[1] * __uint_as_float(uu.x & 0xffff0000u));
            const float y2 = fast_gelu(v[2] + dv[2] * __uint_as_float(uu.y << 16)), y3 = fast_gelu(v[3] + dv[3] * __uint_as_float(uu.y & 0xffff0000u));
            uint2 o; o.x = pk_bf16(y0, y1); o.y = pk_bf16(y2, y3);
            *(uint2*)(ygb + ((size_t)chunk * 32 + j) * 256 + g * 16 + h) = o;
          }
        asm volatile("" ::: "memory");
      }
  }
};
struct EpiGlu {
  static constexpr bool PERM = false, AFTER_DRAIN = false;
  bf16_t* yb; const bf16_t* ygb; float* scr;
  EPI_ZERO_INIT
  __device__ __forceinline__ void operator()(const pg8::f32x4 (&acc_)[2][2][4][2], const pg8::Unit& u, int wr, int wc, int fr_in, int fq_in) const {
    int fr = fr_in, fq = fq_in; asm volatile("" : "+v"(fr), "+v"(fq));
    pg8::f32x4 (&acc)[2][2][4][2] = const_cast<pg8::f32x4 (&)[2][2][4][2]>(acc_);
#pragma unroll
    for (int ai = 0; ai < 2; ++ai)
#pragma unroll
      for (int m = 0; m < 4; ++m) {
        const int rl = ai * 128 + wr * 64 + m * 16 + fr, row = u.pm * 256 + rl;
        float ss = 0.f;
#pragma unroll
        for (int bj = 0; bj < 2; ++bj)
#pragma unroll
          for (int n = 0; n < 2; ++n) {
            const int col = bj * 128 + wc * 32 + n * 16 + 4 * fq;
            const uint2 yy = *(const uint2*)(ygb + (size_t)row * 256 + col);
            const pg8::f32x4 z = acc[ai][bj][m][n];
            pg8::f32x4 r;
            r[0] = __uint_as_float(yy.x << 16) * fast_sigmoid(z[0]); r[1] = __uint_as_float(yy.x & 0xffff0000u) * fast_sigmoid(z[1]);
            r[2] = __uint_as_float(yy.y << 16) * fast_sigmoid(z[2]); r[3] = __uint_as_float(yy.y & 0xffff0000u) * fast_sigmoid(z[3]);
            acc[ai][bj][m][n] = r;
            ss += r[0] * r[0] + r[1] * r[1] + r[2] * r[2] + r[3] * r[3];
          }
        ss += __shfl_xor(ss, 16); ss += __shfl_xor(ss, 32);
        if (fq == 0) scr[rl * 4 + wc] = ss;
        asm volatile("" ::: "memory");
      }
    asm volatile("s_waitcnt lgkmcnt(0)" ::: "memory"); __builtin_amdgcn_s_barrier(); asm volatile("" ::: "memory");
#pragma unroll
    for (int ai = 0; ai < 2; ++ai)
#pragma unroll
      for (int m = 0; m < 4; ++m) {
        const int rl = ai * 128 + wr * 64 + m * 16 + fr, row = u.pm * 256 + rl;
        const pg8::f32x4 s4 = *(const pg8::f32x4*)(scr + rl * 4);
        const float r = rsqrtf((s4[0] + s4[1] + s4[2] + s4[3]) / 256.0f + EPS);
#pragma unroll
        for (int bj = 0; bj < 2; ++bj)
#pragma unroll
          for (int n = 0; n < 2; ++n) { const pg8::f32x4 v = acc[ai][bj][m][n] * r; *(uint2*)(yb + (size_t)row * KD + bj * 128 + wc * 32 + n * 16 + 4 * fq) = make_uint2(pk_bf16(v[0], v[1]), pk_bf16(v[2], v[3])); }
        asm volatile("" ::: "memory");
      }
    asm volatile("s_waitcnt lgkmcnt(0)" ::: "memory"); __builtin_amdgcn_s_barrier(); asm volatile("" ::: "memory");
  }
};

constexpr float QSCALE = 0.125f * 1.4426950408889634f;

__device__ __forceinline__ void phase_pack_moba(const Params& p, int gtid, int ngt) {
  for (int idx = gtid; idx < T * 128; idx += ngt) {
    const int t = idx >> 7, c = idx & 127, isk = c >> 6, cc = c & 63, h = cc >> 3, ch = cc & 7;
    const float* src = p.proj() + (size_t)t * INW + (isk ? OFF_KM : OFF_QM) + h * 64 + ch * 8;
    float4 a = *(const float4*)src, b4 = *(const float4*)(src + 4);
    const float sc = isk ? 1.0f : QSCALE;
    uint4 o; o.x = pk_bf16(a.x * sc, a.y * sc); o.y = pk_bf16(a.z * sc, a.w * sc); o.z = pk_bf16(b4.x * sc, b4.y * sc); o.w = pk_bf16(b4.z * sc, b4.w * sc);
    const int b = t / S, s = t % S;
    bf16_t* dst = isk ? p.Km() + ((((size_t)(b * 8 + h) * (S / 32) + (s >> 5)) * 8 + ch) * 32 + (s & 31)) * 8
                      : p.Qm() + ((size_t)(b * 8 + h) * S + s) * 64 + ch * 8;
    *(uint4*)dst = o;
  }
  for (int idx = gtid; idx < NB * 8 * (S / 32) * 256; idx += ngt) {
    const int ln = idx & 63, ks = (idx >> 6) & 1, mb = (idx >> 7) & 1, tile = (idx >> 8) % (S / 32), bh = idx / (256 * (S / 32));
    const int b = bh >> 3, h = bh & 7, hh = ln >> 5, delta = mb * 32 + (ln & 31);
    float v[8];
#pragma unroll
    for (int j = 0; j < 8; ++j) {
      const int kappa = 16 * ks + 8 * (j >> 2) + 4 * hh + (j & 3), s = tile * 32 + kappa;
      v[j] = p.proj()[(size_t)(b * S + s) * INW + OFF_VM + h * 64 + delta];
    }
    uint4 o; o.x = pk_bf16(v[0], v[1]); o.y = pk_bf16(v[2], v[3]); o.z = pk_bf16(v[4], v[5]); o.w = pk_bf16(v[6], v[7]);
    *(uint4*)(p.Vm() + (size_t)idx * 8) = o;
  }
}

__device__ __forceinline__ void phase_moba2(const Params& p, int l, unsigned char* lds, int bid, int G) {
  constexpr int OLD = 260;
  bf16_t* Qs = (bf16_t*)lds;
  float* Oaccf = (float*)(lds + 32768);
  float* laccf = (float*)(lds + 32768 + 64 * OLD * 4);
  float* kms = laccf + 256;
  float* gat = kms + 1024;
  unsigned char* lists = (unsigned char*)(gat + 4096);
  int* cnt = (int*)(lists + 4096);
  int* items = cnt + 16;
  int* ctr = items + 160;
  unsigned* selp = (unsigned*)(ctr + 4);
  float* bq = (float*)(selp + 256);
  int* Oacc = (int*)Oaccf; int* lacc = (int*)laccf;
  float kmax = 0.f;
  { const float* gk = p.in[13] + l * 64;
    for (int d = 0; d < 64; ++d) kmax = fmaxf(kmax, fabsf(gk[d]));
    kmax *= 8.0f * 1.01f; }
  for (int u = bid; u < NB * 8 * 16; u += G) {
    const int qblk = 15 - (u >> 6), bh = u & 63, b = bh >> 3, h = bh & 7;
    int tid = threadIdx.x; asm volatile("" : "+v"(tid));
    const int lane = tid & 63, wv = tid >> 6, n = lane & 31, hh = lane >> 5;
    __syncthreads();
    { const uint4* src = (const uint4*)(p.Qm() + ((size_t)bh * S + qblk * 256) * 64);
      uint4* dst = (uint4*)Qs;
      for (int i = tid; i < 256 * 64 * 2 / 16; i += NTHR) dst[i] = src[i]; }
    for (int i = tid; i < qblk * 64; i += NTHR) kms[i] = p.kmean()[(size_t)bh * 1024 + i];
    for (int i = tid; i < 64 * OLD; i += NTHR) Oacc[i] = 0;
    if (tid < 256) lacc[tid] = 0;
    if (tid < 16) cnt[tid] = 0;
    __syncthreads();
    { const int q = tid & 255, par = tid >> 8;
      float qv[64];
#pragma unroll
      for (int c = 0; c < 8; ++c) {
        uint4 w = *(const uint4*)(Qs + q * 64 + c * 8);
        qv[c * 8 + 0] = __uint_as_float(w.x << 16); qv[c * 8 + 1] = __uint_as_float(w.x & 0xffff0000u);
        qv[c * 8 + 2] = __uint_as_float(w.y << 16); qv[c * 8 + 3] = __uint_as_float(w.y & 0xffff0000u);
        qv[c * 8 + 4] = __uint_as_float(w.z << 16); qv[c * 8 + 5] = __uint_as_float(w.z & 0xffff0000u);
        qv[c * 8 + 6] = __uint_as_float(w.w << 16); qv[c * 8 + 7] = __uint_as_float(w.w & 0xffff0000u);
      }
      if (par == 0) { float qq = 0.f;
#pragma unroll
        for (int d = 0; d < 64; ++d) qq = fmaf(qv[d], qv[d], qq);
        bq[q] = sqrtf(qq) * kmax; }
      for (int j = par; j < qblk; j += 2) {
        float g = 0.f;
#pragma unroll
        for (int d = 0; d < 64; ++d) g = fmaf(qv[d], kms[j * 64 + d], g);
        gat[q * 16 + j] = g;
      }
    }
    __syncthreads();
    if (tid < 256) {
      float b0 = -INFINITY, b1 = -INFINITY, b2 = -INFINITY; int i0 = 0, i1 = 0, i2 = 0;
      for (int j = 0; j < qblk; ++j) {
        float g = gat[tid * 16 + j];
        if (g > b0) { b2 = b1; i2 = i1; b1 = b0; i1 = i0; b0 = g; i0 = j; }
        else if (g > b1) { b2 = b1; i2 = i1; b1 = g; i1 = j; }
        else if (g > b2) { b2 = g; i2 = j; }
      }
      const int nsel = qblk < 3 ? qblk : 3;
      selp[tid] = (unsigned)i0 | ((unsigned)i1 << 4) | ((unsigned)i2 << 8) | ((unsigned)nsel << 12);
    }
    __syncthreads();
    for (int j = wv; j < qblk; j += 8) {
      int base = 0;
      for (int c = 0; c < 4; ++c) {
        const int q = c * 64 + lane;
        const unsigned sp = selp[q];
        const int ns = sp >> 12;
        const bool f = (ns > 0 && (int)(sp & 15) == j) || (ns > 1 && (int)((sp >> 4) & 15) == j) || (ns > 2 && (int)((sp >> 8) & 15) == j);
        const unsigned long long bal = __ballot(f);
        const int pos = base + __popcll(bal & ((1ull << lane) - 1ull));
        if (f) lists[j * 256 + pos] = (unsigned char)q;
        base += __popcll(bal);
      }
      if (lane == 0) cnt[j] = base;
    }
    __syncthreads();
    if (tid == 0) {
      int ni = 0;
#pragma unroll 1
      for (int g = 7; g >= 0; --g) items[ni++] = (16 << 8) | g;
      for (int j = 0; j < qblk; ++j) { const int ng = (cnt[j] + 31) >> 5; for (int g = 0; g < ng; ++g) items[ni++] = (j << 8) | g; }
      ctr[0] = ni; ctr[1] = 0;
    }
    __syncthreads();
    const int nitems = ctr[0];
    for (;;) {
      int it = 0;
      if (lane == 0) it = atomicAdd(&ctr[1], 1);
      it = __builtin_amdgcn_readfirstlane(it);
      if (it >= nitems) break;
      const int item = items[it];
      const int j = item >> 8, g = item & 255;
      const bool own = (j == 16);
      const int kb = own ? qblk : j;
      const int ntile = own ? (g + 1) : 8;
      int qi; bool valid;
      if (own) { qi = g * 32 + n; valid = true; }
      else { const int pos = g * 32 + n; valid = pos < cnt[j]; qi = lists[j * 256 + (valid ? pos : 0)]; }
      const bf16_t* kt0 = p.Km() + ((size_t)bh * (S / 32) + kb * 8) * 2048 + lane * 8;
      const bf16_t* vt0 = p.Vm() + ((size_t)bh * (S / 32) + kb * 8) * 2048 + lane * 8;
      f32x16 O0, O1;
#pragma unroll
      for (int r = 0; r < 16; ++r) { O0[r] = 0.f; O1[r] = 0.f; }
      float lsum = 0.f;
      const float nbq = -bq[qi];
      bf16x8 kf[3][4], vf[3][4];
#define MOBA_LOAD(KT_, BUF_) { _Pragma("unroll") for (int s = 0; s < 4; ++s) { kf[BUF_][s] = *(const bf16x8*)(kt0 + (size_t)(KT_) * 2048 + s * 512); vf[BUF_][s] = *(const bf16x8*)(vt0 + (size_t)(KT_) * 2048 + s * 512); } }
#define MOBA_STEP(KT_, BUF_)                                                                                                           \
      if ((KT_) < ntile) {                                                                                                               \
        if ((KT_) + 2 < ntile) MOBA_LOAD((KT_) + 2, ((BUF_) + 2) % 3)                                                                     \
        f32x16 X;                                                                                                                         \
        _Pragma("unroll") for (int r = 0; r < 16; ++r) X[r] = nbq;                                                                        \
        _Pragma("unroll") for (int s = 0; s < 4; ++s) X = __builtin_amdgcn_mfma_f32_32x32x16_bf16(kf[BUF_][s], *(const bf16x8*)(Qs + qi * 64 + (2 * s + hh) * 8), X, 0, 0, 0);     \
        const bool diag = own && ((KT_) == g);                                                                                            \
        unsigned pw[8];                                                                                                                   \
        _Pragma("unroll") for (int r = 0; r < 16; r += 2) {                                                                               \
          float e0 = __builtin_amdgcn_exp2f(X[r]), e1 = __builtin_amdgcn_exp2f(X[r + 1]);                                                 \
          if (diag) {                                                                                                                     \
            const int k0 = (r & 3) + 8 * (r >> 2) + 4 * hh, k1 = ((r + 1) & 3) + 8 * ((r + 1) >> 2) + 4 * hh;                             \
            e0 = (k0 <= n) ? e0 : 0.f; e1 = (k1 <= n) ? e1 : 0.f;                                                                         \
          }                                                                                                                               \
          lsum += e0 + e1;                                                                                                                \
          pw[r >> 1] = pk_bf16(e0, e1);                                                                                                   \
        }                                                                                                                                 \
        bf16x8 pf0, pf1;                                                                                                                  \
        { uint4 t0 = make_uint4(pw[0], pw[1], pw[2], pw[3]), t1 = make_uint4(pw[4], pw[5], pw[6], pw[7]);                                 \
          pf0 = *(bf16x8*)&t0; pf1 = *(bf16x8*)&t1; }                                                                                     \
        O0 = __builtin_amdgcn_mfma_f32_32x32x16_bf16(vf[BUF_][0], pf0, O0, 0, 0, 0);                                                      \
        O0 = __builtin_amdgcn_mfma_f32_32x32x16_bf16(vf[BUF_][1], pf1, O0, 0, 0, 0);                                                      \
        O1 = __builtin_amdgcn_mfma_f32_32x32x16_bf16(vf[BUF_][2], pf0, O1, 0, 0, 0);                                                      \
        O1 = __builtin_amdgcn_mfma_f32_32x32x16_bf16(vf[BUF_][3], pf1, O1, 0, 0, 0);                                                      \
      }
      MOBA_LOAD(0, 0)
      if (ntile > 1) MOBA_LOAD(1, 1)
#pragma unroll 1
      for (int kt3 = 0; kt3 < ntile; kt3 += 3) {
        MOBA_STEP(kt3, 0) MOBA_STEP(kt3 + 1, 1) MOBA_STEP(kt3 + 2, 2)
      }
#undef MOBA_STEP
#undef MOBA_LOAD
      lsum += __shfl_xor(lsum, 32);
      if (valid) {
        if (hh == 0) atomicAdd(&lacc[qi], __float2int_rn(lsum * 1048576.0f));
#pragma unroll
        for (int r = 0; r < 16; ++r) {
          const int dim = (r & 3) + 8 * (r >> 2) + 4 * hh;
          atomicAdd(&Oacc[dim * OLD + qi], __float2int_rn(O0[r] * 1048576.0f));
          atomicAdd(&Oacc[(dim + 32) * OLD + qi], __float2int_rn(O1[r] * 1048576.0f));
        }
      }
    }
    __syncthreads();
    { const int q = tid >> 1, half = tid & 1;
      const float inv = 1.0f / (float)lacc[q];
      float o[32], ss = 0.f;
#pragma unroll
      for (int d = 0; d < 32; ++d) { o[d] = (float)Oacc[(half * 32 + d) * OLD + q] * inv; ss += o[d] * o[d]; }
      ss += __shfl_xor(ss, 1);
      const float r = rsqrtf(ss / 64.0f + EPS);
      bf16_t* dst = p.xb() + (size_t)(b * S + qblk * 256 + q) * KD + 256 + h * 64 + half * 32;
#pragma unroll
      for (int d = 0; d < 32; d += 8) *(uint4*)(dst + d) = make_uint4(pk_bf16(o[d] * r, o[d + 1] * r), pk_bf16(o[d + 2] * r, o[d + 3] * r), pk_bf16(o[d + 4] * r, o[d + 5] * r), pk_bf16(o[d + 6] * r, o[d + 7] * r));
    }
  }
}


__device__ __forceinline__ float ret_log2g(int h) { return log2f(1.0f - exp2f(-5.0f - (float)h)); }
__device__ __forceinline__ void phase_pack_ret(const Params& p, int gtid, int ngt) {
  for (int idx = gtid; idx < T * 64; idx += ngt) {
    const int t = idx >> 6, c = idx & 63, isk = c >> 5, cc = c & 31, h = cc >> 3, ch = cc & 7;
    const int b = t / S, s = t % S, i = s & 127;
    const float* src = p.proj() + (size_t)t * INW + (isk ? OFF_KR : OFF_QR) + h * 64 + ch * 8;
    float4 a = *(const float4*)src, b4 = *(const float4*)(src + 4);
    const float sc = exp2f((isk ? -(float)i : (float)i) * ret_log2g(h));
    uint4 o; o.x = pk_bf16(a.x * sc, a.y * sc); o.y = pk_bf16(a.z * sc, a.w * sc); o.z = pk_bf16(b4.x * sc, b4.y * sc); o.w = pk_bf16(b4.z * sc, b4.w * sc);
    const int bh = b * 4 + h;
    bf16_t* dst = isk ? p.Kr() + ((((size_t)bh * (S / 32) + (s >> 5)) * 8 + ch) * 32 + (s & 31)) * 8
                      : p.Qr() + ((size_t)bh * S + s) * 64 + ch * 8;
    *(uint4*)dst = o;
  }
  for (int idx = gtid; idx < 2 * NB * 4 * (S / 32) * 256; idx += ngt) {
    const int ln = idx & 63, ks = (idx >> 6) & 1, blk = (idx >> 7) & 1, tile = (idx >> 8) % (S / 32), rest = idx / (256 * (S / 32)), bh = rest % (NB * 4), which = rest / (NB * 4);
    const int b = bh >> 2, h = bh & 3, hh = ln >> 5, delta = blk * 32 + (ln & 31);
    const float l2g = ret_log2g(h);
    float v[8];
#pragma unroll
    for (int j = 0; j < 8; ++j) {
      const int kappa = 16 * ks + 8 * (j >> 2) + 4 * hh + (j & 3), s = tile * 32 + kappa;
      float x = p.proj()[(size_t)(b * S + s) * INW + (which ? OFF_KR : OFF_VR) + h * 64 + delta];
      if (which) x *= exp2f(-(float)(s & 127) * l2g);
      v[j] = x;
    }
    uint4 o; o.x = pk_bf16(v[0], v[1]); o.y = pk_bf16(v[2], v[3]); o.z = pk_bf16(v[4], v[5]); o.w = pk_bf16(v[6], v[7]);
    *(uint4*)((which ? p.Krv() : p.Vr()) + ((size_t)(idx % (NB * 4 * (S / 32) * 256))) * 8) = o;
  }
}
__device__ __forceinline__ void phase_ret_kv(const Params& p, int gw, int ngw, int lane) {
  const int n = lane & 31, hh = lane >> 5;
  for (int w = gw; w < NB * 4 * 32; w += ngw) {
    const int bh = w >> 5, cn = w & 31;
    const bf16_t* vt = p.Vr() + ((size_t)bh * (S / 32) + cn * 4) * 2048 + lane * 8;
    const bf16_t* kt = p.Krv() + ((size_t)bh * (S / 32) + cn * 4) * 2048 + lane * 8;
    f32x16 acc[2][2];
#pragma unroll
    for (int a = 0; a < 2; ++a)
#pragma unroll
      for (int b2 = 0; b2 < 2; ++b2)
#pragma unroll
        for (int r = 0; r < 16; ++r) acc[a][b2][r] = 0.f;
#pragma unroll 1
    for (int tl = 0; tl < 4; ++tl)
#pragma unroll
      for (int ks = 0; ks < 2; ++ks) {
        bf16x8 vf[2], kf[2];
#pragma unroll
        for (int x = 0; x < 2; ++x) { vf[x] = *(const bf16x8*)(vt + tl * 2048 + (x * 2 + ks) * 512); kf[x] = *(const bf16x8*)(kt + tl * 2048 + (x * 2 + ks) * 512); }
#pragma unroll
        for (int mb = 0; mb < 2; ++mb)
#pragma unroll
          for (int nb = 0; nb < 2; ++nb) acc[mb][nb] = __builtin_amdgcn_mfma_f32_32x32x16_bf16(vf[mb], kf[nb], acc[mb][nb], 0, 0, 0);
      }
    float* dst = p.KVr() + ((size_t)bh * 32 + cn) * 4096;
#pragma unroll
    for (int mb = 0; mb < 2; ++mb)
#pragma unroll
      for (int nb = 0; nb < 2; ++nb)
#pragma unroll
        for (int r = 0; r < 16; ++r) dst[(mb * 32 + (r & 3) + 8 * (r >> 2) + 4 * hh) * 64 + nb * 32 + n] = acc[mb][nb][r];
  }
}
__device__ __forceinline__ void phase_ret_scan(const Params& p, int gtid, int ngt) {
  for (int it = gtid; it < NB * 4 * 4096; it += ngt) {
    const int e = it & 4095, bh = it >> 12, h = bh & 3;
    const float l2g = ret_log2g(h), g1 = exp2f(l2g), g127 = exp2f(127.0f * l2g), g128 = exp2f(128.0f * l2g);
    float R = 0.f; float kv[32];
#pragma unroll
    for (int cn = 0; cn < 32; ++cn) kv[cn] = p.KVr()[((size_t)bh * 32 + cn) * 4096 + e];
#pragma unroll
    for (int cn = 0; cn < 32; ++cn) {
      p.Rb()[((size_t)bh * 32 + cn) * 4096 + e] = f2bf(g1 * R);
      R = g128 * R + g127 * kv[cn];
    }
  }
}
__device__ __forceinline__ void phase_ret_out(const Params& p, int gw, int ngw, int lane) {
  const int n = lane & 31, hh = lane >> 5;
  for (int w = gw; w < NB * 4 * 32 * 4; w += ngw) {
    const int qg = 3 - (w & 3), cn = (w >> 2) & 31, bh = w >> 7, b = bh >> 2, h = bh & 3;
    const int s0 = cn * 128 + qg * 32;
    bf16x8 qf[4];
#pragma unroll
    for (int s = 0; s < 4; ++s) qf[s] = *(const bf16x8*)(p.Qr() + ((size_t)bh * S + s0 + n) * 64 + (2 * s + hh) * 8);
    f32x16 O0, O1;
#pragma unroll
    for (int r = 0; r < 16; ++r) { O0[r] = 0.f; O1[r] = 0.f; }
    { const bf16_t* rb = p.Rb() + ((size_t)bh * 32 + cn) * 4096 + (size_t)n * 64 + hh * 8;
#pragma unroll
      for (int s = 0; s < 4; ++s) {
        const bf16x8 r0 = *(const bf16x8*)(rb + s * 16), r1 = *(const bf16x8*)(rb + 32 * 64 + s * 16);
        O0 = __builtin_amdgcn_mfma_f32_32x32x16_bf16(r0, qf[s], O0, 0, 0, 0);
        O1 = __builtin_amdgcn_mfma_f32_32x32x16_bf16(r1, qf[s], O1, 0, 0, 0);
      } }
    const bf16_t* kt0 = p.Kr() + ((size_t)bh * (S / 32) + cn * 4) * 2048 + lane * 8;
    const bf16_t* vt0 = p.Vr() + ((size_t)bh * (S / 32) + cn * 4) * 2048 + lane * 8;
    for (int kt = 0; kt <= qg; ++kt) {
      bf16x8 kf[4], vf[4];
#pragma unroll
      for (int s = 0; s < 4; ++s) { kf[s] = *(const bf16x8*)(kt0 + (size_t)kt * 2048 + s * 512); vf[s] = *(const bf16x8*)(vt0 + (size_t)kt * 2048 + s * 512); }
      f32x16 X;
#pragma unroll
      for (int r = 0; r < 16; ++r) X[r] = 0.f;
#pragma unroll
      for (int s = 0; s < 4; ++s) X = __builtin_amdgcn_mfma_f32_32x32x16_bf16(kf[s], qf[s], X, 0, 0, 0);
      const bool diag = (kt == qg);
      unsigned pw[8];
#pragma unroll
      for (int r = 0; r < 16; r += 2) {
        float e0 = X[r], e1 = X[r + 1];
        if (diag) {
          const int k0 = (r & 3) + 8 * (r >> 2) + 4 * hh, k1 = ((r + 1) & 3) + 8 * ((r + 1) >> 2) + 4 * hh;
          e0 = (k0 <= n) ? e0 : 0.f; e1 = (k1 <= n) ? e1 : 0.f;
        }
        pw[r >> 1] = pk_bf16(e0, e1);
      }
      bf16x8 pf0, pf1;
      { uint4 t0 = make_uint4(pw[0], pw[1], pw[2], pw[3]), t1 = make_uint4(pw[4], pw[5], pw[6], pw[7]);
        pf0 = *(bf16x8*)&t0; pf1 = *(bf16x8*)&t1; }
      O0 = __builtin_amdgcn_mfma_f32_32x32x16_bf16(vf[0], pf0, O0, 0, 0, 0);
      O0 = __builtin_amdgcn_mfma_f32_32x32x16_bf16(vf[1], pf1, O0, 0, 0, 0);
      O1 = __builtin_amdgcn_mfma_f32_32x32x16_bf16(vf[2], pf0, O1, 0, 0, 0);
      O1 = __builtin_amdgcn_mfma_f32_32x32x16_bf16(vf[3], pf1, O1, 0, 0, 0);
    }
    float ss = 0.f;
#pragma unroll
    for (int r = 0; r < 16; ++r) ss += O0[r] * O0[r] + O1[r] * O1[r];
    ss += __shfl_xor(ss, 32);
    const float rn = rsqrtf(ss / 64.0f + EPS);
    const size_t t = (size_t)b * S + s0 + n;
    const bf16_t* gp = p.projb() + t * INW + OFF_GR + h * 64;
    bf16_t* yo = p.xb() + t * KD + 768 + h * 64;
#pragma unroll
    for (int q4 = 0; q4 < 4; ++q4) {
#pragma unroll
      for (int mb = 0; mb < 2; ++mb) {
        const int d0 = mb * 32 + 8 * q4 + 4 * hh;
        const uint2 gw2 = *(const uint2*)(gp + d0); const float4 g = make_float4(__uint_as_float(gw2.x << 16), __uint_as_float(gw2.x & 0xffff0000u), __uint_as_float(gw2.y << 16), __uint_as_float(gw2.y & 0xffff0000u));
        float4 o;
        const f32x16& Oa = mb ? O1 : O0;
        o.x = Oa[q4 * 4 + 0] * rn * g.x * fast_sigmoid(g.x); o.y = Oa[q4 * 4 + 1] * rn * g.y * fast_sigmoid(g.y);
        o.z = Oa[q4 * 4 + 2] * rn * g.z * fast_sigmoid(g.z); o.w = Oa[q4 * 4 + 3] * rn * g.w * fast_sigmoid(g.w);
        *(uint2*)(yo + d0) = make_uint2(pk_bf16(o.x, o.y), pk_bf16(o.z, o.w));
      }
    }
  }
}

__device__ __forceinline__ void phase_post_pack(const Params& p, int l, int gtid, int ngt, int gw, int ngw, int lane) {
  const float* gq = p.in[12] + l * 64; const float* gk = p.in[13] + l * 64;
  for (int t = gw; t < T; t += ngw) {
    const int s = t % S, b = t / S;
    const bf16_t* row = p.projb() + (size_t)t * INW;
    float vin[24];
#pragma unroll
    for (int sl = 0; sl < 16; ++sl) vin[sl] = bf2f(row[(sl < 8 ? OFF_QM : OFF_KM) + (sl & 7) * 64 + lane]);
#pragma unroll
    for (int sl = 0; sl < 8; ++sl) vin[16 + sl] = bf2f(row[(sl < 4 ? OFF_QR : OFF_KR) + (sl & 3) * 64 + lane]);
    const float cm = p.cosm()[s * 8 + (lane & 7)], sm = p.sinm()[s * 8 + (lane & 7)];
    const float cr = p.cosr()[s * 32 + (lane & 31)], sr = p.sinr()[s * 32 + (lane & 31)];
    const float gqv = gq[lane], gkv = gk[lane];
#pragma unroll
    for (int slot = 0; slot < 16; ++slot) {
      const int h = slot & 7, bh = b * 8 + h; const bool isk = slot >= 8;
      const float v = vin[slot];
      const float ss = wave_sum(v * v);
      const float u = v * rsqrtf(ss / 64.0f + EPS) * (isk ? gkv : gqv);
      const float pu = __shfl(u, (lane < 8 ? lane + 8 : lane - 8) & 63);
      float o = u;
      if (lane < 16) o = lane < 8 ? (u * cm - pu * sm) : (u * cm + pu * sm);
      if (!isk) p.Qm()[((size_t)bh * S + s) * 64 + lane] = f2bf(o * QSCALE);
      else p.Km()[((((size_t)bh * (S / 32) + (s >> 5)) * 8 + (lane >> 3)) * 32 + (s & 31)) * 8 + (lane & 7)] = f2bf(o);
    }
#pragma unroll
    for (int slot = 16; slot < 24; ++slot) {
      const int h = (slot - 16) & 3, bh = b * 4 + h; const bool isk = slot >= 20;
      const float v = vin[slot];
      const float pv = __shfl(v, lane ^ 32);
      const float o = lane < 32 ? (v * cr - pv * sr) : (v * cr + pv * sr);
      const float l2g = ret_log2g(h); const int pos = s & 127;
      if (!isk) p.Qr()[((size_t)bh * S + s) * 64 + lane] = f2bf(o * exp2f((float)pos * l2g));
      else p.Kr()[((((size_t)bh * (S / 32) + (s >> 5)) * 8 + (lane >> 3)) * 32 + (s & 31)) * 8 + (lane & 7)] = f2bf(o * 0.125f * exp2f(-(float)pos * l2g));
    }
  }
  for (int idx = gtid; idx < NB * 8 * (S / 32) * 256; idx += ngt) {
    const int ln = idx & 63, ks = (idx >> 6) & 1, mb = (idx >> 7) & 1, tile = (idx >> 8) % (S / 32), bh = idx / (256 * (S / 32));
    const int b = bh >> 3, h = bh & 7, hh = ln >> 5, delta = mb * 32 + (ln & 31);
    float v[8];
#pragma unroll
    for (int j = 0; j < 8; ++j) { const int kappa = 16 * ks + 8 * (j >> 2) + 4 * hh + (j & 3), s = tile * 32 + kappa; v[j] = bf2f(p.projb()[(size_t)(b * S + s) * INW + OFF_VM + h * 64 + delta]); }
    uint4 o; o.x = pk_bf16(v[0], v[1]); o.y = pk_bf16(v[2], v[3]); o.z = pk_bf16(v[4], v[5]); o.w = pk_bf16(v[6], v[7]);
    *(uint4*)(p.Vm() + (size_t)idx * 8) = o;
  }
  for (int idx = gtid; idx < 2 * NB * 4 * (S / 32) * 256; idx += ngt) {
    const int ln = idx & 63, ks = (idx >> 6) & 1, blk = (idx >> 7) & 1, tile = (idx >> 8) % (S / 32), rest = idx / (256 * (S / 32)), bh = rest % (NB * 4), which = rest / (NB * 4);
    const int b = bh >> 2, h = bh & 3, hh = ln >> 5, delta = blk * 32 + (ln & 31);
    const float l2g = ret_log2g(h);
    float v[8];
#pragma unroll
    for (int j = 0; j < 8; ++j) {
      const int kappa = 16 * ks + 8 * (j >> 2) + 4 * hh + (j & 3), s = tile * 32 + kappa;
      const bf16_t* row = p.projb() + (size_t)(b * S + s) * INW;
      float x;
      if (which) {
        const float a = bf2f(row[OFF_KR + h * 64 + delta]), pa = bf2f(row[OFF_KR + h * 64 + (delta ^ 32)]);
        const int i = delta & 31; const float c = p.cosr()[s * 32 + i], sn = p.sinr()[s * 32 + i];
        x = (delta < 32 ? (a * c - pa * sn) : (a * c + pa * sn)) * 0.125f * exp2f(-(float)(s & 127) * l2g);
      } else x = bf2f(row[OFF_VR + h * 64 + delta]);
      v[j] = x;
    }
    uint4 o; o.x = pk_bf16(v[0], v[1]); o.y = pk_bf16(v[2], v[3]); o.z = pk_bf16(v[4], v[5]); o.w = pk_bf16(v[6], v[7]);
    *(uint4*)((which ? p.Krv() : p.Vr()) + ((size_t)(idx % (NB * 4 * (S / 32) * 256))) * 8) = o;
  }
}
__device__ __forceinline__ void phase_kmean2(const Params& p, int gtid, int ngt) {
  for (int idx = gtid; idx < NB * 8 * 16 * 64; idx += ngt) {
    const int d = idx & 63, j = (idx >> 6) & 15, bh = idx >> 10, c = d >> 3, dj = d & 7;
    float acc = 0.f;
    for (int tl = 0; tl < 8; ++tl) {
      const bf16_t* kp = p.Km() + (((size_t)bh * (S / 32) + j * 8 + tl) * 8 + c) * 256 + dj;
#pragma unroll 8
      for (int key = 0; key < 32; ++key) acc += bf2f(kp[key * 8]);
    }
    p.kmean()[idx] = acc * (1.0f / 256.0f);
  }
}

__device__ __forceinline__ void cvt_f32_bf16(const float* __restrict__ src, bf16_t* __restrict__ dst, size_t n8, int gtid, int ngt) {
  for (size_t i = gtid; i < n8; i += ngt) {
    float4 a = *(const float4*)(src + i * 8), b4 = *(const float4*)(src + i * 8 + 4);
    uint4 o; o.x = pk_bf16(a.x, a.y); o.y = pk_bf16(a.z, a.w); o.z = pk_bf16(b4.x, b4.y); o.w = pk_bf16(b4.z, b4.w);
    *(uint4*)(dst + i * 8) = o;
  }
}
__device__ __forceinline__ int f2key(float f) { int b = __float_as_int(f); return b ^ ((b >> 31) & 0x7fffffff); }
__device__ __forceinline__ float key2f(int k) { return __int_as_float(k ^ ((k >> 31) & 0x7fffffff)); }
#define CASD(a_, b_) { int mx_ = max(a_, b_), mn_ = min(a_, b_); a_ = mx_; b_ = mn_; }
__device__ __forceinline__ void sort16_desc(int (&v)[16]) {
#pragma unroll
  for (int k = 2; k <= 16; k <<= 1)
#pragma unroll
    for (int j = k >> 1; j > 0; j >>= 1)
#pragma unroll
      for (int i = 0; i < 16; ++i) { const int l2 = i ^ j; if (l2 > i) { if ((i & k) == 0) CASD(v[i], v[l2]) else CASD(v[l2], v[i]) } }
}
__device__ __forceinline__ void merge_top16(int (&a)[16], const int (&b)[16]) {
#pragma unroll
  for (int i = 0; i < 16; ++i) a[i] = max(a[i], b[15 - i]);
#pragma unroll
  for (int j = 8; j > 0; j >>= 1)
#pragma unroll
    for (int i = 0; i < 16; ++i) { const int l2 = i ^ j; if (l2 > i) CASD(a[i], a[l2]) }
}
__device__ __forceinline__ int lut4(int w0, int w1, int w2, int w3, int i) {
  const int w = i >> 2; const int d = (w == 0) ? w0 : (w == 1) ? w1 : (w == 2) ? w2 : w3;
  return (d >> ((i & 3) * 8)) & 127;
}

__device__ __forceinline__ void phase_peer_topk(const Params& p, int l, int gw, int ngw, int lane) {
  const int n = lane & 31, hh = lane >> 5;
  const bf16_t* skl = p.skb() + (size_t)l * 16 * 128 * 64;
  for (int w = gw; w < (T / 32) * 8; w += ngw) {
    const int tg = w >> 3, h = w & 7, t = tg * 32 + n;
    int L0[16], L1[16];
#pragma unroll
    for (int c = 0; c < 2; ++c) {
      const int hc = 2 * h + c;
      bf16x8 qf[4];
#pragma unroll
      for (int s = 0; s < 4; ++s) qf[s] = *(const bf16x8*)(p.qb() + (size_t)t * D + hc * 64 + 16 * s + 8 * hh);
      int A[16], Bq[16];
#pragma unroll
      for (int mb = 0; mb < 4; ++mb) {
        f32x16 X;
#pragma unroll
        for (int r = 0; r < 16; ++r) X[r] = 0.f;
#pragma unroll
        for (int s = 0; s < 4; ++s) {
          const bf16x8 kf = *(const bf16x8*)(skl + ((size_t)(hc * 128 + mb * 32 + n)) * 64 + 16 * s + 8 * hh);
          X = __builtin_amdgcn_mfma_f32_32x32x16_bf16(kf, qf[s], X, 0, 0, 0);
        }
        int Gk[16];
#pragma unroll
        for (int r = 0; r < 16; ++r) Gk[r] = (f2key(X[r]) & ~127) | (mb * 32 + (r & 3) + 8 * (r >> 2) + 4 * hh);
        sort16_desc(Gk);
        if (mb == 0) {
#pragma unroll
          for (int r = 0; r < 16; ++r) A[r] = Gk[r];
        } else merge_top16(A, Gk);
      }
#pragma unroll
      for (int r = 0; r < 16; ++r) Bq[r] = __shfl_xor(A[r], 32);
      merge_top16(A, Bq);
#pragma unroll
      for (int r = 0; r < 16; ++r) { if (c == 0) L0[r] = A[r]; else L1[r] = A[r]; }
    }
    float av[16], bv[16];
#pragma unroll
    for (int r = 0; r < 16; ++r) { av[r] = key2f(L0[r] & ~127); bv[r] = key2f(L1[r] & ~127); }
#define CAND(i_, j_) ((f2key(av[i_] + bv[j_]) & ~255) | ((i_) << 4) | (j_))
    int R[16], G1[16], G2[16];
#pragma unroll
    for (int j = 0; j < 16; ++j) R[j] = CAND(0, j);
    G1[0] = CAND(1, 0); G1[1] = CAND(1, 1); G1[2] = CAND(1, 2); G1[3] = CAND(1, 3); G1[4] = CAND(1, 4); G1[5] = CAND(1, 5); G1[6] = CAND(1, 6); G1[7] = CAND(1, 7);
    G1[8] = CAND(2, 0); G1[9] = CAND(2, 1); G1[10] = CAND(2, 2); G1[11] = CAND(2, 3); G1[12] = CAND(2, 4); G1[13] = CAND(3, 0); G1[14] = CAND(3, 1); G1[15] = CAND(3, 2);
    G2[0] = CAND(3, 3); G2[1] = CAND(4, 0); G2[2] = CAND(4, 1); G2[3] = CAND(4, 2); G2[4] = CAND(5, 0); G2[5] = CAND(5, 1); G2[6] = CAND(6, 0); G2[7] = CAND(6, 1);
    G2[8] = CAND(7, 0); G2[9] = CAND(7, 1); G2[10] = CAND(8, 0); G2[11] = CAND(9, 0); G2[12] = CAND(10, 0); G2[13] = CAND(11, 0); G2[14] = CAND(12, 0); G2[15] = CAND(13, 0);
    sort16_desc(G1); merge_top16(R, G1);
    sort16_desc(G2); merge_top16(R, G2);
    { int x0 = CAND(14, 0), x1 = CAND(15, 0);
#pragma unroll
      for (int i = 0; i < 16; ++i) CASD(R[i], x0)
#pragma unroll
      for (int i = 0; i < 16; ++i) CASD(R[i], x1)
    }
#undef CAND
    int pa0 = 0, pa1 = 0, pa2 = 0, pa3 = 0, pb0 = 0, pb1 = 0, pb2 = 0, pb3 = 0;
#pragma unroll
    for (int q = 0; q < 4; ++q) {
      pa0 |= (L0[q] & 127) << (8 * q); pa1 |= (L0[4 + q] & 127) << (8 * q); pa2 |= (L0[8 + q] & 127) << (8 * q); pa3 |= (L0[12 + q] & 127) << (8 * q);
      pb0 |= (L1[q] & 127) << (8 * q); pb1 |= (L1[4 + q] & 127) << (8 * q); pb2 |= (L1[8 + q] & 127) << (8 * q); pb3 |= (L1[12 + q] & 127) << (8 * q);
    }
    float ev[16], sum = 0.f; int ei[16];
    const float mx = key2f(R[0] & ~255);
#pragma unroll
    for (int z = 0; z < 16; ++z) {
      const float v = key2f(R[z] & ~255);
      ev[z] = __expf(v - mx); sum += ev[z];
      const int pay = R[z] & 255;
      ei[z] = lut4(pa0, pa1, pa2, pa3, pay >> 4) * 128 + lut4(pb0, pb1, pb2, pb3, pay & 15);
    }
    const float inv = 1.0f / sum;
    if (hh == 0) {
      float* go = p.gates() + ((size_t)t * 8 + h) * 16; int* eo = p.eidx() + ((size_t)t * 8 + h) * 16;
#pragma unroll
      for (int z = 0; z < 16; z += 4) {
        *(float4*)(go + z) = make_float4(ev[z] * inv, ev[z + 1] * inv, ev[z + 2] * inv, ev[z + 3] * inv);
        *(int4*)(eo + z) = make_int4(ei[z], ei[z + 1], ei[z + 2], ei[z + 3]);
      }
    }
  }
}

__device__ __forceinline__ void phase_peer_apply2(const Params& p, int l, float* coef, int gw, int ngw, int lane) {
  const float* g2 = p.in[16] + l * D;
  for (int t = gw; t < T; t += ngw) {
    const float r = p.rstd()[t];
    float hv[16];
#pragma unroll
    for (int i = 0; i < 2; ++i) {
      const float* xp = p.out + (size_t)t * D + i * 512 + lane * 8; const float* gp = g2 + i * 512 + lane * 8;
      float4 x0 = *(const float4*)xp, x1 = *(const float4*)(xp + 4), g0 = *(const float4*)gp, g1 = *(const float4*)(gp + 4);
      hv[i * 8 + 0] = x0.x * r * g0.x; hv[i * 8 + 1] = x0.y * r * g0.y; hv[i * 8 + 2] = x0.z * r * g0.z; hv[i * 8 + 3] = x0.w * r * g0.w;
      hv[i * 8 + 4] = x1.x * r * g1.x; hv[i * 8 + 5] = x1.y * r * g1.y; hv[i * 8 + 6] = x1.z * r * g1.z; hv[i * 8 + 7] = x1.w * r * g1.w;
    }
    const int e_lo = p.eidx()[(size_t)t * 128 + lane], e_hi = p.eidx()[(size_t)t * 128 + 64 + lane];
    const float g_lo = p.gates()[(size_t)t * 128 + lane], g_hi = p.gates()[(size_t)t * 128 + 64 + lane];
    LDS_FENCE();
#pragma unroll 1
    for (int half = 0; half < 2; ++half) {
      const int ev = half ? e_hi : e_lo;
      float mine = 0.f;
#pragma unroll 4
      for (int j = 0; j < 64; ++j) {
        const int e = __shfl(ev, j);
        const bf16_t* up = p.Ub() + (size_t)e * D + lane * 8;
        uint4 u0 = *(const uint4*)up, u1 = *(const uint4*)(up + 512);
        float d = 0.f;
        d = fmaf(hv[0], __uint_as_float(u0.x << 16), d); d = fmaf(hv[1], __uint_as_float(u0.x & 0xffff0000u), d);
        d = fmaf(hv[2], __uint_as_float(u0.y << 16), d); d = fmaf(hv[3], __uint_as_float(u0.y & 0xffff0000u), d);
        d = fmaf(hv[4], __uint_as_float(u0.z << 16), d); d = fmaf(hv[5], __uint_as_float(u0.z & 0xffff0000u), d);
        d = fmaf(hv[6], __uint_as_float(u0.w << 16), d); d = fmaf(hv[7], __uint_as_float(u0.w & 0xffff0000u), d);
        d = fmaf(hv[8], __uint_as_float(u1.x << 16), d); d = fmaf(hv[9], __uint_as_float(u1.x & 0xffff0000u), d);
        d = fmaf(hv[10], __uint_as_float(u1.y << 16), d); d = fmaf(hv[11], __uint_as_float(u1.y & 0xffff0000u), d);
        d = fmaf(hv[12], __uint_as_float(u1.z << 16), d); d = fmaf(hv[13], __uint_as_float(u1.z & 0xffff0000u), d);
        d = fmaf(hv[14], __uint_as_float(u1.w << 16), d); d = fmaf(hv[15], __uint_as_float(u1.w & 0xffff0000u), d);
        d = wave_sum(d);
        if (lane == j) mine = d;
      }
      coef[half * 64 + lane] = (half ? g_hi : g_lo) * gelu_tanh(mine);
    }
    LDS_FENCE();
    float acc[16];
#pragma unroll
    for (int i = 0; i < 16; ++i) acc[i] = 0.f;
#pragma unroll 1
    for (int half = 0; half < 2; ++half) {
      const int ev = half ? e_hi : e_lo;
#pragma unroll 4
      for (int j = 0; j < 64; ++j) {
        const int e = __shfl(ev, j);
        const float c = coef[half * 64 + j];
        const bf16_t* vp = p.Vb() + (size_t)e * D + lane * 8;
        uint4 v0 = *(const uint4*)vp, v1 = *(const uint4*)(vp + 512);
        acc[0] = fmaf(c, __uint_as_float(v0.x << 16), acc[0]); acc[1] = fmaf(c, __uint_as_float(v0.x & 0xffff0000u), acc[1]);
        acc[2] = fmaf(c, __uint_as_float(v0.y << 16), acc[2]); acc[3] = fmaf(c, __uint_as_float(v0.y & 0xffff0000u), acc[3]);
        acc[4] = fmaf(c, __uint_as_float(v0.z << 16), acc[4]); acc[5] = fmaf(c, __uint_as_float(v0.z & 0xffff0000u), acc[5]);
        acc[6] = fmaf(c, __uint_as_float(v0.w << 16), acc[6]); acc[7] = fmaf(c, __uint_as_float(v0.w & 0xffff0000u), acc[7]);
        acc[8] = fmaf(c, __uint_as_float(v1.x << 16), acc[8]); acc[9] = fmaf(c, __uint_as_float(v1.x & 0xffff0000u), acc[9]);
        acc[10] = fmaf(c, __uint_as_float(v1.y << 16), acc[10]); acc[11] = fmaf(c, __uint_as_float(v1.y & 0xffff0000u), acc[11]);
        acc[12] = fmaf(c, __uint_as_float(v1.z << 16), acc[12]); acc[13] = fmaf(c, __uint_as_float(v1.z & 0xffff0000u), acc[13]);
        acc[14] = fmaf(c, __uint_as_float(v1.w << 16), acc[14]); acc[15] = fmaf(c, __uint_as_float(v1.w & 0xffff0000u), acc[15]);
      }
    }
#pragma unroll
    for (int i = 0; i < 2; ++i) {
      float* xp = p.out + (size_t)t * D + i * 512 + lane * 8;
      float4 x0 = *(float4*)xp, x1 = *(float4*)(xp + 4);
      x0.x += acc[i * 8 + 0]; x0.y += acc[i * 8 + 1]; x0.z += acc[i * 8 + 2]; x0.w += acc[i * 8 + 3];
      x1.x += acc[i * 8 + 4]; x1.y += acc[i * 8 + 5]; x1.z += acc[i * 8 + 6]; x1.w += acc[i * 8 + 7];
      *(float4*)xp = x0; *(float4*)(xp + 4) = x1;
    }
  }
}

typedef int v8i __attribute__((ext_vector_type(8)));
__device__ __forceinline__ unsigned xcc_id() { return (unsigned)__builtin_amdgcn_s_getreg((3 << 11) | 20) & 7u; }
__device__ __forceinline__ float pow2_scale(float amax) {
  if (!(amax > 0.f)) return 1.0f;
  const int e = (int)floorf(log2f(240.0f / amax));
  return exp2f((float)(e < 60 ? (e > -60 ? e : -60) : 60));
}
__device__ __forceinline__ unsigned pack4_fp8(float a, float b, float c, float d) {
  int v = __builtin_amdgcn_cvt_pk_fp8_f32(a, b, 0, false);
  v = __builtin_amdgcn_cvt_pk_fp8_f32(c, d, v, true);
  return (unsigned)v;
}
__device__ __forceinline__ void cvt_table_fp8(const float* __restrict__ src, unsigned char* __restrict__ dst, float* __restrict__ scl, int gw, int ngw, int lane) {
  for (int e0 = gw; e0 < 16384; e0 += 2 * ngw) {
    float4 v[2][4];
#pragma unroll
    for (int u = 0; u < 2; ++u) { const int e = (e0 + u * ngw < 16384) ? e0 + u * ngw : e0;
#pragma unroll
      for (int k = 0; k < 4; ++k) v[u][k] = *(const float4*)(src + (size_t)e * D + k * 256 + lane * 4); }
#pragma unroll
    for (int u = 0; u < 2; ++u) {
      const int e = e0 + u * ngw;
      if (e < 16384) {
        float am = 0.f;
#pragma unroll
        for (int k = 0; k < 4; ++k) am = fmaxf(am, fmaxf(fmaxf(fabsf(v[u][k].x), fabsf(v[u][k].y)), fmaxf(fabsf(v[u][k].z), fabsf(v[u][k].w))));
        am = wave_max(am);
        const float s = pow2_scale(am);
        if (lane == 0) scl[e] = s;
#pragma unroll
        for (int k = 0; k < 4; ++k) {
          const int slice = 2 * k + (lane >> 5), off = (lane & 31) * 4;
          *(unsigned*)(dst + ((size_t)slice * 16384 + e) * 128 + off) = pack4_fp8(v[u][k].x * s, v[u][k].y * s, v[u][k].z * s, v[u][k].w * s);
        }
      }
    }
  }
}
__device__ __forceinline__ void phase_cvt_rows_h8(const Params& p, int l, int gw, int ngw, int lane) {
  const float* g2 = p.in[16] + l * D;
  float4 g[4];
#pragma unroll
  for (int k = 0; k < 4; ++k) g[k] = *(const float4*)(g2 + k * 256 + lane * 4);
  for (int t0 = gw; t0 < T; t0 += 2 * ngw) {
    float4 v[2][4];
#pragma unroll
    for (int u = 0; u < 2; ++u) { const int t = (t0 + u * ngw < T) ? t0 + u * ngw : t0;
#pragma unroll
      for (int k = 0; k < 4; ++k) v[u][k] = *(const float4*)(p.out + (size_t)t * D + k * 256 + lane * 4); }
#pragma unroll
    for (int u = 0; u < 2; ++u) {
      const int t = t0 + u * ngw;
      if (t < T) {
        float ss = 0.f;
#pragma unroll
        for (int k = 0; k < 4; ++k) {
          const float4 w = v[u][k];
          ss += w.x * w.x + w.y * w.y + w.z * w.z + w.w * w.w;
          uint2 ph; ph.x = pk_bf16(w.x, w.y); ph.y = pk_bf16(w.z, w.w);
          *(uint2*)(p.xb() + (size_t)t * KD + k * 256 + lane * 4) = ph;
        }
        ss = wave_sum(ss);
        const float r = rsqrtf(ss / (float)D + EPS);
        if (lane == 0) p.rstd()[t] = r;
#pragma unroll
        for (int k = 0; k < 4; ++k) {
          const float4 w = v[u][k];
          const int slice = 2 * k + (lane >> 5), off = (lane & 31) * 4;
          uint2 o; o.x = pk_bf16(w.x * r * g[k].x, w.y * r * g[k].y); o.y = pk_bf16(w.z * r * g[k].z, w.w * r * g[k].w);
          *(uint2*)(p.hb() + ((size_t)slice * T + t) * 128 + off) = o;
        }
      }
    }
  }
}
#define DPP_ADD(v_, ctrl_) ((v_) + __builtin_bit_cast(float, __builtin_amdgcn_update_dpp(0, __builtin_bit_cast(int, (v_)), (ctrl_), 0xF, 0xF, true)))
__device__ __forceinline__ float sum_xor16(float x) { float a = x, b = x; asm volatile("v_nop\n\tv_nop\n\tv_permlane16_swap_b32 %0, %1" : "+v"(a), "+v"(b)); return a + b; }
__device__ __forceinline__ float sum_xor32(float x) { float a = x, b = x; asm volatile("v_nop\n\tv_nop\n\tv_permlane32_swap_b32 %0, %1" : "+v"(a), "+v"(b)); return a + b; }
__device__ __forceinline__ int q_pull(int* head, int nitems, int* bc, int tid) {
  __syncthreads();
  if (tid == 0) bc[0] = atomicAdd(head, 1);
  __syncthreads();
  const int v = bc[0];
  return v < nitems ? v : -1;
}
constexpr int PEER_TILE = 128;
__device__ __forceinline__ void phase_peer_u(const Params& p, int* heads, unsigned char* lds, int tid) {
  const int lane = tid & 63, wv = tid >> 6, r8 = lane >> 3, c8 = lane & 7;
  int* bc = (int*)lds;
  int* eW = (int*)(lds + 1024 + wv * 12288);
  bf16_t* hW = (bf16_t*)(lds + 1024 + wv * 12288 + 8192);
  const int myx = (int)xcc_id();
  for (int pass = 0; pass < 8; ++pass) {
    const int s = (myx + pass) & 7;
    const unsigned char* Us = p.U8s() + (size_t)s * 16384 * 128 + c8 * 16;
    for (;;) {
      const int item = q_pull(heads + s, T / PEER_TILE, bc, tid);
      if (item < 0) break;
      const int t0 = item * PEER_TILE + wv * 16;
      LDS_FENCE();
      { uint2 ev[16];
        const bf16_t* hsrc = p.hb() + ((size_t)s * T + t0) * 128 + lane * 8;
#pragma unroll
        for (int k = 0; k < 16; ++k) ev[k] = *(const uint2*)(p.eidx() + (size_t)(t0 + k) * 128 + lane * 2);
        const uint4 hq0 = *(const uint4*)(hsrc), hq1 = *(const uint4*)(hsrc + 512), hq2 = *(const uint4*)(hsrc + 1024), hq3 = *(const uint4*)(hsrc + 1536);
#pragma unroll
        for (int k = 0; k < 16; ++k) *(uint2*)(eW + k * 128 + lane * 2) = ev[k];
        *(uint4*)(hW + lane * 8) = hq0; *(uint4*)(hW + 512 + lane * 8) = hq1; *(uint4*)(hW + 1024 + lane * 8) = hq2; *(uint4*)(hW + 1536 + lane * 8) = hq3; }
      LDS_FENCE();
      uint4 R[4][8];
#define PEER_U_LOAD(M_, BUF_) { _Pragma("unroll") for (int eb = 0; eb < 8; ++eb) R[BUF_][eb] = *(const uint4*)(Us + (size_t)eW[(M_) * 64 + eb * 8 + r8] * 128); }
      PEER_U_LOAD(0, 0) PEER_U_LOAD(1, 1) PEER_U_LOAD(2, 2)
      float hv[16]; float res0 = 0.f, res1 = 0.f;
#define PEER_U_LOADH(TOK_) { const bf16_t* hp = hW + (TOK_) * 128 + c8 * 16; const uint4 a = *(const uint4*)hp, b4 = *(const uint4*)(hp + 8); \
        const unsigned w8[8] = {a.x, a.y, a.z, a.w, b4.x, b4.y, b4.z, b4.w};                                                              \
        _Pragma("unroll") for (int z = 0; z < 8; ++z) { hv[2 * z] = __uint_as_float(w8[z] << 16); hv[2 * z + 1] = __uint_as_float(w8[z] & 0xffff0000u); } }
      PEER_U_LOADH(0)
#define PEER_U_HALF(M_, BUF_, HALF_)                                                                           \
      {                                                                                                                                   \
        if ((M_) + 3 < 32) PEER_U_LOAD((M_) + 3, ((BUF_) + 3) & 3)                                                                        \
        _Pragma("unroll") for (int eb = 0; eb < 8; ++eb) {                                                                                \
          const unsigned ww[4] = {R[BUF_][eb].x, R[BUF_][eb].y, R[BUF_][eb].z, R[BUF_][eb].w};                                            \
          float d = 0.f;                                                                                                                  \
          _Pragma("unroll") for (int q4 = 0; q4 < 4; ++q4) {                                                                              \
            const auto f01 = __builtin_amdgcn_cvt_pk_f32_fp8((int)ww[q4], false); const auto f23 = __builtin_amdgcn_cvt_pk_f32_fp8((int)ww[q4], true); \
            d = fmaf(hv[q4 * 4 + 0], f01[0], d); d = fmaf(hv[q4 * 4 + 1], f01[1], d); d = fmaf(hv[q4 * 4 + 2], f23[0], d); d = fmaf(hv[q4 * 4 + 3], f23[1], d); \
          }                                                                                                                               \
          d = DPP_ADD(d, 0xB1); d = DPP_ADD(d, 0x4E); d = DPP_ADD(d, 0x141);     \
          if ((HALF_) == 0) { if (c8 == eb) res0 = d; } else { if (c8 == eb) res1 = d; }                                                  \
        }                                                                                                                                 \
        if ((HALF_) == 1) {                                                                                                               \
          float* po = p.ppart() + ((size_t)s * T + t0 + ((M_) >> 1)) * 128;                                                               \
          po[c8 * 8 + r8] = res0; po[64 + c8 * 8 + r8] = res1;                                                                            \
          if ((M_) + 1 < 32) PEER_U_LOADH(((M_) >> 1) + 1)                                                                                \
        }                                                                                                                                 \
      }
#pragma unroll
      for (int m4 = 0; m4 < 32; m4 += 4) {
        PEER_U_HALF(m4, 0, 0) PEER_U_HALF(m4 + 1, 1, 1) PEER_U_HALF(m4 + 2, 2, 0) PEER_U_HALF(m4 + 3, 3, 1)
      }
#undef PEER_U_HALF
#undef PEER_U_LOADH
#undef PEER_U_LOAD
    }
  }
}
__device__ __forceinline__ void phase_peer_r(const Params& p, int gtid, int ngt) {
  for (int idx0 = gtid; idx0 < T * 128; idx0 += 4 * ngt) {
    float d[4]; int e[4]; float su_[4], sv_[4], g_[4]; bool ok[4];
#pragma unroll
    for (int u = 0; u < 4; ++u) { const int idx = idx0 + u * ngt; ok[u] = idx < T * 128; const int ix = ok[u] ? idx : 0;
      e[u] = p.eidx()[ix]; g_[u] = p.gates()[ix]; float a = 0.f;
#pragma unroll
      for (int s = 0; s < 8; ++s) a += p.ppart()[(size_t)s * T * 128 + ix];
      d[u] = a; }
#pragma unroll
    for (int u = 0; u < 4; ++u) { su_[u] = p.su()[e[u]]; sv_[u] = p.sv()[e[u]]; }
#pragma unroll
    for (int u = 0; u < 4; ++u) if (ok[u]) p.gates()[idx0 + u * ngt] = g_[u] * gelu_tanh(d[u] / su_[u]) / sv_[u];
  }
}
__device__ __forceinline__ void phase_peer_v(const Params& p, int* heads, unsigned char* lds, int tid) {
  const int lane = tid & 63, wv = tid >> 6, r8 = lane >> 3, c8 = lane & 7;
  int* bc = (int*)lds;
  uint2* pW = (uint2*)(lds + 1024 + wv * 16384);
  const int myx = (int)xcc_id();
  for (int pass = 0; pass < 8; ++pass) {
    const int s = (myx + pass) & 7;
    const unsigned char* Vs = p.V8s() + (size_t)s * 16384 * 128 + c8 * 16;
    for (;;) {
      const int item = q_pull(heads + s, T / PEER_TILE, bc, tid);
      if (item < 0) break;
      const int t0 = item * PEER_TILE + wv * 16;
      LDS_FENCE();
      { uint2 e2[16], g2[16];
#pragma unroll
        for (int k = 0; k < 16; ++k) { e2[k] = *(const uint2*)(p.eidx() + (size_t)(t0 + k) * 128 + lane * 2); g2[k] = *(const uint2*)(p.gates() + (size_t)(t0 + k) * 128 + lane * 2); }
#pragma unroll
        for (int k = 0; k < 16; ++k) *(uint4*)(pW + k * 128 + lane * 2) = make_uint4(e2[k].x, g2[k].x, e2[k].y, g2[k].y); }
      LDS_FENCE();
      const int xoff = s * 128 + c8 * 16 + (r8 & 3) * 4;
      float4 xo[16];
#pragma unroll
      for (int k = 0; k < 16; ++k) xo[k] = *(const float4*)(p.out + (size_t)(t0 + k) * D + xoff);
      uint4 R[3][8];
#define PEER_V_LOAD(M_, BUF_) { _Pragma("unroll") for (int eb = 0; eb < 8; ++eb) R[BUF_][eb] = *(const uint4*)(Vs + (size_t)pW[(M_) * 64 + eb * 8 + r8].x * 128); }
      PEER_V_LOAD(0, 0) PEER_V_LOAD(1, 1)
      float acc[16];
#define PEER_V_HALF(M_, BUF_, HALF_)                                                           \
      {                                                                                                                                   \
        if ((M_) + 2 < 32) PEER_V_LOAD((M_) + 2, ((BUF_) + 2) % 3)                                                                        \
        if ((HALF_) == 0) { _Pragma("unroll") for (int z = 0; z < 16; ++z) acc[z] = 0.f; }                                                \
        _Pragma("unroll") for (int eb = 0; eb < 8; ++eb) {                                                                                \
          const float c = __uint_as_float(pW[(M_) * 64 + eb * 8 + r8].y);                                                                 \
          const unsigned ww[4] = {R[BUF_][eb].x, R[BUF_][eb].y, R[BUF_][eb].z, R[BUF_][eb].w};                                            \
          _Pragma("unroll") for (int q4 = 0; q4 < 4; ++q4) {                                                                              \
            const auto f01 = __builtin_amdgcn_cvt_pk_f32_fp8((int)ww[q4], false); const auto f23 = __builtin_amdgcn_cvt_pk_f32_fp8((int)ww[q4], true); \
            acc[q4 * 4 + 0] = fmaf(c, f01[0], acc[q4 * 4 + 0]); acc[q4 * 4 + 1] = fmaf(c, f01[1], acc[q4 * 4 + 1]);                       \
            acc[q4 * 4 + 2] = fmaf(c, f23[0], acc[q4 * 4 + 2]); acc[q4 * 4 + 3] = fmaf(c, f23[1], acc[q4 * 4 + 3]);                       \
          }                                                                                                                               \
        }                                                                                                                                 \
        if ((HALF_) == 1) {                                                                                                               \
          _Pragma("unroll") for (int z = 0; z < 16; ++z) { acc[z] = DPP_ADD(acc[z], 0x128); acc[z] = sum_xor16(acc[z]); acc[z] = sum_xor32(acc[z]); }     \
          const int sel = r8 & 3;                                                                                                         \
          float4 dl;                                                                                                                      \
          dl.x = sel == 0 ? acc[0] : sel == 1 ? acc[4] : sel == 2 ? acc[8] : acc[12];                                                     \
          dl.y = sel == 0 ? acc[1] : sel == 1 ? acc[5] : sel == 2 ? acc[9] : acc[13];                                                     \
          dl.z = sel == 0 ? acc[2] : sel == 1 ? acc[6] : sel == 2 ? acc[10] : acc[14];                                                    \
          dl.w = sel == 0 ? acc[3] : sel == 1 ? acc[7] : sel == 2 ? acc[11] : acc[15];                                                    \
          const float4 xv = xo[(M_) >> 1];                                                                                                \
          if (r8 < 4) *(float4*)(p.out + (size_t)(t0 + ((M_) >> 1)) * D + xoff) = make_float4(xv.x + dl.x, xv.y + dl.y, xv.z + dl.z, xv.w + dl.w); \
        }                                                                                                                                 \
      }
#pragma unroll
      for (int m6 = 0; m6 < 30; m6 += 6) {
        PEER_V_HALF(m6, 0, 0) PEER_V_HALF(m6 + 1, 1, 1) PEER_V_HALF(m6 + 2, 2, 0) PEER_V_HALF(m6 + 3, 0, 1) PEER_V_HALF(m6 + 4, 1, 0) PEER_V_HALF(m6 + 5, 2, 1)
      }
      PEER_V_HALF(30, 0, 0) PEER_V_HALF(31, 1, 1)
#undef PEER_V_HALF
#undef PEER_V_LOAD
    }
  }
}

#if PEER_CHECK
constexpr int CHK_N = 512;
__device__ __forceinline__ float* chk_x(const Params& p) { return (float*)(p.ws + WO_ybuf); }
__device__ __forceinline__ float* chk_m(const Params& p) { return (float*)(p.ws + WO_ybuf + (size_t)CHK_N * D * 4); }
__device__ __forceinline__ float* chk_g(const Params& p) { return (float*)(p.ws + WO_ybuf + (size_t)CHK_N * D * 4 + 4096); }
__device__ __forceinline__ void chk_save(const Params& p, int gtid, int ngt) {
  for (int i = gtid; i < CHK_N * D; i += ngt) chk_x(p)[i] = p.out[(size_t)(i / D) * 64 * D + (i % D)];
  for (int i = gtid; i < CHK_N * 128; i += ngt) chk_g(p)[i] = p.gates()[(size_t)(i / 128) * 64 * 128 + (i % 128)];
  if (gtid < 16) chk_m(p)[gtid] = 0.f;
}
__device__ __forceinline__ void chk_apply(const Params& p, int l, float* coef, int gw, int ngw, int lane) {
  const float* g2 = p.in[16] + l * D;
  const float* U = p.in[19] + (size_t)l * 16384 * D; const float* V = p.in[20] + (size_t)l * 16384 * D;
  for (int i = gw; i < CHK_N; i += ngw) {
    const int t = i * 64;
    const float r = p.rstd()[t];
    float4 hv[4];
#pragma unroll
    for (int k = 0; k < 4; ++k) {
      float4 xv = *(const float4*)(chk_x(p) + (size_t)i * D + (lane + k * 64) * 4);
      float4 gv = *(const float4*)(g2 + (lane + k * 64) * 4);
      hv[k].x = xv.x * r * gv.x; hv[k].y = xv.y * r * gv.y; hv[k].z = xv.z * r * gv.z; hv[k].w = xv.w * r * gv.w;
    }
    LDS_FENCE();
    for (int j = 0; j < 128; ++j) {
      const int e = p.eidx()[(size_t)t * 128 + j];
      const float4* up = (const float4*)(U + (size_t)e * D);
      float dsum = 0.f;
#pragma unroll
      for (int k = 0; k < 4; ++k) { float4 uv = up[lane + k * 64]; dsum += hv[k].x * uv.x + hv[k].y * uv.y + hv[k].z * uv.z + hv[k].w * uv.w; }
      dsum = wave_sum(dsum);
      if (lane == 0) coef[j] = chk_g(p)[(size_t)i * 128 + j] * gelu_tanh(dsum);
    }
    LDS_FENCE();
    float4 acc[4];
#pragma unroll
    for (int k = 0; k < 4; ++k) acc[k] = make_float4(0.f, 0.f, 0.f, 0.f);
    for (int j = 0; j < 128; ++j) {
      const int e = p.eidx()[(size_t)t * 128 + j];
      const float c = coef[j];
      const float4* vp = (const float4*)(V + (size_t)e * D);
#pragma unroll
      for (int k = 0; k < 4; ++k) { float4 vv = vp[lane + k * 64]; acc[k].x = fmaf(c, vv.x, acc[k].x); acc[k].y = fmaf(c, vv.y, acc[k].y); acc[k].z = fmaf(c, vv.z, acc[k].z); acc[k].w = fmaf(c, vv.w, acc[k].w); }
    }
    float d2 = 0.f, r2 = 0.f;
#pragma unroll
    for (int k = 0; k < 4; ++k) {
      float4 xa = *(const float4*)(p.out + (size_t)t * D + (lane + k * 64) * 4);
      float4 xb4 = *(const float4*)(chk_x(p) + (size_t)i * D + (lane + k * 64) * 4);
      float e0 = (xa.x - xb4.x) - acc[k].x, e1 = (xa.y - xb4.y) - acc[k].y, e2 = (xa.z - xb4.z) - acc[k].z, e3 = (xa.w - xb4.w) - acc[k].w;
      d2 += e0 * e0 + e1 * e1 + e2 * e2 + e3 * e3;
      r2 += acc[k].x * acc[k].x + acc[k].y * acc[k].y + acc[k].z * acc[k].z + acc[k].w * acc[k].w;
    }
    d2 = wave_sum(d2); r2 = wave_sum(r2);
    if (lane == 0) { atomicAdd((unsigned long long*)&chk_m(p)[8], (unsigned long long)(d2 * 1099511627776.0f)); atomicAdd((unsigned long long*)&chk_m(p)[10], (unsigned long long)(r2 * 1099511627776.0f)); }
  }
}
__device__ __forceinline__ void chk_topk(const Params& p, int l, int gtid, int ngt) {
  const float* subk = p.in[18] + (size_t)l * 16 * 128 * 64;
  for (int it = gtid; it < CHK_N * 8; it += ngt) {
    const int i = it >> 3, h = it & 7, t = i * 64;
    float tva[16], tvb[16]; int tia[16], tib[16];
#pragma unroll 1
    for (int c = 0; c < 2; ++c) {
      float tv[16]; int ti[16];
#pragma unroll
      for (int z = 0; z < 16; ++z) { tv[z] = -INFINITY; ti[z] = 0; }
      const bf16_t* q = p.qb() + (size_t)t * D + (2 * h + c) * 64;
      const float* kb = subk + (size_t)(2 * h + c) * 128 * 64;
#pragma unroll 1
      for (int n = 0; n < 128; ++n) {
        float sc = 0.f;
        for (int d = 0; d < 64; ++d) sc = fmaf(bf2f(q[d]), kb[n * 64 + d], sc);
        float v_ = sc; int i_ = n;
#pragma unroll
        for (int z = 0; z < 16; ++z) { bool gt = v_ > tv[z]; float a = tv[z]; int b = ti[z]; tv[z] = gt ? v_ : a; ti[z] = gt ? i_ : b; v_ = gt ? a : v_; i_ = gt ? b : i_; }
      }
#pragma unroll
      for (int z = 0; z < 16; ++z) { if (c == 0) { tva[z] = tv[z]; tia[z] = ti[z]; } else { tvb[z] = tv[z]; tib[z] = ti[z]; } }
    }
    float tv[16]; int ti[16];
#pragma unroll
    for (int z = 0; z < 16; ++z) { tv[z] = -INFINITY; ti[z] = 0; }
#pragma unroll 1
    for (int a = 0; a < 16; ++a)
#pragma unroll 1
      for (int b = 0; b < 16; ++b) {
        float av = 0.f, bv = 0.f; int ai = 0, bi = 0;
#pragma unroll
        for (int z = 0; z < 16; ++z) { if (z == a) { av = tva[z]; ai = tia[z]; } if (z == b) { bv = tvb[z]; bi = tib[z]; } }
        float v_ = av + bv; int i_ = ai * 128 + bi;
#pragma unroll
        for (int z = 0; z < 16; ++z) { bool gt = v_ > tv[z]; float x = tv[z]; int y = ti[z]; tv[z] = gt ? v_ : x; ti[z] = gt ? i_ : y; v_ = gt ? x : v_; i_ = gt ? y : i_; }
      }
    float sum = 0.f, ev[16];
#pragma unroll
    for (int z = 0; z < 16; ++z) { ev[z] = expf(tv[z] - tv[0]); sum += ev[z]; }
    int miss = 0; float gerr = 0.f;
    for (int z = 0; z < 16; ++z) {
      const int ef = p.eidx()[((size_t)t * 8 + h) * 16 + z]; const float gf = p.gates()[((size_t)t * 8 + h) * 16 + z];
      bool found = false;
#pragma unroll
      for (int y = 0; y < 16; ++y) if (ti[y] == ef) { found = true; gerr = fmaxf(gerr, fabsf(ev[y] / sum - gf)); }
      if (!found) ++miss;
    }
    atomicAdd(&chk_m(p)[3], (float)miss);
    atomicMax((int*)&chk_m(p)[4], __float_as_int(gerr));
  }
}
__device__ __forceinline__ void chk_emit(const Params& p) {
  float v = 0.f;
  if (PEER_CHECK == 1) v = sqrtf((float)((double)*(unsigned long long*)&chk_m(p)[8] / (double)*(unsigned long long*)&chk_m(p)[10]));
  if (PEER_CHECK == 2) v = chk_m(p)[3] / (float)(CHK_N * 8 * 16);
  if (PEER_CHECK == 3) v = chk_m(p)[4];
  p.out[0] += 1.0e4f * v + 100.0f;
}
#endif

#define XB_TMO      128
#define XB_XCNT(j)  (256  + 64 * (j))
#define XB_XSUB(j)  (1280 + 64 * (j))
#define XB_XGEN(j)  (2304 + 64 * (j))
#define XB_TOP      3328
#define XB_TOPGEN   3392
#define XCD_BAR_WORDS 3456
#define XB_SPIN_CAP (1u << 18)
#define LAS __attribute__((address_space(3)))

__device__ __forceinline__ unsigned xb_ld(unsigned* p)              { return __hip_atomic_load(p, __ATOMIC_RELAXED, __HIP_MEMORY_SCOPE_AGENT); }
__device__ __forceinline__ unsigned xb_add(unsigned* p, unsigned v) { return __hip_atomic_fetch_add(p, v, __ATOMIC_RELAXED, __HIP_MEMORY_SCOPE_AGENT); }
__device__ __forceinline__ unsigned xb_xcc_id() { return (unsigned)__builtin_amdgcn_s_getreg((3 << 11) | 20) & 0xFu; }
#define XB_SPIN(cond, bar) do { unsigned _sp = 0; while (cond) { __builtin_amdgcn_s_sleep(1); \
    if ((++_sp & 255u) == 0u) { if (xb_ld(&(bar)[XB_TMO])) break; if (_sp > XB_SPIN_CAP) { atomicAdd(&(bar)[XB_TMO], 1u); break; } } } } while (0)

struct XcdBarrier {
    unsigned* bar; unsigned x;
    volatile LAS unsigned* st;
};

__device__ __forceinline__ XcdBarrier xcd_barrier_post(unsigned* bar, volatile LAS unsigned* st) {
    XcdBarrier b; b.bar = bar; b.x = xb_xcc_id(); b.st = st;
    if (threadIdx.x == 0) (void)xb_add(&bar[XB_XCNT(b.x)], 1u);
    return b;
}
__device__ __forceinline__ void xcd_barrier_complete(unsigned* bar, unsigned x, unsigned& nloc, unsigned& nx) {
    const unsigned G = gridDim.x * gridDim.y * gridDim.z;
    unsigned sum, cnt, mine, sp = 0u;
    for (;;) {
        sum = 0u; cnt = 0u; mine = 0u;
#pragma unroll
        for (unsigned j = 0; j < 16; ++j) { const unsigned c = xb_ld(&bar[XB_XCNT(j)]); sum += c; cnt += (c > 0u) ? 1u : 0u; mine = (j == x) ? c : mine; }
        if (sum == G) break;
        __builtin_amdgcn_s_sleep(1);
        if ((++sp & 255u) == 0u) { if (xb_ld(&bar[XB_TMO])) break; if (sp > XB_SPIN_CAP) { atomicAdd(&bar[XB_TMO], 1u); break; } }
    }
    nloc = mine > 0u ? mine : 1u; nx = cnt > 0u ? cnt : 1u;
}

__device__ __forceinline__ void xcd_barrier(const XcdBarrier& b) {
    asm volatile("s_waitcnt vmcnt(0)" ::: "memory");
    __syncthreads();
    if (threadIdx.x == 0) {
        unsigned* bar = b.bar;
        __builtin_amdgcn_s_waitcnt(0);
        unsigned nloc = b.st[0], nx = b.st[1];
        if (nloc == 0u) { xcd_barrier_complete(bar, b.x, nloc, nx); b.st[0] = nloc; b.st[1] = nx; }
        const unsigned old = xb_add(&bar[XB_XSUB(b.x)], 1u);
        const unsigned gen = old / nloc;
        if (old + 1u == (gen + 1u) * nloc) {
            __builtin_amdgcn_fence(__ATOMIC_RELEASE, "agent");
            asm volatile("s_waitcnt vmcnt(0)" ::: "memory");
            const unsigned og = xb_add(&bar[XB_TOP], 1u);
            const unsigned tg = og / nx;
            if (og + 1u == (tg + 1u) * nx) xb_add(&bar[XB_TOPGEN], 1u);
            else XB_SPIN(xb_ld(&bar[XB_TOPGEN]) == tg, bar);
            __builtin_amdgcn_fence(__ATOMIC_ACQUIRE, "agent");
            xb_add(&bar[XB_XGEN(b.x)], 1u);
            asm volatile("s_waitcnt vmcnt(0)" ::: "memory");
        } else {
            XB_SPIN(xb_ld(&bar[XB_XGEN(b.x)]) == gen, bar);
            __builtin_amdgcn_fence(__ATOMIC_ACQUIRE, "agent");
            asm volatile("s_waitcnt vmcnt(0)" ::: "memory");
        }
    }
    __syncthreads();
}

__device__ __forceinline__ Params fresh(const Params& p) {
  Params q = p;
  asm volatile("" : "+s"(q.ws), "+s"(q.out));
#pragma unroll
  for (int i = 0; i < 21; ++i) asm volatile("" : "+s"(q.in[i]));
  return q;
}
#define PHASE_IDS int tid = threadIdx.x; asm volatile("" : "+v"(tid)); int bid = blockIdx.x; asm volatile("" : "+s"(bid)); int G = gridDim.x; asm volatile("" : "+s"(G)); \
  const int lane = tid & 63, wv = tid >> 6; const int ngt = G * NTHR, ngw = G * NWAVE; \
  const int gtid = bid * NTHR + tid, gw = bid * NWAVE + wv; (void)lane; (void)wv; (void)gtid; (void)gw; (void)ngt; (void)ngw; \
  const Params q = fresh(p);
__global__ void __launch_bounds__(NTHR) mega(Params p) {
  extern __shared__ __attribute__((aligned(16))) unsigned char lds_raw[];
  cg::grid_group grid = cg::this_grid();
  float* ldsf = (float*)lds_raw;
  if (threadIdx.x == 0) { *(uint4*)(lds_raw + LDS_BYTES - 16) = make_uint4(0u, 0u, 0u, 0u); }
  __syncthreads();
  XcdBarrier xb = xcd_barrier_post(p.bar(), (volatile LAS unsigned*)(lds_raw + LDS_BYTES - 16));

  { PHASE_IDS; phase_prologue(q, gtid, ngt, gw, ngw, lane); cvt_f32_bf16(q.in[18], q.skb(), (size_t)NL * 16 * 128 * 64 / 8, gtid, ngt);
    for (size_t i = gtid; i < (size_t)16 * 256 * 512 / 8; i += ngt) ((uint4*)q.S5Wz())[i] = make_uint4(0u, 0u, 0u, 0u);
    if (gtid < 256) q.qctr()[gtid] = 0; }
  grid.sync();
  { constexpr int l = 0;
    DUP(6) {
    { PHASE_IDS; phase_cvt_rows(q.out, q.xb(), q.rstd(), gw, ngw, lane);
      phase_s5_prep(q, l, gtid, ngt);
 }
    xcd_barrier(xb);
    }
    DUP(5) {
    { const Params q = fresh(p); EpiScaleStoreBf16 e{q.projb(), INW, q.rstd()};
      run_gemm(lds_raw, q.xb(), q.Win_t() + (size_t)l * INW * KD, T, INW, KD, e); }
    xcd_barrier(xb);
    }
    DUP(0) {
    { PHASE_IDS; phase_post_pack(q, l, gtid, ngt, gw, ngw, lane); phase_pack_u(q, gtid, ngt); }
    xcd_barrier(xb);
    }
    DUP(1) {
    { const Params q = fresh(p); EpiS5Z e{q.S5Z()};
      pg8::Gemm g{q.S5A(), q.S5Wz(), 16 * 1024, 16 * 256, 512, 640, 512}; pg8::GroupOrder So; So.init(16, 4, 1, (int)gridDim.x, (int)blockIdx.x);
      pg8::gemm_phase<EpiS5Z, pg8::GroupOrder, true, true>((PG8_LAS unsigned char*)lds_raw, g, So, e); }
    { PHASE_IDS; phase_kmean2(q, gtid, ngt); phase_ret_kv(q, gw, ngw, lane); }
    xcd_barrier(xb);
    }
    DUP(2) {
    { PHASE_IDS; phase_s5_scan(q, gtid, ngt); phase_ret_scan(q, gtid, ngt); }
    __syncthreads();
    { PHASE_IDS; phase_moba2(q, l, lds_raw, bid, G); }
    xcd_barrier(xb);
    }
    DUP(3) {
    { const Params q = fresh(p); EpiS5Y e{q.ygb(), q.S5A(), q.in[10] + l * 256};
      pg8::Gemm g{q.S5A(), q.S5Wy(), 16 * 1024, 16 * 512, 640, 640, 640}; pg8::GroupOrder So; So.init(16, 4, 2, (int)gridDim.x, (int)blockIdx.x);
      pg8::gemm_phase<EpiS5Y, pg8::GroupOrder, true, true>((PG8_LAS unsigned char*)lds_raw, g, So, e); }
    __syncthreads();
    { PHASE_IDS; phase_ret_out(q, gw, ngw, lane); }
    xcd_barrier(xb);
    }
    DUP(4) {
    { const Params q = fresh(p); EpiGlu e{q.xb(), q.ygb(), (float*)(lds_raw + 131072)};
      run_gemm(lds_raw, q.ygb(), q.Wglu_t() + (size_t)l * 65536, T, 256, 256, e); }
    xcd_barrier(xb);
    }
    { const Params q = fresh(p); EpiAccum e{q.out, D};
      run_gemm(lds_raw, q.xb(), q.Wout_t() + (size_t)l * D * KD, T, D, KD, e); }
    xcd_barrier(xb);
    DUP(10) {
    { PHASE_IDS; phase_cvt_rows_h8(q, l, gw, ngw, lane);
      cvt_table_fp8(q.in[19] + (size_t)l * 16384 * D, q.U8s(), q.su(), gw, ngw, lane);
      cvt_table_fp8(q.in[20] + (size_t)l * 16384 * D, q.V8s(), q.sv(), gw, ngw, lane); }
    xcd_barrier(xb);
    }
    DUP(7) {
    { const Params q = fresh(p); EpiScaleStoreBf16 e{q.qb(), D, q.rstd()};
      run_gemm(lds_raw, q.xb(), q.Wq_t() + (size_t)l * D * KD, T, D, KD, e); }
    xcd_barrier(xb);
    }
    if (!(PROBE_SKIP & 2)) {
    DUP(8) {
    { PHASE_IDS; phase_peer_topk(q, l, gw, ngw, lane); }
    xcd_barrier(xb);
    }
    }
#if PEER_CHECK
    if (l == 0) { { PHASE_IDS; chk_save(q, gtid, ngt); } xcd_barrier(xb); { PHASE_IDS; chk_topk(q, l, gtid, ngt); } xcd_barrier(xb); }
#endif
    if (!(PROBE_SKIP & 1)) {
    { PHASE_IDS; phase_peer_u(q, q.qctr() + (l * 2 + 0) * 8, lds_raw, tid); }
    xcd_barrier(xb);
    { PHASE_IDS; phase_peer_r(q, gtid, ngt); }
    xcd_barrier(xb);
    if (!(PROBE_SKIP & 32)) {
    { PHASE_IDS; phase_peer_v(q, q.qctr() + (l * 2 + 1) * 8, lds_raw, tid); }
    xcd_barrier(xb);
    }
    }
#if PEER_CHECK
    if (l == 0) { { PHASE_IDS; chk_apply(q, l, ldsf + wv * 128, gw, ngw, lane); } xcd_barrier(xb);
      if (blockIdx.x == 0 && threadIdx.x == 0) { const Params q = fresh(p); chk_emit(q); } xcd_barrier(xb); }
#endif
  }
  { constexpr int l = 1;
    DUP(6) {
    { PHASE_IDS; phase_cvt_rows(q.out, q.xb(), q.rstd(), gw, ngw, lane);
      phase_s5_prep(q, l, gtid, ngt);
 }
    xcd_barrier(xb);
    }
    DUP(5) {
    { const Params q = fresh(p); EpiScaleStoreBf16 e{q.projb(), INW, q.rstd()};
      run_gemm(lds_raw, q.xb(), q.Win_t() + (size_t)l * INW * KD, T, INW, KD, e); }
    xcd_barrier(xb);
    }
    DUP(0) {
    { PHASE_IDS; phase_post_pack(q, l, gtid, ngt, gw, ngw, lane); phase_pack_u(q, gtid, ngt); }
    xcd_barrier(xb);
    }
    DUP(1) {
    { const Params q = fresh(p); EpiS5Z e{q.S5Z()};
      pg8::Gemm g{q.S5A(), q.S5Wz(), 16 * 1024, 16 * 256, 512, 640, 512}; pg8::GroupOrder So; So.init(16, 4, 1, (int)gridDim.x, (int)blockIdx.x);
      pg8::gemm_phase<EpiS5Z, pg8::GroupOrder, true, true>((PG8_LAS unsigned char*)lds_raw, g, So, e); }
    { PHASE_IDS; phase_kmean2(q, gtid, ngt); phase_ret_kv(q, gw, ngw, lane); }
    xcd_barrier(xb);
    }
    DUP(2) {
    { PHASE_IDS; phase_s5_scan(q, gtid, ngt); phase_ret_scan(q, gtid, ngt); }
    __syncthreads();
    { PHASE_IDS; phase_moba2(q, l, lds_raw, bid, G); }
    xcd_barrier(xb);
    }
    DUP(3) {
    { const Params q = fresh(p); EpiS5Y e{q.ygb(), q.S5A(), q.in[10] + l * 256};
      pg8::Gemm g{q.S5A(), q.S5Wy(), 16 * 1024, 16 * 512, 640, 640, 640}; pg8::GroupOrder So; So.init(16, 4, 2, (int)gridDim.x, (int)blockIdx.x);
      pg8::gemm_phase<EpiS5Y, pg8::GroupOrder, true, true>((PG8_LAS unsigned char*)lds_raw, g, So, e); }
    __syncthreads();
    { PHASE_IDS; phase_ret_out(q, gw, ngw, lane); }
    xcd_barrier(xb);
    }
    DUP(4) {
    { const Params q = fresh(p); EpiGlu e{q.xb(), q.ygb(), (float*)(lds_raw + 131072)};
      run_gemm(lds_raw, q.ygb(), q.Wglu_t() + (size_t)l * 65536, T, 256, 256, e); }
    xcd_barrier(xb);
    }
    { const Params q = fresh(p); EpiAccum e{q.out, D};
      run_gemm(lds_raw, q.xb(), q.Wout_t() + (size_t)l * D * KD, T, D, KD, e); }
    xcd_barrier(xb);
    DUP(10) {
    { PHASE_IDS; phase_cvt_rows_h8(q, l, gw, ngw, lane);
      cvt_table_fp8(q.in[19] + (size_t)l * 16384 * D, q.U8s(), q.su(), gw, ngw, lane);
      cvt_table_fp8(q.in[20] + (size_t)l * 16384 * D, q.V8s(), q.sv(), gw, ngw, lane); }
    xcd_barrier(xb);
    }
    DUP(7) {
    { const Params q = fresh(p); EpiScaleStoreBf16 e{q.qb(), D, q.rstd()};
      run_gemm(lds_raw, q.xb(), q.Wq_t() + (size_t)l * D * KD, T, D, KD, e); }
    xcd_barrier(xb);
    }
    if (!(PROBE_SKIP & 2)) {
    DUP(8) {
    { PHASE_IDS; phase_peer_topk(q, l, gw, ngw, lane); }
    xcd_barrier(xb);
    }
    }
#if PEER_CHECK
    if (l == 0) { { PHASE_IDS; chk_save(q, gtid, ngt); } xcd_barrier(xb); { PHASE_IDS; chk_topk(q, l, gtid, ngt); } xcd_barrier(xb); }
#endif
    if (!(PROBE_SKIP & 1)) {
    { PHASE_IDS; phase_peer_u(q, q.qctr() + (l * 2 + 0) * 8, lds_raw, tid); }
    xcd_barrier(xb);
    { PHASE_IDS; phase_peer_r(q, gtid, ngt); }
    xcd_barrier(xb);
    if (!(PROBE_SKIP & 32)) {
    { PHASE_IDS; phase_peer_v(q, q.qctr() + (l * 2 + 1) * 8, lds_raw, tid); }
    xcd_barrier(xb);
    }
    }
#if PEER_CHECK
    if (l == 0) { { PHASE_IDS; chk_apply(q, l, ldsf + wv * 128, gw, ngw, lane); } xcd_barrier(xb);
      if (blockIdx.x == 0 && threadIdx.x == 0) { const Params q = fresh(p); chk_emit(q); } xcd_barrier(xb); }
#endif
  }
  { constexpr int l = 2;
    DUP(6) {
    { PHASE_IDS; phase_cvt_rows(q.out, q.xb(), q.rstd(), gw, ngw, lane);
      phase_s5_prep(q, l, gtid, ngt);
 }
    xcd_barrier(xb);
    }
    DUP(5) {
    { const Params q = fresh(p); EpiScaleStoreBf16 e{q.projb(), INW, q.rstd()};
      run_gemm(lds_raw, q.xb(), q.Win_t() + (size_t)l * INW * KD, T, INW, KD, e); }
    xcd_barrier(xb);
    }
    DUP(0) {
    { PHASE_IDS; phase_post_pack(q, l, gtid, ngt, gw, ngw, lane); phase_pack_u(q, gtid, ngt); }
    xcd_barrier(xb);
    }
    DUP(1) {
    { const Params q = fresh(p); EpiS5Z e{q.S5Z()};
      pg8::Gemm g{q.S5A(), q.S5Wz(), 16 * 1024, 16 * 256, 512, 640, 512}; pg8::GroupOrder So; So.init(16, 4, 1, (int)gridDim.x, (int)blockIdx.x);
      pg8::gemm_phase<EpiS5Z, pg8::GroupOrder, true, true>((PG8_LAS unsigned char*)lds_raw, g, So, e); }
    { PHASE_IDS; phase_kmean2(q, gtid, ngt); phase_ret_kv(q, gw, ngw, lane); }
    xcd_barrier(xb);
    }
    DUP(2) {
    { PHASE_IDS; phase_s5_scan(q, gtid, ngt); phase_ret_scan(q, gtid, ngt); }
    __syncthreads();
    { PHASE_IDS; phase_moba2(q, l, lds_raw, bid, G); }
    xcd_barrier(xb);
    }
    DUP(3) {
    { const Params q = fresh(p); EpiS5Y e{q.ygb(), q.S5A(), q.in[10] + l * 256};
      pg8::Gemm g{q.S5A(), q.S5Wy(), 16 * 1024, 16 * 512, 640, 640, 640}; pg8::GroupOrder So; So.init(16, 4, 2, (int)gridDim.x, (int)blockIdx.x);
      pg8::gemm_phase<EpiS5Y, pg8::GroupOrder, true, true>((PG8_LAS unsigned char*)lds_raw, g, So, e); }
    __syncthreads();
    { PHASE_IDS; phase_ret_out(q, gw, ngw, lane); }
    xcd_barrier(xb);
    }
    DUP(4) {
    { const Params q = fresh(p); EpiGlu e{q.xb(), q.ygb(), (float*)(lds_raw + 131072)};
      run_gemm(lds_raw, q.ygb(), q.Wglu_t() + (size_t)l * 65536, T, 256, 256, e); }
    xcd_barrier(xb);
    }
    { const Params q = fresh(p); EpiAccum e{q.out, D};
      run_gemm(lds_raw, q.xb(), q.Wout_t() + (size_t)l * D * KD, T, D, KD, e); }
    xcd_barrier(xb);
    DUP(10) {
    { PHASE_IDS; phase_cvt_rows_h8(q, l, gw, ngw, lane);
      cvt_table_fp8(q.in[19] + (size_t)l * 16384 * D, q.U8s(), q.su(), gw, ngw, lane);
      cvt_table_fp8(q.in[20] + (size_t)l * 16384 * D, q.V8s(), q.sv(), gw, ngw, lane); }
    xcd_barrier(xb);
    }
    DUP(7) {
    { const Params q = fresh(p); EpiScaleStoreBf16 e{q.qb(), D, q.rstd()};
      run_gemm(lds_raw, q.xb(), q.Wq_t() + (size_t)l * D * KD, T, D, KD, e); }
    xcd_barrier(xb);
    }
    if (!(PROBE_SKIP & 2)) {
    DUP(8) {
    { PHASE_IDS; phase_peer_topk(q, l, gw, ngw, lane); }
    xcd_barrier(xb);
    }
    }
#if PEER_CHECK
    if (l == 0) { { PHASE_IDS; chk_save(q, gtid, ngt); } xcd_barrier(xb); { PHASE_IDS; chk_topk(q, l, gtid, ngt); } xcd_barrier(xb); }
#endif
    if (!(PROBE_SKIP & 1)) {
    { PHASE_IDS; phase_peer_u(q, q.qctr() + (l * 2 + 0) * 8, lds_raw, tid); }
    xcd_barrier(xb);
    { PHASE_IDS; phase_peer_r(q, gtid, ngt); }
    xcd_barrier(xb);
    if (!(PROBE_SKIP & 32)) {
    { PHASE_IDS; phase_peer_v(q, q.qctr() + (l * 2 + 1) * 8, lds_raw, tid); }
    xcd_barrier(xb);
    }
    }
#if PEER_CHECK
    if (l == 0) { { PHASE_IDS; chk_apply(q, l, ldsf + wv * 128, gw, ngw, lane); } xcd_barrier(xb);
      if (blockIdx.x == 0 && threadIdx.x == 0) { const Params q = fresh(p); chk_emit(q); } xcd_barrier(xb); }
#endif
  }
  { constexpr int l = 3;
    DUP(6) {
    { PHASE_IDS; phase_cvt_rows(q.out, q.xb(), q.rstd(), gw, ngw, lane);
      phase_s5_prep(q, l, gtid, ngt);
 }
    xcd_barrier(xb);
    }
    DUP(5) {
    { const Params q = fresh(p); EpiScaleStoreBf16 e{q.projb(), INW, q.rstd()};
      run_gemm(lds_raw, q.xb(), q.Win_t() + (size_t)l * INW * KD, T, INW, KD, e); }
    xcd_barrier(xb);
    }
    DUP(0) {
    { PHASE_IDS; phase_post_pack(q, l, gtid, ngt, gw, ngw, lane); phase_pack_u(q, gtid, ngt); }
    xcd_barrier(xb);
    }
    DUP(1) {
    { const Params q = fresh(p); EpiS5Z e{q.S5Z()};
      pg8::Gemm g{q.S5A(), q.S5Wz(), 16 * 1024, 16 * 256, 512, 640, 512}; pg8::GroupOrder So; So.init(16, 4, 1, (int)gridDim.x, (int)blockIdx.x);
      pg8::gemm_phase<EpiS5Z, pg8::GroupOrder, true, true>((PG8_LAS unsigned char*)lds_raw, g, So, e); }
    { PHASE_IDS; phase_kmean2(q, gtid, ngt); phase_ret_kv(q, gw, ngw, lane); }
    xcd_barrier(xb);
    }
    DUP(2) {
    { PHASE_IDS; phase_s5_scan(q, gtid, ngt); phase_ret_scan(q, gtid, ngt); }
    __syncthreads();
    { PHASE_IDS; phase_moba2(q, l, lds_raw, bid, G); }
    xcd_barrier(xb);
    }
    DUP(3) {
    { const Params q = fresh(p); EpiS5Y e{q.ygb(), q.S5A(), q.in[10] + l * 256};
      pg8::Gemm g{q.S5A(), q.S5Wy(), 16 * 1024, 16 * 512, 640, 640, 640}; pg8::GroupOrder So; So.init(16, 4, 2, (int)gridDim.x, (int)blockIdx.x);
      pg8::gemm_phase<EpiS5Y, pg8::GroupOrder, true, true>((PG8_LAS unsigned char*)lds_raw, g, So, e); }
    __syncthreads();
    { PHASE_IDS; phase_ret_out(q, gw, ngw, lane); }
    xcd_barrier(xb);
    }
    DUP(4) {
    { const Params q = fresh(p); EpiGlu e{q.xb(), q.ygb(), (float*)(lds_raw + 131072)};
      run_gemm(lds_raw, q.ygb(), q.Wglu_t() + (size_t)l * 65536, T, 256, 256, e); }
    xcd_barrier(xb);
    }
    { const Params q = fresh(p); EpiAccum e{q.out, D};
      run_gemm(lds_raw, q.xb(), q.Wout_t() + (size_t)l * D * KD, T, D, KD, e); }
    xcd_barrier(xb);
    DUP(10) {
    { PHASE_IDS; phase_cvt_rows_h8(q, l, gw, ngw, lane);
      cvt_table_fp8(q.in[19] + (size_t)l * 16384 * D, q.U8s(), q.su(), gw, ngw, lane);
      cvt_table_fp8(q.in[20] + (size_t)l * 16384 * D, q.V8s(), q.sv(), gw, ngw, lane); }
    xcd_barrier(xb);
    }
    DUP(7) {
    { const Params q = fresh(p); EpiScaleStoreBf16 e{q.qb(), D, q.rstd()};
      run_gemm(lds_raw, q.xb(), q.Wq_t() + (size_t)l * D * KD, T, D, KD, e); }
    xcd_barrier(xb);
    }
    if (!(PROBE_SKIP & 2)) {
    DUP(8) {
    { PHASE_IDS; phase_peer_topk(q, l, gw, ngw, lane); }
    xcd_barrier(xb);
    }
    }
#if PEER_CHECK
    if (l == 0) { { PHASE_IDS; chk_save(q, gtid, ngt); } xcd_barrier(xb); { PHASE_IDS; chk_topk(q, l, gtid, ngt); } xcd_barrier(xb); }
#endif
    if (!(PROBE_SKIP & 1)) {
    { PHASE_IDS; phase_peer_u(q, q.qctr() + (l * 2 + 0) * 8, lds_raw, tid); }
    xcd_barrier(xb);
    { PHASE_IDS; phase_peer_r(q, gtid, ngt); }
    xcd_barrier(xb);
    if (!(PROBE_SKIP & 32)) {
    { PHASE_IDS; phase_peer_v(q, q.qctr() + (l * 2 + 1) * 8, lds_raw, tid); }
    xcd_barrier(xb);
    }
    }
#if PEER_CHECK
    if (l == 0) { { PHASE_IDS; chk_apply(q, l, ldsf + wv * 128, gw, ngw, lane); } xcd_barrier(xb);
      if (blockIdx.x == 0 && threadIdx.x == 0) { const Params q = fresh(p); chk_emit(q); } xcd_barrier(xb); }
#endif
  }
}

}

extern "C" void kernel_launch(void* const* d_in, const int* in_sizes, int n_in, void* d_out, int out_size, void* d_ws, size_t ws_size,
                              hipStream_t stream) {
  static int grid_blocks = 0;
  if (!grid_blocks) {
    int dev = 0, cus = 0, per_cu = 0;
    hipGetDevice(&dev);
    hipDeviceGetAttribute(&cus, hipDeviceAttributeMultiprocessorCount, dev);
    hipFuncSetAttribute((const void*)mega, hipFuncAttributeMaxDynamicSharedMemorySize, LDS_BYTES);
    hipOccupancyMaxActiveBlocksPerMultiprocessor(&per_cu, (const void*)mega, NTHR, LDS_BYTES);
    if (per_cu < 1) { fprintf(stderr, "occupancy query returned %d\n", per_cu); per_cu = 1; }
    grid_blocks = cus * 1;
    if (grid_blocks < 64) fprintf(stderr, "unexpected CU count %d\n", cus);
  }
  Params p{};
  for (int i = 0; i < 21; ++i) p.in[i] = (const float*)d_in[i];
  p.out = (float*)d_out;
  p.ws = (unsigned char*)d_ws;
  if (WS_TOTAL > ws_size) { fprintf(stderr, "workspace too small: need %zu have %zu\n", (size_t)WS_TOTAL, ws_size); return; }
  hipMemsetAsync((unsigned char*)d_ws + WO_bar, 0, 16384, stream);
  void* args[] = {&p};
  hipError_t e = hipLaunchCooperativeKernel((const void*)mega, dim3(grid_blocks), dim3(NTHR), args, LDS_BYTES, stream);
  if (e != hipSuccess) fprintf(stderr, "cooperative launch failed: %s (grid %d)\n", hipGetErrorString(e), grid_blocks);
}
```

```cpp
#include <hip/hip_runtime.h>
#include <hip/hip_cooperative_groups.h>
#include <math.h>
#include <stdint.h>
#include <stdio.h>
namespace cg = cooperative_groups;

#ifndef PEER_CHECK
#define PEER_CHECK 0
#endif
#ifndef PROBE_DUP
#define PROBE_DUP 0
#endif
__device__ __forceinline__ int dup_n(int n) { asm volatile("" : "+s"(n)); return n; }
#define DUP(bit) _Pragma("unroll 1") for (int rep_ = 0, repn_ = (((PROBE_DUP >> (bit)) & 1) ? dup_n(2) : 1); rep_ < repn_; ++rep_)
#ifndef PROBE_SKIP
#define PROBE_SKIP 0
#endif
#ifndef PRECISE
#define PRECISE 0
#endif

namespace {
constexpr int NB = 8, S = 4096, D = 1024, NL = 4, T = NB * S;
constexpr int INW = 2816;
constexpr int OFF_U = 0, OFF_QM = 256, OFF_KM = 768, OFF_VM = 1280, OFF_QR = 1792, OFF_KR = 2048, OFF_VR = 2304, OFF_GR = 2560;
constexpr float EPS = 1e-6f;
static_assert(PRECISE == 0, "PRECISE builds are retired");
constexpr int KS = PRECISE ? 3 : 1;
constexpr int KD = D * KS;
constexpr int NTHR = 512, NWAVE = 8;
constexpr int LDS_BYTES = 131072 + 4096 + 1024;

typedef unsigned short bf16_t;
using bf16x8 = __attribute__((ext_vector_type(8))) short;
using f32x4 = __attribute__((ext_vector_type(4))) float;

__device__ __forceinline__ float wave_sum(float v) {
#pragma unroll
  for (int o = 32; o > 0; o >>= 1) v += __shfl_xor(v, o);
  return v;
}
__device__ __forceinline__ float wave_max(float v) {
#pragma unroll
  for (int o = 32; o > 0; o >>= 1) v = fmaxf(v, __shfl_xor(v, o));
  return v;
}
__device__ __forceinline__ float gelu_tanh(float x) {
  const float k0 = 0.7978845608028654f, k1 = 0.044715f;
  float u = k0 * (x + k1 * x * x * x);
  return 0.5f * x * (1.0f + tanhf(u));
}
__device__ __forceinline__ float sigmoidf_(float x) { return 1.0f / (1.0f + expf(-x)); }
__device__ __forceinline__ float fast_sigmoid(float x) { return __builtin_amdgcn_rcpf(1.0f + __builtin_amdgcn_exp2f(-1.4426950408889634f * x)); }
__device__ __forceinline__ float fast_gelu(float x) { const float u = 0.7978845608028654f * (x + 0.044715f * x * x * x); return x * fast_sigmoid(2.0f * u); }
__device__ __forceinline__ bf16_t f2bf(float f) {
  unsigned u = __float_as_uint(f);
  u += 0x7fffu + ((u >> 16) & 1u);
  return (bf16_t)(u >> 16);
}
__device__ __forceinline__ float bf2f(bf16_t h) { return __uint_as_float(((unsigned)h) << 16); }
#define LDS_FENCE() asm volatile("s_waitcnt lgkmcnt(0)" ::: "memory")
typedef __bf16 bf16x2_hw __attribute__((ext_vector_type(2)));
typedef float f32x2_hw __attribute__((ext_vector_type(2)));
__device__ __forceinline__ unsigned pk_bf16(float lo, float hi) { const f32x2_hw f = {lo, hi}; const bf16x2_hw b = __builtin_convertvector(f, bf16x2_hw); return __builtin_bit_cast(unsigned, b); }
typedef float f32x16 __attribute__((ext_vector_type(16)));

constexpr size_t al256(size_t x) { return (x + 255) & ~(size_t)255; }
constexpr size_t WO_rstd = 0;
constexpr size_t WO_cosm = WO_rstd + al256((size_t)T * 4);
constexpr size_t WO_sinm = WO_cosm + al256((size_t)S * 8 * 4);
constexpr size_t WO_cosr = WO_sinm + al256((size_t)S * 8 * 4);
constexpr size_t WO_sinr = WO_cosr + al256((size_t)S * 32 * 4);
constexpr size_t WO_kmean = WO_sinr + al256((size_t)S * 32 * 4);
constexpr size_t WO_proj = WO_kmean + al256((size_t)NB * 8 * 16 * 64 * 4);
constexpr size_t WO_ybuf = WO_proj + al256((size_t)T * INW * 4);
constexpr size_t WO_yg = WO_ybuf + al256((size_t)T * D * 4);
constexpr size_t WO_skb = WO_yg + al256((size_t)T * 256 * 4);
constexpr size_t WO_Ub = WO_skb + al256((size_t)NL * 16 * 128 * 64 * 2);
constexpr size_t WO_Vb = WO_Ub + al256((size_t)16384 * D * 2);
constexpr size_t WO_gates = WO_Vb + al256((size_t)16384 * D * 2);
constexpr size_t WO_eidx = WO_gates + al256((size_t)T * 128 * 4);
constexpr size_t WO_xb = WO_eidx + al256((size_t)T * 128 * 4);
constexpr size_t WO_Win_t = WO_xb + al256((size_t)T * KD * 2);
constexpr size_t WO_Wout_t = WO_Win_t + al256((size_t)NL * INW * KD * 2);
constexpr size_t WO_Wq_t = WO_Wout_t + al256((size_t)NL * D * KD * 2);
constexpr size_t WO_Qm = WO_Wq_t + al256((size_t)NL * D * KD * 2);
constexpr size_t WO_Km = WO_Qm + al256((size_t)T * 512 * 2);
constexpr size_t WO_Vm = WO_Km + al256((size_t)T * 512 * 2);
constexpr size_t WO_S5a32 = WO_Vm + al256((size_t)T * 512 * 2);
constexpr size_t WO_Wglu_t = WO_S5a32 + al256((size_t)16 * 64 * 2 * 4);
constexpr size_t WO_Qr = WO_Wglu_t + al256((size_t)NL * 256 * 256 * 2);
constexpr size_t WO_Kr = WO_Qr + al256((size_t)T * 256 * 2);
constexpr size_t WO_Krv = WO_Kr + al256((size_t)T * 256 * 2);
constexpr size_t WO_Vr = WO_Krv + al256((size_t)T * 256 * 2);
constexpr size_t WO_KVr = WO_Vr + al256((size_t)T * 256 * 2);
constexpr size_t WO_Rb = WO_KVr + al256((size_t)32 * 32 * 4096 * 4);
constexpr size_t WO_qctr = WO_Rb + al256((size_t)32 * 32 * 4096 * 2);
constexpr size_t WO_bar = WO_qctr + al256(1024);
constexpr size_t WO_S5Wy = WO_bar + al256(16384);
constexpr size_t WO_S5Wz = WO_S5Wy + al256((size_t)16 * 512 * 640 * 2);
constexpr size_t WO_ssq1 = WO_S5Wz + al256((size_t)16 * 256 * 512 * 2);
constexpr size_t WO_ssq2 = WO_ssq1 + al256((size_t)T * 8 * 4);
constexpr size_t WS_TOTAL = WO_ssq2 + al256((size_t)T * 16 * 4);
constexpr size_t WO_S5A = WO_gates;
constexpr size_t WO_S5Z = WO_S5A + al256((size_t)16 * 1024 * 640 * 2);
static_assert(WO_S5Z + (size_t)16 * 1024 * 128 * 4 <= WO_gates + 2 * al256((size_t)T * 128 * 4), "S5A/S5Z must fit in gates+eidx");
#define GAS __attribute__((address_space(1)))
static_assert((size_t)T * D * 2 + (size_t)T * 128 * 8 * 4 + (size_t)T * D * 2 <= (size_t)T * INW * 4, "qb + ppart + xb2 must fit in the proj region");
struct Params {
  const GAS float* in[21];
  GAS float* out_;
  GAS unsigned char* ws;
  __device__ __forceinline__ const float* inp(int i) const { return (const float*)in[i]; }
  __device__ __forceinline__ float* outp() const { return (float*)out_; }
  __device__ __forceinline__ float* rstd() const { return (float*)(ws + WO_rstd); }
  __device__ __forceinline__ float* cosm() const { return (float*)(ws + WO_cosm); }
  __device__ __forceinline__ float* sinm() const { return (float*)(ws + WO_sinm); }
  __device__ __forceinline__ float* cosr() const { return (float*)(ws + WO_cosr); }
  __device__ __forceinline__ float* sinr() const { return (float*)(ws + WO_sinr); }
  __device__ __forceinline__ float* kmean() const { return (float*)(ws + WO_kmean); }
  __device__ __forceinline__ float* proj() const { return (float*)(ws + WO_proj); }
  __device__ __forceinline__ float* ybuf() const { return (float*)(ws + WO_ybuf); }
  __device__ __forceinline__ float* yg() const { return (float*)(ws + WO_yg); }
  __device__ __forceinline__ bf16_t* skb() const { return (bf16_t*)(ws + WO_skb); }
  __device__ __forceinline__ bf16_t* Ub() const { return (bf16_t*)(ws + WO_Ub); }
  __device__ __forceinline__ bf16_t* Vb() const { return (bf16_t*)(ws + WO_Vb); }
  __device__ __forceinline__ float* gates() const { return (float*)(ws + WO_gates); }
  __device__ __forceinline__ int* eidx() const { return (int*)(ws + WO_eidx); }
  __device__ __forceinline__ bf16_t* xb() const { return (bf16_t*)(ws + WO_xb); }
  __device__ __forceinline__ bf16_t* Win_t() const { return (bf16_t*)(ws + WO_Win_t); }
  __device__ __forceinline__ bf16_t* Wout_t() const { return (bf16_t*)(ws + WO_Wout_t); }
  __device__ __forceinline__ bf16_t* Wq_t() const { return (bf16_t*)(ws + WO_Wq_t); }
  __device__ __forceinline__ bf16_t* Qm() const { return (bf16_t*)(ws + WO_Qm); }
  __device__ __forceinline__ bf16_t* Km() const { return (bf16_t*)(ws + WO_Km); }
  __device__ __forceinline__ bf16_t* Vm() const { return (bf16_t*)(ws + WO_Vm); }
  __device__ __forceinline__ bf16_t* S5A() const { return (bf16_t*)(ws + WO_S5A); }
  __device__ __forceinline__ bf16_t* S5Wy() const { return (bf16_t*)(ws + WO_S5Wy); }
  __device__ __forceinline__ bf16_t* S5Wz() const { return (bf16_t*)(ws + WO_S5Wz); }
  __device__ __forceinline__ float* S5Z() const { return (float*)(ws + WO_S5Z); }
  __device__ __forceinline__ float* S5a32() const { return (float*)(ws + WO_S5a32); }
  __device__ __forceinline__ bf16_t* Wglu_t() const { return (bf16_t*)(ws + WO_Wglu_t); }
  __device__ __forceinline__ bf16_t* ygb() const { return (bf16_t*)(ws + WO_yg); }
  __device__ __forceinline__ int* qctr() const { return (int*)(ws + WO_qctr); }
  __device__ __forceinline__ unsigned char* U8s() const { return (unsigned char*)(ws + WO_Ub); }
  __device__ __forceinline__ float* su() const { return (float*)(ws + WO_Ub + (size_t)16384 * D); }
  __device__ __forceinline__ unsigned char* V8s() const { return (unsigned char*)(ws + WO_Vb); }
  __device__ __forceinline__ float* sv() const { return (float*)(ws + WO_Vb + (size_t)16384 * D); }
  __device__ __forceinline__ bf16_t* hb() const { return (bf16_t*)(ws + WO_ybuf + ((size_t)4 << 20)); }
  __device__ __forceinline__ unsigned char* h8lo() const { return (unsigned char*)(ws + WO_ybuf + ((size_t)4 << 20) + (size_t)T * D); }
  __device__ __forceinline__ float* sh() const { return (float*)(ws + WO_ybuf + ((size_t)4 << 20) + (size_t)2 * T * D); }
  __device__ __forceinline__ float* ppart() const { return (float*)(ws + WO_proj + (size_t)T * D * 2); }
  __device__ __forceinline__ bf16_t* Qr() const { return (bf16_t*)(ws + WO_Qr); }
  __device__ __forceinline__ bf16_t* Kr() const { return (bf16_t*)(ws + WO_Kr); }
  __device__ __forceinline__ bf16_t* Krv() const { return (bf16_t*)(ws + WO_Krv); }
  __device__ __forceinline__ bf16_t* Vr() const { return (bf16_t*)(ws + WO_Vr); }
  __device__ __forceinline__ float* KVr() const { return (float*)(ws + WO_KVr); }
  __device__ __forceinline__ bf16_t* Rb() const { return (bf16_t*)(ws + WO_Rb); }
  __device__ __forceinline__ unsigned* bar() const { return (unsigned*)(ws + WO_bar); }
  __device__ __forceinline__ bf16_t* projb() const { return (bf16_t*)(ws + WO_proj); }
  __device__ __forceinline__ float* ssq1() const { return (float*)(ws + WO_ssq1); }
  __device__ __forceinline__ float* ssq2() const { return (float*)(ws + WO_ssq2); }
  __device__ __forceinline__ bf16_t* xb2() const { return (bf16_t*)(ws + WO_proj + (size_t)T * D * 2 + (size_t)T * 128 * 8 * 4); }
  __device__ __forceinline__ bf16_t* qb() const { return (bf16_t*)(ws + WO_proj); }
};

namespace pg8 {
#define PG8_LAS __attribute__((address_space(3)))
typedef unsigned short bf16_t;
typedef short bf16x8 __attribute__((ext_vector_type(8)));
typedef float f32x4 __attribute__((ext_vector_type(4)));
typedef unsigned u32x4 __attribute__((ext_vector_type(4)));
constexpr int BM = 256, BK = 64, HALF = 128, HTB = HALF * BK * 2  , STAGE_BYTES = 8 * HTB, NXCD = 8, WGM = 8;

__host__ __device__ __forceinline__ int lds_byte(int r, int c) { const int st = (r >> 4) * 2 + (c >> 5), rr = r & 15, cc = c & 31, ob = rr * 64 + cc * 2; return st * 1024 + (ob ^ (((ob >> 9) & 1) << 5)); }
__host__ __device__ __forceinline__ void stage_rc(int b, int& R, int& C) { const int st = b / 1024, sb = b % 1024, swz = sb ^ (((sb >> 9) & 1) << 5); R = (st >> 1) * 16 + swz / 64; C = (st & 1) * 32 + (swz % 64) / 2; }
__host__ __device__ __forceinline__ int perm32(int rho) { const int n = rho >> 4, i = rho & 15; return 8 * (i >> 2) + 4 * n + (i & 3); }

struct Unit { int pm, pn; };
struct Gemm { const bf16_t* A; const bf16_t* Bt; int M, N, K, lda, ldb; };

struct StaticOrder {
    int nM, nN, nwg, G, c;
    __host__ __device__ void init(int M, int N, int G_, int c_) { nM = M / BM; nN = N / BM; nwg = nM * nN; G = G_; c = c_; }
    __host__ __device__ bool next(int i, Unit& u) const {
        const long L = (long)i * G + c; if (L >= nwg) return false;
        int wgid = (int)L; { const int q = nwg / NXCD, r = nwg % NXCD, xcd = wgid % NXCD, off = wgid / NXCD; wgid = (xcd < r ? xcd * (q + 1) : r * (q + 1) + (xcd - r) * q) + off; }
        const int nig = WGM * nN, gid = wgid / nig, fm = gid * WGM, gsz = (nM - fm) < WGM ? (nM - fm) : WGM;
        u.pm = fm + ((wgid % nig) % gsz); u.pn = (wgid % nig) / gsz; return true;
    }
    __device__ __forceinline__ void a_ready(const Unit&) const {}
    __device__ __forceinline__ void done(const Unit&) const {}
};
struct GroupOrder {
    int mt, nt_, nwg, G, c;
    __host__ __device__ void init(int ngroups, int mt__, int nt__, int G_, int c_) { mt = mt__; nt_ = nt__; nwg = ngroups * mt * nt_; G = G_; c = c_; }
    __host__ __device__ bool next(int i, Unit& u) const {
        const long L = (long)i * G + c; if (L >= nwg) return false;
        const int per = mt * nt_, gi = (int)L / per, r = (int)L % per;
        u.pm = gi * mt + r % mt; u.pn = gi * nt_ + r / mt; return true;
    }
    __device__ __forceinline__ void a_ready(const Unit&) const {}
    __device__ __forceinline__ void done(const Unit&) const {}
};
template <class Epi, class Sched, bool ALIGN_EPI = false, bool SP2 = false>
__device__ __forceinline__ void gemm_phase(PG8_LAS unsigned char* lds, const Gemm g, const Sched& S, const Epi& E) {
    int tid_ = threadIdx.x; asm volatile("" : "+v"(tid_));
    const int tid = tid_, wid = __builtin_amdgcn_readfirstlane(tid >> 6), lane = tid & 63, wr = wid >> 2, wc = wid & 3, fr = lane & 15, fq = lane >> 4;
    const int K = g.K, nt = K / BK;
    unsigned voffA[2], voffB[2];
#pragma unroll
    for (int i = 0; i < 2; ++i) { int R, C; stage_rc(tid * 16 + i * 8192, R, C); const int Rb = Epi::PERM ? ((R & ~31) + perm32(R & 31)) : R;
        voffA[i] = (unsigned)(R * g.lda + C) * 2u; voffB[i] = (unsigned)(Rb * g.ldb + C) * 2u; }
    const size_t kstep = (size_t)(BK * 2);
    const size_t hstepA = (size_t)HALF * g.lda * 2, hstepB = (size_t)HALF * g.ldb * 2;
    const size_t tstepA = 2 * hstepA, tstepB = 2 * hstepB;
    const unsigned ldsw = (unsigned)wid * 1024u;
    const int aoff = lds_byte(wr * 64 + fr, fq * 8), boff = lds_byte(wc * 32 + fr, fq * 8);
#define PG8_SA(b, h) (((b) * 2 + (h)) * HTB)
#define PG8_SB(b, h) ((4 + (b) * 2 + (h)) * HTB)
#define PG8_STAGE(bufoff, gbase, voff) do { _Pragma("unroll") for (int _i = 0; _i < 2; ++_i) \
        __builtin_amdgcn_global_load_lds((const unsigned*)((const char*)(gbase) + (voff)[_i]), (PG8_LAS unsigned*)(lds + (bufoff) + ldsw + _i * 8192), 16, 0, 0); } while (0)
#define PG8_LDA(dst, b, h) do { _Pragma("unroll") for (int m = 0; m < 4; ++m) _Pragma("unroll") for (int k = 0; k < 2; ++k) dst[m][k] = *(const PG8_LAS bf16x8*)(lds + PG8_SA(b, h) + aoff + m * 2048 + k * 1024); } while (0)
#define PG8_LDB(dst, b, h) do { _Pragma("unroll") for (int n = 0; n < 2; ++n) _Pragma("unroll") for (int k = 0; k < 2; ++k) dst[n][k] = *(const PG8_LAS bf16x8*)(lds + PG8_SB(b, h) + boff + n * 2048 + k * 1024); } while (0)
#define PG8_MMA(ai, bj, At, Bt) do { __builtin_amdgcn_s_setprio(1); _Pragma("unroll") for (int m = 0; m < 4; ++m) _Pragma("unroll") for (int n = 0; n < 2; ++n) _Pragma("unroll") for (int k = 0; k < 2; ++k) \
        acc[ai][bj][m][n] = __builtin_amdgcn_mfma_f32_16x16x32_bf16(Bt[n][k], At[m][k], acc[ai][bj][m][n], 0, 0, 0); __builtin_amdgcn_s_setprio(0); } while (0)
#define PG8_WAIT_V(n) asm volatile("s_waitcnt vmcnt(" #n ")" ::: "memory")
#define PG8_WAIT_L(n) asm volatile("s_waitcnt lgkmcnt(" #n ")" ::: "memory")
#define PG8_BAR __builtin_amdgcn_s_barrier()
#define PG8_SCHED __builtin_amdgcn_sched_barrier(0)
    Unit cur, nxt; int ui = 0;
    if (!S.next(0, cur)) return;
    f32x4 acc[2][2][4][2];
    E.init(acc, cur, wr, wc, fr, fq);
    bf16x8 At[4][2], B0[2][2], B1[2][2];
    const char* cA = (const char*)g.A + (size_t)cur.pm * tstepA; const char* cB = (const char*)g.Bt + (size_t)cur.pn * tstepB;
    S.a_ready(cur);
    if constexpr (SP2) {
        PG8_STAGE(PG8_SB(0, 0), cB, voffB); PG8_STAGE(PG8_SB(0, 1), cB + hstepB, voffB); PG8_STAGE(PG8_SA(0, 0), cA, voffA); PG8_STAGE(PG8_SA(0, 1), cA + hstepA, voffA);
        if (wr == 1) PG8_BAR;
        PG8_WAIT_V(2); PG8_BAR;
        PG8_STAGE(PG8_SB(1, 0), cB + kstep, voffB); PG8_STAGE(PG8_SA(1, 0), cA + kstep, voffA); PG8_STAGE(PG8_SB(1, 1), cB + hstepB + kstep, voffB);
        PG8_WAIT_V(6); PG8_BAR;
    } else {
        PG8_STAGE(PG8_SB(0, 0), cB, voffB); PG8_STAGE(PG8_SA(0, 0), cA, voffA); PG8_STAGE(PG8_SB(0, 1), cB + hstepB, voffB); PG8_STAGE(PG8_SA(0, 1), cA + hstepA, voffA);
        if (wr == 1) PG8_BAR;
        PG8_WAIT_V(4); PG8_BAR;
        PG8_STAGE(PG8_SB(1, 0), cB + kstep, voffB); PG8_STAGE(PG8_SA(1, 0), cA + kstep, voffA); PG8_STAGE(PG8_SB(1, 1), cB + hstepB + kstep, voffB);
        PG8_WAIT_V(6); PG8_BAR;
    }
    for (;;) {
        const bool has_next = S.next(ui + 1, nxt);
        const char* nA = has_next ? (const char*)g.A + (size_t)nxt.pm * tstepA : cA; const char* nB = has_next ? (const char*)g.Bt + (size_t)nxt.pn * tstepB : cB;
        for (int t = 0; t < nt; t += 2) {
            const bool last = (t == nt - 2);
            const char* a1 = cA + (size_t)(t + 1) * kstep;
            const char* a2 = last ? nA : cA + (size_t)(t + 2) * kstep; const char* b2 = last ? nB : cB + (size_t)(t + 2) * kstep;
            const char* a3 = a2 + kstep; const char* b3 = b2 + kstep;
            if (last && has_next) S.a_ready(nxt);
            if constexpr (SP2) {
            PG8_LDB(B0, 0, 0); PG8_LDB(B1, 0, 1); PG8_SCHED; PG8_LDA(At, 0, 0); PG8_STAGE(PG8_SA(1, 1), a1 + hstepA, voffA);
            PG8_WAIT_V(8); PG8_WAIT_L(0); PG8_BAR; PG8_MMA(0, 0, At, B0); PG8_MMA(0, 1, At, B1); PG8_BAR; PG8_SCHED;
            PG8_LDA(At, 0, 1); PG8_STAGE(PG8_SB(0, 0), b2, voffB); PG8_STAGE(PG8_SB(0, 1), b2 + hstepB, voffB); PG8_STAGE(PG8_SA(0, 0), a2, voffA);
            PG8_WAIT_V(8); PG8_WAIT_L(0); PG8_BAR; PG8_MMA(1, 0, At, B0); PG8_MMA(1, 1, At, B1); PG8_BAR; PG8_SCHED;
            PG8_LDB(B0, 1, 0); PG8_LDB(B1, 1, 1); PG8_SCHED; PG8_LDA(At, 1, 0); PG8_STAGE(PG8_SA(0, 1), a2 + hstepA, voffA);
            PG8_WAIT_V(8); PG8_WAIT_L(0); PG8_BAR; PG8_MMA(0, 0, At, B0); PG8_MMA(0, 1, At, B1); PG8_BAR; PG8_SCHED;
            PG8_LDA(At, 1, 1); PG8_STAGE(PG8_SB(1, 0), b3, voffB); PG8_STAGE(PG8_SB(1, 1), b3 + hstepB, voffB); PG8_STAGE(PG8_SA(1, 0), a3, voffA);
            PG8_WAIT_V(8); PG8_WAIT_L(0); PG8_BAR; PG8_MMA(1, 0, At, B0); PG8_MMA(1, 1, At, B1); PG8_BAR; PG8_SCHED;
            } else {
            PG8_LDB(B0, 0, 0); PG8_SCHED; PG8_LDA(At, 0, 0); PG8_STAGE(PG8_SA(1, 1), a1 + hstepA, voffA);
            PG8_WAIT_L(8); PG8_BAR; PG8_WAIT_L(0); PG8_MMA(0, 0, At, B0); PG8_BAR; PG8_SCHED;
            PG8_LDB(B1, 0, 1); PG8_STAGE(PG8_SB(0, 0), b2, voffB);
            PG8_BAR; PG8_WAIT_L(0); PG8_MMA(0, 1, At, B1); PG8_BAR;
            PG8_LDA(At, 0, 1); PG8_STAGE(PG8_SA(0, 0), a2, voffA);
            PG8_BAR; PG8_WAIT_L(0); PG8_MMA(1, 0, At, B0); PG8_BAR; PG8_SCHED;
            PG8_STAGE(PG8_SB(0, 1), b2 + hstepB, voffB);
            PG8_WAIT_V(6); PG8_BAR; PG8_MMA(1, 1, At, B1); PG8_BAR;
            PG8_LDB(B0, 1, 0); PG8_SCHED; PG8_LDA(At, 1, 0); PG8_STAGE(PG8_SA(0, 1), a2 + hstepA, voffA);
            PG8_WAIT_L(8); PG8_BAR; PG8_WAIT_L(0); PG8_MMA(0, 0, At, B0); PG8_BAR; PG8_SCHED;
            PG8_LDB(B1, 1, 1); PG8_STAGE(PG8_SB(1, 0), b3, voffB);
            PG8_BAR; PG8_WAIT_L(0); PG8_MMA(0, 1, At, B1); PG8_BAR;
            PG8_LDA(At, 1, 1); PG8_STAGE(PG8_SA(1, 0), a3, voffA);
            PG8_BAR; PG8_WAIT_L(0); PG8_MMA(1, 0, At, B0); PG8_BAR; PG8_SCHED;
            PG8_STAGE(PG8_SB(1, 1), b3 + hstepB, voffB);
            PG8_WAIT_V(6); PG8_BAR; PG8_MMA(1, 1, At, B1); PG8_BAR;
            }
        }
        if constexpr (ALIGN_EPI) { if (wr == 0) PG8_BAR; }
        if constexpr (!Epi::AFTER_DRAIN) { E(acc, cur, wr, wc, fr, fq); S.done(cur); }
        if (!has_next) break;
        E.init(acc, nxt, wr, wc, fr, fq);
        cur = nxt; cA = nA; cB = nB; ++ui;
        if constexpr (ALIGN_EPI) { if (wr == 1) PG8_BAR; }
    }
    PG8_WAIT_V(0);
    if constexpr (!ALIGN_EPI) { if (wr == 0) PG8_BAR; }
    PG8_BAR;
    if constexpr (Epi::AFTER_DRAIN) { E.fused(acc, cur, wr, wc, fr, fq, lds, wid, lane); S.done(cur); }
#undef PG8_SA
#undef PG8_SB
#undef PG8_STAGE
#undef PG8_LDA
#undef PG8_LDB
#undef PG8_MMA
#undef PG8_WAIT_V
#undef PG8_WAIT_L
#undef PG8_BAR
#undef PG8_SCHED
}
}
#define EPI_ZERO_INIT \
  __device__ __forceinline__ void init(pg8::f32x4 (&acc)[2][2][4][2], const pg8::Unit&, int, int, int, int) const { \
    _Pragma("unroll") for (int a = 0; a < 2; ++a) _Pragma("unroll") for (int b = 0; b < 2; ++b) \
    _Pragma("unroll") for (int m = 0; m < 4; ++m) _Pragma("unroll") for (int n = 0; n < 2; ++n) acc[a][b][m][n] = (pg8::f32x4){0.f, 0.f, 0.f, 0.f}; }
struct EpiScaleStore {
  static constexpr bool PERM = false, AFTER_DRAIN = false;
  float* C; int ldc; const float* rs;
  __device__ __forceinline__ void init(pg8::f32x4 (&acc)[2][2][4][2], const pg8::Unit&, int, int, int, int) const {
#pragma unroll
    for (int a = 0; a < 2; ++a)
#pragma unroll
      for (int b = 0; b < 2; ++b)
#pragma unroll
        for (int m = 0; m < 4; ++m)
#pragma unroll
          for (int n = 0; n < 2; ++n) acc[a][b][m][n] = (pg8::f32x4){0.f, 0.f, 0.f, 0.f};
  }
  __device__ __forceinline__ void operator()(const pg8::f32x4 (&acc)[2][2][4][2], const pg8::Unit& u, int wr, int wc, int fr_in, int fq_in) const {
    int fr = fr_in, fq = fq_in; asm volatile("" : "+v"(fr), "+v"(fq));
#pragma unroll
    for (int ai = 0; ai < 2; ++ai)
#pragma unroll
      for (int m = 0; m < 4; ++m) {
        const int row = u.pm * 256 + ai * 128 + wr * 64 + m * 16 + fr;
        const float r = rs[row];
#pragma unroll
        for (int bj = 0; bj < 2; ++bj)
#pragma unroll
          for (int n = 0; n < 2; ++n) {
            const int col = u.pn * 256 + bj * 128 + wc * 32 + n * 16 + 4 * fq;
            pg8::f32x4 v = acc[ai][bj][m][n] * r;
            *(pg8::f32x4*)(C + (size_t)row * ldc + col) = v;
          }
        asm volatile("" ::: "memory");
      }
  }
};
struct EpiResid {
  static constexpr bool PERM = false, AFTER_DRAIN = false;
  float* C; int ldc; bf16_t* xb; bf16_t* hb; const float* g2; float* parts;
  __device__ __forceinline__ void init(pg8::f32x4 (&acc)[2][2][4][2], const pg8::Unit& u, int wr, int wc, int fr, int fq) const {
#pragma unroll
    for (int ai = 0; ai < 2; ++ai)
#pragma unroll
      for (int m = 0; m < 4; ++m) {
        const int row = u.pm * 256 + ai * 128 + wr * 64 + m * 16 + fr;
#pragma unroll
        for (int bj = 0; bj < 2; ++bj)
#pragma unroll
          for (int n = 0; n < 2; ++n) {
            const int col = u.pn * 256 + bj * 128 + wc * 32 + n * 16 + 4 * fq;
            acc[ai][bj][m][n] = *(const pg8::f32x4*)(C + (size_t)row * ldc + col);
          }
      }
  }
  __device__ __forceinline__ void operator()(const pg8::f32x4 (&acc)[2][2][4][2], const pg8::Unit& u, int wr, int wc, int fr_in, int fq_in) const {
    int fr = fr_in, fq = fq_in; asm volatile("" : "+v"(fr), "+v"(fq));
    pg8::f32x4 gv[2][2];
#pragma unroll
    for (int bj = 0; bj < 2; ++bj)
#pragma unroll
      for (int n = 0; n < 2; ++n) gv[bj][n] = *(const pg8::f32x4*)(g2 + u.pn * 256 + bj * 128 + wc * 32 + n * 16 + 4 * fq);
#pragma unroll
    for (int ai = 0; ai < 2; ++ai)
#pragma unroll
      for (int m = 0; m < 4; ++m) {
        const int row = u.pm * 256 + ai * 128 + wr * 64 + m * 16 + fr;
        float ss = 0.f;
#pragma unroll
        for (int bj = 0; bj < 2; ++bj)
#pragma unroll
          for (int n = 0; n < 2; ++n) {
            const int col = u.pn * 256 + bj * 128 + wc * 32 + n * 16 + 4 * fq;
            const pg8::f32x4 v = acc[ai][bj][m][n];
            *(pg8::f32x4*)(C + (size_t)row * ldc + col) = v;
            *(uint2*)(xb + (size_t)row * KD + col) = make_uint2(pk_bf16(v[0], v[1]), pk_bf16(v[2], v[3]));
            const pg8::f32x4 h = v * gv[bj][n];
            *(uint2*)(hb + ((size_t)(col >> 7) * T + row) * 128 + (col & 127)) = make_uint2(pk_bf16(h[0], h[1]), pk_bf16(h[2], h[3]));
            ss += (v[0] * v[0] + v[1] * v[1]) + (v[2] * v[2] + v[3] * v[3]);
          }
        ss += __shfl_xor(ss, 16); ss += __shfl_xor(ss, 32);
        if (fq == 0) parts[(size_t)row * 16 + u.pn * 4 + wc] = ss;
        asm volatile("" ::: "memory");
      }
  }
};
struct EpiScaleStoreBf16 {
  static constexpr bool PERM = false, AFTER_DRAIN = false;
  bf16_t* C; int ldc; const float* parts; int nparts; float* rs_out;
  EPI_ZERO_INIT
  __device__ __forceinline__ void operator()(const pg8::f32x4 (&acc)[2][2][4][2], const pg8::Unit& u, int wr, int wc, int fr_in, int fq_in) const {
    int fr = fr_in, fq = fq_in; asm volatile("" : "+v"(fr), "+v"(fq));
#pragma unroll
    for (int ai = 0; ai < 2; ++ai)
#pragma unroll
      for (int m = 0; m < 4; ++m) {
        const int row = u.pm * 256 + ai * 128 + wr * 64 + m * 16 + fr;
        float ssum = 0.f;
        for (int i = 0; i < nparts; i += 4) { const pg8::f32x4 q4 = *(const pg8::f32x4*)(parts + (size_t)row * nparts + i); ssum += (q4[0] + q4[1]) + (q4[2] + q4[3]); }
        const float r = rsqrtf(ssum * (1.0f / (float)D) + EPS);
        if (rs_out && u.pn == 0 && wc == 0 && fq == 0) rs_out[row] = r;
#pragma unroll
        for (int bj = 0; bj < 2; ++bj)
#pragma unroll
          for (int n = 0; n < 2; ++n) {
            const int col = u.pn * 256 + bj * 128 + wc * 32 + n * 16 + 4 * fq;
            pg8::f32x4 v = acc[ai][bj][m][n] * r;
            uint2 o; o.x = pk_bf16(v[0], v[1]); o.y = pk_bf16(v[2], v[3]);
            *(uint2*)(C + (size_t)row * ldc + col) = o;
          }
        asm volatile("" ::: "memory");
      }
  }
};
template <class Epi>
__device__ __forceinline__ void run_gemm(unsigned char* lds_raw, const bf16_t* A, const bf16_t* Bt, int M, int N, int K, const Epi& e) {
  pg8::Gemm g{A, Bt, M, N, K, K, K}; pg8::StaticOrder So; So.init(M, N, (int)gridDim.x, (int)blockIdx.x);
  pg8::gemm_phase<Epi, pg8::StaticOrder, true, true>((PG8_LAS unsigned char*)lds_raw, g, So, e);
}

__device__ __forceinline__ void transpose_items(const float* __restrict__ W, int K, int N, const float* __restrict__ g, bf16_t* __restrict__ Wt, int gw, int ngw, int lane) {
  const int nkt = K / 64, nnt = N / 64;
  for (int it = gw; it < nkt * nnt; it += ngw) {
    int kt = it % nkt, ntile = it / nkt;
    int k0 = kt * 64, n = ntile * 64 + lane;
    float v[64];
#pragma unroll
    for (int i = 0; i < 64; ++i) v[i] = W[(size_t)(k0 + i) * N + n] * g[k0 + i];
    bf16_t* dst = Wt + (size_t)n * (K * KS) + k0;
#pragma unroll
    for (int c = 0; c < 8; ++c) {
      bf16_t hi[8], lo[8];
#pragma unroll
      for (int e = 0; e < 8; ++e) { hi[e] = f2bf(v[c * 8 + e]); lo[e] = f2bf(v[c * 8 + e] - bf2f(hi[e])); }
      uint4 ph, pl;
      ph.x = hi[0] | ((unsigned)hi[1] << 16); ph.y = hi[2] | ((unsigned)hi[3] << 16); ph.z = hi[4] | ((unsigned)hi[5] << 16); ph.w = hi[6] | ((unsigned)hi[7] << 16);
      pl.x = lo[0] | ((unsigned)lo[1] << 16); pl.y = lo[2] | ((unsigned)lo[3] << 16); pl.z = lo[4] | ((unsigned)lo[5] << 16); pl.w = lo[6] | ((unsigned)lo[7] << 16);
      *(uint4*)(dst + c * 8) = ph;
      if (PRECISE) { *(uint4*)(dst + K + c * 8) = pl; *(uint4*)(dst + 2 * K + c * 8) = ph; }
    }
  }
}

__device__ __forceinline__ void phase_cvt_rows(const float* __restrict__ src, bf16_t* __restrict__ dst, float* __restrict__ rstd, int gw, int ngw, int lane) {
  for (int t0 = gw; t0 < T; t0 += 2 * ngw) {
    float4 v[2][4];
#pragma unroll
    for (int u = 0; u < 2; ++u) { const int t = (t0 + u * ngw < T) ? t0 + u * ngw : t0;
#pragma unroll
      for (int i = 0; i < 4; ++i) v[u][i] = ((const float4*)(src + (size_t)t * D))[lane + i * 64]; }
#pragma unroll
    for (int u = 0; u < 2; ++u) {
      const int t = t0 + u * ngw;
      if (t < T) {
        float ss = 0.f;
#pragma unroll
        for (int i = 0; i < 4; ++i) {
          const float4 w = v[u][i];
          ss += w.x * w.x + w.y * w.y + w.z * w.z + w.w * w.w;
          uint2 ph; ph.x = pk_bf16(w.x, w.y); ph.y = pk_bf16(w.z, w.w);
          *(uint2*)(dst + (size_t)t * KD + (lane + i * 64) * 4) = ph;
        }
        if (rstd) { ss = wave_sum(ss); if (lane == 0) rstd[t] = rsqrtf(ss / (float)D + EPS); }
      }
    }
  }
}

__device__ __forceinline__ void phase_prologue(const Params& p, int gtid, int ngt, int gw, int ngw, int lane) {
  for (int idx = gtid; idx < S * 40; idx += ngt) {
    int s = idx / 40, i = idx % 40;
    if (i < 8) {
      float inv = powf(500000.0f, -(float)(2 * i) / 16.0f);
      float ang = (float)s * inv;
      p.cosm()[s * 8 + i] = (float)cos((double)ang); p.sinm()[s * 8 + i] = (float)sin((double)ang);
    } else {
      int j = i - 8;
      float inv = powf(10000.0f, -((float)j / 31.0f));
      float ang = (float)s * inv;
      p.cosr()[s * 32 + j] = (float)cos((double)ang); p.sinr()[s * 32 + j] = (float)sin((double)ang);
    }
  }
  { const float4* a = (const float4*)p.inp(0); float4* b = (float4*)p.outp();
    for (size_t i = gtid; i < (size_t)T * D / 4; i += ngt) b[i] = a[i]; }
  for (int t = gw; t < T; t += ngw) {
    const float4* xr = (const float4*)(p.inp(0) + (size_t)t * D); float ss = 0.f;
#pragma unroll
    for (int i = 0; i < 4; ++i) { const float4 v = xr[lane + i * 64]; ss += v.x * v.x + v.y * v.y + v.z * v.z + v.w * v.w;
      *(uint2*)(p.xb() + (size_t)t * KD + (lane + i * 64) * 4) = make_uint2(pk_bf16(v.x, v.y), pk_bf16(v.z, v.w)); }
    ss = wave_sum(ss);
    if (lane < 8) p.ssq1()[(size_t)t * 8 + lane] = lane == 0 ? ss : 0.f;
  }
  for (int idx = gtid; idx < NL * 65536; idx += ngt) { const int l2 = idx >> 16, n2 = (idx >> 8) & 255, k2 = idx & 255; p.Wglu_t()[idx] = f2bf(p.inp(11)[(size_t)l2 * 65536 + k2 * 256 + n2]); }
  for (int l = 0; l < NL; ++l) {
    transpose_items(p.inp(2) + (size_t)l * D * INW, D, INW, p.inp(1) + l * D, p.Win_t() + (size_t)l * INW * KD, gw, ngw, lane);
    transpose_items(p.inp(15) + (size_t)l * D * D, D, D, p.inp(14) + l * D, p.Wout_t() + (size_t)l * D * KD, gw, ngw, lane);
    transpose_items(p.inp(17) + (size_t)l * D * D, D, D, p.inp(16) + l * D, p.Wq_t() + (size_t)l * D * KD, gw, ngw, lane);
  }
}

__device__ __forceinline__ void phase_postproj(const Params& p, int l, int gw, int ngw, int lane) {
  const float* gq = p.inp(12) + l * 64; const float* gk = p.inp(13) + l * 64;
  for (int w = gw; w < T * 24; w += ngw) {
    int t = w / 24, slot = w % 24, s = t % S;
    float* row = p.proj() + (size_t)t * INW;
    if (slot < 16) {
      int h = slot & 7;
      float* q = row + (slot < 8 ? OFF_QM : OFF_KM) + h * 64;
      const float* g = slot < 8 ? gq : gk;
      float v = q[lane];
      float ss = wave_sum(v * v);
      float u = v * rsqrtf(ss / 64.0f + EPS) * g[lane];
      int partner = lane < 8 ? lane + 8 : lane - 8;
      float pu = __shfl(u, partner & 63);
      float o = u;
      if (lane < 16) {
        int i = lane & 7;
        float c = p.cosm()[s * 8 + i], sn = p.sinm()[s * 8 + i];
        o = lane < 8 ? (u * c - pu * sn) : (u * c + pu * sn);
      }
      q[lane] = o;
    } else {
      int h = (slot - 16) & 3; bool isk = slot >= 20;
      float* q = row + (isk ? OFF_KR : OFF_QR) + h * 64;
      float v = q[lane];
      float pv = __shfl(v, lane ^ 32);
      int i = lane & 31;
      float c = p.cosr()[s * 32 + i], sn = p.sinr()[s * 32 + i];
      float o = lane < 32 ? (v * c - pv * sn) : (v * c + pv * sn);
      if (isk) o *= 0.125f;
      q[lane] = o;
    }
  }
}

__device__ __forceinline__ void phase_kmean(const Params& p, int gtid, int ngt) {
  for (int idx = gtid; idx < NB * 8 * 16 * 64; idx += ngt) {
    int d = idx & 63, j = (idx >> 6) & 15, h = (idx >> 10) & 7, b = idx >> 13;
    const float* q = p.proj() + ((size_t)(b * S + j * 256)) * INW + OFF_KM + h * 64 + d;
    float acc = 0.f;
    for (int i = 0; i < 256; ++i) acc += q[(size_t)i * INW];
    p.kmean()[idx] = acc / 256.0f;
  }
}

__device__ __forceinline__ void s5_unit(const Params& p, int l, int unit, float* red, int lane) {
  const int b = unit >> 4, g = unit & 15, pp = lane;
  const float* lam_re = p.inp(3) + l * 1024; const float* lam_im = p.inp(4) + l * 1024; const float* log_dt = p.inp(5) + l * 16;
  const float* b_re = p.inp(6) + l * 16384; const float* b_im = p.inp(7) + l * 16384;
  const float* c_re = p.inp(8) + l * 16384; const float* c_im = p.inp(9) + l * 16384; const float* dskip = p.inp(10) + l * 256;
  float lr = lam_re[g * 64 + pp], li = lam_im[g * 64 + pp];
  float dt = expf(log_dt[g]);
  float mag = expf(lr * dt);
  float ar = mag * cosf(li * dt), ai = mag * sinf(li * dt);
  float den = lr * lr + li * li;
  float fr = ((ar - 1.0f) * lr + ai * li) / den;
  float fi = (ai * lr - (ar - 1.0f) * li) / den;
  float bbr[16], bbi[16], cr[16], ci[16];
#pragma unroll
  for (int h = 0; h < 16; ++h) {
    float br = b_re[(g * 64 + pp) * 16 + h], bi = b_im[(g * 64 + pp) * 16 + h];
    bbr[h] = fr * br - fi * bi; bbi[h] = fr * bi + fi * br;
    cr[h] = c_re[(g * 16 + h) * 64 + pp]; ci[h] = c_im[(g * 16 + h) * 64 + pp];
  }
  const int hq = pp >> 2, qq = pp & 3;
  float dsk = dskip[g * 16 + hq];
  float sr = 0.f, si = 0.f;
  for (int t = 0; t < S; ++t) {
    const float* up = p.proj() + (size_t)(b * S + t) * INW + OFF_U + g * 16;
    float u[16];
#pragma unroll
    for (int h4 = 0; h4 < 4; ++h4) { float4 v = *(const float4*)(up + h4 * 4); u[h4 * 4] = v.x; u[h4 * 4 + 1] = v.y; u[h4 * 4 + 2] = v.z; u[h4 * 4 + 3] = v.w; }
    float bur = 0.f, bui = 0.f;
#pragma unroll
    for (int h = 0; h < 16; ++h) { bur = fmaf(u[h], bbr[h], bur); bui = fmaf(u[h], bbi[h], bui); }
    float nr = ar * sr - ai * si + bur, ni = ar * si + ai * sr + bui;
    sr = nr; si = ni;
    LDS_FENCE();
#pragma unroll
    for (int h = 0; h < 16; ++h) red[h * 65 + pp] = sr * cr[h] - si * ci[h];
    LDS_FENCE();
    float acc = 0.f;
#pragma unroll
    for (int i = 0; i < 16; ++i) acc += red[hq * 65 + qq * 16 + i];
    acc += __shfl_xor(acc, 1);
    acc += __shfl_xor(acc, 2);
    if (qq == 0) p.yg()[(size_t)(b * S + t) * 256 + g * 16 + hq] = gelu_tanh(acc + up[hq] * dsk);
  }
}

__device__ __forceinline__ void ret_units(const Params& p, int l, int unit0, float* lds) {
  constexpr int TB = 16;
  int tx_ = threadIdx.x; asm volatile("" : "+v"(tx_));
  const int vb = tx_ >> 8, tid = tx_ & 255;
  float* base_l = lds + vb * (TB * 64 * 3 + TB * 4 * 64);
  float* qs = base_l; float* ks = qs + TB * 64; float* vs = ks + TB * 64; float* red = vs + TB * 64;
  const int unit = unit0 + vb;
  const int b = unit >> 2, h = unit & 3;
  const int e = tid & 63, dg = tid >> 6;
  const float gamma = 1.0f - exp2f(-5.0f - (float)h);
  float St[16];
#pragma unroll
  for (int i = 0; i < 16; ++i) St[i] = 0.f;
  const float* base = p.proj() + (size_t)(b * S) * INW;
  for (int t0 = 0; t0 < S; t0 += TB) {
    __syncthreads();
    for (int i = tid; i < TB * 64; i += 256) {
      int tt = i >> 6, d = i & 63;
      const float* r = base + (size_t)(t0 + tt) * INW;
      qs[tt * 64 + d] = r[OFF_QR + h * 64 + d]; ks[tt * 64 + d] = r[OFF_KR + h * 64 + d]; vs[tt * 64 + d] = r[OFF_VR + h * 64 + d];
    }
    __syncthreads();
    for (int tt = 0; tt < TB; ++tt) {
      float ve = vs[tt * 64 + e], part = 0.f;
#pragma unroll
      for (int i = 0; i < 16; ++i) {
        St[i] = fmaf(gamma, St[i], ks[tt * 64 + dg * 16 + i] * ve);
        part = fmaf(qs[tt * 64 + dg * 16 + i], St[i], part);
      }
      red[(tt * 4 + dg) * 64 + e] = part;
    }
    __syncthreads();
    for (int k = 0; k < 4; ++k) {
      int tt = dg * 4 + k;
      float o = red[(tt * 4 + 0) * 64 + e] + red[(tt * 4 + 1) * 64 + e] + red[(tt * 4 + 2) * 64 + e] + red[(tt * 4 + 3) * 64 + e];
      float ss = wave_sum(o * o);
      float gv = base[(size_t)(t0 + tt) * INW + OFF_GR + h * 64 + e];
      float sl = gv * sigmoidf_(gv);
      int col = 768 + h * 64 + e;
      p.ybuf()[(size_t)(b * S + t0 + tt) * D + col] = sl * o * rsqrtf(ss / 64.0f + EPS);
    }
  }
}

__device__ __forceinline__ void phase_s5glu(const Params& p, int l, float* ys, int gw, int ngw, int lane) {
  const float* wglu = p.inp(11) + (size_t)l * 65536;
  for (int t = gw; t < T; t += ngw) {
    float yv[4];
    LDS_FENCE();
#pragma unroll
    for (int i = 0; i < 4; ++i) { yv[i] = p.yg()[(size_t)t * 256 + lane + i * 64]; ys[lane + i * 64] = yv[i]; }
    LDS_FENCE();
    float z[4] = {0.f, 0.f, 0.f, 0.f};
    for (int k = 0; k < 256; ++k) {
      float yk = ys[k];
#pragma unroll
      for (int i = 0; i < 4; ++i) z[i] = fmaf(yk, wglu[k * 256 + lane + i * 64], z[i]);
    }
    float o[4], ss = 0.f;
#pragma unroll
    for (int i = 0; i < 4; ++i) { o[i] = yv[i] * sigmoidf_(z[i]); ss += o[i] * o[i]; }
    ss = wave_sum(ss);
    float r = rsqrtf(ss / 256.0f + EPS);
#pragma unroll
    for (int i = 0; i < 4; ++i) p.ybuf()[(size_t)t * D + lane + i * 64] = o[i] * r;
  }
}


struct S5P { float lr, li, dt, fr, fi; };
__device__ __forceinline__ S5P s5p(const Params& p, int l, int g, int pp) {
  S5P r; r.lr = p.inp(3)[l * 1024 + g * 64 + pp]; r.li = p.inp(4)[l * 1024 + g * 64 + pp]; r.dt = expf(p.inp(5)[l * 16 + g]);
  const float mag = expf(r.lr * r.dt); float sn, cs; sincosf(r.li * r.dt, &sn, &cs);
  const float ar = mag * cs, ai = mag * sn, den = r.lr * r.lr + r.li * r.li;
  r.fr = ((ar - 1.0f) * r.lr + ai * r.li) / den; r.fi = (ai * r.lr - (ar - 1.0f) * r.li) / den;
  return r;
}
__device__ __forceinline__ void s5pow(const S5P& s, int k, float& re, float& im) {
  const float m = expf((float)k * s.lr * s.dt); float sn, cs; sincosf((float)k * s.li * s.dt, &sn, &cs); re = m * cs; im = m * sn;
}
__device__ __forceinline__ void phase_s5_prep(const Params& p, int l, int gtid, int ngt) {
  const float* b_re = p.inp(6) + l * 16384; const float* b_im = p.inp(7) + l * 16384;
  const float* c_re = p.inp(8) + l * 16384; const float* c_im = p.inp(9) + l * 16384;
  bf16_t* Wy = p.S5Wy(); bf16_t* Wz = p.S5Wz();
  for (int it = gtid; it < 16 * 32 * 256; it += ngt) {
    const int hp = it & 15, h = (it >> 4) & 15, d = (it >> 8) & 31, g = it >> 13;
    float acc = 0.f;
    for (int pp = 0; pp < 64; ++pp) {
      const S5P s = s5p(p, l, g, pp);
      float pr, pi; s5pow(s, d, pr, pi);
      const float br = b_re[(g * 64 + pp) * 16 + hp], bi = b_im[(g * 64 + pp) * 16 + hp];
      const float bbr = s.fr * br - s.fi * bi, bbi = s.fr * bi + s.fi * br;
      const float tr = pr * bbr - pi * bbi, ti = pr * bbi + pi * bbr;
      acc += c_re[(g * 16 + h) * 64 + pp] * tr - c_im[(g * 16 + h) * 64 + pp] * ti;
    }
    const bf16_t v = f2bf(acc);
    for (int jp = 0; jp + d < 32; ++jp) {
      const int j = jp + d;
      Wy[((size_t)g * 512 + j * 16 + h) * 640 + jp * 16 + hp] = v;
      if (d > 0) Wy[((size_t)g * 512 + jp * 16 + h) * 640 + j * 16 + hp] = 0;
    }
  }
  for (int it = gtid; it < 16 * 32 * 16 * 64; it += ngt) {
    const int pp = it & 63, h = (it >> 6) & 15, j = (it >> 10) & 31, g = it >> 15;
    const S5P s = s5p(p, l, g, pp);
    float pr, pi; s5pow(s, j + 1, pr, pi);
    const float cr = c_re[(g * 16 + h) * 64 + pp], ci = c_im[(g * 16 + h) * 64 + pp];
    const unsigned w = pk_bf16(cr * pr - ci * pi, -(cr * pi + ci * pr));
    *(unsigned*)(Wy + ((size_t)g * 512 + j * 16 + h) * 640 + 512 + 2 * pp) = w;
  }
  for (int it = gtid; it < 16 * 64 * 32; it += ngt) {
    const int j = it & 31, pp = (it >> 5) & 63, g = it >> 11;
    const S5P s = s5p(p, l, g, pp);
    float pr, pi; s5pow(s, 31 - j, pr, pi);
    for (int hp = 0; hp < 16; ++hp) {
      const float br = b_re[(g * 64 + pp) * 16 + hp], bi = b_im[(g * 64 + pp) * 16 + hp];
      const float bbr = s.fr * br - s.fi * bi, bbi = s.fr * bi + s.fi * br;
      Wz[((size_t)g * 256 + 2 * pp) * 512 + j * 16 + hp] = f2bf(pr * bbr - pi * bbi);
      Wz[((size_t)g * 256 + 2 * pp + 1) * 512 + j * 16 + hp] = f2bf(pr * bbi + pi * bbr);
    }
  }
  for (int it = gtid; it < 16 * 64; it += ngt) {
    const S5P s = s5p(p, l, it >> 6, it & 63);
    float pr, pi; s5pow(s, 32, pr, pi);
    p.S5a32()[it * 2] = pr; p.S5a32()[it * 2 + 1] = pi;
  }
}
__device__ __forceinline__ void phase_pack_u(const Params& p, int gtid, int ngt) {
  for (int idx = gtid; idx < T * 32; idx += ngt) {
    const int t = idx >> 5, i = idx & 31, g = i >> 1;
    *(uint4*)(p.S5A() + ((size_t)g * 1024 + (t >> 5)) * 640 + (t & 31) * 16 + (i & 1) * 8) = *(const uint4*)(p.projb() + (size_t)t * INW + i * 8);
  }
}
__device__ __forceinline__ void phase_s5_scan(const Params& p, int gtid, int ngt) {
  for (int it = gtid; it < NB * 16 * 64; it += ngt) {
    const int pp = it & 63, g = (it >> 6) & 15, b = it >> 10;
    const float er = p.S5a32()[(g * 64 + pp) * 2], ei = p.S5a32()[(g * 64 + pp) * 2 + 1];
    float sr = 0.f, si = 0.f;
#pragma unroll 1
    for (int c0 = 0; c0 < 128; c0 += 16) {
      float2 z[16];
#pragma unroll
      for (int k = 0; k < 16; ++k) z[k] = *(const float2*)(p.S5Z() + ((size_t)g * 1024 + b * 128 + c0 + k) * 128 + 2 * pp);
#pragma unroll
      for (int k = 0; k < 16; ++k) {
        const size_t ch = (size_t)g * 1024 + b * 128 + c0 + k;
        *(unsigned*)(p.S5A() + ch * 640 + 512 + 2 * pp) = pk_bf16(sr, si);
        const float nr = er * sr - ei * si + z[k].x, ni = er * si + ei * sr + z[k].y;
        sr = nr; si = ni;
      }
    }
  }
}
struct EpiS5Z {
  static constexpr bool PERM = false, AFTER_DRAIN = false;
  float* Z;
  EPI_ZERO_INIT
  __device__ __forceinline__ void operator()(const pg8::f32x4 (&acc)[2][2][4][2], const pg8::Unit& u, int wr, int wc, int fr_in, int fq_in) const {
    int fr = fr_in, fq = fq_in; asm volatile("" : "+v"(fr), "+v"(fq));
    const int g = u.pm >> 2;
#pragma unroll
    for (int ai = 0; ai < 2; ++ai)
#pragma unroll
      for (int m = 0; m < 4; ++m) {
        const int chunk = (u.pm & 3) * 256 + ai * 128 + wr * 64 + m * 16 + fr;
#pragma unroll
        for (int n = 0; n < 2; ++n) *(pg8::f32x4*)(Z + ((size_t)g * 1024 + chunk) * 128 + wc * 32 + n * 16 + 4 * fq) = acc[ai][0][m][n];
      }
  }
};
struct EpiS5Y {
  static constexpr bool PERM = false, AFTER_DRAIN = false;
  bf16_t* ygb; const bf16_t* A; const float* dsk;
  EPI_ZERO_INIT
  __device__ __forceinline__ void operator()(const pg8::f32x4 (&acc)[2][2][4][2], const pg8::Unit& u, int wr, int wc, int fr_in, int fq_in) const {
    int fr = fr_in, fq = fq_in; asm volatile("" : "+v"(fr), "+v"(fq));
    const int g = u.pm >> 2;
#pragma unroll
    for (int ai = 0; ai < 2; ++ai)
#pragma unroll
      for (int m = 0; m < 4; ++m) {
        const int chunk = (u.pm & 3) * 256 + ai * 128 + wr * 64 + m * 16 + fr;
#pragma unroll
        for (int bj = 0; bj < 2; ++bj)
#pragma unroll
          for (int n = 0; n < 2; ++n) {
            const int col = (u.pn & 1) * 256 + bj * 128 + wc * 32 + n * 16 + 4 * fq, j = col >> 4, h = col & 15;
            const uint2 uu = *(const uint2*)(A + ((size_t)g * 1024 + chunk) * 640 + col);
            const pg8::f32x4 dv = *(const pg8::f32x4*)(dsk + g * 16 + h);
            const pg8::f32x4 v = acc[ai][bj][m][n];
            const float y0 = fast_gelu(v[0] + dv[0] * __uint_as_float(uu.x << 16)), y1 = fast_gelu(v[1] + dv[1] * __uint_as_float(uu.x & 0xffff0000u));
            const float y2 = fast_gelu(v[2] + dv[2] * __uint_as_float(uu.y << 16)), y3 = fast_gelu(v[3] + dv[3] * __uint_as_float(uu.y & 0xffff0000u));
            uint2 o; o.x = pk_bf16(y0, y1); o.y = pk_bf16(y2, y3);
            *(uint2*)(ygb + ((size_t)chunk * 32 + j) * 256 + g * 16 + h) = o;
          }
        asm volatile("" ::: "memory");
      }
  }
};
struct EpiGlu {
  static constexpr bool PERM = false, AFTER_DRAIN = false;
  bf16_t* yb; const bf16_t* ygb; float* scr;
  EPI_ZERO_INIT
  __device__ __forceinline__ void operator()(const pg8::f32x4 (&acc_)[2][2][4][2], const pg8::Unit& u, int wr, int wc, int fr_in, int fq_in) const {
    int fr = fr_in, fq = fq_in; asm volatile("" : "+v"(fr), "+v"(fq));
    pg8::f32x4 (&acc)[2][2][4][2] = const_cast<pg8::f32x4 (&)[2][2][4][2]>(acc_);
#pragma unroll
    for (int ai = 0; ai < 2; ++ai)
#pragma unroll
      for (int m = 0; m < 4; ++m) {
        const int rl = ai * 128 + wr * 64 + m * 16 + fr, row = u.pm * 256 + rl;
        float ss = 0.f;
#pragma unroll
        for (int bj = 0; bj < 2; ++bj)
#pragma unroll
          for (int n = 0; n < 2; ++n) {
            const int col = bj * 128 + wc * 32 + n * 16 + 4 * fq;
            const uint2 yy = *(const uint2*)(ygb + (size_t)row * 256 + col);
            const pg8::f32x4 z = acc[ai][bj][m][n];
            pg8::f32x4 r;
            r[0] = __uint_as_float(yy.x << 16) * fast_sigmoid(z[0]); r[1] = __uint_as_float(yy.x & 0xffff0000u) * fast_sigmoid(z[1]);
            r[2] = __uint_as_float(yy.y << 16) * fast_sigmoid(z[2]); r[3] = __uint_as_float(yy.y & 0xffff0000u) * fast_sigmoid(z[3]);
            acc[ai][bj][m][n] = r;
            ss += r[0] * r[0] + r[1] * r[1] + r[2] * r[2] + r[3] * r[3];
          }
        ss += __shfl_xor(ss, 16); ss += __shfl_xor(ss, 32);
        if (fq == 0) scr[rl * 4 + wc] = ss;
        asm volatile("" ::: "memory");
      }
    asm volatile("s_waitcnt lgkmcnt(0)" ::: "memory"); __builtin_amdgcn_s_barrier(); asm volatile("" ::: "memory");
#pragma unroll
    for (int ai = 0; ai < 2; ++ai)
#pragma unroll
      for (int m = 0; m < 4; ++m) {
        const int rl = ai * 128 + wr * 64 + m * 16 + fr, row = u.pm * 256 + rl;
        const pg8::f32x4 s4 = *(const pg8::f32x4*)(scr + rl * 4);
        const float r = rsqrtf((s4[0] + s4[1] + s4[2] + s4[3]) / 256.0f + EPS);
#pragma unroll
        for (int bj = 0; bj < 2; ++bj)
#pragma unroll
          for (int n = 0; n < 2; ++n) { const pg8::f32x4 v = acc[ai][bj][m][n] * r; *(uint2*)(yb + (size_t)row * KD + bj * 128 + wc * 32 + n * 16 + 4 * fq) = make_uint2(pk_bf16(v[0], v[1]), pk_bf16(v[2], v[3])); }
        asm volatile("" ::: "memory");
      }
    asm volatile("s_waitcnt lgkmcnt(0)" ::: "memory"); __builtin_amdgcn_s_barrier(); asm volatile("" ::: "memory");
  }
};

constexpr float QSCALE = 0.125f * 1.4426950408889634f;

__device__ __forceinline__ void phase_pack_moba(const Params& p, int gtid, int ngt) {
  for (int idx = gtid; idx < T * 128; idx += ngt) {
    const int t = idx >> 7, c = idx & 127, isk = c >> 6, cc = c & 63, h = cc >> 3, ch = cc & 7;
    const float* src = p.proj() + (size_t)t * INW + (isk ? OFF_KM : OFF_QM) + h * 64 + ch * 8;
    float4 a = *(const float4*)src, b4 = *(const float4*)(src + 4);
    const float sc = isk ? 1.0f : QSCALE;
    uint4 o; o.x = pk_bf16(a.x * sc, a.y * sc); o.y = pk_bf16(a.z * sc, a.w * sc); o.z = pk_bf16(b4.x * sc, b4.y * sc); o.w = pk_bf16(b4.z * sc, b4.w * sc);
    const int b = t / S, s = t % S;
    bf16_t* dst = isk ? p.Km() + ((((size_t)(b * 8 + h) * (S / 32) + (s >> 5)) * 8 + ch) * 32 + (s & 31)) * 8
                      : p.Qm() + ((size_t)(b * 8 + h) * S + s) * 64 + ch * 8;
    *(uint4*)dst = o;
  }
  for (int idx = gtid; idx < NB * 8 * (S / 32) * 256; idx += ngt) {
    const int ln = idx & 63, ks = (idx >> 6) & 1, mb = (idx >> 7) & 1, tile = (idx >> 8) % (S / 32), bh = idx / (256 * (S / 32));
    const int b = bh >> 3, h = bh & 7, hh = ln >> 5, delta = mb * 32 + (ln & 31);
    float v[8];
#pragma unroll
    for (int j = 0; j < 8; ++j) {
      const int kappa = 16 * ks + 8 * (j >> 2) + 4 * hh + (j & 3), s = tile * 32 + kappa;
      v[j] = p.proj()[(size_t)(b * S + s) * INW + OFF_VM + h * 64 + delta];
    }
    uint4 o; o.x = pk_bf16(v[0], v[1]); o.y = pk_bf16(v[2], v[3]); o.z = pk_bf16(v[4], v[5]); o.w = pk_bf16(v[6], v[7]);
    *(uint4*)(p.Vm() + (size_t)idx * 8) = o;
  }
}

__device__ __forceinline__ void phase_moba2(const Params& p, int l, unsigned char* lds, int bid, int G) {
  constexpr int OLD = 260;
  bf16_t* Qs = (bf16_t*)lds;
  float* Oaccf = (float*)(lds + 32768);
  float* laccf = (float*)(lds + 32768 + 64 * OLD * 4);
  float* kms = laccf + 256;
  float* gat = kms + 1024;
  unsigned char* lists = (unsigned char*)(gat + 4096);
  int* cnt = (int*)(lists + 4096);
  int* items = cnt + 16;
  int* ctr = items + 160;
  unsigned* selp = (unsigned*)(ctr + 4);
  float* bq = (float*)(selp + 256);
  int* Oacc = (int*)Oaccf; int* lacc = (int*)laccf;
  float kmax = 0.f;
  { const float* gk = p.inp(13) + l * 64;
    for (int d = 0; d < 64; ++d) kmax = fmaxf(kmax, fabsf(gk[d]));
    kmax *= 8.0f * 1.01f; }
  for (int u = bid; u < NB * 8 * 16; u += G) {
    const int qblk = 15 - (u >> 6), bh = u & 63, b = bh >> 3, h = bh & 7;
    int tid = threadIdx.x; asm volatile("" : "+v"(tid));
    const int lane = tid & 63, wv = tid >> 6, n = lane & 31, hh = lane >> 5;
    __syncthreads();
    { const uint4* src = (const uint4*)(p.Qm() + ((size_t)bh * S + qblk * 256) * 64);
      uint4* dst = (uint4*)Qs;
      for (int i = tid; i < 256 * 64 * 2 / 16; i += NTHR) dst[i] = src[i]; }
    for (int i = tid; i < qblk * 64; i += NTHR) kms[i] = p.kmean()[(size_t)bh * 1024 + i];
    for (int i = tid; i < 64 * OLD; i += NTHR) Oacc[i] = 0;
    if (tid < 256) lacc[tid] = 0;
    if (tid < 16) cnt[tid] = 0;
    __syncthreads();
    { const int q = tid & 255, par = tid >> 8;
      float qv[64];
#pragma unroll
      for (int c = 0; c < 8; ++c) {
        uint4 w = *(const uint4*)(Qs + q * 64 + c * 8);
        qv[c * 8 + 0] = __uint_as_float(w.x << 16); qv[c * 8 + 1] = __uint_as_float(w.x & 0xffff0000u);
        qv[c * 8 + 2] = __uint_as_float(w.y << 16); qv[c * 8 + 3] = __uint_as_float(w.y & 0xffff0000u);
        qv[c * 8 + 4] = __uint_as_float(w.z << 16); qv[c * 8 + 5] = __uint_as_float(w.z & 0xffff0000u);
        qv[c * 8 + 6] = __uint_as_float(w.w << 16); qv[c * 8 + 7] = __uint_as_float(w.w & 0xffff0000u);
      }
      if (par == 0) { float qq = 0.f;
#pragma unroll
        for (int d = 0; d < 64; ++d) qq = fmaf(qv[d], qv[d], qq);
        bq[q] = sqrtf(qq) * kmax; }
      for (int j = par; j < qblk; j += 2) {
        float g = 0.f;
#pragma unroll
        for (int d = 0; d < 64; ++d) g = fmaf(qv[d], kms[j * 64 + d], g);
        gat[q * 16 + j] = g;
      }
    }
    __syncthreads();
    if (tid < 256) {
      float b0 = -INFINITY, b1 = -INFINITY, b2 = -INFINITY; int i0 = 0, i1 = 0, i2 = 0;
      for (int j = 0; j < qblk; ++j) {
        float g = gat[tid * 16 + j];
        if (g > b0) { b2 = b1; i2 = i1; b1 = b0; i1 = i0; b0 = g; i0 = j; }
        else if (g > b1) { b2 = b1; i2 = i1; b1 = g; i1 = j; }
        else if (g > b2) { b2 = g; i2 = j; }
      }
      const int nsel = qblk < 3 ? qblk : 3;
      selp[tid] = (unsigned)i0 | ((unsigned)i1 << 4) | ((unsigned)i2 << 8) | ((unsigned)nsel << 12);
    }
    __syncthreads();
    for (int j = wv; j < qblk; j += 8) {
      int base = 0;
      for (int c = 0; c < 4; ++c) {
        const int q = c * 64 + lane;
        const unsigned sp = selp[q];
        const int ns = sp >> 12;
        const bool f = (ns > 0 && (int)(sp & 15) == j) || (ns > 1 && (int)((sp >> 4) & 15) == j) || (ns > 2 && (int)((sp >> 8) & 15) == j);
        const unsigned long long bal = __ballot(f);
        const int pos = base + __popcll(bal & ((1ull << lane) - 1ull));
        if (f) lists[j * 256 + pos] = (unsigned char)q;
        base += __popcll(bal);
      }
      if (lane == 0) cnt[j] = base;
    }
    __syncthreads();
    if (tid == 0) {
      int ni = 0;
#pragma unroll 1
      for (int g = 7; g >= 0; --g) items[ni++] = (16 << 8) | g;
      for (int j = 0; j < qblk; ++j) { const int ng = (cnt[j] + 31) >> 5; for (int g = 0; g < ng; ++g) items[ni++] = (j << 8) | g; }
      ctr[0] = ni; ctr[1] = 0;
    }
    __syncthreads();
    const int nitems = ctr[0];
    for (;;) {
      int it = 0;
      if (lane == 0) it = atomicAdd(&ctr[1], 1);
      it = __builtin_amdgcn_readfirstlane(it);
      if (it >= nitems) break;
      const int item = items[it];
      const int j = item >> 8, g = item & 255;
      const bool own = (j == 16);
      const int kb = own ? qblk : j;
      const int ntile = own ? (g + 1) : 8;
      int qi; bool valid;
      if (own) { qi = g * 32 + n; valid = true; }
      else { const int pos = g * 32 + n; valid = pos < cnt[j]; qi = lists[j * 256 + (valid ? pos : 0)]; }
      const bf16_t* kt0 = p.Km() + ((size_t)bh * (S / 32) + kb * 8) * 2048 + lane * 8;
      const bf16_t* vt0 = p.Vm() + ((size_t)bh * (S / 32) + kb * 8) * 2048 + lane * 8;
      f32x16 O0, O1;
#pragma unroll
      for (int r = 0; r < 16; ++r) { O0[r] = 0.f; O1[r] = 0.f; }
      float lsum = 0.f;
      const float nbq = -bq[qi];
      bf16x8 kf[3][4], vf[3][4];
#define MOBA_LOAD(KT_, BUF_) { _Pragma("unroll") for (int s = 0; s < 4; ++s) { kf[BUF_][s] = *(const bf16x8*)(kt0 + (size_t)(KT_) * 2048 + s * 512); vf[BUF_][s] = *(const bf16x8*)(vt0 + (size_t)(KT_) * 2048 + s * 512); } }
#define MOBA_STEP(KT_, BUF_)                                                                                                           \
      if ((KT_) < ntile) {                                                                                                               \
        if ((KT_) + 2 < ntile) MOBA_LOAD((KT_) + 2, ((BUF_) + 2) % 3)                                                                     \
        f32x16 X;                                                                                                                         \
        _Pragma("unroll") for (int r = 0; r < 16; ++r) X[r] = nbq;                                                                        \
        _Pragma("unroll") for (int s = 0; s < 4; ++s) X = __builtin_amdgcn_mfma_f32_32x32x16_bf16(kf[BUF_][s], *(const bf16x8*)(Qs + qi * 64 + (2 * s + hh) * 8), X, 0, 0, 0);     \
        const bool diag = own && ((KT_) == g);                                                                                            \
        unsigned pw[8];                                                                                                                   \
        _Pragma("unroll") for (int r = 0; r < 16; r += 2) {                                                                               \
          float e0 = __builtin_amdgcn_exp2f(X[r]), e1 = __builtin_amdgcn_exp2f(X[r + 1]);                                                 \
          if (diag) {                                                                                                                     \
            const int k0 = (r & 3) + 8 * (r >> 2) + 4 * hh, k1 = ((r + 1) & 3) + 8 * ((r + 1) >> 2) + 4 * hh;                             \
            e0 = (k0 <= n) ? e0 : 0.f; e1 = (k1 <= n) ? e1 : 0.f;                                                                         \
          }                                                                                                                               \
          lsum += e0 + e1;                                                                                                                \
          pw[r >> 1] = pk_bf16(e0, e1);                                                                                                   \
        }                                                                                                                                 \
        bf16x8 pf0, pf1;                                                                                                                  \
        { uint4 t0 = make_uint4(pw[0], pw[1], pw[2], pw[3]), t1 = make_uint4(pw[4], pw[5], pw[6], pw[7]);                                 \
          pf0 = *(bf16x8*)&t0; pf1 = *(bf16x8*)&t1; }                                                                                     \
        O0 = __builtin_amdgcn_mfma_f32_32x32x16_bf16(vf[BUF_][0], pf0, O0, 0, 0, 0);                                                      \
        O0 = __builtin_amdgcn_mfma_f32_32x32x16_bf16(vf[BUF_][1], pf1, O0, 0, 0, 0);                                                      \
        O1 = __builtin_amdgcn_mfma_f32_32x32x16_bf16(vf[BUF_][2], pf0, O1, 0, 0, 0);                                                      \
        O1 = __builtin_amdgcn_mfma_f32_32x32x16_bf16(vf[BUF_][3], pf1, O1, 0, 0, 0);                                                      \
      }
      MOBA_LOAD(0, 0)
      if (ntile > 1) MOBA_LOAD(1, 1)
#pragma unroll 1
      for (int kt3 = 0; kt3 < ntile; kt3 += 3) {
        MOBA_STEP(kt3, 0) MOBA_STEP(kt3 + 1, 1) MOBA_STEP(kt3 + 2, 2)
      }
#undef MOBA_STEP
#undef MOBA_LOAD
      lsum += __shfl_xor(lsum, 32);
      if (valid) {
        if (hh == 0) atomicAdd(&lacc[qi], __float2int_rn(lsum * 1048576.0f));
#pragma unroll
        for (int r = 0; r < 16; ++r) {
          const int dim = (r & 3) + 8 * (r >> 2) + 4 * hh;
          atomicAdd(&Oacc[dim * OLD + qi], __float2int_rn(O0[r] * 1048576.0f));
          atomicAdd(&Oacc[(dim + 32) * OLD + qi], __float2int_rn(O1[r] * 1048576.0f));
        }
      }
    }
    __syncthreads();
    { const int q = tid >> 1, half = tid & 1;
      const float inv = 1.0f / (float)lacc[q];
      float o[32], ss = 0.f;
#pragma unroll
      for (int d = 0; d < 32; ++d) { o[d] = (float)Oacc[(half * 32 + d) * OLD + q] * inv; ss += o[d] * o[d]; }
      ss += __shfl_xor(ss, 1);
      const float r = rsqrtf(ss / 64.0f + EPS);
      bf16_t* dst = p.xb() + (size_t)(b * S + qblk * 256 + q) * KD + 256 + h * 64 + half * 32;
#pragma unroll
      for (int d = 0; d < 32; d += 8) *(uint4*)(dst + d) = make_uint4(pk_bf16(o[d] * r, o[d + 1] * r), pk_bf16(o[d + 2] * r, o[d + 3] * r), pk_bf16(o[d + 4] * r, o[d + 5] * r), pk_bf16(o[d + 6] * r, o[d + 7] * r));
    }
  }
}


__device__ __forceinline__ float ret_log2g(int h) { return log2f(1.0f - exp2f(-5.0f - (float)h)); }
__device__ __forceinline__ void phase_pack_ret(const Params& p, int gtid, int ngt) {
  for (int idx = gtid; idx < T * 64; idx += ngt) {
    const int t = idx >> 6, c = idx & 63, isk = c >> 5, cc = c & 31, h = cc >> 3, ch = cc & 7;
    const int b = t / S, s = t % S, i = s & 127;
    const float* src = p.proj() + (size_t)t * INW + (isk ? OFF_KR : OFF_QR) + h * 64 + ch * 8;
    float4 a = *(const float4*)src, b4 = *(const float4*)(src + 4);
    const float sc = exp2f((isk ? -(float)i : (float)i) * ret_log2g(h));
    uint4 o; o.x = pk_bf16(a.x * sc, a.y * sc); o.y = pk_bf16(a.z * sc, a.w * sc); o.z = pk_bf16(b4.x * sc, b4.y * sc); o.w = pk_bf16(b4.z * sc, b4.w * sc);
    const int bh = b * 4 + h;
    bf16_t* dst = isk ? p.Kr() + ((((size_t)bh * (S / 32) + (s >> 5)) * 8 + ch) * 32 + (s & 31)) * 8
                      : p.Qr() + ((size_t)bh * S + s) * 64 + ch * 8;
    *(uint4*)dst = o;
  }
  for (int idx = gtid; idx < 2 * NB * 4 * (S / 32) * 256; idx += ngt) {
    const int ln = idx & 63, ks = (idx >> 6) & 1, blk = (idx >> 7) & 1, tile = (idx >> 8) % (S / 32), rest = idx / (256 * (S / 32)), bh = rest % (NB * 4), which = rest / (NB * 4);
    const int b = bh >> 2, h = bh & 3, hh = ln >> 5, delta = blk * 32 + (ln & 31);
    const float l2g = ret_log2g(h);
    float v[8];
#pragma unroll
    for (int j = 0; j < 8; ++j) {
      const int kappa = 16 * ks + 8 * (j >> 2) + 4 * hh + (j & 3), s = tile * 32 + kappa;
      float x = p.proj()[(size_t)(b * S + s) * INW + (which ? OFF_KR : OFF_VR) + h * 64 + delta];
      if (which) x *= exp2f(-(float)(s & 127) * l2g);
      v[j] = x;
    }
    uint4 o; o.x = pk_bf16(v[0], v[1]); o.y = pk_bf16(v[2], v[3]); o.z = pk_bf16(v[4], v[5]); o.w = pk_bf16(v[6], v[7]);
    *(uint4*)((which ? p.Krv() : p.Vr()) + ((size_t)(idx % (NB * 4 * (S / 32) * 256))) * 8) = o;
  }
}
__device__ __forceinline__ void phase_ret_kv(const Params& p, int gw, int ngw, int lane) {
  const int n = lane & 31, hh = lane >> 5;
  for (int w = gw; w < NB * 4 * 32; w += ngw) {
    const int bh = w >> 5, cn = w & 31;
    const bf16_t* vt = p.Vr() + ((size_t)bh * (S / 32) + cn * 4) * 2048 + lane * 8;
    const bf16_t* kt = p.Krv() + ((size_t)bh * (S / 32) + cn * 4) * 2048 + lane * 8;
    f32x16 acc[2][2];
#pragma unroll
    for (int a = 0; a < 2; ++a)
#pragma unroll
      for (int b2 = 0; b2 < 2; ++b2)
#pragma unroll
        for (int r = 0; r < 16; ++r) acc[a][b2][r] = 0.f;
#pragma unroll 1
    for (int tl = 0; tl < 4; ++tl)
#pragma unroll
      for (int ks = 0; ks < 2; ++ks) {
        bf16x8 vf[2], kf[2];
#pragma unroll
        for (int x = 0; x < 2; ++x) { vf[x] = *(const bf16x8*)(vt + tl * 2048 + (x * 2 + ks) * 512); kf[x] = *(const bf16x8*)(kt + tl * 2048 + (x * 2 + ks) * 512); }
#pragma unroll
        for (int mb = 0; mb < 2; ++mb)
#pragma unroll
          for (int nb = 0; nb < 2; ++nb) acc[mb][nb] = __builtin_amdgcn_mfma_f32_32x32x16_bf16(vf[mb], kf[nb], acc[mb][nb], 0, 0, 0);
      }
    float* dst = p.KVr() + ((size_t)bh * 32 + cn) * 4096;
#pragma unroll
    for (int mb = 0; mb < 2; ++mb)
#pragma unroll
      for (int nb = 0; nb < 2; ++nb)
#pragma unroll
        for (int r = 0; r < 16; ++r) dst[(mb * 32 + (r & 3) + 8 * (r >> 2) + 4 * hh) * 64 + nb * 32 + n] = acc[mb][nb][r];
  }
}
__device__ __forceinline__ void phase_ret_scan(const Params& p, int gtid, int ngt) {
  for (int it = gtid; it < NB * 4 * 4096; it += ngt) {
    const int e = it & 4095, bh = it >> 12, h = bh & 3;
    const float l2g = ret_log2g(h), g1 = exp2f(l2g), g127 = exp2f(127.0f * l2g), g128 = exp2f(128.0f * l2g);
    float R = 0.f; float kv[32];
#pragma unroll
    for (int cn = 0; cn < 32; ++cn) kv[cn] = p.KVr()[((size_t)bh * 32 + cn) * 4096 + e];
#pragma unroll
    for (int cn = 0; cn < 32; ++cn) {
      p.Rb()[((size_t)bh * 32 + cn) * 4096 + e] = f2bf(g1 * R);
      R = g128 * R + g127 * kv[cn];
    }
  }
}
__device__ __forceinline__ void phase_ret_out(const Params& p, int gw, int ngw, int lane) {
  const int n = lane & 31, hh = lane >> 5;
  for (int w = gw; w < NB * 4 * 32 * 4; w += ngw) {
    const int qg = 3 - (w & 3), cn = (w >> 2) & 31, bh = w >> 7, b = bh >> 2, h = bh & 3;
    const int s0 = cn * 128 + qg * 32;
    bf16x8 qf[4];
#pragma unroll
    for (int s = 0; s < 4; ++s) qf[s] = *(const bf16x8*)(p.Qr() + ((size_t)bh * S + s0 + n) * 64 + (2 * s + hh) * 8);
    f32x16 O0, O1;
#pragma unroll
    for (int r = 0; r < 16; ++r) { O0[r] = 0.f; O1[r] = 0.f; }
    { const bf16_t* rb = p.Rb() + ((size_t)bh * 32 + cn) * 4096 + (size_t)n * 64 + hh * 8;
#pragma unroll
      for (int s = 0; s < 4; ++s) {
        const bf16x8 r0 = *(const bf16x8*)(rb + s * 16), r1 = *(const bf16x8*)(rb + 32 * 64 + s * 16);
        O0 = __builtin_amdgcn_mfma_f32_32x32x16_bf16(r0, qf[s], O0, 0, 0, 0);
        O1 = __builtin_amdgcn_mfma_f32_32x32x16_bf16(r1, qf[s], O1, 0, 0, 0);
      } }
    const bf16_t* kt0 = p.Kr() + ((size_t)bh * (S / 32) + cn * 4) * 2048 + lane * 8;
    const bf16_t* vt0 = p.Vr() + ((size_t)bh * (S / 32) + cn * 4) * 2048 + lane * 8;
    for (int kt = 0; kt <= qg; ++kt) {
      bf16x8 kf[4], vf[4];
#pragma unroll
      for (int s = 0; s < 4; ++s) { kf[s] = *(const bf16x8*)(kt0 + (size_t)kt * 2048 + s * 512); vf[s] = *(const bf16x8*)(vt0 + (size_t)kt * 2048 + s * 512); }
      f32x16 X;
#pragma unroll
      for (int r = 0; r < 16; ++r) X[r] = 0.f;
#pragma unroll
      for (int s = 0; s < 4; ++s) X = __builtin_amdgcn_mfma_f32_32x32x16_bf16(kf[s], qf[s], X, 0, 0, 0);
      const bool diag = (kt == qg);
      unsigned pw[8];
#pragma unroll
      for (int r = 0; r < 16; r += 2) {
        float e0 = X[r], e1 = X[r + 1];
        if (diag) {
          const int k0 = (r & 3) + 8 * (r >> 2) + 4 * hh, k1 = ((r + 1) & 3) + 8 * ((r + 1) >> 2) + 4 * hh;
          e0 = (k0 <= n) ? e0 : 0.f; e1 = (k1 <= n) ? e1 : 0.f;
        }
        pw[r >> 1] = pk_bf16(e0, e1);
      }
      bf16x8 pf0, pf1;
      { uint4 t0 = make_uint4(pw[0], pw[1], pw[2], pw[3]), t1 = make_uint4(pw[4], pw[5], pw[6], pw[7]);
        pf0 = *(bf16x8*)&t0; pf1 = *(bf16x8*)&t1; }
      O0 = __builtin_amdgcn_mfma_f32_32x32x16_bf16(vf[0], pf0, O0, 0, 0, 0);
      O0 = __builtin_amdgcn_mfma_f32_32x32x16_bf16(vf[1], pf1, O0, 0, 0, 0);
      O1 = __builtin_amdgcn_mfma_f32_32x32x16_bf16(vf[2], pf0, O1, 0, 0, 0);
      O1 = __builtin_amdgcn_mfma_f32_32x32x16_bf16(vf[3], pf1, O1, 0, 0, 0);
    }
    float ss = 0.f;
#pragma unroll
    for (int r = 0; r < 16; ++r) ss += O0[r] * O0[r] + O1[r] * O1[r];
    ss += __shfl_xor(ss, 32);
    const float rn = rsqrtf(ss / 64.0f + EPS);
    const size_t t = (size_t)b * S + s0 + n;
    const bf16_t* gp = p.projb() + t * INW + OFF_GR + h * 64;
    bf16_t* yo = p.xb() + t * KD + 768 + h * 64;
#pragma unroll
    for (int q4 = 0; q4 < 4; ++q4) {
#pragma unroll
      for (int mb = 0; mb < 2; ++mb) {
        const int d0 = mb * 32 + 8 * q4 + 4 * hh;
        const uint2 gw2 = *(const uint2*)(gp + d0); const float4 g = make_float4(__uint_as_float(gw2.x << 16), __uint_as_float(gw2.x & 0xffff0000u), __uint_as_float(gw2.y << 16), __uint_as_float(gw2.y & 0xffff0000u));
        float4 o;
        const f32x16& Oa = mb ? O1 : O0;
        o.x = Oa[q4 * 4 + 0] * rn * g.x * fast_sigmoid(g.x); o.y = Oa[q4 * 4 + 1] * rn * g.y * fast_sigmoid(g.y);
        o.z = Oa[q4 * 4 + 2] * rn * g.z * fast_sigmoid(g.z); o.w = Oa[q4 * 4 + 3] * rn * g.w * fast_sigmoid(g.w);
        *(uint2*)(yo + d0) = make_uint2(pk_bf16(o.x, o.y), pk_bf16(o.z, o.w));
      }
    }
  }
}

__device__ __forceinline__ void phase_post_pack(const Params& p, int l, int gtid, int ngt, int gw, int ngw, int lane) {
  const float* gq = p.inp(12) + l * 64; const float* gk = p.inp(13) + l * 64;
  for (int t = gw; t < T; t += ngw) {
    const int s = t % S, b = t / S;
    const bf16_t* row = p.projb() + (size_t)t * INW;
    float vin[24];
#pragma unroll
    for (int sl = 0; sl < 16; ++sl) vin[sl] = bf2f(row[(sl < 8 ? OFF_QM : OFF_KM) + (sl & 7) * 64 + lane]);
#pragma unroll
    for (int sl = 0; sl < 8; ++sl) vin[16 + sl] = bf2f(row[(sl < 4 ? OFF_QR : OFF_KR) + (sl & 3) * 64 + lane]);
    const float cm = p.cosm()[s * 8 + (lane & 7)], sm = p.sinm()[s * 8 + (lane & 7)];
    const float cr = p.cosr()[s * 32 + (lane & 31)], sr = p.sinr()[s * 32 + (lane & 31)];
    const float gqv = gq[lane], gkv = gk[lane];
#pragma unroll
    for (int slot = 0; slot < 16; ++slot) {
      const int h = slot & 7, bh = b * 8 + h; const bool isk = slot >= 8;
      const float v = vin[slot];
      const float ss = wave_sum(v * v);
      const float u = v * rsqrtf(ss / 64.0f + EPS) * (isk ? gkv : gqv);
      const float pu = __shfl(u, (lane < 8 ? lane + 8 : lane - 8) & 63);
      float o = u;
      if (lane < 16) o = lane < 8 ? (u * cm - pu * sm) : (u * cm + pu * sm);
      if (!isk) p.Qm()[((size_t)bh * S + s) * 64 + lane] = f2bf(o * QSCALE);
      else p.Km()[((((size_t)bh * (S / 32) + (s >> 5)) * 8 + (lane >> 3)) * 32 + (s & 31)) * 8 + (lane & 7)] = f2bf(o);
    }
#pragma unroll
    for (int slot = 16; slot < 24; ++slot) {
      const int h = (slot - 16) & 3, bh = b * 4 + h; const bool isk = slot >= 20;
      const float v = vin[slot];
      const float pv = __shfl(v, lane ^ 32);
      const float o = lane < 32 ? (v * cr - pv * sr) : (v * cr + pv * sr);
      const float l2g = ret_log2g(h); const int pos = s & 127;
      if (!isk) p.Qr()[((size_t)bh * S + s) * 64 + lane] = f2bf(o * exp2f((float)pos * l2g));
      else p.Kr()[((((size_t)bh * (S / 32) + (s >> 5)) * 8 + (lane >> 3)) * 32 + (s & 31)) * 8 + (lane & 7)] = f2bf(o * 0.125f * exp2f(-(float)pos * l2g));
    }
  }
  for (int idx = gtid; idx < NB * 8 * (S / 32) * 256; idx += ngt) {
    const int ln = idx & 63, ks = (idx >> 6) & 1, mb = (idx >> 7) & 1, tile = (idx >> 8) % (S / 32), bh = idx / (256 * (S / 32));
    const int b = bh >> 3, h = bh & 7, hh = ln >> 5, delta = mb * 32 + (ln & 31);
    float v[8];
#pragma unroll
    for (int j = 0; j < 8; ++j) { const int kappa = 16 * ks + 8 * (j >> 2) + 4 * hh + (j & 3), s = tile * 32 + kappa; v[j] = bf2f(p.projb()[(size_t)(b * S + s) * INW + OFF_VM + h * 64 + delta]); }
    uint4 o; o.x = pk_bf16(v[0], v[1]); o.y = pk_bf16(v[2], v[3]); o.z = pk_bf16(v[4], v[5]); o.w = pk_bf16(v[6], v[7]);
    *(uint4*)(p.Vm() + (size_t)idx * 8) = o;
  }
  for (int idx = gtid; idx < 2 * NB * 4 * (S / 32) * 256; idx += ngt) {
    const int ln = idx & 63, ks = (idx >> 6) & 1, blk = (idx >> 7) & 1, tile = (idx >> 8) % (S / 32), rest = idx / (256 * (S / 32)), bh = rest % (NB * 4), which = rest / (NB * 4);
    const int b = bh >> 2, h = bh & 3, hh = ln >> 5, delta = blk * 32 + (ln & 31);
    const float l2g = ret_log2g(h);
    float v[8];
#pragma unroll
    for (int j = 0; j < 8; ++j) {
      const int kappa = 16 * ks + 8 * (j >> 2) + 4 * hh + (j & 3), s = tile * 32 + kappa;
      const bf16_t* row = p.projb() + (size_t)(b * S + s) * INW;
      float x;
      if (which) {
        const float a = bf2f(row[OFF_KR + h * 64 + delta]), pa = bf2f(row[OFF_KR + h * 64 + (delta ^ 32)]);
        const int i = delta & 31; const float c = p.cosr()[s * 32 + i], sn = p.sinr()[s * 32 + i];
        x = (delta < 32 ? (a * c - pa * sn) : (a * c + pa * sn)) * 0.125f * exp2f(-(float)(s & 127) * l2g);
      } else x = bf2f(row[OFF_VR + h * 64 + delta]);
      v[j] = x;
    }
    uint4 o; o.x = pk_bf16(v[0], v[1]); o.y = pk_bf16(v[2], v[3]); o.z = pk_bf16(v[4], v[5]); o.w = pk_bf16(v[6], v[7]);
    *(uint4*)((which ? p.Krv() : p.Vr()) + ((size_t)(idx % (NB * 4 * (S / 32) * 256))) * 8) = o;
  }
}
__device__ __forceinline__ void phase_kmean2(const Params& p, int gtid, int ngt) {
  for (int idx = gtid; idx < NB * 8 * 16 * 64; idx += ngt) {
    const int d = idx & 63, j = (idx >> 6) & 15, bh = idx >> 10, c = d >> 3, dj = d & 7;
    float acc = 0.f;
    for (int tl = 0; tl < 8; ++tl) {
      const bf16_t* kp = p.Km() + (((size_t)bh * (S / 32) + j * 8 + tl) * 8 + c) * 256 + dj;
#pragma unroll 8
      for (int key = 0; key < 32; ++key) acc += bf2f(kp[key * 8]);
    }
    p.kmean()[idx] = acc * (1.0f / 256.0f);
  }
}

__device__ __forceinline__ void cvt_f32_bf16(const float* __restrict__ src, bf16_t* __restrict__ dst, size_t n8, int gtid, int ngt) {
  for (size_t i = gtid; i < n8; i += ngt) {
    float4 a = *(const float4*)(src + i * 8), b4 = *(const float4*)(src + i * 8 + 4);
    uint4 o; o.x = pk_bf16(a.x, a.y); o.y = pk_bf16(a.z, a.w); o.z = pk_bf16(b4.x, b4.y); o.w = pk_bf16(b4.z, b4.w);
    *(uint4*)(dst + i * 8) = o;
  }
}
__device__ __forceinline__ int f2key(float f) { int b = __float_as_int(f); return b ^ ((b >> 31) & 0x7fffffff); }
__device__ __forceinline__ float key2f(int k) { return __int_as_float(k ^ ((k >> 31) & 0x7fffffff)); }
#define CASD(a_, b_) { int mx_ = max(a_, b_), mn_ = min(a_, b_); a_ = mx_; b_ = mn_; }
__device__ __forceinline__ void sort16_desc(int (&v)[16]) {
#pragma unroll
  for (int k = 2; k <= 16; k <<= 1)
#pragma unroll
    for (int j = k >> 1; j > 0; j >>= 1)
#pragma unroll
      for (int i = 0; i < 16; ++i) { const int l2 = i ^ j; if (l2 > i) { if ((i & k) == 0) CASD(v[i], v[l2]) else CASD(v[l2], v[i]) } }
}
__device__ __forceinline__ void merge_top16(int (&a)[16], const int (&b)[16]) {
#pragma unroll
  for (int i = 0; i < 16; ++i) a[i] = max(a[i], b[15 - i]);
#pragma unroll
  for (int j = 8; j > 0; j >>= 1)
#pragma unroll
    for (int i = 0; i < 16; ++i) { const int l2 = i ^ j; if (l2 > i) CASD(a[i], a[l2]) }
}
__device__ __forceinline__ int lut4(int w0, int w1, int w2, int w3, int i) {
  const int w = i >> 2; const int d = (w == 0) ? w0 : (w == 1) ? w1 : (w == 2) ? w2 : w3;
  return (d >> ((i & 3) * 8)) & 127;
}

__device__ __forceinline__ void phase_peer_topk(const Params& p, int l, int gw, int ngw, int lane) {
  const int n = lane & 31, hh = lane >> 5;
  const bf16_t* skl = p.skb() + (size_t)l * 16 * 128 * 64;
  for (int w = gw; w < (T / 32) * 8; w += ngw) {
    const int tg = w >> 3, h = w & 7, t = tg * 32 + n;
    int L0[16], L1[16];
#pragma unroll
    for (int c = 0; c < 2; ++c) {
      const int hc = 2 * h + c;
      bf16x8 qf[4];
#pragma unroll
      for (int s = 0; s < 4; ++s) qf[s] = *(const bf16x8*)(p.qb() + (size_t)t * D + hc * 64 + 16 * s + 8 * hh);
      int A[16], Bq[16];
#pragma unroll
      for (int mb = 0; mb < 4; ++mb) {
        f32x16 X;
#pragma unroll
        for (int r = 0; r < 16; ++r) X[r] = 0.f;
#pragma unroll
        for (int s = 0; s < 4; ++s) {
          const bf16x8 kf = *(const bf16x8*)(skl + ((size_t)(hc * 128 + mb * 32 + n)) * 64 + 16 * s + 8 * hh);
          X = __builtin_amdgcn_mfma_f32_32x32x16_bf16(kf, qf[s], X, 0, 0, 0);
        }
        int Gk[16];
#pragma unroll
        for (int r = 0; r < 16; ++r) Gk[r] = (f2key(X[r]) & ~127) | (mb * 32 + (r & 3) + 8 * (r >> 2) + 4 * hh);
        sort16_desc(Gk);
        if (mb == 0) {
#pragma unroll
          for (int r = 0; r < 16; ++r) A[r] = Gk[r];
        } else merge_top16(A, Gk);
      }
#pragma unroll
      for (int r = 0; r < 16; ++r) Bq[r] = __shfl_xor(A[r], 32);
      merge_top16(A, Bq);
#pragma unroll
      for (int r = 0; r < 16; ++r) { if (c == 0) L0[r] = A[r]; else L1[r] = A[r]; }
    }
    float av[16], bv[16];
#pragma unroll
    for (int r = 0; r < 16; ++r) { av[r] = key2f(L0[r] & ~127); bv[r] = key2f(L1[r] & ~127); }
#define CAND(i_, j_) ((f2key(av[i_] + bv[j_]) & ~255) | ((i_) << 4) | (j_))
    int R[16], G1[16], G2[16];
#pragma unroll
    for (int j = 0; j < 16; ++j) R[j] = CAND(0, j);
    G1[0] = CAND(1, 0); G1[1] = CAND(1, 1); G1[2] = CAND(1, 2); G1[3] = CAND(1, 3); G1[4] = CAND(1, 4); G1[5] = CAND(1, 5); G1[6] = CAND(1, 6); G1[7] = CAND(1, 7);
    G1[8] = CAND(2, 0); G1[9] = CAND(2, 1); G1[10] = CAND(2, 2); G1[11] = CAND(2, 3); G1[12] = CAND(2, 4); G1[13] = CAND(3, 0); G1[14] = CAND(3, 1); G1[15] = CAND(3, 2);
    G2[0] = CAND(3, 3); G2[1] = CAND(4, 0); G2[2] = CAND(4, 1); G2[3] = CAND(4, 2); G2[4] = CAND(5, 0); G2[5] = CAND(5, 1); G2[6] = CAND(6, 0); G2[7] = CAND(6, 1);
    G2[8] = CAND(7, 0); G2[9] = CAND(7, 1); G2[10] = CAND(8, 0); G2[11] = CAND(9, 0); G2[12] = CAND(10, 0); G2[13] = CAND(11, 0); G2[14] = CAND(12, 0); G2[15] = CAND(13, 0);
    sort16_desc(G1); merge_top16(R, G1);
    sort16_desc(G2); merge_top16(R, G2);
    { int x0 = CAND(14, 0), x1 = CAND(15, 0);
#pragma unroll
      for (int i = 0; i < 16; ++i) CASD(R[i], x0)
#pragma unroll
      for (int i = 0; i < 16; ++i) CASD(R[i], x1)
    }
#undef CAND
    int pa0 = 0, pa1 = 0, pa2 = 0, pa3 = 0, pb0 = 0, pb1 = 0, pb2 = 0, pb3 = 0;
#pragma unroll
    for (int q = 0; q < 4; ++q) {
      pa0 |= (L0[q] & 127) << (8 * q); pa1 |= (L0[4 + q] & 127) << (8 * q); pa2 |= (L0[8 + q] & 127) << (8 * q); pa3 |= (L0[12 + q] & 127) << (8 * q);
      pb0 |= (L1[q] & 127) << (8 * q); pb1 |= (L1[4 + q] & 127) << (8 * q); pb2 |= (L1[8 + q] & 127) << (8 * q); pb3 |= (L1[12 + q] & 127) << (8 * q);
    }
    float ev[16], sum = 0.f; int ei[16];
    const float mx = key2f(R[0] & ~255);
#pragma unroll
    for (int z = 0; z < 16; ++z) {
      const float v = key2f(R[z] & ~255);
      ev[z] = __expf(v - mx); sum += ev[z];
      const int pay = R[z] & 255;
      ei[z] = lut4(pa0, pa1, pa2, pa3, pay >> 4) * 128 + lut4(pb0, pb1, pb2, pb3, pay & 15);
    }
    const float inv = 1.0f / sum;
    if (hh == 0) {
      float* go = p.gates() + ((size_t)t * 8 + h) * 16; int* eo = p.eidx() + ((size_t)t * 8 + h) * 16;
#pragma unroll
      for (int z = 0; z < 16; z += 4) {
        *(float4*)(go + z) = make_float4(ev[z] * inv, ev[z + 1] * inv, ev[z + 2] * inv, ev[z + 3] * inv);
        *(int4*)(eo + z) = make_int4(ei[z], ei[z + 1], ei[z + 2], ei[z + 3]);
      }
    }
  }
}

__device__ __forceinline__ void phase_peer_apply2(const Params& p, int l, float* coef, int gw, int ngw, int lane) {
  const float* g2 = p.inp(16) + l * D;
  for (int t = gw; t < T; t += ngw) {
    const float r = p.rstd()[t];
    float hv[16];
#pragma unroll
    for (int i = 0; i < 2; ++i) {
      const float* xp = p.outp() + (size_t)t * D + i * 512 + lane * 8; const float* gp = g2 + i * 512 + lane * 8;
      float4 x0 = *(const float4*)xp, x1 = *(const float4*)(xp + 4), g0 = *(const float4*)gp, g1 = *(const float4*)(gp + 4);
      hv[i * 8 + 0] = x0.x * r * g0.x; hv[i * 8 + 1] = x0.y * r * g0.y; hv[i * 8 + 2] = x0.z * r * g0.z; hv[i * 8 + 3] = x0.w * r * g0.w;
      hv[i * 8 + 4] = x1.x * r * g1.x; hv[i * 8 + 5] = x1.y * r * g1.y; hv[i * 8 + 6] = x1.z * r * g1.z; hv[i * 8 + 7] = x1.w * r * g1.w;
    }
    const int e_lo = p.eidx()[(size_t)t * 128 + lane], e_hi = p.eidx()[(size_t)t * 128 + 64 + lane];
    const float g_lo = p.gates()[(size_t)t * 128 + lane], g_hi = p.gates()[(size_t)t * 128 + 64 + lane];
    LDS_FENCE();
#pragma unroll 1
    for (int half = 0; half < 2; ++half) {
      const int ev = half ? e_hi : e_lo;
      float mine = 0.f;
#pragma unroll 4
      for (int j = 0; j < 64; ++j) {
        const int e = __shfl(ev, j);
        const bf16_t* up = p.Ub() + (size_t)e * D + lane * 8;
        uint4 u0 = *(const uint4*)up, u1 = *(const uint4*)(up + 512);
        float d = 0.f;
        d = fmaf(hv[0], __uint_as_float(u0.x << 16), d); d = fmaf(hv[1], __uint_as_float(u0.x & 0xffff0000u), d);
        d = fmaf(hv[2], __uint_as_float(u0.y << 16), d); d = fmaf(hv[3], __uint_as_float(u0.y & 0xffff0000u), d);
        d = fmaf(hv[4], __uint_as_float(u0.z << 16), d); d = fmaf(hv[5], __uint_as_float(u0.z & 0xffff0000u), d);
        d = fmaf(hv[6], __uint_as_float(u0.w << 16), d); d = fmaf(hv[7], __uint_as_float(u0.w & 0xffff0000u), d);
        d = fmaf(hv[8], __uint_as_float(u1.x << 16), d); d = fmaf(hv[9], __uint_as_float(u1.x & 0xffff0000u), d);
        d = fmaf(hv[10], __uint_as_float(u1.y << 16), d); d = fmaf(hv[11], __uint_as_float(u1.y & 0xffff0000u), d);
        d = fmaf(hv[12], __uint_as_float(u1.z << 16), d); d = fmaf(hv[13], __uint_as_float(u1.z & 0xffff0000u), d);
        d = fmaf(hv[14], __uint_as_float(u1.w << 16), d); d = fmaf(hv[15], __uint_as_float(u1.w & 0xffff0000u), d);
        d = wave_sum(d);
        if (lane == j) mine = d;
      }
      coef[half * 64 + lane] = (half ? g_hi : g_lo) * gelu_tanh(mine);
    }
    LDS_FENCE();
    float acc[16];
#pragma unroll
    for (int i = 0; i < 16; ++i) acc[i] = 0.f;
#pragma unroll 1
    for (int half = 0; half < 2; ++half) {
      const int ev = half ? e_hi : e_lo;
#pragma unroll 4
      for (int j = 0; j < 64; ++j) {
        const int e = __shfl(ev, j);
        const float c = coef[half * 64 + j];
        const bf16_t* vp = p.Vb() + (size_t)e * D + lane * 8;
        uint4 v0 = *(const uint4*)vp, v1 = *(const uint4*)(vp + 512);
        acc[0] = fmaf(c, __uint_as_float(v0.x << 16), acc[0]); acc[1] = fmaf(c, __uint_as_float(v0.x & 0xffff0000u), acc[1]);
        acc[2] = fmaf(c, __uint_as_float(v0.y << 16), acc[2]); acc[3] = fmaf(c, __uint_as_float(v0.y & 0xffff0000u), acc[3]);
        acc[4] = fmaf(c, __uint_as_float(v0.z << 16), acc[4]); acc[5] = fmaf(c, __uint_as_float(v0.z & 0xffff0000u), acc[5]);
        acc[6] = fmaf(c, __uint_as_float(v0.w << 16), acc[6]); acc[7] = fmaf(c, __uint_as_float(v0.w & 0xffff0000u), acc[7]);
        acc[8] = fmaf(c, __uint_as_float(v1.x << 16), acc[8]); acc[9] = fmaf(c, __uint_as_float(v1.x & 0xffff0000u), acc[9]);
        acc[10] = fmaf(c, __uint_as_float(v1.y << 16), acc[10]); acc[11] = fmaf(c, __uint_as_float(v1.y & 0xffff0000u), acc[11]);
        acc[12] = fmaf(c, __uint_as_float(v1.z << 16), acc[12]); acc[13] = fmaf(c, __uint_as_float(v1.z & 0xffff0000u), acc[13]);
        acc[14] = fmaf(c, __uint_as_float(v1.w << 16), acc[14]); acc[15] = fmaf(c, __uint_as_float(v1.w & 0xffff0000u), acc[15]);
      }
    }
#pragma unroll
    for (int i = 0; i < 2; ++i) {
      float* xp = p.outp() + (size_t)t * D + i * 512 + lane * 8;
      float4 x0 = *(float4*)xp, x1 = *(float4*)(xp + 4);
      x0.x += acc[i * 8 + 0]; x0.y += acc[i * 8 + 1]; x0.z += acc[i * 8 + 2]; x0.w += acc[i * 8 + 3];
      x1.x += acc[i * 8 + 4]; x1.y += acc[i * 8 + 5]; x1.z += acc[i * 8 + 6]; x1.w += acc[i * 8 + 7];
      *(float4*)xp = x0; *(float4*)(xp + 4) = x1;
    }
  }
}

typedef int v8i __attribute__((ext_vector_type(8)));
__device__ __forceinline__ unsigned xcc_id() { return (unsigned)__builtin_amdgcn_s_getreg((3 << 11) | 20) & 7u; }
__device__ __forceinline__ float pow2_scale(float amax) {
  if (!(amax > 0.f)) return 1.0f;
  const int e = (int)floorf(log2f(240.0f / amax));
  return exp2f((float)(e < 60 ? (e > -60 ? e : -60) : 60));
}
__device__ __forceinline__ unsigned pack4_fp8(float a, float b, float c, float d) {
  int v = __builtin_amdgcn_cvt_pk_fp8_f32(a, b, 0, false);
  v = __builtin_amdgcn_cvt_pk_fp8_f32(c, d, v, true);
  return (unsigned)v;
}
__device__ __forceinline__ void cvt_table_fp8(const float* __restrict__ src, unsigned char* __restrict__ dst, float* __restrict__ scl, int gw, int ngw, int lane) {
  for (int e0 = gw; e0 < 16384; e0 += 2 * ngw) {
    float4 v[2][4];
#pragma unroll
    for (int u = 0; u < 2; ++u) { const int e = (e0 + u * ngw < 16384) ? e0 + u * ngw : e0;
#pragma unroll
      for (int k = 0; k < 4; ++k) v[u][k] = *(const float4*)(src + (size_t)e * D + k * 256 + lane * 4); }
#pragma unroll
    for (int u = 0; u < 2; ++u) {
      const int e = e0 + u * ngw;
      if (e < 16384) {
        float am = 0.f;
#pragma unroll
        for (int k = 0; k < 4; ++k) am = fmaxf(am, fmaxf(fmaxf(fabsf(v[u][k].x), fabsf(v[u][k].y)), fmaxf(fabsf(v[u][k].z), fabsf(v[u][k].w))));
        am = wave_max(am);
        const float s = pow2_scale(am);
        if (lane == 0) scl[e] = s;
#pragma unroll
        for (int k = 0; k < 4; ++k) {
          const int slice = 2 * k + (lane >> 5), off = (lane & 31) * 4;
          *(unsigned*)(dst + ((size_t)slice * 16384 + e) * 128 + off) = pack4_fp8(v[u][k].x * s, v[u][k].y * s, v[u][k].z * s, v[u][k].w * s);
        }
      }
    }
  }
}
__device__ __forceinline__ void phase_cvt_rows_h8(const Params& p, int l, int gw, int ngw, int lane) {
  const float* g2 = p.inp(16) + l * D;
  float4 g[4];
#pragma unroll
  for (int k = 0; k < 4; ++k) g[k] = *(const float4*)(g2 + k * 256 + lane * 4);
  for (int t0 = gw; t0 < T; t0 += 2 * ngw) {
    float4 v[2][4];
#pragma unroll
    for (int u = 0; u < 2; ++u) { const int t = (t0 + u * ngw < T) ? t0 + u * ngw : t0;
#pragma unroll
      for (int k = 0; k < 4; ++k) v[u][k] = *(const float4*)(p.outp() + (size_t)t * D + k * 256 + lane * 4); }
#pragma unroll
    for (int u = 0; u < 2; ++u) {
      const int t = t0 + u * ngw;
      if (t < T) {
        float ss = 0.f;
#pragma unroll
        for (int k = 0; k < 4; ++k) {
          const float4 w = v[u][k];
          ss += w.x * w.x + w.y * w.y + w.z * w.z + w.w * w.w;
          uint2 ph; ph.x = pk_bf16(w.x, w.y); ph.y = pk_bf16(w.z, w.w);
          *(uint2*)(p.xb() + (size_t)t * KD + k * 256 + lane * 4) = ph;
        }
        ss = wave_sum(ss);
        const float r = rsqrtf(ss / (float)D + EPS);
        if (lane == 0) p.rstd()[t] = r;
#pragma unroll
        for (int k = 0; k < 4; ++k) {
          const float4 w = v[u][k];
          const int slice = 2 * k + (lane >> 5), off = (lane & 31) * 4;
          uint2 o; o.x = pk_bf16(w.x * r * g[k].x, w.y * r * g[k].y); o.y = pk_bf16(w.z * r * g[k].z, w.w * r * g[k].w);
          *(uint2*)(p.hb() + ((size_t)slice * T + t) * 128 + off) = o;
        }
      }
    }
  }
}
#define DPP_ADD(v_, ctrl_) ((v_) + __builtin_bit_cast(float, __builtin_amdgcn_update_dpp(0, __builtin_bit_cast(int, (v_)), (ctrl_), 0xF, 0xF, true)))
__device__ __forceinline__ float sum_xor16(float x) { float a = x, b = x; asm volatile("v_nop\n\tv_nop\n\tv_permlane16_swap_b32 %0, %1" : "+v"(a), "+v"(b)); return a + b; }
__device__ __forceinline__ float sum_xor32(float x) { float a = x, b = x; asm volatile("v_nop\n\tv_nop\n\tv_permlane32_swap_b32 %0, %1" : "+v"(a), "+v"(b)); return a + b; }
__device__ __forceinline__ int q_pull(int* head, int nitems, int* bc, int tid) {
  __syncthreads();
  if (tid == 0) bc[0] = atomicAdd(head, 1);
  __syncthreads();
  const int v = bc[0];
  return v < nitems ? v : -1;
}
constexpr int PEER_TILE = 128;
__device__ __forceinline__ void phase_peer_u(const Params& p, int* heads, unsigned char* lds, int tid) {
  const int lane = tid & 63, wv = tid >> 6, r8 = lane >> 3, c8 = lane & 7;
  int* bc = (int*)lds;
  int* eW = (int*)(lds + 1024 + wv * 12288);
  bf16_t* hW = (bf16_t*)(lds + 1024 + wv * 12288 + 8192);
  const int myx = (int)xcc_id();
  for (int pass = 0; pass < 8; ++pass) {
    const int s = (myx + pass) & 7;
    const unsigned char* Us = p.U8s() + (size_t)s * 16384 * 128 + c8 * 16;
    for (;;) {
      const int item = q_pull(heads + s, T / PEER_TILE, bc, tid);
      if (item < 0) break;
      const int t0 = item * PEER_TILE + wv * 16;
      LDS_FENCE();
      { uint2 ev[16];
        const bf16_t* hsrc = p.hb() + ((size_t)s * T + t0) * 128 + lane * 8;
#pragma unroll
        for (int k = 0; k < 16; ++k) ev[k] = *(const uint2*)(p.eidx() + (size_t)(t0 + k) * 128 + lane * 2);
        const uint4 hq0 = *(const uint4*)(hsrc), hq1 = *(const uint4*)(hsrc + 512), hq2 = *(const uint4*)(hsrc + 1024), hq3 = *(const uint4*)(hsrc + 1536);
#pragma unroll
        for (int k = 0; k < 16; ++k) *(uint2*)(eW + k * 128 + lane * 2) = ev[k];
        *(uint4*)(hW + lane * 8) = hq0; *(uint4*)(hW + 512 + lane * 8) = hq1; *(uint4*)(hW + 1024 + lane * 8) = hq2; *(uint4*)(hW + 1536 + lane * 8) = hq3; }
      LDS_FENCE();
      uint4 R[4][8];
#define PEER_U_LOAD(M_, BUF_) { _Pragma("unroll") for (int eb = 0; eb < 8; ++eb) R[BUF_][eb] = *(const uint4*)(Us + (size_t)eW[(M_) * 64 + eb * 8 + r8] * 128); }
      PEER_U_LOAD(0, 0) PEER_U_LOAD(1, 1) PEER_U_LOAD(2, 2)
      float hv[16]; float res0 = 0.f, res1 = 0.f;
#define PEER_U_LOADH(TOK_) { const bf16_t* hp = hW + (TOK_) * 128 + c8 * 16; const uint4 a = *(const uint4*)hp, b4 = *(const uint4*)(hp + 8); \
        const unsigned w8[8] = {a.x, a.y, a.z, a.w, b4.x, b4.y, b4.z, b4.w};                                                              \
        _Pragma("unroll") for (int z = 0; z < 8; ++z) { hv[2 * z] = __uint_as_float(w8[z] << 16); hv[2 * z + 1] = __uint_as_float(w8[z] & 0xffff0000u); } }
      PEER_U_LOADH(0)
#define PEER_U_HALF(M_, BUF_, HALF_)                                                                           \
      {                                                                                                                                   \
        if ((M_) + 3 < 32) PEER_U_LOAD((M_) + 3, ((BUF_) + 3) & 3)                                                                        \
        _Pragma("unroll") for (int eb = 0; eb < 8; ++eb) {                                                                                \
          const unsigned ww[4] = {R[BUF_][eb].x, R[BUF_][eb].y, R[BUF_][eb].z, R[BUF_][eb].w};                                            \
          float d = 0.f;                                                                                                                  \
          _Pragma("unroll") for (int q4 = 0; q4 < 4; ++q4) {                                                                              \
            const auto f01 = __builtin_amdgcn_cvt_pk_f32_fp8((int)ww[q4], false); const auto f23 = __builtin_amdgcn_cvt_pk_f32_fp8((int)ww[q4], true); \
            d = fmaf(hv[q4 * 4 + 0], f01[0], d); d = fmaf(hv[q4 * 4 + 1], f01[1], d); d = fmaf(hv[q4 * 4 + 2], f23[0], d); d = fmaf(hv[q4 * 4 + 3], f23[1], d); \
          }                                                                                                                               \
          d = DPP_ADD(d, 0xB1); d = DPP_ADD(d, 0x4E); d = DPP_ADD(d, 0x141);     \
          if ((HALF_) == 0) { if (c8 == eb) res0 = d; } else { if (c8 == eb) res1 = d; }                                                  \
        }                                                                                                                                 \
        if ((HALF_) == 1) {                                                                                                               \
          float* po = p.ppart() + ((size_t)s * T + t0 + ((M_) >> 1)) * 128;                                                               \
          po[c8 * 8 + r8] = res0; po[64 + c8 * 8 + r8] = res1;                                                                            \
          if ((M_) + 1 < 32) PEER_U_LOADH(((M_) >> 1) + 1)                                                                                \
        }                                                                                                                                 \
      }
#pragma unroll
      for (int m4 = 0; m4 < 32; m4 += 4) {
        PEER_U_HALF(m4, 0, 0) PEER_U_HALF(m4 + 1, 1, 1) PEER_U_HALF(m4 + 2, 2, 0) PEER_U_HALF(m4 + 3, 3, 1)
      }
#undef PEER_U_HALF
#undef PEER_U_LOADH
#undef PEER_U_LOAD
    }
  }
}
__device__ __forceinline__ void phase_peer_r(const Params& p, int gtid, int ngt) {
  for (int idx0 = gtid; idx0 < T * 128; idx0 += 4 * ngt) {
    float d[4]; int e[4]; float su_[4], sv_[4], g_[4]; bool ok[4];
#pragma unroll
    for (int u = 0; u < 4; ++u) { const int idx = idx0 + u * ngt; ok[u] = idx < T * 128; const int ix = ok[u] ? idx : 0;
      e[u] = p.eidx()[ix]; g_[u] = p.gates()[ix]; float a = 0.f;
#pragma unroll
      for (int s = 0; s < 8; ++s) a += p.ppart()[(size_t)s * T * 128 + ix];
      d[u] = a; }
#pragma unroll
    for (int u = 0; u < 4; ++u) { su_[u] = p.su()[e[u]]; sv_[u] = p.sv()[e[u]]; }
#pragma unroll
    for (int u = 0; u < 4; ++u) if (ok[u]) p.gates()[idx0 + u * ngt] = g_[u] * gelu_tanh(d[u] * p.rstd()[(idx0 + u * ngt) >> 7] / su_[u]) / sv_[u];
  }
}
__device__ __forceinline__ void phase_peer_v(const Params& p, int* heads, unsigned char* lds, int tid) {
  const int lane = tid & 63, wv = tid >> 6, r8 = lane >> 3, c8 = lane & 7;
  int* bc = (int*)lds;
  uint2* pW = (uint2*)(lds + 1024 + wv * 16384);
  const int myx = (int)xcc_id();
  for (int pass = 0; pass < 8; ++pass) {
    const int s = (myx + pass) & 7;
    const unsigned char* Vs = p.V8s() + (size_t)s * 16384 * 128 + c8 * 16;
    for (;;) {
      const int item = q_pull(heads + s, T / PEER_TILE, bc, tid);
      if (item < 0) break;
      const int t0 = item * PEER_TILE + wv * 16;
      LDS_FENCE();
      { uint2 e2[16], g2[16];
#pragma unroll
        for (int k = 0; k < 16; ++k) { e2[k] = *(const uint2*)(p.eidx() + (size_t)(t0 + k) * 128 + lane * 2); g2[k] = *(const uint2*)(p.gates() + (size_t)(t0 + k) * 128 + lane * 2); }
#pragma unroll
        for (int k = 0; k < 16; ++k) *(uint4*)(pW + k * 128 + lane * 2) = make_uint4(e2[k].x, g2[k].x, e2[k].y, g2[k].y); }
      LDS_FENCE();
      const int xoff = s * 128 + c8 * 16 + (r8 & 3) * 4;
      float4 xo[8];
#pragma unroll
      for (int k = 0; k < 8; ++k) xo[k] = *(const float4*)(p.outp() + (size_t)(t0 + k) * D + xoff);
      uint4 R[3][8];
#define PEER_V_LOAD(M_, BUF_) { _Pragma("unroll") for (int eb = 0; eb < 8; ++eb) R[BUF_][eb] = *(const uint4*)(Vs + (size_t)pW[(M_) * 64 + eb * 8 + r8].x * 128); }
      PEER_V_LOAD(0, 0) PEER_V_LOAD(1, 1)
      float acc[16];
#define PEER_V_HALF(M_, BUF_, HALF_)                                                           \
      {                                                                                                                                   \
        if ((M_) + 2 < 32) PEER_V_LOAD((M_) + 2, ((BUF_) + 2) % 3)                                                                        \
        if ((HALF_) == 0) { _Pragma("unroll") for (int z = 0; z < 16; ++z) acc[z] = 0.f; }                                                \
        _Pragma("unroll") for (int eb = 0; eb < 8; ++eb) {                                                                                \
          const float c = __uint_as_float(pW[(M_) * 64 + eb * 8 + r8].y);                                                                 \
          const unsigned ww[4] = {R[BUF_][eb].x, R[BUF_][eb].y, R[BUF_][eb].z, R[BUF_][eb].w};                                            \
          _Pragma("unroll") for (int q4 = 0; q4 < 4; ++q4) {                                                                              \
            const auto f01 = __builtin_amdgcn_cvt_pk_f32_fp8((int)ww[q4], false); const auto f23 = __builtin_amdgcn_cvt_pk_f32_fp8((int)ww[q4], true); \
            acc[q4 * 4 + 0] = fmaf(c, f01[0], acc[q4 * 4 + 0]); acc[q4 * 4 + 1] = fmaf(c, f01[1], acc[q4 * 4 + 1]);                       \
            acc[q4 * 4 + 2] = fmaf(c, f23[0], acc[q4 * 4 + 2]); acc[q4 * 4 + 3] = fmaf(c, f23[1], acc[q4 * 4 + 3]);                       \
          }                                                                                                                               \
        }                                                                                                                                 \
        if ((HALF_) == 1) {                                                                                                               \
          _Pragma("unroll") for (int z = 0; z < 16; ++z) { acc[z] = DPP_ADD(acc[z], 0x128); acc[z] = sum_xor16(acc[z]); acc[z] = sum_xor32(acc[z]); }     \
          const int sel = r8 & 3;                                                                                                         \
          float4 dl;                                                                                                                      \
          dl.x = sel == 0 ? acc[0] : sel == 1 ? acc[4] : sel == 2 ? acc[8] : acc[12];                                                     \
          dl.y = sel == 0 ? acc[1] : sel == 1 ? acc[5] : sel == 2 ? acc[9] : acc[13];                                                     \
          dl.z = sel == 0 ? acc[2] : sel == 1 ? acc[6] : sel == 2 ? acc[10] : acc[14];                                                    \
          dl.w = sel == 0 ? acc[3] : sel == 1 ? acc[7] : sel == 2 ? acc[11] : acc[15];                                                    \
          const float4 xv = xo[((M_) >> 1) & 7];                                                                                          \
          if (((M_) >> 1) + 8 < 16) xo[((M_) >> 1) & 7] = *(const float4*)(p.outp() + (size_t)(t0 + ((M_) >> 1) + 8) * D + xoff);                  \
          const float4 xn = make_float4(xv.x + dl.x, xv.y + dl.y, xv.z + dl.z, xv.w + dl.w);                                              \
          float sq = 0.f;                                                                                                                 \
          if (r8 < 4) {                                                                                                                   \
            *(float4*)(p.outp() + (size_t)(t0 + ((M_) >> 1)) * D + xoff) = xn;                                                             \
            *(uint2*)(p.xb() + (size_t)(t0 + ((M_) >> 1)) * KD + xoff) = make_uint2(pk_bf16(xn.x, xn.y), pk_bf16(xn.z, xn.w));     \
            sq = (xn.x * xn.x + xn.y * xn.y) + (xn.z * xn.z + xn.w * xn.w);                                                                \
          }                                                                                                                               \
          sq = DPP_ADD(sq, 0xB1); sq = DPP_ADD(sq, 0x4E); sq = DPP_ADD(sq, 0x141); sq = DPP_ADD(sq, 0x128); sq = sum_xor16(sq);     \
          if (lane == 0) p.ssq1()[(size_t)(t0 + ((M_) >> 1)) * 8 + s] = sq;                                                               \
        }                                                                                                                                 \
      }
#pragma unroll
      for (int m6 = 0; m6 < 30; m6 += 6) {
        PEER_V_HALF(m6, 0, 0) PEER_V_HALF(m6 + 1, 1, 1) PEER_V_HALF(m6 + 2, 2, 0) PEER_V_HALF(m6 + 3, 0, 1) PEER_V_HALF(m6 + 4, 1, 0) PEER_V_HALF(m6 + 5, 2, 1)
      }
      PEER_V_HALF(30, 0, 0) PEER_V_HALF(31, 1, 1)
#undef PEER_V_HALF
#undef PEER_V_LOAD
    }
  }
}

#if PEER_CHECK
constexpr int CHK_N = 512;
__device__ __forceinline__ float* chk_x(const Params& p) { return (float*)(p.ws + WO_ybuf); }
__device__ __forceinline__ float* chk_m(const Params& p) { return (float*)(p.ws + WO_ybuf + (size_t)CHK_N * D * 4); }
__device__ __forceinline__ float* chk_g(const Params& p) { return (float*)(p.ws + WO_ybuf + (size_t)CHK_N * D * 4 + 4096); }
__device__ __forceinline__ void chk_save(const Params& p, int gtid, int ngt) {
  for (int i = gtid; i < CHK_N * D; i += ngt) chk_x(p)[i] = p.outp()[(size_t)(i / D) * 64 * D + (i % D)];
  for (int i = gtid; i < CHK_N * 128; i += ngt) chk_g(p)[i] = p.gates()[(size_t)(i / 128) * 64 * 128 + (i % 128)];
  if (gtid < 16) chk_m(p)[gtid] = 0.f;
}
__device__ __forceinline__ void chk_apply(const Params& p, int l, float* coef, int gw, int ngw, int lane) {
  const float* g2 = p.inp(16) + l * D;
  const float* U = p.inp(19) + (size_t)l * 16384 * D; const float* V = p.inp(20) + (size_t)l * 16384 * D;
  for (int i = gw; i < CHK_N; i += ngw) {
    const int t = i * 64;
    const float r = p.rstd()[t];
    float4 hv[4];
#pragma unroll
    for (int k = 0; k < 4; ++k) {
      float4 xv = *(const float4*)(chk_x(p) + (size_t)i * D + (lane + k * 64) * 4);
      float4 gv = *(const float4*)(g2 + (lane + k * 64) * 4);
      hv[k].x = xv.x * r * gv.x; hv[k].y = xv.y * r * gv.y; hv[k].z = xv.z * r * gv.z; hv[k].w = xv.w * r * gv.w;
    }
    LDS_FENCE();
    for (int j = 0; j < 128; ++j) {
      const int e = p.eidx()[(size_t)t * 128 + j];
      const float4* up = (const float4*)(U + (size_t)e * D);
      float dsum = 0.f;
#pragma unroll
      for (int k = 0; k < 4; ++k) { float4 uv = up[lane + k * 64]; dsum += hv[k].x * uv.x + hv[k].y * uv.y + hv[k].z * uv.z + hv[k].w * uv.w; }
      dsum = wave_sum(dsum);
      if (lane == 0) coef[j] = chk_g(p)[(size_t)i * 128 + j] * gelu_tanh(dsum);
    }
    LDS_FENCE();
    float4 acc[4];
#pragma unroll
    for (int k = 0; k < 4; ++k) acc[k] = make_float4(0.f, 0.f, 0.f, 0.f);
    for (int j = 0; j < 128; ++j) {
      const int e = p.eidx()[(size_t)t * 128 + j];
      const float c = coef[j];
      const float4* vp = (const float4*)(V + (size_t)e * D);
#pragma unroll
      for (int k = 0; k < 4; ++k) { float4 vv = vp[lane + k * 64]; acc[k].x = fmaf(c, vv.x, acc[k].x); acc[k].y = fmaf(c, vv.y, acc[k].y); acc[k].z = fmaf(c, vv.z, acc[k].z); acc[k].w = fmaf(c, vv.w, acc[k].w); }
    }
    float d2 = 0.f, r2 = 0.f;
#pragma unroll
    for (int k = 0; k < 4; ++k) {
      float4 xa = *(const float4*)(p.outp() + (size_t)t * D + (lane + k * 64) * 4);
      float4 xb4 = *(const float4*)(chk_x(p) + (size_t)i * D + (lane + k * 64) * 4);
      float e0 = (xa.x - xb4.x) - acc[k].x, e1 = (xa.y - xb4.y) - acc[k].y, e2 = (xa.z - xb4.z) - acc[k].z, e3 = (xa.w - xb4.w) - acc[k].w;
      d2 += e0 * e0 + e1 * e1 + e2 * e2 + e3 * e3;
      r2 += acc[k].x * acc[k].x + acc[k].y * acc[k].y + acc[k].z * acc[k].z + acc[k].w * acc[k].w;
    }
    d2 = wave_sum(d2); r2 = wave_sum(r2);
    if (lane == 0) { atomicAdd((unsigned long long*)&chk_m(p)[8], (unsigned long long)(d2 * 1099511627776.0f)); atomicAdd((unsigned long long*)&chk_m(p)[10], (unsigned long long)(r2 * 1099511627776.0f)); }
  }
}
__device__ __forceinline__ void chk_topk(const Params& p, int l, int gtid, int ngt) {
  const float* subk = p.inp(18) + (size_t)l * 16 * 128 * 64;
  for (int it = gtid; it < CHK_N * 8; it += ngt) {
    const int i = it >> 3, h = it & 7, t = i * 64;
    float tva[16], tvb[16]; int tia[16], tib[16];
#pragma unroll 1
    for (int c = 0; c < 2; ++c) {
      float tv[16]; int ti[16];
#pragma unroll
      for (int z = 0; z < 16; ++z) { tv[z] = -INFINITY; ti[z] = 0; }
      const bf16_t* q = p.qb() + (size_t)t * D + (2 * h + c) * 64;
      const float* kb = subk + (size_t)(2 * h + c) * 128 * 64;
#pragma unroll 1
      for (int n = 0; n < 128; ++n) {
        float sc = 0.f;
        for (int d = 0; d < 64; ++d) sc = fmaf(bf2f(q[d]), kb[n * 64 + d], sc);
        float v_ = sc; int i_ = n;
#pragma unroll
        for (int z = 0; z < 16; ++z) { bool gt = v_ > tv[z]; float a = tv[z]; int b = ti[z]; tv[z] = gt ? v_ : a; ti[z] = gt ? i_ : b; v_ = gt ? a : v_; i_ = gt ? b : i_; }
      }
#pragma unroll
      for (int z = 0; z < 16; ++z) { if (c == 0) { tva[z] = tv[z]; tia[z] = ti[z]; } else { tvb[z] = tv[z]; tib[z] = ti[z]; } }
    }
    float tv[16]; int ti[16];
#pragma unroll
    for (int z = 0; z < 16; ++z) { tv[z] = -INFINITY; ti[z] = 0; }
#pragma unroll 1
    for (int a = 0; a < 16; ++a)
#pragma unroll 1
      for (int b = 0; b < 16; ++b) {
        float av = 0.f, bv = 0.f; int ai = 0, bi = 0;
#pragma unroll
        for (int z = 0; z < 16; ++z) { if (z == a) { av = tva[z]; ai = tia[z]; } if (z == b) { bv = tvb[z]; bi = tib[z]; } }
        float v_ = av + bv; int i_ = ai * 128 + bi;
#pragma unroll
        for (int z = 0; z < 16; ++z) { bool gt = v_ > tv[z]; float x = tv[z]; int y = ti[z]; tv[z] = gt ? v_ : x; ti[z] = gt ? i_ : y; v_ = gt ? x : v_; i_ = gt ? y : i_; }
      }
    float sum = 0.f, ev[16];
#pragma unroll
    for (int z = 0; z < 16; ++z) { ev[z] = expf(tv[z] - tv[0]); sum += ev[z]; }
    int miss = 0; float gerr = 0.f;
    for (int z = 0; z < 16; ++z) {
      const int ef = p.eidx()[((size_t)t * 8 + h) * 16 + z]; const float gf = p.gates()[((size_t)t * 8 + h) * 16 + z];
      bool found = false;
#pragma unroll
      for (int y = 0; y < 16; ++y) if (ti[y] == ef) { found = true; gerr = fmaxf(gerr, fabsf(ev[y] / sum - gf)); }
      if (!found) ++miss;
    }
    atomicAdd(&chk_m(p)[3], (float)miss);
    atomicMax((int*)&chk_m(p)[4], __float_as_int(gerr));
  }
}
__device__ __forceinline__ void chk_emit(const Params& p) {
  float v = 0.f;
  if (PEER_CHECK == 1) v = sqrtf((float)((double)*(unsigned long long*)&chk_m(p)[8] / (double)*(unsigned long long*)&chk_m(p)[10]));
  if (PEER_CHECK == 2) v = chk_m(p)[3] / (float)(CHK_N * 8 * 16);
  if (PEER_CHECK == 3) v = chk_m(p)[4];
  p.outp()[0] += 1.0e4f * v + 100.0f;
}
#endif

#define XB_TMO      128
#define XB_XCNT(j)  (256  + 64 * (j))
#define XB_XSUB(j)  (1280 + 64 * (j))
#define XB_XGEN(j)  (2304 + 64 * (j))
#define XB_TOP      3328
#define XB_TOPGEN   3392
#define XCD_BAR_WORDS 3456
#define XB_SPIN_CAP (1u << 18)
#define LAS __attribute__((address_space(3)))

__device__ __forceinline__ unsigned xb_ld(unsigned* p)              { return __hip_atomic_load(p, __ATOMIC_RELAXED, __HIP_MEMORY_SCOPE_AGENT); }
__device__ __forceinline__ unsigned xb_add(unsigned* p, unsigned v) { return __hip_atomic_fetch_add(p, v, __ATOMIC_RELAXED, __HIP_MEMORY_SCOPE_AGENT); }
__device__ __forceinline__ unsigned xb_xcc_id() { return (unsigned)__builtin_amdgcn_s_getreg((3 << 11) | 20) & 0xFu; }
#define XB_SPIN(cond, bar) do { unsigned _sp = 0; while (cond) { __builtin_amdgcn_s_sleep(1); \
    if ((++_sp & 255u) == 0u) { if (xb_ld(&(bar)[XB_TMO])) break; if (_sp > XB_SPIN_CAP) { atomicAdd(&(bar)[XB_TMO], 1u); break; } } } } while (0)

struct XcdBarrier {
    unsigned* bar; unsigned x;
    volatile LAS unsigned* st;
};

__device__ __forceinline__ XcdBarrier xcd_barrier_post(unsigned* bar, volatile LAS unsigned* st) {
    XcdBarrier b; b.bar = bar; b.x = xb_xcc_id(); b.st = st;
    if (threadIdx.x == 0) (void)xb_add(&bar[XB_XCNT(b.x)], 1u);
    return b;
}
__device__ __forceinline__ void xcd_barrier_complete(unsigned* bar, unsigned x, unsigned& nloc, unsigned& nx) {
    const unsigned G = gridDim.x * gridDim.y * gridDim.z;
    unsigned sum, cnt, mine, sp = 0u;
    for (;;) {
        sum = 0u; cnt = 0u; mine = 0u;
#pragma unroll
        for (unsigned j = 0; j < 16; ++j) { const unsigned c = xb_ld(&bar[XB_XCNT(j)]); sum += c; cnt += (c > 0u) ? 1u : 0u; mine = (j == x) ? c : mine; }
        if (sum == G) break;
        __builtin_amdgcn_s_sleep(1);
        if ((++sp & 255u) == 0u) { if (xb_ld(&bar[XB_TMO])) break; if (sp > XB_SPIN_CAP) { atomicAdd(&bar[XB_TMO], 1u); break; } }
    }
    nloc = mine > 0u ? mine : 1u; nx = cnt > 0u ? cnt : 1u;
}

__device__ __forceinline__ void xcd_barrier(const XcdBarrier& b) {
    asm volatile("s_waitcnt vmcnt(0)" ::: "memory");
    __syncthreads();
    if (threadIdx.x == 0) {
        unsigned* bar = b.bar;
        __builtin_amdgcn_s_waitcnt(0);
        unsigned nloc = b.st[0], nx = b.st[1];
        if (nloc == 0u) { xcd_barrier_complete(bar, b.x, nloc, nx); b.st[0] = nloc; b.st[1] = nx; }
        const unsigned old = xb_add(&bar[XB_XSUB(b.x)], 1u);
        const unsigned gen = old / nloc;
        if (old + 1u == (gen + 1u) * nloc) {
            __builtin_amdgcn_fence(__ATOMIC_RELEASE, "agent");
            asm volatile("s_waitcnt vmcnt(0)" ::: "memory");
            const unsigned og = xb_add(&bar[XB_TOP], 1u);
            const unsigned tg = og / nx;
            if (og + 1u == (tg + 1u) * nx) xb_add(&bar[XB_TOPGEN], 1u);
            else XB_SPIN(xb_ld(&bar[XB_TOPGEN]) == tg, bar);
            __builtin_amdgcn_fence(__ATOMIC_ACQUIRE, "agent");
            xb_add(&bar[XB_XGEN(b.x)], 1u);
            asm volatile("s_waitcnt vmcnt(0)" ::: "memory");
        } else {
            XB_SPIN(xb_ld(&bar[XB_XGEN(b.x)]) == gen, bar);
            __builtin_amdgcn_fence(__ATOMIC_ACQUIRE, "agent");
            asm volatile("s_waitcnt vmcnt(0)" ::: "memory");
        }
    }
    __syncthreads();
}

__device__ __forceinline__ Params fresh(const Params& p) {
  Params q = p;
  asm volatile("" : "+s"(q.ws), "+s"(q.out_));
#pragma unroll
  for (int i = 0; i < 21; ++i) asm volatile("" : "+s"(q.in[i]));
  return q;
}
#define PHASE_IDS int tid = threadIdx.x; asm volatile("" : "+v"(tid)); int bid = blockIdx.x; asm volatile("" : "+s"(bid)); int G = gridDim.x; asm volatile("" : "+s"(G)); \
  const int lane = tid & 63, wv = tid >> 6; const int ngt = G * NTHR, ngw = G * NWAVE; \
  const int gtid = bid * NTHR + tid, gw = bid * NWAVE + wv; (void)lane; (void)wv; (void)gtid; (void)gw; (void)ngt; (void)ngw; \
  const Params q = fresh(p);
__global__ void __launch_bounds__(NTHR) mega(Params p) {
  extern __shared__ __attribute__((aligned(16))) unsigned char lds_raw[];
  cg::grid_group grid = cg::this_grid();
  float* ldsf = (float*)lds_raw;
  if (threadIdx.x == 0) { *(uint4*)(lds_raw + LDS_BYTES - 16) = make_uint4(0u, 0u, 0u, 0u); }
  __syncthreads();
  XcdBarrier xb = xcd_barrier_post(p.bar(), (volatile LAS unsigned*)(lds_raw + LDS_BYTES - 16));

  { PHASE_IDS; phase_prologue(q, gtid, ngt, gw, ngw, lane); cvt_f32_bf16(q.inp(18), q.skb(), (size_t)NL * 16 * 128 * 64 / 8, gtid, ngt);
    for (size_t i = gtid; i < (size_t)16 * 128 * 512 / 8; i += ngt) { const size_t g = i / (128 * 512 / 8), r = i % (128 * 512 / 8); ((uint4*)q.S5Wz())[g * (256 * 512 / 8) + (128 * 512 / 8) + r] = make_uint4(0u, 0u, 0u, 0u); }
    if (gtid < 256) q.qctr()[gtid] = 0;
    phase_s5_prep(q, 0, gtid, ngt); }
  grid.sync();
  { constexpr int l = 0;
    DUP(5) {
    { const Params q = fresh(p); EpiScaleStoreBf16 e{q.projb(), INW, q.ssq1(), 8, nullptr};
      run_gemm(lds_raw, q.xb(), q.Win_t() + (size_t)l * INW * KD, T, INW, KD, e); }
    xcd_barrier(xb);
    }
    DUP(0) {
    { PHASE_IDS; phase_post_pack(q, l, gtid, ngt, gw, ngw, lane); phase_pack_u(q, gtid, ngt); }
    xcd_barrier(xb);
    }
    DUP(1) {
    { const Params q = fresh(p); EpiS5Z e{q.S5Z()};
      pg8::Gemm g{q.S5A(), q.S5Wz(), 16 * 1024, 16 * 256, 512, 640, 512}; pg8::GroupOrder So; So.init(16, 4, 1, (int)gridDim.x, (int)blockIdx.x);
      pg8::gemm_phase<EpiS5Z, pg8::GroupOrder, true, true>((PG8_LAS unsigned char*)lds_raw, g, So, e); }
    { PHASE_IDS; phase_kmean2(q, gtid, ngt); phase_ret_kv(q, gw, ngw, lane); }
    xcd_barrier(xb);
    }
    DUP(2) {
    { PHASE_IDS; phase_s5_scan(q, gtid, ngt); phase_ret_scan(q, gtid, ngt); }
    __syncthreads();
    { PHASE_IDS; phase_moba2(q, l, lds_raw, bid, G); }
    xcd_barrier(xb);
    }
    DUP(3) {
    { const Params q = fresh(p); EpiS5Y e{q.ygb(), q.S5A(), q.inp(10) + l * 256};
      pg8::Gemm g{q.S5A(), q.S5Wy(), 16 * 1024, 16 * 512, 640, 640, 640}; pg8::GroupOrder So; So.init(16, 4, 2, (int)gridDim.x, (int)blockIdx.x);
      pg8::gemm_phase<EpiS5Y, pg8::GroupOrder, true, true>((PG8_LAS unsigned char*)lds_raw, g, So, e); }
    __syncthreads();
    { PHASE_IDS; phase_ret_out(q, gw, ngw, lane); }
    xcd_barrier(xb);
    }
    DUP(4) {
    { const Params q = fresh(p); EpiGlu e{q.xb(), q.ygb(), (float*)(lds_raw + 131072)};
      run_gemm(lds_raw, q.ygb(), q.Wglu_t() + (size_t)l * 65536, T, 256, 256, e); }
    xcd_barrier(xb);
    }
    { PHASE_IDS; cvt_table_fp8(q.inp(19) + (size_t)l * 16384 * D, q.U8s(), q.su(), gw, ngw, lane);
      cvt_table_fp8(q.inp(20) + (size_t)l * 16384 * D, q.V8s(), q.sv(), gw, ngw, lane); }
    __syncthreads();
    { const Params q = fresh(p); EpiResid e{q.outp(), D, q.xb2(), q.hb(), q.inp(16) + l * D, q.ssq2()};
      run_gemm(lds_raw, q.xb(), q.Wout_t() + (size_t)l * D * KD, T, D, KD, e); }
    xcd_barrier(xb);
    DUP(7) {
    { const Params q = fresh(p); EpiScaleStoreBf16 e{q.qb(), D, q.ssq2(), 16, q.rstd()};
      run_gemm(lds_raw, q.xb2(), q.Wq_t() + (size_t)l * D * KD, T, D, KD, e); }
    xcd_barrier(xb);
    }
    if (!(PROBE_SKIP & 2)) {
    DUP(8) {
    { PHASE_IDS; phase_peer_topk(q, l, gw, ngw, lane); }
    xcd_barrier(xb);
    }
    }
#if PEER_CHECK
    if (l == 0) { { PHASE_IDS; chk_save(q, gtid, ngt); } xcd_barrier(xb); { PHASE_IDS; chk_topk(q, l, gtid, ngt); } xcd_barrier(xb); }
#endif
    if (!(PROBE_SKIP & 1)) {
    { PHASE_IDS; phase_peer_u(q, q.qctr() + (l * 2 + 0) * 8, lds_raw, tid); }
    xcd_barrier(xb);
    { PHASE_IDS; phase_peer_r(q, gtid, ngt); if (l + 1 < NL) phase_s5_prep(q, l + 1, gtid, ngt); }
    xcd_barrier(xb);
    if (!(PROBE_SKIP & 32)) {
    { PHASE_IDS; phase_peer_v(q, q.qctr() + (l * 2 + 1) * 8, lds_raw, tid); }
    xcd_barrier(xb);
    }
    }
#if PEER_CHECK
    if (l == 0) { { PHASE_IDS; chk_apply(q, l, ldsf + wv * 128, gw, ngw, lane); } xcd_barrier(xb);
      if (blockIdx.x == 0 && threadIdx.x == 0) { const Params q = fresh(p); chk_emit(q); } xcd_barrier(xb); }
#endif
  }
  { constexpr int l = 1;
    DUP(5) {
    { const Params q = fresh(p); EpiScaleStoreBf16 e{q.projb(), INW, q.ssq1(), 8, nullptr};
      run_gemm(lds_raw, q.xb(), q.Win_t() + (size_t)l * INW * KD, T, INW, KD, e); }
    xcd_barrier(xb);
    }
    DUP(0) {
    { PHASE_IDS; phase_post_pack(q, l, gtid, ngt, gw, ngw, lane); phase_pack_u(q, gtid, ngt); }
    xcd_barrier(xb);
    }
    DUP(1) {
    { const Params q = fresh(p); EpiS5Z e{q.S5Z()};
      pg8::Gemm g{q.S5A(), q.S5Wz(), 16 * 1024, 16 * 256, 512, 640, 512}; pg8::GroupOrder So; So.init(16, 4, 1, (int)gridDim.x, (int)blockIdx.x);
      pg8::gemm_phase<EpiS5Z, pg8::GroupOrder, true, true>((PG8_LAS unsigned char*)lds_raw, g, So, e); }
    { PHASE_IDS; phase_kmean2(q, gtid, ngt); phase_ret_kv(q, gw, ngw, lane); }
    xcd_barrier(xb);
    }
    DUP(2) {
    { PHASE_IDS; phase_s5_scan(q, gtid, ngt); phase_ret_scan(q, gtid, ngt); }
    __syncthreads();
    { PHASE_IDS; phase_moba2(q, l, lds_raw, bid, G); }
    xcd_barrier(xb);
    }
    DUP(3) {
    { const Params q = fresh(p); EpiS5Y e{q.ygb(), q.S5A(), q.inp(10) + l * 256};
      pg8::Gemm g{q.S5A(), q.S5Wy(), 16 * 1024, 16 * 512, 640, 640, 640}; pg8::GroupOrder So; So.init(16, 4, 2, (int)gridDim.x, (int)blockIdx.x);
      pg8::gemm_phase<EpiS5Y, pg8::GroupOrder, true, true>((PG8_LAS unsigned char*)lds_raw, g, So, e); }
    __syncthreads();
    { PHASE_IDS; phase_ret_out(q, gw, ngw, lane); }
    xcd_barrier(xb);
    }
    DUP(4) {
    { const Params q = fresh(p); EpiGlu e{q.xb(), q.ygb(), (float*)(lds_raw + 131072)};
      run_gemm(lds_raw, q.ygb(), q.Wglu_t() + (size_t)l * 65536, T, 256, 256, e); }
    xcd_barrier(xb);
    }
    { PHASE_IDS; cvt_table_fp8(q.inp(19) + (size_t)l * 16384 * D, q.U8s(), q.su(), gw, ngw, lane);
      cvt_table_fp8(q.inp(20) + (size_t)l * 16384 * D, q.V8s(), q.sv(), gw, ngw, lane); }
    __syncthreads();
    { const Params q = fresh(p); EpiResid e{q.outp(), D, q.xb2(), q.hb(), q.inp(16) + l * D, q.ssq2()};
      run_gemm(lds_raw, q.xb(), q.Wout_t() + (size_t)l * D * KD, T, D, KD, e); }
    xcd_barrier(xb);
    DUP(7) {
    { const Params q = fresh(p); EpiScaleStoreBf16 e{q.qb(), D, q.ssq2(), 16, q.rstd()};
      run_gemm(lds_raw, q.xb2(), q.Wq_t() + (size_t)l * D * KD, T, D, KD, e); }
    xcd_barrier(xb);
    }
    if (!(PROBE_SKIP & 2)) {
    DUP(8) {
    { PHASE_IDS; phase_peer_topk(q, l, gw, ngw, lane); }
    xcd_barrier(xb);
    }
    }
#if PEER_CHECK
    if (l == 0) { { PHASE_IDS; chk_save(q, gtid, ngt); } xcd_barrier(xb); { PHASE_IDS; chk_topk(q, l, gtid, ngt); } xcd_barrier(xb); }
#endif
    if (!(PROBE_SKIP & 1)) {
    { PHASE_IDS; phase_peer_u(q, q.qctr() + (l * 2 + 0) * 8, lds_raw, tid); }
    xcd_barrier(xb);
    { PHASE_IDS; phase_peer_r(q, gtid, ngt); if (l + 1 < NL) phase_s5_prep(q, l + 1, gtid, ngt); }
    xcd_barrier(xb);
    if (!(PROBE_SKIP & 32)) {
    { PHASE_IDS; phase_peer_v(q, q.qctr() + (l * 2 + 1) * 8, lds_raw, tid); }
    xcd_barrier(xb);
    }
    }
#if PEER_CHECK
    if (l == 0) { { PHASE_IDS; chk_apply(q, l, ldsf + wv * 128, gw, ngw, lane); } xcd_barrier(xb);
      if (blockIdx.x == 0 && threadIdx.x == 0) { const Params q = fresh(p); chk_emit(q); } xcd_barrier(xb); }
#endif
  }
  { constexpr int l = 2;
    DUP(5) {
    { const Params q = fresh(p); EpiScaleStoreBf16 e{q.projb(), INW, q.ssq1(), 8, nullptr};
      run_gemm(lds_raw, q.xb(), q.Win_t() + (size_t)l * INW * KD, T, INW, KD, e); }
    xcd_barrier(xb);
    }
    DUP(0) {
    { PHASE_IDS; phase_post_pack(q, l, gtid, ngt, gw, ngw, lane); phase_pack_u(q, gtid, ngt); }
    xcd_barrier(xb);
    }
    DUP(1) {
    { const Params q = fresh(p); EpiS5Z e{q.S5Z()};
      pg8::Gemm g{q.S5A(), q.S5Wz(), 16 * 1024, 16 * 256, 512, 640, 512}; pg8::GroupOrder So; So.init(16, 4, 1, (int)gridDim.x, (int)blockIdx.x);
      pg8::gemm_phase<EpiS5Z, pg8::GroupOrder, true, true>((PG8_LAS unsigned char*)lds_raw, g, So, e); }
    { PHASE_IDS; phase_kmean2(q, gtid, ngt); phase_ret_kv(q, gw, ngw, lane); }
    xcd_barrier(xb);
    }
    DUP(2) {
    { PHASE_IDS; phase_s5_scan(q, gtid, ngt); phase_ret_scan(q, gtid, ngt); }
    __syncthreads();
    { PHASE_IDS; phase_moba2(q, l, lds_raw, bid, G); }
    xcd_barrier(xb);
    }
    DUP(3) {
    { const Params q = fresh(p); EpiS5Y e{q.ygb(), q.S5A(), q.inp(10) + l * 256};
      pg8::Gemm g{q.S5A(), q.S5Wy(), 16 * 1024, 16 * 512, 640, 640, 640}; pg8::GroupOrder So; So.init(16, 4, 2, (int)gridDim.x, (int)blockIdx.x);
      pg8::gemm_phase<EpiS5Y, pg8::GroupOrder, true, true>((PG8_LAS unsigned char*)lds_raw, g, So, e); }
    __syncthreads();
    { PHASE_IDS; phase_ret_out(q, gw, ngw, lane); }
    xcd_barrier(xb);
    }
    DUP(4) {
    { const Params q = fresh(p); EpiGlu e{q.xb(), q.ygb(), (float*)(lds_raw + 131072)};
      run_gemm(lds_raw, q.ygb(), q.Wglu_t() + (size_t)l * 65536, T, 256, 256, e); }
    xcd_barrier(xb);
    }
    { PHASE_IDS; cvt_table_fp8(q.inp(19) + (size_t)l * 16384 * D, q.U8s(), q.su(), gw, ngw, lane);
      cvt_table_fp8(q.inp(20) + (size_t)l * 16384 * D, q.V8s(), q.sv(), gw, ngw, lane); }
    __syncthreads();
    { const Params q = fresh(p); EpiResid e{q.outp(), D, q.xb2(), q.hb(), q.inp(16) + l * D, q.ssq2()};
      run_gemm(lds_raw, q.xb(), q.Wout_t() + (size_t)l * D * KD, T, D, KD, e); }
    xcd_barrier(xb);
    DUP(7) {
    { const Params q = fresh(p); EpiScaleStoreBf16 e{q.qb(), D, q.ssq2(), 16, q.rstd()};
      run_gemm(lds_raw, q.xb2(), q.Wq_t() + (size_t)l * D * KD, T, D, KD, e); }
    xcd_barrier(xb);
    }
    if (!(PROBE_SKIP & 2)) {
    DUP(8) {
    { PHASE_IDS; phase_peer_topk(q, l, gw, ngw, lane); }
    xcd_barrier(xb);
    }
    }
#if PEER_CHECK
    if (l == 0) { { PHASE_IDS; chk_save(q, gtid, ngt); } xcd_barrier(xb); { PHASE_IDS; chk_topk(q, l, gtid, ngt); } xcd_barrier(xb); }
#endif
    if (!(PROBE_SKIP & 1)) {
    { PHASE_IDS; phase_peer_u(q, q.qctr() + (l * 2 + 0) * 8, lds_raw, tid); }
    xcd_barrier(xb);
    { PHASE_IDS; phase_peer_r(q, gtid, ngt); if (l + 1 < NL) phase_s5_prep(q, l + 1, gtid, ngt); }
    xcd_barrier(xb);
    if (!(PROBE_SKIP & 32)) {
    { PHASE_IDS; phase_peer_v(q, q.qctr() + (l * 2 + 1) * 8, lds_raw, tid); }
    xcd_barrier(xb);
    }
    }
#if PEER_CHECK
    if (l == 0) { { PHASE_IDS; chk_apply(q, l, ldsf + wv * 128, gw, ngw, lane); } xcd_barrier(xb);
      if (blockIdx.x == 0 && threadIdx.x == 0) { const Params q = fresh(p); chk_emit(q); } xcd_barrier(xb); }
#endif
  }
  { constexpr int l = 3;
    DUP(5) {
    { const Params q = fresh(p); EpiScaleStoreBf16 e{q.projb(), INW, q.ssq1(), 8, nullptr};
      run_gemm(lds_raw, q.xb(), q.Win_t() + (size_t)l * INW * KD, T, INW, KD, e); }
    xcd_barrier(xb);
    }
    DUP(0) {
    { PHASE_IDS; phase_post_pack(q, l, gtid, ngt, gw, ngw, lane); phase_pack_u(q, gtid, ngt); }
    xcd_barrier(xb);
    }
    DUP(1) {
    { const Params q = fresh(p); EpiS5Z e{q.S5Z()};
      pg8::Gemm g{q.S5A(), q.S5Wz(), 16 * 1024, 16 * 256, 512, 640, 512}; pg8::GroupOrder So; So.init(16, 4, 1, (int)gridDim.x, (int)blockIdx.x);
      pg8::gemm_phase<EpiS5Z, pg8::GroupOrder, true, true>((PG8_LAS unsigned char*)lds_raw, g, So, e); }
    { PHASE_IDS; phase_kmean2(q, gtid, ngt); phase_ret_kv(q, gw, ngw, lane); }
    xcd_barrier(xb);
    }
    DUP(2) {
    { PHASE_IDS; phase_s5_scan(q, gtid, ngt); phase_ret_scan(q, gtid, ngt); }
    __syncthreads();
    { PHASE_IDS; phase_moba2(q, l, lds_raw, bid, G); }
    xcd_barrier(xb);
    }
    DUP(3) {
    { const Params q = fresh(p); EpiS5Y e{q.ygb(), q.S5A(), q.inp(10) + l * 256};
      pg8::Gemm g{q.S5A(), q.S5Wy(), 16 * 1024, 16 * 512, 640, 640, 640}; pg8::GroupOrder So; So.init(16, 4, 2, (int)gridDim.x, (int)blockIdx.x);
      pg8::gemm_phase<EpiS5Y, pg8::GroupOrder, true, true>((PG8_LAS unsigned char*)lds_raw, g, So, e); }
    __syncthreads();
    { PHASE_IDS; phase_ret_out(q, gw, ngw, lane); }
    xcd_barrier(xb);
    }
    DUP(4) {
    { const Params q = fresh(p); EpiGlu e{q.xb(), q.ygb(), (float*)(lds_raw + 131072)};
      run_gemm(lds_raw, q.ygb(), q.Wglu_t() + (size_t)l * 65536, T, 256, 256, e); }
    xcd_barrier(xb);
    }
    { PHASE_IDS; cvt_table_fp8(q.inp(19) + (size_t)l * 16384 * D, q.U8s(), q.su(), gw, ngw, lane);
      cvt_table_fp8(q.inp(20) + (size_t)l * 16384 * D, q.V8s(), q.sv(), gw, ngw, lane); }
    __syncthreads();
    { const Params q = fresh(p); EpiResid e{q.outp(), D, q.xb2(), q.hb(), q.inp(16) + l * D, q.ssq2()};
      run_gemm(lds_raw, q.xb(), q.Wout_t() + (size_t)l * D * KD, T, D, KD, e); }
    xcd_barrier(xb);
    DUP(7) {
    { const Params q = fresh(p); EpiScaleStoreBf16 e{q.qb(), D, q.ssq2(), 16, q.rstd()};
      run_gemm(lds_raw, q.xb2(), q.Wq_t() + (size_t)l * D * KD, T, D, KD, e); }
    xcd_barrier(xb);
    }
    if (!(PROBE_SKIP & 2)) {
    DUP(8) {
    { PHASE_IDS; phase_peer_topk(q, l, gw, ngw, lane); }
    xcd_barrier(xb);
    }
    }
#if PEER_CHECK
    if (l == 0) { { PHASE_IDS; chk_save(q, gtid, ngt); } xcd_barrier(xb); { PHASE_IDS; chk_topk(q, l, gtid, ngt); } xcd_barrier(xb); }
#endif
    if (!(PROBE_SKIP & 1)) {
    { PHASE_IDS; phase_peer_u(q, q.qctr() + (l * 2 + 0) * 8, lds_raw, tid); }
    xcd_barrier(xb);
    { PHASE_IDS; phase_peer_r(q, gtid, ngt); if (l + 1 < NL) phase_s5_prep(q, l + 1, gtid, ngt); }
    xcd_barrier(xb);
    if (!(PROBE_SKIP & 32)) {
    { PHASE_IDS; phase_peer_v(q, q.qctr() + (l * 2 + 1) * 8, lds_raw, tid); }
    xcd_barrier(xb);
    }
    }
#if PEER_CHECK
    if (l == 0) { { PHASE_IDS; chk_apply(q, l, ldsf + wv * 128, gw, ngw, lane); } xcd_barrier(xb);
      if (blockIdx.x == 0 && threadIdx.x == 0) { const Params q = fresh(p); chk_emit(q); } xcd_barrier(xb); }
#endif
  }
}

}

extern "C" void kernel_launch(void* const* d_in, const int* in_sizes, int n_in, void* d_out, int out_size, void* d_ws, size_t ws_size,
                              hipStream_t stream) {
  static int grid_blocks = 0;
  if (!grid_blocks) {
    int dev = 0, cus = 0, per_cu = 0;
    hipGetDevice(&dev);
    hipDeviceGetAttribute(&cus, hipDeviceAttributeMultiprocessorCount, dev);
    hipFuncSetAttribute((const void*)mega, hipFuncAttributeMaxDynamicSharedMemorySize, LDS_BYTES);
    hipOccupancyMaxActiveBlocksPerMultiprocessor(&per_cu, (const void*)mega, NTHR, LDS_BYTES);
    if (per_cu < 1) { fprintf(stderr, "occupancy query returned %d\n", per_cu); per_cu = 1; }
    grid_blocks = cus * 1;
    if (grid_blocks < 64) fprintf(stderr, "unexpected CU count %d\n", cus);
  }
  Params p{};
  for (int i = 0; i < 21; ++i) p.in[i] = (const GAS float*)d_in[i];
  p.out_ = (GAS float*)d_out;
  p.ws = (GAS unsigned char*)d_ws;
  if (WS_TOTAL > ws_size) { fprintf(stderr, "workspace too small: need %zu have %zu\n", (size_t)WS_TOTAL, ws_size); return; }
  hipMemsetAsync((unsigned char*)d_ws + WO_bar, 0, 16384, stream);
  void* args[] = {&p};
  hipError_t e = hipLaunchCooperativeKernel((const void*)mega, dim3(grid_blocks), dim3(NTHR), args, LDS_BYTES, stream);
  if (e != hipSuccess) fprintf(stderr, "cooperative launch failed: %s (grid %d)\n", hipGetErrorString(e), grid_blocks);
}
```

```cpp
#include <hip/hip_runtime.h>
#include <hip/hip_cooperative_groups.h>
#include <math.h>
#include <stdint.h>
#include <stdio.h>
namespace cg = cooperative_groups;

#ifndef PEER_CHECK
#define PEER_CHECK 0
#endif
#ifndef PROBE_DUP
#define PROBE_DUP 0
#endif
__device__ __forceinline__ int dup_n(int n) { asm volatile("" : "+s"(n)); return n; }
#define DUP(bit) _Pragma("unroll 1") for (int rep_ = 0, repn_ = (((PROBE_DUP >> (bit)) & 1) ? dup_n(2) : 1); rep_ < repn_; ++rep_)
#ifndef PROBE_SKIP
#define PROBE_SKIP 0
#endif
#ifndef PRECISE
#define PRECISE 0
#endif

namespace {
constexpr int NB = 8, S = 4096, D = 1024, NL = 4, T = NB * S;
constexpr int INW = 2816;
constexpr int OFF_U = 0, OFF_QM = 256, OFF_KM = 768, OFF_VM = 1280, OFF_QR = 1792, OFF_KR = 2048, OFF_VR = 2304, OFF_GR = 2560;
constexpr float EPS = 1e-6f;
static_assert(PRECISE == 0, "PRECISE builds are retired");
constexpr int KS = PRECISE ? 3 : 1;
constexpr int KD = D * KS;
constexpr int NTHR = 512, NWAVE = 8;
constexpr int LDS_BYTES = 131072 + 4096 + 1024;

typedef unsigned short bf16_t;
using bf16x8 = __attribute__((ext_vector_type(8))) short;
using f32x4 = __attribute__((ext_vector_type(4))) float;

__device__ __forceinline__ float wave_sum(float v) {
#pragma unroll
  for (int o = 32; o > 0; o >>= 1) v += __shfl_xor(v, o);
  return v;
}
__device__ __forceinline__ float wave_max(float v) {
#pragma unroll
  for (int o = 32; o > 0; o >>= 1) v = fmaxf(v, __shfl_xor(v, o));
  return v;
}
__device__ __forceinline__ float gelu_tanh(float x) {
  const float k0 = 0.7978845608028654f, k1 = 0.044715f;
  float u = k0 * (x + k1 * x * x * x);
  return 0.5f * x * (1.0f + tanhf(u));
}
__device__ __forceinline__ float sigmoidf_(float x) { return 1.0f / (1.0f + expf(-x)); }
__device__ __forceinline__ float fast_sigmoid(float x) { return __builtin_amdgcn_rcpf(1.0f + __builtin_amdgcn_exp2f(-1.4426950408889634f * x)); }
__device__ __forceinline__ float fast_gelu(float x) { const float u = 0.7978845608028654f * (x + 0.044715f * x * x * x); return x * fast_sigmoid(2.0f * u); }
__device__ __forceinline__ bf16_t f2bf(float f) {
  unsigned u = __float_as_uint(f);
  u += 0x7fffu + ((u >> 16) & 1u);
  return (bf16_t)(u >> 16);
}
__device__ __forceinline__ float bf2f(bf16_t h) { return __uint_as_float(((unsigned)h) << 16); }
#define LDS_FENCE() asm volatile("s_waitcnt lgkmcnt(0)" ::: "memory")
typedef __bf16 bf16x2_hw __attribute__((ext_vector_type(2)));
typedef float f32x2_hw __attribute__((ext_vector_type(2)));
__device__ __forceinline__ unsigned pk_bf16(float lo, float hi) { const f32x2_hw f = {lo, hi}; const bf16x2_hw b = __builtin_convertvector(f, bf16x2_hw); return __builtin_bit_cast(unsigned, b); }
typedef float f32x16 __attribute__((ext_vector_type(16)));

constexpr size_t al256(size_t x) { return (x + 255) & ~(size_t)255; }
constexpr size_t WO_rstd = 0;
constexpr size_t WO_cosm = WO_rstd + al256((size_t)T * 4);
constexpr size_t WO_sinm = WO_cosm + al256((size_t)S * 8 * 4);
constexpr size_t WO_cosr = WO_sinm + al256((size_t)S * 8 * 4);
constexpr size_t WO_sinr = WO_cosr + al256((size_t)S * 32 * 4);
constexpr size_t WO_kmean = WO_sinr + al256((size_t)S * 32 * 4);
constexpr size_t WO_proj = WO_kmean + al256((size_t)NB * 8 * 16 * 64 * 4);
constexpr size_t WO_ybuf = WO_proj + al256((size_t)T * INW * 4);
constexpr size_t WO_yg = WO_ybuf + al256((size_t)T * D * 4);
constexpr size_t WO_skb = WO_yg + al256((size_t)T * 256 * 4);
constexpr size_t WO_Ub = WO_skb + al256((size_t)NL * 16 * 128 * 64 * 2);
constexpr size_t WO_Vb = WO_Ub + al256((size_t)16384 * D * 2);
constexpr size_t WO_gates = WO_Vb + al256((size_t)16384 * D * 2);
constexpr size_t WO_eidx = WO_gates + al256((size_t)T * 128 * 4);
constexpr size_t WO_xb = WO_eidx + al256((size_t)T * 128 * 4);
constexpr size_t WO_Win_t = WO_xb + al256((size_t)T * KD * 2);
constexpr size_t WO_Wout_t = WO_Win_t + al256((size_t)NL * INW * KD * 2);
constexpr size_t WO_Wq_t = WO_Wout_t + al256((size_t)NL * D * KD * 2);
constexpr size_t WO_Qm = WO_Wq_t + al256((size_t)NL * D * KD * 2);
constexpr size_t WO_Km = WO_Qm + al256((size_t)T * 512 * 2);
constexpr size_t WO_Vm = WO_Km + al256((size_t)T * 512 * 2);
constexpr size_t WO_S5a32 = WO_Vm + al256((size_t)T * 512 * 2);
constexpr size_t WO_Wglu_t = WO_S5a32 + al256((size_t)16 * 64 * 2 * 4);
constexpr size_t WO_Qr = WO_Wglu_t + al256((size_t)NL * 256 * 256 * 2);
constexpr size_t WO_Kr = WO_Qr + al256((size_t)T * 256 * 2);
constexpr size_t WO_Krv = WO_Kr + al256((size_t)T * 256 * 2);
constexpr size_t WO_Vr = WO_Krv + al256((size_t)T * 256 * 2);
constexpr size_t WO_KVr = WO_Vr + al256((size_t)T * 256 * 2);
constexpr size_t WO_Rb = WO_KVr + al256((size_t)32 * 32 * 4096 * 4);
constexpr size_t WO_qctr = WO_Rb + al256((size_t)32 * 32 * 4096 * 2);
constexpr size_t WO_bar = WO_qctr + al256(1024);
constexpr size_t WO_S5Wy = WO_bar + al256(16384);
constexpr size_t WO_S5Wz = WO_S5Wy + al256((size_t)16 * 512 * 640 * 2);
constexpr size_t WO_ssq1 = WO_S5Wz + al256((size_t)16 * 256 * 512 * 2);
constexpr size_t WO_ssq2 = WO_ssq1 + al256((size_t)T * 8 * 4);
constexpr size_t WS_TOTAL = WO_ssq2 + al256((size_t)T * 16 * 4);
constexpr size_t WO_S5A = WO_gates;
constexpr size_t WO_S5Z = WO_S5A + al256((size_t)16 * 1024 * 640 * 2);
static_assert(WO_S5Z + (size_t)16 * 1024 * 128 * 4 <= WO_gates + 2 * al256((size_t)T * 128 * 4), "S5A/S5Z must fit in gates+eidx");
#define GAS __attribute__((address_space(1)))
static_assert((size_t)T * D * 2 + (size_t)T * 128 * 8 * 4 + (size_t)T * D * 2 <= (size_t)T * INW * 4, "qb + ppart + xb2 must fit in the proj region");
struct Params {
  const GAS float* in[21];
  GAS float* out_;
  GAS unsigned char* ws;
  __device__ __forceinline__ const float* inp(int i) const { return (const float*)in[i]; }
  __device__ __forceinline__ float* outp() const { return (float*)out_; }
  __device__ __forceinline__ float* rstd() const { return (float*)(ws + WO_rstd); }
  __device__ __forceinline__ float* cosm() const { return (float*)(ws + WO_cosm); }
  __device__ __forceinline__ float* sinm() const { return (float*)(ws + WO_sinm); }
  __device__ __forceinline__ float* cosr() const { return (float*)(ws + WO_cosr); }
  __device__ __forceinline__ float* sinr() const { return (float*)(ws + WO_sinr); }
  __device__ __forceinline__ float* kmean() const { return (float*)(ws + WO_kmean); }
  __device__ __forceinline__ float* proj() const { return (float*)(ws + WO_proj); }
  __device__ __forceinline__ float* ybuf() const { return (float*)(ws + WO_ybuf); }
  __device__ __forceinline__ float* yg() const { return (float*)(ws + WO_yg); }
  __device__ __forceinline__ bf16_t* skb() const { return (bf16_t*)(ws + WO_skb); }
  __device__ __forceinline__ bf16_t* Ub() const { return (bf16_t*)(ws + WO_Ub); }
  __device__ __forceinline__ bf16_t* Vb() const { return (bf16_t*)(ws + WO_Vb); }
  __device__ __forceinline__ float* gates() const { return (float*)(ws + WO_gates); }
  __device__ __forceinline__ int* eidx() const { return (int*)(ws + WO_eidx); }
  __device__ __forceinline__ bf16_t* xb() const { return (bf16_t*)(ws + WO_xb); }
  __device__ __forceinline__ bf16_t* Win_t() const { return (bf16_t*)(ws + WO_Win_t); }
  __device__ __forceinline__ bf16_t* Wout_t() const { return (bf16_t*)(ws + WO_Wout_t); }
  __device__ __forceinline__ bf16_t* Wq_t() const { return (bf16_t*)(ws + WO_Wq_t); }
  __device__ __forceinline__ bf16_t* Qm() const { return (bf16_t*)(ws + WO_Qm); }
  __device__ __forceinline__ bf16_t* Km() const { return (bf16_t*)(ws + WO_Km); }
  __device__ __forceinline__ bf16_t* Vm() const { return (bf16_t*)(ws + WO_Vm); }
  __device__ __forceinline__ bf16_t* S5A() const { return (bf16_t*)(ws + WO_S5A); }
  __device__ __forceinline__ bf16_t* S5Wy() const { return (bf16_t*)(ws + WO_S5Wy); }
  __device__ __forceinline__ bf16_t* S5Wz() const { return (bf16_t*)(ws + WO_S5Wz); }
  __device__ __forceinline__ float* S5Z() const { return (float*)(ws + WO_S5Z); }
  __device__ __forceinline__ float* S5a32() const { return (float*)(ws + WO_S5a32); }
  __device__ __forceinline__ bf16_t* Wglu_t() const { return (bf16_t*)(ws + WO_Wglu_t); }
  __device__ __forceinline__ bf16_t* ygb() const { return (bf16_t*)(ws + WO_yg); }
  __device__ __forceinline__ int* qctr() const { return (int*)(ws + WO_qctr); }
  __device__ __forceinline__ unsigned char* U8s() const { return (unsigned char*)(ws + WO_Ub); }
  __device__ __forceinline__ float* su() const { return (float*)(ws + WO_Ub + (size_t)16384 * D); }
  __device__ __forceinline__ unsigned char* V8s() const { return (unsigned char*)(ws + WO_Vb); }
  __device__ __forceinline__ float* sv() const { return (float*)(ws + WO_Vb + (size_t)16384 * D); }
  __device__ __forceinline__ bf16_t* hb() const { return (bf16_t*)(ws + WO_ybuf + ((size_t)4 << 20)); }
  __device__ __forceinline__ unsigned char* h8lo() const { return (unsigned char*)(ws + WO_ybuf + ((size_t)4 << 20) + (size_t)T * D); }
  __device__ __forceinline__ float* sh() const { return (float*)(ws + WO_ybuf + ((size_t)4 << 20) + (size_t)2 * T * D); }
  __device__ __forceinline__ float* ppart() const { return (float*)(ws + WO_proj + (size_t)T * D * 2); }
  __device__ __forceinline__ bf16_t* Qr() const { return (bf16_t*)(ws + WO_Qr); }
  __device__ __forceinline__ bf16_t* Kr() const { return (bf16_t*)(ws + WO_Kr); }
  __device__ __forceinline__ bf16_t* Krv() const { return (bf16_t*)(ws + WO_Krv); }
  __device__ __forceinline__ bf16_t* Vr() const { return (bf16_t*)(ws + WO_Vr); }
  __device__ __forceinline__ float* KVr() const { return (float*)(ws + WO_KVr); }
  __device__ __forceinline__ bf16_t* Rb() const { return (bf16_t*)(ws + WO_Rb); }
  __device__ __forceinline__ unsigned* bar() const { return (unsigned*)(ws + WO_bar); }
  __device__ __forceinline__ bf16_t* projb() const { return (bf16_t*)(ws + WO_proj); }
  __device__ __forceinline__ float* ssq1() const { return (float*)(ws + WO_ssq1); }
  __device__ __forceinline__ float* ssq2() const { return (float*)(ws + WO_ssq2); }
  __device__ __forceinline__ bf16_t* xb2() const { return (bf16_t*)(ws + WO_proj + (size_t)T * D * 2 + (size_t)T * 128 * 8 * 4); }
  __device__ __forceinline__ bf16_t* qb() const { return (bf16_t*)(ws + WO_proj); }
};

namespace pg8 {
#define PG8_LAS __attribute__((address_space(3)))
typedef unsigned short bf16_t;
typedef short bf16x8 __attribute__((ext_vector_type(8)));
typedef float f32x4 __attribute__((ext_vector_type(4)));
typedef unsigned u32x4 __attribute__((ext_vector_type(4)));
constexpr int BM = 256, BK = 64, HALF = 128, HTB = HALF * BK * 2  , STAGE_BYTES = 8 * HTB, NXCD = 8, WGM = 8;

__host__ __device__ __forceinline__ int lds_byte(int r, int c) { const int st = (r >> 4) * 2 + (c >> 5), rr = r & 15, cc = c & 31, ob = rr * 64 + cc * 2; return st * 1024 + (ob ^ (((ob >> 9) & 1) << 5)); }
__host__ __device__ __forceinline__ void stage_rc(int b, int& R, int& C) { const int st = b / 1024, sb = b % 1024, swz = sb ^ (((sb >> 9) & 1) << 5); R = (st >> 1) * 16 + swz / 64; C = (st & 1) * 32 + (swz % 64) / 2; }
__host__ __device__ __forceinline__ int perm32(int rho) { const int n = rho >> 4, i = rho & 15; return 8 * (i >> 2) + 4 * n + (i & 3); }

struct Unit { int pm, pn; };
struct Gemm { const bf16_t* A; const bf16_t* Bt; int M, N, K, lda, ldb; };

struct StaticOrder {
    int nM, nN, nwg, G, c;
    __host__ __device__ void init(int M, int N, int G_, int c_) { nM = M / BM; nN = N / BM; nwg = nM * nN; G = G_; c = c_; }
    __host__ __device__ bool next(int i, Unit& u) const {
        const long L = (long)i * G + c; if (L >= nwg) return false;
        int wgid = (int)L; { const int q = nwg / NXCD, r = nwg % NXCD, xcd = wgid % NXCD, off = wgid / NXCD; wgid = (xcd < r ? xcd * (q + 1) : r * (q + 1) + (xcd - r) * q) + off; }
        const int nig = WGM * nN, gid = wgid / nig, fm = gid * WGM, gsz = (nM - fm) < WGM ? (nM - fm) : WGM;
        u.pm = fm + ((wgid % nig) % gsz); u.pn = (wgid % nig) / gsz; return true;
    }
    __device__ __forceinline__ void a_ready(const Unit&) const {}
    __device__ __forceinline__ void done(const Unit&) const {}
};
struct GroupOrder {
    int mt, nt_, nwg, G, c;
    __host__ __device__ void init(int ngroups, int mt__, int nt__, int G_, int c_) { mt = mt__; nt_ = nt__; nwg = ngroups * mt * nt_; G = G_; c = c_; }
    __host__ __device__ bool next(int i, Unit& u) const {
        const long L = (long)i * G + c; if (L >= nwg) return false;
        const int per = mt * nt_, gi = (int)L / per, r = (int)L % per;
        u.pm = gi * mt + r % mt; u.pn = gi * nt_ + r / mt; return true;
    }
    __device__ __forceinline__ void a_ready(const Unit&) const {}
    __device__ __forceinline__ void done(const Unit&) const {}
};
template <class Epi, class Sched, bool ALIGN_EPI = false, bool SP2 = false>
__device__ __forceinline__ void gemm_phase(PG8_LAS unsigned char* lds, const Gemm g, const Sched& S, const Epi& E) {
    int tid_ = threadIdx.x; asm volatile("" : "+v"(tid_));
    const int tid = tid_, wid = __builtin_amdgcn_readfirstlane(tid >> 6), lane = tid & 63, wr = wid >> 2, wc = wid & 3, fr = lane & 15, fq = lane >> 4;
    const int K = g.K, nt = K / BK;
    unsigned voffA[2], voffB[2];
#pragma unroll
    for (int i = 0; i < 2; ++i) { int R, C; stage_rc(tid * 16 + i * 8192, R, C); const int Rb = Epi::PERM ? ((R & ~31) + perm32(R & 31)) : R;
        voffA[i] = (unsigned)(R * g.lda + C) * 2u; voffB[i] = (unsigned)(Rb * g.ldb + C) * 2u; }
    const size_t kstep = (size_t)(BK * 2);
    const size_t hstepA = (size_t)HALF * g.lda * 2, hstepB = (size_t)HALF * g.ldb * 2;
    const size_t tstepA = 2 * hstepA, tstepB = 2 * hstepB;
    const unsigned ldsw = (unsigned)wid * 1024u;
    const int aoff = lds_byte(wr * 64 + fr, fq * 8), boff = lds_byte(wc * 32 + fr, fq * 8);
#define PG8_SA(b, h) (((b) * 2 + (h)) * HTB)
#define PG8_SB(b, h) ((4 + (b) * 2 + (h)) * HTB)
#define PG8_STAGE(bufoff, gbase, voff) do { _Pragma("unroll") for (int _i = 0; _i < 2; ++_i) \
        __builtin_amdgcn_global_load_lds((const unsigned*)((const char*)(gbase) + (voff)[_i]), (PG8_LAS unsigned*)(lds + (bufoff) + ldsw + _i * 8192), 16, 0, 0); } while (0)
#define PG8_LDA(dst, b, h) do { _Pragma("unroll") for (int m = 0; m < 4; ++m) _Pragma("unroll") for (int k = 0; k < 2; ++k) dst[m][k] = *(const PG8_LAS bf16x8*)(lds + PG8_SA(b, h) + aoff + m * 2048 + k * 1024); } while (0)
#define PG8_LDB(dst, b, h) do { _Pragma("unroll") for (int n = 0; n < 2; ++n) _Pragma("unroll") for (int k = 0; k < 2; ++k) dst[n][k] = *(const PG8_LAS bf16x8*)(lds + PG8_SB(b, h) + boff + n * 2048 + k * 1024); } while (0)
#define PG8_MMA(ai, bj, At, Bt) do { __builtin_amdgcn_s_setprio(1); _Pragma("unroll") for (int m = 0; m < 4; ++m) _Pragma("unroll") for (int n = 0; n < 2; ++n) _Pragma("unroll") for (int k = 0; k < 2; ++k) \
        acc[ai][bj][m][n] = __builtin_amdgcn_mfma_f32_16x16x32_bf16(Bt[n][k], At[m][k], acc[ai][bj][m][n], 0, 0, 0); __builtin_amdgcn_s_setprio(0); } while (0)
#define PG8_WAIT_V(n) asm volatile("s_waitcnt vmcnt(" #n ")" ::: "memory")
#define PG8_WAIT_L(n) asm volatile("s_waitcnt lgkmcnt(" #n ")" ::: "memory")
#define PG8_BAR __builtin_amdgcn_s_barrier()
#define PG8_SCHED __builtin_amdgcn_sched_barrier(0)
    Unit cur, nxt; int ui = 0;
    if (!S.next(0, cur)) return;
    f32x4 acc[2][2][4][2];
    E.init(acc, cur, wr, wc, fr, fq);
    bf16x8 At[4][2], B0[2][2], B1[2][2];
    const char* cA = (const char*)g.A + (size_t)cur.pm * tstepA; const char* cB = (const char*)g.Bt + (size_t)cur.pn * tstepB;
    S.a_ready(cur);
    if constexpr (SP2) {
        PG8_STAGE(PG8_SB(0, 0), cB, voffB); PG8_STAGE(PG8_SB(0, 1), cB + hstepB, voffB); PG8_STAGE(PG8_SA(0, 0), cA, voffA); PG8_STAGE(PG8_SA(0, 1), cA + hstepA, voffA);
        if (wr == 1) PG8_BAR;
        PG8_WAIT_V(2); PG8_BAR;
        PG8_STAGE(PG8_SB(1, 0), cB + kstep, voffB); PG8_STAGE(PG8_SA(1, 0), cA + kstep, voffA); PG8_STAGE(PG8_SB(1, 1), cB + hstepB + kstep, voffB);
        PG8_WAIT_V(6); PG8_BAR;
    } else {
        PG8_STAGE(PG8_SB(0, 0), cB, voffB); PG8_STAGE(PG8_SA(0, 0), cA, voffA); PG8_STAGE(PG8_SB(0, 1), cB + hstepB, voffB); PG8_STAGE(PG8_SA(0, 1), cA + hstepA, voffA);
        if (wr == 1) PG8_BAR;
        PG8_WAIT_V(4); PG8_BAR;
        PG8_STAGE(PG8_SB(1, 0), cB + kstep, voffB); PG8_STAGE(PG8_SA(1, 0), cA + kstep, voffA); PG8_STAGE(PG8_SB(1, 1), cB + hstepB + kstep, voffB);
        PG8_WAIT_V(6); PG8_BAR;
    }
    for (;;) {
        const bool has_next = S.next(ui + 1, nxt);
        const char* nA = has_next ? (const char*)g.A + (size_t)nxt.pm * tstepA : cA; const char* nB = has_next ? (const char*)g.Bt + (size_t)nxt.pn * tstepB : cB;
        for (int t = 0; t < nt; t += 2) {
            const bool last = (t == nt - 2);
            const char* a1 = cA + (size_t)(t + 1) * kstep;
            const char* a2 = last ? nA : cA + (size_t)(t + 2) * kstep; const char* b2 = last ? nB : cB + (size_t)(t + 2) * kstep;
            const char* a3 = a2 + kstep; const char* b3 = b2 + kstep;
            if (last && has_next) S.a_ready(nxt);
            if constexpr (SP2) {
            PG8_LDB(B0, 0, 0); PG8_LDB(B1, 0, 1); PG8_SCHED; PG8_LDA(At, 0, 0); PG8_STAGE(PG8_SA(1, 1), a1 + hstepA, voffA);
            PG8_WAIT_V(8); PG8_WAIT_L(0); PG8_BAR; PG8_MMA(0, 0, At, B0); PG8_MMA(0, 1, At, B1); PG8_BAR; PG8_SCHED;
            PG8_LDA(At, 0, 1); PG8_STAGE(PG8_SB(0, 0), b2, voffB); PG8_STAGE(PG8_SB(0, 1), b2 + hstepB, voffB); PG8_STAGE(PG8_SA(0, 0), a2, voffA);
            PG8_WAIT_V(8); PG8_WAIT_L(0); PG8_BAR; PG8_MMA(1, 0, At, B0); PG8_MMA(1, 1, At, B1); PG8_BAR; PG8_SCHED;
            PG8_LDB(B0, 1, 0); PG8_LDB(B1, 1, 1); PG8_SCHED; PG8_LDA(At, 1, 0); PG8_STAGE(PG8_SA(0, 1), a2 + hstepA, voffA);
            PG8_WAIT_V(8); PG8_WAIT_L(0); PG8_BAR; PG8_MMA(0, 0, At, B0); PG8_MMA(0, 1, At, B1); PG8_BAR; PG8_SCHED;
            PG8_LDA(At, 1, 1); PG8_STAGE(PG8_SB(1, 0), b3, voffB); PG8_STAGE(PG8_SB(1, 1), b3 + hstepB, voffB); PG8_STAGE(PG8_SA(1, 0), a3, voffA);
            PG8_WAIT_V(8); PG8_WAIT_L(0); PG8_BAR; PG8_MMA(1, 0, At, B0); PG8_MMA(1, 1, At, B1); PG8_BAR; PG8_SCHED;
            } else {
            PG8_LDB(B0, 0, 0); PG8_SCHED; PG8_LDA(At, 0, 0); PG8_STAGE(PG8_SA(1, 1), a1 + hstepA, voffA);
            PG8_WAIT_L(8); PG8_BAR; PG8_WAIT_L(0); PG8_MMA(0, 0, At, B0); PG8_BAR; PG8_SCHED;
            PG8_LDB(B1, 0, 1); PG8_STAGE(PG8_SB(0, 0), b2, voffB);
            PG8_BAR; PG8_WAIT_L(0); PG8_MMA(0, 1, At, B1); PG8_BAR;
            PG8_LDA(At, 0, 1); PG8_STAGE(PG8_SA(0, 0), a2, voffA);
            PG8_BAR; PG8_WAIT_L(0); PG8_MMA(1, 0, At, B0); PG8_BAR; PG8_SCHED;
            PG8_STAGE(PG8_SB(0, 1), b2 + hstepB, voffB);
            PG8_WAIT_V(6); PG8_BAR; PG8_MMA(1, 1, At, B1); PG8_BAR;
            PG8_LDB(B0, 1, 0); PG8_SCHED; PG8_LDA(At, 1, 0); PG8_STAGE(PG8_SA(0, 1), a2 + hstepA, voffA);
            PG8_WAIT_L(8); PG8_BAR; PG8_WAIT_L(0); PG8_MMA(0, 0, At, B0); PG8_BAR; PG8_SCHED;
            PG8_LDB(B1, 1, 1); PG8_STAGE(PG8_SB(1, 0), b3, voffB);
            PG8_BAR; PG8_WAIT_L(0); PG8_MMA(0, 1, At, B1); PG8_BAR;
            PG8_LDA(At, 1, 1); PG8_STAGE(PG8_SA(1, 0), a3, voffA);
            PG8_BAR; PG8_WAIT_L(0); PG8_MMA(1, 0, At, B0); PG8_BAR; PG8_SCHED;
            PG8_STAGE(PG8_SB(1, 1), b3 + hstepB, voffB);
            PG8_WAIT_V(6); PG8_BAR; PG8_MMA(1, 1, At, B1); PG8_BAR;
            }
        }
        if constexpr (ALIGN_EPI) { if (wr == 0) PG8_BAR; }
        if constexpr (!Epi::AFTER_DRAIN) { E(acc, cur, wr, wc, fr, fq); S.done(cur); }
        if (!has_next) break;
        E.init(acc, nxt, wr, wc, fr, fq);
        cur = nxt; cA = nA; cB = nB; ++ui;
        if constexpr (ALIGN_EPI) { if (wr == 1) PG8_BAR; }
    }
    PG8_WAIT_V(0);
    if constexpr (!ALIGN_EPI) { if (wr == 0) PG8_BAR; }
    PG8_BAR;
    if constexpr (Epi::AFTER_DRAIN) { E.fused(acc, cur, wr, wc, fr, fq, lds, wid, lane); S.done(cur); }
#undef PG8_SA
#undef PG8_SB
#undef PG8_STAGE
#undef PG8_LDA
#undef PG8_LDB
#undef PG8_MMA
#undef PG8_WAIT_V
#undef PG8_WAIT_L
#undef PG8_BAR
#undef PG8_SCHED
}
}
#define EPI_ZERO_INIT \
  __device__ __forceinline__ void init(pg8::f32x4 (&acc)[2][2][4][2], const pg8::Unit&, int, int, int, int) const { \
    _Pragma("unroll") for (int a = 0; a < 2; ++a) _Pragma("unroll") for (int b = 0; b < 2; ++b) \
    _Pragma("unroll") for (int m = 0; m < 4; ++m) _Pragma("unroll") for (int n = 0; n < 2; ++n) acc[a][b][m][n] = (pg8::f32x4){0.f, 0.f, 0.f, 0.f}; }
struct EpiScaleStore {
  static constexpr bool PERM = false, AFTER_DRAIN = false;
  float* C; int ldc; const float* rs;
  __device__ __forceinline__ void init(pg8::f32x4 (&acc)[2][2][4][2], const pg8::Unit&, int, int, int, int) const {
#pragma unroll
    for (int a = 0; a < 2; ++a)
#pragma unroll
      for (int b = 0; b < 2; ++b)
#pragma unroll
        for (int m = 0; m < 4; ++m)
#pragma unroll
          for (int n = 0; n < 2; ++n) acc[a][b][m][n] = (pg8::f32x4){0.f, 0.f, 0.f, 0.f};
  }
  __device__ __forceinline__ void operator()(const pg8::f32x4 (&acc)[2][2][4][2], const pg8::Unit& u, int wr, int wc, int fr_in, int fq_in) const {
    int fr = fr_in, fq = fq_in; asm volatile("" : "+v"(fr), "+v"(fq));
#pragma unroll
    for (int ai = 0; ai < 2; ++ai)
#pragma unroll
      for (int m = 0; m < 4; ++m) {
        const int row = u.pm * 256 + ai * 128 + wr * 64 + m * 16 + fr;
        const float r = rs[row];
#pragma unroll
        for (int bj = 0; bj < 2; ++bj)
#pragma unroll
          for (int n = 0; n < 2; ++n) {
            const int col = u.pn * 256 + bj * 128 + wc * 32 + n * 16 + 4 * fq;
            pg8::f32x4 v = acc[ai][bj][m][n] * r;
            *(pg8::f32x4*)(C + (size_t)row * ldc + col) = v;
          }
        asm volatile("" ::: "memory");
      }
  }
};
struct EpiResid {
  static constexpr bool PERM = false, AFTER_DRAIN = false;
  float* C; int ldc; bf16_t* xb; bf16_t* hb; const float* g2; float* parts;
  __device__ __forceinline__ void init(pg8::f32x4 (&acc)[2][2][4][2], const pg8::Unit& u, int wr, int wc, int fr, int fq) const {
#pragma unroll
    for (int ai = 0; ai < 2; ++ai)
#pragma unroll
      for (int m = 0; m < 4; ++m) {
        const int row = u.pm * 256 + ai * 128 + wr * 64 + m * 16 + fr;
#pragma unroll
        for (int bj = 0; bj < 2; ++bj)
#pragma unroll
          for (int n = 0; n < 2; ++n) {
            const int col = u.pn * 256 + bj * 128 + wc * 32 + n * 16 + 4 * fq;
            acc[ai][bj][m][n] = *(const pg8::f32x4*)(C + (size_t)row * ldc + col);
          }
      }
  }
  __device__ __forceinline__ void operator()(const pg8::f32x4 (&acc)[2][2][4][2], const pg8::Unit& u, int wr, int wc, int fr_in, int fq_in) const {
    int fr = fr_in, fq = fq_in; asm volatile("" : "+v"(fr), "+v"(fq));
    pg8::f32x4 gv[2][2];
#pragma unroll
    for (int bj = 0; bj < 2; ++bj)
#pragma unroll
      for (int n = 0; n < 2; ++n) gv[bj][n] = *(const pg8::f32x4*)(g2 + u.pn * 256 + bj * 128 + wc * 32 + n * 16 + 4 * fq);
#pragma unroll
    for (int ai = 0; ai < 2; ++ai)
#pragma unroll
      for (int m = 0; m < 4; ++m) {
        const int row = u.pm * 256 + ai * 128 + wr * 64 + m * 16 + fr;
        float ss = 0.f;
#pragma unroll
        for (int bj = 0; bj < 2; ++bj)
#pragma unroll
          for (int n = 0; n < 2; ++n) {
            const int col = u.pn * 256 + bj * 128 + wc * 32 + n * 16 + 4 * fq;
            const pg8::f32x4 v = acc[ai][bj][m][n];
            *(pg8::f32x4*)(C + (size_t)row * ldc + col) = v;
            *(uint2*)(xb + (size_t)row * KD + col) = make_uint2(pk_bf16(v[0], v[1]), pk_bf16(v[2], v[3]));
            const pg8::f32x4 h = v * gv[bj][n];
            *(uint2*)(hb + ((size_t)(col >> 7) * T + row) * 128 + (col & 127)) = make_uint2(pk_bf16(h[0], h[1]), pk_bf16(h[2], h[3]));
            ss += (v[0] * v[0] + v[1] * v[1]) + (v[2] * v[2] + v[3] * v[3]);
          }
        ss += __shfl_xor(ss, 16); ss += __shfl_xor(ss, 32);
        if (fq == 0) parts[(size_t)row * 16 + u.pn * 4 + wc] = ss;
        asm volatile("" ::: "memory");
      }
  }
};
struct EpiScaleStoreBf16 {
  static constexpr bool PERM = false, AFTER_DRAIN = false;
  bf16_t* C; int ldc; const float* parts; int nparts; float* rs_out;
  EPI_ZERO_INIT
  __device__ __forceinline__ void operator()(const pg8::f32x4 (&acc)[2][2][4][2], const pg8::Unit& u, int wr, int wc, int fr_in, int fq_in) const {
    int fr = fr_in, fq = fq_in; asm volatile("" : "+v"(fr), "+v"(fq));
#pragma unroll
    for (int ai = 0; ai < 2; ++ai)
#pragma unroll
      for (int m = 0; m < 4; ++m) {
        const int row = u.pm * 256 + ai * 128 + wr * 64 + m * 16 + fr;
        float ssum = 0.f;
        for (int i = 0; i < nparts; i += 4) { const pg8::f32x4 q4 = *(const pg8::f32x4*)(parts + (size_t)row * nparts + i); ssum += (q4[0] + q4[1]) + (q4[2] + q4[3]); }
        const float r = rsqrtf(ssum * (1.0f / (float)D) + EPS);
        if (rs_out && u.pn == 0 && wc == 0 && fq == 0) rs_out[row] = r;
#pragma unroll
        for (int bj = 0; bj < 2; ++bj)
#pragma unroll
          for (int n = 0; n < 2; ++n) {
            const int col = u.pn * 256 + bj * 128 + wc * 32 + n * 16 + 4 * fq;
            pg8::f32x4 v = acc[ai][bj][m][n] * r;
            uint2 o; o.x = pk_bf16(v[0], v[1]); o.y = pk_bf16(v[2], v[3]);
            *(uint2*)(C + (size_t)row * ldc + col) = o;
          }
        asm volatile("" ::: "memory");
      }
  }
};
template <class Epi>
__device__ __forceinline__ void run_gemm(unsigned char* lds_raw, const bf16_t* A, const bf16_t* Bt, int M, int N, int K, const Epi& e) {
  pg8::Gemm g{A, Bt, M, N, K, K, K}; pg8::StaticOrder So; So.init(M, N, (int)gridDim.x, (int)blockIdx.x);
  pg8::gemm_phase<Epi, pg8::StaticOrder, true, true>((PG8_LAS unsigned char*)lds_raw, g, So, e);
}

__device__ __forceinline__ void transpose_items(const float* __restrict__ W, int K, int N, const float* __restrict__ g, bf16_t* __restrict__ Wt, int gw, int ngw, int lane) {
  const int nkt = K / 64, nnt = N / 64;
  for (int it = gw; it < nkt * nnt; it += ngw) {
    int kt = it % nkt, ntile = it / nkt;
    int k0 = kt * 64, n = ntile * 64 + lane;
    float v[64];
#pragma unroll
    for (int i = 0; i < 64; ++i) v[i] = W[(size_t)(k0 + i) * N + n] * g[k0 + i];
    bf16_t* dst = Wt + (size_t)n * (K * KS) + k0;
#pragma unroll
    for (int c = 0; c < 8; ++c) {
      bf16_t hi[8], lo[8];
#pragma unroll
      for (int e = 0; e < 8; ++e) { hi[e] = f2bf(v[c * 8 + e]); lo[e] = f2bf(v[c * 8 + e] - bf2f(hi[e])); }
      uint4 ph, pl;
      ph.x = hi[0] | ((unsigned)hi[1] << 16); ph.y = hi[2] | ((unsigned)hi[3] << 16); ph.z = hi[4] | ((unsigned)hi[5] << 16); ph.w = hi[6] | ((unsigned)hi[7] << 16);
      pl.x = lo[0] | ((unsigned)lo[1] << 16); pl.y = lo[2] | ((unsigned)lo[3] << 16); pl.z = lo[4] | ((unsigned)lo[5] << 16); pl.w = lo[6] | ((unsigned)lo[7] << 16);
      *(uint4*)(dst + c * 8) = ph;
      if (PRECISE) { *(uint4*)(dst + K + c * 8) = pl; *(uint4*)(dst + 2 * K + c * 8) = ph; }
    }
  }
}

__device__ __forceinline__ void phase_cvt_rows(const float* __restrict__ src, bf16_t* __restrict__ dst, float* __restrict__ rstd, int gw, int ngw, int lane) {
  for (int t0 = gw; t0 < T; t0 += 2 * ngw) {
    float4 v[2][4];
#pragma unroll
    for (int u = 0; u < 2; ++u) { const int t = (t0 + u * ngw < T) ? t0 + u * ngw : t0;
#pragma unroll
      for (int i = 0; i < 4; ++i) v[u][i] = ((const float4*)(src + (size_t)t * D))[lane + i * 64]; }
#pragma unroll
    for (int u = 0; u < 2; ++u) {
      const int t = t0 + u * ngw;
      if (t < T) {
        float ss = 0.f;
#pragma unroll
        for (int i = 0; i < 4; ++i) {
          const float4 w = v[u][i];
          ss += w.x * w.x + w.y * w.y + w.z * w.z + w.w * w.w;
          uint2 ph; ph.x = pk_bf16(w.x, w.y); ph.y = pk_bf16(w.z, w.w);
          *(uint2*)(dst + (size_t)t * KD + (lane + i * 64) * 4) = ph;
        }
        if (rstd) { ss = wave_sum(ss); if (lane == 0) rstd[t] = rsqrtf(ss / (float)D + EPS); }
      }
    }
  }
}

__device__ __forceinline__ void phase_prologue(const Params& p, int gtid, int ngt, int gw, int ngw, int lane) {
  for (int idx = gtid; idx < S * 40; idx += ngt) {
    int s = idx / 40, i = idx % 40;
    if (i < 8) {
      float inv = powf(500000.0f, -(float)(2 * i) / 16.0f);
      float ang = (float)s * inv;
      p.cosm()[s * 8 + i] = (float)cos((double)ang); p.sinm()[s * 8 + i] = (float)sin((double)ang);
    } else {
      int j = i - 8;
      float inv = powf(10000.0f, -((float)j / 31.0f));
      float ang = (float)s * inv;
      p.cosr()[s * 32 + j] = (float)cos((double)ang); p.sinr()[s * 32 + j] = (float)sin((double)ang);
    }
  }
  { const float4* a = (const float4*)p.inp(0); float4* b = (float4*)p.outp();
    for (size_t i = gtid; i < (size_t)T * D / 4; i += ngt) b[i] = a[i]; }
  for (int t = gw; t < T; t += ngw) {
    const float4* xr = (const float4*)(p.inp(0) + (size_t)t * D); float ss = 0.f;
#pragma unroll
    for (int i = 0; i < 4; ++i) { const float4 v = xr[lane + i * 64]; ss += v.x * v.x + v.y * v.y + v.z * v.z + v.w * v.w;
      *(uint2*)(p.xb() + (size_t)t * KD + (lane + i * 64) * 4) = make_uint2(pk_bf16(v.x, v.y), pk_bf16(v.z, v.w)); }
    ss = wave_sum(ss);
    if (lane < 8) p.ssq1()[(size_t)t * 8 + lane] = lane == 0 ? ss : 0.f;
  }
  for (int idx = gtid; idx < NL * 65536; idx += ngt) { const int l2 = idx >> 16, n2 = (idx >> 8) & 255, k2 = idx & 255; p.Wglu_t()[idx] = f2bf(p.inp(11)[(size_t)l2 * 65536 + k2 * 256 + n2]); }
  for (int l = 0; l < NL; ++l) {
    transpose_items(p.inp(2) + (size_t)l * D * INW, D, INW, p.inp(1) + l * D, p.Win_t() + (size_t)l * INW * KD, gw, ngw, lane);
    transpose_items(p.inp(15) + (size_t)l * D * D, D, D, p.inp(14) + l * D, p.Wout_t() + (size_t)l * D * KD, gw, ngw, lane);
    transpose_items(p.inp(17) + (size_t)l * D * D, D, D, p.inp(16) + l * D, p.Wq_t() + (size_t)l * D * KD, gw, ngw, lane);
  }
}

__device__ __forceinline__ void phase_postproj(const Params& p, int l, int gw, int ngw, int lane) {
  const float* gq = p.inp(12) + l * 64; const float* gk = p.inp(13) + l * 64;
  for (int w = gw; w < T * 24; w += ngw) {
    int t = w / 24, slot = w % 24, s = t % S;
    float* row = p.proj() + (size_t)t * INW;
    if (slot < 16) {
      int h = slot & 7;
      float* q = row + (slot < 8 ? OFF_QM : OFF_KM) + h * 64;
      const float* g = slot < 8 ? gq : gk;
      float v = q[lane];
      float ss = wave_sum(v * v);
      float u = v * rsqrtf(ss / 64.0f + EPS) * g[lane];
      int partner = lane < 8 ? lane + 8 : lane - 8;
      float pu = __shfl(u, partner & 63);
      float o = u;
      if (lane < 16) {
        int i = lane & 7;
        float c = p.cosm()[s * 8 + i], sn = p.sinm()[s * 8 + i];
        o = lane < 8 ? (u * c - pu * sn) : (u * c + pu * sn);
      }
      q[lane] = o;
    } else {
      int h = (slot - 16) & 3; bool isk = slot >= 20;
      float* q = row + (isk ? OFF_KR : OFF_QR) + h * 64;
      float v = q[lane];
      float pv = __shfl(v, lane ^ 32);
      int i = lane & 31;
      float c = p.cosr()[s * 32 + i], sn = p.sinr()[s * 32 + i];
      float o = lane < 32 ? (v * c - pv * sn) : (v * c + pv * sn);
      if (isk) o *= 0.125f;
      q[lane] = o;
    }
  }
}

__device__ __forceinline__ void phase_kmean(const Params& p, int gtid, int ngt) {
  for (int idx = gtid; idx < NB * 8 * 16 * 64; idx += ngt) {
    int d = idx & 63, j = (idx >> 6) & 15, h = (idx >> 10) & 7, b = idx >> 13;
    const float* q = p.proj() + ((size_t)(b * S + j * 256)) * INW + OFF_KM + h * 64 + d;
    float acc = 0.f;
    for (int i = 0; i < 256; ++i) acc += q[(size_t)i * INW];
    p.kmean()[idx] = acc / 256.0f;
  }
}

__device__ __forceinline__ void s5_unit(const Params& p, int l, int unit, float* red, int lane) {
  const int b = unit >> 4, g = unit & 15, pp = lane;
  const float* lam_re = p.inp(3) + l * 1024; const float* lam_im = p.inp(4) + l * 1024; const float* log_dt = p.inp(5) + l * 16;
  const float* b_re = p.inp(6) + l * 16384; const float* b_im = p.inp(7) + l * 16384;
  const float* c_re = p.inp(8) + l * 16384; const float* c_im = p.inp(9) + l * 16384; const float* dskip = p.inp(10) + l * 256;
  float lr = lam_re[g * 64 + pp], li = lam_im[g * 64 + pp];
  float dt = expf(log_dt[g]);
  float mag = expf(lr * dt);
  float ar = mag * cosf(li * dt), ai = mag * sinf(li * dt);
  float den = lr * lr + li * li;
  float fr = ((ar - 1.0f) * lr + ai * li) / den;
  float fi = (ai * lr - (ar - 1.0f) * li) / den;
  float bbr[16], bbi[16], cr[16], ci[16];
#pragma unroll
  for (int h = 0; h < 16; ++h) {
    float br = b_re[(g * 64 + pp) * 16 + h], bi = b_im[(g * 64 + pp) * 16 + h];
    bbr[h] = fr * br - fi * bi; bbi[h] = fr * bi + fi * br;
    cr[h] = c_re[(g * 16 + h) * 64 + pp]; ci[h] = c_im[(g * 16 + h) * 64 + pp];
  }
  const int hq = pp >> 2, qq = pp & 3;
  float dsk = dskip[g * 16 + hq];
  float sr = 0.f, si = 0.f;
  for (int t = 0; t < S; ++t) {
    const float* up = p.proj() + (size_t)(b * S + t) * INW + OFF_U + g * 16;
    float u[16];
#pragma unroll
    for (int h4 = 0; h4 < 4; ++h4) { float4 v = *(const float4*)(up + h4 * 4); u[h4 * 4] = v.x; u[h4 * 4 + 1] = v.y; u[h4 * 4 + 2] = v.z; u[h4 * 4 + 3] = v.w; }
    float bur = 0.f, bui = 0.f;
#pragma unroll
    for (int h = 0; h < 16; ++h) { bur = fmaf(u[h], bbr[h], bur); bui = fmaf(u[h], bbi[h], bui); }
    float nr = ar * sr - ai * si + bur, ni = ar * si + ai * sr + bui;
    sr = nr; si = ni;
    LDS_FENCE();
#pragma unroll
    for (int h = 0; h < 16; ++h) red[h * 65 + pp] = sr * cr[h] - si * ci[h];
    LDS_FENCE();
    float acc = 0.f;
#pragma unroll
    for (int i = 0; i < 16; ++i) acc += red[hq * 65 + qq * 16 + i];
    acc += __shfl_xor(acc, 1);
    acc += __shfl_xor(acc, 2);
    if (qq == 0) p.yg()[(size_t)(b * S + t) * 256 + g * 16 + hq] = gelu_tanh(acc + up[hq] * dsk);
  }
}

__device__ __forceinline__ void ret_units(const Params& p, int l, int unit0, float* lds) {
  constexpr int TB = 16;
  int tx_ = threadIdx.x; asm volatile("" : "+v"(tx_));
  const int vb = tx_ >> 8, tid = tx_ & 255;
  float* base_l = lds + vb * (TB * 64 * 3 + TB * 4 * 64);
  float* qs = base_l; float* ks = qs + TB * 64; float* vs = ks + TB * 64; float* red = vs + TB * 64;
  const int unit = unit0 + vb;
  const int b = unit >> 2, h = unit & 3;
  const int e = tid & 63, dg = tid >> 6;
  const float gamma = 1.0f - exp2f(-5.0f - (float)h);
  float St[16];
#pragma unroll
  for (int i = 0; i < 16; ++i) St[i] = 0.f;
  const float* base = p.proj() + (size_t)(b * S) * INW;
  for (int t0 = 0; t0 < S; t0 += TB) {
    __syncthreads();
    for (int i = tid; i < TB * 64; i += 256) {
      int tt = i >> 6, d = i & 63;
      const float* r = base + (size_t)(t0 + tt) * INW;
      qs[tt * 64 + d] = r[OFF_QR + h * 64 + d]; ks[tt * 64 + d] = r[OFF_KR + h * 64 + d]; vs[tt * 64 + d] = r[OFF_VR + h * 64 + d];
    }
    __syncthreads();
    for (int tt = 0; tt < TB; ++tt) {
      float ve = vs[tt * 64 + e], part = 0.f;
#pragma unroll
      for (int i = 0; i < 16; ++i) {
        St[i] = fmaf(gamma, St[i], ks[tt * 64 + dg * 16 + i] * ve);
        part = fmaf(qs[tt * 64 + dg * 16 + i], St[i], part);
      }
      red[(tt * 4 + dg) * 64 + e] = part;
    }
    __syncthreads();
    for (int k = 0; k < 4; ++k) {
      int tt = dg * 4 + k;
      float o = red[(tt * 4 + 0) * 64 + e] + red[(tt * 4 + 1) * 64 + e] + red[(tt * 4 + 2) * 64 + e] + red[(tt * 4 + 3) * 64 + e];
      float ss = wave_sum(o * o);
      float gv = base[(size_t)(t0 + tt) * INW + OFF_GR + h * 64 + e];
      float sl = gv * sigmoidf_(gv);
      int col = 768 + h * 64 + e;
      p.ybuf()[(size_t)(b * S + t0 + tt) * D + col] = sl * o * rsqrtf(ss / 64.0f + EPS);
    }
  }
}

__device__ __forceinline__ void phase_s5glu(const Params& p, int l, float* ys, int gw, int ngw, int lane) {
  const float* wglu = p.inp(11) + (size_t)l * 65536;
  for (int t = gw; t < T; t += ngw) {
    float yv[4];
    LDS_FENCE();
#pragma unroll
    for (int i = 0; i < 4; ++i) { yv[i] = p.yg()[(size_t)t * 256 + lane + i * 64]; ys[lane + i * 64] = yv[i]; }
    LDS_FENCE();
    float z[4] = {0.f, 0.f, 0.f, 0.f};
    for (int k = 0; k < 256; ++k) {
      float yk = ys[k];
#pragma unroll
      for (int i = 0; i < 4; ++i) z[i] = fmaf(yk, wglu[k * 256 + lane + i * 64], z[i]);
    }
    float o[4], ss = 0.f;
#pragma unroll
    for (int i = 0; i < 4; ++i) { o[i] = yv[i] * sigmoidf_(z[i]); ss += o[i] * o[i]; }
    ss = wave_sum(ss);
    float r = rsqrtf(ss / 256.0f + EPS);
#pragma unroll
    for (int i = 0; i < 4; ++i) p.ybuf()[(size_t)t * D + lane + i * 64] = o[i] * r;
  }
}


struct S5P { float lr, li, dt, fr, fi; };
__device__ __forceinline__ S5P s5p(const Params& p, int l, int g, int pp) {
  S5P r; r.lr = p.inp(3)[l * 1024 + g * 64 + pp]; r.li = p.inp(4)[l * 1024 + g * 64 + pp]; r.dt = expf(p.inp(5)[l * 16 + g]);
  const float mag = expf(r.lr * r.dt); float sn, cs; sincosf(r.li * r.dt, &sn, &cs);
  const float ar = mag * cs, ai = mag * sn, den = r.lr * r.lr + r.li * r.li;
  r.fr = ((ar - 1.0f) * r.lr + ai * r.li) / den; r.fi = (ai * r.lr - (ar - 1.0f) * r.li) / den;
  return r;
}
__device__ __forceinline__ void s5pow(const S5P& s, int k, float& re, float& im) {
  const float m = expf((float)k * s.lr * s.dt); float sn, cs; sincosf((float)k * s.li * s.dt, &sn, &cs); re = m * cs; im = m * sn;
}
__device__ __forceinline__ void phase_s5_prep(const Params& p, int l, int gtid, int ngt) {
  const float* b_re = p.inp(6) + l * 16384; const float* b_im = p.inp(7) + l * 16384;
  const float* c_re = p.inp(8) + l * 16384; const float* c_im = p.inp(9) + l * 16384;
  bf16_t* Wy = p.S5Wy(); bf16_t* Wz = p.S5Wz();
  for (int it = gtid; it < 16 * 32 * 256; it += ngt) {
    const int hp = it & 15, h = (it >> 4) & 15, d = (it >> 8) & 31, g = it >> 13;
    float acc = 0.f;
    for (int pp = 0; pp < 64; ++pp) {
      const S5P s = s5p(p, l, g, pp);
      float pr, pi; s5pow(s, d, pr, pi);
      const float br = b_re[(g * 64 + pp) * 16 + hp], bi = b_im[(g * 64 + pp) * 16 + hp];
      const float bbr = s.fr * br - s.fi * bi, bbi = s.fr * bi + s.fi * br;
      const float tr = pr * bbr - pi * bbi, ti = pr * bbi + pi * bbr;
      acc += c_re[(g * 16 + h) * 64 + pp] * tr - c_im[(g * 16 + h) * 64 + pp] * ti;
    }
    const bf16_t v = f2bf(acc);
    for (int jp = 0; jp + d < 32; ++jp) {
      const int j = jp + d;
      Wy[((size_t)g * 512 + j * 16 + h) * 640 + jp * 16 + hp] = v;
      if (d > 0) Wy[((size_t)g * 512 + jp * 16 + h) * 640 + j * 16 + hp] = 0;
    }
  }
  for (int it = gtid; it < 16 * 32 * 16 * 64; it += ngt) {
    const int pp = it & 63, h = (it >> 6) & 15, j = (it >> 10) & 31, g = it >> 15;
    const S5P s = s5p(p, l, g, pp);
    float pr, pi; s5pow(s, j + 1, pr, pi);
    const float cr = c_re[(g * 16 + h) * 64 + pp], ci = c_im[(g * 16 + h) * 64 + pp];
    const unsigned w = pk_bf16(cr * pr - ci * pi, -(cr * pi + ci * pr));
    *(unsigned*)(Wy + ((size_t)g * 512 + j * 16 + h) * 640 + 512 + 2 * pp) = w;
  }
  for (int it = gtid; it < 16 * 64 * 32; it += ngt) {
    const int j = it & 31, pp = (it >> 5) & 63, g = it >> 11;
    const S5P s = s5p(p, l, g, pp);
    float pr, pi; s5pow(s, 31 - j, pr, pi);
    for (int hp = 0; hp < 16; ++hp) {
      const float br = b_re[(g * 64 + pp) * 16 + hp], bi = b_im[(g * 64 + pp) * 16 + hp];
      const float bbr = s.fr * br - s.fi * bi, bbi = s.fr * bi + s.fi * br;
      Wz[((size_t)g * 256 + 2 * pp) * 512 + j * 16 + hp] = f2bf(pr * bbr - pi * bbi);
      Wz[((size_t)g * 256 + 2 * pp + 1) * 512 + j * 16 + hp] = f2bf(pr * bbi + pi * bbr);
    }
  }
  for (int it = gtid; it < 16 * 64; it += ngt) {
    const S5P s = s5p(p, l, it >> 6, it & 63);
    float pr, pi; s5pow(s, 32, pr, pi);
    p.S5a32()[it * 2] = pr; p.S5a32()[it * 2 + 1] = pi;
  }
}
__device__ __forceinline__ void phase_pack_u(const Params& p, int gtid, int ngt) {
  for (int idx = gtid; idx < T * 32; idx += ngt) {
    const int t = idx >> 5, i = idx & 31, g = i >> 1;
    *(uint4*)(p.S5A() + ((size_t)g * 1024 + (t >> 5)) * 640 + (t & 31) * 16 + (i & 1) * 8) = *(const uint4*)(p.projb() + (size_t)t * INW + i * 8);
  }
}
__device__ __forceinline__ void phase_s5_scan(const Params& p, int gtid, int ngt) {
  for (int it = gtid; it < NB * 16 * 64; it += ngt) {
    const int pp = it & 63, g = (it >> 6) & 15, b = it >> 10;
    const float er = p.S5a32()[(g * 64 + pp) * 2], ei = p.S5a32()[(g * 64 + pp) * 2 + 1];
    float sr = 0.f, si = 0.f;
#pragma unroll 1
    for (int c0 = 0; c0 < 128; c0 += 16) {
      float2 z[16];
#pragma unroll
      for (int k = 0; k < 16; ++k) z[k] = *(const float2*)(p.S5Z() + ((size_t)g * 1024 + b * 128 + c0 + k) * 128 + 2 * pp);
#pragma unroll
      for (int k = 0; k < 16; ++k) {
        const size_t ch = (size_t)g * 1024 + b * 128 + c0 + k;
        *(unsigned*)(p.S5A() + ch * 640 + 512 + 2 * pp) = pk_bf16(sr, si);
        const float nr = er * sr - ei * si + z[k].x, ni = er * si + ei * sr + z[k].y;
        sr = nr; si = ni;
      }
    }
  }
}
struct EpiS5Z {
  static constexpr bool PERM = false, AFTER_DRAIN = false;
  float* Z;
  EPI_ZERO_INIT
  __device__ __forceinline__ void operator()(const pg8::f32x4 (&acc)[2][2][4][2], const pg8::Unit& u, int wr, int wc, int fr_in, int fq_in) const {
    int fr = fr_in, fq = fq_in; asm volatile("" : "+v"(fr), "+v"(fq));
    const int g = u.pm >> 2;
#pragma unroll
    for (int ai = 0; ai < 2; ++ai)
#pragma unroll
      for (int m = 0; m < 4; ++m) {
        const int chunk = (u.pm & 3) * 256 + ai * 128 + wr * 64 + m * 16 + fr;
#pragma unroll
        for (int n = 0; n < 2; ++n) *(pg8::f32x4*)(Z + ((size_t)g * 1024 + chunk) * 128 + wc * 32 + n * 16 + 4 * fq) = acc[ai][0][m][n];
      }
  }
};
struct EpiS5Y {
  static constexpr bool PERM = false, AFTER_DRAIN = false;
  bf16_t* ygb; const bf16_t* A; const float* dsk;
  EPI_ZERO_INIT
  __device__ __forceinline__ void operator()(const pg8::f32x4 (&acc)[2][2][4][2], const pg8::Unit& u, int wr, int wc, int fr_in, int fq_in) const {
    int fr = fr_in, fq = fq_in; asm volatile("" : "+v"(fr), "+v"(fq));
    const int g = u.pm >> 2;
#pragma unroll
    for (int ai = 0; ai < 2; ++ai)
#pragma unroll
      for (int m = 0; m < 4; ++m) {
        const int chunk = (u.pm & 3) * 256 + ai * 128 + wr * 64 + m * 16 + fr;
#pragma unroll
        for (int bj = 0; bj < 2; ++bj)
#pragma unroll
          for (int n = 0; n < 2; ++n) {
            const int col = (u.pn & 1) * 256 + bj * 128 + wc * 32 + n * 16 + 4 * fq, j = col >> 4, h = col & 15;
            const uint2 uu = *(const uint2*)(A + ((size_t)g * 1024 + chunk) * 640 + col);
            const pg8::f32x4 dv = *(const pg8::f32x4*)(dsk + g * 16 + h);
            const pg8::f32x4 v = acc[ai][bj][m][n];
            const float y0 = fast_gelu(v[0] + dv[0] * __uint_as_float(uu.x << 16)), y1 = fast_gelu(v[1] + dv[1] * __uint_as_float(uu.x & 0xffff0000u));
            const float y2 = fast_gelu(v[2] + dv[2] * __uint_as_float(uu.y << 16)), y3 = fast_gelu(v[3] + dv[3] * __uint_as_float(uu.y & 0xffff0000u));
            uint2 o; o.x = pk_bf16(y0, y1); o.y = pk_bf16(y2, y3);
            *(uint2*)(ygb + ((size_t)chunk * 32 + j) * 256 + g * 16 + h) = o;
          }
        asm volatile("" ::: "memory");
      }
  }
};
struct EpiGlu {
  static constexpr bool PERM = false, AFTER_DRAIN = false;
  bf16_t* yb; const bf16_t* ygb; float* scr;
  EPI_ZERO_INIT
  __device__ __forceinline__ void operator()(const pg8::f32x4 (&acc_)[2][2][4][2], const pg8::Unit& u, int wr, int wc, int fr_in, int fq_in) const {
    int fr = fr_in, fq = fq_in; asm volatile("" : "+v"(fr), "+v"(fq));
    pg8::f32x4 (&acc)[2][2][4][2] = const_cast<pg8::f32x4 (&)[2][2][4][2]>(acc_);
#pragma unroll
    for (int ai = 0; ai < 2; ++ai)
#pragma unroll
      for (int m = 0; m < 4; ++m) {
        const int rl = ai * 128 + wr * 64 + m * 16 + fr, row = u.pm * 256 + rl;
        float ss = 0.f;
#pragma unroll
        for (int bj = 0; bj < 2; ++bj)
#pragma unroll
          for (int n = 0; n < 2; ++n) {
            const int col = bj * 128 + wc * 32 + n * 16 + 4 * fq;
            const uint2 yy = *(const uint2*)(ygb + (size_t)row * 256 + col);
            const pg8::f32x4 z = acc[ai][bj][m][n];
            pg8::f32x4 r;
            r[0] = __uint_as_float(yy.x << 16) * fast_sigmoid(z[0]); r[1] = __uint_as_float(yy.x & 0xffff0000u) * fast_sigmoid(z[1]);
            r[2] = __uint_as_float(yy.y << 16) * fast_sigmoid(z[2]); r[3] = __uint_as_float(yy.y & 0xffff0000u) * fast_sigmoid(z[3]);
            acc[ai][bj][m][n] = r;
            ss += r[0] * r[0] + r[1] * r[1] + r[2] * r[2] + r[3] * r[3];
          }
        ss += __shfl_xor(ss, 16); ss += __shfl_xor(ss, 32);
        if (fq == 0) scr[rl * 4 + wc] = ss;
        asm volatile("" ::: "memory");
      }
    asm volatile("s_waitcnt lgkmcnt(0)" ::: "memory"); __builtin_amdgcn_s_barrier(); asm volatile("" ::: "memory");
#pragma unroll
    for (int ai = 0; ai < 2; ++ai)
#pragma unroll
      for (int m = 0; m < 4; ++m) {
        const int rl = ai * 128 + wr * 64 + m * 16 + fr, row = u.pm * 256 + rl;
        const pg8::f32x4 s4 = *(const pg8::f32x4*)(scr + rl * 4);
        const float r = rsqrtf((s4[0] + s4[1] + s4[2] + s4[3]) / 256.0f + EPS);
#pragma unroll
        for (int bj = 0; bj < 2; ++bj)
#pragma unroll
          for (int n = 0; n < 2; ++n) { const pg8::f32x4 v = acc[ai][bj][m][n] * r; *(uint2*)(yb + (size_t)row * KD + bj * 128 + wc * 32 + n * 16 + 4 * fq) = make_uint2(pk_bf16(v[0], v[1]), pk_bf16(v[2], v[3])); }
        asm volatile("" ::: "memory");
      }
    asm volatile("s_waitcnt lgkmcnt(0)" ::: "memory"); __builtin_amdgcn_s_barrier(); asm volatile("" ::: "memory");
  }
};

constexpr float QSCALE = 0.125f * 1.4426950408889634f;

__device__ __forceinline__ void phase_pack_moba(const Params& p, int gtid, int ngt) {
  for (int idx = gtid; idx < T * 128; idx += ngt) {
    const int t = idx >> 7, c = idx & 127, isk = c >> 6, cc = c & 63, h = cc >> 3, ch = cc & 7;
    const float* src = p.proj() + (size_t)t * INW + (isk ? OFF_KM : OFF_QM) + h * 64 + ch * 8;
    float4 a = *(const float4*)src, b4 = *(const float4*)(src + 4);
    const float sc = isk ? 1.0f : QSCALE;
    uint4 o; o.x = pk_bf16(a.x * sc, a.y * sc); o.y = pk_bf16(a.z * sc, a.w * sc); o.z = pk_bf16(b4.x * sc, b4.y * sc); o.w = pk_bf16(b4.z * sc, b4.w * sc);
    const int b = t / S, s = t % S;
    bf16_t* dst = isk ? p.Km() + ((((size_t)(b * 8 + h) * (S / 32) + (s >> 5)) * 8 + ch) * 32 + (s & 31)) * 8
                      : p.Qm() + ((size_t)(b * 8 + h) * S + s) * 64 + ch * 8;
    *(uint4*)dst = o;
  }
  for (int idx = gtid; idx < NB * 8 * (S / 32) * 256; idx += ngt) {
    const int ln = idx & 63, ks = (idx >> 6) & 1, mb = (idx >> 7) & 1, tile = (idx >> 8) % (S / 32), bh = idx / (256 * (S / 32));
    const int b = bh >> 3, h = bh & 7, hh = ln >> 5, delta = mb * 32 + (ln & 31);
    float v[8];
#pragma unroll
    for (int j = 0; j < 8; ++j) {
      const int kappa = 16 * ks + 8 * (j >> 2) + 4 * hh + (j & 3), s = tile * 32 + kappa;
      v[j] = p.proj()[(size_t)(b * S + s) * INW + OFF_VM + h * 64 + delta];
    }
    uint4 o; o.x = pk_bf16(v[0], v[1]); o.y = pk_bf16(v[2], v[3]); o.z = pk_bf16(v[4], v[5]); o.w = pk_bf16(v[6], v[7]);
    *(uint4*)(p.Vm() + (size_t)idx * 8) = o;
  }
}

__device__ __forceinline__ void phase_moba2(const Params& p, int l, unsigned char* lds, int bid, int G) {
  constexpr int OLD = 260;
  bf16_t* Qs = (bf16_t*)lds;
  float* Oaccf = (float*)(lds + 32768);
  float* laccf = (float*)(lds + 32768 + 64 * OLD * 4);
  float* kms = laccf + 256;
  float* gat = kms + 1024;
  unsigned char* lists = (unsigned char*)(gat + 4096);
  int* cnt = (int*)(lists + 4096);
  int* items = cnt + 16;
  int* ctr = items + 160;
  unsigned* selp = (unsigned*)(ctr + 4);
  float* bq = (float*)(selp + 256);
  int* Oacc = (int*)Oaccf; int* lacc = (int*)laccf;
  float kmax = 0.f;
  { const float* gk = p.inp(13) + l * 64;
    for (int d = 0; d < 64; ++d) kmax = fmaxf(kmax, fabsf(gk[d]));
    kmax *= 8.0f * 1.01f; }
  for (int u = bid; u < NB * 8 * 16; u += G) {
    const int qblk = 15 - (u >> 6), bh = u & 63, b = bh >> 3, h = bh & 7;
    int tid = threadIdx.x; asm volatile("" : "+v"(tid));
    const int lane = tid & 63, wv = tid >> 6, n = lane & 31, hh = lane >> 5;
    __syncthreads();
    { const uint4* src = (const uint4*)(p.Qm() + ((size_t)bh * S + qblk * 256) * 64);
      uint4* dst = (uint4*)Qs;
      for (int i = tid; i < 256 * 64 * 2 / 16; i += NTHR) dst[i] = src[i]; }
    for (int i = tid; i < qblk * 64; i += NTHR) kms[i] = p.kmean()[(size_t)bh * 1024 + i];
    for (int i = tid; i < 64 * OLD; i += NTHR) Oacc[i] = 0;
    if (tid < 256) lacc[tid] = 0;
    if (tid < 16) cnt[tid] = 0;
    __syncthreads();
    { const int q = tid & 255, par = tid >> 8;
      float qv[64];
#pragma unroll
      for (int c = 0; c < 8; ++c) {
        uint4 w = *(const uint4*)(Qs + q * 64 + c * 8);
        qv[c * 8 + 0] = __uint_as_float(w.x << 16); qv[c * 8 + 1] = __uint_as_float(w.x & 0xffff0000u);
        qv[c * 8 + 2] = __uint_as_float(w.y << 16); qv[c * 8 + 3] = __uint_as_float(w.y & 0xffff0000u);
        qv[c * 8 + 4] = __uint_as_float(w.z << 16); qv[c * 8 + 5] = __uint_as_float(w.z & 0xffff0000u);
        qv[c * 8 + 6] = __uint_as_float(w.w << 16); qv[c * 8 + 7] = __uint_as_float(w.w & 0xffff0000u);
      }
      if (par == 0) { float qq = 0.f;
#pragma unroll
        for (int d = 0; d < 64; ++d) qq = fmaf(qv[d], qv[d], qq);
        bq[q] = sqrtf(qq) * kmax; }
      for (int j = par; j < qblk; j += 2) {
        float g = 0.f;
#pragma unroll
        for (int d = 0; d < 64; ++d) g = fmaf(qv[d], kms[j * 64 + d], g);
        gat[q * 16 + j] = g;
      }
    }
    __syncthreads();
    if (tid < 256) {
      float b0 = -INFINITY, b1 = -INFINITY, b2 = -INFINITY; int i0 = 0, i1 = 0, i2 = 0;
      for (int j = 0; j < qblk; ++j) {
        float g = gat[tid * 16 + j];
        if (g > b0) { b2 = b1; i2 = i1; b1 = b0; i1 = i0; b0 = g; i0 = j; }
        else if (g > b1) { b2 = b1; i2 = i1; b1 = g; i1 = j; }
        else if (g > b2) { b2 = g; i2 = j; }
      }
      const int nsel = qblk < 3 ? qblk : 3;
      selp[tid] = (unsigned)i0 | ((unsigned)i1 << 4) | ((unsigned)i2 << 8) | ((unsigned)nsel << 12);
    }
    __syncthreads();
    for (int j = wv; j < qblk; j += 8) {
      int base = 0;
      for (int c = 0; c < 4; ++c) {
        const int q = c * 64 + lane;
        const unsigned sp = selp[q];
        const int ns = sp >> 12;
        const bool f = (ns > 0 && (int)(sp & 15) == j) || (ns > 1 && (int)((sp >> 4) & 15) == j) || (ns > 2 && (int)((sp >> 8) & 15) == j);
        const unsigned long long bal = __ballot(f);
        const int pos = base + __popcll(bal & ((1ull << lane) - 1ull));
        if (f) lists[j * 256 + pos] = (unsigned char)q;
        base += __popcll(bal);
      }
      if (lane == 0) cnt[j] = base;
    }
    __syncthreads();
    if (tid == 0) {
      int ni = 0;
#pragma unroll 1
      for (int g = 7; g >= 0; --g) items[ni++] = (16 << 8) | g;
      for (int j = 0; j < qblk; ++j) { const int ng = (cnt[j] + 31) >> 5; for (int g = 0; g < ng; ++g) items[ni++] = (j << 8) | g; }
      ctr[0] = ni; ctr[1] = 0;
    }
    __syncthreads();
    const int nitems = ctr[0];
    for (;;) {
      int it = 0;
      if (lane == 0) it = atomicAdd(&ctr[1], 1);
      it = __builtin_amdgcn_readfirstlane(it);
      if (it >= nitems) break;
      const int item = items[it];
      const int j = item >> 8, g = item & 255;
      const bool own = (j == 16);
      const int kb = own ? qblk : j;
      const int ntile = own ? (g + 1) : 8;
      int qi; bool valid;
      if (own) { qi = g * 32 + n; valid = true; }
      else { const int pos = g * 32 + n; valid = pos < cnt[j]; qi = lists[j * 256 + (valid ? pos : 0)]; }
      const bf16_t* kt0 = p.Km() + ((size_t)bh * (S / 32) + kb * 8) * 2048 + lane * 8;
      const bf16_t* vt0 = p.Vm() + ((size_t)bh * (S / 32) + kb * 8) * 2048 + lane * 8;
      f32x16 O0, O1;
#pragma unroll
      for (int r = 0; r < 16; ++r) { O0[r] = 0.f; O1[r] = 0.f; }
      float lsum = 0.f;
      const float nbq = -bq[qi];
      bf16x8 kf[3][4], vf[3][4];
#define MOBA_LOAD(KT_, BUF_) { _Pragma("unroll") for (int s = 0; s < 4; ++s) { kf[BUF_][s] = *(const bf16x8*)(kt0 + (size_t)(KT_) * 2048 + s * 512); vf[BUF_][s] = *(const bf16x8*)(vt0 + (size_t)(KT_) * 2048 + s * 512); } }
#define MOBA_STEP(KT_, BUF_)                                                                                                           \
      if ((KT_) < ntile) {                                                                                                               \
        if ((KT_) + 2 < ntile) MOBA_LOAD((KT_) + 2, ((BUF_) + 2) % 3)                                                                     \
        f32x16 X;                                                                                                                         \
        _Pragma("unroll") for (int r = 0; r < 16; ++r) X[r] = nbq;                                                                        \
        _Pragma("unroll") for (int s = 0; s < 4; ++s) X = __builtin_amdgcn_mfma_f32_32x32x16_bf16(kf[BUF_][s], *(const bf16x8*)(Qs + qi * 64 + (2 * s + hh) * 8), X, 0, 0, 0);     \
        const bool diag = own && ((KT_) == g);                                                                                            \
        unsigned pw[8];                                                                                                                   \
        _Pragma("unroll") for (int r = 0; r < 16; r += 2) {                                                                               \
          float e0 = __builtin_amdgcn_exp2f(X[r]), e1 = __builtin_amdgcn_exp2f(X[r + 1]);                                                 \
          if (diag) {                                                                                                                     \
            const int k0 = (r & 3) + 8 * (r >> 2) + 4 * hh, k1 = ((r + 1) & 3) + 8 * ((r + 1) >> 2) + 4 * hh;                             \
            e0 = (k0 <= n) ? e0 : 0.f; e1 = (k1 <= n) ? e1 : 0.f;                                                                         \
          }                                                                                                                               \
          lsum += e0 + e1;                                                                                                                \
          pw[r >> 1] = pk_bf16(e0, e1);                                                                                                   \
        }                                                                                                                                 \
        bf16x8 pf0, pf1;                                                                                                                  \
        { uint4 t0 = make_uint4(pw[0], pw[1], pw[2], pw[3]), t1 = make_uint4(pw[4], pw[5], pw[6], pw[7]);                                 \
          pf0 = *(bf16x8*)&t0; pf1 = *(bf16x8*)&t1; }                                                                                     \
        O0 = __builtin_amdgcn_mfma_f32_32x32x16_bf16(vf[BUF_][0], pf0, O0, 0, 0, 0);                                                      \
        O0 = __builtin_amdgcn_mfma_f32_32x32x16_bf16(vf[BUF_][1], pf1, O0, 0, 0, 0);                                                      \
        O1 = __builtin_amdgcn_mfma_f32_32x32x16_bf16(vf[BUF_][2], pf0, O1, 0, 0, 0);                                                      \
        O1 = __builtin_amdgcn_mfma_f32_32x32x16_bf16(vf[BUF_][3], pf1, O1, 0, 0, 0);                                                      \
      }
      MOBA_LOAD(0, 0)
      if (ntile > 1) MOBA_LOAD(1, 1)
#pragma unroll 1
      for (int kt3 = 0; kt3 < ntile; kt3 += 3) {
        MOBA_STEP(kt3, 0) MOBA_STEP(kt3 + 1, 1) MOBA_STEP(kt3 + 2, 2)
      }
#undef MOBA_STEP
#undef MOBA_LOAD
      lsum += __shfl_xor(lsum, 32);
      if (valid) {
        if (hh == 0) atomicAdd(&lacc[qi], __float2int_rn(lsum * 1048576.0f));
#pragma unroll
        for (int r = 0; r < 16; ++r) {
          const int dim = (r & 3) + 8 * (r >> 2) + 4 * hh;
          atomicAdd(&Oacc[dim * OLD + qi], __float2int_rn(O0[r] * 1048576.0f));
          atomicAdd(&Oacc[(dim + 32) * OLD + qi], __float2int_rn(O1[r] * 1048576.0f));
        }
      }
    }
    __syncthreads();
    { const int q = tid >> 1, half = tid & 1;
      const float inv = 1.0f / (float)lacc[q];
      float o[32], ss = 0.f;
#pragma unroll
      for (int d = 0; d < 32; ++d) { o[d] = (float)Oacc[(half * 32 + d) * OLD + q] * inv; ss += o[d] * o[d]; }
      ss += __shfl_xor(ss, 1);
      const float r = rsqrtf(ss / 64.0f + EPS);
      bf16_t* dst = p.xb() + (size_t)(b * S + qblk * 256 + q) * KD + 256 + h * 64 + half * 32;
#pragma unroll
      for (int d = 0; d < 32; d += 8) *(uint4*)(dst + d) = make_uint4(pk_bf16(o[d] * r, o[d + 1] * r), pk_bf16(o[d + 2] * r, o[d + 3] * r), pk_bf16(o[d + 4] * r, o[d + 5] * r), pk_bf16(o[d + 6] * r, o[d + 7] * r));
    }
  }
}


__device__ __forceinline__ float ret_log2g(int h) { return log2f(1.0f - exp2f(-5.0f - (float)h)); }
__device__ __forceinline__ void phase_pack_ret(const Params& p, int gtid, int ngt) {
  for (int idx = gtid; idx < T * 64; idx += ngt) {
    const int t = idx >> 6, c = idx & 63, isk = c >> 5, cc = c & 31, h = cc >> 3, ch = cc & 7;
    const int b = t / S, s = t % S, i = s & 127;
    const float* src = p.proj() + (size_t)t * INW + (isk ? OFF_KR : OFF_QR) + h * 64 + ch * 8;
    float4 a = *(const float4*)src, b4 = *(const float4*)(src + 4);
    const float sc = exp2f((isk ? -(float)i : (float)i) * ret_log2g(h));
    uint4 o; o.x = pk_bf16(a.x * sc, a.y * sc); o.y = pk_bf16(a.z * sc, a.w * sc); o.z = pk_bf16(b4.x * sc, b4.y * sc); o.w = pk_bf16(b4.z * sc, b4.w * sc);
    const int bh = b * 4 + h;
    bf16_t* dst = isk ? p.Kr() + ((((size_t)bh * (S / 32) + (s >> 5)) * 8 + ch) * 32 + (s & 31)) * 8
                      : p.Qr() + ((size_t)bh * S + s) * 64 + ch * 8;
    *(uint4*)dst = o;
  }
  for (int idx = gtid; idx < 2 * NB * 4 * (S / 32) * 256; idx += ngt) {
    const int ln = idx & 63, ks = (idx >> 6) & 1, blk = (idx >> 7) & 1, tile = (idx >> 8) % (S / 32), rest = idx / (256 * (S / 32)), bh = rest % (NB * 4), which = rest / (NB * 4);
    const int b = bh >> 2, h = bh & 3, hh = ln >> 5, delta = blk * 32 + (ln & 31);
    const float l2g = ret_log2g(h);
    float v[8];
#pragma unroll
    for (int j = 0; j < 8; ++j) {
      const int kappa = 16 * ks + 8 * (j >> 2) + 4 * hh + (j & 3), s = tile * 32 + kappa;
      float x = p.proj()[(size_t)(b * S + s) * INW + (which ? OFF_KR : OFF_VR) + h * 64 + delta];
      if (which) x *= exp2f(-(float)(s & 127) * l2g);
      v[j] = x;
    }
    uint4 o; o.x = pk_bf16(v[0], v[1]); o.y = pk_bf16(v[2], v[3]); o.z = pk_bf16(v[4], v[5]); o.w = pk_bf16(v[6], v[7]);
    *(uint4*)((which ? p.Krv() : p.Vr()) + ((size_t)(idx % (NB * 4 * (S / 32) * 256))) * 8) = o;
  }
}
__device__ __forceinline__ void phase_ret_kv(const Params& p, int gw, int ngw, int lane) {
  const int n = lane & 31, hh = lane >> 5;
  for (int w = gw; w < NB * 4 * 32; w += ngw) {
    const int bh = w >> 5, cn = w & 31;
    const bf16_t* vt = p.Vr() + ((size_t)bh * (S / 32) + cn * 4) * 2048 + lane * 8;
    const bf16_t* kt = p.Krv() + ((size_t)bh * (S / 32) + cn * 4) * 2048 + lane * 8;
    f32x16 acc[2][2];
#pragma unroll
    for (int a = 0; a < 2; ++a)
#pragma unroll
      for (int b2 = 0; b2 < 2; ++b2)
#pragma unroll
        for (int r = 0; r < 16; ++r) acc[a][b2][r] = 0.f;
#pragma unroll 1
    for (int tl = 0; tl < 4; ++tl)
#pragma unroll
      for (int ks = 0; ks < 2; ++ks) {
        bf16x8 vf[2], kf[2];
#pragma unroll
        for (int x = 0; x < 2; ++x) { vf[x] = *(const bf16x8*)(vt + tl * 2048 + (x * 2 + ks) * 512); kf[x] = *(const bf16x8*)(kt + tl * 2048 + (x * 2 + ks) * 512); }
#pragma unroll
        for (int mb = 0; mb < 2; ++mb)
#pragma unroll
          for (int nb = 0; nb < 2; ++nb) acc[mb][nb] = __builtin_amdgcn_mfma_f32_32x32x16_bf16(vf[mb], kf[nb], acc[mb][nb], 0, 0, 0);
      }
    float* dst = p.KVr() + ((size_t)bh * 32 + cn) * 4096;
#pragma unroll
    for (int mb = 0; mb < 2; ++mb)
#pragma unroll
      for (int nb = 0; nb < 2; ++nb)
#pragma unroll
        for (int r = 0; r < 16; ++r) dst[(mb * 32 + (r & 3) + 8 * (r >> 2) + 4 * hh) * 64 + nb * 32 + n] = acc[mb][nb][r];
  }
}
__device__ __forceinline__ void phase_ret_scan(const Params& p, int gtid, int ngt) {
  for (int it = gtid; it < NB * 4 * 4096; it += ngt) {
    const int e = it & 4095, bh = it >> 12, h = bh & 3;
    const float l2g = ret_log2g(h), g1 = exp2f(l2g), g127 = exp2f(127.0f * l2g), g128 = exp2f(128.0f * l2g);
    float R = 0.f; float kv[32];
#pragma unroll
    for (int cn = 0; cn < 32; ++cn) kv[cn] = p.KVr()[((size_t)bh * 32 + cn) * 4096 + e];
#pragma unroll
    for (int cn = 0; cn < 32; ++cn) {
      p.Rb()[((size_t)bh * 32 + cn) * 4096 + e] = f2bf(g1 * R);
      R = g128 * R + g127 * kv[cn];
    }
  }
}
__device__ __forceinline__ void phase_ret_out(const Params& p, int gw, int ngw, int lane) {
  const int n = lane & 31, hh = lane >> 5;
  for (int w = gw; w < NB * 4 * 32 * 4; w += ngw) {
    const int qg = 3 - (w & 3), cn = (w >> 2) & 31, bh = w >> 7, b = bh >> 2, h = bh & 3;
    const int s0 = cn * 128 + qg * 32;
    bf16x8 qf[4];
#pragma unroll
    for (int s = 0; s < 4; ++s) qf[s] = *(const bf16x8*)(p.Qr() + ((size_t)bh * S + s0 + n) * 64 + (2 * s + hh) * 8);
    f32x16 O0, O1;
#pragma unroll
    for (int r = 0; r < 16; ++r) { O0[r] = 0.f; O1[r] = 0.f; }
    { const bf16_t* rb = p.Rb() + ((size_t)bh * 32 + cn) * 4096 + (size_t)n * 64 + hh * 8;
#pragma unroll
      for (int s = 0; s < 4; ++s) {
        const bf16x8 r0 = *(const bf16x8*)(rb + s * 16), r1 = *(const bf16x8*)(rb + 32 * 64 + s * 16);
        O0 = __builtin_amdgcn_mfma_f32_32x32x16_bf16(r0, qf[s], O0, 0, 0, 0);
        O1 = __builtin_amdgcn_mfma_f32_32x32x16_bf16(r1, qf[s], O1, 0, 0, 0);
      } }
    const bf16_t* kt0 = p.Kr() + ((size_t)bh * (S / 32) + cn * 4) * 2048 + lane * 8;
    const bf16_t* vt0 = p.Vr() + ((size_t)bh * (S / 32) + cn * 4) * 2048 + lane * 8;
    for (int kt = 0; kt <= qg; ++kt) {
      bf16x8 kf[4], vf[4];
#pragma unroll
      for (int s = 0; s < 4; ++s) { kf[s] = *(const bf16x8*)(kt0 + (size_t)kt * 2048 + s * 512); vf[s] = *(const bf16x8*)(vt0 + (size_t)kt * 2048 + s * 512); }
      f32x16 X;
#pragma unroll
      for (int r = 0; r < 16; ++r) X[r] = 0.f;
#pragma unroll
      for (int s = 0; s < 4; ++s) X = __builtin_amdgcn_mfma_f32_32x32x16_bf16(kf[s], qf[s], X, 0, 0, 0);
      const bool diag = (kt == qg);
      unsigned pw[8];
#pragma unroll
      for (int r = 0; r < 16; r += 2) {
        float e0 = X[r], e1 = X[r + 1];
        if (diag) {
          const int k0 = (r & 3) + 8 * (r >> 2) + 4 * hh, k1 = ((r + 1) & 3) + 8 * ((r + 1) >> 2) + 4 * hh;
          e0 = (k0 <= n) ? e0 : 0.f; e1 = (k1 <= n) ? e1 : 0.f;
        }
        pw[r >> 1] = pk_bf16(e0, e1);
      }
      bf16x8 pf0, pf1;
      { uint4 t0 = make_uint4(pw[0], pw[1], pw[2], pw[3]), t1 = make_uint4(pw[4], pw[5], pw[6], pw[7]);
        pf0 = *(bf16x8*)&t0; pf1 = *(bf16x8*)&t1; }
      O0 = __builtin_amdgcn_mfma_f32_32x32x16_bf16(vf[0], pf0, O0, 0, 0, 0);
      O0 = __builtin_amdgcn_mfma_f32_32x32x16_bf16(vf[1], pf1, O0, 0, 0, 0);
      O1 = __builtin_amdgcn_mfma_f32_32x32x16_bf16(vf[2], pf0, O1, 0, 0, 0);
      O1 = __builtin_amdgcn_mfma_f32_32x32x16_bf16(vf[3], pf1, O1, 0, 0, 0);
    }
    float ss = 0.f;
#pragma unroll
    for (int r = 0; r < 16; ++r) ss += O0[r] * O0[r] + O1[r] * O1[r];
    ss += __shfl_xor(ss, 32);
    const float rn = rsqrtf(ss / 64.0f + EPS);
    const size_t t = (size_t)b * S + s0 + n;
    const bf16_t* gp = p.projb() + t * INW + OFF_GR + h * 64;
    bf16_t* yo = p.xb() + t * KD + 768 + h * 64;
#pragma unroll
    for (int q4 = 0; q4 < 4; ++q4) {
#pragma unroll
      for (int mb = 0; mb < 2; ++mb) {
        const int d0 = mb * 32 + 8 * q4 + 4 * hh;
        const uint2 gw2 = *(const uint2*)(gp + d0); const float4 g = make_float4(__uint_as_float(gw2.x << 16), __uint_as_float(gw2.x & 0xffff0000u), __uint_as_float(gw2.y << 16), __uint_as_float(gw2.y & 0xffff0000u));
        float4 o;
        const f32x16& Oa = mb ? O1 : O0;
        o.x = Oa[q4 * 4 + 0] * rn * g.x * fast_sigmoid(g.x); o.y = Oa[q4 * 4 + 1] * rn * g.y * fast_sigmoid(g.y);
        o.z = Oa[q4 * 4 + 2] * rn * g.z * fast_sigmoid(g.z); o.w = Oa[q4 * 4 + 3] * rn * g.w * fast_sigmoid(g.w);
        *(uint2*)(yo + d0) = make_uint2(pk_bf16(o.x, o.y), pk_bf16(o.z, o.w));
      }
    }
  }
}

__device__ __forceinline__ void phase_post_pack(const Params& p, int l, int gtid, int ngt, int gw, int ngw, int lane) {
  const float* gq = p.inp(12) + l * 64; const float* gk = p.inp(13) + l * 64;
  for (int t = gw; t < T; t += ngw) {
    const int s = t % S, b = t / S;
    const bf16_t* row = p.projb() + (size_t)t * INW;
    float vin[24];
#pragma unroll
    for (int sl = 0; sl < 16; ++sl) vin[sl] = bf2f(row[(sl < 8 ? OFF_QM : OFF_KM) + (sl & 7) * 64 + lane]);
#pragma unroll
    for (int sl = 0; sl < 8; ++sl) vin[16 + sl] = bf2f(row[(sl < 4 ? OFF_QR : OFF_KR) + (sl & 3) * 64 + lane]);
    const float cm = p.cosm()[s * 8 + (lane & 7)], sm = p.sinm()[s * 8 + (lane & 7)];
    const float cr = p.cosr()[s * 32 + (lane & 31)], sr = p.sinr()[s * 32 + (lane & 31)];
    const float gqv = gq[lane], gkv = gk[lane];
#pragma unroll
    for (int slot = 0; slot < 16; ++slot) {
      const int h = slot & 7, bh = b * 8 + h; const bool isk = slot >= 8;
      const float v = vin[slot];
      const float ss = wave_sum(v * v);
      const float u = v * rsqrtf(ss / 64.0f + EPS) * (isk ? gkv : gqv);
      const float pu = __shfl(u, (lane < 8 ? lane + 8 : lane - 8) & 63);
      float o = u;
      if (lane < 16) o = lane < 8 ? (u * cm - pu * sm) : (u * cm + pu * sm);
      if (!isk) p.Qm()[((size_t)bh * S + s) * 64 + lane] = f2bf(o * QSCALE);
      else p.Km()[((((size_t)bh * (S / 32) + (s >> 5)) * 8 + (lane >> 3)) * 32 + (s & 31)) * 8 + (lane & 7)] = f2bf(o);
    }
#pragma unroll
    for (int slot = 16; slot < 24; ++slot) {
      const int h = (slot - 16) & 3, bh = b * 4 + h; const bool isk = slot >= 20;
      const float v = vin[slot];
      const float pv = __shfl(v, lane ^ 32);
      const float o = lane < 32 ? (v * cr - pv * sr) : (v * cr + pv * sr);
      const float l2g = ret_log2g(h); const int pos = s & 127;
      if (!isk) p.Qr()[((size_t)bh * S + s) * 64 + lane] = f2bf(o * exp2f((float)pos * l2g));
      else p.Kr()[((((size_t)bh * (S / 32) + (s >> 5)) * 8 + (lane >> 3)) * 32 + (s & 31)) * 8 + (lane & 7)] = f2bf(o * 0.125f * exp2f(-(float)pos * l2g));
    }
  }
  for (int idx = gtid; idx < NB * 8 * (S / 32) * 256; idx += ngt) {
    const int ln = idx & 63, ks = (idx >> 6) & 1, mb = (idx >> 7) & 1, tile = (idx >> 8) % (S / 32), bh = idx / (256 * (S / 32));
    const int b = bh >> 3, h = bh & 7, hh = ln >> 5, delta = mb * 32 + (ln & 31);
    float v[8];
#pragma unroll
    for (int j = 0; j < 8; ++j) { const int kappa = 16 * ks + 8 * (j >> 2) + 4 * hh + (j & 3), s = tile * 32 + kappa; v[j] = bf2f(p.projb()[(size_t)(b * S + s) * INW + OFF_VM + h * 64 + delta]); }
    uint4 o; o.x = pk_bf16(v[0], v[1]); o.y = pk_bf16(v[2], v[3]); o.z = pk_bf16(v[4], v[5]); o.w = pk_bf16(v[6], v[7]);
    *(uint4*)(p.Vm() + (size_t)idx * 8) = o;
  }
  for (int idx = gtid; idx < 2 * NB * 4 * (S / 32) * 256; idx += ngt) {
    const int ln = idx & 63, ks = (idx >> 6) & 1, blk = (idx >> 7) & 1, tile = (idx >> 8) % (S / 32), rest = idx / (256 * (S / 32)), bh = rest % (NB * 4), which = rest / (NB * 4);
    const int b = bh >> 2, h = bh & 3, hh = ln >> 5, delta = blk * 32 + (ln & 31);
    const float l2g = ret_log2g(h);
    float v[8];
#pragma unroll
    for (int j = 0; j < 8; ++j) {
      const int kappa = 16 * ks + 8 * (j >> 2) + 4 * hh + (j & 3), s = tile * 32 + kappa;
      const bf16_t* row = p.projb() + (size_t)(b * S + s) * INW;
      float x;
      if (which) {
        const float a = bf2f(row[OFF_KR + h * 64 + delta]), pa = bf2f(row[OFF_KR + h * 64 + (delta ^ 32)]);
        const int i = delta & 31; const float c = p.cosr()[s * 32 + i], sn = p.sinr()[s * 32 + i];
        x = (delta < 32 ? (a * c - pa * sn) : (a * c + pa * sn)) * 0.125f * exp2f(-(float)(s & 127) * l2g);
      } else x = bf2f(row[OFF_VR + h * 64 + delta]);
      v[j] = x;
    }
    uint4 o; o.x = pk_bf16(v[0], v[1]); o.y = pk_bf16(v[2], v[3]); o.z = pk_bf16(v[4], v[5]); o.w = pk_bf16(v[6], v[7]);
    *(uint4*)((which ? p.Krv() : p.Vr()) + ((size_t)(idx % (NB * 4 * (S / 32) * 256))) * 8) = o;
  }
}
__device__ __forceinline__ void phase_kmean2(const Params& p, int gtid, int ngt) {
  for (int idx = gtid; idx < NB * 8 * 16 * 64; idx += ngt) {
    const int d = idx & 63, j = (idx >> 6) & 15, bh = idx >> 10, c = d >> 3, dj = d & 7;
    float acc = 0.f;
    for (int tl = 0; tl < 8; ++tl) {
      const bf16_t* kp = p.Km() + (((size_t)bh * (S / 32) + j * 8 + tl) * 8 + c) * 256 + dj;
#pragma unroll 8
      for (int key = 0; key < 32; ++key) acc += bf2f(kp[key * 8]);
    }
    p.kmean()[idx] = acc * (1.0f / 256.0f);
  }
}

__device__ __forceinline__ void cvt_f32_bf16(const float* __restrict__ src, bf16_t* __restrict__ dst, size_t n8, int gtid, int ngt) {
  for (size_t i = gtid; i < n8; i += ngt) {
    float4 a = *(const float4*)(src + i * 8), b4 = *(const float4*)(src + i * 8 + 4);
    uint4 o; o.x = pk_bf16(a.x, a.y); o.y = pk_bf16(a.z, a.w); o.z = pk_bf16(b4.x, b4.y); o.w = pk_bf16(b4.z, b4.w);
    *(uint4*)(dst + i * 8) = o;
  }
}
__device__ __forceinline__ int f2key(float f) { int b = __float_as_int(f); return b ^ ((b >> 31) & 0x7fffffff); }
__device__ __forceinline__ float key2f(int k) { return __int_as_float(k ^ ((k >> 31) & 0x7fffffff)); }
#define CASD(a_, b_) { int mx_ = max(a_, b_), mn_ = min(a_, b_); a_ = mx_; b_ = mn_; }
__device__ __forceinline__ void sort16_desc(int (&v)[16]) {
#pragma unroll
  for (int k = 2; k <= 16; k <<= 1)
#pragma unroll
    for (int j = k >> 1; j > 0; j >>= 1)
#pragma unroll
      for (int i = 0; i < 16; ++i) { const int l2 = i ^ j; if (l2 > i) { if ((i & k) == 0) CASD(v[i], v[l2]) else CASD(v[l2], v[i]) } }
}
__device__ __forceinline__ void merge_top16(int (&a)[16], const int (&b)[16]) {
#pragma unroll
  for (int i = 0; i < 16; ++i) a[i] = max(a[i], b[15 - i]);
#pragma unroll
  for (int j = 8; j > 0; j >>= 1)
#pragma unroll
    for (int i = 0; i < 16; ++i) { const int l2 = i ^ j; if (l2 > i) CASD(a[i], a[l2]) }
}
__device__ __forceinline__ int lut4(int w0, int w1, int w2, int w3, int i) {
  const int w = i >> 2; const int d = (w == 0) ? w0 : (w == 1) ? w1 : (w == 2) ? w2 : w3;
  return (d >> ((i & 3) * 8)) & 127;
}

__device__ __forceinline__ void phase_peer_topk(const Params& p, int l, int gw, int ngw, int lane) {
  const int n = lane & 31, hh = lane >> 5;
  const bf16_t* skl = p.skb() + (size_t)l * 16 * 128 * 64;
  for (int w = gw; w < (T / 32) * 8; w += ngw) {
    const int tg = w >> 3, h = w & 7, t = tg * 32 + n;
    int L0[16], L1[16];
#pragma unroll
    for (int c = 0; c < 2; ++c) {
      const int hc = 2 * h + c;
      bf16x8 qf[4];
#pragma unroll
      for (int s = 0; s < 4; ++s) qf[s] = *(const bf16x8*)(p.qb() + (size_t)t * D + hc * 64 + 16 * s + 8 * hh);
      int A[16], Bq[16];
#pragma unroll
      for (int mb = 0; mb < 4; ++mb) {
        f32x16 X;
#pragma unroll
        for (int r = 0; r < 16; ++r) X[r] = 0.f;
#pragma unroll
        for (int s = 0; s < 4; ++s) {
          const bf16x8 kf = *(const bf16x8*)(skl + ((size_t)(hc * 128 + mb * 32 + n)) * 64 + 16 * s + 8 * hh);
          X = __builtin_amdgcn_mfma_f32_32x32x16_bf16(kf, qf[s], X, 0, 0, 0);
        }
        int Gk[16];
#pragma unroll
        for (int r = 0; r < 16; ++r) Gk[r] = (f2key(X[r]) & ~127) | (mb * 32 + (r & 3) + 8 * (r >> 2) + 4 * hh);
        sort16_desc(Gk);
        if (mb == 0) {
#pragma unroll
          for (int r = 0; r < 16; ++r) A[r] = Gk[r];
        } else merge_top16(A, Gk);
      }
#pragma unroll
      for (int r = 0; r < 16; ++r) Bq[r] = __shfl_xor(A[r], 32);
      merge_top16(A, Bq);
#pragma unroll
      for (int r = 0; r < 16; ++r) { if (c == 0) L0[r] = A[r]; else L1[r] = A[r]; }
    }
    float av[16], bv[16];
#pragma unroll
    for (int r = 0; r < 16; ++r) { av[r] = key2f(L0[r] & ~127); bv[r] = key2f(L1[r] & ~127); }
#define CAND(i_, j_) ((f2key(av[i_] + bv[j_]) & ~255) | ((i_) << 4) | (j_))
    int R[16], G1[16], G2[16];
#pragma unroll
    for (int j = 0; j < 16; ++j) R[j] = CAND(0, j);
    G1[0] = CAND(1, 0); G1[1] = CAND(1, 1); G1[2] = CAND(1, 2); G1[3] = CAND(1, 3); G1[4] = CAND(1, 4); G1[5] = CAND(1, 5); G1[6] = CAND(1, 6); G1[7] = CAND(1, 7);
    G1[8] = CAND(2, 0); G1[9] = CAND(2, 1); G1[10] = CAND(2, 2); G1[11] = CAND(2, 3); G1[12] = CAND(2, 4); G1[13] = CAND(3, 0); G1[14] = CAND(3, 1); G1[15] = CAND(3, 2);
    G2[0] = CAND(3, 3); G2[1] = CAND(4, 0); G2[2] = CAND(4, 1); G2[3] = CAND(4, 2); G2[4] = CAND(5, 0); G2[5] = CAND(5, 1); G2[6] = CAND(6, 0); G2[7] = CAND(6, 1);
    G2[8] = CAND(7, 0); G2[9] = CAND(7, 1); G2[10] = CAND(8, 0); G2[11] = CAND(9, 0); G2[12] = CAND(10, 0); G2[13] = CAND(11, 0); G2[14] = CAND(12, 0); G2[15] = CAND(13, 0);
    sort16_desc(G1); merge_top16(R, G1);
    sort16_desc(G2); merge_top16(R, G2);
    { int x0 = CAND(14, 0), x1 = CAND(15, 0);
#pragma unroll
      for (int i = 0; i < 16; ++i) CASD(R[i], x0)
#pragma unroll
      for (int i = 0; i < 16; ++i) CASD(R[i], x1)
    }
#undef CAND
    int pa0 = 0, pa1 = 0, pa2 = 0, pa3 = 0, pb0 = 0, pb1 = 0, pb2 = 0, pb3 = 0;
#pragma unroll
    for (int q = 0; q < 4; ++q) {
      pa0 |= (L0[q] & 127) << (8 * q); pa1 |= (L0[4 + q] & 127) << (8 * q); pa2 |= (L0[8 + q] & 127) << (8 * q); pa3 |= (L0[12 + q] & 127) << (8 * q);
      pb0 |= (L1[q] & 127) << (8 * q); pb1 |= (L1[4 + q] & 127) << (8 * q); pb2 |= (L1[8 + q] & 127) << (8 * q); pb3 |= (L1[12 + q] & 127) << (8 * q);
    }
    float ev[16], sum = 0.f; int ei[16];
    const float mx = key2f(R[0] & ~255);
#pragma unroll
    for (int z = 0; z < 16; ++z) {
      const float v = key2f(R[z] & ~255);
      ev[z] = __expf(v - mx); sum += ev[z];
      const int pay = R[z] & 255;
      ei[z] = lut4(pa0, pa1, pa2, pa3, pay >> 4) * 128 + lut4(pb0, pb1, pb2, pb3, pay & 15);
    }
    const float inv = 1.0f / sum;
    if (hh == 0) {
      float* go = p.gates() + ((size_t)t * 8 + h) * 16; int* eo = p.eidx() + ((size_t)t * 8 + h) * 16;
#pragma unroll
      for (int z = 0; z < 16; z += 4) {
        *(float4*)(go + z) = make_float4(ev[z] * inv, ev[z + 1] * inv, ev[z + 2] * inv, ev[z + 3] * inv);
        *(int4*)(eo + z) = make_int4(ei[z], ei[z + 1], ei[z + 2], ei[z + 3]);
      }
    }
  }
}

__device__ __forceinline__ void phase_peer_apply2(const Params& p, int l, float* coef, int gw, int ngw, int lane) {
  const float* g2 = p.inp(16) + l * D;
  for (int t = gw; t < T; t += ngw) {
    const float r = p.rstd()[t];
    float hv[16];
#pragma unroll
    for (int i = 0; i < 2; ++i) {
      const float* xp = p.outp() + (size_t)t * D + i * 512 + lane * 8; const float* gp = g2 + i * 512 + lane * 8;
      float4 x0 = *(const float4*)xp, x1 = *(const float4*)(xp + 4), g0 = *(const float4*)gp, g1 = *(const float4*)(gp + 4);
      hv[i * 8 + 0] = x0.x * r * g0.x; hv[i * 8 + 1] = x0.y * r * g0.y; hv[i * 8 + 2] = x0.z * r * g0.z; hv[i * 8 + 3] = x0.w * r * g0.w;
      hv[i * 8 + 4] = x1.x * r * g1.x; hv[i * 8 + 5] = x1.y * r * g1.y; hv[i * 8 + 6] = x1.z * r * g1.z; hv[i * 8 + 7] = x1.w * r * g1.w;
    }
    const int e_lo = p.eidx()[(size_t)t * 128 + lane], e_hi = p.eidx()[(size_t)t * 128 + 64 + lane];
    const float g_lo = p.gates()[(size_t)t * 128 + lane], g_hi = p.gates()[(size_t)t * 128 + 64 + lane];
    LDS_FENCE();
#pragma unroll 1
    for (int half = 0; half < 2; ++half) {
      const int ev = half ? e_hi : e_lo;
      float mine = 0.f;
#pragma unroll 4
      for (int j = 0; j < 64; ++j) {
        const int e = __shfl(ev, j);
        const bf16_t* up = p.Ub() + (size_t)e * D + lane * 8;
        uint4 u0 = *(const uint4*)up, u1 = *(const uint4*)(up + 512);
        float d = 0.f;
        d = fmaf(hv[0], __uint_as_float(u0.x << 16), d); d = fmaf(hv[1], __uint_as_float(u0.x & 0xffff0000u), d);
        d = fmaf(hv[2], __uint_as_float(u0.y << 16), d); d = fmaf(hv[3], __uint_as_float(u0.y & 0xffff0000u), d);
        d = fmaf(hv[4], __uint_as_float(u0.z << 16), d); d = fmaf(hv[5], __uint_as_float(u0.z & 0xffff0000u), d);
        d = fmaf(hv[6], __uint_as_float(u0.w << 16), d); d = fmaf(hv[7], __uint_as_float(u0.w & 0xffff0000u), d);
        d = fmaf(hv[8], __uint_as_float(u1.x << 16), d); d = fmaf(hv[9], __uint_as_float(u1.x & 0xffff0000u), d);
        d = fmaf(hv[10], __uint_as_float(u1.y << 16), d); d = fmaf(hv[11], __uint_as_float(u1.y & 0xffff0000u), d);
        d = fmaf(hv[12], __uint_as_float(u1.z << 16), d); d = fmaf(hv[13], __uint_as_float(u1.z & 0xffff0000u), d);
        d = fmaf(hv[14], __uint_as_float(u1.w << 16), d); d = fmaf(hv[15], __uint_as_float(u1.w & 0xffff0000u), d);
        d = wave_sum(d);
        if (lane == j) mine = d;
      }
      coef[half * 64 + lane] = (half ? g_hi : g_lo) * gelu_tanh(mine);
    }
    LDS_FENCE();
    float acc[16];
#pragma unroll
    for (int i = 0; i < 16; ++i) acc[i] = 0.f;
#pragma unroll 1
    for (int half = 0; half < 2; ++half) {
      const int ev = half ? e_hi : e_lo;
#pragma unroll 4
      for (int j = 0; j < 64; ++j) {
        const int e = __shfl(ev, j);
        const float c = coef[half * 64 + j];
        const bf16_t* vp = p.Vb() + (size_t)e * D + lane * 8;
        uint4 v0 = *(const uint4*)vp, v1 = *(const uint4*)(vp + 512);
        acc[0] = fmaf(c, __uint_as_float(v0.x << 16), acc[0]); acc[1] = fmaf(c, __uint_as_float(v0.x & 0xffff0000u), acc[1]);
        acc[2] = fmaf(c, __uint_as_float(v0.y << 16), acc[2]); acc[3] = fmaf(c, __uint_as_float(v0.y & 0xffff0000u), acc[3]);
        acc[4] = fmaf(c, __uint_as_float(v0.z << 16), acc[4]); acc[5] = fmaf(c, __uint_as_float(v0.z & 0xffff0000u), acc[5]);
        acc[6] = fmaf(c, __uint_as_float(v0.w << 16), acc[6]); acc[7] = fmaf(c, __uint_as_float(v0.w & 0xffff0000u), acc[7]);
        acc[8] = fmaf(c, __uint_as_float(v1.x << 16), acc[8]); acc[9] = fmaf(c, __uint_as_float(v1.x & 0xffff0000u), acc[9]);
        acc[10] = fmaf(c, __uint_as_float(v1.y << 16), acc[10]); acc[11] = fmaf(c, __uint_as_float(v1.y & 0xffff0000u), acc[11]);
        acc[12] = fmaf(c, __uint_as_float(v1.z << 16), acc[12]); acc[13] = fmaf(c, __uint_as_float(v1.z & 0xffff0000u), acc[13]);
        acc[14] = fmaf(c, __uint_as_float(v1.w << 16), acc[14]); acc[15] = fmaf(c, __uint_as_float(v1.w & 0xffff0000u), acc[15]);
      }
    }
#pragma unroll
    for (int i = 0; i < 2; ++i) {
      float* xp = p.outp() + (size_t)t * D + i * 512 + lane * 8;
      float4 x0 = *(float4*)xp, x1 = *(float4*)(xp + 4);
      x0.x += acc[i * 8 + 0]; x0.y += acc[i * 8 + 1]; x0.z += acc[i * 8 + 2]; x0.w += acc[i * 8 + 3];
      x1.x += acc[i * 8 + 4]; x1.y += acc[i * 8 + 5]; x1.z += acc[i * 8 + 6]; x1.w += acc[i * 8 + 7];
      *(float4*)xp = x0; *(float4*)(xp + 4) = x1;
    }
  }
}

typedef int v8i __attribute__((ext_vector_type(8)));
__device__ __forceinline__ unsigned xcc_id() { return (unsigned)__builtin_amdgcn_s_getreg((3 << 11) | 20) & 7u; }
__device__ __forceinline__ float pow2_scale(float amax) {
  if (!(amax > 0.f)) return 1.0f;
  const int e = (int)floorf(log2f(240.0f / amax));
  return exp2f((float)(e < 60 ? (e > -60 ? e : -60) : 60));
}
__device__ __forceinline__ unsigned pack4_fp8(float a, float b, float c, float d) {
  int v = __builtin_amdgcn_cvt_pk_fp8_f32(a, b, 0, false);
  v = __builtin_amdgcn_cvt_pk_fp8_f32(c, d, v, true);
  return (unsigned)v;
}
__device__ __forceinline__ void cvt_table_fp8(const float* __restrict__ src, unsigned char* __restrict__ dst, float* __restrict__ scl, int gw, int ngw, int lane) {
  for (int e0 = gw; e0 < 16384; e0 += 2 * ngw) {
    float4 v[2][4];
#pragma unroll
    for (int u = 0; u < 2; ++u) { const int e = (e0 + u * ngw < 16384) ? e0 + u * ngw : e0;
#pragma unroll
      for (int k = 0; k < 4; ++k) v[u][k] = *(const float4*)(src + (size_t)e * D + k * 256 + lane * 4); }
#pragma unroll
    for (int u = 0; u < 2; ++u) {
      const int e = e0 + u * ngw;
      if (e < 16384) {
        float am = 0.f;
#pragma unroll
        for (int k = 0; k < 4; ++k) am = fmaxf(am, fmaxf(fmaxf(fabsf(v[u][k].x), fabsf(v[u][k].y)), fmaxf(fabsf(v[u][k].z), fabsf(v[u][k].w))));
        am = wave_max(am);
        const float s = pow2_scale(am);
        if (lane == 0) scl[e] = s;
#pragma unroll
        for (int k = 0; k < 4; ++k) {
          const int slice = 2 * k + (lane >> 5), off = (lane & 31) * 4;
          *(unsigned*)(dst + ((size_t)slice * 16384 + e) * 128 + off) = pack4_fp8(v[u][k].x * s, v[u][k].y * s, v[u][k].z * s, v[u][k].w * s);
        }
      }
    }
  }
}
__device__ __forceinline__ void phase_cvt_rows_h8(const Params& p, int l, int gw, int ngw, int lane) {
  const float* g2 = p.inp(16) + l * D;
  float4 g[4];
#pragma unroll
  for (int k = 0; k < 4; ++k) g[k] = *(const float4*)(g2 + k * 256 + lane * 4);
  for (int t0 = gw; t0 < T; t0 += 2 * ngw) {
    float4 v[2][4];
#pragma unroll
    for (int u = 0; u < 2; ++u) { const int t = (t0 + u * ngw < T) ? t0 + u * ngw : t0;
#pragma unroll
      for (int k = 0; k < 4; ++k) v[u][k] = *(const float4*)(p.outp() + (size_t)t * D + k * 256 + lane * 4); }
#pragma unroll
    for (int u = 0; u < 2; ++u) {
      const int t = t0 + u * ngw;
      if (t < T) {
        float ss = 0.f;
#pragma unroll
        for (int k = 0; k < 4; ++k) {
          const float4 w = v[u][k];
          ss += w.x * w.x + w.y * w.y + w.z * w.z + w.w * w.w;
          uint2 ph; ph.x = pk_bf16(w.x, w.y); ph.y = pk_bf16(w.z, w.w);
          *(uint2*)(p.xb() + (size_t)t * KD + k * 256 + lane * 4) = ph;
        }
        ss = wave_sum(ss);
        const float r = rsqrtf(ss / (float)D + EPS);
        if (lane == 0) p.rstd()[t] = r;
#pragma unroll
        for (int k = 0; k < 4; ++k) {
          const float4 w = v[u][k];
          const int slice = 2 * k + (lane >> 5), off = (lane & 31) * 4;
          uint2 o; o.x = pk_bf16(w.x * r * g[k].x, w.y * r * g[k].y); o.y = pk_bf16(w.z * r * g[k].z, w.w * r * g[k].w);
          *(uint2*)(p.hb() + ((size_t)slice * T + t) * 128 + off) = o;
        }
      }
    }
  }
}
#define DPP_ADD(v_, ctrl_) ((v_) + __builtin_bit_cast(float, __builtin_amdgcn_update_dpp(0, __builtin_bit_cast(int, (v_)), (ctrl_), 0xF, 0xF, true)))
__device__ __forceinline__ float sum_xor16(float x) { float a = x, b = x; asm volatile("v_nop\n\tv_nop\n\tv_permlane16_swap_b32 %0, %1" : "+v"(a), "+v"(b)); return a + b; }
__device__ __forceinline__ float sum_xor32(float x) { float a = x, b = x; asm volatile("v_nop\n\tv_nop\n\tv_permlane32_swap_b32 %0, %1" : "+v"(a), "+v"(b)); return a + b; }
__device__ __forceinline__ int q_pull(int* head, int nitems, int* bc, int tid) {
  __syncthreads();
  if (tid == 0) bc[0] = atomicAdd(head, 1);
  __syncthreads();
  const int v = bc[0];
  return v < nitems ? v : -1;
}
constexpr int PEER_TILE = 128;
__device__ __forceinline__ void phase_peer_u(const Params& p, int* heads, unsigned char* lds, int tid) {
  const int lane = tid & 63, wv = tid >> 6, r8 = lane >> 3, c8 = lane & 7;
  int* bc = (int*)lds;
  int* eW = (int*)(lds + 1024 + wv * 12288);
  bf16_t* hW = (bf16_t*)(lds + 1024 + wv * 12288 + 8192);
  const int myx = (int)xcc_id();
  for (int pass = 0; pass < 8; ++pass) {
    const int s = (myx + pass) & 7;
    const unsigned char* Us = p.U8s() + (size_t)s * 16384 * 128 + c8 * 16;
    for (;;) {
      const int item = q_pull(heads + s, T / PEER_TILE, bc, tid);
      if (item < 0) break;
      const int t0 = item * PEER_TILE + wv * 16;
      LDS_FENCE();
      { uint2 ev[16];
        const bf16_t* hsrc = p.hb() + ((size_t)s * T + t0) * 128 + lane * 8;
#pragma unroll
        for (int k = 0; k < 16; ++k) ev[k] = *(const uint2*)(p.eidx() + (size_t)(t0 + k) * 128 + lane * 2);
        const uint4 hq0 = *(const uint4*)(hsrc), hq1 = *(const uint4*)(hsrc + 512), hq2 = *(const uint4*)(hsrc + 1024), hq3 = *(const uint4*)(hsrc + 1536);
#pragma unroll
        for (int k = 0; k < 16; ++k) *(uint2*)(eW + k * 128 + lane * 2) = ev[k];
        *(uint4*)(hW + lane * 8) = hq0; *(uint4*)(hW + 512 + lane * 8) = hq1; *(uint4*)(hW + 1024 + lane * 8) = hq2; *(uint4*)(hW + 1536 + lane * 8) = hq3; }
      LDS_FENCE();
      uint4 R[4][8];
#define PEER_U_LOAD(M_, BUF_) { _Pragma("unroll") for (int eb = 0; eb < 8; ++eb) R[BUF_][eb] = *(const uint4*)(Us + (size_t)eW[(M_) * 64 + eb * 8 + r8] * 128); }
      PEER_U_LOAD(0, 0) PEER_U_LOAD(1, 1) PEER_U_LOAD(2, 2)
      float hv[16]; float res0 = 0.f, res1 = 0.f;
#define PEER_U_LOADH(TOK_) { const bf16_t* hp = hW + (TOK_) * 128 + c8 * 16; const uint4 a = *(const uint4*)hp, b4 = *(const uint4*)(hp + 8); \
        const unsigned w8[8] = {a.x, a.y, a.z, a.w, b4.x, b4.y, b4.z, b4.w};                                                              \
        _Pragma("unroll") for (int z = 0; z < 8; ++z) { hv[2 * z] = __uint_as_float(w8[z] << 16); hv[2 * z + 1] = __uint_as_float(w8[z] & 0xffff0000u); } }
      PEER_U_LOADH(0)
#define PEER_U_HALF(M_, BUF_, HALF_)                                                                           \
      {                                                                                                                                   \
        if ((M_) + 3 < 32) PEER_U_LOAD((M_) + 3, ((BUF_) + 3) & 3)                                                                        \
        _Pragma("unroll") for (int eb = 0; eb < 8; ++eb) {                                                                                \
          const unsigned ww[4] = {R[BUF_][eb].x, R[BUF_][eb].y, R[BUF_][eb].z, R[BUF_][eb].w};                                            \
          float d = 0.f;                                                                                                                  \
          _Pragma("unroll") for (int q4 = 0; q4 < 4; ++q4) {                                                                              \
            const auto f01 = __builtin_amdgcn_cvt_pk_f32_fp8((int)ww[q4], false); const auto f23 = __builtin_amdgcn_cvt_pk_f32_fp8((int)ww[q4], true); \
            d = fmaf(hv[q4 * 4 + 0], f01[0], d); d = fmaf(hv[q4 * 4 + 1], f01[1], d); d = fmaf(hv[q4 * 4 + 2], f23[0], d); d = fmaf(hv[q4 * 4 + 3], f23[1], d); \
          }                                                                                                                               \
          d = DPP_ADD(d, 0xB1); d = DPP_ADD(d, 0x4E); d = DPP_ADD(d, 0x141);     \
          if ((HALF_) == 0) { if (c8 == eb) res0 = d; } else { if (c8 == eb) res1 = d; }                                                  \
        }                                                                                                                                 \
        if ((HALF_) == 1) {                                                                                                               \
          float* po = p.ppart() + ((size_t)s * T + t0 + ((M_) >> 1)) * 128;                                                               \
          po[c8 * 8 + r8] = res0; po[64 + c8 * 8 + r8] = res1;                                                                            \
          if ((M_) + 1 < 32) PEER_U_LOADH(((M_) >> 1) + 1)                                                                                \
        }                                                                                                                                 \
      }
#pragma unroll
      for (int m4 = 0; m4 < 32; m4 += 4) {
        PEER_U_HALF(m4, 0, 0) PEER_U_HALF(m4 + 1, 1, 1) PEER_U_HALF(m4 + 2, 2, 0) PEER_U_HALF(m4 + 3, 3, 1)
      }
#undef PEER_U_HALF
#undef PEER_U_LOADH
#undef PEER_U_LOAD
    }
  }
}
__device__ __forceinline__ void phase_peer_r(const Params& p, int gtid, int ngt) {
  for (int idx0 = gtid; idx0 < T * 128; idx0 += 4 * ngt) {
    float d[4]; int e[4]; float su_[4], sv_[4], g_[4]; bool ok[4];
#pragma unroll
    for (int u = 0; u < 4; ++u) { const int idx = idx0 + u * ngt; ok[u] = idx < T * 128; const int ix = ok[u] ? idx : 0;
      e[u] = p.eidx()[ix]; g_[u] = p.gates()[ix]; float a = 0.f;
#pragma unroll
      for (int s = 0; s < 8; ++s) a += p.ppart()[(size_t)s * T * 128 + ix];
      d[u] = a; }
#pragma unroll
    for (int u = 0; u < 4; ++u) { su_[u] = p.su()[e[u]]; sv_[u] = p.sv()[e[u]]; }
#pragma unroll
    for (int u = 0; u < 4; ++u) if (ok[u]) p.gates()[idx0 + u * ngt] = g_[u] * gelu_tanh(d[u] * p.rstd()[(idx0 + u * ngt) >> 7] / su_[u]) / sv_[u];
  }
}
__device__ __forceinline__ void phase_peer_v(const Params& p, int* heads, unsigned char* lds, int tid) {
  const int lane = tid & 63, wv = tid >> 6, r8 = lane >> 3, c8 = lane & 7;
  int* bc = (int*)lds;
  uint2* pW = (uint2*)(lds + 1024 + wv * 16384);
  const int myx = (int)xcc_id();
  for (int pass = 0; pass < 8; ++pass) {
    const int s = (myx + pass) & 7;
    const unsigned char* Vs = p.V8s() + (size_t)s * 16384 * 128 + c8 * 16;
    for (;;) {
      const int item = q_pull(heads + s, T / PEER_TILE, bc, tid);
      if (item < 0) break;
      const int t0 = item * PEER_TILE + wv * 16;
      LDS_FENCE();
      { uint2 e2[16], g2[16];
#pragma unroll
        for (int k = 0; k < 16; ++k) { e2[k] = *(const uint2*)(p.eidx() + (size_t)(t0 + k) * 128 + lane * 2); g2[k] = *(const uint2*)(p.gates() + (size_t)(t0 + k) * 128 + lane * 2); }
#pragma unroll
        for (int k = 0; k < 16; ++k) *(uint4*)(pW + k * 128 + lane * 2) = make_uint4(e2[k].x, g2[k].x, e2[k].y, g2[k].y); }
      LDS_FENCE();
      const int rowk = lane >> 4, prow = ((rowk & 1) << 1) | (rowk >> 1);
      const bool wr_lane = (lane & 8) == 0;
      const int xoff = s * 128 + c8 * 16 + prow * 4;
      float4 xo[8];
#pragma unroll
      for (int k = 0; k < 8; ++k) xo[k] = *(const float4*)(p.outp() + (size_t)(t0 + k) * D + xoff);
      uint4 R[3][8];
#define PEER_V_LOAD(M_, BUF_) { _Pragma("unroll") for (int eb = 0; eb < 8; ++eb) R[BUF_][eb] = *(const uint4*)(Vs + (size_t)pW[(M_) * 64 + eb * 8 + r8].x * 128); }
      PEER_V_LOAD(0, 0) PEER_V_LOAD(1, 1)
      float acc[16];
#define PEER_V_HALF(M_, BUF_, HALF_)                                                           \
      {                                                                                                                                   \
        if ((M_) + 2 < 32) PEER_V_LOAD((M_) + 2, ((BUF_) + 2) % 3)                                                                        \
        if ((HALF_) == 0) { _Pragma("unroll") for (int z = 0; z < 16; ++z) acc[z] = 0.f; }                                                \
        _Pragma("unroll") for (int eb = 0; eb < 8; ++eb) {                                                                                \
          const float c = __uint_as_float(pW[(M_) * 64 + eb * 8 + r8].y);                                                                 \
          const unsigned ww[4] = {R[BUF_][eb].x, R[BUF_][eb].y, R[BUF_][eb].z, R[BUF_][eb].w};                                            \
          _Pragma("unroll") for (int q4 = 0; q4 < 4; ++q4) {                                                                              \
            const auto f01 = __builtin_amdgcn_cvt_pk_f32_fp8((int)ww[q4], false); const auto f23 = __builtin_amdgcn_cvt_pk_f32_fp8((int)ww[q4], true); \
            acc[q4 * 4 + 0] = fmaf(c, f01[0], acc[q4 * 4 + 0]); acc[q4 * 4 + 1] = fmaf(c, f01[1], acc[q4 * 4 + 1]);                       \
            acc[q4 * 4 + 2] = fmaf(c, f23[0], acc[q4 * 4 + 2]); acc[q4 * 4 + 3] = fmaf(c, f23[1], acc[q4 * 4 + 3]);                       \
          }                                                                                                                               \
        }                                                                                                                                 \
        if ((HALF_) == 1) {                                                                                                               \
          _Pragma("unroll") for (int z = 0; z < 16; ++z) acc[z] = DPP_ADD(acc[z], 0x128);                                  \
          asm volatile("v_nop\n\tv_nop\n\tv_permlane16_swap_b32 %0, %8\n\tv_permlane16_swap_b32 %1, %9\n\tv_permlane16_swap_b32 %2, %10\n\tv_permlane16_swap_b32 %3, %11\n\t" \
                       "v_permlane16_swap_b32 %4, %12\n\tv_permlane16_swap_b32 %5, %13\n\tv_permlane16_swap_b32 %6, %14\n\tv_permlane16_swap_b32 %7, %15" \
            : "+v"(acc[0]), "+v"(acc[1]), "+v"(acc[2]), "+v"(acc[3]), "+v"(acc[4]), "+v"(acc[5]), "+v"(acc[6]), "+v"(acc[7]),                   \
              "+v"(acc[8]), "+v"(acc[9]), "+v"(acc[10]), "+v"(acc[11]), "+v"(acc[12]), "+v"(acc[13]), "+v"(acc[14]), "+v"(acc[15]));               \
          _Pragma("unroll") for (int z = 0; z < 8; ++z) acc[z] += acc[z + 8];            \
          asm volatile("v_nop\n\tv_nop\n\tv_permlane32_swap_b32 %0, %4\n\tv_permlane32_swap_b32 %1, %5\n\tv_permlane32_swap_b32 %2, %6\n\tv_permlane32_swap_b32 %3, %7" \
            : "+v"(acc[0]), "+v"(acc[1]), "+v"(acc[2]), "+v"(acc[3]), "+v"(acc[4]), "+v"(acc[5]), "+v"(acc[6]), "+v"(acc[7]));                   \
          float4 dl;                                                                                                                      \
          dl.x = acc[0] + acc[4]; dl.y = acc[1] + acc[5]; dl.z = acc[2] + acc[6]; dl.w = acc[3] + acc[7];     \
          const float4 xv = xo[((M_) >> 1) & 7];                                                                                          \
          if (((M_) >> 1) + 8 < 16) xo[((M_) >> 1) & 7] = *(const float4*)(p.outp() + (size_t)(t0 + ((M_) >> 1) + 8) * D + xoff);                  \
          const float4 xn = make_float4(xv.x + dl.x, xv.y + dl.y, xv.z + dl.z, xv.w + dl.w);                                              \
          float sq = 0.f;                                                                                                                 \
          if (wr_lane) {                                                                                                                  \
            *(float4*)(p.outp() + (size_t)(t0 + ((M_) >> 1)) * D + xoff) = xn;                                                             \
            *(uint2*)(p.xb() + (size_t)(t0 + ((M_) >> 1)) * KD + xoff) = make_uint2(pk_bf16(xn.x, xn.y), pk_bf16(xn.z, xn.w));     \
            sq = (xn.x * xn.x + xn.y * xn.y) + (xn.z * xn.z + xn.w * xn.w);                                                                \
          }                                                                                                                               \
          sq = DPP_ADD(sq, 0xB1); sq = DPP_ADD(sq, 0x4E); sq = DPP_ADD(sq, 0x141); sq = DPP_ADD(sq, 0x128); sq = sum_xor16(sq); sq = sum_xor32(sq);     \
          if (lane == 0) p.ssq1()[(size_t)(t0 + ((M_) >> 1)) * 8 + s] = sq;                                                               \
        }                                                                                                                                 \
      }
#pragma unroll
      for (int m6 = 0; m6 < 30; m6 += 6) {
        PEER_V_HALF(m6, 0, 0) PEER_V_HALF(m6 + 1, 1, 1) PEER_V_HALF(m6 + 2, 2, 0) PEER_V_HALF(m6 + 3, 0, 1) PEER_V_HALF(m6 + 4, 1, 0) PEER_V_HALF(m6 + 5, 2, 1)
      }
      PEER_V_HALF(30, 0, 0) PEER_V_HALF(31, 1, 1)
#undef PEER_V_HALF
#undef PEER_V_LOAD
    }
  }
}

#if PEER_CHECK
constexpr int CHK_N = 512;
__device__ __forceinline__ float* chk_x(const Params& p) { return (float*)(p.ws + WO_ybuf); }
__device__ __forceinline__ float* chk_m(const Params& p) { return (float*)(p.ws + WO_ybuf + (size_t)CHK_N * D * 4); }
__device__ __forceinline__ float* chk_g(const Params& p) { return (float*)(p.ws + WO_ybuf + (size_t)CHK_N * D * 4 + 4096); }
__device__ __forceinline__ void chk_save(const Params& p, int gtid, int ngt) {
  for (int i = gtid; i < CHK_N * D; i += ngt) chk_x(p)[i] = p.outp()[(size_t)(i / D) * 64 * D + (i % D)];
  for (int i = gtid; i < CHK_N * 128; i += ngt) chk_g(p)[i] = p.gates()[(size_t)(i / 128) * 64 * 128 + (i % 128)];
  if (gtid < 16) chk_m(p)[gtid] = 0.f;
}
__device__ __forceinline__ void chk_apply(const Params& p, int l, float* coef, int gw, int ngw, int lane) {
  const float* g2 = p.inp(16) + l * D;
  const float* U = p.inp(19) + (size_t)l * 16384 * D; const float* V = p.inp(20) + (size_t)l * 16384 * D;
  for (int i = gw; i < CHK_N; i += ngw) {
    const int t = i * 64;
    const float r = p.rstd()[t];
    float4 hv[4];
#pragma unroll
    for (int k = 0; k < 4; ++k) {
      float4 xv = *(const float4*)(chk_x(p) + (size_t)i * D + (lane + k * 64) * 4);
      float4 gv = *(const float4*)(g2 + (lane + k * 64) * 4);
      hv[k].x = xv.x * r * gv.x; hv[k].y = xv.y * r * gv.y; hv[k].z = xv.z * r * gv.z; hv[k].w = xv.w * r * gv.w;
    }
    LDS_FENCE();
    for (int j = 0; j < 128; ++j) {
      const int e = p.eidx()[(size_t)t * 128 + j];
      const float4* up = (const float4*)(U + (size_t)e * D);
      float dsum = 0.f;
#pragma unroll
      for (int k = 0; k < 4; ++k) { float4 uv = up[lane + k * 64]; dsum += hv[k].x * uv.x + hv[k].y * uv.y + hv[k].z * uv.z + hv[k].w * uv.w; }
      dsum = wave_sum(dsum);
      if (lane == 0) coef[j] = chk_g(p)[(size_t)i * 128 + j] * gelu_tanh(dsum);
    }
    LDS_FENCE();
    float4 acc[4];
#pragma unroll
    for (int k = 0; k < 4; ++k) acc[k] = make_float4(0.f, 0.f, 0.f, 0.f);
    for (int j = 0; j < 128; ++j) {
      const int e = p.eidx()[(size_t)t * 128 + j];
      const float c = coef[j];
      const float4* vp = (const float4*)(V + (size_t)e * D);
#pragma unroll
      for (int k = 0; k < 4; ++k) { float4 vv = vp[lane + k * 64]; acc[k].x = fmaf(c, vv.x, acc[k].x); acc[k].y = fmaf(c, vv.y, acc[k].y); acc[k].z = fmaf(c, vv.z, acc[k].z); acc[k].w = fmaf(c, vv.w, acc[k].w); }
    }
    float d2 = 0.f, r2 = 0.f;
#pragma unroll
    for (int k = 0; k < 4; ++k) {
      float4 xa = *(const float4*)(p.outp() + (size_t)t * D + (lane + k * 64) * 4);
      float4 xb4 = *(const float4*)(chk_x(p) + (size_t)i * D + (lane + k * 64) * 4);
      float e0 = (xa.x - xb4.x) - acc[k].x, e1 = (xa.y - xb4.y) - acc[k].y, e2 = (xa.z - xb4.z) - acc[k].z, e3 = (xa.w - xb4.w) - acc[k].w;
      d2 += e0 * e0 + e1 * e1 + e2 * e2 + e3 * e3;
      r2 += acc[k].x * acc[k].x + acc[k].y * acc[k].y + acc[k].z * acc[k].z + acc[k].w * acc[k].w;
    }
    d2 = wave_sum(d2); r2 = wave_sum(r2);
    if (lane == 0) { atomicAdd((unsigned long long*)&chk_m(p)[8], (unsigned long long)(d2 * 1099511627776.0f)); atomicAdd((unsigned long long*)&chk_m(p)[10], (unsigned long long)(r2 * 1099511627776.0f)); }
  }
}
__device__ __forceinline__ void chk_topk(const Params& p, int l, int gtid, int ngt) {
  const float* subk = p.inp(18) + (size_t)l * 16 * 128 * 64;
  for (int it = gtid; it < CHK_N * 8; it += ngt) {
    const int i = it >> 3, h = it & 7, t = i * 64;
    float tva[16], tvb[16]; int tia[16], tib[16];
#pragma unroll 1
    for (int c = 0; c < 2; ++c) {
      float tv[16]; int ti[16];
#pragma unroll
      for (int z = 0; z < 16; ++z) { tv[z] = -INFINITY; ti[z] = 0; }
      const bf16_t* q = p.qb() + (size_t)t * D + (2 * h + c) * 64;
      const float* kb = subk + (size_t)(2 * h + c) * 128 * 64;
#pragma unroll 1
      for (int n = 0; n < 128; ++n) {
        float sc = 0.f;
        for (int d = 0; d < 64; ++d) sc = fmaf(bf2f(q[d]), kb[n * 64 + d], sc);
        float v_ = sc; int i_ = n;
#pragma unroll
        for (int z = 0; z < 16; ++z) { bool gt = v_ > tv[z]; float a = tv[z]; int b = ti[z]; tv[z] = gt ? v_ : a; ti[z] = gt ? i_ : b; v_ = gt ? a : v_; i_ = gt ? b : i_; }
      }
#pragma unroll
      for (int z = 0; z < 16; ++z) { if (c == 0) { tva[z] = tv[z]; tia[z] = ti[z]; } else { tvb[z] = tv[z]; tib[z] = ti[z]; } }
    }
    float tv[16]; int ti[16];
#pragma unroll
    for (int z = 0; z < 16; ++z) { tv[z] = -INFINITY; ti[z] = 0; }
#pragma unroll 1
    for (int a = 0; a < 16; ++a)
#pragma unroll 1
      for (int b = 0; b < 16; ++b) {
        float av = 0.f, bv = 0.f; int ai = 0, bi = 0;
#pragma unroll
        for (int z = 0; z < 16; ++z) { if (z == a) { av = tva[z]; ai = tia[z]; } if (z == b) { bv = tvb[z]; bi = tib[z]; } }
        float v_ = av + bv; int i_ = ai * 128 + bi;
#pragma unroll
        for (int z = 0; z < 16; ++z) { bool gt = v_ > tv[z]; float x = tv[z]; int y = ti[z]; tv[z] = gt ? v_ : x; ti[z] = gt ? i_ : y; v_ = gt ? x : v_; i_ = gt ? y : i_; }
      }
    float sum = 0.f, ev[16];
#pragma unroll
    for (int z = 0; z < 16; ++z) { ev[z] = expf(tv[z] - tv[0]); sum += ev[z]; }
    int miss = 0; float gerr = 0.f;
    for (int z = 0; z < 16; ++z) {
      const int ef = p.eidx()[((size_t)t * 8 + h) * 16 + z]; const float gf = p.gates()[((size_t)t * 8 + h) * 16 + z];
      bool found = false;
#pragma unroll
      for (int y = 0; y < 16; ++y) if (ti[y] == ef) { found = true; gerr = fmaxf(gerr, fabsf(ev[y] / sum - gf)); }
      if (!found) ++miss;
    }
    atomicAdd(&chk_m(p)[3], (float)miss);
    atomicMax((int*)&chk_m(p)[4], __float_as_int(gerr));
  }
}
__device__ __forceinline__ void chk_emit(const Params& p) {
  float v = 0.f;
  if (PEER_CHECK == 1) v = sqrtf((float)((double)*(unsigned long long*)&chk_m(p)[8] / (double)*(unsigned long long*)&chk_m(p)[10]));
  if (PEER_CHECK == 2) v = chk_m(p)[3] / (float)(CHK_N * 8 * 16);
  if (PEER_CHECK == 3) v = chk_m(p)[4];
  p.outp()[0] += 1.0e4f * v + 100.0f;
}
#endif

#define XB_TMO      128
#define XB_XCNT(j)  (256  + 64 * (j))
#define XB_XSUB(j)  (1280 + 64 * (j))
#define XB_XGEN(j)  (2304 + 64 * (j))
#define XB_TOP      3328
#define XB_TOPGEN   3392
#define XCD_BAR_WORDS 3456
#define XB_SPIN_CAP (1u << 18)
#define LAS __attribute__((address_space(3)))

__device__ __forceinline__ unsigned xb_ld(unsigned* p)              { return __hip_atomic_load(p, __ATOMIC_RELAXED, __HIP_MEMORY_SCOPE_AGENT); }
__device__ __forceinline__ unsigned xb_add(unsigned* p, unsigned v) { return __hip_atomic_fetch_add(p, v, __ATOMIC_RELAXED, __HIP_MEMORY_SCOPE_AGENT); }
__device__ __forceinline__ unsigned xb_xcc_id() { return (unsigned)__builtin_amdgcn_s_getreg((3 << 11) | 20) & 0xFu; }
#define XB_SPIN(cond, bar) do { unsigned _sp = 0; while (cond) { __builtin_amdgcn_s_sleep(1); \
    if ((++_sp & 255u) == 0u) { if (xb_ld(&(bar)[XB_TMO])) break; if (_sp > XB_SPIN_CAP) { atomicAdd(&(bar)[XB_TMO], 1u); break; } } } } while (0)

struct XcdBarrier {
    unsigned* bar; unsigned x;
    volatile LAS unsigned* st;
};

__device__ __forceinline__ XcdBarrier xcd_barrier_post(unsigned* bar, volatile LAS unsigned* st) {
    XcdBarrier b; b.bar = bar; b.x = xb_xcc_id(); b.st = st;
    if (threadIdx.x == 0) (void)xb_add(&bar[XB_XCNT(b.x)], 1u);
    return b;
}
__device__ __forceinline__ void xcd_barrier_complete(unsigned* bar, unsigned x, unsigned& nloc, unsigned& nx) {
    const unsigned G = gridDim.x * gridDim.y * gridDim.z;
    unsigned sum, cnt, mine, sp = 0u;
    for (;;) {
        sum = 0u; cnt = 0u; mine = 0u;
#pragma unroll
        for (unsigned j = 0; j < 16; ++j) { const unsigned c = xb_ld(&bar[XB_XCNT(j)]); sum += c; cnt += (c > 0u) ? 1u : 0u; mine = (j == x) ? c : mine; }
        if (sum == G) break;
        __builtin_amdgcn_s_sleep(1);
        if ((++sp & 255u) == 0u) { if (xb_ld(&bar[XB_TMO])) break; if (sp > XB_SPIN_CAP) { atomicAdd(&bar[XB_TMO], 1u); break; } }
    }
    nloc = mine > 0u ? mine : 1u; nx = cnt > 0u ? cnt : 1u;
}

__device__ __forceinline__ void xcd_barrier(const XcdBarrier& b) {
    asm volatile("s_waitcnt vmcnt(0)" ::: "memory");
    __syncthreads();
    if (threadIdx.x == 0) {
        unsigned* bar = b.bar;
        __builtin_amdgcn_s_waitcnt(0);
        unsigned nloc = b.st[0], nx = b.st[1];
        if (nloc == 0u) { xcd_barrier_complete(bar, b.x, nloc, nx); b.st[0] = nloc; b.st[1] = nx; }
        const unsigned old = xb_add(&bar[XB_XSUB(b.x)], 1u);
        const unsigned gen = old / nloc;
        if (old + 1u == (gen + 1u) * nloc) {
            __builtin_amdgcn_fence(__ATOMIC_RELEASE, "agent");
            asm volatile("s_waitcnt vmcnt(0)" ::: "memory");
            const unsigned og = xb_add(&bar[XB_TOP], 1u);
            const unsigned tg = og / nx;
            if (og + 1u == (tg + 1u) * nx) xb_add(&bar[XB_TOPGEN], 1u);
            else XB_SPIN(xb_ld(&bar[XB_TOPGEN]) == tg, bar);
            __builtin_amdgcn_fence(__ATOMIC_ACQUIRE, "agent");
            xb_add(&bar[XB_XGEN(b.x)], 1u);
            asm volatile("s_waitcnt vmcnt(0)" ::: "memory");
        } else {
            XB_SPIN(xb_ld(&bar[XB_XGEN(b.x)]) == gen, bar);
            __builtin_amdgcn_fence(__ATOMIC_ACQUIRE, "agent");
            asm volatile("s_waitcnt vmcnt(0)" ::: "memory");
        }
    }
    __syncthreads();
}

__device__ __forceinline__ Params fresh(const Params& p) {
  Params q = p;
  asm volatile("" : "+s"(q.ws), "+s"(q.out_));
#pragma unroll
  for (int i = 0; i < 21; ++i) asm volatile("" : "+s"(q.in[i]));
  return q;
}
#define PHASE_IDS int tid = threadIdx.x; asm volatile("" : "+v"(tid)); int bid = blockIdx.x; asm volatile("" : "+s"(bid)); int G = gridDim.x; asm volatile("" : "+s"(G)); \
  const int lane = tid & 63, wv = tid >> 6; const int ngt = G * NTHR, ngw = G * NWAVE; \
  const int gtid = bid * NTHR + tid, gw = bid * NWAVE + wv; (void)lane; (void)wv; (void)gtid; (void)gw; (void)ngt; (void)ngw; \
  const Params q = fresh(p);
__global__ void __launch_bounds__(NTHR) mega(Params p) {
  extern __shared__ __attribute__((aligned(16))) unsigned char lds_raw[];
  cg::grid_group grid = cg::this_grid();
  float* ldsf = (float*)lds_raw;
  if (threadIdx.x == 0) { *(uint4*)(lds_raw + LDS_BYTES - 16) = make_uint4(0u, 0u, 0u, 0u); }
  __syncthreads();
  XcdBarrier xb = xcd_barrier_post(p.bar(), (volatile LAS unsigned*)(lds_raw + LDS_BYTES - 16));

  { PHASE_IDS; phase_prologue(q, gtid, ngt, gw, ngw, lane); cvt_f32_bf16(q.inp(18), q.skb(), (size_t)NL * 16 * 128 * 64 / 8, gtid, ngt);
    for (size_t i = gtid; i < (size_t)16 * 128 * 512 / 8; i += ngt) { const size_t g = i / (128 * 512 / 8), r = i % (128 * 512 / 8); ((uint4*)q.S5Wz())[g * (256 * 512 / 8) + (128 * 512 / 8) + r] = make_uint4(0u, 0u, 0u, 0u); }
    if (gtid < 256) q.qctr()[gtid] = 0;
    phase_s5_prep(q, 0, gtid, ngt); }
  grid.sync();
  { constexpr int l = 0;
    DUP(5) {
    { const Params q = fresh(p); EpiScaleStoreBf16 e{q.projb(), INW, q.ssq1(), 8, nullptr};
      run_gemm(lds_raw, q.xb(), q.Win_t() + (size_t)l * INW * KD, T, INW, KD, e); }
    xcd_barrier(xb);
    }
    DUP(0) {
    { PHASE_IDS; phase_post_pack(q, l, gtid, ngt, gw, ngw, lane); phase_pack_u(q, gtid, ngt); }
    xcd_barrier(xb);
    }
    DUP(1) {
    { const Params q = fresh(p); EpiS5Z e{q.S5Z()};
      pg8::Gemm g{q.S5A(), q.S5Wz(), 16 * 1024, 16 * 256, 512, 640, 512}; pg8::GroupOrder So; So.init(16, 4, 1, (int)gridDim.x, (int)blockIdx.x);
      pg8::gemm_phase<EpiS5Z, pg8::GroupOrder, true, true>((PG8_LAS unsigned char*)lds_raw, g, So, e); }
    { PHASE_IDS; phase_kmean2(q, gtid, ngt); phase_ret_kv(q, gw, ngw, lane); }
    xcd_barrier(xb);
    }
    DUP(2) {
    { PHASE_IDS; phase_s5_scan(q, gtid, ngt); phase_ret_scan(q, gtid, ngt); }
    __syncthreads();
    { PHASE_IDS; phase_moba2(q, l, lds_raw, bid, G); }
    xcd_barrier(xb);
    }
    DUP(3) {
    { const Params q = fresh(p); EpiS5Y e{q.ygb(), q.S5A(), q.inp(10) + l * 256};
      pg8::Gemm g{q.S5A(), q.S5Wy(), 16 * 1024, 16 * 512, 640, 640, 640}; pg8::GroupOrder So; So.init(16, 4, 2, (int)gridDim.x, (int)blockIdx.x);
      pg8::gemm_phase<EpiS5Y, pg8::GroupOrder, true, true>((PG8_LAS unsigned char*)lds_raw, g, So, e); }
    __syncthreads();
    { PHASE_IDS; phase_ret_out(q, gw, ngw, lane); }
    xcd_barrier(xb);
    }
    DUP(4) {
    { const Params q = fresh(p); EpiGlu e{q.xb(), q.ygb(), (float*)(lds_raw + 131072)};
      run_gemm(lds_raw, q.ygb(), q.Wglu_t() + (size_t)l * 65536, T, 256, 256, e); }
    xcd_barrier(xb);
    }
    { PHASE_IDS; cvt_table_fp8(q.inp(19) + (size_t)l * 16384 * D, q.U8s(), q.su(), gw, ngw, lane);
      cvt_table_fp8(q.inp(20) + (size_t)l * 16384 * D, q.V8s(), q.sv(), gw, ngw, lane); }
    __syncthreads();
    { const Params q = fresh(p); EpiResid e{q.outp(), D, q.xb2(), q.hb(), q.inp(16) + l * D, q.ssq2()};
      run_gemm(lds_raw, q.xb(), q.Wout_t() + (size_t)l * D * KD, T, D, KD, e); }
    xcd_barrier(xb);
    DUP(7) {
    { const Params q = fresh(p); EpiScaleStoreBf16 e{q.qb(), D, q.ssq2(), 16, q.rstd()};
      run_gemm(lds_raw, q.xb2(), q.Wq_t() + (size_t)l * D * KD, T, D, KD, e); }
    xcd_barrier(xb);
    }
    if (!(PROBE_SKIP & 2)) {
    DUP(8) {
    { PHASE_IDS; phase_peer_topk(q, l, gw, ngw, lane); }
    xcd_barrier(xb);
    }
    }
#if PEER_CHECK
    if (l == 0) { { PHASE_IDS; chk_save(q, gtid, ngt); } xcd_barrier(xb); { PHASE_IDS; chk_topk(q, l, gtid, ngt); } xcd_barrier(xb); }
#endif
    if (!(PROBE_SKIP & 1)) {
    { PHASE_IDS; phase_peer_u(q, q.qctr() + (l * 2 + 0) * 8, lds_raw, tid); }
    xcd_barrier(xb);
    { PHASE_IDS; phase_peer_r(q, gtid, ngt); if (l + 1 < NL) phase_s5_prep(q, l + 1, gtid, ngt); }
    xcd_barrier(xb);
    if (!(PROBE_SKIP & 32)) {
    { PHASE_IDS; phase_peer_v(q, q.qctr() + (l * 2 + 1) * 8, lds_raw, tid); }
    xcd_barrier(xb);
    }
    }
#if PEER_CHECK
    if (l == 0) { { PHASE_IDS; chk_apply(q, l, ldsf + wv * 128, gw, ngw, lane); } xcd_barrier(xb);
      if (blockIdx.x == 0 && threadIdx.x == 0) { const Params q = fresh(p); chk_emit(q); } xcd_barrier(xb); }
#endif
  }
  { constexpr int l = 1;
    DUP(5) {
    { const Params q = fresh(p); EpiScaleStoreBf16 e{q.projb(), INW, q.ssq1(), 8, nullptr};
      run_gemm(lds_raw, q.xb(), q.Win_t() + (size_t)l * INW * KD, T, INW, KD, e); }
    xcd_barrier(xb);
    }
    DUP(0) {
    { PHASE_IDS; phase_post_pack(q, l, gtid, ngt, gw, ngw, lane); phase_pack_u(q, gtid, ngt); }
    xcd_barrier(xb);
    }
    DUP(1) {
    { const Params q = fresh(p); EpiS5Z e{q.S5Z()};
      pg8::Gemm g{q.S5A(), q.S5Wz(), 16 * 1024, 16 * 256, 512, 640, 512}; pg8::GroupOrder So; So.init(16, 4, 1, (int)gridDim.x, (int)blockIdx.x);
      pg8::gemm_phase<EpiS5Z, pg8::GroupOrder, true, true>((PG8_LAS unsigned char*)lds_raw, g, So, e); }
    { PHASE_IDS; phase_kmean2(q, gtid, ngt); phase_ret_kv(q, gw, ngw, lane); }
    xcd_barrier(xb);
    }
    DUP(2) {
    { PHASE_IDS; phase_s5_scan(q, gtid, ngt); phase_ret_scan(q, gtid, ngt); }
    __syncthreads();
    { PHASE_IDS; phase_moba2(q, l, lds_raw, bid, G); }
    xcd_barrier(xb);
    }
    DUP(3) {
    { const Params q = fresh(p); EpiS5Y e{q.ygb(), q.S5A(), q.inp(10) + l * 256};
      pg8::Gemm g{q.S5A(), q.S5Wy(), 16 * 1024, 16 * 512, 640, 640, 640}; pg8::GroupOrder So; So.init(16, 4, 2, (int)gridDim.x, (int)blockIdx.x);
      pg8::gemm_phase<EpiS5Y, pg8::GroupOrder, true, true>((PG8_LAS unsigned char*)lds_raw, g, So, e); }
    __syncthreads();
    { PHASE_IDS; phase_ret_out(q, gw, ngw, lane); }
    xcd_barrier(xb);
    }
    DUP(4) {
    { const Params q = fresh(p); EpiGlu e{q.xb(), q.ygb(), (float*)(lds_raw + 131072)};
      run_gemm(lds_raw, q.ygb(), q.Wglu_t() + (size_t)l * 65536, T, 256, 256, e); }
    xcd_barrier(xb);
    }
    { PHASE_IDS; cvt_table_fp8(q.inp(19) + (size_t)l * 16384 * D, q.U8s(), q.su(), gw, ngw, lane);
      cvt_table_fp8(q.inp(20) + (size_t)l * 16384 * D, q.V8s(), q.sv(), gw, ngw, lane); }
    __syncthreads();
    { const Params q = fresh(p); EpiResid e{q.outp(), D, q.xb2(), q.hb(), q.inp(16) + l * D, q.ssq2()};
      run_gemm(lds_raw, q.xb(), q.Wout_t() + (size_t)l * D * KD, T, D, KD, e); }
    xcd_barrier(xb);
    DUP(7) {
    { const Params q = fresh(p); EpiScaleStoreBf16 e{q.qb(), D, q.ssq2(), 16, q.rstd()};
      run_gemm(lds_raw, q.xb2(), q.Wq_t() + (size_t)l * D * KD, T, D, KD, e); }
    xcd_barrier(xb);
    }
    if (!(PROBE_SKIP & 2)) {
    DUP(8) {
    { PHASE_IDS; phase_peer_topk(q, l, gw, ngw, lane); }
    xcd_barrier(xb);
    }
    }
#if PEER_CHECK
    if (l == 0) { { PHASE_IDS; chk_save(q, gtid, ngt); } xcd_barrier(xb); { PHASE_IDS; chk_topk(q, l, gtid, ngt); } xcd_barrier(xb); }
#endif
    if (!(PROBE_SKIP & 1)) {
    { PHASE_IDS; phase_peer_u(q, q.qctr() + (l * 2 + 0) * 8, lds_raw, tid); }
    xcd_barrier(xb);
    { PHASE_IDS; phase_peer_r(q, gtid, ngt); if (l + 1 < NL) phase_s5_prep(q, l + 1, gtid, ngt); }
    xcd_barrier(xb);
    if (!(PROBE_SKIP & 32)) {
    { PHASE_IDS; phase_peer_v(q, q.qctr() + (l * 2 + 1) * 8, lds_raw, tid); }
    xcd_barrier(xb);
    }
    }
#if PEER_CHECK
    if (l == 0) { { PHASE_IDS; chk_apply(q, l, ldsf + wv * 128, gw, ngw, lane); } xcd_barrier(xb);
      if (blockIdx.x == 0 && threadIdx.x == 0) { const Params q = fresh(p); chk_emit(q); } xcd_barrier(xb); }
#endif
  }
  { constexpr int l = 2;
    DUP(5) {
    { const Params q = fresh(p); EpiScaleStoreBf16 e{q.projb(), INW, q.ssq1(), 8, nullptr};
      run_gemm(lds_raw, q.xb(), q.Win_t() + (size_t)l * INW * KD, T, INW, KD, e); }
    xcd_barrier(xb);
    }
    DUP(0) {
    { PHASE_IDS; phase_post_pack(q, l, gtid, ngt, gw, ngw, lane); phase_pack_u(q, gtid, ngt); }
    xcd_barrier(xb);
    }
    DUP(1) {
    { const Params q = fresh(p); EpiS5Z e{q.S5Z()};
      pg8::Gemm g{q.S5A(), q.S5Wz(), 16 * 1024, 16 * 256, 512, 640, 512}; pg8::GroupOrder So; So.init(16, 4, 1, (int)gridDim.x, (int)blockIdx.x);
      pg8::gemm_phase<EpiS5Z, pg8::GroupOrder, true, true>((PG8_LAS unsigned char*)lds_raw, g, So, e); }
    { PHASE_IDS; phase_kmean2(q, gtid, ngt); phase_ret_kv(q, gw, ngw, lane); }
    xcd_barrier(xb);
    }
    DUP(2) {
    { PHASE_IDS; phase_s5_scan(q, gtid, ngt); phase_ret_scan(q, gtid, ngt); }
    __syncthreads();
    { PHASE_IDS; phase_moba2(q, l, lds_raw, bid, G); }
    xcd_barrier(xb);
    }
    DUP(3) {
    { const Params q = fresh(p); EpiS5Y e{q.ygb(), q.S5A(), q.inp(10) + l * 256};
      pg8::Gemm g{q.S5A(), q.S5Wy(), 16 * 1024, 16 * 512, 640, 640, 640}; pg8::GroupOrder So; So.init(16, 4, 2, (int)gridDim.x, (int)blockIdx.x);
      pg8::gemm_phase<EpiS5Y, pg8::GroupOrder, true, true>((PG8_LAS unsigned char*)lds_raw, g, So, e); }
    __syncthreads();
    { PHASE_IDS; phase_ret_out(q, gw, ngw, lane); }
    xcd_barrier(xb);
    }
    DUP(4) {
    { const Params q = fresh(p); EpiGlu e{q.xb(), q.ygb(), (float*)(lds_raw + 131072)};
      run_gemm(lds_raw, q.ygb(), q.Wglu_t() + (size_t)l * 65536, T, 256, 256, e); }
    xcd_barrier(xb);
    }
    { PHASE_IDS; cvt_table_fp8(q.inp(19) + (size_t)l * 16384 * D, q.U8s(), q.su(), gw, ngw, lane);
      cvt_table_fp8(q.inp(20) + (size_t)l * 16384 * D, q.V8s(), q.sv(), gw, ngw, lane); }
    __syncthreads();
    { const Params q = fresh(p); EpiResid e{q.outp(), D, q.xb2(), q.hb(), q.inp(16) + l * D, q.ssq2()};
      run_gemm(lds_raw, q.xb(), q.Wout_t() + (size_t)l * D * KD, T, D, KD, e); }
    xcd_barrier(xb);
    DUP(7) {
    { const Params q = fresh(p); EpiScaleStoreBf16 e{q.qb(), D, q.ssq2(), 16, q.rstd()};
      run_gemm(lds_raw, q.xb2(), q.Wq_t() + (size_t)l * D * KD, T, D, KD, e); }
    xcd_barrier(xb);
    }
    if (!(PROBE_SKIP & 2)) {
    DUP(8) {
    { PHASE_IDS; phase_peer_topk(q, l, gw, ngw, lane); }
    xcd_barrier(xb);
    }
    }
#if PEER_CHECK
    if (l == 0) { { PHASE_IDS; chk_save(q, gtid, ngt); } xcd_barrier(xb); { PHASE_IDS; chk_topk(q, l, gtid, ngt); } xcd_barrier(xb); }
#endif
    if (!(PROBE_SKIP & 1)) {
    { PHASE_IDS; phase_peer_u(q, q.qctr() + (l * 2 + 0) * 8, lds_raw, tid); }
    xcd_barrier(xb);
    { PHASE_IDS; phase_peer_r(q, gtid, ngt); if (l + 1 < NL) phase_s5_prep(q, l + 1, gtid, ngt); }
    xcd_barrier(xb);
    if (!(PROBE_SKIP & 32)) {
    { PHASE_IDS; phase_peer_v(q, q.qctr() + (l * 2 + 1) * 8, lds_raw, tid); }
    xcd_barrier(xb);
    }
    }
#if PEER_CHECK
    if (l == 0) { { PHASE_IDS; chk_apply(q, l, ldsf + wv * 128, gw, ngw, lane); } xcd_barrier(xb);
      if (blockIdx.x == 0 && threadIdx.x == 0) { const Params q = fresh(p); chk_emit(q); } xcd_barrier(xb); }
#endif
  }
  { constexpr int l = 3;
    DUP(5) {
    { const Params q = fresh(p); EpiScaleStoreBf16 e{q.projb(), INW, q.ssq1(), 8, nullptr};
      run_gemm(lds_raw, q.xb(), q.Win_t() + (size_t)l * INW * KD, T, INW, KD, e); }
    xcd_barrier(xb);
    }
    DUP(0) {
    { PHASE_IDS; phase_post_pack(q, l, gtid, ngt, gw, ngw, lane); phase_pack_u(q, gtid, ngt); }
    xcd_barrier(xb);
    }
    DUP(1) {
    { const Params q = fresh(p); EpiS5Z e{q.S5Z()};
      pg8::Gemm g{q.S5A(), q.S5Wz(), 16 * 1024, 16 * 256, 512, 640, 512}; pg8::GroupOrder So; So.init(16, 4, 1, (int)gridDim.x, (int)blockIdx.x);
      pg8::gemm_phase<EpiS5Z, pg8::GroupOrder, true, true>((PG8_LAS unsigned char*)lds_raw, g, So, e); }
    { PHASE_IDS; phase_kmean2(q, gtid, ngt); phase_ret_kv(q, gw, ngw, lane); }
    xcd_barrier(xb);
    }
    DUP(2) {
    { PHASE_IDS; phase_s5_scan(q, gtid, ngt); phase_ret_scan(q, gtid, ngt); }
    __syncthreads();
    { PHASE_IDS; phase_moba2(q, l, lds_raw, bid, G); }
    xcd_barrier(xb);
    }
    DUP(3) {
    { const Params q = fresh(p); EpiS5Y e{q.ygb(), q.S5A(), q.inp(10) + l * 256};
      pg8::Gemm g{q.S5A(), q.S5Wy(), 16 * 1024, 16 * 512, 640, 640, 640}; pg8::GroupOrder So; So.init(16, 4, 2, (int)gridDim.x, (int)blockIdx.x);
      pg8::gemm_phase<EpiS5Y, pg8::GroupOrder, true, true>((PG8_LAS unsigned char*)lds_raw, g, So, e); }
    __syncthreads();
    { PHASE_IDS; phase_ret_out(q, gw, ngw, lane); }
    xcd_barrier(xb);
    }
    DUP(4) {
    { const Params q = fresh(p); EpiGlu e{q.xb(), q.ygb(), (float*)(lds_raw + 131072)};
      run_gemm(lds_raw, q.ygb(), q.Wglu_t() + (size_t)l * 65536, T, 256, 256, e); }
    xcd_barrier(xb);
    }
    { PHASE_IDS; cvt_table_fp8(q.inp(19) + (size_t)l * 16384 * D, q.U8s(), q.su(), gw, ngw, lane);
      cvt_table_fp8(q.inp(20) + (size_t)l * 16384 * D, q.V8s(), q.sv(), gw, ngw, lane); }
    __syncthreads();
    { const Params q = fresh(p); EpiResid e{q.outp(), D, q.xb2(), q.hb(), q.inp(16) + l * D, q.ssq2()};
      run_gemm(lds_raw, q.xb(), q.Wout_t() + (size_t)l * D * KD, T, D, KD, e); }
    xcd_barrier(xb);
    DUP(7) {
    { const Params q = fresh(p); EpiScaleStoreBf16 e{q.qb(), D, q.ssq2(), 16, q.rstd()};
      run_gemm(lds_raw, q.xb2(), q.Wq_t() + (size_t)l * D * KD, T, D, KD, e); }
    xcd_barrier(xb);
    }
    if (!(PROBE_SKIP & 2)) {
    DUP(8) {
    { PHASE_IDS; phase_peer_topk(q, l, gw, ngw, lane); }
    xcd_barrier(xb);
    }
    }
#if PEER_CHECK
    if (l == 0) { { PHASE_IDS; chk_save(q, gtid, ngt); } xcd_barrier(xb); { PHASE_IDS; chk_topk(q, l, gtid, ngt); } xcd_barrier(xb); }
#endif
    if (!(PROBE_SKIP & 1)) {
    { PHASE_IDS; phase_peer_u(q, q.qctr() + (l * 2 + 0) * 8, lds_raw, tid); }
    xcd_barrier(xb);
    { PHASE_IDS; phase_peer_r(q, gtid, ngt); if (l + 1 < NL) phase_s5_prep(q, l + 1, gtid, ngt); }
    xcd_barrier(xb);
    if (!(PROBE_SKIP & 32)) {
    { PHASE_IDS; phase_peer_v(q, q.qctr() + (l * 2 + 1) * 8, lds_raw, tid); }
    xcd_barrier(xb);
    }
    }
#if PEER_CHECK
    if (l == 0) { { PHASE_IDS; chk_apply(q, l, ldsf + wv * 128, gw, ngw, lane); } xcd_barrier(xb);
      if (blockIdx.x == 0 && threadIdx.x == 0) { const Params q = fresh(p); chk_emit(q); } xcd_barrier(xb); }
#endif
  }
}

}

extern "C" void kernel_launch(void* const* d_in, const int* in_sizes, int n_in, void* d_out, int out_size, void* d_ws, size_t ws_size,
                              hipStream_t stream) {
  static int grid_blocks = 0;
  if (!grid_blocks) {
    int dev = 0, cus = 0, per_cu = 0;
    hipGetDevice(&dev);
    hipDeviceGetAttribute(&cus, hipDeviceAttributeMultiprocessorCount, dev);
    hipFuncSetAttribute((const void*)mega, hipFuncAttributeMaxDynamicSharedMemorySize, LDS_BYTES);
    hipOccupancyMaxActiveBlocksPerMultiprocessor(&per_cu, (const void*)mega, NTHR, LDS_BYTES);
    if (per_cu < 1) { fprintf(stderr, "occupancy query returned %d\n", per_cu); per_cu = 1; }
    grid_blocks = cus * 1;
    if (grid_blocks < 64) fprintf(stderr, "unexpected CU count %d\n", cus);
  }
  Params p{};
  for (int i = 0; i < 21; ++i) p.in[i] = (const GAS float*)d_in[i];
  p.out_ = (GAS float*)d_out;
  p.ws = (GAS unsigned char*)d_ws;
  if (WS_TOTAL > ws_size) { fprintf(stderr, "workspace too small: need %zu have %zu\n", (size_t)WS_TOTAL, ws_size); return; }
  hipMemsetAsync((unsigned char*)d_ws + WO_bar, 0, 16384, stream);
  void* args[] = {&p};
  hipError_t e = hipLaunchCooperativeKernel((const void*)mega, dim3(grid_blocks), dim3(NTHR), args, LDS_BYTES, stream);
  if (e != hipSuccess) fprintf(stderr, "cooperative launch failed: %s (grid %d)\n", hipGetErrorString(e), grid_blocks);
}
```

```cpp
#include <hip/hip_runtime.h>
#include <hip/hip_cooperative_groups.h>
#include <math.h>
#include <stdint.h>
#include <stdio.h>
namespace cg = cooperative_groups;

#ifndef PEER_CHECK
#define PEER_CHECK 0
#endif
#ifndef PROBE_DUP
#define PROBE_DUP 0
#endif
__device__ __forceinline__ int dup_n(int n) { asm volatile("" : "+s"(n)); return n; }
#define DUP(bit) _Pragma("unroll 1") for (int rep_ = 0, repn_ = (((PROBE_DUP >> (bit)) & 1) ? dup_n(2) : 1); rep_ < repn_; ++rep_)
#ifndef PROBE_SKIP
#define PROBE_SKIP 0
#endif
#ifndef PRECISE
#define PRECISE 0
#endif

namespace {
constexpr int NB = 8, S = 4096, D = 1024, NL = 4, T = NB * S;
constexpr int INW = 2816;
constexpr int OFF_U = 0, OFF_QM = 256, OFF_KM = 768, OFF_VM = 1280, OFF_QR = 1792, OFF_KR = 2048, OFF_VR = 2304, OFF_GR = 2560;
constexpr float EPS = 1e-6f;
static_assert(PRECISE == 0, "PRECISE builds are retired");
constexpr int KS = PRECISE ? 3 : 1;
constexpr int KD = D * KS;
constexpr int NTHR = 512, NWAVE = 8;
constexpr int LDS_BYTES = 131072 + 4096 + 1024;

typedef unsigned short bf16_t;
using bf16x8 = __attribute__((ext_vector_type(8))) short;
using f32x4 = __attribute__((ext_vector_type(4))) float;

__device__ __forceinline__ float wave_sum(float v) {
#pragma unroll
  for (int o = 32; o > 0; o >>= 1) v += __shfl_xor(v, o);
  return v;
}
__device__ __forceinline__ float wave_max(float v) {
#pragma unroll
  for (int o = 32; o > 0; o >>= 1) v = fmaxf(v, __shfl_xor(v, o));
  return v;
}
__device__ __forceinline__ float gelu_tanh(float x) {
  const float k0 = 0.7978845608028654f, k1 = 0.044715f;
  float u = k0 * (x + k1 * x * x * x);
  return 0.5f * x * (1.0f + tanhf(u));
}
__device__ __forceinline__ float sigmoidf_(float x) { return 1.0f / (1.0f + expf(-x)); }
__device__ __forceinline__ float fast_sigmoid(float x) { return __builtin_amdgcn_rcpf(1.0f + __builtin_amdgcn_exp2f(-1.4426950408889634f * x)); }
__device__ __forceinline__ float fast_gelu(float x) { const float u = 0.7978845608028654f * (x + 0.044715f * x * x * x); return x * fast_sigmoid(2.0f * u); }
__device__ __forceinline__ bf16_t f2bf(float f) {
  unsigned u = __float_as_uint(f);
  u += 0x7fffu + ((u >> 16) & 1u);
  return (bf16_t)(u >> 16);
}
__device__ __forceinline__ float bf2f(bf16_t h) { return __uint_as_float(((unsigned)h) << 16); }
#define LDS_FENCE() asm volatile("s_waitcnt lgkmcnt(0)" ::: "memory")
typedef __bf16 bf16x2_hw __attribute__((ext_vector_type(2)));
typedef float f32x2_hw __attribute__((ext_vector_type(2)));
__device__ __forceinline__ unsigned pk_bf16(float lo, float hi) { const f32x2_hw f = {lo, hi}; const bf16x2_hw b = __builtin_convertvector(f, bf16x2_hw); return __builtin_bit_cast(unsigned, b); }
typedef float f32x16 __attribute__((ext_vector_type(16)));

constexpr size_t al256(size_t x) { return (x + 255) & ~(size_t)255; }
constexpr size_t WO_rstd = 0;
constexpr size_t WO_cosm = WO_rstd + al256((size_t)T * 4);
constexpr size_t WO_sinm = WO_cosm + al256((size_t)S * 8 * 4);
constexpr size_t WO_cosr = WO_sinm + al256((size_t)S * 8 * 4);
constexpr size_t WO_sinr = WO_cosr + al256((size_t)S * 32 * 4);
constexpr size_t WO_kmean = WO_sinr + al256((size_t)S * 32 * 4);
constexpr size_t WO_proj = WO_kmean + al256((size_t)NB * 8 * 16 * 64 * 4);
constexpr size_t WO_ybuf = WO_proj + al256((size_t)T * INW * 4);
constexpr size_t WO_yg = WO_ybuf + al256((size_t)T * D * 4);
constexpr size_t WO_skb = WO_yg + al256((size_t)T * 256 * 4);
constexpr size_t WO_Ub = WO_skb + al256((size_t)NL * 16 * 128 * 64 * 2);
constexpr size_t WO_Vb = WO_Ub + al256((size_t)16384 * D * 2);
constexpr size_t WO_gates = WO_Vb + al256((size_t)16384 * D * 2);
constexpr size_t WO_eidx = WO_gates + al256((size_t)T * 128 * 4);
constexpr size_t WO_xb = WO_eidx + al256((size_t)T * 128 * 4);
constexpr size_t WO_Win_t = WO_xb + al256((size_t)T * KD * 2);
constexpr size_t WO_Wout_t = WO_Win_t + al256((size_t)NL * INW * KD * 2);
constexpr size_t WO_Wq_t = WO_Wout_t + al256((size_t)NL * D * KD * 2);
constexpr size_t WO_Qm = WO_Wq_t + al256((size_t)NL * D * KD * 2);
constexpr size_t WO_Km = WO_Qm + al256((size_t)T * 512 * 2);
constexpr size_t WO_Vm = WO_Km + al256((size_t)T * 512 * 2);
constexpr size_t WO_S5a32 = WO_Vm + al256((size_t)T * 512 * 2);
constexpr size_t WO_Wglu_t = WO_S5a32 + al256((size_t)16 * 64 * 2 * 4);
constexpr size_t WO_Qr = WO_Wglu_t + al256((size_t)NL * 256 * 256 * 2);
constexpr size_t WO_Kr = WO_Qr + al256((size_t)T * 256 * 2);
constexpr size_t WO_Krv = WO_Kr + al256((size_t)T * 256 * 2);
constexpr size_t WO_Vr = WO_Krv + al256((size_t)T * 256 * 2);
constexpr size_t WO_KVr = WO_Vr + al256((size_t)T * 256 * 2);
constexpr size_t WO_Rb = WO_KVr + al256((size_t)32 * 32 * 4096 * 4);
constexpr size_t WO_qctr = WO_Rb + al256((size_t)32 * 32 * 4096 * 2);
constexpr size_t WO_bar = WO_qctr + al256(1024);
constexpr size_t WO_S5Wy = WO_bar + al256(16384);
constexpr size_t WO_S5Wz = WO_S5Wy + al256((size_t)16 * 512 * 640 * 2);
constexpr size_t WO_ssq1 = WO_S5Wz + al256((size_t)16 * 256 * 512 * 2);
constexpr size_t WO_ssq2 = WO_ssq1 + al256((size_t)T * 8 * 4);
constexpr size_t WS_TOTAL = WO_ssq2 + al256((size_t)T * 16 * 4);
constexpr size_t WO_S5A = WO_gates;
constexpr size_t WO_S5Z = WO_S5A + al256((size_t)16 * 1024 * 640 * 2);
static_assert(WO_S5Z + (size_t)16 * 1024 * 128 * 4 <= WO_gates + 2 * al256((size_t)T * 128 * 4), "S5A/S5Z must fit in gates+eidx");
#define GAS __attribute__((address_space(1)))
static_assert((size_t)T * D * 2 + (size_t)T * 128 * 8 * 4 + (size_t)T * D * 2 <= (size_t)T * INW * 4, "qb + ppart + xb2 must fit in the proj region");
struct Params {
  const GAS float* in[21];
  GAS float* out_;
  GAS unsigned char* ws;
  __device__ __forceinline__ const float* inp(int i) const { return (const float*)in[i]; }
  __device__ __forceinline__ float* outp() const { return (float*)out_; }
  __device__ __forceinline__ float* rstd() const { return (float*)(ws + WO_rstd); }
  __device__ __forceinline__ float* cosm() const { return (float*)(ws + WO_cosm); }
  __device__ __forceinline__ float* sinm() const { return (float*)(ws + WO_sinm); }
  __device__ __forceinline__ float* cosr() const { return (float*)(ws + WO_cosr); }
  __device__ __forceinline__ float* sinr() const { return (float*)(ws + WO_sinr); }
  __device__ __forceinline__ float* kmean() const { return (float*)(ws + WO_kmean); }
  __device__ __forceinline__ float* proj() const { return (float*)(ws + WO_proj); }
  __device__ __forceinline__ float* ybuf() const { return (float*)(ws + WO_ybuf); }
  __device__ __forceinline__ float* yg() const { return (float*)(ws + WO_yg); }
  __device__ __forceinline__ bf16_t* skb() const { return (bf16_t*)(ws + WO_skb); }
  __device__ __forceinline__ bf16_t* Ub() const { return (bf16_t*)(ws + WO_Ub); }
  __device__ __forceinline__ bf16_t* Vb() const { return (bf16_t*)(ws + WO_Vb); }
  __device__ __forceinline__ float* gates() const { return (float*)(ws + WO_gates); }
  __device__ __forceinline__ int* eidx() const { return (int*)(ws + WO_eidx); }
  __device__ __forceinline__ bf16_t* xb() const { return (bf16_t*)(ws + WO_xb); }
  __device__ __forceinline__ bf16_t* Win_t() const { return (bf16_t*)(ws + WO_Win_t); }
  __device__ __forceinline__ bf16_t* Wout_t() const { return (bf16_t*)(ws + WO_Wout_t); }
  __device__ __forceinline__ bf16_t* Wq_t() const { return (bf16_t*)(ws + WO_Wq_t); }
  __device__ __forceinline__ bf16_t* Qm() const { return (bf16_t*)(ws + WO_Qm); }
  __device__ __forceinline__ bf16_t* Km() const { return (bf16_t*)(ws + WO_Km); }
  __device__ __forceinline__ bf16_t* Vm() const { return (bf16_t*)(ws + WO_Vm); }
  __device__ __forceinline__ bf16_t* S5A() const { return (bf16_t*)(ws + WO_S5A); }
  __device__ __forceinline__ bf16_t* S5Wy() const { return (bf16_t*)(ws + WO_S5Wy); }
  __device__ __forceinline__ bf16_t* S5Wz() const { return (bf16_t*)(ws + WO_S5Wz); }
  __device__ __forceinline__ float* S5Z() const { return (float*)(ws + WO_S5Z); }
  __device__ __forceinline__ float* S5a32() const { return (float*)(ws + WO_S5a32); }
  __device__ __forceinline__ bf16_t* Wglu_t() const { return (bf16_t*)(ws + WO_Wglu_t); }
  __device__ __forceinline__ bf16_t* ygb() const { return (bf16_t*)(ws + WO_yg); }
  __device__ __forceinline__ int* qctr() const { return (int*)(ws + WO_qctr); }
  __device__ __forceinline__ unsigned char* U8s() const { return (unsigned char*)(ws + WO_Ub); }
  __device__ __forceinline__ float* su() const { return (float*)(ws + WO_Ub + (size_t)16384 * D); }
  __device__ __forceinline__ unsigned char* V8s() const { return (unsigned char*)(ws + WO_Vb); }
  __device__ __forceinline__ float* sv() const { return (float*)(ws + WO_Vb + (size_t)16384 * D); }
  __device__ __forceinline__ bf16_t* hb() const { return (bf16_t*)(ws + WO_ybuf + ((size_t)4 << 20)); }
  __device__ __forceinline__ float* ppart() const { return (float*)(ws + WO_proj + (size_t)T * D * 2); }
  __device__ __forceinline__ bf16_t* Qr() const { return (bf16_t*)(ws + WO_Qr); }
  __device__ __forceinline__ bf16_t* Kr() const { return (bf16_t*)(ws + WO_Kr); }
  __device__ __forceinline__ bf16_t* Krv() const { return (bf16_t*)(ws + WO_Krv); }
  __device__ __forceinline__ bf16_t* Vr() const { return (bf16_t*)(ws + WO_Vr); }
  __device__ __forceinline__ float* KVr() const { return (float*)(ws + WO_KVr); }
  __device__ __forceinline__ bf16_t* Rb() const { return (bf16_t*)(ws + WO_Rb); }
  __device__ __forceinline__ unsigned* bar() const { return (unsigned*)(ws + WO_bar); }
  __device__ __forceinline__ bf16_t* projb() const { return (bf16_t*)(ws + WO_proj); }
  __device__ __forceinline__ float* ssq1() const { return (float*)(ws + WO_ssq1); }
  __device__ __forceinline__ float* ssq2() const { return (float*)(ws + WO_ssq2); }
  __device__ __forceinline__ bf16_t* xb2() const { return (bf16_t*)(ws + WO_proj + (size_t)T * D * 2 + (size_t)T * 128 * 8 * 4); }
  __device__ __forceinline__ bf16_t* qb() const { return (bf16_t*)(ws + WO_proj); }
};

namespace pg8 {
#define PG8_LAS __attribute__((address_space(3)))
typedef unsigned short bf16_t;
typedef short bf16x8 __attribute__((ext_vector_type(8)));
typedef float f32x4 __attribute__((ext_vector_type(4)));
typedef unsigned u32x4 __attribute__((ext_vector_type(4)));
constexpr int BM = 256, BK = 64, HALF = 128, HTB = HALF * BK * 2  , STAGE_BYTES = 8 * HTB, NXCD = 8, WGM = 8;

__host__ __device__ __forceinline__ int lds_byte(int r, int c) { const int st = (r >> 4) * 2 + (c >> 5), rr = r & 15, cc = c & 31, ob = rr * 64 + cc * 2; return st * 1024 + (ob ^ (((ob >> 9) & 1) << 5)); }
__host__ __device__ __forceinline__ void stage_rc(int b, int& R, int& C) { const int st = b / 1024, sb = b % 1024, swz = sb ^ (((sb >> 9) & 1) << 5); R = (st >> 1) * 16 + swz / 64; C = (st & 1) * 32 + (swz % 64) / 2; }
__host__ __device__ __forceinline__ int perm32(int rho) { const int n = rho >> 4, i = rho & 15; return 8 * (i >> 2) + 4 * n + (i & 3); }

struct Unit { int pm, pn; };
struct Gemm { const bf16_t* A; const bf16_t* Bt; int M, N, K, lda, ldb; };

struct StaticOrder {
    int nM, nN, nwg, G, c;
    __host__ __device__ void init(int M, int N, int G_, int c_) { nM = M / BM; nN = N / BM; nwg = nM * nN; G = G_; c = c_; }
    __host__ __device__ bool next(int i, Unit& u) const {
        const long L = (long)i * G + c; if (L >= nwg) return false;
        int wgid = (int)L; { const int q = nwg / NXCD, r = nwg % NXCD, xcd = wgid % NXCD, off = wgid / NXCD; wgid = (xcd < r ? xcd * (q + 1) : r * (q + 1) + (xcd - r) * q) + off; }
        const int nig = WGM * nN, gid = wgid / nig, fm = gid * WGM, gsz = (nM - fm) < WGM ? (nM - fm) : WGM;
        u.pm = fm + ((wgid % nig) % gsz); u.pn = (wgid % nig) / gsz; return true;
    }
    __device__ __forceinline__ void a_ready(const Unit&) const {}
    __device__ __forceinline__ void done(const Unit&) const {}
};
struct GroupOrder {
    int mt, nt_, nwg, G, c;
    __host__ __device__ void init(int ngroups, int mt__, int nt__, int G_, int c_) { mt = mt__; nt_ = nt__; nwg = ngroups * mt * nt_; G = G_; c = c_; }
    __host__ __device__ bool next(int i, Unit& u) const {
        const long L = (long)i * G + c; if (L >= nwg) return false;
        const int per = mt * nt_, gi = (int)L / per, r = (int)L % per;
        u.pm = gi * mt + r % mt; u.pn = gi * nt_ + r / mt; return true;
    }
    __device__ __forceinline__ void a_ready(const Unit&) const {}
    __device__ __forceinline__ void done(const Unit&) const {}
};
template <class Epi, class Sched, bool ALIGN_EPI = false, bool SP2 = false>
__device__ __forceinline__ void gemm_phase(PG8_LAS unsigned char* lds, const Gemm g, const Sched& S, const Epi& E) {
    int tid_ = threadIdx.x; asm volatile("" : "+v"(tid_));
    const int tid = tid_, wid = __builtin_amdgcn_readfirstlane(tid >> 6), lane = tid & 63, wr = wid >> 2, wc = wid & 3, fr = lane & 15, fq = lane >> 4;
    const int K = g.K, nt = K / BK;
    unsigned voffA[2], voffB[2];
#pragma unroll
    for (int i = 0; i < 2; ++i) { int R, C; stage_rc(tid * 16 + i * 8192, R, C); const int Rb = Epi::PERM ? ((R & ~31) + perm32(R & 31)) : R;
        voffA[i] = (unsigned)(R * g.lda + C) * 2u; voffB[i] = (unsigned)(Rb * g.ldb + C) * 2u; }
    const size_t kstep = (size_t)(BK * 2);
    const size_t hstepA = (size_t)HALF * g.lda * 2, hstepB = (size_t)HALF * g.ldb * 2;
    const size_t tstepA = 2 * hstepA, tstepB = 2 * hstepB;
    const unsigned ldsw = (unsigned)wid * 1024u;
    const int aoff = lds_byte(wr * 64 + fr, fq * 8), boff = lds_byte(wc * 32 + fr, fq * 8);
#define PG8_SA(b, h) (((b) * 2 + (h)) * HTB)
#define PG8_SB(b, h) ((4 + (b) * 2 + (h)) * HTB)
#define PG8_STAGE(bufoff, gbase, voff) do { _Pragma("unroll") for (int _i = 0; _i < 2; ++_i) \
        __builtin_amdgcn_global_load_lds((const unsigned*)((const char*)(gbase) + (voff)[_i]), (PG8_LAS unsigned*)(lds + (bufoff) + ldsw + _i * 8192), 16, 0, 0); } while (0)
#define PG8_LDA(dst, b, h) do { _Pragma("unroll") for (int m = 0; m < 4; ++m) _Pragma("unroll") for (int k = 0; k < 2; ++k) dst[m][k] = *(const PG8_LAS bf16x8*)(lds + PG8_SA(b, h) + aoff + m * 2048 + k * 1024); } while (0)
#define PG8_LDB(dst, b, h) do { _Pragma("unroll") for (int n = 0; n < 2; ++n) _Pragma("unroll") for (int k = 0; k < 2; ++k) dst[n][k] = *(const PG8_LAS bf16x8*)(lds + PG8_SB(b, h) + boff + n * 2048 + k * 1024); } while (0)
#define PG8_MMA(ai, bj, At, Bt) do { __builtin_amdgcn_s_setprio(1); _Pragma("unroll") for (int m = 0; m < 4; ++m) _Pragma("unroll") for (int n = 0; n < 2; ++n) _Pragma("unroll") for (int k = 0; k < 2; ++k) \
        acc[ai][bj][m][n] = __builtin_amdgcn_mfma_f32_16x16x32_bf16(Bt[n][k], At[m][k], acc[ai][bj][m][n], 0, 0, 0); __builtin_amdgcn_s_setprio(0); } while (0)
#define PG8_WAIT_V(n) asm volatile("s_waitcnt vmcnt(" #n ")" ::: "memory")
#define PG8_WAIT_L(n) asm volatile("s_waitcnt lgkmcnt(" #n ")" ::: "memory")
#define PG8_BAR __builtin_amdgcn_s_barrier()
#define PG8_SCHED __builtin_amdgcn_sched_barrier(0)
    Unit cur, nxt; int ui = 0;
    if (!S.next(0, cur)) return;
    f32x4 acc[2][2][4][2];
    E.init(acc, cur, wr, wc, fr, fq);
    bf16x8 At[4][2], B0[2][2], B1[2][2];
    const char* cA = (const char*)g.A + (size_t)cur.pm * tstepA; const char* cB = (const char*)g.Bt + (size_t)cur.pn * tstepB;
    S.a_ready(cur);
    if constexpr (SP2) {
        PG8_STAGE(PG8_SB(0, 0), cB, voffB); PG8_STAGE(PG8_SB(0, 1), cB + hstepB, voffB); PG8_STAGE(PG8_SA(0, 0), cA, voffA); PG8_STAGE(PG8_SA(0, 1), cA + hstepA, voffA);
        if (wr == 1) PG8_BAR;
        PG8_WAIT_V(2); PG8_BAR;
        PG8_STAGE(PG8_SB(1, 0), cB + kstep, voffB); PG8_STAGE(PG8_SA(1, 0), cA + kstep, voffA); PG8_STAGE(PG8_SB(1, 1), cB + hstepB + kstep, voffB);
        PG8_WAIT_V(6); PG8_BAR;
    } else {
        PG8_STAGE(PG8_SB(0, 0), cB, voffB); PG8_STAGE(PG8_SA(0, 0), cA, voffA); PG8_STAGE(PG8_SB(0, 1), cB + hstepB, voffB); PG8_STAGE(PG8_SA(0, 1), cA + hstepA, voffA);
        if (wr == 1) PG8_BAR;
        PG8_WAIT_V(4); PG8_BAR;
        PG8_STAGE(PG8_SB(1, 0), cB + kstep, voffB); PG8_STAGE(PG8_SA(1, 0), cA + kstep, voffA); PG8_STAGE(PG8_SB(1, 1), cB + hstepB + kstep, voffB);
        PG8_WAIT_V(6); PG8_BAR;
    }
    for (;;) {
        const bool has_next = S.next(ui + 1, nxt);
        const char* nA = has_next ? (const char*)g.A + (size_t)nxt.pm * tstepA : cA; const char* nB = has_next ? (const char*)g.Bt + (size_t)nxt.pn * tstepB : cB;
        for (int t = 0; t < nt; t += 2) {
            const bool last = (t == nt - 2);
            const char* a1 = cA + (size_t)(t + 1) * kstep;
            const char* a2 = last ? nA : cA + (size_t)(t + 2) * kstep; const char* b2 = last ? nB : cB + (size_t)(t + 2) * kstep;
            const char* a3 = a2 + kstep; const char* b3 = b2 + kstep;
            if (last && has_next) S.a_ready(nxt);
            if constexpr (SP2) {
            PG8_LDB(B0, 0, 0); PG8_LDB(B1, 0, 1); PG8_SCHED; PG8_LDA(At, 0, 0); PG8_STAGE(PG8_SA(1, 1), a1 + hstepA, voffA);
            PG8_WAIT_V(8); PG8_WAIT_L(0); PG8_BAR; PG8_MMA(0, 0, At, B0); PG8_MMA(0, 1, At, B1); PG8_BAR; PG8_SCHED;
            PG8_LDA(At, 0, 1); PG8_STAGE(PG8_SB(0, 0), b2, voffB); PG8_STAGE(PG8_SB(0, 1), b2 + hstepB, voffB); PG8_STAGE(PG8_SA(0, 0), a2, voffA);
            PG8_WAIT_V(8); PG8_WAIT_L(0); PG8_BAR; PG8_MMA(1, 0, At, B0); PG8_MMA(1, 1, At, B1); PG8_BAR; PG8_SCHED;
            PG8_LDB(B0, 1, 0); PG8_LDB(B1, 1, 1); PG8_SCHED; PG8_LDA(At, 1, 0); PG8_STAGE(PG8_SA(0, 1), a2 + hstepA, voffA);
            PG8_WAIT_V(8); PG8_WAIT_L(0); PG8_BAR; PG8_MMA(0, 0, At, B0); PG8_MMA(0, 1, At, B1); PG8_BAR; PG8_SCHED;
            PG8_LDA(At, 1, 1); PG8_STAGE(PG8_SB(1, 0), b3, voffB); PG8_STAGE(PG8_SB(1, 1), b3 + hstepB, voffB); PG8_STAGE(PG8_SA(1, 0), a3, voffA);
            PG8_WAIT_V(8); PG8_WAIT_L(0); PG8_BAR; PG8_MMA(1, 0, At, B0); PG8_MMA(1, 1, At, B1); PG8_BAR; PG8_SCHED;
            } else {
            PG8_LDB(B0, 0, 0); PG8_SCHED; PG8_LDA(At, 0, 0); PG8_STAGE(PG8_SA(1, 1), a1 + hstepA, voffA);
            PG8_WAIT_L(8); PG8_BAR; PG8_WAIT_L(0); PG8_MMA(0, 0, At, B0); PG8_BAR; PG8_SCHED;
            PG8_LDB(B1, 0, 1); PG8_STAGE(PG8_SB(0, 0), b2, voffB);
            PG8_BAR; PG8_WAIT_L(0); PG8_MMA(0, 1, At, B1); PG8_BAR;
            PG8_LDA(At, 0, 1); PG8_STAGE(PG8_SA(0, 0), a2, voffA);
            PG8_BAR; PG8_WAIT_L(0); PG8_MMA(1, 0, At, B0); PG8_BAR; PG8_SCHED;
            PG8_STAGE(PG8_SB(0, 1), b2 + hstepB, voffB);
            PG8_WAIT_V(6); PG8_BAR; PG8_MMA(1, 1, At, B1); PG8_BAR;
            PG8_LDB(B0, 1, 0); PG8_SCHED; PG8_LDA(At, 1, 0); PG8_STAGE(PG8_SA(0, 1), a2 + hstepA, voffA);
            PG8_WAIT_L(8); PG8_BAR; PG8_WAIT_L(0); PG8_MMA(0, 0, At, B0); PG8_BAR; PG8_SCHED;
            PG8_LDB(B1, 1, 1); PG8_STAGE(PG8_SB(1, 0), b3, voffB);
            PG8_BAR; PG8_WAIT_L(0); PG8_MMA(0, 1, At, B1); PG8_BAR;
            PG8_LDA(At, 1, 1); PG8_STAGE(PG8_SA(1, 0), a3, voffA);
            PG8_BAR; PG8_WAIT_L(0); PG8_MMA(1, 0, At, B0); PG8_BAR; PG8_SCHED;
            PG8_STAGE(PG8_SB(1, 1), b3 + hstepB, voffB);
            PG8_WAIT_V(6); PG8_BAR; PG8_MMA(1, 1, At, B1); PG8_BAR;
            }
        }
        if constexpr (ALIGN_EPI) { if (wr == 0) PG8_BAR; }
        if constexpr (!Epi::AFTER_DRAIN) { E(acc, cur, wr, wc, fr, fq); S.done(cur); }
        if (!has_next) break;
        E.init(acc, nxt, wr, wc, fr, fq);
        cur = nxt; cA = nA; cB = nB; ++ui;
        if constexpr (ALIGN_EPI) { if (wr == 1) PG8_BAR; }
    }
    PG8_WAIT_V(0);
    if constexpr (!ALIGN_EPI) { if (wr == 0) PG8_BAR; }
    PG8_BAR;
    if constexpr (Epi::AFTER_DRAIN) { E.fused(acc, cur, wr, wc, fr, fq, lds, wid, lane); S.done(cur); }
#undef PG8_SA
#undef PG8_SB
#undef PG8_STAGE
#undef PG8_LDA
#undef PG8_LDB
#undef PG8_MMA
#undef PG8_WAIT_V
#undef PG8_WAIT_L
#undef PG8_BAR
#undef PG8_SCHED
}
}
#define EPI_ZERO_INIT \
  __device__ __forceinline__ void init(pg8::f32x4 (&acc)[2][2][4][2], const pg8::Unit&, int, int, int, int) const { \
    _Pragma("unroll") for (int a = 0; a < 2; ++a) _Pragma("unroll") for (int b = 0; b < 2; ++b) \
    _Pragma("unroll") for (int m = 0; m < 4; ++m) _Pragma("unroll") for (int n = 0; n < 2; ++n) acc[a][b][m][n] = (pg8::f32x4){0.f, 0.f, 0.f, 0.f}; }
struct EpiResid {
  static constexpr bool PERM = false, AFTER_DRAIN = false;
  float* C; int ldc; bf16_t* xb; bf16_t* hb; const float* g2; float* parts;
  __device__ __forceinline__ void init(pg8::f32x4 (&acc)[2][2][4][2], const pg8::Unit& u, int wr, int wc, int fr, int fq) const {
#pragma unroll
    for (int ai = 0; ai < 2; ++ai)
#pragma unroll
      for (int m = 0; m < 4; ++m) {
        const int row = u.pm * 256 + ai * 128 + wr * 64 + m * 16 + fr;
#pragma unroll
        for (int bj = 0; bj < 2; ++bj)
#pragma unroll
          for (int n = 0; n < 2; ++n) {
            const int col = u.pn * 256 + bj * 128 + wc * 32 + n * 16 + 4 * fq;
            acc[ai][bj][m][n] = *(const pg8::f32x4*)(C + (size_t)row * ldc + col);
          }
      }
  }
  __device__ __forceinline__ void operator()(const pg8::f32x4 (&acc)[2][2][4][2], const pg8::Unit& u, int wr, int wc, int fr_in, int fq_in) const {
    int fr = fr_in, fq = fq_in; asm volatile("" : "+v"(fr), "+v"(fq));
    pg8::f32x4 gv[2][2];
#pragma unroll
    for (int bj = 0; bj < 2; ++bj)
#pragma unroll
      for (int n = 0; n < 2; ++n) gv[bj][n] = *(const pg8::f32x4*)(g2 + u.pn * 256 + bj * 128 + wc * 32 + n * 16 + 4 * fq);
#pragma unroll
    for (int ai = 0; ai < 2; ++ai)
#pragma unroll
      for (int m = 0; m < 4; ++m) {
        const int row = u.pm * 256 + ai * 128 + wr * 64 + m * 16 + fr;
        float ss = 0.f;
#pragma unroll
        for (int bj = 0; bj < 2; ++bj)
#pragma unroll
          for (int n = 0; n < 2; ++n) {
            const int col = u.pn * 256 + bj * 128 + wc * 32 + n * 16 + 4 * fq;
            const pg8::f32x4 v = acc[ai][bj][m][n];
            *(pg8::f32x4*)(C + (size_t)row * ldc + col) = v;
            *(uint2*)(xb + (size_t)row * KD + col) = make_uint2(pk_bf16(v[0], v[1]), pk_bf16(v[2], v[3]));
            const pg8::f32x4 h = v * gv[bj][n];
            *(uint2*)(hb + ((size_t)(col >> 7) * T + row) * 128 + (col & 127)) = make_uint2(pk_bf16(h[0], h[1]), pk_bf16(h[2], h[3]));
            ss += (v[0] * v[0] + v[1] * v[1]) + (v[2] * v[2] + v[3] * v[3]);
          }
        ss += __shfl_xor(ss, 16); ss += __shfl_xor(ss, 32);
        if (fq == 0) parts[(size_t)row * 16 + u.pn * 4 + wc] = ss;
        asm volatile("" ::: "memory");
      }
  }
};
struct EpiScaleStoreBf16 {
  static constexpr bool PERM = false, AFTER_DRAIN = false;
  bf16_t* C; int ldc; const float* parts; int nparts; float* rs_out;
  EPI_ZERO_INIT
  __device__ __forceinline__ void operator()(const pg8::f32x4 (&acc)[2][2][4][2], const pg8::Unit& u, int wr, int wc, int fr_in, int fq_in) const {
    int fr = fr_in, fq = fq_in; asm volatile("" : "+v"(fr), "+v"(fq));
#pragma unroll
    for (int ai = 0; ai < 2; ++ai)
#pragma unroll
      for (int m = 0; m < 4; ++m) {
        const int row = u.pm * 256 + ai * 128 + wr * 64 + m * 16 + fr;
        float ssum = 0.f;
        for (int i = 0; i < nparts; i += 4) { const pg8::f32x4 q4 = *(const pg8::f32x4*)(parts + (size_t)row * nparts + i); ssum += (q4[0] + q4[1]) + (q4[2] + q4[3]); }
        const float r = rsqrtf(ssum * (1.0f / (float)D) + EPS);
        if (rs_out && u.pn == 0 && wc == 0 && fq == 0) rs_out[row] = r;
#pragma unroll
        for (int bj = 0; bj < 2; ++bj)
#pragma unroll
          for (int n = 0; n < 2; ++n) {
            const int col = u.pn * 256 + bj * 128 + wc * 32 + n * 16 + 4 * fq;
            pg8::f32x4 v = acc[ai][bj][m][n] * r;
            uint2 o; o.x = pk_bf16(v[0], v[1]); o.y = pk_bf16(v[2], v[3]);
            *(uint2*)(C + (size_t)row * ldc + col) = o;
          }
        asm volatile("" ::: "memory");
      }
  }
};
template <class Epi>
__device__ __forceinline__ void run_gemm(unsigned char* lds_raw, const bf16_t* A, const bf16_t* Bt, int M, int N, int K, const Epi& e) {
  pg8::Gemm g{A, Bt, M, N, K, K, K}; pg8::StaticOrder So; So.init(M, N, (int)gridDim.x, (int)blockIdx.x);
  pg8::gemm_phase<Epi, pg8::StaticOrder, true, true>((PG8_LAS unsigned char*)lds_raw, g, So, e);
}

__device__ __forceinline__ void transpose_items(const float* __restrict__ W, int K, int N, const float* __restrict__ g, bf16_t* __restrict__ Wt, int gw, int ngw, int lane) {
  const int nkt = K / 64, nnt = N / 64;
  for (int it = gw; it < nkt * nnt; it += ngw) {
    int kt = it % nkt, ntile = it / nkt;
    int k0 = kt * 64, n = ntile * 64 + lane;
    float v[64];
#pragma unroll
    for (int i = 0; i < 64; ++i) v[i] = W[(size_t)(k0 + i) * N + n] * g[k0 + i];
    bf16_t* dst = Wt + (size_t)n * (K * KS) + k0;
#pragma unroll
    for (int c = 0; c < 8; ++c) {
      bf16_t hi[8], lo[8];
#pragma unroll
      for (int e = 0; e < 8; ++e) { hi[e] = f2bf(v[c * 8 + e]); lo[e] = f2bf(v[c * 8 + e] - bf2f(hi[e])); }
      uint4 ph, pl;
      ph.x = hi[0] | ((unsigned)hi[1] << 16); ph.y = hi[2] | ((unsigned)hi[3] << 16); ph.z = hi[4] | ((unsigned)hi[5] << 16); ph.w = hi[6] | ((unsigned)hi[7] << 16);
      pl.x = lo[0] | ((unsigned)lo[1] << 16); pl.y = lo[2] | ((unsigned)lo[3] << 16); pl.z = lo[4] | ((unsigned)lo[5] << 16); pl.w = lo[6] | ((unsigned)lo[7] << 16);
      *(uint4*)(dst + c * 8) = ph;
      if (PRECISE) { *(uint4*)(dst + K + c * 8) = pl; *(uint4*)(dst + 2 * K + c * 8) = ph; }
    }
  }
}


__device__ __forceinline__ void phase_prologue(const Params& p, int gtid, int ngt, int gw, int ngw, int lane) {
  for (int idx = gtid; idx < S * 40; idx += ngt) {
    int s = idx / 40, i = idx % 40;
    if (i < 8) {
      float inv = powf(500000.0f, -(float)(2 * i) / 16.0f);
      float ang = (float)s * inv;
      p.cosm()[s * 8 + i] = (float)cos((double)ang); p.sinm()[s * 8 + i] = (float)sin((double)ang);
    } else {
      int j = i - 8;
      float inv = powf(10000.0f, -((float)j / 31.0f));
      float ang = (float)s * inv;
      p.cosr()[s * 32 + j] = (float)cos((double)ang); p.sinr()[s * 32 + j] = (float)sin((double)ang);
    }
  }
  { const float4* a = (const float4*)p.inp(0); float4* b = (float4*)p.outp();
    for (size_t i = gtid; i < (size_t)T * D / 4; i += ngt) b[i] = a[i]; }
  for (int t = gw; t < T; t += ngw) {
    const float4* xr = (const float4*)(p.inp(0) + (size_t)t * D); float ss = 0.f;
#pragma unroll
    for (int i = 0; i < 4; ++i) { const float4 v = xr[lane + i * 64]; ss += v.x * v.x + v.y * v.y + v.z * v.z + v.w * v.w;
      *(uint2*)(p.xb() + (size_t)t * KD + (lane + i * 64) * 4) = make_uint2(pk_bf16(v.x, v.y), pk_bf16(v.z, v.w)); }
    ss = wave_sum(ss);
    if (lane < 8) p.ssq1()[(size_t)t * 8 + lane] = lane == 0 ? ss : 0.f;
  }
  for (int idx = gtid; idx < NL * 65536; idx += ngt) { const int l2 = idx >> 16, n2 = (idx >> 8) & 255, k2 = idx & 255; p.Wglu_t()[idx] = f2bf(p.inp(11)[(size_t)l2 * 65536 + k2 * 256 + n2]); }
  for (int l = 0; l < NL; ++l) {
    transpose_items(p.inp(2) + (size_t)l * D * INW, D, INW, p.inp(1) + l * D, p.Win_t() + (size_t)l * INW * KD, gw, ngw, lane);
    transpose_items(p.inp(15) + (size_t)l * D * D, D, D, p.inp(14) + l * D, p.Wout_t() + (size_t)l * D * KD, gw, ngw, lane);
    transpose_items(p.inp(17) + (size_t)l * D * D, D, D, p.inp(16) + l * D, p.Wq_t() + (size_t)l * D * KD, gw, ngw, lane);
  }
}


struct S5P { float lr, li, dt, fr, fi; };
__device__ __forceinline__ S5P s5p(const Params& p, int l, int g, int pp) {
  S5P r; r.lr = p.inp(3)[l * 1024 + g * 64 + pp]; r.li = p.inp(4)[l * 1024 + g * 64 + pp]; r.dt = expf(p.inp(5)[l * 16 + g]);
  const float mag = expf(r.lr * r.dt); float sn, cs; sincosf(r.li * r.dt, &sn, &cs);
  const float ar = mag * cs, ai = mag * sn, den = r.lr * r.lr + r.li * r.li;
  r.fr = ((ar - 1.0f) * r.lr + ai * r.li) / den; r.fi = (ai * r.lr - (ar - 1.0f) * r.li) / den;
  return r;
}
__device__ __forceinline__ void s5pow(const S5P& s, int k, float& re, float& im) {
  const float m = expf((float)k * s.lr * s.dt); float sn, cs; sincosf((float)k * s.li * s.dt, &sn, &cs); re = m * cs; im = m * sn;
}
__device__ __forceinline__ void phase_s5_prep(const Params& p, int l, int gtid, int ngt) {
  const float* b_re = p.inp(6) + l * 16384; const float* b_im = p.inp(7) + l * 16384;
  const float* c_re = p.inp(8) + l * 16384; const float* c_im = p.inp(9) + l * 16384;
  bf16_t* Wy = p.S5Wy(); bf16_t* Wz = p.S5Wz();
  for (int it = gtid; it < 16 * 32 * 256; it += ngt) {
    const int hp = it & 15, h = (it >> 4) & 15, d = (it >> 8) & 31, g = it >> 13;
    float acc = 0.f;
    for (int pp = 0; pp < 64; ++pp) {
      const S5P s = s5p(p, l, g, pp);
      float pr, pi; s5pow(s, d, pr, pi);
      const float br = b_re[(g * 64 + pp) * 16 + hp], bi = b_im[(g * 64 + pp) * 16 + hp];
      const float bbr = s.fr * br - s.fi * bi, bbi = s.fr * bi + s.fi * br;
      const float tr = pr * bbr - pi * bbi, ti = pr * bbi + pi * bbr;
      acc += c_re[(g * 16 + h) * 64 + pp] * tr - c_im[(g * 16 + h) * 64 + pp] * ti;
    }
    const bf16_t v = f2bf(acc);
    for (int jp = 0; jp + d < 32; ++jp) {
      const int j = jp + d;
      Wy[((size_t)g * 512 + j * 16 + h) * 640 + jp * 16 + hp] = v;
      if (d > 0) Wy[((size_t)g * 512 + jp * 16 + h) * 640 + j * 16 + hp] = 0;
    }
  }
  for (int it = gtid; it < 16 * 32 * 16 * 64; it += ngt) {
    const int pp = it & 63, h = (it >> 6) & 15, j = (it >> 10) & 31, g = it >> 15;
    const S5P s = s5p(p, l, g, pp);
    float pr, pi; s5pow(s, j + 1, pr, pi);
    const float cr = c_re[(g * 16 + h) * 64 + pp], ci = c_im[(g * 16 + h) * 64 + pp];
    const unsigned w = pk_bf16(cr * pr - ci * pi, -(cr * pi + ci * pr));
    *(unsigned*)(Wy + ((size_t)g * 512 + j * 16 + h) * 640 + 512 + 2 * pp) = w;
  }
  for (int it = gtid; it < 16 * 64 * 32; it += ngt) {
    const int j = it & 31, pp = (it >> 5) & 63, g = it >> 11;
    const S5P s = s5p(p, l, g, pp);
    float pr, pi; s5pow(s, 31 - j, pr, pi);
    for (int hp = 0; hp < 16; ++hp) {
      const float br = b_re[(g * 64 + pp) * 16 + hp], bi = b_im[(g * 64 + pp) * 16 + hp];
      const float bbr = s.fr * br - s.fi * bi, bbi = s.fr * bi + s.fi * br;
      Wz[((size_t)g * 256 + 2 * pp) * 512 + j * 16 + hp] = f2bf(pr * bbr - pi * bbi);
      Wz[((size_t)g * 256 + 2 * pp + 1) * 512 + j * 16 + hp] = f2bf(pr * bbi + pi * bbr);
    }
  }
  for (int it = gtid; it < 16 * 64; it += ngt) {
    const S5P s = s5p(p, l, it >> 6, it & 63);
    float pr, pi; s5pow(s, 32, pr, pi);
    p.S5a32()[it * 2] = pr; p.S5a32()[it * 2 + 1] = pi;
  }
}
__device__ __forceinline__ void phase_pack_u(const Params& p, int gtid, int ngt) {
  for (int idx = gtid; idx < T * 32; idx += ngt) {
    const int t = idx >> 5, i = idx & 31, g = i >> 1;
    *(uint4*)(p.S5A() + ((size_t)g * 1024 + (t >> 5)) * 640 + (t & 31) * 16 + (i & 1) * 8) = *(const uint4*)(p.projb() + (size_t)t * INW + i * 8);
  }
}
__device__ __forceinline__ void phase_s5_scan(const Params& p, int gtid, int ngt) {
  for (int it = gtid; it < NB * 16 * 64; it += ngt) {
    const int pp = it & 63, g = (it >> 6) & 15, b = it >> 10;
    const float er = p.S5a32()[(g * 64 + pp) * 2], ei = p.S5a32()[(g * 64 + pp) * 2 + 1];
    float sr = 0.f, si = 0.f;
#pragma unroll 1
    for (int c0 = 0; c0 < 128; c0 += 16) {
      float2 z[16];
#pragma unroll
      for (int k = 0; k < 16; ++k) z[k] = *(const float2*)(p.S5Z() + ((size_t)g * 1024 + b * 128 + c0 + k) * 128 + 2 * pp);
#pragma unroll
      for (int k = 0; k < 16; ++k) {
        const size_t ch = (size_t)g * 1024 + b * 128 + c0 + k;
        *(unsigned*)(p.S5A() + ch * 640 + 512 + 2 * pp) = pk_bf16(sr, si);
        const float nr = er * sr - ei * si + z[k].x, ni = er * si + ei * sr + z[k].y;
        sr = nr; si = ni;
      }
    }
  }
}
struct EpiS5Z {
  static constexpr bool PERM = false, AFTER_DRAIN = false;
  float* Z;
  EPI_ZERO_INIT
  __device__ __forceinline__ void operator()(const pg8::f32x4 (&acc)[2][2][4][2], const pg8::Unit& u, int wr, int wc, int fr_in, int fq_in) const {
    int fr = fr_in, fq = fq_in; asm volatile("" : "+v"(fr), "+v"(fq));
    const int g = u.pm >> 2;
#pragma unroll
    for (int ai = 0; ai < 2; ++ai)
#pragma unroll
      for (int m = 0; m < 4; ++m) {
        const int chunk = (u.pm & 3) * 256 + ai * 128 + wr * 64 + m * 16 + fr;
#pragma unroll
        for (int n = 0; n < 2; ++n) *(pg8::f32x4*)(Z + ((size_t)g * 1024 + chunk) * 128 + wc * 32 + n * 16 + 4 * fq) = acc[ai][0][m][n];
      }
  }
};
struct EpiS5Y {
  static constexpr bool PERM = false, AFTER_DRAIN = false;
  bf16_t* ygb; const bf16_t* A; const float* dsk;
  EPI_ZERO_INIT
  __device__ __forceinline__ void operator()(const pg8::f32x4 (&acc)[2][2][4][2], const pg8::Unit& u, int wr, int wc, int fr_in, int fq_in) const {
    int fr = fr_in, fq = fq_in; asm volatile("" : "+v"(fr), "+v"(fq));
    const int g = u.pm >> 2;
#pragma unroll
    for (int ai = 0; ai < 2; ++ai)
#pragma unroll
      for (int m = 0; m < 4; ++m) {
        const int chunk = (u.pm & 3) * 256 + ai * 128 + wr * 64 + m * 16 + fr;
#pragma unroll
        for (int bj = 0; bj < 2; ++bj)
#pragma unroll
          for (int n = 0; n < 2; ++n) {
            const int col = (u.pn & 1) * 256 + bj * 128 + wc * 32 + n * 16 + 4 * fq, j = col >> 4, h = col & 15;
            const uint2 uu = *(const uint2*)(A + ((size_t)g * 1024 + chunk) * 640 + col);
            const pg8::f32x4 dv = *(const pg8::f32x4*)(dsk + g * 16 + h);
            const pg8::f32x4 v = acc[ai][bj][m][n];
            const float y0 = fast_gelu(v[0] + dv[0] * __uint_as_float(uu.x << 16)), y1 = fast_gelu(v[1] + dv[1] * __uint_as_float(uu.x & 0xffff0000u));
            const float y2 = fast_gelu(v[2] + dv[2] * __uint_as_float(uu.y << 16)), y3 = fast_gelu(v[3] + dv[3] * __uint_as_float(uu.y & 0xffff0000u));
            uint2 o; o.x = pk_bf16(y0, y1); o.y = pk_bf16(y2, y3);
            *(uint2*)(ygb + ((size_t)chunk * 32 + j) * 256 + g * 16 + h) = o;
          }
        asm volatile("" ::: "memory");
      }
  }
};
struct EpiGlu {
  static constexpr bool PERM = false, AFTER_DRAIN = false;
  bf16_t* yb; const bf16_t* ygb; float* scr;
  EPI_ZERO_INIT
  __device__ __forceinline__ void operator()(const pg8::f32x4 (&acc_)[2][2][4][2], const pg8::Unit& u, int wr, int wc, int fr_in, int fq_in) const {
    int fr = fr_in, fq = fq_in; asm volatile("" : "+v"(fr), "+v"(fq));
    pg8::f32x4 (&acc)[2][2][4][2] = const_cast<pg8::f32x4 (&)[2][2][4][2]>(acc_);
#pragma unroll
    for (int ai = 0; ai < 2; ++ai)
#pragma unroll
      for (int m = 0; m < 4; ++m) {
        const int rl = ai * 128 + wr * 64 + m * 16 + fr, row = u.pm * 256 + rl;
        float ss = 0.f;
#pragma unroll
        for (int bj = 0; bj < 2; ++bj)
#pragma unroll
          for (int n = 0; n < 2; ++n) {
            const int col = bj * 128 + wc * 32 + n * 16 + 4 * fq;
            const uint2 yy = *(const uint2*)(ygb + (size_t)row * 256 + col);
            const pg8::f32x4 z = acc[ai][bj][m][n];
            pg8::f32x4 r;
            r[0] = __uint_as_float(yy.x << 16) * fast_sigmoid(z[0]); r[1] = __uint_as_float(yy.x & 0xffff0000u) * fast_sigmoid(z[1]);
            r[2] = __uint_as_float(yy.y << 16) * fast_sigmoid(z[2]); r[3] = __uint_as_float(yy.y & 0xffff0000u) * fast_sigmoid(z[3]);
            acc[ai][bj][m][n] = r;
            ss += r[0] * r[0] + r[1] * r[1] + r[2] * r[2] + r[3] * r[3];
          }
        ss += __shfl_xor(ss, 16); ss += __shfl_xor(ss, 32);
        if (fq == 0) scr[rl * 4 + wc] = ss;
        asm volatile("" ::: "memory");
      }
    asm volatile("s_waitcnt lgkmcnt(0)" ::: "memory"); __builtin_amdgcn_s_barrier(); asm volatile("" ::: "memory");
#pragma unroll
    for (int ai = 0; ai < 2; ++ai)
#pragma unroll
      for (int m = 0; m < 4; ++m) {
        const int rl = ai * 128 + wr * 64 + m * 16 + fr, row = u.pm * 256 + rl;
        const pg8::f32x4 s4 = *(const pg8::f32x4*)(scr + rl * 4);
        const float r = rsqrtf((s4[0] + s4[1] + s4[2] + s4[3]) / 256.0f + EPS);
#pragma unroll
        for (int bj = 0; bj < 2; ++bj)
#pragma unroll
          for (int n = 0; n < 2; ++n) { const pg8::f32x4 v = acc[ai][bj][m][n] * r; *(uint2*)(yb + (size_t)row * KD + bj * 128 + wc * 32 + n * 16 + 4 * fq) = make_uint2(pk_bf16(v[0], v[1]), pk_bf16(v[2], v[3])); }
        asm volatile("" ::: "memory");
      }
    asm volatile("s_waitcnt lgkmcnt(0)" ::: "memory"); __builtin_amdgcn_s_barrier(); asm volatile("" ::: "memory");
  }
};

constexpr float QSCALE = 0.125f * 1.4426950408889634f;


__device__ __forceinline__ void phase_moba2(const Params& p, int l, unsigned char* lds, int bid, int G) {
  constexpr int OLD = 260;
  bf16_t* Qs = (bf16_t*)lds;
  float* Oaccf = (float*)(lds + 32768);
  float* laccf = (float*)(lds + 32768 + 64 * OLD * 4);
  float* kms = laccf + 256;
  float* gat = kms + 1024;
  unsigned char* lists = (unsigned char*)(gat + 4096);
  int* cnt = (int*)(lists + 4096);
  int* items = cnt + 16;
  int* ctr = items + 160;
  unsigned* selp = (unsigned*)(ctr + 4);
  float* bq = (float*)(selp + 256);
  int* Oacc = (int*)Oaccf; int* lacc = (int*)laccf;
  float kmax = 0.f;
  { const float* gk = p.inp(13) + l * 64;
    for (int d = 0; d < 64; ++d) kmax = fmaxf(kmax, fabsf(gk[d]));
    kmax *= 8.0f * 1.01f; }
  for (int u = bid; u < NB * 8 * 16; u += G) {
    const int qblk = 15 - (u >> 6), bh = u & 63, b = bh >> 3, h = bh & 7;
    int tid = threadIdx.x; asm volatile("" : "+v"(tid));
    const int lane = tid & 63, wv = tid >> 6, n = lane & 31, hh = lane >> 5;
    __syncthreads();
    { const uint4* src = (const uint4*)(p.Qm() + ((size_t)bh * S + qblk * 256) * 64);
      uint4* dst = (uint4*)Qs;
      for (int i = tid; i < 256 * 64 * 2 / 16; i += NTHR) dst[i] = src[i]; }
    for (int i = tid; i < qblk * 64; i += NTHR) kms[i] = p.kmean()[(size_t)bh * 1024 + i];
    for (int i = tid; i < 64 * OLD; i += NTHR) Oacc[i] = 0;
    if (tid < 256) lacc[tid] = 0;
    if (tid < 16) cnt[tid] = 0;
    __syncthreads();
    { const int q = tid & 255, par = tid >> 8;
      float qv[64];
#pragma unroll
      for (int c = 0; c < 8; ++c) {
        uint4 w = *(const uint4*)(Qs + q * 64 + c * 8);
        qv[c * 8 + 0] = __uint_as_float(w.x << 16); qv[c * 8 + 1] = __uint_as_float(w.x & 0xffff0000u);
        qv[c * 8 + 2] = __uint_as_float(w.y << 16); qv[c * 8 + 3] = __uint_as_float(w.y & 0xffff0000u);
        qv[c * 8 + 4] = __uint_as_float(w.z << 16); qv[c * 8 + 5] = __uint_as_float(w.z & 0xffff0000u);
        qv[c * 8 + 6] = __uint_as_float(w.w << 16); qv[c * 8 + 7] = __uint_as_float(w.w & 0xffff0000u);
      }
      if (par == 0) { float qq = 0.f;
#pragma unroll
        for (int d = 0; d < 64; ++d) qq = fmaf(qv[d], qv[d], qq);
        bq[q] = sqrtf(qq) * kmax; }
      for (int j = par; j < qblk; j += 2) {
        float g = 0.f;
#pragma unroll
        for (int d = 0; d < 64; ++d) g = fmaf(qv[d], kms[j * 64 + d], g);
        gat[q * 16 + j] = g;
      }
    }
    __syncthreads();
    if (tid < 256) {
      float b0 = -INFINITY, b1 = -INFINITY, b2 = -INFINITY; int i0 = 0, i1 = 0, i2 = 0;
      for (int j = 0; j < qblk; ++j) {
        float g = gat[tid * 16 + j];
        if (g > b0) { b2 = b1; i2 = i1; b1 = b0; i1 = i0; b0 = g; i0 = j; }
        else if (g > b1) { b2 = b1; i2 = i1; b1 = g; i1 = j; }
        else if (g > b2) { b2 = g; i2 = j; }
      }
      const int nsel = qblk < 3 ? qblk : 3;
      selp[tid] = (unsigned)i0 | ((unsigned)i1 << 4) | ((unsigned)i2 << 8) | ((unsigned)nsel << 12);
    }
    __syncthreads();
    for (int j = wv; j < qblk; j += 8) {
      int base = 0;
      for (int c = 0; c < 4; ++c) {
        const int q = c * 64 + lane;
        const unsigned sp = selp[q];
        const int ns = sp >> 12;
        const bool f = (ns > 0 && (int)(sp & 15) == j) || (ns > 1 && (int)((sp >> 4) & 15) == j) || (ns > 2 && (int)((sp >> 8) & 15) == j);
        const unsigned long long bal = __ballot(f);
        const int pos = base + __popcll(bal & ((1ull << lane) - 1ull));
        if (f) lists[j * 256 + pos] = (unsigned char)q;
        base += __popcll(bal);
      }
      if (lane == 0) cnt[j] = base;
    }
    __syncthreads();
    if (tid == 0) {
      int ni = 0;
#pragma unroll 1
      for (int g = 7; g >= 0; --g) items[ni++] = (16 << 8) | g;
      for (int j = 0; j < qblk; ++j) { const int ng = (cnt[j] + 31) >> 5; for (int g = 0; g < ng; ++g) items[ni++] = (j << 8) | g; }
      ctr[0] = ni; ctr[1] = 0;
    }
    __syncthreads();
    const int nitems = ctr[0];
    for (;;) {
      int it = 0;
      if (lane == 0) it = atomicAdd(&ctr[1], 1);
      it = __builtin_amdgcn_readfirstlane(it);
      if (it >= nitems) break;
      const int item = items[it];
      const int j = item >> 8, g = item & 255;
      const bool own = (j == 16);
      const int kb = own ? qblk : j;
      const int ntile = own ? (g + 1) : 8;
      int qi; bool valid;
      if (own) { qi = g * 32 + n; valid = true; }
      else { const int pos = g * 32 + n; valid = pos < cnt[j]; qi = lists[j * 256 + (valid ? pos : 0)]; }
      const bf16_t* kt0 = p.Km() + ((size_t)bh * (S / 32) + kb * 8) * 2048 + lane * 8;
      const bf16_t* vt0 = p.Vm() + ((size_t)bh * (S / 32) + kb * 8) * 2048 + lane * 8;
      f32x16 O0, O1;
#pragma unroll
      for (int r = 0; r < 16; ++r) { O0[r] = 0.f; O1[r] = 0.f; }
      float lsum = 0.f;
      const float nbq = -bq[qi];
      bf16x8 kf[3][4], vf[3][4];
#define MOBA_LOAD(KT_, BUF_) { _Pragma("unroll") for (int s = 0; s < 4; ++s) { kf[BUF_][s] = *(const bf16x8*)(kt0 + (size_t)(KT_) * 2048 + s * 512); vf[BUF_][s] = *(const bf16x8*)(vt0 + (size_t)(KT_) * 2048 + s * 512); } }
#define MOBA_STEP(KT_, BUF_)                                                                                                           \
      if ((KT_) < ntile) {                                                                                                               \
        if ((KT_) + 2 < ntile) MOBA_LOAD((KT_) + 2, ((BUF_) + 2) % 3)                                                                     \
        f32x16 X;                                                                                                                         \
        _Pragma("unroll") for (int r = 0; r < 16; ++r) X[r] = nbq;                                                                        \
        _Pragma("unroll") for (int s = 0; s < 4; ++s) X = __builtin_amdgcn_mfma_f32_32x32x16_bf16(kf[BUF_][s], *(const bf16x8*)(Qs + qi * 64 + (2 * s + hh) * 8), X, 0, 0, 0);     \
        const bool diag = own && ((KT_) == g);                                                                                            \
        unsigned pw[8];                                                                                                                   \
        _Pragma("unroll") for (int r = 0; r < 16; r += 2) {                                                                               \
          float e0 = __builtin_amdgcn_exp2f(X[r]), e1 = __builtin_amdgcn_exp2f(X[r + 1]);                                                 \
          if (diag) {                                                                                                                     \
            const int k0 = (r & 3) + 8 * (r >> 2) + 4 * hh, k1 = ((r + 1) & 3) + 8 * ((r + 1) >> 2) + 4 * hh;                             \
            e0 = (k0 <= n) ? e0 : 0.f; e1 = (k1 <= n) ? e1 : 0.f;                                                                         \
          }                                                                                                                               \
          lsum += e0 + e1;                                                                                                                \
          pw[r >> 1] = pk_bf16(e0, e1);                                                                                                   \
        }                                                                                                                                 \
        bf16x8 pf0, pf1;                                                                                                                  \
        { uint4 t0 = make_uint4(pw[0], pw[1], pw[2], pw[3]), t1 = make_uint4(pw[4], pw[5], pw[6], pw[7]);                                 \
          pf0 = *(bf16x8*)&t0; pf1 = *(bf16x8*)&t1; }                                                                                     \
        O0 = __builtin_amdgcn_mfma_f32_32x32x16_bf16(vf[BUF_][0], pf0, O0, 0, 0, 0);                                                      \
        O0 = __builtin_amdgcn_mfma_f32_32x32x16_bf16(vf[BUF_][1], pf1, O0, 0, 0, 0);                                                      \
        O1 = __builtin_amdgcn_mfma_f32_32x32x16_bf16(vf[BUF_][2], pf0, O1, 0, 0, 0);                                                      \
        O1 = __builtin_amdgcn_mfma_f32_32x32x16_bf16(vf[BUF_][3], pf1, O1, 0, 0, 0);                                                      \
      }
      MOBA_LOAD(0, 0)
      if (ntile > 1) MOBA_LOAD(1, 1)
#pragma unroll 1
      for (int kt3 = 0; kt3 < ntile; kt3 += 3) {
        MOBA_STEP(kt3, 0) MOBA_STEP(kt3 + 1, 1) MOBA_STEP(kt3 + 2, 2)
      }
#undef MOBA_STEP
#undef MOBA_LOAD
      lsum += __shfl_xor(lsum, 32);
      if (valid) {
        if (hh == 0) atomicAdd(&lacc[qi], __float2int_rn(lsum * 1048576.0f));
#pragma unroll
        for (int r = 0; r < 16; ++r) {
          const int dim = (r & 3) + 8 * (r >> 2) + 4 * hh;
          atomicAdd(&Oacc[dim * OLD + qi], __float2int_rn(O0[r] * 1048576.0f));
          atomicAdd(&Oacc[(dim + 32) * OLD + qi], __float2int_rn(O1[r] * 1048576.0f));
        }
      }
    }
    __syncthreads();
    { const int q = tid >> 1, half = tid & 1;
      const float inv = 1.0f / (float)lacc[q];
      float o[32], ss = 0.f;
#pragma unroll
      for (int d = 0; d < 32; ++d) { o[d] = (float)Oacc[(half * 32 + d) * OLD + q] * inv; ss += o[d] * o[d]; }
      ss += __shfl_xor(ss, 1);
      const float r = rsqrtf(ss / 64.0f + EPS);
      bf16_t* dst = p.xb() + (size_t)(b * S + qblk * 256 + q) * KD + 256 + h * 64 + half * 32;
#pragma unroll
      for (int d = 0; d < 32; d += 8) *(uint4*)(dst + d) = make_uint4(pk_bf16(o[d] * r, o[d + 1] * r), pk_bf16(o[d + 2] * r, o[d + 3] * r), pk_bf16(o[d + 4] * r, o[d + 5] * r), pk_bf16(o[d + 6] * r, o[d + 7] * r));
    }
  }
}


__device__ __forceinline__ float ret_log2g(int h) { return log2f(1.0f - exp2f(-5.0f - (float)h)); }
__device__ __forceinline__ void phase_ret_kv(const Params& p, int gw, int ngw, int lane) {
  const int n = lane & 31, hh = lane >> 5;
  for (int w = gw; w < NB * 4 * 32; w += ngw) {
    const int bh = w >> 5, cn = w & 31;
    const bf16_t* vt = p.Vr() + ((size_t)bh * (S / 32) + cn * 4) * 2048 + lane * 8;
    const bf16_t* kt = p.Krv() + ((size_t)bh * (S / 32) + cn * 4) * 2048 + lane * 8;
    f32x16 acc[2][2];
#pragma unroll
    for (int a = 0; a < 2; ++a)
#pragma unroll
      for (int b2 = 0; b2 < 2; ++b2)
#pragma unroll
        for (int r = 0; r < 16; ++r) acc[a][b2][r] = 0.f;
#pragma unroll 1
    for (int tl = 0; tl < 4; ++tl)
#pragma unroll
      for (int ks = 0; ks < 2; ++ks) {
        bf16x8 vf[2], kf[2];
#pragma unroll
        for (int x = 0; x < 2; ++x) { vf[x] = *(const bf16x8*)(vt + tl * 2048 + (x * 2 + ks) * 512); kf[x] = *(const bf16x8*)(kt + tl * 2048 + (x * 2 + ks) * 512); }
#pragma unroll
        for (int mb = 0; mb < 2; ++mb)
#pragma unroll
          for (int nb = 0; nb < 2; ++nb) acc[mb][nb] = __builtin_amdgcn_mfma_f32_32x32x16_bf16(vf[mb], kf[nb], acc[mb][nb], 0, 0, 0);
      }
    float* dst = p.KVr() + ((size_t)bh * 32 + cn) * 4096;
#pragma unroll
    for (int mb = 0; mb < 2; ++mb)
#pragma unroll
      for (int nb = 0; nb < 2; ++nb)
#pragma unroll
        for (int r = 0; r < 16; ++r) dst[(mb * 32 + (r & 3) + 8 * (r >> 2) + 4 * hh) * 64 + nb * 32 + n] = acc[mb][nb][r];
  }
}
__device__ __forceinline__ void phase_ret_scan(const Params& p, int gtid, int ngt) {
  for (int it = gtid; it < NB * 4 * 4096; it += ngt) {
    const int e = it & 4095, bh = it >> 12, h = bh & 3;
    const float l2g = ret_log2g(h), g1 = exp2f(l2g), g127 = exp2f(127.0f * l2g), g128 = exp2f(128.0f * l2g);
    float R = 0.f; float kv[32];
#pragma unroll
    for (int cn = 0; cn < 32; ++cn) kv[cn] = p.KVr()[((size_t)bh * 32 + cn) * 4096 + e];
#pragma unroll
    for (int cn = 0; cn < 32; ++cn) {
      p.Rb()[((size_t)bh * 32 + cn) * 4096 + e] = f2bf(g1 * R);
      R = g128 * R + g127 * kv[cn];
    }
  }
}
__device__ __forceinline__ void phase_ret_out(const Params& p, int gw, int ngw, int lane) {
  const int n = lane & 31, hh = lane >> 5;
  for (int w = gw; w < NB * 4 * 32 * 4; w += ngw) {
    const int qg = 3 - (w & 3), cn = (w >> 2) & 31, bh = w >> 7, b = bh >> 2, h = bh & 3;
    const int s0 = cn * 128 + qg * 32;
    bf16x8 qf[4];
#pragma unroll
    for (int s = 0; s < 4; ++s) qf[s] = *(const bf16x8*)(p.Qr() + ((size_t)bh * S + s0 + n) * 64 + (2 * s + hh) * 8);
    f32x16 O0, O1;
#pragma unroll
    for (int r = 0; r < 16; ++r) { O0[r] = 0.f; O1[r] = 0.f; }
    { const bf16_t* rb = p.Rb() + ((size_t)bh * 32 + cn) * 4096 + (size_t)n * 64 + hh * 8;
#pragma unroll
      for (int s = 0; s < 4; ++s) {
        const bf16x8 r0 = *(const bf16x8*)(rb + s * 16), r1 = *(const bf16x8*)(rb + 32 * 64 + s * 16);
        O0 = __builtin_amdgcn_mfma_f32_32x32x16_bf16(r0, qf[s], O0, 0, 0, 0);
        O1 = __builtin_amdgcn_mfma_f32_32x32x16_bf16(r1, qf[s], O1, 0, 0, 0);
      } }
    const bf16_t* kt0 = p.Kr() + ((size_t)bh * (S / 32) + cn * 4) * 2048 + lane * 8;
    const bf16_t* vt0 = p.Vr() + ((size_t)bh * (S / 32) + cn * 4) * 2048 + lane * 8;
    for (int kt = 0; kt <= qg; ++kt) {
      bf16x8 kf[4], vf[4];
#pragma unroll
      for (int s = 0; s < 4; ++s) { kf[s] = *(const bf16x8*)(kt0 + (size_t)kt * 2048 + s * 512); vf[s] = *(const bf16x8*)(vt0 + (size_t)kt * 2048 + s * 512); }
      f32x16 X;
#pragma unroll
      for (int r = 0; r < 16; ++r) X[r] = 0.f;
#pragma unroll
      for (int s = 0; s < 4; ++s) X = __builtin_amdgcn_mfma_f32_32x32x16_bf16(kf[s], qf[s], X, 0, 0, 0);
      const bool diag = (kt == qg);
      unsigned pw[8];
#pragma unroll
      for (int r = 0; r < 16; r += 2) {
        float e0 = X[r], e1 = X[r + 1];
        if (diag) {
          const int k0 = (r & 3) + 8 * (r >> 2) + 4 * hh, k1 = ((r + 1) & 3) + 8 * ((r + 1) >> 2) + 4 * hh;
          e0 = (k0 <= n) ? e0 : 0.f; e1 = (k1 <= n) ? e1 : 0.f;
        }
        pw[r >> 1] = pk_bf16(e0, e1);
      }
      bf16x8 pf0, pf1;
      { uint4 t0 = make_uint4(pw[0], pw[1], pw[2], pw[3]), t1 = make_uint4(pw[4], pw[5], pw[6], pw[7]);
        pf0 = *(bf16x8*)&t0; pf1 = *(bf16x8*)&t1; }
      O0 = __builtin_amdgcn_mfma_f32_32x32x16_bf16(vf[0], pf0, O0, 0, 0, 0);
      O0 = __builtin_amdgcn_mfma_f32_32x32x16_bf16(vf[1], pf1, O0, 0, 0, 0);
      O1 = __builtin_amdgcn_mfma_f32_32x32x16_bf16(vf[2], pf0, O1, 0, 0, 0);
      O1 = __builtin_amdgcn_mfma_f32_32x32x16_bf16(vf[3], pf1, O1, 0, 0, 0);
    }
    float ss = 0.f;
#pragma unroll
    for (int r = 0; r < 16; ++r) ss += O0[r] * O0[r] + O1[r] * O1[r];
    ss += __shfl_xor(ss, 32);
    const float rn = rsqrtf(ss / 64.0f + EPS);
    const size_t t = (size_t)b * S + s0 + n;
    const bf16_t* gp = p.projb() + t * INW + OFF_GR + h * 64;
    bf16_t* yo = p.xb() + t * KD + 768 + h * 64;
#pragma unroll
    for (int q4 = 0; q4 < 4; ++q4) {
#pragma unroll
      for (int mb = 0; mb < 2; ++mb) {
        const int d0 = mb * 32 + 8 * q4 + 4 * hh;
        const uint2 gw2 = *(const uint2*)(gp + d0); const float4 g = make_float4(__uint_as_float(gw2.x << 16), __uint_as_float(gw2.x & 0xffff0000u), __uint_as_float(gw2.y << 16), __uint_as_float(gw2.y & 0xffff0000u));
        float4 o;
        const f32x16& Oa = mb ? O1 : O0;
        o.x = Oa[q4 * 4 + 0] * rn * g.x * fast_sigmoid(g.x); o.y = Oa[q4 * 4 + 1] * rn * g.y * fast_sigmoid(g.y);
        o.z = Oa[q4 * 4 + 2] * rn * g.z * fast_sigmoid(g.z); o.w = Oa[q4 * 4 + 3] * rn * g.w * fast_sigmoid(g.w);
        *(uint2*)(yo + d0) = make_uint2(pk_bf16(o.x, o.y), pk_bf16(o.z, o.w));
      }
    }
  }
}

__device__ __forceinline__ void phase_post_pack(const Params& p, int l, int gtid, int ngt, int gw, int ngw, int lane) {
  const float* gq = p.inp(12) + l * 64; const float* gk = p.inp(13) + l * 64;
  for (int t = gw; t < T; t += ngw) {
    const int s = t % S, b = t / S;
    const bf16_t* row = p.projb() + (size_t)t * INW;
    float vin[24];
#pragma unroll
    for (int sl = 0; sl < 16; ++sl) vin[sl] = bf2f(row[(sl < 8 ? OFF_QM : OFF_KM) + (sl & 7) * 64 + lane]);
#pragma unroll
    for (int sl = 0; sl < 8; ++sl) vin[16 + sl] = bf2f(row[(sl < 4 ? OFF_QR : OFF_KR) + (sl & 3) * 64 + lane]);
    const float cm = p.cosm()[s * 8 + (lane & 7)], sm = p.sinm()[s * 8 + (lane & 7)];
    const float cr = p.cosr()[s * 32 + (lane & 31)], sr = p.sinr()[s * 32 + (lane & 31)];
    const float gqv = gq[lane], gkv = gk[lane];
#pragma unroll
    for (int slot = 0; slot < 16; ++slot) {
      const int h = slot & 7, bh = b * 8 + h; const bool isk = slot >= 8;
      const float v = vin[slot];
      const float ss = wave_sum(v * v);
      const float u = v * rsqrtf(ss / 64.0f + EPS) * (isk ? gkv : gqv);
      const float pu = __shfl(u, (lane < 8 ? lane + 8 : lane - 8) & 63);
      float o = u;
      if (lane < 16) o = lane < 8 ? (u * cm - pu * sm) : (u * cm + pu * sm);
      if (!isk) p.Qm()[((size_t)bh * S + s) * 64 + lane] = f2bf(o * QSCALE);
      else p.Km()[((((size_t)bh * (S / 32) + (s >> 5)) * 8 + (lane >> 3)) * 32 + (s & 31)) * 8 + (lane & 7)] = f2bf(o);
    }
#pragma unroll
    for (int slot = 16; slot < 24; ++slot) {
      const int h = (slot - 16) & 3, bh = b * 4 + h; const bool isk = slot >= 20;
      const float v = vin[slot];
      const float pv = __shfl(v, lane ^ 32);
      const float o = lane < 32 ? (v * cr - pv * sr) : (v * cr + pv * sr);
      const float l2g = ret_log2g(h); const int pos = s & 127;
      if (!isk) p.Qr()[((size_t)bh * S + s) * 64 + lane] = f2bf(o * exp2f((float)pos * l2g));
      else p.Kr()[((((size_t)bh * (S / 32) + (s >> 5)) * 8 + (lane >> 3)) * 32 + (s & 31)) * 8 + (lane & 7)] = f2bf(o * 0.125f * exp2f(-(float)pos * l2g));
    }
  }
  for (int idx = gtid; idx < NB * 8 * (S / 32) * 256; idx += ngt) {
    const int ln = idx & 63, ks = (idx >> 6) & 1, mb = (idx >> 7) & 1, tile = (idx >> 8) % (S / 32), bh = idx / (256 * (S / 32));
    const int b = bh >> 3, h = bh & 7, hh = ln >> 5, delta = mb * 32 + (ln & 31);
    float v[8];
#pragma unroll
    for (int j = 0; j < 8; ++j) { const int kappa = 16 * ks + 8 * (j >> 2) + 4 * hh + (j & 3), s = tile * 32 + kappa; v[j] = bf2f(p.projb()[(size_t)(b * S + s) * INW + OFF_VM + h * 64 + delta]); }
    uint4 o; o.x = pk_bf16(v[0], v[1]); o.y = pk_bf16(v[2], v[3]); o.z = pk_bf16(v[4], v[5]); o.w = pk_bf16(v[6], v[7]);
    *(uint4*)(p.Vm() + (size_t)idx * 8) = o;
  }
  for (int idx = gtid; idx < 2 * NB * 4 * (S / 32) * 256; idx += ngt) {
    const int ln = idx & 63, ks = (idx >> 6) & 1, blk = (idx >> 7) & 1, tile = (idx >> 8) % (S / 32), rest = idx / (256 * (S / 32)), bh = rest % (NB * 4), which = rest / (NB * 4);
    const int b = bh >> 2, h = bh & 3, hh = ln >> 5, delta = blk * 32 + (ln & 31);
    const float l2g = ret_log2g(h);
    float v[8];
#pragma unroll
    for (int j = 0; j < 8; ++j) {
      const int kappa = 16 * ks + 8 * (j >> 2) + 4 * hh + (j & 3), s = tile * 32 + kappa;
      const bf16_t* row = p.projb() + (size_t)(b * S + s) * INW;
      float x;
      if (which) {
        const float a = bf2f(row[OFF_KR + h * 64 + delta]), pa = bf2f(row[OFF_KR + h * 64 + (delta ^ 32)]);
        const int i = delta & 31; const float c = p.cosr()[s * 32 + i], sn = p.sinr()[s * 32 + i];
        x = (delta < 32 ? (a * c - pa * sn) : (a * c + pa * sn)) * 0.125f * exp2f(-(float)(s & 127) * l2g);
      } else x = bf2f(row[OFF_VR + h * 64 + delta]);
      v[j] = x;
    }
    uint4 o; o.x = pk_bf16(v[0], v[1]); o.y = pk_bf16(v[2], v[3]); o.z = pk_bf16(v[4], v[5]); o.w = pk_bf16(v[6], v[7]);
    *(uint4*)((which ? p.Krv() : p.Vr()) + ((size_t)(idx % (NB * 4 * (S / 32) * 256))) * 8) = o;
  }
}
__device__ __forceinline__ void phase_kmean2(const Params& p, int gtid, int ngt) {
  for (int idx = gtid; idx < NB * 8 * 16 * 64; idx += ngt) {
    const int d = idx & 63, j = (idx >> 6) & 15, bh = idx >> 10, c = d >> 3, dj = d & 7;
    float acc = 0.f;
    for (int tl = 0; tl < 8; ++tl) {
      const bf16_t* kp = p.Km() + (((size_t)bh * (S / 32) + j * 8 + tl) * 8 + c) * 256 + dj;
#pragma unroll 8
      for (int key = 0; key < 32; ++key) acc += bf2f(kp[key * 8]);
    }
    p.kmean()[idx] = acc * (1.0f / 256.0f);
  }
}

__device__ __forceinline__ void cvt_f32_bf16(const float* __restrict__ src, bf16_t* __restrict__ dst, size_t n8, int gtid, int ngt) {
  for (size_t i = gtid; i < n8; i += ngt) {
    float4 a = *(const float4*)(src + i * 8), b4 = *(const float4*)(src + i * 8 + 4);
    uint4 o; o.x = pk_bf16(a.x, a.y); o.y = pk_bf16(a.z, a.w); o.z = pk_bf16(b4.x, b4.y); o.w = pk_bf16(b4.z, b4.w);
    *(uint4*)(dst + i * 8) = o;
  }
}
__device__ __forceinline__ int f2key(float f) { int b = __float_as_int(f); return b ^ ((b >> 31) & 0x7fffffff); }
__device__ __forceinline__ float key2f(int k) { return __int_as_float(k ^ ((k >> 31) & 0x7fffffff)); }
#define CASD(a_, b_) { int mx_ = max(a_, b_), mn_ = min(a_, b_); a_ = mx_; b_ = mn_; }
__device__ __forceinline__ void sort16_desc(int (&v)[16]) {
#pragma unroll
  for (int k = 2; k <= 16; k <<= 1)
#pragma unroll
    for (int j = k >> 1; j > 0; j >>= 1)
#pragma unroll
      for (int i = 0; i < 16; ++i) { const int l2 = i ^ j; if (l2 > i) { if ((i & k) == 0) CASD(v[i], v[l2]) else CASD(v[l2], v[i]) } }
}
__device__ __forceinline__ void merge_top16(int (&a)[16], const int (&b)[16]) {
#pragma unroll
  for (int i = 0; i < 16; ++i) a[i] = max(a[i], b[15 - i]);
#pragma unroll
  for (int j = 8; j > 0; j >>= 1)
#pragma unroll
    for (int i = 0; i < 16; ++i) { const int l2 = i ^ j; if (l2 > i) CASD(a[i], a[l2]) }
}
__device__ __forceinline__ int lut4(int w0, int w1, int w2, int w3, int i) {
  const int w = i >> 2; const int d = (w == 0) ? w0 : (w == 1) ? w1 : (w == 2) ? w2 : w3;
  return (d >> ((i & 3) * 8)) & 127;
}

__device__ __forceinline__ void phase_peer_topk(const Params& p, int l, int gw, int ngw, int lane) {
  const int n = lane & 31, hh = lane >> 5;
  const bf16_t* skl = p.skb() + (size_t)l * 16 * 128 * 64;
  for (int w = gw; w < (T / 32) * 8; w += ngw) {
    const int tg = w >> 3, h = w & 7, t = tg * 32 + n;
    int L0[16], L1[16];
#pragma unroll
    for (int c = 0; c < 2; ++c) {
      const int hc = 2 * h + c;
      bf16x8 qf[4];
#pragma unroll
      for (int s = 0; s < 4; ++s) qf[s] = *(const bf16x8*)(p.qb() + (size_t)t * D + hc * 64 + 16 * s + 8 * hh);
      int A[16], Bq[16];
#pragma unroll
      for (int mb = 0; mb < 4; ++mb) {
        f32x16 X;
#pragma unroll
        for (int r = 0; r < 16; ++r) X[r] = 0.f;
#pragma unroll
        for (int s = 0; s < 4; ++s) {
          const bf16x8 kf = *(const bf16x8*)(skl + ((size_t)(hc * 128 + mb * 32 + n)) * 64 + 16 * s + 8 * hh);
          X = __builtin_amdgcn_mfma_f32_32x32x16_bf16(kf, qf[s], X, 0, 0, 0);
        }
        int Gk[16];
#pragma unroll
        for (int r = 0; r < 16; ++r) Gk[r] = (f2key(X[r]) & ~127) | (mb * 32 + (r & 3) + 8 * (r >> 2) + 4 * hh);
        sort16_desc(Gk);
        if (mb == 0) {
#pragma unroll
          for (int r = 0; r < 16; ++r) A[r] = Gk[r];
        } else merge_top16(A, Gk);
      }
#pragma unroll
      for (int r = 0; r < 16; ++r) Bq[r] = __shfl_xor(A[r], 32);
      merge_top16(A, Bq);
#pragma unroll
      for (int r = 0; r < 16; ++r) { if (c == 0) L0[r] = A[r]; else L1[r] = A[r]; }
    }
    float av[16], bv[16];
#pragma unroll
    for (int r = 0; r < 16; ++r) { av[r] = key2f(L0[r] & ~127); bv[r] = key2f(L1[r] & ~127); }
#define CAND(i_, j_) ((f2key(av[i_] + bv[j_]) & ~255) | ((i_) << 4) | (j_))
    int R[16], G1[16], G2[16];
#pragma unroll
    for (int j = 0; j < 16; ++j) R[j] = CAND(0, j);
    G1[0] = CAND(1, 0); G1[1] = CAND(1, 1); G1[2] = CAND(1, 2); G1[3] = CAND(1, 3); G1[4] = CAND(1, 4); G1[5] = CAND(1, 5); G1[6] = CAND(1, 6); G1[7] = CAND(1, 7);
    G1[8] = CAND(2, 0); G1[9] = CAND(2, 1); G1[10] = CAND(2, 2); G1[11] = CAND(2, 3); G1[12] = CAND(2, 4); G1[13] = CAND(3, 0); G1[14] = CAND(3, 1); G1[15] = CAND(3, 2);
    G2[0] = CAND(3, 3); G2[1] = CAND(4, 0); G2[2] = CAND(4, 1); G2[3] = CAND(4, 2); G2[4] = CAND(5, 0); G2[5] = CAND(5, 1); G2[6] = CAND(6, 0); G2[7] = CAND(6, 1);
    G2[8] = CAND(7, 0); G2[9] = CAND(7, 1); G2[10] = CAND(8, 0); G2[11] = CAND(9, 0); G2[12] = CAND(10, 0); G2[13] = CAND(11, 0); G2[14] = CAND(12, 0); G2[15] = CAND(13, 0);
    sort16_desc(G1); merge_top16(R, G1);
    sort16_desc(G2); merge_top16(R, G2);
    { int x0 = CAND(14, 0), x1 = CAND(15, 0);
#pragma unroll
      for (int i = 0; i < 16; ++i) CASD(R[i], x0)
#pragma unroll
      for (int i = 0; i < 16; ++i) CASD(R[i], x1)
    }
#undef CAND
    int pa0 = 0, pa1 = 0, pa2 = 0, pa3 = 0, pb0 = 0, pb1 = 0, pb2 = 0, pb3 = 0;
#pragma unroll
    for (int q = 0; q < 4; ++q) {
      pa0 |= (L0[q] & 127) << (8 * q); pa1 |= (L0[4 + q] & 127) << (8 * q); pa2 |= (L0[8 + q] & 127) << (8 * q); pa3 |= (L0[12 + q] & 127) << (8 * q);
      pb0 |= (L1[q] & 127) << (8 * q); pb1 |= (L1[4 + q] & 127) << (8 * q); pb2 |= (L1[8 + q] & 127) << (8 * q); pb3 |= (L1[12 + q] & 127) << (8 * q);
    }
    float ev[16], sum = 0.f; int ei[16];
    const float mx = key2f(R[0] & ~255);
#pragma unroll
    for (int z = 0; z < 16; ++z) {
      const float v = key2f(R[z] & ~255);
      ev[z] = __expf(v - mx); sum += ev[z];
      const int pay = R[z] & 255;
      ei[z] = lut4(pa0, pa1, pa2, pa3, pay >> 4) * 128 + lut4(pb0, pb1, pb2, pb3, pay & 15);
    }
    const float inv = 1.0f / sum;
    if (hh == 0) {
      float* go = p.gates() + ((size_t)t * 8 + h) * 16; int* eo = p.eidx() + ((size_t)t * 8 + h) * 16;
#pragma unroll
      for (int z = 0; z < 16; z += 4) {
        *(float4*)(go + z) = make_float4(ev[z] * inv, ev[z + 1] * inv, ev[z + 2] * inv, ev[z + 3] * inv);
        *(int4*)(eo + z) = make_int4(ei[z], ei[z + 1], ei[z + 2], ei[z + 3]);
      }
    }
  }
}


typedef int v8i __attribute__((ext_vector_type(8)));
__device__ __forceinline__ unsigned xcc_id() { return (unsigned)__builtin_amdgcn_s_getreg((3 << 11) | 20) & 7u; }
__device__ __forceinline__ float pow2_scale(float amax) {
  if (!(amax > 0.f)) return 1.0f;
  const int e = (int)floorf(log2f(240.0f / amax));
  return exp2f((float)(e < 60 ? (e > -60 ? e : -60) : 60));
}
__device__ __forceinline__ unsigned pack4_fp8(float a, float b, float c, float d) {
  int v = __builtin_amdgcn_cvt_pk_fp8_f32(a, b, 0, false);
  v = __builtin_amdgcn_cvt_pk_fp8_f32(c, d, v, true);
  return (unsigned)v;
}
__device__ __forceinline__ void cvt_table_fp8(const float* __restrict__ src, unsigned char* __restrict__ dst, float* __restrict__ scl, int gw, int ngw, int lane) {
  for (int e0 = gw; e0 < 16384; e0 += 2 * ngw) {
    float4 v[2][4];
#pragma unroll
    for (int u = 0; u < 2; ++u) { const int e = (e0 + u * ngw < 16384) ? e0 + u * ngw : e0;
#pragma unroll
      for (int k = 0; k < 4; ++k) v[u][k] = *(const float4*)(src + (size_t)e * D + k * 256 + lane * 4); }
#pragma unroll
    for (int u = 0; u < 2; ++u) {
      const int e = e0 + u * ngw;
      if (e < 16384) {
        float am = 0.f;
#pragma unroll
        for (int k = 0; k < 4; ++k) am = fmaxf(am, fmaxf(fmaxf(fabsf(v[u][k].x), fabsf(v[u][k].y)), fmaxf(fabsf(v[u][k].z), fabsf(v[u][k].w))));
        am = wave_max(am);
        const float s = pow2_scale(am);
        if (lane == 0) scl[e] = s;
#pragma unroll
        for (int k = 0; k < 4; ++k) {
          const int slice = 2 * k + (lane >> 5), off = (lane & 31) * 4;
          *(unsigned*)(dst + ((size_t)slice * 16384 + e) * 128 + off) = pack4_fp8(v[u][k].x * s, v[u][k].y * s, v[u][k].z * s, v[u][k].w * s);
        }
      }
    }
  }
}
#define DPP_ADD(v_, ctrl_) ((v_) + __builtin_bit_cast(float, __builtin_amdgcn_update_dpp(0, __builtin_bit_cast(int, (v_)), (ctrl_), 0xF, 0xF, true)))
__device__ __forceinline__ float sum_xor16(float x) { float a = x, b = x; asm volatile("v_nop\n\tv_nop\n\tv_permlane16_swap_b32 %0, %1" : "+v"(a), "+v"(b)); return a + b; }
__device__ __forceinline__ float sum_xor32(float x) { float a = x, b = x; asm volatile("v_nop\n\tv_nop\n\tv_permlane32_swap_b32 %0, %1" : "+v"(a), "+v"(b)); return a + b; }
__device__ __forceinline__ int q_pull(int* head, int nitems, int* bc, int tid) {
  __syncthreads();
  if (tid == 0) bc[0] = atomicAdd(head, 1);
  __syncthreads();
  const int v = bc[0];
  return v < nitems ? v : -1;
}
constexpr int PEER_TILE = 128;
__device__ __forceinline__ void phase_peer_u(const Params& p, int* heads, unsigned char* lds, int tid) {
  const int lane = tid & 63, wv = tid >> 6, r8 = lane >> 3, c8 = lane & 7;
  int* bc = (int*)lds;
  int* eW = (int*)(lds + 1024 + wv * 12288);
  bf16_t* hW = (bf16_t*)(lds + 1024 + wv * 12288 + 8192);
  const int myx = (int)xcc_id();
  for (int pass = 0; pass < 8; ++pass) {
    const int s = (myx + pass) & 7;
    const unsigned char* Us = p.U8s() + (size_t)s * 16384 * 128 + c8 * 16;
    for (;;) {
      const int item = q_pull(heads + s, T / PEER_TILE, bc, tid);
      if (item < 0) break;
      const int t0 = item * PEER_TILE + wv * 16;
      LDS_FENCE();
      { uint2 ev[16];
        const bf16_t* hsrc = p.hb() + ((size_t)s * T + t0) * 128 + lane * 8;
#pragma unroll
        for (int k = 0; k < 16; ++k) ev[k] = *(const uint2*)(p.eidx() + (size_t)(t0 + k) * 128 + lane * 2);
        const uint4 hq0 = *(const uint4*)(hsrc), hq1 = *(const uint4*)(hsrc + 512), hq2 = *(const uint4*)(hsrc + 1024), hq3 = *(const uint4*)(hsrc + 1536);
#pragma unroll
        for (int k = 0; k < 16; ++k) *(uint2*)(eW + k * 128 + lane * 2) = ev[k];
        *(uint4*)(hW + lane * 8) = hq0; *(uint4*)(hW + 512 + lane * 8) = hq1; *(uint4*)(hW + 1024 + lane * 8) = hq2; *(uint4*)(hW + 1536 + lane * 8) = hq3; }
      LDS_FENCE();
      uint4 R[4][8];
#define PEER_U_LOAD(M_, BUF_) { _Pragma("unroll") for (int eb = 0; eb < 8; ++eb) R[BUF_][eb] = *(const uint4*)(Us + (size_t)eW[(M_) * 64 + eb * 8 + r8] * 128); }
      PEER_U_LOAD(0, 0) PEER_U_LOAD(1, 1) PEER_U_LOAD(2, 2)
      float hv[16]; float res0 = 0.f, res1 = 0.f;
#define PEER_U_LOADH(TOK_) { const bf16_t* hp = hW + (TOK_) * 128 + c8 * 16; const uint4 a = *(const uint4*)hp, b4 = *(const uint4*)(hp + 8); \
        const unsigned w8[8] = {a.x, a.y, a.z, a.w, b4.x, b4.y, b4.z, b4.w};                                                              \
        _Pragma("unroll") for (int z = 0; z < 8; ++z) { hv[2 * z] = __uint_as_float(w8[z] << 16); hv[2 * z + 1] = __uint_as_float(w8[z] & 0xffff0000u); } }
      PEER_U_LOADH(0)
#define PEER_U_HALF(M_, BUF_, HALF_)                                                                           \
      {                                                                                                                                   \
        if ((M_) + 3 < 32) PEER_U_LOAD((M_) + 3, ((BUF_) + 3) & 3)                                                                        \
        _Pragma("unroll") for (int eb = 0; eb < 8; ++eb) {                                                                                \
          const unsigned ww[4] = {R[BUF_][eb].x, R[BUF_][eb].y, R[BUF_][eb].z, R[BUF_][eb].w};                                            \
          float d = 0.f;                                                                                                                  \
          _Pragma("unroll") for (int q4 = 0; q4 < 4; ++q4) {                                                                              \
            const auto f01 = __builtin_amdgcn_cvt_pk_f32_fp8((int)ww[q4], false); const auto f23 = __builtin_amdgcn_cvt_pk_f32_fp8((int)ww[q4], true); \
            d = fmaf(hv[q4 * 4 + 0], f01[0], d); d = fmaf(hv[q4 * 4 + 1], f01[1], d); d = fmaf(hv[q4 * 4 + 2], f23[0], d); d = fmaf(hv[q4 * 4 + 3], f23[1], d); \
          }                                                                                                                               \
          d = DPP_ADD(d, 0xB1); d = DPP_ADD(d, 0x4E); d = DPP_ADD(d, 0x141);     \
          if ((HALF_) == 0) { if (c8 == eb) res0 = d; } else { if (c8 == eb) res1 = d; }                                                  \
        }                                                                                                                                 \
        if ((HALF_) == 1) {                                                                                                               \
          float* po = p.ppart() + ((size_t)s * T + t0 + ((M_) >> 1)) * 128;                                                               \
          po[c8 * 8 + r8] = res0; po[64 + c8 * 8 + r8] = res1;                                                                            \
          if ((M_) + 1 < 32) PEER_U_LOADH(((M_) >> 1) + 1)                                                                                \
        }                                                                                                                                 \
      }
#pragma unroll
      for (int m4 = 0; m4 < 32; m4 += 4) {
        PEER_U_HALF(m4, 0, 0) PEER_U_HALF(m4 + 1, 1, 1) PEER_U_HALF(m4 + 2, 2, 0) PEER_U_HALF(m4 + 3, 3, 1)
      }
#undef PEER_U_HALF
#undef PEER_U_LOADH
#undef PEER_U_LOAD
    }
  }
}
__device__ __forceinline__ void phase_peer_r(const Params& p, int gtid, int ngt) {
  for (int idx0 = gtid; idx0 < T * 128; idx0 += 4 * ngt) {
    float d[4]; int e[4]; float su_[4], sv_[4], g_[4]; bool ok[4];
#pragma unroll
    for (int u = 0; u < 4; ++u) { const int idx = idx0 + u * ngt; ok[u] = idx < T * 128; const int ix = ok[u] ? idx : 0;
      e[u] = p.eidx()[ix]; g_[u] = p.gates()[ix]; float a = 0.f;
#pragma unroll
      for (int s = 0; s < 8; ++s) a += p.ppart()[(size_t)s * T * 128 + ix];
      d[u] = a; }
#pragma unroll
    for (int u = 0; u < 4; ++u) { su_[u] = p.su()[e[u]]; sv_[u] = p.sv()[e[u]]; }
#pragma unroll
    for (int u = 0; u < 4; ++u) if (ok[u]) p.gates()[idx0 + u * ngt] = g_[u] * gelu_tanh(d[u] * p.rstd()[(idx0 + u * ngt) >> 7] / su_[u]) / sv_[u];
  }
}
__device__ __forceinline__ void phase_peer_v(const Params& p, int* heads, unsigned char* lds, int tid) {
  const int lane = tid & 63, wv = tid >> 6, r8 = lane >> 3, c8 = lane & 7;
  int* bc = (int*)lds;
  uint2* pW = (uint2*)(lds + 1024 + wv * 16384);
  const int myx = (int)xcc_id();
  for (int pass = 0; pass < 8; ++pass) {
    const int s = (myx + pass) & 7;
    const unsigned char* Vs = p.V8s() + (size_t)s * 16384 * 128 + c8 * 16;
    for (;;) {
      const int item = q_pull(heads + s, T / PEER_TILE, bc, tid);
      if (item < 0) break;
      const int t0 = item * PEER_TILE + wv * 16;
      LDS_FENCE();
      { uint2 e2[16], g2[16];
#pragma unroll
        for (int k = 0; k < 16; ++k) { e2[k] = *(const uint2*)(p.eidx() + (size_t)(t0 + k) * 128 + lane * 2); g2[k] = *(const uint2*)(p.gates() + (size_t)(t0 + k) * 128 + lane * 2); }
#pragma unroll
        for (int k = 0; k < 16; ++k) *(uint4*)(pW + k * 128 + lane * 2) = make_uint4(e2[k].x, g2[k].x, e2[k].y, g2[k].y); }
      LDS_FENCE();
      const int rowk = lane >> 4, prow = ((rowk & 1) << 1) | (rowk >> 1);
      const bool wr_lane = (lane & 8) == 0;
      const int xoff = s * 128 + c8 * 16 + prow * 4;
      float4 xo[8];
#pragma unroll
      for (int k = 0; k < 8; ++k) xo[k] = *(const float4*)(p.outp() + (size_t)(t0 + k) * D + xoff);
      uint4 R[3][8];
#define PEER_V_LOAD(M_, BUF_) { _Pragma("unroll") for (int eb = 0; eb < 8; ++eb) R[BUF_][eb] = *(const uint4*)(Vs + (size_t)pW[(M_) * 64 + eb * 8 + r8].x * 128); }
      PEER_V_LOAD(0, 0) PEER_V_LOAD(1, 1)
      float acc[16];
#define PEER_V_HALF(M_, BUF_, HALF_)                                                           \
      {                                                                                                                                   \
        if ((M_) + 2 < 32) PEER_V_LOAD((M_) + 2, ((BUF_) + 2) % 3)                                                                        \
        if ((HALF_) == 0) { _Pragma("unroll") for (int z = 0; z < 16; ++z) acc[z] = 0.f; }                                                \
        _Pragma("unroll") for (int eb = 0; eb < 8; ++eb) {                                                                                \
          const float c = __uint_as_float(pW[(M_) * 64 + eb * 8 + r8].y);                                                                 \
          const unsigned ww[4] = {R[BUF_][eb].x, R[BUF_][eb].y, R[BUF_][eb].z, R[BUF_][eb].w};                                            \
          _Pragma("unroll") for (int q4 = 0; q4 < 4; ++q4) {                                                                              \
            const auto f01 = __builtin_amdgcn_cvt_pk_f32_fp8((int)ww[q4], false); const auto f23 = __builtin_amdgcn_cvt_pk_f32_fp8((int)ww[q4], true); \
            acc[q4 * 4 + 0] = fmaf(c, f01[0], acc[q4 * 4 + 0]); acc[q4 * 4 + 1] = fmaf(c, f01[1], acc[q4 * 4 + 1]);                       \
            acc[q4 * 4 + 2] = fmaf(c, f23[0], acc[q4 * 4 + 2]); acc[q4 * 4 + 3] = fmaf(c, f23[1], acc[q4 * 4 + 3]);                       \
          }                                                                                                                               \
        }                                                                                                                                 \
        if ((HALF_) == 1) {                                                                                                               \
          _Pragma("unroll") for (int z = 0; z < 16; ++z) acc[z] = DPP_ADD(acc[z], 0x128);                                  \
          asm volatile("v_nop\n\tv_nop\n\tv_permlane16_swap_b32 %0, %8\n\tv_permlane16_swap_b32 %1, %9\n\tv_permlane16_swap_b32 %2, %10\n\tv_permlane16_swap_b32 %3, %11\n\t" \
                       "v_permlane16_swap_b32 %4, %12\n\tv_permlane16_swap_b32 %5, %13\n\tv_permlane16_swap_b32 %6, %14\n\tv_permlane16_swap_b32 %7, %15" \
            : "+v"(acc[0]), "+v"(acc[1]), "+v"(acc[2]), "+v"(acc[3]), "+v"(acc[4]), "+v"(acc[5]), "+v"(acc[6]), "+v"(acc[7]),                   \
              "+v"(acc[8]), "+v"(acc[9]), "+v"(acc[10]), "+v"(acc[11]), "+v"(acc[12]), "+v"(acc[13]), "+v"(acc[14]), "+v"(acc[15]));               \
          _Pragma("unroll") for (int z = 0; z < 8; ++z) acc[z] += acc[z + 8];            \
          asm volatile("v_nop\n\tv_nop\n\tv_permlane32_swap_b32 %0, %4\n\tv_permlane32_swap_b32 %1, %5\n\tv_permlane32_swap_b32 %2, %6\n\tv_permlane32_swap_b32 %3, %7" \
            : "+v"(acc[0]), "+v"(acc[1]), "+v"(acc[2]), "+v"(acc[3]), "+v"(acc[4]), "+v"(acc[5]), "+v"(acc[6]), "+v"(acc[7]));                   \
          float4 dl;                                                                                                                      \
          dl.x = acc[0] + acc[4]; dl.y = acc[1] + acc[5]; dl.z = acc[2] + acc[6]; dl.w = acc[3] + acc[7];     \
          const float4 xv = xo[((M_) >> 1) & 7];                                                                                          \
          if (((M_) >> 1) + 8 < 16) xo[((M_) >> 1) & 7] = *(const float4*)(p.outp() + (size_t)(t0 + ((M_) >> 1) + 8) * D + xoff);                  \
          const float4 xn = make_float4(xv.x + dl.x, xv.y + dl.y, xv.z + dl.z, xv.w + dl.w);                                              \
          float sq = 0.f;                                                                                                                 \
          if (wr_lane) {                                                                                                                  \
            *(float4*)(p.outp() + (size_t)(t0 + ((M_) >> 1)) * D + xoff) = xn;                                                             \
            *(uint2*)(p.xb() + (size_t)(t0 + ((M_) >> 1)) * KD + xoff) = make_uint2(pk_bf16(xn.x, xn.y), pk_bf16(xn.z, xn.w));     \
            sq = (xn.x * xn.x + xn.y * xn.y) + (xn.z * xn.z + xn.w * xn.w);                                                                \
          }                                                                                                                               \
          sq = DPP_ADD(sq, 0xB1); sq = DPP_ADD(sq, 0x4E); sq = DPP_ADD(sq, 0x141); sq = DPP_ADD(sq, 0x128); sq = sum_xor16(sq); sq = sum_xor32(sq);     \
          if (lane == 0) p.ssq1()[(size_t)(t0 + ((M_) >> 1)) * 8 + s] = sq;                                                               \
        }                                                                                                                                 \
      }
#pragma unroll
      for (int m6 = 0; m6 < 30; m6 += 6) {
        PEER_V_HALF(m6, 0, 0) PEER_V_HALF(m6 + 1, 1, 1) PEER_V_HALF(m6 + 2, 2, 0) PEER_V_HALF(m6 + 3, 0, 1) PEER_V_HALF(m6 + 4, 1, 0) PEER_V_HALF(m6 + 5, 2, 1)
      }
      PEER_V_HALF(30, 0, 0) PEER_V_HALF(31, 1, 1)
#undef PEER_V_HALF
#undef PEER_V_LOAD
    }
  }
}

#if PEER_CHECK
constexpr int CHK_N = 512;
__device__ __forceinline__ float* chk_x(const Params& p) { return (float*)(p.ws + WO_ybuf); }
__device__ __forceinline__ float* chk_m(const Params& p) { return (float*)(p.ws + WO_ybuf + (size_t)CHK_N * D * 4); }
__device__ __forceinline__ float* chk_g(const Params& p) { return (float*)(p.ws + WO_ybuf + (size_t)CHK_N * D * 4 + 4096); }
__device__ __forceinline__ void chk_save(const Params& p, int gtid, int ngt) {
  for (int i = gtid; i < CHK_N * D; i += ngt) chk_x(p)[i] = p.outp()[(size_t)(i / D) * 64 * D + (i % D)];
  for (int i = gtid; i < CHK_N * 128; i += ngt) chk_g(p)[i] = p.gates()[(size_t)(i / 128) * 64 * 128 + (i % 128)];
  if (gtid < 16) chk_m(p)[gtid] = 0.f;
}
__device__ __forceinline__ void chk_apply(const Params& p, int l, float* coef, int gw, int ngw, int lane) {
  const float* g2 = p.inp(16) + l * D;
  const float* U = p.inp(19) + (size_t)l * 16384 * D; const float* V = p.inp(20) + (size_t)l * 16384 * D;
  for (int i = gw; i < CHK_N; i += ngw) {
    const int t = i * 64;
    const float r = p.rstd()[t];
    float4 hv[4];
#pragma unroll
    for (int k = 0; k < 4; ++k) {
      float4 xv = *(const float4*)(chk_x(p) + (size_t)i * D + (lane + k * 64) * 4);
      float4 gv = *(const float4*)(g2 + (lane + k * 64) * 4);
      hv[k].x = xv.x * r * gv.x; hv[k].y = xv.y * r * gv.y; hv[k].z = xv.z * r * gv.z; hv[k].w = xv.w * r * gv.w;
    }
    LDS_FENCE();
    for (int j = 0; j < 128; ++j) {
      const int e = p.eidx()[(size_t)t * 128 + j];
      const float4* up = (const float4*)(U + (size_t)e * D);
      float dsum = 0.f;
#pragma unroll
      for (int k = 0; k < 4; ++k) { float4 uv = up[lane + k * 64]; dsum += hv[k].x * uv.x + hv[k].y * uv.y + hv[k].z * uv.z + hv[k].w * uv.w; }
      dsum = wave_sum(dsum);
      if (lane == 0) coef[j] = chk_g(p)[(size_t)i * 128 + j] * gelu_tanh(dsum);
    }
    LDS_FENCE();
    float4 acc[4];
#pragma unroll
    for (int k = 0; k < 4; ++k) acc[k] = make_float4(0.f, 0.f, 0.f, 0.f);
    for (int j = 0; j < 128; ++j) {
      const int e = p.eidx()[(size_t)t * 128 + j];
      const float c = coef[j];
      const float4* vp = (const float4*)(V + (size_t)e * D);
#pragma unroll
      for (int k = 0; k < 4; ++k) { float4 vv = vp[lane + k * 64]; acc[k].x = fmaf(c, vv.x, acc[k].x); acc[k].y = fmaf(c, vv.y, acc[k].y); acc[k].z = fmaf(c, vv.z, acc[k].z); acc[k].w = fmaf(c, vv.w, acc[k].w); }
    }
    float d2 = 0.f, r2 = 0.f;
#pragma unroll
    for (int k = 0; k < 4; ++k) {
      float4 xa = *(const float4*)(p.outp() + (size_t)t * D + (lane + k * 64) * 4);
      float4 xb4 = *(const float4*)(chk_x(p) + (size_t)i * D + (lane + k * 64) * 4);
      float e0 = (xa.x - xb4.x) - acc[k].x, e1 = (xa.y - xb4.y) - acc[k].y, e2 = (xa.z - xb4.z) - acc[k].z, e3 = (xa.w - xb4.w) - acc[k].w;
      d2 += e0 * e0 + e1 * e1 + e2 * e2 + e3 * e3;
      r2 += acc[k].x * acc[k].x + acc[k].y * acc[k].y + acc[k].z * acc[k].z + acc[k].w * acc[k].w;
    }
    d2 = wave_sum(d2); r2 = wave_sum(r2);
    if (lane == 0) { atomicAdd((unsigned long long*)&chk_m(p)[8], (unsigned long long)(d2 * 1099511627776.0f)); atomicAdd((unsigned long long*)&chk_m(p)[10], (unsigned long long)(r2 * 1099511627776.0f)); }
  }
}
__device__ __forceinline__ void chk_topk(const Params& p, int l, int gtid, int ngt) {
  const float* subk = p.inp(18) + (size_t)l * 16 * 128 * 64;
  for (int it = gtid; it < CHK_N * 8; it += ngt) {
    const int i = it >> 3, h = it & 7, t = i * 64;
    float tva[16], tvb[16]; int tia[16], tib[16];
#pragma unroll 1
    for (int c = 0; c < 2; ++c) {
      float tv[16]; int ti[16];
#pragma unroll
      for (int z = 0; z < 16; ++z) { tv[z] = -INFINITY; ti[z] = 0; }
      const bf16_t* q = p.qb() + (size_t)t * D + (2 * h + c) * 64;
      const float* kb = subk + (size_t)(2 * h + c) * 128 * 64;
#pragma unroll 1
      for (int n = 0; n < 128; ++n) {
        float sc = 0.f;
        for (int d = 0; d < 64; ++d) sc = fmaf(bf2f(q[d]), kb[n * 64 + d], sc);
        float v_ = sc; int i_ = n;
#pragma unroll
        for (int z = 0; z < 16; ++z) { bool gt = v_ > tv[z]; float a = tv[z]; int b = ti[z]; tv[z] = gt ? v_ : a; ti[z] = gt ? i_ : b; v_ = gt ? a : v_; i_ = gt ? b : i_; }
      }
#pragma unroll
      for (int z = 0; z < 16; ++z) { if (c == 0) { tva[z] = tv[z]; tia[z] = ti[z]; } else { tvb[z] = tv[z]; tib[z] = ti[z]; } }
    }
    float tv[16]; int ti[16];
#pragma unroll
    for (int z = 0; z < 16; ++z) { tv[z] = -INFINITY; ti[z] = 0; }
#pragma unroll 1
    for (int a = 0; a < 16; ++a)
#pragma unroll 1
      for (int b = 0; b < 16; ++b) {
        float av = 0.f, bv = 0.f; int ai = 0, bi = 0;
#pragma unroll
        for (int z = 0; z < 16; ++z) { if (z == a) { av = tva[z]; ai = tia[z]; } if (z == b) { bv = tvb[z]; bi = tib[z]; } }
        float v_ = av + bv; int i_ = ai * 128 + bi;
#pragma unroll
        for (int z = 0; z < 16; ++z) { bool gt = v_ > tv[z]; float x = tv[z]; int y = ti[z]; tv[z] = gt ? v_ : x; ti[z] = gt ? i_ : y; v_ = gt ? x : v_; i_ = gt ? y : i_; }
      }
    float sum = 0.f, ev[16];
#pragma unroll
    for (int z = 0; z < 16; ++z) { ev[z] = expf(tv[z] - tv[0]); sum += ev[z]; }
    int miss = 0; float gerr = 0.f;
    for (int z = 0; z < 16; ++z) {
      const int ef = p.eidx()[((size_t)t * 8 + h) * 16 + z]; const float gf = p.gates()[((size_t)t * 8 + h) * 16 + z];
      bool found = false;
#pragma unroll
      for (int y = 0; y < 16; ++y) if (ti[y] == ef) { found = true; gerr = fmaxf(gerr, fabsf(ev[y] / sum - gf)); }
      if (!found) ++miss;
    }
    atomicAdd(&chk_m(p)[3], (float)miss);
    atomicMax((int*)&chk_m(p)[4], __float_as_int(gerr));
  }
}
__device__ __forceinline__ void chk_emit(const Params& p) {
  float v = 0.f;
  if (PEER_CHECK == 1) v = sqrtf((float)((double)*(unsigned long long*)&chk_m(p)[8] / (double)*(unsigned long long*)&chk_m(p)[10]));
  if (PEER_CHECK == 2) v = chk_m(p)[3] / (float)(CHK_N * 8 * 16);
  if (PEER_CHECK == 3) v = chk_m(p)[4];
  p.outp()[0] += 1.0e4f * v + 100.0f;
}
#endif

#define XB_TMO      128
#define XB_XCNT(j)  (256  + 64 * (j))
#define XB_XSUB(j)  (1280 + 64 * (j))
#define XB_XGEN(j)  (2304 + 64 * (j))
#define XB_TOP      3328
#define XB_TOPGEN   3392
#define XCD_BAR_WORDS 3456
#define XB_SPIN_CAP (1u << 18)
#define LAS __attribute__((address_space(3)))

__device__ __forceinline__ unsigned xb_ld(unsigned* p)              { return __hip_atomic_load(p, __ATOMIC_RELAXED, __HIP_MEMORY_SCOPE_AGENT); }
__device__ __forceinline__ unsigned xb_add(unsigned* p, unsigned v) { return __hip_atomic_fetch_add(p, v, __ATOMIC_RELAXED, __HIP_MEMORY_SCOPE_AGENT); }
__device__ __forceinline__ unsigned xb_xcc_id() { return (unsigned)__builtin_amdgcn_s_getreg((3 << 11) | 20) & 0xFu; }
#define XB_SPIN(cond, bar) do { unsigned _sp = 0; while (cond) { __builtin_amdgcn_s_sleep(1); \
    if ((++_sp & 255u) == 0u) { if (xb_ld(&(bar)[XB_TMO])) break; if (_sp > XB_SPIN_CAP) { atomicAdd(&(bar)[XB_TMO], 1u); break; } } } } while (0)

struct XcdBarrier {
    unsigned* bar; unsigned x;
    volatile LAS unsigned* st;
};

__device__ __forceinline__ XcdBarrier xcd_barrier_post(unsigned* bar, volatile LAS unsigned* st) {
    XcdBarrier b; b.bar = bar; b.x = xb_xcc_id(); b.st = st;
    if (threadIdx.x == 0) (void)xb_add(&bar[XB_XCNT(b.x)], 1u);
    return b;
}
__device__ __forceinline__ void xcd_barrier_complete(unsigned* bar, unsigned x, unsigned& nloc, unsigned& nx) {
    const unsigned G = gridDim.x * gridDim.y * gridDim.z;
    unsigned sum, cnt, mine, sp = 0u;
    for (;;) {
        sum = 0u; cnt = 0u; mine = 0u;
#pragma unroll
        for (unsigned j = 0; j < 16; ++j) { const unsigned c = xb_ld(&bar[XB_XCNT(j)]); sum += c; cnt += (c > 0u) ? 1u : 0u; mine = (j == x) ? c : mine; }
        if (sum == G) break;
        __builtin_amdgcn_s_sleep(1);
        if ((++sp & 255u) == 0u) { if (xb_ld(&bar[XB_TMO])) break; if (sp > XB_SPIN_CAP) { atomicAdd(&bar[XB_TMO], 1u); break; } }
    }
    nloc = mine > 0u ? mine : 1u; nx = cnt > 0u ? cnt : 1u;
}

__device__ __forceinline__ void xcd_barrier(const XcdBarrier& b) {
    asm volatile("s_waitcnt vmcnt(0)" ::: "memory");
    __syncthreads();
    if (threadIdx.x == 0) {
        unsigned* bar = b.bar;
        __builtin_amdgcn_s_waitcnt(0);
        unsigned nloc = b.st[0], nx = b.st[1];
        if (nloc == 0u) { xcd_barrier_complete(bar, b.x, nloc, nx); b.st[0] = nloc; b.st[1] = nx; }
        const unsigned old = xb_add(&bar[XB_XSUB(b.x)], 1u);
        const unsigned gen = old / nloc;
        if (old + 1u == (gen + 1u) * nloc) {
            __builtin_amdgcn_fence(__ATOMIC_RELEASE, "agent");
            asm volatile("s_waitcnt vmcnt(0)" ::: "memory");
            const unsigned og = xb_add(&bar[XB_TOP], 1u);
            const unsigned tg = og / nx;
            if (og + 1u == (tg + 1u) * nx) xb_add(&bar[XB_TOPGEN], 1u);
            else XB_SPIN(xb_ld(&bar[XB_TOPGEN]) == tg, bar);
            __builtin_amdgcn_fence(__ATOMIC_ACQUIRE, "agent");
            xb_add(&bar[XB_XGEN(b.x)], 1u);
            asm volatile("s_waitcnt vmcnt(0)" ::: "memory");
        } else {
            XB_SPIN(xb_ld(&bar[XB_XGEN(b.x)]) == gen, bar);
            __builtin_amdgcn_fence(__ATOMIC_ACQUIRE, "agent");
            asm volatile("s_waitcnt vmcnt(0)" ::: "memory");
        }
    }
    __syncthreads();
}

__device__ __forceinline__ Params fresh(const Params& p) {
  Params q = p;
  asm volatile("" : "+s"(q.ws), "+s"(q.out_));
#pragma unroll
  for (int i = 0; i < 21; ++i) asm volatile("" : "+s"(q.in[i]));
  return q;
}
#define PHASE_IDS int tid = threadIdx.x; asm volatile("" : "+v"(tid)); int bid = blockIdx.x; asm volatile("" : "+s"(bid)); int G = gridDim.x; asm volatile("" : "+s"(G)); \
  const int lane = tid & 63, wv = tid >> 6; const int ngt = G * NTHR, ngw = G * NWAVE; \
  const int gtid = bid * NTHR + tid, gw = bid * NWAVE + wv; (void)lane; (void)wv; (void)gtid; (void)gw; (void)ngt; (void)ngw; \
  const Params q = fresh(p);
__global__ void __launch_bounds__(NTHR) mega(Params p) {
  extern __shared__ __attribute__((aligned(16))) unsigned char lds_raw[];
  cg::grid_group grid = cg::this_grid();
  float* ldsf = (float*)lds_raw;
  if (threadIdx.x == 0) { *(uint4*)(lds_raw + LDS_BYTES - 16) = make_uint4(0u, 0u, 0u, 0u); }
  __syncthreads();
  XcdBarrier xb = xcd_barrier_post(p.bar(), (volatile LAS unsigned*)(lds_raw + LDS_BYTES - 16));

  { PHASE_IDS; phase_prologue(q, gtid, ngt, gw, ngw, lane); cvt_f32_bf16(q.inp(18), q.skb(), (size_t)NL * 16 * 128 * 64 / 8, gtid, ngt);
    for (size_t i = gtid; i < (size_t)16 * 128 * 512 / 8; i += ngt) { const size_t g = i / (128 * 512 / 8), r = i % (128 * 512 / 8); ((uint4*)q.S5Wz())[g * (256 * 512 / 8) + (128 * 512 / 8) + r] = make_uint4(0u, 0u, 0u, 0u); }
    if (gtid < 256) q.qctr()[gtid] = 0;
    phase_s5_prep(q, 0, gtid, ngt); }
  grid.sync();
  { constexpr int l = 0;
    DUP(5) {
    { const Params q = fresh(p); EpiScaleStoreBf16 e{q.projb(), INW, q.ssq1(), 8, nullptr};
      run_gemm(lds_raw, q.xb(), q.Win_t() + (size_t)l * INW * KD, T, INW, KD, e); }
    xcd_barrier(xb);
    }
    DUP(0) {
    { PHASE_IDS; phase_post_pack(q, l, gtid, ngt, gw, ngw, lane); phase_pack_u(q, gtid, ngt); }
    xcd_barrier(xb);
    }
    DUP(1) {
    { const Params q = fresh(p); EpiS5Z e{q.S5Z()};
      pg8::Gemm g{q.S5A(), q.S5Wz(), 16 * 1024, 16 * 256, 512, 640, 512}; pg8::GroupOrder So; So.init(16, 4, 1, (int)gridDim.x, (int)blockIdx.x);
      pg8::gemm_phase<EpiS5Z, pg8::GroupOrder, true, true>((PG8_LAS unsigned char*)lds_raw, g, So, e); }
    { PHASE_IDS; phase_kmean2(q, gtid, ngt); phase_ret_kv(q, gw, ngw, lane); }
    xcd_barrier(xb);
    }
    DUP(2) {
    { PHASE_IDS; phase_s5_scan(q, gtid, ngt); phase_ret_scan(q, gtid, ngt); }
    __syncthreads();
    { PHASE_IDS; phase_moba2(q, l, lds_raw, bid, G); }
    xcd_barrier(xb);
    }
    DUP(3) {
    { const Params q = fresh(p); EpiS5Y e{q.ygb(), q.S5A(), q.inp(10) + l * 256};
      pg8::Gemm g{q.S5A(), q.S5Wy(), 16 * 1024, 16 * 512, 640, 640, 640}; pg8::GroupOrder So; So.init(16, 4, 2, (int)gridDim.x, (int)blockIdx.x);
      pg8::gemm_phase<EpiS5Y, pg8::GroupOrder, true, true>((PG8_LAS unsigned char*)lds_raw, g, So, e); }
    __syncthreads();
    { PHASE_IDS; phase_ret_out(q, gw, ngw, lane); }
    xcd_barrier(xb);
    }
    DUP(4) {
    { const Params q = fresh(p); EpiGlu e{q.xb(), q.ygb(), (float*)(lds_raw + 131072)};
      run_gemm(lds_raw, q.ygb(), q.Wglu_t() + (size_t)l * 65536, T, 256, 256, e); }
    xcd_barrier(xb);
    }
    { PHASE_IDS; cvt_table_fp8(q.inp(19) + (size_t)l * 16384 * D, q.U8s(), q.su(), gw, ngw, lane);
      cvt_table_fp8(q.inp(20) + (size_t)l * 16384 * D, q.V8s(), q.sv(), gw, ngw, lane); }
    __syncthreads();
    { const Params q = fresh(p); EpiResid e{q.outp(), D, q.xb2(), q.hb(), q.inp(16) + l * D, q.ssq2()};
      run_gemm(lds_raw, q.xb(), q.Wout_t() + (size_t)l * D * KD, T, D, KD, e); }
    xcd_barrier(xb);
    DUP(7) {
    { const Params q = fresh(p); EpiScaleStoreBf16 e{q.qb(), D, q.ssq2(), 16, q.rstd()};
      run_gemm(lds_raw, q.xb2(), q.Wq_t() + (size_t)l * D * KD, T, D, KD, e); }
    xcd_barrier(xb);
    }
    if (!(PROBE_SKIP & 2)) {
    DUP(8) {
    { PHASE_IDS; phase_peer_topk(q, l, gw, ngw, lane); }
    xcd_barrier(xb);
    }
    }
#if PEER_CHECK
    if (l == 0) { { PHASE_IDS; chk_save(q, gtid, ngt); } xcd_barrier(xb); { PHASE_IDS; chk_topk(q, l, gtid, ngt); } xcd_barrier(xb); }
#endif
    if (!(PROBE_SKIP & 1)) {
    { PHASE_IDS; phase_peer_u(q, q.qctr() + (l * 2 + 0) * 8, lds_raw, tid); }
    xcd_barrier(xb);
    { PHASE_IDS; phase_peer_r(q, gtid, ngt); if (l + 1 < NL) phase_s5_prep(q, l + 1, gtid, ngt); }
    xcd_barrier(xb);
    if (!(PROBE_SKIP & 32)) {
    { PHASE_IDS; phase_peer_v(q, q.qctr() + (l * 2 + 1) * 8, lds_raw, tid); }
    xcd_barrier(xb);
    }
    }
#if PEER_CHECK
    if (l == 0) { { PHASE_IDS; chk_apply(q, l, ldsf + wv * 128, gw, ngw, lane); } xcd_barrier(xb);
      if (blockIdx.x == 0 && threadIdx.x == 0) { const Params q = fresh(p); chk_emit(q); } xcd_barrier(xb); }
#endif
  }
  { constexpr int l = 1;
    DUP(5) {
    { const Params q = fresh(p); EpiScaleStoreBf16 e{q.projb(), INW, q.ssq1(), 8, nullptr};
      run_gemm(lds_raw, q.xb(), q.Win_t() + (size_t)l * INW * KD, T, INW, KD, e); }
    xcd_barrier(xb);
    }
    DUP(0) {
    { PHASE_IDS; phase_post_pack(q, l, gtid, ngt, gw, ngw, lane); phase_pack_u(q, gtid, ngt); }
    xcd_barrier(xb);
    }
    DUP(1) {
    { const Params q = fresh(p); EpiS5Z e{q.S5Z()};
      pg8::Gemm g{q.S5A(), q.S5Wz(), 16 * 1024, 16 * 256, 512, 640, 512}; pg8::GroupOrder So; So.init(16, 4, 1, (int)gridDim.x, (int)blockIdx.x);
      pg8::gemm_phase<EpiS5Z, pg8::GroupOrder, true, true>((PG8_LAS unsigned char*)lds_raw, g, So, e); }
    { PHASE_IDS; phase_kmean2(q, gtid, ngt); phase_ret_kv(q, gw, ngw, lane); }
    xcd_barrier(xb);
    }
    DUP(2) {
    { PHASE_IDS; phase_s5_scan(q, gtid, ngt); phase_ret_scan(q, gtid, ngt); }
    __syncthreads();
    { PHASE_IDS; phase_moba2(q, l, lds_raw, bid, G); }
    xcd_barrier(xb);
    }
    DUP(3) {
    { const Params q = fresh(p); EpiS5Y e{q.ygb(), q.S5A(), q.inp(10) + l * 256};
      pg8::Gemm g{q.S5A(), q.S5Wy(), 16 * 1024, 16 * 512, 640, 640, 640}; pg8::GroupOrder So; So.init(16, 4, 2, (int)gridDim.x, (int)blockIdx.x);
      pg8::gemm_phase<EpiS5Y, pg8::GroupOrder, true, true>((PG8_LAS unsigned char*)lds_raw, g, So, e); }
    __syncthreads();
    { PHASE_IDS; phase_ret_out(q, gw, ngw, lane); }
    xcd_barrier(xb);
    }
    DUP(4) {
    { const Params q = fresh(p); EpiGlu e{q.xb(), q.ygb(), (float*)(lds_raw + 131072)};
      run_gemm(lds_raw, q.ygb(), q.Wglu_t() + (size_t)l * 65536, T, 256, 256, e); }
    xcd_barrier(xb);
    }
    { PHASE_IDS; cvt_table_fp8(q.inp(19) + (size_t)l * 16384 * D, q.U8s(), q.su(), gw, ngw, lane);
      cvt_table_fp8(q.inp(20) + (size_t)l * 16384 * D, q.V8s(), q.sv(), gw, ngw, lane); }
    __syncthreads();
    { const Params q = fresh(p); EpiResid e{q.outp(), D, q.xb2(), q.hb(), q.inp(16) + l * D, q.ssq2()};
      run_gemm(lds_raw, q.xb(), q.Wout_t() + (size_t)l * D * KD, T, D, KD, e); }
    xcd_barrier(xb);
    DUP(7) {
    { const Params q = fresh(p); EpiScaleStoreBf16 e{q.qb(), D, q.ssq2(), 16, q.rstd()};
      run_gemm(lds_raw, q.xb2(), q.Wq_t() + (size_t)l * D * KD, T, D, KD, e); }
    xcd_barrier(xb);
    }
    if (!(PROBE_SKIP & 2)) {
    DUP(8) {
    { PHASE_IDS; phase_peer_topk(q, l, gw, ngw, lane); }
    xcd_barrier(xb);
    }
    }
#if PEER_CHECK
    if (l == 0) { { PHASE_IDS; chk_save(q, gtid, ngt); } xcd_barrier(xb); { PHASE_IDS; chk_topk(q, l, gtid, ngt); } xcd_barrier(xb); }
#endif
    if (!(PROBE_SKIP & 1)) {
    { PHASE_IDS; phase_peer_u(q, q.qctr() + (l * 2 + 0) * 8, lds_raw, tid); }
    xcd_barrier(xb);
    { PHASE_IDS; phase_peer_r(q, gtid, ngt); if (l + 1 < NL) phase_s5_prep(q, l + 1, gtid, ngt); }
    xcd_barrier(xb);
    if (!(PROBE_SKIP & 32)) {
    { PHASE_IDS; phase_peer_v(q, q.qctr() + (l * 2 + 1) * 8, lds_raw, tid); }
    xcd_barrier(xb);
    }
    }
#if PEER_CHECK
    if (l == 0) { { PHASE_IDS; chk_apply(q, l, ldsf + wv * 128, gw, ngw, lane); } xcd_barrier(xb);
      if (blockIdx.x == 0 && threadIdx.x == 0) { const Params q = fresh(p); chk_emit(q); } xcd_barrier(xb); }
#endif
  }
  { constexpr int l = 2;
    DUP(5) {
    { const Params q = fresh(p); EpiScaleStoreBf16 e{q.projb(), INW, q.ssq1(), 8, nullptr};
      run_gemm(lds_raw, q.xb(), q.Win_t() + (size_t)l * INW * KD, T, INW, KD, e); }
    xcd_barrier(xb);
    }
    DUP(0) {
    { PHASE_IDS; phase_post_pack(q, l, gtid, ngt, gw, ngw, lane); phase_pack_u(q, gtid, ngt); }
    xcd_barrier(xb);
    }
    DUP(1) {
    { const Params q = fresh(p); EpiS5Z e{q.S5Z()};
      pg8::Gemm g{q.S5A(), q.S5Wz(), 16 * 1024, 16 * 256, 512, 640, 512}; pg8::GroupOrder So; So.init(16, 4, 1, (int)gridDim.x, (int)blockIdx.x);
      pg8::gemm_phase<EpiS5Z, pg8::GroupOrder, true, true>((PG8_LAS unsigned char*)lds_raw, g, So, e); }
    { PHASE_IDS; phase_kmean2(q, gtid, ngt); phase_ret_kv(q, gw, ngw, lane); }
    xcd_barrier(xb);
    }
    DUP(2) {
    { PHASE_IDS; phase_s5_scan(q, gtid, ngt); phase_ret_scan(q, gtid, ngt); }
    __syncthreads();
    { PHASE_IDS; phase_moba2(q, l, lds_raw, bid, G); }
    xcd_barrier(xb);
    }
    DUP(3) {
    { const Params q = fresh(p); EpiS5Y e{q.ygb(), q.S5A(), q.inp(10) + l * 256};
      pg8::Gemm g{q.S5A(), q.S5Wy(), 16 * 1024, 16 * 512, 640, 640, 640}; pg8::GroupOrder So; So.init(16, 4, 2, (int)gridDim.x, (int)blockIdx.x);
      pg8::gemm_phase<EpiS5Y, pg8::GroupOrder, true, true>((PG8_LAS unsigned char*)lds_raw, g, So, e); }
    __syncthreads();
    { PHASE_IDS; phase_ret_out(q, gw, ngw, lane); }
    xcd_barrier(xb);
    }
    DUP(4) {
    { const Params q = fresh(p); EpiGlu e{q.xb(), q.ygb(), (float*)(lds_raw + 131072)};
      run_gemm(lds_raw, q.ygb(), q.Wglu_t() + (size_t)l * 65536, T, 256, 256, e); }
    xcd_barrier(xb);
    }
    { PHASE_IDS; cvt_table_fp8(q.inp(19) + (size_t)l * 16384 * D, q.U8s(), q.su(), gw, ngw, lane);
      cvt_table_fp8(q.inp(20) + (size_t)l * 16384 * D, q.V8s(), q.sv(), gw, ngw, lane); }
    __syncthreads();
    { const Params q = fresh(p); EpiResid e{q.outp(), D, q.xb2(), q.hb(), q.inp(16) + l * D, q.ssq2()};
      run_gemm(lds_raw, q.xb(), q.Wout_t() + (size_t)l * D * KD, T, D, KD, e); }
    xcd_barrier(xb);
    DUP(7) {
    { const Params q = fresh(p); EpiScaleStoreBf16 e{q.qb(), D, q.ssq2(), 16, q.rstd()};
      run_gemm(lds_raw, q.xb2(), q.Wq_t() + (size_t)l * D * KD, T, D, KD, e); }
    xcd_barrier(xb);
    }
    if (!(PROBE_SKIP & 2)) {
    DUP(8) {
    { PHASE_IDS; phase_peer_topk(q, l, gw, ngw, lane); }
    xcd_barrier(xb);
    }
    }
#if PEER_CHECK
    if (l == 0) { { PHASE_IDS; chk_save(q, gtid, ngt); } xcd_barrier(xb); { PHASE_IDS; chk_topk(q, l, gtid, ngt); } xcd_barrier(xb); }
#endif
    if (!(PROBE_SKIP & 1)) {
    { PHASE_IDS; phase_peer_u(q, q.qctr() + (l * 2 + 0) * 8, lds_raw, tid); }
    xcd_barrier(xb);
    { PHASE_IDS; phase_peer_r(q, gtid, ngt); if (l + 1 < NL) phase_s5_prep(q, l + 1, gtid, ngt); }
    xcd_barrier(xb);
    if (!(PROBE_SKIP & 32)) {
    { PHASE_IDS; phase_peer_v(q, q.qctr() + (l * 2 + 1) * 8, lds_raw, tid); }
    xcd_barrier(xb);
    }
    }
#if PEER_CHECK
    if (l == 0) { { PHASE_IDS; chk_apply(q, l, ldsf + wv * 128, gw, ngw, lane); } xcd_barrier(xb);
      if (blockIdx.x == 0 && threadIdx.x == 0) { const Params q = fresh(p); chk_emit(q); } xcd_barrier(xb); }
#endif
  }
  { constexpr int l = 3;
    DUP(5) {
    { const Params q = fresh(p); EpiScaleStoreBf16 e{q.projb(), INW, q.ssq1(), 8, nullptr};
      run_gemm(lds_raw, q.xb(), q.Win_t() + (size_t)l * INW * KD, T, INW, KD, e); }
    xcd_barrier(xb);
    }
    DUP(0) {
    { PHASE_IDS; phase_post_pack(q, l, gtid, ngt, gw, ngw, lane); phase_pack_u(q, gtid, ngt); }
    xcd_barrier(xb);
    }
    DUP(1) {
    { const Params q = fresh(p); EpiS5Z e{q.S5Z()};
      pg8::Gemm g{q.S5A(), q.S5Wz(), 16 * 1024, 16 * 256, 512, 640, 512}; pg8::GroupOrder So; So.init(16, 4, 1, (int)gridDim.x, (int)blockIdx.x);
      pg8::gemm_phase<EpiS5Z, pg8::GroupOrder, true, true>((PG8_LAS unsigned char*)lds_raw, g, So, e); }
    { PHASE_IDS; phase_kmean2(q, gtid, ngt); phase_ret_kv(q, gw, ngw, lane); }
    xcd_barrier(xb);
    }
    DUP(2) {
    { PHASE_IDS; phase_s5_scan(q, gtid, ngt); phase_ret_scan(q, gtid, ngt); }
    __syncthreads();
    { PHASE_IDS; phase_moba2(q, l, lds_raw, bid, G); }
    xcd_barrier(xb);
    }
    DUP(3) {
    { const Params q = fresh(p); EpiS5Y e{q.ygb(), q.S5A(), q.inp(10) + l * 256};
      pg8::Gemm g{q.S5A(), q.S5Wy(), 16 * 1024, 16 * 512, 640, 640, 640}; pg8::GroupOrder So; So.init(16, 4, 2, (int)gridDim.x, (int)blockIdx.x);
      pg8::gemm_phase<EpiS5Y, pg8::GroupOrder, true, true>((PG8_LAS unsigned char*)lds_raw, g, So, e); }
    __syncthreads();
    { PHASE_IDS; phase_ret_out(q, gw, ngw, lane); }
    xcd_barrier(xb);
    }
    DUP(4) {
    { const Params q = fresh(p); EpiGlu e{q.xb(), q.ygb(), (float*)(lds_raw + 131072)};
      run_gemm(lds_raw, q.ygb(), q.Wglu_t() + (size_t)l * 65536, T, 256, 256, e); }
    xcd_barrier(xb);
    }
    { PHASE_IDS; cvt_table_fp8(q.inp(19) + (size_t)l * 16384 * D, q.U8s(), q.su(), gw, ngw, lane);
      cvt_table_fp8(q.inp(20) + (size_t)l * 16384 * D, q.V8s(), q.sv(), gw, ngw, lane); }
    __syncthreads();
    { const Params q = fresh(p); EpiResid e{q.outp(), D, q.xb2(), q.hb(), q.inp(16) + l * D, q.ssq2()};
      run_gemm(lds_raw, q.xb(), q.Wout_t() + (size_t)l * D * KD, T, D, KD, e); }
    xcd_barrier(xb);
    DUP(7) {
    { const Params q = fresh(p); EpiScaleStoreBf16 e{q.qb(), D, q.ssq2(), 16, q.rstd()};
      run_gemm(lds_raw, q.xb2(), q.Wq_t() + (size_t)l * D * KD, T, D, KD, e); }
    xcd_barrier(xb);
    }
    if (!(PROBE_SKIP & 2)) {
    DUP(8) {
    { PHASE_IDS; phase_peer_topk(q, l, gw, ngw, lane); }
    xcd_barrier(xb);
    }
    }
#if PEER_CHECK
    if (l == 0) { { PHASE_IDS; chk_save(q, gtid, ngt); } xcd_barrier(xb); { PHASE_IDS; chk_topk(q, l, gtid, ngt); } xcd_barrier(xb); }
#endif
    if (!(PROBE_SKIP & 1)) {
    { PHASE_IDS; phase_peer_u(q, q.qctr() + (l * 2 + 0) * 8, lds_raw, tid); }
    xcd_barrier(xb);
    { PHASE_IDS; phase_peer_r(q, gtid, ngt); if (l + 1 < NL) phase_s5_prep(q, l + 1, gtid, ngt); }
    xcd_barrier(xb);
    if (!(PROBE_SKIP & 32)) {
    { PHASE_IDS; phase_peer_v(q, q.qctr() + (l * 2 + 1) * 8, lds_raw, tid); }
    xcd_barrier(xb);
    }
    }
#if PEER_CHECK
    if (l == 0) { { PHASE_IDS; chk_apply(q, l, ldsf + wv * 128, gw, ngw, lane); } xcd_barrier(xb);
      if (blockIdx.x == 0 && threadIdx.x == 0) { const Params q = fresh(p); chk_emit(q); } xcd_barrier(xb); }
#endif
  }
}

}

extern "C" void kernel_launch(void* const* d_in, const int* in_sizes, int n_in, void* d_out, int out_size, void* d_ws, size_t ws_size,
                              hipStream_t stream) {
  static int grid_blocks = 0;
  if (!grid_blocks) {
    int dev = 0, cus = 0, per_cu = 0;
    hipGetDevice(&dev);
    hipDeviceGetAttribute(&cus, hipDeviceAttributeMultiprocessorCount, dev);
    hipFuncSetAttribute((const void*)mega, hipFuncAttributeMaxDynamicSharedMemorySize, LDS_BYTES);
    hipOccupancyMaxActiveBlocksPerMultiprocessor(&per_cu, (const void*)mega, NTHR, LDS_BYTES);
    if (per_cu < 1) { fprintf(stderr, "occupancy query returned %d\n", per_cu); per_cu = 1; }
    grid_blocks = cus * 1;
    if (grid_blocks < 64) fprintf(stderr, "unexpected CU count %d\n", cus);
  }
  Params p{};
  for (int i = 0; i < 21; ++i) p.in[i] = (const GAS float*)d_in[i];
  p.out_ = (GAS float*)d_out;
  p.ws = (GAS unsigned char*)d_ws;
  if (WS_TOTAL > ws_size) { fprintf(stderr, "workspace too small: need %zu have %zu\n", (size_t)WS_TOTAL, ws_size); return; }
  hipMemsetAsync((unsigned char*)d_ws + WO_bar, 0, 16384, stream);
  void* args[] = {&p};
  hipError_t e = hipLaunchCooperativeKernel((const void*)mega, dim3(grid_blocks), dim3(NTHR), args, LDS_BYTES, stream);
  if (e != hipSuccess) fprintf(stderr, "cooperative launch failed: %s (grid %d)\n", hipGetErrorString(e), grid_blocks);
}
```

```cpp
#include <hip/hip_runtime.h>
#include <hip/hip_cooperative_groups.h>
#include <math.h>
#include <stdint.h>
#include <stdio.h>
namespace cg = cooperative_groups;

#ifndef PEER_CHECK
#define PEER_CHECK 0
#endif
#ifndef PROBE_DUP
#define PROBE_DUP 0
#endif
__device__ __forceinline__ int dup_n(int n) { asm volatile("" : "+s"(n)); return n; }
#define DUP(bit) _Pragma("unroll 1") for (int rep_ = 0, repn_ = (((PROBE_DUP >> (bit)) & 1) ? dup_n(2) : 1); rep_ < repn_; ++rep_)
#ifndef PROBE_SKIP
#define PROBE_SKIP 0
#endif
#ifndef PRECISE
#define PRECISE 0
#endif

namespace {
constexpr int NB = 8, S = 4096, D = 1024, NL = 4, T = NB * S;
constexpr int INW = 2816;
constexpr int OFF_U = 0, OFF_QM = 256, OFF_KM = 768, OFF_VM = 1280, OFF_QR = 1792, OFF_KR = 2048, OFF_VR = 2304, OFF_GR = 2560;
constexpr float EPS = 1e-6f;
static_assert(PRECISE == 0, "PRECISE builds are retired");
constexpr int KS = PRECISE ? 3 : 1;
constexpr int KD = D * KS;
constexpr int NTHR = 512, NWAVE = 8;
constexpr int LDS_BYTES = 131072 + 4096 + 1024;

typedef unsigned short bf16_t;
using bf16x8 = __attribute__((ext_vector_type(8))) short;
using f32x4 = __attribute__((ext_vector_type(4))) float;

__device__ __forceinline__ float wave_sum(float v) {
#pragma unroll
  for (int o = 32; o > 0; o >>= 1) v += __shfl_xor(v, o);
  return v;
}
__device__ __forceinline__ float wave_max(float v) {
#pragma unroll
  for (int o = 32; o > 0; o >>= 1) v = fmaxf(v, __shfl_xor(v, o));
  return v;
}
__device__ __forceinline__ float gelu_tanh(float x) {
  const float k0 = 0.7978845608028654f, k1 = 0.044715f;
  float u = k0 * (x + k1 * x * x * x);
  return 0.5f * x * (1.0f + tanhf(u));
}
__device__ __forceinline__ float sigmoidf_(float x) { return 1.0f / (1.0f + expf(-x)); }
__device__ __forceinline__ float fast_sigmoid(float x) { return __builtin_amdgcn_rcpf(1.0f + __builtin_amdgcn_exp2f(-1.4426950408889634f * x)); }
__device__ __forceinline__ float fast_gelu(float x) { const float u = 0.7978845608028654f * (x + 0.044715f * x * x * x); return x * fast_sigmoid(2.0f * u); }
__device__ __forceinline__ bf16_t f2bf(float f) {
  unsigned u = __float_as_uint(f);
  u += 0x7fffu + ((u >> 16) & 1u);
  return (bf16_t)(u >> 16);
}
__device__ __forceinline__ float bf2f(bf16_t h) { return __uint_as_float(((unsigned)h) << 16); }
#define LDS_FENCE() asm volatile("s_waitcnt lgkmcnt(0)" ::: "memory")
typedef __bf16 bf16x2_hw __attribute__((ext_vector_type(2)));
typedef float f32x2_hw __attribute__((ext_vector_type(2)));
__device__ __forceinline__ unsigned pk_bf16(float lo, float hi) { const f32x2_hw f = {lo, hi}; const bf16x2_hw b = __builtin_convertvector(f, bf16x2_hw); return __builtin_bit_cast(unsigned, b); }
typedef float f32x16 __attribute__((ext_vector_type(16)));

constexpr size_t al256(size_t x) { return (x + 255) & ~(size_t)255; }
constexpr size_t WO_rstd = 0;
constexpr size_t WO_cosm = WO_rstd + al256((size_t)T * 4);
constexpr size_t WO_sinm = WO_cosm + al256((size_t)S * 8 * 4);
constexpr size_t WO_cosr = WO_sinm + al256((size_t)S * 8 * 4);
constexpr size_t WO_sinr = WO_cosr + al256((size_t)S * 32 * 4);
constexpr size_t WO_kmean = WO_sinr + al256((size_t)S * 32 * 4);
constexpr size_t WO_proj = WO_kmean + al256((size_t)NB * 8 * 16 * 64 * 4);
constexpr size_t WO_ybuf = WO_proj + al256((size_t)T * INW * 4);
constexpr size_t WO_yg = WO_ybuf + al256((size_t)T * D * 4);
constexpr size_t WO_skb = WO_yg + al256((size_t)T * 256 * 4);
constexpr size_t WO_Ub = WO_skb + al256((size_t)NL * 16 * 128 * 64 * 2);
constexpr size_t WO_Vb = WO_Ub + al256((size_t)16384 * D * 2);
constexpr size_t WO_gates = WO_Vb + al256((size_t)16384 * D * 2);
constexpr size_t WO_eidx = WO_gates + al256((size_t)T * 128 * 4);
constexpr size_t WO_xb = WO_eidx + al256((size_t)T * 128 * 4);
constexpr size_t WO_Win_t = WO_xb + al256((size_t)T * KD * 2);
constexpr size_t WO_Wout_t = WO_Win_t + al256((size_t)NL * INW * KD * 2);
constexpr size_t WO_Wq_t = WO_Wout_t + al256((size_t)NL * D * KD * 2);
constexpr size_t WO_Qm = WO_Wq_t + al256((size_t)NL * D * KD * 2);
constexpr size_t WO_Km = WO_Qm + al256((size_t)T * 512 * 2);
constexpr size_t WO_Vm = WO_Km + al256((size_t)T * 512 * 2);
constexpr size_t WO_S5a32 = WO_Vm + al256((size_t)T * 512 * 2);
constexpr size_t WO_Wglu_t = WO_S5a32 + al256((size_t)16 * 64 * 2 * 4);
constexpr size_t WO_Qr = WO_Wglu_t + al256((size_t)NL * 256 * 256 * 2);
constexpr size_t WO_Kr = WO_Qr + al256((size_t)T * 256 * 2);
constexpr size_t WO_Krv = WO_Kr + al256((size_t)T * 256 * 2);
constexpr size_t WO_Vr = WO_Krv + al256((size_t)T * 256 * 2);
constexpr size_t WO_KVr = WO_Vr + al256((size_t)T * 256 * 2);
constexpr size_t WO_Rb = WO_KVr + al256((size_t)32 * 32 * 4096 * 4);
constexpr size_t WO_qctr = WO_Rb + al256((size_t)32 * 32 * 4096 * 2);
constexpr size_t WO_bar = WO_qctr + al256(1024);
constexpr size_t WO_S5Wy = WO_bar + al256(16384);
constexpr size_t WO_S5Wz = WO_S5Wy + al256((size_t)16 * 512 * 640 * 2);
constexpr size_t WO_ssq1 = WO_S5Wz + al256((size_t)16 * 256 * 512 * 2);
constexpr size_t WO_ssq2 = WO_ssq1 + al256((size_t)T * 8 * 4);
constexpr size_t WS_TOTAL = WO_ssq2 + al256((size_t)T * 16 * 4);
constexpr size_t WO_S5A = WO_gates;
constexpr size_t WO_S5Z = WO_S5A + al256((size_t)16 * 1024 * 640 * 2);
static_assert(WO_S5Z + (size_t)16 * 1024 * 128 * 4 <= WO_gates + 2 * al256((size_t)T * 128 * 4), "S5A/S5Z must fit in gates+eidx");
#define GAS __attribute__((address_space(1)))
static_assert((size_t)T * D * 2 + (size_t)T * 128 * 8 * 4 + (size_t)T * D * 2 <= (size_t)T * INW * 4, "qb + ppart + xb2 must fit in the proj region");
struct Params {
  const GAS float* in[21];
  GAS float* out_;
  GAS unsigned char* ws;
  __device__ __forceinline__ const float* inp(int i) const { return (const float*)in[i]; }
  __device__ __forceinline__ float* outp() const { return (float*)out_; }
  __device__ __forceinline__ float* rstd() const { return (float*)(ws + WO_rstd); }
  __device__ __forceinline__ float* cosm() const { return (float*)(ws + WO_cosm); }
  __device__ __forceinline__ float* sinm() const { return (float*)(ws + WO_sinm); }
  __device__ __forceinline__ float* cosr() const { return (float*)(ws + WO_cosr); }
  __device__ __forceinline__ float* sinr() const { return (float*)(ws + WO_sinr); }
  __device__ __forceinline__ float* kmean() const { return (float*)(ws + WO_kmean); }
  __device__ __forceinline__ float* proj() const { return (float*)(ws + WO_proj); }
  __device__ __forceinline__ float* ybuf() const { return (float*)(ws + WO_ybuf); }
  __device__ __forceinline__ float* yg() const { return (float*)(ws + WO_yg); }
  __device__ __forceinline__ bf16_t* skb() const { return (bf16_t*)(ws + WO_skb); }
  __device__ __forceinline__ bf16_t* Ub() const { return (bf16_t*)(ws + WO_Ub); }
  __device__ __forceinline__ bf16_t* Vb() const { return (bf16_t*)(ws + WO_Vb); }
  __device__ __forceinline__ float* gates() const { return (float*)(ws + WO_gates); }
  __device__ __forceinline__ int* eidx() const { return (int*)(ws + WO_eidx); }
  __device__ __forceinline__ bf16_t* xb() const { return (bf16_t*)(ws + WO_xb); }
  __device__ __forceinline__ bf16_t* Win_t() const { return (bf16_t*)(ws + WO_Win_t); }
  __device__ __forceinline__ bf16_t* Wout_t() const { return (bf16_t*)(ws + WO_Wout_t); }
  __device__ __forceinline__ bf16_t* Wq_t() const { return (bf16_t*)(ws + WO_Wq_t); }
  __device__ __forceinline__ bf16_t* Qm() const { return (bf16_t*)(ws + WO_Qm); }
  __device__ __forceinline__ bf16_t* Km() const { return (bf16_t*)(ws + WO_Km); }
  __device__ __forceinline__ bf16_t* Vm() const { return (bf16_t*)(ws + WO_Vm); }
  __device__ __forceinline__ bf16_t* S5A() const { return (bf16_t*)(ws + WO_S5A); }
  __device__ __forceinline__ bf16_t* S5Wy() const { return (bf16_t*)(ws + WO_S5Wy); }
  __device__ __forceinline__ bf16_t* S5Wz() const { return (bf16_t*)(ws + WO_S5Wz); }
  __device__ __forceinline__ float* S5Z() const { return (float*)(ws + WO_S5Z); }
  __device__ __forceinline__ float* S5a32() const { return (float*)(ws + WO_S5a32); }
  __device__ __forceinline__ bf16_t* Wglu_t() const { return (bf16_t*)(ws + WO_Wglu_t); }
  __device__ __forceinline__ bf16_t* ygb() const { return (bf16_t*)(ws + WO_yg); }
  __device__ __forceinline__ int* qctr() const { return (int*)(ws + WO_qctr); }
  __device__ __forceinline__ unsigned char* U8s() const { return (unsigned char*)(ws + WO_Ub); }
  __device__ __forceinline__ float* su() const { return (float*)(ws + WO_Ub + (size_t)16384 * D); }
  __device__ __forceinline__ unsigned char* V8s() const { return (unsigned char*)(ws + WO_Vb); }
  __device__ __forceinline__ float* sv() const { return (float*)(ws + WO_Vb + (size_t)16384 * D); }
  __device__ __forceinline__ bf16_t* hb() const { return (bf16_t*)(ws + WO_ybuf + ((size_t)4 << 20)); }
  __device__ __forceinline__ float* ppart() const { return (float*)(ws + WO_proj + (size_t)T * D * 2); }
  __device__ __forceinline__ bf16_t* Qr() const { return (bf16_t*)(ws + WO_Qr); }
  __device__ __forceinline__ bf16_t* Kr() const { return (bf16_t*)(ws + WO_Kr); }
  __device__ __forceinline__ bf16_t* Krv() const { return (bf16_t*)(ws + WO_Krv); }
  __device__ __forceinline__ bf16_t* Vr() const { return (bf16_t*)(ws + WO_Vr); }
  __device__ __forceinline__ float* KVr() const { return (float*)(ws + WO_KVr); }
  __device__ __forceinline__ bf16_t* Rb() const { return (bf16_t*)(ws + WO_Rb); }
  __device__ __forceinline__ unsigned* bar() const { return (unsigned*)(ws + WO_bar); }
  __device__ __forceinline__ bf16_t* projb() const { return (bf16_t*)(ws + WO_proj); }
  __device__ __forceinline__ float* ssq1() const { return (float*)(ws + WO_ssq1); }
  __device__ __forceinline__ float* ssq2() const { return (float*)(ws + WO_ssq2); }
  __device__ __forceinline__ bf16_t* xb2() const { return (bf16_t*)(ws + WO_proj + (size_t)T * D * 2 + (size_t)T * 128 * 8 * 4); }
  __device__ __forceinline__ bf16_t* qb() const { return (bf16_t*)(ws + WO_proj); }
};

namespace pg8 {
#define PG8_LAS __attribute__((address_space(3)))
typedef unsigned short bf16_t;
typedef short bf16x8 __attribute__((ext_vector_type(8)));
typedef float f32x4 __attribute__((ext_vector_type(4)));
typedef unsigned u32x4 __attribute__((ext_vector_type(4)));
constexpr int BM = 256, BK = 64, HALF = 128, HTB = HALF * BK * 2  , STAGE_BYTES = 8 * HTB, NXCD = 8, WGM = 8;

__host__ __device__ __forceinline__ int lds_byte(int r, int c) { const int st = (r >> 4) * 2 + (c >> 5), rr = r & 15, cc = c & 31, ob = rr * 64 + cc * 2; return st * 1024 + (ob ^ (((ob >> 9) & 1) << 5)); }
__host__ __device__ __forceinline__ void stage_rc(int b, int& R, int& C) { const int st = b / 1024, sb = b % 1024, swz = sb ^ (((sb >> 9) & 1) << 5); R = (st >> 1) * 16 + swz / 64; C = (st & 1) * 32 + (swz % 64) / 2; }
__host__ __device__ __forceinline__ int perm32(int rho) { const int n = rho >> 4, i = rho & 15; return 8 * (i >> 2) + 4 * n + (i & 3); }

struct Unit { int pm, pn; };
struct Gemm { const bf16_t* A; const bf16_t* Bt; int M, N, K, lda, ldb; };

struct StaticOrder {
    int nM, nN, nwg, G, c;
    __host__ __device__ void init(int M, int N, int G_, int c_) { nM = M / BM; nN = N / BM; nwg = nM * nN; G = G_; c = c_; }
    __host__ __device__ bool next(int i, Unit& u) const {
        const long L = (long)i * G + c; if (L >= nwg) return false;
        int wgid = (int)L; { const int q = nwg / NXCD, r = nwg % NXCD, xcd = wgid % NXCD, off = wgid / NXCD; wgid = (xcd < r ? xcd * (q + 1) : r * (q + 1) + (xcd - r) * q) + off; }
        const int nig = WGM * nN, gid = wgid / nig, fm = gid * WGM, gsz = (nM - fm) < WGM ? (nM - fm) : WGM;
        u.pm = fm + ((wgid % nig) % gsz); u.pn = (wgid % nig) / gsz; return true;
    }
    __device__ __forceinline__ void a_ready(const Unit&) const {}
    __device__ __forceinline__ void done(const Unit&) const {}
};
struct GroupOrder {
    int mt, nt_, nwg, G, c;
    __host__ __device__ void init(int ngroups, int mt__, int nt__, int G_, int c_) { mt = mt__; nt_ = nt__; nwg = ngroups * mt * nt_; G = G_; c = c_; }
    __host__ __device__ bool next(int i, Unit& u) const {
        const long L = (long)i * G + c; if (L >= nwg) return false;
        const int per = mt * nt_, gi = (int)L / per, r = (int)L % per;
        u.pm = gi * mt + r % mt; u.pn = gi * nt_ + r / mt; return true;
    }
    __device__ __forceinline__ void a_ready(const Unit&) const {}
    __device__ __forceinline__ void done(const Unit&) const {}
};
template <class Epi, class Sched, bool ALIGN_EPI = false, bool SP2 = false>
__device__ __forceinline__ void gemm_phase(PG8_LAS unsigned char* lds, const Gemm g, const Sched& S, const Epi& E) {
    int tid_ = threadIdx.x; asm volatile("" : "+v"(tid_));
    const int tid = tid_, wid = __builtin_amdgcn_readfirstlane(tid >> 6), lane = tid & 63, wr = wid >> 2, wc = wid & 3, fr = lane & 15, fq = lane >> 4;
    const int K = g.K, nt = K / BK;
    unsigned voffA[2], voffB[2];
#pragma unroll
    for (int i = 0; i < 2; ++i) { int R, C; stage_rc(tid * 16 + i * 8192, R, C); const int Rb = Epi::PERM ? ((R & ~31) + perm32(R & 31)) : R;
        voffA[i] = (unsigned)(R * g.lda + C) * 2u; voffB[i] = (unsigned)(Rb * g.ldb + C) * 2u; }
    const size_t kstep = (size_t)(BK * 2);
    const size_t hstepA = (size_t)HALF * g.lda * 2, hstepB = (size_t)HALF * g.ldb * 2;
    const size_t tstepA = 2 * hstepA, tstepB = 2 * hstepB;
    const unsigned ldsw = (unsigned)wid * 1024u;
    const int aoff = lds_byte(wr * 64 + fr, fq * 8), boff = lds_byte(wc * 32 + fr, fq * 8);
#define PG8_SA(b, h) (((b) * 2 + (h)) * HTB)
#define PG8_SB(b, h) ((4 + (b) * 2 + (h)) * HTB)
#define PG8_STAGE(bufoff, gbase, voff) do { _Pragma("unroll") for (int _i = 0; _i < 2; ++_i) \
        __builtin_amdgcn_global_load_lds((const unsigned*)((const char*)(gbase) + (voff)[_i]), (PG8_LAS unsigned*)(lds + (bufoff) + ldsw + _i * 8192), 16, 0, 0); } while (0)
#define PG8_LDA(dst, b, h) do { _Pragma("unroll") for (int m = 0; m < 4; ++m) _Pragma("unroll") for (int k = 0; k < 2; ++k) dst[m][k] = *(const PG8_LAS bf16x8*)(lds + PG8_SA(b, h) + aoff + m * 2048 + k * 1024); } while (0)
#define PG8_LDB(dst, b, h) do { _Pragma("unroll") for (int n = 0; n < 2; ++n) _Pragma("unroll") for (int k = 0; k < 2; ++k) dst[n][k] = *(const PG8_LAS bf16x8*)(lds + PG8_SB(b, h) + boff + n * 2048 + k * 1024); } while (0)
#define PG8_MMA(ai, bj, At, Bt) do { __builtin_amdgcn_s_setprio(1); _Pragma("unroll") for (int m = 0; m < 4; ++m) _Pragma("unroll") for (int n = 0; n < 2; ++n) _Pragma("unroll") for (int k = 0; k < 2; ++k) \
        acc[ai][bj][m][n] = __builtin_amdgcn_mfma_f32_16x16x32_bf16(Bt[n][k], At[m][k], acc[ai][bj][m][n], 0, 0, 0); __builtin_amdgcn_s_setprio(0); } while (0)
#define PG8_WAIT_V(n) asm volatile("s_waitcnt vmcnt(" #n ")" ::: "memory")
#define PG8_WAIT_L(n) asm volatile("s_waitcnt lgkmcnt(" #n ")" ::: "memory")
#define PG8_BAR __builtin_amdgcn_s_barrier()
#define PG8_SCHED __builtin_amdgcn_sched_barrier(0)
    Unit cur, nxt; int ui = 0;
    if (!S.next(0, cur)) return;
    f32x4 acc[2][2][4][2];
    E.init(acc, cur, wr, wc, fr, fq);
    bf16x8 At[4][2], B0[2][2], B1[2][2];
    const char* cA = (const char*)g.A + (size_t)cur.pm * tstepA; const char* cB = (const char*)g.Bt + (size_t)cur.pn * tstepB;
    S.a_ready(cur);
    if constexpr (SP2) {
        PG8_STAGE(PG8_SB(0, 0), cB, voffB); PG8_STAGE(PG8_SB(0, 1), cB + hstepB, voffB); PG8_STAGE(PG8_SA(0, 0), cA, voffA); PG8_STAGE(PG8_SA(0, 1), cA + hstepA, voffA);
        if (wr == 1) PG8_BAR;
        PG8_WAIT_V(2); PG8_BAR;
        PG8_STAGE(PG8_SB(1, 0), cB + kstep, voffB); PG8_STAGE(PG8_SA(1, 0), cA + kstep, voffA); PG8_STAGE(PG8_SB(1, 1), cB + hstepB + kstep, voffB);
        PG8_WAIT_V(6); PG8_BAR;
    } else {
        PG8_STAGE(PG8_SB(0, 0), cB, voffB); PG8_STAGE(PG8_SA(0, 0), cA, voffA); PG8_STAGE(PG8_SB(0, 1), cB + hstepB, voffB); PG8_STAGE(PG8_SA(0, 1), cA + hstepA, voffA);
        if (wr == 1) PG8_BAR;
        PG8_WAIT_V(4); PG8_BAR;
        PG8_STAGE(PG8_SB(1, 0), cB + kstep, voffB); PG8_STAGE(PG8_SA(1, 0), cA + kstep, voffA); PG8_STAGE(PG8_SB(1, 1), cB + hstepB + kstep, voffB);
        PG8_WAIT_V(6); PG8_BAR;
    }
    for (;;) {
        const bool has_next = S.next(ui + 1, nxt);
        const char* nA = has_next ? (const char*)g.A + (size_t)nxt.pm * tstepA : cA; const char* nB = has_next ? (const char*)g.Bt + (size_t)nxt.pn * tstepB : cB;
        for (int t = 0; t < nt; t += 2) {
            const bool last = (t == nt - 2);
            const char* a1 = cA + (size_t)(t + 1) * kstep;
            const char* a2 = last ? nA : cA + (size_t)(t + 2) * kstep; const char* b2 = last ? nB : cB + (size_t)(t + 2) * kstep;
            const char* a3 = a2 + kstep; const char* b3 = b2 + kstep;
            if (last && has_next) S.a_ready(nxt);
            if constexpr (SP2) {
            PG8_LDB(B0, 0, 0); PG8_LDB(B1, 0, 1); PG8_SCHED; PG8_LDA(At, 0, 0); PG8_STAGE(PG8_SA(1, 1), a1 + hstepA, voffA);
            PG8_WAIT_V(8); PG8_WAIT_L(0); PG8_BAR; PG8_MMA(0, 0, At, B0); PG8_MMA(0, 1, At, B1); PG8_BAR; PG8_SCHED;
            PG8_LDA(At, 0, 1); PG8_STAGE(PG8_SB(0, 0), b2, voffB); PG8_STAGE(PG8_SB(0, 1), b2 + hstepB, voffB); PG8_STAGE(PG8_SA(0, 0), a2, voffA);
            PG8_WAIT_V(8); PG8_WAIT_L(0); PG8_BAR; PG8_MMA(1, 0, At, B0); PG8_MMA(1, 1, At, B1); PG8_BAR; PG8_SCHED;
            PG8_LDB(B0, 1, 0); PG8_LDB(B1, 1, 1); PG8_SCHED; PG8_LDA(At, 1, 0); PG8_STAGE(PG8_SA(0, 1), a2 + hstepA, voffA);
            PG8_WAIT_V(8); PG8_WAIT_L(0); PG8_BAR; PG8_MMA(0, 0, At, B0); PG8_MMA(0, 1, At, B1); PG8_BAR; PG8_SCHED;
            PG8_LDA(At, 1, 1); PG8_STAGE(PG8_SB(1, 0), b3, voffB); PG8_STAGE(PG8_SB(1, 1), b3 + hstepB, voffB); PG8_STAGE(PG8_SA(1, 0), a3, voffA);
            PG8_WAIT_V(8); PG8_WAIT_L(0); PG8_BAR; PG8_MMA(1, 0, At, B0); PG8_MMA(1, 1, At, B1); PG8_BAR; PG8_SCHED;
            } else {
            PG8_LDB(B0, 0, 0); PG8_SCHED; PG8_LDA(At, 0, 0); PG8_STAGE(PG8_SA(1, 1), a1 + hstepA, voffA);
            PG8_WAIT_L(8); PG8_BAR; PG8_WAIT_L(0); PG8_MMA(0, 0, At, B0); PG8_BAR; PG8_SCHED;
            PG8_LDB(B1, 0, 1); PG8_STAGE(PG8_SB(0, 0), b2, voffB);
            PG8_BAR; PG8_WAIT_L(0); PG8_MMA(0, 1, At, B1); PG8_BAR;
            PG8_LDA(At, 0, 1); PG8_STAGE(PG8_SA(0, 0), a2, voffA);
            PG8_BAR; PG8_WAIT_L(0); PG8_MMA(1, 0, At, B0); PG8_BAR; PG8_SCHED;
            PG8_STAGE(PG8_SB(0, 1), b2 + hstepB, voffB);
            PG8_WAIT_V(6); PG8_BAR; PG8_MMA(1, 1, At, B1); PG8_BAR;
            PG8_LDB(B0, 1, 0); PG8_SCHED; PG8_LDA(At, 1, 0); PG8_STAGE(PG8_SA(0, 1), a2 + hstepA, voffA);
            PG8_WAIT_L(8); PG8_BAR; PG8_WAIT_L(0); PG8_MMA(0, 0, At, B0); PG8_BAR; PG8_SCHED;
            PG8_LDB(B1, 1, 1); PG8_STAGE(PG8_SB(1, 0), b3, voffB);
            PG8_BAR; PG8_WAIT_L(0); PG8_MMA(0, 1, At, B1); PG8_BAR;
            PG8_LDA(At, 1, 1); PG8_STAGE(PG8_SA(1, 0), a3, voffA);
            PG8_BAR; PG8_WAIT_L(0); PG8_MMA(1, 0, At, B0); PG8_BAR; PG8_SCHED;
            PG8_STAGE(PG8_SB(1, 1), b3 + hstepB, voffB);
            PG8_WAIT_V(6); PG8_BAR; PG8_MMA(1, 1, At, B1); PG8_BAR;
            }
        }
        if constexpr (ALIGN_EPI) { if (wr == 0) PG8_BAR; }
        if constexpr (!Epi::AFTER_DRAIN) { E(acc, cur, wr, wc, fr, fq); S.done(cur); }
        if (!has_next) break;
        E.init(acc, nxt, wr, wc, fr, fq);
        cur = nxt; cA = nA; cB = nB; ++ui;
        if constexpr (ALIGN_EPI) { if (wr == 1) PG8_BAR; }
    }
    PG8_WAIT_V(0);
    if constexpr (!ALIGN_EPI) { if (wr == 0) PG8_BAR; }
    PG8_BAR;
    if constexpr (Epi::AFTER_DRAIN) { E.fused(acc, cur, wr, wc, fr, fq, lds, wid, lane); S.done(cur); }
#undef PG8_SA
#undef PG8_SB
#undef PG8_STAGE
#undef PG8_LDA
#undef PG8_LDB
#undef PG8_MMA
#undef PG8_WAIT_V
#undef PG8_WAIT_L
#undef PG8_BAR
#undef PG8_SCHED
}
}
#define EPI_ZERO_INIT \
  __device__ __forceinline__ void init(pg8::f32x4 (&acc)[2][2][4][2], const pg8::Unit&, int, int, int, int) const { \
    _Pragma("unroll") for (int a = 0; a < 2; ++a) _Pragma("unroll") for (int b = 0; b < 2; ++b) \
    _Pragma("unroll") for (int m = 0; m < 4; ++m) _Pragma("unroll") for (int n = 0; n < 2; ++n) acc[a][b][m][n] = (pg8::f32x4){0.f, 0.f, 0.f, 0.f}; }
struct EpiResid {
  static constexpr bool PERM = true, AFTER_DRAIN = false;
  float* C; int ldc; bf16_t* xb; bf16_t* hb; const float* g2; float* parts;
  __device__ __forceinline__ void init(pg8::f32x4 (&acc)[2][2][4][2], const pg8::Unit& u, int wr, int wc, int fr, int fq) const {
#pragma unroll
    for (int ai = 0; ai < 2; ++ai)
#pragma unroll
      for (int m = 0; m < 4; ++m) {
        const int row = u.pm * 256 + ai * 128 + wr * 64 + m * 16 + fr;
#pragma unroll
        for (int bj = 0; bj < 2; ++bj)
#pragma unroll
          for (int n = 0; n < 2; ++n) {
            const int col = u.pn * 256 + bj * 128 + wc * 32 + 8 * fq + 4 * n;
            acc[ai][bj][m][n] = *(const pg8::f32x4*)(C + (size_t)row * ldc + col);
          }
      }
  }
  __device__ __forceinline__ void operator()(const pg8::f32x4 (&acc)[2][2][4][2], const pg8::Unit& u, int wr, int wc, int fr_in, int fq_in) const {
    int fr = fr_in, fq = fq_in; asm volatile("" : "+v"(fr), "+v"(fq));
    pg8::f32x4 gv[2][2];
#pragma unroll
    for (int bj = 0; bj < 2; ++bj)
#pragma unroll
      for (int n = 0; n < 2; ++n) gv[bj][n] = *(const pg8::f32x4*)(g2 + u.pn * 256 + bj * 128 + wc * 32 + 8 * fq + 4 * n);
#pragma unroll
    for (int ai = 0; ai < 2; ++ai)
#pragma unroll
      for (int m = 0; m < 4; ++m) {
        const int row = u.pm * 256 + ai * 128 + wr * 64 + m * 16 + fr;
        float ss = 0.f;
#pragma unroll
        for (int bj = 0; bj < 2; ++bj) {
          const int col = u.pn * 256 + bj * 128 + wc * 32 + 8 * fq;
          const pg8::f32x4 v0 = acc[ai][bj][m][0], v1 = acc[ai][bj][m][1];
          *(pg8::f32x4*)(C + (size_t)row * ldc + col) = v0; *(pg8::f32x4*)(C + (size_t)row * ldc + col + 4) = v1;
          *(uint4*)(xb + (size_t)row * KD + col) = make_uint4(pk_bf16(v0[0], v0[1]), pk_bf16(v0[2], v0[3]), pk_bf16(v1[0], v1[1]), pk_bf16(v1[2], v1[3]));
          const pg8::f32x4 h0 = v0 * gv[bj][0], h1 = v1 * gv[bj][1];
          *(uint4*)(hb + ((size_t)(col >> 7) * T + row) * 128 + (col & 127)) = make_uint4(pk_bf16(h0[0], h0[1]), pk_bf16(h0[2], h0[3]), pk_bf16(h1[0], h1[1]), pk_bf16(h1[2], h1[3]));
          ss += ((v0[0] * v0[0] + v0[1] * v0[1]) + (v0[2] * v0[2] + v0[3] * v0[3])) + ((v1[0] * v1[0] + v1[1] * v1[1]) + (v1[2] * v1[2] + v1[3] * v1[3]));
        }
        ss += __shfl_xor(ss, 16); ss += __shfl_xor(ss, 32);
        if (fq == 0) parts[(size_t)row * 16 + u.pn * 4 + wc] = ss;
        asm volatile("" ::: "memory");
      }
  }
};
struct EpiScaleStoreBf16 {
  static constexpr bool PERM = true, AFTER_DRAIN = false;
  bf16_t* C; int ldc; const float* parts; int nparts; float* rs_out;
  EPI_ZERO_INIT
  __device__ __forceinline__ void operator()(const pg8::f32x4 (&acc)[2][2][4][2], const pg8::Unit& u, int wr, int wc, int fr_in, int fq_in) const {
    int fr = fr_in, fq = fq_in; asm volatile("" : "+v"(fr), "+v"(fq));
#pragma unroll
    for (int ai = 0; ai < 2; ++ai)
#pragma unroll
      for (int m = 0; m < 4; ++m) {
        const int row = u.pm * 256 + ai * 128 + wr * 64 + m * 16 + fr;
        float ssum = 0.f;
        for (int i = 0; i < nparts; i += 4) { const pg8::f32x4 q4 = *(const pg8::f32x4*)(parts + (size_t)row * nparts + i); ssum += (q4[0] + q4[1]) + (q4[2] + q4[3]); }
        const float r = rsqrtf(ssum * (1.0f / (float)D) + EPS);
        if (rs_out && u.pn == 0 && wc == 0 && fq == 0) rs_out[row] = r;
#pragma unroll
        for (int bj = 0; bj < 2; ++bj) {
          const int col = u.pn * 256 + bj * 128 + wc * 32 + 8 * fq;
          const pg8::f32x4 v0 = acc[ai][bj][m][0] * r, v1 = acc[ai][bj][m][1] * r;
          *(uint4*)(C + (size_t)row * ldc + col) = make_uint4(pk_bf16(v0[0], v0[1]), pk_bf16(v0[2], v0[3]), pk_bf16(v1[0], v1[1]), pk_bf16(v1[2], v1[3]));
        }
        asm volatile("" ::: "memory");
      }
  }
};
template <class Epi>
__device__ __forceinline__ void run_gemm(unsigned char* lds_raw, const bf16_t* A, const bf16_t* Bt, int M, int N, int K, const Epi& e) {
  pg8::Gemm g{A, Bt, M, N, K, K, K}; pg8::StaticOrder So; So.init(M, N, (int)gridDim.x, (int)blockIdx.x);
  pg8::gemm_phase<Epi, pg8::StaticOrder, true, true>((PG8_LAS unsigned char*)lds_raw, g, So, e);
}

__device__ __forceinline__ void transpose_items(const float* __restrict__ W, int K, int N, const float* __restrict__ g, bf16_t* __restrict__ Wt, int gw, int ngw, int lane) {
  const int nkt = K / 64, nnt = N / 64;
  for (int it = gw; it < nkt * nnt; it += ngw) {
    int kt = it % nkt, ntile = it / nkt;
    int k0 = kt * 64, n = ntile * 64 + lane;
    float v[64];
#pragma unroll
    for (int i = 0; i < 64; ++i) v[i] = W[(size_t)(k0 + i) * N + n] * g[k0 + i];
    bf16_t* dst = Wt + (size_t)n * (K * KS) + k0;
#pragma unroll
    for (int c = 0; c < 8; ++c) {
      bf16_t hi[8], lo[8];
#pragma unroll
      for (int e = 0; e < 8; ++e) { hi[e] = f2bf(v[c * 8 + e]); lo[e] = f2bf(v[c * 8 + e] - bf2f(hi[e])); }
      uint4 ph, pl;
      ph.x = hi[0] | ((unsigned)hi[1] << 16); ph.y = hi[2] | ((unsigned)hi[3] << 16); ph.z = hi[4] | ((unsigned)hi[5] << 16); ph.w = hi[6] | ((unsigned)hi[7] << 16);
      pl.x = lo[0] | ((unsigned)lo[1] << 16); pl.y = lo[2] | ((unsigned)lo[3] << 16); pl.z = lo[4] | ((unsigned)lo[5] << 16); pl.w = lo[6] | ((unsigned)lo[7] << 16);
      *(uint4*)(dst + c * 8) = ph;
      if (PRECISE) { *(uint4*)(dst + K + c * 8) = pl; *(uint4*)(dst + 2 * K + c * 8) = ph; }
    }
  }
}


__device__ __forceinline__ void phase_prologue(const Params& p, int gtid, int ngt, int gw, int ngw, int lane) {
  for (int idx = gtid; idx < S * 40; idx += ngt) {
    int s = idx / 40, i = idx % 40;
    if (i < 8) {
      float inv = powf(500000.0f, -(float)(2 * i) / 16.0f);
      float ang = (float)s * inv;
      p.cosm()[s * 8 + i] = (float)cos((double)ang); p.sinm()[s * 8 + i] = (float)sin((double)ang);
    } else {
      int j = i - 8;
      float inv = powf(10000.0f, -((float)j / 31.0f));
      float ang = (float)s * inv;
      p.cosr()[s * 32 + j] = (float)cos((double)ang); p.sinr()[s * 32 + j] = (float)sin((double)ang);
    }
  }
  { const float4* a = (const float4*)p.inp(0); float4* b = (float4*)p.outp();
    for (size_t i = gtid; i < (size_t)T * D / 4; i += ngt) b[i] = a[i]; }
  for (int t = gw; t < T; t += ngw) {
    const float4* xr = (const float4*)(p.inp(0) + (size_t)t * D); float ss = 0.f;
#pragma unroll
    for (int i = 0; i < 4; ++i) { const float4 v = xr[lane + i * 64]; ss += v.x * v.x + v.y * v.y + v.z * v.z + v.w * v.w;
      *(uint2*)(p.xb() + (size_t)t * KD + (lane + i * 64) * 4) = make_uint2(pk_bf16(v.x, v.y), pk_bf16(v.z, v.w)); }
    ss = wave_sum(ss);
    if (lane < 8) p.ssq1()[(size_t)t * 8 + lane] = lane == 0 ? ss : 0.f;
  }
  for (int idx = gtid; idx < NL * 65536; idx += ngt) { const int l2 = idx >> 16, n2 = (idx >> 8) & 255, k2 = idx & 255; p.Wglu_t()[idx] = f2bf(p.inp(11)[(size_t)l2 * 65536 + k2 * 256 + n2]); }
  for (int l = 0; l < NL; ++l) {
    transpose_items(p.inp(2) + (size_t)l * D * INW, D, INW, p.inp(1) + l * D, p.Win_t() + (size_t)l * INW * KD, gw, ngw, lane);
    transpose_items(p.inp(15) + (size_t)l * D * D, D, D, p.inp(14) + l * D, p.Wout_t() + (size_t)l * D * KD, gw, ngw, lane);
    transpose_items(p.inp(17) + (size_t)l * D * D, D, D, p.inp(16) + l * D, p.Wq_t() + (size_t)l * D * KD, gw, ngw, lane);
  }
}


struct S5P { float lr, li, dt, fr, fi; };
__device__ __forceinline__ S5P s5p(const Params& p, int l, int g, int pp) {
  S5P r; r.lr = p.inp(3)[l * 1024 + g * 64 + pp]; r.li = p.inp(4)[l * 1024 + g * 64 + pp]; r.dt = expf(p.inp(5)[l * 16 + g]);
  const float mag = expf(r.lr * r.dt); float sn, cs; sincosf(r.li * r.dt, &sn, &cs);
  const float ar = mag * cs, ai = mag * sn, den = r.lr * r.lr + r.li * r.li;
  r.fr = ((ar - 1.0f) * r.lr + ai * r.li) / den; r.fi = (ai * r.lr - (ar - 1.0f) * r.li) / den;
  return r;
}
__device__ __forceinline__ void s5pow(const S5P& s, int k, float& re, float& im) {
  const float m = expf((float)k * s.lr * s.dt); float sn, cs; sincosf((float)k * s.li * s.dt, &sn, &cs); re = m * cs; im = m * sn;
}
__device__ __forceinline__ void phase_s5_prep(const Params& p, int l, int gtid, int ngt) {
  const float* b_re = p.inp(6) + l * 16384; const float* b_im = p.inp(7) + l * 16384;
  const float* c_re = p.inp(8) + l * 16384; const float* c_im = p.inp(9) + l * 16384;
  bf16_t* Wy = p.S5Wy(); bf16_t* Wz = p.S5Wz();
  for (int it = gtid; it < 16 * 32 * 256; it += ngt) {
    const int hp = it & 15, h = (it >> 4) & 15, d = (it >> 8) & 31, g = it >> 13;
    float acc = 0.f;
    for (int pp = 0; pp < 64; ++pp) {
      const S5P s = s5p(p, l, g, pp);
      float pr, pi; s5pow(s, d, pr, pi);
      const float br = b_re[(g * 64 + pp) * 16 + hp], bi = b_im[(g * 64 + pp) * 16 + hp];
      const float bbr = s.fr * br - s.fi * bi, bbi = s.fr * bi + s.fi * br;
      const float tr = pr * bbr - pi * bbi, ti = pr * bbi + pi * bbr;
      acc += c_re[(g * 16 + h) * 64 + pp] * tr - c_im[(g * 16 + h) * 64 + pp] * ti;
    }
    const bf16_t v = f2bf(acc);
    for (int jp = 0; jp + d < 32; ++jp) {
      const int j = jp + d;
      Wy[((size_t)g * 512 + j * 16 + h) * 640 + jp * 16 + hp] = v;
      if (d > 0) Wy[((size_t)g * 512 + jp * 16 + h) * 640 + j * 16 + hp] = 0;
    }
  }
  for (int it = gtid; it < 16 * 32 * 16 * 64; it += ngt) {
    const int pp = it & 63, h = (it >> 6) & 15, j = (it >> 10) & 31, g = it >> 15;
    const S5P s = s5p(p, l, g, pp);
    float pr, pi; s5pow(s, j + 1, pr, pi);
    const float cr = c_re[(g * 16 + h) * 64 + pp], ci = c_im[(g * 16 + h) * 64 + pp];
    const unsigned w = pk_bf16(cr * pr - ci * pi, -(cr * pi + ci * pr));
    *(unsigned*)(Wy + ((size_t)g * 512 + j * 16 + h) * 640 + 512 + 2 * pp) = w;
  }
  for (int it = gtid; it < 16 * 64 * 32; it += ngt) {
    const int j = it & 31, pp = (it >> 5) & 63, g = it >> 11;
    const S5P s = s5p(p, l, g, pp);
    float pr, pi; s5pow(s, 31 - j, pr, pi);
    for (int hp = 0; hp < 16; ++hp) {
      const float br = b_re[(g * 64 + pp) * 16 + hp], bi = b_im[(g * 64 + pp) * 16 + hp];
      const float bbr = s.fr * br - s.fi * bi, bbi = s.fr * bi + s.fi * br;
      Wz[((size_t)g * 256 + 2 * pp) * 512 + j * 16 + hp] = f2bf(pr * bbr - pi * bbi);
      Wz[((size_t)g * 256 + 2 * pp + 1) * 512 + j * 16 + hp] = f2bf(pr * bbi + pi * bbr);
    }
  }
  for (int it = gtid; it < 16 * 64; it += ngt) {
    const S5P s = s5p(p, l, it >> 6, it & 63);
    float pr, pi; s5pow(s, 32, pr, pi);
    p.S5a32()[it * 2] = pr; p.S5a32()[it * 2 + 1] = pi;
  }
}
__device__ __forceinline__ void phase_pack_u(const Params& p, int gtid, int ngt) {
  for (int idx = gtid; idx < T * 32; idx += ngt) {
    const int t = idx >> 5, i = idx & 31, g = i >> 1;
    *(uint4*)(p.S5A() + ((size_t)g * 1024 + (t >> 5)) * 640 + (t & 31) * 16 + (i & 1) * 8) = *(const uint4*)(p.projb() + (size_t)t * INW + i * 8);
  }
}
__device__ __forceinline__ void phase_s5_scan(const Params& p, int gtid, int ngt) {
  for (int it = gtid; it < NB * 16 * 64; it += ngt) {
    const int pp = it & 63, g = (it >> 6) & 15, b = it >> 10;
    const float er = p.S5a32()[(g * 64 + pp) * 2], ei = p.S5a32()[(g * 64 + pp) * 2 + 1];
    float sr = 0.f, si = 0.f;
#pragma unroll 1
    for (int c0 = 0; c0 < 128; c0 += 16) {
      float2 z[16];
#pragma unroll
      for (int k = 0; k < 16; ++k) z[k] = *(const float2*)(p.S5Z() + ((size_t)g * 1024 + b * 128 + c0 + k) * 128 + 2 * pp);
#pragma unroll
      for (int k = 0; k < 16; ++k) {
        const size_t ch = (size_t)g * 1024 + b * 128 + c0 + k;
        *(unsigned*)(p.S5A() + ch * 640 + 512 + 2 * pp) = pk_bf16(sr, si);
        const float nr = er * sr - ei * si + z[k].x, ni = er * si + ei * sr + z[k].y;
        sr = nr; si = ni;
      }
    }
  }
}
struct EpiS5Z {
  static constexpr bool PERM = false, AFTER_DRAIN = false;
  float* Z;
  EPI_ZERO_INIT
  __device__ __forceinline__ void operator()(const pg8::f32x4 (&acc)[2][2][4][2], const pg8::Unit& u, int wr, int wc, int fr_in, int fq_in) const {
    int fr = fr_in, fq = fq_in; asm volatile("" : "+v"(fr), "+v"(fq));
    const int g = u.pm >> 2;
#pragma unroll
    for (int ai = 0; ai < 2; ++ai)
#pragma unroll
      for (int m = 0; m < 4; ++m) {
        const int chunk = (u.pm & 3) * 256 + ai * 128 + wr * 64 + m * 16 + fr;
#pragma unroll
        for (int n = 0; n < 2; ++n) *(pg8::f32x4*)(Z + ((size_t)g * 1024 + chunk) * 128 + wc * 32 + n * 16 + 4 * fq) = acc[ai][0][m][n];
      }
  }
};
struct EpiS5Y {
  static constexpr bool PERM = false, AFTER_DRAIN = false;
  bf16_t* ygb; const bf16_t* A; const float* dsk;
  EPI_ZERO_INIT
  __device__ __forceinline__ void operator()(const pg8::f32x4 (&acc)[2][2][4][2], const pg8::Unit& u, int wr, int wc, int fr_in, int fq_in) const {
    int fr = fr_in, fq = fq_in; asm volatile("" : "+v"(fr), "+v"(fq));
    const int g = u.pm >> 2;
#pragma unroll
    for (int ai = 0; ai < 2; ++ai)
#pragma unroll
      for (int m = 0; m < 4; ++m) {
        const int chunk = (u.pm & 3) * 256 + ai * 128 + wr * 64 + m * 16 + fr;
#pragma unroll
        for (int bj = 0; bj < 2; ++bj)
#pragma unroll
          for (int n = 0; n < 2; ++n) {
            const int col = (u.pn & 1) * 256 + bj * 128 + wc * 32 + n * 16 + 4 * fq, j = col >> 4, h = col & 15;
            const uint2 uu = *(const uint2*)(A + ((size_t)g * 1024 + chunk) * 640 + col);
            const pg8::f32x4 dv = *(const pg8::f32x4*)(dsk + g * 16 + h);
            const pg8::f32x4 v = acc[ai][bj][m][n];
            const float y0 = fast_gelu(v[0] + dv[0] * __uint_as_float(uu.x << 16)), y1 = fast_gelu(v[1] + dv[1] * __uint_as_float(uu.x & 0xffff0000u));
            const float y2 = fast_gelu(v[2] + dv[2] * __uint_as_float(uu.y << 16)), y3 = fast_gelu(v[3] + dv[3] * __uint_as_float(uu.y & 0xffff0000u));
            uint2 o; o.x = pk_bf16(y0, y1); o.y = pk_bf16(y2, y3);
            *(uint2*)(ygb + ((size_t)chunk * 32 + j) * 256 + g * 16 + h) = o;
          }
        asm volatile("" ::: "memory");
      }
  }
};
struct EpiGlu {
  static constexpr bool PERM = false, AFTER_DRAIN = false;
  bf16_t* yb; const bf16_t* ygb; float* scr;
  EPI_ZERO_INIT
  __device__ __forceinline__ void operator()(const pg8::f32x4 (&acc_)[2][2][4][2], const pg8::Unit& u, int wr, int wc, int fr_in, int fq_in) const {
    int fr = fr_in, fq = fq_in; asm volatile("" : "+v"(fr), "+v"(fq));
    pg8::f32x4 (&acc)[2][2][4][2] = const_cast<pg8::f32x4 (&)[2][2][4][2]>(acc_);
#pragma unroll
    for (int ai = 0; ai < 2; ++ai)
#pragma unroll
      for (int m = 0; m < 4; ++m) {
        const int rl = ai * 128 + wr * 64 + m * 16 + fr, row = u.pm * 256 + rl;
        float ss = 0.f;
#pragma unroll
        for (int bj = 0; bj < 2; ++bj)
#pragma unroll
          for (int n = 0; n < 2; ++n) {
            const int col = bj * 128 + wc * 32 + n * 16 + 4 * fq;
            const uint2 yy = *(const uint2*)(ygb + (size_t)row * 256 + col);
            const pg8::f32x4 z = acc[ai][bj][m][n];
            pg8::f32x4 r;
            r[0] = __uint_as_float(yy.x << 16) * fast_sigmoid(z[0]); r[1] = __uint_as_float(yy.x & 0xffff0000u) * fast_sigmoid(z[1]);
            r[2] = __uint_as_float(yy.y << 16) * fast_sigmoid(z[2]); r[3] = __uint_as_float(yy.y & 0xffff0000u) * fast_sigmoid(z[3]);
            acc[ai][bj][m][n] = r;
            ss += r[0] * r[0] + r[1] * r[1] + r[2] * r[2] + r[3] * r[3];
          }
        ss += __shfl_xor(ss, 16); ss += __shfl_xor(ss, 32);
        if (fq == 0) scr[rl * 4 + wc] = ss;
        asm volatile("" ::: "memory");
      }
    asm volatile("s_waitcnt lgkmcnt(0)" ::: "memory"); __builtin_amdgcn_s_barrier(); asm volatile("" ::: "memory");
#pragma unroll
    for (int ai = 0; ai < 2; ++ai)
#pragma unroll
      for (int m = 0; m < 4; ++m) {
        const int rl = ai * 128 + wr * 64 + m * 16 + fr, row = u.pm * 256 + rl;
        const pg8::f32x4 s4 = *(const pg8::f32x4*)(scr + rl * 4);
        const float r = rsqrtf((s4[0] + s4[1] + s4[2] + s4[3]) / 256.0f + EPS);
#pragma unroll
        for (int bj = 0; bj < 2; ++bj)
#pragma unroll
          for (int n = 0; n < 2; ++n) { const pg8::f32x4 v = acc[ai][bj][m][n] * r; *(uint2*)(yb + (size_t)row * KD + bj * 128 + wc * 32 + n * 16 + 4 * fq) = make_uint2(pk_bf16(v[0], v[1]), pk_bf16(v[2], v[3])); }
        asm volatile("" ::: "memory");
      }
    asm volatile("s_waitcnt lgkmcnt(0)" ::: "memory"); __builtin_amdgcn_s_barrier(); asm volatile("" ::: "memory");
  }
};

constexpr float QSCALE = 0.125f * 1.4426950408889634f;


__device__ __forceinline__ void phase_moba2(const Params& p, int l, unsigned char* lds, int bid, int G) {
  constexpr int OLD = 260;
  bf16_t* Qs = (bf16_t*)lds;
  float* Oaccf = (float*)(lds + 32768);
  float* laccf = (float*)(lds + 32768 + 64 * OLD * 4);
  float* kms = laccf + 256;
  float* gat = kms + 1024;
  unsigned char* lists = (unsigned char*)(gat + 4096);
  int* cnt = (int*)(lists + 4096);
  int* items = cnt + 16;
  int* ctr = items + 160;
  unsigned* selp = (unsigned*)(ctr + 4);
  float* bq = (float*)(selp + 256);
  int* Oacc = (int*)Oaccf; int* lacc = (int*)laccf;
  float kmax = 0.f;
  { const float* gk = p.inp(13) + l * 64;
    for (int d = 0; d < 64; ++d) kmax = fmaxf(kmax, fabsf(gk[d]));
    kmax *= 8.0f * 1.01f; }
  for (int u = bid; u < NB * 8 * 16; u += G) {
    const int qblk = 15 - (u >> 6), bh = u & 63, b = bh >> 3, h = bh & 7;
    int tid = threadIdx.x; asm volatile("" : "+v"(tid));
    const int lane = tid & 63, wv = tid >> 6, n = lane & 31, hh = lane >> 5;
    __syncthreads();
    { const uint4* src = (const uint4*)(p.Qm() + ((size_t)bh * S + qblk * 256) * 64);
      uint4* dst = (uint4*)Qs;
      for (int i = tid; i < 256 * 64 * 2 / 16; i += NTHR) dst[i] = src[i]; }
    for (int i = tid; i < qblk * 64; i += NTHR) kms[i] = p.kmean()[(size_t)bh * 1024 + i];
    for (int i = tid; i < 64 * OLD; i += NTHR) Oacc[i] = 0;
    if (tid < 256) lacc[tid] = 0;
    if (tid < 16) cnt[tid] = 0;
    __syncthreads();
    { const int q = tid & 255, par = tid >> 8;
      float qv[64];
#pragma unroll
      for (int c = 0; c < 8; ++c) {
        uint4 w = *(const uint4*)(Qs + q * 64 + c * 8);
        qv[c * 8 + 0] = __uint_as_float(w.x << 16); qv[c * 8 + 1] = __uint_as_float(w.x & 0xffff0000u);
        qv[c * 8 + 2] = __uint_as_float(w.y << 16); qv[c * 8 + 3] = __uint_as_float(w.y & 0xffff0000u);
        qv[c * 8 + 4] = __uint_as_float(w.z << 16); qv[c * 8 + 5] = __uint_as_float(w.z & 0xffff0000u);
        qv[c * 8 + 6] = __uint_as_float(w.w << 16); qv[c * 8 + 7] = __uint_as_float(w.w & 0xffff0000u);
      }
      if (par == 0) { float qq = 0.f;
#pragma unroll
        for (int d = 0; d < 64; ++d) qq = fmaf(qv[d], qv[d], qq);
        bq[q] = sqrtf(qq) * kmax; }
      for (int j = par; j < qblk; j += 2) {
        float g = 0.f;
#pragma unroll
        for (int d = 0; d < 64; ++d) g = fmaf(qv[d], kms[j * 64 + d], g);
        gat[q * 16 + j] = g;
      }
    }
    __syncthreads();
    if (tid < 256) {
      float b0 = -INFINITY, b1 = -INFINITY, b2 = -INFINITY; int i0 = 0, i1 = 0, i2 = 0;
      for (int j = 0; j < qblk; ++j) {
        float g = gat[tid * 16 + j];
        if (g > b0) { b2 = b1; i2 = i1; b1 = b0; i1 = i0; b0 = g; i0 = j; }
        else if (g > b1) { b2 = b1; i2 = i1; b1 = g; i1 = j; }
        else if (g > b2) { b2 = g; i2 = j; }
      }
      const int nsel = qblk < 3 ? qblk : 3;
      selp[tid] = (unsigned)i0 | ((unsigned)i1 << 4) | ((unsigned)i2 << 8) | ((unsigned)nsel << 12);
    }
    __syncthreads();
    for (int j = wv; j < qblk; j += 8) {
      int base = 0;
      for (int c = 0; c < 4; ++c) {
        const int q = c * 64 + lane;
        const unsigned sp = selp[q];
        const int ns = sp >> 12;
        const bool f = (ns > 0 && (int)(sp & 15) == j) || (ns > 1 && (int)((sp >> 4) & 15) == j) || (ns > 2 && (int)((sp >> 8) & 15) == j);
        const unsigned long long bal = __ballot(f);
        const int pos = base + __popcll(bal & ((1ull << lane) - 1ull));
        if (f) lists[j * 256 + pos] = (unsigned char)q;
        base += __popcll(bal);
      }
      if (lane == 0) cnt[j] = base;
    }
    __syncthreads();
    if (tid == 0) {
      int ni = 0;
#pragma unroll 1
      for (int g = 7; g >= 0; --g) items[ni++] = (16 << 8) | g;
      for (int j = 0; j < qblk; ++j) { const int ng = (cnt[j] + 31) >> 5; for (int g = 0; g < ng; ++g) items[ni++] = (j << 8) | g; }
      ctr[0] = ni; ctr[1] = 0;
    }
    __syncthreads();
    const int nitems = ctr[0];
    for (;;) {
      int it = 0;
      if (lane == 0) it = atomicAdd(&ctr[1], 1);
      it = __builtin_amdgcn_readfirstlane(it);
      if (it >= nitems) break;
      const int item = items[it];
      const int j = item >> 8, g = item & 255;
      const bool own = (j == 16);
      const int kb = own ? qblk : j;
      const int ntile = own ? (g + 1) : 8;
      int qi; bool valid;
      if (own) { qi = g * 32 + n; valid = true; }
      else { const int pos = g * 32 + n; valid = pos < cnt[j]; qi = lists[j * 256 + (valid ? pos : 0)]; }
      const bf16_t* kt0 = p.Km() + ((size_t)bh * (S / 32) + kb * 8) * 2048 + lane * 8;
      const bf16_t* vt0 = p.Vm() + ((size_t)bh * (S / 32) + kb * 8) * 2048 + lane * 8;
      f32x16 O0, O1;
#pragma unroll
      for (int r = 0; r < 16; ++r) { O0[r] = 0.f; O1[r] = 0.f; }
      float lsum = 0.f;
      const float nbq = -bq[qi];
      bf16x8 kf[3][4], vf[3][4];
#define MOBA_LOAD(KT_, BUF_) { _Pragma("unroll") for (int s = 0; s < 4; ++s) { kf[BUF_][s] = *(const bf16x8*)(kt0 + (size_t)(KT_) * 2048 + s * 512); vf[BUF_][s] = *(const bf16x8*)(vt0 + (size_t)(KT_) * 2048 + s * 512); } }
#define MOBA_STEP(KT_, BUF_)                                                                                                           \
      if ((KT_) < ntile) {                                                                                                               \
        if ((KT_) + 2 < ntile) MOBA_LOAD((KT_) + 2, ((BUF_) + 2) % 3)                                                                     \
        f32x16 X;                                                                                                                         \
        _Pragma("unroll") for (int r = 0; r < 16; ++r) X[r] = nbq;                                                                        \
        _Pragma("unroll") for (int s = 0; s < 4; ++s) X = __builtin_amdgcn_mfma_f32_32x32x16_bf16(kf[BUF_][s], *(const bf16x8*)(Qs + qi * 64 + (2 * s + hh) * 8), X, 0, 0, 0);     \
        const bool diag = own && ((KT_) == g);                                                                                            \
        unsigned pw[8];                                                                                                                   \
        _Pragma("unroll") for (int r = 0; r < 16; r += 2) {                                                                               \
          float e0 = __builtin_amdgcn_exp2f(X[r]), e1 = __builtin_amdgcn_exp2f(X[r + 1]);                                                 \
          if (diag) {                                                                                                                     \
            const int k0 = (r & 3) + 8 * (r >> 2) + 4 * hh, k1 = ((r + 1) & 3) + 8 * ((r + 1) >> 2) + 4 * hh;                             \
            e0 = (k0 <= n) ? e0 : 0.f; e1 = (k1 <= n) ? e1 : 0.f;                                                                         \
          }                                                                                                                               \
          lsum += e0 + e1;                                                                                                                \
          pw[r >> 1] = pk_bf16(e0, e1);                                                                                                   \
        }                                                                                                                                 \
        bf16x8 pf0, pf1;                                                                                                                  \
        { uint4 t0 = make_uint4(pw[0], pw[1], pw[2], pw[3]), t1 = make_uint4(pw[4], pw[5], pw[6], pw[7]);                                 \
          pf0 = *(bf16x8*)&t0; pf1 = *(bf16x8*)&t1; }                                                                                     \
        O0 = __builtin_amdgcn_mfma_f32_32x32x16_bf16(vf[BUF_][0], pf0, O0, 0, 0, 0);                                                      \
        O0 = __builtin_amdgcn_mfma_f32_32x32x16_bf16(vf[BUF_][1], pf1, O0, 0, 0, 0);                                                      \
        O1 = __builtin_amdgcn_mfma_f32_32x32x16_bf16(vf[BUF_][2], pf0, O1, 0, 0, 0);                                                      \
        O1 = __builtin_amdgcn_mfma_f32_32x32x16_bf16(vf[BUF_][3], pf1, O1, 0, 0, 0);                                                      \
      }
      MOBA_LOAD(0, 0)
      if (ntile > 1) MOBA_LOAD(1, 1)
#pragma unroll 1
      for (int kt3 = 0; kt3 < ntile; kt3 += 3) {
        MOBA_STEP(kt3, 0) MOBA_STEP(kt3 + 1, 1) MOBA_STEP(kt3 + 2, 2)
      }
#undef MOBA_STEP
#undef MOBA_LOAD
      lsum += __shfl_xor(lsum, 32);
      if (valid) {
        if (hh == 0) atomicAdd(&lacc[qi], __float2int_rn(lsum * 1048576.0f));
#pragma unroll
        for (int r = 0; r < 16; ++r) {
          const int dim = (r & 3) + 8 * (r >> 2) + 4 * hh;
          atomicAdd(&Oacc[dim * OLD + qi], __float2int_rn(O0[r] * 1048576.0f));
          atomicAdd(&Oacc[(dim + 32) * OLD + qi], __float2int_rn(O1[r] * 1048576.0f));
        }
      }
    }
    __syncthreads();
    { const int q = tid >> 1, half = tid & 1;
      const float inv = 1.0f / (float)lacc[q];
      float o[32], ss = 0.f;
#pragma unroll
      for (int d = 0; d < 32; ++d) { o[d] = (float)Oacc[(half * 32 + d) * OLD + q] * inv; ss += o[d] * o[d]; }
      ss += __shfl_xor(ss, 1);
      const float r = rsqrtf(ss / 64.0f + EPS);
      bf16_t* dst = p.xb() + (size_t)(b * S + qblk * 256 + q) * KD + 256 + h * 64 + half * 32;
#pragma unroll
      for (int d = 0; d < 32; d += 8) *(uint4*)(dst + d) = make_uint4(pk_bf16(o[d] * r, o[d + 1] * r), pk_bf16(o[d + 2] * r, o[d + 3] * r), pk_bf16(o[d + 4] * r, o[d + 5] * r), pk_bf16(o[d + 6] * r, o[d + 7] * r));
    }
  }
}


__device__ __forceinline__ float ret_log2g(int h) { return log2f(1.0f - exp2f(-5.0f - (float)h)); }
__device__ __forceinline__ void phase_ret_kv(const Params& p, int gw, int ngw, int lane) {
  const int n = lane & 31, hh = lane >> 5;
  for (int w = gw; w < NB * 4 * 32; w += ngw) {
    const int bh = w >> 5, cn = w & 31;
    const bf16_t* vt = p.Vr() + ((size_t)bh * (S / 32) + cn * 4) * 2048 + lane * 8;
    const bf16_t* kt = p.Krv() + ((size_t)bh * (S / 32) + cn * 4) * 2048 + lane * 8;
    f32x16 acc[2][2];
#pragma unroll
    for (int a = 0; a < 2; ++a)
#pragma unroll
      for (int b2 = 0; b2 < 2; ++b2)
#pragma unroll
        for (int r = 0; r < 16; ++r) acc[a][b2][r] = 0.f;
#pragma unroll 1
    for (int tl = 0; tl < 4; ++tl)
#pragma unroll
      for (int ks = 0; ks < 2; ++ks) {
        bf16x8 vf[2], kf[2];
#pragma unroll
        for (int x = 0; x < 2; ++x) { vf[x] = *(const bf16x8*)(vt + tl * 2048 + (x * 2 + ks) * 512); kf[x] = *(const bf16x8*)(kt + tl * 2048 + (x * 2 + ks) * 512); }
#pragma unroll
        for (int mb = 0; mb < 2; ++mb)
#pragma unroll
          for (int nb = 0; nb < 2; ++nb) acc[mb][nb] = __builtin_amdgcn_mfma_f32_32x32x16_bf16(vf[mb], kf[nb], acc[mb][nb], 0, 0, 0);
      }
    float* dst = p.KVr() + ((size_t)bh * 32 + cn) * 4096;
#pragma unroll
    for (int mb = 0; mb < 2; ++mb)
#pragma unroll
      for (int nb = 0; nb < 2; ++nb)
#pragma unroll
        for (int r = 0; r < 16; ++r) dst[(mb * 32 + (r & 3) + 8 * (r >> 2) + 4 * hh) * 64 + nb * 32 + n] = acc[mb][nb][r];
  }
}
__device__ __forceinline__ void phase_ret_scan(const Params& p, int gtid, int ngt) {
  for (int it = gtid; it < NB * 4 * 4096; it += ngt) {
    const int e = it & 4095, bh = it >> 12, h = bh & 3;
    const float l2g = ret_log2g(h), g1 = exp2f(l2g), g127 = exp2f(127.0f * l2g), g128 = exp2f(128.0f * l2g);
    float R = 0.f; float kv[32];
#pragma unroll
    for (int cn = 0; cn < 32; ++cn) kv[cn] = p.KVr()[((size_t)bh * 32 + cn) * 4096 + e];
#pragma unroll
    for (int cn = 0; cn < 32; ++cn) {
      p.Rb()[((size_t)bh * 32 + cn) * 4096 + e] = f2bf(g1 * R);
      R = g128 * R + g127 * kv[cn];
    }
  }
}
__device__ __forceinline__ void phase_ret_out(const Params& p, int gw, int ngw, int lane) {
  const int n = lane & 31, hh = lane >> 5;
  for (int w = gw; w < NB * 4 * 32 * 4; w += ngw) {
    const int qg = 3 - (w & 3), cn = (w >> 2) & 31, bh = w >> 7, b = bh >> 2, h = bh & 3;
    const int s0 = cn * 128 + qg * 32;
    bf16x8 qf[4];
#pragma unroll
    for (int s = 0; s < 4; ++s) qf[s] = *(const bf16x8*)(p.Qr() + ((size_t)bh * S + s0 + n) * 64 + (2 * s + hh) * 8);
    f32x16 O0, O1;
#pragma unroll
    for (int r = 0; r < 16; ++r) { O0[r] = 0.f; O1[r] = 0.f; }
    { const bf16_t* rb = p.Rb() + ((size_t)bh * 32 + cn) * 4096 + (size_t)n * 64 + hh * 8;
#pragma unroll
      for (int s = 0; s < 4; ++s) {
        const bf16x8 r0 = *(const bf16x8*)(rb + s * 16), r1 = *(const bf16x8*)(rb + 32 * 64 + s * 16);
        O0 = __builtin_amdgcn_mfma_f32_32x32x16_bf16(r0, qf[s], O0, 0, 0, 0);
        O1 = __builtin_amdgcn_mfma_f32_32x32x16_bf16(r1, qf[s], O1, 0, 0, 0);
      } }
    const bf16_t* kt0 = p.Kr() + ((size_t)bh * (S / 32) + cn * 4) * 2048 + lane * 8;
    const bf16_t* vt0 = p.Vr() + ((size_t)bh * (S / 32) + cn * 4) * 2048 + lane * 8;
    for (int kt = 0; kt <= qg; ++kt) {
      bf16x8 kf[4], vf[4];
#pragma unroll
      for (int s = 0; s < 4; ++s) { kf[s] = *(const bf16x8*)(kt0 + (size_t)kt * 2048 + s * 512); vf[s] = *(const bf16x8*)(vt0 + (size_t)kt * 2048 + s * 512); }
      f32x16 X;
#pragma unroll
      for (int r = 0; r < 16; ++r) X[r] = 0.f;
#pragma unroll
      for (int s = 0; s < 4; ++s) X = __builtin_amdgcn_mfma_f32_32x32x16_bf16(kf[s], qf[s], X, 0, 0, 0);
      const bool diag = (kt == qg);
      unsigned pw[8];
#pragma unroll
      for (int r = 0; r < 16; r += 2) {
        float e0 = X[r], e1 = X[r + 1];
        if (diag) {
          const int k0 = (r & 3) + 8 * (r >> 2) + 4 * hh, k1 = ((r + 1) & 3) + 8 * ((r + 1) >> 2) + 4 * hh;
          e0 = (k0 <= n) ? e0 : 0.f; e1 = (k1 <= n) ? e1 : 0.f;
        }
        pw[r >> 1] = pk_bf16(e0, e1);
      }
      bf16x8 pf0, pf1;
      { uint4 t0 = make_uint4(pw[0], pw[1], pw[2], pw[3]), t1 = make_uint4(pw[4], pw[5], pw[6], pw[7]);
        pf0 = *(bf16x8*)&t0; pf1 = *(bf16x8*)&t1; }
      O0 = __builtin_amdgcn_mfma_f32_32x32x16_bf16(vf[0], pf0, O0, 0, 0, 0);
      O0 = __builtin_amdgcn_mfma_f32_32x32x16_bf16(vf[1], pf1, O0, 0, 0, 0);
      O1 = __builtin_amdgcn_mfma_f32_32x32x16_bf16(vf[2], pf0, O1, 0, 0, 0);
      O1 = __builtin_amdgcn_mfma_f32_32x32x16_bf16(vf[3], pf1, O1, 0, 0, 0);
    }
    float ss = 0.f;
#pragma unroll
    for (int r = 0; r < 16; ++r) ss += O0[r] * O0[r] + O1[r] * O1[r];
    ss += __shfl_xor(ss, 32);
    const float rn = rsqrtf(ss / 64.0f + EPS);
    const size_t t = (size_t)b * S + s0 + n;
    const bf16_t* gp = p.projb() + t * INW + OFF_GR + h * 64;
    bf16_t* yo = p.xb() + t * KD + 768 + h * 64;
#pragma unroll
    for (int q4 = 0; q4 < 4; ++q4) {
#pragma unroll
      for (int mb = 0; mb < 2; ++mb) {
        const int d0 = mb * 32 + 8 * q4 + 4 * hh;
        const uint2 gw2 = *(const uint2*)(gp + d0); const float4 g = make_float4(__uint_as_float(gw2.x << 16), __uint_as_float(gw2.x & 0xffff0000u), __uint_as_float(gw2.y << 16), __uint_as_float(gw2.y & 0xffff0000u));
        float4 o;
        const f32x16& Oa = mb ? O1 : O0;
        o.x = Oa[q4 * 4 + 0] * rn * g.x * fast_sigmoid(g.x); o.y = Oa[q4 * 4 + 1] * rn * g.y * fast_sigmoid(g.y);
        o.z = Oa[q4 * 4 + 2] * rn * g.z * fast_sigmoid(g.z); o.w = Oa[q4 * 4 + 3] * rn * g.w * fast_sigmoid(g.w);
        *(uint2*)(yo + d0) = make_uint2(pk_bf16(o.x, o.y), pk_bf16(o.z, o.w));
      }
    }
  }
}

__device__ __forceinline__ void phase_post_pack(const Params& p, int l, int gtid, int ngt, int gw, int ngw, int lane) {
  const float* gq = p.inp(12) + l * 64; const float* gk = p.inp(13) + l * 64;
  for (int t = gw; t < T; t += ngw) {
    const int s = t % S, b = t / S;
    const bf16_t* row = p.projb() + (size_t)t * INW;
    float vin[24];
#pragma unroll
    for (int sl = 0; sl < 16; ++sl) vin[sl] = bf2f(row[(sl < 8 ? OFF_QM : OFF_KM) + (sl & 7) * 64 + lane]);
#pragma unroll
    for (int sl = 0; sl < 8; ++sl) vin[16 + sl] = bf2f(row[(sl < 4 ? OFF_QR : OFF_KR) + (sl & 3) * 64 + lane]);
    const float cm = p.cosm()[s * 8 + (lane & 7)], sm = p.sinm()[s * 8 + (lane & 7)];
    const float cr = p.cosr()[s * 32 + (lane & 31)], sr = p.sinr()[s * 32 + (lane & 31)];
    const float gqv = gq[lane], gkv = gk[lane];
#pragma unroll
    for (int slot = 0; slot < 16; ++slot) {
      const int h = slot & 7, bh = b * 8 + h; const bool isk = slot >= 8;
      const float v = vin[slot];
      const float ss = wave_sum(v * v);
      const float u = v * rsqrtf(ss / 64.0f + EPS) * (isk ? gkv : gqv);
      const float pu = __shfl(u, (lane < 8 ? lane + 8 : lane - 8) & 63);
      float o = u;
      if (lane < 16) o = lane < 8 ? (u * cm - pu * sm) : (u * cm + pu * sm);
      if (!isk) p.Qm()[((size_t)bh * S + s) * 64 + lane] = f2bf(o * QSCALE);
      else p.Km()[((((size_t)bh * (S / 32) + (s >> 5)) * 8 + (lane >> 3)) * 32 + (s & 31)) * 8 + (lane & 7)] = f2bf(o);
    }
#pragma unroll
    for (int slot = 16; slot < 24; ++slot) {
      const int h = (slot - 16) & 3, bh = b * 4 + h; const bool isk = slot >= 20;
      const float v = vin[slot];
      const float pv = __shfl(v, lane ^ 32);
      const float o = lane < 32 ? (v * cr - pv * sr) : (v * cr + pv * sr);
      const float l2g = ret_log2g(h); const int pos = s & 127;
      if (!isk) p.Qr()[((size_t)bh * S + s) * 64 + lane] = f2bf(o * exp2f((float)pos * l2g));
      else p.Kr()[((((size_t)bh * (S / 32) + (s >> 5)) * 8 + (lane >> 3)) * 32 + (s & 31)) * 8 + (lane & 7)] = f2bf(o * 0.125f * exp2f(-(float)pos * l2g));
    }
  }
  for (int idx = gtid; idx < NB * 8 * (S / 32) * 256; idx += ngt) {
    const int ln = idx & 63, ks = (idx >> 6) & 1, mb = (idx >> 7) & 1, tile = (idx >> 8) % (S / 32), bh = idx / (256 * (S / 32));
    const int b = bh >> 3, h = bh & 7, hh = ln >> 5, delta = mb * 32 + (ln & 31);
    float v[8];
#pragma unroll
    for (int j = 0; j < 8; ++j) { const int kappa = 16 * ks + 8 * (j >> 2) + 4 * hh + (j & 3), s = tile * 32 + kappa; v[j] = bf2f(p.projb()[(size_t)(b * S + s) * INW + OFF_VM + h * 64 + delta]); }
    uint4 o; o.x = pk_bf16(v[0], v[1]); o.y = pk_bf16(v[2], v[3]); o.z = pk_bf16(v[4], v[5]); o.w = pk_bf16(v[6], v[7]);
    *(uint4*)(p.Vm() + (size_t)idx * 8) = o;
  }
  for (int idx = gtid; idx < 2 * NB * 4 * (S / 32) * 256; idx += ngt) {
    const int ln = idx & 63, ks = (idx >> 6) & 1, blk = (idx >> 7) & 1, tile = (idx >> 8) % (S / 32), rest = idx / (256 * (S / 32)), bh = rest % (NB * 4), which = rest / (NB * 4);
    const int b = bh >> 2, h = bh & 3, hh = ln >> 5, delta = blk * 32 + (ln & 31);
    const float l2g = ret_log2g(h);
    float v[8];
#pragma unroll
    for (int j = 0; j < 8; ++j) {
      const int kappa = 16 * ks + 8 * (j >> 2) + 4 * hh + (j & 3), s = tile * 32 + kappa;
      const bf16_t* row = p.projb() + (size_t)(b * S + s) * INW;
      float x;
      if (which) {
        const float a = bf2f(row[OFF_KR + h * 64 + delta]), pa = bf2f(row[OFF_KR + h * 64 + (delta ^ 32)]);
        const int i = delta & 31; const float c = p.cosr()[s * 32 + i], sn = p.sinr()[s * 32 + i];
        x = (delta < 32 ? (a * c - pa * sn) : (a * c + pa * sn)) * 0.125f * exp2f(-(float)(s & 127) * l2g);
      } else x = bf2f(row[OFF_VR + h * 64 + delta]);
      v[j] = x;
    }
    uint4 o; o.x = pk_bf16(v[0], v[1]); o.y = pk_bf16(v[2], v[3]); o.z = pk_bf16(v[4], v[5]); o.w = pk_bf16(v[6], v[7]);
    *(uint4*)((which ? p.Krv() : p.Vr()) + ((size_t)(idx % (NB * 4 * (S / 32) * 256))) * 8) = o;
  }
}
__device__ __forceinline__ void phase_kmean2(const Params& p, int gtid, int ngt) {
  for (int idx = gtid; idx < NB * 8 * 16 * 64; idx += ngt) {
    const int d = idx & 63, j = (idx >> 6) & 15, bh = idx >> 10, c = d >> 3, dj = d & 7;
    float acc = 0.f;
    for (int tl = 0; tl < 8; ++tl) {
      const bf16_t* kp = p.Km() + (((size_t)bh * (S / 32) + j * 8 + tl) * 8 + c) * 256 + dj;
#pragma unroll 8
      for (int key = 0; key < 32; ++key) acc += bf2f(kp[key * 8]);
    }
    p.kmean()[idx] = acc * (1.0f / 256.0f);
  }
}

__device__ __forceinline__ void cvt_f32_bf16(const float* __restrict__ src, bf16_t* __restrict__ dst, size_t n8, int gtid, int ngt) {
  for (size_t i = gtid; i < n8; i += ngt) {
    float4 a = *(const float4*)(src + i * 8), b4 = *(const float4*)(src + i * 8 + 4);
    uint4 o; o.x = pk_bf16(a.x, a.y); o.y = pk_bf16(a.z, a.w); o.z = pk_bf16(b4.x, b4.y); o.w = pk_bf16(b4.z, b4.w);
    *(uint4*)(dst + i * 8) = o;
  }
}
__device__ __forceinline__ int f2key(float f) { int b = __float_as_int(f); return b ^ ((b >> 31) & 0x7fffffff); }
__device__ __forceinline__ float key2f(int k) { return __int_as_float(k ^ ((k >> 31) & 0x7fffffff)); }
#define CASD(a_, b_) { int mx_ = max(a_, b_), mn_ = min(a_, b_); a_ = mx_; b_ = mn_; }
__device__ __forceinline__ void sort16_desc(int (&v)[16]) {
#pragma unroll
  for (int k = 2; k <= 16; k <<= 1)
#pragma unroll
    for (int j = k >> 1; j > 0; j >>= 1)
#pragma unroll
      for (int i = 0; i < 16; ++i) { const int l2 = i ^ j; if (l2 > i) { if ((i & k) == 0) CASD(v[i], v[l2]) else CASD(v[l2], v[i]) } }
}
__device__ __forceinline__ void merge_top16(int (&a)[16], const int (&b)[16]) {
#pragma unroll
  for (int i = 0; i < 16; ++i) a[i] = max(a[i], b[15 - i]);
#pragma unroll
  for (int j = 8; j > 0; j >>= 1)
#pragma unroll
    for (int i = 0; i < 16; ++i) { const int l2 = i ^ j; if (l2 > i) CASD(a[i], a[l2]) }
}
__device__ __forceinline__ int lut4(int w0, int w1, int w2, int w3, int i) {
  const int w = i >> 2; const int d = (w == 0) ? w0 : (w == 1) ? w1 : (w == 2) ? w2 : w3;
  return (d >> ((i & 3) * 8)) & 127;
}

__device__ __forceinline__ void phase_peer_topk(const Params& p, int l, int gw, int ngw, int lane) {
  const int n = lane & 31, hh = lane >> 5;
  const bf16_t* skl = p.skb() + (size_t)l * 16 * 128 * 64;
  for (int w = gw; w < (T / 32) * 8; w += ngw) {
    const int tg = w >> 3, h = w & 7, t = tg * 32 + n;
    int L0[16], L1[16];
#pragma unroll
    for (int c = 0; c < 2; ++c) {
      const int hc = 2 * h + c;
      bf16x8 qf[4];
#pragma unroll
      for (int s = 0; s < 4; ++s) qf[s] = *(const bf16x8*)(p.qb() + (size_t)t * D + hc * 64 + 16 * s + 8 * hh);
      int A[16], Bq[16];
#pragma unroll
      for (int mb = 0; mb < 4; ++mb) {
        f32x16 X;
#pragma unroll
        for (int r = 0; r < 16; ++r) X[r] = 0.f;
#pragma unroll
        for (int s = 0; s < 4; ++s) {
          const bf16x8 kf = *(const bf16x8*)(skl + ((size_t)(hc * 128 + mb * 32 + n)) * 64 + 16 * s + 8 * hh);
          X = __builtin_amdgcn_mfma_f32_32x32x16_bf16(kf, qf[s], X, 0, 0, 0);
        }
        int Gk[16];
#pragma unroll
        for (int r = 0; r < 16; ++r) Gk[r] = (f2key(X[r]) & ~127) | (mb * 32 + (r & 3) + 8 * (r >> 2) + 4 * hh);
        sort16_desc(Gk);
        if (mb == 0) {
#pragma unroll
          for (int r = 0; r < 16; ++r) A[r] = Gk[r];
        } else merge_top16(A, Gk);
      }
#pragma unroll
      for (int r = 0; r < 16; ++r) Bq[r] = __shfl_xor(A[r], 32);
      merge_top16(A, Bq);
#pragma unroll
      for (int r = 0; r < 16; ++r) { if (c == 0) L0[r] = A[r]; else L1[r] = A[r]; }
    }
    float av[16], bv[16];
#pragma unroll
    for (int r = 0; r < 16; ++r) { av[r] = key2f(L0[r] & ~127); bv[r] = key2f(L1[r] & ~127); }
#define CAND(i_, j_) ((f2key(av[i_] + bv[j_]) & ~255) | ((i_) << 4) | (j_))
    int R[16], G1[16], G2[16];
#pragma unroll
    for (int j = 0; j < 16; ++j) R[j] = CAND(0, j);
    G1[0] = CAND(1, 0); G1[1] = CAND(1, 1); G1[2] = CAND(1, 2); G1[3] = CAND(1, 3); G1[4] = CAND(1, 4); G1[5] = CAND(1, 5); G1[6] = CAND(1, 6); G1[7] = CAND(1, 7);
    G1[8] = CAND(2, 0); G1[9] = CAND(2, 1); G1[10] = CAND(2, 2); G1[11] = CAND(2, 3); G1[12] = CAND(2, 4); G1[13] = CAND(3, 0); G1[14] = CAND(3, 1); G1[15] = CAND(3, 2);
    G2[0] = CAND(3, 3); G2[1] = CAND(4, 0); G2[2] = CAND(4, 1); G2[3] = CAND(4, 2); G2[4] = CAND(5, 0); G2[5] = CAND(5, 1); G2[6] = CAND(6, 0); G2[7] = CAND(6, 1);
    G2[8] = CAND(7, 0); G2[9] = CAND(7, 1); G2[10] = CAND(8, 0); G2[11] = CAND(9, 0); G2[12] = CAND(10, 0); G2[13] = CAND(11, 0); G2[14] = CAND(12, 0); G2[15] = CAND(13, 0);
    sort16_desc(G1); merge_top16(R, G1);
    sort16_desc(G2); merge_top16(R, G2);
    { int x0 = CAND(14, 0), x1 = CAND(15, 0);
#pragma unroll
      for (int i = 0; i < 16; ++i) CASD(R[i], x0)
#pragma unroll
      for (int i = 0; i < 16; ++i) CASD(R[i], x1)
    }
#undef CAND
    int pa0 = 0, pa1 = 0, pa2 = 0, pa3 = 0, pb0 = 0, pb1 = 0, pb2 = 0, pb3 = 0;
#pragma unroll
    for (int q = 0; q < 4; ++q) {
      pa0 |= (L0[q] & 127) << (8 * q); pa1 |= (L0[4 + q] & 127) << (8 * q); pa2 |= (L0[8 + q] & 127) << (8 * q); pa3 |= (L0[12 + q] & 127) << (8 * q);
      pb0 |= (L1[q] & 127) << (8 * q); pb1 |= (L1[4 + q] & 127) << (8 * q); pb2 |= (L1[8 + q] & 127) << (8 * q); pb3 |= (L1[12 + q] & 127) << (8 * q);
    }
    float ev[16], sum = 0.f; int ei[16];
    const float mx = key2f(R[0] & ~255);
#pragma unroll
    for (int z = 0; z < 16; ++z) {
      const float v = key2f(R[z] & ~255);
      ev[z] = __expf(v - mx); sum += ev[z];
      const int pay = R[z] & 255;
      ei[z] = lut4(pa0, pa1, pa2, pa3, pay >> 4) * 128 + lut4(pb0, pb1, pb2, pb3, pay & 15);
    }
    const float inv = 1.0f / sum;
    if (hh == 0) {
      float* go = p.gates() + ((size_t)t * 8 + h) * 16; int* eo = p.eidx() + ((size_t)t * 8 + h) * 16;
#pragma unroll
      for (int z = 0; z < 16; z += 4) {
        *(float4*)(go + z) = make_float4(ev[z] * inv, ev[z + 1] * inv, ev[z + 2] * inv, ev[z + 3] * inv);
        *(int4*)(eo + z) = make_int4(ei[z], ei[z + 1], ei[z + 2], ei[z + 3]);
      }
    }
  }
}


typedef int v8i __attribute__((ext_vector_type(8)));
__device__ __forceinline__ unsigned xcc_id() { return (unsigned)__builtin_amdgcn_s_getreg((3 << 11) | 20) & 7u; }
__device__ __forceinline__ float pow2_scale(float amax) {
  if (!(amax > 0.f)) return 1.0f;
  const int e = (int)floorf(log2f(240.0f / amax));
  return exp2f((float)(e < 60 ? (e > -60 ? e : -60) : 60));
}
__device__ __forceinline__ unsigned pack4_fp8(float a, float b, float c, float d) {
  int v = __builtin_amdgcn_cvt_pk_fp8_f32(a, b, 0, false);
  v = __builtin_amdgcn_cvt_pk_fp8_f32(c, d, v, true);
  return (unsigned)v;
}
__device__ __forceinline__ void cvt_table_fp8(const float* __restrict__ src, unsigned char* __restrict__ dst, float* __restrict__ scl, int gw, int ngw, int lane) {
  for (int e0 = gw; e0 < 16384; e0 += 2 * ngw) {
    float4 v[2][4];
#pragma unroll
    for (int u = 0; u < 2; ++u) { const int e = (e0 + u * ngw < 16384) ? e0 + u * ngw : e0;
#pragma unroll
      for (int k = 0; k < 4; ++k) v[u][k] = *(const float4*)(src + (size_t)e * D + k * 256 + lane * 4); }
#pragma unroll
    for (int u = 0; u < 2; ++u) {
      const int e = e0 + u * ngw;
      if (e < 16384) {
        float am = 0.f;
#pragma unroll
        for (int k = 0; k < 4; ++k) am = fmaxf(am, fmaxf(fmaxf(fabsf(v[u][k].x), fabsf(v[u][k].y)), fmaxf(fabsf(v[u][k].z), fabsf(v[u][k].w))));
        am = wave_max(am);
        const float s = pow2_scale(am);
        if (lane == 0) scl[e] = s;
#pragma unroll
        for (int k = 0; k < 4; ++k) {
          const int slice = 2 * k + (lane >> 5), off = (lane & 31) * 4;
          *(unsigned*)(dst + ((size_t)slice * 16384 + e) * 128 + off) = pack4_fp8(v[u][k].x * s, v[u][k].y * s, v[u][k].z * s, v[u][k].w * s);
        }
      }
    }
  }
}
#define DPP_ADD(v_, ctrl_) ((v_) + __builtin_bit_cast(float, __builtin_amdgcn_update_dpp(0, __builtin_bit_cast(int, (v_)), (ctrl_), 0xF, 0xF, true)))
__device__ __forceinline__ float sum_xor16(float x) { float a = x, b = x; asm volatile("v_nop\n\tv_nop\n\tv_permlane16_swap_b32 %0, %1" : "+v"(a), "+v"(b)); return a + b; }
__device__ __forceinline__ float sum_xor32(float x) { float a = x, b = x; asm volatile("v_nop\n\tv_nop\n\tv_permlane32_swap_b32 %0, %1" : "+v"(a), "+v"(b)); return a + b; }
__device__ __forceinline__ int q_pull(int* head, int nitems, int* bc, int tid) {
  __syncthreads();
  if (tid == 0) bc[0] = atomicAdd(head, 1);
  __syncthreads();
  const int v = bc[0];
  return v < nitems ? v : -1;
}
constexpr int PEER_TILE = 128;
__device__ __forceinline__ void phase_peer_u(const Params& p, int* heads, unsigned char* lds, int tid) {
  const int lane = tid & 63, wv = tid >> 6, r8 = lane >> 3, c8 = lane & 7;
  int* bc = (int*)lds;
  int* eW = (int*)(lds + 1024 + wv * 12288);
  bf16_t* hW = (bf16_t*)(lds + 1024 + wv * 12288 + 8192);
  const int myx = (int)xcc_id();
  for (int pass = 0; pass < 8; ++pass) {
    const int s = (myx + pass) & 7;
    const unsigned char* Us = p.U8s() + (size_t)s * 16384 * 128 + c8 * 16;
    for (;;) {
      const int item = q_pull(heads + s, T / PEER_TILE, bc, tid);
      if (item < 0) break;
      const int t0 = item * PEER_TILE + wv * 16;
      LDS_FENCE();
      { uint2 ev[16];
        const bf16_t* hsrc = p.hb() + ((size_t)s * T + t0) * 128 + lane * 8;
#pragma unroll
        for (int k = 0; k < 16; ++k) ev[k] = *(const uint2*)(p.eidx() + (size_t)(t0 + k) * 128 + lane * 2);
        const uint4 hq0 = *(const uint4*)(hsrc), hq1 = *(const uint4*)(hsrc + 512), hq2 = *(const uint4*)(hsrc + 1024), hq3 = *(const uint4*)(hsrc + 1536);
#pragma unroll
        for (int k = 0; k < 16; ++k) *(uint2*)(eW + k * 128 + lane * 2) = ev[k];
        *(uint4*)(hW + lane * 8) = hq0; *(uint4*)(hW + 512 + lane * 8) = hq1; *(uint4*)(hW + 1024 + lane * 8) = hq2; *(uint4*)(hW + 1536 + lane * 8) = hq3; }
      LDS_FENCE();
      uint4 R[4][8];
#define PEER_U_LOAD(M_, BUF_) { _Pragma("unroll") for (int eb = 0; eb < 8; ++eb) R[BUF_][eb] = *(const uint4*)(Us + (size_t)eW[(M_) * 64 + eb * 8 + r8] * 128); }
      PEER_U_LOAD(0, 0) PEER_U_LOAD(1, 1) PEER_U_LOAD(2, 2)
      float hv[16]; float res0 = 0.f, res1 = 0.f;
#define PEER_U_LOADH(TOK_) { const bf16_t* hp = hW + (TOK_) * 128 + c8 * 16; const uint4 a = *(const uint4*)hp, b4 = *(const uint4*)(hp + 8); \
        const unsigned w8[8] = {a.x, a.y, a.z, a.w, b4.x, b4.y, b4.z, b4.w};                                                              \
        _Pragma("unroll") for (int z = 0; z < 8; ++z) { hv[2 * z] = __uint_as_float(w8[z] << 16); hv[2 * z + 1] = __uint_as_float(w8[z] & 0xffff0000u); } }
      PEER_U_LOADH(0)
#define PEER_U_HALF(M_, BUF_, HALF_)                                                                           \
      {                                                                                                                                   \
        if ((M_) + 3 < 32) PEER_U_LOAD((M_) + 3, ((BUF_) + 3) & 3)                                                                        \
        _Pragma("unroll") for (int eb = 0; eb < 8; ++eb) {                                                                                \
          const unsigned ww[4] = {R[BUF_][eb].x, R[BUF_][eb].y, R[BUF_][eb].z, R[BUF_][eb].w};                                            \
          float d = 0.f;                                                                                                                  \
          _Pragma("unroll") for (int q4 = 0; q4 < 4; ++q4) {                                                                              \
            const auto f01 = __builtin_amdgcn_cvt_pk_f32_fp8((int)ww[q4], false); const auto f23 = __builtin_amdgcn_cvt_pk_f32_fp8((int)ww[q4], true); \
            d = fmaf(hv[q4 * 4 + 0], f01[0], d); d = fmaf(hv[q4 * 4 + 1], f01[1], d); d = fmaf(hv[q4 * 4 + 2], f23[0], d); d = fmaf(hv[q4 * 4 + 3], f23[1], d); \
          }                                                                                                                               \
          d = DPP_ADD(d, 0xB1); d = DPP_ADD(d, 0x4E); d = DPP_ADD(d, 0x141);     \
          if ((HALF_) == 0) { if (c8 == eb) res0 = d; } else { if (c8 == eb) res1 = d; }                                                  \
        }                                                                                                                                 \
        if ((HALF_) == 1) {                                                                                                               \
          float* po = p.ppart() + ((size_t)s * T + t0 + ((M_) >> 1)) * 128;                                                               \
          po[c8 * 8 + r8] = res0; po[64 + c8 * 8 + r8] = res1;                                                                            \
          if ((M_) + 1 < 32) PEER_U_LOADH(((M_) >> 1) + 1)                                                                                \
        }                                                                                                                                 \
      }
#pragma unroll
      for (int m4 = 0; m4 < 32; m4 += 4) {
        PEER_U_HALF(m4, 0, 0) PEER_U_HALF(m4 + 1, 1, 1) PEER_U_HALF(m4 + 2, 2, 0) PEER_U_HALF(m4 + 3, 3, 1)
      }
#undef PEER_U_HALF
#undef PEER_U_LOADH
#undef PEER_U_LOAD
    }
  }
}
__device__ __forceinline__ void phase_peer_r(const Params& p, int gtid, int ngt) {
  for (int idx0 = gtid; idx0 < T * 128; idx0 += 4 * ngt) {
    float d[4]; int e[4]; float su_[4], sv_[4], g_[4]; bool ok[4];
#pragma unroll
    for (int u = 0; u < 4; ++u) { const int idx = idx0 + u * ngt; ok[u] = idx < T * 128; const int ix = ok[u] ? idx : 0;
      e[u] = p.eidx()[ix]; g_[u] = p.gates()[ix]; float a = 0.f;
#pragma unroll
      for (int s = 0; s < 8; ++s) a += p.ppart()[(size_t)s * T * 128 + ix];
      d[u] = a; }
#pragma unroll
    for (int u = 0; u < 4; ++u) { su_[u] = p.su()[e[u]]; sv_[u] = p.sv()[e[u]]; }
#pragma unroll
    for (int u = 0; u < 4; ++u) if (ok[u]) p.gates()[idx0 + u * ngt] = g_[u] * gelu_tanh(d[u] * p.rstd()[(idx0 + u * ngt) >> 7] / su_[u]) / sv_[u];
  }
}
__device__ __forceinline__ void phase_peer_v(const Params& p, int* heads, unsigned char* lds, int tid) {
  const int lane = tid & 63, wv = tid >> 6, r8 = lane >> 3, c8 = lane & 7;
  int* bc = (int*)lds;
  uint2* pW = (uint2*)(lds + 1024 + wv * 16384);
  const int myx = (int)xcc_id();
  for (int pass = 0; pass < 8; ++pass) {
    const int s = (myx + pass) & 7;
    const unsigned char* Vs = p.V8s() + (size_t)s * 16384 * 128 + c8 * 16;
    for (;;) {
      const int item = q_pull(heads + s, T / PEER_TILE, bc, tid);
      if (item < 0) break;
      const int t0 = item * PEER_TILE + wv * 16;
      LDS_FENCE();
      { uint2 e2[16], g2[16];
#pragma unroll
        for (int k = 0; k < 16; ++k) { e2[k] = *(const uint2*)(p.eidx() + (size_t)(t0 + k) * 128 + lane * 2); g2[k] = *(const uint2*)(p.gates() + (size_t)(t0 + k) * 128 + lane * 2); }
#pragma unroll
        for (int k = 0; k < 16; ++k) *(uint4*)(pW + k * 128 + lane * 2) = make_uint4(e2[k].x, g2[k].x, e2[k].y, g2[k].y); }
      LDS_FENCE();
      const int rowk = lane >> 4, prow = ((rowk & 1) << 1) | (rowk >> 1);
      const bool wr_lane = (lane & 8) == 0;
      const int xoff = s * 128 + c8 * 16 + prow * 4;
      float4 xo[8];
#pragma unroll
      for (int k = 0; k < 8; ++k) xo[k] = *(const float4*)(p.outp() + (size_t)(t0 + k) * D + xoff);
      uint4 R[3][8];
#define PEER_V_LOAD(M_, BUF_) { _Pragma("unroll") for (int eb = 0; eb < 8; ++eb) R[BUF_][eb] = *(const uint4*)(Vs + (size_t)pW[(M_) * 64 + eb * 8 + r8].x * 128); }
      PEER_V_LOAD(0, 0) PEER_V_LOAD(1, 1)
      float acc[16];
#define PEER_V_HALF(M_, BUF_, HALF_)                                                           \
      {                                                                                                                                   \
        if ((M_) + 2 < 32) PEER_V_LOAD((M_) + 2, ((BUF_) + 2) % 3)                                                                        \
        if ((HALF_) == 0) { _Pragma("unroll") for (int z = 0; z < 16; ++z) acc[z] = 0.f; }                                                \
        _Pragma("unroll") for (int eb = 0; eb < 8; ++eb) {                                                                                \
          const float c = __uint_as_float(pW[(M_) * 64 + eb * 8 + r8].y);                                                                 \
          const unsigned ww[4] = {R[BUF_][eb].x, R[BUF_][eb].y, R[BUF_][eb].z, R[BUF_][eb].w};                                            \
          _Pragma("unroll") for (int q4 = 0; q4 < 4; ++q4) {                                                                              \
            const auto f01 = __builtin_amdgcn_cvt_pk_f32_fp8((int)ww[q4], false); const auto f23 = __builtin_amdgcn_cvt_pk_f32_fp8((int)ww[q4], true); \
            acc[q4 * 4 + 0] = fmaf(c, f01[0], acc[q4 * 4 + 0]); acc[q4 * 4 + 1] = fmaf(c, f01[1], acc[q4 * 4 + 1]);                       \
            acc[q4 * 4 + 2] = fmaf(c, f23[0], acc[q4 * 4 + 2]); acc[q4 * 4 + 3] = fmaf(c, f23[1], acc[q4 * 4 + 3]);                       \
          }                                                                                                                               \
        }                                                                                                                                 \
        if ((HALF_) == 1) {                                                                                                               \
          _Pragma("unroll") for (int z = 0; z < 16; ++z) acc[z] = DPP_ADD(acc[z], 0x128);                                  \
          asm volatile("v_nop\n\tv_nop\n\tv_permlane16_swap_b32 %0, %8\n\tv_permlane16_swap_b32 %1, %9\n\tv_permlane16_swap_b32 %2, %10\n\tv_permlane16_swap_b32 %3, %11\n\t" \
                       "v_permlane16_swap_b32 %4, %12\n\tv_permlane16_swap_b32 %5, %13\n\tv_permlane16_swap_b32 %6, %14\n\tv_permlane16_swap_b32 %7, %15" \
            : "+v"(acc[0]), "+v"(acc[1]), "+v"(acc[2]), "+v"(acc[3]), "+v"(acc[4]), "+v"(acc[5]), "+v"(acc[6]), "+v"(acc[7]),                   \
              "+v"(acc[8]), "+v"(acc[9]), "+v"(acc[10]), "+v"(acc[11]), "+v"(acc[12]), "+v"(acc[13]), "+v"(acc[14]), "+v"(acc[15]));               \
          _Pragma("unroll") for (int z = 0; z < 8; ++z) acc[z] += acc[z + 8];            \
          asm volatile("v_nop\n\tv_nop\n\tv_permlane32_swap_b32 %0, %4\n\tv_permlane32_swap_b32 %1, %5\n\tv_permlane32_swap_b32 %2, %6\n\tv_permlane32_swap_b32 %3, %7" \
            : "+v"(acc[0]), "+v"(acc[1]), "+v"(acc[2]), "+v"(acc[3]), "+v"(acc[4]), "+v"(acc[5]), "+v"(acc[6]), "+v"(acc[7]));                   \
          float4 dl;                                                                                                                      \
          dl.x = acc[0] + acc[4]; dl.y = acc[1] + acc[5]; dl.z = acc[2] + acc[6]; dl.w = acc[3] + acc[7];     \
          const float4 xv = xo[((M_) >> 1) & 7];                                                                                          \
          if (((M_) >> 1) + 8 < 16) xo[((M_) >> 1) & 7] = *(const float4*)(p.outp() + (size_t)(t0 + ((M_) >> 1) + 8) * D + xoff);                  \
          const float4 xn = make_float4(xv.x + dl.x, xv.y + dl.y, xv.z + dl.z, xv.w + dl.w);                                              \
          float sq = 0.f;                                                                                                                 \
          if (wr_lane) {                                                                                                                  \
            *(float4*)(p.outp() + (size_t)(t0 + ((M_) >> 1)) * D + xoff) = xn;                                                             \
            *(uint2*)(p.xb() + (size_t)(t0 + ((M_) >> 1)) * KD + xoff) = make_uint2(pk_bf16(xn.x, xn.y), pk_bf16(xn.z, xn.w));     \
            sq = (xn.x * xn.x + xn.y * xn.y) + (xn.z * xn.z + xn.w * xn.w);                                                                \
          }                                                                                                                               \
          sq = DPP_ADD(sq, 0xB1); sq = DPP_ADD(sq, 0x4E); sq = DPP_ADD(sq, 0x141); sq = DPP_ADD(sq, 0x128); sq = sum_xor16(sq); sq = sum_xor32(sq);     \
          if (lane == 0) p.ssq1()[(size_t)(t0 + ((M_) >> 1)) * 8 + s] = sq;                                                               \
        }                                                                                                                                 \
      }
#pragma unroll
      for (int m6 = 0; m6 < 30; m6 += 6) {
        PEER_V_HALF(m6, 0, 0) PEER_V_HALF(m6 + 1, 1, 1) PEER_V_HALF(m6 + 2, 2, 0) PEER_V_HALF(m6 + 3, 0, 1) PEER_V_HALF(m6 + 4, 1, 0) PEER_V_HALF(m6 + 5, 2, 1)
      }
      PEER_V_HALF(30, 0, 0) PEER_V_HALF(31, 1, 1)
#undef PEER_V_HALF
#undef PEER_V_LOAD
    }
  }
}

#if PEER_CHECK
constexpr int CHK_N = 512;
__device__ __forceinline__ float* chk_x(const Params& p) { return (float*)(p.ws + WO_ybuf); }
__device__ __forceinline__ float* chk_m(const Params& p) { return (float*)(p.ws + WO_ybuf + (size_t)CHK_N * D * 4); }
__device__ __forceinline__ float* chk_g(const Params& p) { return (float*)(p.ws + WO_ybuf + (size_t)CHK_N * D * 4 + 4096); }
__device__ __forceinline__ void chk_save(const Params& p, int gtid, int ngt) {
  for (int i = gtid; i < CHK_N * D; i += ngt) chk_x(p)[i] = p.outp()[(size_t)(i / D) * 64 * D + (i % D)];
  for (int i = gtid; i < CHK_N * 128; i += ngt) chk_g(p)[i] = p.gates()[(size_t)(i / 128) * 64 * 128 + (i % 128)];
  if (gtid < 16) chk_m(p)[gtid] = 0.f;
}
__device__ __forceinline__ void chk_apply(const Params& p, int l, float* coef, int gw, int ngw, int lane) {
  const float* g2 = p.inp(16) + l * D;
  const float* U = p.inp(19) + (size_t)l * 16384 * D; const float* V = p.inp(20) + (size_t)l * 16384 * D;
  for (int i = gw; i < CHK_N; i += ngw) {
    const int t = i * 64;
    const float r = p.rstd()[t];
    float4 hv[4];
#pragma unroll
    for (int k = 0; k < 4; ++k) {
      float4 xv = *(const float4*)(chk_x(p) + (size_t)i * D + (lane + k * 64) * 4);
      float4 gv = *(const float4*)(g2 + (lane + k * 64) * 4);
      hv[k].x = xv.x * r * gv.x; hv[k].y = xv.y * r * gv.y; hv[k].z = xv.z * r * gv.z; hv[k].w = xv.w * r * gv.w;
    }
    LDS_FENCE();
    for (int j = 0; j < 128; ++j) {
      const int e = p.eidx()[(size_t)t * 128 + j];
      const float4* up = (const float4*)(U + (size_t)e * D);
      float dsum = 0.f;
#pragma unroll
      for (int k = 0; k < 4; ++k) { float4 uv = up[lane + k * 64]; dsum += hv[k].x * uv.x + hv[k].y * uv.y + hv[k].z * uv.z + hv[k].w * uv.w; }
      dsum = wave_sum(dsum);
      if (lane == 0) coef[j] = chk_g(p)[(size_t)i * 128 + j] * gelu_tanh(dsum);
    }
    LDS_FENCE();
    float4 acc[4];
#pragma unroll
    for (int k = 0; k < 4; ++k) acc[k] = make_float4(0.f, 0.f, 0.f, 0.f);
    for (int j = 0; j < 128; ++j) {
      const int e = p.eidx()[(size_t)t * 128 + j];
      const float c = coef[j];
      const float4* vp = (const float4*)(V + (size_t)e * D);
#pragma unroll
      for (int k = 0; k < 4; ++k) { float4 vv = vp[lane + k * 64]; acc[k].x = fmaf(c, vv.x, acc[k].x); acc[k].y = fmaf(c, vv.y, acc[k].y); acc[k].z = fmaf(c, vv.z, acc[k].z); acc[k].w = fmaf(c, vv.w, acc[k].w); }
    }
    float d2 = 0.f, r2 = 0.f;
#pragma unroll
    for (int k = 0; k < 4; ++k) {
      float4 xa = *(const float4*)(p.outp() + (size_t)t * D + (lane + k * 64) * 4);
      float4 xb4 = *(const float4*)(chk_x(p) + (size_t)i * D + (lane + k * 64) * 4);
      float e0 = (xa.x - xb4.x) - acc[k].x, e1 = (xa.y - xb4.y) - acc[k].y, e2 = (xa.z - xb4.z) - acc[k].z, e3 = (xa.w - xb4.w) - acc[k].w;
      d2 += e0 * e0 + e1 * e1 + e2 * e2 + e3 * e3;
      r2 += acc[k].x * acc[k].x + acc[k].y * acc[k].y + acc[k].z * acc[k].z + acc[k].w * acc[k].w;
    }
    d2 = wave_sum(d2); r2 = wave_sum(r2);
    if (lane == 0) { atomicAdd((unsigned long long*)&chk_m(p)[8], (unsigned long long)(d2 * 1099511627776.0f)); atomicAdd((unsigned long long*)&chk_m(p)[10], (unsigned long long)(r2 * 1099511627776.0f)); }
  }
}
__device__ __forceinline__ void chk_topk(const Params& p, int l, int gtid, int ngt) {
  const float* subk = p.inp(18) + (size_t)l * 16 * 128 * 64;
  for (int it = gtid; it < CHK_N * 8; it += ngt) {
    const int i = it >> 3, h = it & 7, t = i * 64;
    float tva[16], tvb[16]; int tia[16], tib[16];
#pragma unroll 1
    for (int c = 0; c < 2; ++c) {
      float tv[16]; int ti[16];
#pragma unroll
      for (int z = 0; z < 16; ++z) { tv[z] = -INFINITY; ti[z] = 0; }
      const bf16_t* q = p.qb() + (size_t)t * D + (2 * h + c) * 64;
      const float* kb = subk + (size_t)(2 * h + c) * 128 * 64;
#pragma unroll 1
      for (int n = 0; n < 128; ++n) {
        float sc = 0.f;
        for (int d = 0; d < 64; ++d) sc = fmaf(bf2f(q[d]), kb[n * 64 + d], sc);
        float v_ = sc; int i_ = n;
#pragma unroll
        for (int z = 0; z < 16; ++z) { bool gt = v_ > tv[z]; float a = tv[z]; int b = ti[z]; tv[z] = gt ? v_ : a; ti[z] = gt ? i_ : b; v_ = gt ? a : v_; i_ = gt ? b : i_; }
      }
#pragma unroll
      for (int z = 0; z < 16; ++z) { if (c == 0) { tva[z] = tv[z]; tia[z] = ti[z]; } else { tvb[z] = tv[z]; tib[z] = ti[z]; } }
    }
    float tv[16]; int ti[16];
#pragma unroll
    for (int z = 0; z < 16; ++z) { tv[z] = -INFINITY; ti[z] = 0; }
#pragma unroll 1
    for (int a = 0; a < 16; ++a)
#pragma unroll 1
      for (int b = 0; b < 16; ++b) {
        float av = 0.f, bv = 0.f; int ai = 0, bi = 0;
#pragma unroll
        for (int z = 0; z < 16; ++z) { if (z == a) { av = tva[z]; ai = tia[z]; } if (z == b) { bv = tvb[z]; bi = tib[z]; } }
        float v_ = av + bv; int i_ = ai * 128 + bi;
#pragma unroll
        for (int z = 0; z < 16; ++z) { bool gt = v_ > tv[z]; float x = tv[z]; int y = ti[z]; tv[z] = gt ? v_ : x; ti[z] = gt ? i_ : y; v_ = gt ? x : v_; i_ = gt ? y : i_; }
      }
    float sum = 0.f, ev[16];
#pragma unroll
    for (int z = 0; z < 16; ++z) { ev[z] = expf(tv[z] - tv[0]); sum += ev[z]; }
    int miss = 0; float gerr = 0.f;
    for (int z = 0; z < 16; ++z) {
      const int ef = p.eidx()[((size_t)t * 8 + h) * 16 + z]; const float gf = p.gates()[((size_t)t * 8 + h) * 16 + z];
      bool found = false;
#pragma unroll
      for (int y = 0; y < 16; ++y) if (ti[y] == ef) { found = true; gerr = fmaxf(gerr, fabsf(ev[y] / sum - gf)); }
      if (!found) ++miss;
    }
    atomicAdd(&chk_m(p)[3], (float)miss);
    atomicMax((int*)&chk_m(p)[4], __float_as_int(gerr));
  }
}
__device__ __forceinline__ void chk_emit(const Params& p) {
  float v = 0.f;
  if (PEER_CHECK == 1) v = sqrtf((float)((double)*(unsigned long long*)&chk_m(p)[8] / (double)*(unsigned long long*)&chk_m(p)[10]));
  if (PEER_CHECK == 2) v = chk_m(p)[3] / (float)(CHK_N * 8 * 16);
  if (PEER_CHECK == 3) v = chk_m(p)[4];
  p.outp()[0] += 1.0e4f * v + 100.0f;
}
#endif

#define XB_TMO      128
#define XB_XCNT(j)  (256  + 64 * (j))
#define XB_XSUB(j)  (1280 + 64 * (j))
#define XB_XGEN(j)  (2304 + 64 * (j))
#define XB_TOP      3328
#define XB_TOPGEN   3392
#define XCD_BAR_WORDS 3456
#define XB_SPIN_CAP (1u << 18)
#define LAS __attribute__((address_space(3)))

__device__ __forceinline__ unsigned xb_ld(unsigned* p)              { return __hip_atomic_load(p, __ATOMIC_RELAXED, __HIP_MEMORY_SCOPE_AGENT); }
__device__ __forceinline__ unsigned xb_add(unsigned* p, unsigned v) { return __hip_atomic_fetch_add(p, v, __ATOMIC_RELAXED, __HIP_MEMORY_SCOPE_AGENT); }
__device__ __forceinline__ unsigned xb_xcc_id() { return (unsigned)__builtin_amdgcn_s_getreg((3 << 11) | 20) & 0xFu; }
#define XB_SPIN(cond, bar) do { unsigned _sp = 0; while (cond) { __builtin_amdgcn_s_sleep(1); \
    if ((++_sp & 255u) == 0u) { if (xb_ld(&(bar)[XB_TMO])) break; if (_sp > XB_SPIN_CAP) { atomicAdd(&(bar)[XB_TMO], 1u); break; } } } } while (0)

struct XcdBarrier {
    unsigned* bar; unsigned x;
    volatile LAS unsigned* st;
};

__device__ __forceinline__ XcdBarrier xcd_barrier_post(unsigned* bar, volatile LAS unsigned* st) {
    XcdBarrier b; b.bar = bar; b.x = xb_xcc_id(); b.st = st;
    if (threadIdx.x == 0) (void)xb_add(&bar[XB_XCNT(b.x)], 1u);
    return b;
}
__device__ __forceinline__ void xcd_barrier_complete(unsigned* bar, unsigned x, unsigned& nloc, unsigned& nx) {
    const unsigned G = gridDim.x * gridDim.y * gridDim.z;
    unsigned sum, cnt, mine, sp = 0u;
    for (;;) {
        sum = 0u; cnt = 0u; mine = 0u;
#pragma unroll
        for (unsigned j = 0; j < 16; ++j) { const unsigned c = xb_ld(&bar[XB_XCNT(j)]); sum += c; cnt += (c > 0u) ? 1u : 0u; mine = (j == x) ? c : mine; }
        if (sum == G) break;
        __builtin_amdgcn_s_sleep(1);
        if ((++sp & 255u) == 0u) { if (xb_ld(&bar[XB_TMO])) break; if (sp > XB_SPIN_CAP) { atomicAdd(&bar[XB_TMO], 1u); break; } }
    }
    nloc = mine > 0u ? mine : 1u; nx = cnt > 0u ? cnt : 1u;
}

__device__ __forceinline__ void xcd_barrier(const XcdBarrier& b) {
    asm volatile("s_waitcnt vmcnt(0)" ::: "memory");
    __syncthreads();
    if (threadIdx.x == 0) {
        unsigned* bar = b.bar;
        __builtin_amdgcn_s_waitcnt(0);
        unsigned nloc = b.st[0], nx = b.st[1];
        if (nloc == 0u) { xcd_barrier_complete(bar, b.x, nloc, nx); b.st[0] = nloc; b.st[1] = nx; }
        const unsigned old = xb_add(&bar[XB_XSUB(b.x)], 1u);
        const unsigned gen = old / nloc;
        if (old + 1u == (gen + 1u) * nloc) {
            __builtin_amdgcn_fence(__ATOMIC_RELEASE, "agent");
            asm volatile("s_waitcnt vmcnt(0)" ::: "memory");
            const unsigned og = xb_add(&bar[XB_TOP], 1u);
            const unsigned tg = og / nx;
            if (og + 1u == (tg + 1u) * nx) xb_add(&bar[XB_TOPGEN], 1u);
            else XB_SPIN(xb_ld(&bar[XB_TOPGEN]) == tg, bar);
            __builtin_amdgcn_fence(__ATOMIC_ACQUIRE, "agent");
            xb_add(&bar[XB_XGEN(b.x)], 1u);
            asm volatile("s_waitcnt vmcnt(0)" ::: "memory");
        } else {
            XB_SPIN(xb_ld(&bar[XB_XGEN(b.x)]) == gen, bar);
            __builtin_amdgcn_fence(__ATOMIC_ACQUIRE, "agent");
            asm volatile("s_waitcnt vmcnt(0)" ::: "memory");
        }
    }
    __syncthreads();
}

__device__ __forceinline__ Params fresh(const Params& p) {
  Params q = p;
  asm volatile("" : "+s"(q.ws), "+s"(q.out_));
#pragma unroll
  for (int i = 0; i < 21; ++i) asm volatile("" : "+s"(q.in[i]));
  return q;
}
#define PHASE_IDS int tid = threadIdx.x; asm volatile("" : "+v"(tid)); int bid = blockIdx.x; asm volatile("" : "+s"(bid)); int G = gridDim.x; asm volatile("" : "+s"(G)); \
  const int lane = tid & 63, wv = tid >> 6; const int ngt = G * NTHR, ngw = G * NWAVE; \
  const int gtid = bid * NTHR + tid, gw = bid * NWAVE + wv; (void)lane; (void)wv; (void)gtid; (void)gw; (void)ngt; (void)ngw; \
  const Params q = fresh(p);
__global__ void __launch_bounds__(NTHR) mega(Params p) {
  extern __shared__ __attribute__((aligned(16))) unsigned char lds_raw[];
  cg::grid_group grid = cg::this_grid();
  float* ldsf = (float*)lds_raw;
  if (threadIdx.x == 0) { *(uint4*)(lds_raw + LDS_BYTES - 16) = make_uint4(0u, 0u, 0u, 0u); }
  __syncthreads();
  XcdBarrier xb = xcd_barrier_post(p.bar(), (volatile LAS unsigned*)(lds_raw + LDS_BYTES - 16));

  { PHASE_IDS; phase_prologue(q, gtid, ngt, gw, ngw, lane); cvt_f32_bf16(q.inp(18), q.skb(), (size_t)NL * 16 * 128 * 64 / 8, gtid, ngt);
    for (size_t i = gtid; i < (size_t)16 * 128 * 512 / 8; i += ngt) { const size_t g = i / (128 * 512 / 8), r = i % (128 * 512 / 8); ((uint4*)q.S5Wz())[g * (256 * 512 / 8) + (128 * 512 / 8) + r] = make_uint4(0u, 0u, 0u, 0u); }
    if (gtid < 256) q.qctr()[gtid] = 0;
    phase_s5_prep(q, 0, gtid, ngt); }
  grid.sync();
  { constexpr int l = 0;
    DUP(5) {
    { const Params q = fresh(p); EpiScaleStoreBf16 e{q.projb(), INW, q.ssq1(), 8, nullptr};
      run_gemm(lds_raw, q.xb(), q.Win_t() + (size_t)l * INW * KD, T, INW, KD, e); }
    xcd_barrier(xb);
    }
    DUP(0) {
    { PHASE_IDS; phase_post_pack(q, l, gtid, ngt, gw, ngw, lane); phase_pack_u(q, gtid, ngt); }
    xcd_barrier(xb);
    }
    DUP(1) {
    { const Params q = fresh(p); EpiS5Z e{q.S5Z()};
      pg8::Gemm g{q.S5A(), q.S5Wz(), 16 * 1024, 16 * 256, 512, 640, 512}; pg8::GroupOrder So; So.init(16, 4, 1, (int)gridDim.x, (int)blockIdx.x);
      pg8::gemm_phase<EpiS5Z, pg8::GroupOrder, true, true>((PG8_LAS unsigned char*)lds_raw, g, So, e); }
    { PHASE_IDS; phase_kmean2(q, gtid, ngt); phase_ret_kv(q, gw, ngw, lane); }
    xcd_barrier(xb);
    }
    DUP(2) {
    { PHASE_IDS; phase_s5_scan(q, gtid, ngt); phase_ret_scan(q, gtid, ngt); }
    __syncthreads();
    { PHASE_IDS; phase_moba2(q, l, lds_raw, bid, G); }
    xcd_barrier(xb);
    }
    DUP(3) {
    { const Params q = fresh(p); EpiS5Y e{q.ygb(), q.S5A(), q.inp(10) + l * 256};
      pg8::Gemm g{q.S5A(), q.S5Wy(), 16 * 1024, 16 * 512, 640, 640, 640}; pg8::GroupOrder So; So.init(16, 4, 2, (int)gridDim.x, (int)blockIdx.x);
      pg8::gemm_phase<EpiS5Y, pg8::GroupOrder, true, true>((PG8_LAS unsigned char*)lds_raw, g, So, e); }
    __syncthreads();
    { PHASE_IDS; phase_ret_out(q, gw, ngw, lane); }
    xcd_barrier(xb);
    }
    DUP(4) {
    { const Params q = fresh(p); EpiGlu e{q.xb(), q.ygb(), (float*)(lds_raw + 131072)};
      run_gemm(lds_raw, q.ygb(), q.Wglu_t() + (size_t)l * 65536, T, 256, 256, e); }
    xcd_barrier(xb);
    }
    { PHASE_IDS; cvt_table_fp8(q.inp(19) + (size_t)l * 16384 * D, q.U8s(), q.su(), gw, ngw, lane);
      cvt_table_fp8(q.inp(20) + (size_t)l * 16384 * D, q.V8s(), q.sv(), gw, ngw, lane); }
    __syncthreads();
    { const Params q = fresh(p); EpiResid e{q.outp(), D, q.xb2(), q.hb(), q.inp(16) + l * D, q.ssq2()};
      run_gemm(lds_raw, q.xb(), q.Wout_t() + (size_t)l * D * KD, T, D, KD, e); }
    xcd_barrier(xb);
    DUP(7) {
    { const Params q = fresh(p); EpiScaleStoreBf16 e{q.qb(), D, q.ssq2(), 16, q.rstd()};
      run_gemm(lds_raw, q.xb2(), q.Wq_t() + (size_t)l * D * KD, T, D, KD, e); }
    xcd_barrier(xb);
    }
    if (!(PROBE_SKIP & 2)) {
    DUP(8) {
    { PHASE_IDS; phase_peer_topk(q, l, gw, ngw, lane); }
    xcd_barrier(xb);
    }
    }
#if PEER_CHECK
    if (l == 0) { { PHASE_IDS; chk_save(q, gtid, ngt); } xcd_barrier(xb); { PHASE_IDS; chk_topk(q, l, gtid, ngt); } xcd_barrier(xb); }
#endif
    if (!(PROBE_SKIP & 1)) {
    { PHASE_IDS; phase_peer_u(q, q.qctr() + (l * 2 + 0) * 8, lds_raw, tid); }
    xcd_barrier(xb);
    { PHASE_IDS; phase_peer_r(q, gtid, ngt); if (l + 1 < NL) phase_s5_prep(q, l + 1, gtid, ngt); }
    xcd_barrier(xb);
    if (!(PROBE_SKIP & 32)) {
    { PHASE_IDS; phase_peer_v(q, q.qctr() + (l * 2 + 1) * 8, lds_raw, tid); }
    xcd_barrier(xb);
    }
    }
#if PEER_CHECK
    if (l == 0) { { PHASE_IDS; chk_apply(q, l, ldsf + wv * 128, gw, ngw, lane); } xcd_barrier(xb);
      if (blockIdx.x == 0 && threadIdx.x == 0) { const Params q = fresh(p); chk_emit(q); } xcd_barrier(xb); }
#endif
  }
  { constexpr int l = 1;
    DUP(5) {
    { const Params q = fresh(p); EpiScaleStoreBf16 e{q.projb(), INW, q.ssq1(), 8, nullptr};
      run_gemm(lds_raw, q.xb(), q.Win_t() + (size_t)l * INW * KD, T, INW, KD, e); }
    xcd_barrier(xb);
    }
    DUP(0) {
    { PHASE_IDS; phase_post_pack(q, l, gtid, ngt, gw, ngw, lane); phase_pack_u(q, gtid, ngt); }
    xcd_barrier(xb);
    }
    DUP(1) {
    { const Params q = fresh(p); EpiS5Z e{q.S5Z()};
      pg8::Gemm g{q.S5A(), q.S5Wz(), 16 * 1024, 16 * 256, 512, 640, 512}; pg8::GroupOrder So; So.init(16, 4, 1, (int)gridDim.x, (int)blockIdx.x);
      pg8::gemm_phase<EpiS5Z, pg8::GroupOrder, true, true>((PG8_LAS unsigned char*)lds_raw, g, So, e); }
    { PHASE_IDS; phase_kmean2(q, gtid, ngt); phase_ret_kv(q, gw, ngw, lane); }
    xcd_barrier(xb);
    }
    DUP(2) {
    { PHASE_IDS; phase_s5_scan(q, gtid, ngt); phase_ret_scan(q, gtid, ngt); }
    __syncthreads();
    { PHASE_IDS; phase_moba2(q, l, lds_raw, bid, G); }
    xcd_barrier(xb);
    }
    DUP(3) {
    { const Params q = fresh(p); EpiS5Y e{q.ygb(), q.S5A(), q.inp(10) + l * 256};
      pg8::Gemm g{q.S5A(), q.S5Wy(), 16 * 1024, 16 * 512, 640, 640, 640}; pg8::GroupOrder So; So.init(16, 4, 2, (int)gridDim.x, (int)blockIdx.x);
      pg8::gemm_phase<EpiS5Y, pg8::GroupOrder, true, true>((PG8_LAS unsigned char*)lds_raw, g, So, e); }
    __syncthreads();
    { PHASE_IDS; phase_ret_out(q, gw, ngw, lane); }
    xcd_barrier(xb);
    }
    DUP(4) {
    { const Params q = fresh(p); EpiGlu e{q.xb(), q.ygb(), (float*)(lds_raw + 131072)};
      run_gemm(lds_raw, q.ygb(), q.Wglu_t() + (size_t)l * 65536, T, 256, 256, e); }
    xcd_barrier(xb);
    }
    { PHASE_IDS; cvt_table_fp8(q.inp(19) + (size_t)l * 16384 * D, q.U8s(), q.su(), gw, ngw, lane);
      cvt_table_fp8(q.inp(20) + (size_t)l * 16384 * D, q.V8s(), q.sv(), gw, ngw, lane); }
    __syncthreads();
    { const Params q = fresh(p); EpiResid e{q.outp(), D, q.xb2(), q.hb(), q.inp(16) + l * D, q.ssq2()};
      run_gemm(lds_raw, q.xb(), q.Wout_t() + (size_t)l * D * KD, T, D, KD, e); }
    xcd_barrier(xb);
    DUP(7) {
    { const Params q = fresh(p); EpiScaleStoreBf16 e{q.qb(), D, q.ssq2(), 16, q.rstd()};
      run_gemm(lds_raw, q.xb2(), q.Wq_t() + (size_t)l * D * KD, T, D, KD, e); }
    xcd_barrier(xb);
    }
    if (!(PROBE_SKIP & 2)) {
    DUP(8) {
    { PHASE_IDS; phase_peer_topk(q, l, gw, ngw, lane); }
    xcd_barrier(xb);
    }
    }
#if PEER_CHECK
    if (l == 0) { { PHASE_IDS; chk_save(q, gtid, ngt); } xcd_barrier(xb); { PHASE_IDS; chk_topk(q, l, gtid, ngt); } xcd_barrier(xb); }
#endif
    if (!(PROBE_SKIP & 1)) {
    { PHASE_IDS; phase_peer_u(q, q.qctr() + (l * 2 + 0) * 8, lds_raw, tid); }
    xcd_barrier(xb);
    { PHASE_IDS; phase_peer_r(q, gtid, ngt); if (l + 1 < NL) phase_s5_prep(q, l + 1, gtid, ngt); }
    xcd_barrier(xb);
    if (!(PROBE_SKIP & 32)) {
    { PHASE_IDS; phase_peer_v(q, q.qctr() + (l * 2 + 1) * 8, lds_raw, tid); }
    xcd_barrier(xb);
    }
    }
#if PEER_CHECK
    if (l == 0) { { PHASE_IDS; chk_apply(q, l, ldsf + wv * 128, gw, ngw, lane); } xcd_barrier(xb);
      if (blockIdx.x == 0 && threadIdx.x == 0) { const Params q = fresh(p); chk_emit(q); } xcd_barrier(xb); }
#endif
  }
  { constexpr int l = 2;
    DUP(5) {
    { const Params q = fresh(p); EpiScaleStoreBf16 e{q.projb(), INW, q.ssq1(), 8, nullptr};
      run_gemm(lds_raw, q.xb(), q.Win_t() + (size_t)l * INW * KD, T, INW, KD, e); }
    xcd_barrier(xb);
    }
    DUP(0) {
    { PHASE_IDS; phase_post_pack(q, l, gtid, ngt, gw, ngw, lane); phase_pack_u(q, gtid, ngt); }
    xcd_barrier(xb);
    }
    DUP(1) {
    { const Params q = fresh(p); EpiS5Z e{q.S5Z()};
      pg8::Gemm g{q.S5A(), q.S5Wz(), 16 * 1024, 16 * 256, 512, 640, 512}; pg8::GroupOrder So; So.init(16, 4, 1, (int)gridDim.x, (int)blockIdx.x);
      pg8::gemm_phase<EpiS5Z, pg8::GroupOrder, true, true>((PG8_LAS unsigned char*)lds_raw, g, So, e); }
    { PHASE_IDS; phase_kmean2(q, gtid, ngt); phase_ret_kv(q, gw, ngw, lane); }
    xcd_barrier(xb);
    }
    DUP(2) {
    { PHASE_IDS; phase_s5_scan(q, gtid, ngt); phase_ret_scan(q, gtid, ngt); }
    __syncthreads();
    { PHASE_IDS; phase_moba2(q, l, lds_raw, bid, G); }
    xcd_barrier(xb);
    }
    DUP(3) {
    { const Params q = fresh(p); EpiS5Y e{q.ygb(), q.S5A(), q.inp(10) + l * 256};
      pg8::Gemm g{q.S5A(), q.S5Wy(), 16 * 1024, 16 * 512, 640, 640, 640}; pg8::GroupOrder So; So.init(16, 4, 2, (int)gridDim.x, (int)blockIdx.x);
      pg8::gemm_phase<EpiS5Y, pg8::GroupOrder, true, true>((PG8_LAS unsigned char*)lds_raw, g, So, e); }
    __syncthreads();
    { PHASE_IDS; phase_ret_out(q, gw, ngw, lane); }
    xcd_barrier(xb);
    }
    DUP(4) {
    { const Params q = fresh(p); EpiGlu e{q.xb(), q.ygb(), (float*)(lds_raw + 131072)};
      run_gemm(lds_raw, q.ygb(), q.Wglu_t() + (size_t)l * 65536, T, 256, 256, e); }
    xcd_barrier(xb);
    }
    { PHASE_IDS; cvt_table_fp8(q.inp(19) + (size_t)l * 16384 * D, q.U8s(), q.su(), gw, ngw, lane);
      cvt_table_fp8(q.inp(20) + (size_t)l * 16384 * D, q.V8s(), q.sv(), gw, ngw, lane); }
    __syncthreads();
    { const Params q = fresh(p); EpiResid e{q.outp(), D, q.xb2(), q.hb(), q.inp(16) + l * D, q.ssq2()};
      run_gemm(lds_raw, q.xb(), q.Wout_t() + (size_t)l * D * KD, T, D, KD, e); }
    xcd_barrier(xb);
    DUP(7) {
    { const Params q = fresh(p); EpiScaleStoreBf16 e{q.qb(), D, q.ssq2(), 16, q.rstd()};
      run_gemm(lds_raw, q.xb2(), q.Wq_t() + (size_t)l * D * KD, T, D, KD, e); }
    xcd_barrier(xb);
    }
    if (!(PROBE_SKIP & 2)) {
    DUP(8) {
    { PHASE_IDS; phase_peer_topk(q, l, gw, ngw, lane); }
    xcd_barrier(xb);
    }
    }
#if PEER_CHECK
    if (l == 0) { { PHASE_IDS; chk_save(q, gtid, ngt); } xcd_barrier(xb); { PHASE_IDS; chk_topk(q, l, gtid, ngt); } xcd_barrier(xb); }
#endif
    if (!(PROBE_SKIP & 1)) {
    { PHASE_IDS; phase_peer_u(q, q.qctr() + (l * 2 + 0) * 8, lds_raw, tid); }
    xcd_barrier(xb);
    { PHASE_IDS; phase_peer_r(q, gtid, ngt); if (l + 1 < NL) phase_s5_prep(q, l + 1, gtid, ngt); }
    xcd_barrier(xb);
    if (!(PROBE_SKIP & 32)) {
    { PHASE_IDS; phase_peer_v(q, q.qctr() + (l * 2 + 1) * 8, lds_raw, tid); }
    xcd_barrier(xb);
    }
    }
#if PEER_CHECK
    if (l == 0) { { PHASE_IDS; chk_apply(q, l, ldsf + wv * 128, gw, ngw, lane); } xcd_barrier(xb);
      if (blockIdx.x == 0 && threadIdx.x == 0) { const Params q = fresh(p); chk_emit(q); } xcd_barrier(xb); }
#endif
  }
  { constexpr int l = 3;
    DUP(5) {
    { const Params q = fresh(p); EpiScaleStoreBf16 e{q.projb(), INW, q.ssq1(), 8, nullptr};
      run_gemm(lds_raw, q.xb(), q.Win_t() + (size_t)l * INW * KD, T, INW, KD, e); }
    xcd_barrier(xb);
    }
    DUP(0) {
    { PHASE_IDS; phase_post_pack(q, l, gtid, ngt, gw, ngw, lane); phase_pack_u(q, gtid, ngt); }
    xcd_barrier(xb);
    }
    DUP(1) {
    { const Params q = fresh(p); EpiS5Z e{q.S5Z()};
      pg8::Gemm g{q.S5A(), q.S5Wz(), 16 * 1024, 16 * 256, 512, 640, 512}; pg8::GroupOrder So; So.init(16, 4, 1, (int)gridDim.x, (int)blockIdx.x);
      pg8::gemm_phase<EpiS5Z, pg8::GroupOrder, true, true>((PG8_LAS unsigned char*)lds_raw, g, So, e); }
    { PHASE_IDS; phase_kmean2(q, gtid, ngt); phase_ret_kv(q, gw, ngw, lane); }
    xcd_barrier(xb);
    }
    DUP(2) {
    { PHASE_IDS; phase_s5_scan(q, gtid, ngt); phase_ret_scan(q, gtid, ngt); }
    __syncthreads();
    { PHASE_IDS; phase_moba2(q, l, lds_raw, bid, G); }
    xcd_barrier(xb);
    }
    DUP(3) {
    { const Params q = fresh(p); EpiS5Y e{q.ygb(), q.S5A(), q.inp(10) + l * 256};
      pg8::Gemm g{q.S5A(), q.S5Wy(), 16 * 1024, 16 * 512, 640, 640, 640}; pg8::GroupOrder So; So.init(16, 4, 2, (int)gridDim.x, (int)blockIdx.x);
      pg8::gemm_phase<EpiS5Y, pg8::GroupOrder, true, true>((PG8_LAS unsigned char*)lds_raw, g, So, e); }
    __syncthreads();
    { PHASE_IDS; phase_ret_out(q, gw, ngw, lane); }
    xcd_barrier(xb);
    }
    DUP(4) {
    { const Params q = fresh(p); EpiGlu e{q.xb(), q.ygb(), (float*)(lds_raw + 131072)};
      run_gemm(lds_raw, q.ygb(), q.Wglu_t() + (size_t)l * 65536, T, 256, 256, e); }
    xcd_barrier(xb);
    }
    { PHASE_IDS; cvt_table_fp8(q.inp(19) + (size_t)l * 16384 * D, q.U8s(), q.su(), gw, ngw, lane);
      cvt_table_fp8(q.inp(20) + (size_t)l * 16384 * D, q.V8s(), q.sv(), gw, ngw, lane); }
    __syncthreads();
    { const Params q = fresh(p); EpiResid e{q.outp(), D, q.xb2(), q.hb(), q.inp(16) + l * D, q.ssq2()};
      run_gemm(lds_raw, q.xb(), q.Wout_t() + (size_t)l * D * KD, T, D, KD, e); }
    xcd_barrier(xb);
    DUP(7) {
    { const Params q = fresh(p); EpiScaleStoreBf16 e{q.qb(), D, q.ssq2(), 16, q.rstd()};
      run_gemm(lds_raw, q.xb2(), q.Wq_t() + (size_t)l * D * KD, T, D, KD, e); }
    xcd_barrier(xb);
    }
    if (!(PROBE_SKIP & 2)) {
    DUP(8) {
    { PHASE_IDS; phase_peer_topk(q, l, gw, ngw, lane); }
    xcd_barrier(xb);
    }
    }
#if PEER_CHECK
    if (l == 0) { { PHASE_IDS; chk_save(q, gtid, ngt); } xcd_barrier(xb); { PHASE_IDS; chk_topk(q, l, gtid, ngt); } xcd_barrier(xb); }
#endif
    if (!(PROBE_SKIP & 1)) {
    { PHASE_IDS; phase_peer_u(q, q.qctr() + (l * 2 + 0) * 8, lds_raw, tid); }
    xcd_barrier(xb);
    { PHASE_IDS; phase_peer_r(q, gtid, ngt); if (l + 1 < NL) phase_s5_prep(q, l + 1, gtid, ngt); }
    xcd_barrier(xb);
    if (!(PROBE_SKIP & 32)) {
    { PHASE_IDS; phase_peer_v(q, q.qctr() + (l * 2 + 1) * 8, lds_raw, tid); }
    xcd_barrier(xb);
    }
    }
#if PEER_CHECK
    if (l == 0) { { PHASE_IDS; chk_apply(q, l, ldsf + wv * 128, gw, ngw, lane); } xcd_barrier(xb);
      if (blockIdx.x == 0 && threadIdx.x == 0) { const Params q = fresh(p); chk_emit(q); } xcd_barrier(xb); }
#endif
  }
}

}

extern "C" void kernel_launch(void* const* d_in, const int* in_sizes, int n_in, void* d_out, int out_size, void* d_ws, size_t ws_size,
                              hipStream_t stream) {
  static int grid_blocks = 0;
  if (!grid_blocks) {
    int dev = 0, cus = 0, per_cu = 0;
    hipGetDevice(&dev);
    hipDeviceGetAttribute(&cus, hipDeviceAttributeMultiprocessorCount, dev);
    hipFuncSetAttribute((const void*)mega, hipFuncAttributeMaxDynamicSharedMemorySize, LDS_BYTES);
    hipOccupancyMaxActiveBlocksPerMultiprocessor(&per_cu, (const void*)mega, NTHR, LDS_BYTES);
    if (per_cu < 1) { fprintf(stderr, "occupancy query returned %d\n", per_cu); per_cu = 1; }
    grid_blocks = cus * 1;
    if (grid_blocks < 64) fprintf(stderr, "unexpected CU count %d\n", cus);
  }
  Params p{};
  for (int i = 0; i < 21; ++i) p.in[i] = (const GAS float*)d_in[i];
  p.out_ = (GAS float*)d_out;
  p.ws = (GAS unsigned char*)d_ws;
  if (WS_TOTAL > ws_size) { fprintf(stderr, "workspace too small: need %zu have %zu\n", (size_t)WS_TOTAL, ws_size); return; }
  hipMemsetAsync((unsigned char*)d_ws + WO_bar, 0, 16384, stream);
  void* args[] = {&p};
  hipError_t e = hipLaunchCooperativeKernel((const void*)mega, dim3(grid_blocks), dim3(NTHR), args, LDS_BYTES, stream);
  if (e != hipSuccess) fprintf(stderr, "cooperative launch failed: %s (grid %d)\n", hipGetErrorString(e), grid_blocks);
}
```

```cpp
#include <hip/hip_runtime.h>
#include <hip/hip_cooperative_groups.h>
#include <math.h>
#include <stdint.h>
#include <stdio.h>
namespace cg = cooperative_groups;

#ifndef PEER_CHECK
#define PEER_CHECK 0
#endif
#ifndef PROBE_DUP
#define PROBE_DUP 0
#endif
__device__ __forceinline__ int dup_n(int n) { asm volatile("" : "+s"(n)); return n; }
#define DUP(bit) _Pragma("unroll 1") for (int rep_ = 0, repn_ = (((PROBE_DUP >> (bit)) & 1) ? dup_n(2) : 1); rep_ < repn_; ++rep_)
#ifndef PROBE_SKIP
#define PROBE_SKIP 0
#endif
#ifndef PRECISE
#define PRECISE 0
#endif

namespace {
constexpr int NB = 8, S = 4096, D = 1024, NL = 4, T = NB * S;
constexpr int INW = 2816;
constexpr int OFF_U = 0, OFF_QM = 256, OFF_KM = 768, OFF_VM = 1280, OFF_QR = 1792, OFF_KR = 2048, OFF_VR = 2304, OFF_GR = 2560;
constexpr float EPS = 1e-6f;
static_assert(PRECISE == 0, "PRECISE builds are retired");
constexpr int KS = PRECISE ? 3 : 1;
constexpr int KD = D * KS;
constexpr int NTHR = 512, NWAVE = 8;
constexpr int LDS_BYTES = 131072 + 4096 + 1024;

typedef unsigned short bf16_t;
using bf16x8 = __attribute__((ext_vector_type(8))) short;
using f32x4 = __attribute__((ext_vector_type(4))) float;

__device__ __forceinline__ float wave_sum(float v) {
#pragma unroll
  for (int o = 32; o > 0; o >>= 1) v += __shfl_xor(v, o);
  return v;
}
__device__ __forceinline__ float wave_max(float v) {
#pragma unroll
  for (int o = 32; o > 0; o >>= 1) v = fmaxf(v, __shfl_xor(v, o));
  return v;
}
__device__ __forceinline__ int q_pull(int* head, int nitems, int* bc, int tid) {
  __syncthreads();
  if (tid == 0) bc[0] = atomicAdd(head, 1);
  __syncthreads();
  const int v = bc[0];
  return v < nitems ? v : -1;
}
__device__ __forceinline__ float gelu_tanh(float x) {
  const float k0 = 0.7978845608028654f, k1 = 0.044715f;
  float u = k0 * (x + k1 * x * x * x);
  return 0.5f * x * (1.0f + tanhf(u));
}
__device__ __forceinline__ float sigmoidf_(float x) { return 1.0f / (1.0f + expf(-x)); }
__device__ __forceinline__ float fast_sigmoid(float x) { return __builtin_amdgcn_rcpf(1.0f + __builtin_amdgcn_exp2f(-1.4426950408889634f * x)); }
__device__ __forceinline__ float fast_gelu(float x) { const float u = 0.7978845608028654f * (x + 0.044715f * x * x * x); return x * fast_sigmoid(2.0f * u); }
__device__ __forceinline__ bf16_t f2bf(float f) {
  unsigned u = __float_as_uint(f);
  u += 0x7fffu + ((u >> 16) & 1u);
  return (bf16_t)(u >> 16);
}
__device__ __forceinline__ float bf2f(bf16_t h) { return __uint_as_float(((unsigned)h) << 16); }
#define LDS_FENCE() asm volatile("s_waitcnt lgkmcnt(0)" ::: "memory")
typedef __bf16 bf16x2_hw __attribute__((ext_vector_type(2)));
typedef float f32x2_hw __attribute__((ext_vector_type(2)));
__device__ __forceinline__ unsigned pk_bf16(float lo, float hi) { const f32x2_hw f = {lo, hi}; const bf16x2_hw b = __builtin_convertvector(f, bf16x2_hw); return __builtin_bit_cast(unsigned, b); }
typedef float f32x16 __attribute__((ext_vector_type(16)));

constexpr size_t al256(size_t x) { return (x + 255) & ~(size_t)255; }
constexpr size_t WO_rstd = 0;
constexpr size_t WO_cosm = WO_rstd + al256((size_t)T * 4);
constexpr size_t WO_sinm = WO_cosm + al256((size_t)S * 8 * 4);
constexpr size_t WO_cosr = WO_sinm + al256((size_t)S * 8 * 4);
constexpr size_t WO_sinr = WO_cosr + al256((size_t)S * 32 * 4);
constexpr size_t WO_kmean = WO_sinr + al256((size_t)S * 32 * 4);
constexpr size_t WO_proj = WO_kmean + al256((size_t)NB * 8 * 16 * 64 * 4);
constexpr size_t WO_ybuf = WO_proj + al256((size_t)T * INW * 4);
constexpr size_t WO_yg = WO_ybuf + al256((size_t)T * D * 4);
constexpr size_t WO_skb = WO_yg + al256((size_t)T * 256 * 4);
constexpr size_t WO_Ub = WO_skb + al256((size_t)NL * 16 * 128 * 64 * 2);
constexpr size_t WO_Vb = WO_Ub + al256((size_t)16384 * D * 2);
constexpr size_t WO_gates = WO_Vb + al256((size_t)16384 * D * 2);
constexpr size_t WO_eidx = WO_gates + al256((size_t)T * 128 * 4);
constexpr size_t WO_xb = WO_eidx + al256((size_t)T * 128 * 4);
constexpr size_t WO_Win_t = WO_xb + al256((size_t)T * KD * 2);
constexpr size_t WO_Wout_t = WO_Win_t + al256((size_t)NL * INW * KD * 2);
constexpr size_t WO_Wq_t = WO_Wout_t + al256((size_t)NL * D * KD * 2);
constexpr size_t WO_Qm = WO_Wq_t + al256((size_t)NL * D * KD * 2);
constexpr size_t WO_Km = WO_Qm + al256((size_t)T * 512 * 2);
constexpr size_t WO_Vm = WO_Km + al256((size_t)T * 512 * 2);
constexpr size_t WO_S5a32 = WO_Vm + al256((size_t)T * 512 * 2);
constexpr size_t WO_Wglu_t = WO_S5a32 + al256((size_t)16 * 64 * 2 * 4);
constexpr size_t WO_Qr = WO_Wglu_t + al256((size_t)NL * 256 * 256 * 2);
constexpr size_t WO_Kr = WO_Qr + al256((size_t)T * 256 * 2);
constexpr size_t WO_Krv = WO_Kr + al256((size_t)T * 256 * 2);
constexpr size_t WO_Vr = WO_Krv + al256((size_t)T * 256 * 2);
constexpr size_t WO_KVr = WO_Vr + al256((size_t)T * 256 * 2);
constexpr size_t WO_Rb = WO_KVr + al256((size_t)32 * 32 * 4096 * 4);
constexpr size_t WO_qctr = WO_Rb + al256((size_t)32 * 32 * 4096 * 2);
constexpr size_t WO_bar = WO_qctr + al256(1024);
constexpr size_t WO_S5Wy = WO_bar + al256(16384);
constexpr size_t WO_S5Wz = WO_S5Wy + al256((size_t)16 * 512 * 640 * 2);
constexpr size_t WO_ssq1 = WO_S5Wz + al256((size_t)16 * 256 * 512 * 2);
constexpr size_t WO_ssq2 = WO_ssq1 + al256((size_t)T * 8 * 4);
constexpr size_t WS_TOTAL = WO_ssq2 + al256((size_t)T * 16 * 4);
constexpr size_t WO_S5A = WO_gates;
constexpr size_t WO_S5Z = WO_S5A + al256((size_t)16 * 1024 * 640 * 2);
static_assert(WO_S5Z + (size_t)16 * 1024 * 128 * 4 <= WO_gates + 2 * al256((size_t)T * 128 * 4), "S5A/S5Z must fit in gates+eidx");
#define GAS __attribute__((address_space(1)))
static_assert((size_t)T * D * 2 + (size_t)T * 128 * 8 * 4 + (size_t)T * D * 2 <= (size_t)T * INW * 4, "qb + ppart + xb2 must fit in the proj region");
struct Params {
  const GAS float* in[21];
  GAS float* out_;
  GAS unsigned char* ws;
  __device__ __forceinline__ const float* inp(int i) const { return (const float*)in[i]; }
  __device__ __forceinline__ float* outp() const { return (float*)out_; }
  __device__ __forceinline__ float* rstd() const { return (float*)(ws + WO_rstd); }
  __device__ __forceinline__ float* cosm() const { return (float*)(ws + WO_cosm); }
  __device__ __forceinline__ float* sinm() const { return (float*)(ws + WO_sinm); }
  __device__ __forceinline__ float* cosr() const { return (float*)(ws + WO_cosr); }
  __device__ __forceinline__ float* sinr() const { return (float*)(ws + WO_sinr); }
  __device__ __forceinline__ float* kmean() const { return (float*)(ws + WO_kmean); }
  __device__ __forceinline__ float* proj() const { return (float*)(ws + WO_proj); }
  __device__ __forceinline__ float* ybuf() const { return (float*)(ws + WO_ybuf); }
  __device__ __forceinline__ float* yg() const { return (float*)(ws + WO_yg); }
  __device__ __forceinline__ bf16_t* skb() const { return (bf16_t*)(ws + WO_skb); }
  __device__ __forceinline__ bf16_t* Ub() const { return (bf16_t*)(ws + WO_Ub); }
  __device__ __forceinline__ bf16_t* Vb() const { return (bf16_t*)(ws + WO_Vb); }
  __device__ __forceinline__ float* gates() const { return (float*)(ws + WO_gates); }
  __device__ __forceinline__ int* eidx() const { return (int*)(ws + WO_eidx); }
  __device__ __forceinline__ bf16_t* xb() const { return (bf16_t*)(ws + WO_xb); }
  __device__ __forceinline__ bf16_t* Win_t() const { return (bf16_t*)(ws + WO_Win_t); }
  __device__ __forceinline__ bf16_t* Wout_t() const { return (bf16_t*)(ws + WO_Wout_t); }
  __device__ __forceinline__ bf16_t* Wq_t() const { return (bf16_t*)(ws + WO_Wq_t); }
  __device__ __forceinline__ bf16_t* Qm() const { return (bf16_t*)(ws + WO_Qm); }
  __device__ __forceinline__ bf16_t* Km() const { return (bf16_t*)(ws + WO_Km); }
  __device__ __forceinline__ bf16_t* Vm() const { return (bf16_t*)(ws + WO_Vm); }
  __device__ __forceinline__ bf16_t* S5A() const { return (bf16_t*)(ws + WO_S5A); }
  __device__ __forceinline__ bf16_t* S5Wy() const { return (bf16_t*)(ws + WO_S5Wy); }
  __device__ __forceinline__ bf16_t* S5Wz() const { return (bf16_t*)(ws + WO_S5Wz); }
  __device__ __forceinline__ float* S5Z() const { return (float*)(ws + WO_S5Z); }
  __device__ __forceinline__ float* S5a32() const { return (float*)(ws + WO_S5a32); }
  __device__ __forceinline__ bf16_t* Wglu_t() const { return (bf16_t*)(ws + WO_Wglu_t); }
  __device__ __forceinline__ bf16_t* ygb() const { return (bf16_t*)(ws + WO_yg); }
  __device__ __forceinline__ int* qctr() const { return (int*)(ws + WO_qctr); }
  __device__ __forceinline__ unsigned char* U8s() const { return (unsigned char*)(ws + WO_Ub); }
  __device__ __forceinline__ float* su() const { return (float*)(ws + WO_Ub + (size_t)16384 * D); }
  __device__ __forceinline__ unsigned char* V8s() const { return (unsigned char*)(ws + WO_Vb); }
  __device__ __forceinline__ float* sv() const { return (float*)(ws + WO_Vb + (size_t)16384 * D); }
  __device__ __forceinline__ bf16_t* hb() const { return (bf16_t*)(ws + WO_ybuf + ((size_t)4 << 20)); }
  __device__ __forceinline__ float* ppart() const { return (float*)(ws + WO_proj + (size_t)T * D * 2); }
  __device__ __forceinline__ bf16_t* Qr() const { return (bf16_t*)(ws + WO_Qr); }
  __device__ __forceinline__ bf16_t* Kr() const { return (bf16_t*)(ws + WO_Kr); }
  __device__ __forceinline__ bf16_t* Krv() const { return (bf16_t*)(ws + WO_Krv); }
  __device__ __forceinline__ bf16_t* Vr() const { return (bf16_t*)(ws + WO_Vr); }
  __device__ __forceinline__ float* KVr() const { return (float*)(ws + WO_KVr); }
  __device__ __forceinline__ bf16_t* Rb() const { return (bf16_t*)(ws + WO_Rb); }
  __device__ __forceinline__ unsigned* bar() const { return (unsigned*)(ws + WO_bar); }
  __device__ __forceinline__ bf16_t* projb() const { return (bf16_t*)(ws + WO_proj); }
  __device__ __forceinline__ float* ssq1() const { return (float*)(ws + WO_ssq1); }
  __device__ __forceinline__ float* ssq2() const { return (float*)(ws + WO_ssq2); }
  __device__ __forceinline__ bf16_t* xb2() const { return (bf16_t*)(ws + WO_proj + (size_t)T * D * 2 + (size_t)T * 128 * 8 * 4); }
  __device__ __forceinline__ bf16_t* qb() const { return (bf16_t*)(ws + WO_proj); }
};

namespace pg8 {
#define PG8_LAS __attribute__((address_space(3)))
typedef unsigned short bf16_t;
typedef short bf16x8 __attribute__((ext_vector_type(8)));
typedef float f32x4 __attribute__((ext_vector_type(4)));
typedef unsigned u32x4 __attribute__((ext_vector_type(4)));
constexpr int BM = 256, BK = 64, HALF = 128, HTB = HALF * BK * 2  , STAGE_BYTES = 8 * HTB, NXCD = 8, WGM = 8;

__host__ __device__ __forceinline__ int lds_byte(int r, int c) { const int st = (r >> 4) * 2 + (c >> 5), rr = r & 15, cc = c & 31, ob = rr * 64 + cc * 2; return st * 1024 + (ob ^ (((ob >> 9) & 1) << 5)); }
__host__ __device__ __forceinline__ void stage_rc(int b, int& R, int& C) { const int st = b / 1024, sb = b % 1024, swz = sb ^ (((sb >> 9) & 1) << 5); R = (st >> 1) * 16 + swz / 64; C = (st & 1) * 32 + (swz % 64) / 2; }
__host__ __device__ __forceinline__ int perm32(int rho) { const int n = rho >> 4, i = rho & 15; return 8 * (i >> 2) + 4 * n + (i & 3); }

struct Unit { int pm, pn; };
struct Gemm { const bf16_t* A; const bf16_t* Bt; int M, N, K, lda, ldb; };

struct StaticOrder {
    int nM, nN, nwg, G, c;
    __host__ __device__ void init(int M, int N, int G_, int c_) { nM = M / BM; nN = N / BM; nwg = nM * nN; G = G_; c = c_; }
    __host__ __device__ bool next(int i, Unit& u) const {
        const long L = (long)i * G + c; if (L >= nwg) return false;
        int wgid = (int)L; { const int q = nwg / NXCD, r = nwg % NXCD, xcd = wgid % NXCD, off = wgid / NXCD; wgid = (xcd < r ? xcd * (q + 1) : r * (q + 1) + (xcd - r) * q) + off; }
        const int nig = WGM * nN, gid = wgid / nig, fm = gid * WGM, gsz = (nM - fm) < WGM ? (nM - fm) : WGM;
        u.pm = fm + ((wgid % nig) % gsz); u.pn = (wgid % nig) / gsz; return true;
    }
    __device__ __forceinline__ void a_ready(const Unit&) const {}
    __device__ __forceinline__ void done(const Unit&) const {}
};
struct GroupOrder {
    int mt, nt_, nwg, G, c;
    __host__ __device__ void init(int ngroups, int mt__, int nt__, int G_, int c_) { mt = mt__; nt_ = nt__; nwg = ngroups * mt * nt_; G = G_; c = c_; }
    __host__ __device__ bool next(int i, Unit& u) const {
        const long L = (long)i * G + c; if (L >= nwg) return false;
        const int per = mt * nt_, gi = (int)L / per, r = (int)L % per;
        u.pm = gi * mt + r % mt; u.pn = gi * nt_ + r / mt; return true;
    }
    __device__ __forceinline__ void a_ready(const Unit&) const {}
    __device__ __forceinline__ void done(const Unit&) const {}
};
template <class Epi, class Sched, bool ALIGN_EPI = false, bool SP2 = false>
__device__ __forceinline__ void gemm_phase(PG8_LAS unsigned char* lds, const Gemm g, const Sched& S, const Epi& E) {
    int tid_ = threadIdx.x; asm volatile("" : "+v"(tid_));
    const int tid = tid_, wid = __builtin_amdgcn_readfirstlane(tid >> 6), lane = tid & 63, wr = wid >> 2, wc = wid & 3, fr = lane & 15, fq = lane >> 4;
    const int K = g.K, nt = K / BK;
    unsigned voffA[2], voffB[2];
#pragma unroll
    for (int i = 0; i < 2; ++i) { int R, C; stage_rc(tid * 16 + i * 8192, R, C); const int Rb = Epi::PERM ? ((R & ~31) + perm32(R & 31)) : R;
        voffA[i] = (unsigned)(R * g.lda + C) * 2u; voffB[i] = (unsigned)(Rb * g.ldb + C) * 2u; }
    const size_t kstep = (size_t)(BK * 2);
    const size_t hstepA = (size_t)HALF * g.lda * 2, hstepB = (size_t)HALF * g.ldb * 2;
    const size_t tstepA = 2 * hstepA, tstepB = 2 * hstepB;
    const unsigned ldsw = (unsigned)wid * 1024u;
    const int aoff = lds_byte(wr * 64 + fr, fq * 8), boff = lds_byte(wc * 32 + fr, fq * 8);
#define PG8_SA(b, h) (((b) * 2 + (h)) * HTB)
#define PG8_SB(b, h) ((4 + (b) * 2 + (h)) * HTB)
#define PG8_STAGE(bufoff, gbase, voff) do { _Pragma("unroll") for (int _i = 0; _i < 2; ++_i) \
        __builtin_amdgcn_global_load_lds((const unsigned*)((const char*)(gbase) + (voff)[_i]), (PG8_LAS unsigned*)(lds + (bufoff) + ldsw + _i * 8192), 16, 0, 0); } while (0)
#define PG8_LDA(dst, b, h) do { _Pragma("unroll") for (int m = 0; m < 4; ++m) _Pragma("unroll") for (int k = 0; k < 2; ++k) dst[m][k] = *(const PG8_LAS bf16x8*)(lds + PG8_SA(b, h) + aoff + m * 2048 + k * 1024); } while (0)
#define PG8_LDB(dst, b, h) do { _Pragma("unroll") for (int n = 0; n < 2; ++n) _Pragma("unroll") for (int k = 0; k < 2; ++k) dst[n][k] = *(const PG8_LAS bf16x8*)(lds + PG8_SB(b, h) + boff + n * 2048 + k * 1024); } while (0)
#define PG8_MMA(ai, bj, At, Bt) do { __builtin_amdgcn_s_setprio(1); _Pragma("unroll") for (int m = 0; m < 4; ++m) _Pragma("unroll") for (int n = 0; n < 2; ++n) _Pragma("unroll") for (int k = 0; k < 2; ++k) \
        acc[ai][bj][m][n] = __builtin_amdgcn_mfma_f32_16x16x32_bf16(Bt[n][k], At[m][k], acc[ai][bj][m][n], 0, 0, 0); __builtin_amdgcn_s_setprio(0); } while (0)
#define PG8_WAIT_V(n) asm volatile("s_waitcnt vmcnt(" #n ")" ::: "memory")
#define PG8_WAIT_L(n) asm volatile("s_waitcnt lgkmcnt(" #n ")" ::: "memory")
#define PG8_BAR __builtin_amdgcn_s_barrier()
#define PG8_SCHED __builtin_amdgcn_sched_barrier(0)
    Unit cur, nxt; int ui = 0;
    if (!S.next(0, cur)) return;
    f32x4 acc[2][2][4][2];
    E.init(acc, cur, wr, wc, fr, fq);
    bf16x8 At[4][2], B0[2][2], B1[2][2];
    const char* cA = (const char*)g.A + (size_t)cur.pm * tstepA; const char* cB = (const char*)g.Bt + (size_t)cur.pn * tstepB;
    S.a_ready(cur);
    if constexpr (SP2) {
        PG8_STAGE(PG8_SB(0, 0), cB, voffB); PG8_STAGE(PG8_SB(0, 1), cB + hstepB, voffB); PG8_STAGE(PG8_SA(0, 0), cA, voffA); PG8_STAGE(PG8_SA(0, 1), cA + hstepA, voffA);
        if (wr == 1) PG8_BAR;
        PG8_WAIT_V(2); PG8_BAR;
        PG8_STAGE(PG8_SB(1, 0), cB + kstep, voffB); PG8_STAGE(PG8_SA(1, 0), cA + kstep, voffA); PG8_STAGE(PG8_SB(1, 1), cB + hstepB + kstep, voffB);
        PG8_WAIT_V(6); PG8_BAR;
    } else {
        PG8_STAGE(PG8_SB(0, 0), cB, voffB); PG8_STAGE(PG8_SA(0, 0), cA, voffA); PG8_STAGE(PG8_SB(0, 1), cB + hstepB, voffB); PG8_STAGE(PG8_SA(0, 1), cA + hstepA, voffA);
        if (wr == 1) PG8_BAR;
        PG8_WAIT_V(4); PG8_BAR;
        PG8_STAGE(PG8_SB(1, 0), cB + kstep, voffB); PG8_STAGE(PG8_SA(1, 0), cA + kstep, voffA); PG8_STAGE(PG8_SB(1, 1), cB + hstepB + kstep, voffB);
        PG8_WAIT_V(6); PG8_BAR;
    }
    for (;;) {
        const bool has_next = S.next(ui + 1, nxt);
        const char* nA = has_next ? (const char*)g.A + (size_t)nxt.pm * tstepA : cA; const char* nB = has_next ? (const char*)g.Bt + (size_t)nxt.pn * tstepB : cB;
        for (int t = 0; t < nt; t += 2) {
            const bool last = (t == nt - 2);
            const char* a1 = cA + (size_t)(t + 1) * kstep;
            const char* a2 = last ? nA : cA + (size_t)(t + 2) * kstep; const char* b2 = last ? nB : cB + (size_t)(t + 2) * kstep;
            const char* a3 = a2 + kstep; const char* b3 = b2 + kstep;
            if (last && has_next) S.a_ready(nxt);
            if constexpr (SP2) {
            PG8_LDB(B0, 0, 0); PG8_LDB(B1, 0, 1); PG8_SCHED; PG8_LDA(At, 0, 0); PG8_STAGE(PG8_SA(1, 1), a1 + hstepA, voffA);
            PG8_WAIT_V(8); PG8_WAIT_L(0); PG8_BAR; PG8_MMA(0, 0, At, B0); PG8_MMA(0, 1, At, B1); PG8_BAR; PG8_SCHED;
            PG8_LDA(At, 0, 1); PG8_STAGE(PG8_SB(0, 0), b2, voffB); PG8_STAGE(PG8_SB(0, 1), b2 + hstepB, voffB); PG8_STAGE(PG8_SA(0, 0), a2, voffA);
            PG8_WAIT_V(8); PG8_WAIT_L(0); PG8_BAR; PG8_MMA(1, 0, At, B0); PG8_MMA(1, 1, At, B1); PG8_BAR; PG8_SCHED;
            PG8_LDB(B0, 1, 0); PG8_LDB(B1, 1, 1); PG8_SCHED; PG8_LDA(At, 1, 0); PG8_STAGE(PG8_SA(0, 1), a2 + hstepA, voffA);
            PG8_WAIT_V(8); PG8_WAIT_L(0); PG8_BAR; PG8_MMA(0, 0, At, B0); PG8_MMA(0, 1, At, B1); PG8_BAR; PG8_SCHED;
            PG8_LDA(At, 1, 1); PG8_STAGE(PG8_SB(1, 0), b3, voffB); PG8_STAGE(PG8_SB(1, 1), b3 + hstepB, voffB); PG8_STAGE(PG8_SA(1, 0), a3, voffA);
            PG8_WAIT_V(8); PG8_WAIT_L(0); PG8_BAR; PG8_MMA(1, 0, At, B0); PG8_MMA(1, 1, At, B1); PG8_BAR; PG8_SCHED;
            } else {
            PG8_LDB(B0, 0, 0); PG8_SCHED; PG8_LDA(At, 0, 0); PG8_STAGE(PG8_SA(1, 1), a1 + hstepA, voffA);
            PG8_WAIT_L(8); PG8_BAR; PG8_WAIT_L(0); PG8_MMA(0, 0, At, B0); PG8_BAR; PG8_SCHED;
            PG8_LDB(B1, 0, 1); PG8_STAGE(PG8_SB(0, 0), b2, voffB);
            PG8_BAR; PG8_WAIT_L(0); PG8_MMA(0, 1, At, B1); PG8_BAR;
            PG8_LDA(At, 0, 1); PG8_STAGE(PG8_SA(0, 0), a2, voffA);
            PG8_BAR; PG8_WAIT_L(0); PG8_MMA(1, 0, At, B0); PG8_BAR; PG8_SCHED;
            PG8_STAGE(PG8_SB(0, 1), b2 + hstepB, voffB);
            PG8_WAIT_V(6); PG8_BAR; PG8_MMA(1, 1, At, B1); PG8_BAR;
            PG8_LDB(B0, 1, 0); PG8_SCHED; PG8_LDA(At, 1, 0); PG8_STAGE(PG8_SA(0, 1), a2 + hstepA, voffA);
            PG8_WAIT_L(8); PG8_BAR; PG8_WAIT_L(0); PG8_MMA(0, 0, At, B0); PG8_BAR; PG8_SCHED;
            PG8_LDB(B1, 1, 1); PG8_STAGE(PG8_SB(1, 0), b3, voffB);
            PG8_BAR; PG8_WAIT_L(0); PG8_MMA(0, 1, At, B1); PG8_BAR;
            PG8_LDA(At, 1, 1); PG8_STAGE(PG8_SA(1, 0), a3, voffA);
            PG8_BAR; PG8_WAIT_L(0); PG8_MMA(1, 0, At, B0); PG8_BAR; PG8_SCHED;
            PG8_STAGE(PG8_SB(1, 1), b3 + hstepB, voffB);
            PG8_WAIT_V(6); PG8_BAR; PG8_MMA(1, 1, At, B1); PG8_BAR;
            }
        }
        if constexpr (ALIGN_EPI) { if (wr == 0) PG8_BAR; }
        if constexpr (!Epi::AFTER_DRAIN) { E(acc, cur, wr, wc, fr, fq); S.done(cur); }
        if (!has_next) break;
        E.init(acc, nxt, wr, wc, fr, fq);
        cur = nxt; cA = nA; cB = nB; ++ui;
        if constexpr (ALIGN_EPI) { if (wr == 1) PG8_BAR; }
    }
    PG8_WAIT_V(0);
    if constexpr (!ALIGN_EPI) { if (wr == 0) PG8_BAR; }
    PG8_BAR;
    if constexpr (Epi::AFTER_DRAIN) { E.fused(acc, cur, wr, wc, fr, fq, lds, wid, lane); S.done(cur); }
#undef PG8_SA
#undef PG8_SB
#undef PG8_STAGE
#undef PG8_LDA
#undef PG8_LDB
#undef PG8_MMA
#undef PG8_WAIT_V
#undef PG8_WAIT_L
#undef PG8_BAR
#undef PG8_SCHED
}
}
#define EPI_ZERO_INIT \
  __device__ __forceinline__ void init(pg8::f32x4 (&acc)[2][2][4][2], const pg8::Unit&, int, int, int, int) const { \
    _Pragma("unroll") for (int a = 0; a < 2; ++a) _Pragma("unroll") for (int b = 0; b < 2; ++b) \
    _Pragma("unroll") for (int m = 0; m < 4; ++m) _Pragma("unroll") for (int n = 0; n < 2; ++n) acc[a][b][m][n] = (pg8::f32x4){0.f, 0.f, 0.f, 0.f}; }
struct EpiResid {
  static constexpr bool PERM = true, AFTER_DRAIN = false;
  float* C; int ldc; bf16_t* xb; bf16_t* hb; const float* g2; float* parts;
  __device__ __forceinline__ void init(pg8::f32x4 (&acc)[2][2][4][2], const pg8::Unit& u, int wr, int wc, int fr, int fq) const {
#pragma unroll
    for (int ai = 0; ai < 2; ++ai)
#pragma unroll
      for (int m = 0; m < 4; ++m) {
        const int row = u.pm * 256 + ai * 128 + wr * 64 + m * 16 + fr;
#pragma unroll
        for (int bj = 0; bj < 2; ++bj)
#pragma unroll
          for (int n = 0; n < 2; ++n) {
            const int col = u.pn * 256 + bj * 128 + wc * 32 + 8 * fq + 4 * n;
            acc[ai][bj][m][n] = *(const pg8::f32x4*)(C + (size_t)row * ldc + col);
          }
      }
  }
  __device__ __forceinline__ void operator()(const pg8::f32x4 (&acc)[2][2][4][2], const pg8::Unit& u, int wr, int wc, int fr_in, int fq_in) const {
    int fr = fr_in, fq = fq_in; asm volatile("" : "+v"(fr), "+v"(fq));
    pg8::f32x4 gv[2][2];
#pragma unroll
    for (int bj = 0; bj < 2; ++bj)
#pragma unroll
      for (int n = 0; n < 2; ++n) gv[bj][n] = *(const pg8::f32x4*)(g2 + u.pn * 256 + bj * 128 + wc * 32 + 8 * fq + 4 * n);
#pragma unroll
    for (int ai = 0; ai < 2; ++ai)
#pragma unroll
      for (int m = 0; m < 4; ++m) {
        const int row = u.pm * 256 + ai * 128 + wr * 64 + m * 16 + fr;
        float ss = 0.f;
#pragma unroll
        for (int bj = 0; bj < 2; ++bj) {
          const int col = u.pn * 256 + bj * 128 + wc * 32 + 8 * fq;
          const pg8::f32x4 v0 = acc[ai][bj][m][0], v1 = acc[ai][bj][m][1];
          *(pg8::f32x4*)(C + (size_t)row * ldc + col) = v0; *(pg8::f32x4*)(C + (size_t)row * ldc + col + 4) = v1;
          *(uint4*)(xb + (size_t)row * KD + col) = make_uint4(pk_bf16(v0[0], v0[1]), pk_bf16(v0[2], v0[3]), pk_bf16(v1[0], v1[1]), pk_bf16(v1[2], v1[3]));
          const pg8::f32x4 h0 = v0 * gv[bj][0], h1 = v1 * gv[bj][1];
          *(uint4*)(hb + ((size_t)(col >> 7) * T + row) * 128 + (col & 127)) = make_uint4(pk_bf16(h0[0], h0[1]), pk_bf16(h0[2], h0[3]), pk_bf16(h1[0], h1[1]), pk_bf16(h1[2], h1[3]));
          ss += ((v0[0] * v0[0] + v0[1] * v0[1]) + (v0[2] * v0[2] + v0[3] * v0[3])) + ((v1[0] * v1[0] + v1[1] * v1[1]) + (v1[2] * v1[2] + v1[3] * v1[3]));
        }
        ss += __shfl_xor(ss, 16); ss += __shfl_xor(ss, 32);
        if (fq == 0) parts[(size_t)row * 16 + u.pn * 4 + wc] = ss;
        asm volatile("" ::: "memory");
      }
  }
};
struct EpiScaleStoreBf16 {
  static constexpr bool PERM = true, AFTER_DRAIN = false;
  bf16_t* C; int ldc; const float* parts; int nparts; float* rs_out;
  EPI_ZERO_INIT
  __device__ __forceinline__ void operator()(const pg8::f32x4 (&acc)[2][2][4][2], const pg8::Unit& u, int wr, int wc, int fr_in, int fq_in) const {
    int fr = fr_in, fq = fq_in; asm volatile("" : "+v"(fr), "+v"(fq));
#pragma unroll
    for (int ai = 0; ai < 2; ++ai)
#pragma unroll
      for (int m = 0; m < 4; ++m) {
        const int row = u.pm * 256 + ai * 128 + wr * 64 + m * 16 + fr;
        float ssum = 0.f;
        for (int i = 0; i < nparts; i += 4) { const pg8::f32x4 q4 = *(const pg8::f32x4*)(parts + (size_t)row * nparts + i); ssum += (q4[0] + q4[1]) + (q4[2] + q4[3]); }
        const float r = rsqrtf(ssum * (1.0f / (float)D) + EPS);
        if (rs_out && u.pn == 0 && wc == 0 && fq == 0) rs_out[row] = r;
#pragma unroll
        for (int bj = 0; bj < 2; ++bj) {
          const int col = u.pn * 256 + bj * 128 + wc * 32 + 8 * fq;
          const pg8::f32x4 v0 = acc[ai][bj][m][0] * r, v1 = acc[ai][bj][m][1] * r;
          *(uint4*)(C + (size_t)row * ldc + col) = make_uint4(pk_bf16(v0[0], v0[1]), pk_bf16(v0[2], v0[3]), pk_bf16(v1[0], v1[1]), pk_bf16(v1[2], v1[3]));
        }
        asm volatile("" ::: "memory");
      }
  }
};
template <class Epi>
__device__ __forceinline__ void run_gemm(unsigned char* lds_raw, const bf16_t* A, const bf16_t* Bt, int M, int N, int K, const Epi& e) {
  pg8::Gemm g{A, Bt, M, N, K, K, K}; pg8::StaticOrder So; So.init(M, N, (int)gridDim.x, (int)blockIdx.x);
  pg8::gemm_phase<Epi, pg8::StaticOrder, true, true>((PG8_LAS unsigned char*)lds_raw, g, So, e);
}

__device__ __forceinline__ void transpose_items(const float* __restrict__ W, int K, int N, const float* __restrict__ g, bf16_t* __restrict__ Wt, int gw, int ngw, int lane) {
  const int nkt = K / 64, nnt = N / 64;
  for (int it = gw; it < nkt * nnt; it += ngw) {
    int kt = it % nkt, ntile = it / nkt;
    int k0 = kt * 64, n = ntile * 64 + lane;
    float v[64];
#pragma unroll
    for (int i = 0; i < 64; ++i) v[i] = W[(size_t)(k0 + i) * N + n] * g[k0 + i];
    bf16_t* dst = Wt + (size_t)n * (K * KS) + k0;
#pragma unroll
    for (int c = 0; c < 8; ++c) {
      bf16_t hi[8], lo[8];
#pragma unroll
      for (int e = 0; e < 8; ++e) { hi[e] = f2bf(v[c * 8 + e]); lo[e] = f2bf(v[c * 8 + e] - bf2f(hi[e])); }
      uint4 ph, pl;
      ph.x = hi[0] | ((unsigned)hi[1] << 16); ph.y = hi[2] | ((unsigned)hi[3] << 16); ph.z = hi[4] | ((unsigned)hi[5] << 16); ph.w = hi[6] | ((unsigned)hi[7] << 16);
      pl.x = lo[0] | ((unsigned)lo[1] << 16); pl.y = lo[2] | ((unsigned)lo[3] << 16); pl.z = lo[4] | ((unsigned)lo[5] << 16); pl.w = lo[6] | ((unsigned)lo[7] << 16);
      *(uint4*)(dst + c * 8) = ph;
      if (PRECISE) { *(uint4*)(dst + K + c * 8) = pl; *(uint4*)(dst + 2 * K + c * 8) = ph; }
    }
  }
}


__device__ __forceinline__ void phase_prologue(const Params& p, int gtid, int ngt, int gw, int ngw, int lane) {
  for (int idx = gtid; idx < S * 40; idx += ngt) {
    int s = idx / 40, i = idx % 40;
    if (i < 8) {
      float inv = powf(500000.0f, -(float)(2 * i) / 16.0f);
      float ang = (float)s * inv;
      p.cosm()[s * 8 + i] = (float)cos((double)ang); p.sinm()[s * 8 + i] = (float)sin((double)ang);
    } else {
      int j = i - 8;
      float inv = powf(10000.0f, -((float)j / 31.0f));
      float ang = (float)s * inv;
      p.cosr()[s * 32 + j] = (float)cos((double)ang); p.sinr()[s * 32 + j] = (float)sin((double)ang);
    }
  }
  { const float4* a = (const float4*)p.inp(0); float4* b = (float4*)p.outp();
    for (size_t i = gtid; i < (size_t)T * D / 4; i += ngt) b[i] = a[i]; }
  for (int t = gw; t < T; t += ngw) {
    const float4* xr = (const float4*)(p.inp(0) + (size_t)t * D); float ss = 0.f;
#pragma unroll
    for (int i = 0; i < 4; ++i) { const float4 v = xr[lane + i * 64]; ss += v.x * v.x + v.y * v.y + v.z * v.z + v.w * v.w;
      *(uint2*)(p.xb() + (size_t)t * KD + (lane + i * 64) * 4) = make_uint2(pk_bf16(v.x, v.y), pk_bf16(v.z, v.w)); }
    ss = wave_sum(ss);
    if (lane < 8) p.ssq1()[(size_t)t * 8 + lane] = lane == 0 ? ss : 0.f;
  }
  for (int idx = gtid; idx < NL * 65536; idx += ngt) { const int l2 = idx >> 16, n2 = (idx >> 8) & 255, k2 = idx & 255; p.Wglu_t()[idx] = f2bf(p.inp(11)[(size_t)l2 * 65536 + k2 * 256 + n2]); }
  for (int l = 0; l < NL; ++l) {
    transpose_items(p.inp(2) + (size_t)l * D * INW, D, INW, p.inp(1) + l * D, p.Win_t() + (size_t)l * INW * KD, gw, ngw, lane);
    transpose_items(p.inp(15) + (size_t)l * D * D, D, D, p.inp(14) + l * D, p.Wout_t() + (size_t)l * D * KD, gw, ngw, lane);
    transpose_items(p.inp(17) + (size_t)l * D * D, D, D, p.inp(16) + l * D, p.Wq_t() + (size_t)l * D * KD, gw, ngw, lane);
  }
}


struct S5P { float lr, li, dt, fr, fi; };
__device__ __forceinline__ S5P s5p(const Params& p, int l, int g, int pp) {
  S5P r; r.lr = p.inp(3)[l * 1024 + g * 64 + pp]; r.li = p.inp(4)[l * 1024 + g * 64 + pp]; r.dt = expf(p.inp(5)[l * 16 + g]);
  const float mag = expf(r.lr * r.dt); float sn, cs; sincosf(r.li * r.dt, &sn, &cs);
  const float ar = mag * cs, ai = mag * sn, den = r.lr * r.lr + r.li * r.li;
  r.fr = ((ar - 1.0f) * r.lr + ai * r.li) / den; r.fi = (ai * r.lr - (ar - 1.0f) * r.li) / den;
  return r;
}
__device__ __forceinline__ void s5pow(const S5P& s, int k, float& re, float& im) {
  const float m = expf((float)k * s.lr * s.dt); float sn, cs; sincosf((float)k * s.li * s.dt, &sn, &cs); re = m * cs; im = m * sn;
}
__device__ __forceinline__ void phase_s5_prep(const Params& p, int l, int gtid, int ngt) {
  const float* b_re = p.inp(6) + l * 16384; const float* b_im = p.inp(7) + l * 16384;
  const float* c_re = p.inp(8) + l * 16384; const float* c_im = p.inp(9) + l * 16384;
  bf16_t* Wy = p.S5Wy(); bf16_t* Wz = p.S5Wz();
  for (int it = gtid; it < 16 * 32 * 256; it += ngt) {
    const int hp = it & 15, h = (it >> 4) & 15, d = (it >> 8) & 31, g = it >> 13;
    float acc = 0.f;
    for (int pp = 0; pp < 64; ++pp) {
      const S5P s = s5p(p, l, g, pp);
      float pr, pi; s5pow(s, d, pr, pi);
      const float br = b_re[(g * 64 + pp) * 16 + hp], bi = b_im[(g * 64 + pp) * 16 + hp];
      const float bbr = s.fr * br - s.fi * bi, bbi = s.fr * bi + s.fi * br;
      const float tr = pr * bbr - pi * bbi, ti = pr * bbi + pi * bbr;
      acc += c_re[(g * 16 + h) * 64 + pp] * tr - c_im[(g * 16 + h) * 64 + pp] * ti;
    }
    const bf16_t v = f2bf(acc);
    for (int jp = 0; jp + d < 32; ++jp) {
      const int j = jp + d;
      Wy[((size_t)g * 512 + j * 16 + h) * 640 + jp * 16 + hp] = v;
      if (d > 0) Wy[((size_t)g * 512 + jp * 16 + h) * 640 + j * 16 + hp] = 0;
    }
  }
  for (int it = gtid; it < 16 * 32 * 16 * 64; it += ngt) {
    const int pp = it & 63, h = (it >> 6) & 15, j = (it >> 10) & 31, g = it >> 15;
    const S5P s = s5p(p, l, g, pp);
    float pr, pi; s5pow(s, j + 1, pr, pi);
    const float cr = c_re[(g * 16 + h) * 64 + pp], ci = c_im[(g * 16 + h) * 64 + pp];
    const unsigned w = pk_bf16(cr * pr - ci * pi, -(cr * pi + ci * pr));
    *(unsigned*)(Wy + ((size_t)g * 512 + j * 16 + h) * 640 + 512 + 2 * pp) = w;
  }
  for (int it = gtid; it < 16 * 64 * 32; it += ngt) {
    const int j = it & 31, pp = (it >> 5) & 63, g = it >> 11;
    const S5P s = s5p(p, l, g, pp);
    float pr, pi; s5pow(s, 31 - j, pr, pi);
    for (int hp = 0; hp < 16; ++hp) {
      const float br = b_re[(g * 64 + pp) * 16 + hp], bi = b_im[(g * 64 + pp) * 16 + hp];
      const float bbr = s.fr * br - s.fi * bi, bbi = s.fr * bi + s.fi * br;
      Wz[((size_t)g * 256 + 2 * pp) * 512 + j * 16 + hp] = f2bf(pr * bbr - pi * bbi);
      Wz[((size_t)g * 256 + 2 * pp + 1) * 512 + j * 16 + hp] = f2bf(pr * bbi + pi * bbr);
    }
  }
  for (int it = gtid; it < 16 * 64; it += ngt) {
    const S5P s = s5p(p, l, it >> 6, it & 63);
    float pr, pi; s5pow(s, 32, pr, pi);
    p.S5a32()[it * 2] = pr; p.S5a32()[it * 2 + 1] = pi;
  }
}
__device__ __forceinline__ void phase_pack_u(const Params& p, int gtid, int ngt) {
  for (int idx = gtid; idx < T * 32; idx += ngt) {
    const int t = idx >> 5, i = idx & 31, g = i >> 1;
    *(uint4*)(p.S5A() + ((size_t)g * 1024 + (t >> 5)) * 640 + (t & 31) * 16 + (i & 1) * 8) = *(const uint4*)(p.projb() + (size_t)t * INW + i * 8);
  }
}
__device__ __forceinline__ void phase_s5_scan(const Params& p, int gtid, int ngt) {
  for (int it = gtid; it < NB * 16 * 64; it += ngt) {
    const int pp = it & 63, g = (it >> 6) & 15, b = it >> 10;
    const float er = p.S5a32()[(g * 64 + pp) * 2], ei = p.S5a32()[(g * 64 + pp) * 2 + 1];
    float sr = 0.f, si = 0.f;
#pragma unroll 1
    for (int c0 = 0; c0 < 128; c0 += 16) {
      float2 z[16];
#pragma unroll
      for (int k = 0; k < 16; ++k) z[k] = *(const float2*)(p.S5Z() + ((size_t)g * 1024 + b * 128 + c0 + k) * 128 + 2 * pp);
#pragma unroll
      for (int k = 0; k < 16; ++k) {
        const size_t ch = (size_t)g * 1024 + b * 128 + c0 + k;
        *(unsigned*)(p.S5A() + ch * 640 + 512 + 2 * pp) = pk_bf16(sr, si);
        const float nr = er * sr - ei * si + z[k].x, ni = er * si + ei * sr + z[k].y;
        sr = nr; si = ni;
      }
    }
  }
}
struct EpiS5Z {
  static constexpr bool PERM = false, AFTER_DRAIN = false;
  float* Z;
  EPI_ZERO_INIT
  __device__ __forceinline__ void operator()(const pg8::f32x4 (&acc)[2][2][4][2], const pg8::Unit& u, int wr, int wc, int fr_in, int fq_in) const {
    int fr = fr_in, fq = fq_in; asm volatile("" : "+v"(fr), "+v"(fq));
    const int g = u.pm >> 2;
#pragma unroll
    for (int ai = 0; ai < 2; ++ai)
#pragma unroll
      for (int m = 0; m < 4; ++m) {
        const int chunk = (u.pm & 3) * 256 + ai * 128 + wr * 64 + m * 16 + fr;
#pragma unroll
        for (int n = 0; n < 2; ++n) *(pg8::f32x4*)(Z + ((size_t)g * 1024 + chunk) * 128 + wc * 32 + n * 16 + 4 * fq) = acc[ai][0][m][n];
      }
  }
};
struct EpiS5Y {
  static constexpr bool PERM = false, AFTER_DRAIN = false;
  bf16_t* ygb; const bf16_t* A; const float* dsk;
  EPI_ZERO_INIT
  __device__ __forceinline__ void operator()(const pg8::f32x4 (&acc)[2][2][4][2], const pg8::Unit& u, int wr, int wc, int fr_in, int fq_in) const {
    int fr = fr_in, fq = fq_in; asm volatile("" : "+v"(fr), "+v"(fq));
    const int g = u.pm >> 2;
#pragma unroll
    for (int ai = 0; ai < 2; ++ai)
#pragma unroll
      for (int m = 0; m < 4; ++m) {
        const int chunk = (u.pm & 3) * 256 + ai * 128 + wr * 64 + m * 16 + fr;
#pragma unroll
        for (int bj = 0; bj < 2; ++bj)
#pragma unroll
          for (int n = 0; n < 2; ++n) {
            const int col = (u.pn & 1) * 256 + bj * 128 + wc * 32 + n * 16 + 4 * fq, j = col >> 4, h = col & 15;
            const uint2 uu = *(const uint2*)(A + ((size_t)g * 1024 + chunk) * 640 + col);
            const pg8::f32x4 dv = *(const pg8::f32x4*)(dsk + g * 16 + h);
            const pg8::f32x4 v = acc[ai][bj][m][n];
            const float y0 = fast_gelu(v[0] + dv[0] * __uint_as_float(uu.x << 16)), y1 = fast_gelu(v[1] + dv[1] * __uint_as_float(uu.x & 0xffff0000u));
            const float y2 = fast_gelu(v[2] + dv[2] * __uint_as_float(uu.y << 16)), y3 = fast_gelu(v[3] + dv[3] * __uint_as_float(uu.y & 0xffff0000u));
            uint2 o; o.x = pk_bf16(y0, y1); o.y = pk_bf16(y2, y3);
            *(uint2*)(ygb + ((size_t)chunk * 32 + j) * 256 + g * 16 + h) = o;
          }
        asm volatile("" ::: "memory");
      }
  }
};
struct EpiGlu {
  static constexpr bool PERM = false, AFTER_DRAIN = false;
  bf16_t* yb; const bf16_t* ygb; float* scr;
  EPI_ZERO_INIT
  __device__ __forceinline__ void operator()(const pg8::f32x4 (&acc_)[2][2][4][2], const pg8::Unit& u, int wr, int wc, int fr_in, int fq_in) const {
    int fr = fr_in, fq = fq_in; asm volatile("" : "+v"(fr), "+v"(fq));
    pg8::f32x4 (&acc)[2][2][4][2] = const_cast<pg8::f32x4 (&)[2][2][4][2]>(acc_);
#pragma unroll
    for (int ai = 0; ai < 2; ++ai)
#pragma unroll
      for (int m = 0; m < 4; ++m) {
        const int rl = ai * 128 + wr * 64 + m * 16 + fr, row = u.pm * 256 + rl;
        float ss = 0.f;
#pragma unroll
        for (int bj = 0; bj < 2; ++bj)
#pragma unroll
          for (int n = 0; n < 2; ++n) {
            const int col = bj * 128 + wc * 32 + n * 16 + 4 * fq;
            const uint2 yy = *(const uint2*)(ygb + (size_t)row * 256 + col);
            const pg8::f32x4 z = acc[ai][bj][m][n];
            pg8::f32x4 r;
            r[0] = __uint_as_float(yy.x << 16) * fast_sigmoid(z[0]); r[1] = __uint_as_float(yy.x & 0xffff0000u) * fast_sigmoid(z[1]);
            r[2] = __uint_as_float(yy.y << 16) * fast_sigmoid(z[2]); r[3] = __uint_as_float(yy.y & 0xffff0000u) * fast_sigmoid(z[3]);
            acc[ai][bj][m][n] = r;
            ss += r[0] * r[0] + r[1] * r[1] + r[2] * r[2] + r[3] * r[3];
          }
        ss += __shfl_xor(ss, 16); ss += __shfl_xor(ss, 32);
        if (fq == 0) scr[rl * 4 + wc] = ss;
        asm volatile("" ::: "memory");
      }
    asm volatile("s_waitcnt lgkmcnt(0)" ::: "memory"); __builtin_amdgcn_s_barrier(); asm volatile("" ::: "memory");
#pragma unroll
    for (int ai = 0; ai < 2; ++ai)
#pragma unroll
      for (int m = 0; m < 4; ++m) {
        const int rl = ai * 128 + wr * 64 + m * 16 + fr, row = u.pm * 256 + rl;
        const pg8::f32x4 s4 = *(const pg8::f32x4*)(scr + rl * 4);
        const float r = rsqrtf((s4[0] + s4[1] + s4[2] + s4[3]) / 256.0f + EPS);
#pragma unroll
        for (int bj = 0; bj < 2; ++bj)
#pragma unroll
          for (int n = 0; n < 2; ++n) { const pg8::f32x4 v = acc[ai][bj][m][n] * r; *(uint2*)(yb + (size_t)row * KD + bj * 128 + wc * 32 + n * 16 + 4 * fq) = make_uint2(pk_bf16(v[0], v[1]), pk_bf16(v[2], v[3])); }
        asm volatile("" ::: "memory");
      }
    asm volatile("s_waitcnt lgkmcnt(0)" ::: "memory"); __builtin_amdgcn_s_barrier(); asm volatile("" ::: "memory");
  }
};

constexpr float QSCALE = 0.125f * 1.4426950408889634f;


__device__ __forceinline__ void phase_moba2(const Params& p, int l, unsigned char* lds, int* uq) {
  constexpr int OLD = 260;
  bf16_t* Qs = (bf16_t*)lds;
  float* Oaccf = (float*)(lds + 32768);
  float* laccf = (float*)(lds + 32768 + 64 * OLD * 4);
  float* kms = laccf + 256;
  float* gat = kms + 1024;
  unsigned char* lists = (unsigned char*)(gat + 4096);
  int* cnt = (int*)(lists + 4096);
  int* items = cnt + 16;
  int* ctr = items + 160;
  unsigned* selp = (unsigned*)(ctr + 4);
  float* bq = (float*)(selp + 256);
  int* Oacc = (int*)Oaccf; int* lacc = (int*)laccf;
  float kmax = 0.f;
  { const float* gk = p.inp(13) + l * 64;
    for (int d = 0; d < 64; ++d) kmax = fmaxf(kmax, fabsf(gk[d]));
    kmax *= 8.0f * 1.01f; }
  for (;;) {
    const int u = q_pull(uq, NB * 8 * 16, (int*)(lds + 131072), threadIdx.x);
    if (u < 0) break;
    const int qblk = 15 - (u >> 6), bh = u & 63, b = bh >> 3, h = bh & 7;
    int tid = threadIdx.x; asm volatile("" : "+v"(tid));
    const int lane = tid & 63, wv = tid >> 6, n = lane & 31, hh = lane >> 5;
    __syncthreads();
    { const uint4* src = (const uint4*)(p.Qm() + ((size_t)bh * S + qblk * 256) * 64);
      uint4* dst = (uint4*)Qs;
      for (int i = tid; i < 256 * 64 * 2 / 16; i += NTHR) dst[i] = src[i]; }
    for (int i = tid; i < qblk * 64; i += NTHR) kms[i] = p.kmean()[(size_t)bh * 1024 + i];
    for (int i = tid; i < 64 * OLD; i += NTHR) Oacc[i] = 0;
    if (tid < 256) lacc[tid] = 0;
    if (tid < 16) cnt[tid] = 0;
    __syncthreads();
    { const int q = tid & 255, par = tid >> 8;
      float qv[64];
#pragma unroll
      for (int c = 0; c < 8; ++c) {
        uint4 w = *(const uint4*)(Qs + q * 64 + c * 8);
        qv[c * 8 + 0] = __uint_as_float(w.x << 16); qv[c * 8 + 1] = __uint_as_float(w.x & 0xffff0000u);
        qv[c * 8 + 2] = __uint_as_float(w.y << 16); qv[c * 8 + 3] = __uint_as_float(w.y & 0xffff0000u);
        qv[c * 8 + 4] = __uint_as_float(w.z << 16); qv[c * 8 + 5] = __uint_as_float(w.z & 0xffff0000u);
        qv[c * 8 + 6] = __uint_as_float(w.w << 16); qv[c * 8 + 7] = __uint_as_float(w.w & 0xffff0000u);
      }
      if (par == 0) { float qq = 0.f;
#pragma unroll
        for (int d = 0; d < 64; ++d) qq = fmaf(qv[d], qv[d], qq);
        bq[q] = sqrtf(qq) * kmax; }
      for (int j = par; j < qblk; j += 2) {
        float g = 0.f;
#pragma unroll
        for (int d = 0; d < 64; ++d) g = fmaf(qv[d], kms[j * 64 + d], g);
        gat[q * 16 + j] = g;
      }
    }
    __syncthreads();
    if (tid < 256) {
      float b0 = -INFINITY, b1 = -INFINITY, b2 = -INFINITY; int i0 = 0, i1 = 0, i2 = 0;
      for (int j = 0; j < qblk; ++j) {
        float g = gat[tid * 16 + j];
        if (g > b0) { b2 = b1; i2 = i1; b1 = b0; i1 = i0; b0 = g; i0 = j; }
        else if (g > b1) { b2 = b1; i2 = i1; b1 = g; i1 = j; }
        else if (g > b2) { b2 = g; i2 = j; }
      }
      const int nsel = qblk < 3 ? qblk : 3;
      selp[tid] = (unsigned)i0 | ((unsigned)i1 << 4) | ((unsigned)i2 << 8) | ((unsigned)nsel << 12);
    }
    __syncthreads();
    for (int j = wv; j < qblk; j += 8) {
      int base = 0;
      for (int c = 0; c < 4; ++c) {
        const int q = c * 64 + lane;
        const unsigned sp = selp[q];
        const int ns = sp >> 12;
        const bool f = (ns > 0 && (int)(sp & 15) == j) || (ns > 1 && (int)((sp >> 4) & 15) == j) || (ns > 2 && (int)((sp >> 8) & 15) == j);
        const unsigned long long bal = __ballot(f);
        const int pos = base + __popcll(bal & ((1ull << lane) - 1ull));
        if (f) lists[j * 256 + pos] = (unsigned char)q;
        base += __popcll(bal);
      }
      if (lane == 0) cnt[j] = base;
    }
    __syncthreads();
    if (tid == 0) {
      int ni = 0;
#pragma unroll 1
      for (int g = 7; g >= 0; --g) items[ni++] = (16 << 8) | g;
      for (int j = 0; j < qblk; ++j) { const int ng = (cnt[j] + 31) >> 5; for (int g = 0; g < ng; ++g) items[ni++] = (j << 8) | g; }
      ctr[0] = ni; ctr[1] = 0;
    }
    __syncthreads();
    const int nitems = ctr[0];
    for (;;) {
      int it = 0;
      if (lane == 0) it = atomicAdd(&ctr[1], 1);
      it = __builtin_amdgcn_readfirstlane(it);
      if (it >= nitems) break;
      const int item = items[it];
      const int j = item >> 8, g = item & 255;
      const bool own = (j == 16);
      const int kb = own ? qblk : j;
      const int ntile = own ? (g + 1) : 8;
      int qi; bool valid;
      if (own) { qi = g * 32 + n; valid = true; }
      else { const int pos = g * 32 + n; valid = pos < cnt[j]; qi = lists[j * 256 + (valid ? pos : 0)]; }
      const bf16_t* kt0 = p.Km() + ((size_t)bh * (S / 32) + kb * 8) * 2048 + lane * 8;
      const bf16_t* vt0 = p.Vm() + ((size_t)bh * (S / 32) + kb * 8) * 2048 + lane * 8;
      f32x16 O0, O1;
#pragma unroll
      for (int r = 0; r < 16; ++r) { O0[r] = 0.f; O1[r] = 0.f; }
      float lsum = 0.f;
      const float nbq = -bq[qi];
      bf16x8 kf[3][4], vf[3][4];
#define MOBA_LOAD(KT_, BUF_) { _Pragma("unroll") for (int s = 0; s < 4; ++s) { kf[BUF_][s] = *(const bf16x8*)(kt0 + (size_t)(KT_) * 2048 + s * 512); vf[BUF_][s] = *(const bf16x8*)(vt0 + (size_t)(KT_) * 2048 + s * 512); } }
#define MOBA_STEP(KT_, BUF_)                                                                                                           \
      if ((KT_) < ntile) {                                                                                                               \
        if ((KT_) + 2 < ntile) MOBA_LOAD((KT_) + 2, ((BUF_) + 2) % 3)                                                                     \
        f32x16 X;                                                                                                                         \
        _Pragma("unroll") for (int r = 0; r < 16; ++r) X[r] = nbq;                                                                        \
        _Pragma("unroll") for (int s = 0; s < 4; ++s) X = __builtin_amdgcn_mfma_f32_32x32x16_bf16(kf[BUF_][s], *(const bf16x8*)(Qs + qi * 64 + (2 * s + hh) * 8), X, 0, 0, 0);     \
        const bool diag = own && ((KT_) == g);                                                                                            \
        unsigned pw[8];                                                                                                                   \
        _Pragma("unroll") for (int r = 0; r < 16; r += 2) {                                                                               \
          float e0 = __builtin_amdgcn_exp2f(X[r]), e1 = __builtin_amdgcn_exp2f(X[r + 1]);                                                 \
          if (diag) {                                                                                                                     \
            const int k0 = (r & 3) + 8 * (r >> 2) + 4 * hh, k1 = ((r + 1) & 3) + 8 * ((r + 1) >> 2) + 4 * hh;                             \
            e0 = (k0 <= n) ? e0 : 0.f; e1 = (k1 <= n) ? e1 : 0.f;                                                                         \
          }                                                                                                                               \
          lsum += e0 + e1;                                                                                                                \
          pw[r >> 1] = pk_bf16(e0, e1);                                                                                                   \
        }                                                                                                                                 \
        bf16x8 pf0, pf1;                                                                                                                  \
        { uint4 t0 = make_uint4(pw[0], pw[1], pw[2], pw[3]), t1 = make_uint4(pw[4], pw[5], pw[6], pw[7]);                                 \
          pf0 = *(bf16x8*)&t0; pf1 = *(bf16x8*)&t1; }                                                                                     \
        O0 = __builtin_amdgcn_mfma_f32_32x32x16_bf16(vf[BUF_][0], pf0, O0, 0, 0, 0);                                                      \
        O0 = __builtin_amdgcn_mfma_f32_32x32x16_bf16(vf[BUF_][1], pf1, O0, 0, 0, 0);                                                      \
        O1 = __builtin_amdgcn_mfma_f32_32x32x16_bf16(vf[BUF_][2], pf0, O1, 0, 0, 0);                                                      \
        O1 = __builtin_amdgcn_mfma_f32_32x32x16_bf16(vf[BUF_][3], pf1, O1, 0, 0, 0);                                                      \
      }
      MOBA_LOAD(0, 0)
      if (ntile > 1) MOBA_LOAD(1, 1)
#pragma unroll 1
      for (int kt3 = 0; kt3 < ntile; kt3 += 3) {
        MOBA_STEP(kt3, 0) MOBA_STEP(kt3 + 1, 1) MOBA_STEP(kt3 + 2, 2)
      }
#undef MOBA_STEP
#undef MOBA_LOAD
      lsum += __shfl_xor(lsum, 32);
      if (valid) {
        if (hh == 0) atomicAdd(&lacc[qi], __float2int_rn(lsum * 1048576.0f));
#pragma unroll
        for (int r = 0; r < 16; ++r) {
          const int dim = (r & 3) + 8 * (r >> 2) + 4 * hh;
          atomicAdd(&Oacc[dim * OLD + qi], __float2int_rn(O0[r] * 1048576.0f));
          atomicAdd(&Oacc[(dim + 32) * OLD + qi], __float2int_rn(O1[r] * 1048576.0f));
        }
      }
    }
    __syncthreads();
    { const int q = tid >> 1, half = tid & 1;
      const float inv = 1.0f / (float)lacc[q];
      float o[32], ss = 0.f;
#pragma unroll
      for (int d = 0; d < 32; ++d) { o[d] = (float)Oacc[(half * 32 + d) * OLD + q] * inv; ss += o[d] * o[d]; }
      ss += __shfl_xor(ss, 1);
      const float r = rsqrtf(ss / 64.0f + EPS);
      bf16_t* dst = p.xb() + (size_t)(b * S + qblk * 256 + q) * KD + 256 + h * 64 + half * 32;
#pragma unroll
      for (int d = 0; d < 32; d += 8) *(uint4*)(dst + d) = make_uint4(pk_bf16(o[d] * r, o[d + 1] * r), pk_bf16(o[d + 2] * r, o[d + 3] * r), pk_bf16(o[d + 4] * r, o[d + 5] * r), pk_bf16(o[d + 6] * r, o[d + 7] * r));
    }
  }
}


__device__ __forceinline__ float ret_log2g(int h) { return log2f(1.0f - exp2f(-5.0f - (float)h)); }
__device__ __forceinline__ void phase_ret_kv(const Params& p, int gw, int ngw, int lane) {
  const int n = lane & 31, hh = lane >> 5;
  for (int w = gw; w < NB * 4 * 32; w += ngw) {
    const int bh = w >> 5, cn = w & 31;
    const bf16_t* vt = p.Vr() + ((size_t)bh * (S / 32) + cn * 4) * 2048 + lane * 8;
    const bf16_t* kt = p.Krv() + ((size_t)bh * (S / 32) + cn * 4) * 2048 + lane * 8;
    f32x16 acc[2][2];
#pragma unroll
    for (int a = 0; a < 2; ++a)
#pragma unroll
      for (int b2 = 0; b2 < 2; ++b2)
#pragma unroll
        for (int r = 0; r < 16; ++r) acc[a][b2][r] = 0.f;
#pragma unroll 1
    for (int tl = 0; tl < 4; ++tl)
#pragma unroll
      for (int ks = 0; ks < 2; ++ks) {
        bf16x8 vf[2], kf[2];
#pragma unroll
        for (int x = 0; x < 2; ++x) { vf[x] = *(const bf16x8*)(vt + tl * 2048 + (x * 2 + ks) * 512); kf[x] = *(const bf16x8*)(kt + tl * 2048 + (x * 2 + ks) * 512); }
#pragma unroll
        for (int mb = 0; mb < 2; ++mb)
#pragma unroll
          for (int nb = 0; nb < 2; ++nb) acc[mb][nb] = __builtin_amdgcn_mfma_f32_32x32x16_bf16(vf[mb], kf[nb], acc[mb][nb], 0, 0, 0);
      }
    float* dst = p.KVr() + ((size_t)bh * 32 + cn) * 4096;
#pragma unroll
    for (int mb = 0; mb < 2; ++mb)
#pragma unroll
      for (int nb = 0; nb < 2; ++nb)
#pragma unroll
        for (int r = 0; r < 16; ++r) dst[(mb * 32 + (r & 3) + 8 * (r >> 2) + 4 * hh) * 64 + nb * 32 + n] = acc[mb][nb][r];
  }
}
__device__ __forceinline__ void phase_ret_scan(const Params& p, int gtid, int ngt) {
  for (int it = gtid; it < NB * 4 * 4096; it += ngt) {
    const int e = it & 4095, bh = it >> 12, h = bh & 3;
    const float l2g = ret_log2g(h), g1 = exp2f(l2g), g127 = exp2f(127.0f * l2g), g128 = exp2f(128.0f * l2g);
    float R = 0.f; float kv[32];
#pragma unroll
    for (int cn = 0; cn < 32; ++cn) kv[cn] = p.KVr()[((size_t)bh * 32 + cn) * 4096 + e];
#pragma unroll
    for (int cn = 0; cn < 32; ++cn) {
      p.Rb()[((size_t)bh * 32 + cn) * 4096 + e] = f2bf(g1 * R);
      R = g128 * R + g127 * kv[cn];
    }
  }
}
__device__ __forceinline__ void phase_ret_out(const Params& p, int gw, int ngw, int lane) {
  const int n = lane & 31, hh = lane >> 5;
  for (int w = gw; w < NB * 4 * 32 * 4; w += ngw) {
    const int qg = 3 - (w & 3), cn = (w >> 2) & 31, bh = w >> 7, b = bh >> 2, h = bh & 3;
    const int s0 = cn * 128 + qg * 32;
    bf16x8 qf[4];
#pragma unroll
    for (int s = 0; s < 4; ++s) qf[s] = *(const bf16x8*)(p.Qr() + ((size_t)bh * S + s0 + n) * 64 + (2 * s + hh) * 8);
    f32x16 O0, O1;
#pragma unroll
    for (int r = 0; r < 16; ++r) { O0[r] = 0.f; O1[r] = 0.f; }
    { const bf16_t* rb = p.Rb() + ((size_t)bh * 32 + cn) * 4096 + (size_t)n * 64 + hh * 8;
#pragma unroll
      for (int s = 0; s < 4; ++s) {
        const bf16x8 r0 = *(const bf16x8*)(rb + s * 16), r1 = *(const bf16x8*)(rb + 32 * 64 + s * 16);
        O0 = __builtin_amdgcn_mfma_f32_32x32x16_bf16(r0, qf[s], O0, 0, 0, 0);
        O1 = __builtin_amdgcn_mfma_f32_32x32x16_bf16(r1, qf[s], O1, 0, 0, 0);
      } }
    const bf16_t* kt0 = p.Kr() + ((size_t)bh * (S / 32) + cn * 4) * 2048 + lane * 8;
    const bf16_t* vt0 = p.Vr() + ((size_t)bh * (S / 32) + cn * 4) * 2048 + lane * 8;
    for (int kt = 0; kt <= qg; ++kt) {
      bf16x8 kf[4], vf[4];
#pragma unroll
      for (int s = 0; s < 4; ++s) { kf[s] = *(const bf16x8*)(kt0 + (size_t)kt * 2048 + s * 512); vf[s] = *(const bf16x8*)(vt0 + (size_t)kt * 2048 + s * 512); }
      f32x16 X;
#pragma unroll
      for (int r = 0; r < 16; ++r) X[r] = 0.f;
#pragma unroll
      for (int s = 0; s < 4; ++s) X = __builtin_amdgcn_mfma_f32_32x32x16_bf16(kf[s], qf[s], X, 0, 0, 0);
      const bool diag = (kt == qg);
      unsigned pw[8];
#pragma unroll
      for (int r = 0; r < 16; r += 2) {
        float e0 = X[r], e1 = X[r + 1];
        if (diag) {
          const int k0 = (r & 3) + 8 * (r >> 2) + 4 * hh, k1 = ((r + 1) & 3) + 8 * ((r + 1) >> 2) + 4 * hh;
          e0 = (k0 <= n) ? e0 : 0.f; e1 = (k1 <= n) ? e1 : 0.f;
        }
        pw[r >> 1] = pk_bf16(e0, e1);
      }
      bf16x8 pf0, pf1;
      { uint4 t0 = make_uint4(pw[0], pw[1], pw[2], pw[3]), t1 = make_uint4(pw[4], pw[5], pw[6], pw[7]);
        pf0 = *(bf16x8*)&t0; pf1 = *(bf16x8*)&t1; }
      O0 = __builtin_amdgcn_mfma_f32_32x32x16_bf16(vf[0], pf0, O0, 0, 0, 0);
      O0 = __builtin_amdgcn_mfma_f32_32x32x16_bf16(vf[1], pf1, O0, 0, 0, 0);
      O1 = __builtin_amdgcn_mfma_f32_32x32x16_bf16(vf[2], pf0, O1, 0, 0, 0);
      O1 = __builtin_amdgcn_mfma_f32_32x32x16_bf16(vf[3], pf1, O1, 0, 0, 0);
    }
    float ss = 0.f;
#pragma unroll
    for (int r = 0; r < 16; ++r) ss += O0[r] * O0[r] + O1[r] * O1[r];
    ss += __shfl_xor(ss, 32);
    const float rn = rsqrtf(ss / 64.0f + EPS);
    const size_t t = (size_t)b * S + s0 + n;
    const bf16_t* gp = p.projb() + t * INW + OFF_GR + h * 64;
    bf16_t* yo = p.xb() + t * KD + 768 + h * 64;
#pragma unroll
    for (int q4 = 0; q4 < 4; ++q4) {
#pragma unroll
      for (int mb = 0; mb < 2; ++mb) {
        const int d0 = mb * 32 + 8 * q4 + 4 * hh;
        const uint2 gw2 = *(const uint2*)(gp + d0); const float4 g = make_float4(__uint_as_float(gw2.x << 16), __uint_as_float(gw2.x & 0xffff0000u), __uint_as_float(gw2.y << 16), __uint_as_float(gw2.y & 0xffff0000u));
        float4 o;
        const f32x16& Oa = mb ? O1 : O0;
        o.x = Oa[q4 * 4 + 0] * rn * g.x * fast_sigmoid(g.x); o.y = Oa[q4 * 4 + 1] * rn * g.y * fast_sigmoid(g.y);
        o.z = Oa[q4 * 4 + 2] * rn * g.z * fast_sigmoid(g.z); o.w = Oa[q4 * 4 + 3] * rn * g.w * fast_sigmoid(g.w);
        *(uint2*)(yo + d0) = make_uint2(pk_bf16(o.x, o.y), pk_bf16(o.z, o.w));
      }
    }
  }
}

__device__ __forceinline__ void phase_post_pack(const Params& p, int l, int gtid, int ngt, int gw, int ngw, int lane) {
  const float* gq = p.inp(12) + l * 64; const float* gk = p.inp(13) + l * 64;
  for (int t = gw; t < T; t += ngw) {
    const int s = t % S, b = t / S;
    const bf16_t* row = p.projb() + (size_t)t * INW;
    float vin[24];
#pragma unroll
    for (int sl = 0; sl < 16; ++sl) vin[sl] = bf2f(row[(sl < 8 ? OFF_QM : OFF_KM) + (sl & 7) * 64 + lane]);
#pragma unroll
    for (int sl = 0; sl < 8; ++sl) vin[16 + sl] = bf2f(row[(sl < 4 ? OFF_QR : OFF_KR) + (sl & 3) * 64 + lane]);
    const float cm = p.cosm()[s * 8 + (lane & 7)], sm = p.sinm()[s * 8 + (lane & 7)];
    const float cr = p.cosr()[s * 32 + (lane & 31)], sr = p.sinr()[s * 32 + (lane & 31)];
    const float gqv = gq[lane], gkv = gk[lane];
#pragma unroll
    for (int slot = 0; slot < 16; ++slot) {
      const int h = slot & 7, bh = b * 8 + h; const bool isk = slot >= 8;
      const float v = vin[slot];
      const float ss = wave_sum(v * v);
      const float u = v * rsqrtf(ss / 64.0f + EPS) * (isk ? gkv : gqv);
      const float pu = __shfl(u, (lane < 8 ? lane + 8 : lane - 8) & 63);
      float o = u;
      if (lane < 16) o = lane < 8 ? (u * cm - pu * sm) : (u * cm + pu * sm);
      if (!isk) p.Qm()[((size_t)bh * S + s) * 64 + lane] = f2bf(o * QSCALE);
      else p.Km()[((((size_t)bh * (S / 32) + (s >> 5)) * 8 + (lane >> 3)) * 32 + (s & 31)) * 8 + (lane & 7)] = f2bf(o);
    }
#pragma unroll
    for (int slot = 16; slot < 24; ++slot) {
      const int h = (slot - 16) & 3, bh = b * 4 + h; const bool isk = slot >= 20;
      const float v = vin[slot];
      const float pv = __shfl(v, lane ^ 32);
      const float o = lane < 32 ? (v * cr - pv * sr) : (v * cr + pv * sr);
      const float l2g = ret_log2g(h); const int pos = s & 127;
      if (!isk) p.Qr()[((size_t)bh * S + s) * 64 + lane] = f2bf(o * exp2f((float)pos * l2g));
      else p.Kr()[((((size_t)bh * (S / 32) + (s >> 5)) * 8 + (lane >> 3)) * 32 + (s & 31)) * 8 + (lane & 7)] = f2bf(o * 0.125f * exp2f(-(float)pos * l2g));
    }
  }
  for (int idx = gtid; idx < NB * 8 * (S / 32) * 256; idx += ngt) {
    const int ln = idx & 63, ks = (idx >> 6) & 1, mb = (idx >> 7) & 1, tile = (idx >> 8) % (S / 32), bh = idx / (256 * (S / 32));
    const int b = bh >> 3, h = bh & 7, hh = ln >> 5, delta = mb * 32 + (ln & 31);
    float v[8];
#pragma unroll
    for (int j = 0; j < 8; ++j) { const int kappa = 16 * ks + 8 * (j >> 2) + 4 * hh + (j & 3), s = tile * 32 + kappa; v[j] = bf2f(p.projb()[(size_t)(b * S + s) * INW + OFF_VM + h * 64 + delta]); }
    uint4 o; o.x = pk_bf16(v[0], v[1]); o.y = pk_bf16(v[2], v[3]); o.z = pk_bf16(v[4], v[5]); o.w = pk_bf16(v[6], v[7]);
    *(uint4*)(p.Vm() + (size_t)idx * 8) = o;
  }
  for (int idx = gtid; idx < 2 * NB * 4 * (S / 32) * 256; idx += ngt) {
    const int ln = idx & 63, ks = (idx >> 6) & 1, blk = (idx >> 7) & 1, tile = (idx >> 8) % (S / 32), rest = idx / (256 * (S / 32)), bh = rest % (NB * 4), which = rest / (NB * 4);
    const int b = bh >> 2, h = bh & 3, hh = ln >> 5, delta = blk * 32 + (ln & 31);
    const float l2g = ret_log2g(h);
    float v[8];
#pragma unroll
    for (int j = 0; j < 8; ++j) {
      const int kappa = 16 * ks + 8 * (j >> 2) + 4 * hh + (j & 3), s = tile * 32 + kappa;
      const bf16_t* row = p.projb() + (size_t)(b * S + s) * INW;
      float x;
      if (which) {
        const float a = bf2f(row[OFF_KR + h * 64 + delta]), pa = bf2f(row[OFF_KR + h * 64 + (delta ^ 32)]);
        const int i = delta & 31; const float c = p.cosr()[s * 32 + i], sn = p.sinr()[s * 32 + i];
        x = (delta < 32 ? (a * c - pa * sn) : (a * c + pa * sn)) * 0.125f * exp2f(-(float)(s & 127) * l2g);
      } else x = bf2f(row[OFF_VR + h * 64 + delta]);
      v[j] = x;
    }
    uint4 o; o.x = pk_bf16(v[0], v[1]); o.y = pk_bf16(v[2], v[3]); o.z = pk_bf16(v[4], v[5]); o.w = pk_bf16(v[6], v[7]);
    *(uint4*)((which ? p.Krv() : p.Vr()) + ((size_t)(idx % (NB * 4 * (S / 32) * 256))) * 8) = o;
  }
}
__device__ __forceinline__ void phase_kmean2(const Params& p, int gtid, int ngt) {
  for (int idx = gtid; idx < NB * 8 * 16 * 64; idx += ngt) {
    const int d = idx & 63, j = (idx >> 6) & 15, bh = idx >> 10, c = d >> 3, dj = d & 7;
    float acc = 0.f;
    for (int tl = 0; tl < 8; ++tl) {
      const bf16_t* kp = p.Km() + (((size_t)bh * (S / 32) + j * 8 + tl) * 8 + c) * 256 + dj;
#pragma unroll 8
      for (int key = 0; key < 32; ++key) acc += bf2f(kp[key * 8]);
    }
    p.kmean()[idx] = acc * (1.0f / 256.0f);
  }
}

__device__ __forceinline__ void cvt_f32_bf16(const float* __restrict__ src, bf16_t* __restrict__ dst, size_t n8, int gtid, int ngt) {
  for (size_t i = gtid; i < n8; i += ngt) {
    float4 a = *(const float4*)(src + i * 8), b4 = *(const float4*)(src + i * 8 + 4);
    uint4 o; o.x = pk_bf16(a.x, a.y); o.y = pk_bf16(a.z, a.w); o.z = pk_bf16(b4.x, b4.y); o.w = pk_bf16(b4.z, b4.w);
    *(uint4*)(dst + i * 8) = o;
  }
}
__device__ __forceinline__ int f2key(float f) { int b = __float_as_int(f); return b ^ ((b >> 31) & 0x7fffffff); }
__device__ __forceinline__ float key2f(int k) { return __int_as_float(k ^ ((k >> 31) & 0x7fffffff)); }
#define CASD(a_, b_) { int mx_ = max(a_, b_), mn_ = min(a_, b_); a_ = mx_; b_ = mn_; }
__device__ __forceinline__ void sort16_desc(int (&v)[16]) {
#pragma unroll
  for (int k = 2; k <= 16; k <<= 1)
#pragma unroll
    for (int j = k >> 1; j > 0; j >>= 1)
#pragma unroll
      for (int i = 0; i < 16; ++i) { const int l2 = i ^ j; if (l2 > i) { if ((i & k) == 0) CASD(v[i], v[l2]) else CASD(v[l2], v[i]) } }
}
__device__ __forceinline__ void merge_top16(int (&a)[16], const int (&b)[16]) {
#pragma unroll
  for (int i = 0; i < 16; ++i) a[i] = max(a[i], b[15 - i]);
#pragma unroll
  for (int j = 8; j > 0; j >>= 1)
#pragma unroll
    for (int i = 0; i < 16; ++i) { const int l2 = i ^ j; if (l2 > i) CASD(a[i], a[l2]) }
}
__device__ __forceinline__ int lut4(int w0, int w1, int w2, int w3, int i) {
  const int w = i >> 2; const int d = (w == 0) ? w0 : (w == 1) ? w1 : (w == 2) ? w2 : w3;
  return (d >> ((i & 3) * 8)) & 127;
}

__device__ __forceinline__ void phase_peer_topk(const Params& p, int l, int gw, int ngw, int lane) {
  const int n = lane & 31, hh = lane >> 5;
  const bf16_t* skl = p.skb() + (size_t)l * 16 * 128 * 64;
  for (int w = gw; w < (T / 32) * 8; w += ngw) {
    const int tg = w >> 3, h = w & 7, t = tg * 32 + n;
    int L0[16], L1[16];
#pragma unroll
    for (int c = 0; c < 2; ++c) {
      const int hc = 2 * h + c;
      bf16x8 qf[4];
#pragma unroll
      for (int s = 0; s < 4; ++s) qf[s] = *(const bf16x8*)(p.qb() + (size_t)t * D + hc * 64 + 16 * s + 8 * hh);
      int A[16], Bq[16];
#pragma unroll
      for (int mb = 0; mb < 4; ++mb) {
        f32x16 X;
#pragma unroll
        for (int r = 0; r < 16; ++r) X[r] = 0.f;
#pragma unroll
        for (int s = 0; s < 4; ++s) {
          const bf16x8 kf = *(const bf16x8*)(skl + ((size_t)(hc * 128 + mb * 32 + n)) * 64 + 16 * s + 8 * hh);
          X = __builtin_amdgcn_mfma_f32_32x32x16_bf16(kf, qf[s], X, 0, 0, 0);
        }
        int Gk[16];
#pragma unroll
        for (int r = 0; r < 16; ++r) Gk[r] = (f2key(X[r]) & ~127) | (mb * 32 + (r & 3) + 8 * (r >> 2) + 4 * hh);
        sort16_desc(Gk);
        if (mb == 0) {
#pragma unroll
          for (int r = 0; r < 16; ++r) A[r] = Gk[r];
        } else merge_top16(A, Gk);
      }
#pragma unroll
      for (int r = 0; r < 16; ++r) Bq[r] = __shfl_xor(A[r], 32);
      merge_top16(A, Bq);
#pragma unroll
      for (int r = 0; r < 16; ++r) { if (c == 0) L0[r] = A[r]; else L1[r] = A[r]; }
    }
    float av[16], bv[16];
#pragma unroll
    for (int r = 0; r < 16; ++r) { av[r] = key2f(L0[r] & ~127); bv[r] = key2f(L1[r] & ~127); }
#define CAND(i_, j_) ((f2key(av[i_] + bv[j_]) & ~255) | ((i_) << 4) | (j_))
    int R[16], G1[16], G2[16];
#pragma unroll
    for (int j = 0; j < 16; ++j) R[j] = CAND(0, j);
    G1[0] = CAND(1, 0); G1[1] = CAND(1, 1); G1[2] = CAND(1, 2); G1[3] = CAND(1, 3); G1[4] = CAND(1, 4); G1[5] = CAND(1, 5); G1[6] = CAND(1, 6); G1[7] = CAND(1, 7);
    G1[8] = CAND(2, 0); G1[9] = CAND(2, 1); G1[10] = CAND(2, 2); G1[11] = CAND(2, 3); G1[12] = CAND(2, 4); G1[13] = CAND(3, 0); G1[14] = CAND(3, 1); G1[15] = CAND(3, 2);
    G2[0] = CAND(3, 3); G2[1] = CAND(4, 0); G2[2] = CAND(4, 1); G2[3] = CAND(4, 2); G2[4] = CAND(5, 0); G2[5] = CAND(5, 1); G2[6] = CAND(6, 0); G2[7] = CAND(6, 1);
    G2[8] = CAND(7, 0); G2[9] = CAND(7, 1); G2[10] = CAND(8, 0); G2[11] = CAND(9, 0); G2[12] = CAND(10, 0); G2[13] = CAND(11, 0); G2[14] = CAND(12, 0); G2[15] = CAND(13, 0);
    sort16_desc(G1); merge_top16(R, G1);
    sort16_desc(G2); merge_top16(R, G2);
    { int x0 = CAND(14, 0), x1 = CAND(15, 0);
#pragma unroll
      for (int i = 0; i < 16; ++i) CASD(R[i], x0)
#pragma unroll
      for (int i = 0; i < 16; ++i) CASD(R[i], x1)
    }
#undef CAND
    int pa0 = 0, pa1 = 0, pa2 = 0, pa3 = 0, pb0 = 0, pb1 = 0, pb2 = 0, pb3 = 0;
#pragma unroll
    for (int q = 0; q < 4; ++q) {
      pa0 |= (L0[q] & 127) << (8 * q); pa1 |= (L0[4 + q] & 127) << (8 * q); pa2 |= (L0[8 + q] & 127) << (8 * q); pa3 |= (L0[12 + q] & 127) << (8 * q);
      pb0 |= (L1[q] & 127) << (8 * q); pb1 |= (L1[4 + q] & 127) << (8 * q); pb2 |= (L1[8 + q] & 127) << (8 * q); pb3 |= (L1[12 + q] & 127) << (8 * q);
    }
    float ev[16], sum = 0.f; int ei[16];
    const float mx = key2f(R[0] & ~255);
#pragma unroll
    for (int z = 0; z < 16; ++z) {
      const float v = key2f(R[z] & ~255);
      ev[z] = __expf(v - mx); sum += ev[z];
      const int pay = R[z] & 255;
      ei[z] = lut4(pa0, pa1, pa2, pa3, pay >> 4) * 128 + lut4(pb0, pb1, pb2, pb3, pay & 15);
    }
    const float inv = 1.0f / sum;
    if (hh == 0) {
      float* go = p.gates() + ((size_t)t * 8 + h) * 16; int* eo = p.eidx() + ((size_t)t * 8 + h) * 16;
#pragma unroll
      for (int z = 0; z < 16; z += 4) {
        *(float4*)(go + z) = make_float4(ev[z] * inv, ev[z + 1] * inv, ev[z + 2] * inv, ev[z + 3] * inv);
        *(int4*)(eo + z) = make_int4(ei[z], ei[z + 1], ei[z + 2], ei[z + 3]);
      }
    }
  }
}


typedef int v8i __attribute__((ext_vector_type(8)));
__device__ __forceinline__ unsigned xcc_id() { return (unsigned)__builtin_amdgcn_s_getreg((3 << 11) | 20) & 7u; }
__device__ __forceinline__ float pow2_scale(float amax) {
  if (!(amax > 0.f)) return 1.0f;
  const int e = (int)floorf(log2f(240.0f / amax));
  return exp2f((float)(e < 60 ? (e > -60 ? e : -60) : 60));
}
__device__ __forceinline__ unsigned pack4_fp8(float a, float b, float c, float d) {
  int v = __builtin_amdgcn_cvt_pk_fp8_f32(a, b, 0, false);
  v = __builtin_amdgcn_cvt_pk_fp8_f32(c, d, v, true);
  return (unsigned)v;
}
__device__ __forceinline__ void cvt_table_fp8(const float* __restrict__ src, unsigned char* __restrict__ dst, float* __restrict__ scl, int gw, int ngw, int lane) {
  for (int e0 = gw; e0 < 16384; e0 += 2 * ngw) {
    float4 v[2][4];
#pragma unroll
    for (int u = 0; u < 2; ++u) { const int e = (e0 + u * ngw < 16384) ? e0 + u * ngw : e0;
#pragma unroll
      for (int k = 0; k < 4; ++k) v[u][k] = *(const float4*)(src + (size_t)e * D + k * 256 + lane * 4); }
#pragma unroll
    for (int u = 0; u < 2; ++u) {
      const int e = e0 + u * ngw;
      if (e < 16384) {
        float am = 0.f;
#pragma unroll
        for (int k = 0; k < 4; ++k) am = fmaxf(am, fmaxf(fmaxf(fabsf(v[u][k].x), fabsf(v[u][k].y)), fmaxf(fabsf(v[u][k].z), fabsf(v[u][k].w))));
        am = wave_max(am);
        const float s = pow2_scale(am);
        if (lane == 0) scl[e] = s;
#pragma unroll
        for (int k = 0; k < 4; ++k) {
          const int slice = 2 * k + (lane >> 5), off = (lane & 31) * 4;
          *(unsigned*)(dst + ((size_t)slice * 16384 + e) * 128 + off) = pack4_fp8(v[u][k].x * s, v[u][k].y * s, v[u][k].z * s, v[u][k].w * s);
        }
      }
    }
  }
}
#define DPP_ADD(v_, ctrl_) ((v_) + __builtin_bit_cast(float, __builtin_amdgcn_update_dpp(0, __builtin_bit_cast(int, (v_)), (ctrl_), 0xF, 0xF, true)))
__device__ __forceinline__ float sum_xor16(float x) { float a = x, b = x; asm volatile("v_nop\n\tv_nop\n\tv_permlane16_swap_b32 %0, %1" : "+v"(a), "+v"(b)); return a + b; }
__device__ __forceinline__ float sum_xor32(float x) { float a = x, b = x; asm volatile("v_nop\n\tv_nop\n\tv_permlane32_swap_b32 %0, %1" : "+v"(a), "+v"(b)); return a + b; }
constexpr int PEER_TILE = 128;
__device__ __forceinline__ void phase_peer_u(const Params& p, int* heads, unsigned char* lds, int tid) {
  const int lane = tid & 63, wv = tid >> 6, r8 = lane >> 3, c8 = lane & 7;
  int* bc = (int*)lds;
  int* eW = (int*)(lds + 1024 + wv * 12288);
  bf16_t* hW = (bf16_t*)(lds + 1024 + wv * 12288 + 8192);
  const int myx = (int)xcc_id();
  for (int pass = 0; pass < 8; ++pass) {
    const int s = (myx + pass) & 7;
    const unsigned char* Us = p.U8s() + (size_t)s * 16384 * 128 + c8 * 16;
    for (;;) {
      const int item = q_pull(heads + s, T / PEER_TILE, bc, tid);
      if (item < 0) break;
      const int t0 = item * PEER_TILE + wv * 16;
      LDS_FENCE();
      { uint2 ev[16];
        const bf16_t* hsrc = p.hb() + ((size_t)s * T + t0) * 128 + lane * 8;
#pragma unroll
        for (int k = 0; k < 16; ++k) ev[k] = *(const uint2*)(p.eidx() + (size_t)(t0 + k) * 128 + lane * 2);
        const uint4 hq0 = *(const uint4*)(hsrc), hq1 = *(const uint4*)(hsrc + 512), hq2 = *(const uint4*)(hsrc + 1024), hq3 = *(const uint4*)(hsrc + 1536);
#pragma unroll
        for (int k = 0; k < 16; ++k) *(uint2*)(eW + k * 128 + lane * 2) = ev[k];
        *(uint4*)(hW + lane * 8) = hq0; *(uint4*)(hW + 512 + lane * 8) = hq1; *(uint4*)(hW + 1024 + lane * 8) = hq2; *(uint4*)(hW + 1536 + lane * 8) = hq3; }
      LDS_FENCE();
      uint4 R[4][8];
#define PEER_U_LOAD(M_, BUF_) { _Pragma("unroll") for (int eb = 0; eb < 8; ++eb) R[BUF_][eb] = *(const uint4*)(Us + (size_t)eW[(M_) * 64 + eb * 8 + r8] * 128); }
      PEER_U_LOAD(0, 0) PEER_U_LOAD(1, 1) PEER_U_LOAD(2, 2)
      float hv[16]; float res0 = 0.f, res1 = 0.f;
#define PEER_U_LOADH(TOK_) { const bf16_t* hp = hW + (TOK_) * 128 + c8 * 16; const uint4 a = *(const uint4*)hp, b4 = *(const uint4*)(hp + 8); \
        const unsigned w8[8] = {a.x, a.y, a.z, a.w, b4.x, b4.y, b4.z, b4.w};                                                              \
        _Pragma("unroll") for (int z = 0; z < 8; ++z) { hv[2 * z] = __uint_as_float(w8[z] << 16); hv[2 * z + 1] = __uint_as_float(w8[z] & 0xffff0000u); } }
      PEER_U_LOADH(0)
#define PEER_U_HALF(M_, BUF_, HALF_)                                                                           \
      {                                                                                                                                   \
        if ((M_) + 3 < 32) PEER_U_LOAD((M_) + 3, ((BUF_) + 3) & 3)                                                                        \
        _Pragma("unroll") for (int eb = 0; eb < 8; ++eb) {                                                                                \
          const unsigned ww[4] = {R[BUF_][eb].x, R[BUF_][eb].y, R[BUF_][eb].z, R[BUF_][eb].w};                                            \
          float d = 0.f;                                                                                                                  \
          _Pragma("unroll") for (int q4 = 0; q4 < 4; ++q4) {                                                                              \
            const auto f01 = __builtin_amdgcn_cvt_pk_f32_fp8((int)ww[q4], false); const auto f23 = __builtin_amdgcn_cvt_pk_f32_fp8((int)ww[q4], true); \
            d = fmaf(hv[q4 * 4 + 0], f01[0], d); d = fmaf(hv[q4 * 4 + 1], f01[1], d); d = fmaf(hv[q4 * 4 + 2], f23[0], d); d = fmaf(hv[q4 * 4 + 3], f23[1], d); \
          }                                                                                                                               \
          d = DPP_ADD(d, 0xB1); d = DPP_ADD(d, 0x4E); d = DPP_ADD(d, 0x141);     \
          if ((HALF_) == 0) { if (c8 == eb) res0 = d; } else { if (c8 == eb) res1 = d; }                                                  \
        }                                                                                                                                 \
        if ((HALF_) == 1) {                                                                                                               \
          float* po = p.ppart() + ((size_t)s * T + t0 + ((M_) >> 1)) * 128;                                                               \
          po[c8 * 8 + r8] = res0; po[64 + c8 * 8 + r8] = res1;                                                                            \
          if ((M_) + 1 < 32) PEER_U_LOADH(((M_) >> 1) + 1)                                                                                \
        }                                                                                                                                 \
      }
#pragma unroll
      for (int m4 = 0; m4 < 32; m4 += 4) {
        PEER_U_HALF(m4, 0, 0) PEER_U_HALF(m4 + 1, 1, 1) PEER_U_HALF(m4 + 2, 2, 0) PEER_U_HALF(m4 + 3, 3, 1)
      }
#undef PEER_U_HALF
#undef PEER_U_LOADH
#undef PEER_U_LOAD
    }
  }
}
__device__ __forceinline__ void phase_peer_r(const Params& p, int gtid, int ngt) {
  for (int idx0 = gtid; idx0 < T * 128; idx0 += 4 * ngt) {
    float d[4]; int e[4]; float su_[4], sv_[4], g_[4]; bool ok[4];
#pragma unroll
    for (int u = 0; u < 4; ++u) { const int idx = idx0 + u * ngt; ok[u] = idx < T * 128; const int ix = ok[u] ? idx : 0;
      e[u] = p.eidx()[ix]; g_[u] = p.gates()[ix]; float a = 0.f;
#pragma unroll
      for (int s = 0; s < 8; ++s) a += p.ppart()[(size_t)s * T * 128 + ix];
      d[u] = a; }
#pragma unroll
    for (int u = 0; u < 4; ++u) { su_[u] = p.su()[e[u]]; sv_[u] = p.sv()[e[u]]; }
#pragma unroll
    for (int u = 0; u < 4; ++u) if (ok[u]) p.gates()[idx0 + u * ngt] = g_[u] * gelu_tanh(d[u] * p.rstd()[(idx0 + u * ngt) >> 7] / su_[u]) / sv_[u];
  }
}
__device__ __forceinline__ void phase_peer_v(const Params& p, int* heads, unsigned char* lds, int tid) {
  const int lane = tid & 63, wv = tid >> 6, r8 = lane >> 3, c8 = lane & 7;
  int* bc = (int*)lds;
  uint2* pW = (uint2*)(lds + 1024 + wv * 16384);
  const int myx = (int)xcc_id();
  for (int pass = 0; pass < 8; ++pass) {
    const int s = (myx + pass) & 7;
    const unsigned char* Vs = p.V8s() + (size_t)s * 16384 * 128 + c8 * 16;
    for (;;) {
      const int item = q_pull(heads + s, T / PEER_TILE, bc, tid);
      if (item < 0) break;
      const int t0 = item * PEER_TILE + wv * 16;
      LDS_FENCE();
      { uint2 e2[16], g2[16];
#pragma unroll
        for (int k = 0; k < 16; ++k) { e2[k] = *(const uint2*)(p.eidx() + (size_t)(t0 + k) * 128 + lane * 2); g2[k] = *(const uint2*)(p.gates() + (size_t)(t0 + k) * 128 + lane * 2); }
#pragma unroll
        for (int k = 0; k < 16; ++k) *(uint4*)(pW + k * 128 + lane * 2) = make_uint4(e2[k].x, g2[k].x, e2[k].y, g2[k].y); }
      LDS_FENCE();
      const int rowk = lane >> 4, prow = ((rowk & 1) << 1) | (rowk >> 1);
      const bool wr_lane = (lane & 8) == 0;
      const int xoff = s * 128 + c8 * 16 + prow * 4;
      float4 xo[8];
#pragma unroll
      for (int k = 0; k < 8; ++k) xo[k] = *(const float4*)(p.outp() + (size_t)(t0 + k) * D + xoff);
      uint4 R[3][8];
#define PEER_V_LOAD(M_, BUF_) { _Pragma("unroll") for (int eb = 0; eb < 8; ++eb) R[BUF_][eb] = *(const uint4*)(Vs + (size_t)pW[(M_) * 64 + eb * 8 + r8].x * 128); }
      PEER_V_LOAD(0, 0) PEER_V_LOAD(1, 1)
      float acc[16];
#define PEER_V_HALF(M_, BUF_, HALF_)                                                           \
      {                                                                                                                                   \
        if ((M_) + 2 < 32) PEER_V_LOAD((M_) + 2, ((BUF_) + 2) % 3)                                                                        \
        if ((HALF_) == 0) { _Pragma("unroll") for (int z = 0; z < 16; ++z) acc[z] = 0.f; }                                                \
        _Pragma("unroll") for (int eb = 0; eb < 8; ++eb) {                                                                                \
          const float c = __uint_as_float(pW[(M_) * 64 + eb * 8 + r8].y);                                                                 \
          const unsigned ww[4] = {R[BUF_][eb].x, R[BUF_][eb].y, R[BUF_][eb].z, R[BUF_][eb].w};                                            \
          _Pragma("unroll") for (int q4 = 0; q4 < 4; ++q4) {                                                                              \
            const auto f01 = __builtin_amdgcn_cvt_pk_f32_fp8((int)ww[q4], false); const auto f23 = __builtin_amdgcn_cvt_pk_f32_fp8((int)ww[q4], true); \
            acc[q4 * 4 + 0] = fmaf(c, f01[0], acc[q4 * 4 + 0]); acc[q4 * 4 + 1] = fmaf(c, f01[1], acc[q4 * 4 + 1]);                       \
            acc[q4 * 4 + 2] = fmaf(c, f23[0], acc[q4 * 4 + 2]); acc[q4 * 4 + 3] = fmaf(c, f23[1], acc[q4 * 4 + 3]);                       \
          }                                                                                                                               \
        }                                                                                                                                 \
        if ((HALF_) == 1) {                                                                                                               \
          _Pragma("unroll") for (int z = 0; z < 16; ++z) acc[z] = DPP_ADD(acc[z], 0x128);                                  \
          asm volatile("v_nop\n\tv_nop\n\tv_permlane16_swap_b32 %0, %8\n\tv_permlane16_swap_b32 %1, %9\n\tv_permlane16_swap_b32 %2, %10\n\tv_permlane16_swap_b32 %3, %11\n\t" \
                       "v_permlane16_swap_b32 %4, %12\n\tv_permlane16_swap_b32 %5, %13\n\tv_permlane16_swap_b32 %6, %14\n\tv_permlane16_swap_b32 %7, %15" \
            : "+v"(acc[0]), "+v"(acc[1]), "+v"(acc[2]), "+v"(acc[3]), "+v"(acc[4]), "+v"(acc[5]), "+v"(acc[6]), "+v"(acc[7]),                   \
              "+v"(acc[8]), "+v"(acc[9]), "+v"(acc[10]), "+v"(acc[11]), "+v"(acc[12]), "+v"(acc[13]), "+v"(acc[14]), "+v"(acc[15]));               \
          _Pragma("unroll") for (int z = 0; z < 8; ++z) acc[z] += acc[z + 8];            \
          asm volatile("v_nop\n\tv_nop\n\tv_permlane32_swap_b32 %0, %4\n\tv_permlane32_swap_b32 %1, %5\n\tv_permlane32_swap_b32 %2, %6\n\tv_permlane32_swap_b32 %3, %7" \
            : "+v"(acc[0]), "+v"(acc[1]), "+v"(acc[2]), "+v"(acc[3]), "+v"(acc[4]), "+v"(acc[5]), "+v"(acc[6]), "+v"(acc[7]));                   \
          float4 dl;                                                                                                                      \
          dl.x = acc[0] + acc[4]; dl.y = acc[1] + acc[5]; dl.z = acc[2] + acc[6]; dl.w = acc[3] + acc[7];     \
          const float4 xv = xo[((M_) >> 1) & 7];                                                                                          \
          if (((M_) >> 1) + 8 < 16) xo[((M_) >> 1) & 7] = *(const float4*)(p.outp() + (size_t)(t0 + ((M_) >> 1) + 8) * D + xoff);                  \
          const float4 xn = make_float4(xv.x + dl.x, xv.y + dl.y, xv.z + dl.z, xv.w + dl.w);                                              \
          float sq = 0.f;                                                                                                                 \
          if (wr_lane) {                                                                                                                  \
            *(float4*)(p.outp() + (size_t)(t0 + ((M_) >> 1)) * D + xoff) = xn;                                                             \
            *(uint2*)(p.xb() + (size_t)(t0 + ((M_) >> 1)) * KD + xoff) = make_uint2(pk_bf16(xn.x, xn.y), pk_bf16(xn.z, xn.w));     \
            sq = (xn.x * xn.x + xn.y * xn.y) + (xn.z * xn.z + xn.w * xn.w);                                                                \
          }                                                                                                                               \
          sq = DPP_ADD(sq, 0xB1); sq = DPP_ADD(sq, 0x4E); sq = DPP_ADD(sq, 0x141); sq = DPP_ADD(sq, 0x128); sq = sum_xor16(sq); sq = sum_xor32(sq);     \
          if (lane == 0) p.ssq1()[(size_t)(t0 + ((M_) >> 1)) * 8 + s] = sq;                                                               \
        }                                                                                                                                 \
      }
#pragma unroll
      for (int m6 = 0; m6 < 30; m6 += 6) {
        PEER_V_HALF(m6, 0, 0) PEER_V_HALF(m6 + 1, 1, 1) PEER_V_HALF(m6 + 2, 2, 0) PEER_V_HALF(m6 + 3, 0, 1) PEER_V_HALF(m6 + 4, 1, 0) PEER_V_HALF(m6 + 5, 2, 1)
      }
      PEER_V_HALF(30, 0, 0) PEER_V_HALF(31, 1, 1)
#undef PEER_V_HALF
#undef PEER_V_LOAD
    }
  }
}

#if PEER_CHECK
constexpr int CHK_N = 512;
__device__ __forceinline__ float* chk_x(const Params& p) { return (float*)(p.ws + WO_ybuf); }
__device__ __forceinline__ float* chk_m(const Params& p) { return (float*)(p.ws + WO_ybuf + (size_t)CHK_N * D * 4); }
__device__ __forceinline__ float* chk_g(const Params& p) { return (float*)(p.ws + WO_ybuf + (size_t)CHK_N * D * 4 + 4096); }
__device__ __forceinline__ void chk_save(const Params& p, int gtid, int ngt) {
  for (int i = gtid; i < CHK_N * D; i += ngt) chk_x(p)[i] = p.outp()[(size_t)(i / D) * 64 * D + (i % D)];
  for (int i = gtid; i < CHK_N * 128; i += ngt) chk_g(p)[i] = p.gates()[(size_t)(i / 128) * 64 * 128 + (i % 128)];
  if (gtid < 16) chk_m(p)[gtid] = 0.f;
}
__device__ __forceinline__ void chk_apply(const Params& p, int l, float* coef, int gw, int ngw, int lane) {
  const float* g2 = p.inp(16) + l * D;
  const float* U = p.inp(19) + (size_t)l * 16384 * D; const float* V = p.inp(20) + (size_t)l * 16384 * D;
  for (int i = gw; i < CHK_N; i += ngw) {
    const int t = i * 64;
    const float r = p.rstd()[t];
    float4 hv[4];
#pragma unroll
    for (int k = 0; k < 4; ++k) {
      float4 xv = *(const float4*)(chk_x(p) + (size_t)i * D + (lane + k * 64) * 4);
      float4 gv = *(const float4*)(g2 + (lane + k * 64) * 4);
      hv[k].x = xv.x * r * gv.x; hv[k].y = xv.y * r * gv.y; hv[k].z = xv.z * r * gv.z; hv[k].w = xv.w * r * gv.w;
    }
    LDS_FENCE();
    for (int j = 0; j < 128; ++j) {
      const int e = p.eidx()[(size_t)t * 128 + j];
      const float4* up = (const float4*)(U + (size_t)e * D);
      float dsum = 0.f;
#pragma unroll
      for (int k = 0; k < 4; ++k) { float4 uv = up[lane + k * 64]; dsum += hv[k].x * uv.x + hv[k].y * uv.y + hv[k].z * uv.z + hv[k].w * uv.w; }
      dsum = wave_sum(dsum);
      if (lane == 0) coef[j] = chk_g(p)[(size_t)i * 128 + j] * gelu_tanh(dsum);
    }
    LDS_FENCE();
    float4 acc[4];
#pragma unroll
    for (int k = 0; k < 4; ++k) acc[k] = make_float4(0.f, 0.f, 0.f, 0.f);
    for (int j = 0; j < 128; ++j) {
      const int e = p.eidx()[(size_t)t * 128 + j];
      const float c = coef[j];
      const float4* vp = (const float4*)(V + (size_t)e * D);
#pragma unroll
      for (int k = 0; k < 4; ++k) { float4 vv = vp[lane + k * 64]; acc[k].x = fmaf(c, vv.x, acc[k].x); acc[k].y = fmaf(c, vv.y, acc[k].y); acc[k].z = fmaf(c, vv.z, acc[k].z); acc[k].w = fmaf(c, vv.w, acc[k].w); }
    }
    float d2 = 0.f, r2 = 0.f;
#pragma unroll
    for (int k = 0; k < 4; ++k) {
      float4 xa = *(const float4*)(p.outp() + (size_t)t * D + (lane + k * 64) * 4);
      float4 xb4 = *(const float4*)(chk_x(p) + (size_t)i * D + (lane + k * 64) * 4);
      float e0 = (xa.x - xb4.x) - acc[k].x, e1 = (xa.y - xb4.y) - acc[k].y, e2 = (xa.z - xb4.z) - acc[k].z, e3 = (xa.w - xb4.w) - acc[k].w;
      d2 += e0 * e0 + e1 * e1 + e2 * e2 + e3 * e3;
      r2 += acc[k].x * acc[k].x + acc[k].y * acc[k].y + acc[k].z * acc[k].z + acc[k].w * acc[k].w;
    }
    d2 = wave_sum(d2); r2 = wave_sum(r2);
    if (lane == 0) { atomicAdd((unsigned long long*)&chk_m(p)[8], (unsigned long long)(d2 * 1099511627776.0f)); atomicAdd((unsigned long long*)&chk_m(p)[10], (unsigned long long)(r2 * 1099511627776.0f)); }
  }
}
__device__ __forceinline__ void chk_topk(const Params& p, int l, int gtid, int ngt) {
  const float* subk = p.inp(18) + (size_t)l * 16 * 128 * 64;
  for (int it = gtid; it < CHK_N * 8; it += ngt) {
    const int i = it >> 3, h = it & 7, t = i * 64;
    float tva[16], tvb[16]; int tia[16], tib[16];
#pragma unroll 1
    for (int c = 0; c < 2; ++c) {
      float tv[16]; int ti[16];
#pragma unroll
      for (int z = 0; z < 16; ++z) { tv[z] = -INFINITY; ti[z] = 0; }
      const bf16_t* q = p.qb() + (size_t)t * D + (2 * h + c) * 64;
      const float* kb = subk + (size_t)(2 * h + c) * 128 * 64;
#pragma unroll 1
      for (int n = 0; n < 128; ++n) {
        float sc = 0.f;
        for (int d = 0; d < 64; ++d) sc = fmaf(bf2f(q[d]), kb[n * 64 + d], sc);
        float v_ = sc; int i_ = n;
#pragma unroll
        for (int z = 0; z < 16; ++z) { bool gt = v_ > tv[z]; float a = tv[z]; int b = ti[z]; tv[z] = gt ? v_ : a; ti[z] = gt ? i_ : b; v_ = gt ? a : v_; i_ = gt ? b : i_; }
      }
#pragma unroll
      for (int z = 0; z < 16; ++z) { if (c == 0) { tva[z] = tv[z]; tia[z] = ti[z]; } else { tvb[z] = tv[z]; tib[z] = ti[z]; } }
    }
    float tv[16]; int ti[16];
#pragma unroll
    for (int z = 0; z < 16; ++z) { tv[z] = -INFINITY; ti[z] = 0; }
#pragma unroll 1
    for (int a = 0; a < 16; ++a)
#pragma unroll 1
      for (int b = 0; b < 16; ++b) {
        float av = 0.f, bv = 0.f; int ai = 0, bi = 0;
#pragma unroll
        for (int z = 0; z < 16; ++z) { if (z == a) { av = tva[z]; ai = tia[z]; } if (z == b) { bv = tvb[z]; bi = tib[z]; } }
        float v_ = av + bv; int i_ = ai * 128 + bi;
#pragma unroll
        for (int z = 0; z < 16; ++z) { bool gt = v_ > tv[z]; float x = tv[z]; int y = ti[z]; tv[z] = gt ? v_ : x; ti[z] = gt ? i_ : y; v_ = gt ? x : v_; i_ = gt ? y : i_; }
      }
    float sum = 0.f, ev[16];
#pragma unroll
    for (int z = 0; z < 16; ++z) { ev[z] = expf(tv[z] - tv[0]); sum += ev[z]; }
    int miss = 0; float gerr = 0.f;
    for (int z = 0; z < 16; ++z) {
      const int ef = p.eidx()[((size_t)t * 8 + h) * 16 + z]; const float gf = p.gates()[((size_t)t * 8 + h) * 16 + z];
      bool found = false;
#pragma unroll
      for (int y = 0; y < 16; ++y) if (ti[y] == ef) { found = true; gerr = fmaxf(gerr, fabsf(ev[y] / sum - gf)); }
      if (!found) ++miss;
    }
    atomicAdd(&chk_m(p)[3], (float)miss);
    atomicMax((int*)&chk_m(p)[4], __float_as_int(gerr));
  }
}
__device__ __forceinline__ void chk_emit(const Params& p) {
  float v = 0.f;
  if (PEER_CHECK == 1) v = sqrtf((float)((double)*(unsigned long long*)&chk_m(p)[8] / (double)*(unsigned long long*)&chk_m(p)[10]));
  if (PEER_CHECK == 2) v = chk_m(p)[3] / (float)(CHK_N * 8 * 16);
  if (PEER_CHECK == 3) v = chk_m(p)[4];
  p.outp()[0] += 1.0e4f * v + 100.0f;
}
#endif

#define XB_TMO      128
#define XB_XCNT(j)  (256  + 64 * (j))
#define XB_XSUB(j)  (1280 + 64 * (j))
#define XB_XGEN(j)  (2304 + 64 * (j))
#define XB_TOP      3328
#define XB_TOPGEN   3392
#define XCD_BAR_WORDS 3456
#define XB_SPIN_CAP (1u << 18)
#define LAS __attribute__((address_space(3)))

__device__ __forceinline__ unsigned xb_ld(unsigned* p)              { return __hip_atomic_load(p, __ATOMIC_RELAXED, __HIP_MEMORY_SCOPE_AGENT); }
__device__ __forceinline__ unsigned xb_add(unsigned* p, unsigned v) { return __hip_atomic_fetch_add(p, v, __ATOMIC_RELAXED, __HIP_MEMORY_SCOPE_AGENT); }
__device__ __forceinline__ unsigned xb_xcc_id() { return (unsigned)__builtin_amdgcn_s_getreg((3 << 11) | 20) & 0xFu; }
#define XB_SPIN(cond, bar) do { unsigned _sp = 0; while (cond) { __builtin_amdgcn_s_sleep(1); \
    if ((++_sp & 255u) == 0u) { if (xb_ld(&(bar)[XB_TMO])) break; if (_sp > XB_SPIN_CAP) { atomicAdd(&(bar)[XB_TMO], 1u); break; } } } } while (0)

struct XcdBarrier {
    unsigned* bar; unsigned x;
    volatile LAS unsigned* st;
};

__device__ __forceinline__ XcdBarrier xcd_barrier_post(unsigned* bar, volatile LAS unsigned* st) {
    XcdBarrier b; b.bar = bar; b.x = xb_xcc_id(); b.st = st;
    if (threadIdx.x == 0) (void)xb_add(&bar[XB_XCNT(b.x)], 1u);
    return b;
}
__device__ __forceinline__ void xcd_barrier_complete(unsigned* bar, unsigned x, unsigned& nloc, unsigned& nx) {
    const unsigned G = gridDim.x * gridDim.y * gridDim.z;
    unsigned sum, cnt, mine, sp = 0u;
    for (;;) {
        sum = 0u; cnt = 0u; mine = 0u;
#pragma unroll
        for (unsigned j = 0; j < 16; ++j) { const unsigned c = xb_ld(&bar[XB_XCNT(j)]); sum += c; cnt += (c > 0u) ? 1u : 0u; mine = (j == x) ? c : mine; }
        if (sum == G) break;
        __builtin_amdgcn_s_sleep(1);
        if ((++sp & 255u) == 0u) { if (xb_ld(&bar[XB_TMO])) break; if (sp > XB_SPIN_CAP) { atomicAdd(&bar[XB_TMO], 1u); break; } }
    }
    nloc = mine > 0u ? mine : 1u; nx = cnt > 0u ? cnt : 1u;
}

__device__ __forceinline__ void xcd_barrier(const XcdBarrier& b) {
    asm volatile("s_waitcnt vmcnt(0)" ::: "memory");
    __syncthreads();
    if (threadIdx.x == 0) {
        unsigned* bar = b.bar;
        __builtin_amdgcn_s_waitcnt(0);
        unsigned nloc = b.st[0], nx = b.st[1];
        if (nloc == 0u) { xcd_barrier_complete(bar, b.x, nloc, nx); b.st[0] = nloc; b.st[1] = nx; }
        const unsigned old = xb_add(&bar[XB_XSUB(b.x)], 1u);
        const unsigned gen = old / nloc;
        if (old + 1u == (gen + 1u) * nloc) {
            __builtin_amdgcn_fence(__ATOMIC_RELEASE, "agent");
            asm volatile("s_waitcnt vmcnt(0)" ::: "memory");
            const unsigned og = xb_add(&bar[XB_TOP], 1u);
            const unsigned tg = og / nx;
            if (og + 1u == (tg + 1u) * nx) xb_add(&bar[XB_TOPGEN], 1u);
            else XB_SPIN(xb_ld(&bar[XB_TOPGEN]) == tg, bar);
            __builtin_amdgcn_fence(__ATOMIC_ACQUIRE, "agent");
            xb_add(&bar[XB_XGEN(b.x)], 1u);
            asm volatile("s_waitcnt vmcnt(0)" ::: "memory");
        } else {
            XB_SPIN(xb_ld(&bar[XB_XGEN(b.x)]) == gen, bar);
            __builtin_amdgcn_fence(__ATOMIC_ACQUIRE, "agent");
            asm volatile("s_waitcnt vmcnt(0)" ::: "memory");
        }
    }
    __syncthreads();
}

__device__ __forceinline__ Params fresh(const Params& p) {
  Params q = p;
  asm volatile("" : "+s"(q.ws), "+s"(q.out_));
#pragma unroll
  for (int i = 0; i < 21; ++i) asm volatile("" : "+s"(q.in[i]));
  return q;
}
#define PHASE_IDS int tid = threadIdx.x; asm volatile("" : "+v"(tid)); int bid = blockIdx.x; asm volatile("" : "+s"(bid)); int G = gridDim.x; asm volatile("" : "+s"(G)); \
  const int lane = tid & 63, wv = tid >> 6; const int ngt = G * NTHR, ngw = G * NWAVE; \
  const int gtid = bid * NTHR + tid, gw = bid * NWAVE + wv; (void)lane; (void)wv; (void)gtid; (void)gw; (void)ngt; (void)ngw; \
  const Params q = fresh(p);
__global__ void __launch_bounds__(NTHR) mega(Params p) {
  extern __shared__ __attribute__((aligned(16))) unsigned char lds_raw[];
  cg::grid_group grid = cg::this_grid();
  float* ldsf = (float*)lds_raw;
  if (threadIdx.x == 0) { *(uint4*)(lds_raw + LDS_BYTES - 16) = make_uint4(0u, 0u, 0u, 0u); }
  __syncthreads();
  XcdBarrier xb = xcd_barrier_post(p.bar(), (volatile LAS unsigned*)(lds_raw + LDS_BYTES - 16));

  { PHASE_IDS; phase_prologue(q, gtid, ngt, gw, ngw, lane); cvt_f32_bf16(q.inp(18), q.skb(), (size_t)NL * 16 * 128 * 64 / 8, gtid, ngt);
    for (size_t i = gtid; i < (size_t)16 * 128 * 512 / 8; i += ngt) { const size_t g = i / (128 * 512 / 8), r = i % (128 * 512 / 8); ((uint4*)q.S5Wz())[g * (256 * 512 / 8) + (128 * 512 / 8) + r] = make_uint4(0u, 0u, 0u, 0u); }
    if (gtid < 256) q.qctr()[gtid] = 0;
    phase_s5_prep(q, 0, gtid, ngt); }
  grid.sync();
  { constexpr int l = 0;
    DUP(5) {
    { const Params q = fresh(p); EpiScaleStoreBf16 e{q.projb(), INW, q.ssq1(), 8, nullptr};
      run_gemm(lds_raw, q.xb(), q.Win_t() + (size_t)l * INW * KD, T, INW, KD, e); }
    xcd_barrier(xb);
    }
    DUP(0) {
    { PHASE_IDS; phase_post_pack(q, l, gtid, ngt, gw, ngw, lane); phase_pack_u(q, gtid, ngt); }
    xcd_barrier(xb);
    }
    DUP(1) {
    { const Params q = fresh(p); EpiS5Z e{q.S5Z()};
      pg8::Gemm g{q.S5A(), q.S5Wz(), 16 * 1024, 16 * 256, 512, 640, 512}; pg8::GroupOrder So; So.init(16, 4, 1, (int)gridDim.x, (int)blockIdx.x);
      pg8::gemm_phase<EpiS5Z, pg8::GroupOrder, true, true>((PG8_LAS unsigned char*)lds_raw, g, So, e); }
    { PHASE_IDS; phase_kmean2(q, gtid, ngt); phase_ret_kv(q, gw, ngw, lane); }
    xcd_barrier(xb);
    }
    DUP(2) {
    { PHASE_IDS; phase_s5_scan(q, gtid, ngt); phase_ret_scan(q, gtid, ngt); }
    __syncthreads();
    { PHASE_IDS; phase_moba2(q, l, lds_raw, q.qctr() + 64 + l); }
    xcd_barrier(xb);
    }
    DUP(3) {
    { const Params q = fresh(p); EpiS5Y e{q.ygb(), q.S5A(), q.inp(10) + l * 256};
      pg8::Gemm g{q.S5A(), q.S5Wy(), 16 * 1024, 16 * 512, 640, 640, 640}; pg8::GroupOrder So; So.init(16, 4, 2, (int)gridDim.x, (int)blockIdx.x);
      pg8::gemm_phase<EpiS5Y, pg8::GroupOrder, true, true>((PG8_LAS unsigned char*)lds_raw, g, So, e); }
    __syncthreads();
    { PHASE_IDS; phase_ret_out(q, gw, ngw, lane); }
    xcd_barrier(xb);
    }
    DUP(4) {
    { const Params q = fresh(p); EpiGlu e{q.xb(), q.ygb(), (float*)(lds_raw + 131072)};
      run_gemm(lds_raw, q.ygb(), q.Wglu_t() + (size_t)l * 65536, T, 256, 256, e); }
    xcd_barrier(xb);
    }
    { PHASE_IDS; cvt_table_fp8(q.inp(19) + (size_t)l * 16384 * D, q.U8s(), q.su(), gw, ngw, lane);
      cvt_table_fp8(q.inp(20) + (size_t)l * 16384 * D, q.V8s(), q.sv(), gw, ngw, lane); }
    __syncthreads();
    { const Params q = fresh(p); EpiResid e{q.outp(), D, q.xb2(), q.hb(), q.inp(16) + l * D, q.ssq2()};
      run_gemm(lds_raw, q.xb(), q.Wout_t() + (size_t)l * D * KD, T, D, KD, e); }
    xcd_barrier(xb);
    DUP(7) {
    { const Params q = fresh(p); EpiScaleStoreBf16 e{q.qb(), D, q.ssq2(), 16, q.rstd()};
      run_gemm(lds_raw, q.xb2(), q.Wq_t() + (size_t)l * D * KD, T, D, KD, e); }
    xcd_barrier(xb);
    }
    if (!(PROBE_SKIP & 2)) {
    DUP(8) {
    { PHASE_IDS; phase_peer_topk(q, l, gw, ngw, lane); }
    xcd_barrier(xb);
    }
    }
#if PEER_CHECK
    if (l == 0) { { PHASE_IDS; chk_save(q, gtid, ngt); } xcd_barrier(xb); { PHASE_IDS; chk_topk(q, l, gtid, ngt); } xcd_barrier(xb); }
#endif
    if (!(PROBE_SKIP & 1)) {
    { PHASE_IDS; phase_peer_u(q, q.qctr() + (l * 2 + 0) * 8, lds_raw, tid); }
    xcd_barrier(xb);
    { PHASE_IDS; phase_peer_r(q, gtid, ngt); if (l + 1 < NL) phase_s5_prep(q, l + 1, gtid, ngt); }
    xcd_barrier(xb);
    if (!(PROBE_SKIP & 32)) {
    { PHASE_IDS; phase_peer_v(q, q.qctr() + (l * 2 + 1) * 8, lds_raw, tid); }
    xcd_barrier(xb);
    }
    }
#if PEER_CHECK
    if (l == 0) { { PHASE_IDS; chk_apply(q, l, ldsf + wv * 128, gw, ngw, lane); } xcd_barrier(xb);
      if (blockIdx.x == 0 && threadIdx.x == 0) { const Params q = fresh(p); chk_emit(q); } xcd_barrier(xb); }
#endif
  }
  { constexpr int l = 1;
    DUP(5) {
    { const Params q = fresh(p); EpiScaleStoreBf16 e{q.projb(), INW, q.ssq1(), 8, nullptr};
      run_gemm(lds_raw, q.xb(), q.Win_t() + (size_t)l * INW * KD, T, INW, KD, e); }
    xcd_barrier(xb);
    }
    DUP(0) {
    { PHASE_IDS; phase_post_pack(q, l, gtid, ngt, gw, ngw, lane); phase_pack_u(q, gtid, ngt); }
    xcd_barrier(xb);
    }
    DUP(1) {
    { const Params q = fresh(p); EpiS5Z e{q.S5Z()};
      pg8::Gemm g{q.S5A(), q.S5Wz(), 16 * 1024, 16 * 256, 512, 640, 512}; pg8::GroupOrder So; So.init(16, 4, 1, (int)gridDim.x, (int)blockIdx.x);
      pg8::gemm_phase<EpiS5Z, pg8::GroupOrder, true, true>((PG8_LAS unsigned char*)lds_raw, g, So, e); }
    { PHASE_IDS; phase_kmean2(q, gtid, ngt); phase_ret_kv(q, gw, ngw, lane); }
    xcd_barrier(xb);
    }
    DUP(2) {
    { PHASE_IDS; phase_s5_scan(q, gtid, ngt); phase_ret_scan(q, gtid, ngt); }
    __syncthreads();
    { PHASE_IDS; phase_moba2(q, l, lds_raw, q.qctr() + 64 + l); }
    xcd_barrier(xb);
    }
    DUP(3) {
    { const Params q = fresh(p); EpiS5Y e{q.ygb(), q.S5A(), q.inp(10) + l * 256};
      pg8::Gemm g{q.S5A(), q.S5Wy(), 16 * 1024, 16 * 512, 640, 640, 640}; pg8::GroupOrder So; So.init(16, 4, 2, (int)gridDim.x, (int)blockIdx.x);
      pg8::gemm_phase<EpiS5Y, pg8::GroupOrder, true, true>((PG8_LAS unsigned char*)lds_raw, g, So, e); }
    __syncthreads();
    { PHASE_IDS; phase_ret_out(q, gw, ngw, lane); }
    xcd_barrier(xb);
    }
    DUP(4) {
    { const Params q = fresh(p); EpiGlu e{q.xb(), q.ygb(), (float*)(lds_raw + 131072)};
      run_gemm(lds_raw, q.ygb(), q.Wglu_t() + (size_t)l * 65536, T, 256, 256, e); }
    xcd_barrier(xb);
    }
    { PHASE_IDS; cvt_table_fp8(q.inp(19) + (size_t)l * 16384 * D, q.U8s(), q.su(), gw, ngw, lane);
      cvt_table_fp8(q.inp(20) + (size_t)l * 16384 * D, q.V8s(), q.sv(), gw, ngw, lane); }
    __syncthreads();
    { const Params q = fresh(p); EpiResid e{q.outp(), D, q.xb2(), q.hb(), q.inp(16) + l * D, q.ssq2()};
      run_gemm(lds_raw, q.xb(), q.Wout_t() + (size_t)l * D * KD, T, D, KD, e); }
    xcd_barrier(xb);
    DUP(7) {
    { const Params q = fresh(p); EpiScaleStoreBf16 e{q.qb(), D, q.ssq2(), 16, q.rstd()};
      run_gemm(lds_raw, q.xb2(), q.Wq_t() + (size_t)l * D * KD, T, D, KD, e); }
    xcd_barrier(xb);
    }
    if (!(PROBE_SKIP & 2)) {
    DUP(8) {
    { PHASE_IDS; phase_peer_topk(q, l, gw, ngw, lane); }
    xcd_barrier(xb);
    }
    }
#if PEER_CHECK
    if (l == 0) { { PHASE_IDS; chk_save(q, gtid, ngt); } xcd_barrier(xb); { PHASE_IDS; chk_topk(q, l, gtid, ngt); } xcd_barrier(xb); }
#endif
    if (!(PROBE_SKIP & 1)) {
    { PHASE_IDS; phase_peer_u(q, q.qctr() + (l * 2 + 0) * 8, lds_raw, tid); }
    xcd_barrier(xb);
    { PHASE_IDS; phase_peer_r(q, gtid, ngt); if (l + 1 < NL) phase_s5_prep(q, l + 1, gtid, ngt); }
    xcd_barrier(xb);
    if (!(PROBE_SKIP & 32)) {
    { PHASE_IDS; phase_peer_v(q, q.qctr() + (l * 2 + 1) * 8, lds_raw, tid); }
    xcd_barrier(xb);
    }
    }
#if PEER_CHECK
    if (l == 0) { { PHASE_IDS; chk_apply(q, l, ldsf + wv * 128, gw, ngw, lane); } xcd_barrier(xb);
      if (blockIdx.x == 0 && threadIdx.x == 0) { const Params q = fresh(p); chk_emit(q); } xcd_barrier(xb); }
#endif
  }
  { constexpr int l = 2;
    DUP(5) {
    { const Params q = fresh(p); EpiScaleStoreBf16 e{q.projb(), INW, q.ssq1(), 8, nullptr};
      run_gemm(lds_raw, q.xb(), q.Win_t() + (size_t)l * INW * KD, T, INW, KD, e); }
    xcd_barrier(xb);
    }
    DUP(0) {
    { PHASE_IDS; phase_post_pack(q, l, gtid, ngt, gw, ngw, lane); phase_pack_u(q, gtid, ngt); }
    xcd_barrier(xb);
    }
    DUP(1) {
    { const Params q = fresh(p); EpiS5Z e{q.S5Z()};
      pg8::Gemm g{q.S5A(), q.S5Wz(), 16 * 1024, 16 * 256, 512, 640, 512}; pg8::GroupOrder So; So.init(16, 4, 1, (int)gridDim.x, (int)blockIdx.x);
      pg8::gemm_phase<EpiS5Z, pg8::GroupOrder, true, true>((PG8_LAS unsigned char*)lds_raw, g, So, e); }
    { PHASE_IDS; phase_kmean2(q, gtid, ngt); phase_ret_kv(q, gw, ngw, lane); }
    xcd_barrier(xb);
    }
    DUP(2) {
    { PHASE_IDS; phase_s5_scan(q, gtid, ngt); phase_ret_scan(q, gtid, ngt); }
    __syncthreads();
    { PHASE_IDS; phase_moba2(q, l, lds_raw, q.qctr() + 64 + l); }
    xcd_barrier(xb);
    }
    DUP(3) {
    { const Params q = fresh(p); EpiS5Y e{q.ygb(), q.S5A(), q.inp(10) + l * 256};
      pg8::Gemm g{q.S5A(), q.S5Wy(), 16 * 1024, 16 * 512, 640, 640, 640}; pg8::GroupOrder So; So.init(16, 4, 2, (int)gridDim.x, (int)blockIdx.x);
      pg8::gemm_phase<EpiS5Y, pg8::GroupOrder, true, true>((PG8_LAS unsigned char*)lds_raw, g, So, e); }
    __syncthreads();
    { PHASE_IDS; phase_ret_out(q, gw, ngw, lane); }
    xcd_barrier(xb);
    }
    DUP(4) {
    { const Params q = fresh(p); EpiGlu e{q.xb(), q.ygb(), (float*)(lds_raw + 131072)};
      run_gemm(lds_raw, q.ygb(), q.Wglu_t() + (size_t)l * 65536, T, 256, 256, e); }
    xcd_barrier(xb);
    }
    { PHASE_IDS; cvt_table_fp8(q.inp(19) + (size_t)l * 16384 * D, q.U8s(), q.su(), gw, ngw, lane);
      cvt_table_fp8(q.inp(20) + (size_t)l * 16384 * D, q.V8s(), q.sv(), gw, ngw, lane); }
    __syncthreads();
    { const Params q = fresh(p); EpiResid e{q.outp(), D, q.xb2(), q.hb(), q.inp(16) + l * D, q.ssq2()};
      run_gemm(lds_raw, q.xb(), q.Wout_t() + (size_t)l * D * KD, T, D, KD, e); }
    xcd_barrier(xb);
    DUP(7) {
    { const Params q = fresh(p); EpiScaleStoreBf16 e{q.qb(), D, q.ssq2(), 16, q.rstd()};
      run_gemm(lds_raw, q.xb2(), q.Wq_t() + (size_t)l * D * KD, T, D, KD, e); }
    xcd_barrier(xb);
    }
    if (!(PROBE_SKIP & 2)) {
    DUP(8) {
    { PHASE_IDS; phase_peer_topk(q, l, gw, ngw, lane); }
    xcd_barrier(xb);
    }
    }
#if PEER_CHECK
    if (l == 0) { { PHASE_IDS; chk_save(q, gtid, ngt); } xcd_barrier(xb); { PHASE_IDS; chk_topk(q, l, gtid, ngt); } xcd_barrier(xb); }
#endif
    if (!(PROBE_SKIP & 1)) {
    { PHASE_IDS; phase_peer_u(q, q.qctr() + (l * 2 + 0) * 8, lds_raw, tid); }
    xcd_barrier(xb);
    { PHASE_IDS; phase_peer_r(q, gtid, ngt); if (l + 1 < NL) phase_s5_prep(q, l + 1, gtid, ngt); }
    xcd_barrier(xb);
    if (!(PROBE_SKIP & 32)) {
    { PHASE_IDS; phase_peer_v(q, q.qctr() + (l * 2 + 1) * 8, lds_raw, tid); }
    xcd_barrier(xb);
    }
    }
#if PEER_CHECK
    if (l == 0) { { PHASE_IDS; chk_apply(q, l, ldsf + wv * 128, gw, ngw, lane); } xcd_barrier(xb);
      if (blockIdx.x == 0 && threadIdx.x == 0) { const Params q = fresh(p); chk_emit(q); } xcd_barrier(xb); }
#endif
  }
  { constexpr int l = 3;
    DUP(5) {
    { const Params q = fresh(p); EpiScaleStoreBf16 e{q.projb(), INW, q.ssq1(), 8, nullptr};
      run_gemm(lds_raw, q.xb(), q.Win_t() + (size_t)l * INW * KD, T, INW, KD, e); }
    xcd_barrier(xb);
    }
    DUP(0) {
    { PHASE_IDS; phase_post_pack(q, l, gtid, ngt, gw, ngw, lane); phase_pack_u(q, gtid, ngt); }
    xcd_barrier(xb);
    }
    DUP(1) {
    { const Params q = fresh(p); EpiS5Z e{q.S5Z()};
      pg8::Gemm g{q.S5A(), q.S5Wz(), 16 * 1024, 16 * 256, 512, 640, 512}; pg8::GroupOrder So; So.init(16, 4, 1, (int)gridDim.x, (int)blockIdx.x);
      pg8::gemm_phase<EpiS5Z, pg8::GroupOrder, true, true>((PG8_LAS unsigned char*)lds_raw, g, So, e); }
    { PHASE_IDS; phase_kmean2(q, gtid, ngt); phase_ret_kv(q, gw, ngw, lane); }
    xcd_barrier(xb);
    }
    DUP(2) {
    { PHASE_IDS; phase_s5_scan(q, gtid, ngt); phase_ret_scan(q, gtid, ngt); }
    __syncthreads();
    { PHASE_IDS; phase_moba2(q, l, lds_raw, q.qctr() + 64 + l); }
    xcd_barrier(xb);
    }
    DUP(3) {
    { const Params q = fresh(p); EpiS5Y e{q.ygb(), q.S5A(), q.inp(10) + l * 256};
      pg8::Gemm g{q.S5A(), q.S5Wy(), 16 * 1024, 16 * 512, 640, 640, 640}; pg8::GroupOrder So; So.init(16, 4, 2, (int)gridDim.x, (int)blockIdx.x);
      pg8::gemm_phase<EpiS5Y, pg8::GroupOrder, true, true>((PG8_LAS unsigned char*)lds_raw, g, So, e); }
    __syncthreads();
    { PHASE_IDS; phase_ret_out(q, gw, ngw, lane); }
    xcd_barrier(xb);
    }
    DUP(4) {
    { const Params q = fresh(p); EpiGlu e{q.xb(), q.ygb(), (float*)(lds_raw + 131072)};
      run_gemm(lds_raw, q.ygb(), q.Wglu_t() + (size_t)l * 65536, T, 256, 256, e); }
    xcd_barrier(xb);
    }
    { PHASE_IDS; cvt_table_fp8(q.inp(19) + (size_t)l * 16384 * D, q.U8s(), q.su(), gw, ngw, lane);
      cvt_table_fp8(q.inp(20) + (size_t)l * 16384 * D, q.V8s(), q.sv(), gw, ngw, lane); }
    __syncthreads();
    { const Params q = fresh(p); EpiResid e{q.outp(), D, q.xb2(), q.hb(), q.inp(16) + l * D, q.ssq2()};
      run_gemm(lds_raw, q.xb(), q.Wout_t() + (size_t)l * D * KD, T, D, KD, e); }
    xcd_barrier(xb);
    DUP(7) {
    { const Params q = fresh(p); EpiScaleStoreBf16 e{q.qb(), D, q.ssq2(), 16, q.rstd()};
      run_gemm(lds_raw, q.xb2(), q.Wq_t() + (size_t)l * D * KD, T, D, KD, e); }
    xcd_barrier(xb);
    }
    if (!(PROBE_SKIP & 2)) {
    DUP(8) {
    { PHASE_IDS; phase_peer_topk(q, l, gw, ngw, lane); }
    xcd_barrier(xb);
    }
    }
#if PEER_CHECK
    if (l == 0) { { PHASE_IDS; chk_save(q, gtid, ngt); } xcd_barrier(xb); { PHASE_IDS; chk_topk(q, l, gtid, ngt); } xcd_barrier(xb); }
#endif
    if (!(PROBE_SKIP & 1)) {
    { PHASE_IDS; phase_peer_u(q, q.qctr() + (l * 2 + 0) * 8, lds_raw, tid); }
    xcd_barrier(xb);
    { PHASE_IDS; phase_peer_r(q, gtid, ngt); if (l + 1 < NL) phase_s5_prep(q, l + 1, gtid, ngt); }
    xcd_barrier(xb);
    if (!(PROBE_SKIP & 32)) {
    { PHASE_IDS; phase_peer_v(q, q.qctr() + (l * 2 + 1) * 8, lds_raw, tid); }
    xcd_barrier(xb);
    }
    }
#if PEER_CHECK
    if (l == 0) { { PHASE_IDS; chk_apply(q, l, ldsf + wv * 128, gw, ngw, lane); } xcd_barrier(xb);
      if (blockIdx.x == 0 && threadIdx.x == 0) { const Params q = fresh(p); chk_emit(q); } xcd_barrier(xb); }
#endif
  }
}

}

extern "C" void kernel_launch(void* const* d_in, const int* in_sizes, int n_in, void* d_out, int out_size, void* d_ws, size_t ws_size,
                              hipStream_t stream) {
  static int grid_blocks = 0;
  if (!grid_blocks) {
    int dev = 0, cus = 0, per_cu = 0;
    hipGetDevice(&dev);
    hipDeviceGetAttribute(&cus, hipDeviceAttributeMultiprocessorCount, dev);
    hipFuncSetAttribute((const void*)mega, hipFuncAttributeMaxDynamicSharedMemorySize, LDS_BYTES);
    hipOccupancyMaxActiveBlocksPerMultiprocessor(&per_cu, (const void*)mega, NTHR, LDS_BYTES);
    if (per_cu < 1) { fprintf(stderr, "occupancy query returned %d\n", per_cu); per_cu = 1; }
    grid_blocks = cus * 1;
    if (grid_blocks < 64) fprintf(stderr, "unexpected CU count %d\n", cus);
  }
  Params p{};
  for (int i = 0; i < 21; ++i) p.in[i] = (const GAS float*)d_in[i];
  p.out_ = (GAS float*)d_out;
  p.ws = (GAS unsigned char*)d_ws;
  if (WS_TOTAL > ws_size) { fprintf(stderr, "workspace too small: need %zu have %zu\n", (size_t)WS_TOTAL, ws_size); return; }
  hipMemsetAsync((unsigned char*)d_ws + WO_bar, 0, 16384, stream);
  void* args[] = {&p};
  hipError_t e = hipLaunchCooperativeKernel((const void*)mega, dim3(grid_blocks), dim3(NTHR), args, LDS_BYTES, stream);
  if (e != hipSuccess) fprintf(stderr, "cooperative launch failed: %s (grid %d)\n", hipGetErrorString(e), grid_blocks);
}
```

```cpp
#include <hip/hip_runtime.h>
#include <hip/hip_cooperative_groups.h>
#include <math.h>
#include <stdint.h>
#include <stdio.h>
namespace cg = cooperative_groups;

#ifndef PEER_CHECK
#define PEER_CHECK 0
#endif
#ifndef PROBE_DUP
#define PROBE_DUP 0
#endif
__device__ __forceinline__ int dup_n(int n) { asm volatile("" : "+s"(n)); return n; }
#define DUP(bit) _Pragma("unroll 1") for (int rep_ = 0, repn_ = (((PROBE_DUP >> (bit)) & 1) ? dup_n(2) : 1); rep_ < repn_; ++rep_)
#ifndef PROBE_SKIP
#define PROBE_SKIP 0
#endif
#ifndef PRECISE
#define PRECISE 0
#endif

namespace {
constexpr int NB = 8, S = 4096, D = 1024, NL = 4, T = NB * S;
constexpr int INW = 2816;
constexpr int OFF_U = 0, OFF_QM = 256, OFF_KM = 768, OFF_VM = 1280, OFF_QR = 1792, OFF_KR = 2048, OFF_VR = 2304, OFF_GR = 2560;
constexpr float EPS = 1e-6f;
static_assert(PRECISE == 0, "PRECISE builds are retired");
constexpr int KS = PRECISE ? 3 : 1;
constexpr int KD = D * KS;
constexpr int NTHR = 512, NWAVE = 8;
constexpr int LDS_BYTES = 131072 + 4096 + 1024;

typedef unsigned short bf16_t;
using bf16x8 = __attribute__((ext_vector_type(8))) short;
using f32x4 = __attribute__((ext_vector_type(4))) float;

__device__ __forceinline__ float wave_sum(float v) {
#pragma unroll
  for (int o = 32; o > 0; o >>= 1) v += __shfl_xor(v, o);
  return v;
}
__device__ __forceinline__ float wave_max(float v) {
#pragma unroll
  for (int o = 32; o > 0; o >>= 1) v = fmaxf(v, __shfl_xor(v, o));
  return v;
}
__device__ __forceinline__ int q_pull(int* head, int nitems, int* bc, int tid) {
  __syncthreads();
  if (tid == 0) bc[0] = atomicAdd(head, 1);
  __syncthreads();
  const int v = bc[0];
  return v < nitems ? v : -1;
}
__device__ __forceinline__ float gelu_tanh(float x) {
  const float k0 = 0.7978845608028654f, k1 = 0.044715f;
  float u = k0 * (x + k1 * x * x * x);
  return 0.5f * x * (1.0f + tanhf(u));
}
__device__ __forceinline__ float sigmoidf_(float x) { return 1.0f / (1.0f + expf(-x)); }
__device__ __forceinline__ float fast_sigmoid(float x) { return __builtin_amdgcn_rcpf(1.0f + __builtin_amdgcn_exp2f(-1.4426950408889634f * x)); }
__device__ __forceinline__ float fast_gelu(float x) { const float u = 0.7978845608028654f * (x + 0.044715f * x * x * x); return x * fast_sigmoid(2.0f * u); }
__device__ __forceinline__ bf16_t f2bf(float f) {
  unsigned u = __float_as_uint(f);
  u += 0x7fffu + ((u >> 16) & 1u);
  return (bf16_t)(u >> 16);
}
__device__ __forceinline__ float bf2f(bf16_t h) { return __uint_as_float(((unsigned)h) << 16); }
#define LDS_FENCE() asm volatile("s_waitcnt lgkmcnt(0)" ::: "memory")
typedef __bf16 bf16x2_hw __attribute__((ext_vector_type(2)));
typedef float f32x2_hw __attribute__((ext_vector_type(2)));
__device__ __forceinline__ unsigned pk_bf16(float lo, float hi) { const f32x2_hw f = {lo, hi}; const bf16x2_hw b = __builtin_convertvector(f, bf16x2_hw); return __builtin_bit_cast(unsigned, b); }
typedef float f32x16 __attribute__((ext_vector_type(16)));

constexpr size_t al256(size_t x) { return (x + 255) & ~(size_t)255; }
constexpr size_t WO_rstd = 0;
constexpr size_t WO_cosm = WO_rstd + al256((size_t)T * 4);
constexpr size_t WO_sinm = WO_cosm + al256((size_t)S * 8 * 4);
constexpr size_t WO_cosr = WO_sinm + al256((size_t)S * 8 * 4);
constexpr size_t WO_sinr = WO_cosr + al256((size_t)S * 32 * 4);
constexpr size_t WO_kmean = WO_sinr + al256((size_t)S * 32 * 4);
constexpr size_t WO_proj = WO_kmean + al256((size_t)NB * 8 * 16 * 64 * 4);
constexpr size_t WO_ybuf = WO_proj + al256((size_t)T * INW * 4);
constexpr size_t WO_yg = WO_ybuf + al256((size_t)T * D * 4);
constexpr size_t WO_skb = WO_yg + al256((size_t)T * 256 * 4);
constexpr size_t WO_Ub = WO_skb + al256((size_t)NL * 16 * 128 * 64 * 2);
constexpr size_t WO_Vb = WO_Ub + al256((size_t)16384 * D * 2);
constexpr size_t WO_gates = WO_Vb + al256((size_t)16384 * D * 2);
constexpr size_t WO_eidx = WO_gates + al256((size_t)T * 128 * 4);
constexpr size_t WO_xb = WO_eidx + al256((size_t)T * 128 * 4);
constexpr size_t WO_Win_t = WO_xb + al256((size_t)T * KD * 2);
constexpr size_t WO_Wout_t = WO_Win_t + al256((size_t)NL * INW * KD * 2);
constexpr size_t WO_Wq_t = WO_Wout_t + al256((size_t)NL * D * KD * 2);
constexpr size_t WO_Qm = WO_Wq_t + al256((size_t)NL * D * KD * 2);
constexpr size_t WO_Km = WO_Qm + al256((size_t)T * 512 * 2);
constexpr size_t WO_Vm = WO_Km + al256((size_t)T * 512 * 2);
constexpr size_t WO_S5a32 = WO_Vm + al256((size_t)T * 512 * 2);
constexpr size_t WO_Wglu_t = WO_S5a32 + al256((size_t)16 * 64 * 2 * 4);
constexpr size_t WO_Qr = WO_Wglu_t + al256((size_t)NL * 256 * 256 * 2);
constexpr size_t WO_Kr = WO_Qr + al256((size_t)T * 256 * 2);
constexpr size_t WO_Krv = WO_Kr + al256((size_t)T * 256 * 2);
constexpr size_t WO_Vr = WO_Krv + al256((size_t)T * 256 * 2);
constexpr size_t WO_KVr = WO_Vr + al256((size_t)T * 256 * 2);
constexpr size_t WO_Rb = WO_KVr + al256((size_t)32 * 32 * 4096 * 4);
constexpr size_t WO_qctr = WO_Rb + al256((size_t)32 * 32 * 4096 * 2);
constexpr size_t WO_bar = WO_qctr + al256(1024);
constexpr size_t WO_S5Wy = WO_bar + al256(16384);
constexpr size_t WO_S5Wz = WO_S5Wy + al256((size_t)16 * 512 * 640 * 2);
constexpr size_t WO_ssq1 = WO_S5Wz + al256((size_t)16 * 256 * 512 * 2);
constexpr size_t WO_ssq2 = WO_ssq1 + al256((size_t)T * 8 * 4);
constexpr size_t WS_TOTAL = WO_ssq2 + al256((size_t)T * 16 * 4);
constexpr size_t WO_S5A = WO_gates;
constexpr size_t WO_S5Z = WO_S5A + al256((size_t)16 * 1024 * 640 * 2);
static_assert(WO_S5Z + (size_t)16 * 1024 * 128 * 4 <= WO_gates + 2 * al256((size_t)T * 128 * 4), "S5A/S5Z must fit in gates+eidx");
#define GAS __attribute__((address_space(1)))
static_assert((size_t)T * D * 2 + (size_t)T * 128 * 8 * 4 + (size_t)T * D * 2 <= (size_t)T * INW * 4, "qb + ppart + xb2 must fit in the proj region");
struct Params {
  const GAS float* in[21];
  GAS float* out_;
  GAS unsigned char* ws;
  __device__ __forceinline__ const float* inp(int i) const { return (const float*)in[i]; }
  __device__ __forceinline__ float* outp() const { return (float*)out_; }
  __device__ __forceinline__ float* rstd() const { return (float*)(ws + WO_rstd); }
  __device__ __forceinline__ float* cosm() const { return (float*)(ws + WO_cosm); }
  __device__ __forceinline__ float* sinm() const { return (float*)(ws + WO_sinm); }
  __device__ __forceinline__ float* cosr() const { return (float*)(ws + WO_cosr); }
  __device__ __forceinline__ float* sinr() const { return (float*)(ws + WO_sinr); }
  __device__ __forceinline__ float* kmean() const { return (float*)(ws + WO_kmean); }
  __device__ __forceinline__ float* proj() const { return (float*)(ws + WO_proj); }
  __device__ __forceinline__ float* ybuf() const { return (float*)(ws + WO_ybuf); }
  __device__ __forceinline__ float* yg() const { return (float*)(ws + WO_yg); }
  __device__ __forceinline__ bf16_t* skb() const { return (bf16_t*)(ws + WO_skb); }
  __device__ __forceinline__ bf16_t* Ub() const { return (bf16_t*)(ws + WO_Ub); }
  __device__ __forceinline__ bf16_t* Vb() const { return (bf16_t*)(ws + WO_Vb); }
  __device__ __forceinline__ float* gates() const { return (float*)(ws + WO_gates); }
  __device__ __forceinline__ int* eidx() const { return (int*)(ws + WO_eidx); }
  __device__ __forceinline__ bf16_t* xb() const { return (bf16_t*)(ws + WO_xb); }
  __device__ __forceinline__ bf16_t* Win_t() const { return (bf16_t*)(ws + WO_Win_t); }
  __device__ __forceinline__ bf16_t* Wout_t() const { return (bf16_t*)(ws + WO_Wout_t); }
  __device__ __forceinline__ bf16_t* Wq_t() const { return (bf16_t*)(ws + WO_Wq_t); }
  __device__ __forceinline__ bf16_t* Qm() const { return (bf16_t*)(ws + WO_Qm); }
  __device__ __forceinline__ bf16_t* Km() const { return (bf16_t*)(ws + WO_Km); }
  __device__ __forceinline__ bf16_t* Vm() const { return (bf16_t*)(ws + WO_Vm); }
  __device__ __forceinline__ bf16_t* S5A() const { return (bf16_t*)(ws + WO_S5A); }
  __device__ __forceinline__ bf16_t* S5Wy() const { return (bf16_t*)(ws + WO_S5Wy); }
  __device__ __forceinline__ bf16_t* S5Wz() const { return (bf16_t*)(ws + WO_S5Wz); }
  __device__ __forceinline__ float* S5Z() const { return (float*)(ws + WO_S5Z); }
  __device__ __forceinline__ float* S5a32() const { return (float*)(ws + WO_S5a32); }
  __device__ __forceinline__ bf16_t* Wglu_t() const { return (bf16_t*)(ws + WO_Wglu_t); }
  __device__ __forceinline__ bf16_t* ygb() const { return (bf16_t*)(ws + WO_yg); }
  __device__ __forceinline__ int* qctr() const { return (int*)(ws + WO_qctr); }
  __device__ __forceinline__ unsigned char* U8s() const { return (unsigned char*)(ws + WO_Ub); }
  __device__ __forceinline__ float* su() const { return (float*)(ws + WO_Ub + (size_t)16384 * D); }
  __device__ __forceinline__ unsigned char* V8s() const { return (unsigned char*)(ws + WO_Vb); }
  __device__ __forceinline__ float* sv() const { return (float*)(ws + WO_Vb + (size_t)16384 * D); }
  __device__ __forceinline__ bf16_t* hb() const { return (bf16_t*)(ws + WO_ybuf + ((size_t)4 << 20)); }
  __device__ __forceinline__ float* ppart() const { return (float*)(ws + WO_proj + (size_t)T * D * 2); }
  __device__ __forceinline__ bf16_t* Qr() const { return (bf16_t*)(ws + WO_Qr); }
  __device__ __forceinline__ bf16_t* Kr() const { return (bf16_t*)(ws + WO_Kr); }
  __device__ __forceinline__ bf16_t* Krv() const { return (bf16_t*)(ws + WO_Krv); }
  __device__ __forceinline__ bf16_t* Vr() const { return (bf16_t*)(ws + WO_Vr); }
  __device__ __forceinline__ float* KVr() const { return (float*)(ws + WO_KVr); }
  __device__ __forceinline__ bf16_t* Rb() const { return (bf16_t*)(ws + WO_Rb); }
  __device__ __forceinline__ unsigned* bar() const { return (unsigned*)(ws + WO_bar); }
  __device__ __forceinline__ bf16_t* projb() const { return (bf16_t*)(ws + WO_proj); }
  __device__ __forceinline__ float* ssq1() const { return (float*)(ws + WO_ssq1); }
  __device__ __forceinline__ float* ssq2() const { return (float*)(ws + WO_ssq2); }
  __device__ __forceinline__ bf16_t* xb2() const { return (bf16_t*)(ws + WO_proj + (size_t)T * D * 2 + (size_t)T * 128 * 8 * 4); }
  __device__ __forceinline__ bf16_t* qb() const { return (bf16_t*)(ws + WO_proj); }
};

namespace pg8 {
#define PG8_LAS __attribute__((address_space(3)))
typedef unsigned short bf16_t;
typedef short bf16x8 __attribute__((ext_vector_type(8)));
typedef float f32x4 __attribute__((ext_vector_type(4)));
typedef unsigned u32x4 __attribute__((ext_vector_type(4)));
constexpr int BM = 256, BK = 64, HALF = 128, HTB = HALF * BK * 2  , STAGE_BYTES = 8 * HTB, NXCD = 8, WGM = 8;

__host__ __device__ __forceinline__ int lds_byte(int r, int c) { const int st = (r >> 4) * 2 + (c >> 5), rr = r & 15, cc = c & 31, ob = rr * 64 + cc * 2; return st * 1024 + (ob ^ (((ob >> 9) & 1) << 5)); }
__host__ __device__ __forceinline__ void stage_rc(int b, int& R, int& C) { const int st = b / 1024, sb = b % 1024, swz = sb ^ (((sb >> 9) & 1) << 5); R = (st >> 1) * 16 + swz / 64; C = (st & 1) * 32 + (swz % 64) / 2; }
__host__ __device__ __forceinline__ int perm32(int rho) { const int n = rho >> 4, i = rho & 15; return 8 * (i >> 2) + 4 * n + (i & 3); }

struct Unit { int pm, pn; };
struct Gemm { const bf16_t* A; const bf16_t* Bt; int M, N, K, lda, ldb; };

struct StaticOrder {
    int nM, nN, nwg, G, c;
    __host__ __device__ void init(int M, int N, int G_, int c_) { nM = M / BM; nN = N / BM; nwg = nM * nN; G = G_; c = c_; }
    __host__ __device__ bool next(int i, Unit& u) const {
        const long L = (long)i * G + c; if (L >= nwg) return false;
        int wgid = (int)L; { const int q = nwg / NXCD, r = nwg % NXCD, xcd = wgid % NXCD, off = wgid / NXCD; wgid = (xcd < r ? xcd * (q + 1) : r * (q + 1) + (xcd - r) * q) + off; }
        const int nig = WGM * nN, gid = wgid / nig, fm = gid * WGM, gsz = (nM - fm) < WGM ? (nM - fm) : WGM;
        u.pm = fm + ((wgid % nig) % gsz); u.pn = (wgid % nig) / gsz; return true;
    }
    __device__ __forceinline__ void a_ready(const Unit&) const {}
    __device__ __forceinline__ void done(const Unit&) const {}
};
struct GroupOrder {
    int mt, nt_, nwg, G, c;
    __host__ __device__ void init(int ngroups, int mt__, int nt__, int G_, int c_) { mt = mt__; nt_ = nt__; nwg = ngroups * mt * nt_; G = G_; c = c_; }
    __host__ __device__ bool next(int i, Unit& u) const {
        const long L = (long)i * G + c; if (L >= nwg) return false;
        const int per = mt * nt_, gi = (int)L / per, r = (int)L % per;
        u.pm = gi * mt + r % mt; u.pn = gi * nt_ + r / mt; return true;
    }
    __device__ __forceinline__ void a_ready(const Unit&) const {}
    __device__ __forceinline__ void done(const Unit&) const {}
};
template <class Epi, class Sched, bool ALIGN_EPI = false, bool SP2 = false>
__device__ __forceinline__ void gemm_phase(PG8_LAS unsigned char* lds, const Gemm g, const Sched& S, const Epi& E) {
    int tid_ = threadIdx.x; asm volatile("" : "+v"(tid_));
    const int tid = tid_, wid = __builtin_amdgcn_readfirstlane(tid >> 6), lane = tid & 63, wr = wid >> 2, wc = wid & 3, fr = lane & 15, fq = lane >> 4;
    const int K = g.K, nt = K / BK;
    unsigned voffA[2], voffB[2];
#pragma unroll
    for (int i = 0; i < 2; ++i) { int R, C; stage_rc(tid * 16 + i * 8192, R, C); const int Rb = Epi::PERM ? ((R & ~31) + perm32(R & 31)) : R;
        voffA[i] = (unsigned)(R * g.lda + C) * 2u; voffB[i] = (unsigned)(Rb * g.ldb + C) * 2u; }
    const size_t kstep = (size_t)(BK * 2);
    const size_t hstepA = (size_t)HALF * g.lda * 2, hstepB = (size_t)HALF * g.ldb * 2;
    const size_t tstepA = 2 * hstepA, tstepB = 2 * hstepB;
    const unsigned ldsw = (unsigned)wid * 1024u;
    const int aoff = lds_byte(wr * 64 + fr, fq * 8), boff = lds_byte(wc * 32 + fr, fq * 8);
#define PG8_SA(b, h) (((b) * 2 + (h)) * HTB)
#define PG8_SB(b, h) ((4 + (b) * 2 + (h)) * HTB)
#define PG8_STAGE(bufoff, gbase, voff) do { _Pragma("unroll") for (int _i = 0; _i < 2; ++_i) \
        __builtin_amdgcn_global_load_lds((const unsigned*)((const char*)(gbase) + (voff)[_i]), (PG8_LAS unsigned*)(lds + (bufoff) + ldsw + _i * 8192), 16, 0, 0); } while (0)
#define PG8_LDA(dst, b, h) do { _Pragma("unroll") for (int m = 0; m < 4; ++m) _Pragma("unroll") for (int k = 0; k < 2; ++k) dst[m][k] = *(const PG8_LAS bf16x8*)(lds + PG8_SA(b, h) + aoff + m * 2048 + k * 1024); } while (0)
#define PG8_LDB(dst, b, h) do { _Pragma("unroll") for (int n = 0; n < 2; ++n) _Pragma("unroll") for (int k = 0; k < 2; ++k) dst[n][k] = *(const PG8_LAS bf16x8*)(lds + PG8_SB(b, h) + boff + n * 2048 + k * 1024); } while (0)
#define PG8_MMA(ai, bj, At, Bt) do { __builtin_amdgcn_s_setprio(1); _Pragma("unroll") for (int m = 0; m < 4; ++m) _Pragma("unroll") for (int n = 0; n < 2; ++n) _Pragma("unroll") for (int k = 0; k < 2; ++k) \
        acc[ai][bj][m][n] = __builtin_amdgcn_mfma_f32_16x16x32_bf16(Bt[n][k], At[m][k], acc[ai][bj][m][n], 0, 0, 0); __builtin_amdgcn_s_setprio(0); } while (0)
#define PG8_WAIT_V(n) asm volatile("s_waitcnt vmcnt(" #n ")" ::: "memory")
#define PG8_WAIT_L(n) asm volatile("s_waitcnt lgkmcnt(" #n ")" ::: "memory")
#define PG8_BAR __builtin_amdgcn_s_barrier()
#define PG8_SCHED __builtin_amdgcn_sched_barrier(0)
    Unit cur, nxt; int ui = 0;
    if (!S.next(0, cur)) return;
    f32x4 acc[2][2][4][2];
    E.init(acc, cur, wr, wc, fr, fq);
    bf16x8 At[4][2], B0[2][2], B1[2][2];
    const char* cA = (const char*)g.A + (size_t)cur.pm * tstepA; const char* cB = (const char*)g.Bt + (size_t)cur.pn * tstepB;
    S.a_ready(cur);
    if constexpr (SP2) {
        PG8_STAGE(PG8_SB(0, 0), cB, voffB); PG8_STAGE(PG8_SB(0, 1), cB + hstepB, voffB); PG8_STAGE(PG8_SA(0, 0), cA, voffA); PG8_STAGE(PG8_SA(0, 1), cA + hstepA, voffA);
        if (wr == 1) PG8_BAR;
        PG8_WAIT_V(2); PG8_BAR;
        PG8_STAGE(PG8_SB(1, 0), cB + kstep, voffB); PG8_STAGE(PG8_SA(1, 0), cA + kstep, voffA); PG8_STAGE(PG8_SB(1, 1), cB + hstepB + kstep, voffB);
        PG8_WAIT_V(6); PG8_BAR;
    } else {
        PG8_STAGE(PG8_SB(0, 0), cB, voffB); PG8_STAGE(PG8_SA(0, 0), cA, voffA); PG8_STAGE(PG8_SB(0, 1), cB + hstepB, voffB); PG8_STAGE(PG8_SA(0, 1), cA + hstepA, voffA);
        if (wr == 1) PG8_BAR;
        PG8_WAIT_V(4); PG8_BAR;
        PG8_STAGE(PG8_SB(1, 0), cB + kstep, voffB); PG8_STAGE(PG8_SA(1, 0), cA + kstep, voffA); PG8_STAGE(PG8_SB(1, 1), cB + hstepB + kstep, voffB);
        PG8_WAIT_V(6); PG8_BAR;
    }
    for (;;) {
        const bool has_next = S.next(ui + 1, nxt);
        const char* nA = has_next ? (const char*)g.A + (size_t)nxt.pm * tstepA : cA; const char* nB = has_next ? (const char*)g.Bt + (size_t)nxt.pn * tstepB : cB;
        for (int t = 0; t < nt; t += 2) {
            const bool last = (t == nt - 2);
            const char* a1 = cA + (size_t)(t + 1) * kstep;
            const char* a2 = last ? nA : cA + (size_t)(t + 2) * kstep; const char* b2 = last ? nB : cB + (size_t)(t + 2) * kstep;
            const char* a3 = a2 + kstep; const char* b3 = b2 + kstep;
            if (last && has_next) S.a_ready(nxt);
            if constexpr (SP2) {
            PG8_LDB(B0, 0, 0); PG8_LDB(B1, 0, 1); PG8_SCHED; PG8_LDA(At, 0, 0); PG8_STAGE(PG8_SA(1, 1), a1 + hstepA, voffA);
            PG8_WAIT_V(8); PG8_WAIT_L(0); PG8_BAR; PG8_MMA(0, 0, At, B0); PG8_MMA(0, 1, At, B1); PG8_BAR; PG8_SCHED;
            PG8_LDA(At, 0, 1); PG8_STAGE(PG8_SB(0, 0), b2, voffB); PG8_STAGE(PG8_SB(0, 1), b2 + hstepB, voffB); PG8_STAGE(PG8_SA(0, 0), a2, voffA);
            PG8_WAIT_V(8); PG8_WAIT_L(0); PG8_BAR; PG8_MMA(1, 0, At, B0); PG8_MMA(1, 1, At, B1); PG8_BAR; PG8_SCHED;
            PG8_LDB(B0, 1, 0); PG8_LDB(B1, 1, 1); PG8_SCHED; PG8_LDA(At, 1, 0); PG8_STAGE(PG8_SA(0, 1), a2 + hstepA, voffA);
            PG8_WAIT_V(8); PG8_WAIT_L(0); PG8_BAR; PG8_MMA(0, 0, At, B0); PG8_MMA(0, 1, At, B1); PG8_BAR; PG8_SCHED;
            PG8_LDA(At, 1, 1); PG8_STAGE(PG8_SB(1, 0), b3, voffB); PG8_STAGE(PG8_SB(1, 1), b3 + hstepB, voffB); PG8_STAGE(PG8_SA(1, 0), a3, voffA);
            PG8_WAIT_V(8); PG8_WAIT_L(0); PG8_BAR; PG8_MMA(1, 0, At, B0); PG8_MMA(1, 1, At, B1); PG8_BAR; PG8_SCHED;
            } else {
            PG8_LDB(B0, 0, 0); PG8_SCHED; PG8_LDA(At, 0, 0); PG8_STAGE(PG8_SA(1, 1), a1 + hstepA, voffA);
            PG8_WAIT_L(8); PG8_BAR; PG8_WAIT_L(0); PG8_MMA(0, 0, At, B0); PG8_BAR; PG8_SCHED;
            PG8_LDB(B1, 0, 1); PG8_STAGE(PG8_SB(0, 0), b2, voffB);
            PG8_BAR; PG8_WAIT_L(0); PG8_MMA(0, 1, At, B1); PG8_BAR;
            PG8_LDA(At, 0, 1); PG8_STAGE(PG8_SA(0, 0), a2, voffA);
            PG8_BAR; PG8_WAIT_L(0); PG8_MMA(1, 0, At, B0); PG8_BAR; PG8_SCHED;
            PG8_STAGE(PG8_SB(0, 1), b2 + hstepB, voffB);
            PG8_WAIT_V(6); PG8_BAR; PG8_MMA(1, 1, At, B1); PG8_BAR;
            PG8_LDB(B0, 1, 0); PG8_SCHED; PG8_LDA(At, 1, 0); PG8_STAGE(PG8_SA(0, 1), a2 + hstepA, voffA);
            PG8_WAIT_L(8); PG8_BAR; PG8_WAIT_L(0); PG8_MMA(0, 0, At, B0); PG8_BAR; PG8_SCHED;
            PG8_LDB(B1, 1, 1); PG8_STAGE(PG8_SB(1, 0), b3, voffB);
            PG8_BAR; PG8_WAIT_L(0); PG8_MMA(0, 1, At, B1); PG8_BAR;
            PG8_LDA(At, 1, 1); PG8_STAGE(PG8_SA(1, 0), a3, voffA);
            PG8_BAR; PG8_WAIT_L(0); PG8_MMA(1, 0, At, B0); PG8_BAR; PG8_SCHED;
            PG8_STAGE(PG8_SB(1, 1), b3 + hstepB, voffB);
            PG8_WAIT_V(6); PG8_BAR; PG8_MMA(1, 1, At, B1); PG8_BAR;
            }
        }
        if constexpr (ALIGN_EPI) { if (wr == 0) PG8_BAR; }
        if constexpr (!Epi::AFTER_DRAIN) { E(acc, cur, wr, wc, fr, fq); S.done(cur); }
        if (!has_next) break;
        E.init(acc, nxt, wr, wc, fr, fq);
        cur = nxt; cA = nA; cB = nB; ++ui;
        if constexpr (ALIGN_EPI) { if (wr == 1) PG8_BAR; }
    }
    PG8_WAIT_V(0);
    if constexpr (!ALIGN_EPI) { if (wr == 0) PG8_BAR; }
    PG8_BAR;
    if constexpr (Epi::AFTER_DRAIN) { E.fused(acc, cur, wr, wc, fr, fq, lds, wid, lane); S.done(cur); }
#undef PG8_SA
#undef PG8_SB
#undef PG8_STAGE
#undef PG8_LDA
#undef PG8_LDB
#undef PG8_MMA
#undef PG8_WAIT_V
#undef PG8_WAIT_L
#undef PG8_BAR
#undef PG8_SCHED
}
}
#define EPI_ZERO_INIT \
  __device__ __forceinline__ void init(pg8::f32x4 (&acc)[2][2][4][2], const pg8::Unit&, int, int, int, int) const { \
    _Pragma("unroll") for (int a = 0; a < 2; ++a) _Pragma("unroll") for (int b = 0; b < 2; ++b) \
    _Pragma("unroll") for (int m = 0; m < 4; ++m) _Pragma("unroll") for (int n = 0; n < 2; ++n) acc[a][b][m][n] = (pg8::f32x4){0.f, 0.f, 0.f, 0.f}; }
struct EpiResid {
  static constexpr bool PERM = true, AFTER_DRAIN = false;
  float* C; int ldc; bf16_t* xb; bf16_t* hb; const float* g2; float* parts;
  __device__ __forceinline__ void init(pg8::f32x4 (&acc)[2][2][4][2], const pg8::Unit& u, int wr, int wc, int fr, int fq) const {
#pragma unroll
    for (int ai = 0; ai < 2; ++ai)
#pragma unroll
      for (int m = 0; m < 4; ++m) {
        const int row = u.pm * 256 + ai * 128 + wr * 64 + m * 16 + fr;
#pragma unroll
        for (int bj = 0; bj < 2; ++bj)
#pragma unroll
          for (int n = 0; n < 2; ++n) {
            const int col = u.pn * 256 + bj * 128 + wc * 32 + 8 * fq + 4 * n;
            acc[ai][bj][m][n] = *(const pg8::f32x4*)(C + (size_t)row * ldc + col);
          }
      }
  }
  __device__ __forceinline__ void operator()(const pg8::f32x4 (&acc)[2][2][4][2], const pg8::Unit& u, int wr, int wc, int fr_in, int fq_in) const {
    int fr = fr_in, fq = fq_in; asm volatile("" : "+v"(fr), "+v"(fq));
    pg8::f32x4 gv[2][2];
#pragma unroll
    for (int bj = 0; bj < 2; ++bj)
#pragma unroll
      for (int n = 0; n < 2; ++n) gv[bj][n] = *(const pg8::f32x4*)(g2 + u.pn * 256 + bj * 128 + wc * 32 + 8 * fq + 4 * n);
#pragma unroll
    for (int ai = 0; ai < 2; ++ai)
#pragma unroll
      for (int m = 0; m < 4; ++m) {
        const int row = u.pm * 256 + ai * 128 + wr * 64 + m * 16 + fr;
        float ss = 0.f;
#pragma unroll
        for (int bj = 0; bj < 2; ++bj) {
          const int col = u.pn * 256 + bj * 128 + wc * 32 + 8 * fq;
          const pg8::f32x4 v0 = acc[ai][bj][m][0], v1 = acc[ai][bj][m][1];
          *(pg8::f32x4*)(C + (size_t)row * ldc + col) = v0; *(pg8::f32x4*)(C + (size_t)row * ldc + col + 4) = v1;
          *(uint4*)(xb + (size_t)row * KD + col) = make_uint4(pk_bf16(v0[0], v0[1]), pk_bf16(v0[2], v0[3]), pk_bf16(v1[0], v1[1]), pk_bf16(v1[2], v1[3]));
          const pg8::f32x4 h0 = v0 * gv[bj][0], h1 = v1 * gv[bj][1];
          *(uint4*)(hb + ((size_t)(col >> 7) * T + row) * 128 + (col & 127)) = make_uint4(pk_bf16(h0[0], h0[1]), pk_bf16(h0[2], h0[3]), pk_bf16(h1[0], h1[1]), pk_bf16(h1[2], h1[3]));
          ss += ((v0[0] * v0[0] + v0[1] * v0[1]) + (v0[2] * v0[2] + v0[3] * v0[3])) + ((v1[0] * v1[0] + v1[1] * v1[1]) + (v1[2] * v1[2] + v1[3] * v1[3]));
        }
        ss += __shfl_xor(ss, 16); ss += __shfl_xor(ss, 32);
        if (fq == 0) parts[(size_t)row * 16 + u.pn * 4 + wc] = ss;
        asm volatile("" ::: "memory");
      }
  }
};
struct EpiScaleStoreBf16 {
  static constexpr bool PERM = true, AFTER_DRAIN = false;
  bf16_t* C; int ldc; const float* parts; int nparts; float* rs_out;
  EPI_ZERO_INIT
  __device__ __forceinline__ void operator()(const pg8::f32x4 (&acc)[2][2][4][2], const pg8::Unit& u, int wr, int wc, int fr_in, int fq_in) const {
    int fr = fr_in, fq = fq_in; asm volatile("" : "+v"(fr), "+v"(fq));
#pragma unroll
    for (int ai = 0; ai < 2; ++ai)
#pragma unroll
      for (int m = 0; m < 4; ++m) {
        const int row = u.pm * 256 + ai * 128 + wr * 64 + m * 16 + fr;
        float ssum = 0.f;
        for (int i = 0; i < nparts; i += 4) { const pg8::f32x4 q4 = *(const pg8::f32x4*)(parts + (size_t)row * nparts + i); ssum += (q4[0] + q4[1]) + (q4[2] + q4[3]); }
        const float r = rsqrtf(ssum * (1.0f / (float)D) + EPS);
        if (rs_out && u.pn == 0 && wc == 0 && fq == 0) rs_out[row] = r;
#pragma unroll
        for (int bj = 0; bj < 2; ++bj) {
          const int col = u.pn * 256 + bj * 128 + wc * 32 + 8 * fq;
          const pg8::f32x4 v0 = acc[ai][bj][m][0] * r, v1 = acc[ai][bj][m][1] * r;
          *(uint4*)(C + (size_t)row * ldc + col) = make_uint4(pk_bf16(v0[0], v0[1]), pk_bf16(v0[2], v0[3]), pk_bf16(v1[0], v1[1]), pk_bf16(v1[2], v1[3]));
        }
        asm volatile("" ::: "memory");
      }
  }
};
template <class Epi>
__device__ __forceinline__ void run_gemm(unsigned char* lds_raw, const bf16_t* A, const bf16_t* Bt, int M, int N, int K, const Epi& e) {
  pg8::Gemm g{A, Bt, M, N, K, K, K}; pg8::StaticOrder So; So.init(M, N, (int)gridDim.x, (int)blockIdx.x);
  pg8::gemm_phase<Epi, pg8::StaticOrder, true, true>((PG8_LAS unsigned char*)lds_raw, g, So, e);
}

__device__ __forceinline__ void transpose_items(const float* __restrict__ W, int K, int N, const float* __restrict__ g, bf16_t* __restrict__ Wt, int gw, int ngw, int lane) {
  const int nkt = K / 64, nnt = N / 64;
  for (int it = gw; it < nkt * nnt; it += ngw) {
    int kt = it % nkt, ntile = it / nkt;
    int k0 = kt * 64, n = ntile * 64 + lane;
    float v[64];
#pragma unroll
    for (int i = 0; i < 64; ++i) v[i] = W[(size_t)(k0 + i) * N + n] * g[k0 + i];
    bf16_t* dst = Wt + (size_t)n * (K * KS) + k0;
#pragma unroll
    for (int c = 0; c < 8; ++c) {
      bf16_t hi[8], lo[8];
#pragma unroll
      for (int e = 0; e < 8; ++e) { hi[e] = f2bf(v[c * 8 + e]); lo[e] = f2bf(v[c * 8 + e] - bf2f(hi[e])); }
      uint4 ph, pl;
      ph.x = hi[0] | ((unsigned)hi[1] << 16); ph.y = hi[2] | ((unsigned)hi[3] << 16); ph.z = hi[4] | ((unsigned)hi[5] << 16); ph.w = hi[6] | ((unsigned)hi[7] << 16);
      pl.x = lo[0] | ((unsigned)lo[1] << 16); pl.y = lo[2] | ((unsigned)lo[3] << 16); pl.z = lo[4] | ((unsigned)lo[5] << 16); pl.w = lo[6] | ((unsigned)lo[7] << 16);
      *(uint4*)(dst + c * 8) = ph;
      if (PRECISE) { *(uint4*)(dst + K + c * 8) = pl; *(uint4*)(dst + 2 * K + c * 8) = ph; }
    }
  }
}


__device__ __forceinline__ void phase_prologue(const Params& p, int gtid, int ngt, int gw, int ngw, int lane) {
  for (int idx = gtid; idx < S * 40; idx += ngt) {
    int s = idx / 40, i = idx % 40;
    if (i < 8) {
      float inv = powf(500000.0f, -(float)(2 * i) / 16.0f);
      float ang = (float)s * inv;
      p.cosm()[s * 8 + i] = (float)cos((double)ang); p.sinm()[s * 8 + i] = (float)sin((double)ang);
    } else {
      int j = i - 8;
      float inv = powf(10000.0f, -((float)j / 31.0f));
      float ang = (float)s * inv;
      p.cosr()[s * 32 + j] = (float)cos((double)ang); p.sinr()[s * 32 + j] = (float)sin((double)ang);
    }
  }
  { const float4* a = (const float4*)p.inp(0); float4* b = (float4*)p.outp();
    for (size_t i = gtid; i < (size_t)T * D / 4; i += ngt) b[i] = a[i]; }
  for (int t = gw; t < T; t += ngw) {
    const float4* xr = (const float4*)(p.inp(0) + (size_t)t * D); float ss = 0.f;
#pragma unroll
    for (int i = 0; i < 4; ++i) { const float4 v = xr[lane + i * 64]; ss += v.x * v.x + v.y * v.y + v.z * v.z + v.w * v.w;
      *(uint2*)(p.xb() + (size_t)t * KD + (lane + i * 64) * 4) = make_uint2(pk_bf16(v.x, v.y), pk_bf16(v.z, v.w)); }
    ss = wave_sum(ss);
    if (lane < 8) p.ssq1()[(size_t)t * 8 + lane] = lane == 0 ? ss : 0.f;
  }
  for (int idx = gtid; idx < NL * 65536; idx += ngt) { const int l2 = idx >> 16, n2 = (idx >> 8) & 255, k2 = idx & 255; p.Wglu_t()[idx] = f2bf(p.inp(11)[(size_t)l2 * 65536 + k2 * 256 + n2]); }
  for (int l = 0; l < NL; ++l) {
    transpose_items(p.inp(2) + (size_t)l * D * INW, D, INW, p.inp(1) + l * D, p.Win_t() + (size_t)l * INW * KD, gw, ngw, lane);
    transpose_items(p.inp(15) + (size_t)l * D * D, D, D, p.inp(14) + l * D, p.Wout_t() + (size_t)l * D * KD, gw, ngw, lane);
    transpose_items(p.inp(17) + (size_t)l * D * D, D, D, p.inp(16) + l * D, p.Wq_t() + (size_t)l * D * KD, gw, ngw, lane);
  }
}


struct S5P { float lr, li, dt, fr, fi; };
__device__ __forceinline__ S5P s5p(const Params& p, int l, int g, int pp) {
  S5P r; r.lr = p.inp(3)[l * 1024 + g * 64 + pp]; r.li = p.inp(4)[l * 1024 + g * 64 + pp]; r.dt = expf(p.inp(5)[l * 16 + g]);
  const float mag = expf(r.lr * r.dt); float sn, cs; sincosf(r.li * r.dt, &sn, &cs);
  const float ar = mag * cs, ai = mag * sn, den = r.lr * r.lr + r.li * r.li;
  r.fr = ((ar - 1.0f) * r.lr + ai * r.li) / den; r.fi = (ai * r.lr - (ar - 1.0f) * r.li) / den;
  return r;
}
__device__ __forceinline__ void s5pow(const S5P& s, int k, float& re, float& im) {
  const float m = expf((float)k * s.lr * s.dt); float sn, cs; sincosf((float)k * s.li * s.dt, &sn, &cs); re = m * cs; im = m * sn;
}
__device__ __forceinline__ void phase_s5_prep(const Params& p, int l, int gtid, int ngt) {
  const float* b_re = p.inp(6) + l * 16384; const float* b_im = p.inp(7) + l * 16384;
  const float* c_re = p.inp(8) + l * 16384; const float* c_im = p.inp(9) + l * 16384;
  bf16_t* Wy = p.S5Wy(); bf16_t* Wz = p.S5Wz();
  for (int it = gtid; it < 16 * 32 * 256; it += ngt) {
    const int hp = it & 15, h = (it >> 4) & 15, d = (it >> 8) & 31, g = it >> 13;
    float acc = 0.f;
    for (int pp = 0; pp < 64; ++pp) {
      const S5P s = s5p(p, l, g, pp);
      float pr, pi; s5pow(s, d, pr, pi);
      const float br = b_re[(g * 64 + pp) * 16 + hp], bi = b_im[(g * 64 + pp) * 16 + hp];
      const float bbr = s.fr * br - s.fi * bi, bbi = s.fr * bi + s.fi * br;
      const float tr = pr * bbr - pi * bbi, ti = pr * bbi + pi * bbr;
      acc += c_re[(g * 16 + h) * 64 + pp] * tr - c_im[(g * 16 + h) * 64 + pp] * ti;
    }
    const bf16_t v = f2bf(acc);
    for (int jp = 0; jp + d < 32; ++jp) {
      const int j = jp + d;
      Wy[((size_t)g * 512 + j * 16 + h) * 640 + jp * 16 + hp] = v;
      if (d > 0) Wy[((size_t)g * 512 + jp * 16 + h) * 640 + j * 16 + hp] = 0;
    }
  }
  for (int it = gtid; it < 16 * 32 * 16 * 64; it += ngt) {
    const int pp = it & 63, h = (it >> 6) & 15, j = (it >> 10) & 31, g = it >> 15;
    const S5P s = s5p(p, l, g, pp);
    float pr, pi; s5pow(s, j + 1, pr, pi);
    const float cr = c_re[(g * 16 + h) * 64 + pp], ci = c_im[(g * 16 + h) * 64 + pp];
    const unsigned w = pk_bf16(cr * pr - ci * pi, -(cr * pi + ci * pr));
    *(unsigned*)(Wy + ((size_t)g * 512 + j * 16 + h) * 640 + 512 + 2 * pp) = w;
  }
  for (int it = gtid; it < 16 * 64 * 32; it += ngt) {
    const int j = it & 31, pp = (it >> 5) & 63, g = it >> 11;
    const S5P s = s5p(p, l, g, pp);
    float pr, pi; s5pow(s, 31 - j, pr, pi);
    for (int hp = 0; hp < 16; ++hp) {
      const float br = b_re[(g * 64 + pp) * 16 + hp], bi = b_im[(g * 64 + pp) * 16 + hp];
      const float bbr = s.fr * br - s.fi * bi, bbi = s.fr * bi + s.fi * br;
      Wz[((size_t)g * 256 + 2 * pp) * 512 + j * 16 + hp] = f2bf(pr * bbr - pi * bbi);
      Wz[((size_t)g * 256 + 2 * pp + 1) * 512 + j * 16 + hp] = f2bf(pr * bbi + pi * bbr);
    }
  }
  for (int it = gtid; it < 16 * 64; it += ngt) {
    const S5P s = s5p(p, l, it >> 6, it & 63);
    float pr, pi; s5pow(s, 32, pr, pi);
    p.S5a32()[it * 2] = pr; p.S5a32()[it * 2 + 1] = pi;
  }
}
__device__ __forceinline__ void phase_pack_u(const Params& p, int gtid, int ngt) {
  for (int idx = gtid; idx < T * 32; idx += ngt) {
    const int t = idx >> 5, i = idx & 31, g = i >> 1;
    *(uint4*)(p.S5A() + ((size_t)g * 1024 + (t >> 5)) * 640 + (t & 31) * 16 + (i & 1) * 8) = *(const uint4*)(p.projb() + (size_t)t * INW + i * 8);
  }
}
__device__ __forceinline__ void phase_s5_scan(const Params& p, int gtid, int ngt) {
  for (int it = gtid; it < NB * 16 * 64; it += ngt) {
    const int pp = it & 63, g = (it >> 6) & 15, b = it >> 10;
    const float er = p.S5a32()[(g * 64 + pp) * 2], ei = p.S5a32()[(g * 64 + pp) * 2 + 1];
    float sr = 0.f, si = 0.f;
#pragma unroll 1
    for (int c0 = 0; c0 < 128; c0 += 16) {
      float2 z[16];
#pragma unroll
      for (int k = 0; k < 16; ++k) z[k] = *(const float2*)(p.S5Z() + ((size_t)g * 1024 + b * 128 + c0 + k) * 128 + 2 * pp);
#pragma unroll
      for (int k = 0; k < 16; ++k) {
        const size_t ch = (size_t)g * 1024 + b * 128 + c0 + k;
        *(unsigned*)(p.S5A() + ch * 640 + 512 + 2 * pp) = pk_bf16(sr, si);
        const float nr = er * sr - ei * si + z[k].x, ni = er * si + ei * sr + z[k].y;
        sr = nr; si = ni;
      }
    }
  }
}
struct EpiS5Z {
  static constexpr bool PERM = false, AFTER_DRAIN = false;
  float* Z;
  EPI_ZERO_INIT
  __device__ __forceinline__ void operator()(const pg8::f32x4 (&acc)[2][2][4][2], const pg8::Unit& u, int wr, int wc, int fr_in, int fq_in) const {
    int fr = fr_in, fq = fq_in; asm volatile("" : "+v"(fr), "+v"(fq));
    const int g = u.pm >> 2;
#pragma unroll
    for (int ai = 0; ai < 2; ++ai)
#pragma unroll
      for (int m = 0; m < 4; ++m) {
        const int chunk = (u.pm & 3) * 256 + ai * 128 + wr * 64 + m * 16 + fr;
#pragma unroll
        for (int n = 0; n < 2; ++n) *(pg8::f32x4*)(Z + ((size_t)g * 1024 + chunk) * 128 + wc * 32 + n * 16 + 4 * fq) = acc[ai][0][m][n];
      }
  }
};
struct EpiS5Y {
  static constexpr bool PERM = false, AFTER_DRAIN = false;
  bf16_t* ygb; const bf16_t* A; const float* dsk;
  EPI_ZERO_INIT
  __device__ __forceinline__ void operator()(const pg8::f32x4 (&acc)[2][2][4][2], const pg8::Unit& u, int wr, int wc, int fr_in, int fq_in) const {
    int fr = fr_in, fq = fq_in; asm volatile("" : "+v"(fr), "+v"(fq));
    const int g = u.pm >> 2;
#pragma unroll
    for (int ai = 0; ai < 2; ++ai)
#pragma unroll
      for (int m = 0; m < 4; ++m) {
        const int chunk = (u.pm & 3) * 256 + ai * 128 + wr * 64 + m * 16 + fr;
#pragma unroll
        for (int bj = 0; bj < 2; ++bj)
#pragma unroll
          for (int n = 0; n < 2; ++n) {
            const int col = (u.pn & 1) * 256 + bj * 128 + wc * 32 + n * 16 + 4 * fq, j = col >> 4, h = col & 15;
            const uint2 uu = *(const uint2*)(A + ((size_t)g * 1024 + chunk) * 640 + col);
            const pg8::f32x4 dv = *(const pg8::f32x4*)(dsk + g * 16 + h);
            const pg8::f32x4 v = acc[ai][bj][m][n];
            const float y0 = fast_gelu(v[0] + dv[0] * __uint_as_float(uu.x << 16)), y1 = fast_gelu(v[1] + dv[1] * __uint_as_float(uu.x & 0xffff0000u));
            const float y2 = fast_gelu(v[2] + dv[2] * __uint_as_float(uu.y << 16)), y3 = fast_gelu(v[3] + dv[3] * __uint_as_float(uu.y & 0xffff0000u));
            uint2 o; o.x = pk_bf16(y0, y1); o.y = pk_bf16(y2, y3);
            *(uint2*)(ygb + ((size_t)chunk * 32 + j) * 256 + g * 16 + h) = o;
          }
        asm volatile("" ::: "memory");
      }
  }
};
struct EpiGlu {
  static constexpr bool PERM = false, AFTER_DRAIN = false;
  bf16_t* yb; const bf16_t* ygb; float* scr;
  EPI_ZERO_INIT
  __device__ __forceinline__ void operator()(const pg8::f32x4 (&acc_)[2][2][4][2], const pg8::Unit& u, int wr, int wc, int fr_in, int fq_in) const {
    int fr = fr_in, fq = fq_in; asm volatile("" : "+v"(fr), "+v"(fq));
    pg8::f32x4 (&acc)[2][2][4][2] = const_cast<pg8::f32x4 (&)[2][2][4][2]>(acc_);
#pragma unroll
    for (int ai = 0; ai < 2; ++ai)
#pragma unroll
      for (int m = 0; m < 4; ++m) {
        const int rl = ai * 128 + wr * 64 + m * 16 + fr, row = u.pm * 256 + rl;
        float ss = 0.f;
#pragma unroll
        for (int bj = 0; bj < 2; ++bj)
#pragma unroll
          for (int n = 0; n < 2; ++n) {
            const int col = bj * 128 + wc * 32 + n * 16 + 4 * fq;
            const uint2 yy = *(const uint2*)(ygb + (size_t)row * 256 + col);
            const pg8::f32x4 z = acc[ai][bj][m][n];
            pg8::f32x4 r;
            r[0] = __uint_as_float(yy.x << 16) * fast_sigmoid(z[0]); r[1] = __uint_as_float(yy.x & 0xffff0000u) * fast_sigmoid(z[1]);
            r[2] = __uint_as_float(yy.y << 16) * fast_sigmoid(z[2]); r[3] = __uint_as_float(yy.y & 0xffff0000u) * fast_sigmoid(z[3]);
            acc[ai][bj][m][n] = r;
            ss += r[0] * r[0] + r[1] * r[1] + r[2] * r[2] + r[3] * r[3];
          }
        ss += __shfl_xor(ss, 16); ss += __shfl_xor(ss, 32);
        if (fq == 0) scr[rl * 4 + wc] = ss;
        asm volatile("" ::: "memory");
      }
    asm volatile("s_waitcnt lgkmcnt(0)" ::: "memory"); __builtin_amdgcn_s_barrier(); asm volatile("" ::: "memory");
#pragma unroll
    for (int ai = 0; ai < 2; ++ai)
#pragma unroll
      for (int m = 0; m < 4; ++m) {
        const int rl = ai * 128 + wr * 64 + m * 16 + fr, row = u.pm * 256 + rl;
        const pg8::f32x4 s4 = *(const pg8::f32x4*)(scr + rl * 4);
        const float r = rsqrtf((s4[0] + s4[1] + s4[2] + s4[3]) / 256.0f + EPS);
#pragma unroll
        for (int bj = 0; bj < 2; ++bj)
#pragma unroll
          for (int n = 0; n < 2; ++n) { const pg8::f32x4 v = acc[ai][bj][m][n] * r; *(uint2*)(yb + (size_t)row * KD + bj * 128 + wc * 32 + n * 16 + 4 * fq) = make_uint2(pk_bf16(v[0], v[1]), pk_bf16(v[2], v[3])); }
        asm volatile("" ::: "memory");
      }
    asm volatile("s_waitcnt lgkmcnt(0)" ::: "memory"); __builtin_amdgcn_s_barrier(); asm volatile("" ::: "memory");
  }
};

constexpr float QSCALE = 0.125f * 1.4426950408889634f;


__device__ __forceinline__ void phase_moba2(const Params& p, int l, unsigned char* lds, int* uq) {
  constexpr int OLD = 260;
  bf16_t* Qs = (bf16_t*)lds;
  float* Oaccf = (float*)(lds + 32768);
  float* laccf = (float*)(lds + 32768 + 64 * OLD * 4);
  float* kms = laccf + 256;
  float* gat = kms + 1024;
  unsigned char* lists = (unsigned char*)(gat + 4096);
  int* cnt = (int*)(lists + 4096);
  int* items = cnt + 16;
  int* ctr = items + 160;
  unsigned* selp = (unsigned*)(ctr + 4);
  float* bq = (float*)(selp + 256);
  int* Oacc = (int*)Oaccf; int* lacc = (int*)laccf;
  float kmax = 0.f;
  { const float* gk = p.inp(13) + l * 64;
    for (int d = 0; d < 64; ++d) kmax = fmaxf(kmax, fabsf(gk[d]));
    kmax *= 8.0f * 1.01f; }
  for (;;) {
    const int u = q_pull(uq, NB * 8 * 16, (int*)(lds + 131072), threadIdx.x);
    if (u < 0) break;
    const int qblk = 15 - (u >> 6), bh = u & 63, b = bh >> 3, h = bh & 7;
    int tid = threadIdx.x; asm volatile("" : "+v"(tid));
    const int lane = tid & 63, wv = tid >> 6, n = lane & 31, hh = lane >> 5;
    __syncthreads();
    { const uint4* src = (const uint4*)(p.Qm() + ((size_t)bh * S + qblk * 256) * 64);
      uint4* dst = (uint4*)Qs;
      for (int i = tid; i < 256 * 64 * 2 / 16; i += NTHR) dst[i] = src[i]; }
    for (int i = tid; i < qblk * 64; i += NTHR) kms[i] = p.kmean()[(size_t)bh * 1024 + i];
    for (int i = tid; i < 64 * OLD; i += NTHR) Oacc[i] = 0;
    if (tid < 256) lacc[tid] = 0;
    if (tid < 16) cnt[tid] = 0;
    __syncthreads();
    { const int q = tid & 255, par = tid >> 8;
      float qv[64];
#pragma unroll
      for (int c = 0; c < 8; ++c) {
        uint4 w = *(const uint4*)(Qs + q * 64 + c * 8);
        qv[c * 8 + 0] = __uint_as_float(w.x << 16); qv[c * 8 + 1] = __uint_as_float(w.x & 0xffff0000u);
        qv[c * 8 + 2] = __uint_as_float(w.y << 16); qv[c * 8 + 3] = __uint_as_float(w.y & 0xffff0000u);
        qv[c * 8 + 4] = __uint_as_float(w.z << 16); qv[c * 8 + 5] = __uint_as_float(w.z & 0xffff0000u);
        qv[c * 8 + 6] = __uint_as_float(w.w << 16); qv[c * 8 + 7] = __uint_as_float(w.w & 0xffff0000u);
      }
      if (par == 0) { float qq = 0.f;
#pragma unroll
        for (int d = 0; d < 64; ++d) qq = fmaf(qv[d], qv[d], qq);
        bq[q] = sqrtf(qq) * kmax; }
      for (int j = par; j < qblk; j += 2) {
        float g = 0.f;
#pragma unroll
        for (int d = 0; d < 64; ++d) g = fmaf(qv[d], kms[j * 64 + d], g);
        gat[q * 16 + j] = g;
      }
    }
    __syncthreads();
    if (tid < 256) {
      float b0 = -INFINITY, b1 = -INFINITY, b2 = -INFINITY; int i0 = 0, i1 = 0, i2 = 0;
      for (int j = 0; j < qblk; ++j) {
        float g = gat[tid * 16 + j];
        if (g > b0) { b2 = b1; i2 = i1; b1 = b0; i1 = i0; b0 = g; i0 = j; }
        else if (g > b1) { b2 = b1; i2 = i1; b1 = g; i1 = j; }
        else if (g > b2) { b2 = g; i2 = j; }
      }
      const int nsel = qblk < 3 ? qblk : 3;
      selp[tid] = (unsigned)i0 | ((unsigned)i1 << 4) | ((unsigned)i2 << 8) | ((unsigned)nsel << 12);
    }
    __syncthreads();
    for (int j = wv; j < qblk; j += 8) {
      int base = 0;
      for (int c = 0; c < 4; ++c) {
        const int q = c * 64 + lane;
        const unsigned sp = selp[q];
        const int ns = sp >> 12;
        const bool f = (ns > 0 && (int)(sp & 15) == j) || (ns > 1 && (int)((sp >> 4) & 15) == j) || (ns > 2 && (int)((sp >> 8) & 15) == j);
        const unsigned long long bal = __ballot(f);
        const int pos = base + __popcll(bal & ((1ull << lane) - 1ull));
        if (f) lists[j * 256 + pos] = (unsigned char)q;
        base += __popcll(bal);
      }
      if (lane == 0) cnt[j] = base;
    }
    __syncthreads();
    if (tid == 0) {
      int ni = 0;
#pragma unroll 1
      for (int g = 7; g >= 0; --g) items[ni++] = (16 << 8) | g;
      for (int j = 0; j < qblk; ++j) { const int ng = (cnt[j] + 31) >> 5; for (int g = 0; g < ng; ++g) items[ni++] = (j << 8) | g; }
      ctr[0] = ni; ctr[1] = 0;
    }
    __syncthreads();
    const int nitems = ctr[0];
    for (;;) {
      int it = 0;
      if (lane == 0) it = atomicAdd(&ctr[1], 1);
      it = __builtin_amdgcn_readfirstlane(it);
      if (it >= nitems) break;
      const int item = items[it];
      const int j = item >> 8, g = item & 255;
      const bool own = (j == 16);
      const int kb = own ? qblk : j;
      const int ntile = own ? (g + 1) : 8;
      int qi; bool valid;
      if (own) { qi = g * 32 + n; valid = true; }
      else { const int pos = g * 32 + n; valid = pos < cnt[j]; qi = lists[j * 256 + (valid ? pos : 0)]; }
      const bf16_t* kt0 = p.Km() + ((size_t)bh * (S / 32) + kb * 8) * 2048 + lane * 8;
      const bf16_t* vt0 = p.Vm() + ((size_t)bh * (S / 32) + kb * 8) * 2048 + lane * 8;
      f32x16 O0, O1;
#pragma unroll
      for (int r = 0; r < 16; ++r) { O0[r] = 0.f; O1[r] = 0.f; }
      float lsum = 0.f;
      const float nbq = -bq[qi];
      bf16x8 kf[3][4], vf[3][4];
#define MOBA_LOAD(KT_, BUF_) { _Pragma("unroll") for (int s = 0; s < 4; ++s) { kf[BUF_][s] = *(const bf16x8*)(kt0 + (size_t)(KT_) * 2048 + s * 512); vf[BUF_][s] = *(const bf16x8*)(vt0 + (size_t)(KT_) * 2048 + s * 512); } }
#define MOBA_STEP(KT_, BUF_)                                                                                                           \
      if ((KT_) < ntile) {                                                                                                               \
        if ((KT_) + 2 < ntile) MOBA_LOAD((KT_) + 2, ((BUF_) + 2) % 3)                                                                     \
        f32x16 X;                                                                                                                         \
        _Pragma("unroll") for (int r = 0; r < 16; ++r) X[r] = nbq;                                                                        \
        _Pragma("unroll") for (int s = 0; s < 4; ++s) X = __builtin_amdgcn_mfma_f32_32x32x16_bf16(kf[BUF_][s], *(const bf16x8*)(Qs + qi * 64 + (2 * s + hh) * 8), X, 0, 0, 0);     \
        const bool diag = own && ((KT_) == g);                                                                                            \
        unsigned pw[8];                                                                                                                   \
        _Pragma("unroll") for (int r = 0; r < 16; r += 2) {                                                                               \
          float e0 = __builtin_amdgcn_exp2f(X[r]), e1 = __builtin_amdgcn_exp2f(X[r + 1]);                                                 \
          if (diag) {                                                                                                                     \
            const int k0 = (r & 3) + 8 * (r >> 2) + 4 * hh, k1 = ((r + 1) & 3) + 8 * ((r + 1) >> 2) + 4 * hh;                             \
            e0 = (k0 <= n) ? e0 : 0.f; e1 = (k1 <= n) ? e1 : 0.f;                                                                         \
          }                                                                                                                               \
          lsum += e0 + e1;                                                                                                                \
          pw[r >> 1] = pk_bf16(e0, e1);                                                                                                   \
        }                                                                                                                                 \
        bf16x8 pf0, pf1;                                                                                                                  \
        { uint4 t0 = make_uint4(pw[0], pw[1], pw[2], pw[3]), t1 = make_uint4(pw[4], pw[5], pw[6], pw[7]);                                 \
          pf0 = *(bf16x8*)&t0; pf1 = *(bf16x8*)&t1; }                                                                                     \
        O0 = __builtin_amdgcn_mfma_f32_32x32x16_bf16(vf[BUF_][0], pf0, O0, 0, 0, 0);                                                      \
        O0 = __builtin_amdgcn_mfma_f32_32x32x16_bf16(vf[BUF_][1], pf1, O0, 0, 0, 0);                                                      \
        O1 = __builtin_amdgcn_mfma_f32_32x32x16_bf16(vf[BUF_][2], pf0, O1, 0, 0, 0);                                                      \
        O1 = __builtin_amdgcn_mfma_f32_32x32x16_bf16(vf[BUF_][3], pf1, O1, 0, 0, 0);                                                      \
      }
      MOBA_LOAD(0, 0)
      if (ntile > 1) MOBA_LOAD(1, 1)
#pragma unroll 1
      for (int kt3 = 0; kt3 < ntile; kt3 += 3) {
        MOBA_STEP(kt3, 0) MOBA_STEP(kt3 + 1, 1) MOBA_STEP(kt3 + 2, 2)
      }
#undef MOBA_STEP
#undef MOBA_LOAD
      lsum += __shfl_xor(lsum, 32);
      if (valid) {
        if (hh == 0) atomicAdd(&lacc[qi], __float2int_rn(lsum * 1048576.0f));
#pragma unroll
        for (int r = 0; r < 16; ++r) {
          const int dim = (r & 3) + 8 * (r >> 2) + 4 * hh;
          atomicAdd(&Oacc[dim * OLD + qi], __float2int_rn(O0[r] * 1048576.0f));
          atomicAdd(&Oacc[(dim + 32) * OLD + qi], __float2int_rn(O1[r] * 1048576.0f));
        }
      }
    }
    __syncthreads();
    { const int q = tid >> 1, half = tid & 1;
      const float inv = 1.0f / (float)lacc[q];
      float o[32], ss = 0.f;
#pragma unroll
      for (int d = 0; d < 32; ++d) { o[d] = (float)Oacc[(half * 32 + d) * OLD + q] * inv; ss += o[d] * o[d]; }
      ss += __shfl_xor(ss, 1);
      const float r = rsqrtf(ss / 64.0f + EPS);
      bf16_t* dst = p.xb() + (size_t)(b * S + qblk * 256 + q) * KD + 256 + h * 64 + half * 32;
#pragma unroll
      for (int d = 0; d < 32; d += 8) *(uint4*)(dst + d) = make_uint4(pk_bf16(o[d] * r, o[d + 1] * r), pk_bf16(o[d + 2] * r, o[d + 3] * r), pk_bf16(o[d + 4] * r, o[d + 5] * r), pk_bf16(o[d + 6] * r, o[d + 7] * r));
    }
  }
}


__device__ __forceinline__ float ret_log2g(int h) { return log2f(1.0f - exp2f(-5.0f - (float)h)); }
__device__ __forceinline__ void phase_ret_kv(const Params& p, int gw, int ngw, int lane) {
  const int n = lane & 31, hh = lane >> 5;
  for (int w = gw; w < NB * 4 * 32; w += ngw) {
    const int bh = w >> 5, cn = w & 31;
    const bf16_t* vt = p.Vr() + ((size_t)bh * (S / 32) + cn * 4) * 2048 + lane * 8;
    const bf16_t* kt = p.Krv() + ((size_t)bh * (S / 32) + cn * 4) * 2048 + lane * 8;
    f32x16 acc[2][2];
#pragma unroll
    for (int a = 0; a < 2; ++a)
#pragma unroll
      for (int b2 = 0; b2 < 2; ++b2)
#pragma unroll
        for (int r = 0; r < 16; ++r) acc[a][b2][r] = 0.f;
#pragma unroll 1
    for (int tl = 0; tl < 4; ++tl)
#pragma unroll
      for (int ks = 0; ks < 2; ++ks) {
        bf16x8 vf[2], kf[2];
#pragma unroll
        for (int x = 0; x < 2; ++x) { vf[x] = *(const bf16x8*)(vt + tl * 2048 + (x * 2 + ks) * 512); kf[x] = *(const bf16x8*)(kt + tl * 2048 + (x * 2 + ks) * 512); }
#pragma unroll
        for (int mb = 0; mb < 2; ++mb)
#pragma unroll
          for (int nb = 0; nb < 2; ++nb) acc[mb][nb] = __builtin_amdgcn_mfma_f32_32x32x16_bf16(vf[mb], kf[nb], acc[mb][nb], 0, 0, 0);
      }
    float* dst = p.KVr() + ((size_t)bh * 32 + cn) * 4096;
#pragma unroll
    for (int mb = 0; mb < 2; ++mb)
#pragma unroll
      for (int nb = 0; nb < 2; ++nb)
#pragma unroll
        for (int r = 0; r < 16; ++r) dst[(mb * 32 + (r & 3) + 8 * (r >> 2) + 4 * hh) * 64 + nb * 32 + n] = acc[mb][nb][r];
  }
}
__device__ __forceinline__ void phase_ret_scan(const Params& p, int gtid, int ngt) {
  for (int it = gtid; it < NB * 4 * 4096; it += ngt) {
    const int e = it & 4095, bh = it >> 12, h = bh & 3;
    const float l2g = ret_log2g(h), g1 = exp2f(l2g), g127 = exp2f(127.0f * l2g), g128 = exp2f(128.0f * l2g);
    float R = 0.f; float kv[32];
#pragma unroll
    for (int cn = 0; cn < 32; ++cn) kv[cn] = p.KVr()[((size_t)bh * 32 + cn) * 4096 + e];
#pragma unroll
    for (int cn = 0; cn < 32; ++cn) {
      p.Rb()[((size_t)bh * 32 + cn) * 4096 + e] = f2bf(g1 * R);
      R = g128 * R + g127 * kv[cn];
    }
  }
}
__device__ __forceinline__ void phase_ret_out(const Params& p, int gw, int ngw, int lane) {
  const int n = lane & 31, hh = lane >> 5;
  for (int w = gw; w < NB * 4 * 32 * 4; w += ngw) {
    const int qg = 3 - (w & 3), cn = (w >> 2) & 31, bh = w >> 7, b = bh >> 2, h = bh & 3;
    const int s0 = cn * 128 + qg * 32;
    bf16x8 qf[4];
#pragma unroll
    for (int s = 0; s < 4; ++s) qf[s] = *(const bf16x8*)(p.Qr() + ((size_t)bh * S + s0 + n) * 64 + (2 * s + hh) * 8);
    f32x16 O0, O1;
#pragma unroll
    for (int r = 0; r < 16; ++r) { O0[r] = 0.f; O1[r] = 0.f; }
    { const bf16_t* rb = p.Rb() + ((size_t)bh * 32 + cn) * 4096 + (size_t)n * 64 + hh * 8;
#pragma unroll
      for (int s = 0; s < 4; ++s) {
        const bf16x8 r0 = *(const bf16x8*)(rb + s * 16), r1 = *(const bf16x8*)(rb + 32 * 64 + s * 16);
        O0 = __builtin_amdgcn_mfma_f32_32x32x16_bf16(r0, qf[s], O0, 0, 0, 0);
        O1 = __builtin_amdgcn_mfma_f32_32x32x16_bf16(r1, qf[s], O1, 0, 0, 0);
      } }
    const bf16_t* kt0 = p.Kr() + ((size_t)bh * (S / 32) + cn * 4) * 2048 + lane * 8;
    const bf16_t* vt0 = p.Vr() + ((size_t)bh * (S / 32) + cn * 4) * 2048 + lane * 8;
    for (int kt = 0; kt <= qg; ++kt) {
      bf16x8 kf[4], vf[4];
#pragma unroll
      for (int s = 0; s < 4; ++s) { kf[s] = *(const bf16x8*)(kt0 + (size_t)kt * 2048 + s * 512); vf[s] = *(const bf16x8*)(vt0 + (size_t)kt * 2048 + s * 512); }
      f32x16 X;
#pragma unroll
      for (int r = 0; r < 16; ++r) X[r] = 0.f;
#pragma unroll
      for (int s = 0; s < 4; ++s) X = __builtin_amdgcn_mfma_f32_32x32x16_bf16(kf[s], qf[s], X, 0, 0, 0);
      const bool diag = (kt == qg);
      unsigned pw[8];
#pragma unroll
      for (int r = 0; r < 16; r += 2) {
        float e0 = X[r], e1 = X[r + 1];
        if (diag) {
          const int k0 = (r & 3) + 8 * (r >> 2) + 4 * hh, k1 = ((r + 1) & 3) + 8 * ((r + 1) >> 2) + 4 * hh;
          e0 = (k0 <= n) ? e0 : 0.f; e1 = (k1 <= n) ? e1 : 0.f;
        }
        pw[r >> 1] = pk_bf16(e0, e1);
      }
      bf16x8 pf0, pf1;
      { uint4 t0 = make_uint4(pw[0], pw[1], pw[2], pw[3]), t1 = make_uint4(pw[4], pw[5], pw[6], pw[7]);
        pf0 = *(bf16x8*)&t0; pf1 = *(bf16x8*)&t1; }
      O0 = __builtin_amdgcn_mfma_f32_32x32x16_bf16(vf[0], pf0, O0, 0, 0, 0);
      O0 = __builtin_amdgcn_mfma_f32_32x32x16_bf16(vf[1], pf1, O0, 0, 0, 0);
      O1 = __builtin_amdgcn_mfma_f32_32x32x16_bf16(vf[2], pf0, O1, 0, 0, 0);
      O1 = __builtin_amdgcn_mfma_f32_32x32x16_bf16(vf[3], pf1, O1, 0, 0, 0);
    }
    float ss = 0.f;
#pragma unroll
    for (int r = 0; r < 16; ++r) ss += O0[r] * O0[r] + O1[r] * O1[r];
    ss += __shfl_xor(ss, 32);
    const float rn = rsqrtf(ss / 64.0f + EPS);
    const size_t t = (size_t)b * S + s0 + n;
    const bf16_t* gp = p.projb() + t * INW + OFF_GR + h * 64;
    bf16_t* yo = p.xb() + t * KD + 768 + h * 64;
#pragma unroll
    for (int q4 = 0; q4 < 4; ++q4) {
#pragma unroll
      for (int mb = 0; mb < 2; ++mb) {
        const int d0 = mb * 32 + 8 * q4 + 4 * hh;
        const uint2 gw2 = *(const uint2*)(gp + d0); const float4 g = make_float4(__uint_as_float(gw2.x << 16), __uint_as_float(gw2.x & 0xffff0000u), __uint_as_float(gw2.y << 16), __uint_as_float(gw2.y & 0xffff0000u));
        float4 o;
        const f32x16& Oa = mb ? O1 : O0;
        o.x = Oa[q4 * 4 + 0] * rn * g.x * fast_sigmoid(g.x); o.y = Oa[q4 * 4 + 1] * rn * g.y * fast_sigmoid(g.y);
        o.z = Oa[q4 * 4 + 2] * rn * g.z * fast_sigmoid(g.z); o.w = Oa[q4 * 4 + 3] * rn * g.w * fast_sigmoid(g.w);
        *(uint2*)(yo + d0) = make_uint2(pk_bf16(o.x, o.y), pk_bf16(o.z, o.w));
      }
    }
  }
}

__device__ __forceinline__ void phase_post_pack(const Params& p, int l, int gtid, int ngt, int gw, int ngw, int lane) {
  const float* gq = p.inp(12) + l * 64; const float* gk = p.inp(13) + l * 64;
  for (int t = gw; t < T; t += ngw) {
    const int s = t % S, b = t / S;
    const bf16_t* row = p.projb() + (size_t)t * INW;
    float vin[24];
#pragma unroll
    for (int sl = 0; sl < 16; ++sl) vin[sl] = bf2f(row[(sl < 8 ? OFF_QM : OFF_KM) + (sl & 7) * 64 + lane]);
#pragma unroll
    for (int sl = 0; sl < 8; ++sl) vin[16 + sl] = bf2f(row[(sl < 4 ? OFF_QR : OFF_KR) + (sl & 3) * 64 + lane]);
    const float cm = p.cosm()[s * 8 + (lane & 7)], sm = p.sinm()[s * 8 + (lane & 7)];
    const float cr = p.cosr()[s * 32 + (lane & 31)], sr = p.sinr()[s * 32 + (lane & 31)];
    const float gqv = gq[lane], gkv = gk[lane];
#pragma unroll
    for (int slot = 0; slot < 16; ++slot) {
      const int h = slot & 7, bh = b * 8 + h; const bool isk = slot >= 8;
      const float v = vin[slot];
      const float ss = wave_sum(v * v);
      const float u = v * rsqrtf(ss / 64.0f + EPS) * (isk ? gkv : gqv);
      const float pu = __shfl(u, (lane < 8 ? lane + 8 : lane - 8) & 63);
      float o = u;
      if (lane < 16) o = lane < 8 ? (u * cm - pu * sm) : (u * cm + pu * sm);
      if (!isk) p.Qm()[((size_t)bh * S + s) * 64 + lane] = f2bf(o * QSCALE);
      else p.Km()[((((size_t)bh * (S / 32) + (s >> 5)) * 8 + (lane >> 3)) * 32 + (s & 31)) * 8 + (lane & 7)] = f2bf(o);
    }
#pragma unroll
    for (int slot = 16; slot < 24; ++slot) {
      const int h = (slot - 16) & 3, bh = b * 4 + h; const bool isk = slot >= 20;
      const float v = vin[slot];
      const float pv = __shfl(v, lane ^ 32);
      const float o = lane < 32 ? (v * cr - pv * sr) : (v * cr + pv * sr);
      const float l2g = ret_log2g(h); const int pos = s & 127;
      if (!isk) p.Qr()[((size_t)bh * S + s) * 64 + lane] = f2bf(o * exp2f((float)pos * l2g));
      else p.Kr()[((((size_t)bh * (S / 32) + (s >> 5)) * 8 + (lane >> 3)) * 32 + (s & 31)) * 8 + (lane & 7)] = f2bf(o * 0.125f * exp2f(-(float)pos * l2g));
    }
  }
  for (int idx = gtid; idx < NB * 8 * (S / 32) * 256; idx += ngt) {
    const int ln = idx & 63, ks = (idx >> 6) & 1, mb = (idx >> 7) & 1, tile = (idx >> 8) % (S / 32), bh = idx / (256 * (S / 32));
    const int b = bh >> 3, h = bh & 7, hh = ln >> 5, delta = mb * 32 + (ln & 31);
    float v[8];
#pragma unroll
    for (int j = 0; j < 8; ++j) { const int kappa = 16 * ks + 8 * (j >> 2) + 4 * hh + (j & 3), s = tile * 32 + kappa; v[j] = bf2f(p.projb()[(size_t)(b * S + s) * INW + OFF_VM + h * 64 + delta]); }
    uint4 o; o.x = pk_bf16(v[0], v[1]); o.y = pk_bf16(v[2], v[3]); o.z = pk_bf16(v[4], v[5]); o.w = pk_bf16(v[6], v[7]);
    *(uint4*)(p.Vm() + (size_t)idx * 8) = o;
  }
  for (int idx = gtid; idx < 2 * NB * 4 * (S / 32) * 256; idx += ngt) {
    const int ln = idx & 63, ks = (idx >> 6) & 1, blk = (idx >> 7) & 1, tile = (idx >> 8) % (S / 32), rest = idx / (256 * (S / 32)), bh = rest % (NB * 4), which = rest / (NB * 4);
    const int b = bh >> 2, h = bh & 3, hh = ln >> 5, delta = blk * 32 + (ln & 31);
    const float l2g = ret_log2g(h);
    float v[8];
#pragma unroll
    for (int j = 0; j < 8; ++j) {
      const int kappa = 16 * ks + 8 * (j >> 2) + 4 * hh + (j & 3), s = tile * 32 + kappa;
      const bf16_t* row = p.projb() + (size_t)(b * S + s) * INW;
      float x;
      if (which) {
        const float a = bf2f(row[OFF_KR + h * 64 + delta]), pa = bf2f(row[OFF_KR + h * 64 + (delta ^ 32)]);
        const int i = delta & 31; const float c = p.cosr()[s * 32 + i], sn = p.sinr()[s * 32 + i];
        x = (delta < 32 ? (a * c - pa * sn) : (a * c + pa * sn)) * 0.125f * exp2f(-(float)(s & 127) * l2g);
      } else x = bf2f(row[OFF_VR + h * 64 + delta]);
      v[j] = x;
    }
    uint4 o; o.x = pk_bf16(v[0], v[1]); o.y = pk_bf16(v[2], v[3]); o.z = pk_bf16(v[4], v[5]); o.w = pk_bf16(v[6], v[7]);
    *(uint4*)((which ? p.Krv() : p.Vr()) + ((size_t)(idx % (NB * 4 * (S / 32) * 256))) * 8) = o;
  }
}
__device__ __forceinline__ void phase_kmean2(const Params& p, int gtid, int ngt) {
  for (int idx = gtid; idx < NB * 8 * 16 * 64; idx += ngt) {
    const int d = idx & 63, j = (idx >> 6) & 15, bh = idx >> 10, c = d >> 3, dj = d & 7;
    float acc = 0.f;
    for (int tl = 0; tl < 8; ++tl) {
      const bf16_t* kp = p.Km() + (((size_t)bh * (S / 32) + j * 8 + tl) * 8 + c) * 256 + dj;
#pragma unroll 8
      for (int key = 0; key < 32; ++key) acc += bf2f(kp[key * 8]);
    }
    p.kmean()[idx] = acc * (1.0f / 256.0f);
  }
}

__device__ __forceinline__ void cvt_f32_bf16(const float* __restrict__ src, bf16_t* __restrict__ dst, size_t n8, int gtid, int ngt) {
  for (size_t i = gtid; i < n8; i += ngt) {
    float4 a = *(const float4*)(src + i * 8), b4 = *(const float4*)(src + i * 8 + 4);
    uint4 o; o.x = pk_bf16(a.x, a.y); o.y = pk_bf16(a.z, a.w); o.z = pk_bf16(b4.x, b4.y); o.w = pk_bf16(b4.z, b4.w);
    *(uint4*)(dst + i * 8) = o;
  }
}
__device__ __forceinline__ int f2key(float f) { int b = __float_as_int(f); return b ^ ((b >> 31) & 0x7fffffff); }
__device__ __forceinline__ float key2f(int k) { return __int_as_float(k ^ ((k >> 31) & 0x7fffffff)); }
#define CASD(a_, b_) { int mx_ = max(a_, b_), mn_ = min(a_, b_); a_ = mx_; b_ = mn_; }
__device__ __forceinline__ void sort16_desc(int (&v)[16]) {
#pragma unroll
  for (int k = 2; k <= 16; k <<= 1)
#pragma unroll
    for (int j = k >> 1; j > 0; j >>= 1)
#pragma unroll
      for (int i = 0; i < 16; ++i) { const int l2 = i ^ j; if (l2 > i) { if ((i & k) == 0) CASD(v[i], v[l2]) else CASD(v[l2], v[i]) } }
}
__device__ __forceinline__ void merge_top16(int (&a)[16], const int (&b)[16]) {
#pragma unroll
  for (int i = 0; i < 16; ++i) a[i] = max(a[i], b[15 - i]);
#pragma unroll
  for (int j = 8; j > 0; j >>= 1)
#pragma unroll
    for (int i = 0; i < 16; ++i) { const int l2 = i ^ j; if (l2 > i) CASD(a[i], a[l2]) }
}
__device__ __forceinline__ int lut4(int w0, int w1, int w2, int w3, int i) {
  const int w = i >> 2; const int d = (w == 0) ? w0 : (w == 1) ? w1 : (w == 2) ? w2 : w3;
  return (d >> ((i & 3) * 8)) & 127;
}

__device__ __forceinline__ void phase_peer_topk(const Params& p, int l, int gw, int ngw, int lane) {
  const int n = lane & 31, hh = lane >> 5;
  const bf16_t* skl = p.skb() + (size_t)l * 16 * 128 * 64;
  for (int w = gw; w < (T / 32) * 8; w += ngw) {
    const int tg = w >> 3, h = w & 7, t = tg * 32 + n;
    int L0[16], L1[16];
#pragma unroll
    for (int c = 0; c < 2; ++c) {
      const int hc = 2 * h + c;
      bf16x8 qf[4];
#pragma unroll
      for (int s = 0; s < 4; ++s) qf[s] = *(const bf16x8*)(p.qb() + (size_t)t * D + hc * 64 + 16 * s + 8 * hh);
      int A[16], Bq[16];
#pragma unroll
      for (int mb = 0; mb < 4; ++mb) {
        f32x16 X;
#pragma unroll
        for (int r = 0; r < 16; ++r) X[r] = 0.f;
#pragma unroll
        for (int s = 0; s < 4; ++s) {
          const bf16x8 kf = *(const bf16x8*)(skl + ((size_t)(hc * 128 + mb * 32 + n)) * 64 + 16 * s + 8 * hh);
          X = __builtin_amdgcn_mfma_f32_32x32x16_bf16(kf, qf[s], X, 0, 0, 0);
        }
        int Gk[16];
#pragma unroll
        for (int r = 0; r < 16; ++r) Gk[r] = (f2key(X[r]) & ~127) | (mb * 32 + (r & 3) + 8 * (r >> 2) + 4 * hh);
        sort16_desc(Gk);
        if (mb == 0) {
#pragma unroll
          for (int r = 0; r < 16; ++r) A[r] = Gk[r];
        } else merge_top16(A, Gk);
      }
#pragma unroll
      for (int r = 0; r < 16; ++r) Bq[r] = __shfl_xor(A[r], 32);
      merge_top16(A, Bq);
#pragma unroll
      for (int r = 0; r < 16; ++r) { if (c == 0) L0[r] = A[r]; else L1[r] = A[r]; }
    }
    float av[16], bv[16];
#pragma unroll
    for (int r = 0; r < 16; ++r) { av[r] = key2f(L0[r] & ~127); bv[r] = key2f(L1[r] & ~127); }
#define CAND(i_, j_) ((f2key(av[i_] + bv[j_]) & ~255) | ((i_) << 4) | (j_))
    int R[16], G1[16], G2[16];
#pragma unroll
    for (int j = 0; j < 16; ++j) R[j] = CAND(0, j);
    G1[0] = CAND(1, 0); G1[1] = CAND(1, 1); G1[2] = CAND(1, 2); G1[3] = CAND(1, 3); G1[4] = CAND(1, 4); G1[5] = CAND(1, 5); G1[6] = CAND(1, 6); G1[7] = CAND(1, 7);
    G1[8] = CAND(2, 0); G1[9] = CAND(2, 1); G1[10] = CAND(2, 2); G1[11] = CAND(2, 3); G1[12] = CAND(2, 4); G1[13] = CAND(3, 0); G1[14] = CAND(3, 1); G1[15] = CAND(3, 2);
    G2[0] = CAND(3, 3); G2[1] = CAND(4, 0); G2[2] = CAND(4, 1); G2[3] = CAND(4, 2); G2[4] = CAND(5, 0); G2[5] = CAND(5, 1); G2[6] = CAND(6, 0); G2[7] = CAND(6, 1);
    G2[8] = CAND(7, 0); G2[9] = CAND(7, 1); G2[10] = CAND(8, 0); G2[11] = CAND(9, 0); G2[12] = CAND(10, 0); G2[13] = CAND(11, 0); G2[14] = CAND(12, 0); G2[15] = CAND(13, 0);
    sort16_desc(G1); merge_top16(R, G1);
    sort16_desc(G2); merge_top16(R, G2);
    { int x0 = CAND(14, 0), x1 = CAND(15, 0);
#pragma unroll
      for (int i = 0; i < 16; ++i) CASD(R[i], x0)
#pragma unroll
      for (int i = 0; i < 16; ++i) CASD(R[i], x1)
    }
#undef CAND
    int pa0 = 0, pa1 = 0, pa2 = 0, pa3 = 0, pb0 = 0, pb1 = 0, pb2 = 0, pb3 = 0;
#pragma unroll
    for (int q = 0; q < 4; ++q) {
      pa0 |= (L0[q] & 127) << (8 * q); pa1 |= (L0[4 + q] & 127) << (8 * q); pa2 |= (L0[8 + q] & 127) << (8 * q); pa3 |= (L0[12 + q] & 127) << (8 * q);
      pb0 |= (L1[q] & 127) << (8 * q); pb1 |= (L1[4 + q] & 127) << (8 * q); pb2 |= (L1[8 + q] & 127) << (8 * q); pb3 |= (L1[12 + q] & 127) << (8 * q);
    }
    float ev[16], sum = 0.f; int ei[16];
    const float mx = key2f(R[0] & ~255);
#pragma unroll
    for (int z = 0; z < 16; ++z) {
      const float v = key2f(R[z] & ~255);
      ev[z] = __expf(v - mx); sum += ev[z];
      const int pay = R[z] & 255;
      ei[z] = lut4(pa0, pa1, pa2, pa3, pay >> 4) * 128 + lut4(pb0, pb1, pb2, pb3, pay & 15);
    }
    const float inv = 1.0f / sum;
    if (hh == 0) {
      float* go = p.gates() + ((size_t)t * 8 + h) * 16; int* eo = p.eidx() + ((size_t)t * 8 + h) * 16;
#pragma unroll
      for (int z = 0; z < 16; z += 4) {
        *(float4*)(go + z) = make_float4(ev[z] * inv, ev[z + 1] * inv, ev[z + 2] * inv, ev[z + 3] * inv);
        *(int4*)(eo + z) = make_int4(ei[z], ei[z + 1], ei[z + 2], ei[z + 3]);
      }
    }
  }
}


typedef int v8i __attribute__((ext_vector_type(8)));
__device__ __forceinline__ unsigned xcc_id() { return (unsigned)__builtin_amdgcn_s_getreg((3 << 11) | 20) & 7u; }
__device__ __forceinline__ float pow2_scale(float amax) {
  if (!(amax > 0.f)) return 1.0f;
  const int e = (int)floorf(log2f(240.0f / amax));
  return exp2f((float)(e < 60 ? (e > -60 ? e : -60) : 60));
}
__device__ __forceinline__ unsigned pack4_fp8(float a, float b, float c, float d) {
  int v = __builtin_amdgcn_cvt_pk_fp8_f32(a, b, 0, false);
  v = __builtin_amdgcn_cvt_pk_fp8_f32(c, d, v, true);
  return (unsigned)v;
}
__device__ __forceinline__ void cvt_table_i8(const float* __restrict__ src, unsigned char* __restrict__ dst, float* __restrict__ scl, int gw, int ngw, int lane) {
  for (int e0 = gw; e0 < 16384; e0 += 2 * ngw) {
    float4 v[2][4];
#pragma unroll
    for (int u = 0; u < 2; ++u) { const int e = (e0 + u * ngw < 16384) ? e0 + u * ngw : e0;
#pragma unroll
      for (int k = 0; k < 4; ++k) v[u][k] = *(const float4*)(src + (size_t)e * D + k * 256 + lane * 4); }
#pragma unroll
    for (int u = 0; u < 2; ++u) {
      const int e = e0 + u * ngw;
      if (e < 16384) {
        float am = 0.f;
#pragma unroll
        for (int k = 0; k < 4; ++k) am = fmaxf(am, fmaxf(fmaxf(fabsf(v[u][k].x), fabsf(v[u][k].y)), fmaxf(fabsf(v[u][k].z), fabsf(v[u][k].w))));
        am = wave_max(am);
        const float s = am > 0.f ? 127.0f / am : 1.0f;
        if (lane == 0) scl[e] = s;
#pragma unroll
        for (int k = 0; k < 4; ++k) {
          const int slice = 2 * k + (lane >> 5), off = (lane & 31) * 4;
          const unsigned w = (unsigned)(__float2int_rn(v[u][k].x * s) & 255) | ((unsigned)(__float2int_rn(v[u][k].y * s) & 255) << 8) |
                             ((unsigned)(__float2int_rn(v[u][k].z * s) & 255) << 16) | ((unsigned)(__float2int_rn(v[u][k].w * s) & 255) << 24);
          *(unsigned*)(dst + ((size_t)slice * 16384 + e) * 128 + off) = w;
        }
      }
    }
  }
}
__device__ __forceinline__ void cvt_table_fp8(const float* __restrict__ src, unsigned char* __restrict__ dst, float* __restrict__ scl, int gw, int ngw, int lane) {
  for (int e0 = gw; e0 < 16384; e0 += 2 * ngw) {
    float4 v[2][4];
#pragma unroll
    for (int u = 0; u < 2; ++u) { const int e = (e0 + u * ngw < 16384) ? e0 + u * ngw : e0;
#pragma unroll
      for (int k = 0; k < 4; ++k) v[u][k] = *(const float4*)(src + (size_t)e * D + k * 256 + lane * 4); }
#pragma unroll
    for (int u = 0; u < 2; ++u) {
      const int e = e0 + u * ngw;
      if (e < 16384) {
        float am = 0.f;
#pragma unroll
        for (int k = 0; k < 4; ++k) am = fmaxf(am, fmaxf(fmaxf(fabsf(v[u][k].x), fabsf(v[u][k].y)), fmaxf(fabsf(v[u][k].z), fabsf(v[u][k].w))));
        am = wave_max(am);
        const float s = pow2_scale(am);
        if (lane == 0) scl[e] = s;
#pragma unroll
        for (int k = 0; k < 4; ++k) {
          const int slice = 2 * k + (lane >> 5), off = (lane & 31) * 4;
          *(unsigned*)(dst + ((size_t)slice * 16384 + e) * 128 + off) = pack4_fp8(v[u][k].x * s, v[u][k].y * s, v[u][k].z * s, v[u][k].w * s);
        }
      }
    }
  }
}
#define DPP_ADD(v_, ctrl_) ((v_) + __builtin_bit_cast(float, __builtin_amdgcn_update_dpp(0, __builtin_bit_cast(int, (v_)), (ctrl_), 0xF, 0xF, true)))
__device__ __forceinline__ float sum_xor16(float x) { float a = x, b = x; asm volatile("v_nop\n\tv_nop\n\tv_permlane16_swap_b32 %0, %1" : "+v"(a), "+v"(b)); return a + b; }
__device__ __forceinline__ float sum_xor32(float x) { float a = x, b = x; asm volatile("v_nop\n\tv_nop\n\tv_permlane32_swap_b32 %0, %1" : "+v"(a), "+v"(b)); return a + b; }
constexpr int PEER_TILE = 128;
__device__ __forceinline__ void phase_peer_u(const Params& p, int* heads, unsigned char* lds, int tid) {
  const int lane = tid & 63, wv = tid >> 6, r8 = lane >> 3, c8 = lane & 7;
  int* bc = (int*)lds;
  int* eW = (int*)(lds + 1024 + wv * 12288);
  bf16_t* hW = (bf16_t*)(lds + 1024 + wv * 12288 + 8192);
  const int myx = (int)xcc_id();
  for (int pass = 0; pass < 8; ++pass) {
    const int s = (myx + pass) & 7;
    const unsigned char* Us = p.U8s() + (size_t)s * 16384 * 128 + c8 * 16;
    for (;;) {
      const int item = q_pull(heads + s, T / PEER_TILE, bc, tid);
      if (item < 0) break;
      const int t0 = item * PEER_TILE + wv * 16;
      LDS_FENCE();
      { uint2 ev[16];
        const bf16_t* hsrc = p.hb() + ((size_t)s * T + t0) * 128 + lane * 8;
#pragma unroll
        for (int k = 0; k < 16; ++k) ev[k] = *(const uint2*)(p.eidx() + (size_t)(t0 + k) * 128 + lane * 2);
        const uint4 hq0 = *(const uint4*)(hsrc), hq1 = *(const uint4*)(hsrc + 512), hq2 = *(const uint4*)(hsrc + 1024), hq3 = *(const uint4*)(hsrc + 1536);
#pragma unroll
        for (int k = 0; k < 16; ++k) *(uint2*)(eW + k * 128 + lane * 2) = ev[k];
        *(uint4*)(hW + lane * 8) = hq0; *(uint4*)(hW + 512 + lane * 8) = hq1; *(uint4*)(hW + 1024 + lane * 8) = hq2; *(uint4*)(hW + 1536 + lane * 8) = hq3; }
      LDS_FENCE();
      uint4 R[4][8];
#define PEER_U_LOAD(M_, BUF_) { _Pragma("unroll") for (int eb = 0; eb < 8; ++eb) R[BUF_][eb] = *(const uint4*)(Us + (size_t)eW[(M_) * 64 + eb * 8 + r8] * 128); }
      PEER_U_LOAD(0, 0) PEER_U_LOAD(1, 1) PEER_U_LOAD(2, 2)
      int hq[4]; float hinv = 0.f; float res0 = 0.f, res1 = 0.f;
#define PEER_U_LOADH(TOK_) { const bf16_t* hp = hW + (TOK_) * 128 + c8 * 16; const uint4 a = *(const uint4*)hp, b4 = *(const uint4*)(hp + 8); \
        const unsigned w8[8] = {a.x, a.y, a.z, a.w, b4.x, b4.y, b4.z, b4.w}; float hv[16]; float am = 0.f;                               \
        _Pragma("unroll") for (int z = 0; z < 8; ++z) { hv[2 * z] = __uint_as_float(w8[z] << 16); hv[2 * z + 1] = __uint_as_float(w8[z] & 0xffff0000u); \
          am = fmaxf(am, fmaxf(fabsf(hv[2 * z]), fabsf(hv[2 * z + 1]))); }                                                                \
        am = fmaxf(am, __builtin_bit_cast(float, __builtin_amdgcn_update_dpp(0, __builtin_bit_cast(int, am), 0xB1, 0xF, 0xF, true)));     \
        am = fmaxf(am, __builtin_bit_cast(float, __builtin_amdgcn_update_dpp(0, __builtin_bit_cast(int, am), 0x4E, 0xF, 0xF, true)));     \
        am = fmaxf(am, __builtin_bit_cast(float, __builtin_amdgcn_update_dpp(0, __builtin_bit_cast(int, am), 0x141, 0xF, 0xF, true)));    \
        const float hs = am > 0.f ? 127.0f / am : 1.0f; hinv = am > 0.f ? am * (1.0f / 127.0f) : 1.0f;                                    \
        _Pragma("unroll") for (int z = 0; z < 4; ++z) hq[z] = (__float2int_rn(hv[4 * z] * hs) & 255) | ((__float2int_rn(hv[4 * z + 1] * hs) & 255) << 8) | \
                                                               ((__float2int_rn(hv[4 * z + 2] * hs) & 255) << 16) | (__float2int_rn(hv[4 * z + 3] * hs) << 24); }
      PEER_U_LOADH(0)
#define PEER_U_HALF(M_, BUF_, HALF_)                                                                           \
      {                                                                                                                                   \
        if ((M_) + 3 < 32) PEER_U_LOAD((M_) + 3, ((BUF_) + 3) & 3)                                                                        \
        _Pragma("unroll") for (int eb = 0; eb < 8; ++eb) {                                                                                \
          int di = __builtin_amdgcn_sdot4((int)R[BUF_][eb].x, hq[0], 0, false);                                                           \
          di = __builtin_amdgcn_sdot4((int)R[BUF_][eb].y, hq[1], di, false);                                                              \
          di = __builtin_amdgcn_sdot4((int)R[BUF_][eb].z, hq[2], di, false);                                                              \
          di = __builtin_amdgcn_sdot4((int)R[BUF_][eb].w, hq[3], di, false);                                                              \
          di += __builtin_amdgcn_update_dpp(0, di, 0xB1, 0xF, 0xF, true); di += __builtin_amdgcn_update_dpp(0, di, 0x4E, 0xF, 0xF, true);   \
          di += __builtin_amdgcn_update_dpp(0, di, 0x141, 0xF, 0xF, true);     \
          const float d = (float)di * hinv;                                                                                               \
          if ((HALF_) == 0) { if (c8 == eb) res0 = d; } else { if (c8 == eb) res1 = d; }                                                  \
        }                                                                                                                                 \
        if ((HALF_) == 1) {                                                                                                               \
          float* po = p.ppart() + ((size_t)s * T + t0 + ((M_) >> 1)) * 128;                                                               \
          po[c8 * 8 + r8] = res0; po[64 + c8 * 8 + r8] = res1;                                                                            \
          if ((M_) + 1 < 32) PEER_U_LOADH(((M_) >> 1) + 1)                                                                                \
        }                                                                                                                                 \
      }
#pragma unroll
      for (int m4 = 0; m4 < 32; m4 += 4) {
        PEER_U_HALF(m4, 0, 0) PEER_U_HALF(m4 + 1, 1, 1) PEER_U_HALF(m4 + 2, 2, 0) PEER_U_HALF(m4 + 3, 3, 1)
      }
#undef PEER_U_HALF
#undef PEER_U_LOADH
#undef PEER_U_LOAD
    }
  }
}
__device__ __forceinline__ void phase_peer_r(const Params& p, int gtid, int ngt) {
  for (int idx0 = gtid; idx0 < T * 128; idx0 += 4 * ngt) {
    float d[4]; int e[4]; float su_[4], sv_[4], g_[4]; bool ok[4];
#pragma unroll
    for (int u = 0; u < 4; ++u) { const int idx = idx0 + u * ngt; ok[u] = idx < T * 128; const int ix = ok[u] ? idx : 0;
      e[u] = p.eidx()[ix]; g_[u] = p.gates()[ix]; float a = 0.f;
#pragma unroll
      for (int s = 0; s < 8; ++s) a += p.ppart()[(size_t)s * T * 128 + ix];
      d[u] = a; }
#pragma unroll
    for (int u = 0; u < 4; ++u) { su_[u] = p.su()[e[u]]; sv_[u] = p.sv()[e[u]]; }
#pragma unroll
    for (int u = 0; u < 4; ++u) if (ok[u]) p.gates()[idx0 + u * ngt] = g_[u] * gelu_tanh(d[u] * p.rstd()[(idx0 + u * ngt) >> 7] / su_[u]) / sv_[u];
  }
}
__device__ __forceinline__ void phase_peer_v(const Params& p, int* heads, unsigned char* lds, int tid) {
  const int lane = tid & 63, wv = tid >> 6, r8 = lane >> 3, c8 = lane & 7;
  int* bc = (int*)lds;
  uint2* pW = (uint2*)(lds + 1024 + wv * 16384);
  const int myx = (int)xcc_id();
  for (int pass = 0; pass < 8; ++pass) {
    const int s = (myx + pass) & 7;
    const unsigned char* Vs = p.V8s() + (size_t)s * 16384 * 128 + c8 * 16;
    for (;;) {
      const int item = q_pull(heads + s, T / PEER_TILE, bc, tid);
      if (item < 0) break;
      const int t0 = item * PEER_TILE + wv * 16;
      LDS_FENCE();
      { uint2 e2[16], g2[16];
#pragma unroll
        for (int k = 0; k < 16; ++k) { e2[k] = *(const uint2*)(p.eidx() + (size_t)(t0 + k) * 128 + lane * 2); g2[k] = *(const uint2*)(p.gates() + (size_t)(t0 + k) * 128 + lane * 2); }
#pragma unroll
        for (int k = 0; k < 16; ++k) *(uint4*)(pW + k * 128 + lane * 2) = make_uint4(e2[k].x, g2[k].x, e2[k].y, g2[k].y); }
      LDS_FENCE();
      const int rowk = lane >> 4, prow = ((rowk & 1) << 1) | (rowk >> 1);
      const bool wr_lane = (lane & 8) == 0;
      const int xoff = s * 128 + c8 * 16 + prow * 4;
      float4 xo[8];
#pragma unroll
      for (int k = 0; k < 8; ++k) xo[k] = *(const float4*)(p.outp() + (size_t)(t0 + k) * D + xoff);
      uint4 R[3][8];
#define PEER_V_LOAD(M_, BUF_) { _Pragma("unroll") for (int eb = 0; eb < 8; ++eb) R[BUF_][eb] = *(const uint4*)(Vs + (size_t)pW[(M_) * 64 + eb * 8 + r8].x * 128); }
      PEER_V_LOAD(0, 0) PEER_V_LOAD(1, 1)
      float acc[16];
#define PEER_V_HALF(M_, BUF_, HALF_)                                                           \
      {                                                                                                                                   \
        if ((M_) + 2 < 32) PEER_V_LOAD((M_) + 2, ((BUF_) + 2) % 3)                                                                        \
        if ((HALF_) == 0) { _Pragma("unroll") for (int z = 0; z < 16; ++z) acc[z] = 0.f; }                                                \
        _Pragma("unroll") for (int eb = 0; eb < 8; ++eb) {                                                                                \
          const float c = __uint_as_float(pW[(M_) * 64 + eb * 8 + r8].y);                                                                 \
          const unsigned ww[4] = {R[BUF_][eb].x, R[BUF_][eb].y, R[BUF_][eb].z, R[BUF_][eb].w};                                            \
          _Pragma("unroll") for (int q4 = 0; q4 < 4; ++q4) {                                                                              \
            const auto f01 = __builtin_amdgcn_cvt_pk_f32_fp8((int)ww[q4], false); const auto f23 = __builtin_amdgcn_cvt_pk_f32_fp8((int)ww[q4], true); \
            acc[q4 * 4 + 0] = fmaf(c, f01[0], acc[q4 * 4 + 0]); acc[q4 * 4 + 1] = fmaf(c, f01[1], acc[q4 * 4 + 1]);                       \
            acc[q4 * 4 + 2] = fmaf(c, f23[0], acc[q4 * 4 + 2]); acc[q4 * 4 + 3] = fmaf(c, f23[1], acc[q4 * 4 + 3]);                       \
          }                                                                                                                               \
        }                                                                                                                                 \
        if ((HALF_) == 1) {                                                                                                               \
          _Pragma("unroll") for (int z = 0; z < 16; ++z) acc[z] = DPP_ADD(acc[z], 0x128);                                  \
          asm volatile("v_nop\n\tv_nop\n\tv_permlane16_swap_b32 %0, %8\n\tv_permlane16_swap_b32 %1, %9\n\tv_permlane16_swap_b32 %2, %10\n\tv_permlane16_swap_b32 %3, %11\n\t" \
                       "v_permlane16_swap_b32 %4, %12\n\tv_permlane16_swap_b32 %5, %13\n\tv_permlane16_swap_b32 %6, %14\n\tv_permlane16_swap_b32 %7, %15" \
            : "+v"(acc[0]), "+v"(acc[1]), "+v"(acc[2]), "+v"(acc[3]), "+v"(acc[4]), "+v"(acc[5]), "+v"(acc[6]), "+v"(acc[7]),                   \
              "+v"(acc[8]), "+v"(acc[9]), "+v"(acc[10]), "+v"(acc[11]), "+v"(acc[12]), "+v"(acc[13]), "+v"(acc[14]), "+v"(acc[15]));               \
          _Pragma("unroll") for (int z = 0; z < 8; ++z) acc[z] += acc[z + 8];            \
          asm volatile("v_nop\n\tv_nop\n\tv_permlane32_swap_b32 %0, %4\n\tv_permlane32_swap_b32 %1, %5\n\tv_permlane32_swap_b32 %2, %6\n\tv_permlane32_swap_b32 %3, %7" \
            : "+v"(acc[0]), "+v"(acc[1]), "+v"(acc[2]), "+v"(acc[3]), "+v"(acc[4]), "+v"(acc[5]), "+v"(acc[6]), "+v"(acc[7]));                   \
          float4 dl;                                                                                                                      \
          dl.x = acc[0] + acc[4]; dl.y = acc[1] + acc[5]; dl.z = acc[2] + acc[6]; dl.w = acc[3] + acc[7];     \
          const float4 xv = xo[((M_) >> 1) & 7];                                                                                          \
          if (((M_) >> 1) + 8 < 16) xo[((M_) >> 1) & 7] = *(const float4*)(p.outp() + (size_t)(t0 + ((M_) >> 1) + 8) * D + xoff);                  \
          const float4 xn = make_float4(xv.x + dl.x, xv.y + dl.y, xv.z + dl.z, xv.w + dl.w);                                              \
          float sq = 0.f;                                                                                                                 \
          if (wr_lane) {                                                                                                                  \
            *(float4*)(p.outp() + (size_t)(t0 + ((M_) >> 1)) * D + xoff) = xn;                                                             \
            *(uint2*)(p.xb() + (size_t)(t0 + ((M_) >> 1)) * KD + xoff) = make_uint2(pk_bf16(xn.x, xn.y), pk_bf16(xn.z, xn.w));     \
            sq = (xn.x * xn.x + xn.y * xn.y) + (xn.z * xn.z + xn.w * xn.w);                                                                \
          }                                                                                                                               \
          sq = DPP_ADD(sq, 0xB1); sq = DPP_ADD(sq, 0x4E); sq = DPP_ADD(sq, 0x141); sq = DPP_ADD(sq, 0x128); sq = sum_xor16(sq); sq = sum_xor32(sq);     \
          if (lane == 0) p.ssq1()[(size_t)(t0 + ((M_) >> 1)) * 8 + s] = sq;                                                               \
        }                                                                                                                                 \
      }
#pragma unroll
      for (int m6 = 0; m6 < 30; m6 += 6) {
        PEER_V_HALF(m6, 0, 0) PEER_V_HALF(m6 + 1, 1, 1) PEER_V_HALF(m6 + 2, 2, 0) PEER_V_HALF(m6 + 3, 0, 1) PEER_V_HALF(m6 + 4, 1, 0) PEER_V_HALF(m6 + 5, 2, 1)
      }
      PEER_V_HALF(30, 0, 0) PEER_V_HALF(31, 1, 1)
#undef PEER_V_HALF
#undef PEER_V_LOAD
    }
  }
}

#if PEER_CHECK
constexpr int CHK_N = 512;
__device__ __forceinline__ float* chk_x(const Params& p) { return (float*)(p.ws + WO_ybuf); }
__device__ __forceinline__ float* chk_m(const Params& p) { return (float*)(p.ws + WO_ybuf + (size_t)CHK_N * D * 4); }
__device__ __forceinline__ float* chk_g(const Params& p) { return (float*)(p.ws + WO_ybuf + (size_t)CHK_N * D * 4 + 4096); }
__device__ __forceinline__ void chk_save(const Params& p, int gtid, int ngt) {
  for (int i = gtid; i < CHK_N * D; i += ngt) chk_x(p)[i] = p.outp()[(size_t)(i / D) * 64 * D + (i % D)];
  for (int i = gtid; i < CHK_N * 128; i += ngt) chk_g(p)[i] = p.gates()[(size_t)(i / 128) * 64 * 128 + (i % 128)];
  if (gtid < 16) chk_m(p)[gtid] = 0.f;
}
__device__ __forceinline__ void chk_apply(const Params& p, int l, float* coef, int gw, int ngw, int lane) {
  const float* g2 = p.inp(16) + l * D;
  const float* U = p.inp(19) + (size_t)l * 16384 * D; const float* V = p.inp(20) + (size_t)l * 16384 * D;
  for (int i = gw; i < CHK_N; i += ngw) {
    const int t = i * 64;
    const float r = p.rstd()[t];
    float4 hv[4];
#pragma unroll
    for (int k = 0; k < 4; ++k) {
      float4 xv = *(const float4*)(chk_x(p) + (size_t)i * D + (lane + k * 64) * 4);
      float4 gv = *(const float4*)(g2 + (lane + k * 64) * 4);
      hv[k].x = xv.x * r * gv.x; hv[k].y = xv.y * r * gv.y; hv[k].z = xv.z * r * gv.z; hv[k].w = xv.w * r * gv.w;
    }
    LDS_FENCE();
    for (int j = 0; j < 128; ++j) {
      const int e = p.eidx()[(size_t)t * 128 + j];
      const float4* up = (const float4*)(U + (size_t)e * D);
      float dsum = 0.f;
#pragma unroll
      for (int k = 0; k < 4; ++k) { float4 uv = up[lane + k * 64]; dsum += hv[k].x * uv.x + hv[k].y * uv.y + hv[k].z * uv.z + hv[k].w * uv.w; }
      dsum = wave_sum(dsum);
      if (lane == 0) coef[j] = chk_g(p)[(size_t)i * 128 + j] * gelu_tanh(dsum);
    }
    LDS_FENCE();
    float4 acc[4];
#pragma unroll
    for (int k = 0; k < 4; ++k) acc[k] = make_float4(0.f, 0.f, 0.f, 0.f);
    for (int j = 0; j < 128; ++j) {
      const int e = p.eidx()[(size_t)t * 128 + j];
      const float c = coef[j];
      const float4* vp = (const float4*)(V + (size_t)e * D);
#pragma unroll
      for (int k = 0; k < 4; ++k) { float4 vv = vp[lane + k * 64]; acc[k].x = fmaf(c, vv.x, acc[k].x); acc[k].y = fmaf(c, vv.y, acc[k].y); acc[k].z = fmaf(c, vv.z, acc[k].z); acc[k].w = fmaf(c, vv.w, acc[k].w); }
    }
    float d2 = 0.f, r2 = 0.f;
#pragma unroll
    for (int k = 0; k < 4; ++k) {
      float4 xa = *(const float4*)(p.outp() + (size_t)t * D + (lane + k * 64) * 4);
      float4 xb4 = *(const float4*)(chk_x(p) + (size_t)i * D + (lane + k * 64) * 4);
      float e0 = (xa.x - xb4.x) - acc[k].x, e1 = (xa.y - xb4.y) - acc[k].y, e2 = (xa.z - xb4.z) - acc[k].z, e3 = (xa.w - xb4.w) - acc[k].w;
      d2 += e0 * e0 + e1 * e1 + e2 * e2 + e3 * e3;
      r2 += acc[k].x * acc[k].x + acc[k].y * acc[k].y + acc[k].z * acc[k].z + acc[k].w * acc[k].w;
    }
    d2 = wave_sum(d2); r2 = wave_sum(r2);
    if (lane == 0) { atomicAdd((unsigned long long*)&chk_m(p)[8], (unsigned long long)(d2 * 1099511627776.0f)); atomicAdd((unsigned long long*)&chk_m(p)[10], (unsigned long long)(r2 * 1099511627776.0f)); }
  }
}
__device__ __forceinline__ void chk_topk(const Params& p, int l, int gtid, int ngt) {
  const float* subk = p.inp(18) + (size_t)l * 16 * 128 * 64;
  for (int it = gtid; it < CHK_N * 8; it += ngt) {
    const int i = it >> 3, h = it & 7, t = i * 64;
    float tva[16], tvb[16]; int tia[16], tib[16];
#pragma unroll 1
    for (int c = 0; c < 2; ++c) {
      float tv[16]; int ti[16];
#pragma unroll
      for (int z = 0; z < 16; ++z) { tv[z] = -INFINITY; ti[z] = 0; }
      const bf16_t* q = p.qb() + (size_t)t * D + (2 * h + c) * 64;
      const float* kb = subk + (size_t)(2 * h + c) * 128 * 64;
#pragma unroll 1
      for (int n = 0; n < 128; ++n) {
        float sc = 0.f;
        for (int d = 0; d < 64; ++d) sc = fmaf(bf2f(q[d]), kb[n * 64 + d], sc);
        float v_ = sc; int i_ = n;
#pragma unroll
        for (int z = 0; z < 16; ++z) { bool gt = v_ > tv[z]; float a = tv[z]; int b = ti[z]; tv[z] = gt ? v_ : a; ti[z] = gt ? i_ : b; v_ = gt ? a : v_; i_ = gt ? b : i_; }
      }
#pragma unroll
      for (int z = 0; z < 16; ++z) { if (c == 0) { tva[z] = tv[z]; tia[z] = ti[z]; } else { tvb[z] = tv[z]; tib[z] = ti[z]; } }
    }
    float tv[16]; int ti[16];
#pragma unroll
    for (int z = 0; z < 16; ++z) { tv[z] = -INFINITY; ti[z] = 0; }
#pragma unroll 1
    for (int a = 0; a < 16; ++a)
#pragma unroll 1
      for (int b = 0; b < 16; ++b) {
        float av = 0.f, bv = 0.f; int ai = 0, bi = 0;
#pragma unroll
        for (int z = 0; z < 16; ++z) { if (z == a) { av = tva[z]; ai = tia[z]; } if (z == b) { bv = tvb[z]; bi = tib[z]; } }
        float v_ = av + bv; int i_ = ai * 128 + bi;
#pragma unroll
        for (int z = 0; z < 16; ++z) { bool gt = v_ > tv[z]; float x = tv[z]; int y = ti[z]; tv[z] = gt ? v_ : x; ti[z] = gt ? i_ : y; v_ = gt ? x : v_; i_ = gt ? y : i_; }
      }
    float sum = 0.f, ev[16];
#pragma unroll
    for (int z = 0; z < 16; ++z) { ev[z] = expf(tv[z] - tv[0]); sum += ev[z]; }
    int miss = 0; float gerr = 0.f;
    for (int z = 0; z < 16; ++z) {
      const int ef = p.eidx()[((size_t)t * 8 + h) * 16 + z]; const float gf = p.gates()[((size_t)t * 8 + h) * 16 + z];
      bool found = false;
#pragma unroll
      for (int y = 0; y < 16; ++y) if (ti[y] == ef) { found = true; gerr = fmaxf(gerr, fabsf(ev[y] / sum - gf)); }
      if (!found) ++miss;
    }
    atomicAdd(&chk_m(p)[3], (float)miss);
    atomicMax((int*)&chk_m(p)[4], __float_as_int(gerr));
  }
}
__device__ __forceinline__ void chk_emit(const Params& p) {
  float v = 0.f;
  if (PEER_CHECK == 1) v = sqrtf((float)((double)*(unsigned long long*)&chk_m(p)[8] / (double)*(unsigned long long*)&chk_m(p)[10]));
  if (PEER_CHECK == 2) v = chk_m(p)[3] / (float)(CHK_N * 8 * 16);
  if (PEER_CHECK == 3) v = chk_m(p)[4];
  p.outp()[0] += 1.0e4f * v + 100.0f;
}
#endif

#define XB_TMO      128
#define XB_XCNT(j)  (256  + 64 * (j))
#define XB_XSUB(j)  (1280 + 64 * (j))
#define XB_XGEN(j)  (2304 + 64 * (j))
#define XB_TOP      3328
#define XB_TOPGEN   3392
#define XCD_BAR_WORDS 3456
#define XB_SPIN_CAP (1u << 18)
#define LAS __attribute__((address_space(3)))

__device__ __forceinline__ unsigned xb_ld(unsigned* p)              { return __hip_atomic_load(p, __ATOMIC_RELAXED, __HIP_MEMORY_SCOPE_AGENT); }
__device__ __forceinline__ unsigned xb_add(unsigned* p, unsigned v) { return __hip_atomic_fetch_add(p, v, __ATOMIC_RELAXED, __HIP_MEMORY_SCOPE_AGENT); }
__device__ __forceinline__ unsigned xb_xcc_id() { return (unsigned)__builtin_amdgcn_s_getreg((3 << 11) | 20) & 0xFu; }
#define XB_SPIN(cond, bar) do { unsigned _sp = 0; while (cond) { __builtin_amdgcn_s_sleep(1); \
    if ((++_sp & 255u) == 0u) { if (xb_ld(&(bar)[XB_TMO])) break; if (_sp > XB_SPIN_CAP) { atomicAdd(&(bar)[XB_TMO], 1u); break; } } } } while (0)

struct XcdBarrier {
    unsigned* bar; unsigned x;
    volatile LAS unsigned* st;
};

__device__ __forceinline__ XcdBarrier xcd_barrier_post(unsigned* bar, volatile LAS unsigned* st) {
    XcdBarrier b; b.bar = bar; b.x = xb_xcc_id(); b.st = st;
    if (threadIdx.x == 0) (void)xb_add(&bar[XB_XCNT(b.x)], 1u);
    return b;
}
__device__ __forceinline__ void xcd_barrier_complete(unsigned* bar, unsigned x, unsigned& nloc, unsigned& nx) {
    const unsigned G = gridDim.x * gridDim.y * gridDim.z;
    unsigned sum, cnt, mine, sp = 0u;
    for (;;) {
        sum = 0u; cnt = 0u; mine = 0u;
#pragma unroll
        for (unsigned j = 0; j < 16; ++j) { const unsigned c = xb_ld(&bar[XB_XCNT(j)]); sum += c; cnt += (c > 0u) ? 1u : 0u; mine = (j == x) ? c : mine; }
        if (sum == G) break;
        __builtin_amdgcn_s_sleep(1);
        if ((++sp & 255u) == 0u) { if (xb_ld(&bar[XB_TMO])) break; if (sp > XB_SPIN_CAP) { atomicAdd(&bar[XB_TMO], 1u); break; } }
    }
    nloc = mine > 0u ? mine : 1u; nx = cnt > 0u ? cnt : 1u;
}

__device__ __forceinline__ void xcd_barrier(const XcdBarrier& b) {
    asm volatile("s_waitcnt vmcnt(0)" ::: "memory");
    __syncthreads();
    if (threadIdx.x == 0) {
        unsigned* bar = b.bar;
        __builtin_amdgcn_s_waitcnt(0);
        unsigned nloc = b.st[0], nx = b.st[1];
        if (nloc == 0u) { xcd_barrier_complete(bar, b.x, nloc, nx); b.st[0] = nloc; b.st[1] = nx; }
        const unsigned old = xb_add(&bar[XB_XSUB(b.x)], 1u);
        const unsigned gen = old / nloc;
        if (old + 1u == (gen + 1u) * nloc) {
            __builtin_amdgcn_fence(__ATOMIC_RELEASE, "agent");
            asm volatile("s_waitcnt vmcnt(0)" ::: "memory");
            const unsigned og = xb_add(&bar[XB_TOP], 1u);
            const unsigned tg = og / nx;
            if (og + 1u == (tg + 1u) * nx) xb_add(&bar[XB_TOPGEN], 1u);
            else XB_SPIN(xb_ld(&bar[XB_TOPGEN]) == tg, bar);
            __builtin_amdgcn_fence(__ATOMIC_ACQUIRE, "agent");
            xb_add(&bar[XB_XGEN(b.x)], 1u);
            asm volatile("s_waitcnt vmcnt(0)" ::: "memory");
        } else {
            XB_SPIN(xb_ld(&bar[XB_XGEN(b.x)]) == gen, bar);
            __builtin_amdgcn_fence(__ATOMIC_ACQUIRE, "agent");
            asm volatile("s_waitcnt vmcnt(0)" ::: "memory");
        }
    }
    __syncthreads();
}

__device__ __forceinline__ Params fresh(const Params& p) {
  Params q = p;
  asm volatile("" : "+s"(q.ws), "+s"(q.out_));
#pragma unroll
  for (int i = 0; i < 21; ++i) asm volatile("" : "+s"(q.in[i]));
  return q;
}
#define PHASE_IDS int tid = threadIdx.x; asm volatile("" : "+v"(tid)); int bid = blockIdx.x; asm volatile("" : "+s"(bid)); int G = gridDim.x; asm volatile("" : "+s"(G)); \
  const int lane = tid & 63, wv = tid >> 6; const int ngt = G * NTHR, ngw = G * NWAVE; \
  const int gtid = bid * NTHR + tid, gw = bid * NWAVE + wv; (void)lane; (void)wv; (void)gtid; (void)gw; (void)ngt; (void)ngw; \
  const Params q = fresh(p);
__global__ void __launch_bounds__(NTHR) mega(Params p) {
  extern __shared__ __attribute__((aligned(16))) unsigned char lds_raw[];
  cg::grid_group grid = cg::this_grid();
  float* ldsf = (float*)lds_raw;
  if (threadIdx.x == 0) { *(uint4*)(lds_raw + LDS_BYTES - 16) = make_uint4(0u, 0u, 0u, 0u); }
  __syncthreads();
  XcdBarrier xb = xcd_barrier_post(p.bar(), (volatile LAS unsigned*)(lds_raw + LDS_BYTES - 16));

  { PHASE_IDS; phase_prologue(q, gtid, ngt, gw, ngw, lane); cvt_f32_bf16(q.inp(18), q.skb(), (size_t)NL * 16 * 128 * 64 / 8, gtid, ngt);
    for (size_t i = gtid; i < (size_t)16 * 128 * 512 / 8; i += ngt) { const size_t g = i / (128 * 512 / 8), r = i % (128 * 512 / 8); ((uint4*)q.S5Wz())[g * (256 * 512 / 8) + (128 * 512 / 8) + r] = make_uint4(0u, 0u, 0u, 0u); }
    if (gtid < 256) q.qctr()[gtid] = 0;
    phase_s5_prep(q, 0, gtid, ngt); }
  grid.sync();
  { constexpr int l = 0;
    DUP(5) {
    { const Params q = fresh(p); EpiScaleStoreBf16 e{q.projb(), INW, q.ssq1(), 8, nullptr};
      run_gemm(lds_raw, q.xb(), q.Win_t() + (size_t)l * INW * KD, T, INW, KD, e); }
    xcd_barrier(xb);
    }
    DUP(0) {
    { PHASE_IDS; phase_post_pack(q, l, gtid, ngt, gw, ngw, lane); phase_pack_u(q, gtid, ngt); }
    xcd_barrier(xb);
    }
    DUP(1) {
    { const Params q = fresh(p); EpiS5Z e{q.S5Z()};
      pg8::Gemm g{q.S5A(), q.S5Wz(), 16 * 1024, 16 * 256, 512, 640, 512}; pg8::GroupOrder So; So.init(16, 4, 1, (int)gridDim.x, (int)blockIdx.x);
      pg8::gemm_phase<EpiS5Z, pg8::GroupOrder, true, true>((PG8_LAS unsigned char*)lds_raw, g, So, e); }
    { PHASE_IDS; phase_kmean2(q, gtid, ngt); phase_ret_kv(q, gw, ngw, lane); }
    xcd_barrier(xb);
    }
    DUP(2) {
    { PHASE_IDS; phase_s5_scan(q, gtid, ngt); phase_ret_scan(q, gtid, ngt); }
    __syncthreads();
    { PHASE_IDS; phase_moba2(q, l, lds_raw, q.qctr() + 64 + l); }
    xcd_barrier(xb);
    }
    DUP(3) {
    { const Params q = fresh(p); EpiS5Y e{q.ygb(), q.S5A(), q.inp(10) + l * 256};
      pg8::Gemm g{q.S5A(), q.S5Wy(), 16 * 1024, 16 * 512, 640, 640, 640}; pg8::GroupOrder So; So.init(16, 4, 2, (int)gridDim.x, (int)blockIdx.x);
      pg8::gemm_phase<EpiS5Y, pg8::GroupOrder, true, true>((PG8_LAS unsigned char*)lds_raw, g, So, e); }
    __syncthreads();
    { PHASE_IDS; phase_ret_out(q, gw, ngw, lane); }
    xcd_barrier(xb);
    }
    DUP(4) {
    { const Params q = fresh(p); EpiGlu e{q.xb(), q.ygb(), (float*)(lds_raw + 131072)};
      run_gemm(lds_raw, q.ygb(), q.Wglu_t() + (size_t)l * 65536, T, 256, 256, e); }
    xcd_barrier(xb);
    }
    { PHASE_IDS; cvt_table_i8(q.inp(19) + (size_t)l * 16384 * D, q.U8s(), q.su(), gw, ngw, lane);
      cvt_table_fp8(q.inp(20) + (size_t)l * 16384 * D, q.V8s(), q.sv(), gw, ngw, lane); }
    __syncthreads();
    { const Params q = fresh(p); EpiResid e{q.outp(), D, q.xb2(), q.hb(), q.inp(16) + l * D, q.ssq2()};
      run_gemm(lds_raw, q.xb(), q.Wout_t() + (size_t)l * D * KD, T, D, KD, e); }
    xcd_barrier(xb);
    DUP(7) {
    { const Params q = fresh(p); EpiScaleStoreBf16 e{q.qb(), D, q.ssq2(), 16, q.rstd()};
      run_gemm(lds_raw, q.xb2(), q.Wq_t() + (size_t)l * D * KD, T, D, KD, e); }
    xcd_barrier(xb);
    }
    if (!(PROBE_SKIP & 2)) {
    DUP(8) {
    { PHASE_IDS; phase_peer_topk(q, l, gw, ngw, lane); }
    xcd_barrier(xb);
    }
    }
#if PEER_CHECK
    if (l == 0) { { PHASE_IDS; chk_save(q, gtid, ngt); } xcd_barrier(xb); { PHASE_IDS; chk_topk(q, l, gtid, ngt); } xcd_barrier(xb); }
#endif
    if (!(PROBE_SKIP & 1)) {
    { PHASE_IDS; phase_peer_u(q, q.qctr() + (l * 2 + 0) * 8, lds_raw, tid); }
    xcd_barrier(xb);
    { PHASE_IDS; phase_peer_r(q, gtid, ngt); if (l + 1 < NL) phase_s5_prep(q, l + 1, gtid, ngt); }
    xcd_barrier(xb);
    if (!(PROBE_SKIP & 32)) {
    { PHASE_IDS; phase_peer_v(q, q.qctr() + (l * 2 + 1) * 8, lds_raw, tid); }
    xcd_barrier(xb);
    }
    }
#if PEER_CHECK
    if (l == 0) { { PHASE_IDS; chk_apply(q, l, ldsf + wv * 128, gw, ngw, lane); } xcd_barrier(xb);
      if (blockIdx.x == 0 && threadIdx.x == 0) { const Params q = fresh(p); chk_emit(q); } xcd_barrier(xb); }
#endif
  }
  { constexpr int l = 1;
    DUP(5) {
    { const Params q = fresh(p); EpiScaleStoreBf16 e{q.projb(), INW, q.ssq1(), 8, nullptr};
      run_gemm(lds_raw, q.xb(), q.Win_t() + (size_t)l * INW * KD, T, INW, KD, e); }
    xcd_barrier(xb);
    }
    DUP(0) {
    { PHASE_IDS; phase_post_pack(q, l, gtid, ngt, gw, ngw, lane); phase_pack_u(q, gtid, ngt); }
    xcd_barrier(xb);
    }
    DUP(1) {
    { const Params q = fresh(p); EpiS5Z e{q.S5Z()};
      pg8::Gemm g{q.S5A(), q.S5Wz(), 16 * 1024, 16 * 256, 512, 640, 512}; pg8::GroupOrder So; So.init(16, 4, 1, (int)gridDim.x, (int)blockIdx.x);
      pg8::gemm_phase<EpiS5Z, pg8::GroupOrder, true, true>((PG8_LAS unsigned char*)lds_raw, g, So, e); }
    { PHASE_IDS; phase_kmean2(q, gtid, ngt); phase_ret_kv(q, gw, ngw, lane); }
    xcd_barrier(xb);
    }
    DUP(2) {
    { PHASE_IDS; phase_s5_scan(q, gtid, ngt); phase_ret_scan(q, gtid, ngt); }
    __syncthreads();
    { PHASE_IDS; phase_moba2(q, l, lds_raw, q.qctr() + 64 + l); }
    xcd_barrier(xb);
    }
    DUP(3) {
    { const Params q = fresh(p); EpiS5Y e{q.ygb(), q.S5A(), q.inp(10) + l * 256};
      pg8::Gemm g{q.S5A(), q.S5Wy(), 16 * 1024, 16 * 512, 640, 640, 640}; pg8::GroupOrder So; So.init(16, 4, 2, (int)gridDim.x, (int)blockIdx.x);
      pg8::gemm_phase<EpiS5Y, pg8::GroupOrder, true, true>((PG8_LAS unsigned char*)lds_raw, g, So, e); }
    __syncthreads();
    { PHASE_IDS; phase_ret_out(q, gw, ngw, lane); }
    xcd_barrier(xb);
    }
    DUP(4) {
    { const Params q = fresh(p); EpiGlu e{q.xb(), q.ygb(), (float*)(lds_raw + 131072)};
      run_gemm(lds_raw, q.ygb(), q.Wglu_t() + (size_t)l * 65536, T, 256, 256, e); }
    xcd_barrier(xb);
    }
    { PHASE_IDS; cvt_table_i8(q.inp(19) + (size_t)l * 16384 * D, q.U8s(), q.su(), gw, ngw, lane);
      cvt_table_fp8(q.inp(20) + (size_t)l * 16384 * D, q.V8s(), q.sv(), gw, ngw, lane); }
    __syncthreads();
    { const Params q = fresh(p); EpiResid e{q.outp(), D, q.xb2(), q.hb(), q.inp(16) + l * D, q.ssq2()};
      run_gemm(lds_raw, q.xb(), q.Wout_t() + (size_t)l * D * KD, T, D, KD, e); }
    xcd_barrier(xb);
    DUP(7) {
    { const Params q = fresh(p); EpiScaleStoreBf16 e{q.qb(), D, q.ssq2(), 16, q.rstd()};
      run_gemm(lds_raw, q.xb2(), q.Wq_t() + (size_t)l * D * KD, T, D, KD, e); }
    xcd_barrier(xb);
    }
    if (!(PROBE_SKIP & 2)) {
    DUP(8) {
    { PHASE_IDS; phase_peer_topk(q, l, gw, ngw, lane); }
    xcd_barrier(xb);
    }
    }
#if PEER_CHECK
    if (l == 0) { { PHASE_IDS; chk_save(q, gtid, ngt); } xcd_barrier(xb); { PHASE_IDS; chk_topk(q, l, gtid, ngt); } xcd_barrier(xb); }
#endif
    if (!(PROBE_SKIP & 1)) {
    { PHASE_IDS; phase_peer_u(q, q.qctr() + (l * 2 + 0) * 8, lds_raw, tid); }
    xcd_barrier(xb);
    { PHASE_IDS; phase_peer_r(q, gtid, ngt); if (l + 1 < NL) phase_s5_prep(q, l + 1, gtid, ngt); }
    xcd_barrier(xb);
    if (!(PROBE_SKIP & 32)) {
    { PHASE_IDS; phase_peer_v(q, q.qctr() + (l * 2 + 1) * 8, lds_raw, tid); }
    xcd_barrier(xb);
    }
    }
#if PEER_CHECK
    if (l == 0) { { PHASE_IDS; chk_apply(q, l, ldsf + wv * 128, gw, ngw, lane); } xcd_barrier(xb);
      if (blockIdx.x == 0 && threadIdx.x == 0) { const Params q = fresh(p); chk_emit(q); } xcd_barrier(xb); }
#endif
  }
  { constexpr int l = 2;
    DUP(5) {
    { const Params q = fresh(p); EpiScaleStoreBf16 e{q.projb(), INW, q.ssq1(), 8, nullptr};
      run_gemm(lds_raw, q.xb(), q.Win_t() + (size_t)l * INW * KD, T, INW, KD, e); }
    xcd_barrier(xb);
    }
    DUP(0) {
    { PHASE_IDS; phase_post_pack(q, l, gtid, ngt, gw, ngw, lane); phase_pack_u(q, gtid, ngt); }
    xcd_barrier(xb);
    }
    DUP(1) {
    { const Params q = fresh(p); EpiS5Z e{q.S5Z()};
      pg8::Gemm g{q.S5A(), q.S5Wz(), 16 * 1024, 16 * 256, 512, 640, 512}; pg8::GroupOrder So; So.init(16, 4, 1, (int)gridDim.x, (int)blockIdx.x);
      pg8::gemm_phase<EpiS5Z, pg8::GroupOrder, true, true>((PG8_LAS unsigned char*)lds_raw, g, So, e); }
    { PHASE_IDS; phase_kmean2(q, gtid, ngt); phase_ret_kv(q, gw, ngw, lane); }
    xcd_barrier(xb);
    }
    DUP(2) {
    { PHASE_IDS; phase_s5_scan(q, gtid, ngt); phase_ret_scan(q, gtid, ngt); }
    __syncthreads();
    { PHASE_IDS; phase_moba2(q, l, lds_raw, q.qctr() + 64 + l); }
    xcd_barrier(xb);
    }
    DUP(3) {
    { const Params q = fresh(p); EpiS5Y e{q.ygb(), q.S5A(), q.inp(10) + l * 256};
      pg8::Gemm g{q.S5A(), q.S5Wy(), 16 * 1024, 16 * 512, 640, 640, 640}; pg8::GroupOrder So; So.init(16, 4, 2, (int)gridDim.x, (int)blockIdx.x);
      pg8::gemm_phase<EpiS5Y, pg8::GroupOrder, true, true>((PG8_LAS unsigned char*)lds_raw, g, So, e); }
    __syncthreads();
    { PHASE_IDS; phase_ret_out(q, gw, ngw, lane); }
    xcd_barrier(xb);
    }
    DUP(4) {
    { const Params q = fresh(p); EpiGlu e{q.xb(), q.ygb(), (float*)(lds_raw + 131072)};
      run_gemm(lds_raw, q.ygb(), q.Wglu_t() + (size_t)l * 65536, T, 256, 256, e); }
    xcd_barrier(xb);
    }
    { PHASE_IDS; cvt_table_i8(q.inp(19) + (size_t)l * 16384 * D, q.U8s(), q.su(), gw, ngw, lane);
      cvt_table_fp8(q.inp(20) + (size_t)l * 16384 * D, q.V8s(), q.sv(), gw, ngw, lane); }
    __syncthreads();
    { const Params q = fresh(p); EpiResid e{q.outp(), D, q.xb2(), q.hb(), q.inp(16) + l * D, q.ssq2()};
      run_gemm(lds_raw, q.xb(), q.Wout_t() + (size_t)l * D * KD, T, D, KD, e); }
    xcd_barrier(xb);
    DUP(7) {
    { const Params q = fresh(p); EpiScaleStoreBf16 e{q.qb(), D, q.ssq2(), 16, q.rstd()};
      run_gemm(lds_raw, q.xb2(), q.Wq_t() + (size_t)l * D * KD, T, D, KD, e); }
    xcd_barrier(xb);
    }
    if (!(PROBE_SKIP & 2)) {
    DUP(8) {
    { PHASE_IDS; phase_peer_topk(q, l, gw, ngw, lane); }
    xcd_barrier(xb);
    }
    }
#if PEER_CHECK
    if (l == 0) { { PHASE_IDS; chk_save(q, gtid, ngt); } xcd_barrier(xb); { PHASE_IDS; chk_topk(q, l, gtid, ngt); } xcd_barrier(xb); }
#endif
    if (!(PROBE_SKIP & 1)) {
    { PHASE_IDS; phase_peer_u(q, q.qctr() + (l * 2 + 0) * 8, lds_raw, tid); }
    xcd_barrier(xb);
    { PHASE_IDS; phase_peer_r(q, gtid, ngt); if (l + 1 < NL) phase_s5_prep(q, l + 1, gtid, ngt); }
    xcd_barrier(xb);
    if (!(PROBE_SKIP & 32)) {
    { PHASE_IDS; phase_peer_v(q, q.qctr() + (l * 2 + 1) * 8, lds_raw, tid); }
    xcd_barrier(xb);
    }
    }
#if PEER_CHECK
    if (l == 0) { { PHASE_IDS; chk_apply(q, l, ldsf + wv * 128, gw, ngw, lane); } xcd_barrier(xb);
      if (blockIdx.x == 0 && threadIdx.x == 0) { const Params q = fresh(p); chk_emit(q); } xcd_barrier(xb); }
#endif
  }
  { constexpr int l = 3;
    DUP(5) {
    { const Params q = fresh(p); EpiScaleStoreBf16 e{q.projb(), INW, q.ssq1(), 8, nullptr};
      run_gemm(lds_raw, q.xb(), q.Win_t() + (size_t)l * INW * KD, T, INW, KD, e); }
    xcd_barrier(xb);
    }
    DUP(0) {
    { PHASE_IDS; phase_post_pack(q, l, gtid, ngt, gw, ngw, lane); phase_pack_u(q, gtid, ngt); }
    xcd_barrier(xb);
    }
    DUP(1) {
    { const Params q = fresh(p); EpiS5Z e{q.S5Z()};
      pg8::Gemm g{q.S5A(), q.S5Wz(), 16 * 1024, 16 * 256, 512, 640, 512}; pg8::GroupOrder So; So.init(16, 4, 1, (int)gridDim.x, (int)blockIdx.x);
      pg8::gemm_phase<EpiS5Z, pg8::GroupOrder, true, true>((PG8_LAS unsigned char*)lds_raw, g, So, e); }
    { PHASE_IDS; phase_kmean2(q, gtid, ngt); phase_ret_kv(q, gw, ngw, lane); }
    xcd_barrier(xb);
    }
    DUP(2) {
    { PHASE_IDS; phase_s5_scan(q, gtid, ngt); phase_ret_scan(q, gtid, ngt); }
    __syncthreads();
    { PHASE_IDS; phase_moba2(q, l, lds_raw, q.qctr() + 64 + l); }
    xcd_barrier(xb);
    }
    DUP(3) {
    { const Params q = fresh(p); EpiS5Y e{q.ygb(), q.S5A(), q.inp(10) + l * 256};
      pg8::Gemm g{q.S5A(), q.S5Wy(), 16 * 1024, 16 * 512, 640, 640, 640}; pg8::GroupOrder So; So.init(16, 4, 2, (int)gridDim.x, (int)blockIdx.x);
      pg8::gemm_phase<EpiS5Y, pg8::GroupOrder, true, true>((PG8_LAS unsigned char*)lds_raw, g, So, e); }
    __syncthreads();
    { PHASE_IDS; phase_ret_out(q, gw, ngw, lane); }
    xcd_barrier(xb);
    }
    DUP(4) {
    { const Params q = fresh(p); EpiGlu e{q.xb(), q.ygb(), (float*)(lds_raw + 131072)};
      run_gemm(lds_raw, q.ygb(), q.Wglu_t() + (size_t)l * 65536, T, 256, 256, e); }
    xcd_barrier(xb);
    }
    { PHASE_IDS; cvt_table_i8(q.inp(19) + (size_t)l * 16384 * D, q.U8s(), q.su(), gw, ngw, lane);
      cvt_table_fp8(q.inp(20) + (size_t)l * 16384 * D, q.V8s(), q.sv(), gw, ngw, lane); }
    __syncthreads();
    { const Params q = fresh(p); EpiResid e{q.outp(), D, q.xb2(), q.hb(), q.inp(16) + l * D, q.ssq2()};
      run_gemm(lds_raw, q.xb(), q.Wout_t() + (size_t)l * D * KD, T, D, KD, e); }
    xcd_barrier(xb);
    DUP(7) {
    { const Params q = fresh(p); EpiScaleStoreBf16 e{q.qb(), D, q.ssq2(), 16, q.rstd()};
      run_gemm(lds_raw, q.xb2(), q.Wq_t() + (size_t)l * D * KD, T, D, KD, e); }
    xcd_barrier(xb);
    }
    if (!(PROBE_SKIP & 2)) {
    DUP(8) {
    { PHASE_IDS; phase_peer_topk(q, l, gw, ngw, lane); }
    xcd_barrier(xb);
    }
    }
#if PEER_CHECK
    if (l == 0) { { PHASE_IDS; chk_save(q, gtid, ngt); } xcd_barrier(xb); { PHASE_IDS; chk_topk(q, l, gtid, ngt); } xcd_barrier(xb); }
#endif
    if (!(PROBE_SKIP & 1)) {
    { PHASE_IDS; phase_peer_u(q, q.qctr() + (l * 2 + 0) * 8, lds_raw, tid); }
    xcd_barrier(xb);
    { PHASE_IDS; phase_peer_r(q, gtid, ngt); if (l + 1 < NL) phase_s5_prep(q, l + 1, gtid, ngt); }
    xcd_barrier(xb);
    if (!(PROBE_SKIP & 32)) {
    { PHASE_IDS; phase_peer_v(q, q.qctr() + (l * 2 + 1) * 8, lds_raw, tid); }
    xcd_barrier(xb);
    }
    }
#if PEER_CHECK
    if (l == 0) { { PHASE_IDS; chk_apply(q, l, ldsf + wv * 128, gw, ngw, lane); } xcd_barrier(xb);
      if (blockIdx.x == 0 && threadIdx.x == 0) { const Params q = fresh(p); chk_emit(q); } xcd_barrier(xb); }
#endif
  }
}

}

extern "C" void kernel_launch(void* const* d_in, const int* in_sizes, int n_in, void* d_out, int out_size, void* d_ws, size_t ws_size,
                              hipStream_t stream) {
  static int grid_blocks = 0;
  if (!grid_blocks) {
    int dev = 0, cus = 0, per_cu = 0;
    hipGetDevice(&dev);
    hipDeviceGetAttribute(&cus, hipDeviceAttributeMultiprocessorCount, dev);
    hipFuncSetAttribute((const void*)mega, hipFuncAttributeMaxDynamicSharedMemorySize, LDS_BYTES);
    hipOccupancyMaxActiveBlocksPerMultiprocessor(&per_cu, (const void*)mega, NTHR, LDS_BYTES);
    if (per_cu < 1) { fprintf(stderr, "occupancy query returned %d\n", per_cu); per_cu = 1; }
    grid_blocks = cus * 1;
    if (grid_blocks < 64) fprintf(stderr, "unexpected CU count %d\n", cus);
  }
  Params p{};
  for (int i = 0; i < 21; ++i) p.in[i] = (const GAS float*)d_in[i];
  p.out_ = (GAS float*)d_out;
  p.ws = (GAS unsigned char*)d_ws;
  if (WS_TOTAL > ws_size) { fprintf(stderr, "workspace too small: need %zu have %zu\n", (size_t)WS_TOTAL, ws_size); return; }
  hipMemsetAsync((unsigned char*)d_ws + WO_bar, 0, 16384, stream);
  void* args[] = {&p};
  hipError_t e = hipLaunchCooperativeKernel((const void*)mega, dim3(grid_blocks), dim3(NTHR), args, LDS_BYTES, stream);
  if (e != hipSuccess) fprintf(stderr, "cooperative launch failed: %s (grid %d)\n", hipGetErrorString(e), grid_blocks);
}
```

```cpp
#include <hip/hip_runtime.h>
#include <hip/hip_cooperative_groups.h>
#include <math.h>
#include <stdint.h>
#include <stdio.h>
namespace cg = cooperative_groups;

#ifndef PEER_CHECK
#define PEER_CHECK 0
#endif
#ifndef PROBE_DUP
#define PROBE_DUP 0
#endif
__device__ __forceinline__ int dup_n(int n) { asm volatile("" : "+s"(n)); return n; }
#define DUP(bit) _Pragma("unroll 1") for (int rep_ = 0, repn_ = (((PROBE_DUP >> (bit)) & 1) ? dup_n(2) : 1); rep_ < repn_; ++rep_)
#ifndef PROBE_SKIP
#define PROBE_SKIP 0
#endif
#ifndef PRECISE
#define PRECISE 0
#endif

namespace {
constexpr int NB = 8, S = 4096, D = 1024, NL = 4, T = NB * S;
constexpr int INW = 2816;
constexpr int OFF_U = 0, OFF_QM = 256, OFF_KM = 768, OFF_VM = 1280, OFF_QR = 1792, OFF_KR = 2048, OFF_VR = 2304, OFF_GR = 2560;
constexpr float EPS = 1e-6f;
static_assert(PRECISE == 0, "PRECISE builds are retired");
constexpr int KS = PRECISE ? 3 : 1;
constexpr int KD = D * KS;
constexpr int NTHR = 512, NWAVE = 8;
constexpr int LDS_BYTES = 131072 + 4096 + 1024;

typedef unsigned short bf16_t;
using bf16x8 = __attribute__((ext_vector_type(8))) short;
using f32x4 = __attribute__((ext_vector_type(4))) float;

__device__ __forceinline__ float wave_sum(float v) {
#pragma unroll
  for (int o = 32; o > 0; o >>= 1) v += __shfl_xor(v, o);
  return v;
}
__device__ __forceinline__ float wave_max(float v) {
#pragma unroll
  for (int o = 32; o > 0; o >>= 1) v = fmaxf(v, __shfl_xor(v, o));
  return v;
}
__device__ __forceinline__ int q_pull(int* head, int nitems, int* bc, int tid) {
  __syncthreads();
  if (tid == 0) bc[0] = atomicAdd(head, 1);
  __syncthreads();
  const int v = bc[0];
  return v < nitems ? v : -1;
}
constexpr float QSCALE = 0.125f * 1.4426950408889634f;
__device__ __forceinline__ float ret_log2g(int h) { return log2f(1.0f - exp2f(-5.0f - (float)h)); }
__device__ __forceinline__ float gelu_tanh(float x) {
  const float k0 = 0.7978845608028654f, k1 = 0.044715f;
  float u = k0 * (x + k1 * x * x * x);
  return 0.5f * x * (1.0f + tanhf(u));
}
__device__ __forceinline__ float sigmoidf_(float x) { return 1.0f / (1.0f + expf(-x)); }
__device__ __forceinline__ float fast_sigmoid(float x) { return __builtin_amdgcn_rcpf(1.0f + __builtin_amdgcn_exp2f(-1.4426950408889634f * x)); }
__device__ __forceinline__ float fast_gelu(float x) { const float u = 0.7978845608028654f * (x + 0.044715f * x * x * x); return x * fast_sigmoid(2.0f * u); }
__device__ __forceinline__ bf16_t f2bf(float f) {
  unsigned u = __float_as_uint(f);
  u += 0x7fffu + ((u >> 16) & 1u);
  return (bf16_t)(u >> 16);
}
__device__ __forceinline__ float bf2f(bf16_t h) { return __uint_as_float(((unsigned)h) << 16); }
#define LDS_FENCE() asm volatile("s_waitcnt lgkmcnt(0)" ::: "memory")
typedef __bf16 bf16x2_hw __attribute__((ext_vector_type(2)));
typedef float f32x2_hw __attribute__((ext_vector_type(2)));
__device__ __forceinline__ unsigned pk_bf16(float lo, float hi) { const f32x2_hw f = {lo, hi}; const bf16x2_hw b = __builtin_convertvector(f, bf16x2_hw); return __builtin_bit_cast(unsigned, b); }
typedef float f32x16 __attribute__((ext_vector_type(16)));

constexpr size_t al256(size_t x) { return (x + 255) & ~(size_t)255; }
constexpr size_t WO_rstd = 0;
constexpr size_t WO_cosm = WO_rstd + al256((size_t)T * 4);
constexpr size_t WO_sinm = WO_cosm + al256((size_t)S * 8 * 4);
constexpr size_t WO_cosr = WO_sinm + al256((size_t)S * 8 * 4);
constexpr size_t WO_sinr = WO_cosr + al256((size_t)S * 32 * 4);
constexpr size_t WO_kmean = WO_sinr + al256((size_t)S * 32 * 4);
constexpr size_t WO_proj = WO_kmean + al256((size_t)NB * 8 * 16 * 64 * 4);
constexpr size_t WO_ybuf = WO_proj + al256((size_t)T * INW * 4);
constexpr size_t WO_yg = WO_ybuf + al256((size_t)T * D * 4);
constexpr size_t WO_skb = WO_yg + al256((size_t)T * 256 * 4);
constexpr size_t WO_Ub = WO_skb + al256((size_t)NL * 16 * 128 * 64 * 2);
constexpr size_t WO_Vb = WO_Ub + al256((size_t)16384 * D * 2);
constexpr size_t WO_gates = WO_Vb + al256((size_t)16384 * D * 2);
constexpr size_t WO_eidx = WO_gates + al256((size_t)T * 128 * 4);
constexpr size_t WO_xb = WO_eidx + al256((size_t)T * 128 * 4);
constexpr size_t WO_Win_t = WO_xb + al256((size_t)T * KD * 2);
constexpr size_t WO_Wout_t = WO_Win_t + al256((size_t)NL * INW * KD * 2);
constexpr size_t WO_Wq_t = WO_Wout_t + al256((size_t)NL * D * KD * 2);
constexpr size_t WO_Qm = WO_Wq_t + al256((size_t)NL * D * KD * 2);
constexpr size_t WO_Km = WO_Qm + al256((size_t)T * 512 * 2);
constexpr size_t WO_Vm = WO_Km + al256((size_t)T * 512 * 2);
constexpr size_t WO_S5a32 = WO_Vm + al256((size_t)T * 512 * 2);
constexpr size_t WO_Wglu_t = WO_S5a32 + al256((size_t)16 * 64 * 2 * 4);
constexpr size_t WO_Qr = WO_Wglu_t + al256((size_t)NL * 256 * 256 * 2);
constexpr size_t WO_Kr = WO_Qr + al256((size_t)T * 256 * 2);
constexpr size_t WO_Krv = WO_Kr + al256((size_t)T * 256 * 2);
constexpr size_t WO_Vr = WO_Krv + al256((size_t)T * 256 * 2);
constexpr size_t WO_KVr = WO_Vr + al256((size_t)T * 256 * 2);
constexpr size_t WO_Rb = WO_KVr + al256((size_t)32 * 32 * 4096 * 4);
constexpr size_t WO_qctr = WO_Rb + al256((size_t)32 * 32 * 4096 * 2);
constexpr size_t WO_bar = WO_qctr + al256(1024);
constexpr size_t WO_S5Wy = WO_bar + al256(16384);
constexpr size_t WO_S5Wz = WO_S5Wy + al256((size_t)16 * 512 * 640 * 2);
constexpr size_t WO_ssq1 = WO_S5Wz + al256((size_t)16 * 256 * 512 * 2);
constexpr size_t WO_ssq2 = WO_ssq1 + al256((size_t)T * 8 * 4);
constexpr size_t WS_TOTAL = WO_ssq2 + al256((size_t)T * 16 * 4);
constexpr size_t WO_S5A = WO_gates;
constexpr size_t WO_S5Z = WO_S5A + al256((size_t)16 * 1024 * 640 * 2);
static_assert(WO_S5Z + (size_t)16 * 1024 * 128 * 4 <= WO_gates + 2 * al256((size_t)T * 128 * 4), "S5A/S5Z must fit in gates+eidx");
#define GAS __attribute__((address_space(1)))
static_assert((size_t)T * D * 2 + (size_t)T * 128 * 8 * 4 + (size_t)T * D * 2 <= (size_t)T * INW * 4, "qb + ppart + xb2 must fit in the proj region");
struct Params {
  const GAS float* in[21];
  GAS float* out_;
  GAS unsigned char* ws;
  __device__ __forceinline__ const float* inp(int i) const { return (const float*)in[i]; }
  __device__ __forceinline__ float* outp() const { return (float*)out_; }
  __device__ __forceinline__ float* rstd() const { return (float*)(ws + WO_rstd); }
  __device__ __forceinline__ float* cosm() const { return (float*)(ws + WO_cosm); }
  __device__ __forceinline__ float* sinm() const { return (float*)(ws + WO_sinm); }
  __device__ __forceinline__ float* cosr() const { return (float*)(ws + WO_cosr); }
  __device__ __forceinline__ float* sinr() const { return (float*)(ws + WO_sinr); }
  __device__ __forceinline__ float* kmean() const { return (float*)(ws + WO_kmean); }
  __device__ __forceinline__ float* proj() const { return (float*)(ws + WO_proj); }
  __device__ __forceinline__ float* ybuf() const { return (float*)(ws + WO_ybuf); }
  __device__ __forceinline__ float* yg() const { return (float*)(ws + WO_yg); }
  __device__ __forceinline__ bf16_t* skb() const { return (bf16_t*)(ws + WO_skb); }
  __device__ __forceinline__ bf16_t* Ub() const { return (bf16_t*)(ws + WO_Ub); }
  __device__ __forceinline__ bf16_t* Vb() const { return (bf16_t*)(ws + WO_Vb); }
  __device__ __forceinline__ float* gates() const { return (float*)(ws + WO_gates); }
  __device__ __forceinline__ int* eidx() const { return (int*)(ws + WO_eidx); }
  __device__ __forceinline__ bf16_t* xb() const { return (bf16_t*)(ws + WO_xb); }
  __device__ __forceinline__ bf16_t* Win_t() const { return (bf16_t*)(ws + WO_Win_t); }
  __device__ __forceinline__ bf16_t* Wout_t() const { return (bf16_t*)(ws + WO_Wout_t); }
  __device__ __forceinline__ bf16_t* Wq_t() const { return (bf16_t*)(ws + WO_Wq_t); }
  __device__ __forceinline__ bf16_t* Qm() const { return (bf16_t*)(ws + WO_Qm); }
  __device__ __forceinline__ bf16_t* Km() const { return (bf16_t*)(ws + WO_Km); }
  __device__ __forceinline__ bf16_t* Vm() const { return (bf16_t*)(ws + WO_Vm); }
  __device__ __forceinline__ bf16_t* S5A() const { return (bf16_t*)(ws + WO_S5A); }
  __device__ __forceinline__ bf16_t* S5Wy() const { return (bf16_t*)(ws + WO_S5Wy); }
  __device__ __forceinline__ bf16_t* S5Wz() const { return (bf16_t*)(ws + WO_S5Wz); }
  __device__ __forceinline__ float* S5Z() const { return (float*)(ws + WO_S5Z); }
  __device__ __forceinline__ float* S5a32() const { return (float*)(ws + WO_S5a32); }
  __device__ __forceinline__ bf16_t* Wglu_t() const { return (bf16_t*)(ws + WO_Wglu_t); }
  __device__ __forceinline__ bf16_t* ygb() const { return (bf16_t*)(ws + WO_yg); }
  __device__ __forceinline__ int* qctr() const { return (int*)(ws + WO_qctr); }
  __device__ __forceinline__ unsigned char* U8s() const { return (unsigned char*)(ws + WO_Ub); }
  __device__ __forceinline__ float* su() const { return (float*)(ws + WO_Ub + (size_t)16384 * D); }
  __device__ __forceinline__ unsigned char* V8s() const { return (unsigned char*)(ws + WO_Vb); }
  __device__ __forceinline__ float* sv() const { return (float*)(ws + WO_Vb + (size_t)16384 * D); }
  __device__ __forceinline__ bf16_t* hb() const { return (bf16_t*)(ws + WO_ybuf + ((size_t)4 << 20)); }
  __device__ __forceinline__ float* ppart() const { return (float*)(ws + WO_proj + (size_t)T * D * 2); }
  __device__ __forceinline__ bf16_t* Qr() const { return (bf16_t*)(ws + WO_Qr); }
  __device__ __forceinline__ bf16_t* Kr() const { return (bf16_t*)(ws + WO_Kr); }
  __device__ __forceinline__ bf16_t* Krv() const { return (bf16_t*)(ws + WO_Krv); }
  __device__ __forceinline__ bf16_t* Vr() const { return (bf16_t*)(ws + WO_Vr); }
  __device__ __forceinline__ float* KVr() const { return (float*)(ws + WO_KVr); }
  __device__ __forceinline__ bf16_t* Rb() const { return (bf16_t*)(ws + WO_Rb); }
  __device__ __forceinline__ unsigned* bar() const { return (unsigned*)(ws + WO_bar); }
  __device__ __forceinline__ bf16_t* projb() const { return (bf16_t*)(ws + WO_proj); }
  __device__ __forceinline__ float* ssq1() const { return (float*)(ws + WO_ssq1); }
  __device__ __forceinline__ float* ssq2() const { return (float*)(ws + WO_ssq2); }
  __device__ __forceinline__ bf16_t* xb2() const { return (bf16_t*)(ws + WO_proj + (size_t)T * D * 2 + (size_t)T * 128 * 8 * 4); }
  __device__ __forceinline__ bf16_t* vrow() const { return (bf16_t*)(ws + WO_proj); }
  __device__ __forceinline__ bf16_t* vrrow() const { return (bf16_t*)(ws + WO_proj + (size_t)T * 512 * 2); }
  __device__ __forceinline__ bf16_t* krow() const { return (bf16_t*)(ws + WO_proj + (size_t)T * 768 * 2); }
  __device__ __forceinline__ bf16_t* grow() const { return (bf16_t*)(ws + WO_proj + (size_t)T * 1024 * 2); }
  __device__ __forceinline__ bf16_t* qb() const { return (bf16_t*)(ws + WO_proj); }
};

namespace pg8 {
#define PG8_LAS __attribute__((address_space(3)))
typedef unsigned short bf16_t;
typedef short bf16x8 __attribute__((ext_vector_type(8)));
typedef float f32x4 __attribute__((ext_vector_type(4)));
typedef unsigned u32x4 __attribute__((ext_vector_type(4)));
constexpr int BM = 256, BK = 64, HALF = 128, HTB = HALF * BK * 2  , STAGE_BYTES = 8 * HTB, NXCD = 8, WGM = 8;

__host__ __device__ __forceinline__ int lds_byte(int r, int c) { const int st = (r >> 4) * 2 + (c >> 5), rr = r & 15, cc = c & 31, ob = rr * 64 + cc * 2; return st * 1024 + (ob ^ (((ob >> 9) & 1) << 5)); }
__host__ __device__ __forceinline__ void stage_rc(int b, int& R, int& C) { const int st = b / 1024, sb = b % 1024, swz = sb ^ (((sb >> 9) & 1) << 5); R = (st >> 1) * 16 + swz / 64; C = (st & 1) * 32 + (swz % 64) / 2; }
__host__ __device__ __forceinline__ int perm32(int rho) { const int n = rho >> 4, i = rho & 15; return 8 * (i >> 2) + 4 * n + (i & 3); }

struct Unit { int pm, pn; };
struct Gemm { const bf16_t* A; const bf16_t* Bt; int M, N, K, lda, ldb; };

struct StaticOrder {
    int nM, nN, nwg, G, c;
    __host__ __device__ void init(int M, int N, int G_, int c_) { nM = M / BM; nN = N / BM; nwg = nM * nN; G = G_; c = c_; }
    __host__ __device__ bool next(int i, Unit& u) const {
        const long L = (long)i * G + c; if (L >= nwg) return false;
        int wgid = (int)L; { const int q = nwg / NXCD, r = nwg % NXCD, xcd = wgid % NXCD, off = wgid / NXCD; wgid = (xcd < r ? xcd * (q + 1) : r * (q + 1) + (xcd - r) * q) + off; }
        const int nig = WGM * nN, gid = wgid / nig, fm = gid * WGM, gsz = (nM - fm) < WGM ? (nM - fm) : WGM;
        u.pm = fm + ((wgid % nig) % gsz); u.pn = (wgid % nig) / gsz; return true;
    }
    __device__ __forceinline__ void a_ready(const Unit&) const {}
    __device__ __forceinline__ void done(const Unit&) const {}
};
struct GroupOrder {
    int mt, nt_, nwg, G, c;
    __host__ __device__ void init(int ngroups, int mt__, int nt__, int G_, int c_) { mt = mt__; nt_ = nt__; nwg = ngroups * mt * nt_; G = G_; c = c_; }
    __host__ __device__ bool next(int i, Unit& u) const {
        const long L = (long)i * G + c; if (L >= nwg) return false;
        const int per = mt * nt_, gi = (int)L / per, r = (int)L % per;
        u.pm = gi * mt + r % mt; u.pn = gi * nt_ + r / mt; return true;
    }
    __device__ __forceinline__ void a_ready(const Unit&) const {}
    __device__ __forceinline__ void done(const Unit&) const {}
};
template <class Epi, class Sched, bool ALIGN_EPI = false, bool SP2 = false>
__device__ __forceinline__ void gemm_phase(PG8_LAS unsigned char* lds, const Gemm g, const Sched& S, const Epi& E) {
    int tid_ = threadIdx.x; asm volatile("" : "+v"(tid_));
    const int tid = tid_, wid = __builtin_amdgcn_readfirstlane(tid >> 6), lane = tid & 63, wr = wid >> 2, wc = wid & 3, fr = lane & 15, fq = lane >> 4;
    const int K = g.K, nt = K / BK;
    unsigned voffA[2], voffB[2];
#pragma unroll
    for (int i = 0; i < 2; ++i) { int R, C; stage_rc(tid * 16 + i * 8192, R, C); const int Rb = Epi::PERM ? ((R & ~31) + perm32(R & 31)) : R;
        voffA[i] = (unsigned)(R * g.lda + C) * 2u; voffB[i] = (unsigned)(Rb * g.ldb + C) * 2u; }
    const size_t kstep = (size_t)(BK * 2);
    const size_t hstepA = (size_t)HALF * g.lda * 2, hstepB = (size_t)HALF * g.ldb * 2;
    const size_t tstepA = 2 * hstepA, tstepB = 2 * hstepB;
    const unsigned ldsw = (unsigned)wid * 1024u;
    const int aoff = lds_byte(wr * 64 + fr, fq * 8), boff = lds_byte(wc * 32 + fr, fq * 8);
#define PG8_SA(b, h) (((b) * 2 + (h)) * HTB)
#define PG8_SB(b, h) ((4 + (b) * 2 + (h)) * HTB)
#define PG8_STAGE(bufoff, gbase, voff) do { _Pragma("unroll") for (int _i = 0; _i < 2; ++_i) \
        __builtin_amdgcn_global_load_lds((const unsigned*)((const char*)(gbase) + (voff)[_i]), (PG8_LAS unsigned*)(lds + (bufoff) + ldsw + _i * 8192), 16, 0, 0); } while (0)
#define PG8_LDA(dst, b, h) do { _Pragma("unroll") for (int m = 0; m < 4; ++m) _Pragma("unroll") for (int k = 0; k < 2; ++k) dst[m][k] = *(const PG8_LAS bf16x8*)(lds + PG8_SA(b, h) + aoff + m * 2048 + k * 1024); } while (0)
#define PG8_LDB(dst, b, h) do { _Pragma("unroll") for (int n = 0; n < 2; ++n) _Pragma("unroll") for (int k = 0; k < 2; ++k) dst[n][k] = *(const PG8_LAS bf16x8*)(lds + PG8_SB(b, h) + boff + n * 2048 + k * 1024); } while (0)
#define PG8_MMA(ai, bj, At, Bt) do { __builtin_amdgcn_s_setprio(1); _Pragma("unroll") for (int m = 0; m < 4; ++m) _Pragma("unroll") for (int n = 0; n < 2; ++n) _Pragma("unroll") for (int k = 0; k < 2; ++k) \
        acc[ai][bj][m][n] = __builtin_amdgcn_mfma_f32_16x16x32_bf16(Bt[n][k], At[m][k], acc[ai][bj][m][n], 0, 0, 0); __builtin_amdgcn_s_setprio(0); } while (0)
#define PG8_WAIT_V(n) asm volatile("s_waitcnt vmcnt(" #n ")" ::: "memory")
#define PG8_WAIT_L(n) asm volatile("s_waitcnt lgkmcnt(" #n ")" ::: "memory")
#define PG8_BAR __builtin_amdgcn_s_barrier()
#define PG8_SCHED __builtin_amdgcn_sched_barrier(0)
    Unit cur, nxt; int ui = 0;
    if (!S.next(0, cur)) return;
    f32x4 acc[2][2][4][2];
    E.init(acc, cur, wr, wc, fr, fq);
    bf16x8 At[4][2], B0[2][2], B1[2][2];
    const char* cA = (const char*)g.A + (size_t)cur.pm * tstepA; const char* cB = (const char*)g.Bt + (size_t)cur.pn * tstepB;
    S.a_ready(cur);
    if constexpr (SP2) {
        PG8_STAGE(PG8_SB(0, 0), cB, voffB); PG8_STAGE(PG8_SB(0, 1), cB + hstepB, voffB); PG8_STAGE(PG8_SA(0, 0), cA, voffA); PG8_STAGE(PG8_SA(0, 1), cA + hstepA, voffA);
        if (wr == 1) PG8_BAR;
        PG8_WAIT_V(2); PG8_BAR;
        PG8_STAGE(PG8_SB(1, 0), cB + kstep, voffB); PG8_STAGE(PG8_SA(1, 0), cA + kstep, voffA); PG8_STAGE(PG8_SB(1, 1), cB + hstepB + kstep, voffB);
        PG8_WAIT_V(6); PG8_BAR;
    } else {
        PG8_STAGE(PG8_SB(0, 0), cB, voffB); PG8_STAGE(PG8_SA(0, 0), cA, voffA); PG8_STAGE(PG8_SB(0, 1), cB + hstepB, voffB); PG8_STAGE(PG8_SA(0, 1), cA + hstepA, voffA);
        if (wr == 1) PG8_BAR;
        PG8_WAIT_V(4); PG8_BAR;
        PG8_STAGE(PG8_SB(1, 0), cB + kstep, voffB); PG8_STAGE(PG8_SA(1, 0), cA + kstep, voffA); PG8_STAGE(PG8_SB(1, 1), cB + hstepB + kstep, voffB);
        PG8_WAIT_V(6); PG8_BAR;
    }
    for (;;) {
        const bool has_next = S.next(ui + 1, nxt);
        const char* nA = has_next ? (const char*)g.A + (size_t)nxt.pm * tstepA : cA; const char* nB = has_next ? (const char*)g.Bt + (size_t)nxt.pn * tstepB : cB;
        for (int t = 0; t < nt; t += 2) {
            const bool last = (t == nt - 2);
            const char* a1 = cA + (size_t)(t + 1) * kstep;
            const char* a2 = last ? nA : cA + (size_t)(t + 2) * kstep; const char* b2 = last ? nB : cB + (size_t)(t + 2) * kstep;
            const char* a3 = a2 + kstep; const char* b3 = b2 + kstep;
            if (last && has_next) S.a_ready(nxt);
            if constexpr (SP2) {
            PG8_LDB(B0, 0, 0); PG8_LDB(B1, 0, 1); PG8_SCHED; PG8_LDA(At, 0, 0); PG8_STAGE(PG8_SA(1, 1), a1 + hstepA, voffA);
            PG8_WAIT_V(8); PG8_WAIT_L(0); PG8_BAR; PG8_MMA(0, 0, At, B0); PG8_MMA(0, 1, At, B1); PG8_BAR; PG8_SCHED;
            PG8_LDA(At, 0, 1); PG8_STAGE(PG8_SB(0, 0), b2, voffB); PG8_STAGE(PG8_SB(0, 1), b2 + hstepB, voffB); PG8_STAGE(PG8_SA(0, 0), a2, voffA);
            PG8_WAIT_V(8); PG8_WAIT_L(0); PG8_BAR; PG8_MMA(1, 0, At, B0); PG8_MMA(1, 1, At, B1); PG8_BAR; PG8_SCHED;
            PG8_LDB(B0, 1, 0); PG8_LDB(B1, 1, 1); PG8_SCHED; PG8_LDA(At, 1, 0); PG8_STAGE(PG8_SA(0, 1), a2 + hstepA, voffA);
            PG8_WAIT_V(8); PG8_WAIT_L(0); PG8_BAR; PG8_MMA(0, 0, At, B0); PG8_MMA(0, 1, At, B1); PG8_BAR; PG8_SCHED;
            PG8_LDA(At, 1, 1); PG8_STAGE(PG8_SB(1, 0), b3, voffB); PG8_STAGE(PG8_SB(1, 1), b3 + hstepB, voffB); PG8_STAGE(PG8_SA(1, 0), a3, voffA);
            PG8_WAIT_V(8); PG8_WAIT_L(0); PG8_BAR; PG8_MMA(1, 0, At, B0); PG8_MMA(1, 1, At, B1); PG8_BAR; PG8_SCHED;
            } else {
            PG8_LDB(B0, 0, 0); PG8_SCHED; PG8_LDA(At, 0, 0); PG8_STAGE(PG8_SA(1, 1), a1 + hstepA, voffA);
            PG8_WAIT_L(8); PG8_BAR; PG8_WAIT_L(0); PG8_MMA(0, 0, At, B0); PG8_BAR; PG8_SCHED;
            PG8_LDB(B1, 0, 1); PG8_STAGE(PG8_SB(0, 0), b2, voffB);
            PG8_BAR; PG8_WAIT_L(0); PG8_MMA(0, 1, At, B1); PG8_BAR;
            PG8_LDA(At, 0, 1); PG8_STAGE(PG8_SA(0, 0), a2, voffA);
            PG8_BAR; PG8_WAIT_L(0); PG8_MMA(1, 0, At, B0); PG8_BAR; PG8_SCHED;
            PG8_STAGE(PG8_SB(0, 1), b2 + hstepB, voffB);
            PG8_WAIT_V(6); PG8_BAR; PG8_MMA(1, 1, At, B1); PG8_BAR;
            PG8_LDB(B0, 1, 0); PG8_SCHED; PG8_LDA(At, 1, 0); PG8_STAGE(PG8_SA(0, 1), a2 + hstepA, voffA);
            PG8_WAIT_L(8); PG8_BAR; PG8_WAIT_L(0); PG8_MMA(0, 0, At, B0); PG8_BAR; PG8_SCHED;
            PG8_LDB(B1, 1, 1); PG8_STAGE(PG8_SB(1, 0), b3, voffB);
            PG8_BAR; PG8_WAIT_L(0); PG8_MMA(0, 1, At, B1); PG8_BAR;
            PG8_LDA(At, 1, 1); PG8_STAGE(PG8_SA(1, 0), a3, voffA);
            PG8_BAR; PG8_WAIT_L(0); PG8_MMA(1, 0, At, B0); PG8_BAR; PG8_SCHED;
            PG8_STAGE(PG8_SB(1, 1), b3 + hstepB, voffB);
            PG8_WAIT_V(6); PG8_BAR; PG8_MMA(1, 1, At, B1); PG8_BAR;
            }
        }
        if constexpr (ALIGN_EPI) { if (wr == 0) PG8_BAR; }
        if constexpr (!Epi::AFTER_DRAIN) { E(acc, cur, wr, wc, fr, fq); S.done(cur); }
        if (!has_next) break;
        E.init(acc, nxt, wr, wc, fr, fq);
        cur = nxt; cA = nA; cB = nB; ++ui;
        if constexpr (ALIGN_EPI) { if (wr == 1) PG8_BAR; }
    }
    PG8_WAIT_V(0);
    if constexpr (!ALIGN_EPI) { if (wr == 0) PG8_BAR; }
    PG8_BAR;
    if constexpr (Epi::AFTER_DRAIN) { E.fused(acc, cur, wr, wc, fr, fq, lds, wid, lane); S.done(cur); }
#undef PG8_SA
#undef PG8_SB
#undef PG8_STAGE
#undef PG8_LDA
#undef PG8_LDB
#undef PG8_MMA
#undef PG8_WAIT_V
#undef PG8_WAIT_L
#undef PG8_BAR
#undef PG8_SCHED
}
}
#define EPI_ZERO_INIT \
  __device__ __forceinline__ void init(pg8::f32x4 (&acc)[2][2][4][2], const pg8::Unit&, int, int, int, int) const { \
    _Pragma("unroll") for (int a = 0; a < 2; ++a) _Pragma("unroll") for (int b = 0; b < 2; ++b) \
    _Pragma("unroll") for (int m = 0; m < 4; ++m) _Pragma("unroll") for (int n = 0; n < 2; ++n) acc[a][b][m][n] = (pg8::f32x4){0.f, 0.f, 0.f, 0.f}; }
struct EpiResid {
  static constexpr bool PERM = true, AFTER_DRAIN = false;
  float* C; int ldc; bf16_t* xb; bf16_t* hb; const float* g2; float* parts;
  __device__ __forceinline__ void init(pg8::f32x4 (&acc)[2][2][4][2], const pg8::Unit& u, int wr, int wc, int fr, int fq) const {
#pragma unroll
    for (int ai = 0; ai < 2; ++ai)
#pragma unroll
      for (int m = 0; m < 4; ++m) {
        const int row = u.pm * 256 + ai * 128 + wr * 64 + m * 16 + fr;
#pragma unroll
        for (int bj = 0; bj < 2; ++bj)
#pragma unroll
          for (int n = 0; n < 2; ++n) {
            const int col = u.pn * 256 + bj * 128 + wc * 32 + 8 * fq + 4 * n;
            acc[ai][bj][m][n] = *(const pg8::f32x4*)(C + (size_t)row * ldc + col);
          }
      }
  }
  __device__ __forceinline__ void operator()(const pg8::f32x4 (&acc)[2][2][4][2], const pg8::Unit& u, int wr, int wc, int fr_in, int fq_in) const {
    int fr = fr_in, fq = fq_in; asm volatile("" : "+v"(fr), "+v"(fq));
    pg8::f32x4 gv[2][2];
#pragma unroll
    for (int bj = 0; bj < 2; ++bj)
#pragma unroll
      for (int n = 0; n < 2; ++n) gv[bj][n] = *(const pg8::f32x4*)(g2 + u.pn * 256 + bj * 128 + wc * 32 + 8 * fq + 4 * n);
#pragma unroll
    for (int ai = 0; ai < 2; ++ai)
#pragma unroll
      for (int m = 0; m < 4; ++m) {
        const int row = u.pm * 256 + ai * 128 + wr * 64 + m * 16 + fr;
        float ss = 0.f;
#pragma unroll
        for (int bj = 0; bj < 2; ++bj) {
          const int col = u.pn * 256 + bj * 128 + wc * 32 + 8 * fq;
          const pg8::f32x4 v0 = acc[ai][bj][m][0], v1 = acc[ai][bj][m][1];
          *(pg8::f32x4*)(C + (size_t)row * ldc + col) = v0; *(pg8::f32x4*)(C + (size_t)row * ldc + col + 4) = v1;
          *(uint4*)(xb + (size_t)row * KD + col) = make_uint4(pk_bf16(v0[0], v0[1]), pk_bf16(v0[2], v0[3]), pk_bf16(v1[0], v1[1]), pk_bf16(v1[2], v1[3]));
          const pg8::f32x4 h0 = v0 * gv[bj][0], h1 = v1 * gv[bj][1];
          *(uint4*)(hb + ((size_t)(col >> 7) * T + row) * 128 + (col & 127)) = make_uint4(pk_bf16(h0[0], h0[1]), pk_bf16(h0[2], h0[3]), pk_bf16(h1[0], h1[1]), pk_bf16(h1[2], h1[3]));
          ss += ((v0[0] * v0[0] + v0[1] * v0[1]) + (v0[2] * v0[2] + v0[3] * v0[3])) + ((v1[0] * v1[0] + v1[1] * v1[1]) + (v1[2] * v1[2] + v1[3] * v1[3]));
        }
        ss += __shfl_xor(ss, 16); ss += __shfl_xor(ss, 32);
        if (fq == 0) parts[(size_t)row * 16 + u.pn * 4 + wc] = ss;
        asm volatile("" ::: "memory");
      }
  }
};
struct EpiScaleStoreBf16 {
  static constexpr bool PERM = true, AFTER_DRAIN = false;
  bf16_t* C; int ldc; const float* parts; int nparts; float* rs_out;
  EPI_ZERO_INIT
  __device__ __forceinline__ void operator()(const pg8::f32x4 (&acc)[2][2][4][2], const pg8::Unit& u, int wr, int wc, int fr_in, int fq_in) const {
    int fr = fr_in, fq = fq_in; asm volatile("" : "+v"(fr), "+v"(fq));
#pragma unroll
    for (int ai = 0; ai < 2; ++ai)
#pragma unroll
      for (int m = 0; m < 4; ++m) {
        const int row = u.pm * 256 + ai * 128 + wr * 64 + m * 16 + fr;
        float ssum = 0.f;
        for (int i = 0; i < nparts; i += 4) { const pg8::f32x4 q4 = *(const pg8::f32x4*)(parts + (size_t)row * nparts + i); ssum += (q4[0] + q4[1]) + (q4[2] + q4[3]); }
        const float r = rsqrtf(ssum * (1.0f / (float)D) + EPS);
        if (rs_out && u.pn == 0 && wc == 0 && fq == 0) rs_out[row] = r;
#pragma unroll
        for (int bj = 0; bj < 2; ++bj) {
          const int col = u.pn * 256 + bj * 128 + wc * 32 + 8 * fq;
          const pg8::f32x4 v0 = acc[ai][bj][m][0] * r, v1 = acc[ai][bj][m][1] * r;
          *(uint4*)(C + (size_t)row * ldc + col) = make_uint4(pk_bf16(v0[0], v0[1]), pk_bf16(v0[2], v0[3]), pk_bf16(v1[0], v1[1]), pk_bf16(v1[2], v1[3]));
        }
        asm volatile("" ::: "memory");
      }
  }
};
struct EpiInProj {
  static constexpr bool PERM = true, AFTER_DRAIN = false;
  const float* parts;
  bf16_t *S5A, *Qm, *Km, *vrow, *Qr, *Kr, *krow, *vrrow, *grow;
  const float *gq, *gk, *cosm, *sinm, *cosr, *sinr;
  EPI_ZERO_INIT
  __device__ __forceinline__ void operator()(const pg8::f32x4 (&acc)[2][2][4][2], const pg8::Unit& u, int wr, int wc, int fr_in, int fq_in) const {
    int fr = fr_in, fq = fq_in; asm volatile("" : "+v"(fr), "+v"(fq));
    const int pn = u.pn;
    float gain[2][8];
    if (pn >= 1 && pn <= 4) {
      const float* gsrc = pn <= 2 ? gq : gk;
#pragma unroll
      for (int bj = 0; bj < 2; ++bj) { const pg8::f32x4 a = *(const pg8::f32x4*)(gsrc + bj * 32 + 8 * fq), b = *(const pg8::f32x4*)(gsrc + bj * 32 + 8 * fq + 4);
        gain[bj][0] = a[0]; gain[bj][1] = a[1]; gain[bj][2] = a[2]; gain[bj][3] = a[3]; gain[bj][4] = b[0]; gain[bj][5] = b[1]; gain[bj][6] = b[2]; gain[bj][7] = b[3]; }
    }
    const float l2g = ret_log2g(wc);
#pragma unroll
    for (int ai = 0; ai < 2; ++ai)
#pragma unroll
      for (int m = 0; m < 4; ++m) {
        const int t = u.pm * 256 + ai * 128 + wr * 64 + m * 16 + fr, s = t & (S - 1), b = t >> 12;
        float r;
        { const pg8::f32x4 p0 = *(const pg8::f32x4*)(parts + (size_t)t * 8), p1 = *(const pg8::f32x4*)(parts + (size_t)t * 8 + 4);
          r = rsqrtf((((p0[0] + p0[1]) + (p0[2] + p0[3])) + ((p1[0] + p1[1]) + (p1[2] + p1[3]))) * (1.0f / (float)D) + EPS); }
        float v[2][8];
#pragma unroll
        for (int bj = 0; bj < 2; ++bj)
#pragma unroll
          for (int e = 0; e < 8; ++e) v[bj][e] = acc[ai][bj][m][e >> 2][e & 3] * r;
#define PK8(x_) make_uint4(pk_bf16((x_)[0], (x_)[1]), pk_bf16((x_)[2], (x_)[3]), pk_bf16((x_)[4], (x_)[5]), pk_bf16((x_)[6], (x_)[7]))
        if (pn == 0) {
#pragma unroll
          for (int bj = 0; bj < 2; ++bj) { const int g = wc * 4 + bj * 2 + (fq >> 1);
            *(uint4*)(S5A + ((size_t)g * 1024 + (t >> 5)) * 640 + (t & 31) * 16 + 8 * (fq & 1)) = PK8(v[bj]); }
        } else if (pn <= 4) {
          const bool isk = pn >= 3; const int h = ((pn - 1) & 1) * 4 + wc, bh = b * 8 + h;
          float ss = 0.f;
#pragma unroll
          for (int bj = 0; bj < 2; ++bj)
#pragma unroll
            for (int e = 0; e < 8; ++e) ss += v[bj][e] * v[bj][e];
          ss += __shfl_xor(ss, 16); ss += __shfl_xor(ss, 32);
          const float rh = rsqrtf(ss * (1.0f / 64.0f) + EPS);
#pragma unroll
          for (int bj = 0; bj < 2; ++bj)
#pragma unroll
            for (int e = 0; e < 8; ++e) v[bj][e] *= rh * gain[bj][e];
          { const pg8::f32x4 c0 = *(const pg8::f32x4*)(cosm + s * 8), c1 = *(const pg8::f32x4*)(cosm + s * 8 + 4), s0 = *(const pg8::f32x4*)(sinm + s * 8), s1 = *(const pg8::f32x4*)(sinm + s * 8 + 4);
#pragma unroll
            for (int e = 0; e < 8; ++e) {
              const float pu = __shfl_xor(v[0][e], 16);
              const float c = e < 4 ? c0[e & 3] : c1[e & 3], sn = e < 4 ? s0[e & 3] : s1[e & 3];
              const float o = fq == 0 ? (v[0][e] * c - pu * sn) : (v[0][e] * c + pu * sn);
              v[0][e] = fq < 2 ? o : v[0][e];
            } }
          if (!isk) {
#pragma unroll
            for (int bj = 0; bj < 2; ++bj) { float q8[8];
#pragma unroll
              for (int e = 0; e < 8; ++e) q8[e] = v[bj][e] * QSCALE;
              *(uint4*)(Qm + ((size_t)bh * S + s) * 64 + bj * 32 + 8 * fq) = PK8(q8); }
          } else {
#pragma unroll
            for (int bj = 0; bj < 2; ++bj) *(uint4*)(Km + ((((size_t)bh * (S / 32) + (s >> 5)) * 8 + bj * 4 + fq) * 32 + (s & 31)) * 8) = PK8(v[bj]);
          }
        } else if (pn <= 6) {
#pragma unroll
          for (int bj = 0; bj < 2; ++bj) *(uint4*)(vrow + (size_t)t * 512 + (pn - 5) * 256 + wc * 64 + bj * 32 + 8 * fq) = PK8(v[bj]);
        } else if (pn <= 8) {
          const bool isk = pn == 8; const int bh = b * 4 + wc, pos = s & 127;
          const float sc = isk ? 0.125f * exp2f(-(float)pos * l2g) : exp2f((float)pos * l2g);
          const pg8::f32x4 c0 = *(const pg8::f32x4*)(cosr + s * 32 + 8 * fq), c1 = *(const pg8::f32x4*)(cosr + s * 32 + 8 * fq + 4);
          const pg8::f32x4 s0 = *(const pg8::f32x4*)(sinr + s * 32 + 8 * fq), s1 = *(const pg8::f32x4*)(sinr + s * 32 + 8 * fq + 4);
          float o1[8], o2[8];
#pragma unroll
          for (int e = 0; e < 8; ++e) { const float c = e < 4 ? c0[e & 3] : c1[e & 3], sn = e < 4 ? s0[e & 3] : s1[e & 3];
            o1[e] = (v[0][e] * c - v[1][e] * sn) * sc; o2[e] = (v[1][e] * c + v[0][e] * sn) * sc; }
          if (!isk) {
            *(uint4*)(Qr + ((size_t)bh * S + s) * 64 + 8 * fq) = PK8(o1); *(uint4*)(Qr + ((size_t)bh * S + s) * 64 + 32 + 8 * fq) = PK8(o2);
          } else {
            *(uint4*)(Kr + ((((size_t)bh * (S / 32) + (s >> 5)) * 8 + fq) * 32 + (s & 31)) * 8) = PK8(o1);
            *(uint4*)(Kr + ((((size_t)bh * (S / 32) + (s >> 5)) * 8 + 4 + fq) * 32 + (s & 31)) * 8) = PK8(o2);
            *(uint4*)(krow + (size_t)t * 256 + wc * 64 + 8 * fq) = PK8(o1); *(uint4*)(krow + (size_t)t * 256 + wc * 64 + 32 + 8 * fq) = PK8(o2);
          }
        } else {
          bf16_t* dst = (pn == 9 ? vrrow : grow) + (size_t)t * 256 + wc * 64 + 8 * fq;
          *(uint4*)dst = PK8(v[0]); *(uint4*)(dst + 32) = PK8(v[1]);
        }
#undef PK8
        asm volatile("" ::: "memory");
      }
  }
};
template <class Epi>
__device__ __forceinline__ void run_gemm(unsigned char* lds_raw, const bf16_t* A, const bf16_t* Bt, int M, int N, int K, const Epi& e) {
  pg8::Gemm g{A, Bt, M, N, K, K, K}; pg8::StaticOrder So; So.init(M, N, (int)gridDim.x, (int)blockIdx.x);
  pg8::gemm_phase<Epi, pg8::StaticOrder, true, true>((PG8_LAS unsigned char*)lds_raw, g, So, e);
}

template <bool HEADPERM>
__device__ __forceinline__ void transpose_items(const float* __restrict__ W, int K, int N, const float* __restrict__ g, bf16_t* __restrict__ Wt, int gw, int ngw, int lane) {
  const int nkt = K / 64, nnt = N / 64;
  for (int it = gw; it < nkt * nnt; it += ngw) {
    int kt = it % nkt, ntile = it / nkt;
    int k0 = kt * 64, n = ntile * 64 + lane;
    int ns = n;
    if (HEADPERM) { const int cp = n & 255; ns = (n & ~255) + ((cp >> 5) & 3) * 64 + (cp >> 7) * 32 + (cp & 31); }
    float v[64];
#pragma unroll
    for (int i = 0; i < 64; ++i) v[i] = W[(size_t)(k0 + i) * N + ns] * g[k0 + i];
    bf16_t* dst = Wt + (size_t)n * (K * KS) + k0;
#pragma unroll
    for (int c = 0; c < 8; ++c) {
      bf16_t hi[8], lo[8];
#pragma unroll
      for (int e = 0; e < 8; ++e) { hi[e] = f2bf(v[c * 8 + e]); lo[e] = f2bf(v[c * 8 + e] - bf2f(hi[e])); }
      uint4 ph, pl;
      ph.x = hi[0] | ((unsigned)hi[1] << 16); ph.y = hi[2] | ((unsigned)hi[3] << 16); ph.z = hi[4] | ((unsigned)hi[5] << 16); ph.w = hi[6] | ((unsigned)hi[7] << 16);
      pl.x = lo[0] | ((unsigned)lo[1] << 16); pl.y = lo[2] | ((unsigned)lo[3] << 16); pl.z = lo[4] | ((unsigned)lo[5] << 16); pl.w = lo[6] | ((unsigned)lo[7] << 16);
      *(uint4*)(dst + c * 8) = ph;
      if (PRECISE) { *(uint4*)(dst + K + c * 8) = pl; *(uint4*)(dst + 2 * K + c * 8) = ph; }
    }
  }
}


__device__ __forceinline__ void phase_prologue(const Params& p, int gtid, int ngt, int gw, int ngw, int lane) {
  for (int idx = gtid; idx < S * 40; idx += ngt) {
    int s = idx / 40, i = idx % 40;
    if (i < 8) {
      float inv = powf(500000.0f, -(float)(2 * i) / 16.0f);
      float ang = (float)s * inv;
      p.cosm()[s * 8 + i] = (float)cos((double)ang); p.sinm()[s * 8 + i] = (float)sin((double)ang);
    } else {
      int j = i - 8;
      float inv = powf(10000.0f, -((float)j / 31.0f));
      float ang = (float)s * inv;
      p.cosr()[s * 32 + j] = (float)cos((double)ang); p.sinr()[s * 32 + j] = (float)sin((double)ang);
    }
  }
  { const float4* a = (const float4*)p.inp(0); float4* b = (float4*)p.outp();
    for (size_t i = gtid; i < (size_t)T * D / 4; i += ngt) b[i] = a[i]; }
  for (int t = gw; t < T; t += ngw) {
    const float4* xr = (const float4*)(p.inp(0) + (size_t)t * D); float ss = 0.f;
#pragma unroll
    for (int i = 0; i < 4; ++i) { const float4 v = xr[lane + i * 64]; ss += v.x * v.x + v.y * v.y + v.z * v.z + v.w * v.w;
      *(uint2*)(p.xb() + (size_t)t * KD + (lane + i * 64) * 4) = make_uint2(pk_bf16(v.x, v.y), pk_bf16(v.z, v.w)); }
    ss = wave_sum(ss);
    if (lane < 8) p.ssq1()[(size_t)t * 8 + lane] = lane == 0 ? ss : 0.f;
  }
  for (int idx = gtid; idx < NL * 65536; idx += ngt) { const int l2 = idx >> 16, n2 = (idx >> 8) & 255, k2 = idx & 255; p.Wglu_t()[idx] = f2bf(p.inp(11)[(size_t)l2 * 65536 + k2 * 256 + n2]); }
  for (int l = 0; l < NL; ++l) {
    transpose_items<true>(p.inp(2) + (size_t)l * D * INW, D, INW, p.inp(1) + l * D, p.Win_t() + (size_t)l * INW * KD, gw, ngw, lane);
    transpose_items<false>(p.inp(15) + (size_t)l * D * D, D, D, p.inp(14) + l * D, p.Wout_t() + (size_t)l * D * KD, gw, ngw, lane);
    transpose_items<false>(p.inp(17) + (size_t)l * D * D, D, D, p.inp(16) + l * D, p.Wq_t() + (size_t)l * D * KD, gw, ngw, lane);
  }
}


struct S5P { float lr, li, dt, fr, fi; };
__device__ __forceinline__ S5P s5p(const Params& p, int l, int g, int pp) {
  S5P r; r.lr = p.inp(3)[l * 1024 + g * 64 + pp]; r.li = p.inp(4)[l * 1024 + g * 64 + pp]; r.dt = expf(p.inp(5)[l * 16 + g]);
  const float mag = expf(r.lr * r.dt); float sn, cs; sincosf(r.li * r.dt, &sn, &cs);
  const float ar = mag * cs, ai = mag * sn, den = r.lr * r.lr + r.li * r.li;
  r.fr = ((ar - 1.0f) * r.lr + ai * r.li) / den; r.fi = (ai * r.lr - (ar - 1.0f) * r.li) / den;
  return r;
}
__device__ __forceinline__ void s5pow(const S5P& s, int k, float& re, float& im) {
  const float m = expf((float)k * s.lr * s.dt); float sn, cs; sincosf((float)k * s.li * s.dt, &sn, &cs); re = m * cs; im = m * sn;
}
__device__ __forceinline__ void phase_s5_prep(const Params& p, int l, int gtid, int ngt) {
  const float* b_re = p.inp(6) + l * 16384; const float* b_im = p.inp(7) + l * 16384;
  const float* c_re = p.inp(8) + l * 16384; const float* c_im = p.inp(9) + l * 16384;
  bf16_t* Wy = p.S5Wy(); bf16_t* Wz = p.S5Wz();
  for (int it = gtid; it < 16 * 32 * 256; it += ngt) {
    const int hp = it & 15, h = (it >> 4) & 15, d = (it >> 8) & 31, g = it >> 13;
    float acc = 0.f;
    for (int pp = 0; pp < 64; ++pp) {
      const S5P s = s5p(p, l, g, pp);
      float pr, pi; s5pow(s, d, pr, pi);
      const float br = b_re[(g * 64 + pp) * 16 + hp], bi = b_im[(g * 64 + pp) * 16 + hp];
      const float bbr = s.fr * br - s.fi * bi, bbi = s.fr * bi + s.fi * br;
      const float tr = pr * bbr - pi * bbi, ti = pr * bbi + pi * bbr;
      acc += c_re[(g * 16 + h) * 64 + pp] * tr - c_im[(g * 16 + h) * 64 + pp] * ti;
    }
    const bf16_t v = f2bf(acc);
    for (int jp = 0; jp + d < 32; ++jp) {
      const int j = jp + d;
      Wy[((size_t)g * 512 + j * 16 + h) * 640 + jp * 16 + hp] = v;
      if (d > 0) Wy[((size_t)g * 512 + jp * 16 + h) * 640 + j * 16 + hp] = 0;
    }
  }
  for (int it = gtid; it < 16 * 32 * 16 * 64; it += ngt) {
    const int pp = it & 63, h = (it >> 6) & 15, j = (it >> 10) & 31, g = it >> 15;
    const S5P s = s5p(p, l, g, pp);
    float pr, pi; s5pow(s, j + 1, pr, pi);
    const float cr = c_re[(g * 16 + h) * 64 + pp], ci = c_im[(g * 16 + h) * 64 + pp];
    const unsigned w = pk_bf16(cr * pr - ci * pi, -(cr * pi + ci * pr));
    *(unsigned*)(Wy + ((size_t)g * 512 + j * 16 + h) * 640 + 512 + 2 * pp) = w;
  }
  for (int it = gtid; it < 16 * 64 * 32; it += ngt) {
    const int j = it & 31, pp = (it >> 5) & 63, g = it >> 11;
    const S5P s = s5p(p, l, g, pp);
    float pr, pi; s5pow(s, 31 - j, pr, pi);
    for (int hp = 0; hp < 16; ++hp) {
      const float br = b_re[(g * 64 + pp) * 16 + hp], bi = b_im[(g * 64 + pp) * 16 + hp];
      const float bbr = s.fr * br - s.fi * bi, bbi = s.fr * bi + s.fi * br;
      Wz[((size_t)g * 256 + 2 * pp) * 512 + j * 16 + hp] = f2bf(pr * bbr - pi * bbi);
      Wz[((size_t)g * 256 + 2 * pp + 1) * 512 + j * 16 + hp] = f2bf(pr * bbi + pi * bbr);
    }
  }
  for (int it = gtid; it < 16 * 64; it += ngt) {
    const S5P s = s5p(p, l, it >> 6, it & 63);
    float pr, pi; s5pow(s, 32, pr, pi);
    p.S5a32()[it * 2] = pr; p.S5a32()[it * 2 + 1] = pi;
  }
}
__device__ __forceinline__ void phase_s5_scan(const Params& p, int gtid, int ngt) {
  for (int it = gtid; it < NB * 16 * 64; it += ngt) {
    const int pp = it & 63, g = (it >> 6) & 15, b = it >> 10;
    const float er = p.S5a32()[(g * 64 + pp) * 2], ei = p.S5a32()[(g * 64 + pp) * 2 + 1];
    float sr = 0.f, si = 0.f;
#pragma unroll 1
    for (int c0 = 0; c0 < 128; c0 += 16) {
      float2 z[16];
#pragma unroll
      for (int k = 0; k < 16; ++k) z[k] = *(const float2*)(p.S5Z() + ((size_t)g * 1024 + b * 128 + c0 + k) * 128 + 2 * pp);
#pragma unroll
      for (int k = 0; k < 16; ++k) {
        const size_t ch = (size_t)g * 1024 + b * 128 + c0 + k;
        *(unsigned*)(p.S5A() + ch * 640 + 512 + 2 * pp) = pk_bf16(sr, si);
        const float nr = er * sr - ei * si + z[k].x, ni = er * si + ei * sr + z[k].y;
        sr = nr; si = ni;
      }
    }
  }
}
struct EpiS5Z {
  static constexpr bool PERM = false, AFTER_DRAIN = false;
  float* Z;
  EPI_ZERO_INIT
  __device__ __forceinline__ void operator()(const pg8::f32x4 (&acc)[2][2][4][2], const pg8::Unit& u, int wr, int wc, int fr_in, int fq_in) const {
    int fr = fr_in, fq = fq_in; asm volatile("" : "+v"(fr), "+v"(fq));
    const int g = u.pm >> 2;
#pragma unroll
    for (int ai = 0; ai < 2; ++ai)
#pragma unroll
      for (int m = 0; m < 4; ++m) {
        const int chunk = (u.pm & 3) * 256 + ai * 128 + wr * 64 + m * 16 + fr;
#pragma unroll
        for (int n = 0; n < 2; ++n) *(pg8::f32x4*)(Z + ((size_t)g * 1024 + chunk) * 128 + wc * 32 + n * 16 + 4 * fq) = acc[ai][0][m][n];
      }
  }
};
struct EpiS5Y {
  static constexpr bool PERM = false, AFTER_DRAIN = false;
  bf16_t* ygb; const bf16_t* A; const float* dsk;
  EPI_ZERO_INIT
  __device__ __forceinline__ void operator()(const pg8::f32x4 (&acc)[2][2][4][2], const pg8::Unit& u, int wr, int wc, int fr_in, int fq_in) const {
    int fr = fr_in, fq = fq_in; asm volatile("" : "+v"(fr), "+v"(fq));
    const int g = u.pm >> 2;
#pragma unroll
    for (int ai = 0; ai < 2; ++ai)
#pragma unroll
      for (int m = 0; m < 4; ++m) {
        const int chunk = (u.pm & 3) * 256 + ai * 128 + wr * 64 + m * 16 + fr;
#pragma unroll
        for (int bj = 0; bj < 2; ++bj)
#pragma unroll
          for (int n = 0; n < 2; ++n) {
            const int col = (u.pn & 1) * 256 + bj * 128 + wc * 32 + n * 16 + 4 * fq, j = col >> 4, h = col & 15;
            const uint2 uu = *(const uint2*)(A + ((size_t)g * 1024 + chunk) * 640 + col);
            const pg8::f32x4 dv = *(const pg8::f32x4*)(dsk + g * 16 + h);
            const pg8::f32x4 v = acc[ai][bj][m][n];
            const float y0 = fast_gelu(v[0] + dv[0] * __uint_as_float(uu.x << 16)), y1 = fast_gelu(v[1] + dv[1] * __uint_as_float(uu.x & 0xffff0000u));
            const float y2 = fast_gelu(v[2] + dv[2] * __uint_as_float(uu.y << 16)), y3 = fast_gelu(v[3] + dv[3] * __uint_as_float(uu.y & 0xffff0000u));
            uint2 o; o.x = pk_bf16(y0, y1); o.y = pk_bf16(y2, y3);
            *(uint2*)(ygb + ((size_t)chunk * 32 + j) * 256 + g * 16 + h) = o;
          }
        asm volatile("" ::: "memory");
      }
  }
};
struct EpiGlu {
  static constexpr bool PERM = false, AFTER_DRAIN = false;
  bf16_t* yb; const bf16_t* ygb; float* scr;
  EPI_ZERO_INIT
  __device__ __forceinline__ void operator()(const pg8::f32x4 (&acc_)[2][2][4][2], const pg8::Unit& u, int wr, int wc, int fr_in, int fq_in) const {
    int fr = fr_in, fq = fq_in; asm volatile("" : "+v"(fr), "+v"(fq));
    pg8::f32x4 (&acc)[2][2][4][2] = const_cast<pg8::f32x4 (&)[2][2][4][2]>(acc_);
#pragma unroll
    for (int ai = 0; ai < 2; ++ai)
#pragma unroll
      for (int m = 0; m < 4; ++m) {
        const int rl = ai * 128 + wr * 64 + m * 16 + fr, row = u.pm * 256 + rl;
        float ss = 0.f;
#pragma unroll
        for (int bj = 0; bj < 2; ++bj)
#pragma unroll
          for (int n = 0; n < 2; ++n) {
            const int col = bj * 128 + wc * 32 + n * 16 + 4 * fq;
            const uint2 yy = *(const uint2*)(ygb + (size_t)row * 256 + col);
            const pg8::f32x4 z = acc[ai][bj][m][n];
            pg8::f32x4 r;
            r[0] = __uint_as_float(yy.x << 16) * fast_sigmoid(z[0]); r[1] = __uint_as_float(yy.x & 0xffff0000u) * fast_sigmoid(z[1]);
            r[2] = __uint_as_float(yy.y << 16) * fast_sigmoid(z[2]); r[3] = __uint_as_float(yy.y & 0xffff0000u) * fast_sigmoid(z[3]);
            acc[ai][bj][m][n] = r;
            ss += r[0] * r[0] + r[1] * r[1] + r[2] * r[2] + r[3] * r[3];
          }
        ss += __shfl_xor(ss, 16); ss += __shfl_xor(ss, 32);
        if (fq == 0) scr[rl * 4 + wc] = ss;
        asm volatile("" ::: "memory");
      }
    asm volatile("s_waitcnt lgkmcnt(0)" ::: "memory"); __builtin_amdgcn_s_barrier(); asm volatile("" ::: "memory");
#pragma unroll
    for (int ai = 0; ai < 2; ++ai)
#pragma unroll
      for (int m = 0; m < 4; ++m) {
        const int rl = ai * 128 + wr * 64 + m * 16 + fr, row = u.pm * 256 + rl;
        const pg8::f32x4 s4 = *(const pg8::f32x4*)(scr + rl * 4);
        const float r = rsqrtf((s4[0] + s4[1] + s4[2] + s4[3]) / 256.0f + EPS);
#pragma unroll
        for (int bj = 0; bj < 2; ++bj)
#pragma unroll
          for (int n = 0; n < 2; ++n) { const pg8::f32x4 v = acc[ai][bj][m][n] * r; *(uint2*)(yb + (size_t)row * KD + bj * 128 + wc * 32 + n * 16 + 4 * fq) = make_uint2(pk_bf16(v[0], v[1]), pk_bf16(v[2], v[3])); }
        asm volatile("" ::: "memory");
      }
    asm volatile("s_waitcnt lgkmcnt(0)" ::: "memory"); __builtin_amdgcn_s_barrier(); asm volatile("" ::: "memory");
  }
};


__device__ __forceinline__ void phase_moba2(const Params& p, int l, unsigned char* lds, int* uq) {
  constexpr int OLD = 260;
  bf16_t* Qs = (bf16_t*)lds;
  float* Oaccf = (float*)(lds + 32768);
  float* laccf = (float*)(lds + 32768 + 64 * OLD * 4);
  float* kms = laccf + 256;
  float* gat = kms + 1024;
  unsigned char* lists = (unsigned char*)(gat + 4096);
  int* cnt = (int*)(lists + 4096);
  int* items = cnt + 16;
  int* ctr = items + 160;
  unsigned* selp = (unsigned*)(ctr + 4);
  float* bq = (float*)(selp + 256);
  int* Oacc = (int*)Oaccf; int* lacc = (int*)laccf;
  float kmax = 0.f;
  { const float* gk = p.inp(13) + l * 64;
    for (int d = 0; d < 64; ++d) kmax = fmaxf(kmax, fabsf(gk[d]));
    kmax *= 8.0f * 1.01f; }
  for (;;) {
    const int u = q_pull(uq, NB * 8 * 16, (int*)(lds + 131072), threadIdx.x);
    if (u < 0) break;
    const int qblk = 15 - (u >> 6), bh = u & 63, b = bh >> 3, h = bh & 7;
    int tid = threadIdx.x; asm volatile("" : "+v"(tid));
    const int lane = tid & 63, wv = tid >> 6, n = lane & 31, hh = lane >> 5;
    __syncthreads();
    { const uint4* src = (const uint4*)(p.Qm() + ((size_t)bh * S + qblk * 256) * 64);
      uint4* dst = (uint4*)Qs;
      for (int i = tid; i < 256 * 64 * 2 / 16; i += NTHR) dst[i] = src[i]; }
    for (int i = tid; i < qblk * 64; i += NTHR) kms[i] = p.kmean()[(size_t)bh * 1024 + i];
    for (int i = tid; i < 64 * OLD; i += NTHR) Oacc[i] = 0;
    if (tid < 256) lacc[tid] = 0;
    if (tid < 16) cnt[tid] = 0;
    __syncthreads();
    { const int q = tid & 255, par = tid >> 8;
      float qv[64];
#pragma unroll
      for (int c = 0; c < 8; ++c) {
        uint4 w = *(const uint4*)(Qs + q * 64 + c * 8);
        qv[c * 8 + 0] = __uint_as_float(w.x << 16); qv[c * 8 + 1] = __uint_as_float(w.x & 0xffff0000u);
        qv[c * 8 + 2] = __uint_as_float(w.y << 16); qv[c * 8 + 3] = __uint_as_float(w.y & 0xffff0000u);
        qv[c * 8 + 4] = __uint_as_float(w.z << 16); qv[c * 8 + 5] = __uint_as_float(w.z & 0xffff0000u);
        qv[c * 8 + 6] = __uint_as_float(w.w << 16); qv[c * 8 + 7] = __uint_as_float(w.w & 0xffff0000u);
      }
      if (par == 0) { float qq = 0.f;
#pragma unroll
        for (int d = 0; d < 64; ++d) qq = fmaf(qv[d], qv[d], qq);
        bq[q] = sqrtf(qq) * kmax; }
      for (int j = par; j < qblk; j += 2) {
        float g = 0.f;
#pragma unroll
        for (int d = 0; d < 64; ++d) g = fmaf(qv[d], kms[j * 64 + d], g);
        gat[q * 16 + j] = g;
      }
    }
    __syncthreads();
    if (tid < 256) {
      float b0 = -INFINITY, b1 = -INFINITY, b2 = -INFINITY; int i0 = 0, i1 = 0, i2 = 0;
      for (int j = 0; j < qblk; ++j) {
        float g = gat[tid * 16 + j];
        if (g > b0) { b2 = b1; i2 = i1; b1 = b0; i1 = i0; b0 = g; i0 = j; }
        else if (g > b1) { b2 = b1; i2 = i1; b1 = g; i1 = j; }
        else if (g > b2) { b2 = g; i2 = j; }
      }
      const int nsel = qblk < 3 ? qblk : 3;
      selp[tid] = (unsigned)i0 | ((unsigned)i1 << 4) | ((unsigned)i2 << 8) | ((unsigned)nsel << 12);
    }
    __syncthreads();
    for (int j = wv; j < qblk; j += 8) {
      int base = 0;
      for (int c = 0; c < 4; ++c) {
        const int q = c * 64 + lane;
        const unsigned sp = selp[q];
        const int ns = sp >> 12;
        const bool f = (ns > 0 && (int)(sp & 15) == j) || (ns > 1 && (int)((sp >> 4) & 15) == j) || (ns > 2 && (int)((sp >> 8) & 15) == j);
        const unsigned long long bal = __ballot(f);
        const int pos = base + __popcll(bal & ((1ull << lane) - 1ull));
        if (f) lists[j * 256 + pos] = (unsigned char)q;
        base += __popcll(bal);
      }
      if (lane == 0) cnt[j] = base;
    }
    __syncthreads();
    if (tid == 0) {
      int ni = 0;
#pragma unroll 1
      for (int g = 7; g >= 0; --g) items[ni++] = (16 << 8) | g;
      for (int j = 0; j < qblk; ++j) { const int ng = (cnt[j] + 31) >> 5; for (int g = 0; g < ng; ++g) items[ni++] = (j << 8) | g; }
      ctr[0] = ni; ctr[1] = 0;
    }
    __syncthreads();
    const int nitems = ctr[0];
    for (;;) {
      int it = 0;
      if (lane == 0) it = atomicAdd(&ctr[1], 1);
      it = __builtin_amdgcn_readfirstlane(it);
      if (it >= nitems) break;
      const int item = items[it];
      const int j = item >> 8, g = item & 255;
      const bool own = (j == 16);
      const int kb = own ? qblk : j;
      const int ntile = own ? (g + 1) : 8;
      int qi; bool valid;
      if (own) { qi = g * 32 + n; valid = true; }
      else { const int pos = g * 32 + n; valid = pos < cnt[j]; qi = lists[j * 256 + (valid ? pos : 0)]; }
      const bf16_t* kt0 = p.Km() + ((size_t)bh * (S / 32) + kb * 8) * 2048 + lane * 8;
      const bf16_t* vt0 = p.Vm() + ((size_t)bh * (S / 32) + kb * 8) * 2048 + lane * 8;
      f32x16 O0, O1;
#pragma unroll
      for (int r = 0; r < 16; ++r) { O0[r] = 0.f; O1[r] = 0.f; }
      float lsum = 0.f;
      const float nbq = -bq[qi];
      bf16x8 kf[3][4], vf[3][4];
#define MOBA_LOAD(KT_, BUF_) { _Pragma("unroll") for (int s = 0; s < 4; ++s) { kf[BUF_][s] = *(const bf16x8*)(kt0 + (size_t)(KT_) * 2048 + s * 512); vf[BUF_][s] = *(const bf16x8*)(vt0 + (size_t)(KT_) * 2048 + s * 512); } }
#define MOBA_STEP(KT_, BUF_)                                                                                                           \
      if ((KT_) < ntile) {                                                                                                               \
        if ((KT_) + 2 < ntile) MOBA_LOAD((KT_) + 2, ((BUF_) + 2) % 3)                                                                     \
        f32x16 X;                                                                                                                         \
        _Pragma("unroll") for (int r = 0; r < 16; ++r) X[r] = nbq;                                                                        \
        _Pragma("unroll") for (int s = 0; s < 4; ++s) X = __builtin_amdgcn_mfma_f32_32x32x16_bf16(kf[BUF_][s], *(const bf16x8*)(Qs + qi * 64 + (2 * s + hh) * 8), X, 0, 0, 0);     \
        const bool diag = own && ((KT_) == g);                                                                                            \
        unsigned pw[8];                                                                                                                   \
        _Pragma("unroll") for (int r = 0; r < 16; r += 2) {                                                                               \
          float e0 = __builtin_amdgcn_exp2f(X[r]), e1 = __builtin_amdgcn_exp2f(X[r + 1]);                                                 \
          if (diag) {                                                                                                                     \
            const int k0 = (r & 3) + 8 * (r >> 2) + 4 * hh, k1 = ((r + 1) & 3) + 8 * ((r + 1) >> 2) + 4 * hh;                             \
            e0 = (k0 <= n) ? e0 : 0.f; e1 = (k1 <= n) ? e1 : 0.f;                                                                         \
          }                                                                                                                               \
          lsum += e0 + e1;                                                                                                                \
          pw[r >> 1] = pk_bf16(e0, e1);                                                                                                   \
        }                                                                                                                                 \
        bf16x8 pf0, pf1;                                                                                                                  \
        { uint4 t0 = make_uint4(pw[0], pw[1], pw[2], pw[3]), t1 = make_uint4(pw[4], pw[5], pw[6], pw[7]);                                 \
          pf0 = *(bf16x8*)&t0; pf1 = *(bf16x8*)&t1; }                                                                                     \
        O0 = __builtin_amdgcn_mfma_f32_32x32x16_bf16(vf[BUF_][0], pf0, O0, 0, 0, 0);                                                      \
        O0 = __builtin_amdgcn_mfma_f32_32x32x16_bf16(vf[BUF_][1], pf1, O0, 0, 0, 0);                                                      \
        O1 = __builtin_amdgcn_mfma_f32_32x32x16_bf16(vf[BUF_][2], pf0, O1, 0, 0, 0);                                                      \
        O1 = __builtin_amdgcn_mfma_f32_32x32x16_bf16(vf[BUF_][3], pf1, O1, 0, 0, 0);                                                      \
      }
      MOBA_LOAD(0, 0)
      if (ntile > 1) MOBA_LOAD(1, 1)
#pragma unroll 1
      for (int kt3 = 0; kt3 < ntile; kt3 += 3) {
        MOBA_STEP(kt3, 0) MOBA_STEP(kt3 + 1, 1) MOBA_STEP(kt3 + 2, 2)
      }
#undef MOBA_STEP
#undef MOBA_LOAD
      lsum += __shfl_xor(lsum, 32);
      if (valid) {
        if (hh == 0) atomicAdd(&lacc[qi], __float2int_rn(lsum * 1048576.0f));
#pragma unroll
        for (int r = 0; r < 16; ++r) {
          const int dim = (r & 3) + 8 * (r >> 2) + 4 * hh;
          atomicAdd(&Oacc[dim * OLD + qi], __float2int_rn(O0[r] * 1048576.0f));
          atomicAdd(&Oacc[(dim + 32) * OLD + qi], __float2int_rn(O1[r] * 1048576.0f));
        }
      }
    }
    __syncthreads();
    { const int q = tid >> 1, half = tid & 1;
      const float inv = 1.0f / (float)lacc[q];
      float o[32], ss = 0.f;
#pragma unroll
      for (int d = 0; d < 32; ++d) { o[d] = (float)Oacc[(half * 32 + d) * OLD + q] * inv; ss += o[d] * o[d]; }
      ss += __shfl_xor(ss, 1);
      const float r = rsqrtf(ss / 64.0f + EPS);
      bf16_t* dst = p.xb() + (size_t)(b * S + qblk * 256 + q) * KD + 256 + h * 64 + half * 32;
#pragma unroll
      for (int d = 0; d < 32; d += 8) *(uint4*)(dst + d) = make_uint4(pk_bf16(o[d] * r, o[d + 1] * r), pk_bf16(o[d + 2] * r, o[d + 3] * r), pk_bf16(o[d + 4] * r, o[d + 5] * r), pk_bf16(o[d + 6] * r, o[d + 7] * r));
    }
  }
}


__device__ __forceinline__ void phase_ret_kv(const Params& p, int gw, int ngw, int lane) {
  const int n = lane & 31, hh = lane >> 5;
  for (int w = gw; w < NB * 4 * 32; w += ngw) {
    const int bh = w >> 5, cn = w & 31;
    const bf16_t* vt = p.Vr() + ((size_t)bh * (S / 32) + cn * 4) * 2048 + lane * 8;
    const bf16_t* kt = p.Krv() + ((size_t)bh * (S / 32) + cn * 4) * 2048 + lane * 8;
    f32x16 acc[2][2];
#pragma unroll
    for (int a = 0; a < 2; ++a)
#pragma unroll
      for (int b2 = 0; b2 < 2; ++b2)
#pragma unroll
        for (int r = 0; r < 16; ++r) acc[a][b2][r] = 0.f;
#pragma unroll 1
    for (int tl = 0; tl < 4; ++tl)
#pragma unroll
      for (int ks = 0; ks < 2; ++ks) {
        bf16x8 vf[2], kf[2];
#pragma unroll
        for (int x = 0; x < 2; ++x) { vf[x] = *(const bf16x8*)(vt + tl * 2048 + (x * 2 + ks) * 512); kf[x] = *(const bf16x8*)(kt + tl * 2048 + (x * 2 + ks) * 512); }
#pragma unroll
        for (int mb = 0; mb < 2; ++mb)
#pragma unroll
          for (int nb = 0; nb < 2; ++nb) acc[mb][nb] = __builtin_amdgcn_mfma_f32_32x32x16_bf16(vf[mb], kf[nb], acc[mb][nb], 0, 0, 0);
      }
    float* dst = p.KVr() + ((size_t)bh * 32 + cn) * 4096;
#pragma unroll
    for (int mb = 0; mb < 2; ++mb)
#pragma unroll
      for (int nb = 0; nb < 2; ++nb)
#pragma unroll
        for (int r = 0; r < 16; ++r) dst[(mb * 32 + (r & 3) + 8 * (r >> 2) + 4 * hh) * 64 + nb * 32 + n] = acc[mb][nb][r];
  }
}
__device__ __forceinline__ void phase_ret_scan(const Params& p, int gtid, int ngt) {
  for (int it = gtid; it < NB * 4 * 4096; it += ngt) {
    const int e = it & 4095, bh = it >> 12, h = bh & 3;
    const float l2g = ret_log2g(h), g1 = exp2f(l2g), g127 = exp2f(127.0f * l2g), g128 = exp2f(128.0f * l2g);
    float R = 0.f; float kv[32];
#pragma unroll
    for (int cn = 0; cn < 32; ++cn) kv[cn] = p.KVr()[((size_t)bh * 32 + cn) * 4096 + e];
#pragma unroll
    for (int cn = 0; cn < 32; ++cn) {
      p.Rb()[((size_t)bh * 32 + cn) * 4096 + e] = f2bf(g1 * R);
      R = g128 * R + g127 * kv[cn];
    }
  }
}
__device__ __forceinline__ void phase_ret_out(const Params& p, int gw, int ngw, int lane) {
  const int n = lane & 31, hh = lane >> 5;
  for (int w = gw; w < NB * 4 * 32 * 4; w += ngw) {
    const int qg = 3 - (w & 3), cn = (w >> 2) & 31, bh = w >> 7, b = bh >> 2, h = bh & 3;
    const int s0 = cn * 128 + qg * 32;
    bf16x8 qf[4];
#pragma unroll
    for (int s = 0; s < 4; ++s) qf[s] = *(const bf16x8*)(p.Qr() + ((size_t)bh * S + s0 + n) * 64 + (2 * s + hh) * 8);
    f32x16 O0, O1;
#pragma unroll
    for (int r = 0; r < 16; ++r) { O0[r] = 0.f; O1[r] = 0.f; }
    { const bf16_t* rb = p.Rb() + ((size_t)bh * 32 + cn) * 4096 + (size_t)n * 64 + hh * 8;
#pragma unroll
      for (int s = 0; s < 4; ++s) {
        const bf16x8 r0 = *(const bf16x8*)(rb + s * 16), r1 = *(const bf16x8*)(rb + 32 * 64 + s * 16);
        O0 = __builtin_amdgcn_mfma_f32_32x32x16_bf16(r0, qf[s], O0, 0, 0, 0);
        O1 = __builtin_amdgcn_mfma_f32_32x32x16_bf16(r1, qf[s], O1, 0, 0, 0);
      } }
    const bf16_t* kt0 = p.Kr() + ((size_t)bh * (S / 32) + cn * 4) * 2048 + lane * 8;
    const bf16_t* vt0 = p.Vr() + ((size_t)bh * (S / 32) + cn * 4) * 2048 + lane * 8;
    for (int kt = 0; kt <= qg; ++kt) {
      bf16x8 kf[4], vf[4];
#pragma unroll
      for (int s = 0; s < 4; ++s) { kf[s] = *(const bf16x8*)(kt0 + (size_t)kt * 2048 + s * 512); vf[s] = *(const bf16x8*)(vt0 + (size_t)kt * 2048 + s * 512); }
      f32x16 X;
#pragma unroll
      for (int r = 0; r < 16; ++r) X[r] = 0.f;
#pragma unroll
      for (int s = 0; s < 4; ++s) X = __builtin_amdgcn_mfma_f32_32x32x16_bf16(kf[s], qf[s], X, 0, 0, 0);
      const bool diag = (kt == qg);
      unsigned pw[8];
#pragma unroll
      for (int r = 0; r < 16; r += 2) {
        float e0 = X[r], e1 = X[r + 1];
        if (diag) {
          const int k0 = (r & 3) + 8 * (r >> 2) + 4 * hh, k1 = ((r + 1) & 3) + 8 * ((r + 1) >> 2) + 4 * hh;
          e0 = (k0 <= n) ? e0 : 0.f; e1 = (k1 <= n) ? e1 : 0.f;
        }
        pw[r >> 1] = pk_bf16(e0, e1);
      }
      bf16x8 pf0, pf1;
      { uint4 t0 = make_uint4(pw[0], pw[1], pw[2], pw[3]), t1 = make_uint4(pw[4], pw[5], pw[6], pw[7]);
        pf0 = *(bf16x8*)&t0; pf1 = *(bf16x8*)&t1; }
      O0 = __builtin_amdgcn_mfma_f32_32x32x16_bf16(vf[0], pf0, O0, 0, 0, 0);
      O0 = __builtin_amdgcn_mfma_f32_32x32x16_bf16(vf[1], pf1, O0, 0, 0, 0);
      O1 = __builtin_amdgcn_mfma_f32_32x32x16_bf16(vf[2], pf0, O1, 0, 0, 0);
      O1 = __builtin_amdgcn_mfma_f32_32x32x16_bf16(vf[3], pf1, O1, 0, 0, 0);
    }
    float ss = 0.f;
#pragma unroll
    for (int r = 0; r < 16; ++r) ss += O0[r] * O0[r] + O1[r] * O1[r];
    ss += __shfl_xor(ss, 32);
    const float rn = rsqrtf(ss / 64.0f + EPS);
    const size_t t = (size_t)b * S + s0 + n;
    const bf16_t* gp = p.grow() + t * 256 + h * 64;
    bf16_t* yo = p.xb() + t * KD + 768 + h * 64;
#pragma unroll
    for (int q4 = 0; q4 < 4; ++q4) {
#pragma unroll
      for (int mb = 0; mb < 2; ++mb) {
        const int d0 = mb * 32 + 8 * q4 + 4 * hh;
        const uint2 gw2 = *(const uint2*)(gp + d0); const float4 g = make_float4(__uint_as_float(gw2.x << 16), __uint_as_float(gw2.x & 0xffff0000u), __uint_as_float(gw2.y << 16), __uint_as_float(gw2.y & 0xffff0000u));
        float4 o;
        const f32x16& Oa = mb ? O1 : O0;
        o.x = Oa[q4 * 4 + 0] * rn * g.x * fast_sigmoid(g.x); o.y = Oa[q4 * 4 + 1] * rn * g.y * fast_sigmoid(g.y);
        o.z = Oa[q4 * 4 + 2] * rn * g.z * fast_sigmoid(g.z); o.w = Oa[q4 * 4 + 3] * rn * g.w * fast_sigmoid(g.w);
        *(uint2*)(yo + d0) = make_uint2(pk_bf16(o.x, o.y), pk_bf16(o.z, o.w));
      }
    }
  }
}

__device__ __forceinline__ void phase_post_pack(const Params& p, int gtid, int ngt) {
  for (int idx = gtid; idx < NB * 8 * (S / 32) * 256; idx += ngt) {
    const int ln = idx & 63, ks = (idx >> 6) & 1, mb = (idx >> 7) & 1, tile = (idx >> 8) % (S / 32), bh = idx / (256 * (S / 32));
    const int b = bh >> 3, h = bh & 7, hh = ln >> 5, delta = mb * 32 + (ln & 31);
    bf16_t v[8];
#pragma unroll
    for (int j = 0; j < 8; ++j) { const int kappa = 16 * ks + 8 * (j >> 2) + 4 * hh + (j & 3), s = tile * 32 + kappa; v[j] = p.vrow()[(size_t)(b * S + s) * 512 + h * 64 + delta]; }
    *(uint4*)(p.Vm() + (size_t)idx * 8) = make_uint4(v[0] | ((unsigned)v[1] << 16), v[2] | ((unsigned)v[3] << 16), v[4] | ((unsigned)v[5] << 16), v[6] | ((unsigned)v[7] << 16));
  }
  for (int idx = gtid; idx < 2 * NB * 4 * (S / 32) * 256; idx += ngt) {
    const int ln = idx & 63, ks = (idx >> 6) & 1, blk = (idx >> 7) & 1, tile = (idx >> 8) % (S / 32), rest = idx / (256 * (S / 32)), bh = rest % (NB * 4), which = rest / (NB * 4);
    const int b = bh >> 2, h = bh & 3, hh = ln >> 5, delta = blk * 32 + (ln & 31);
    const bf16_t* srcp = which ? p.krow() : p.vrrow();
    bf16_t v[8];
#pragma unroll
    for (int j = 0; j < 8; ++j) { const int kappa = 16 * ks + 8 * (j >> 2) + 4 * hh + (j & 3), s = tile * 32 + kappa; v[j] = srcp[(size_t)(b * S + s) * 256 + h * 64 + delta]; }
    *(uint4*)((which ? p.Krv() : p.Vr()) + ((size_t)(idx % (NB * 4 * (S / 32) * 256))) * 8) = make_uint4(v[0] | ((unsigned)v[1] << 16), v[2] | ((unsigned)v[3] << 16), v[4] | ((unsigned)v[5] << 16), v[6] | ((unsigned)v[7] << 16));
  }
}
__device__ __forceinline__ void phase_kmean2(const Params& p, int gtid, int ngt) {
  for (int idx = gtid; idx < NB * 8 * 16 * 64; idx += ngt) {
    const int d = idx & 63, j = (idx >> 6) & 15, bh = idx >> 10, c = d >> 3, dj = d & 7;
    float acc = 0.f;
    for (int tl = 0; tl < 8; ++tl) {
      const bf16_t* kp = p.Km() + (((size_t)bh * (S / 32) + j * 8 + tl) * 8 + c) * 256 + dj;
#pragma unroll 8
      for (int key = 0; key < 32; ++key) acc += bf2f(kp[key * 8]);
    }
    p.kmean()[idx] = acc * (1.0f / 256.0f);
  }
}

__device__ __forceinline__ void cvt_f32_bf16(const float* __restrict__ src, bf16_t* __restrict__ dst, size_t n8, int gtid, int ngt) {
  for (size_t i = gtid; i < n8; i += ngt) {
    float4 a = *(const float4*)(src + i * 8), b4 = *(const float4*)(src + i * 8 + 4);
    uint4 o; o.x = pk_bf16(a.x, a.y); o.y = pk_bf16(a.z, a.w); o.z = pk_bf16(b4.x, b4.y); o.w = pk_bf16(b4.z, b4.w);
    *(uint4*)(dst + i * 8) = o;
  }
}
__device__ __forceinline__ int f2key(float f) { int b = __float_as_int(f); return b ^ ((b >> 31) & 0x7fffffff); }
__device__ __forceinline__ float key2f(int k) { return __int_as_float(k ^ ((k >> 31) & 0x7fffffff)); }
#define CASD(a_, b_) { int mx_ = max(a_, b_), mn_ = min(a_, b_); a_ = mx_; b_ = mn_; }
__device__ __forceinline__ void sort16_desc(int (&v)[16]) {
#pragma unroll
  for (int k = 2; k <= 16; k <<= 1)
#pragma unroll
    for (int j = k >> 1; j > 0; j >>= 1)
#pragma unroll
      for (int i = 0; i < 16; ++i) { const int l2 = i ^ j; if (l2 > i) { if ((i & k) == 0) CASD(v[i], v[l2]) else CASD(v[l2], v[i]) } }
}
__device__ __forceinline__ void merge_top16(int (&a)[16], const int (&b)[16]) {
#pragma unroll
  for (int i = 0; i < 16; ++i) a[i] = max(a[i], b[15 - i]);
#pragma unroll
  for (int j = 8; j > 0; j >>= 1)
#pragma unroll
    for (int i = 0; i < 16; ++i) { const int l2 = i ^ j; if (l2 > i) CASD(a[i], a[l2]) }
}
__device__ __forceinline__ int lut4(int w0, int w1, int w2, int w3, int i) {
  const int w = i >> 2; const int d = (w == 0) ? w0 : (w == 1) ? w1 : (w == 2) ? w2 : w3;
  return (d >> ((i & 3) * 8)) & 127;
}

__device__ __forceinline__ void phase_peer_topk(const Params& p, int l, int gw, int ngw, int lane) {
  const int n = lane & 31, hh = lane >> 5;
  const bf16_t* skl = p.skb() + (size_t)l * 16 * 128 * 64;
  for (int w = gw; w < (T / 32) * 8; w += ngw) {
    const int tg = w >> 3, h = w & 7, t = tg * 32 + n;
    int L0[16], L1[16];
#pragma unroll
    for (int c = 0; c < 2; ++c) {
      const int hc = 2 * h + c;
      bf16x8 qf[4];
#pragma unroll
      for (int s = 0; s < 4; ++s) qf[s] = *(const bf16x8*)(p.qb() + (size_t)t * D + hc * 64 + 16 * s + 8 * hh);
      int A[16], Bq[16];
#pragma unroll
      for (int mb = 0; mb < 4; ++mb) {
        f32x16 X;
#pragma unroll
        for (int r = 0; r < 16; ++r) X[r] = 0.f;
#pragma unroll
        for (int s = 0; s < 4; ++s) {
          const bf16x8 kf = *(const bf16x8*)(skl + ((size_t)(hc * 128 + mb * 32 + n)) * 64 + 16 * s + 8 * hh);
          X = __builtin_amdgcn_mfma_f32_32x32x16_bf16(kf, qf[s], X, 0, 0, 0);
        }
        int Gk[16];
#pragma unroll
        for (int r = 0; r < 16; ++r) Gk[r] = (f2key(X[r]) & ~127) | (mb * 32 + (r & 3) + 8 * (r >> 2) + 4 * hh);
        sort16_desc(Gk);
        if (mb == 0) {
#pragma unroll
          for (int r = 0; r < 16; ++r) A[r] = Gk[r];
        } else merge_top16(A, Gk);
      }
#pragma unroll
      for (int r = 0; r < 16; ++r) Bq[r] = __shfl_xor(A[r], 32);
      merge_top16(A, Bq);
#pragma unroll
      for (int r = 0; r < 16; ++r) { if (c == 0) L0[r] = A[r]; else L1[r] = A[r]; }
    }
    float av[16], bv[16];
#pragma unroll
    for (int r = 0; r < 16; ++r) { av[r] = key2f(L0[r] & ~127); bv[r] = key2f(L1[r] & ~127); }
#define CAND(i_, j_) ((f2key(av[i_] + bv[j_]) & ~255) | ((i_) << 4) | (j_))
    int R[16], G1[16], G2[16];
#pragma unroll
    for (int j = 0; j < 16; ++j) R[j] = CAND(0, j);
    G1[0] = CAND(1, 0); G1[1] = CAND(1, 1); G1[2] = CAND(1, 2); G1[3] = CAND(1, 3); G1[4] = CAND(1, 4); G1[5] = CAND(1, 5); G1[6] = CAND(1, 6); G1[7] = CAND(1, 7);
    G1[8] = CAND(2, 0); G1[9] = CAND(2, 1); G1[10] = CAND(2, 2); G1[11] = CAND(2, 3); G1[12] = CAND(2, 4); G1[13] = CAND(3, 0); G1[14] = CAND(3, 1); G1[15] = CAND(3, 2);
    G2[0] = CAND(3, 3); G2[1] = CAND(4, 0); G2[2] = CAND(4, 1); G2[3] = CAND(4, 2); G2[4] = CAND(5, 0); G2[5] = CAND(5, 1); G2[6] = CAND(6, 0); G2[7] = CAND(6, 1);
    G2[8] = CAND(7, 0); G2[9] = CAND(7, 1); G2[10] = CAND(8, 0); G2[11] = CAND(9, 0); G2[12] = CAND(10, 0); G2[13] = CAND(11, 0); G2[14] = CAND(12, 0); G2[15] = CAND(13, 0);
    sort16_desc(G1); merge_top16(R, G1);
    sort16_desc(G2); merge_top16(R, G2);
    { int x0 = CAND(14, 0), x1 = CAND(15, 0);
#pragma unroll
      for (int i = 0; i < 16; ++i) CASD(R[i], x0)
#pragma unroll
      for (int i = 0; i < 16; ++i) CASD(R[i], x1)
    }
#undef CAND
    int pa0 = 0, pa1 = 0, pa2 = 0, pa3 = 0, pb0 = 0, pb1 = 0, pb2 = 0, pb3 = 0;
#pragma unroll
    for (int q = 0; q < 4; ++q) {
      pa0 |= (L0[q] & 127) << (8 * q); pa1 |= (L0[4 + q] & 127) << (8 * q); pa2 |= (L0[8 + q] & 127) << (8 * q); pa3 |= (L0[12 + q] & 127) << (8 * q);
      pb0 |= (L1[q] & 127) << (8 * q); pb1 |= (L1[4 + q] & 127) << (8 * q); pb2 |= (L1[8 + q] & 127) << (8 * q); pb3 |= (L1[12 + q] & 127) << (8 * q);
    }
    float ev[16], sum = 0.f; int ei[16];
    const float mx = key2f(R[0] & ~255);
#pragma unroll
    for (int z = 0; z < 16; ++z) {
      const float v = key2f(R[z] & ~255);
      ev[z] = __expf(v - mx); sum += ev[z];
      const int pay = R[z] & 255;
      ei[z] = lut4(pa0, pa1, pa2, pa3, pay >> 4) * 128 + lut4(pb0, pb1, pb2, pb3, pay & 15);
    }
    const float inv = 1.0f / sum;
    if (hh == 0) {
      float* go = p.gates() + ((size_t)t * 8 + h) * 16; int* eo = p.eidx() + ((size_t)t * 8 + h) * 16;
#pragma unroll
      for (int z = 0; z < 16; z += 4) {
        *(float4*)(go + z) = make_float4(ev[z] * inv, ev[z + 1] * inv, ev[z + 2] * inv, ev[z + 3] * inv);
        *(int4*)(eo + z) = make_int4(ei[z], ei[z + 1], ei[z + 2], ei[z + 3]);
      }
    }
  }
}


typedef int v8i __attribute__((ext_vector_type(8)));
__device__ __forceinline__ unsigned xcc_id() { return (unsigned)__builtin_amdgcn_s_getreg((3 << 11) | 20) & 7u; }
__device__ __forceinline__ float pow2_scale(float amax) {
  if (!(amax > 0.f)) return 1.0f;
  const int e = (int)floorf(log2f(240.0f / amax));
  return exp2f((float)(e < 60 ? (e > -60 ? e : -60) : 60));
}
__device__ __forceinline__ unsigned pack4_fp8(float a, float b, float c, float d) {
  int v = __builtin_amdgcn_cvt_pk_fp8_f32(a, b, 0, false);
  v = __builtin_amdgcn_cvt_pk_fp8_f32(c, d, v, true);
  return (unsigned)v;
}
__device__ __forceinline__ void cvt_table_i8(const float* __restrict__ src, unsigned char* __restrict__ dst, float* __restrict__ scl, int gw, int ngw, int lane) {
  for (int e0 = gw; e0 < 16384; e0 += 2 * ngw) {
    float4 v[2][4];
#pragma unroll
    for (int u = 0; u < 2; ++u) { const int e = (e0 + u * ngw < 16384) ? e0 + u * ngw : e0;
#pragma unroll
      for (int k = 0; k < 4; ++k) v[u][k] = *(const float4*)(src + (size_t)e * D + k * 256 + lane * 4); }
#pragma unroll
    for (int u = 0; u < 2; ++u) {
      const int e = e0 + u * ngw;
      if (e < 16384) {
        float am = 0.f;
#pragma unroll
        for (int k = 0; k < 4; ++k) am = fmaxf(am, fmaxf(fmaxf(fabsf(v[u][k].x), fabsf(v[u][k].y)), fmaxf(fabsf(v[u][k].z), fabsf(v[u][k].w))));
        am = wave_max(am);
        const float s = am > 0.f ? 127.0f / am : 1.0f;
        if (lane == 0) scl[e] = s;
#pragma unroll
        for (int k = 0; k < 4; ++k) {
          const int slice = 2 * k + (lane >> 5), off = (lane & 31) * 4;
          const unsigned w = (unsigned)(__float2int_rn(v[u][k].x * s) & 255) | ((unsigned)(__float2int_rn(v[u][k].y * s) & 255) << 8) |
                             ((unsigned)(__float2int_rn(v[u][k].z * s) & 255) << 16) | ((unsigned)(__float2int_rn(v[u][k].w * s) & 255) << 24);
          *(unsigned*)(dst + ((size_t)slice * 16384 + e) * 128 + off) = w;
        }
      }
    }
  }
}
__device__ __forceinline__ void cvt_table_fp8(const float* __restrict__ src, unsigned char* __restrict__ dst, float* __restrict__ scl, int gw, int ngw, int lane) {
  for (int e0 = gw; e0 < 16384; e0 += 2 * ngw) {
    float4 v[2][4];
#pragma unroll
    for (int u = 0; u < 2; ++u) { const int e = (e0 + u * ngw < 16384) ? e0 + u * ngw : e0;
#pragma unroll
      for (int k = 0; k < 4; ++k) v[u][k] = *(const float4*)(src + (size_t)e * D + k * 256 + lane * 4); }
#pragma unroll
    for (int u = 0; u < 2; ++u) {
      const int e = e0 + u * ngw;
      if (e < 16384) {
        float am = 0.f;
#pragma unroll
        for (int k = 0; k < 4; ++k) am = fmaxf(am, fmaxf(fmaxf(fabsf(v[u][k].x), fabsf(v[u][k].y)), fmaxf(fabsf(v[u][k].z), fabsf(v[u][k].w))));
        am = wave_max(am);
        const float s = pow2_scale(am);
        if (lane == 0) scl[e] = s;
#pragma unroll
        for (int k = 0; k < 4; ++k) {
          const int slice = 2 * k + (lane >> 5), off = (lane & 31) * 4;
          *(unsigned*)(dst + ((size_t)slice * 16384 + e) * 128 + off) = pack4_fp8(v[u][k].x * s, v[u][k].y * s, v[u][k].z * s, v[u][k].w * s);
        }
      }
    }
  }
}
#define DPP_ADD(v_, ctrl_) ((v_) + __builtin_bit_cast(float, __builtin_amdgcn_update_dpp(0, __builtin_bit_cast(int, (v_)), (ctrl_), 0xF, 0xF, true)))
__device__ __forceinline__ float sum_xor16(float x) { float a = x, b = x; asm volatile("v_nop\n\tv_nop\n\tv_permlane16_swap_b32 %0, %1" : "+v"(a), "+v"(b)); return a + b; }
__device__ __forceinline__ float sum_xor32(float x) { float a = x, b = x; asm volatile("v_nop\n\tv_nop\n\tv_permlane32_swap_b32 %0, %1" : "+v"(a), "+v"(b)); return a + b; }
constexpr int PEER_TILE = 128;
__device__ __forceinline__ void phase_peer_u(const Params& p, int* heads, unsigned char* lds, int tid) {
  const int lane = tid & 63, wv = tid >> 6, r8 = lane >> 3, c8 = lane & 7;
  int* bc = (int*)lds;
  int* eW = (int*)(lds + 1024 + wv * 12288);
  bf16_t* hW = (bf16_t*)(lds + 1024 + wv * 12288 + 8192);
  const int myx = (int)xcc_id();
  for (int pass = 0; pass < 8; ++pass) {
    const int s = (myx + pass) & 7;
    const unsigned char* Us = p.U8s() + (size_t)s * 16384 * 128 + c8 * 16;
    for (;;) {
      const int item = q_pull(heads + s, T / PEER_TILE, bc, tid);
      if (item < 0) break;
      const int t0 = item * PEER_TILE + wv * 16;
      LDS_FENCE();
      { uint2 ev[16];
        const bf16_t* hsrc = p.hb() + ((size_t)s * T + t0) * 128 + lane * 8;
#pragma unroll
        for (int k = 0; k < 16; ++k) ev[k] = *(const uint2*)(p.eidx() + (size_t)(t0 + k) * 128 + lane * 2);
        const uint4 hq0 = *(const uint4*)(hsrc), hq1 = *(const uint4*)(hsrc + 512), hq2 = *(const uint4*)(hsrc + 1024), hq3 = *(const uint4*)(hsrc + 1536);
#pragma unroll
        for (int k = 0; k < 16; ++k) *(uint2*)(eW + k * 128 + lane * 2) = ev[k];
        *(uint4*)(hW + lane * 8) = hq0; *(uint4*)(hW + 512 + lane * 8) = hq1; *(uint4*)(hW + 1024 + lane * 8) = hq2; *(uint4*)(hW + 1536 + lane * 8) = hq3; }
      LDS_FENCE();
      uint4 R[4][8];
#define PEER_U_LOAD(M_, BUF_) { _Pragma("unroll") for (int eb = 0; eb < 8; ++eb) R[BUF_][eb] = *(const uint4*)(Us + (size_t)eW[(M_) * 64 + eb * 8 + r8] * 128); }
      PEER_U_LOAD(0, 0) PEER_U_LOAD(1, 1) PEER_U_LOAD(2, 2)
      int hq[4]; float hinv = 0.f; float res0 = 0.f, res1 = 0.f;
#define PEER_U_LOADH(TOK_) { const bf16_t* hp = hW + (TOK_) * 128 + c8 * 16; const uint4 a = *(const uint4*)hp, b4 = *(const uint4*)(hp + 8); \
        const unsigned w8[8] = {a.x, a.y, a.z, a.w, b4.x, b4.y, b4.z, b4.w}; float hv[16]; float am = 0.f;                               \
        _Pragma("unroll") for (int z = 0; z < 8; ++z) { hv[2 * z] = __uint_as_float(w8[z] << 16); hv[2 * z + 1] = __uint_as_float(w8[z] & 0xffff0000u); \
          am = fmaxf(am, fmaxf(fabsf(hv[2 * z]), fabsf(hv[2 * z + 1]))); }                                                                \
        am = fmaxf(am, __builtin_bit_cast(float, __builtin_amdgcn_update_dpp(0, __builtin_bit_cast(int, am), 0xB1, 0xF, 0xF, true)));     \
        am = fmaxf(am, __builtin_bit_cast(float, __builtin_amdgcn_update_dpp(0, __builtin_bit_cast(int, am), 0x4E, 0xF, 0xF, true)));     \
        am = fmaxf(am, __builtin_bit_cast(float, __builtin_amdgcn_update_dpp(0, __builtin_bit_cast(int, am), 0x141, 0xF, 0xF, true)));    \
        const float hs = am > 0.f ? 127.0f / am : 1.0f; hinv = am > 0.f ? am * (1.0f / 127.0f) : 1.0f;                                    \
        _Pragma("unroll") for (int z = 0; z < 4; ++z) hq[z] = (__float2int_rn(hv[4 * z] * hs) & 255) | ((__float2int_rn(hv[4 * z + 1] * hs) & 255) << 8) | \
                                                               ((__float2int_rn(hv[4 * z + 2] * hs) & 255) << 16) | (__float2int_rn(hv[4 * z + 3] * hs) << 24); }
      PEER_U_LOADH(0)
#define PEER_U_HALF(M_, BUF_, HALF_)                                                                           \
      {                                                                                                                                   \
        if ((M_) + 3 < 32) PEER_U_LOAD((M_) + 3, ((BUF_) + 3) & 3)                                                                        \
        _Pragma("unroll") for (int eb = 0; eb < 8; ++eb) {                                                                                \
          int di = __builtin_amdgcn_sdot4((int)R[BUF_][eb].x, hq[0], 0, false);                                                           \
          di = __builtin_amdgcn_sdot4((int)R[BUF_][eb].y, hq[1], di, false);                                                              \
          di = __builtin_amdgcn_sdot4((int)R[BUF_][eb].z, hq[2], di, false);                                                              \
          di = __builtin_amdgcn_sdot4((int)R[BUF_][eb].w, hq[3], di, false);                                                              \
          di += __builtin_amdgcn_update_dpp(0, di, 0xB1, 0xF, 0xF, true); di += __builtin_amdgcn_update_dpp(0, di, 0x4E, 0xF, 0xF, true);   \
          di += __builtin_amdgcn_update_dpp(0, di, 0x141, 0xF, 0xF, true);     \
          const float d = (float)di * hinv;                                                                                               \
          if ((HALF_) == 0) { if (c8 == eb) res0 = d; } else { if (c8 == eb) res1 = d; }                                                  \
        }                                                                                                                                 \
        if ((HALF_) == 1) {                                                                                                               \
          float* po = p.ppart() + ((size_t)s * T + t0 + ((M_) >> 1)) * 128;                                                               \
          po[c8 * 8 + r8] = res0; po[64 + c8 * 8 + r8] = res1;                                                                            \
          if ((M_) + 1 < 32) PEER_U_LOADH(((M_) >> 1) + 1)                                                                                \
        }                                                                                                                                 \
      }
#pragma unroll
      for (int m4 = 0; m4 < 32; m4 += 4) {
        PEER_U_HALF(m4, 0, 0) PEER_U_HALF(m4 + 1, 1, 1) PEER_U_HALF(m4 + 2, 2, 0) PEER_U_HALF(m4 + 3, 3, 1)
      }
#undef PEER_U_HALF
#undef PEER_U_LOADH
#undef PEER_U_LOAD
    }
  }
}
__device__ __forceinline__ void phase_peer_r(const Params& p, int gtid, int ngt) {
  for (int idx0 = gtid; idx0 < T * 128; idx0 += 4 * ngt) {
    float d[4]; int e[4]; float su_[4], sv_[4], g_[4]; bool ok[4];
#pragma unroll
    for (int u = 0; u < 4; ++u) { const int idx = idx0 + u * ngt; ok[u] = idx < T * 128; const int ix = ok[u] ? idx : 0;
      e[u] = p.eidx()[ix]; g_[u] = p.gates()[ix]; float a = 0.f;
#pragma unroll
      for (int s = 0; s < 8; ++s) a += p.ppart()[(size_t)s * T * 128 + ix];
      d[u] = a; }
#pragma unroll
    for (int u = 0; u < 4; ++u) { su_[u] = p.su()[e[u]]; sv_[u] = p.sv()[e[u]]; }
#pragma unroll
    for (int u = 0; u < 4; ++u) if (ok[u]) p.gates()[idx0 + u * ngt] = g_[u] * gelu_tanh(d[u] * p.rstd()[(idx0 + u * ngt) >> 7] / su_[u]) / sv_[u];
  }
}
__device__ __forceinline__ void phase_peer_v(const Params& p, int* heads, unsigned char* lds, int tid) {
  const int lane = tid & 63, wv = tid >> 6, r8 = lane >> 3, c8 = lane & 7;
  int* bc = (int*)lds;
  uint2* pW = (uint2*)(lds + 1024 + wv * 16384);
  const int myx = (int)xcc_id();
  for (int pass = 0; pass < 8; ++pass) {
    const int s = (myx + pass) & 7;
    const unsigned char* Vs = p.V8s() + (size_t)s * 16384 * 128 + c8 * 16;
    for (;;) {
      const int item = q_pull(heads + s, T / PEER_TILE, bc, tid);
      if (item < 0) break;
      const int t0 = item * PEER_TILE + wv * 16;
      LDS_FENCE();
      { uint2 e2[16], g2[16];
#pragma unroll
        for (int k = 0; k < 16; ++k) { e2[k] = *(const uint2*)(p.eidx() + (size_t)(t0 + k) * 128 + lane * 2); g2[k] = *(const uint2*)(p.gates() + (size_t)(t0 + k) * 128 + lane * 2); }
#pragma unroll
        for (int k = 0; k < 16; ++k) *(uint4*)(pW + k * 128 + lane * 2) = make_uint4(e2[k].x, g2[k].x, e2[k].y, g2[k].y); }
      LDS_FENCE();
      const int rowk = lane >> 4, prow = ((rowk & 1) << 1) | (rowk >> 1);
      const bool wr_lane = (lane & 8) == 0;
      const int xoff = s * 128 + c8 * 16 + prow * 4;
      float4 xo[8];
#pragma unroll
      for (int k = 0; k < 8; ++k) xo[k] = *(const float4*)(p.outp() + (size_t)(t0 + k) * D + xoff);
      uint4 R[3][8];
#define PEER_V_LOAD(M_, BUF_) { _Pragma("unroll") for (int eb = 0; eb < 8; ++eb) R[BUF_][eb] = *(const uint4*)(Vs + (size_t)pW[(M_) * 64 + eb * 8 + r8].x * 128); }
      PEER_V_LOAD(0, 0) PEER_V_LOAD(1, 1)
      float acc[16];
#define PEER_V_HALF(M_, BUF_, HALF_)                                                           \
      {                                                                                                                                   \
        if ((M_) + 2 < 32) PEER_V_LOAD((M_) + 2, ((BUF_) + 2) % 3)                                                                        \
        if ((HALF_) == 0) { _Pragma("unroll") for (int z = 0; z < 16; ++z) acc[z] = 0.f; }                                                \
        _Pragma("unroll") for (int eb = 0; eb < 8; ++eb) {                                                                                \
          const float c = __uint_as_float(pW[(M_) * 64 + eb * 8 + r8].y);                                                                 \
          const unsigned ww[4] = {R[BUF_][eb].x, R[BUF_][eb].y, R[BUF_][eb].z, R[BUF_][eb].w};                                            \
          _Pragma("unroll") for (int q4 = 0; q4 < 4; ++q4) {                                                                              \
            const auto f01 = __builtin_amdgcn_cvt_pk_f32_fp8((int)ww[q4], false); const auto f23 = __builtin_amdgcn_cvt_pk_f32_fp8((int)ww[q4], true); \
            acc[q4 * 4 + 0] = fmaf(c, f01[0], acc[q4 * 4 + 0]); acc[q4 * 4 + 1] = fmaf(c, f01[1], acc[q4 * 4 + 1]);                       \
            acc[q4 * 4 + 2] = fmaf(c, f23[0], acc[q4 * 4 + 2]); acc[q4 * 4 + 3] = fmaf(c, f23[1], acc[q4 * 4 + 3]);                       \
          }                                                                                                                               \
        }                                                                                                                                 \
        if ((HALF_) == 1) {                                                                                                               \
          _Pragma("unroll") for (int z = 0; z < 16; ++z) acc[z] = DPP_ADD(acc[z], 0x128);                                  \
          asm volatile("v_nop\n\tv_nop\n\tv_permlane16_swap_b32 %0, %8\n\tv_permlane16_swap_b32 %1, %9\n\tv_permlane16_swap_b32 %2, %10\n\tv_permlane16_swap_b32 %3, %11\n\t" \
                       "v_permlane16_swap_b32 %4, %12\n\tv_permlane16_swap_b32 %5, %13\n\tv_permlane16_swap_b32 %6, %14\n\tv_permlane16_swap_b32 %7, %15" \
            : "+v"(acc[0]), "+v"(acc[1]), "+v"(acc[2]), "+v"(acc[3]), "+v"(acc[4]), "+v"(acc[5]), "+v"(acc[6]), "+v"(acc[7]),                   \
              "+v"(acc[8]), "+v"(acc[9]), "+v"(acc[10]), "+v"(acc[11]), "+v"(acc[12]), "+v"(acc[13]), "+v"(acc[14]), "+v"(acc[15]));               \
          _Pragma("unroll") for (int z = 0; z < 8; ++z) acc[z] += acc[z + 8];            \
          asm volatile("v_nop\n\tv_nop\n\tv_permlane32_swap_b32 %0, %4\n\tv_permlane32_swap_b32 %1, %5\n\tv_permlane32_swap_b32 %2, %6\n\tv_permlane32_swap_b32 %3, %7" \
            : "+v"(acc[0]), "+v"(acc[1]), "+v"(acc[2]), "+v"(acc[3]), "+v"(acc[4]), "+v"(acc[5]), "+v"(acc[6]), "+v"(acc[7]));                   \
          float4 dl;                                                                                                                      \
          dl.x = acc[0] + acc[4]; dl.y = acc[1] + acc[5]; dl.z = acc[2] + acc[6]; dl.w = acc[3] + acc[7];     \
          const float4 xv = xo[((M_) >> 1) & 7];                                                                                          \
          if (((M_) >> 1) + 8 < 16) xo[((M_) >> 1) & 7] = *(const float4*)(p.outp() + (size_t)(t0 + ((M_) >> 1) + 8) * D + xoff);                  \
          const float4 xn = make_float4(xv.x + dl.x, xv.y + dl.y, xv.z + dl.z, xv.w + dl.w);                                              \
          float sq = 0.f;                                                                                                                 \
          if (wr_lane) {                                                                                                                  \
            *(float4*)(p.outp() + (size_t)(t0 + ((M_) >> 1)) * D + xoff) = xn;                                                             \
            *(uint2*)(p.xb() + (size_t)(t0 + ((M_) >> 1)) * KD + xoff) = make_uint2(pk_bf16(xn.x, xn.y), pk_bf16(xn.z, xn.w));     \
            sq = (xn.x * xn.x + xn.y * xn.y) + (xn.z * xn.z + xn.w * xn.w);                                                                \
          }                                                                                                                               \
          sq = DPP_ADD(sq, 0xB1); sq = DPP_ADD(sq, 0x4E); sq = DPP_ADD(sq, 0x141); sq = DPP_ADD(sq, 0x128); sq = sum_xor16(sq); sq = sum_xor32(sq);     \
          if (lane == 0) p.ssq1()[(size_t)(t0 + ((M_) >> 1)) * 8 + s] = sq;                                                               \
        }                                                                                                                                 \
      }
#pragma unroll
      for (int m6 = 0; m6 < 30; m6 += 6) {
        PEER_V_HALF(m6, 0, 0) PEER_V_HALF(m6 + 1, 1, 1) PEER_V_HALF(m6 + 2, 2, 0) PEER_V_HALF(m6 + 3, 0, 1) PEER_V_HALF(m6 + 4, 1, 0) PEER_V_HALF(m6 + 5, 2, 1)
      }
      PEER_V_HALF(30, 0, 0) PEER_V_HALF(31, 1, 1)
#undef PEER_V_HALF
#undef PEER_V_LOAD
    }
  }
}

#if PEER_CHECK
constexpr int CHK_N = 512;
__device__ __forceinline__ float* chk_x(const Params& p) { return (float*)(p.ws + WO_ybuf); }
__device__ __forceinline__ float* chk_m(const Params& p) { return (float*)(p.ws + WO_ybuf + (size_t)CHK_N * D * 4); }
__device__ __forceinline__ float* chk_g(const Params& p) { return (float*)(p.ws + WO_ybuf + (size_t)CHK_N * D * 4 + 4096); }
__device__ __forceinline__ void chk_save(const Params& p, int gtid, int ngt) {
  for (int i = gtid; i < CHK_N * D; i += ngt) chk_x(p)[i] = p.outp()[(size_t)(i / D) * 64 * D + (i % D)];
  for (int i = gtid; i < CHK_N * 128; i += ngt) chk_g(p)[i] = p.gates()[(size_t)(i / 128) * 64 * 128 + (i % 128)];
  if (gtid < 16) chk_m(p)[gtid] = 0.f;
}
__device__ __forceinline__ void chk_apply(const Params& p, int l, float* coef, int gw, int ngw, int lane) {
  const float* g2 = p.inp(16) + l * D;
  const float* U = p.inp(19) + (size_t)l * 16384 * D; const float* V = p.inp(20) + (size_t)l * 16384 * D;
  for (int i = gw; i < CHK_N; i += ngw) {
    const int t = i * 64;
    const float r = p.rstd()[t];
    float4 hv[4];
#pragma unroll
    for (int k = 0; k < 4; ++k) {
      float4 xv = *(const float4*)(chk_x(p) + (size_t)i * D + (lane + k * 64) * 4);
      float4 gv = *(const float4*)(g2 + (lane + k * 64) * 4);
      hv[k].x = xv.x * r * gv.x; hv[k].y = xv.y * r * gv.y; hv[k].z = xv.z * r * gv.z; hv[k].w = xv.w * r * gv.w;
    }
    LDS_FENCE();
    for (int j = 0; j < 128; ++j) {
      const int e = p.eidx()[(size_t)t * 128 + j];
      const float4* up = (const float4*)(U + (size_t)e * D);
      float dsum = 0.f;
#pragma unroll
      for (int k = 0; k < 4; ++k) { float4 uv = up[lane + k * 64]; dsum += hv[k].x * uv.x + hv[k].y * uv.y + hv[k].z * uv.z + hv[k].w * uv.w; }
      dsum = wave_sum(dsum);
      if (lane == 0) coef[j] = chk_g(p)[(size_t)i * 128 + j] * gelu_tanh(dsum);
    }
    LDS_FENCE();
    float4 acc[4];
#pragma unroll
    for (int k = 0; k < 4; ++k) acc[k] = make_float4(0.f, 0.f, 0.f, 0.f);
    for (int j = 0; j < 128; ++j) {
      const int e = p.eidx()[(size_t)t * 128 + j];
      const float c = coef[j];
      const float4* vp = (const float4*)(V + (size_t)e * D);
#pragma unroll
      for (int k = 0; k < 4; ++k) { float4 vv = vp[lane + k * 64]; acc[k].x = fmaf(c, vv.x, acc[k].x); acc[k].y = fmaf(c, vv.y, acc[k].y); acc[k].z = fmaf(c, vv.z, acc[k].z); acc[k].w = fmaf(c, vv.w, acc[k].w); }
    }
    float d2 = 0.f, r2 = 0.f;
#pragma unroll
    for (int k = 0; k < 4; ++k) {
      float4 xa = *(const float4*)(p.outp() + (size_t)t * D + (lane + k * 64) * 4);
      float4 xb4 = *(const float4*)(chk_x(p) + (size_t)i * D + (lane + k * 64) * 4);
      float e0 = (xa.x - xb4.x) - acc[k].x, e1 = (xa.y - xb4.y) - acc[k].y, e2 = (xa.z - xb4.z) - acc[k].z, e3 = (xa.w - xb4.w) - acc[k].w;
      d2 += e0 * e0 + e1 * e1 + e2 * e2 + e3 * e3;
      r2 += acc[k].x * acc[k].x + acc[k].y * acc[k].y + acc[k].z * acc[k].z + acc[k].w * acc[k].w;
    }
    d2 = wave_sum(d2); r2 = wave_sum(r2);
    if (lane == 0) { atomicAdd((unsigned long long*)&chk_m(p)[8], (unsigned long long)(d2 * 1099511627776.0f)); atomicAdd((unsigned long long*)&chk_m(p)[10], (unsigned long long)(r2 * 1099511627776.0f)); }
  }
}
__device__ __forceinline__ void chk_topk(const Params& p, int l, int gtid, int ngt) {
  const float* subk = p.inp(18) + (size_t)l * 16 * 128 * 64;
  for (int it = gtid; it < CHK_N * 8; it += ngt) {
    const int i = it >> 3, h = it & 7, t = i * 64;
    float tva[16], tvb[16]; int tia[16], tib[16];
#pragma unroll 1
    for (int c = 0; c < 2; ++c) {
      float tv[16]; int ti[16];
#pragma unroll
      for (int z = 0; z < 16; ++z) { tv[z] = -INFINITY; ti[z] = 0; }
      const bf16_t* q = p.qb() + (size_t)t * D + (2 * h + c) * 64;
      const float* kb = subk + (size_t)(2 * h + c) * 128 * 64;
#pragma unroll 1
      for (int n = 0; n < 128; ++n) {
        float sc = 0.f;
        for (int d = 0; d < 64; ++d) sc = fmaf(bf2f(q[d]), kb[n * 64 + d], sc);
        float v_ = sc; int i_ = n;
#pragma unroll
        for (int z = 0; z < 16; ++z) { bool gt = v_ > tv[z]; float a = tv[z]; int b = ti[z]; tv[z] = gt ? v_ : a; ti[z] = gt ? i_ : b; v_ = gt ? a : v_; i_ = gt ? b : i_; }
      }
#pragma unroll
      for (int z = 0; z < 16; ++z) { if (c == 0) { tva[z] = tv[z]; tia[z] = ti[z]; } else { tvb[z] = tv[z]; tib[z] = ti[z]; } }
    }
    float tv[16]; int ti[16];
#pragma unroll
    for (int z = 0; z < 16; ++z) { tv[z] = -INFINITY; ti[z] = 0; }
#pragma unroll 1
    for (int a = 0; a < 16; ++a)
#pragma unroll 1
      for (int b = 0; b < 16; ++b) {
        float av = 0.f, bv = 0.f; int ai = 0, bi = 0;
#pragma unroll
        for (int z = 0; z < 16; ++z) { if (z == a) { av = tva[z]; ai = tia[z]; } if (z == b) { bv = tvb[z]; bi = tib[z]; } }
        float v_ = av + bv; int i_ = ai * 128 + bi;
#pragma unroll
        for (int z = 0; z < 16; ++z) { bool gt = v_ > tv[z]; float x = tv[z]; int y = ti[z]; tv[z] = gt ? v_ : x; ti[z] = gt ? i_ : y; v_ = gt ? x : v_; i_ = gt ? y : i_; }
      }
    float sum = 0.f, ev[16];
#pragma unroll
    for (int z = 0; z < 16; ++z) { ev[z] = expf(tv[z] - tv[0]); sum += ev[z]; }
    int miss = 0; float gerr = 0.f;
    for (int z = 0; z < 16; ++z) {
      const int ef = p.eidx()[((size_t)t * 8 + h) * 16 + z]; const float gf = p.gates()[((size_t)t * 8 + h) * 16 + z];
      bool found = false;
#pragma unroll
      for (int y = 0; y < 16; ++y) if (ti[y] == ef) { found = true; gerr = fmaxf(gerr, fabsf(ev[y] / sum - gf)); }
      if (!found) ++miss;
    }
    atomicAdd(&chk_m(p)[3], (float)miss);
    atomicMax((int*)&chk_m(p)[4], __float_as_int(gerr));
  }
}
__device__ __forceinline__ void chk_emit(const Params& p) {
  float v = 0.f;
  if (PEER_CHECK == 1) v = sqrtf((float)((double)*(unsigned long long*)&chk_m(p)[8] / (double)*(unsigned long long*)&chk_m(p)[10]));
  if (PEER_CHECK == 2) v = chk_m(p)[3] / (float)(CHK_N * 8 * 16);
  if (PEER_CHECK == 3) v = chk_m(p)[4];
  p.outp()[0] += 1.0e4f * v + 100.0f;
}
#endif

#define XB_TMO      128
#define XB_XCNT(j)  (256  + 64 * (j))
#define XB_XSUB(j)  (1280 + 64 * (j))
#define XB_XGEN(j)  (2304 + 64 * (j))
#define XB_TOP      3328
#define XB_TOPGEN   3392
#define XCD_BAR_WORDS 3456
#define XB_SPIN_CAP (1u << 18)
#define LAS __attribute__((address_space(3)))

__device__ __forceinline__ unsigned xb_ld(unsigned* p)              { return __hip_atomic_load(p, __ATOMIC_RELAXED, __HIP_MEMORY_SCOPE_AGENT); }
__device__ __forceinline__ unsigned xb_add(unsigned* p, unsigned v) { return __hip_atomic_fetch_add(p, v, __ATOMIC_RELAXED, __HIP_MEMORY_SCOPE_AGENT); }
__device__ __forceinline__ unsigned xb_xcc_id() { return (unsigned)__builtin_amdgcn_s_getreg((3 << 11) | 20) & 0xFu; }
#define XB_SPIN(cond, bar) do { unsigned _sp = 0; while (cond) { __builtin_amdgcn_s_sleep(1); \
    if ((++_sp & 255u) == 0u) { if (xb_ld(&(bar)[XB_TMO])) break; if (_sp > XB_SPIN_CAP) { atomicAdd(&(bar)[XB_TMO], 1u); break; } } } } while (0)

struct XcdBarrier {
    unsigned* bar; unsigned x;
    volatile LAS unsigned* st;
};

__device__ __forceinline__ XcdBarrier xcd_barrier_post(unsigned* bar, volatile LAS unsigned* st) {
    XcdBarrier b; b.bar = bar; b.x = xb_xcc_id(); b.st = st;
    if (threadIdx.x == 0) (void)xb_add(&bar[XB_XCNT(b.x)], 1u);
    return b;
}
__device__ __forceinline__ void xcd_barrier_complete(unsigned* bar, unsigned x, unsigned& nloc, unsigned& nx) {
    const unsigned G = gridDim.x * gridDim.y * gridDim.z;
    unsigned sum, cnt, mine, sp = 0u;
    for (;;) {
        sum = 0u; cnt = 0u; mine = 0u;
#pragma unroll
        for (unsigned j = 0; j < 16; ++j) { const unsigned c = xb_ld(&bar[XB_XCNT(j)]); sum += c; cnt += (c > 0u) ? 1u : 0u; mine = (j == x) ? c : mine; }
        if (sum == G) break;
        __builtin_amdgcn_s_sleep(1);
        if ((++sp & 255u) == 0u) { if (xb_ld(&bar[XB_TMO])) break; if (sp > XB_SPIN_CAP) { atomicAdd(&bar[XB_TMO], 1u); break; } }
    }
    nloc = mine > 0u ? mine : 1u; nx = cnt > 0u ? cnt : 1u;
}

__device__ __forceinline__ void xcd_barrier(const XcdBarrier& b) {
    asm volatile("s_waitcnt vmcnt(0)" ::: "memory");
    __syncthreads();
    if (threadIdx.x == 0) {
        unsigned* bar = b.bar;
        __builtin_amdgcn_s_waitcnt(0);
        unsigned nloc = b.st[0], nx = b.st[1];
        if (nloc == 0u) { xcd_barrier_complete(bar, b.x, nloc, nx); b.st[0] = nloc; b.st[1] = nx; }
        const unsigned old = xb_add(&bar[XB_XSUB(b.x)], 1u);
        const unsigned gen = old / nloc;
        if (old + 1u == (gen + 1u) * nloc) {
            __builtin_amdgcn_fence(__ATOMIC_RELEASE, "agent");
            asm volatile("s_waitcnt vmcnt(0)" ::: "memory");
            const unsigned og = xb_add(&bar[XB_TOP], 1u);
            const unsigned tg = og / nx;
            if (og + 1u == (tg + 1u) * nx) xb_add(&bar[XB_TOPGEN], 1u);
            else XB_SPIN(xb_ld(&bar[XB_TOPGEN]) == tg, bar);
            __builtin_amdgcn_fence(__ATOMIC_ACQUIRE, "agent");
            xb_add(&bar[XB_XGEN(b.x)], 1u);
            asm volatile("s_waitcnt vmcnt(0)" ::: "memory");
        } else {
            XB_SPIN(xb_ld(&bar[XB_XGEN(b.x)]) == gen, bar);
            __builtin_amdgcn_fence(__ATOMIC_ACQUIRE, "agent");
            asm volatile("s_waitcnt vmcnt(0)" ::: "memory");
        }
    }
    __syncthreads();
}

__device__ __forceinline__ Params fresh(const Params& p) {
  Params q = p;
  asm volatile("" : "+s"(q.ws), "+s"(q.out_));
#pragma unroll
  for (int i = 0; i < 21; ++i) asm volatile("" : "+s"(q.in[i]));
  return q;
}
#define PHASE_IDS int tid = threadIdx.x; asm volatile("" : "+v"(tid)); int bid = blockIdx.x; asm volatile("" : "+s"(bid)); int G = gridDim.x; asm volatile("" : "+s"(G)); \
  const int lane = tid & 63, wv = tid >> 6; const int ngt = G * NTHR, ngw = G * NWAVE; \
  const int gtid = bid * NTHR + tid, gw = bid * NWAVE + wv; (void)lane; (void)wv; (void)gtid; (void)gw; (void)ngt; (void)ngw; \
  const Params q = fresh(p);
__global__ void __launch_bounds__(NTHR) mega(Params p) {
  extern __shared__ __attribute__((aligned(16))) unsigned char lds_raw[];
  cg::grid_group grid = cg::this_grid();
  float* ldsf = (float*)lds_raw;
  if (threadIdx.x == 0) { *(uint4*)(lds_raw + LDS_BYTES - 16) = make_uint4(0u, 0u, 0u, 0u); }
  __syncthreads();
  XcdBarrier xb = xcd_barrier_post(p.bar(), (volatile LAS unsigned*)(lds_raw + LDS_BYTES - 16));

  { PHASE_IDS; phase_prologue(q, gtid, ngt, gw, ngw, lane); cvt_f32_bf16(q.inp(18), q.skb(), (size_t)NL * 16 * 128 * 64 / 8, gtid, ngt);
    for (size_t i = gtid; i < (size_t)16 * 128 * 512 / 8; i += ngt) { const size_t g = i / (128 * 512 / 8), r = i % (128 * 512 / 8); ((uint4*)q.S5Wz())[g * (256 * 512 / 8) + (128 * 512 / 8) + r] = make_uint4(0u, 0u, 0u, 0u); }
    if (gtid < 256) q.qctr()[gtid] = 0;
    phase_s5_prep(q, 0, gtid, ngt); }
  grid.sync();
  { constexpr int l = 0;
    DUP(5) {
    { const Params q = fresh(p);
      EpiInProj e{q.ssq1(), q.S5A(), q.Qm(), q.Km(), q.vrow(), q.Qr(), q.Kr(), q.krow(), q.vrrow(), q.grow(),
                  q.inp(12) + l * 64, q.inp(13) + l * 64, q.cosm(), q.sinm(), q.cosr(), q.sinr()};
      run_gemm(lds_raw, q.xb(), q.Win_t() + (size_t)l * INW * KD, T, INW, KD, e); }
    xcd_barrier(xb);
    }
    DUP(0) {
    { PHASE_IDS; phase_post_pack(q, gtid, ngt); }
    xcd_barrier(xb);
    }
    DUP(1) {
    { const Params q = fresh(p); EpiS5Z e{q.S5Z()};
      pg8::Gemm g{q.S5A(), q.S5Wz(), 16 * 1024, 16 * 256, 512, 640, 512}; pg8::GroupOrder So; So.init(16, 4, 1, (int)gridDim.x, (int)blockIdx.x);
      pg8::gemm_phase<EpiS5Z, pg8::GroupOrder, true, true>((PG8_LAS unsigned char*)lds_raw, g, So, e); }
    { PHASE_IDS; phase_kmean2(q, gtid, ngt); phase_ret_kv(q, gw, ngw, lane); }
    xcd_barrier(xb);
    }
    DUP(2) {
    { PHASE_IDS; phase_s5_scan(q, gtid, ngt); phase_ret_scan(q, gtid, ngt); }
    __syncthreads();
    { PHASE_IDS; phase_moba2(q, l, lds_raw, q.qctr() + 64 + l); }
    xcd_barrier(xb);
    }
    DUP(3) {
    { const Params q = fresh(p); EpiS5Y e{q.ygb(), q.S5A(), q.inp(10) + l * 256};
      pg8::Gemm g{q.S5A(), q.S5Wy(), 16 * 1024, 16 * 512, 640, 640, 640}; pg8::GroupOrder So; So.init(16, 4, 2, (int)gridDim.x, (int)blockIdx.x);
      pg8::gemm_phase<EpiS5Y, pg8::GroupOrder, true, true>((PG8_LAS unsigned char*)lds_raw, g, So, e); }
    __syncthreads();
    { PHASE_IDS; phase_ret_out(q, gw, ngw, lane); }
    xcd_barrier(xb);
    }
    DUP(4) {
    { const Params q = fresh(p); EpiGlu e{q.xb(), q.ygb(), (float*)(lds_raw + 131072)};
      run_gemm(lds_raw, q.ygb(), q.Wglu_t() + (size_t)l * 65536, T, 256, 256, e); }
    xcd_barrier(xb);
    }
    { PHASE_IDS; cvt_table_i8(q.inp(19) + (size_t)l * 16384 * D, q.U8s(), q.su(), gw, ngw, lane);
      cvt_table_fp8(q.inp(20) + (size_t)l * 16384 * D, q.V8s(), q.sv(), gw, ngw, lane); }
    __syncthreads();
    { const Params q = fresh(p); EpiResid e{q.outp(), D, q.xb2(), q.hb(), q.inp(16) + l * D, q.ssq2()};
      run_gemm(lds_raw, q.xb(), q.Wout_t() + (size_t)l * D * KD, T, D, KD, e); }
    xcd_barrier(xb);
    DUP(7) {
    { const Params q = fresh(p); EpiScaleStoreBf16 e{q.qb(), D, q.ssq2(), 16, q.rstd()};
      run_gemm(lds_raw, q.xb2(), q.Wq_t() + (size_t)l * D * KD, T, D, KD, e); }
    xcd_barrier(xb);
    }
    if (!(PROBE_SKIP & 2)) {
    DUP(8) {
    { PHASE_IDS; phase_peer_topk(q, l, gw, ngw, lane); }
    xcd_barrier(xb);
    }
    }
#if PEER_CHECK
    if (l == 0) { { PHASE_IDS; chk_save(q, gtid, ngt); } xcd_barrier(xb); { PHASE_IDS; chk_topk(q, l, gtid, ngt); } xcd_barrier(xb); }
#endif
    if (!(PROBE_SKIP & 1)) {
    { PHASE_IDS; phase_peer_u(q, q.qctr() + (l * 2 + 0) * 8, lds_raw, tid); }
    xcd_barrier(xb);
    { PHASE_IDS; phase_peer_r(q, gtid, ngt); if (l + 1 < NL) phase_s5_prep(q, l + 1, gtid, ngt); }
    xcd_barrier(xb);
    if (!(PROBE_SKIP & 32)) {
    { PHASE_IDS; phase_peer_v(q, q.qctr() + (l * 2 + 1) * 8, lds_raw, tid); }
    xcd_barrier(xb);
    }
    }
#if PEER_CHECK
    if (l == 0) { { PHASE_IDS; chk_apply(q, l, ldsf + wv * 128, gw, ngw, lane); } xcd_barrier(xb);
      if (blockIdx.x == 0 && threadIdx.x == 0) { const Params q = fresh(p); chk_emit(q); } xcd_barrier(xb); }
#endif
  }
  { constexpr int l = 1;
    DUP(5) {
    { const Params q = fresh(p);
      EpiInProj e{q.ssq1(), q.S5A(), q.Qm(), q.Km(), q.vrow(), q.Qr(), q.Kr(), q.krow(), q.vrrow(), q.grow(),
                  q.inp(12) + l * 64, q.inp(13) + l * 64, q.cosm(), q.sinm(), q.cosr(), q.sinr()};
      run_gemm(lds_raw, q.xb(), q.Win_t() + (size_t)l * INW * KD, T, INW, KD, e); }
    xcd_barrier(xb);
    }
    DUP(0) {
    { PHASE_IDS; phase_post_pack(q, gtid, ngt); }
    xcd_barrier(xb);
    }
    DUP(1) {
    { const Params q = fresh(p); EpiS5Z e{q.S5Z()};
      pg8::Gemm g{q.S5A(), q.S5Wz(), 16 * 1024, 16 * 256, 512, 640, 512}; pg8::GroupOrder So; So.init(16, 4, 1, (int)gridDim.x, (int)blockIdx.x);
      pg8::gemm_phase<EpiS5Z, pg8::GroupOrder, true, true>((PG8_LAS unsigned char*)lds_raw, g, So, e); }
    { PHASE_IDS; phase_kmean2(q, gtid, ngt); phase_ret_kv(q, gw, ngw, lane); }
    xcd_barrier(xb);
    }
    DUP(2) {
    { PHASE_IDS; phase_s5_scan(q, gtid, ngt); phase_ret_scan(q, gtid, ngt); }
    __syncthreads();
    { PHASE_IDS; phase_moba2(q, l, lds_raw, q.qctr() + 64 + l); }
    xcd_barrier(xb);
    }
    DUP(3) {
    { const Params q = fresh(p); EpiS5Y e{q.ygb(), q.S5A(), q.inp(10) + l * 256};
      pg8::Gemm g{q.S5A(), q.S5Wy(), 16 * 1024, 16 * 512, 640, 640, 640}; pg8::GroupOrder So; So.init(16, 4, 2, (int)gridDim.x, (int)blockIdx.x);
      pg8::gemm_phase<EpiS5Y, pg8::GroupOrder, true, true>((PG8_LAS unsigned char*)lds_raw, g, So, e); }
    __syncthreads();
    { PHASE_IDS; phase_ret_out(q, gw, ngw, lane); }
    xcd_barrier(xb);
    }
    DUP(4) {
    { const Params q = fresh(p); EpiGlu e{q.xb(), q.ygb(), (float*)(lds_raw + 131072)};
      run_gemm(lds_raw, q.ygb(), q.Wglu_t() + (size_t)l * 65536, T, 256, 256, e); }
    xcd_barrier(xb);
    }
    { PHASE_IDS; cvt_table_i8(q.inp(19) + (size_t)l * 16384 * D, q.U8s(), q.su(), gw, ngw, lane);
      cvt_table_fp8(q.inp(20) + (size_t)l * 16384 * D, q.V8s(), q.sv(), gw, ngw, lane); }
    __syncthreads();
    { const Params q = fresh(p); EpiResid e{q.outp(), D, q.xb2(), q.hb(), q.inp(16) + l * D, q.ssq2()};
      run_gemm(lds_raw, q.xb(), q.Wout_t() + (size_t)l * D * KD, T, D, KD, e); }
    xcd_barrier(xb);
    DUP(7) {
    { const Params q = fresh(p); EpiScaleStoreBf16 e{q.qb(), D, q.ssq2(), 16, q.rstd()};
      run_gemm(lds_raw, q.xb2(), q.Wq_t() + (size_t)l * D * KD, T, D, KD, e); }
    xcd_barrier(xb);
    }
    if (!(PROBE_SKIP & 2)) {
    DUP(8) {
    { PHASE_IDS; phase_peer_topk(q, l, gw, ngw, lane); }
    xcd_barrier(xb);
    }
    }
#if PEER_CHECK
    if (l == 0) { { PHASE_IDS; chk_save(q, gtid, ngt); } xcd_barrier(xb); { PHASE_IDS; chk_topk(q, l, gtid, ngt); } xcd_barrier(xb); }
#endif
    if (!(PROBE_SKIP & 1)) {
    { PHASE_IDS; phase_peer_u(q, q.qctr() + (l * 2 + 0) * 8, lds_raw, tid); }
    xcd_barrier(xb);
    { PHASE_IDS; phase_peer_r(q, gtid, ngt); if (l + 1 < NL) phase_s5_prep(q, l + 1, gtid, ngt); }
    xcd_barrier(xb);
    if (!(PROBE_SKIP & 32)) {
    { PHASE_IDS; phase_peer_v(q, q.qctr() + (l * 2 + 1) * 8, lds_raw, tid); }
    xcd_barrier(xb);
    }
    }
#if PEER_CHECK
    if (l == 0) { { PHASE_IDS; chk_apply(q, l, ldsf + wv * 128, gw, ngw, lane); } xcd_barrier(xb);
      if (blockIdx.x == 0 && threadIdx.x == 0) { const Params q = fresh(p); chk_emit(q); } xcd_barrier(xb); }
#endif
  }
  { constexpr int l = 2;
    DUP(5) {
    { const Params q = fresh(p);
      EpiInProj e{q.ssq1(), q.S5A(), q.Qm(), q.Km(), q.vrow(), q.Qr(), q.Kr(), q.krow(), q.vrrow(), q.grow(),
                  q.inp(12) + l * 64, q.inp(13) + l * 64, q.cosm(), q.sinm(), q.cosr(), q.sinr()};
      run_gemm(lds_raw, q.xb(), q.Win_t() + (size_t)l * INW * KD, T, INW, KD, e); }
    xcd_barrier(xb);
    }
    DUP(0) {
    { PHASE_IDS; phase_post_pack(q, gtid, ngt); }
    xcd_barrier(xb);
    }
    DUP(1) {
    { const Params q = fresh(p); EpiS5Z e{q.S5Z()};
      pg8::Gemm g{q.S5A(), q.S5Wz(), 16 * 1024, 16 * 256, 512, 640, 512}; pg8::GroupOrder So; So.init(16, 4, 1, (int)gridDim.x, (int)blockIdx.x);
      pg8::gemm_phase<EpiS5Z, pg8::GroupOrder, true, true>((PG8_LAS unsigned char*)lds_raw, g, So, e); }
    { PHASE_IDS; phase_kmean2(q, gtid, ngt); phase_ret_kv(q, gw, ngw, lane); }
    xcd_barrier(xb);
    }
    DUP(2) {
    { PHASE_IDS; phase_s5_scan(q, gtid, ngt); phase_ret_scan(q, gtid, ngt); }
    __syncthreads();
    { PHASE_IDS; phase_moba2(q, l, lds_raw, q.qctr() + 64 + l); }
    xcd_barrier(xb);
    }
    DUP(3) {
    { const Params q = fresh(p); EpiS5Y e{q.ygb(), q.S5A(), q.inp(10) + l * 256};
      pg8::Gemm g{q.S5A(), q.S5Wy(), 16 * 1024, 16 * 512, 640, 640, 640}; pg8::GroupOrder So; So.init(16, 4, 2, (int)gridDim.x, (int)blockIdx.x);
      pg8::gemm_phase<EpiS5Y, pg8::GroupOrder, true, true>((PG8_LAS unsigned char*)lds_raw, g, So, e); }
    __syncthreads();
    { PHASE_IDS; phase_ret_out(q, gw, ngw, lane); }
    xcd_barrier(xb);
    }
    DUP(4) {
    { const Params q = fresh(p); EpiGlu e{q.xb(), q.ygb(), (float*)(lds_raw + 131072)};
      run_gemm(lds_raw, q.ygb(), q.Wglu_t() + (size_t)l * 65536, T, 256, 256, e); }
    xcd_barrier(xb);
    }
    { PHASE_IDS; cvt_table_i8(q.inp(19) + (size_t)l * 16384 * D, q.U8s(), q.su(), gw, ngw, lane);
      cvt_table_fp8(q.inp(20) + (size_t)l * 16384 * D, q.V8s(), q.sv(), gw, ngw, lane); }
    __syncthreads();
    { const Params q = fresh(p); EpiResid e{q.outp(), D, q.xb2(), q.hb(), q.inp(16) + l * D, q.ssq2()};
      run_gemm(lds_raw, q.xb(), q.Wout_t() + (size_t)l * D * KD, T, D, KD, e); }
    xcd_barrier(xb);
    DUP(7) {
    { const Params q = fresh(p); EpiScaleStoreBf16 e{q.qb(), D, q.ssq2(), 16, q.rstd()};
      run_gemm(lds_raw, q.xb2(), q.Wq_t() + (size_t)l * D * KD, T, D, KD, e); }
    xcd_barrier(xb);
    }
    if (!(PROBE_SKIP & 2)) {
    DUP(8) {
    { PHASE_IDS; phase_peer_topk(q, l, gw, ngw, lane); }
    xcd_barrier(xb);
    }
    }
#if PEER_CHECK
    if (l == 0) { { PHASE_IDS; chk_save(q, gtid, ngt); } xcd_barrier(xb); { PHASE_IDS; chk_topk(q, l, gtid, ngt); } xcd_barrier(xb); }
#endif
    if (!(PROBE_SKIP & 1)) {
    { PHASE_IDS; phase_peer_u(q, q.qctr() + (l * 2 + 0) * 8, lds_raw, tid); }
    xcd_barrier(xb);
    { PHASE_IDS; phase_peer_r(q, gtid, ngt); if (l + 1 < NL) phase_s5_prep(q, l + 1, gtid, ngt); }
    xcd_barrier(xb);
    if (!(PROBE_SKIP & 32)) {
    { PHASE_IDS; phase_peer_v(q, q.qctr() + (l * 2 + 1) * 8, lds_raw, tid); }
    xcd_barrier(xb);
    }
    }
#if PEER_CHECK
    if (l == 0) { { PHASE_IDS; chk_apply(q, l, ldsf + wv * 128, gw, ngw, lane); } xcd_barrier(xb);
      if (blockIdx.x == 0 && threadIdx.x == 0) { const Params q = fresh(p); chk_emit(q); } xcd_barrier(xb); }
#endif
  }
  { constexpr int l = 3;
    DUP(5) {
    { const Params q = fresh(p);
      EpiInProj e{q.ssq1(), q.S5A(), q.Qm(), q.Km(), q.vrow(), q.Qr(), q.Kr(), q.krow(), q.vrrow(), q.grow(),
                  q.inp(12) + l * 64, q.inp(13) + l * 64, q.cosm(), q.sinm(), q.cosr(), q.sinr()};
      run_gemm(lds_raw, q.xb(), q.Win_t() + (size_t)l * INW * KD, T, INW, KD, e); }
    xcd_barrier(xb);
    }
    DUP(0) {
    { PHASE_IDS; phase_post_pack(q, gtid, ngt); }
    xcd_barrier(xb);
    }
    DUP(1) {
    { const Params q = fresh(p); EpiS5Z e{q.S5Z()};
      pg8::Gemm g{q.S5A(), q.S5Wz(), 16 * 1024, 16 * 256, 512, 640, 512}; pg8::GroupOrder So; So.init(16, 4, 1, (int)gridDim.x, (int)blockIdx.x);
      pg8::gemm_phase<EpiS5Z, pg8::GroupOrder, true, true>((PG8_LAS unsigned char*)lds_raw, g, So, e); }
    { PHASE_IDS; phase_kmean2(q, gtid, ngt); phase_ret_kv(q, gw, ngw, lane); }
    xcd_barrier(xb);
    }
    DUP(2) {
    { PHASE_IDS; phase_s5_scan(q, gtid, ngt); phase_ret_scan(q, gtid, ngt); }
    __syncthreads();
    { PHASE_IDS; phase_moba2(q, l, lds_raw, q.qctr() + 64 + l); }
    xcd_barrier(xb);
    }
    DUP(3) {
    { const Params q = fresh(p); EpiS5Y e{q.ygb(), q.S5A(), q.inp(10) + l * 256};
      pg8::Gemm g{q.S5A(), q.S5Wy(), 16 * 1024, 16 * 512, 640, 640, 640}; pg8::GroupOrder So; So.init(16, 4, 2, (int)gridDim.x, (int)blockIdx.x);
      pg8::gemm_phase<EpiS5Y, pg8::GroupOrder, true, true>((PG8_LAS unsigned char*)lds_raw, g, So, e); }
    __syncthreads();
    { PHASE_IDS; phase_ret_out(q, gw, ngw, lane); }
    xcd_barrier(xb);
    }
    DUP(4) {
    { const Params q = fresh(p); EpiGlu e{q.xb(), q.ygb(), (float*)(lds_raw + 131072)};
      run_gemm(lds_raw, q.ygb(), q.Wglu_t() + (size_t)l * 65536, T, 256, 256, e); }
    xcd_barrier(xb);
    }
    { PHASE_IDS; cvt_table_i8(q.inp(19) + (size_t)l * 16384 * D, q.U8s(), q.su(), gw, ngw, lane);
      cvt_table_fp8(q.inp(20) + (size_t)l * 16384 * D, q.V8s(), q.sv(), gw, ngw, lane); }
    __syncthreads();
    { const Params q = fresh(p); EpiResid e{q.outp(), D, q.xb2(), q.hb(), q.inp(16) + l * D, q.ssq2()};
      run_gemm(lds_raw, q.xb(), q.Wout_t() + (size_t)l * D * KD, T, D, KD, e); }
    xcd_barrier(xb);
    DUP(7) {
    { const Params q = fresh(p); EpiScaleStoreBf16 e{q.qb(), D, q.ssq2(), 16, q.rstd()};
      run_gemm(lds_raw, q.xb2(), q.Wq_t() + (size_t)l * D * KD, T, D, KD, e); }
    xcd_barrier(xb);
    }
    if (!(PROBE_SKIP & 2)) {
    DUP(8) {
    { PHASE_IDS; phase_peer_topk(q, l, gw, ngw, lane); }
    xcd_barrier(xb);
    }
    }
#if PEER_CHECK
    if (l == 0) { { PHASE_IDS; chk_save(q, gtid, ngt); } xcd_barrier(xb); { PHASE_IDS; chk_topk(q, l, gtid, ngt); } xcd_barrier(xb); }
#endif
    if (!(PROBE_SKIP & 1)) {
    { PHASE_IDS; phase_peer_u(q, q.qctr() + (l * 2 + 0) * 8, lds_raw, tid); }
    xcd_barrier(xb);
    { PHASE_IDS; phase_peer_r(q, gtid, ngt); if (l + 1 < NL) phase_s5_prep(q, l + 1, gtid, ngt); }
    xcd_barrier(xb);
    if (!(PROBE_SKIP & 32)) {
    { PHASE_IDS; phase_peer_v(q, q.qctr() + (l * 2 + 1) * 8, lds_raw, tid); }
    xcd_barrier(xb);
    }
    }
#if PEER_CHECK
    if (l == 0) { { PHASE_IDS; chk_apply(q, l, ldsf + wv * 128, gw, ngw, lane); } xcd_barrier(xb);
      if (blockIdx.x == 0 && threadIdx.x == 0) { const Params q = fresh(p); chk_emit(q); } xcd_barrier(xb); }
#endif
  }
}

}

extern "C" void kernel_launch(void* const* d_in, const int* in_sizes, int n_in, void* d_out, int out_size, void* d_ws, size_t ws_size,
                              hipStream_t stream) {
  static int grid_blocks = 0;
  if (!grid_blocks) {
    int dev = 0, cus = 0, per_cu = 0;
    hipGetDevice(&dev);
    hipDeviceGetAttribute(&cus, hipDeviceAttributeMultiprocessorCount, dev);
    hipFuncSetAttribute((const void*)mega, hipFuncAttributeMaxDynamicSharedMemorySize, LDS_BYTES);
    hipOccupancyMaxActiveBlocksPerMultiprocessor(&per_cu, (const void*)mega, NTHR, LDS_BYTES);
    if (per_cu < 1) { fprintf(stderr, "occupancy query returned %d\n", per_cu); per_cu = 1; }
    grid_blocks = cus * 1;
    if (grid_blocks < 64) fprintf(stderr, "unexpected CU count %d\n", cus);
  }
  Params p{};
  for (int i = 0; i < 21; ++i) p.in[i] = (const GAS float*)d_in[i];
  p.out_ = (GAS float*)d_out;
  p.ws = (GAS unsigned char*)d_ws;
  if (WS_TOTAL > ws_size) { fprintf(stderr, "workspace too small: need %zu have %zu\n", (size_t)WS_TOTAL, ws_size); return; }
  hipMemsetAsync((unsigned char*)d_ws + WO_bar, 0, 16384, stream);
  void* args[] = {&p};
  hipError_t e = hipLaunchCooperativeKernel((const void*)mega, dim3(grid_blocks), dim3(NTHR), args, LDS_BYTES, stream);
  if (e != hipSuccess) fprintf(stderr, "cooperative launch failed: %s (grid %d)\n", hipGetErrorString(e), grid_blocks);
}
```

```cpp
#include <hip/hip_runtime.h>
#include <hip/hip_cooperative_groups.h>
#include <math.h>
#include <stdint.h>
#include <stdio.h>
namespace cg = cooperative_groups;

#ifndef PEER_CHECK
#define PEER_CHECK 0
#endif
#ifndef PROBE_DUP
#define PROBE_DUP 0
#endif
__device__ __forceinline__ int dup_n(int n) { asm volatile("" : "+s"(n)); return n; }
#define DUP(bit) _Pragma("unroll 1") for (int rep_ = 0, repn_ = (((PROBE_DUP >> (bit)) & 1) ? dup_n(2) : 1); rep_ < repn_; ++rep_)
#ifndef PROBE_SKIP
#define PROBE_SKIP 0
#endif
#ifndef PRECISE
#define PRECISE 0
#endif

namespace {
constexpr int NB = 8, S = 4096, D = 1024, NL = 4, T = NB * S;
constexpr int INW = 2816;
constexpr int OFF_U = 0, OFF_QM = 256, OFF_KM = 768, OFF_VM = 1280, OFF_QR = 1792, OFF_KR = 2048, OFF_VR = 2304, OFF_GR = 2560;
constexpr float EPS = 1e-6f;
static_assert(PRECISE == 0, "PRECISE builds are retired");
constexpr int KS = PRECISE ? 3 : 1;
constexpr int KD = D * KS;
constexpr int NTHR = 512, NWAVE = 8;
constexpr int LDS_BYTES = 131072 + 4096 + 1024;

typedef unsigned short bf16_t;
using bf16x8 = __attribute__((ext_vector_type(8))) short;
using f32x4 = __attribute__((ext_vector_type(4))) float;

__device__ __forceinline__ float wave_sum(float v) {
#pragma unroll
  for (int o = 32; o > 0; o >>= 1) v += __shfl_xor(v, o);
  return v;
}
__device__ __forceinline__ float wave_max(float v) {
#pragma unroll
  for (int o = 32; o > 0; o >>= 1) v = fmaxf(v, __shfl_xor(v, o));
  return v;
}
__device__ __forceinline__ int q_pull(int* head, int nitems, int* bc, int tid) {
  __syncthreads();
  if (tid == 0) bc[0] = atomicAdd(head, 1);
  __syncthreads();
  const int v = bc[0];
  return v < nitems ? v : -1;
}
constexpr float QSCALE = 0.125f * 1.4426950408889634f;
__device__ __forceinline__ float ret_log2g(int h) { return log2f(1.0f - exp2f(-5.0f - (float)h)); }
__device__ __forceinline__ float gelu_tanh(float x) {
  const float k0 = 0.7978845608028654f, k1 = 0.044715f;
  float u = k0 * (x + k1 * x * x * x);
  return 0.5f * x * (1.0f + tanhf(u));
}
__device__ __forceinline__ float sigmoidf_(float x) { return 1.0f / (1.0f + expf(-x)); }
__device__ __forceinline__ float fast_sigmoid(float x) { return __builtin_amdgcn_rcpf(1.0f + __builtin_amdgcn_exp2f(-1.4426950408889634f * x)); }
__device__ __forceinline__ float fast_gelu(float x) { const float u = 0.7978845608028654f * (x + 0.044715f * x * x * x); return x * fast_sigmoid(2.0f * u); }
__device__ __forceinline__ bf16_t f2bf(float f) {
  unsigned u = __float_as_uint(f);
  u += 0x7fffu + ((u >> 16) & 1u);
  return (bf16_t)(u >> 16);
}
__device__ __forceinline__ float bf2f(bf16_t h) { return __uint_as_float(((unsigned)h) << 16); }
#define LDS_FENCE() asm volatile("s_waitcnt lgkmcnt(0)" ::: "memory")
typedef __bf16 bf16x2_hw __attribute__((ext_vector_type(2)));
typedef float f32x2_hw __attribute__((ext_vector_type(2)));
__device__ __forceinline__ unsigned pk_bf16(float lo, float hi) { const f32x2_hw f = {lo, hi}; const bf16x2_hw b = __builtin_convertvector(f, bf16x2_hw); return __builtin_bit_cast(unsigned, b); }
typedef float f32x16 __attribute__((ext_vector_type(16)));

constexpr size_t al256(size_t x) { return (x + 255) & ~(size_t)255; }
constexpr size_t WO_rstd = 0;
constexpr size_t WO_cosm = WO_rstd + al256((size_t)T * 4);
constexpr size_t WO_sinm = WO_cosm + al256((size_t)S * 8 * 4);
constexpr size_t WO_cosr = WO_sinm + al256((size_t)S * 8 * 4);
constexpr size_t WO_sinr = WO_cosr + al256((size_t)S * 32 * 4);
constexpr size_t WO_kmean = WO_sinr + al256((size_t)S * 32 * 4);
constexpr size_t WO_proj = WO_kmean + al256((size_t)NB * 8 * 16 * 64 * 4);
constexpr size_t WO_ybuf = WO_proj + al256((size_t)T * INW * 4);
constexpr size_t WO_yg = WO_ybuf + al256((size_t)T * D * 4);
constexpr size_t WO_skb = WO_yg + al256((size_t)T * 256 * 4);
constexpr size_t WO_Ub = WO_skb + al256((size_t)NL * 16 * 128 * 64 * 2);
constexpr size_t WO_Vb = WO_Ub + al256((size_t)16384 * D * 2);
constexpr size_t WO_gates = WO_Vb + al256((size_t)16384 * D * 2);
constexpr size_t WO_eidx = WO_gates + al256((size_t)T * 128 * 4);
constexpr size_t WO_xb = WO_eidx + al256((size_t)T * 128 * 4);
constexpr size_t WO_Win_t = WO_xb + al256((size_t)T * KD * 2);
constexpr size_t WO_Wout_t = WO_Win_t + al256((size_t)NL * INW * KD * 2);
constexpr size_t WO_Wq_t = WO_Wout_t + al256((size_t)NL * D * KD * 2);
constexpr size_t WO_Qm = WO_Wq_t + al256((size_t)NL * D * KD * 2);
constexpr size_t WO_Km = WO_Qm + al256((size_t)T * 512 * 2);
constexpr size_t WO_Vm = WO_Km + al256((size_t)T * 512 * 2);
constexpr size_t WO_S5a32 = WO_Vm + al256((size_t)T * 512 * 2);
constexpr size_t WO_Wglu_t = WO_S5a32 + al256((size_t)16 * 64 * 2 * 4);
constexpr size_t WO_Qr = WO_Wglu_t + al256((size_t)NL * 256 * 256 * 2);
constexpr size_t WO_Kr = WO_Qr + al256((size_t)T * 256 * 2);
constexpr size_t WO_Krv = WO_Kr + al256((size_t)T * 256 * 2);
constexpr size_t WO_Vr = WO_Krv + al256((size_t)T * 256 * 2);
constexpr size_t WO_KVr = WO_Vr + al256((size_t)T * 256 * 2);
constexpr size_t WO_Rb = WO_KVr + al256((size_t)32 * 32 * 4096 * 4);
constexpr size_t WO_qctr = WO_Rb + al256((size_t)32 * 32 * 4096 * 2);
constexpr size_t WO_bar = WO_qctr + al256(1024);
constexpr size_t WO_S5Wy = WO_bar + al256(16384);
constexpr size_t WO_S5Wz = WO_S5Wy + al256((size_t)16 * 512 * 640 * 2);
constexpr size_t WO_ssq1 = WO_S5Wz + al256((size_t)16 * 256 * 512 * 2);
constexpr size_t WO_ssq2 = WO_ssq1 + al256((size_t)T * 8 * 4);
constexpr size_t WS_TOTAL = WO_ssq2 + al256((size_t)T * 16 * 4);
constexpr size_t WO_S5A = WO_gates;
constexpr size_t WO_S5Z = WO_S5A + al256((size_t)16 * 1024 * 640 * 2);
static_assert(WO_S5Z + (size_t)16 * 1024 * 128 * 4 <= WO_gates + 2 * al256((size_t)T * 128 * 4), "S5A/S5Z must fit in gates+eidx");
#define GAS __attribute__((address_space(1)))
static_assert((size_t)T * D * 2 + (size_t)T * 128 * 8 * 4 + (size_t)T * D * 2 <= (size_t)T * INW * 4, "qb + ppart + xb2 must fit in the proj region");
struct Params {
  const GAS float* in[21];
  GAS float* out_;
  GAS unsigned char* ws;
  __device__ __forceinline__ const float* inp(int i) const { return (const float*)in[i]; }
  __device__ __forceinline__ float* outp() const { return (float*)out_; }
  __device__ __forceinline__ float* rstd() const { return (float*)(ws + WO_rstd); }
  __device__ __forceinline__ float* cosm() const { return (float*)(ws + WO_cosm); }
  __device__ __forceinline__ float* sinm() const { return (float*)(ws + WO_sinm); }
  __device__ __forceinline__ float* cosr() const { return (float*)(ws + WO_cosr); }
  __device__ __forceinline__ float* sinr() const { return (float*)(ws + WO_sinr); }
  __device__ __forceinline__ float* kmean() const { return (float*)(ws + WO_kmean); }
  __device__ __forceinline__ float* proj() const { return (float*)(ws + WO_proj); }
  __device__ __forceinline__ float* ybuf() const { return (float*)(ws + WO_ybuf); }
  __device__ __forceinline__ float* yg() const { return (float*)(ws + WO_yg); }
  __device__ __forceinline__ bf16_t* skb() const { return (bf16_t*)(ws + WO_skb); }
  __device__ __forceinline__ bf16_t* Ub() const { return (bf16_t*)(ws + WO_Ub); }
  __device__ __forceinline__ bf16_t* Vb() const { return (bf16_t*)(ws + WO_Vb); }
  __device__ __forceinline__ float* gates() const { return (float*)(ws + WO_gates); }
  __device__ __forceinline__ int* eidx() const { return (int*)(ws + WO_eidx); }
  __device__ __forceinline__ bf16_t* xb() const { return (bf16_t*)(ws + WO_xb); }
  __device__ __forceinline__ bf16_t* Win_t() const { return (bf16_t*)(ws + WO_Win_t); }
  __device__ __forceinline__ bf16_t* Wout_t() const { return (bf16_t*)(ws + WO_Wout_t); }
  __device__ __forceinline__ bf16_t* Wq_t() const { return (bf16_t*)(ws + WO_Wq_t); }
  __device__ __forceinline__ bf16_t* Qm() const { return (bf16_t*)(ws + WO_Qm); }
  __device__ __forceinline__ bf16_t* Km() const { return (bf16_t*)(ws + WO_Km); }
  __device__ __forceinline__ bf16_t* Vm() const { return (bf16_t*)(ws + WO_Vm); }
  __device__ __forceinline__ bf16_t* S5A() const { return (bf16_t*)(ws + WO_S5A); }
  __device__ __forceinline__ bf16_t* S5Wy() const { return (bf16_t*)(ws + WO_S5Wy); }
  __device__ __forceinline__ bf16_t* S5Wz() const { return (bf16_t*)(ws + WO_S5Wz); }
  __device__ __forceinline__ float* S5Z() const { return (float*)(ws + WO_S5Z); }
  __device__ __forceinline__ float* S5a32() const { return (float*)(ws + WO_S5a32); }
  __device__ __forceinline__ bf16_t* Wglu_t() const { return (bf16_t*)(ws + WO_Wglu_t); }
  __device__ __forceinline__ bf16_t* ygb() const { return (bf16_t*)(ws + WO_yg); }
  __device__ __forceinline__ int* qctr() const { return (int*)(ws + WO_qctr); }
  __device__ __forceinline__ unsigned char* U8s() const { return (unsigned char*)(ws + WO_Ub); }
  __device__ __forceinline__ float* su() const { return (float*)(ws + WO_Ub + (size_t)16384 * D); }
  __device__ __forceinline__ unsigned char* V8s() const { return (unsigned char*)(ws + WO_Vb); }
  __device__ __forceinline__ float* sv() const { return (float*)(ws + WO_Vb + (size_t)16384 * D); }
  __device__ __forceinline__ bf16_t* hb() const { return (bf16_t*)(ws + WO_ybuf + ((size_t)4 << 20)); }
  __device__ __forceinline__ float* ppart() const { return (float*)(ws + WO_proj + (size_t)T * D * 2); }
  __device__ __forceinline__ bf16_t* Qr() const { return (bf16_t*)(ws + WO_Qr); }
  __device__ __forceinline__ bf16_t* Kr() const { return (bf16_t*)(ws + WO_Kr); }
  __device__ __forceinline__ bf16_t* Krv() const { return (bf16_t*)(ws + WO_Krv); }
  __device__ __forceinline__ bf16_t* Vr() const { return (bf16_t*)(ws + WO_Vr); }
  __device__ __forceinline__ float* KVr() const { return (float*)(ws + WO_KVr); }
  __device__ __forceinline__ bf16_t* Rb() const { return (bf16_t*)(ws + WO_Rb); }
  __device__ __forceinline__ unsigned* bar() const { return (unsigned*)(ws + WO_bar); }
  __device__ __forceinline__ bf16_t* projb() const { return (bf16_t*)(ws + WO_proj); }
  __device__ __forceinline__ float* ssq1() const { return (float*)(ws + WO_ssq1); }
  __device__ __forceinline__ float* ssq2() const { return (float*)(ws + WO_ssq2); }
  __device__ __forceinline__ bf16_t* xb2() const { return (bf16_t*)(ws + WO_proj + (size_t)T * D * 2 + (size_t)T * 128 * 8 * 4); }
  __device__ __forceinline__ bf16_t* vrow() const { return (bf16_t*)(ws + WO_proj); }
  __device__ __forceinline__ bf16_t* vrrow() const { return (bf16_t*)(ws + WO_proj + (size_t)T * 512 * 2); }
  __device__ __forceinline__ bf16_t* krow() const { return (bf16_t*)(ws + WO_proj + (size_t)T * 768 * 2); }
  __device__ __forceinline__ bf16_t* grow() const { return (bf16_t*)(ws + WO_proj + (size_t)T * 1024 * 2); }
  __device__ __forceinline__ bf16_t* qb() const { return (bf16_t*)(ws + WO_proj); }
};

namespace pg8 {
#define PG8_LAS __attribute__((address_space(3)))
typedef unsigned short bf16_t;
typedef short bf16x8 __attribute__((ext_vector_type(8)));
typedef float f32x4 __attribute__((ext_vector_type(4)));
typedef unsigned u32x4 __attribute__((ext_vector_type(4)));
constexpr int BM = 256, BK = 64, HALF = 128, HTB = HALF * BK * 2  , STAGE_BYTES = 8 * HTB, NXCD = 8, WGM = 8;

__host__ __device__ __forceinline__ int lds_byte(int r, int c) { const int st = (r >> 4) * 2 + (c >> 5), rr = r & 15, cc = c & 31, ob = rr * 64 + cc * 2; return st * 1024 + (ob ^ (((ob >> 9) & 1) << 5)); }
__host__ __device__ __forceinline__ void stage_rc(int b, int& R, int& C) { const int st = b / 1024, sb = b % 1024, swz = sb ^ (((sb >> 9) & 1) << 5); R = (st >> 1) * 16 + swz / 64; C = (st & 1) * 32 + (swz % 64) / 2; }
__host__ __device__ __forceinline__ int perm32(int rho) { const int n = rho >> 4, i = rho & 15; return 8 * (i >> 2) + 4 * n + (i & 3); }

struct Unit { int pm, pn; };
struct Gemm { const bf16_t* A; const bf16_t* Bt; int M, N, K, lda, ldb; };

struct StaticOrder {
    int nM, nN, nwg, G, c;
    __host__ __device__ void init(int M, int N, int G_, int c_) { nM = M / BM; nN = N / BM; nwg = nM * nN; G = G_; c = c_; }
    __host__ __device__ bool next(int i, Unit& u) const {
        const long L = (long)i * G + c; if (L >= nwg) return false;
        int wgid = (int)L; { const int q = nwg / NXCD, r = nwg % NXCD, xcd = wgid % NXCD, off = wgid / NXCD; wgid = (xcd < r ? xcd * (q + 1) : r * (q + 1) + (xcd - r) * q) + off; }
        const int nig = WGM * nN, gid = wgid / nig, fm = gid * WGM, gsz = (nM - fm) < WGM ? (nM - fm) : WGM;
        u.pm = fm + ((wgid % nig) % gsz); u.pn = (wgid % nig) / gsz; return true;
    }
    __device__ __forceinline__ void a_ready(const Unit&) const {}
    __device__ __forceinline__ void done(const Unit&) const {}
};
struct GroupOrder {
    int mt, nt_, nwg, G, c;
    __host__ __device__ void init(int ngroups, int mt__, int nt__, int G_, int c_) { mt = mt__; nt_ = nt__; nwg = ngroups * mt * nt_; G = G_; c = c_; }
    __host__ __device__ bool next(int i, Unit& u) const {
        const long L = (long)i * G + c; if (L >= nwg) return false;
        const int per = mt * nt_, gi = (int)L / per, r = (int)L % per;
        u.pm = gi * mt + r % mt; u.pn = gi * nt_ + r / mt; return true;
    }
    __device__ __forceinline__ void a_ready(const Unit&) const {}
    __device__ __forceinline__ void done(const Unit&) const {}
};
template <class Epi, class Sched, bool ALIGN_EPI = false, bool SP2 = false>
__device__ __forceinline__ void gemm_phase(PG8_LAS unsigned char* lds, const Gemm g, const Sched& S, const Epi& E) {
    int tid_ = threadIdx.x; asm volatile("" : "+v"(tid_));
    const int tid = tid_, wid = __builtin_amdgcn_readfirstlane(tid >> 6), lane = tid & 63, wr = wid >> 2, wc = wid & 3, fr = lane & 15, fq = lane >> 4;
    const int K = g.K, nt = K / BK;
    unsigned voffA[2], voffB[2];
#pragma unroll
    for (int i = 0; i < 2; ++i) { int R, C; stage_rc(tid * 16 + i * 8192, R, C); const int Rb = Epi::PERM ? ((R & ~31) + perm32(R & 31)) : R;
        voffA[i] = (unsigned)(R * g.lda + C) * 2u; voffB[i] = (unsigned)(Rb * g.ldb + C) * 2u; }
    const size_t kstep = (size_t)(BK * 2);
    const size_t hstepA = (size_t)HALF * g.lda * 2, hstepB = (size_t)HALF * g.ldb * 2;
    const size_t tstepA = 2 * hstepA, tstepB = 2 * hstepB;
    const unsigned ldsw = (unsigned)wid * 1024u;
    const int aoff = lds_byte(wr * 64 + fr, fq * 8), boff = lds_byte(wc * 32 + fr, fq * 8);
#define PG8_SA(b, h) (((b) * 2 + (h)) * HTB)
#define PG8_SB(b, h) ((4 + (b) * 2 + (h)) * HTB)
#define PG8_STAGE(bufoff, gbase, voff) do { _Pragma("unroll") for (int _i = 0; _i < 2; ++_i) \
        __builtin_amdgcn_global_load_lds((const unsigned*)((const char*)(gbase) + (voff)[_i]), (PG8_LAS unsigned*)(lds + (bufoff) + ldsw + _i * 8192), 16, 0, 0); } while (0)
#define PG8_LDA(dst, b, h) do { _Pragma("unroll") for (int m = 0; m < 4; ++m) _Pragma("unroll") for (int k = 0; k < 2; ++k) dst[m][k] = *(const PG8_LAS bf16x8*)(lds + PG8_SA(b, h) + aoff + m * 2048 + k * 1024); } while (0)
#define PG8_LDB(dst, b, h) do { _Pragma("unroll") for (int n = 0; n < 2; ++n) _Pragma("unroll") for (int k = 0; k < 2; ++k) dst[n][k] = *(const PG8_LAS bf16x8*)(lds + PG8_SB(b, h) + boff + n * 2048 + k * 1024); } while (0)
#define PG8_MMA(ai, bj, At, Bt) do { __builtin_amdgcn_s_setprio(1); _Pragma("unroll") for (int m = 0; m < 4; ++m) _Pragma("unroll") for (int n = 0; n < 2; ++n) _Pragma("unroll") for (int k = 0; k < 2; ++k) \
        acc[ai][bj][m][n] = __builtin_amdgcn_mfma_f32_16x16x32_bf16(Bt[n][k], At[m][k], acc[ai][bj][m][n], 0, 0, 0); __builtin_amdgcn_s_setprio(0); } while (0)
#define PG8_WAIT_V(n) asm volatile("s_waitcnt vmcnt(" #n ")" ::: "memory")
#define PG8_WAIT_L(n) asm volatile("s_waitcnt lgkmcnt(" #n ")" ::: "memory")
#define PG8_BAR __builtin_amdgcn_s_barrier()
#define PG8_SCHED __builtin_amdgcn_sched_barrier(0)
    Unit cur, nxt; int ui = 0;
    if (!S.next(0, cur)) return;
    f32x4 acc[2][2][4][2];
    E.init(acc, cur, wr, wc, fr, fq);
    bf16x8 At[4][2], B0[2][2], B1[2][2];
    const char* cA = (const char*)g.A + (size_t)cur.pm * tstepA; const char* cB = (const char*)g.Bt + (size_t)cur.pn * tstepB;
    S.a_ready(cur);
    if constexpr (SP2) {
        PG8_STAGE(PG8_SB(0, 0), cB, voffB); PG8_STAGE(PG8_SB(0, 1), cB + hstepB, voffB); PG8_STAGE(PG8_SA(0, 0), cA, voffA); PG8_STAGE(PG8_SA(0, 1), cA + hstepA, voffA);
        if (wr == 1) PG8_BAR;
        PG8_WAIT_V(2); PG8_BAR;
        PG8_STAGE(PG8_SB(1, 0), cB + kstep, voffB); PG8_STAGE(PG8_SA(1, 0), cA + kstep, voffA); PG8_STAGE(PG8_SB(1, 1), cB + hstepB + kstep, voffB);
        PG8_WAIT_V(6); PG8_BAR;
    } else {
        PG8_STAGE(PG8_SB(0, 0), cB, voffB); PG8_STAGE(PG8_SA(0, 0), cA, voffA); PG8_STAGE(PG8_SB(0, 1), cB + hstepB, voffB); PG8_STAGE(PG8_SA(0, 1), cA + hstepA, voffA);
        if (wr == 1) PG8_BAR;
        PG8_WAIT_V(4); PG8_BAR;
        PG8_STAGE(PG8_SB(1, 0), cB + kstep, voffB); PG8_STAGE(PG8_SA(1, 0), cA + kstep, voffA); PG8_STAGE(PG8_SB(1, 1), cB + hstepB + kstep, voffB);
        PG8_WAIT_V(6); PG8_BAR;
    }
    for (;;) {
        const bool has_next = S.next(ui + 1, nxt);
        const char* nA = has_next ? (const char*)g.A + (size_t)nxt.pm * tstepA : cA; const char* nB = has_next ? (const char*)g.Bt + (size_t)nxt.pn * tstepB : cB;
        for (int t = 0; t < nt; t += 2) {
            const bool last = (t == nt - 2);
            const char* a1 = cA + (size_t)(t + 1) * kstep;
            const char* a2 = last ? nA : cA + (size_t)(t + 2) * kstep; const char* b2 = last ? nB : cB + (size_t)(t + 2) * kstep;
            const char* a3 = a2 + kstep; const char* b3 = b2 + kstep;
            if (last && has_next) S.a_ready(nxt);
            if constexpr (SP2) {
            PG8_LDB(B0, 0, 0); PG8_LDB(B1, 0, 1); PG8_SCHED; PG8_LDA(At, 0, 0); PG8_STAGE(PG8_SA(1, 1), a1 + hstepA, voffA);
            PG8_WAIT_V(8); PG8_WAIT_L(0); PG8_BAR; PG8_MMA(0, 0, At, B0); PG8_MMA(0, 1, At, B1); PG8_BAR; PG8_SCHED;
            PG8_LDA(At, 0, 1); PG8_STAGE(PG8_SB(0, 0), b2, voffB); PG8_STAGE(PG8_SB(0, 1), b2 + hstepB, voffB); PG8_STAGE(PG8_SA(0, 0), a2, voffA);
            PG8_WAIT_V(8); PG8_WAIT_L(0); PG8_BAR; PG8_MMA(1, 0, At, B0); PG8_MMA(1, 1, At, B1); PG8_BAR; PG8_SCHED;
            PG8_LDB(B0, 1, 0); PG8_LDB(B1, 1, 1); PG8_SCHED; PG8_LDA(At, 1, 0); PG8_STAGE(PG8_SA(0, 1), a2 + hstepA, voffA);
            PG8_WAIT_V(8); PG8_WAIT_L(0); PG8_BAR; PG8_MMA(0, 0, At, B0); PG8_MMA(0, 1, At, B1); PG8_BAR; PG8_SCHED;
            PG8_LDA(At, 1, 1); PG8_STAGE(PG8_SB(1, 0), b3, voffB); PG8_STAGE(PG8_SB(1, 1), b3 + hstepB, voffB); PG8_STAGE(PG8_SA(1, 0), a3, voffA);
            PG8_WAIT_V(8); PG8_WAIT_L(0); PG8_BAR; PG8_MMA(1, 0, At, B0); PG8_MMA(1, 1, At, B1); PG8_BAR; PG8_SCHED;
            } else {
            PG8_LDB(B0, 0, 0); PG8_SCHED; PG8_LDA(At, 0, 0); PG8_STAGE(PG8_SA(1, 1), a1 + hstepA, voffA);
            PG8_WAIT_L(8); PG8_BAR; PG8_WAIT_L(0); PG8_MMA(0, 0, At, B0); PG8_BAR; PG8_SCHED;
            PG8_LDB(B1, 0, 1); PG8_STAGE(PG8_SB(0, 0), b2, voffB);
            PG8_BAR; PG8_WAIT_L(0); PG8_MMA(0, 1, At, B1); PG8_BAR;
            PG8_LDA(At, 0, 1); PG8_STAGE(PG8_SA(0, 0), a2, voffA);
            PG8_BAR; PG8_WAIT_L(0); PG8_MMA(1, 0, At, B0); PG8_BAR; PG8_SCHED;
            PG8_STAGE(PG8_SB(0, 1), b2 + hstepB, voffB);
            PG8_WAIT_V(6); PG8_BAR; PG8_MMA(1, 1, At, B1); PG8_BAR;
            PG8_LDB(B0, 1, 0); PG8_SCHED; PG8_LDA(At, 1, 0); PG8_STAGE(PG8_SA(0, 1), a2 + hstepA, voffA);
            PG8_WAIT_L(8); PG8_BAR; PG8_WAIT_L(0); PG8_MMA(0, 0, At, B0); PG8_BAR; PG8_SCHED;
            PG8_LDB(B1, 1, 1); PG8_STAGE(PG8_SB(1, 0), b3, voffB);
            PG8_BAR; PG8_WAIT_L(0); PG8_MMA(0, 1, At, B1); PG8_BAR;
            PG8_LDA(At, 1, 1); PG8_STAGE(PG8_SA(1, 0), a3, voffA);
            PG8_BAR; PG8_WAIT_L(0); PG8_MMA(1, 0, At, B0); PG8_BAR; PG8_SCHED;
            PG8_STAGE(PG8_SB(1, 1), b3 + hstepB, voffB);
            PG8_WAIT_V(6); PG8_BAR; PG8_MMA(1, 1, At, B1); PG8_BAR;
            }
        }
        if constexpr (ALIGN_EPI) { if (wr == 0) PG8_BAR; }
        if constexpr (!Epi::AFTER_DRAIN) { E(acc, cur, wr, wc, fr, fq); S.done(cur); }
        if (!has_next) break;
        E.init(acc, nxt, wr, wc, fr, fq);
        cur = nxt; cA = nA; cB = nB; ++ui;
        if constexpr (ALIGN_EPI) { if (wr == 1) PG8_BAR; }
    }
    PG8_WAIT_V(0);
    if constexpr (!ALIGN_EPI) { if (wr == 0) PG8_BAR; }
    PG8_BAR;
    if constexpr (Epi::AFTER_DRAIN) { E.fused(acc, cur, wr, wc, fr, fq, lds, wid, lane); S.done(cur); }
#undef PG8_SA
#undef PG8_SB
#undef PG8_STAGE
#undef PG8_LDA
#undef PG8_LDB
#undef PG8_MMA
#undef PG8_WAIT_V
#undef PG8_WAIT_L
#undef PG8_BAR
#undef PG8_SCHED
}
}
#define EPI_ZERO_INIT \
  __device__ __forceinline__ void init(pg8::f32x4 (&acc)[2][2][4][2], const pg8::Unit&, int, int, int, int) const { \
    _Pragma("unroll") for (int a = 0; a < 2; ++a) _Pragma("unroll") for (int b = 0; b < 2; ++b) \
    _Pragma("unroll") for (int m = 0; m < 4; ++m) _Pragma("unroll") for (int n = 0; n < 2; ++n) acc[a][b][m][n] = (pg8::f32x4){0.f, 0.f, 0.f, 0.f}; }
struct EpiResid {
  static constexpr bool PERM = true, AFTER_DRAIN = false;
  float* C; int ldc; bf16_t* xb; bf16_t* hb; const float* g2; float* parts;
  __device__ __forceinline__ void init(pg8::f32x4 (&acc)[2][2][4][2], const pg8::Unit& u, int wr, int wc, int fr, int fq) const {
#pragma unroll
    for (int ai = 0; ai < 2; ++ai)
#pragma unroll
      for (int m = 0; m < 4; ++m) {
        const int row = u.pm * 256 + ai * 128 + wr * 64 + m * 16 + fr;
#pragma unroll
        for (int bj = 0; bj < 2; ++bj)
#pragma unroll
          for (int n = 0; n < 2; ++n) {
            const int col = u.pn * 256 + bj * 128 + wc * 32 + 8 * fq + 4 * n;
            acc[ai][bj][m][n] = *(const pg8::f32x4*)(C + (size_t)row * ldc + col);
          }
      }
  }
  __device__ __forceinline__ void operator()(const pg8::f32x4 (&acc)[2][2][4][2], const pg8::Unit& u, int wr, int wc, int fr_in, int fq_in) const {
    int fr = fr_in, fq = fq_in; asm volatile("" : "+v"(fr), "+v"(fq));
    pg8::f32x4 gv[2][2];
#pragma unroll
    for (int bj = 0; bj < 2; ++bj)
#pragma unroll
      for (int n = 0; n < 2; ++n) gv[bj][n] = *(const pg8::f32x4*)(g2 + u.pn * 256 + bj * 128 + wc * 32 + 8 * fq + 4 * n);
#pragma unroll
    for (int ai = 0; ai < 2; ++ai)
#pragma unroll
      for (int m = 0; m < 4; ++m) {
        const int row = u.pm * 256 + ai * 128 + wr * 64 + m * 16 + fr;
        float ss = 0.f;
#pragma unroll
        for (int bj = 0; bj < 2; ++bj) {
          const int col = u.pn * 256 + bj * 128 + wc * 32 + 8 * fq;
          const pg8::f32x4 v0 = acc[ai][bj][m][0], v1 = acc[ai][bj][m][1];
          *(pg8::f32x4*)(C + (size_t)row * ldc + col) = v0; *(pg8::f32x4*)(C + (size_t)row * ldc + col + 4) = v1;
          *(uint4*)(xb + (size_t)row * KD + col) = make_uint4(pk_bf16(v0[0], v0[1]), pk_bf16(v0[2], v0[3]), pk_bf16(v1[0], v1[1]), pk_bf16(v1[2], v1[3]));
          const pg8::f32x4 h0 = v0 * gv[bj][0], h1 = v1 * gv[bj][1];
          *(uint4*)(hb + ((size_t)(col >> 7) * T + row) * 128 + (col & 127)) = make_uint4(pk_bf16(h0[0], h0[1]), pk_bf16(h0[2], h0[3]), pk_bf16(h1[0], h1[1]), pk_bf16(h1[2], h1[3]));
          ss += ((v0[0] * v0[0] + v0[1] * v0[1]) + (v0[2] * v0[2] + v0[3] * v0[3])) + ((v1[0] * v1[0] + v1[1] * v1[1]) + (v1[2] * v1[2] + v1[3] * v1[3]));
        }
        ss += __shfl_xor(ss, 16); ss += __shfl_xor(ss, 32);
        if (fq == 0) parts[(size_t)row * 16 + u.pn * 4 + wc] = ss;
        asm volatile("" ::: "memory");
      }
  }
};
struct EpiScaleStoreBf16 {
  static constexpr bool PERM = true, AFTER_DRAIN = false;
  bf16_t* C; int ldc; const float* parts; int nparts; float* rs_out;
  EPI_ZERO_INIT
  __device__ __forceinline__ void operator()(const pg8::f32x4 (&acc)[2][2][4][2], const pg8::Unit& u, int wr, int wc, int fr_in, int fq_in) const {
    int fr = fr_in, fq = fq_in; asm volatile("" : "+v"(fr), "+v"(fq));
#pragma unroll
    for (int ai = 0; ai < 2; ++ai)
#pragma unroll
      for (int m = 0; m < 4; ++m) {
        const int row = u.pm * 256 + ai * 128 + wr * 64 + m * 16 + fr;
        float ssum = 0.f;
        for (int i = 0; i < nparts; i += 4) { const pg8::f32x4 q4 = *(const pg8::f32x4*)(parts + (size_t)row * nparts + i); ssum += (q4[0] + q4[1]) + (q4[2] + q4[3]); }
        const float r = rsqrtf(ssum * (1.0f / (float)D) + EPS);
        if (rs_out && u.pn == 0 && wc == 0 && fq == 0) rs_out[row] = r;
#pragma unroll
        for (int bj = 0; bj < 2; ++bj) {
          const int col = u.pn * 256 + bj * 128 + wc * 32 + 8 * fq;
          const pg8::f32x4 v0 = acc[ai][bj][m][0] * r, v1 = acc[ai][bj][m][1] * r;
          *(uint4*)(C + (size_t)row * ldc + col) = make_uint4(pk_bf16(v0[0], v0[1]), pk_bf16(v0[2], v0[3]), pk_bf16(v1[0], v1[1]), pk_bf16(v1[2], v1[3]));
        }
        asm volatile("" ::: "memory");
      }
  }
};
struct EpiInProj {
  static constexpr bool PERM = true, AFTER_DRAIN = false;
  const float* parts;
  bf16_t *S5A, *Qm, *Km, *vrow, *Qr, *Kr, *krow, *vrrow, *grow;
  const float *gq, *gk, *cosm, *sinm, *cosr, *sinr;
  EPI_ZERO_INIT
  __device__ __forceinline__ void operator()(const pg8::f32x4 (&acc)[2][2][4][2], const pg8::Unit& u, int wr, int wc, int fr_in, int fq_in) const {
    int fr = fr_in, fq = fq_in; asm volatile("" : "+v"(fr), "+v"(fq));
    const int pn = u.pn;
    float gain[2][8];
    if (pn >= 1 && pn <= 4) {
      const float* gsrc = pn <= 2 ? gq : gk;
#pragma unroll
      for (int bj = 0; bj < 2; ++bj) { const pg8::f32x4 a = *(const pg8::f32x4*)(gsrc + bj * 32 + 8 * fq), b = *(const pg8::f32x4*)(gsrc + bj * 32 + 8 * fq + 4);
        gain[bj][0] = a[0]; gain[bj][1] = a[1]; gain[bj][2] = a[2]; gain[bj][3] = a[3]; gain[bj][4] = b[0]; gain[bj][5] = b[1]; gain[bj][6] = b[2]; gain[bj][7] = b[3]; }
    }
    const float l2g = ret_log2g(wc);
#pragma unroll
    for (int ai = 0; ai < 2; ++ai)
#pragma unroll
      for (int m = 0; m < 4; ++m) {
        const int t = u.pm * 256 + ai * 128 + wr * 64 + m * 16 + fr, s = t & (S - 1), b = t >> 12;
        float r;
        { const pg8::f32x4 p0 = *(const pg8::f32x4*)(parts + (size_t)t * 8), p1 = *(const pg8::f32x4*)(parts + (size_t)t * 8 + 4);
          r = rsqrtf((((p0[0] + p0[1]) + (p0[2] + p0[3])) + ((p1[0] + p1[1]) + (p1[2] + p1[3]))) * (1.0f / (float)D) + EPS); }
        float v[2][8];
#pragma unroll
        for (int bj = 0; bj < 2; ++bj)
#pragma unroll
          for (int e = 0; e < 8; ++e) v[bj][e] = acc[ai][bj][m][e >> 2][e & 3] * r;
#define PK8(x_) make_uint4(pk_bf16((x_)[0], (x_)[1]), pk_bf16((x_)[2], (x_)[3]), pk_bf16((x_)[4], (x_)[5]), pk_bf16((x_)[6], (x_)[7]))
        if (pn == 0) {
#pragma unroll
          for (int bj = 0; bj < 2; ++bj) { const int g = wc * 4 + bj * 2 + (fq >> 1);
            *(uint4*)(S5A + ((size_t)g * 1024 + (t >> 5)) * 640 + (t & 31) * 16 + 8 * (fq & 1)) = PK8(v[bj]); }
        } else if (pn <= 4) {
          const bool isk = pn >= 3; const int h = ((pn - 1) & 1) * 4 + wc, bh = b * 8 + h;
          float ss = 0.f;
#pragma unroll
          for (int bj = 0; bj < 2; ++bj)
#pragma unroll
            for (int e = 0; e < 8; ++e) ss += v[bj][e] * v[bj][e];
          ss += __shfl_xor(ss, 16); ss += __shfl_xor(ss, 32);
          const float rh = rsqrtf(ss * (1.0f / 64.0f) + EPS);
#pragma unroll
          for (int bj = 0; bj < 2; ++bj)
#pragma unroll
            for (int e = 0; e < 8; ++e) v[bj][e] *= rh * gain[bj][e];
          { const pg8::f32x4 c0 = *(const pg8::f32x4*)(cosm + s * 8), c1 = *(const pg8::f32x4*)(cosm + s * 8 + 4), s0 = *(const pg8::f32x4*)(sinm + s * 8), s1 = *(const pg8::f32x4*)(sinm + s * 8 + 4);
#pragma unroll
            for (int e = 0; e < 8; ++e) {
              const float pu = __shfl_xor(v[0][e], 16);
              const float c = e < 4 ? c0[e & 3] : c1[e & 3], sn = e < 4 ? s0[e & 3] : s1[e & 3];
              const float o = fq == 0 ? (v[0][e] * c - pu * sn) : (v[0][e] * c + pu * sn);
              v[0][e] = fq < 2 ? o : v[0][e];
            } }
          if (!isk) {
#pragma unroll
            for (int bj = 0; bj < 2; ++bj) { float q8[8];
#pragma unroll
              for (int e = 0; e < 8; ++e) q8[e] = v[bj][e] * QSCALE;
              *(uint4*)(Qm + ((size_t)bh * S + s) * 64 + bj * 32 + 8 * fq) = PK8(q8); }
          } else {
#pragma unroll
            for (int bj = 0; bj < 2; ++bj) *(uint4*)(Km + ((((size_t)bh * (S / 32) + (s >> 5)) * 8 + bj * 4 + fq) * 32 + (s & 31)) * 8) = PK8(v[bj]);
          }
        } else if (pn <= 6) {
#pragma unroll
          for (int bj = 0; bj < 2; ++bj) *(uint4*)(vrow + (size_t)t * 512 + (pn - 5) * 256 + wc * 64 + bj * 32 + 8 * fq) = PK8(v[bj]);
        } else if (pn <= 8) {
          const bool isk = pn == 8; const int bh = b * 4 + wc, pos = s & 127;
          const float sc = isk ? 0.125f * exp2f(-(float)pos * l2g) : exp2f((float)pos * l2g);
          const pg8::f32x4 c0 = *(const pg8::f32x4*)(cosr + s * 32 + 8 * fq), c1 = *(const pg8::f32x4*)(cosr + s * 32 + 8 * fq + 4);
          const pg8::f32x4 s0 = *(const pg8::f32x4*)(sinr + s * 32 + 8 * fq), s1 = *(const pg8::f32x4*)(sinr + s * 32 + 8 * fq + 4);
          float o1[8], o2[8];
#pragma unroll
          for (int e = 0; e < 8; ++e) { const float c = e < 4 ? c0[e & 3] : c1[e & 3], sn = e < 4 ? s0[e & 3] : s1[e & 3];
            o1[e] = (v[0][e] * c - v[1][e] * sn) * sc; o2[e] = (v[1][e] * c + v[0][e] * sn) * sc; }
          if (!isk) {
            *(uint4*)(Qr + ((size_t)bh * S + s) * 64 + 8 * fq) = PK8(o1); *(uint4*)(Qr + ((size_t)bh * S + s) * 64 + 32 + 8 * fq) = PK8(o2);
          } else {
            *(uint4*)(Kr + ((((size_t)bh * (S / 32) + (s >> 5)) * 8 + fq) * 32 + (s & 31)) * 8) = PK8(o1);
            *(uint4*)(Kr + ((((size_t)bh * (S / 32) + (s >> 5)) * 8 + 4 + fq) * 32 + (s & 31)) * 8) = PK8(o2);
            *(uint4*)(krow + (size_t)t * 256 + wc * 64 + 8 * fq) = PK8(o1); *(uint4*)(krow + (size_t)t * 256 + wc * 64 + 32 + 8 * fq) = PK8(o2);
          }
        } else {
          bf16_t* dst = (pn == 9 ? vrrow : grow) + (size_t)t * 256 + wc * 64 + 8 * fq;
          *(uint4*)dst = PK8(v[0]); *(uint4*)(dst + 32) = PK8(v[1]);
        }
#undef PK8
        asm volatile("" ::: "memory");
      }
  }
};
template <class Epi>
__device__ __forceinline__ void run_gemm(unsigned char* lds_raw, const bf16_t* A, const bf16_t* Bt, int M, int N, int K, const Epi& e) {
  pg8::Gemm g{A, Bt, M, N, K, K, K}; pg8::StaticOrder So; So.init(M, N, (int)gridDim.x, (int)blockIdx.x);
  pg8::gemm_phase<Epi, pg8::StaticOrder, true, true>((PG8_LAS unsigned char*)lds_raw, g, So, e);
}

template <bool HEADPERM>
__device__ __forceinline__ void transpose_items(const float* __restrict__ W, int K, int N, const float* __restrict__ g, bf16_t* __restrict__ Wt, int gw, int ngw, int lane) {
  const int nkt = K / 64, nnt = N / 64;
  for (int it = gw; it < nkt * nnt; it += ngw) {
    int kt = it % nkt, ntile = it / nkt;
    int k0 = kt * 64, n = ntile * 64 + lane;
    int ns = n;
    if (HEADPERM) { const int cp = n & 255; ns = (n & ~255) + ((cp >> 5) & 3) * 64 + (cp >> 7) * 32 + (cp & 31); }
    float v[64];
#pragma unroll
    for (int i = 0; i < 64; ++i) v[i] = W[(size_t)(k0 + i) * N + ns] * g[k0 + i];
    bf16_t* dst = Wt + (size_t)n * (K * KS) + k0;
#pragma unroll
    for (int c = 0; c < 8; ++c) {
      bf16_t hi[8], lo[8];
#pragma unroll
      for (int e = 0; e < 8; ++e) { hi[e] = f2bf(v[c * 8 + e]); lo[e] = f2bf(v[c * 8 + e] - bf2f(hi[e])); }
      uint4 ph, pl;
      ph.x = hi[0] | ((unsigned)hi[1] << 16); ph.y = hi[2] | ((unsigned)hi[3] << 16); ph.z = hi[4] | ((unsigned)hi[5] << 16); ph.w = hi[6] | ((unsigned)hi[7] << 16);
      pl.x = lo[0] | ((unsigned)lo[1] << 16); pl.y = lo[2] | ((unsigned)lo[3] << 16); pl.z = lo[4] | ((unsigned)lo[5] << 16); pl.w = lo[6] | ((unsigned)lo[7] << 16);
      *(uint4*)(dst + c * 8) = ph;
      if (PRECISE) { *(uint4*)(dst + K + c * 8) = pl; *(uint4*)(dst + 2 * K + c * 8) = ph; }
    }
  }
}


__device__ __forceinline__ void phase_prologue(const Params& p, int gtid, int ngt, int gw, int ngw, int lane) {
  for (int idx = gtid; idx < S * 40; idx += ngt) {
    int s = idx / 40, i = idx % 40;
    if (i < 8) {
      float inv = powf(500000.0f, -(float)(2 * i) / 16.0f);
      float ang = (float)s * inv;
      p.cosm()[s * 8 + i] = (float)cos((double)ang); p.sinm()[s * 8 + i] = (float)sin((double)ang);
    } else {
      int j = i - 8;
      float inv = powf(10000.0f, -((float)j / 31.0f));
      float ang = (float)s * inv;
      p.cosr()[s * 32 + j] = (float)cos((double)ang); p.sinr()[s * 32 + j] = (float)sin((double)ang);
    }
  }
  { const float4* a = (const float4*)p.inp(0); float4* b = (float4*)p.outp();
    for (size_t i = gtid; i < (size_t)T * D / 4; i += ngt) b[i] = a[i]; }
  for (int t = gw; t < T; t += ngw) {
    const float4* xr = (const float4*)(p.inp(0) + (size_t)t * D); float ss = 0.f;
#pragma unroll
    for (int i = 0; i < 4; ++i) { const float4 v = xr[lane + i * 64]; ss += v.x * v.x + v.y * v.y + v.z * v.z + v.w * v.w;
      *(uint2*)(p.xb() + (size_t)t * KD + (lane + i * 64) * 4) = make_uint2(pk_bf16(v.x, v.y), pk_bf16(v.z, v.w)); }
    ss = wave_sum(ss);
    if (lane < 8) p.ssq1()[(size_t)t * 8 + lane] = lane == 0 ? ss : 0.f;
  }
  for (int idx = gtid; idx < NL * 65536; idx += ngt) { const int l2 = idx >> 16, n2 = (idx >> 8) & 255, k2 = idx & 255; p.Wglu_t()[idx] = f2bf(p.inp(11)[(size_t)l2 * 65536 + k2 * 256 + n2]); }
  for (int l = 0; l < NL; ++l) {
    transpose_items<true>(p.inp(2) + (size_t)l * D * INW, D, INW, p.inp(1) + l * D, p.Win_t() + (size_t)l * INW * KD, gw, ngw, lane);
    transpose_items<false>(p.inp(15) + (size_t)l * D * D, D, D, p.inp(14) + l * D, p.Wout_t() + (size_t)l * D * KD, gw, ngw, lane);
    transpose_items<false>(p.inp(17) + (size_t)l * D * D, D, D, p.inp(16) + l * D, p.Wq_t() + (size_t)l * D * KD, gw, ngw, lane);
  }
}


struct S5P { float lr, li, dt, fr, fi; };
__device__ __forceinline__ S5P s5p(const Params& p, int l, int g, int pp) {
  S5P r; r.lr = p.inp(3)[l * 1024 + g * 64 + pp]; r.li = p.inp(4)[l * 1024 + g * 64 + pp]; r.dt = expf(p.inp(5)[l * 16 + g]);
  const float mag = expf(r.lr * r.dt); float sn, cs; sincosf(r.li * r.dt, &sn, &cs);
  const float ar = mag * cs, ai = mag * sn, den = r.lr * r.lr + r.li * r.li;
  r.fr = ((ar - 1.0f) * r.lr + ai * r.li) / den; r.fi = (ai * r.lr - (ar - 1.0f) * r.li) / den;
  return r;
}
__device__ __forceinline__ void s5pow(const S5P& s, int k, float& re, float& im) {
  const float m = expf((float)k * s.lr * s.dt); float sn, cs; sincosf((float)k * s.li * s.dt, &sn, &cs); re = m * cs; im = m * sn;
}
__device__ __forceinline__ void phase_s5_prep(const Params& p, int l, int gtid, int ngt) {
  const float* b_re = p.inp(6) + l * 16384; const float* b_im = p.inp(7) + l * 16384;
  const float* c_re = p.inp(8) + l * 16384; const float* c_im = p.inp(9) + l * 16384;
  bf16_t* Wy = p.S5Wy(); bf16_t* Wz = p.S5Wz();
  for (int it = gtid; it < 16 * 32 * 256; it += ngt) {
    const int hp = it & 15, h = (it >> 4) & 15, d = (it >> 8) & 31, g = it >> 13;
    float acc = 0.f;
    for (int pp = 0; pp < 64; ++pp) {
      const S5P s = s5p(p, l, g, pp);
      float pr, pi; s5pow(s, d, pr, pi);
      const float br = b_re[(g * 64 + pp) * 16 + hp], bi = b_im[(g * 64 + pp) * 16 + hp];
      const float bbr = s.fr * br - s.fi * bi, bbi = s.fr * bi + s.fi * br;
      const float tr = pr * bbr - pi * bbi, ti = pr * bbi + pi * bbr;
      acc += c_re[(g * 16 + h) * 64 + pp] * tr - c_im[(g * 16 + h) * 64 + pp] * ti;
    }
    const bf16_t v = f2bf(acc);
    for (int jp = 0; jp + d < 32; ++jp) {
      const int j = jp + d;
      Wy[((size_t)g * 512 + j * 16 + h) * 640 + jp * 16 + hp] = v;
      if (d > 0) Wy[((size_t)g * 512 + jp * 16 + h) * 640 + j * 16 + hp] = 0;
    }
  }
  for (int it = gtid; it < 16 * 32 * 16 * 64; it += ngt) {
    const int pp = it & 63, h = (it >> 6) & 15, j = (it >> 10) & 31, g = it >> 15;
    const S5P s = s5p(p, l, g, pp);
    float pr, pi; s5pow(s, j + 1, pr, pi);
    const float cr = c_re[(g * 16 + h) * 64 + pp], ci = c_im[(g * 16 + h) * 64 + pp];
    const unsigned w = pk_bf16(cr * pr - ci * pi, -(cr * pi + ci * pr));
    *(unsigned*)(Wy + ((size_t)g * 512 + j * 16 + h) * 640 + 512 + 2 * pp) = w;
  }
  for (int it = gtid; it < 16 * 64 * 32; it += ngt) {
    const int j = it & 31, pp = (it >> 5) & 63, g = it >> 11;
    const S5P s = s5p(p, l, g, pp);
    float pr, pi; s5pow(s, 31 - j, pr, pi);
    for (int hp = 0; hp < 16; ++hp) {
      const float br = b_re[(g * 64 + pp) * 16 + hp], bi = b_im[(g * 64 + pp) * 16 + hp];
      const float bbr = s.fr * br - s.fi * bi, bbi = s.fr * bi + s.fi * br;
      Wz[((size_t)g * 256 + 2 * pp) * 512 + j * 16 + hp] = f2bf(pr * bbr - pi * bbi);
      Wz[((size_t)g * 256 + 2 * pp + 1) * 512 + j * 16 + hp] = f2bf(pr * bbi + pi * bbr);
    }
  }
  for (int it = gtid; it < 16 * 64; it += ngt) {
    const S5P s = s5p(p, l, it >> 6, it & 63);
    float pr, pi; s5pow(s, 32, pr, pi);
    p.S5a32()[it * 2] = pr; p.S5a32()[it * 2 + 1] = pi;
  }
}
__device__ __forceinline__ void phase_s5_scan(const Params& p, int gtid, int ngt) {
  for (int it = gtid; it < NB * 16 * 64; it += ngt) {
    const int pp = it & 63, g = (it >> 6) & 15, b = it >> 10;
    const float er = p.S5a32()[(g * 64 + pp) * 2], ei = p.S5a32()[(g * 64 + pp) * 2 + 1];
    float sr = 0.f, si = 0.f;
#pragma unroll 1
    for (int c0 = 0; c0 < 128; c0 += 16) {
      float2 z[16];
#pragma unroll
      for (int k = 0; k < 16; ++k) z[k] = *(const float2*)(p.S5Z() + ((size_t)g * 1024 + b * 128 + c0 + k) * 128 + 2 * pp);
#pragma unroll
      for (int k = 0; k < 16; ++k) {
        const size_t ch = (size_t)g * 1024 + b * 128 + c0 + k;
        *(unsigned*)(p.S5A() + ch * 640 + 512 + 2 * pp) = pk_bf16(sr, si);
        const float nr = er * sr - ei * si + z[k].x, ni = er * si + ei * sr + z[k].y;
        sr = nr; si = ni;
      }
    }
  }
}
struct EpiS5Z {
  static constexpr bool PERM = false, AFTER_DRAIN = false;
  float* Z;
  EPI_ZERO_INIT
  __device__ __forceinline__ void operator()(const pg8::f32x4 (&acc)[2][2][4][2], const pg8::Unit& u, int wr, int wc, int fr_in, int fq_in) const {
    int fr = fr_in, fq = fq_in; asm volatile("" : "+v"(fr), "+v"(fq));
    const int g = u.pm >> 2;
#pragma unroll
    for (int ai = 0; ai < 2; ++ai)
#pragma unroll
      for (int m = 0; m < 4; ++m) {
        const int chunk = (u.pm & 3) * 256 + ai * 128 + wr * 64 + m * 16 + fr;
#pragma unroll
        for (int n = 0; n < 2; ++n) *(pg8::f32x4*)(Z + ((size_t)g * 1024 + chunk) * 128 + wc * 32 + n * 16 + 4 * fq) = acc[ai][0][m][n];
      }
  }
};
struct EpiS5Y {
  static constexpr bool PERM = false, AFTER_DRAIN = false;
  bf16_t* ygb; const bf16_t* A; const float* dsk;
  EPI_ZERO_INIT
  __device__ __forceinline__ void operator()(const pg8::f32x4 (&acc)[2][2][4][2], const pg8::Unit& u, int wr, int wc, int fr_in, int fq_in) const {
    int fr = fr_in, fq = fq_in; asm volatile("" : "+v"(fr), "+v"(fq));
    const int g = u.pm >> 2;
#pragma unroll
    for (int ai = 0; ai < 2; ++ai)
#pragma unroll
      for (int m = 0; m < 4; ++m) {
        const int chunk = (u.pm & 3) * 256 + ai * 128 + wr * 64 + m * 16 + fr;
#pragma unroll
        for (int bj = 0; bj < 2; ++bj)
#pragma unroll
          for (int n = 0; n < 2; ++n) {
            const int col = (u.pn & 1) * 256 + bj * 128 + wc * 32 + n * 16 + 4 * fq, j = col >> 4, h = col & 15;
            const uint2 uu = *(const uint2*)(A + ((size_t)g * 1024 + chunk) * 640 + col);
            const pg8::f32x4 dv = *(const pg8::f32x4*)(dsk + g * 16 + h);
            const pg8::f32x4 v = acc[ai][bj][m][n];
            const float y0 = fast_gelu(v[0] + dv[0] * __uint_as_float(uu.x << 16)), y1 = fast_gelu(v[1] + dv[1] * __uint_as_float(uu.x & 0xffff0000u));
            const float y2 = fast_gelu(v[2] + dv[2] * __uint_as_float(uu.y << 16)), y3 = fast_gelu(v[3] + dv[3] * __uint_as_float(uu.y & 0xffff0000u));
            uint2 o; o.x = pk_bf16(y0, y1); o.y = pk_bf16(y2, y3);
            *(uint2*)(ygb + ((size_t)chunk * 32 + j) * 256 + g * 16 + h) = o;
          }
        asm volatile("" ::: "memory");
      }
  }
};
struct EpiGlu {
  static constexpr bool PERM = false, AFTER_DRAIN = false;
  bf16_t* yb; const bf16_t* ygb; float* scr;
  EPI_ZERO_INIT
  __device__ __forceinline__ void operator()(const pg8::f32x4 (&acc_)[2][2][4][2], const pg8::Unit& u, int wr, int wc, int fr_in, int fq_in) const {
    int fr = fr_in, fq = fq_in; asm volatile("" : "+v"(fr), "+v"(fq));
    pg8::f32x4 (&acc)[2][2][4][2] = const_cast<pg8::f32x4 (&)[2][2][4][2]>(acc_);
#pragma unroll
    for (int ai = 0; ai < 2; ++ai)
#pragma unroll
      for (int m = 0; m < 4; ++m) {
        const int rl = ai * 128 + wr * 64 + m * 16 + fr, row = u.pm * 256 + rl;
        float ss = 0.f;
#pragma unroll
        for (int bj = 0; bj < 2; ++bj)
#pragma unroll
          for (int n = 0; n < 2; ++n) {
            const int col = bj * 128 + wc * 32 + n * 16 + 4 * fq;
            const uint2 yy = *(const uint2*)(ygb + (size_t)row * 256 + col);
            const pg8::f32x4 z = acc[ai][bj][m][n];
            pg8::f32x4 r;
            r[0] = __uint_as_float(yy.x << 16) * fast_sigmoid(z[0]); r[1] = __uint_as_float(yy.x & 0xffff0000u) * fast_sigmoid(z[1]);
            r[2] = __uint_as_float(yy.y << 16) * fast_sigmoid(z[2]); r[3] = __uint_as_float(yy.y & 0xffff0000u) * fast_sigmoid(z[3]);
            acc[ai][bj][m][n] = r;
            ss += r[0] * r[0] + r[1] * r[1] + r[2] * r[2] + r[3] * r[3];
          }
        ss += __shfl_xor(ss, 16); ss += __shfl_xor(ss, 32);
        if (fq == 0) scr[rl * 4 + wc] = ss;
        asm volatile("" ::: "memory");
      }
    asm volatile("s_waitcnt lgkmcnt(0)" ::: "memory"); __builtin_amdgcn_s_barrier(); asm volatile("" ::: "memory");
#pragma unroll
    for (int ai = 0; ai < 2; ++ai)
#pragma unroll
      for (int m = 0; m < 4; ++m) {
        const int rl = ai * 128 + wr * 64 + m * 16 + fr, row = u.pm * 256 + rl;
        const pg8::f32x4 s4 = *(const pg8::f32x4*)(scr + rl * 4);
        const float r = rsqrtf((s4[0] + s4[1] + s4[2] + s4[3]) / 256.0f + EPS);
#pragma unroll
        for (int bj = 0; bj < 2; ++bj)
#pragma unroll
          for (int n = 0; n < 2; ++n) { const pg8::f32x4 v = acc[ai][bj][m][n] * r; *(uint2*)(yb + (size_t)row * KD + bj * 128 + wc * 32 + n * 16 + 4 * fq) = make_uint2(pk_bf16(v[0], v[1]), pk_bf16(v[2], v[3])); }
        asm volatile("" ::: "memory");
      }
    asm volatile("s_waitcnt lgkmcnt(0)" ::: "memory"); __builtin_amdgcn_s_barrier(); asm volatile("" ::: "memory");
  }
};


__device__ __forceinline__ void phase_moba2(const Params& p, int l, unsigned char* lds, int* uq) {
  constexpr int OLD = 260;
  bf16_t* Qs = (bf16_t*)lds;
  float* Oaccf = (float*)(lds + 32768);
  float* laccf = (float*)(lds + 32768 + 64 * OLD * 4);
  float* kms = laccf + 256;
  float* gat = kms + 1024;
  unsigned char* lists = (unsigned char*)(gat + 4096);
  int* cnt = (int*)(lists + 4096);
  int* items = cnt + 16;
  int* ctr = items + 160;
  unsigned* selp = (unsigned*)(ctr + 4);
  float* bq = (float*)(selp + 256);
  int* Oacc = (int*)Oaccf; int* lacc = (int*)laccf;
  float kmax = 0.f;
  { const float* gk = p.inp(13) + l * 64;
    for (int d = 0; d < 64; ++d) kmax = fmaxf(kmax, fabsf(gk[d]));
    kmax *= 8.0f * 1.01f; }
  for (;;) {
    const int u = q_pull(uq, NB * 8 * 16, (int*)(lds + 131072), threadIdx.x);
    if (u < 0) break;
    const int qblk = 15 - (u >> 6), bh = u & 63, b = bh >> 3, h = bh & 7;
    int tid = threadIdx.x; asm volatile("" : "+v"(tid));
    const int lane = tid & 63, wv = tid >> 6, n = lane & 31, hh = lane >> 5;
    __syncthreads();
    { const uint4* src = (const uint4*)(p.Qm() + ((size_t)bh * S + qblk * 256) * 64);
      uint4* dst = (uint4*)Qs;
      for (int i = tid; i < 256 * 64 * 2 / 16; i += NTHR) dst[i] = src[i]; }
    for (int i = tid; i < qblk * 64; i += NTHR) kms[i] = p.kmean()[(size_t)bh * 1024 + i];
    for (int i = tid; i < 64 * OLD; i += NTHR) Oacc[i] = 0;
    if (tid < 256) lacc[tid] = 0;
    if (tid < 16) cnt[tid] = 0;
    __syncthreads();
    { const int q = tid & 255, par = tid >> 8;
      float qv[64];
#pragma unroll
      for (int c = 0; c < 8; ++c) {
        uint4 w = *(const uint4*)(Qs + q * 64 + c * 8);
        qv[c * 8 + 0] = __uint_as_float(w.x << 16); qv[c * 8 + 1] = __uint_as_float(w.x & 0xffff0000u);
        qv[c * 8 + 2] = __uint_as_float(w.y << 16); qv[c * 8 + 3] = __uint_as_float(w.y & 0xffff0000u);
        qv[c * 8 + 4] = __uint_as_float(w.z << 16); qv[c * 8 + 5] = __uint_as_float(w.z & 0xffff0000u);
        qv[c * 8 + 6] = __uint_as_float(w.w << 16); qv[c * 8 + 7] = __uint_as_float(w.w & 0xffff0000u);
      }
      if (par == 0) { float qq = 0.f;
#pragma unroll
        for (int d = 0; d < 64; ++d) qq = fmaf(qv[d], qv[d], qq);
        bq[q] = sqrtf(qq) * kmax; }
      for (int j = par; j < qblk; j += 2) {
        float g = 0.f;
#pragma unroll
        for (int d = 0; d < 64; ++d) g = fmaf(qv[d], kms[j * 64 + d], g);
        gat[q * 16 + j] = g;
      }
    }
    __syncthreads();
    if (tid < 256) {
      float b0 = -INFINITY, b1 = -INFINITY, b2 = -INFINITY; int i0 = 0, i1 = 0, i2 = 0;
      for (int j = 0; j < qblk; ++j) {
        float g = gat[tid * 16 + j];
        if (g > b0) { b2 = b1; i2 = i1; b1 = b0; i1 = i0; b0 = g; i0 = j; }
        else if (g > b1) { b2 = b1; i2 = i1; b1 = g; i1 = j; }
        else if (g > b2) { b2 = g; i2 = j; }
      }
      const int nsel = qblk < 3 ? qblk : 3;
      selp[tid] = (unsigned)i0 | ((unsigned)i1 << 4) | ((unsigned)i2 << 8) | ((unsigned)nsel << 12);
    }
    __syncthreads();
    for (int j = wv; j < qblk; j += 8) {
      int base = 0;
      for (int c = 0; c < 4; ++c) {
        const int q = c * 64 + lane;
        const unsigned sp = selp[q];
        const int ns = sp >> 12;
        const bool f = (ns > 0 && (int)(sp & 15) == j) || (ns > 1 && (int)((sp >> 4) & 15) == j) || (ns > 2 && (int)((sp >> 8) & 15) == j);
        const unsigned long long bal = __ballot(f);
        const int pos = base + __popcll(bal & ((1ull << lane) - 1ull));
        if (f) lists[j * 256 + pos] = (unsigned char)q;
        base += __popcll(bal);
      }
      if (lane == 0) cnt[j] = base;
    }
    __syncthreads();
    if (tid == 0) {
      int ni = 0;
#pragma unroll 1
      for (int g = 7; g >= 0; --g) items[ni++] = (16 << 8) | g;
      for (int j = 0; j < qblk; ++j) { const int ng = (cnt[j] + 31) >> 5; for (int g = 0; g < ng; ++g) items[ni++] = (j << 8) | g; }
      ctr[0] = ni; ctr[1] = 0;
    }
    __syncthreads();
    const int nitems = ctr[0];
    DUP(11) {
    if (rep_ > 0) { __syncthreads(); if (tid == 0) ctr[1] = 0; __syncthreads(); }
    for (;;) {
      int it = 0;
      if (lane == 0) it = atomicAdd(&ctr[1], 1);
      it = __builtin_amdgcn_readfirstlane(it);
      if (it >= nitems) break;
      const int item = items[it];
      const int j = item >> 8, g = item & 255;
      const bool own = (j == 16);
      const int kb = own ? qblk : j;
      const int ntile = own ? (g + 1) : 8;
      int qi; bool valid;
      if (own) { qi = g * 32 + n; valid = true; }
      else { const int pos = g * 32 + n; valid = pos < cnt[j]; qi = lists[j * 256 + (valid ? pos : 0)]; }
      const bf16_t* kt0 = p.Km() + ((size_t)bh * (S / 32) + kb * 8) * 2048 + lane * 8;
      const bf16_t* vt0 = p.Vm() + ((size_t)bh * (S / 32) + kb * 8) * 2048 + lane * 8;
      f32x16 O0, O1;
#pragma unroll
      for (int r = 0; r < 16; ++r) { O0[r] = 0.f; O1[r] = 0.f; }
      float lsum = 0.f;
      const float nbq = -bq[qi];
      bf16x8 kf[3][4], vf[3][4];
#define MOBA_LOAD(KT_, BUF_) { _Pragma("unroll") for (int s = 0; s < 4; ++s) { kf[BUF_][s] = *(const bf16x8*)(kt0 + (size_t)(KT_) * 2048 + s * 512); vf[BUF_][s] = *(const bf16x8*)(vt0 + (size_t)(KT_) * 2048 + s * 512); } }
#define MOBA_STEP(KT_, BUF_)                                                                                                           \
      if ((KT_) < ntile) {                                                                                                               \
        if ((KT_) + 2 < ntile) MOBA_LOAD((KT_) + 2, ((BUF_) + 2) % 3)                                                                     \
        f32x16 X;                                                                                                                         \
        _Pragma("unroll") for (int r = 0; r < 16; ++r) X[r] = nbq;                                                                        \
        _Pragma("unroll") for (int s = 0; s < 4; ++s) X = __builtin_amdgcn_mfma_f32_32x32x16_bf16(kf[BUF_][s], *(const bf16x8*)(Qs + qi * 64 + (2 * s + hh) * 8), X, 0, 0, 0);     \
        const bool diag = own && ((KT_) == g);                                                                                            \
        unsigned pw[8];                                                                                                                   \
        _Pragma("unroll") for (int r = 0; r < 16; r += 2) {                                                                               \
          float e0 = __builtin_amdgcn_exp2f(X[r]), e1 = __builtin_amdgcn_exp2f(X[r + 1]);                                                 \
          if (diag) {                                                                                                                     \
            const int k0 = (r & 3) + 8 * (r >> 2) + 4 * hh, k1 = ((r + 1) & 3) + 8 * ((r + 1) >> 2) + 4 * hh;                             \
            e0 = (k0 <= n) ? e0 : 0.f; e1 = (k1 <= n) ? e1 : 0.f;                                                                         \
          }                                                                                                                               \
          lsum += e0 + e1;                                                                                                                \
          pw[r >> 1] = pk_bf16(e0, e1);                                                                                                   \
        }                                                                                                                                 \
        bf16x8 pf0, pf1;                                                                                                                  \
        { uint4 t0 = make_uint4(pw[0], pw[1], pw[2], pw[3]), t1 = make_uint4(pw[4], pw[5], pw[6], pw[7]);                                 \
          pf0 = *(bf16x8*)&t0; pf1 = *(bf16x8*)&t1; }                                                                                     \
        O0 = __builtin_amdgcn_mfma_f32_32x32x16_bf16(vf[BUF_][0], pf0, O0, 0, 0, 0);                                                      \
        O0 = __builtin_amdgcn_mfma_f32_32x32x16_bf16(vf[BUF_][1], pf1, O0, 0, 0, 0);                                                      \
        O1 = __builtin_amdgcn_mfma_f32_32x32x16_bf16(vf[BUF_][2], pf0, O1, 0, 0, 0);                                                      \
        O1 = __builtin_amdgcn_mfma_f32_32x32x16_bf16(vf[BUF_][3], pf1, O1, 0, 0, 0);                                                      \
      }
      MOBA_LOAD(0, 0)
      if (ntile > 1) MOBA_LOAD(1, 1)
#pragma unroll 1
      for (int kt3 = 0; kt3 < ntile; kt3 += 3) {
        MOBA_STEP(kt3, 0) MOBA_STEP(kt3 + 1, 1) MOBA_STEP(kt3 + 2, 2)
      }
#undef MOBA_STEP
#undef MOBA_LOAD
      lsum += __shfl_xor(lsum, 32);
      if (valid) {
        if (hh == 0) atomicAdd(&lacc[qi], __float2int_rn(lsum * 1048576.0f));
#pragma unroll
        for (int r = 0; r < 16; ++r) {
          const int dim = (r & 3) + 8 * (r >> 2) + 4 * hh;
          atomicAdd(&Oacc[dim * OLD + qi], __float2int_rn(O0[r] * 1048576.0f));
          atomicAdd(&Oacc[(dim + 32) * OLD + qi], __float2int_rn(O1[r] * 1048576.0f));
        }
      }
    }
    }
    __syncthreads();
    { const int q = tid >> 1, half = tid & 1;
      const float inv = 1.0f / (float)lacc[q];
      float o[32], ss = 0.f;
#pragma unroll
      for (int d = 0; d < 32; ++d) { o[d] = (float)Oacc[(half * 32 + d) * OLD + q] * inv; ss += o[d] * o[d]; }
      ss += __shfl_xor(ss, 1);
      const float r = rsqrtf(ss / 64.0f + EPS);
      bf16_t* dst = p.xb() + (size_t)(b * S + qblk * 256 + q) * KD + 256 + h * 64 + half * 32;
#pragma unroll
      for (int d = 0; d < 32; d += 8) *(uint4*)(dst + d) = make_uint4(pk_bf16(o[d] * r, o[d + 1] * r), pk_bf16(o[d + 2] * r, o[d + 3] * r), pk_bf16(o[d + 4] * r, o[d + 5] * r), pk_bf16(o[d + 6] * r, o[d + 7] * r));
    }
  }
}


__device__ __forceinline__ void phase_ret_kv(const Params& p, int gw, int ngw, int lane) {
  const int n = lane & 31, hh = lane >> 5;
  for (int w = gw; w < NB * 4 * 32; w += ngw) {
    const int bh = w >> 5, cn = w & 31;
    const bf16_t* vt = p.Vr() + ((size_t)bh * (S / 32) + cn * 4) * 2048 + lane * 8;
    const bf16_t* kt = p.Krv() + ((size_t)bh * (S / 32) + cn * 4) * 2048 + lane * 8;
    f32x16 acc[2][2];
#pragma unroll
    for (int a = 0; a < 2; ++a)
#pragma unroll
      for (int b2 = 0; b2 < 2; ++b2)
#pragma unroll
        for (int r = 0; r < 16; ++r) acc[a][b2][r] = 0.f;
#pragma unroll 1
    for (int tl = 0; tl < 4; ++tl)
#pragma unroll
      for (int ks = 0; ks < 2; ++ks) {
        bf16x8 vf[2], kf[2];
#pragma unroll
        for (int x = 0; x < 2; ++x) { vf[x] = *(const bf16x8*)(vt + tl * 2048 + (x * 2 + ks) * 512); kf[x] = *(const bf16x8*)(kt + tl * 2048 + (x * 2 + ks) * 512); }
#pragma unroll
        for (int mb = 0; mb < 2; ++mb)
#pragma unroll
          for (int nb = 0; nb < 2; ++nb) acc[mb][nb] = __builtin_amdgcn_mfma_f32_32x32x16_bf16(vf[mb], kf[nb], acc[mb][nb], 0, 0, 0);
      }
    float* dst = p.KVr() + ((size_t)bh * 32 + cn) * 4096;
#pragma unroll
    for (int mb = 0; mb < 2; ++mb)
#pragma unroll
      for (int nb = 0; nb < 2; ++nb)
#pragma unroll
        for (int r = 0; r < 16; ++r) dst[(mb * 32 + (r & 3) + 8 * (r >> 2) + 4 * hh) * 64 + nb * 32 + n] = acc[mb][nb][r];
  }
}
__device__ __forceinline__ void phase_ret_scan(const Params& p, int gtid, int ngt) {
  for (int it = gtid; it < NB * 4 * 4096; it += ngt) {
    const int e = it & 4095, bh = it >> 12, h = bh & 3;
    const float l2g = ret_log2g(h), g1 = exp2f(l2g), g127 = exp2f(127.0f * l2g), g128 = exp2f(128.0f * l2g);
    float R = 0.f; float kv[32];
#pragma unroll
    for (int cn = 0; cn < 32; ++cn) kv[cn] = p.KVr()[((size_t)bh * 32 + cn) * 4096 + e];
#pragma unroll
    for (int cn = 0; cn < 32; ++cn) {
      p.Rb()[((size_t)bh * 32 + cn) * 4096 + e] = f2bf(g1 * R);
      R = g128 * R + g127 * kv[cn];
    }
  }
}
__device__ __forceinline__ void phase_ret_out(const Params& p, int gw, int ngw, int lane) {
  const int n = lane & 31, hh = lane >> 5;
  for (int w = gw; w < NB * 4 * 32 * 4; w += ngw) {
    const int qg = 3 - (w & 3), cn = (w >> 2) & 31, bh = w >> 7, b = bh >> 2, h = bh & 3;
    const int s0 = cn * 128 + qg * 32;
    bf16x8 qf[4];
#pragma unroll
    for (int s = 0; s < 4; ++s) qf[s] = *(const bf16x8*)(p.Qr() + ((size_t)bh * S + s0 + n) * 64 + (2 * s + hh) * 8);
    f32x16 O0, O1;
#pragma unroll
    for (int r = 0; r < 16; ++r) { O0[r] = 0.f; O1[r] = 0.f; }
    { const bf16_t* rb = p.Rb() + ((size_t)bh * 32 + cn) * 4096 + (size_t)n * 64 + hh * 8;
#pragma unroll
      for (int s = 0; s < 4; ++s) {
        const bf16x8 r0 = *(const bf16x8*)(rb + s * 16), r1 = *(const bf16x8*)(rb + 32 * 64 + s * 16);
        O0 = __builtin_amdgcn_mfma_f32_32x32x16_bf16(r0, qf[s], O0, 0, 0, 0);
        O1 = __builtin_amdgcn_mfma_f32_32x32x16_bf16(r1, qf[s], O1, 0, 0, 0);
      } }
    const bf16_t* kt0 = p.Kr() + ((size_t)bh * (S / 32) + cn * 4) * 2048 + lane * 8;
    const bf16_t* vt0 = p.Vr() + ((size_t)bh * (S / 32) + cn * 4) * 2048 + lane * 8;
    for (int kt = 0; kt <= qg; ++kt) {
      bf16x8 kf[4], vf[4];
#pragma unroll
      for (int s = 0; s < 4; ++s) { kf[s] = *(const bf16x8*)(kt0 + (size_t)kt * 2048 + s * 512); vf[s] = *(const bf16x8*)(vt0 + (size_t)kt * 2048 + s * 512); }
      f32x16 X;
#pragma unroll
      for (int r = 0; r < 16; ++r) X[r] = 0.f;
#pragma unroll
      for (int s = 0; s < 4; ++s) X = __builtin_amdgcn_mfma_f32_32x32x16_bf16(kf[s], qf[s], X, 0, 0, 0);
      const bool diag = (kt == qg);
      unsigned pw[8];
#pragma unroll
      for (int r = 0; r < 16; r += 2) {
        float e0 = X[r], e1 = X[r + 1];
        if (diag) {
          const int k0 = (r & 3) + 8 * (r >> 2) + 4 * hh, k1 = ((r + 1) & 3) + 8 * ((r + 1) >> 2) + 4 * hh;
          e0 = (k0 <= n) ? e0 : 0.f; e1 = (k1 <= n) ? e1 : 0.f;
        }
        pw[r >> 1] = pk_bf16(e0, e1);
      }
      bf16x8 pf0, pf1;
      { uint4 t0 = make_uint4(pw[0], pw[1], pw[2], pw[3]), t1 = make_uint4(pw[4], pw[5], pw[6], pw[7]);
        pf0 = *(bf16x8*)&t0; pf1 = *(bf16x8*)&t1; }
      O0 = __builtin_amdgcn_mfma_f32_32x32x16_bf16(vf[0], pf0, O0, 0, 0, 0);
      O0 = __builtin_amdgcn_mfma_f32_32x32x16_bf16(vf[1], pf1, O0, 0, 0, 0);
      O1 = __builtin_amdgcn_mfma_f32_32x32x16_bf16(vf[2], pf0, O1, 0, 0, 0);
      O1 = __builtin_amdgcn_mfma_f32_32x32x16_bf16(vf[3], pf1, O1, 0, 0, 0);
    }
    float ss = 0.f;
#pragma unroll
    for (int r = 0; r < 16; ++r) ss += O0[r] * O0[r] + O1[r] * O1[r];
    ss += __shfl_xor(ss, 32);
    const float rn = rsqrtf(ss / 64.0f + EPS);
    const size_t t = (size_t)b * S + s0 + n;
    const bf16_t* gp = p.grow() + t * 256 + h * 64;
    bf16_t* yo = p.xb() + t * KD + 768 + h * 64;
#pragma unroll
    for (int q4 = 0; q4 < 4; ++q4) {
#pragma unroll
      for (int mb = 0; mb < 2; ++mb) {
        const int d0 = mb * 32 + 8 * q4 + 4 * hh;
        const uint2 gw2 = *(const uint2*)(gp + d0); const float4 g = make_float4(__uint_as_float(gw2.x << 16), __uint_as_float(gw2.x & 0xffff0000u), __uint_as_float(gw2.y << 16), __uint_as_float(gw2.y & 0xffff0000u));
        float4 o;
        const f32x16& Oa = mb ? O1 : O0;
        o.x = Oa[q4 * 4 + 0] * rn * g.x * fast_sigmoid(g.x); o.y = Oa[q4 * 4 + 1] * rn * g.y * fast_sigmoid(g.y);
        o.z = Oa[q4 * 4 + 2] * rn * g.z * fast_sigmoid(g.z); o.w = Oa[q4 * 4 + 3] * rn * g.w * fast_sigmoid(g.w);
        *(uint2*)(yo + d0) = make_uint2(pk_bf16(o.x, o.y), pk_bf16(o.z, o.w));
      }
    }
  }
}

__device__ __forceinline__ void phase_post_pack(const Params& p, int gtid, int ngt) {
  for (int idx = gtid; idx < NB * 8 * (S / 32) * 256; idx += ngt) {
    const int ln = idx & 63, ks = (idx >> 6) & 1, mb = (idx >> 7) & 1, tile = (idx >> 8) % (S / 32), bh = idx / (256 * (S / 32));
    const int b = bh >> 3, h = bh & 7, hh = ln >> 5, delta = mb * 32 + (ln & 31);
    bf16_t v[8];
#pragma unroll
    for (int j = 0; j < 8; ++j) { const int kappa = 16 * ks + 8 * (j >> 2) + 4 * hh + (j & 3), s = tile * 32 + kappa; v[j] = p.vrow()[(size_t)(b * S + s) * 512 + h * 64 + delta]; }
    *(uint4*)(p.Vm() + (size_t)idx * 8) = make_uint4(v[0] | ((unsigned)v[1] << 16), v[2] | ((unsigned)v[3] << 16), v[4] | ((unsigned)v[5] << 16), v[6] | ((unsigned)v[7] << 16));
  }
  for (int idx = gtid; idx < 2 * NB * 4 * (S / 32) * 256; idx += ngt) {
    const int ln = idx & 63, ks = (idx >> 6) & 1, blk = (idx >> 7) & 1, tile = (idx >> 8) % (S / 32), rest = idx / (256 * (S / 32)), bh = rest % (NB * 4), which = rest / (NB * 4);
    const int b = bh >> 2, h = bh & 3, hh = ln >> 5, delta = blk * 32 + (ln & 31);
    const bf16_t* srcp = which ? p.krow() : p.vrrow();
    bf16_t v[8];
#pragma unroll
    for (int j = 0; j < 8; ++j) { const int kappa = 16 * ks + 8 * (j >> 2) + 4 * hh + (j & 3), s = tile * 32 + kappa; v[j] = srcp[(size_t)(b * S + s) * 256 + h * 64 + delta]; }
    *(uint4*)((which ? p.Krv() : p.Vr()) + ((size_t)(idx % (NB * 4 * (S / 32) * 256))) * 8) = make_uint4(v[0] | ((unsigned)v[1] << 16), v[2] | ((unsigned)v[3] << 16), v[4] | ((unsigned)v[5] << 16), v[6] | ((unsigned)v[7] << 16));
  }
}
__device__ __forceinline__ void phase_kmean2(const Params& p, int gtid, int ngt) {
  for (int idx = gtid; idx < NB * 8 * 16 * 64; idx += ngt) {
    const int d = idx & 63, j = (idx >> 6) & 15, bh = idx >> 10, c = d >> 3, dj = d & 7;
    float acc = 0.f;
    for (int tl = 0; tl < 8; ++tl) {
      const bf16_t* kp = p.Km() + (((size_t)bh * (S / 32) + j * 8 + tl) * 8 + c) * 256 + dj;
#pragma unroll 8
      for (int key = 0; key < 32; ++key) acc += bf2f(kp[key * 8]);
    }
    p.kmean()[idx] = acc * (1.0f / 256.0f);
  }
}

__device__ __forceinline__ void cvt_f32_bf16(const float* __restrict__ src, bf16_t* __restrict__ dst, size_t n8, int gtid, int ngt) {
  for (size_t i = gtid; i < n8; i += ngt) {
    float4 a = *(const float4*)(src + i * 8), b4 = *(const float4*)(src + i * 8 + 4);
    uint4 o; o.x = pk_bf16(a.x, a.y); o.y = pk_bf16(a.z, a.w); o.z = pk_bf16(b4.x, b4.y); o.w = pk_bf16(b4.z, b4.w);
    *(uint4*)(dst + i * 8) = o;
  }
}
__device__ __forceinline__ int f2key(float f) { int b = __float_as_int(f); return b ^ ((b >> 31) & 0x7fffffff); }
__device__ __forceinline__ float key2f(int k) { return __int_as_float(k ^ ((k >> 31) & 0x7fffffff)); }
#define CASD(a_, b_) { int mx_ = max(a_, b_), mn_ = min(a_, b_); a_ = mx_; b_ = mn_; }
__device__ __forceinline__ void sort16_desc(int (&v)[16]) {
#pragma unroll
  for (int k = 2; k <= 16; k <<= 1)
#pragma unroll
    for (int j = k >> 1; j > 0; j >>= 1)
#pragma unroll
      for (int i = 0; i < 16; ++i) { const int l2 = i ^ j; if (l2 > i) { if ((i & k) == 0) CASD(v[i], v[l2]) else CASD(v[l2], v[i]) } }
}
__device__ __forceinline__ void merge_top16(int (&a)[16], const int (&b)[16]) {
#pragma unroll
  for (int i = 0; i < 16; ++i) a[i] = max(a[i], b[15 - i]);
#pragma unroll
  for (int j = 8; j > 0; j >>= 1)
#pragma unroll
    for (int i = 0; i < 16; ++i) { const int l2 = i ^ j; if (l2 > i) CASD(a[i], a[l2]) }
}
__device__ __forceinline__ int lut4(int w0, int w1, int w2, int w3, int i) {
  const int w = i >> 2; const int d = (w == 0) ? w0 : (w == 1) ? w1 : (w == 2) ? w2 : w3;
  return (d >> ((i & 3) * 8)) & 127;
}

__device__ __forceinline__ void phase_peer_topk(const Params& p, int l, int gw, int ngw, int lane) {
  const int n = lane & 31, hh = lane >> 5;
  const bf16_t* skl = p.skb() + (size_t)l * 16 * 128 * 64;
  for (int w = gw; w < (T / 32) * 8; w += ngw) {
    const int tg = w >> 3, h = w & 7, t = tg * 32 + n;
    int L0[16], L1[16];
#pragma unroll
    for (int c = 0; c < 2; ++c) {
      const int hc = 2 * h + c;
      bf16x8 qf[4];
#pragma unroll
      for (int s = 0; s < 4; ++s) qf[s] = *(const bf16x8*)(p.qb() + (size_t)t * D + hc * 64 + 16 * s + 8 * hh);
      int A[16], Bq[16];
#pragma unroll
      for (int mb = 0; mb < 4; ++mb) {
        f32x16 X;
#pragma unroll
        for (int r = 0; r < 16; ++r) X[r] = 0.f;
#pragma unroll
        for (int s = 0; s < 4; ++s) {
          const bf16x8 kf = *(const bf16x8*)(skl + ((size_t)(hc * 128 + mb * 32 + n)) * 64 + 16 * s + 8 * hh);
          X = __builtin_amdgcn_mfma_f32_32x32x16_bf16(kf, qf[s], X, 0, 0, 0);
        }
        int Gk[16];
#pragma unroll
        for (int r = 0; r < 16; ++r) Gk[r] = (f2key(X[r]) & ~127) | (mb * 32 + (r & 3) + 8 * (r >> 2) + 4 * hh);
        sort16_desc(Gk);
        if (mb == 0) {
#pragma unroll
          for (int r = 0; r < 16; ++r) A[r] = Gk[r];
        } else merge_top16(A, Gk);
      }
#pragma unroll
      for (int r = 0; r < 16; ++r) Bq[r] = __shfl_xor(A[r], 32);
      merge_top16(A, Bq);
#pragma unroll
      for (int r = 0; r < 16; ++r) { if (c == 0) L0[r] = A[r]; else L1[r] = A[r]; }
    }
    float av[16], bv[16];
#pragma unroll
    for (int r = 0; r < 16; ++r) { av[r] = key2f(L0[r] & ~127); bv[r] = key2f(L1[r] & ~127); }
#define CAND(i_, j_) ((f2key(av[i_] + bv[j_]) & ~255) | ((i_) << 4) | (j_))
    int R[16], G1[16], G2[16];
#pragma unroll
    for (int j = 0; j < 16; ++j) R[j] = CAND(0, j);
    G1[0] = CAND(1, 0); G1[1] = CAND(1, 1); G1[2] = CAND(1, 2); G1[3] = CAND(1, 3); G1[4] = CAND(1, 4); G1[5] = CAND(1, 5); G1[6] = CAND(1, 6); G1[7] = CAND(1, 7);
    G1[8] = CAND(2, 0); G1[9] = CAND(2, 1); G1[10] = CAND(2, 2); G1[11] = CAND(2, 3); G1[12] = CAND(2, 4); G1[13] = CAND(3, 0); G1[14] = CAND(3, 1); G1[15] = CAND(3, 2);
    G2[0] = CAND(3, 3); G2[1] = CAND(4, 0); G2[2] = CAND(4, 1); G2[3] = CAND(4, 2); G2[4] = CAND(5, 0); G2[5] = CAND(5, 1); G2[6] = CAND(6, 0); G2[7] = CAND(6, 1);
    G2[8] = CAND(7, 0); G2[9] = CAND(7, 1); G2[10] = CAND(8, 0); G2[11] = CAND(9, 0); G2[12] = CAND(10, 0); G2[13] = CAND(11, 0); G2[14] = CAND(12, 0); G2[15] = CAND(13, 0);
    sort16_desc(G1); merge_top16(R, G1);
    sort16_desc(G2); merge_top16(R, G2);
    { int x0 = CAND(14, 0), x1 = CAND(15, 0);
#pragma unroll
      for (int i = 0; i < 16; ++i) CASD(R[i], x0)
#pragma unroll
      for (int i = 0; i < 16; ++i) CASD(R[i], x1)
    }
#undef CAND
    int pa0 = 0, pa1 = 0, pa2 = 0, pa3 = 0, pb0 = 0, pb1 = 0, pb2 = 0, pb3 = 0;
#pragma unroll
    for (int q = 0; q < 4; ++q) {
      pa0 |= (L0[q] & 127) << (8 * q); pa1 |= (L0[4 + q] & 127) << (8 * q); pa2 |= (L0[8 + q] & 127) << (8 * q); pa3 |= (L0[12 + q] & 127) << (8 * q);
      pb0 |= (L1[q] & 127) << (8 * q); pb1 |= (L1[4 + q] & 127) << (8 * q); pb2 |= (L1[8 + q] & 127) << (8 * q); pb3 |= (L1[12 + q] & 127) << (8 * q);
    }
    float ev[16], sum = 0.f; int ei[16];
    const float mx = key2f(R[0] & ~255);
#pragma unroll
    for (int z = 0; z < 16; ++z) {
      const float v = key2f(R[z] & ~255);
      ev[z] = __expf(v - mx); sum += ev[z];
      const int pay = R[z] & 255;
      ei[z] = lut4(pa0, pa1, pa2, pa3, pay >> 4) * 128 + lut4(pb0, pb1, pb2, pb3, pay & 15);
    }
    const float inv = 1.0f / sum;
    if (hh == 0) {
      float* go = p.gates() + ((size_t)t * 8 + h) * 16; int* eo = p.eidx() + ((size_t)t * 8 + h) * 16;
#pragma unroll
      for (int z = 0; z < 16; z += 4) {
        *(float4*)(go + z) = make_float4(ev[z] * inv, ev[z + 1] * inv, ev[z + 2] * inv, ev[z + 3] * inv);
        *(int4*)(eo + z) = make_int4(ei[z], ei[z + 1], ei[z + 2], ei[z + 3]);
      }
    }
  }
}


typedef int v8i __attribute__((ext_vector_type(8)));
__device__ __forceinline__ unsigned xcc_id() { return (unsigned)__builtin_amdgcn_s_getreg((3 << 11) | 20) & 7u; }
__device__ __forceinline__ float pow2_scale(float amax) {
  if (!(amax > 0.f)) return 1.0f;
  const int e = (int)floorf(log2f(240.0f / amax));
  return exp2f((float)(e < 60 ? (e > -60 ? e : -60) : 60));
}
__device__ __forceinline__ unsigned pack4_fp8(float a, float b, float c, float d) {
  int v = __builtin_amdgcn_cvt_pk_fp8_f32(a, b, 0, false);
  v = __builtin_amdgcn_cvt_pk_fp8_f32(c, d, v, true);
  return (unsigned)v;
}
__device__ __forceinline__ void cvt_table_i8(const float* __restrict__ src, unsigned char* __restrict__ dst, float* __restrict__ scl, int gw, int ngw, int lane) {
  for (int e0 = gw; e0 < 16384; e0 += 2 * ngw) {
    float4 v[2][4];
#pragma unroll
    for (int u = 0; u < 2; ++u) { const int e = (e0 + u * ngw < 16384) ? e0 + u * ngw : e0;
#pragma unroll
      for (int k = 0; k < 4; ++k) v[u][k] = *(const float4*)(src + (size_t)e * D + k * 256 + lane * 4); }
#pragma unroll
    for (int u = 0; u < 2; ++u) {
      const int e = e0 + u * ngw;
      if (e < 16384) {
        float am = 0.f;
#pragma unroll
        for (int k = 0; k < 4; ++k) am = fmaxf(am, fmaxf(fmaxf(fabsf(v[u][k].x), fabsf(v[u][k].y)), fmaxf(fabsf(v[u][k].z), fabsf(v[u][k].w))));
        am = wave_max(am);
        const float s = am > 0.f ? 127.0f / am : 1.0f;
        if (lane == 0) scl[e] = s;
#pragma unroll
        for (int k = 0; k < 4; ++k) {
          const int slice = 2 * k + (lane >> 5), off = (lane & 31) * 4;
          const unsigned w = (unsigned)(__float2int_rn(v[u][k].x * s) & 255) | ((unsigned)(__float2int_rn(v[u][k].y * s) & 255) << 8) |
                             ((unsigned)(__float2int_rn(v[u][k].z * s) & 255) << 16) | ((unsigned)(__float2int_rn(v[u][k].w * s) & 255) << 24);
          *(unsigned*)(dst + ((size_t)slice * 16384 + e) * 128 + off) = w;
        }
      }
    }
  }
}
__device__ __forceinline__ void cvt_table_fp8(const float* __restrict__ src, unsigned char* __restrict__ dst, float* __restrict__ scl, int gw, int ngw, int lane) {
  for (int e0 = gw; e0 < 16384; e0 += 2 * ngw) {
    float4 v[2][4];
#pragma unroll
    for (int u = 0; u < 2; ++u) { const int e = (e0 + u * ngw < 16384) ? e0 + u * ngw : e0;
#pragma unroll
      for (int k = 0; k < 4; ++k) v[u][k] = *(const float4*)(src + (size_t)e * D + k * 256 + lane * 4); }
#pragma unroll
    for (int u = 0; u < 2; ++u) {
      const int e = e0 + u * ngw;
      if (e < 16384) {
        float am = 0.f;
#pragma unroll
        for (int k = 0; k < 4; ++k) am = fmaxf(am, fmaxf(fmaxf(fabsf(v[u][k].x), fabsf(v[u][k].y)), fmaxf(fabsf(v[u][k].z), fabsf(v[u][k].w))));
        am = wave_max(am);
        const float s = pow2_scale(am);
        if (lane == 0) scl[e] = s;
#pragma unroll
        for (int k = 0; k < 4; ++k) {
          const int slice = 2 * k + (lane >> 5), off = (lane & 31) * 4;
          *(unsigned*)(dst + ((size_t)slice * 16384 + e) * 128 + off) = pack4_fp8(v[u][k].x * s, v[u][k].y * s, v[u][k].z * s, v[u][k].w * s);
        }
      }
    }
  }
}
#define DPP_ADD(v_, ctrl_) ((v_) + __builtin_bit_cast(float, __builtin_amdgcn_update_dpp(0, __builtin_bit_cast(int, (v_)), (ctrl_), 0xF, 0xF, true)))
__device__ __forceinline__ float sum_xor16(float x) { float a = x, b = x; asm volatile("v_nop\n\tv_nop\n\tv_permlane16_swap_b32 %0, %1" : "+v"(a), "+v"(b)); return a + b; }
__device__ __forceinline__ float sum_xor32(float x) { float a = x, b = x; asm volatile("v_nop\n\tv_nop\n\tv_permlane32_swap_b32 %0, %1" : "+v"(a), "+v"(b)); return a + b; }
constexpr int PEER_TILE = 128;
__device__ __forceinline__ void phase_peer_u(const Params& p, int* heads, unsigned char* lds, int tid) {
  const int lane = tid & 63, wv = tid >> 6, r8 = lane >> 3, c8 = lane & 7;
  int* bc = (int*)lds;
  int* eW = (int*)(lds + 1024 + wv * 12288);
  bf16_t* hW = (bf16_t*)(lds + 1024 + wv * 12288 + 8192);
  const int myx = (int)xcc_id();
  for (int pass = 0; pass < 8; ++pass) {
    const int s = (myx + pass) & 7;
    const unsigned char* Us = p.U8s() + (size_t)s * 16384 * 128 + c8 * 16;
    for (;;) {
      const int item = q_pull(heads + s, T / PEER_TILE, bc, tid);
      if (item < 0) break;
      const int t0 = item * PEER_TILE + wv * 16;
      LDS_FENCE();
      { uint2 ev[16];
        const bf16_t* hsrc = p.hb() + ((size_t)s * T + t0) * 128 + lane * 8;
#pragma unroll
        for (int k = 0; k < 16; ++k) ev[k] = *(const uint2*)(p.eidx() + (size_t)(t0 + k) * 128 + lane * 2);
        const uint4 hq0 = *(const uint4*)(hsrc), hq1 = *(const uint4*)(hsrc + 512), hq2 = *(const uint4*)(hsrc + 1024), hq3 = *(const uint4*)(hsrc + 1536);
#pragma unroll
        for (int k = 0; k < 16; ++k) *(uint2*)(eW + k * 128 + lane * 2) = ev[k];
        *(uint4*)(hW + lane * 8) = hq0; *(uint4*)(hW + 512 + lane * 8) = hq1; *(uint4*)(hW + 1024 + lane * 8) = hq2; *(uint4*)(hW + 1536 + lane * 8) = hq3; }
      LDS_FENCE();
      uint4 R[4][8];
#define PEER_U_LOAD(M_, BUF_) { _Pragma("unroll") for (int eb = 0; eb < 8; ++eb) R[BUF_][eb] = *(const uint4*)(Us + (size_t)eW[(M_) * 64 + eb * 8 + r8] * 128); }
      if (!(PROBE_SKIP & 128)) { PEER_U_LOAD(0, 0) PEER_U_LOAD(1, 1) PEER_U_LOAD(2, 2) } else { _Pragma("unroll") for (int a_ = 0; a_ < 4; ++a_) _Pragma("unroll") for (int b_ = 0; b_ < 8; ++b_) R[a_][b_] = make_uint4(0u, 0u, 0u, 0u); }
      int hq[4]; float hinv = 0.f; float res0 = 0.f, res1 = 0.f;
#define PEER_U_LOADH(TOK_) { const bf16_t* hp = hW + (TOK_) * 128 + c8 * 16; const uint4 a = *(const uint4*)hp, b4 = *(const uint4*)(hp + 8); \
        const unsigned w8[8] = {a.x, a.y, a.z, a.w, b4.x, b4.y, b4.z, b4.w}; float hv[16]; float am = 0.f;                               \
        _Pragma("unroll") for (int z = 0; z < 8; ++z) { hv[2 * z] = __uint_as_float(w8[z] << 16); hv[2 * z + 1] = __uint_as_float(w8[z] & 0xffff0000u); \
          am = fmaxf(am, fmaxf(fabsf(hv[2 * z]), fabsf(hv[2 * z + 1]))); }                                                                \
        am = fmaxf(am, __builtin_bit_cast(float, __builtin_amdgcn_update_dpp(0, __builtin_bit_cast(int, am), 0xB1, 0xF, 0xF, true)));     \
        am = fmaxf(am, __builtin_bit_cast(float, __builtin_amdgcn_update_dpp(0, __builtin_bit_cast(int, am), 0x4E, 0xF, 0xF, true)));     \
        am = fmaxf(am, __builtin_bit_cast(float, __builtin_amdgcn_update_dpp(0, __builtin_bit_cast(int, am), 0x141, 0xF, 0xF, true)));    \
        const float hs = am > 0.f ? 127.0f / am : 1.0f; hinv = am > 0.f ? am * (1.0f / 127.0f) : 1.0f;                                    \
        _Pragma("unroll") for (int z = 0; z < 4; ++z) hq[z] = (__float2int_rn(hv[4 * z] * hs) & 255) | ((__float2int_rn(hv[4 * z + 1] * hs) & 255) << 8) | \
                                                               ((__float2int_rn(hv[4 * z + 2] * hs) & 255) << 16) | (__float2int_rn(hv[4 * z + 3] * hs) << 24); }
      PEER_U_LOADH(0)
#define PEER_U_HALF(M_, BUF_, HALF_)                                                                           \
      {                                                                                                                                   \
        if (!(PROBE_SKIP & 128)) { if ((M_) + 3 < 32) PEER_U_LOAD((M_) + 3, ((BUF_) + 3) & 3) }                                             \
        if (!(PROBE_SKIP & 128)) _Pragma("unroll") for (int eb = 0; eb < 8; ++eb) {                                                       \
          int di = __builtin_amdgcn_sdot4((int)R[BUF_][eb].x, hq[0], 0, false);                                                           \
          di = __builtin_amdgcn_sdot4((int)R[BUF_][eb].y, hq[1], di, false);                                                              \
          di = __builtin_amdgcn_sdot4((int)R[BUF_][eb].z, hq[2], di, false);                                                              \
          di = __builtin_amdgcn_sdot4((int)R[BUF_][eb].w, hq[3], di, false);                                                              \
          di += __builtin_amdgcn_update_dpp(0, di, 0xB1, 0xF, 0xF, true); di += __builtin_amdgcn_update_dpp(0, di, 0x4E, 0xF, 0xF, true);   \
          di += __builtin_amdgcn_update_dpp(0, di, 0x141, 0xF, 0xF, true);     \
          const float d = (float)di * hinv;                                                                                               \
          if ((HALF_) == 0) { if (c8 == eb) res0 = d; } else { if (c8 == eb) res1 = d; }                                                  \
        }                                                                                                                                 \
        if ((HALF_) == 1) {                                                                                                               \
          float* po = p.ppart() + ((size_t)s * T + t0 + ((M_) >> 1)) * 128;                                                               \
          po[c8 * 8 + r8] = res0; po[64 + c8 * 8 + r8] = res1;                                                                            \
          if ((M_) + 1 < 32) PEER_U_LOADH(((M_) >> 1) + 1)                                                                                \
        }                                                                                                                                 \
      }
#pragma unroll
      for (int m4 = 0; m4 < 32; m4 += 4) {
        PEER_U_HALF(m4, 0, 0) PEER_U_HALF(m4 + 1, 1, 1) PEER_U_HALF(m4 + 2, 2, 0) PEER_U_HALF(m4 + 3, 3, 1)
      }
#undef PEER_U_HALF
#undef PEER_U_LOADH
#undef PEER_U_LOAD
    }
  }
}
__device__ __forceinline__ void phase_peer_r(const Params& p, int gtid, int ngt) {
  for (int idx0 = gtid; idx0 < T * 128; idx0 += 4 * ngt) {
    float d[4]; int e[4]; float su_[4], sv_[4], g_[4]; bool ok[4];
#pragma unroll
    for (int u = 0; u < 4; ++u) { const int idx = idx0 + u * ngt; ok[u] = idx < T * 128; const int ix = ok[u] ? idx : 0;
      e[u] = p.eidx()[ix]; g_[u] = p.gates()[ix]; float a = 0.f;
#pragma unroll
      for (int s = 0; s < 8; ++s) a += p.ppart()[(size_t)s * T * 128 + ix];
      d[u] = a; }
#pragma unroll
    for (int u = 0; u < 4; ++u) { su_[u] = p.su()[e[u]]; sv_[u] = p.sv()[e[u]]; }
#pragma unroll
    for (int u = 0; u < 4; ++u) if (ok[u]) p.gates()[idx0 + u * ngt] = g_[u] * gelu_tanh(d[u] * p.rstd()[(idx0 + u * ngt) >> 7] / su_[u]) / sv_[u];
  }
}
__device__ __forceinline__ void phase_peer_v(const Params& p, int* heads, unsigned char* lds, int tid) {
  const int lane = tid & 63, wv = tid >> 6, r8 = lane >> 3, c8 = lane & 7;
  int* bc = (int*)lds;
  uint2* pW = (uint2*)(lds + 1024 + wv * 16384);
  const int myx = (int)xcc_id();
  for (int pass = 0; pass < 8; ++pass) {
    const int s = (myx + pass) & 7;
    const unsigned char* Vs = p.V8s() + (size_t)s * 16384 * 128 + c8 * 16;
    for (;;) {
      const int item = q_pull(heads + s, T / PEER_TILE, bc, tid);
      if (item < 0) break;
      const int t0 = item * PEER_TILE + wv * 16;
      LDS_FENCE();
      { uint2 e2[16], g2[16];
#pragma unroll
        for (int k = 0; k < 16; ++k) { e2[k] = *(const uint2*)(p.eidx() + (size_t)(t0 + k) * 128 + lane * 2); g2[k] = *(const uint2*)(p.gates() + (size_t)(t0 + k) * 128 + lane * 2); }
#pragma unroll
        for (int k = 0; k < 16; ++k) *(uint4*)(pW + k * 128 + lane * 2) = make_uint4(e2[k].x, g2[k].x, e2[k].y, g2[k].y); }
      LDS_FENCE();
      const int rowk = lane >> 4, prow = ((rowk & 1) << 1) | (rowk >> 1);
      const bool wr_lane = (lane & 8) == 0;
      const int xoff = s * 128 + c8 * 16 + prow * 4;
      float4 xo[8];
#pragma unroll
      for (int k = 0; k < 8; ++k) xo[k] = *(const float4*)(p.outp() + (size_t)(t0 + k) * D + xoff);
      uint4 R[3][8];
#define PEER_V_LOAD(M_, BUF_) { _Pragma("unroll") for (int eb = 0; eb < 8; ++eb) R[BUF_][eb] = *(const uint4*)(Vs + (size_t)pW[(M_) * 64 + eb * 8 + r8].x * 128); }
      if (!(PROBE_SKIP & 64)) { PEER_V_LOAD(0, 0) PEER_V_LOAD(1, 1) } else { _Pragma("unroll") for (int a_ = 0; a_ < 3; ++a_) _Pragma("unroll") for (int b_ = 0; b_ < 8; ++b_) R[a_][b_] = make_uint4(0u, 0u, 0u, 0u); }
      float acc[16];
#define PEER_V_HALF(M_, BUF_, HALF_)                                                           \
      {                                                                                                                                   \
        if (!(PROBE_SKIP & 64)) { if ((M_) + 2 < 32) PEER_V_LOAD((M_) + 2, ((BUF_) + 2) % 3) }                                              \
        if ((HALF_) == 0) { _Pragma("unroll") for (int z = 0; z < 16; ++z) acc[z] = 0.f; }                                                \
        if (!(PROBE_SKIP & 64)) _Pragma("unroll") for (int eb = 0; eb < 8; ++eb) {                                                        \
          const float c = __uint_as_float(pW[(M_) * 64 + eb * 8 + r8].y);                                                                 \
          const unsigned ww[4] = {R[BUF_][eb].x, R[BUF_][eb].y, R[BUF_][eb].z, R[BUF_][eb].w};                                            \
          _Pragma("unroll") for (int q4 = 0; q4 < 4; ++q4) {                                                                              \
            const auto f01 = __builtin_amdgcn_cvt_pk_f32_fp8((int)ww[q4], false); const auto f23 = __builtin_amdgcn_cvt_pk_f32_fp8((int)ww[q4], true); \
            acc[q4 * 4 + 0] = fmaf(c, f01[0], acc[q4 * 4 + 0]); acc[q4 * 4 + 1] = fmaf(c, f01[1], acc[q4 * 4 + 1]);                       \
            acc[q4 * 4 + 2] = fmaf(c, f23[0], acc[q4 * 4 + 2]); acc[q4 * 4 + 3] = fmaf(c, f23[1], acc[q4 * 4 + 3]);                       \
          }                                                                                                                               \
        }                                                                                                                                 \
        if ((HALF_) == 1) {                                                                                                               \
          _Pragma("unroll") for (int z = 0; z < 16; ++z) acc[z] = DPP_ADD(acc[z], 0x128);                                  \
          asm volatile("v_nop\n\tv_nop\n\tv_permlane16_swap_b32 %0, %8\n\tv_permlane16_swap_b32 %1, %9\n\tv_permlane16_swap_b32 %2, %10\n\tv_permlane16_swap_b32 %3, %11\n\t" \
                       "v_permlane16_swap_b32 %4, %12\n\tv_permlane16_swap_b32 %5, %13\n\tv_permlane16_swap_b32 %6, %14\n\tv_permlane16_swap_b32 %7, %15" \
            : "+v"(acc[0]), "+v"(acc[1]), "+v"(acc[2]), "+v"(acc[3]), "+v"(acc[4]), "+v"(acc[5]), "+v"(acc[6]), "+v"(acc[7]),                   \
              "+v"(acc[8]), "+v"(acc[9]), "+v"(acc[10]), "+v"(acc[11]), "+v"(acc[12]), "+v"(acc[13]), "+v"(acc[14]), "+v"(acc[15]));               \
          _Pragma("unroll") for (int z = 0; z < 8; ++z) acc[z] += acc[z + 8];            \
          asm volatile("v_nop\n\tv_nop\n\tv_permlane32_swap_b32 %0, %4\n\tv_permlane32_swap_b32 %1, %5\n\tv_permlane32_swap_b32 %2, %6\n\tv_permlane32_swap_b32 %3, %7" \
            : "+v"(acc[0]), "+v"(acc[1]), "+v"(acc[2]), "+v"(acc[3]), "+v"(acc[4]), "+v"(acc[5]), "+v"(acc[6]), "+v"(acc[7]));                   \
          float4 dl;                                                                                                                      \
          dl.x = acc[0] + acc[4]; dl.y = acc[1] + acc[5]; dl.z = acc[2] + acc[6]; dl.w = acc[3] + acc[7];     \
          const float4 xv = xo[((M_) >> 1) & 7];                                                                                          \
          if (((M_) >> 1) + 8 < 16) xo[((M_) >> 1) & 7] = *(const float4*)(p.outp() + (size_t)(t0 + ((M_) >> 1) + 8) * D + xoff);                  \
          const float4 xn = make_float4(xv.x + dl.x, xv.y + dl.y, xv.z + dl.z, xv.w + dl.w);                                              \
          float sq = 0.f;                                                                                                                 \
          if (wr_lane) {                                                                                                                  \
            *(float4*)(p.outp() + (size_t)(t0 + ((M_) >> 1)) * D + xoff) = xn;                                                             \
            *(uint2*)(p.xb() + (size_t)(t0 + ((M_) >> 1)) * KD + xoff) = make_uint2(pk_bf16(xn.x, xn.y), pk_bf16(xn.z, xn.w));     \
            sq = (xn.x * xn.x + xn.y * xn.y) + (xn.z * xn.z + xn.w * xn.w);                                                                \
          }                                                                                                                               \
          sq = DPP_ADD(sq, 0xB1); sq = DPP_ADD(sq, 0x4E); sq = DPP_ADD(sq, 0x141); sq = DPP_ADD(sq, 0x128); sq = sum_xor16(sq); sq = sum_xor32(sq);     \
          if (lane == 0) p.ssq1()[(size_t)(t0 + ((M_) >> 1)) * 8 + s] = sq;                                                               \
        }                                                                                                                                 \
      }
#pragma unroll
      for (int m6 = 0; m6 < 30; m6 += 6) {
        PEER_V_HALF(m6, 0, 0) PEER_V_HALF(m6 + 1, 1, 1) PEER_V_HALF(m6 + 2, 2, 0) PEER_V_HALF(m6 + 3, 0, 1) PEER_V_HALF(m6 + 4, 1, 0) PEER_V_HALF(m6 + 5, 2, 1)
      }
      PEER_V_HALF(30, 0, 0) PEER_V_HALF(31, 1, 1)
#undef PEER_V_HALF
#undef PEER_V_LOAD
    }
  }
}

#if PEER_CHECK
constexpr int CHK_N = 512;
__device__ __forceinline__ float* chk_x(const Params& p) { return (float*)(p.ws + WO_ybuf); }
__device__ __forceinline__ float* chk_m(const Params& p) { return (float*)(p.ws + WO_ybuf + (size_t)CHK_N * D * 4); }
__device__ __forceinline__ float* chk_g(const Params& p) { return (float*)(p.ws + WO_ybuf + (size_t)CHK_N * D * 4 + 4096); }
__device__ __forceinline__ void chk_save(const Params& p, int gtid, int ngt) {
  for (int i = gtid; i < CHK_N * D; i += ngt) chk_x(p)[i] = p.outp()[(size_t)(i / D) * 64 * D + (i % D)];
  for (int i = gtid; i < CHK_N * 128; i += ngt) chk_g(p)[i] = p.gates()[(size_t)(i / 128) * 64 * 128 + (i % 128)];
  if (gtid < 16) chk_m(p)[gtid] = 0.f;
}
__device__ __forceinline__ void chk_apply(const Params& p, int l, float* coef, int gw, int ngw, int lane) {
  const float* g2 = p.inp(16) + l * D;
  const float* U = p.inp(19) + (size_t)l * 16384 * D; const float* V = p.inp(20) + (size_t)l * 16384 * D;
  for (int i = gw; i < CHK_N; i += ngw) {
    const int t = i * 64;
    const float r = p.rstd()[t];
    float4 hv[4];
#pragma unroll
    for (int k = 0; k < 4; ++k) {
      float4 xv = *(const float4*)(chk_x(p) + (size_t)i * D + (lane + k * 64) * 4);
      float4 gv = *(const float4*)(g2 + (lane + k * 64) * 4);
      hv[k].x = xv.x * r * gv.x; hv[k].y = xv.y * r * gv.y; hv[k].z = xv.z * r * gv.z; hv[k].w = xv.w * r * gv.w;
    }
    LDS_FENCE();
    for (int j = 0; j < 128; ++j) {
      const int e = p.eidx()[(size_t)t * 128 + j];
      const float4* up = (const float4*)(U + (size_t)e * D);
      float dsum = 0.f;
#pragma unroll
      for (int k = 0; k < 4; ++k) { float4 uv = up[lane + k * 64]; dsum += hv[k].x * uv.x + hv[k].y * uv.y + hv[k].z * uv.z + hv[k].w * uv.w; }
      dsum = wave_sum(dsum);
      if (lane == 0) coef[j] = chk_g(p)[(size_t)i * 128 + j] * gelu_tanh(dsum);
    }
    LDS_FENCE();
    float4 acc[4];
#pragma unroll
    for (int k = 0; k < 4; ++k) acc[k] = make_float4(0.f, 0.f, 0.f, 0.f);
    for (int j = 0; j < 128; ++j) {
      const int e = p.eidx()[(size_t)t * 128 + j];
      const float c = coef[j];
      const float4* vp = (const float4*)(V + (size_t)e * D);
#pragma unroll
      for (int k = 0; k < 4; ++k) { float4 vv = vp[lane + k * 64]; acc[k].x = fmaf(c, vv.x, acc[k].x); acc[k].y = fmaf(c, vv.y, acc[k].y); acc[k].z = fmaf(c, vv.z, acc[k].z); acc[k].w = fmaf(c, vv.w, acc[k].w); }
    }
    float d2 = 0.f, r2 = 0.f;
#pragma unroll
    for (int k = 0; k < 4; ++k) {
      float4 xa = *(const float4*)(p.outp() + (size_t)t * D + (lane + k * 64) * 4);
      float4 xb4 = *(const float4*)(chk_x(p) + (size_t)i * D + (lane + k * 64) * 4);
      float e0 = (xa.x - xb4.x) - acc[k].x, e1 = (xa.y - xb4.y) - acc[k].y, e2 = (xa.z - xb4.z) - acc[k].z, e3 = (xa.w - xb4.w) - acc[k].w;
      d2 += e0 * e0 + e1 * e1 + e2 * e2 + e3 * e3;
      r2 += acc[k].x * acc[k].x + acc[k].y * acc[k].y + acc[k].z * acc[k].z + acc[k].w * acc[k].w;
    }
    d2 = wave_sum(d2); r2 = wave_sum(r2);
    if (lane == 0) { atomicAdd((unsigned long long*)&chk_m(p)[8], (unsigned long long)(d2 * 1099511627776.0f)); atomicAdd((unsigned long long*)&chk_m(p)[10], (unsigned long long)(r2 * 1099511627776.0f)); }
  }
}
__device__ __forceinline__ void chk_topk(const Params& p, int l, int gtid, int ngt) {
  const float* subk = p.inp(18) + (size_t)l * 16 * 128 * 64;
  for (int it = gtid; it < CHK_N * 8; it += ngt) {
    const int i = it >> 3, h = it & 7, t = i * 64;
    float tva[16], tvb[16]; int tia[16], tib[16];
#pragma unroll 1
    for (int c = 0; c < 2; ++c) {
      float tv[16]; int ti[16];
#pragma unroll
      for (int z = 0; z < 16; ++z) { tv[z] = -INFINITY; ti[z] = 0; }
      const bf16_t* q = p.qb() + (size_t)t * D + (2 * h + c) * 64;
      const float* kb = subk + (size_t)(2 * h + c) * 128 * 64;
#pragma unroll 1
      for (int n = 0; n < 128; ++n) {
        float sc = 0.f;
        for (int d = 0; d < 64; ++d) sc = fmaf(bf2f(q[d]), kb[n * 64 + d], sc);
        float v_ = sc; int i_ = n;
#pragma unroll
        for (int z = 0; z < 16; ++z) { bool gt = v_ > tv[z]; float a = tv[z]; int b = ti[z]; tv[z] = gt ? v_ : a; ti[z] = gt ? i_ : b; v_ = gt ? a : v_; i_ = gt ? b : i_; }
      }
#pragma unroll
      for (int z = 0; z < 16; ++z) { if (c == 0) { tva[z] = tv[z]; tia[z] = ti[z]; } else { tvb[z] = tv[z]; tib[z] = ti[z]; } }
    }
    float tv[16]; int ti[16];
#pragma unroll
    for (int z = 0; z < 16; ++z) { tv[z] = -INFINITY; ti[z] = 0; }
#pragma unroll 1
    for (int a = 0; a < 16; ++a)
#pragma unroll 1
      for (int b = 0; b < 16; ++b) {
        float av = 0.f, bv = 0.f; int ai = 0, bi = 0;
#pragma unroll
        for (int z = 0; z < 16; ++z) { if (z == a) { av = tva[z]; ai = tia[z]; } if (z == b) { bv = tvb[z]; bi = tib[z]; } }
        float v_ = av + bv; int i_ = ai * 128 + bi;
#pragma unroll
        for (int z = 0; z < 16; ++z) { bool gt = v_ > tv[z]; float x = tv[z]; int y = ti[z]; tv[z] = gt ? v_ : x; ti[z] = gt ? i_ : y; v_ = gt ? x : v_; i_ = gt ? y : i_; }
      }
    float sum = 0.f, ev[16];
#pragma unroll
    for (int z = 0; z < 16; ++z) { ev[z] = expf(tv[z] - tv[0]); sum += ev[z]; }
    int miss = 0; float gerr = 0.f;
    for (int z = 0; z < 16; ++z) {
      const int ef = p.eidx()[((size_t)t * 8 + h) * 16 + z]; const float gf = p.gates()[((size_t)t * 8 + h) * 16 + z];
      bool found = false;
#pragma unroll
      for (int y = 0; y < 16; ++y) if (ti[y] == ef) { found = true; gerr = fmaxf(gerr, fabsf(ev[y] / sum - gf)); }
      if (!found) ++miss;
    }
    atomicAdd(&chk_m(p)[3], (float)miss);
    atomicMax((int*)&chk_m(p)[4], __float_as_int(gerr));
  }
}
__device__ __forceinline__ void chk_emit(const Params& p) {
  float v = 0.f;
  if (PEER_CHECK == 1) v = sqrtf((float)((double)*(unsigned long long*)&chk_m(p)[8] / (double)*(unsigned long long*)&chk_m(p)[10]));
  if (PEER_CHECK == 2) v = chk_m(p)[3] / (float)(CHK_N * 8 * 16);
  if (PEER_CHECK == 3) v = chk_m(p)[4];
  p.outp()[0] += 1.0e4f * v + 100.0f;
}
#endif

#define XB_TMO      128
#define XB_XCNT(j)  (256  + 64 * (j))
#define XB_XSUB(j)  (1280 + 64 * (j))
#define XB_XGEN(j)  (2304 + 64 * (j))
#define XB_TOP      3328
#define XB_TOPGEN   3392
#define XCD_BAR_WORDS 3456
#define XB_SPIN_CAP (1u << 18)
#define LAS __attribute__((address_space(3)))

__device__ __forceinline__ unsigned xb_ld(unsigned* p)              { return __hip_atomic_load(p, __ATOMIC_RELAXED, __HIP_MEMORY_SCOPE_AGENT); }
__device__ __forceinline__ unsigned xb_add(unsigned* p, unsigned v) { return __hip_atomic_fetch_add(p, v, __ATOMIC_RELAXED, __HIP_MEMORY_SCOPE_AGENT); }
__device__ __forceinline__ unsigned xb_xcc_id() { return (unsigned)__builtin_amdgcn_s_getreg((3 << 11) | 20) & 0xFu; }
#define XB_SPIN(cond, bar) do { unsigned _sp = 0; while (cond) { __builtin_amdgcn_s_sleep(1); \
    if ((++_sp & 255u) == 0u) { if (xb_ld(&(bar)[XB_TMO])) break; if (_sp > XB_SPIN_CAP) { atomicAdd(&(bar)[XB_TMO], 1u); break; } } } } while (0)

struct XcdBarrier {
    unsigned* bar; unsigned x;
    volatile LAS unsigned* st;
};

__device__ __forceinline__ XcdBarrier xcd_barrier_post(unsigned* bar, volatile LAS unsigned* st) {
    XcdBarrier b; b.bar = bar; b.x = xb_xcc_id(); b.st = st;
    if (threadIdx.x == 0) (void)xb_add(&bar[XB_XCNT(b.x)], 1u);
    return b;
}
__device__ __forceinline__ void xcd_barrier_complete(unsigned* bar, unsigned x, unsigned& nloc, unsigned& nx) {
    const unsigned G = gridDim.x * gridDim.y * gridDim.z;
    unsigned sum, cnt, mine, sp = 0u;
    for (;;) {
        sum = 0u; cnt = 0u; mine = 0u;
#pragma unroll
        for (unsigned j = 0; j < 16; ++j) { const unsigned c = xb_ld(&bar[XB_XCNT(j)]); sum += c; cnt += (c > 0u) ? 1u : 0u; mine = (j == x) ? c : mine; }
        if (sum == G) break;
        __builtin_amdgcn_s_sleep(1);
        if ((++sp & 255u) == 0u) { if (xb_ld(&bar[XB_TMO])) break; if (sp > XB_SPIN_CAP) { atomicAdd(&bar[XB_TMO], 1u); break; } }
    }
    nloc = mine > 0u ? mine : 1u; nx = cnt > 0u ? cnt : 1u;
}

__device__ __forceinline__ void xcd_barrier(const XcdBarrier& b) {
    asm volatile("s_waitcnt vmcnt(0)" ::: "memory");
    __syncthreads();
    if (threadIdx.x == 0) {
        unsigned* bar = b.bar;
        __builtin_amdgcn_s_waitcnt(0);
        unsigned nloc = b.st[0], nx = b.st[1];
        if (nloc == 0u) { xcd_barrier_complete(bar, b.x, nloc, nx); b.st[0] = nloc; b.st[1] = nx; }
        const unsigned old = xb_add(&bar[XB_XSUB(b.x)], 1u);
        const unsigned gen = old / nloc;
        if (old + 1u == (gen + 1u) * nloc) {
            __builtin_amdgcn_fence(__ATOMIC_RELEASE, "agent");
            asm volatile("s_waitcnt vmcnt(0)" ::: "memory");
            const unsigned og = xb_add(&bar[XB_TOP], 1u);
            const unsigned tg = og / nx;
            if (og + 1u == (tg + 1u) * nx) xb_add(&bar[XB_TOPGEN], 1u);
            else XB_SPIN(xb_ld(&bar[XB_TOPGEN]) == tg, bar);
            __builtin_amdgcn_fence(__ATOMIC_ACQUIRE, "agent");
            xb_add(&bar[XB_XGEN(b.x)], 1u);
            asm volatile("s_waitcnt vmcnt(0)" ::: "memory");
        } else {
            XB_SPIN(xb_ld(&bar[XB_XGEN(b.x)]) == gen, bar);
            __builtin_amdgcn_fence(__ATOMIC_ACQUIRE, "agent");
            asm volatile("s_waitcnt vmcnt(0)" ::: "memory");
        }
    }
    __syncthreads();
}

__device__ __forceinline__ Params fresh(const Params& p) {
  Params q = p;
  asm volatile("" : "+s"(q.ws), "+s"(q.out_));
#pragma unroll
  for (int i = 0; i < 21; ++i) asm volatile("" : "+s"(q.in[i]));
  return q;
}
#define PHASE_IDS int tid = threadIdx.x; asm volatile("" : "+v"(tid)); int bid = blockIdx.x; asm volatile("" : "+s"(bid)); int G = gridDim.x; asm volatile("" : "+s"(G)); \
  const int lane = tid & 63, wv = tid >> 6; const int ngt = G * NTHR, ngw = G * NWAVE; \
  const int gtid = bid * NTHR + tid, gw = bid * NWAVE + wv; (void)lane; (void)wv; (void)gtid; (void)gw; (void)ngt; (void)ngw; \
  const Params q = fresh(p);
__global__ void __launch_bounds__(NTHR) mega(Params p) {
  extern __shared__ __attribute__((aligned(16))) unsigned char lds_raw[];
  cg::grid_group grid = cg::this_grid();
  float* ldsf = (float*)lds_raw;
  if (threadIdx.x == 0) { *(uint4*)(lds_raw + LDS_BYTES - 16) = make_uint4(0u, 0u, 0u, 0u); }
  __syncthreads();
  XcdBarrier xb = xcd_barrier_post(p.bar(), (volatile LAS unsigned*)(lds_raw + LDS_BYTES - 16));

  { PHASE_IDS; phase_prologue(q, gtid, ngt, gw, ngw, lane); cvt_f32_bf16(q.inp(18), q.skb(), (size_t)NL * 16 * 128 * 64 / 8, gtid, ngt);
    for (size_t i = gtid; i < (size_t)16 * 128 * 512 / 8; i += ngt) { const size_t g = i / (128 * 512 / 8), r = i % (128 * 512 / 8); ((uint4*)q.S5Wz())[g * (256 * 512 / 8) + (128 * 512 / 8) + r] = make_uint4(0u, 0u, 0u, 0u); }
    if (gtid < 256) q.qctr()[gtid] = 0;
    phase_s5_prep(q, 0, gtid, ngt); }
  grid.sync();
  { constexpr int l = 0;
    DUP(5) {
    { const Params q = fresh(p);
      EpiInProj e{q.ssq1(), q.S5A(), q.Qm(), q.Km(), q.vrow(), q.Qr(), q.Kr(), q.krow(), q.vrrow(), q.grow(),
                  q.inp(12) + l * 64, q.inp(13) + l * 64, q.cosm(), q.sinm(), q.cosr(), q.sinr()};
      run_gemm(lds_raw, q.xb(), q.Win_t() + (size_t)l * INW * KD, T, INW, KD, e); }
    xcd_barrier(xb);
    }
    DUP(1) {
    { PHASE_IDS; phase_post_pack(q, gtid, ngt); }
    { const Params q = fresh(p); EpiS5Z e{q.S5Z()};
      pg8::Gemm g{q.S5A(), q.S5Wz(), 16 * 1024, 16 * 256, 512, 640, 512}; pg8::GroupOrder So; So.init(16, 4, 1, (int)gridDim.x, (int)blockIdx.x);
      pg8::gemm_phase<EpiS5Z, pg8::GroupOrder, true, true>((PG8_LAS unsigned char*)lds_raw, g, So, e); }
    { PHASE_IDS; phase_kmean2(q, gtid, ngt); }
    xcd_barrier(xb);
    }
    DUP(2) {
    { PHASE_IDS; phase_s5_scan(q, gtid, ngt); phase_ret_kv(q, gw, ngw, lane); }
    __syncthreads();
    { PHASE_IDS; phase_moba2(q, l, lds_raw, q.qctr() + 64 + l); }
    xcd_barrier(xb);
    }
    DUP(3) {
    { const Params q = fresh(p); EpiS5Y e{q.ygb(), q.S5A(), q.inp(10) + l * 256};
      pg8::Gemm g{q.S5A(), q.S5Wy(), 16 * 1024, 16 * 512, 640, 640, 640}; pg8::GroupOrder So; So.init(16, 4, 2, (int)gridDim.x, (int)blockIdx.x);
      pg8::gemm_phase<EpiS5Y, pg8::GroupOrder, true, true>((PG8_LAS unsigned char*)lds_raw, g, So, e); }
    { PHASE_IDS; phase_ret_scan(q, gtid, ngt); }
    xcd_barrier(xb);
    }
    DUP(4) {
    { const Params q = fresh(p); EpiGlu e{q.xb(), q.ygb(), (float*)(lds_raw + 131072)};
      run_gemm(lds_raw, q.ygb(), q.Wglu_t() + (size_t)l * 65536, T, 256, 256, e); }
    { PHASE_IDS; phase_ret_out(q, gw, ngw, lane); }
    xcd_barrier(xb);
    }
    { PHASE_IDS; cvt_table_i8(q.inp(19) + (size_t)l * 16384 * D, q.U8s(), q.su(), gw, ngw, lane);
      cvt_table_fp8(q.inp(20) + (size_t)l * 16384 * D, q.V8s(), q.sv(), gw, ngw, lane); }
    __syncthreads();
    { const Params q = fresh(p); EpiResid e{q.outp(), D, q.xb2(), q.hb(), q.inp(16) + l * D, q.ssq2()};
      run_gemm(lds_raw, q.xb(), q.Wout_t() + (size_t)l * D * KD, T, D, KD, e); }
    xcd_barrier(xb);
    DUP(7) {
    { const Params q = fresh(p); EpiScaleStoreBf16 e{q.qb(), D, q.ssq2(), 16, q.rstd()};
      run_gemm(lds_raw, q.xb2(), q.Wq_t() + (size_t)l * D * KD, T, D, KD, e); }
    xcd_barrier(xb);
    }
    if (!(PROBE_SKIP & 2)) {
    DUP(8) {
    { PHASE_IDS; phase_peer_topk(q, l, gw, ngw, lane); }
    xcd_barrier(xb);
    }
    }
#if PEER_CHECK
    if (l == 0) { { PHASE_IDS; chk_save(q, gtid, ngt); } xcd_barrier(xb); { PHASE_IDS; chk_topk(q, l, gtid, ngt); } xcd_barrier(xb); }
#endif
    if (!(PROBE_SKIP & 1)) {
    { PHASE_IDS; phase_peer_u(q, q.qctr() + (l * 2 + 0) * 8, lds_raw, tid); }
    xcd_barrier(xb);
    { PHASE_IDS; phase_peer_r(q, gtid, ngt); if (l + 1 < NL) phase_s5_prep(q, l + 1, gtid, ngt); }
    xcd_barrier(xb);
    if (!(PROBE_SKIP & 32)) {
    { PHASE_IDS; phase_peer_v(q, q.qctr() + (l * 2 + 1) * 8, lds_raw, tid); }
    xcd_barrier(xb);
    }
    }
#if PEER_CHECK
    if (l == 0) { { PHASE_IDS; chk_apply(q, l, ldsf + wv * 128, gw, ngw, lane); } xcd_barrier(xb);
      if (blockIdx.x == 0 && threadIdx.x == 0) { const Params q = fresh(p); chk_emit(q); } xcd_barrier(xb); }
#endif
  }
  { constexpr int l = 1;
    DUP(5) {
    { const Params q = fresh(p);
      EpiInProj e{q.ssq1(), q.S5A(), q.Qm(), q.Km(), q.vrow(), q.Qr(), q.Kr(), q.krow(), q.vrrow(), q.grow(),
                  q.inp(12) + l * 64, q.inp(13) + l * 64, q.cosm(), q.sinm(), q.cosr(), q.sinr()};
      run_gemm(lds_raw, q.xb(), q.Win_t() + (size_t)l * INW * KD, T, INW, KD, e); }
    xcd_barrier(xb);
    }
    DUP(1) {
    { PHASE_IDS; phase_post_pack(q, gtid, ngt); }
    { const Params q = fresh(p); EpiS5Z e{q.S5Z()};
      pg8::Gemm g{q.S5A(), q.S5Wz(), 16 * 1024, 16 * 256, 512, 640, 512}; pg8::GroupOrder So; So.init(16, 4, 1, (int)gridDim.x, (int)blockIdx.x);
      pg8::gemm_phase<EpiS5Z, pg8::GroupOrder, true, true>((PG8_LAS unsigned char*)lds_raw, g, So, e); }
    { PHASE_IDS; phase_kmean2(q, gtid, ngt); }
    xcd_barrier(xb);
    }
    DUP(2) {
    { PHASE_IDS; phase_s5_scan(q, gtid, ngt); phase_ret_kv(q, gw, ngw, lane); }
    __syncthreads();
    { PHASE_IDS; phase_moba2(q, l, lds_raw, q.qctr() + 64 + l); }
    xcd_barrier(xb);
    }
    DUP(3) {
    { const Params q = fresh(p); EpiS5Y e{q.ygb(), q.S5A(), q.inp(10) + l * 256};
      pg8::Gemm g{q.S5A(), q.S5Wy(), 16 * 1024, 16 * 512, 640, 640, 640}; pg8::GroupOrder So; So.init(16, 4, 2, (int)gridDim.x, (int)blockIdx.x);
      pg8::gemm_phase<EpiS5Y, pg8::GroupOrder, true, true>((PG8_LAS unsigned char*)lds_raw, g, So, e); }
    { PHASE_IDS; phase_ret_scan(q, gtid, ngt); }
    xcd_barrier(xb);
    }
    DUP(4) {
    { const Params q = fresh(p); EpiGlu e{q.xb(), q.ygb(), (float*)(lds_raw + 131072)};
      run_gemm(lds_raw, q.ygb(), q.Wglu_t() + (size_t)l * 65536, T, 256, 256, e); }
    { PHASE_IDS; phase_ret_out(q, gw, ngw, lane); }
    xcd_barrier(xb);
    }
    { PHASE_IDS; cvt_table_i8(q.inp(19) + (size_t)l * 16384 * D, q.U8s(), q.su(), gw, ngw, lane);
      cvt_table_fp8(q.inp(20) + (size_t)l * 16384 * D, q.V8s(), q.sv(), gw, ngw, lane); }
    __syncthreads();
    { const Params q = fresh(p); EpiResid e{q.outp(), D, q.xb2(), q.hb(), q.inp(16) + l * D, q.ssq2()};
      run_gemm(lds_raw, q.xb(), q.Wout_t() + (size_t)l * D * KD, T, D, KD, e); }
    xcd_barrier(xb);
    DUP(7) {
    { const Params q = fresh(p); EpiScaleStoreBf16 e{q.qb(), D, q.ssq2(), 16, q.rstd()};
      run_gemm(lds_raw, q.xb2(), q.Wq_t() + (size_t)l * D * KD, T, D, KD, e); }
    xcd_barrier(xb);
    }
    if (!(PROBE_SKIP & 2)) {
    DUP(8) {
    { PHASE_IDS; phase_peer_topk(q, l, gw, ngw, lane); }
    xcd_barrier(xb);
    }
    }
#if PEER_CHECK
    if (l == 0) { { PHASE_IDS; chk_save(q, gtid, ngt); } xcd_barrier(xb); { PHASE_IDS; chk_topk(q, l, gtid, ngt); } xcd_barrier(xb); }
#endif
    if (!(PROBE_SKIP & 1)) {
    { PHASE_IDS; phase_peer_u(q, q.qctr() + (l * 2 + 0) * 8, lds_raw, tid); }
    xcd_barrier(xb);
    { PHASE_IDS; phase_peer_r(q, gtid, ngt); if (l + 1 < NL) phase_s5_prep(q, l + 1, gtid, ngt); }
    xcd_barrier(xb);
    if (!(PROBE_SKIP & 32)) {
    { PHASE_IDS; phase_peer_v(q, q.qctr() + (l * 2 + 1) * 8, lds_raw, tid); }
    xcd_barrier(xb);
    }
    }
#if PEER_CHECK
    if (l == 0) { { PHASE_IDS; chk_apply(q, l, ldsf + wv * 128, gw, ngw, lane); } xcd_barrier(xb);
      if (blockIdx.x == 0 && threadIdx.x == 0) { const Params q = fresh(p); chk_emit(q); } xcd_barrier(xb); }
#endif
  }
  { constexpr int l = 2;
    DUP(5) {
    { const Params q = fresh(p);
      EpiInProj e{q.ssq1(), q.S5A(), q.Qm(), q.Km(), q.vrow(), q.Qr(), q.Kr(), q.krow(), q.vrrow(), q.grow(),
                  q.inp(12) + l * 64, q.inp(13) + l * 64, q.cosm(), q.sinm(), q.cosr(), q.sinr()};
      run_gemm(lds_raw, q.xb(), q.Win_t() + (size_t)l * INW * KD, T, INW, KD, e); }
    xcd_barrier(xb);
    }
    DUP(1) {
    { PHASE_IDS; phase_post_pack(q, gtid, ngt); }
    { const Params q = fresh(p); EpiS5Z e{q.S5Z()};
      pg8::Gemm g{q.S5A(), q.S5Wz(), 16 * 1024, 16 * 256, 512, 640, 512}; pg8::GroupOrder So; So.init(16, 4, 1, (int)gridDim.x, (int)blockIdx.x);
      pg8::gemm_phase<EpiS5Z, pg8::GroupOrder, true, true>((PG8_LAS unsigned char*)lds_raw, g, So, e); }
    { PHASE_IDS; phase_kmean2(q, gtid, ngt); }
    xcd_barrier(xb);
    }
    DUP(2) {
    { PHASE_IDS; phase_s5_scan(q, gtid, ngt); phase_ret_kv(q, gw, ngw, lane); }
    __syncthreads();
    { PHASE_IDS; phase_moba2(q, l, lds_raw, q.qctr() + 64 + l); }
    xcd_barrier(xb);
    }
    DUP(3) {
    { const Params q = fresh(p); EpiS5Y e{q.ygb(), q.S5A(), q.inp(10) + l * 256};
      pg8::Gemm g{q.S5A(), q.S5Wy(), 16 * 1024, 16 * 512, 640, 640, 640}; pg8::GroupOrder So; So.init(16, 4, 2, (int)gridDim.x, (int)blockIdx.x);
      pg8::gemm_phase<EpiS5Y, pg8::GroupOrder, true, true>((PG8_LAS unsigned char*)lds_raw, g, So, e); }
    { PHASE_IDS; phase_ret_scan(q, gtid, ngt); }
    xcd_barrier(xb);
    }
    DUP(4) {
    { const Params q = fresh(p); EpiGlu e{q.xb(), q.ygb(), (float*)(lds_raw + 131072)};
      run_gemm(lds_raw, q.ygb(), q.Wglu_t() + (size_t)l * 65536, T, 256, 256, e); }
    { PHASE_IDS; phase_ret_out(q, gw, ngw, lane); }
    xcd_barrier(xb);
    }
    { PHASE_IDS; cvt_table_i8(q.inp(19) + (size_t)l * 16384 * D, q.U8s(), q.su(), gw, ngw, lane);
      cvt_table_fp8(q.inp(20) + (size_t)l * 16384 * D, q.V8s(), q.sv(), gw, ngw, lane); }
    __syncthreads();
    { const Params q = fresh(p); EpiResid e{q.outp(), D, q.xb2(), q.hb(), q.inp(16) + l * D, q.ssq2()};
      run_gemm(lds_raw, q.xb(), q.Wout_t() + (size_t)l * D * KD, T, D, KD, e); }
    xcd_barrier(xb);
    DUP(7) {
    { const Params q = fresh(p); EpiScaleStoreBf16 e{q.qb(), D, q.ssq2(), 16, q.rstd()};
      run_gemm(lds_raw, q.xb2(), q.Wq_t() + (size_t)l * D * KD, T, D, KD, e); }
    xcd_barrier(xb);
    }
    if (!(PROBE_SKIP & 2)) {
    DUP(8) {
    { PHASE_IDS; phase_peer_topk(q, l, gw, ngw, lane); }
    xcd_barrier(xb);
    }
    }
#if PEER_CHECK
    if (l == 0) { { PHASE_IDS; chk_save(q, gtid, ngt); } xcd_barrier(xb); { PHASE_IDS; chk_topk(q, l, gtid, ngt); } xcd_barrier(xb); }
#endif
    if (!(PROBE_SKIP & 1)) {
    { PHASE_IDS; phase_peer_u(q, q.qctr() + (l * 2 + 0) * 8, lds_raw, tid); }
    xcd_barrier(xb);
    { PHASE_IDS; phase_peer_r(q, gtid, ngt); if (l + 1 < NL) phase_s5_prep(q, l + 1, gtid, ngt); }
    xcd_barrier(xb);
    if (!(PROBE_SKIP & 32)) {
    { PHASE_IDS; phase_peer_v(q, q.qctr() + (l * 2 + 1) * 8, lds_raw, tid); }
    xcd_barrier(xb);
    }
    }
#if PEER_CHECK
    if (l == 0) { { PHASE_IDS; chk_apply(q, l, ldsf + wv * 128, gw, ngw, lane); } xcd_barrier(xb);
      if (blockIdx.x == 0 && threadIdx.x == 0) { const Params q = fresh(p); chk_emit(q); } xcd_barrier(xb); }
#endif
  }
  { constexpr int l = 3;
    DUP(5) {
    { const Params q = fresh(p);
      EpiInProj e{q.ssq1(), q.S5A(), q.Qm(), q.Km(), q.vrow(), q.Qr(), q.Kr(), q.krow(), q.vrrow(), q.grow(),
                  q.inp(12) + l * 64, q.inp(13) + l * 64, q.cosm(), q.sinm(), q.cosr(), q.sinr()};
      run_gemm(lds_raw, q.xb(), q.Win_t() + (size_t)l * INW * KD, T, INW, KD, e); }
    xcd_barrier(xb);
    }
    DUP(1) {
    { PHASE_IDS; phase_post_pack(q, gtid, ngt); }
    { const Params q = fresh(p); EpiS5Z e{q.S5Z()};
      pg8::Gemm g{q.S5A(), q.S5Wz(), 16 * 1024, 16 * 256, 512, 640, 512}; pg8::GroupOrder So; So.init(16, 4, 1, (int)gridDim.x, (int)blockIdx.x);
      pg8::gemm_phase<EpiS5Z, pg8::GroupOrder, true, true>((PG8_LAS unsigned char*)lds_raw, g, So, e); }
    { PHASE_IDS; phase_kmean2(q, gtid, ngt); }
    xcd_barrier(xb);
    }
    DUP(2) {
    { PHASE_IDS; phase_s5_scan(q, gtid, ngt); phase_ret_kv(q, gw, ngw, lane); }
    __syncthreads();
    { PHASE_IDS; phase_moba2(q, l, lds_raw, q.qctr() + 64 + l); }
    xcd_barrier(xb);
    }
    DUP(3) {
    { const Params q = fresh(p); EpiS5Y e{q.ygb(), q.S5A(), q.inp(10) + l * 256};
      pg8::Gemm g{q.S5A(), q.S5Wy(), 16 * 1024, 16 * 512, 640, 640, 640}; pg8::GroupOrder So; So.init(16, 4, 2, (int)gridDim.x, (int)blockIdx.x);
      pg8::gemm_phase<EpiS5Y, pg8::GroupOrder, true, true>((PG8_LAS unsigned char*)lds_raw, g, So, e); }
    { PHASE_IDS; phase_ret_scan(q, gtid, ngt); }
    xcd_barrier(xb);
    }
    DUP(4) {
    { const Params q = fresh(p); EpiGlu e{q.xb(), q.ygb(), (float*)(lds_raw + 131072)};
      run_gemm(lds_raw, q.ygb(), q.Wglu_t() + (size_t)l * 65536, T, 256, 256, e); }
    { PHASE_IDS; phase_ret_out(q, gw, ngw, lane); }
    xcd_barrier(xb);
    }
    { PHASE_IDS; cvt_table_i8(q.inp(19) + (size_t)l * 16384 * D, q.U8s(), q.su(), gw, ngw, lane);
      cvt_table_fp8(q.inp(20) + (size_t)l * 16384 * D, q.V8s(), q.sv(), gw, ngw, lane); }
    __syncthreads();
    { const Params q = fresh(p); EpiResid e{q.outp(), D, q.xb2(), q.hb(), q.inp(16) + l * D, q.ssq2()};
      run_gemm(lds_raw, q.xb(), q.Wout_t() + (size_t)l * D * KD, T, D, KD, e); }
    xcd_barrier(xb);
    DUP(7) {
    { const Params q = fresh(p); EpiScaleStoreBf16 e{q.qb(), D, q.ssq2(), 16, q.rstd()};
      run_gemm(lds_raw, q.xb2(), q.Wq_t() + (size_t)l * D * KD, T, D, KD, e); }
    xcd_barrier(xb);
    }
    if (!(PROBE_SKIP & 2)) {
    DUP(8) {
    { PHASE_IDS; phase_peer_topk(q, l, gw, ngw, lane); }
    xcd_barrier(xb);
    }
    }
#if PEER_CHECK
    if (l == 0) { { PHASE_IDS; chk_save(q, gtid, ngt); } xcd_barrier(xb); { PHASE_IDS; chk_topk(q, l, gtid, ngt); } xcd_barrier(xb); }
#endif
    if (!(PROBE_SKIP & 1)) {
    { PHASE_IDS; phase_peer_u(q, q.qctr() + (l * 2 + 0) * 8, lds_raw, tid); }
    xcd_barrier(xb);
    { PHASE_IDS; phase_peer_r(q, gtid, ngt); if (l + 1 < NL) phase_s5_prep(q, l + 1, gtid, ngt); }
    xcd_barrier(xb);
    if (!(PROBE_SKIP & 32)) {
    { PHASE_IDS; phase_peer_v(q, q.qctr() + (l * 2 + 1) * 8, lds_raw, tid); }
    xcd_barrier(xb);
    }
    }
#if PEER_CHECK
    if (l == 0) { { PHASE_IDS; chk_apply(q, l, ldsf + wv * 128, gw, ngw, lane); } xcd_barrier(xb);
      if (blockIdx.x == 0 && threadIdx.x == 0) { const Params q = fresh(p); chk_emit(q); } xcd_barrier(xb); }
#endif
  }
}

}

extern "C" void kernel_launch(void* const* d_in, const int* in_sizes, int n_in, void* d_out, int out_size, void* d_ws, size_t ws_size,
                              hipStream_t stream) {
  static int grid_blocks = 0;
  if (!grid_blocks) {
    int dev = 0, cus = 0, per_cu = 0;
    hipGetDevice(&dev);
    hipDeviceGetAttribute(&cus, hipDeviceAttributeMultiprocessorCount, dev);
    hipFuncSetAttribute((const void*)mega, hipFuncAttributeMaxDynamicSharedMemorySize, LDS_BYTES);
    hipOccupancyMaxActiveBlocksPerMultiprocessor(&per_cu, (const void*)mega, NTHR, LDS_BYTES);
    if (per_cu < 1) { fprintf(stderr, "occupancy query returned %d\n", per_cu); per_cu = 1; }
    grid_blocks = cus * 1;
    if (grid_blocks < 64) fprintf(stderr, "unexpected CU count %d\n", cus);
  }
  Params p{};
  for (int i = 0; i < 21; ++i) p.in[i] = (const GAS float*)d_in[i];
  p.out_ = (GAS float*)d_out;
  p.ws = (GAS unsigned char*)d_ws;
  if (WS_TOTAL > ws_size) { fprintf(stderr, "workspace too small: need %zu have %zu\n", (size_t)WS_TOTAL, ws_size); return; }
  hipMemsetAsync((unsigned char*)d_ws + WO_bar, 0, 16384, stream);
  void* args[] = {&p};
  hipError_t e = hipLaunchCooperativeKernel((const void*)mega, dim3(grid_blocks), dim3(NTHR), args, LDS_BYTES, stream);
  if (e != hipSuccess) fprintf(stderr, "cooperative launch failed: %s (grid %d)\n", hipGetErrorString(e), grid_blocks);
}
```

```cpp
#include <hip/hip_runtime.h>
#include <hip/hip_cooperative_groups.h>
#include <math.h>
#include <stdint.h>
#include <stdio.h>
namespace cg = cooperative_groups;

#ifndef PEER_CHECK
#define PEER_CHECK 0
#endif
#ifndef PROBE_DUP
#define PROBE_DUP 0
#endif
__device__ __forceinline__ int dup_n(int n) { asm volatile("" : "+s"(n)); return n; }
#define DUP(bit) _Pragma("unroll 1") for (int rep_ = 0, repn_ = (((PROBE_DUP >> (bit)) & 1) ? dup_n(2) : 1); rep_ < repn_; ++rep_)
#ifndef PROBE_SKIP
#define PROBE_SKIP 0
#endif
#ifndef PRECISE
#define PRECISE 0
#endif

namespace {
constexpr int NB = 8, S = 4096, D = 1024, NL = 4, T = NB * S;
constexpr int INW = 2816;
constexpr int OFF_U = 0, OFF_QM = 256, OFF_KM = 768, OFF_VM = 1280, OFF_QR = 1792, OFF_KR = 2048, OFF_VR = 2304, OFF_GR = 2560;
constexpr float EPS = 1e-6f;
static_assert(PRECISE == 0, "PRECISE builds are retired");
constexpr int KS = PRECISE ? 3 : 1;
constexpr int KD = D * KS;
constexpr int NTHR = 512, NWAVE = 8;
constexpr int LDS_BYTES = 131072 + 4096 + 1024;

typedef unsigned short bf16_t;
using bf16x8 = __attribute__((ext_vector_type(8))) short;
using f32x4 = __attribute__((ext_vector_type(4))) float;

__device__ __forceinline__ float wave_sum(float v) {
#pragma unroll
  for (int o = 32; o > 0; o >>= 1) v += __shfl_xor(v, o);
  return v;
}
__device__ __forceinline__ float wave_max(float v) {
#pragma unroll
  for (int o = 32; o > 0; o >>= 1) v = fmaxf(v, __shfl_xor(v, o));
  return v;
}
__device__ __forceinline__ int q_pull(int* head, int nitems, int* bc, int tid) {
  __syncthreads();
  if (tid == 0) bc[0] = atomicAdd(head, 1);
  __syncthreads();
  const int v = bc[0];
  return v < nitems ? v : -1;
}
constexpr float QSCALE = 0.125f * 1.4426950408889634f;
__device__ __forceinline__ float ret_log2g(int h) { return log2f(1.0f - exp2f(-5.0f - (float)h)); }
__device__ __forceinline__ float gelu_tanh(float x) {
  const float k0 = 0.7978845608028654f, k1 = 0.044715f;
  float u = k0 * (x + k1 * x * x * x);
  return 0.5f * x * (1.0f + tanhf(u));
}
__device__ __forceinline__ float sigmoidf_(float x) { return 1.0f / (1.0f + expf(-x)); }
__device__ __forceinline__ float fast_sigmoid(float x) { return __builtin_amdgcn_rcpf(1.0f + __builtin_amdgcn_exp2f(-1.4426950408889634f * x)); }
__device__ __forceinline__ float fast_gelu(float x) { const float u = 0.7978845608028654f * (x + 0.044715f * x * x * x); return x * fast_sigmoid(2.0f * u); }
__device__ __forceinline__ bf16_t f2bf(float f) {
  unsigned u = __float_as_uint(f);
  u += 0x7fffu + ((u >> 16) & 1u);
  return (bf16_t)(u >> 16);
}
__device__ __forceinline__ float bf2f(bf16_t h) { return __uint_as_float(((unsigned)h) << 16); }
#define LDS_FENCE() asm volatile("s_waitcnt lgkmcnt(0)" ::: "memory")
typedef __bf16 bf16x2_hw __attribute__((ext_vector_type(2)));
typedef float f32x2_hw __attribute__((ext_vector_type(2)));
__device__ __forceinline__ unsigned pk_bf16(float lo, float hi) { const f32x2_hw f = {lo, hi}; const bf16x2_hw b = __builtin_convertvector(f, bf16x2_hw); return __builtin_bit_cast(unsigned, b); }
typedef float f32x16 __attribute__((ext_vector_type(16)));

constexpr size_t al256(size_t x) { return (x + 255) & ~(size_t)255; }
constexpr size_t WO_rstd = 0;
constexpr size_t WO_cosm = WO_rstd + al256((size_t)T * 4);
constexpr size_t WO_sinm = WO_cosm + al256((size_t)S * 8 * 4);
constexpr size_t WO_cosr = WO_sinm + al256((size_t)S * 8 * 4);
constexpr size_t WO_sinr = WO_cosr + al256((size_t)S * 32 * 4);
constexpr size_t WO_kmean = WO_sinr + al256((size_t)S * 32 * 4);
constexpr size_t WO_proj = WO_kmean + al256((size_t)NB * 8 * 16 * 64 * 4);
constexpr size_t WO_ybuf = WO_proj + al256((size_t)T * INW * 4);
constexpr size_t WO_yg = WO_ybuf + al256((size_t)T * D * 4);
constexpr size_t WO_skb = WO_yg + al256((size_t)T * 256 * 4);
constexpr size_t WO_Ub = WO_skb + al256((size_t)NL * 16 * 128 * 64 * 2);
constexpr size_t WO_Vb = WO_Ub + al256((size_t)16384 * D * 2);
constexpr size_t WO_gates = WO_Vb + al256((size_t)16384 * D * 2);
constexpr size_t WO_eidx = WO_gates + al256((size_t)T * 128 * 4);
constexpr size_t WO_xb = WO_eidx + al256((size_t)T * 128 * 4);
constexpr size_t WO_Win_t = WO_xb + al256((size_t)T * KD * 2);
constexpr size_t WO_Wout_t = WO_Win_t + al256((size_t)NL * INW * KD * 2);
constexpr size_t WO_Wq_t = WO_Wout_t + al256((size_t)NL * D * KD * 2);
constexpr size_t WO_Qm = WO_Wq_t + al256((size_t)NL * D * KD * 2);
constexpr size_t WO_Km = WO_Qm + al256((size_t)T * 512 * 2);
constexpr size_t WO_Vm = WO_Km + al256((size_t)T * 512 * 2);
constexpr size_t WO_S5a32 = WO_Vm + al256((size_t)T * 512 * 2);
constexpr size_t WO_Wglu_t = WO_S5a32 + al256((size_t)16 * 64 * 2 * 4);
constexpr size_t WO_Qr = WO_Wglu_t + al256((size_t)NL * 256 * 256 * 2);
constexpr size_t WO_Kr = WO_Qr + al256((size_t)T * 256 * 2);
constexpr size_t WO_Krv = WO_Kr + al256((size_t)T * 256 * 2);
constexpr size_t WO_Vr = WO_Krv + al256((size_t)T * 256 * 2);
constexpr size_t WO_KVr = WO_Vr + al256((size_t)T * 256 * 2);
constexpr size_t WO_Rb = WO_KVr + al256((size_t)32 * 32 * 4096 * 4);
constexpr size_t WO_qctr = WO_Rb + al256((size_t)32 * 32 * 4096 * 2);
constexpr size_t WO_bar = WO_qctr + al256(1024);
constexpr size_t WO_S5Wy = WO_bar + al256(16384);
constexpr size_t WO_S5Wz = WO_S5Wy + al256((size_t)16 * 512 * 640 * 2);
constexpr size_t WO_ssq1 = WO_S5Wz + al256((size_t)16 * 256 * 512 * 2);
constexpr size_t WO_ssq2 = WO_ssq1 + al256((size_t)T * 8 * 4);
constexpr size_t WS_TOTAL = WO_ssq2 + al256((size_t)T * 16 * 4);
constexpr size_t WO_S5A = WO_gates;
constexpr size_t WO_S5Z = WO_S5A + al256((size_t)16 * 1024 * 640 * 2);
static_assert(WO_S5Z + (size_t)16 * 1024 * 128 * 4 <= WO_gates + 2 * al256((size_t)T * 128 * 4), "S5A/S5Z must fit in gates+eidx");
#define GAS __attribute__((address_space(1)))
static_assert((size_t)T * D * 2 + (size_t)T * 128 * 8 * 4 + (size_t)T * D * 2 <= (size_t)T * INW * 4, "qb + ppart + xb2 must fit in the proj region");
struct Params {
  const GAS float* in[21];
  GAS float* out_;
  GAS unsigned char* ws;
  __device__ __forceinline__ const float* inp(int i) const { return (const float*)in[i]; }
  __device__ __forceinline__ float* outp() const { return (float*)out_; }
  __device__ __forceinline__ float* rstd() const { return (float*)(ws + WO_rstd); }
  __device__ __forceinline__ float* cosm() const { return (float*)(ws + WO_cosm); }
  __device__ __forceinline__ float* sinm() const { return (float*)(ws + WO_sinm); }
  __device__ __forceinline__ float* cosr() const { return (float*)(ws + WO_cosr); }
  __device__ __forceinline__ float* sinr() const { return (float*)(ws + WO_sinr); }
  __device__ __forceinline__ float* kmean() const { return (float*)(ws + WO_kmean); }
  __device__ __forceinline__ float* proj() const { return (float*)(ws + WO_proj); }
  __device__ __forceinline__ float* ybuf() const { return (float*)(ws + WO_ybuf); }
  __device__ __forceinline__ float* yg() const { return (float*)(ws + WO_yg); }
  __device__ __forceinline__ bf16_t* skb() const { return (bf16_t*)(ws + WO_skb); }
  __device__ __forceinline__ bf16_t* Ub() const { return (bf16_t*)(ws + WO_Ub); }
  __device__ __forceinline__ bf16_t* Vb() const { return (bf16_t*)(ws + WO_Vb); }
  __device__ __forceinline__ float* gates() const { return (float*)(ws + WO_gates); }
  __device__ __forceinline__ int* eidx() const { return (int*)(ws + WO_eidx); }
  __device__ __forceinline__ bf16_t* xb() const { return (bf16_t*)(ws + WO_xb); }
  __device__ __forceinline__ bf16_t* Win_t() const { return (bf16_t*)(ws + WO_Win_t); }
  __device__ __forceinline__ bf16_t* Wout_t() const { return (bf16_t*)(ws + WO_Wout_t); }
  __device__ __forceinline__ bf16_t* Wq_t() const { return (bf16_t*)(ws + WO_Wq_t); }
  __device__ __forceinline__ bf16_t* Qm() const { return (bf16_t*)(ws + WO_Qm); }
  __device__ __forceinline__ bf16_t* Km() const { return (bf16_t*)(ws + WO_Km); }
  __device__ __forceinline__ bf16_t* Vm() const { return (bf16_t*)(ws + WO_Vm); }
  __device__ __forceinline__ bf16_t* S5A() const { return (bf16_t*)(ws + WO_S5A); }
  __device__ __forceinline__ bf16_t* S5Wy() const { return (bf16_t*)(ws + WO_S5Wy); }
  __device__ __forceinline__ bf16_t* S5Wz() const { return (bf16_t*)(ws + WO_S5Wz); }
  __device__ __forceinline__ float* S5Z() const { return (float*)(ws + WO_S5Z); }
  __device__ __forceinline__ float* S5a32() const { return (float*)(ws + WO_S5a32); }
  __device__ __forceinline__ bf16_t* Wglu_t() const { return (bf16_t*)(ws + WO_Wglu_t); }
  __device__ __forceinline__ bf16_t* ygb() const { return (bf16_t*)(ws + WO_yg); }
  __device__ __forceinline__ int* qctr() const { return (int*)(ws + WO_qctr); }
  __device__ __forceinline__ unsigned char* U8s() const { return (unsigned char*)(ws + WO_Ub); }
  __device__ __forceinline__ float* su() const { return (float*)(ws + WO_Ub + (size_t)16384 * D); }
  __device__ __forceinline__ unsigned char* V8s() const { return (unsigned char*)(ws + WO_Vb); }
  __device__ __forceinline__ float* sv() const { return (float*)(ws + WO_Vb + (size_t)16384 * D); }
  __device__ __forceinline__ bf16_t* hb() const { return (bf16_t*)(ws + WO_ybuf + ((size_t)4 << 20)); }
  __device__ __forceinline__ bf16_t* ppart() const { return (bf16_t*)(ws + WO_proj + (size_t)T * D * 2); }
  __device__ __forceinline__ bf16_t* Qr() const { return (bf16_t*)(ws + WO_Qr); }
  __device__ __forceinline__ bf16_t* Kr() const { return (bf16_t*)(ws + WO_Kr); }
  __device__ __forceinline__ bf16_t* Krv() const { return (bf16_t*)(ws + WO_Krv); }
  __device__ __forceinline__ bf16_t* Vr() const { return (bf16_t*)(ws + WO_Vr); }
  __device__ __forceinline__ float* KVr() const { return (float*)(ws + WO_KVr); }
  __device__ __forceinline__ bf16_t* Rb() const { return (bf16_t*)(ws + WO_Rb); }
  __device__ __forceinline__ unsigned* bar() const { return (unsigned*)(ws + WO_bar); }
  __device__ __forceinline__ bf16_t* projb() const { return (bf16_t*)(ws + WO_proj); }
  __device__ __forceinline__ float* ssq1() const { return (float*)(ws + WO_ssq1); }
  __device__ __forceinline__ float* ssq2() const { return (float*)(ws + WO_ssq2); }
  __device__ __forceinline__ bf16_t* xb2() const { return (bf16_t*)(ws + WO_proj + (size_t)T * D * 2 + (size_t)T * 128 * 8 * 4); }
  __device__ __forceinline__ bf16_t* vrow() const { return (bf16_t*)(ws + WO_proj); }
  __device__ __forceinline__ bf16_t* vrrow() const { return (bf16_t*)(ws + WO_proj + (size_t)T * 512 * 2); }
  __device__ __forceinline__ bf16_t* krow() const { return (bf16_t*)(ws + WO_proj + (size_t)T * 768 * 2); }
  __device__ __forceinline__ bf16_t* grow() const { return (bf16_t*)(ws + WO_proj + (size_t)T * 1024 * 2); }
  __device__ __forceinline__ bf16_t* qb() const { return (bf16_t*)(ws + WO_proj); }
};

namespace pg8 {
#define PG8_LAS __attribute__((address_space(3)))
typedef unsigned short bf16_t;
typedef short bf16x8 __attribute__((ext_vector_type(8)));
typedef float f32x4 __attribute__((ext_vector_type(4)));
typedef unsigned u32x4 __attribute__((ext_vector_type(4)));
constexpr int BM = 256, BK = 64, HALF = 128, HTB = HALF * BK * 2  , STAGE_BYTES = 8 * HTB, NXCD = 8, WGM = 8;

__host__ __device__ __forceinline__ int lds_byte(int r, int c) { const int st = (r >> 4) * 2 + (c >> 5), rr = r & 15, cc = c & 31, ob = rr * 64 + cc * 2; return st * 1024 + (ob ^ (((ob >> 9) & 1) << 5)); }
__host__ __device__ __forceinline__ void stage_rc(int b, int& R, int& C) { const int st = b / 1024, sb = b % 1024, swz = sb ^ (((sb >> 9) & 1) << 5); R = (st >> 1) * 16 + swz / 64; C = (st & 1) * 32 + (swz % 64) / 2; }
__host__ __device__ __forceinline__ int perm32(int rho) { const int n = rho >> 4, i = rho & 15; return 8 * (i >> 2) + 4 * n + (i & 3); }

struct Unit { int pm, pn; };
struct Gemm { const bf16_t* A; const bf16_t* Bt; int M, N, K, lda, ldb; };

struct StaticOrder {
    int nM, nN, nwg, G, c;
    __host__ __device__ void init(int M, int N, int G_, int c_) { nM = M / BM; nN = N / BM; nwg = nM * nN; G = G_; c = c_; }
    __host__ __device__ bool next(int i, Unit& u) const {
        const long L = (long)i * G + c; if (L >= nwg) return false;
        int wgid = (int)L; { const int q = nwg / NXCD, r = nwg % NXCD, xcd = wgid % NXCD, off = wgid / NXCD; wgid = (xcd < r ? xcd * (q + 1) : r * (q + 1) + (xcd - r) * q) + off; }
        const int nig = WGM * nN, gid = wgid / nig, fm = gid * WGM, gsz = (nM - fm) < WGM ? (nM - fm) : WGM;
        u.pm = fm + ((wgid % nig) % gsz); u.pn = (wgid % nig) / gsz; return true;
    }
    __device__ __forceinline__ void a_ready(const Unit&) const {}
    __device__ __forceinline__ void done(const Unit&) const {}
};
struct GroupOrder {
    int mt, nt_, nwg, G, c;
    __host__ __device__ void init(int ngroups, int mt__, int nt__, int G_, int c_) { mt = mt__; nt_ = nt__; nwg = ngroups * mt * nt_; G = G_; c = c_; }
    __host__ __device__ bool next(int i, Unit& u) const {
        const long L = (long)i * G + c; if (L >= nwg) return false;
        const int per = mt * nt_, gi = (int)L / per, r = (int)L % per;
        u.pm = gi * mt + r % mt; u.pn = gi * nt_ + r / mt; return true;
    }
    __device__ __forceinline__ void a_ready(const Unit&) const {}
    __device__ __forceinline__ void done(const Unit&) const {}
};
template <class Epi, class Sched, bool ALIGN_EPI = false, bool SP2 = false>
__device__ __forceinline__ void gemm_phase(PG8_LAS unsigned char* lds, const Gemm g, const Sched& S, const Epi& E) {
    int tid_ = threadIdx.x; asm volatile("" : "+v"(tid_));
    const int tid = tid_, wid = __builtin_amdgcn_readfirstlane(tid >> 6), lane = tid & 63, wr = wid >> 2, wc = wid & 3, fr = lane & 15, fq = lane >> 4;
    const int K = g.K, nt = K / BK;
    unsigned voffA[2], voffB[2];
#pragma unroll
    for (int i = 0; i < 2; ++i) { int R, C; stage_rc(tid * 16 + i * 8192, R, C); const int Rb = Epi::PERM ? ((R & ~31) + perm32(R & 31)) : R;
        voffA[i] = (unsigned)(R * g.lda + C) * 2u; voffB[i] = (unsigned)(Rb * g.ldb + C) * 2u; }
    const size_t kstep = (size_t)(BK * 2);
    const size_t hstepA = (size_t)HALF * g.lda * 2, hstepB = (size_t)HALF * g.ldb * 2;
    const size_t tstepA = 2 * hstepA, tstepB = 2 * hstepB;
    const unsigned ldsw = (unsigned)wid * 1024u;
    const int aoff = lds_byte(wr * 64 + fr, fq * 8), boff = lds_byte(wc * 32 + fr, fq * 8);
#define PG8_SA(b, h) (((b) * 2 + (h)) * HTB)
#define PG8_SB(b, h) ((4 + (b) * 2 + (h)) * HTB)
#define PG8_STAGE(bufoff, gbase, voff) do { _Pragma("unroll") for (int _i = 0; _i < 2; ++_i) \
        __builtin_amdgcn_global_load_lds((const unsigned*)((const char*)(gbase) + (voff)[_i]), (PG8_LAS unsigned*)(lds + (bufoff) + ldsw + _i * 8192), 16, 0, 0); } while (0)
#define PG8_LDA(dst, b, h) do { _Pragma("unroll") for (int m = 0; m < 4; ++m) _Pragma("unroll") for (int k = 0; k < 2; ++k) dst[m][k] = *(const PG8_LAS bf16x8*)(lds + PG8_SA(b, h) + aoff + m * 2048 + k * 1024); } while (0)
#define PG8_LDB(dst, b, h) do { _Pragma("unroll") for (int n = 0; n < 2; ++n) _Pragma("unroll") for (int k = 0; k < 2; ++k) dst[n][k] = *(const PG8_LAS bf16x8*)(lds + PG8_SB(b, h) + boff + n * 2048 + k * 1024); } while (0)
#define PG8_MMA(ai, bj, At, Bt) do { __builtin_amdgcn_s_setprio(1); _Pragma("unroll") for (int m = 0; m < 4; ++m) _Pragma("unroll") for (int n = 0; n < 2; ++n) _Pragma("unroll") for (int k = 0; k < 2; ++k) \
        acc[ai][bj][m][n] = __builtin_amdgcn_mfma_f32_16x16x32_bf16(Bt[n][k], At[m][k], acc[ai][bj][m][n], 0, 0, 0); __builtin_amdgcn_s_setprio(0); } while (0)
#define PG8_WAIT_V(n) asm volatile("s_waitcnt vmcnt(" #n ")" ::: "memory")
#define PG8_WAIT_L(n) asm volatile("s_waitcnt lgkmcnt(" #n ")" ::: "memory")
#define PG8_BAR __builtin_amdgcn_s_barrier()
#define PG8_SCHED __builtin_amdgcn_sched_barrier(0)
    Unit cur, nxt; int ui = 0;
    if (!S.next(0, cur)) return;
    f32x4 acc[2][2][4][2];
    E.init(acc, cur, wr, wc, fr, fq);
    bf16x8 At[4][2], B0[2][2], B1[2][2];
    const char* cA = (const char*)g.A + (size_t)cur.pm * tstepA; const char* cB = (const char*)g.Bt + (size_t)cur.pn * tstepB;
    S.a_ready(cur);
    if constexpr (SP2) {
        PG8_STAGE(PG8_SB(0, 0), cB, voffB); PG8_STAGE(PG8_SB(0, 1), cB + hstepB, voffB); PG8_STAGE(PG8_SA(0, 0), cA, voffA); PG8_STAGE(PG8_SA(0, 1), cA + hstepA, voffA);
        if (wr == 1) PG8_BAR;
        PG8_WAIT_V(2); PG8_BAR;
        PG8_STAGE(PG8_SB(1, 0), cB + kstep, voffB); PG8_STAGE(PG8_SA(1, 0), cA + kstep, voffA); PG8_STAGE(PG8_SB(1, 1), cB + hstepB + kstep, voffB);
        PG8_WAIT_V(6); PG8_BAR;
    } else {
        PG8_STAGE(PG8_SB(0, 0), cB, voffB); PG8_STAGE(PG8_SA(0, 0), cA, voffA); PG8_STAGE(PG8_SB(0, 1), cB + hstepB, voffB); PG8_STAGE(PG8_SA(0, 1), cA + hstepA, voffA);
        if (wr == 1) PG8_BAR;
        PG8_WAIT_V(4); PG8_BAR;
        PG8_STAGE(PG8_SB(1, 0), cB + kstep, voffB); PG8_STAGE(PG8_SA(1, 0), cA + kstep, voffA); PG8_STAGE(PG8_SB(1, 1), cB + hstepB + kstep, voffB);
        PG8_WAIT_V(6); PG8_BAR;
    }
    for (;;) {
        const bool has_next = S.next(ui + 1, nxt);
        const char* nA = has_next ? (const char*)g.A + (size_t)nxt.pm * tstepA : cA; const char* nB = has_next ? (const char*)g.Bt + (size_t)nxt.pn * tstepB : cB;
        for (int t = 0; t < nt; t += 2) {
            const bool last = (t == nt - 2);
            const char* a1 = cA + (size_t)(t + 1) * kstep;
            const char* a2 = last ? nA : cA + (size_t)(t + 2) * kstep; const char* b2 = last ? nB : cB + (size_t)(t + 2) * kstep;
            const char* a3 = a2 + kstep; const char* b3 = b2 + kstep;
            if (last && has_next) S.a_ready(nxt);
            if constexpr (SP2) {
            PG8_LDB(B0, 0, 0); PG8_LDB(B1, 0, 1); PG8_SCHED; PG8_LDA(At, 0, 0); PG8_STAGE(PG8_SA(1, 1), a1 + hstepA, voffA);
            PG8_WAIT_V(8); PG8_WAIT_L(0); PG8_BAR; PG8_MMA(0, 0, At, B0); PG8_MMA(0, 1, At, B1); PG8_BAR; PG8_SCHED;
            PG8_LDA(At, 0, 1); PG8_STAGE(PG8_SB(0, 0), b2, voffB); PG8_STAGE(PG8_SB(0, 1), b2 + hstepB, voffB); PG8_STAGE(PG8_SA(0, 0), a2, voffA);
            PG8_WAIT_V(8); PG8_WAIT_L(0); PG8_BAR; PG8_MMA(1, 0, At, B0); PG8_MMA(1, 1, At, B1); PG8_BAR; PG8_SCHED;
            PG8_LDB(B0, 1, 0); PG8_LDB(B1, 1, 1); PG8_SCHED; PG8_LDA(At, 1, 0); PG8_STAGE(PG8_SA(0, 1), a2 + hstepA, voffA);
            PG8_WAIT_V(8); PG8_WAIT_L(0); PG8_BAR; PG8_MMA(0, 0, At, B0); PG8_MMA(0, 1, At, B1); PG8_BAR; PG8_SCHED;
            PG8_LDA(At, 1, 1); PG8_STAGE(PG8_SB(1, 0), b3, voffB); PG8_STAGE(PG8_SB(1, 1), b3 + hstepB, voffB); PG8_STAGE(PG8_SA(1, 0), a3, voffA);
            PG8_WAIT_V(8); PG8_WAIT_L(0); PG8_BAR; PG8_MMA(1, 0, At, B0); PG8_MMA(1, 1, At, B1); PG8_BAR; PG8_SCHED;
            } else {
            PG8_LDB(B0, 0, 0); PG8_SCHED; PG8_LDA(At, 0, 0); PG8_STAGE(PG8_SA(1, 1), a1 + hstepA, voffA);
            PG8_WAIT_L(8); PG8_BAR; PG8_WAIT_L(0); PG8_MMA(0, 0, At, B0); PG8_BAR; PG8_SCHED;
            PG8_LDB(B1, 0, 1); PG8_STAGE(PG8_SB(0, 0), b2, voffB);
            PG8_BAR; PG8_WAIT_L(0); PG8_MMA(0, 1, At, B1); PG8_BAR;
            PG8_LDA(At, 0, 1); PG8_STAGE(PG8_SA(0, 0), a2, voffA);
            PG8_BAR; PG8_WAIT_L(0); PG8_MMA(1, 0, At, B0); PG8_BAR; PG8_SCHED;
            PG8_STAGE(PG8_SB(0, 1), b2 + hstepB, voffB);
            PG8_WAIT_V(6); PG8_BAR; PG8_MMA(1, 1, At, B1); PG8_BAR;
            PG8_LDB(B0, 1, 0); PG8_SCHED; PG8_LDA(At, 1, 0); PG8_STAGE(PG8_SA(0, 1), a2 + hstepA, voffA);
            PG8_WAIT_L(8); PG8_BAR; PG8_WAIT_L(0); PG8_MMA(0, 0, At, B0); PG8_BAR; PG8_SCHED;
            PG8_LDB(B1, 1, 1); PG8_STAGE(PG8_SB(1, 0), b3, voffB);
            PG8_BAR; PG8_WAIT_L(0); PG8_MMA(0, 1, At, B1); PG8_BAR;
            PG8_LDA(At, 1, 1); PG8_STAGE(PG8_SA(1, 0), a3, voffA);
            PG8_BAR; PG8_WAIT_L(0); PG8_MMA(1, 0, At, B0); PG8_BAR; PG8_SCHED;
            PG8_STAGE(PG8_SB(1, 1), b3 + hstepB, voffB);
            PG8_WAIT_V(6); PG8_BAR; PG8_MMA(1, 1, At, B1); PG8_BAR;
            }
        }
        if constexpr (ALIGN_EPI) { if (wr == 0) PG8_BAR; }
        if constexpr (!Epi::AFTER_DRAIN) { E(acc, cur, wr, wc, fr, fq); S.done(cur); }
        if (!has_next) break;
        E.init(acc, nxt, wr, wc, fr, fq);
        cur = nxt; cA = nA; cB = nB; ++ui;
        if constexpr (ALIGN_EPI) { if (wr == 1) PG8_BAR; }
    }
    PG8_WAIT_V(0);
    if constexpr (!ALIGN_EPI) { if (wr == 0) PG8_BAR; }
    PG8_BAR;
    if constexpr (Epi::AFTER_DRAIN) { E.fused(acc, cur, wr, wc, fr, fq, lds, wid, lane); S.done(cur); }
#undef PG8_SA
#undef PG8_SB
#undef PG8_STAGE
#undef PG8_LDA
#undef PG8_LDB
#undef PG8_MMA
#undef PG8_WAIT_V
#undef PG8_WAIT_L
#undef PG8_BAR
#undef PG8_SCHED
}
}
#define EPI_ZERO_INIT \
  __device__ __forceinline__ void init(pg8::f32x4 (&acc)[2][2][4][2], const pg8::Unit&, int, int, int, int) const { \
    _Pragma("unroll") for (int a = 0; a < 2; ++a) _Pragma("unroll") for (int b = 0; b < 2; ++b) \
    _Pragma("unroll") for (int m = 0; m < 4; ++m) _Pragma("unroll") for (int n = 0; n < 2; ++n) acc[a][b][m][n] = (pg8::f32x4){0.f, 0.f, 0.f, 0.f}; }
struct EpiResid {
  static constexpr bool PERM = true, AFTER_DRAIN = false;
  float* C; int ldc; bf16_t* xb; bf16_t* hb; const float* g2; float* parts;
  __device__ __forceinline__ void init(pg8::f32x4 (&acc)[2][2][4][2], const pg8::Unit& u, int wr, int wc, int fr, int fq) const {
#pragma unroll
    for (int ai = 0; ai < 2; ++ai)
#pragma unroll
      for (int m = 0; m < 4; ++m) {
        const int row = u.pm * 256 + ai * 128 + wr * 64 + m * 16 + fr;
#pragma unroll
        for (int bj = 0; bj < 2; ++bj)
#pragma unroll
          for (int n = 0; n < 2; ++n) {
            const int col = u.pn * 256 + bj * 128 + wc * 32 + 8 * fq + 4 * n;
            acc[ai][bj][m][n] = *(const pg8::f32x4*)(C + (size_t)row * ldc + col);
          }
      }
  }
  __device__ __forceinline__ void operator()(const pg8::f32x4 (&acc)[2][2][4][2], const pg8::Unit& u, int wr, int wc, int fr_in, int fq_in) const {
    int fr = fr_in, fq = fq_in; asm volatile("" : "+v"(fr), "+v"(fq));
    pg8::f32x4 gv[2][2];
#pragma unroll
    for (int bj = 0; bj < 2; ++bj)
#pragma unroll
      for (int n = 0; n < 2; ++n) gv[bj][n] = *(const pg8::f32x4*)(g2 + u.pn * 256 + bj * 128 + wc * 32 + 8 * fq + 4 * n);
#pragma unroll
    for (int ai = 0; ai < 2; ++ai)
#pragma unroll
      for (int m = 0; m < 4; ++m) {
        const int row = u.pm * 256 + ai * 128 + wr * 64 + m * 16 + fr;
        float ss = 0.f;
#pragma unroll
        for (int bj = 0; bj < 2; ++bj) {
          const int col = u.pn * 256 + bj * 128 + wc * 32 + 8 * fq;
          const pg8::f32x4 v0 = acc[ai][bj][m][0], v1 = acc[ai][bj][m][1];
          *(pg8::f32x4*)(C + (size_t)row * ldc + col) = v0; *(pg8::f32x4*)(C + (size_t)row * ldc + col + 4) = v1;
          *(uint4*)(xb + (size_t)row * KD + col) = make_uint4(pk_bf16(v0[0], v0[1]), pk_bf16(v0[2], v0[3]), pk_bf16(v1[0], v1[1]), pk_bf16(v1[2], v1[3]));
          const pg8::f32x4 h0 = v0 * gv[bj][0], h1 = v1 * gv[bj][1];
          *(uint4*)(hb + ((size_t)(col >> 7) * T + row) * 128 + (col & 127)) = make_uint4(pk_bf16(h0[0], h0[1]), pk_bf16(h0[2], h0[3]), pk_bf16(h1[0], h1[1]), pk_bf16(h1[2], h1[3]));
          ss += ((v0[0] * v0[0] + v0[1] * v0[1]) + (v0[2] * v0[2] + v0[3] * v0[3])) + ((v1[0] * v1[0] + v1[1] * v1[1]) + (v1[2] * v1[2] + v1[3] * v1[3]));
        }
        ss += __shfl_xor(ss, 16); ss += __shfl_xor(ss, 32);
        if (fq == 0) parts[(size_t)row * 16 + u.pn * 4 + wc] = ss;
        asm volatile("" ::: "memory");
      }
  }
};
struct EpiScaleStoreBf16 {
  static constexpr bool PERM = true, AFTER_DRAIN = false;
  bf16_t* C; int ldc; const float* parts; int nparts; float* rs_out;
  EPI_ZERO_INIT
  __device__ __forceinline__ void operator()(const pg8::f32x4 (&acc)[2][2][4][2], const pg8::Unit& u, int wr, int wc, int fr_in, int fq_in) const {
    int fr = fr_in, fq = fq_in; asm volatile("" : "+v"(fr), "+v"(fq));
#pragma unroll
    for (int ai = 0; ai < 2; ++ai)
#pragma unroll
      for (int m = 0; m < 4; ++m) {
        const int row = u.pm * 256 + ai * 128 + wr * 64 + m * 16 + fr;
        float ssum = 0.f;
        for (int i = 0; i < nparts; i += 4) { const pg8::f32x4 q4 = *(const pg8::f32x4*)(parts + (size_t)row * nparts + i); ssum += (q4[0] + q4[1]) + (q4[2] + q4[3]); }
        const float r = rsqrtf(ssum * (1.0f / (float)D) + EPS);
        if (rs_out && u.pn == 0 && wc == 0 && fq == 0) rs_out[row] = r;
#pragma unroll
        for (int bj = 0; bj < 2; ++bj) {
          const int col = u.pn * 256 + bj * 128 + wc * 32 + 8 * fq;
          const pg8::f32x4 v0 = acc[ai][bj][m][0] * r, v1 = acc[ai][bj][m][1] * r;
          *(uint4*)(C + (size_t)row * ldc + col) = make_uint4(pk_bf16(v0[0], v0[1]), pk_bf16(v0[2], v0[3]), pk_bf16(v1[0], v1[1]), pk_bf16(v1[2], v1[3]));
        }
        asm volatile("" ::: "memory");
      }
  }
};
struct EpiInProj {
  static constexpr bool PERM = true, AFTER_DRAIN = false;
  const float* parts;
  bf16_t *S5A, *Qm, *Km, *vrow, *Qr, *Kr, *krow, *vrrow, *grow;
  const float *gq, *gk, *cosm, *sinm, *cosr, *sinr;
  EPI_ZERO_INIT
  __device__ __forceinline__ void operator()(const pg8::f32x4 (&acc)[2][2][4][2], const pg8::Unit& u, int wr, int wc, int fr_in, int fq_in) const {
    int fr = fr_in, fq = fq_in; asm volatile("" : "+v"(fr), "+v"(fq));
    const int pn = u.pn;
    float gain[2][8];
    if (pn >= 1 && pn <= 4) {
      const float* gsrc = pn <= 2 ? gq : gk;
#pragma unroll
      for (int bj = 0; bj < 2; ++bj) { const pg8::f32x4 a = *(const pg8::f32x4*)(gsrc + bj * 32 + 8 * fq), b = *(const pg8::f32x4*)(gsrc + bj * 32 + 8 * fq + 4);
        gain[bj][0] = a[0]; gain[bj][1] = a[1]; gain[bj][2] = a[2]; gain[bj][3] = a[3]; gain[bj][4] = b[0]; gain[bj][5] = b[1]; gain[bj][6] = b[2]; gain[bj][7] = b[3]; }
    }
    const float l2g = ret_log2g(wc);
#pragma unroll
    for (int ai = 0; ai < 2; ++ai)
#pragma unroll
      for (int m = 0; m < 4; ++m) {
        const int t = u.pm * 256 + ai * 128 + wr * 64 + m * 16 + fr, s = t & (S - 1), b = t >> 12;
        float r;
        { const pg8::f32x4 p0 = *(const pg8::f32x4*)(parts + (size_t)t * 8), p1 = *(const pg8::f32x4*)(parts + (size_t)t * 8 + 4);
          r = rsqrtf((((p0[0] + p0[1]) + (p0[2] + p0[3])) + ((p1[0] + p1[1]) + (p1[2] + p1[3]))) * (1.0f / (float)D) + EPS); }
        float v[2][8];
#pragma unroll
        for (int bj = 0; bj < 2; ++bj)
#pragma unroll
          for (int e = 0; e < 8; ++e) v[bj][e] = acc[ai][bj][m][e >> 2][e & 3] * r;
#define PK8(x_) make_uint4(pk_bf16((x_)[0], (x_)[1]), pk_bf16((x_)[2], (x_)[3]), pk_bf16((x_)[4], (x_)[5]), pk_bf16((x_)[6], (x_)[7]))
        if (pn == 0) {
#pragma unroll
          for (int bj = 0; bj < 2; ++bj) { const int g = wc * 4 + bj * 2 + (fq >> 1);
            *(uint4*)(S5A + ((size_t)g * 1024 + (t >> 5)) * 640 + (t & 31) * 16 + 8 * (fq & 1)) = PK8(v[bj]); }
        } else if (pn <= 4) {
          const bool isk = pn >= 3; const int h = ((pn - 1) & 1) * 4 + wc, bh = b * 8 + h;
          float ss = 0.f;
#pragma unroll
          for (int bj = 0; bj < 2; ++bj)
#pragma unroll
            for (int e = 0; e < 8; ++e) ss += v[bj][e] * v[bj][e];
          ss += __shfl_xor(ss, 16); ss += __shfl_xor(ss, 32);
          const float rh = rsqrtf(ss * (1.0f / 64.0f) + EPS);
#pragma unroll
          for (int bj = 0; bj < 2; ++bj)
#pragma unroll
            for (int e = 0; e < 8; ++e) v[bj][e] *= rh * gain[bj][e];
          { const pg8::f32x4 c0 = *(const pg8::f32x4*)(cosm + s * 8), c1 = *(const pg8::f32x4*)(cosm + s * 8 + 4), s0 = *(const pg8::f32x4*)(sinm + s * 8), s1 = *(const pg8::f32x4*)(sinm + s * 8 + 4);
#pragma unroll
            for (int e = 0; e < 8; ++e) {
              const float pu = __shfl_xor(v[0][e], 16);
              const float c = e < 4 ? c0[e & 3] : c1[e & 3], sn = e < 4 ? s0[e & 3] : s1[e & 3];
              const float o = fq == 0 ? (v[0][e] * c - pu * sn) : (v[0][e] * c + pu * sn);
              v[0][e] = fq < 2 ? o : v[0][e];
            } }
          if (!isk) {
#pragma unroll
            for (int bj = 0; bj < 2; ++bj) { float q8[8];
#pragma unroll
              for (int e = 0; e < 8; ++e) q8[e] = v[bj][e] * QSCALE;
              *(uint4*)(Qm + ((size_t)bh * S + s) * 64 + bj * 32 + 8 * fq) = PK8(q8); }
          } else {
#pragma unroll
            for (int bj = 0; bj < 2; ++bj) *(uint4*)(Km + ((((size_t)bh * (S / 32) + (s >> 5)) * 8 + bj * 4 + fq) * 32 + (s & 31)) * 8) = PK8(v[bj]);
          }
        } else if (pn <= 6) {
#pragma unroll
          for (int bj = 0; bj < 2; ++bj) *(uint4*)(vrow + (size_t)t * 512 + (pn - 5) * 256 + wc * 64 + bj * 32 + 8 * fq) = PK8(v[bj]);
        } else if (pn <= 8) {
          const bool isk = pn == 8; const int bh = b * 4 + wc, pos = s & 127;
          const float sc = isk ? 0.125f * exp2f(-(float)pos * l2g) : exp2f((float)pos * l2g);
          const pg8::f32x4 c0 = *(const pg8::f32x4*)(cosr + s * 32 + 8 * fq), c1 = *(const pg8::f32x4*)(cosr + s * 32 + 8 * fq + 4);
          const pg8::f32x4 s0 = *(const pg8::f32x4*)(sinr + s * 32 + 8 * fq), s1 = *(const pg8::f32x4*)(sinr + s * 32 + 8 * fq + 4);
          float o1[8], o2[8];
#pragma unroll
          for (int e = 0; e < 8; ++e) { const float c = e < 4 ? c0[e & 3] : c1[e & 3], sn = e < 4 ? s0[e & 3] : s1[e & 3];
            o1[e] = (v[0][e] * c - v[1][e] * sn) * sc; o2[e] = (v[1][e] * c + v[0][e] * sn) * sc; }
          if (!isk) {
            *(uint4*)(Qr + ((size_t)bh * S + s) * 64 + 8 * fq) = PK8(o1); *(uint4*)(Qr + ((size_t)bh * S + s) * 64 + 32 + 8 * fq) = PK8(o2);
          } else {
            *(uint4*)(Kr + ((((size_t)bh * (S / 32) + (s >> 5)) * 8 + fq) * 32 + (s & 31)) * 8) = PK8(o1);
            *(uint4*)(Kr + ((((size_t)bh * (S / 32) + (s >> 5)) * 8 + 4 + fq) * 32 + (s & 31)) * 8) = PK8(o2);
            *(uint4*)(krow + (size_t)t * 256 + wc * 64 + 8 * fq) = PK8(o1); *(uint4*)(krow + (size_t)t * 256 + wc * 64 + 32 + 8 * fq) = PK8(o2);
          }
        } else {
          bf16_t* dst = (pn == 9 ? vrrow : grow) + (size_t)t * 256 + wc * 64 + 8 * fq;
          *(uint4*)dst = PK8(v[0]); *(uint4*)(dst + 32) = PK8(v[1]);
        }
#undef PK8
        asm volatile("" ::: "memory");
      }
  }
};
template <class Epi>
__device__ __forceinline__ void run_gemm(unsigned char* lds_raw, const bf16_t* A, const bf16_t* Bt, int M, int N, int K, const Epi& e) {
  pg8::Gemm g{A, Bt, M, N, K, K, K}; pg8::StaticOrder So; So.init(M, N, (int)gridDim.x, (int)blockIdx.x);
  pg8::gemm_phase<Epi, pg8::StaticOrder, true, true>((PG8_LAS unsigned char*)lds_raw, g, So, e);
}

template <bool HEADPERM>
__device__ __forceinline__ void transpose_items(const float* __restrict__ W, int K, int N, const float* __restrict__ g, bf16_t* __restrict__ Wt, int gw, int ngw, int lane) {
  const int nkt = K / 64, nnt = N / 64;
  for (int it = gw; it < nkt * nnt; it += ngw) {
    int kt = it % nkt, ntile = it / nkt;
    int k0 = kt * 64, n = ntile * 64 + lane;
    int ns = n;
    if (HEADPERM) { const int cp = n & 255; ns = (n & ~255) + ((cp >> 5) & 3) * 64 + (cp >> 7) * 32 + (cp & 31); }
    float v[64];
#pragma unroll
    for (int i = 0; i < 64; ++i) v[i] = W[(size_t)(k0 + i) * N + ns] * g[k0 + i];
    bf16_t* dst = Wt + (size_t)n * (K * KS) + k0;
#pragma unroll
    for (int c = 0; c < 8; ++c) {
      bf16_t hi[8], lo[8];
#pragma unroll
      for (int e = 0; e < 8; ++e) { hi[e] = f2bf(v[c * 8 + e]); lo[e] = f2bf(v[c * 8 + e] - bf2f(hi[e])); }
      uint4 ph, pl;
      ph.x = hi[0] | ((unsigned)hi[1] << 16); ph.y = hi[2] | ((unsigned)hi[3] << 16); ph.z = hi[4] | ((unsigned)hi[5] << 16); ph.w = hi[6] | ((unsigned)hi[7] << 16);
      pl.x = lo[0] | ((unsigned)lo[1] << 16); pl.y = lo[2] | ((unsigned)lo[3] << 16); pl.z = lo[4] | ((unsigned)lo[5] << 16); pl.w = lo[6] | ((unsigned)lo[7] << 16);
      *(uint4*)(dst + c * 8) = ph;
      if (PRECISE) { *(uint4*)(dst + K + c * 8) = pl; *(uint4*)(dst + 2 * K + c * 8) = ph; }
    }
  }
}


__device__ __forceinline__ void phase_prologue(const Params& p, int gtid, int ngt, int gw, int ngw, int lane) {
  for (int idx = gtid; idx < S * 40; idx += ngt) {
    int s = idx / 40, i = idx % 40;
    if (i < 8) {
      float inv = powf(500000.0f, -(float)(2 * i) / 16.0f);
      float ang = (float)s * inv;
      p.cosm()[s * 8 + i] = (float)cos((double)ang); p.sinm()[s * 8 + i] = (float)sin((double)ang);
    } else {
      int j = i - 8;
      float inv = powf(10000.0f, -((float)j / 31.0f));
      float ang = (float)s * inv;
      p.cosr()[s * 32 + j] = (float)cos((double)ang); p.sinr()[s * 32 + j] = (float)sin((double)ang);
    }
  }
  { const float4* a = (const float4*)p.inp(0); float4* b = (float4*)p.outp();
    for (size_t i = gtid; i < (size_t)T * D / 4; i += ngt) b[i] = a[i]; }
  for (int t = gw; t < T; t += ngw) {
    const float4* xr = (const float4*)(p.inp(0) + (size_t)t * D); float ss = 0.f;
#pragma unroll
    for (int i = 0; i < 4; ++i) { const float4 v = xr[lane + i * 64]; ss += v.x * v.x + v.y * v.y + v.z * v.z + v.w * v.w;
      *(uint2*)(p.xb() + (size_t)t * KD + (lane + i * 64) * 4) = make_uint2(pk_bf16(v.x, v.y), pk_bf16(v.z, v.w)); }
    ss = wave_sum(ss);
    if (lane < 8) p.ssq1()[(size_t)t * 8 + lane] = lane == 0 ? ss : 0.f;
  }
  for (int idx = gtid; idx < NL * 65536; idx += ngt) { const int l2 = idx >> 16, n2 = (idx >> 8) & 255, k2 = idx & 255; p.Wglu_t()[idx] = f2bf(p.inp(11)[(size_t)l2 * 65536 + k2 * 256 + n2]); }
  for (int l = 0; l < NL; ++l) {
    transpose_items<true>(p.inp(2) + (size_t)l * D * INW, D, INW, p.inp(1) + l * D, p.Win_t() + (size_t)l * INW * KD, gw, ngw, lane);
    transpose_items<false>(p.inp(15) + (size_t)l * D * D, D, D, p.inp(14) + l * D, p.Wout_t() + (size_t)l * D * KD, gw, ngw, lane);
    transpose_items<false>(p.inp(17) + (size_t)l * D * D, D, D, p.inp(16) + l * D, p.Wq_t() + (size_t)l * D * KD, gw, ngw, lane);
  }
}


struct S5P { float lr, li, dt, fr, fi; };
__device__ __forceinline__ S5P s5p(const Params& p, int l, int g, int pp) {
  S5P r; r.lr = p.inp(3)[l * 1024 + g * 64 + pp]; r.li = p.inp(4)[l * 1024 + g * 64 + pp]; r.dt = expf(p.inp(5)[l * 16 + g]);
  const float mag = expf(r.lr * r.dt); float sn, cs; sincosf(r.li * r.dt, &sn, &cs);
  const float ar = mag * cs, ai = mag * sn, den = r.lr * r.lr + r.li * r.li;
  r.fr = ((ar - 1.0f) * r.lr + ai * r.li) / den; r.fi = (ai * r.lr - (ar - 1.0f) * r.li) / den;
  return r;
}
__device__ __forceinline__ void s5pow(const S5P& s, int k, float& re, float& im) {
  const float m = expf((float)k * s.lr * s.dt); float sn, cs; sincosf((float)k * s.li * s.dt, &sn, &cs); re = m * cs; im = m * sn;
}
__device__ __forceinline__ void phase_s5_prep(const Params& p, int l, int gtid, int ngt) {
  const float* b_re = p.inp(6) + l * 16384; const float* b_im = p.inp(7) + l * 16384;
  const float* c_re = p.inp(8) + l * 16384; const float* c_im = p.inp(9) + l * 16384;
  bf16_t* Wy = p.S5Wy(); bf16_t* Wz = p.S5Wz();
  for (int it = gtid; it < 16 * 32 * 256; it += ngt) {
    const int hp = it & 15, h = (it >> 4) & 15, d = (it >> 8) & 31, g = it >> 13;
    float acc = 0.f;
    for (int pp = 0; pp < 64; ++pp) {
      const S5P s = s5p(p, l, g, pp);
      float pr, pi; s5pow(s, d, pr, pi);
      const float br = b_re[(g * 64 + pp) * 16 + hp], bi = b_im[(g * 64 + pp) * 16 + hp];
      const float bbr = s.fr * br - s.fi * bi, bbi = s.fr * bi + s.fi * br;
      const float tr = pr * bbr - pi * bbi, ti = pr * bbi + pi * bbr;
      acc += c_re[(g * 16 + h) * 64 + pp] * tr - c_im[(g * 16 + h) * 64 + pp] * ti;
    }
    const bf16_t v = f2bf(acc);
    for (int jp = 0; jp + d < 32; ++jp) {
      const int j = jp + d;
      Wy[((size_t)g * 512 + j * 16 + h) * 640 + jp * 16 + hp] = v;
      if (d > 0) Wy[((size_t)g * 512 + jp * 16 + h) * 640 + j * 16 + hp] = 0;
    }
  }
  for (int it = gtid; it < 16 * 32 * 16 * 64; it += ngt) {
    const int pp = it & 63, h = (it >> 6) & 15, j = (it >> 10) & 31, g = it >> 15;
    const S5P s = s5p(p, l, g, pp);
    float pr, pi; s5pow(s, j + 1, pr, pi);
    const float cr = c_re[(g * 16 + h) * 64 + pp], ci = c_im[(g * 16 + h) * 64 + pp];
    const unsigned w = pk_bf16(cr * pr - ci * pi, -(cr * pi + ci * pr));
    *(unsigned*)(Wy + ((size_t)g * 512 + j * 16 + h) * 640 + 512 + 2 * pp) = w;
  }
  for (int it = gtid; it < 16 * 64 * 32; it += ngt) {
    const int j = it & 31, pp = (it >> 5) & 63, g = it >> 11;
    const S5P s = s5p(p, l, g, pp);
    float pr, pi; s5pow(s, 31 - j, pr, pi);
    for (int hp = 0; hp < 16; ++hp) {
      const float br = b_re[(g * 64 + pp) * 16 + hp], bi = b_im[(g * 64 + pp) * 16 + hp];
      const float bbr = s.fr * br - s.fi * bi, bbi = s.fr * bi + s.fi * br;
      Wz[((size_t)g * 256 + 2 * pp) * 512 + j * 16 + hp] = f2bf(pr * bbr - pi * bbi);
      Wz[((size_t)g * 256 + 2 * pp + 1) * 512 + j * 16 + hp] = f2bf(pr * bbi + pi * bbr);
    }
  }
  for (int it = gtid; it < 16 * 64; it += ngt) {
    const S5P s = s5p(p, l, it >> 6, it & 63);
    float pr, pi; s5pow(s, 32, pr, pi);
    p.S5a32()[it * 2] = pr; p.S5a32()[it * 2 + 1] = pi;
  }
}
__device__ __forceinline__ void phase_s5_scan(const Params& p, int gtid, int ngt) {
  for (int it = gtid; it < NB * 16 * 64; it += ngt) {
    const int pp = it & 63, g = (it >> 6) & 15, b = it >> 10;
    const float er = p.S5a32()[(g * 64 + pp) * 2], ei = p.S5a32()[(g * 64 + pp) * 2 + 1];
    float sr = 0.f, si = 0.f;
#pragma unroll 1
    for (int c0 = 0; c0 < 128; c0 += 16) {
      float2 z[16];
#pragma unroll
      for (int k = 0; k < 16; ++k) z[k] = *(const float2*)(p.S5Z() + ((size_t)g * 1024 + b * 128 + c0 + k) * 128 + 2 * pp);
#pragma unroll
      for (int k = 0; k < 16; ++k) {
        const size_t ch = (size_t)g * 1024 + b * 128 + c0 + k;
        *(unsigned*)(p.S5A() + ch * 640 + 512 + 2 * pp) = pk_bf16(sr, si);
        const float nr = er * sr - ei * si + z[k].x, ni = er * si + ei * sr + z[k].y;
        sr = nr; si = ni;
      }
    }
  }
}
struct EpiS5Z {
  static constexpr bool PERM = false, AFTER_DRAIN = false;
  float* Z;
  EPI_ZERO_INIT
  __device__ __forceinline__ void operator()(const pg8::f32x4 (&acc)[2][2][4][2], const pg8::Unit& u, int wr, int wc, int fr_in, int fq_in) const {
    int fr = fr_in, fq = fq_in; asm volatile("" : "+v"(fr), "+v"(fq));
    const int g = u.pm >> 2;
#pragma unroll
    for (int ai = 0; ai < 2; ++ai)
#pragma unroll
      for (int m = 0; m < 4; ++m) {
        const int chunk = (u.pm & 3) * 256 + ai * 128 + wr * 64 + m * 16 + fr;
#pragma unroll
        for (int n = 0; n < 2; ++n) *(pg8::f32x4*)(Z + ((size_t)g * 1024 + chunk) * 128 + wc * 32 + n * 16 + 4 * fq) = acc[ai][0][m][n];
      }
  }
};
struct EpiS5Y {
  static constexpr bool PERM = false, AFTER_DRAIN = false;
  bf16_t* ygb; const bf16_t* A; const float* dsk;
  EPI_ZERO_INIT
  __device__ __forceinline__ void operator()(const pg8::f32x4 (&acc)[2][2][4][2], const pg8::Unit& u, int wr, int wc, int fr_in, int fq_in) const {
    int fr = fr_in, fq = fq_in; asm volatile("" : "+v"(fr), "+v"(fq));
    const int g = u.pm >> 2;
#pragma unroll
    for (int ai = 0; ai < 2; ++ai)
#pragma unroll
      for (int m = 0; m < 4; ++m) {
        const int chunk = (u.pm & 3) * 256 + ai * 128 + wr * 64 + m * 16 + fr;
#pragma unroll
        for (int bj = 0; bj < 2; ++bj)
#pragma unroll
          for (int n = 0; n < 2; ++n) {
            const int col = (u.pn & 1) * 256 + bj * 128 + wc * 32 + n * 16 + 4 * fq, j = col >> 4, h = col & 15;
            const uint2 uu = *(const uint2*)(A + ((size_t)g * 1024 + chunk) * 640 + col);
            const pg8::f32x4 dv = *(const pg8::f32x4*)(dsk + g * 16 + h);
            const pg8::f32x4 v = acc[ai][bj][m][n];
            const float y0 = fast_gelu(v[0] + dv[0] * __uint_as_float(uu.x << 16)), y1 = fast_gelu(v[1] + dv[1] * __uint_as_float(uu.x & 0xffff0000u));
            const float y2 = fast_gelu(v[2] + dv[2] * __uint_as_float(uu.y << 16)), y3 = fast_gelu(v[3] + dv[3] * __uint_as_float(uu.y & 0xffff0000u));
            uint2 o; o.x = pk_bf16(y0, y1); o.y = pk_bf16(y2, y3);
            *(uint2*)(ygb + ((size_t)chunk * 32 + j) * 256 + g * 16 + h) = o;
          }
        asm volatile("" ::: "memory");
      }
  }
};
struct EpiGlu {
  static constexpr bool PERM = false, AFTER_DRAIN = false;
  bf16_t* yb; const bf16_t* ygb; float* scr;
  EPI_ZERO_INIT
  __device__ __forceinline__ void operator()(const pg8::f32x4 (&acc_)[2][2][4][2], const pg8::Unit& u, int wr, int wc, int fr_in, int fq_in) const {
    int fr = fr_in, fq = fq_in; asm volatile("" : "+v"(fr), "+v"(fq));
    pg8::f32x4 (&acc)[2][2][4][2] = const_cast<pg8::f32x4 (&)[2][2][4][2]>(acc_);
#pragma unroll
    for (int ai = 0; ai < 2; ++ai)
#pragma unroll
      for (int m = 0; m < 4; ++m) {
        const int rl = ai * 128 + wr * 64 + m * 16 + fr, row = u.pm * 256 + rl;
        float ss = 0.f;
#pragma unroll
        for (int bj = 0; bj < 2; ++bj)
#pragma unroll
          for (int n = 0; n < 2; ++n) {
            const int col = bj * 128 + wc * 32 + n * 16 + 4 * fq;
            const uint2 yy = *(const uint2*)(ygb + (size_t)row * 256 + col);
            const pg8::f32x4 z = acc[ai][bj][m][n];
            pg8::f32x4 r;
            r[0] = __uint_as_float(yy.x << 16) * fast_sigmoid(z[0]); r[1] = __uint_as_float(yy.x & 0xffff0000u) * fast_sigmoid(z[1]);
            r[2] = __uint_as_float(yy.y << 16) * fast_sigmoid(z[2]); r[3] = __uint_as_float(yy.y & 0xffff0000u) * fast_sigmoid(z[3]);
            acc[ai][bj][m][n] = r;
            ss += r[0] * r[0] + r[1] * r[1] + r[2] * r[2] + r[3] * r[3];
          }
        ss += __shfl_xor(ss, 16); ss += __shfl_xor(ss, 32);
        if (fq == 0) scr[rl * 4 + wc] = ss;
        asm volatile("" ::: "memory");
      }
    asm volatile("s_waitcnt lgkmcnt(0)" ::: "memory"); __builtin_amdgcn_s_barrier(); asm volatile("" ::: "memory");
#pragma unroll
    for (int ai = 0; ai < 2; ++ai)
#pragma unroll
      for (int m = 0; m < 4; ++m) {
        const int rl = ai * 128 + wr * 64 + m * 16 + fr, row = u.pm * 256 + rl;
        const pg8::f32x4 s4 = *(const pg8::f32x4*)(scr + rl * 4);
        const float r = rsqrtf((s4[0] + s4[1] + s4[2] + s4[3]) / 256.0f + EPS);
#pragma unroll
        for (int bj = 0; bj < 2; ++bj)
#pragma unroll
          for (int n = 0; n < 2; ++n) { const pg8::f32x4 v = acc[ai][bj][m][n] * r; *(uint2*)(yb + (size_t)row * KD + bj * 128 + wc * 32 + n * 16 + 4 * fq) = make_uint2(pk_bf16(v[0], v[1]), pk_bf16(v[2], v[3])); }
        asm volatile("" ::: "memory");
      }
    asm volatile("s_waitcnt lgkmcnt(0)" ::: "memory"); __builtin_amdgcn_s_barrier(); asm volatile("" ::: "memory");
  }
};


__device__ __forceinline__ void phase_moba2(const Params& p, int l, unsigned char* lds, int* uq) {
  constexpr int OLD = 260;
  bf16_t* Qs = (bf16_t*)lds;
  float* Oaccf = (float*)(lds + 32768);
  float* laccf = (float*)(lds + 32768 + 64 * OLD * 4);
  float* kms = laccf + 256;
  float* gat = kms + 1024;
  unsigned char* lists = (unsigned char*)(gat + 4096);
  int* cnt = (int*)(lists + 4096);
  int* items = cnt + 16;
  int* ctr = items + 160;
  unsigned* selp = (unsigned*)(ctr + 4);
  float* bq = (float*)(selp + 256);
  int* Oacc = (int*)Oaccf; int* lacc = (int*)laccf;
  float kmax = 0.f;
  { const float* gk = p.inp(13) + l * 64;
    for (int d = 0; d < 64; ++d) kmax = fmaxf(kmax, fabsf(gk[d]));
    kmax *= 8.0f * 1.01f; }
  for (;;) {
    const int u = q_pull(uq, NB * 8 * 16, (int*)(lds + 131072), threadIdx.x);
    if (u < 0) break;
    const int qblk = 15 - (u >> 6), bh = u & 63, b = bh >> 3, h = bh & 7;
    int tid = threadIdx.x; asm volatile("" : "+v"(tid));
    const int lane = tid & 63, wv = tid >> 6, n = lane & 31, hh = lane >> 5;
    __syncthreads();
    { const uint4* src = (const uint4*)(p.Qm() + ((size_t)bh * S + qblk * 256) * 64);
      uint4* dst = (uint4*)Qs;
      for (int i = tid; i < 256 * 64 * 2 / 16; i += NTHR) dst[i] = src[i]; }
    for (int i = tid; i < qblk * 64; i += NTHR) kms[i] = p.kmean()[(size_t)bh * 1024 + i];
    for (int i = tid; i < 64 * OLD; i += NTHR) Oacc[i] = 0;
    if (tid < 256) lacc[tid] = 0;
    if (tid < 16) cnt[tid] = 0;
    __syncthreads();
    { const int q = tid & 255, par = tid >> 8;
      float qv[64];
#pragma unroll
      for (int c = 0; c < 8; ++c) {
        uint4 w = *(const uint4*)(Qs + q * 64 + c * 8);
        qv[c * 8 + 0] = __uint_as_float(w.x << 16); qv[c * 8 + 1] = __uint_as_float(w.x & 0xffff0000u);
        qv[c * 8 + 2] = __uint_as_float(w.y << 16); qv[c * 8 + 3] = __uint_as_float(w.y & 0xffff0000u);
        qv[c * 8 + 4] = __uint_as_float(w.z << 16); qv[c * 8 + 5] = __uint_as_float(w.z & 0xffff0000u);
        qv[c * 8 + 6] = __uint_as_float(w.w << 16); qv[c * 8 + 7] = __uint_as_float(w.w & 0xffff0000u);
      }
      if (par == 0) { float qq = 0.f;
#pragma unroll
        for (int d = 0; d < 64; ++d) qq = fmaf(qv[d], qv[d], qq);
        bq[q] = sqrtf(qq) * kmax; }
      for (int j = par; j < qblk; j += 2) {
        float g = 0.f;
#pragma unroll
        for (int d = 0; d < 64; ++d) g = fmaf(qv[d], kms[j * 64 + d], g);
        gat[q * 16 + j] = g;
      }
    }
    __syncthreads();
    if (tid < 256) {
      float b0 = -INFINITY, b1 = -INFINITY, b2 = -INFINITY; int i0 = 0, i1 = 0, i2 = 0;
      for (int j = 0; j < qblk; ++j) {
        float g = gat[tid * 16 + j];
        if (g > b0) { b2 = b1; i2 = i1; b1 = b0; i1 = i0; b0 = g; i0 = j; }
        else if (g > b1) { b2 = b1; i2 = i1; b1 = g; i1 = j; }
        else if (g > b2) { b2 = g; i2 = j; }
      }
      const int nsel = qblk < 3 ? qblk : 3;
      selp[tid] = (unsigned)i0 | ((unsigned)i1 << 4) | ((unsigned)i2 << 8) | ((unsigned)nsel << 12);
    }
    __syncthreads();
    for (int j = wv; j < qblk; j += 8) {
      int base = 0;
      for (int c = 0; c < 4; ++c) {
        const int q = c * 64 + lane;
        const unsigned sp = selp[q];
        const int ns = sp >> 12;
        const bool f = (ns > 0 && (int)(sp & 15) == j) || (ns > 1 && (int)((sp >> 4) & 15) == j) || (ns > 2 && (int)((sp >> 8) & 15) == j);
        const unsigned long long bal = __ballot(f);
        const int pos = base + __popcll(bal & ((1ull << lane) - 1ull));
        if (f) lists[j * 256 + pos] = (unsigned char)q;
        base += __popcll(bal);
      }
      if (lane == 0) cnt[j] = base;
    }
    __syncthreads();
    if (tid == 0) {
      int ni = 0;
#pragma unroll 1
      for (int g = 7; g >= 0; --g) items[ni++] = (16 << 8) | g;
      for (int j = 0; j < qblk; ++j) { const int ng = (cnt[j] + 31) >> 5; for (int g = 0; g < ng; ++g) items[ni++] = (j << 8) | g; }
      ctr[0] = ni; ctr[1] = 0;
    }
    __syncthreads();
    const int nitems = ctr[0];
    DUP(11) {
    if (rep_ > 0) { __syncthreads(); if (tid == 0) ctr[1] = 0; __syncthreads(); }
    for (;;) {
      int it = 0;
      if (lane == 0) it = atomicAdd(&ctr[1], 1);
      it = __builtin_amdgcn_readfirstlane(it);
      if (it >= nitems) break;
      const int item = items[it];
      const int j = item >> 8, g = item & 255;
      const bool own = (j == 16);
      const int kb = own ? qblk : j;
      const int ntile = own ? (g + 1) : 8;
      int qi; bool valid;
      if (own) { qi = g * 32 + n; valid = true; }
      else { const int pos = g * 32 + n; valid = pos < cnt[j]; qi = lists[j * 256 + (valid ? pos : 0)]; }
      const bf16_t* kt0 = p.Km() + ((size_t)bh * (S / 32) + kb * 8) * 2048 + lane * 8;
      const bf16_t* vt0 = p.Vm() + ((size_t)bh * (S / 32) + kb * 8) * 2048 + lane * 8;
      f32x16 O0, O1;
#pragma unroll
      for (int r = 0; r < 16; ++r) { O0[r] = 0.f; O1[r] = 0.f; }
      float lsum = 0.f;
      const float nbq = -bq[qi];
      bf16x8 kf[3][4], vf[3][4];
#define MOBA_LOAD(KT_, BUF_) { _Pragma("unroll") for (int s = 0; s < 4; ++s) { kf[BUF_][s] = *(const bf16x8*)(kt0 + (size_t)(KT_) * 2048 + s * 512); vf[BUF_][s] = *(const bf16x8*)(vt0 + (size_t)(KT_) * 2048 + s * 512); } }
#define MOBA_STEP(KT_, BUF_)                                                                                                           \
      if ((KT_) < ntile) {                                                                                                               \
        if ((KT_) + 2 < ntile) MOBA_LOAD((KT_) + 2, ((BUF_) + 2) % 3)                                                                     \
        f32x16 X;                                                                                                                         \
        _Pragma("unroll") for (int r = 0; r < 16; ++r) X[r] = nbq;                                                                        \
        _Pragma("unroll") for (int s = 0; s < 4; ++s) X = __builtin_amdgcn_mfma_f32_32x32x16_bf16(kf[BUF_][s], *(const bf16x8*)(Qs + qi * 64 + (2 * s + hh) * 8), X, 0, 0, 0);     \
        const bool diag = own && ((KT_) == g);                                                                                            \
        unsigned pw[8];                                                                                                                   \
        _Pragma("unroll") for (int r = 0; r < 16; r += 2) {                                                                               \
          float e0 = __builtin_amdgcn_exp2f(X[r]), e1 = __builtin_amdgcn_exp2f(X[r + 1]);                                                 \
          if (diag) {                                                                                                                     \
            const int k0 = (r & 3) + 8 * (r >> 2) + 4 * hh, k1 = ((r + 1) & 3) + 8 * ((r + 1) >> 2) + 4 * hh;                             \
            e0 = (k0 <= n) ? e0 : 0.f; e1 = (k1 <= n) ? e1 : 0.f;                                                                         \
          }                                                                                                                               \
          lsum += e0 + e1;                                                                                                                \
          pw[r >> 1] = pk_bf16(e0, e1);                                                                                                   \
        }                                                                                                                                 \
        bf16x8 pf0, pf1;                                                                                                                  \
        { uint4 t0 = make_uint4(pw[0], pw[1], pw[2], pw[3]), t1 = make_uint4(pw[4], pw[5], pw[6], pw[7]);                                 \
          pf0 = *(bf16x8*)&t0; pf1 = *(bf16x8*)&t1; }                                                                                     \
        O0 = __builtin_amdgcn_mfma_f32_32x32x16_bf16(vf[BUF_][0], pf0, O0, 0, 0, 0);                                                      \
        O0 = __builtin_amdgcn_mfma_f32_32x32x16_bf16(vf[BUF_][1], pf1, O0, 0, 0, 0);                                                      \
        O1 = __builtin_amdgcn_mfma_f32_32x32x16_bf16(vf[BUF_][2], pf0, O1, 0, 0, 0);                                                      \
        O1 = __builtin_amdgcn_mfma_f32_32x32x16_bf16(vf[BUF_][3], pf1, O1, 0, 0, 0);                                                      \
      }
      MOBA_LOAD(0, 0)
      if (ntile > 1) MOBA_LOAD(1, 1)
#pragma unroll 1
      for (int kt3 = 0; kt3 < ntile; kt3 += 3) {
        MOBA_STEP(kt3, 0) MOBA_STEP(kt3 + 1, 1) MOBA_STEP(kt3 + 2, 2)
      }
#undef MOBA_STEP
#undef MOBA_LOAD
      lsum += __shfl_xor(lsum, 32);
      if (valid) {
        if (hh == 0) atomicAdd(&lacc[qi], __float2int_rn(lsum * 1048576.0f));
#pragma unroll
        for (int r = 0; r < 16; ++r) {
          const int dim = (r & 3) + 8 * (r >> 2) + 4 * hh;
          atomicAdd(&Oacc[dim * OLD + qi], __float2int_rn(O0[r] * 1048576.0f));
          atomicAdd(&Oacc[(dim + 32) * OLD + qi], __float2int_rn(O1[r] * 1048576.0f));
        }
      }
    }
    }
    __syncthreads();
    { const int q = tid >> 1, half = tid & 1;
      const float inv = 1.0f / (float)lacc[q];
      float o[32], ss = 0.f;
#pragma unroll
      for (int d = 0; d < 32; ++d) { o[d] = (float)Oacc[(half * 32 + d) * OLD + q] * inv; ss += o[d] * o[d]; }
      ss += __shfl_xor(ss, 1);
      const float r = rsqrtf(ss / 64.0f + EPS);
      bf16_t* dst = p.xb() + (size_t)(b * S + qblk * 256 + q) * KD + 256 + h * 64 + half * 32;
#pragma unroll
      for (int d = 0; d < 32; d += 8) *(uint4*)(dst + d) = make_uint4(pk_bf16(o[d] * r, o[d + 1] * r), pk_bf16(o[d + 2] * r, o[d + 3] * r), pk_bf16(o[d + 4] * r, o[d + 5] * r), pk_bf16(o[d + 6] * r, o[d + 7] * r));
    }
  }
}


__device__ __forceinline__ void phase_ret_kv(const Params& p, int gw, int ngw, int lane) {
  const int n = lane & 31, hh = lane >> 5;
  for (int w = gw; w < NB * 4 * 32; w += ngw) {
    const int bh = w >> 5, cn = w & 31;
    const bf16_t* vt = p.Vr() + ((size_t)bh * (S / 32) + cn * 4) * 2048 + lane * 8;
    const bf16_t* kt = p.Krv() + ((size_t)bh * (S / 32) + cn * 4) * 2048 + lane * 8;
    f32x16 acc[2][2];
#pragma unroll
    for (int a = 0; a < 2; ++a)
#pragma unroll
      for (int b2 = 0; b2 < 2; ++b2)
#pragma unroll
        for (int r = 0; r < 16; ++r) acc[a][b2][r] = 0.f;
#pragma unroll 1
    for (int tl = 0; tl < 4; ++tl)
#pragma unroll
      for (int ks = 0; ks < 2; ++ks) {
        bf16x8 vf[2], kf[2];
#pragma unroll
        for (int x = 0; x < 2; ++x) { vf[x] = *(const bf16x8*)(vt + tl * 2048 + (x * 2 + ks) * 512); kf[x] = *(const bf16x8*)(kt + tl * 2048 + (x * 2 + ks) * 512); }
#pragma unroll
        for (int mb = 0; mb < 2; ++mb)
#pragma unroll
          for (int nb = 0; nb < 2; ++nb) acc[mb][nb] = __builtin_amdgcn_mfma_f32_32x32x16_bf16(vf[mb], kf[nb], acc[mb][nb], 0, 0, 0);
      }
    float* dst = p.KVr() + ((size_t)bh * 32 + cn) * 4096;
#pragma unroll
    for (int mb = 0; mb < 2; ++mb)
#pragma unroll
      for (int nb = 0; nb < 2; ++nb)
#pragma unroll
        for (int r = 0; r < 16; ++r) dst[(mb * 32 + (r & 3) + 8 * (r >> 2) + 4 * hh) * 64 + nb * 32 + n] = acc[mb][nb][r];
  }
}
__device__ __forceinline__ void phase_ret_scan(const Params& p, int gtid, int ngt) {
  for (int it = gtid; it < NB * 4 * 4096; it += ngt) {
    const int e = it & 4095, bh = it >> 12, h = bh & 3;
    const float l2g = ret_log2g(h), g1 = exp2f(l2g), g127 = exp2f(127.0f * l2g), g128 = exp2f(128.0f * l2g);
    float R = 0.f; float kv[32];
#pragma unroll
    for (int cn = 0; cn < 32; ++cn) kv[cn] = p.KVr()[((size_t)bh * 32 + cn) * 4096 + e];
#pragma unroll
    for (int cn = 0; cn < 32; ++cn) {
      p.Rb()[((size_t)bh * 32 + cn) * 4096 + e] = f2bf(g1 * R);
      R = g128 * R + g127 * kv[cn];
    }
  }
}
__device__ __forceinline__ void phase_ret_out(const Params& p, int gw, int ngw, int lane) {
  const int n = lane & 31, hh = lane >> 5;
  for (int w = gw; w < NB * 4 * 32 * 4; w += ngw) {
    const int qg = 3 - (w & 3), cn = (w >> 2) & 31, bh = w >> 7, b = bh >> 2, h = bh & 3;
    const int s0 = cn * 128 + qg * 32;
    bf16x8 qf[4];
#pragma unroll
    for (int s = 0; s < 4; ++s) qf[s] = *(const bf16x8*)(p.Qr() + ((size_t)bh * S + s0 + n) * 64 + (2 * s + hh) * 8);
    f32x16 O0, O1;
#pragma unroll
    for (int r = 0; r < 16; ++r) { O0[r] = 0.f; O1[r] = 0.f; }
    { const bf16_t* rb = p.Rb() + ((size_t)bh * 32 + cn) * 4096 + (size_t)n * 64 + hh * 8;
#pragma unroll
      for (int s = 0; s < 4; ++s) {
        const bf16x8 r0 = *(const bf16x8*)(rb + s * 16), r1 = *(const bf16x8*)(rb + 32 * 64 + s * 16);
        O0 = __builtin_amdgcn_mfma_f32_32x32x16_bf16(r0, qf[s], O0, 0, 0, 0);
        O1 = __builtin_amdgcn_mfma_f32_32x32x16_bf16(r1, qf[s], O1, 0, 0, 0);
      } }
    const bf16_t* kt0 = p.Kr() + ((size_t)bh * (S / 32) + cn * 4) * 2048 + lane * 8;
    const bf16_t* vt0 = p.Vr() + ((size_t)bh * (S / 32) + cn * 4) * 2048 + lane * 8;
    for (int kt = 0; kt <= qg; ++kt) {
      bf16x8 kf[4], vf[4];
#pragma unroll
      for (int s = 0; s < 4; ++s) { kf[s] = *(const bf16x8*)(kt0 + (size_t)kt * 2048 + s * 512); vf[s] = *(const bf16x8*)(vt0 + (size_t)kt * 2048 + s * 512); }
      f32x16 X;
#pragma unroll
      for (int r = 0; r < 16; ++r) X[r] = 0.f;
#pragma unroll
      for (int s = 0; s < 4; ++s) X = __builtin_amdgcn_mfma_f32_32x32x16_bf16(kf[s], qf[s], X, 0, 0, 0);
      const bool diag = (kt == qg);
      unsigned pw[8];
#pragma unroll
      for (int r = 0; r < 16; r += 2) {
        float e0 = X[r], e1 = X[r + 1];
        if (diag) {
          const int k0 = (r & 3) + 8 * (r >> 2) + 4 * hh, k1 = ((r + 1) & 3) + 8 * ((r + 1) >> 2) + 4 * hh;
          e0 = (k0 <= n) ? e0 : 0.f; e1 = (k1 <= n) ? e1 : 0.f;
        }
        pw[r >> 1] = pk_bf16(e0, e1);
      }
      bf16x8 pf0, pf1;
      { uint4 t0 = make_uint4(pw[0], pw[1], pw[2], pw[3]), t1 = make_uint4(pw[4], pw[5], pw[6], pw[7]);
        pf0 = *(bf16x8*)&t0; pf1 = *(bf16x8*)&t1; }
      O0 = __builtin_amdgcn_mfma_f32_32x32x16_bf16(vf[0], pf0, O0, 0, 0, 0);
      O0 = __builtin_amdgcn_mfma_f32_32x32x16_bf16(vf[1], pf1, O0, 0, 0, 0);
      O1 = __builtin_amdgcn_mfma_f32_32x32x16_bf16(vf[2], pf0, O1, 0, 0, 0);
      O1 = __builtin_amdgcn_mfma_f32_32x32x16_bf16(vf[3], pf1, O1, 0, 0, 0);
    }
    float ss = 0.f;
#pragma unroll
    for (int r = 0; r < 16; ++r) ss += O0[r] * O0[r] + O1[r] * O1[r];
    ss += __shfl_xor(ss, 32);
    const float rn = rsqrtf(ss / 64.0f + EPS);
    const size_t t = (size_t)b * S + s0 + n;
    const bf16_t* gp = p.grow() + t * 256 + h * 64;
    bf16_t* yo = p.xb() + t * KD + 768 + h * 64;
#pragma unroll
    for (int q4 = 0; q4 < 4; ++q4) {
#pragma unroll
      for (int mb = 0; mb < 2; ++mb) {
        const int d0 = mb * 32 + 8 * q4 + 4 * hh;
        const uint2 gw2 = *(const uint2*)(gp + d0); const float4 g = make_float4(__uint_as_float(gw2.x << 16), __uint_as_float(gw2.x & 0xffff0000u), __uint_as_float(gw2.y << 16), __uint_as_float(gw2.y & 0xffff0000u));
        float4 o;
        const f32x16& Oa = mb ? O1 : O0;
        o.x = Oa[q4 * 4 + 0] * rn * g.x * fast_sigmoid(g.x); o.y = Oa[q4 * 4 + 1] * rn * g.y * fast_sigmoid(g.y);
        o.z = Oa[q4 * 4 + 2] * rn * g.z * fast_sigmoid(g.z); o.w = Oa[q4 * 4 + 3] * rn * g.w * fast_sigmoid(g.w);
        *(uint2*)(yo + d0) = make_uint2(pk_bf16(o.x, o.y), pk_bf16(o.z, o.w));
      }
    }
  }
}

__device__ __forceinline__ void phase_post_pack(const Params& p, int gtid, int ngt) {
  for (int idx = gtid; idx < NB * 8 * (S / 32) * 256; idx += ngt) {
    const int ln = idx & 63, ks = (idx >> 6) & 1, mb = (idx >> 7) & 1, tile = (idx >> 8) % (S / 32), bh = idx / (256 * (S / 32));
    const int b = bh >> 3, h = bh & 7, hh = ln >> 5, delta = mb * 32 + (ln & 31);
    bf16_t v[8];
#pragma unroll
    for (int j = 0; j < 8; ++j) { const int kappa = 16 * ks + 8 * (j >> 2) + 4 * hh + (j & 3), s = tile * 32 + kappa; v[j] = p.vrow()[(size_t)(b * S + s) * 512 + h * 64 + delta]; }
    *(uint4*)(p.Vm() + (size_t)idx * 8) = make_uint4(v[0] | ((unsigned)v[1] << 16), v[2] | ((unsigned)v[3] << 16), v[4] | ((unsigned)v[5] << 16), v[6] | ((unsigned)v[7] << 16));
  }
  for (int idx = gtid; idx < 2 * NB * 4 * (S / 32) * 256; idx += ngt) {
    const int ln = idx & 63, ks = (idx >> 6) & 1, blk = (idx >> 7) & 1, tile = (idx >> 8) % (S / 32), rest = idx / (256 * (S / 32)), bh = rest % (NB * 4), which = rest / (NB * 4);
    const int b = bh >> 2, h = bh & 3, hh = ln >> 5, delta = blk * 32 + (ln & 31);
    const bf16_t* srcp = which ? p.krow() : p.vrrow();
    bf16_t v[8];
#pragma unroll
    for (int j = 0; j < 8; ++j) { const int kappa = 16 * ks + 8 * (j >> 2) + 4 * hh + (j & 3), s = tile * 32 + kappa; v[j] = srcp[(size_t)(b * S + s) * 256 + h * 64 + delta]; }
    *(uint4*)((which ? p.Krv() : p.Vr()) + ((size_t)(idx % (NB * 4 * (S / 32) * 256))) * 8) = make_uint4(v[0] | ((unsigned)v[1] << 16), v[2] | ((unsigned)v[3] << 16), v[4] | ((unsigned)v[5] << 16), v[6] | ((unsigned)v[7] << 16));
  }
}
__device__ __forceinline__ void phase_kmean2(const Params& p, int gtid, int ngt) {
  for (int idx = gtid; idx < NB * 8 * 16 * 64; idx += ngt) {
    const int d = idx & 63, j = (idx >> 6) & 15, bh = idx >> 10, c = d >> 3, dj = d & 7;
    float acc = 0.f;
    for (int tl = 0; tl < 8; ++tl) {
      const bf16_t* kp = p.Km() + (((size_t)bh * (S / 32) + j * 8 + tl) * 8 + c) * 256 + dj;
#pragma unroll 8
      for (int key = 0; key < 32; ++key) acc += bf2f(kp[key * 8]);
    }
    p.kmean()[idx] = acc * (1.0f / 256.0f);
  }
}

__device__ __forceinline__ void cvt_f32_bf16(const float* __restrict__ src, bf16_t* __restrict__ dst, size_t n8, int gtid, int ngt) {
  for (size_t i = gtid; i < n8; i += ngt) {
    float4 a = *(const float4*)(src + i * 8), b4 = *(const float4*)(src + i * 8 + 4);
    uint4 o; o.x = pk_bf16(a.x, a.y); o.y = pk_bf16(a.z, a.w); o.z = pk_bf16(b4.x, b4.y); o.w = pk_bf16(b4.z, b4.w);
    *(uint4*)(dst + i * 8) = o;
  }
}
__device__ __forceinline__ int f2key(float f) { int b = __float_as_int(f); return b ^ ((b >> 31) & 0x7fffffff); }
__device__ __forceinline__ float key2f(int k) { return __int_as_float(k ^ ((k >> 31) & 0x7fffffff)); }
#define CASD(a_, b_) { int mx_ = max(a_, b_), mn_ = min(a_, b_); a_ = mx_; b_ = mn_; }
__device__ __forceinline__ void sort16_desc(int (&v)[16]) {
#pragma unroll
  for (int k = 2; k <= 16; k <<= 1)
#pragma unroll
    for (int j = k >> 1; j > 0; j >>= 1)
#pragma unroll
      for (int i = 0; i < 16; ++i) { const int l2 = i ^ j; if (l2 > i) { if ((i & k) == 0) CASD(v[i], v[l2]) else CASD(v[l2], v[i]) } }
}
__device__ __forceinline__ void merge_top16(int (&a)[16], const int (&b)[16]) {
#pragma unroll
  for (int i = 0; i < 16; ++i) a[i] = max(a[i], b[15 - i]);
#pragma unroll
  for (int j = 8; j > 0; j >>= 1)
#pragma unroll
    for (int i = 0; i < 16; ++i) { const int l2 = i ^ j; if (l2 > i) CASD(a[i], a[l2]) }
}
__device__ __forceinline__ int lut4(int w0, int w1, int w2, int w3, int i) {
  const int w = i >> 2; const int d = (w == 0) ? w0 : (w == 1) ? w1 : (w == 2) ? w2 : w3;
  return (d >> ((i & 3) * 8)) & 127;
}

__device__ __forceinline__ void phase_peer_topk(const Params& p, int l, int gw, int ngw, int lane) {
  const int n = lane & 31, hh = lane >> 5;
  const bf16_t* skl = p.skb() + (size_t)l * 16 * 128 * 64;
  for (int w = gw; w < (T / 32) * 8; w += ngw) {
    const int tg = w >> 3, h = w & 7, t = tg * 32 + n;
    int L0[16], L1[16];
#pragma unroll
    for (int c = 0; c < 2; ++c) {
      const int hc = 2 * h + c;
      bf16x8 qf[4];
#pragma unroll
      for (int s = 0; s < 4; ++s) qf[s] = *(const bf16x8*)(p.qb() + (size_t)t * D + hc * 64 + 16 * s + 8 * hh);
      int A[16], Bq[16];
#pragma unroll
      for (int mb = 0; mb < 4; ++mb) {
        f32x16 X;
#pragma unroll
        for (int r = 0; r < 16; ++r) X[r] = 0.f;
#pragma unroll
        for (int s = 0; s < 4; ++s) {
          const bf16x8 kf = *(const bf16x8*)(skl + ((size_t)(hc * 128 + mb * 32 + n)) * 64 + 16 * s + 8 * hh);
          X = __builtin_amdgcn_mfma_f32_32x32x16_bf16(kf, qf[s], X, 0, 0, 0);
        }
        int Gk[16];
#pragma unroll
        for (int r = 0; r < 16; ++r) Gk[r] = (f2key(X[r]) & ~127) | (mb * 32 + (r & 3) + 8 * (r >> 2) + 4 * hh);
        sort16_desc(Gk);
        if (mb == 0) {
#pragma unroll
          for (int r = 0; r < 16; ++r) A[r] = Gk[r];
        } else merge_top16(A, Gk);
      }
#pragma unroll
      for (int r = 0; r < 16; ++r) Bq[r] = __shfl_xor(A[r], 32);
      merge_top16(A, Bq);
#pragma unroll
      for (int r = 0; r < 16; ++r) { if (c == 0) L0[r] = A[r]; else L1[r] = A[r]; }
    }
    float av[16], bv[16];
#pragma unroll
    for (int r = 0; r < 16; ++r) { av[r] = key2f(L0[r] & ~127); bv[r] = key2f(L1[r] & ~127); }
#define CAND(i_, j_) ((f2key(av[i_] + bv[j_]) & ~255) | ((i_) << 4) | (j_))
    int R[16], G1[16], G2[16];
#pragma unroll
    for (int j = 0; j < 16; ++j) R[j] = CAND(0, j);
    G1[0] = CAND(1, 0); G1[1] = CAND(1, 1); G1[2] = CAND(1, 2); G1[3] = CAND(1, 3); G1[4] = CAND(1, 4); G1[5] = CAND(1, 5); G1[6] = CAND(1, 6); G1[7] = CAND(1, 7);
    G1[8] = CAND(2, 0); G1[9] = CAND(2, 1); G1[10] = CAND(2, 2); G1[11] = CAND(2, 3); G1[12] = CAND(2, 4); G1[13] = CAND(3, 0); G1[14] = CAND(3, 1); G1[15] = CAND(3, 2);
    G2[0] = CAND(3, 3); G2[1] = CAND(4, 0); G2[2] = CAND(4, 1); G2[3] = CAND(4, 2); G2[4] = CAND(5, 0); G2[5] = CAND(5, 1); G2[6] = CAND(6, 0); G2[7] = CAND(6, 1);
    G2[8] = CAND(7, 0); G2[9] = CAND(7, 1); G2[10] = CAND(8, 0); G2[11] = CAND(9, 0); G2[12] = CAND(10, 0); G2[13] = CAND(11, 0); G2[14] = CAND(12, 0); G2[15] = CAND(13, 0);
    sort16_desc(G1); merge_top16(R, G1);
    sort16_desc(G2); merge_top16(R, G2);
    { int x0 = CAND(14, 0), x1 = CAND(15, 0);
#pragma unroll
      for (int i = 0; i < 16; ++i) CASD(R[i], x0)
#pragma unroll
      for (int i = 0; i < 16; ++i) CASD(R[i], x1)
    }
#undef CAND
    int pa0 = 0, pa1 = 0, pa2 = 0, pa3 = 0, pb0 = 0, pb1 = 0, pb2 = 0, pb3 = 0;
#pragma unroll
    for (int q = 0; q < 4; ++q) {
      pa0 |= (L0[q] & 127) << (8 * q); pa1 |= (L0[4 + q] & 127) << (8 * q); pa2 |= (L0[8 + q] & 127) << (8 * q); pa3 |= (L0[12 + q] & 127) << (8 * q);
      pb0 |= (L1[q] & 127) << (8 * q); pb1 |= (L1[4 + q] & 127) << (8 * q); pb2 |= (L1[8 + q] & 127) << (8 * q); pb3 |= (L1[12 + q] & 127) << (8 * q);
    }
    float ev[16], sum = 0.f; int ei[16];
    const float mx = key2f(R[0] & ~255);
#pragma unroll
    for (int z = 0; z < 16; ++z) {
      const float v = key2f(R[z] & ~255);
      ev[z] = __expf(v - mx); sum += ev[z];
      const int pay = R[z] & 255;
      ei[z] = lut4(pa0, pa1, pa2, pa3, pay >> 4) * 128 + lut4(pb0, pb1, pb2, pb3, pay & 15);
    }
    const float inv = 1.0f / sum;
    if (hh == 0) {
      float* go = p.gates() + ((size_t)t * 8 + h) * 16; int* eo = p.eidx() + ((size_t)t * 8 + h) * 16;
#pragma unroll
      for (int z = 0; z < 16; z += 4) {
        *(float4*)(go + z) = make_float4(ev[z] * inv, ev[z + 1] * inv, ev[z + 2] * inv, ev[z + 3] * inv);
        *(int4*)(eo + z) = make_int4(ei[z], ei[z + 1], ei[z + 2], ei[z + 3]);
      }
    }
  }
}


typedef int v8i __attribute__((ext_vector_type(8)));
__device__ __forceinline__ unsigned xcc_id() { return (unsigned)__builtin_amdgcn_s_getreg((3 << 11) | 20) & 7u; }
__device__ __forceinline__ float pow2_scale(float amax) {
  if (!(amax > 0.f)) return 1.0f;
  const int e = (int)floorf(log2f(240.0f / amax));
  return exp2f((float)(e < 60 ? (e > -60 ? e : -60) : 60));
}
__device__ __forceinline__ unsigned pack4_fp8(float a, float b, float c, float d) {
  int v = __builtin_amdgcn_cvt_pk_fp8_f32(a, b, 0, false);
  v = __builtin_amdgcn_cvt_pk_fp8_f32(c, d, v, true);
  return (unsigned)v;
}
__device__ __forceinline__ void cvt_table_i8(const float* __restrict__ src, unsigned char* __restrict__ dst, float* __restrict__ scl, int gw, int ngw, int lane) {
  for (int e0 = gw; e0 < 16384; e0 += 2 * ngw) {
    float4 v[2][4];
#pragma unroll
    for (int u = 0; u < 2; ++u) { const int e = (e0 + u * ngw < 16384) ? e0 + u * ngw : e0;
#pragma unroll
      for (int k = 0; k < 4; ++k) v[u][k] = *(const float4*)(src + (size_t)e * D + k * 256 + lane * 4); }
#pragma unroll
    for (int u = 0; u < 2; ++u) {
      const int e = e0 + u * ngw;
      if (e < 16384) {
        float am = 0.f;
#pragma unroll
        for (int k = 0; k < 4; ++k) am = fmaxf(am, fmaxf(fmaxf(fabsf(v[u][k].x), fabsf(v[u][k].y)), fmaxf(fabsf(v[u][k].z), fabsf(v[u][k].w))));
        am = wave_max(am);
        const float s = am > 0.f ? 127.0f / am : 1.0f;
        if (lane == 0) scl[e] = s;
#pragma unroll
        for (int k = 0; k < 4; ++k) {
          const int slice = 2 * k + (lane >> 5), off = (lane & 31) * 4;
          const unsigned w = (unsigned)(__float2int_rn(v[u][k].x * s) & 255) | ((unsigned)(__float2int_rn(v[u][k].y * s) & 255) << 8) |
                             ((unsigned)(__float2int_rn(v[u][k].z * s) & 255) << 16) | ((unsigned)(__float2int_rn(v[u][k].w * s) & 255) << 24);
          *(unsigned*)(dst + ((size_t)slice * 16384 + e) * 128 + off) = w;
        }
      }
    }
  }
}
__device__ __forceinline__ void cvt_table_fp8(const float* __restrict__ src, unsigned char* __restrict__ dst, float* __restrict__ scl, int gw, int ngw, int lane) {
  for (int e0 = gw; e0 < 16384; e0 += 2 * ngw) {
    float4 v[2][4];
#pragma unroll
    for (int u = 0; u < 2; ++u) { const int e = (e0 + u * ngw < 16384) ? e0 + u * ngw : e0;
#pragma unroll
      for (int k = 0; k < 4; ++k) v[u][k] = *(const float4*)(src + (size_t)e * D + k * 256 + lane * 4); }
#pragma unroll
    for (int u = 0; u < 2; ++u) {
      const int e = e0 + u * ngw;
      if (e < 16384) {
        float am = 0.f;
#pragma unroll
        for (int k = 0; k < 4; ++k) am = fmaxf(am, fmaxf(fmaxf(fabsf(v[u][k].x), fabsf(v[u][k].y)), fmaxf(fabsf(v[u][k].z), fabsf(v[u][k].w))));
        am = wave_max(am);
        const float s = pow2_scale(am);
        if (lane == 0) scl[e] = s;
#pragma unroll
        for (int k = 0; k < 4; ++k) {
          const int slice = 2 * k + (lane >> 5), off = (lane & 31) * 4;
          *(unsigned*)(dst + ((size_t)slice * 16384 + e) * 128 + off) = pack4_fp8(v[u][k].x * s, v[u][k].y * s, v[u][k].z * s, v[u][k].w * s);
        }
      }
    }
  }
}
#define DPP_ADD(v_, ctrl_) ((v_) + __builtin_bit_cast(float, __builtin_amdgcn_update_dpp(0, __builtin_bit_cast(int, (v_)), (ctrl_), 0xF, 0xF, true)))
__device__ __forceinline__ float sum_xor16(float x) { float a = x, b = x; asm volatile("v_nop\n\tv_nop\n\tv_permlane16_swap_b32 %0, %1" : "+v"(a), "+v"(b)); return a + b; }
__device__ __forceinline__ float sum_xor32(float x) { float a = x, b = x; asm volatile("v_nop\n\tv_nop\n\tv_permlane32_swap_b32 %0, %1" : "+v"(a), "+v"(b)); return a + b; }
constexpr int PEER_TILE = 128;
__device__ __forceinline__ void phase_peer_u(const Params& p, int* heads, unsigned char* lds, int tid) {
  const int lane = tid & 63, wv = tid >> 6, r8 = lane >> 3, c8 = lane & 7;
  int* bc = (int*)lds;
  int* eW = (int*)(lds + 1024 + wv * 12288);
  bf16_t* hW = (bf16_t*)(lds + 1024 + wv * 12288 + 8192);
  const int myx = (int)xcc_id();
  for (int pass = 0; pass < 8; ++pass) {
    const int s = (myx + pass) & 7;
    const unsigned char* Us = p.U8s() + (size_t)s * 16384 * 128 + c8 * 16;
    for (;;) {
      const int item = q_pull(heads + s, T / PEER_TILE, bc, tid);
      if (item < 0) break;
      const int t0 = item * PEER_TILE + wv * 16;
      LDS_FENCE();
      { uint2 ev[16];
        const bf16_t* hsrc = p.hb() + ((size_t)s * T + t0) * 128 + lane * 8;
#pragma unroll
        for (int k = 0; k < 16; ++k) ev[k] = *(const uint2*)(p.eidx() + (size_t)(t0 + k) * 128 + lane * 2);
        const uint4 hq0 = *(const uint4*)(hsrc), hq1 = *(const uint4*)(hsrc + 512), hq2 = *(const uint4*)(hsrc + 1024), hq3 = *(const uint4*)(hsrc + 1536);
#pragma unroll
        for (int k = 0; k < 16; ++k) *(uint2*)(eW + k * 128 + lane * 2) = ev[k];
        *(uint4*)(hW + lane * 8) = hq0; *(uint4*)(hW + 512 + lane * 8) = hq1; *(uint4*)(hW + 1024 + lane * 8) = hq2; *(uint4*)(hW + 1536 + lane * 8) = hq3; }
      LDS_FENCE();
      uint4 R[4][8];
#define PEER_U_LOAD(M_, BUF_) { _Pragma("unroll") for (int eb = 0; eb < 8; ++eb) R[BUF_][eb] = *(const uint4*)(Us + (size_t)eW[(M_) * 64 + eb * 8 + r8] * 128); }
      if (!(PROBE_SKIP & 128)) { PEER_U_LOAD(0, 0) PEER_U_LOAD(1, 1) PEER_U_LOAD(2, 2) } else { _Pragma("unroll") for (int a_ = 0; a_ < 4; ++a_) _Pragma("unroll") for (int b_ = 0; b_ < 8; ++b_) R[a_][b_] = make_uint4(0u, 0u, 0u, 0u); }
      int hq[4]; float hinv = 0.f; float res0 = 0.f, res1 = 0.f;
#define PEER_U_LOADH(TOK_) { const bf16_t* hp = hW + (TOK_) * 128 + c8 * 16; const uint4 a = *(const uint4*)hp, b4 = *(const uint4*)(hp + 8); \
        const unsigned w8[8] = {a.x, a.y, a.z, a.w, b4.x, b4.y, b4.z, b4.w}; float hv[16]; float am = 0.f;                               \
        _Pragma("unroll") for (int z = 0; z < 8; ++z) { hv[2 * z] = __uint_as_float(w8[z] << 16); hv[2 * z + 1] = __uint_as_float(w8[z] & 0xffff0000u); \
          am = fmaxf(am, fmaxf(fabsf(hv[2 * z]), fabsf(hv[2 * z + 1]))); }                                                                \
        am = fmaxf(am, __builtin_bit_cast(float, __builtin_amdgcn_update_dpp(0, __builtin_bit_cast(int, am), 0xB1, 0xF, 0xF, true)));     \
        am = fmaxf(am, __builtin_bit_cast(float, __builtin_amdgcn_update_dpp(0, __builtin_bit_cast(int, am), 0x4E, 0xF, 0xF, true)));     \
        am = fmaxf(am, __builtin_bit_cast(float, __builtin_amdgcn_update_dpp(0, __builtin_bit_cast(int, am), 0x141, 0xF, 0xF, true)));    \
        const float hs = am > 0.f ? 127.0f / am : 1.0f; hinv = am > 0.f ? am * (1.0f / 127.0f) : 1.0f;                                    \
        _Pragma("unroll") for (int z = 0; z < 4; ++z) hq[z] = (__float2int_rn(hv[4 * z] * hs) & 255) | ((__float2int_rn(hv[4 * z + 1] * hs) & 255) << 8) | \
                                                               ((__float2int_rn(hv[4 * z + 2] * hs) & 255) << 16) | (__float2int_rn(hv[4 * z + 3] * hs) << 24); }
      PEER_U_LOADH(0)
#define PEER_U_HALF(M_, BUF_, HALF_)                                                                           \
      {                                                                                                                                   \
        if (!(PROBE_SKIP & 128)) { if ((M_) + 3 < 32) PEER_U_LOAD((M_) + 3, ((BUF_) + 3) & 3) }                                             \
        if (!(PROBE_SKIP & 128)) _Pragma("unroll") for (int eb = 0; eb < 8; ++eb) {                                                       \
          int di = __builtin_amdgcn_sdot4((int)R[BUF_][eb].x, hq[0], 0, false);                                                           \
          di = __builtin_amdgcn_sdot4((int)R[BUF_][eb].y, hq[1], di, false);                                                              \
          di = __builtin_amdgcn_sdot4((int)R[BUF_][eb].z, hq[2], di, false);                                                              \
          di = __builtin_amdgcn_sdot4((int)R[BUF_][eb].w, hq[3], di, false);                                                              \
          di += __builtin_amdgcn_update_dpp(0, di, 0xB1, 0xF, 0xF, true); di += __builtin_amdgcn_update_dpp(0, di, 0x4E, 0xF, 0xF, true);   \
          di += __builtin_amdgcn_update_dpp(0, di, 0x141, 0xF, 0xF, true);     \
          const float d = (float)di * hinv;                                                                                               \
          if ((HALF_) == 0) { if (c8 == eb) res0 = d; } else { if (c8 == eb) res1 = d; }                                                  \
        }                                                                                                                                 \
        if ((HALF_) == 1) {                                                                                                               \
          bf16_t* po = p.ppart() + ((size_t)s * T + t0 + ((M_) >> 1)) * 128;                                                              \
          po[c8 * 8 + r8] = f2bf(res0); po[64 + c8 * 8 + r8] = f2bf(res1);                                                                \
          if ((M_) + 1 < 32) PEER_U_LOADH(((M_) >> 1) + 1)                                                                                \
        }                                                                                                                                 \
      }
#pragma unroll
      for (int m4 = 0; m4 < 32; m4 += 4) {
        PEER_U_HALF(m4, 0, 0) PEER_U_HALF(m4 + 1, 1, 1) PEER_U_HALF(m4 + 2, 2, 0) PEER_U_HALF(m4 + 3, 3, 1)
      }
#undef PEER_U_HALF
#undef PEER_U_LOADH
#undef PEER_U_LOAD
    }
  }
}
__device__ __forceinline__ void phase_peer_r(const Params& p, int gtid, int ngt) {
  for (int idx0 = gtid; idx0 < T * 128; idx0 += 4 * ngt) {
    float d[4]; int e[4]; float su_[4], sv_[4], g_[4]; bool ok[4];
#pragma unroll
    for (int u = 0; u < 4; ++u) { const int idx = idx0 + u * ngt; ok[u] = idx < T * 128; const int ix = ok[u] ? idx : 0;
      e[u] = p.eidx()[ix]; g_[u] = p.gates()[ix]; float a = 0.f;
#pragma unroll
      for (int s = 0; s < 8; ++s) a += bf2f(p.ppart()[(size_t)s * T * 128 + ix]);
      d[u] = a; }
#pragma unroll
    for (int u = 0; u < 4; ++u) { su_[u] = p.su()[e[u]]; sv_[u] = p.sv()[e[u]]; }
#pragma unroll
    for (int u = 0; u < 4; ++u) if (ok[u]) p.gates()[idx0 + u * ngt] = g_[u] * gelu_tanh(d[u] * p.rstd()[(idx0 + u * ngt) >> 7] / su_[u]) / sv_[u];
  }
}
__device__ __forceinline__ void phase_peer_v(const Params& p, int* heads, unsigned char* lds, int tid) {
  const int lane = tid & 63, wv = tid >> 6, r8 = lane >> 3, c8 = lane & 7;
  int* bc = (int*)lds;
  uint2* pW = (uint2*)(lds + 1024 + wv * 16384);
  const int myx = (int)xcc_id();
  for (int pass = 0; pass < 8; ++pass) {
    const int s = (myx + pass) & 7;
    const unsigned char* Vs = p.V8s() + (size_t)s * 16384 * 128 + c8 * 16;
    for (;;) {
      const int item = q_pull(heads + s, T / PEER_TILE, bc, tid);
      if (item < 0) break;
      const int t0 = item * PEER_TILE + wv * 16;
      LDS_FENCE();
      { uint2 e2[16], g2[16];
#pragma unroll
        for (int k = 0; k < 16; ++k) { e2[k] = *(const uint2*)(p.eidx() + (size_t)(t0 + k) * 128 + lane * 2); g2[k] = *(const uint2*)(p.gates() + (size_t)(t0 + k) * 128 + lane * 2); }
#pragma unroll
        for (int k = 0; k < 16; ++k) *(uint4*)(pW + k * 128 + lane * 2) = make_uint4(e2[k].x, g2[k].x, e2[k].y, g2[k].y); }
      LDS_FENCE();
      const int rowk = lane >> 4, prow = ((rowk & 1) << 1) | (rowk >> 1);
      const bool wr_lane = (lane & 8) == 0;
      const int xoff = s * 128 + c8 * 16 + prow * 4;
      float4 xo[8];
#pragma unroll
      for (int k = 0; k < 8; ++k) xo[k] = *(const float4*)(p.outp() + (size_t)(t0 + k) * D + xoff);
      uint4 R[3][8];
#define PEER_V_LOAD(M_, BUF_) { _Pragma("unroll") for (int eb = 0; eb < 8; ++eb) R[BUF_][eb] = *(const uint4*)(Vs + (size_t)pW[(M_) * 64 + eb * 8 + r8].x * 128); }
      if (!(PROBE_SKIP & 64)) { PEER_V_LOAD(0, 0) PEER_V_LOAD(1, 1) } else { _Pragma("unroll") for (int a_ = 0; a_ < 3; ++a_) _Pragma("unroll") for (int b_ = 0; b_ < 8; ++b_) R[a_][b_] = make_uint4(0u, 0u, 0u, 0u); }
      float acc[16];
#define PEER_V_HALF(M_, BUF_, HALF_)                                                           \
      {                                                                                                                                   \
        if (!(PROBE_SKIP & 64)) { if ((M_) + 2 < 32) PEER_V_LOAD((M_) + 2, ((BUF_) + 2) % 3) }                                              \
        if ((HALF_) == 0) { _Pragma("unroll") for (int z = 0; z < 16; ++z) acc[z] = 0.f; }                                                \
        if (!(PROBE_SKIP & 64)) _Pragma("unroll") for (int eb = 0; eb < 8; ++eb) {                                                        \
          const float c = __uint_as_float(pW[(M_) * 64 + eb * 8 + r8].y);                                                                 \
          const unsigned ww[4] = {R[BUF_][eb].x, R[BUF_][eb].y, R[BUF_][eb].z, R[BUF_][eb].w};                                            \
          _Pragma("unroll") for (int q4 = 0; q4 < 4; ++q4) {                                                                              \
            const auto f01 = __builtin_amdgcn_cvt_pk_f32_fp8((int)ww[q4], false); const auto f23 = __builtin_amdgcn_cvt_pk_f32_fp8((int)ww[q4], true); \
            acc[q4 * 4 + 0] = fmaf(c, f01[0], acc[q4 * 4 + 0]); acc[q4 * 4 + 1] = fmaf(c, f01[1], acc[q4 * 4 + 1]);                       \
            acc[q4 * 4 + 2] = fmaf(c, f23[0], acc[q4 * 4 + 2]); acc[q4 * 4 + 3] = fmaf(c, f23[1], acc[q4 * 4 + 3]);                       \
          }                                                                                                                               \
        }                                                                                                                                 \
        if ((HALF_) == 1) {                                                                                                               \
          _Pragma("unroll") for (int z = 0; z < 16; ++z) acc[z] = DPP_ADD(acc[z], 0x128);                                  \
          asm volatile("v_nop\n\tv_nop\n\tv_permlane16_swap_b32 %0, %8\n\tv_permlane16_swap_b32 %1, %9\n\tv_permlane16_swap_b32 %2, %10\n\tv_permlane16_swap_b32 %3, %11\n\t" \
                       "v_permlane16_swap_b32 %4, %12\n\tv_permlane16_swap_b32 %5, %13\n\tv_permlane16_swap_b32 %6, %14\n\tv_permlane16_swap_b32 %7, %15" \
            : "+v"(acc[0]), "+v"(acc[1]), "+v"(acc[2]), "+v"(acc[3]), "+v"(acc[4]), "+v"(acc[5]), "+v"(acc[6]), "+v"(acc[7]),                   \
              "+v"(acc[8]), "+v"(acc[9]), "+v"(acc[10]), "+v"(acc[11]), "+v"(acc[12]), "+v"(acc[13]), "+v"(acc[14]), "+v"(acc[15]));               \
          _Pragma("unroll") for (int z = 0; z < 8; ++z) acc[z] += acc[z + 8];            \
          asm volatile("v_nop\n\tv_nop\n\tv_permlane32_swap_b32 %0, %4\n\tv_permlane32_swap_b32 %1, %5\n\tv_permlane32_swap_b32 %2, %6\n\tv_permlane32_swap_b32 %3, %7" \
            : "+v"(acc[0]), "+v"(acc[1]), "+v"(acc[2]), "+v"(acc[3]), "+v"(acc[4]), "+v"(acc[5]), "+v"(acc[6]), "+v"(acc[7]));                   \
          float4 dl;                                                                                                                      \
          dl.x = acc[0] + acc[4]; dl.y = acc[1] + acc[5]; dl.z = acc[2] + acc[6]; dl.w = acc[3] + acc[7];     \
          const float4 xv = xo[((M_) >> 1) & 7];                                                                                          \
          if (((M_) >> 1) + 8 < 16) xo[((M_) >> 1) & 7] = *(const float4*)(p.outp() + (size_t)(t0 + ((M_) >> 1) + 8) * D + xoff);                  \
          const float4 xn = make_float4(xv.x + dl.x, xv.y + dl.y, xv.z + dl.z, xv.w + dl.w);                                              \
          float sq = 0.f;                                                                                                                 \
          if (wr_lane) {                                                                                                                  \
            *(float4*)(p.outp() + (size_t)(t0 + ((M_) >> 1)) * D + xoff) = xn;                                                             \
            *(uint2*)(p.xb() + (size_t)(t0 + ((M_) >> 1)) * KD + xoff) = make_uint2(pk_bf16(xn.x, xn.y), pk_bf16(xn.z, xn.w));     \
            sq = (xn.x * xn.x + xn.y * xn.y) + (xn.z * xn.z + xn.w * xn.w);                                                                \
          }                                                                                                                               \
          sq = DPP_ADD(sq, 0xB1); sq = DPP_ADD(sq, 0x4E); sq = DPP_ADD(sq, 0x141); sq = DPP_ADD(sq, 0x128); sq = sum_xor16(sq); sq = sum_xor32(sq);     \
          if (lane == 0) p.ssq1()[(size_t)(t0 + ((M_) >> 1)) * 8 + s] = sq;                                                               \
        }                                                                                                                                 \
      }
#pragma unroll
      for (int m6 = 0; m6 < 30; m6 += 6) {
        PEER_V_HALF(m6, 0, 0) PEER_V_HALF(m6 + 1, 1, 1) PEER_V_HALF(m6 + 2, 2, 0) PEER_V_HALF(m6 + 3, 0, 1) PEER_V_HALF(m6 + 4, 1, 0) PEER_V_HALF(m6 + 5, 2, 1)
      }
      PEER_V_HALF(30, 0, 0) PEER_V_HALF(31, 1, 1)
#undef PEER_V_HALF
#undef PEER_V_LOAD
    }
  }
}

#if PEER_CHECK
constexpr int CHK_N = 512;
__device__ __forceinline__ float* chk_x(const Params& p) { return (float*)(p.ws + WO_ybuf); }
__device__ __forceinline__ float* chk_m(const Params& p) { return (float*)(p.ws + WO_ybuf + (size_t)CHK_N * D * 4); }
__device__ __forceinline__ float* chk_g(const Params& p) { return (float*)(p.ws + WO_ybuf + (size_t)CHK_N * D * 4 + 4096); }
__device__ __forceinline__ void chk_save(const Params& p, int gtid, int ngt) {
  for (int i = gtid; i < CHK_N * D; i += ngt) chk_x(p)[i] = p.outp()[(size_t)(i / D) * 64 * D + (i % D)];
  for (int i = gtid; i < CHK_N * 128; i += ngt) chk_g(p)[i] = p.gates()[(size_t)(i / 128) * 64 * 128 + (i % 128)];
  if (gtid < 16) chk_m(p)[gtid] = 0.f;
}
__device__ __forceinline__ void chk_apply(const Params& p, int l, float* coef, int gw, int ngw, int lane) {
  const float* g2 = p.inp(16) + l * D;
  const float* U = p.inp(19) + (size_t)l * 16384 * D; const float* V = p.inp(20) + (size_t)l * 16384 * D;
  for (int i = gw; i < CHK_N; i += ngw) {
    const int t = i * 64;
    const float r = p.rstd()[t];
    float4 hv[4];
#pragma unroll
    for (int k = 0; k < 4; ++k) {
      float4 xv = *(const float4*)(chk_x(p) + (size_t)i * D + (lane + k * 64) * 4);
      float4 gv = *(const float4*)(g2 + (lane + k * 64) * 4);
      hv[k].x = xv.x * r * gv.x; hv[k].y = xv.y * r * gv.y; hv[k].z = xv.z * r * gv.z; hv[k].w = xv.w * r * gv.w;
    }
    LDS_FENCE();
    for (int j = 0; j < 128; ++j) {
      const int e = p.eidx()[(size_t)t * 128 + j];
      const float4* up = (const float4*)(U + (size_t)e * D);
      float dsum = 0.f;
#pragma unroll
      for (int k = 0; k < 4; ++k) { float4 uv = up[lane + k * 64]; dsum += hv[k].x * uv.x + hv[k].y * uv.y + hv[k].z * uv.z + hv[k].w * uv.w; }
      dsum = wave_sum(dsum);
      if (lane == 0) coef[j] = chk_g(p)[(size_t)i * 128 + j] * gelu_tanh(dsum);
    }
    LDS_FENCE();
    float4 acc[4];
#pragma unroll
    for (int k = 0; k < 4; ++k) acc[k] = make_float4(0.f, 0.f, 0.f, 0.f);
    for (int j = 0; j < 128; ++j) {
      const int e = p.eidx()[(size_t)t * 128 + j];
      const float c = coef[j];
      const float4* vp = (const float4*)(V + (size_t)e * D);
#pragma unroll
      for (int k = 0; k < 4; ++k) { float4 vv = vp[lane + k * 64]; acc[k].x = fmaf(c, vv.x, acc[k].x); acc[k].y = fmaf(c, vv.y, acc[k].y); acc[k].z = fmaf(c, vv.z, acc[k].z); acc[k].w = fmaf(c, vv.w, acc[k].w); }
    }
    float d2 = 0.f, r2 = 0.f;
#pragma unroll
    for (int k = 0; k < 4; ++k) {
      float4 xa = *(const float4*)(p.outp() + (size_t)t * D + (lane + k * 64) * 4);
      float4 xb4 = *(const float4*)(chk_x(p) + (size_t)i * D + (lane + k * 64) * 4);
      float e0 = (xa.x - xb4.x) - acc[k].x, e1 = (xa.y - xb4.y) - acc[k].y, e2 = (xa.z - xb4.z) - acc[k].z, e3 = (xa.w - xb4.w) - acc[k].w;
      d2 += e0 * e0 + e1 * e1 + e2 * e2 + e3 * e3;
      r2 += acc[k].x * acc[k].x + acc[k].y * acc[k].y + acc[k].z * acc[k].z + acc[k].w * acc[k].w;
    }
    d2 = wave_sum(d2); r2 = wave_sum(r2);
    if (lane == 0) { atomicAdd((unsigned long long*)&chk_m(p)[8], (unsigned long long)(d2 * 1099511627776.0f)); atomicAdd((unsigned long long*)&chk_m(p)[10], (unsigned long long)(r2 * 1099511627776.0f)); }
  }
}
__device__ __forceinline__ void chk_topk(const Params& p, int l, int gtid, int ngt) {
  const float* subk = p.inp(18) + (size_t)l * 16 * 128 * 64;
  for (int it = gtid; it < CHK_N * 8; it += ngt) {
    const int i = it >> 3, h = it & 7, t = i * 64;
    float tva[16], tvb[16]; int tia[16], tib[16];
#pragma unroll 1
    for (int c = 0; c < 2; ++c) {
      float tv[16]; int ti[16];
#pragma unroll
      for (int z = 0; z < 16; ++z) { tv[z] = -INFINITY; ti[z] = 0; }
      const bf16_t* q = p.qb() + (size_t)t * D + (2 * h + c) * 64;
      const float* kb = subk + (size_t)(2 * h + c) * 128 * 64;
#pragma unroll 1
      for (int n = 0; n < 128; ++n) {
        float sc = 0.f;
        for (int d = 0; d < 64; ++d) sc = fmaf(bf2f(q[d]), kb[n * 64 + d], sc);
        float v_ = sc; int i_ = n;
#pragma unroll
        for (int z = 0; z < 16; ++z) { bool gt = v_ > tv[z]; float a = tv[z]; int b = ti[z]; tv[z] = gt ? v_ : a; ti[z] = gt ? i_ : b; v_ = gt ? a : v_; i_ = gt ? b : i_; }
      }
#pragma unroll
      for (int z = 0; z < 16; ++z) { if (c == 0) { tva[z] = tv[z]; tia[z] = ti[z]; } else { tvb[z] = tv[z]; tib[z] = ti[z]; } }
    }
    float tv[16]; int ti[16];
#pragma unroll
    for (int z = 0; z < 16; ++z) { tv[z] = -INFINITY; ti[z] = 0; }
#pragma unroll 1
    for (int a = 0; a < 16; ++a)
#pragma unroll 1
      for (int b = 0; b < 16; ++b) {
        float av = 0.f, bv = 0.f; int ai = 0, bi = 0;
#pragma unroll
        for (int z = 0; z < 16; ++z) { if (z == a) { av = tva[z]; ai = tia[z]; } if (z == b) { bv = tvb[z]; bi = tib[z]; } }
        float v_ = av + bv; int i_ = ai * 128 + bi;
#pragma unroll
        for (int z = 0; z < 16; ++z) { bool gt = v_ > tv[z]; float x = tv[z]; int y = ti[z]; tv[z] = gt ? v_ : x; ti[z] = gt ? i_ : y; v_ = gt ? x : v_; i_ = gt ? y : i_; }
      }
    float sum = 0.f, ev[16];
#pragma unroll
    for (int z = 0; z < 16; ++z) { ev[z] = expf(tv[z] - tv[0]); sum += ev[z]; }
    int miss = 0; float gerr = 0.f;
    for (int z = 0; z < 16; ++z) {
      const int ef = p.eidx()[((size_t)t * 8 + h) * 16 + z]; const float gf = p.gates()[((size_t)t * 8 + h) * 16 + z];
      bool found = false;
#pragma unroll
      for (int y = 0; y < 16; ++y) if (ti[y] == ef) { found = true; gerr = fmaxf(gerr, fabsf(ev[y] / sum - gf)); }
      if (!found) ++miss;
    }
    atomicAdd(&chk_m(p)[3], (float)miss);
    atomicMax((int*)&chk_m(p)[4], __float_as_int(gerr));
  }
}
__device__ __forceinline__ void chk_emit(const Params& p) {
  float v = 0.f;
  if (PEER_CHECK == 1) v = sqrtf((float)((double)*(unsigned long long*)&chk_m(p)[8] / (double)*(unsigned long long*)&chk_m(p)[10]));
  if (PEER_CHECK == 2) v = chk_m(p)[3] / (float)(CHK_N * 8 * 16);
  if (PEER_CHECK == 3) v = chk_m(p)[4];
  p.outp()[0] += 1.0e4f * v + 100.0f;
}
#endif

#define XB_TMO      128
#define XB_XCNT(j)  (256  + 64 * (j))
#define XB_XSUB(j)  (1280 + 64 * (j))
#define XB_XGEN(j)  (2304 + 64 * (j))
#define XB_TOP      3328
#define XB_TOPGEN   3392
#define XCD_BAR_WORDS 3456
#define XB_SPIN_CAP (1u << 18)
#define LAS __attribute__((address_space(3)))

__device__ __forceinline__ unsigned xb_ld(unsigned* p)              { return __hip_atomic_load(p, __ATOMIC_RELAXED, __HIP_MEMORY_SCOPE_AGENT); }
__device__ __forceinline__ unsigned xb_add(unsigned* p, unsigned v) { return __hip_atomic_fetch_add(p, v, __ATOMIC_RELAXED, __HIP_MEMORY_SCOPE_AGENT); }
__device__ __forceinline__ unsigned xb_xcc_id() { return (unsigned)__builtin_amdgcn_s_getreg((3 << 11) | 20) & 0xFu; }
#define XB_SPIN(cond, bar) do { unsigned _sp = 0; while (cond) { __builtin_amdgcn_s_sleep(1); \
    if ((++_sp & 255u) == 0u) { if (xb_ld(&(bar)[XB_TMO])) break; if (_sp > XB_SPIN_CAP) { atomicAdd(&(bar)[XB_TMO], 1u); break; } } } } while (0)

struct XcdBarrier {
    unsigned* bar; unsigned x;
    volatile LAS unsigned* st;
};

__device__ __forceinline__ XcdBarrier xcd_barrier_post(unsigned* bar, volatile LAS unsigned* st) {
    XcdBarrier b; b.bar = bar; b.x = xb_xcc_id(); b.st = st;
    if (threadIdx.x == 0) (void)xb_add(&bar[XB_XCNT(b.x)], 1u);
    return b;
}
__device__ __forceinline__ void xcd_barrier_complete(unsigned* bar, unsigned x, unsigned& nloc, unsigned& nx) {
    const unsigned G = gridDim.x * gridDim.y * gridDim.z;
    unsigned sum, cnt, mine, sp = 0u;
    for (;;) {
        sum = 0u; cnt = 0u; mine = 0u;
#pragma unroll
        for (unsigned j = 0; j < 16; ++j) { const unsigned c = xb_ld(&bar[XB_XCNT(j)]); sum += c; cnt += (c > 0u) ? 1u : 0u; mine = (j == x) ? c : mine; }
        if (sum == G) break;
        __builtin_amdgcn_s_sleep(1);
        if ((++sp & 255u) == 0u) { if (xb_ld(&bar[XB_TMO])) break; if (sp > XB_SPIN_CAP) { atomicAdd(&bar[XB_TMO], 1u); break; } }
    }
    nloc = mine > 0u ? mine : 1u; nx = cnt > 0u ? cnt : 1u;
}

__device__ __forceinline__ void xcd_barrier(const XcdBarrier& b) {
    asm volatile("s_waitcnt vmcnt(0)" ::: "memory");
    __syncthreads();
    if (threadIdx.x == 0) {
        unsigned* bar = b.bar;
        __builtin_amdgcn_s_waitcnt(0);
        unsigned nloc = b.st[0], nx = b.st[1];
        if (nloc == 0u) { xcd_barrier_complete(bar, b.x, nloc, nx); b.st[0] = nloc; b.st[1] = nx; }
        const unsigned old = xb_add(&bar[XB_XSUB(b.x)], 1u);
        const unsigned gen = old / nloc;
        if (old + 1u == (gen + 1u) * nloc) {
            __builtin_amdgcn_fence(__ATOMIC_RELEASE, "agent");
            asm volatile("s_waitcnt vmcnt(0)" ::: "memory");
            const unsigned og = xb_add(&bar[XB_TOP], 1u);
            const unsigned tg = og / nx;
            if (og + 1u == (tg + 1u) * nx) xb_add(&bar[XB_TOPGEN], 1u);
            else XB_SPIN(xb_ld(&bar[XB_TOPGEN]) == tg, bar);
            __builtin_amdgcn_fence(__ATOMIC_ACQUIRE, "agent");
            xb_add(&bar[XB_XGEN(b.x)], 1u);
            asm volatile("s_waitcnt vmcnt(0)" ::: "memory");
        } else {
            XB_SPIN(xb_ld(&bar[XB_XGEN(b.x)]) == gen, bar);
            __builtin_amdgcn_fence(__ATOMIC_ACQUIRE, "agent");
            asm volatile("s_waitcnt vmcnt(0)" ::: "memory");
        }
    }
    __syncthreads();
}

__device__ __forceinline__ Params fresh(const Params& p) {
  Params q = p;
  asm volatile("" : "+s"(q.ws), "+s"(q.out_));
#pragma unroll
  for (int i = 0; i < 21; ++i) asm volatile("" : "+s"(q.in[i]));
  return q;
}
#define PHASE_IDS int tid = threadIdx.x; asm volatile("" : "+v"(tid)); int bid = blockIdx.x; asm volatile("" : "+s"(bid)); int G = gridDim.x; asm volatile("" : "+s"(G)); \
  const int lane = tid & 63, wv = tid >> 6; const int ngt = G * NTHR, ngw = G * NWAVE; \
  const int gtid = bid * NTHR + tid, gw = bid * NWAVE + wv; (void)lane; (void)wv; (void)gtid; (void)gw; (void)ngt; (void)ngw; \
  const Params q = fresh(p);
__global__ void __launch_bounds__(NTHR) mega(Params p) {
  extern __shared__ __attribute__((aligned(16))) unsigned char lds_raw[];
  cg::grid_group grid = cg::this_grid();
  float* ldsf = (float*)lds_raw;
  if (threadIdx.x == 0) { *(uint4*)(lds_raw + LDS_BYTES - 16) = make_uint4(0u, 0u, 0u, 0u); }
  __syncthreads();
  XcdBarrier xb = xcd_barrier_post(p.bar(), (volatile LAS unsigned*)(lds_raw + LDS_BYTES - 16));

  { PHASE_IDS; phase_prologue(q, gtid, ngt, gw, ngw, lane); cvt_f32_bf16(q.inp(18), q.skb(), (size_t)NL * 16 * 128 * 64 / 8, gtid, ngt);
    for (size_t i = gtid; i < (size_t)16 * 128 * 512 / 8; i += ngt) { const size_t g = i / (128 * 512 / 8), r = i % (128 * 512 / 8); ((uint4*)q.S5Wz())[g * (256 * 512 / 8) + (128 * 512 / 8) + r] = make_uint4(0u, 0u, 0u, 0u); }
    if (gtid < 256) q.qctr()[gtid] = 0;
    phase_s5_prep(q, 0, gtid, ngt); }
  grid.sync();
  { constexpr int l = 0;
    DUP(5) {
    { const Params q = fresh(p);
      EpiInProj e{q.ssq1(), q.S5A(), q.Qm(), q.Km(), q.vrow(), q.Qr(), q.Kr(), q.krow(), q.vrrow(), q.grow(),
                  q.inp(12) + l * 64, q.inp(13) + l * 64, q.cosm(), q.sinm(), q.cosr(), q.sinr()};
      run_gemm(lds_raw, q.xb(), q.Win_t() + (size_t)l * INW * KD, T, INW, KD, e); }
    xcd_barrier(xb);
    }
    DUP(1) {
    { PHASE_IDS; phase_post_pack(q, gtid, ngt); }
    { const Params q = fresh(p); EpiS5Z e{q.S5Z()};
      pg8::Gemm g{q.S5A(), q.S5Wz(), 16 * 1024, 16 * 256, 512, 640, 512}; pg8::GroupOrder So; So.init(16, 4, 1, (int)gridDim.x, (int)blockIdx.x);
      pg8::gemm_phase<EpiS5Z, pg8::GroupOrder, true, true>((PG8_LAS unsigned char*)lds_raw, g, So, e); }
    { PHASE_IDS; phase_kmean2(q, gtid, ngt); }
    xcd_barrier(xb);
    }
    DUP(2) {
    { PHASE_IDS; phase_s5_scan(q, gtid, ngt); phase_ret_kv(q, gw, ngw, lane); }
    __syncthreads();
    { PHASE_IDS; phase_moba2(q, l, lds_raw, q.qctr() + 64 + l); }
    xcd_barrier(xb);
    }
    DUP(3) {
    { const Params q = fresh(p); EpiS5Y e{q.ygb(), q.S5A(), q.inp(10) + l * 256};
      pg8::Gemm g{q.S5A(), q.S5Wy(), 16 * 1024, 16 * 512, 640, 640, 640}; pg8::GroupOrder So; So.init(16, 4, 2, (int)gridDim.x, (int)blockIdx.x);
      pg8::gemm_phase<EpiS5Y, pg8::GroupOrder, true, true>((PG8_LAS unsigned char*)lds_raw, g, So, e); }
    { PHASE_IDS; phase_ret_scan(q, gtid, ngt); }
    xcd_barrier(xb);
    }
    DUP(4) {
    { const Params q = fresh(p); EpiGlu e{q.xb(), q.ygb(), (float*)(lds_raw + 131072)};
      run_gemm(lds_raw, q.ygb(), q.Wglu_t() + (size_t)l * 65536, T, 256, 256, e); }
    { PHASE_IDS; phase_ret_out(q, gw, ngw, lane); }
    xcd_barrier(xb);
    }
    { PHASE_IDS; cvt_table_i8(q.inp(19) + (size_t)l * 16384 * D, q.U8s(), q.su(), gw, ngw, lane);
      cvt_table_fp8(q.inp(20) + (size_t)l * 16384 * D, q.V8s(), q.sv(), gw, ngw, lane); }
    __syncthreads();
    { const Params q = fresh(p); EpiResid e{q.outp(), D, q.xb2(), q.hb(), q.inp(16) + l * D, q.ssq2()};
      run_gemm(lds_raw, q.xb(), q.Wout_t() + (size_t)l * D * KD, T, D, KD, e); }
    xcd_barrier(xb);
    DUP(7) {
    { const Params q = fresh(p); EpiScaleStoreBf16 e{q.qb(), D, q.ssq2(), 16, q.rstd()};
      run_gemm(lds_raw, q.xb2(), q.Wq_t() + (size_t)l * D * KD, T, D, KD, e); }
    xcd_barrier(xb);
    }
    if (!(PROBE_SKIP & 2)) {
    DUP(8) {
    { PHASE_IDS; phase_peer_topk(q, l, gw, ngw, lane); }
    xcd_barrier(xb);
    }
    }
#if PEER_CHECK
    if (l == 0) { { PHASE_IDS; chk_save(q, gtid, ngt); } xcd_barrier(xb); { PHASE_IDS; chk_topk(q, l, gtid, ngt); } xcd_barrier(xb); }
#endif
    if (!(PROBE_SKIP & 1)) {
    { PHASE_IDS; phase_peer_u(q, q.qctr() + (l * 2 + 0) * 8, lds_raw, tid); }
    xcd_barrier(xb);
    { PHASE_IDS; phase_peer_r(q, gtid, ngt); if (l + 1 < NL) phase_s5_prep(q, l + 1, gtid, ngt); }
    xcd_barrier(xb);
    if (!(PROBE_SKIP & 32)) {
    { PHASE_IDS; phase_peer_v(q, q.qctr() + (l * 2 + 1) * 8, lds_raw, tid); }
    xcd_barrier(xb);
    }
    }
#if PEER_CHECK
    if (l == 0) { { PHASE_IDS; chk_apply(q, l, ldsf + wv * 128, gw, ngw, lane); } xcd_barrier(xb);
      if (blockIdx.x == 0 && threadIdx.x == 0) { const Params q = fresh(p); chk_emit(q); } xcd_barrier(xb); }
#endif
  }
  { constexpr int l = 1;
    DUP(5) {
    { const Params q = fresh(p);
      EpiInProj e{q.ssq1(), q.S5A(), q.Qm(), q.Km(), q.vrow(), q.Qr(), q.Kr(), q.krow(), q.vrrow(), q.grow(),
                  q.inp(12) + l * 64, q.inp(13) + l * 64, q.cosm(), q.sinm(), q.cosr(), q.sinr()};
      run_gemm(lds_raw, q.xb(), q.Win_t() + (size_t)l * INW * KD, T, INW, KD, e); }
    xcd_barrier(xb);
    }
    DUP(1) {
    { PHASE_IDS; phase_post_pack(q, gtid, ngt); }
    { const Params q = fresh(p); EpiS5Z e{q.S5Z()};
      pg8::Gemm g{q.S5A(), q.S5Wz(), 16 * 1024, 16 * 256, 512, 640, 512}; pg8::GroupOrder So; So.init(16, 4, 1, (int)gridDim.x, (int)blockIdx.x);
      pg8::gemm_phase<EpiS5Z, pg8::GroupOrder, true, true>((PG8_LAS unsigned char*)lds_raw, g, So, e); }
    { PHASE_IDS; phase_kmean2(q, gtid, ngt); }
    xcd_barrier(xb);
    }
    DUP(2) {
    { PHASE_IDS; phase_s5_scan(q, gtid, ngt); phase_ret_kv(q, gw, ngw, lane); }
    __syncthreads();
    { PHASE_IDS; phase_moba2(q, l, lds_raw, q.qctr() + 64 + l); }
    xcd_barrier(xb);
    }
    DUP(3) {
    { const Params q = fresh(p); EpiS5Y e{q.ygb(), q.S5A(), q.inp(10) + l * 256};
      pg8::Gemm g{q.S5A(), q.S5Wy(), 16 * 1024, 16 * 512, 640, 640, 640}; pg8::GroupOrder So; So.init(16, 4, 2, (int)gridDim.x, (int)blockIdx.x);
      pg8::gemm_phase<EpiS5Y, pg8::GroupOrder, true, true>((PG8_LAS unsigned char*)lds_raw, g, So, e); }
    { PHASE_IDS; phase_ret_scan(q, gtid, ngt); }
    xcd_barrier(xb);
    }
    DUP(4) {
    { const Params q = fresh(p); EpiGlu e{q.xb(), q.ygb(), (float*)(lds_raw + 131072)};
      run_gemm(lds_raw, q.ygb(), q.Wglu_t() + (size_t)l * 65536, T, 256, 256, e); }
    { PHASE_IDS; phase_ret_out(q, gw, ngw, lane); }
    xcd_barrier(xb);
    }
    { PHASE_IDS; cvt_table_i8(q.inp(19) + (size_t)l * 16384 * D, q.U8s(), q.su(), gw, ngw, lane);
      cvt_table_fp8(q.inp(20) + (size_t)l * 16384 * D, q.V8s(), q.sv(), gw, ngw, lane); }
    __syncthreads();
    { const Params q = fresh(p); EpiResid e{q.outp(), D, q.xb2(), q.hb(), q.inp(16) + l * D, q.ssq2()};
      run_gemm(lds_raw, q.xb(), q.Wout_t() + (size_t)l * D * KD, T, D, KD, e); }
    xcd_barrier(xb);
    DUP(7) {
    { const Params q = fresh(p); EpiScaleStoreBf16 e{q.qb(), D, q.ssq2(), 16, q.rstd()};
      run_gemm(lds_raw, q.xb2(), q.Wq_t() + (size_t)l * D * KD, T, D, KD, e); }
    xcd_barrier(xb);
    }
    if (!(PROBE_SKIP & 2)) {
    DUP(8) {
    { PHASE_IDS; phase_peer_topk(q, l, gw, ngw, lane); }
    xcd_barrier(xb);
    }
    }
#if PEER_CHECK
    if (l == 0) { { PHASE_IDS; chk_save(q, gtid, ngt); } xcd_barrier(xb); { PHASE_IDS; chk_topk(q, l, gtid, ngt); } xcd_barrier(xb); }
#endif
    if (!(PROBE_SKIP & 1)) {
    { PHASE_IDS; phase_peer_u(q, q.qctr() + (l * 2 + 0) * 8, lds_raw, tid); }
    xcd_barrier(xb);
    { PHASE_IDS; phase_peer_r(q, gtid, ngt); if (l + 1 < NL) phase_s5_prep(q, l + 1, gtid, ngt); }
    xcd_barrier(xb);
    if (!(PROBE_SKIP & 32)) {
    { PHASE_IDS; phase_peer_v(q, q.qctr() + (l * 2 + 1) * 8, lds_raw, tid); }
    xcd_barrier(xb);
    }
    }
#if PEER_CHECK
    if (l == 0) { { PHASE_IDS; chk_apply(q, l, ldsf + wv * 128, gw, ngw, lane); } xcd_barrier(xb);
      if (blockIdx.x == 0 && threadIdx.x == 0) { const Params q = fresh(p); chk_emit(q); } xcd_barrier(xb); }
#endif
  }
  { constexpr int l = 2;
    DUP(5) {
    { const Params q = fresh(p);
      EpiInProj e{q.ssq1(), q.S5A(), q.Qm(), q.Km(), q.vrow(), q.Qr(), q.Kr(), q.krow(), q.vrrow(), q.grow(),
                  q.inp(12) + l * 64, q.inp(13) + l * 64, q.cosm(), q.sinm(), q.cosr(), q.sinr()};
      run_gemm(lds_raw, q.xb(), q.Win_t() + (size_t)l * INW * KD, T, INW, KD, e); }
    xcd_barrier(xb);
    }
    DUP(1) {
    { PHASE_IDS; phase_post_pack(q, gtid, ngt); }
    { const Params q = fresh(p); EpiS5Z e{q.S5Z()};
      pg8::Gemm g{q.S5A(), q.S5Wz(), 16 * 1024, 16 * 256, 512, 640, 512}; pg8::GroupOrder So; So.init(16, 4, 1, (int)gridDim.x, (int)blockIdx.x);
      pg8::gemm_phase<EpiS5Z, pg8::GroupOrder, true, true>((PG8_LAS unsigned char*)lds_raw, g, So, e); }
    { PHASE_IDS; phase_kmean2(q, gtid, ngt); }
    xcd_barrier(xb);
    }
    DUP(2) {
    { PHASE_IDS; phase_s5_scan(q, gtid, ngt); phase_ret_kv(q, gw, ngw, lane); }
    __syncthreads();
    { PHASE_IDS; phase_moba2(q, l, lds_raw, q.qctr() + 64 + l); }
    xcd_barrier(xb);
    }
    DUP(3) {
    { const Params q = fresh(p); EpiS5Y e{q.ygb(), q.S5A(), q.inp(10) + l * 256};
      pg8::Gemm g{q.S5A(), q.S5Wy(), 16 * 1024, 16 * 512, 640, 640, 640}; pg8::GroupOrder So; So.init(16, 4, 2, (int)gridDim.x, (int)blockIdx.x);
      pg8::gemm_phase<EpiS5Y, pg8::GroupOrder, true, true>((PG8_LAS unsigned char*)lds_raw, g, So, e); }
    { PHASE_IDS; phase_ret_scan(q, gtid, ngt); }
    xcd_barrier(xb);
    }
    DUP(4) {
    { const Params q = fresh(p); EpiGlu e{q.xb(), q.ygb(), (float*)(lds_raw + 131072)};
      run_gemm(lds_raw, q.ygb(), q.Wglu_t() + (size_t)l * 65536, T, 256, 256, e); }
    { PHASE_IDS; phase_ret_out(q, gw, ngw, lane); }
    xcd_barrier(xb);
    }
    { PHASE_IDS; cvt_table_i8(q.inp(19) + (size_t)l * 16384 * D, q.U8s(), q.su(), gw, ngw, lane);
      cvt_table_fp8(q.inp(20) + (size_t)l * 16384 * D, q.V8s(), q.sv(), gw, ngw, lane); }
    __syncthreads();
    { const Params q = fresh(p); EpiResid e{q.outp(), D, q.xb2(), q.hb(), q.inp(16) + l * D, q.ssq2()};
      run_gemm(lds_raw, q.xb(), q.Wout_t() + (size_t)l * D * KD, T, D, KD, e); }
    xcd_barrier(xb);
    DUP(7) {
    { const Params q = fresh(p); EpiScaleStoreBf16 e{q.qb(), D, q.ssq2(), 16, q.rstd()};
      run_gemm(lds_raw, q.xb2(), q.Wq_t() + (size_t)l * D * KD, T, D, KD, e); }
    xcd_barrier(xb);
    }
    if (!(PROBE_SKIP & 2)) {
    DUP(8) {
    { PHASE_IDS; phase_peer_topk(q, l, gw, ngw, lane); }
    xcd_barrier(xb);
    }
    }
#if PEER_CHECK
    if (l == 0) { { PHASE_IDS; chk_save(q, gtid, ngt); } xcd_barrier(xb); { PHASE_IDS; chk_topk(q, l, gtid, ngt); } xcd_barrier(xb); }
#endif
    if (!(PROBE_SKIP & 1)) {
    { PHASE_IDS; phase_peer_u(q, q.qctr() + (l * 2 + 0) * 8, lds_raw, tid); }
    xcd_barrier(xb);
    { PHASE_IDS; phase_peer_r(q, gtid, ngt); if (l + 1 < NL) phase_s5_prep(q, l + 1, gtid, ngt); }
    xcd_barrier(xb);
    if (!(PROBE_SKIP & 32)) {
    { PHASE_IDS; phase_peer_v(q, q.qctr() + (l * 2 + 1) * 8, lds_raw, tid); }
    xcd_barrier(xb);
    }
    }
#if PEER_CHECK
    if (l == 0) { { PHASE_IDS; chk_apply(q, l, ldsf + wv * 128, gw, ngw, lane); } xcd_barrier(xb);
      if (blockIdx.x == 0 && threadIdx.x == 0) { const Params q = fresh(p); chk_emit(q); } xcd_barrier(xb); }
#endif
  }
  { constexpr int l = 3;
    DUP(5) {
    { const Params q = fresh(p);
      EpiInProj e{q.ssq1(), q.S5A(), q.Qm(), q.Km(), q.vrow(), q.Qr(), q.Kr(), q.krow(), q.vrrow(), q.grow(),
                  q.inp(12) + l * 64, q.inp(13) + l * 64, q.cosm(), q.sinm(), q.cosr(), q.sinr()};
      run_gemm(lds_raw, q.xb(), q.Win_t() + (size_t)l * INW * KD, T, INW, KD, e); }
    xcd_barrier(xb);
    }
    DUP(1) {
    { PHASE_IDS; phase_post_pack(q, gtid, ngt); }
    { const Params q = fresh(p); EpiS5Z e{q.S5Z()};
      pg8::Gemm g{q.S5A(), q.S5Wz(), 16 * 1024, 16 * 256, 512, 640, 512}; pg8::GroupOrder So; So.init(16, 4, 1, (int)gridDim.x, (int)blockIdx.x);
      pg8::gemm_phase<EpiS5Z, pg8::GroupOrder, true, true>((PG8_LAS unsigned char*)lds_raw, g, So, e); }
    { PHASE_IDS; phase_kmean2(q, gtid, ngt); }
    xcd_barrier(xb);
    }
    DUP(2) {
    { PHASE_IDS; phase_s5_scan(q, gtid, ngt); phase_ret_kv(q, gw, ngw, lane); }
    __syncthreads();
    { PHASE_IDS; phase_moba2(q, l, lds_raw, q.qctr() + 64 + l); }
    xcd_barrier(xb);
    }
    DUP(3) {
    { const Params q = fresh(p); EpiS5Y e{q.ygb(), q.S5A(), q.inp(10) + l * 256};
      pg8::Gemm g{q.S5A(), q.S5Wy(), 16 * 1024, 16 * 512, 640, 640, 640}; pg8::GroupOrder So; So.init(16, 4, 2, (int)gridDim.x, (int)blockIdx.x);
      pg8::gemm_phase<EpiS5Y, pg8::GroupOrder, true, true>((PG8_LAS unsigned char*)lds_raw, g, So, e); }
    { PHASE_IDS; phase_ret_scan(q, gtid, ngt); }
    xcd_barrier(xb);
    }
    DUP(4) {
    { const Params q = fresh(p); EpiGlu e{q.xb(), q.ygb(), (float*)(lds_raw + 131072)};
      run_gemm(lds_raw, q.ygb(), q.Wglu_t() + (size_t)l * 65536, T, 256, 256, e); }
    { PHASE_IDS; phase_ret_out(q, gw, ngw, lane); }
    xcd_barrier(xb);
    }
    { PHASE_IDS; cvt_table_i8(q.inp(19) + (size_t)l * 16384 * D, q.U8s(), q.su(), gw, ngw, lane);
      cvt_table_fp8(q.inp(20) + (size_t)l * 16384 * D, q.V8s(), q.sv(), gw, ngw, lane); }
    __syncthreads();
    { const Params q = fresh(p); EpiResid e{q.outp(), D, q.xb2(), q.hb(), q.inp(16) + l * D, q.ssq2()};
      run_gemm(lds_raw, q.xb(), q.Wout_t() + (size_t)l * D * KD, T, D, KD, e); }
    xcd_barrier(xb);
    DUP(7) {
    { const Params q = fresh(p); EpiScaleStoreBf16 e{q.qb(), D, q.ssq2(), 16, q.rstd()};
      run_gemm(lds_raw, q.xb2(), q.Wq_t() + (size_t)l * D * KD, T, D, KD, e); }
    xcd_barrier(xb);
    }
    if (!(PROBE_SKIP & 2)) {
    DUP(8) {
    { PHASE_IDS; phase_peer_topk(q, l, gw, ngw, lane); }
    xcd_barrier(xb);
    }
    }
#if PEER_CHECK
    if (l == 0) { { PHASE_IDS; chk_save(q, gtid, ngt); } xcd_barrier(xb); { PHASE_IDS; chk_topk(q, l, gtid, ngt); } xcd_barrier(xb); }
#endif
    if (!(PROBE_SKIP & 1)) {
    { PHASE_IDS; phase_peer_u(q, q.qctr() + (l * 2 + 0) * 8, lds_raw, tid); }
    xcd_barrier(xb);
    { PHASE_IDS; phase_peer_r(q, gtid, ngt); if (l + 1 < NL) phase_s5_prep(q, l + 1, gtid, ngt); }
    xcd_barrier(xb);
    if (!(PROBE_SKIP & 32)) {
    { PHASE_IDS; phase_peer_v(q, q.qctr() + (l * 2 + 1) * 8, lds_raw, tid); }
    xcd_barrier(xb);
    }
    }
#if PEER_CHECK
    if (l == 0) { { PHASE_IDS; chk_apply(q, l, ldsf + wv * 128, gw, ngw, lane); } xcd_barrier(xb);
      if (blockIdx.x == 0 && threadIdx.x == 0) { const Params q = fresh(p); chk_emit(q); } xcd_barrier(xb); }
#endif
  }
}

}

extern "C" void kernel_launch(void* const* d_in, const int* in_sizes, int n_in, void* d_out, int out_size, void* d_ws, size_t ws_size,
                              hipStream_t stream) {
  static int grid_blocks = 0;
  if (!grid_blocks) {
    int dev = 0, cus = 0, per_cu = 0;
    hipGetDevice(&dev);
    hipDeviceGetAttribute(&cus, hipDeviceAttributeMultiprocessorCount, dev);
    hipFuncSetAttribute((const void*)mega, hipFuncAttributeMaxDynamicSharedMemorySize, LDS_BYTES);
    hipOccupancyMaxActiveBlocksPerMultiprocessor(&per_cu, (const void*)mega, NTHR, LDS_BYTES);
    if (per_cu < 1) { fprintf(stderr, "occupancy query returned %d\n", per_cu); per_cu = 1; }
    grid_blocks = cus * 1;
    if (grid_blocks < 64) fprintf(stderr, "unexpected CU count %d\n", cus);
  }
  Params p{};
  for (int i = 0; i < 21; ++i) p.in[i] = (const GAS float*)d_in[i];
  p.out_ = (GAS float*)d_out;
  p.ws = (GAS unsigned char*)d_ws;
  if (WS_TOTAL > ws_size) { fprintf(stderr, "workspace too small: need %zu have %zu\n", (size_t)WS_TOTAL, ws_size); return; }
  hipMemsetAsync((unsigned char*)d_ws + WO_bar, 0, 16384, stream);
  void* args[] = {&p};
  hipError_t e = hipLaunchCooperativeKernel((const void*)mega, dim3(grid_blocks), dim3(NTHR), args, LDS_BYTES, stream);
  if (e != hipSuccess) fprintf(stderr, "cooperative launch failed: %s (grid %d)\n", hipGetErrorString(e), grid_blocks);
}
```

```cpp
#include <hip/hip_runtime.h>
#include <hip/hip_cooperative_groups.h>
#include <math.h>
#include <stdint.h>
#include <stdio.h>
namespace cg = cooperative_groups;

#ifndef PEER_CHECK
#define PEER_CHECK 0
#endif
#ifndef PROBE_DUP
#define PROBE_DUP 0
#endif
__device__ __forceinline__ int dup_n(int n) { asm volatile("" : "+s"(n)); return n; }
#define DUP(bit) _Pragma("unroll 1") for (int rep_ = 0, repn_ = (((PROBE_DUP >> (bit)) & 1) ? dup_n(2) : 1); rep_ < repn_; ++rep_)
#ifndef PROBE_SKIP
#define PROBE_SKIP 0
#endif
#ifndef PRECISE
#define PRECISE 0
#endif

namespace {
constexpr int NB = 8, S = 4096, D = 1024, NL = 4, T = NB * S;
constexpr int INW = 2816;
constexpr int OFF_U = 0, OFF_QM = 256, OFF_KM = 768, OFF_VM = 1280, OFF_QR = 1792, OFF_KR = 2048, OFF_VR = 2304, OFF_GR = 2560;
constexpr float EPS = 1e-6f;
static_assert(PRECISE == 0, "PRECISE builds are retired");
constexpr int KS = PRECISE ? 3 : 1;
constexpr int KD = D * KS;
constexpr int NTHR = 512, NWAVE = 8;
constexpr int LDS_BYTES = 131072 + 4096 + 1024;

typedef unsigned short bf16_t;
using bf16x8 = __attribute__((ext_vector_type(8))) short;
using f32x4 = __attribute__((ext_vector_type(4))) float;

__device__ __forceinline__ float wave_sum(float v) {
#pragma unroll
  for (int o = 32; o > 0; o >>= 1) v += __shfl_xor(v, o);
  return v;
}
__device__ __forceinline__ float wave_max(float v) {
#pragma unroll
  for (int o = 32; o > 0; o >>= 1) v = fmaxf(v, __shfl_xor(v, o));
  return v;
}
__device__ __forceinline__ int q_pull(int* head, int nitems, int* bc, int tid) {
  __syncthreads();
  if (tid == 0) bc[0] = atomicAdd(head, 1);
  __syncthreads();
  const int v = bc[0];
  return v < nitems ? v : -1;
}
constexpr float QSCALE = 0.125f * 1.4426950408889634f;
__device__ __forceinline__ float ret_log2g(int h) { return log2f(1.0f - exp2f(-5.0f - (float)h)); }
__device__ __forceinline__ float gelu_tanh(float x) {
  const float k0 = 0.7978845608028654f, k1 = 0.044715f;
  float u = k0 * (x + k1 * x * x * x);
  return 0.5f * x * (1.0f + tanhf(u));
}
__device__ __forceinline__ float sigmoidf_(float x) { return 1.0f / (1.0f + expf(-x)); }
__device__ __forceinline__ float fast_sigmoid(float x) { return __builtin_amdgcn_rcpf(1.0f + __builtin_amdgcn_exp2f(-1.4426950408889634f * x)); }
__device__ __forceinline__ float fast_gelu(float x) { const float u = 0.7978845608028654f * (x + 0.044715f * x * x * x); return x * fast_sigmoid(2.0f * u); }
__device__ __forceinline__ bf16_t f2bf(float f) {
  unsigned u = __float_as_uint(f);
  u += 0x7fffu + ((u >> 16) & 1u);
  return (bf16_t)(u >> 16);
}
__device__ __forceinline__ float bf2f(bf16_t h) { return __uint_as_float(((unsigned)h) << 16); }
#define LDS_FENCE() asm volatile("s_waitcnt lgkmcnt(0)" ::: "memory")
typedef __bf16 bf16x2_hw __attribute__((ext_vector_type(2)));
typedef float f32x2_hw __attribute__((ext_vector_type(2)));
__device__ __forceinline__ unsigned pk_bf16(float lo, float hi) { const f32x2_hw f = {lo, hi}; const bf16x2_hw b = __builtin_convertvector(f, bf16x2_hw); return __builtin_bit_cast(unsigned, b); }
typedef float f32x16 __attribute__((ext_vector_type(16)));

constexpr size_t al256(size_t x) { return (x + 255) & ~(size_t)255; }
constexpr size_t WO_rstd = 0;
constexpr size_t WO_cosm = WO_rstd + al256((size_t)T * 4);
constexpr size_t WO_sinm = WO_cosm + al256((size_t)S * 8 * 4);
constexpr size_t WO_cosr = WO_sinm + al256((size_t)S * 8 * 4);
constexpr size_t WO_sinr = WO_cosr + al256((size_t)S * 32 * 4);
constexpr size_t WO_kmean = WO_sinr + al256((size_t)S * 32 * 4);
constexpr size_t WO_proj = WO_kmean + al256((size_t)NB * 8 * 16 * 64 * 4);
constexpr size_t WO_ybuf = WO_proj + al256((size_t)T * INW * 4);
constexpr size_t WO_yg = WO_ybuf + al256((size_t)T * D * 4);
constexpr size_t WO_skb = WO_yg + al256((size_t)T * 256 * 4);
constexpr size_t WO_Ub = WO_skb + al256((size_t)NL * 16 * 128 * 64 * 2);
constexpr size_t WO_Vb = WO_Ub + al256((size_t)16384 * D * 2);
constexpr size_t WO_gates = WO_Vb + al256((size_t)16384 * D * 2);
constexpr size_t WO_eidx = WO_gates + al256((size_t)T * 128 * 4);
constexpr size_t WO_xb = WO_eidx + al256((size_t)T * 128 * 4);
constexpr size_t WO_Win_t = WO_xb + al256((size_t)T * KD * 2);
constexpr size_t WO_Wout_t = WO_Win_t + al256((size_t)NL * INW * KD * 2);
constexpr size_t WO_Wq_t = WO_Wout_t + al256((size_t)NL * D * KD * 2);
constexpr size_t WO_Qm = WO_Wq_t + al256((size_t)NL * D * KD * 2);
constexpr size_t WO_Km = WO_Qm + al256((size_t)T * 512 * 2);
constexpr size_t WO_Vm = WO_Km + al256((size_t)T * 512 * 2);
constexpr size_t WO_S5a32 = WO_Vm + al256((size_t)T * 512 * 2);
constexpr size_t WO_Wglu_t = WO_S5a32 + al256((size_t)16 * 64 * 2 * 4);
constexpr size_t WO_Qr = WO_Wglu_t + al256((size_t)NL * 256 * 256 * 2);
constexpr size_t WO_Kr = WO_Qr + al256((size_t)T * 256 * 2);
constexpr size_t WO_Krv = WO_Kr + al256((size_t)T * 256 * 2);
constexpr size_t WO_Vr = WO_Krv + al256((size_t)T * 256 * 2);
constexpr size_t WO_KVr = WO_Vr + al256((size_t)T * 256 * 2);
constexpr size_t WO_Rb = WO_KVr + al256((size_t)32 * 32 * 4096 * 4);
constexpr size_t WO_qctr = WO_Rb + al256((size_t)32 * 32 * 4096 * 2);
constexpr size_t WO_bar = WO_qctr + al256(1024);
constexpr size_t WO_S5Wy = WO_bar + al256(16384);
constexpr size_t WO_S5Wz = WO_S5Wy + al256((size_t)16 * 512 * 640 * 2);
constexpr size_t WO_ssq1 = WO_S5Wz + al256((size_t)16 * 256 * 512 * 2);
constexpr size_t WO_ssq2 = WO_ssq1 + al256((size_t)T * 8 * 4);
constexpr size_t WS_TOTAL = WO_ssq2 + al256((size_t)T * 16 * 4);
constexpr size_t WO_S5A = WO_gates;
constexpr size_t WO_S5Z = WO_S5A + al256((size_t)16 * 1024 * 640 * 2);
static_assert(WO_S5Z + (size_t)16 * 1024 * 128 * 4 <= WO_gates + 2 * al256((size_t)T * 128 * 4), "S5A/S5Z must fit in gates+eidx");
#define GAS __attribute__((address_space(1)))
static_assert((size_t)T * D * 2 + (size_t)T * 128 * 8 * 4 + (size_t)T * D * 2 <= (size_t)T * INW * 4, "qb + ppart + xb2 must fit in the proj region");
struct Params {
  const GAS float* in[21];
  GAS float* out_;
  GAS unsigned char* ws;
  __device__ __forceinline__ const float* inp(int i) const { return (const float*)in[i]; }
  __device__ __forceinline__ float* outp() const { return (float*)out_; }
  __device__ __forceinline__ float* rstd() const { return (float*)(ws + WO_rstd); }
  __device__ __forceinline__ float* cosm() const { return (float*)(ws + WO_cosm); }
  __device__ __forceinline__ float* sinm() const { return (float*)(ws + WO_sinm); }
  __device__ __forceinline__ float* cosr() const { return (float*)(ws + WO_cosr); }
  __device__ __forceinline__ float* sinr() const { return (float*)(ws + WO_sinr); }
  __device__ __forceinline__ float* kmean() const { return (float*)(ws + WO_kmean); }
  __device__ __forceinline__ float* proj() const { return (float*)(ws + WO_proj); }
  __device__ __forceinline__ float* ybuf() const { return (float*)(ws + WO_ybuf); }
  __device__ __forceinline__ float* yg() const { return (float*)(ws + WO_yg); }
  __device__ __forceinline__ bf16_t* skb() const { return (bf16_t*)(ws + WO_skb); }
  __device__ __forceinline__ bf16_t* Ub() const { return (bf16_t*)(ws + WO_Ub); }
  __device__ __forceinline__ bf16_t* Vb() const { return (bf16_t*)(ws + WO_Vb); }
  __device__ __forceinline__ float* gates() const { return (float*)(ws + WO_gates); }
  __device__ __forceinline__ int* eidx() const { return (int*)(ws + WO_eidx); }
  __device__ __forceinline__ bf16_t* xb() const { return (bf16_t*)(ws + WO_xb); }
  __device__ __forceinline__ bf16_t* Win_t() const { return (bf16_t*)(ws + WO_Win_t); }
  __device__ __forceinline__ bf16_t* Wout_t() const { return (bf16_t*)(ws + WO_Wout_t); }
  __device__ __forceinline__ bf16_t* Wq_t() const { return (bf16_t*)(ws + WO_Wq_t); }
  __device__ __forceinline__ bf16_t* Qm() const { return (bf16_t*)(ws + WO_Qm); }
  __device__ __forceinline__ bf16_t* Km() const { return (bf16_t*)(ws + WO_Km); }
  __device__ __forceinline__ bf16_t* Vm() const { return (bf16_t*)(ws + WO_Vm); }
  __device__ __forceinline__ bf16_t* S5A() const { return (bf16_t*)(ws + WO_S5A); }
  __device__ __forceinline__ bf16_t* S5Wy() const { return (bf16_t*)(ws + WO_S5Wy); }
  __device__ __forceinline__ bf16_t* S5Wz() const { return (bf16_t*)(ws + WO_S5Wz); }
  __device__ __forceinline__ float* S5Z() const { return (float*)(ws + WO_S5Z); }
  __device__ __forceinline__ float* S5a32() const { return (float*)(ws + WO_S5a32); }
  __device__ __forceinline__ bf16_t* Wglu_t() const { return (bf16_t*)(ws + WO_Wglu_t); }
  __device__ __forceinline__ bf16_t* ygb() const { return (bf16_t*)(ws + WO_yg); }
  __device__ __forceinline__ int* qctr() const { return (int*)(ws + WO_qctr); }
  __device__ __forceinline__ unsigned char* U8s() const { return (unsigned char*)(ws + WO_Ub); }
  __device__ __forceinline__ float* su() const { return (float*)(ws + WO_Ub + (size_t)16384 * D); }
  __device__ __forceinline__ unsigned char* V8s() const { return (unsigned char*)(ws + WO_Vb); }
  __device__ __forceinline__ float* sv() const { return (float*)(ws + WO_Vb + (size_t)16384 * D); }
  __device__ __forceinline__ bf16_t* hb() const { return (bf16_t*)(ws + WO_ybuf + ((size_t)4 << 20)); }
  __device__ __forceinline__ bf16_t* ppart() const { return (bf16_t*)(ws + WO_proj + (size_t)T * D * 2); }
  __device__ __forceinline__ bf16_t* Qr() const { return (bf16_t*)(ws + WO_Qr); }
  __device__ __forceinline__ bf16_t* Kr() const { return (bf16_t*)(ws + WO_Kr); }
  __device__ __forceinline__ bf16_t* Krv() const { return (bf16_t*)(ws + WO_Krv); }
  __device__ __forceinline__ bf16_t* Vr() const { return (bf16_t*)(ws + WO_Vr); }
  __device__ __forceinline__ float* KVr() const { return (float*)(ws + WO_KVr); }
  __device__ __forceinline__ bf16_t* Rb() const { return (bf16_t*)(ws + WO_Rb); }
  __device__ __forceinline__ unsigned* bar() const { return (unsigned*)(ws + WO_bar); }
  __device__ __forceinline__ bf16_t* projb() const { return (bf16_t*)(ws + WO_proj); }
  __device__ __forceinline__ float* ssq1() const { return (float*)(ws + WO_ssq1); }
  __device__ __forceinline__ float* ssq2() const { return (float*)(ws + WO_ssq2); }
  __device__ __forceinline__ bf16_t* xb2() const { return (bf16_t*)(ws + WO_proj + (size_t)T * D * 2 + (size_t)T * 128 * 8 * 4); }
  __device__ __forceinline__ bf16_t* vrow() const { return (bf16_t*)(ws + WO_proj); }
  __device__ __forceinline__ bf16_t* vrrow() const { return (bf16_t*)(ws + WO_proj + (size_t)T * 512 * 2); }
  __device__ __forceinline__ bf16_t* krow() const { return (bf16_t*)(ws + WO_proj + (size_t)T * 768 * 2); }
  __device__ __forceinline__ bf16_t* grow() const { return (bf16_t*)(ws + WO_proj + (size_t)T * 1024 * 2); }
  __device__ __forceinline__ bf16_t* qb() const { return (bf16_t*)(ws + WO_proj); }
};

namespace pg8 {
#define PG8_LAS __attribute__((address_space(3)))
typedef unsigned short bf16_t;
typedef short bf16x8 __attribute__((ext_vector_type(8)));
typedef float f32x4 __attribute__((ext_vector_type(4)));
typedef unsigned u32x4 __attribute__((ext_vector_type(4)));
constexpr int BM = 256, BK = 64, HALF = 128, HTB = HALF * BK * 2  , STAGE_BYTES = 8 * HTB, NXCD = 8, WGM = 8;

__host__ __device__ __forceinline__ int lds_byte(int r, int c) { const int st = (r >> 4) * 2 + (c >> 5), rr = r & 15, cc = c & 31, ob = rr * 64 + cc * 2; return st * 1024 + (ob ^ (((ob >> 9) & 1) << 5)); }
__host__ __device__ __forceinline__ void stage_rc(int b, int& R, int& C) { const int st = b / 1024, sb = b % 1024, swz = sb ^ (((sb >> 9) & 1) << 5); R = (st >> 1) * 16 + swz / 64; C = (st & 1) * 32 + (swz % 64) / 2; }
__host__ __device__ __forceinline__ int perm32(int rho) { const int n = rho >> 4, i = rho & 15; return 8 * (i >> 2) + 4 * n + (i & 3); }

struct Unit { int pm, pn; };
struct Gemm { const bf16_t* A; const bf16_t* Bt; int M, N, K, lda, ldb; };

struct StaticOrder {
    int nM, nN, nwg, G, c;
    __host__ __device__ void init(int M, int N, int G_, int c_) { nM = M / BM; nN = N / BM; nwg = nM * nN; G = G_; c = c_; }
    __host__ __device__ bool next(int i, Unit& u) const {
        const long L = (long)i * G + c; if (L >= nwg) return false;
        int wgid = (int)L; { const int q = nwg / NXCD, r = nwg % NXCD, xcd = wgid % NXCD, off = wgid / NXCD; wgid = (xcd < r ? xcd * (q + 1) : r * (q + 1) + (xcd - r) * q) + off; }
        const int nig = WGM * nN, gid = wgid / nig, fm = gid * WGM, gsz = (nM - fm) < WGM ? (nM - fm) : WGM;
        u.pm = fm + ((wgid % nig) % gsz); u.pn = (wgid % nig) / gsz; return true;
    }
    __device__ __forceinline__ void a_ready(const Unit&) const {}
    __device__ __forceinline__ void done(const Unit&) const {}
};
struct GroupOrder {
    int mt, nt_, nwg, G, c;
    __host__ __device__ void init(int ngroups, int mt__, int nt__, int G_, int c_) { mt = mt__; nt_ = nt__; nwg = ngroups * mt * nt_; G = G_; c = c_; }
    __host__ __device__ bool next(int i, Unit& u) const {
        const long L = (long)i * G + c; if (L >= nwg) return false;
        const int per = mt * nt_, gi = (int)L / per, r = (int)L % per;
        u.pm = gi * mt + r % mt; u.pn = gi * nt_ + r / mt; return true;
    }
    __device__ __forceinline__ void a_ready(const Unit&) const {}
    __device__ __forceinline__ void done(const Unit&) const {}
};
template <class Epi, class Sched, bool ALIGN_EPI = false, bool SP2 = false>
__device__ __forceinline__ void gemm_phase(PG8_LAS unsigned char* lds, const Gemm g, const Sched& S, const Epi& E) {
    int tid_ = threadIdx.x; asm volatile("" : "+v"(tid_));
    const int tid = tid_, wid = __builtin_amdgcn_readfirstlane(tid >> 6), lane = tid & 63, wr = wid >> 2, wc = wid & 3, fr = lane & 15, fq = lane >> 4;
    const int K = g.K, nt = K / BK;
    unsigned voffA[2], voffB[2];
#pragma unroll
    for (int i = 0; i < 2; ++i) { int R, C; stage_rc(tid * 16 + i * 8192, R, C); const int Rb = Epi::PERM ? ((R & ~31) + perm32(R & 31)) : R;
        voffA[i] = (unsigned)(R * g.lda + C) * 2u; voffB[i] = (unsigned)(Rb * g.ldb + C) * 2u; }
    const size_t kstep = (size_t)(BK * 2);
    const size_t hstepA = (size_t)HALF * g.lda * 2, hstepB = (size_t)HALF * g.ldb * 2;
    const size_t tstepA = 2 * hstepA, tstepB = 2 * hstepB;
    const unsigned ldsw = (unsigned)wid * 1024u;
    const int aoff = lds_byte(wr * 64 + fr, fq * 8), boff = lds_byte(wc * 32 + fr, fq * 8);
#define PG8_SA(b, h) (((b) * 2 + (h)) * HTB)
#define PG8_SB(b, h) ((4 + (b) * 2 + (h)) * HTB)
#define PG8_STAGE(bufoff, gbase, voff) do { _Pragma("unroll") for (int _i = 0; _i < 2; ++_i) \
        __builtin_amdgcn_global_load_lds((const unsigned*)((const char*)(gbase) + (voff)[_i]), (PG8_LAS unsigned*)(lds + (bufoff) + ldsw + _i * 8192), 16, 0, 0); } while (0)
#define PG8_LDA(dst, b, h) do { _Pragma("unroll") for (int m = 0; m < 4; ++m) _Pragma("unroll") for (int k = 0; k < 2; ++k) dst[m][k] = *(const PG8_LAS bf16x8*)(lds + PG8_SA(b, h) + aoff + m * 2048 + k * 1024); } while (0)
#define PG8_LDB(dst, b, h) do { _Pragma("unroll") for (int n = 0; n < 2; ++n) _Pragma("unroll") for (int k = 0; k < 2; ++k) dst[n][k] = *(const PG8_LAS bf16x8*)(lds + PG8_SB(b, h) + boff + n * 2048 + k * 1024); } while (0)
#define PG8_MMA(ai, bj, At, Bt) do { __builtin_amdgcn_s_setprio(1); _Pragma("unroll") for (int m = 0; m < 4; ++m) _Pragma("unroll") for (int n = 0; n < 2; ++n) _Pragma("unroll") for (int k = 0; k < 2; ++k) \
        acc[ai][bj][m][n] = __builtin_amdgcn_mfma_f32_16x16x32_bf16(Bt[n][k], At[m][k], acc[ai][bj][m][n], 0, 0, 0); __builtin_amdgcn_s_setprio(0); } while (0)
#define PG8_WAIT_V(n) asm volatile("s_waitcnt vmcnt(" #n ")" ::: "memory")
#define PG8_WAIT_L(n) asm volatile("s_waitcnt lgkmcnt(" #n ")" ::: "memory")
#define PG8_BAR __builtin_amdgcn_s_barrier()
#define PG8_SCHED __builtin_amdgcn_sched_barrier(0)
    Unit cur, nxt; int ui = 0;
    if (!S.next(0, cur)) return;
    f32x4 acc[2][2][4][2];
    E.init(acc, cur, wr, wc, fr, fq);
    bf16x8 At[4][2], B0[2][2], B1[2][2];
    const char* cA = (const char*)g.A + (size_t)cur.pm * tstepA; const char* cB = (const char*)g.Bt + (size_t)cur.pn * tstepB;
    S.a_ready(cur);
    if constexpr (SP2) {
        PG8_STAGE(PG8_SB(0, 0), cB, voffB); PG8_STAGE(PG8_SB(0, 1), cB + hstepB, voffB); PG8_STAGE(PG8_SA(0, 0), cA, voffA); PG8_STAGE(PG8_SA(0, 1), cA + hstepA, voffA);
        if (wr == 1) PG8_BAR;
        PG8_WAIT_V(2); PG8_BAR;
        PG8_STAGE(PG8_SB(1, 0), cB + kstep, voffB); PG8_STAGE(PG8_SA(1, 0), cA + kstep, voffA); PG8_STAGE(PG8_SB(1, 1), cB + hstepB + kstep, voffB);
        PG8_WAIT_V(6); PG8_BAR;
    } else {
        PG8_STAGE(PG8_SB(0, 0), cB, voffB); PG8_STAGE(PG8_SA(0, 0), cA, voffA); PG8_STAGE(PG8_SB(0, 1), cB + hstepB, voffB); PG8_STAGE(PG8_SA(0, 1), cA + hstepA, voffA);
        if (wr == 1) PG8_BAR;
        PG8_WAIT_V(4); PG8_BAR;
        PG8_STAGE(PG8_SB(1, 0), cB + kstep, voffB); PG8_STAGE(PG8_SA(1, 0), cA + kstep, voffA); PG8_STAGE(PG8_SB(1, 1), cB + hstepB + kstep, voffB);
        PG8_WAIT_V(6); PG8_BAR;
    }
    for (;;) {
        const bool has_next = S.next(ui + 1, nxt);
        const char* nA = has_next ? (const char*)g.A + (size_t)nxt.pm * tstepA : cA; const char* nB = has_next ? (const char*)g.Bt + (size_t)nxt.pn * tstepB : cB;
        for (int t = 0; t < nt; t += 2) {
            const bool last = (t == nt - 2);
            const char* a1 = cA + (size_t)(t + 1) * kstep;
            const char* a2 = last ? nA : cA + (size_t)(t + 2) * kstep; const char* b2 = last ? nB : cB + (size_t)(t + 2) * kstep;
            const char* a3 = a2 + kstep; const char* b3 = b2 + kstep;
            if (last && has_next) S.a_ready(nxt);
            if constexpr (SP2) {
            PG8_LDB(B0, 0, 0); PG8_LDB(B1, 0, 1); PG8_SCHED; PG8_LDA(At, 0, 0); PG8_STAGE(PG8_SA(1, 1), a1 + hstepA, voffA);
            PG8_WAIT_V(8); PG8_WAIT_L(0); PG8_BAR; PG8_MMA(0, 0, At, B0); PG8_MMA(0, 1, At, B1); PG8_BAR; PG8_SCHED;
            PG8_LDA(At, 0, 1); PG8_STAGE(PG8_SB(0, 0), b2, voffB); PG8_STAGE(PG8_SB(0, 1), b2 + hstepB, voffB); PG8_STAGE(PG8_SA(0, 0), a2, voffA);
            PG8_WAIT_V(8); PG8_WAIT_L(0); PG8_BAR; PG8_MMA(1, 0, At, B0); PG8_MMA(1, 1, At, B1); PG8_BAR; PG8_SCHED;
            PG8_LDB(B0, 1, 0); PG8_LDB(B1, 1, 1); PG8_SCHED; PG8_LDA(At, 1, 0); PG8_STAGE(PG8_SA(0, 1), a2 + hstepA, voffA);
            PG8_WAIT_V(8); PG8_WAIT_L(0); PG8_BAR; PG8_MMA(0, 0, At, B0); PG8_MMA(0, 1, At, B1); PG8_BAR; PG8_SCHED;
            PG8_LDA(At, 1, 1); PG8_STAGE(PG8_SB(1, 0), b3, voffB); PG8_STAGE(PG8_SB(1, 1), b3 + hstepB, voffB); PG8_STAGE(PG8_SA(1, 0), a3, voffA);
            PG8_WAIT_V(8); PG8_WAIT_L(0); PG8_BAR; PG8_MMA(1, 0, At, B0); PG8_MMA(1, 1, At, B1); PG8_BAR; PG8_SCHED;
            } else {
            PG8_LDB(B0, 0, 0); PG8_SCHED; PG8_LDA(At, 0, 0); PG8_STAGE(PG8_SA(1, 1), a1 + hstepA, voffA);
            PG8_WAIT_L(8); PG8_BAR; PG8_WAIT_L(0); PG8_MMA(0, 0, At, B0); PG8_BAR; PG8_SCHED;
            PG8_LDB(B1, 0, 1); PG8_STAGE(PG8_SB(0, 0), b2, voffB);
            PG8_BAR; PG8_WAIT_L(0); PG8_MMA(0, 1, At, B1); PG8_BAR;
            PG8_LDA(At, 0, 1); PG8_STAGE(PG8_SA(0, 0), a2, voffA);
            PG8_BAR; PG8_WAIT_L(0); PG8_MMA(1, 0, At, B0); PG8_BAR; PG8_SCHED;
            PG8_STAGE(PG8_SB(0, 1), b2 + hstepB, voffB);
            PG8_WAIT_V(6); PG8_BAR; PG8_MMA(1, 1, At, B1); PG8_BAR;
            PG8_LDB(B0, 1, 0); PG8_SCHED; PG8_LDA(At, 1, 0); PG8_STAGE(PG8_SA(0, 1), a2 + hstepA, voffA);
            PG8_WAIT_L(8); PG8_BAR; PG8_WAIT_L(0); PG8_MMA(0, 0, At, B0); PG8_BAR; PG8_SCHED;
            PG8_LDB(B1, 1, 1); PG8_STAGE(PG8_SB(1, 0), b3, voffB);
            PG8_BAR; PG8_WAIT_L(0); PG8_MMA(0, 1, At, B1); PG8_BAR;
            PG8_LDA(At, 1, 1); PG8_STAGE(PG8_SA(1, 0), a3, voffA);
            PG8_BAR; PG8_WAIT_L(0); PG8_MMA(1, 0, At, B0); PG8_BAR; PG8_SCHED;
            PG8_STAGE(PG8_SB(1, 1), b3 + hstepB, voffB);
            PG8_WAIT_V(6); PG8_BAR; PG8_MMA(1, 1, At, B1); PG8_BAR;
            }
        }
        if constexpr (ALIGN_EPI) { if (wr == 0) PG8_BAR; }
        if constexpr (!Epi::AFTER_DRAIN) { E(acc, cur, wr, wc, fr, fq); S.done(cur); }
        if (!has_next) break;
        E.init(acc, nxt, wr, wc, fr, fq);
        cur = nxt; cA = nA; cB = nB; ++ui;
        if constexpr (ALIGN_EPI) { if (wr == 1) PG8_BAR; }
    }
    PG8_WAIT_V(0);
    if constexpr (!ALIGN_EPI) { if (wr == 0) PG8_BAR; }
    PG8_BAR;
    if constexpr (Epi::AFTER_DRAIN) { E.fused(acc, cur, wr, wc, fr, fq, lds, wid, lane); S.done(cur); }
#undef PG8_SA
#undef PG8_SB
#undef PG8_STAGE
#undef PG8_LDA
#undef PG8_LDB
#undef PG8_MMA
#undef PG8_WAIT_V
#undef PG8_WAIT_L
#undef PG8_BAR
#undef PG8_SCHED
}
}
#define EPI_ZERO_INIT \
  __device__ __forceinline__ void init(pg8::f32x4 (&acc)[2][2][4][2], const pg8::Unit&, int, int, int, int) const { \
    _Pragma("unroll") for (int a = 0; a < 2; ++a) _Pragma("unroll") for (int b = 0; b < 2; ++b) \
    _Pragma("unroll") for (int m = 0; m < 4; ++m) _Pragma("unroll") for (int n = 0; n < 2; ++n) acc[a][b][m][n] = (pg8::f32x4){0.f, 0.f, 0.f, 0.f}; }
struct EpiResid {
  static constexpr bool PERM = true, AFTER_DRAIN = false;
  float* C; int ldc; bf16_t* xb; bf16_t* hb; const float* g2; float* parts;
  __device__ __forceinline__ void init(pg8::f32x4 (&acc)[2][2][4][2], const pg8::Unit& u, int wr, int wc, int fr, int fq) const {
#pragma unroll
    for (int ai = 0; ai < 2; ++ai)
#pragma unroll
      for (int m = 0; m < 4; ++m) {
        const int row = u.pm * 256 + ai * 128 + wr * 64 + m * 16 + fr;
#pragma unroll
        for (int bj = 0; bj < 2; ++bj)
#pragma unroll
          for (int n = 0; n < 2; ++n) {
            const int col = u.pn * 256 + bj * 128 + wc * 32 + 8 * fq + 4 * n;
            acc[ai][bj][m][n] = *(const pg8::f32x4*)(C + (size_t)row * ldc + col);
          }
      }
  }
  __device__ __forceinline__ void operator()(const pg8::f32x4 (&acc)[2][2][4][2], const pg8::Unit& u, int wr, int wc, int fr_in, int fq_in) const {
    int fr = fr_in, fq = fq_in; asm volatile("" : "+v"(fr), "+v"(fq));
    pg8::f32x4 gv[2][2];
#pragma unroll
    for (int bj = 0; bj < 2; ++bj)
#pragma unroll
      for (int n = 0; n < 2; ++n) gv[bj][n] = *(const pg8::f32x4*)(g2 + u.pn * 256 + bj * 128 + wc * 32 + 8 * fq + 4 * n);
#pragma unroll
    for (int ai = 0; ai < 2; ++ai)
#pragma unroll
      for (int m = 0; m < 4; ++m) {
        const int row = u.pm * 256 + ai * 128 + wr * 64 + m * 16 + fr;
        float ss = 0.f;
#pragma unroll
        for (int bj = 0; bj < 2; ++bj) {
          const int col = u.pn * 256 + bj * 128 + wc * 32 + 8 * fq;
          const pg8::f32x4 v0 = acc[ai][bj][m][0], v1 = acc[ai][bj][m][1];
          *(pg8::f32x4*)(C + (size_t)row * ldc + col) = v0; *(pg8::f32x4*)(C + (size_t)row * ldc + col + 4) = v1;
          *(uint4*)(xb + (size_t)row * KD + col) = make_uint4(pk_bf16(v0[0], v0[1]), pk_bf16(v0[2], v0[3]), pk_bf16(v1[0], v1[1]), pk_bf16(v1[2], v1[3]));
          const pg8::f32x4 h0 = v0 * gv[bj][0], h1 = v1 * gv[bj][1];
          *(uint4*)(hb + ((size_t)(col >> 7) * T + row) * 128 + (col & 127)) = make_uint4(pk_bf16(h0[0], h0[1]), pk_bf16(h0[2], h0[3]), pk_bf16(h1[0], h1[1]), pk_bf16(h1[2], h1[3]));
          ss += ((v0[0] * v0[0] + v0[1] * v0[1]) + (v0[2] * v0[2] + v0[3] * v0[3])) + ((v1[0] * v1[0] + v1[1] * v1[1]) + (v1[2] * v1[2] + v1[3] * v1[3]));
        }
        ss += __shfl_xor(ss, 16); ss += __shfl_xor(ss, 32);
        if (fq == 0) parts[(size_t)row * 16 + u.pn * 4 + wc] = ss;
        asm volatile("" ::: "memory");
      }
  }
};
struct EpiScaleStoreBf16 {
  static constexpr bool PERM = true, AFTER_DRAIN = false;
  bf16_t* C; int ldc; const float* parts; int nparts; float* rs_out;
  EPI_ZERO_INIT
  __device__ __forceinline__ void operator()(const pg8::f32x4 (&acc)[2][2][4][2], const pg8::Unit& u, int wr, int wc, int fr_in, int fq_in) const {
    int fr = fr_in, fq = fq_in; asm volatile("" : "+v"(fr), "+v"(fq));
#pragma unroll
    for (int ai = 0; ai < 2; ++ai)
#pragma unroll
      for (int m = 0; m < 4; ++m) {
        const int row = u.pm * 256 + ai * 128 + wr * 64 + m * 16 + fr;
        float ssum = 0.f;
        for (int i = 0; i < nparts; i += 4) { const pg8::f32x4 q4 = *(const pg8::f32x4*)(parts + (size_t)row * nparts + i); ssum += (q4[0] + q4[1]) + (q4[2] + q4[3]); }
        const float r = rsqrtf(ssum * (1.0f / (float)D) + EPS);
        if (rs_out && u.pn == 0 && wc == 0 && fq == 0) rs_out[row] = r;
#pragma unroll
        for (int bj = 0; bj < 2; ++bj) {
          const int col = u.pn * 256 + bj * 128 + wc * 32 + 8 * fq;
          const pg8::f32x4 v0 = acc[ai][bj][m][0] * r, v1 = acc[ai][bj][m][1] * r;
          *(uint4*)(C + (size_t)row * ldc + col) = make_uint4(pk_bf16(v0[0], v0[1]), pk_bf16(v0[2], v0[3]), pk_bf16(v1[0], v1[1]), pk_bf16(v1[2], v1[3]));
        }
        asm volatile("" ::: "memory");
      }
  }
};
struct EpiInProj {
  static constexpr bool PERM = true, AFTER_DRAIN = false;
  const float* parts;
  bf16_t *S5A, *Qm, *Km, *vrow, *Qr, *Kr, *krow, *vrrow, *grow;
  const float *gq, *gk, *cosm, *sinm, *cosr, *sinr;
  EPI_ZERO_INIT
  __device__ __forceinline__ void operator()(const pg8::f32x4 (&acc)[2][2][4][2], const pg8::Unit& u, int wr, int wc, int fr_in, int fq_in) const {
    int fr = fr_in, fq = fq_in; asm volatile("" : "+v"(fr), "+v"(fq));
    const int pn = u.pn;
    float gain[2][8];
    if (pn >= 1 && pn <= 4) {
      const float* gsrc = pn <= 2 ? gq : gk;
#pragma unroll
      for (int bj = 0; bj < 2; ++bj) { const pg8::f32x4 a = *(const pg8::f32x4*)(gsrc + bj * 32 + 8 * fq), b = *(const pg8::f32x4*)(gsrc + bj * 32 + 8 * fq + 4);
        gain[bj][0] = a[0]; gain[bj][1] = a[1]; gain[bj][2] = a[2]; gain[bj][3] = a[3]; gain[bj][4] = b[0]; gain[bj][5] = b[1]; gain[bj][6] = b[2]; gain[bj][7] = b[3]; }
    }
    const float l2g = ret_log2g(wc);
#pragma unroll
    for (int ai = 0; ai < 2; ++ai)
#pragma unroll
      for (int m = 0; m < 4; ++m) {
        const int t = u.pm * 256 + ai * 128 + wr * 64 + m * 16 + fr, s = t & (S - 1), b = t >> 12;
        float r;
        { const pg8::f32x4 p0 = *(const pg8::f32x4*)(parts + (size_t)t * 8), p1 = *(const pg8::f32x4*)(parts + (size_t)t * 8 + 4);
          r = rsqrtf((((p0[0] + p0[1]) + (p0[2] + p0[3])) + ((p1[0] + p1[1]) + (p1[2] + p1[3]))) * (1.0f / (float)D) + EPS); }
        float v[2][8];
#pragma unroll
        for (int bj = 0; bj < 2; ++bj)
#pragma unroll
          for (int e = 0; e < 8; ++e) v[bj][e] = acc[ai][bj][m][e >> 2][e & 3] * r;
#define PK8(x_) make_uint4(pk_bf16((x_)[0], (x_)[1]), pk_bf16((x_)[2], (x_)[3]), pk_bf16((x_)[4], (x_)[5]), pk_bf16((x_)[6], (x_)[7]))
        if (pn == 0) {
#pragma unroll
          for (int bj = 0; bj < 2; ++bj) { const int g = wc * 4 + bj * 2 + (fq >> 1);
            *(uint4*)(S5A + ((size_t)g * 1024 + (t >> 5)) * 640 + (t & 31) * 16 + 8 * (fq & 1)) = PK8(v[bj]); }
        } else if (pn <= 4) {
          const bool isk = pn >= 3; const int h = ((pn - 1) & 1) * 4 + wc, bh = b * 8 + h;
          float ss = 0.f;
#pragma unroll
          for (int bj = 0; bj < 2; ++bj)
#pragma unroll
            for (int e = 0; e < 8; ++e) ss += v[bj][e] * v[bj][e];
          ss += __shfl_xor(ss, 16); ss += __shfl_xor(ss, 32);
          const float rh = rsqrtf(ss * (1.0f / 64.0f) + EPS);
#pragma unroll
          for (int bj = 0; bj < 2; ++bj)
#pragma unroll
            for (int e = 0; e < 8; ++e) v[bj][e] *= rh * gain[bj][e];
          { const pg8::f32x4 c0 = *(const pg8::f32x4*)(cosm + s * 8), c1 = *(const pg8::f32x4*)(cosm + s * 8 + 4), s0 = *(const pg8::f32x4*)(sinm + s * 8), s1 = *(const pg8::f32x4*)(sinm + s * 8 + 4);
#pragma unroll
            for (int e = 0; e < 8; ++e) {
              const float pu = __shfl_xor(v[0][e], 16);
              const float c = e < 4 ? c0[e & 3] : c1[e & 3], sn = e < 4 ? s0[e & 3] : s1[e & 3];
              const float o = fq == 0 ? (v[0][e] * c - pu * sn) : (v[0][e] * c + pu * sn);
              v[0][e] = fq < 2 ? o : v[0][e];
            } }
          if (!isk) {
#pragma unroll
            for (int bj = 0; bj < 2; ++bj) { float q8[8];
#pragma unroll
              for (int e = 0; e < 8; ++e) q8[e] = v[bj][e] * QSCALE;
              *(uint4*)(Qm + ((size_t)bh * S + s) * 64 + bj * 32 + 8 * fq) = PK8(q8); }
          } else {
#pragma unroll
            for (int bj = 0; bj < 2; ++bj) *(uint4*)(Km + ((((size_t)bh * (S / 32) + (s >> 5)) * 8 + bj * 4 + fq) * 32 + (s & 31)) * 8) = PK8(v[bj]);
          }
        } else if (pn <= 6) {
#pragma unroll
          for (int bj = 0; bj < 2; ++bj) *(uint4*)(vrow + (size_t)t * 512 + (pn - 5) * 256 + wc * 64 + bj * 32 + 8 * fq) = PK8(v[bj]);
        } else if (pn <= 8) {
          const bool isk = pn == 8; const int bh = b * 4 + wc, pos = s & 127;
          const float sc = isk ? 0.125f * exp2f(-(float)pos * l2g) : exp2f((float)pos * l2g);
          const pg8::f32x4 c0 = *(const pg8::f32x4*)(cosr + s * 32 + 8 * fq), c1 = *(const pg8::f32x4*)(cosr + s * 32 + 8 * fq + 4);
          const pg8::f32x4 s0 = *(const pg8::f32x4*)(sinr + s * 32 + 8 * fq), s1 = *(const pg8::f32x4*)(sinr + s * 32 + 8 * fq + 4);
          float o1[8], o2[8];
#pragma unroll
          for (int e = 0; e < 8; ++e) { const float c = e < 4 ? c0[e & 3] : c1[e & 3], sn = e < 4 ? s0[e & 3] : s1[e & 3];
            o1[e] = (v[0][e] * c - v[1][e] * sn) * sc; o2[e] = (v[1][e] * c + v[0][e] * sn) * sc; }
          if (!isk) {
            *(uint4*)(Qr + ((size_t)bh * S + s) * 64 + 8 * fq) = PK8(o1); *(uint4*)(Qr + ((size_t)bh * S + s) * 64 + 32 + 8 * fq) = PK8(o2);
          } else {
            *(uint4*)(Kr + ((((size_t)bh * (S / 32) + (s >> 5)) * 8 + fq) * 32 + (s & 31)) * 8) = PK8(o1);
            *(uint4*)(Kr + ((((size_t)bh * (S / 32) + (s >> 5)) * 8 + 4 + fq) * 32 + (s & 31)) * 8) = PK8(o2);
            *(uint4*)(krow + (size_t)t * 256 + wc * 64 + 8 * fq) = PK8(o1); *(uint4*)(krow + (size_t)t * 256 + wc * 64 + 32 + 8 * fq) = PK8(o2);
          }
        } else {
          bf16_t* dst = (pn == 9 ? vrrow : grow) + (size_t)t * 256 + wc * 64 + 8 * fq;
          *(uint4*)dst = PK8(v[0]); *(uint4*)(dst + 32) = PK8(v[1]);
        }
#undef PK8
        asm volatile("" ::: "memory");
      }
  }
};
template <class Epi>
__device__ __forceinline__ void run_gemm(unsigned char* lds_raw, const bf16_t* A, const bf16_t* Bt, int M, int N, int K, const Epi& e) {
  pg8::Gemm g{A, Bt, M, N, K, K, K}; pg8::StaticOrder So; So.init(M, N, (int)gridDim.x, (int)blockIdx.x);
  pg8::gemm_phase<Epi, pg8::StaticOrder, true, true>((PG8_LAS unsigned char*)lds_raw, g, So, e);
}

template <bool HEADPERM>
__device__ __forceinline__ void transpose_items(const float* __restrict__ W, int K, int N, const float* __restrict__ g, bf16_t* __restrict__ Wt, int gw, int ngw, int lane) {
  const int nkt = K / 64, nnt = N / 64;
  for (int it = gw; it < nkt * nnt; it += ngw) {
    int kt = it % nkt, ntile = it / nkt;
    int k0 = kt * 64, n = ntile * 64 + lane;
    int ns = n;
    if (HEADPERM) { const int cp = n & 255; ns = (n & ~255) + ((cp >> 5) & 3) * 64 + (cp >> 7) * 32 + (cp & 31); }
    float v[64];
#pragma unroll
    for (int i = 0; i < 64; ++i) v[i] = W[(size_t)(k0 + i) * N + ns] * g[k0 + i];
    bf16_t* dst = Wt + (size_t)n * (K * KS) + k0;
#pragma unroll
    for (int c = 0; c < 8; ++c) {
      bf16_t hi[8], lo[8];
#pragma unroll
      for (int e = 0; e < 8; ++e) { hi[e] = f2bf(v[c * 8 + e]); lo[e] = f2bf(v[c * 8 + e] - bf2f(hi[e])); }
      uint4 ph, pl;
      ph.x = hi[0] | ((unsigned)hi[1] << 16); ph.y = hi[2] | ((unsigned)hi[3] << 16); ph.z = hi[4] | ((unsigned)hi[5] << 16); ph.w = hi[6] | ((unsigned)hi[7] << 16);
      pl.x = lo[0] | ((unsigned)lo[1] << 16); pl.y = lo[2] | ((unsigned)lo[3] << 16); pl.z = lo[4] | ((unsigned)lo[5] << 16); pl.w = lo[6] | ((unsigned)lo[7] << 16);
      *(uint4*)(dst + c * 8) = ph;
      if (PRECISE) { *(uint4*)(dst + K + c * 8) = pl; *(uint4*)(dst + 2 * K + c * 8) = ph; }
    }
  }
}


__device__ __forceinline__ void phase_prologue(const Params& p, int gtid, int ngt, int gw, int ngw, int lane) {
  for (int idx = gtid; idx < S * 40; idx += ngt) {
    int s = idx / 40, i = idx % 40;
    if (i < 8) {
      const float inv = powf(500000.0f, -(float)(2 * i) / 16.0f);
      float sn, cs; sincosf((float)s * inv, &sn, &cs);
      p.cosm()[s * 8 + i] = cs; p.sinm()[s * 8 + i] = sn;
    } else {
      const int j = i - 8;
      const float inv = powf(10000.0f, -((float)j / 31.0f));
      float sn, cs; sincosf((float)s * inv, &sn, &cs);
      p.cosr()[s * 32 + j] = cs; p.sinr()[s * 32 + j] = sn;
    }
  }
  { const float4* a = (const float4*)p.inp(0); float4* b = (float4*)p.outp();
    for (size_t i = gtid; i < (size_t)T * D / 4; i += ngt) b[i] = a[i]; }
  for (int t = gw; t < T; t += ngw) {
    const float4* xr = (const float4*)(p.inp(0) + (size_t)t * D); float ss = 0.f;
#pragma unroll
    for (int i = 0; i < 4; ++i) { const float4 v = xr[lane + i * 64]; ss += v.x * v.x + v.y * v.y + v.z * v.z + v.w * v.w;
      *(uint2*)(p.xb() + (size_t)t * KD + (lane + i * 64) * 4) = make_uint2(pk_bf16(v.x, v.y), pk_bf16(v.z, v.w)); }
    ss = wave_sum(ss);
    if (lane < 8) p.ssq1()[(size_t)t * 8 + lane] = lane == 0 ? ss : 0.f;
  }
  for (int idx = gtid; idx < NL * 65536; idx += ngt) { const int l2 = idx >> 16, n2 = (idx >> 8) & 255, k2 = idx & 255; p.Wglu_t()[idx] = f2bf(p.inp(11)[(size_t)l2 * 65536 + k2 * 256 + n2]); }
  for (int l = 0; l < NL; ++l) {
    transpose_items<true>(p.inp(2) + (size_t)l * D * INW, D, INW, p.inp(1) + l * D, p.Win_t() + (size_t)l * INW * KD, gw, ngw, lane);
    transpose_items<false>(p.inp(15) + (size_t)l * D * D, D, D, p.inp(14) + l * D, p.Wout_t() + (size_t)l * D * KD, gw, ngw, lane);
    transpose_items<false>(p.inp(17) + (size_t)l * D * D, D, D, p.inp(16) + l * D, p.Wq_t() + (size_t)l * D * KD, gw, ngw, lane);
  }
}


struct S5P { float lr, li, dt, fr, fi; };
__device__ __forceinline__ S5P s5p(const Params& p, int l, int g, int pp) {
  S5P r; r.lr = p.inp(3)[l * 1024 + g * 64 + pp]; r.li = p.inp(4)[l * 1024 + g * 64 + pp]; r.dt = expf(p.inp(5)[l * 16 + g]);
  const float mag = expf(r.lr * r.dt); float sn, cs; sincosf(r.li * r.dt, &sn, &cs);
  const float ar = mag * cs, ai = mag * sn, den = r.lr * r.lr + r.li * r.li;
  r.fr = ((ar - 1.0f) * r.lr + ai * r.li) / den; r.fi = (ai * r.lr - (ar - 1.0f) * r.li) / den;
  return r;
}
__device__ __forceinline__ void s5pow(const S5P& s, int k, float& re, float& im) {
  const float m = expf((float)k * s.lr * s.dt); float sn, cs; sincosf((float)k * s.li * s.dt, &sn, &cs); re = m * cs; im = m * sn;
}
__device__ __forceinline__ void phase_s5_prep(const Params& p, int l, int gtid, int ngt) {
  const float* b_re = p.inp(6) + l * 16384; const float* b_im = p.inp(7) + l * 16384;
  const float* c_re = p.inp(8) + l * 16384; const float* c_im = p.inp(9) + l * 16384;
  bf16_t* Wy = p.S5Wy(); bf16_t* Wz = p.S5Wz();
  for (int it = gtid; it < 16 * 32 * 256; it += ngt) {
    const int hp = it & 15, h = (it >> 4) & 15, d = (it >> 8) & 31, g = it >> 13;
    float prl, pil, frl, fil;
    { const S5P sl = s5p(p, l, g, (int)(threadIdx.x & 63)); s5pow(sl, d, prl, pil); frl = sl.fr; fil = sl.fi; }
    float acc = 0.f;
    for (int pp = 0; pp < 64; ++pp) {
      const float pr = __shfl(prl, pp), pi = __shfl(pil, pp);
      S5P s; s.fr = __shfl(frl, pp); s.fi = __shfl(fil, pp);
      const float br = b_re[(g * 64 + pp) * 16 + hp], bi = b_im[(g * 64 + pp) * 16 + hp];
      const float bbr = s.fr * br - s.fi * bi, bbi = s.fr * bi + s.fi * br;
      const float tr = pr * bbr - pi * bbi, ti = pr * bbi + pi * bbr;
      acc += c_re[(g * 16 + h) * 64 + pp] * tr - c_im[(g * 16 + h) * 64 + pp] * ti;
    }
    const bf16_t v = f2bf(acc);
    for (int jp = 0; jp + d < 32; ++jp) {
      const int j = jp + d;
      Wy[((size_t)g * 512 + j * 16 + h) * 640 + jp * 16 + hp] = v;
      if (d > 0) Wy[((size_t)g * 512 + jp * 16 + h) * 640 + j * 16 + hp] = 0;
    }
  }
  for (int it = gtid; it < 16 * 32 * 16 * 64; it += ngt) {
    const int pp = it & 63, h = (it >> 6) & 15, j = (it >> 10) & 31, g = it >> 15;
    const S5P s = s5p(p, l, g, pp);
    float pr, pi; s5pow(s, j + 1, pr, pi);
    const float cr = c_re[(g * 16 + h) * 64 + pp], ci = c_im[(g * 16 + h) * 64 + pp];
    const unsigned w = pk_bf16(cr * pr - ci * pi, -(cr * pi + ci * pr));
    *(unsigned*)(Wy + ((size_t)g * 512 + j * 16 + h) * 640 + 512 + 2 * pp) = w;
  }
  for (int it = gtid; it < 16 * 64 * 32; it += ngt) {
    const int j = it & 31, pp = (it >> 5) & 63, g = it >> 11;
    const S5P s = s5p(p, l, g, pp);
    float pr, pi; s5pow(s, 31 - j, pr, pi);
    for (int hp = 0; hp < 16; ++hp) {
      const float br = b_re[(g * 64 + pp) * 16 + hp], bi = b_im[(g * 64 + pp) * 16 + hp];
      const float bbr = s.fr * br - s.fi * bi, bbi = s.fr * bi + s.fi * br;
      Wz[((size_t)g * 256 + 2 * pp) * 512 + j * 16 + hp] = f2bf(pr * bbr - pi * bbi);
      Wz[((size_t)g * 256 + 2 * pp + 1) * 512 + j * 16 + hp] = f2bf(pr * bbi + pi * bbr);
    }
  }
  for (int it = gtid; it < 16 * 64; it += ngt) {
    const S5P s = s5p(p, l, it >> 6, it & 63);
    float pr, pi; s5pow(s, 32, pr, pi);
    p.S5a32()[it * 2] = pr; p.S5a32()[it * 2 + 1] = pi;
  }
}
__device__ __forceinline__ void phase_s5_scan(const Params& p, int gtid, int ngt) {
  for (int it = gtid; it < NB * 16 * 64; it += ngt) {
    const int pp = it & 63, g = (it >> 6) & 15, b = it >> 10;
    const float er = p.S5a32()[(g * 64 + pp) * 2], ei = p.S5a32()[(g * 64 + pp) * 2 + 1];
    float sr = 0.f, si = 0.f;
#pragma unroll 1
    for (int c0 = 0; c0 < 128; c0 += 16) {
      float2 z[16];
#pragma unroll
      for (int k = 0; k < 16; ++k) z[k] = *(const float2*)(p.S5Z() + ((size_t)g * 1024 + b * 128 + c0 + k) * 128 + 2 * pp);
#pragma unroll
      for (int k = 0; k < 16; ++k) {
        const size_t ch = (size_t)g * 1024 + b * 128 + c0 + k;
        *(unsigned*)(p.S5A() + ch * 640 + 512 + 2 * pp) = pk_bf16(sr, si);
        const float nr = er * sr - ei * si + z[k].x, ni = er * si + ei * sr + z[k].y;
        sr = nr; si = ni;
      }
    }
  }
}
struct EpiS5Z {
  static constexpr bool PERM = false, AFTER_DRAIN = false;
  float* Z;
  EPI_ZERO_INIT
  __device__ __forceinline__ void operator()(const pg8::f32x4 (&acc)[2][2][4][2], const pg8::Unit& u, int wr, int wc, int fr_in, int fq_in) const {
    int fr = fr_in, fq = fq_in; asm volatile("" : "+v"(fr), "+v"(fq));
    const int g = u.pm >> 2;
#pragma unroll
    for (int ai = 0; ai < 2; ++ai)
#pragma unroll
      for (int m = 0; m < 4; ++m) {
        const int chunk = (u.pm & 3) * 256 + ai * 128 + wr * 64 + m * 16 + fr;
#pragma unroll
        for (int n = 0; n < 2; ++n) *(pg8::f32x4*)(Z + ((size_t)g * 1024 + chunk) * 128 + wc * 32 + n * 16 + 4 * fq) = acc[ai][0][m][n];
      }
  }
};
struct EpiS5Y {
  static constexpr bool PERM = false, AFTER_DRAIN = false;
  bf16_t* ygb; const bf16_t* A; const float* dsk;
  EPI_ZERO_INIT
  __device__ __forceinline__ void operator()(const pg8::f32x4 (&acc)[2][2][4][2], const pg8::Unit& u, int wr, int wc, int fr_in, int fq_in) const {
    int fr = fr_in, fq = fq_in; asm volatile("" : "+v"(fr), "+v"(fq));
    const int g = u.pm >> 2;
#pragma unroll
    for (int ai = 0; ai < 2; ++ai)
#pragma unroll
      for (int m = 0; m < 4; ++m) {
        const int chunk = (u.pm & 3) * 256 + ai * 128 + wr * 64 + m * 16 + fr;
#pragma unroll
        for (int bj = 0; bj < 2; ++bj)
#pragma unroll
          for (int n = 0; n < 2; ++n) {
            const int col = (u.pn & 1) * 256 + bj * 128 + wc * 32 + n * 16 + 4 * fq, j = col >> 4, h = col & 15;
            const uint2 uu = *(const uint2*)(A + ((size_t)g * 1024 + chunk) * 640 + col);
            const pg8::f32x4 dv = *(const pg8::f32x4*)(dsk + g * 16 + h);
            const pg8::f32x4 v = acc[ai][bj][m][n];
            const float y0 = fast_gelu(v[0] + dv[0] * __uint_as_float(uu.x << 16)), y1 = fast_gelu(v[1] + dv[1] * __uint_as_float(uu.x & 0xffff0000u));
            const float y2 = fast_gelu(v[2] + dv[2] * __uint_as_float(uu.y << 16)), y3 = fast_gelu(v[3] + dv[3] * __uint_as_float(uu.y & 0xffff0000u));
            uint2 o; o.x = pk_bf16(y0, y1); o.y = pk_bf16(y2, y3);
            *(uint2*)(ygb + ((size_t)chunk * 32 + j) * 256 + g * 16 + h) = o;
          }
        asm volatile("" ::: "memory");
      }
  }
};
struct EpiGlu {
  static constexpr bool PERM = false, AFTER_DRAIN = false;
  bf16_t* yb; const bf16_t* ygb; float* scr;
  EPI_ZERO_INIT
  __device__ __forceinline__ void operator()(const pg8::f32x4 (&acc_)[2][2][4][2], const pg8::Unit& u, int wr, int wc, int fr_in, int fq_in) const {
    int fr = fr_in, fq = fq_in; asm volatile("" : "+v"(fr), "+v"(fq));
    pg8::f32x4 (&acc)[2][2][4][2] = const_cast<pg8::f32x4 (&)[2][2][4][2]>(acc_);
#pragma unroll
    for (int ai = 0; ai < 2; ++ai)
#pragma unroll
      for (int m = 0; m < 4; ++m) {
        const int rl = ai * 128 + wr * 64 + m * 16 + fr, row = u.pm * 256 + rl;
        float ss = 0.f;
#pragma unroll
        for (int bj = 0; bj < 2; ++bj)
#pragma unroll
          for (int n = 0; n < 2; ++n) {
            const int col = bj * 128 + wc * 32 + n * 16 + 4 * fq;
            const uint2 yy = *(const uint2*)(ygb + (size_t)row * 256 + col);
            const pg8::f32x4 z = acc[ai][bj][m][n];
            pg8::f32x4 r;
            r[0] = __uint_as_float(yy.x << 16) * fast_sigmoid(z[0]); r[1] = __uint_as_float(yy.x & 0xffff0000u) * fast_sigmoid(z[1]);
            r[2] = __uint_as_float(yy.y << 16) * fast_sigmoid(z[2]); r[3] = __uint_as_float(yy.y & 0xffff0000u) * fast_sigmoid(z[3]);
            acc[ai][bj][m][n] = r;
            ss += r[0] * r[0] + r[1] * r[1] + r[2] * r[2] + r[3] * r[3];
          }
        ss += __shfl_xor(ss, 16); ss += __shfl_xor(ss, 32);
        if (fq == 0) scr[rl * 4 + wc] = ss;
        asm volatile("" ::: "memory");
      }
    asm volatile("s_waitcnt lgkmcnt(0)" ::: "memory"); __builtin_amdgcn_s_barrier(); asm volatile("" ::: "memory");
#pragma unroll
    for (int ai = 0; ai < 2; ++ai)
#pragma unroll
      for (int m = 0; m < 4; ++m) {
        const int rl = ai * 128 + wr * 64 + m * 16 + fr, row = u.pm * 256 + rl;
        const pg8::f32x4 s4 = *(const pg8::f32x4*)(scr + rl * 4);
        const float r = rsqrtf((s4[0] + s4[1] + s4[2] + s4[3]) / 256.0f + EPS);
#pragma unroll
        for (int bj = 0; bj < 2; ++bj)
#pragma unroll
          for (int n = 0; n < 2; ++n) { const pg8::f32x4 v = acc[ai][bj][m][n] * r; *(uint2*)(yb + (size_t)row * KD + bj * 128 + wc * 32 + n * 16 + 4 * fq) = make_uint2(pk_bf16(v[0], v[1]), pk_bf16(v[2], v[3])); }
        asm volatile("" ::: "memory");
      }
    asm volatile("s_waitcnt lgkmcnt(0)" ::: "memory"); __builtin_amdgcn_s_barrier(); asm volatile("" ::: "memory");
  }
};


__device__ __forceinline__ void phase_moba2(const Params& p, int l, unsigned char* lds, int* uq) {
  constexpr int OLD = 260;
  bf16_t* Qs = (bf16_t*)lds;
  float* Oaccf = (float*)(lds + 32768);
  float* laccf = (float*)(lds + 32768 + 64 * OLD * 4);
  float* kms = laccf + 256;
  float* gat = kms + 1024;
  unsigned char* lists = (unsigned char*)(gat + 4096);
  int* cnt = (int*)(lists + 4096);
  int* items = cnt + 16;
  int* ctr = items + 160;
  unsigned* selp = (unsigned*)(ctr + 4);
  float* bq = (float*)(selp + 256);
  int* Oacc = (int*)Oaccf; int* lacc = (int*)laccf;
  float kmax = 0.f;
  { const float* gk = p.inp(13) + l * 64;
    for (int d = 0; d < 64; ++d) kmax = fmaxf(kmax, fabsf(gk[d]));
    kmax *= 8.0f * 1.01f; }
  for (;;) {
    const int u = q_pull(uq, NB * 8 * 16, (int*)(lds + 131072), threadIdx.x);
    if (u < 0) break;
    const int qblk = 15 - (u >> 6), bh = u & 63, b = bh >> 3, h = bh & 7;
    int tid = threadIdx.x; asm volatile("" : "+v"(tid));
    const int lane = tid & 63, wv = tid >> 6, n = lane & 31, hh = lane >> 5;
    __syncthreads();
    { const uint4* src = (const uint4*)(p.Qm() + ((size_t)bh * S + qblk * 256) * 64);
      uint4* dst = (uint4*)Qs;
      for (int i = tid; i < 256 * 64 * 2 / 16; i += NTHR) dst[i] = src[i]; }
    for (int i = tid; i < qblk * 64; i += NTHR) kms[i] = p.kmean()[(size_t)bh * 1024 + i];
    for (int i = tid; i < 64 * OLD; i += NTHR) Oacc[i] = 0;
    if (tid < 256) lacc[tid] = 0;
    if (tid < 16) cnt[tid] = 0;
    __syncthreads();
    { const int q = tid & 255, par = tid >> 8;
      float qv[64];
#pragma unroll
      for (int c = 0; c < 8; ++c) {
        uint4 w = *(const uint4*)(Qs + q * 64 + c * 8);
        qv[c * 8 + 0] = __uint_as_float(w.x << 16); qv[c * 8 + 1] = __uint_as_float(w.x & 0xffff0000u);
        qv[c * 8 + 2] = __uint_as_float(w.y << 16); qv[c * 8 + 3] = __uint_as_float(w.y & 0xffff0000u);
        qv[c * 8 + 4] = __uint_as_float(w.z << 16); qv[c * 8 + 5] = __uint_as_float(w.z & 0xffff0000u);
        qv[c * 8 + 6] = __uint_as_float(w.w << 16); qv[c * 8 + 7] = __uint_as_float(w.w & 0xffff0000u);
      }
      if (par == 0) { float qq = 0.f;
#pragma unroll
        for (int d = 0; d < 64; ++d) qq = fmaf(qv[d], qv[d], qq);
        bq[q] = sqrtf(qq) * kmax; }
      for (int j = par; j < qblk; j += 2) {
        float g = 0.f;
#pragma unroll
        for (int d = 0; d < 64; ++d) g = fmaf(qv[d], kms[j * 64 + d], g);
        gat[q * 16 + j] = g;
      }
    }
    __syncthreads();
    if (tid < 256) {
      float b0 = -INFINITY, b1 = -INFINITY, b2 = -INFINITY; int i0 = 0, i1 = 0, i2 = 0;
      for (int j = 0; j < qblk; ++j) {
        float g = gat[tid * 16 + j];
        if (g > b0) { b2 = b1; i2 = i1; b1 = b0; i1 = i0; b0 = g; i0 = j; }
        else if (g > b1) { b2 = b1; i2 = i1; b1 = g; i1 = j; }
        else if (g > b2) { b2 = g; i2 = j; }
      }
      const int nsel = qblk < 3 ? qblk : 3;
      selp[tid] = (unsigned)i0 | ((unsigned)i1 << 4) | ((unsigned)i2 << 8) | ((unsigned)nsel << 12);
    }
    __syncthreads();
    for (int j = wv; j < qblk; j += 8) {
      int base = 0;
      for (int c = 0; c < 4; ++c) {
        const int q = c * 64 + lane;
        const unsigned sp = selp[q];
        const int ns = sp >> 12;
        const bool f = (ns > 0 && (int)(sp & 15) == j) || (ns > 1 && (int)((sp >> 4) & 15) == j) || (ns > 2 && (int)((sp >> 8) & 15) == j);
        const unsigned long long bal = __ballot(f);
        const int pos = base + __popcll(bal & ((1ull << lane) - 1ull));
        if (f) lists[j * 256 + pos] = (unsigned char)q;
        base += __popcll(bal);
      }
      if (lane == 0) cnt[j] = base;
    }
    __syncthreads();
    if (tid == 0) {
      int ni = 0;
#pragma unroll 1
      for (int g = 7; g >= 0; --g) items[ni++] = (16 << 8) | g;
      for (int j = 0; j < qblk; ++j) { const int ng = (cnt[j] + 31) >> 5; for (int g = 0; g < ng; ++g) items[ni++] = (j << 8) | g; }
      ctr[0] = ni; ctr[1] = 0;
    }
    __syncthreads();
    const int nitems = ctr[0];
    DUP(11) {
    if (rep_ > 0) { __syncthreads(); if (tid == 0) ctr[1] = 0; __syncthreads(); }
    for (;;) {
      int it = 0;
      if (lane == 0) it = atomicAdd(&ctr[1], 1);
      it = __builtin_amdgcn_readfirstlane(it);
      if (it >= nitems) break;
      const int item = items[it];
      const int j = item >> 8, g = item & 255;
      const bool own = (j == 16);
      const int kb = own ? qblk : j;
      const int ntile = own ? (g + 1) : 8;
      int qi; bool valid;
      if (own) { qi = g * 32 + n; valid = true; }
      else { const int pos = g * 32 + n; valid = pos < cnt[j]; qi = lists[j * 256 + (valid ? pos : 0)]; }
      const bf16_t* kt0 = p.Km() + ((size_t)bh * (S / 32) + kb * 8) * 2048 + lane * 8;
      const bf16_t* vt0 = p.Vm() + ((size_t)bh * (S / 32) + kb * 8) * 2048 + lane * 8;
      f32x16 O0, O1;
#pragma unroll
      for (int r = 0; r < 16; ++r) { O0[r] = 0.f; O1[r] = 0.f; }
      float lsum = 0.f;
      const float nbq = -bq[qi];
      bf16x8 kf[3][4], vf[3][4];
#define MOBA_LOAD(KT_, BUF_) { _Pragma("unroll") for (int s = 0; s < 4; ++s) { kf[BUF_][s] = *(const bf16x8*)(kt0 + (size_t)(KT_) * 2048 + s * 512); vf[BUF_][s] = *(const bf16x8*)(vt0 + (size_t)(KT_) * 2048 + s * 512); } }
#define MOBA_STEP(KT_, BUF_)                                                                                                           \
      if ((KT_) < ntile) {                                                                                                               \
        if ((KT_) + 2 < ntile) MOBA_LOAD((KT_) + 2, ((BUF_) + 2) % 3)                                                                     \
        f32x16 X;                                                                                                                         \
        _Pragma("unroll") for (int r = 0; r < 16; ++r) X[r] = nbq;                                                                        \
        _Pragma("unroll") for (int s = 0; s < 4; ++s) X = __builtin_amdgcn_mfma_f32_32x32x16_bf16(kf[BUF_][s], *(const bf16x8*)(Qs + qi * 64 + (2 * s + hh) * 8), X, 0, 0, 0);     \
        const bool diag = own && ((KT_) == g);                                                                                            \
        unsigned pw[8];                                                                                                                   \
        _Pragma("unroll") for (int r = 0; r < 16; r += 2) {                                                                               \
          float e0 = __builtin_amdgcn_exp2f(X[r]), e1 = __builtin_amdgcn_exp2f(X[r + 1]);                                                 \
          if (diag) {                                                                                                                     \
            const int k0 = (r & 3) + 8 * (r >> 2) + 4 * hh, k1 = ((r + 1) & 3) + 8 * ((r + 1) >> 2) + 4 * hh;                             \
            e0 = (k0 <= n) ? e0 : 0.f; e1 = (k1 <= n) ? e1 : 0.f;                                                                         \
          }                                                                                                                               \
          lsum += e0 + e1;                                                                                                                \
          pw[r >> 1] = pk_bf16(e0, e1);                                                                                                   \
        }                                                                                                                                 \
        bf16x8 pf0, pf1;                                                                                                                  \
        { uint4 t0 = make_uint4(pw[0], pw[1], pw[2], pw[3]), t1 = make_uint4(pw[4], pw[5], pw[6], pw[7]);                                 \
          pf0 = *(bf16x8*)&t0; pf1 = *(bf16x8*)&t1; }                                                                                     \
        O0 = __builtin_amdgcn_mfma_f32_32x32x16_bf16(vf[BUF_][0], pf0, O0, 0, 0, 0);                                                      \
        O0 = __builtin_amdgcn_mfma_f32_32x32x16_bf16(vf[BUF_][1], pf1, O0, 0, 0, 0);                                                      \
        O1 = __builtin_amdgcn_mfma_f32_32x32x16_bf16(vf[BUF_][2], pf0, O1, 0, 0, 0);                                                      \
        O1 = __builtin_amdgcn_mfma_f32_32x32x16_bf16(vf[BUF_][3], pf1, O1, 0, 0, 0);                                                      \
      }
      MOBA_LOAD(0, 0)
      if (ntile > 1) MOBA_LOAD(1, 1)
#pragma unroll 1
      for (int kt3 = 0; kt3 < ntile; kt3 += 3) {
        MOBA_STEP(kt3, 0) MOBA_STEP(kt3 + 1, 1) MOBA_STEP(kt3 + 2, 2)
      }
#undef MOBA_STEP
#undef MOBA_LOAD
      lsum += __shfl_xor(lsum, 32);
      if (valid) {
        if (hh == 0) atomicAdd(&lacc[qi], __float2int_rn(lsum * 1048576.0f));
#pragma unroll
        for (int r = 0; r < 16; ++r) {
          const int dim = (r & 3) + 8 * (r >> 2) + 4 * hh;
          atomicAdd(&Oacc[dim * OLD + qi], __float2int_rn(O0[r] * 1048576.0f));
          atomicAdd(&Oacc[(dim + 32) * OLD + qi], __float2int_rn(O1[r] * 1048576.0f));
        }
      }
    }
    }
    __syncthreads();
    { const int q = tid >> 1, half = tid & 1;
      const float inv = 1.0f / (float)lacc[q];
      float o[32], ss = 0.f;
#pragma unroll
      for (int d = 0; d < 32; ++d) { o[d] = (float)Oacc[(half * 32 + d) * OLD + q] * inv; ss += o[d] * o[d]; }
      ss += __shfl_xor(ss, 1);
      const float r = rsqrtf(ss / 64.0f + EPS);
      bf16_t* dst = p.xb() + (size_t)(b * S + qblk * 256 + q) * KD + 256 + h * 64 + half * 32;
#pragma unroll
      for (int d = 0; d < 32; d += 8) *(uint4*)(dst + d) = make_uint4(pk_bf16(o[d] * r, o[d + 1] * r), pk_bf16(o[d + 2] * r, o[d + 3] * r), pk_bf16(o[d + 4] * r, o[d + 5] * r), pk_bf16(o[d + 6] * r, o[d + 7] * r));
    }
  }
}


__device__ __forceinline__ void phase_ret_kv(const Params& p, int gw, int ngw, int lane) {
  const int n = lane & 31, hh = lane >> 5;
  for (int w = gw; w < NB * 4 * 32; w += ngw) {
    const int bh = w >> 5, cn = w & 31;
    const bf16_t* vt = p.Vr() + ((size_t)bh * (S / 32) + cn * 4) * 2048 + lane * 8;
    const bf16_t* kt = p.Krv() + ((size_t)bh * (S / 32) + cn * 4) * 2048 + lane * 8;
    f32x16 acc[2][2];
#pragma unroll
    for (int a = 0; a < 2; ++a)
#pragma unroll
      for (int b2 = 0; b2 < 2; ++b2)
#pragma unroll
        for (int r = 0; r < 16; ++r) acc[a][b2][r] = 0.f;
#pragma unroll 1
    for (int tl = 0; tl < 4; ++tl)
#pragma unroll
      for (int ks = 0; ks < 2; ++ks) {
        bf16x8 vf[2], kf[2];
#pragma unroll
        for (int x = 0; x < 2; ++x) { vf[x] = *(const bf16x8*)(vt + tl * 2048 + (x * 2 + ks) * 512); kf[x] = *(const bf16x8*)(kt + tl * 2048 + (x * 2 + ks) * 512); }
#pragma unroll
        for (int mb = 0; mb < 2; ++mb)
#pragma unroll
          for (int nb = 0; nb < 2; ++nb) acc[mb][nb] = __builtin_amdgcn_mfma_f32_32x32x16_bf16(vf[mb], kf[nb], acc[mb][nb], 0, 0, 0);
      }
    float* dst = p.KVr() + ((size_t)bh * 32 + cn) * 4096;
#pragma unroll
    for (int mb = 0; mb < 2; ++mb)
#pragma unroll
      for (int nb = 0; nb < 2; ++nb)
#pragma unroll
        for (int r = 0; r < 16; ++r) dst[(mb * 32 + (r & 3) + 8 * (r >> 2) + 4 * hh) * 64 + nb * 32 + n] = acc[mb][nb][r];
  }
}
__device__ __forceinline__ void phase_ret_scan(const Params& p, int gtid, int ngt) {
  for (int it = gtid; it < NB * 4 * 4096; it += ngt) {
    const int e = it & 4095, bh = it >> 12, h = bh & 3;
    const float l2g = ret_log2g(h), g1 = exp2f(l2g), g127 = exp2f(127.0f * l2g), g128 = exp2f(128.0f * l2g);
    float R = 0.f; float kv[32];
#pragma unroll
    for (int cn = 0; cn < 32; ++cn) kv[cn] = p.KVr()[((size_t)bh * 32 + cn) * 4096 + e];
#pragma unroll
    for (int cn = 0; cn < 32; ++cn) {
      p.Rb()[((size_t)bh * 32 + cn) * 4096 + e] = f2bf(g1 * R);
      R = g128 * R + g127 * kv[cn];
    }
  }
}
__device__ __forceinline__ void phase_ret_out(const Params& p, int gw, int ngw, int lane) {
  const int n = lane & 31, hh = lane >> 5;
  for (int w = gw; w < NB * 4 * 32 * 4; w += ngw) {
    const int qg = 3 - (w & 3), cn = (w >> 2) & 31, bh = w >> 7, b = bh >> 2, h = bh & 3;
    const int s0 = cn * 128 + qg * 32;
    bf16x8 qf[4];
#pragma unroll
    for (int s = 0; s < 4; ++s) qf[s] = *(const bf16x8*)(p.Qr() + ((size_t)bh * S + s0 + n) * 64 + (2 * s + hh) * 8);
    f32x16 O0, O1;
#pragma unroll
    for (int r = 0; r < 16; ++r) { O0[r] = 0.f; O1[r] = 0.f; }
    { const bf16_t* rb = p.Rb() + ((size_t)bh * 32 + cn) * 4096 + (size_t)n * 64 + hh * 8;
#pragma unroll
      for (int s = 0; s < 4; ++s) {
        const bf16x8 r0 = *(const bf16x8*)(rb + s * 16), r1 = *(const bf16x8*)(rb + 32 * 64 + s * 16);
        O0 = __builtin_amdgcn_mfma_f32_32x32x16_bf16(r0, qf[s], O0, 0, 0, 0);
        O1 = __builtin_amdgcn_mfma_f32_32x32x16_bf16(r1, qf[s], O1, 0, 0, 0);
      } }
    const bf16_t* kt0 = p.Kr() + ((size_t)bh * (S / 32) + cn * 4) * 2048 + lane * 8;
    const bf16_t* vt0 = p.Vr() + ((size_t)bh * (S / 32) + cn * 4) * 2048 + lane * 8;
    for (int kt = 0; kt <= qg; ++kt) {
      bf16x8 kf[4], vf[4];
#pragma unroll
      for (int s = 0; s < 4; ++s) { kf[s] = *(const bf16x8*)(kt0 + (size_t)kt * 2048 + s * 512); vf[s] = *(const bf16x8*)(vt0 + (size_t)kt * 2048 + s * 512); }
      f32x16 X;
#pragma unroll
      for (int r = 0; r < 16; ++r) X[r] = 0.f;
#pragma unroll
      for (int s = 0; s < 4; ++s) X = __builtin_amdgcn_mfma_f32_32x32x16_bf16(kf[s], qf[s], X, 0, 0, 0);
      const bool diag = (kt == qg);
      unsigned pw[8];
#pragma unroll
      for (int r = 0; r < 16; r += 2) {
        float e0 = X[r], e1 = X[r + 1];
        if (diag) {
          const int k0 = (r & 3) + 8 * (r >> 2) + 4 * hh, k1 = ((r + 1) & 3) + 8 * ((r + 1) >> 2) + 4 * hh;
          e0 = (k0 <= n) ? e0 : 0.f; e1 = (k1 <= n) ? e1 : 0.f;
        }
        pw[r >> 1] = pk_bf16(e0, e1);
      }
      bf16x8 pf0, pf1;
      { uint4 t0 = make_uint4(pw[0], pw[1], pw[2], pw[3]), t1 = make_uint4(pw[4], pw[5], pw[6], pw[7]);
        pf0 = *(bf16x8*)&t0; pf1 = *(bf16x8*)&t1; }
      O0 = __builtin_amdgcn_mfma_f32_32x32x16_bf16(vf[0], pf0, O0, 0, 0, 0);
      O0 = __builtin_amdgcn_mfma_f32_32x32x16_bf16(vf[1], pf1, O0, 0, 0, 0);
      O1 = __builtin_amdgcn_mfma_f32_32x32x16_bf16(vf[2], pf0, O1, 0, 0, 0);
      O1 = __builtin_amdgcn_mfma_f32_32x32x16_bf16(vf[3], pf1, O1, 0, 0, 0);
    }
    float ss = 0.f;
#pragma unroll
    for (int r = 0; r < 16; ++r) ss += O0[r] * O0[r] + O1[r] * O1[r];
    ss += __shfl_xor(ss, 32);
    const float rn = rsqrtf(ss / 64.0f + EPS);
    const size_t t = (size_t)b * S + s0 + n;
    const bf16_t* gp = p.grow() + t * 256 + h * 64;
    bf16_t* yo = p.xb() + t * KD + 768 + h * 64;
#pragma unroll
    for (int q4 = 0; q4 < 4; ++q4) {
#pragma unroll
      for (int mb = 0; mb < 2; ++mb) {
        const int d0 = mb * 32 + 8 * q4 + 4 * hh;
        const uint2 gw2 = *(const uint2*)(gp + d0); const float4 g = make_float4(__uint_as_float(gw2.x << 16), __uint_as_float(gw2.x & 0xffff0000u), __uint_as_float(gw2.y << 16), __uint_as_float(gw2.y & 0xffff0000u));
        float4 o;
        const f32x16& Oa = mb ? O1 : O0;
        o.x = Oa[q4 * 4 + 0] * rn * g.x * fast_sigmoid(g.x); o.y = Oa[q4 * 4 + 1] * rn * g.y * fast_sigmoid(g.y);
        o.z = Oa[q4 * 4 + 2] * rn * g.z * fast_sigmoid(g.z); o.w = Oa[q4 * 4 + 3] * rn * g.w * fast_sigmoid(g.w);
        *(uint2*)(yo + d0) = make_uint2(pk_bf16(o.x, o.y), pk_bf16(o.z, o.w));
      }
    }
  }
}

__device__ __forceinline__ void phase_post_pack(const Params& p, int gtid, int ngt) {
  for (int idx = gtid; idx < NB * 8 * (S / 32) * 256; idx += ngt) {
    const int ln = idx & 63, ks = (idx >> 6) & 1, mb = (idx >> 7) & 1, tile = (idx >> 8) % (S / 32), bh = idx / (256 * (S / 32));
    const int b = bh >> 3, h = bh & 7, hh = ln >> 5, delta = mb * 32 + (ln & 31);
    bf16_t v[8];
#pragma unroll
    for (int j = 0; j < 8; ++j) { const int kappa = 16 * ks + 8 * (j >> 2) + 4 * hh + (j & 3), s = tile * 32 + kappa; v[j] = p.vrow()[(size_t)(b * S + s) * 512 + h * 64 + delta]; }
    *(uint4*)(p.Vm() + (size_t)idx * 8) = make_uint4(v[0] | ((unsigned)v[1] << 16), v[2] | ((unsigned)v[3] << 16), v[4] | ((unsigned)v[5] << 16), v[6] | ((unsigned)v[7] << 16));
  }
  for (int idx = gtid; idx < 2 * NB * 4 * (S / 32) * 256; idx += ngt) {
    const int ln = idx & 63, ks = (idx >> 6) & 1, blk = (idx >> 7) & 1, tile = (idx >> 8) % (S / 32), rest = idx / (256 * (S / 32)), bh = rest % (NB * 4), which = rest / (NB * 4);
    const int b = bh >> 2, h = bh & 3, hh = ln >> 5, delta = blk * 32 + (ln & 31);
    const bf16_t* srcp = which ? p.krow() : p.vrrow();
    bf16_t v[8];
#pragma unroll
    for (int j = 0; j < 8; ++j) { const int kappa = 16 * ks + 8 * (j >> 2) + 4 * hh + (j & 3), s = tile * 32 + kappa; v[j] = srcp[(size_t)(b * S + s) * 256 + h * 64 + delta]; }
    *(uint4*)((which ? p.Krv() : p.Vr()) + ((size_t)(idx % (NB * 4 * (S / 32) * 256))) * 8) = make_uint4(v[0] | ((unsigned)v[1] << 16), v[2] | ((unsigned)v[3] << 16), v[4] | ((unsigned)v[5] << 16), v[6] | ((unsigned)v[7] << 16));
  }
}
__device__ __forceinline__ void phase_kmean2(const Params& p, int gtid, int ngt) {
  for (int idx = gtid; idx < NB * 8 * 16 * 64; idx += ngt) {
    const int d = idx & 63, j = (idx >> 6) & 15, bh = idx >> 10, c = d >> 3, dj = d & 7;
    float acc = 0.f;
    for (int tl = 0; tl < 8; ++tl) {
      const bf16_t* kp = p.Km() + (((size_t)bh * (S / 32) + j * 8 + tl) * 8 + c) * 256 + dj;
#pragma unroll 8
      for (int key = 0; key < 32; ++key) acc += bf2f(kp[key * 8]);
    }
    p.kmean()[idx] = acc * (1.0f / 256.0f);
  }
}

__device__ __forceinline__ void cvt_f32_bf16(const float* __restrict__ src, bf16_t* __restrict__ dst, size_t n8, int gtid, int ngt) {
  for (size_t i = gtid; i < n8; i += ngt) {
    float4 a = *(const float4*)(src + i * 8), b4 = *(const float4*)(src + i * 8 + 4);
    uint4 o; o.x = pk_bf16(a.x, a.y); o.y = pk_bf16(a.z, a.w); o.z = pk_bf16(b4.x, b4.y); o.w = pk_bf16(b4.z, b4.w);
    *(uint4*)(dst + i * 8) = o;
  }
}
__device__ __forceinline__ int f2key(float f) { int b = __float_as_int(f); return b ^ ((b >> 31) & 0x7fffffff); }
__device__ __forceinline__ float key2f(int k) { return __int_as_float(k ^ ((k >> 31) & 0x7fffffff)); }
#define CASD(a_, b_) { int mx_ = max(a_, b_), mn_ = min(a_, b_); a_ = mx_; b_ = mn_; }
__device__ __forceinline__ void sort16_desc(int (&v)[16]) {
#pragma unroll
  for (int k = 2; k <= 16; k <<= 1)
#pragma unroll
    for (int j = k >> 1; j > 0; j >>= 1)
#pragma unroll
      for (int i = 0; i < 16; ++i) { const int l2 = i ^ j; if (l2 > i) { if ((i & k) == 0) CASD(v[i], v[l2]) else CASD(v[l2], v[i]) } }
}
__device__ __forceinline__ void merge_top16(int (&a)[16], const int (&b)[16]) {
#pragma unroll
  for (int i = 0; i < 16; ++i) a[i] = max(a[i], b[15 - i]);
#pragma unroll
  for (int j = 8; j > 0; j >>= 1)
#pragma unroll
    for (int i = 0; i < 16; ++i) { const int l2 = i ^ j; if (l2 > i) CASD(a[i], a[l2]) }
}
__device__ __forceinline__ int lut4(int w0, int w1, int w2, int w3, int i) {
  const int w = i >> 2; const int d = (w == 0) ? w0 : (w == 1) ? w1 : (w == 2) ? w2 : w3;
  return (d >> ((i & 3) * 8)) & 127;
}

__device__ __forceinline__ void phase_peer_topk(const Params& p, int l, int gw, int ngw, int lane) {
  const int n = lane & 31, hh = lane >> 5;
  const bf16_t* skl = p.skb() + (size_t)l * 16 * 128 * 64;
  for (int w = gw; w < (T / 32) * 8; w += ngw) {
    const int tg = w >> 3, h = w & 7, t = tg * 32 + n;
    int L0[16], L1[16];
#pragma unroll
    for (int c = 0; c < 2; ++c) {
      const int hc = 2 * h + c;
      bf16x8 qf[4];
#pragma unroll
      for (int s = 0; s < 4; ++s) qf[s] = *(const bf16x8*)(p.qb() + (size_t)t * D + hc * 64 + 16 * s + 8 * hh);
      int A[16], Bq[16];
#pragma unroll
      for (int mb = 0; mb < 4; ++mb) {
        f32x16 X;
#pragma unroll
        for (int r = 0; r < 16; ++r) X[r] = 0.f;
#pragma unroll
        for (int s = 0; s < 4; ++s) {
          const bf16x8 kf = *(const bf16x8*)(skl + ((size_t)(hc * 128 + mb * 32 + n)) * 64 + 16 * s + 8 * hh);
          X = __builtin_amdgcn_mfma_f32_32x32x16_bf16(kf, qf[s], X, 0, 0, 0);
        }
        int Gk[16];
#pragma unroll
        for (int r = 0; r < 16; ++r) Gk[r] = (f2key(X[r]) & ~127) | (mb * 32 + (r & 3) + 8 * (r >> 2) + 4 * hh);
        sort16_desc(Gk);
        if (mb == 0) {
#pragma unroll
          for (int r = 0; r < 16; ++r) A[r] = Gk[r];
        } else merge_top16(A, Gk);
      }
#pragma unroll
      for (int r = 0; r < 16; ++r) Bq[r] = __shfl_xor(A[r], 32);
      merge_top16(A, Bq);
#pragma unroll
      for (int r = 0; r < 16; ++r) { if (c == 0) L0[r] = A[r]; else L1[r] = A[r]; }
    }
    float av[16], bv[16];
#pragma unroll
    for (int r = 0; r < 16; ++r) { av[r] = key2f(L0[r] & ~127); bv[r] = key2f(L1[r] & ~127); }
#define CAND(i_, j_) ((f2key(av[i_] + bv[j_]) & ~255) | ((i_) << 4) | (j_))
    int R[16], G1[16], G2[16];
#pragma unroll
    for (int j = 0; j < 16; ++j) R[j] = CAND(0, j);
    G1[0] = CAND(1, 0); G1[1] = CAND(1, 1); G1[2] = CAND(1, 2); G1[3] = CAND(1, 3); G1[4] = CAND(1, 4); G1[5] = CAND(1, 5); G1[6] = CAND(1, 6); G1[7] = CAND(1, 7);
    G1[8] = CAND(2, 0); G1[9] = CAND(2, 1); G1[10] = CAND(2, 2); G1[11] = CAND(2, 3); G1[12] = CAND(2, 4); G1[13] = CAND(3, 0); G1[14] = CAND(3, 1); G1[15] = CAND(3, 2);
    G2[0] = CAND(3, 3); G2[1] = CAND(4, 0); G2[2] = CAND(4, 1); G2[3] = CAND(4, 2); G2[4] = CAND(5, 0); G2[5] = CAND(5, 1); G2[6] = CAND(6, 0); G2[7] = CAND(6, 1);
    G2[8] = CAND(7, 0); G2[9] = CAND(7, 1); G2[10] = CAND(8, 0); G2[11] = CAND(9, 0); G2[12] = CAND(10, 0); G2[13] = CAND(11, 0); G2[14] = CAND(12, 0); G2[15] = CAND(13, 0);
    sort16_desc(G1); merge_top16(R, G1);
    sort16_desc(G2); merge_top16(R, G2);
    { int x0 = CAND(14, 0), x1 = CAND(15, 0);
#pragma unroll
      for (int i = 0; i < 16; ++i) CASD(R[i], x0)
#pragma unroll
      for (int i = 0; i < 16; ++i) CASD(R[i], x1)
    }
#undef CAND
    int pa0 = 0, pa1 = 0, pa2 = 0, pa3 = 0, pb0 = 0, pb1 = 0, pb2 = 0, pb3 = 0;
#pragma unroll
    for (int q = 0; q < 4; ++q) {
      pa0 |= (L0[q] & 127) << (8 * q); pa1 |= (L0[4 + q] & 127) << (8 * q); pa2 |= (L0[8 + q] & 127) << (8 * q); pa3 |= (L0[12 + q] & 127) << (8 * q);
      pb0 |= (L1[q] & 127) << (8 * q); pb1 |= (L1[4 + q] & 127) << (8 * q); pb2 |= (L1[8 + q] & 127) << (8 * q); pb3 |= (L1[12 + q] & 127) << (8 * q);
    }
    float ev[16], sum = 0.f; int ei[16];
    const float mx = key2f(R[0] & ~255);
#pragma unroll
    for (int z = 0; z < 16; ++z) {
      const float v = key2f(R[z] & ~255);
      ev[z] = __expf(v - mx); sum += ev[z];
      const int pay = R[z] & 255;
      ei[z] = lut4(pa0, pa1, pa2, pa3, pay >> 4) * 128 + lut4(pb0, pb1, pb2, pb3, pay & 15);
    }
    const float inv = 1.0f / sum;
    if (hh == 0) {
      float* go = p.gates() + ((size_t)t * 8 + h) * 16; int* eo = p.eidx() + ((size_t)t * 8 + h) * 16;
#pragma unroll
      for (int z = 0; z < 16; z += 4) {
        *(float4*)(go + z) = make_float4(ev[z] * inv, ev[z + 1] * inv, ev[z + 2] * inv, ev[z + 3] * inv);
        *(int4*)(eo + z) = make_int4(ei[z], ei[z + 1], ei[z + 2], ei[z + 3]);
      }
    }
  }
}


typedef int v8i __attribute__((ext_vector_type(8)));
__device__ __forceinline__ unsigned xcc_id() { return (unsigned)__builtin_amdgcn_s_getreg((3 << 11) | 20) & 7u; }
__device__ __forceinline__ float pow2_scale(float amax) {
  if (!(amax > 0.f)) return 1.0f;
  const int e = (int)floorf(log2f(240.0f / amax));
  return exp2f((float)(e < 60 ? (e > -60 ? e : -60) : 60));
}
__device__ __forceinline__ unsigned pack4_fp8(float a, float b, float c, float d) {
  int v = __builtin_amdgcn_cvt_pk_fp8_f32(a, b, 0, false);
  v = __builtin_amdgcn_cvt_pk_fp8_f32(c, d, v, true);
  return (unsigned)v;
}
__device__ __forceinline__ void cvt_table_i8(const float* __restrict__ src, unsigned char* __restrict__ dst, float* __restrict__ scl, int gw, int ngw, int lane) {
  for (int e0 = gw; e0 < 16384; e0 += 2 * ngw) {
    float4 v[2][4];
#pragma unroll
    for (int u = 0; u < 2; ++u) { const int e = (e0 + u * ngw < 16384) ? e0 + u * ngw : e0;
#pragma unroll
      for (int k = 0; k < 4; ++k) v[u][k] = *(const float4*)(src + (size_t)e * D + k * 256 + lane * 4); }
#pragma unroll
    for (int u = 0; u < 2; ++u) {
      const int e = e0 + u * ngw;
      if (e < 16384) {
        float am = 0.f;
#pragma unroll
        for (int k = 0; k < 4; ++k) am = fmaxf(am, fmaxf(fmaxf(fabsf(v[u][k].x), fabsf(v[u][k].y)), fmaxf(fabsf(v[u][k].z), fabsf(v[u][k].w))));
        am = wave_max(am);
        const float s = am > 0.f ? 127.0f / am : 1.0f;
        if (lane == 0) scl[e] = s;
#pragma unroll
        for (int k = 0; k < 4; ++k) {
          const int slice = 2 * k + (lane >> 5), off = (lane & 31) * 4;
          const unsigned w = (unsigned)(__float2int_rn(v[u][k].x * s) & 255) | ((unsigned)(__float2int_rn(v[u][k].y * s) & 255) << 8) |
                             ((unsigned)(__float2int_rn(v[u][k].z * s) & 255) << 16) | ((unsigned)(__float2int_rn(v[u][k].w * s) & 255) << 24);
          *(unsigned*)(dst + ((size_t)slice * 16384 + e) * 128 + off) = w;
        }
      }
    }
  }
}
__device__ __forceinline__ void cvt_table_fp8(const float* __restrict__ src, unsigned char* __restrict__ dst, float* __restrict__ scl, int gw, int ngw, int lane) {
  for (int e0 = gw; e0 < 16384; e0 += 2 * ngw) {
    float4 v[2][4];
#pragma unroll
    for (int u = 0; u < 2; ++u) { const int e = (e0 + u * ngw < 16384) ? e0 + u * ngw : e0;
#pragma unroll
      for (int k = 0; k < 4; ++k) v[u][k] = *(const float4*)(src + (size_t)e * D + k * 256 + lane * 4); }
#pragma unroll
    for (int u = 0; u < 2; ++u) {
      const int e = e0 + u * ngw;
      if (e < 16384) {
        float am = 0.f;
#pragma unroll
        for (int k = 0; k < 4; ++k) am = fmaxf(am, fmaxf(fmaxf(fabsf(v[u][k].x), fabsf(v[u][k].y)), fmaxf(fabsf(v[u][k].z), fabsf(v[u][k].w))));
        am = wave_max(am);
        const float s = pow2_scale(am);
        if (lane == 0) scl[e] = s;
#pragma unroll
        for (int k = 0; k < 4; ++k) {
          const int slice = 2 * k + (lane >> 5), off = (lane & 31) * 4;
          *(unsigned*)(dst + ((size_t)slice * 16384 + e) * 128 + off) = pack4_fp8(v[u][k].x * s, v[u][k].y * s, v[u][k].z * s, v[u][k].w * s);
        }
      }
    }
  }
}
#define DPP_ADD(v_, ctrl_) ((v_) + __builtin_bit_cast(float, __builtin_amdgcn_update_dpp(0, __builtin_bit_cast(int, (v_)), (ctrl_), 0xF, 0xF, true)))
__device__ __forceinline__ float sum_xor16(float x) { float a = x, b = x; asm volatile("v_nop\n\tv_nop\n\tv_permlane16_swap_b32 %0, %1" : "+v"(a), "+v"(b)); return a + b; }
__device__ __forceinline__ float sum_xor32(float x) { float a = x, b = x; asm volatile("v_nop\n\tv_nop\n\tv_permlane32_swap_b32 %0, %1" : "+v"(a), "+v"(b)); return a + b; }
constexpr int PEER_TILE = 128;
__device__ __forceinline__ void phase_peer_u(const Params& p, int* heads, unsigned char* lds, int tid) {
  const int lane = tid & 63, wv = tid >> 6, r8 = lane >> 3, c8 = lane & 7;
  int* bc = (int*)lds;
  int* eW = (int*)(lds + 1024 + wv * 12288);
  bf16_t* hW = (bf16_t*)(lds + 1024 + wv * 12288 + 8192);
  const int myx = (int)xcc_id();
  for (int pass = 0; pass < 8; ++pass) {
    const int s = (myx + pass) & 7;
    const unsigned char* Us = p.U8s() + (size_t)s * 16384 * 128 + c8 * 16;
    for (;;) {
      const int item = q_pull(heads + s, T / PEER_TILE, bc, tid);
      if (item < 0) break;
      const int t0 = item * PEER_TILE + wv * 16;
      LDS_FENCE();
      { uint2 ev[16];
        const bf16_t* hsrc = p.hb() + ((size_t)s * T + t0) * 128 + lane * 8;
#pragma unroll
        for (int k = 0; k < 16; ++k) ev[k] = *(const uint2*)(p.eidx() + (size_t)(t0 + k) * 128 + lane * 2);
        const uint4 hq0 = *(const uint4*)(hsrc), hq1 = *(const uint4*)(hsrc + 512), hq2 = *(const uint4*)(hsrc + 1024), hq3 = *(const uint4*)(hsrc + 1536);
#pragma unroll
        for (int k = 0; k < 16; ++k) *(uint2*)(eW + k * 128 + lane * 2) = ev[k];
        *(uint4*)(hW + lane * 8) = hq0; *(uint4*)(hW + 512 + lane * 8) = hq1; *(uint4*)(hW + 1024 + lane * 8) = hq2; *(uint4*)(hW + 1536 + lane * 8) = hq3; }
      LDS_FENCE();
      uint4 R[4][8];
#define PEER_U_LOAD(M_, BUF_) { _Pragma("unroll") for (int eb = 0; eb < 8; ++eb) R[BUF_][eb] = *(const uint4*)(Us + (size_t)eW[(M_) * 64 + eb * 8 + r8] * 128); }
      if (!(PROBE_SKIP & 128)) { PEER_U_LOAD(0, 0) PEER_U_LOAD(1, 1) PEER_U_LOAD(2, 2) } else { _Pragma("unroll") for (int a_ = 0; a_ < 4; ++a_) _Pragma("unroll") for (int b_ = 0; b_ < 8; ++b_) R[a_][b_] = make_uint4(0u, 0u, 0u, 0u); }
      int hq[4]; float hinv = 0.f; float res0 = 0.f, res1 = 0.f;
#define PEER_U_LOADH(TOK_) { const bf16_t* hp = hW + (TOK_) * 128 + c8 * 16; const uint4 a = *(const uint4*)hp, b4 = *(const uint4*)(hp + 8); \
        const unsigned w8[8] = {a.x, a.y, a.z, a.w, b4.x, b4.y, b4.z, b4.w}; float hv[16]; float am = 0.f;                               \
        _Pragma("unroll") for (int z = 0; z < 8; ++z) { hv[2 * z] = __uint_as_float(w8[z] << 16); hv[2 * z + 1] = __uint_as_float(w8[z] & 0xffff0000u); \
          am = fmaxf(am, fmaxf(fabsf(hv[2 * z]), fabsf(hv[2 * z + 1]))); }                                                                \
        am = fmaxf(am, __builtin_bit_cast(float, __builtin_amdgcn_update_dpp(0, __builtin_bit_cast(int, am), 0xB1, 0xF, 0xF, true)));     \
        am = fmaxf(am, __builtin_bit_cast(float, __builtin_amdgcn_update_dpp(0, __builtin_bit_cast(int, am), 0x4E, 0xF, 0xF, true)));     \
        am = fmaxf(am, __builtin_bit_cast(float, __builtin_amdgcn_update_dpp(0, __builtin_bit_cast(int, am), 0x141, 0xF, 0xF, true)));    \
        const float hs = am > 0.f ? 127.0f / am : 1.0f; hinv = am > 0.f ? am * (1.0f / 127.0f) : 1.0f;                                    \
        _Pragma("unroll") for (int z = 0; z < 4; ++z) hq[z] = (__float2int_rn(hv[4 * z] * hs) & 255) | ((__float2int_rn(hv[4 * z + 1] * hs) & 255) << 8) | \
                                                               ((__float2int_rn(hv[4 * z + 2] * hs) & 255) << 16) | (__float2int_rn(hv[4 * z + 3] * hs) << 24); }
      PEER_U_LOADH(0)
#define PEER_U_HALF(M_, BUF_, HALF_)                                                                           \
      {                                                                                                                                   \
        if (!(PROBE_SKIP & 128)) { if ((M_) + 3 < 32) PEER_U_LOAD((M_) + 3, ((BUF_) + 3) & 3) }                                             \
        if (!(PROBE_SKIP & 128)) _Pragma("unroll") for (int eb = 0; eb < 8; ++eb) {                                                       \
          int di = __builtin_amdgcn_sdot4((int)R[BUF_][eb].x, hq[0], 0, false);                                                           \
          di = __builtin_amdgcn_sdot4((int)R[BUF_][eb].y, hq[1], di, false);                                                              \
          di = __builtin_amdgcn_sdot4((int)R[BUF_][eb].z, hq[2], di, false);                                                              \
          di = __builtin_amdgcn_sdot4((int)R[BUF_][eb].w, hq[3], di, false);                                                              \
          di += __builtin_amdgcn_update_dpp(0, di, 0xB1, 0xF, 0xF, true); di += __builtin_amdgcn_update_dpp(0, di, 0x4E, 0xF, 0xF, true);   \
          di += __builtin_amdgcn_update_dpp(0, di, 0x141, 0xF, 0xF, true);     \
          const float d = (float)di * hinv;                                                                                               \
          if ((HALF_) == 0) { if (c8 == eb) res0 = d; } else { if (c8 == eb) res1 = d; }                                                  \
        }                                                                                                                                 \
        if ((HALF_) == 1) {                                                                                                               \
          bf16_t* po = p.ppart() + ((size_t)s * T + t0 + ((M_) >> 1)) * 128;                                                              \
          po[c8 * 8 + r8] = f2bf(res0); po[64 + c8 * 8 + r8] = f2bf(res1);                                                                \
          if ((M_) + 1 < 32) PEER_U_LOADH(((M_) >> 1) + 1)                                                                                \
        }                                                                                                                                 \
      }
#pragma unroll
      for (int m4 = 0; m4 < 32; m4 += 4) {
        PEER_U_HALF(m4, 0, 0) PEER_U_HALF(m4 + 1, 1, 1) PEER_U_HALF(m4 + 2, 2, 0) PEER_U_HALF(m4 + 3, 3, 1)
      }
#undef PEER_U_HALF
#undef PEER_U_LOADH
#undef PEER_U_LOAD
    }
  }
}
__device__ __forceinline__ void phase_peer_r(const Params& p, int gtid, int ngt) {
  for (int idx0 = gtid; idx0 < T * 128; idx0 += 4 * ngt) {
    float d[4]; int e[4]; float su_[4], sv_[4], g_[4]; bool ok[4];
#pragma unroll
    for (int u = 0; u < 4; ++u) { const int idx = idx0 + u * ngt; ok[u] = idx < T * 128; const int ix = ok[u] ? idx : 0;
      e[u] = p.eidx()[ix]; g_[u] = p.gates()[ix]; float a = 0.f;
#pragma unroll
      for (int s = 0; s < 8; ++s) a += bf2f(p.ppart()[(size_t)s * T * 128 + ix]);
      d[u] = a; }
#pragma unroll
    for (int u = 0; u < 4; ++u) { su_[u] = p.su()[e[u]]; sv_[u] = p.sv()[e[u]]; }
#pragma unroll
    for (int u = 0; u < 4; ++u) if (ok[u]) p.gates()[idx0 + u * ngt] = g_[u] * gelu_tanh(d[u] * p.rstd()[(idx0 + u * ngt) >> 7] / su_[u]) / sv_[u];
  }
}
__device__ __forceinline__ void phase_peer_v(const Params& p, int* heads, unsigned char* lds, int tid) {
  const int lane = tid & 63, wv = tid >> 6, r8 = lane >> 3, c8 = lane & 7;
  int* bc = (int*)lds;
  uint2* pW = (uint2*)(lds + 1024 + wv * 16384);
  const int myx = (int)xcc_id();
  for (int pass = 0; pass < 8; ++pass) {
    const int s = (myx + pass) & 7;
    const unsigned char* Vs = p.V8s() + (size_t)s * 16384 * 128 + c8 * 16;
    for (;;) {
      const int item = q_pull(heads + s, T / PEER_TILE, bc, tid);
      if (item < 0) break;
      const int t0 = item * PEER_TILE + wv * 16;
      LDS_FENCE();
      { uint2 e2[16], g2[16];
#pragma unroll
        for (int k = 0; k < 16; ++k) { e2[k] = *(const uint2*)(p.eidx() + (size_t)(t0 + k) * 128 + lane * 2); g2[k] = *(const uint2*)(p.gates() + (size_t)(t0 + k) * 128 + lane * 2); }
#pragma unroll
        for (int k = 0; k < 16; ++k) *(uint4*)(pW + k * 128 + lane * 2) = make_uint4(e2[k].x, g2[k].x, e2[k].y, g2[k].y); }
      LDS_FENCE();
      const int rowk = lane >> 4, prow = ((rowk & 1) << 1) | (rowk >> 1);
      const bool wr_lane = (lane & 8) == 0;
      const int xoff = s * 128 + c8 * 16 + prow * 4;
      float4 xo[8];
#pragma unroll
      for (int k = 0; k < 8; ++k) xo[k] = *(const float4*)(p.outp() + (size_t)(t0 + k) * D + xoff);
      uint4 R[3][8];
#define PEER_V_LOAD(M_, BUF_) { _Pragma("unroll") for (int eb = 0; eb < 8; ++eb) R[BUF_][eb] = *(const uint4*)(Vs + (size_t)pW[(M_) * 64 + eb * 8 + r8].x * 128); }
      if (!(PROBE_SKIP & 64)) { PEER_V_LOAD(0, 0) PEER_V_LOAD(1, 1) } else { _Pragma("unroll") for (int a_ = 0; a_ < 3; ++a_) _Pragma("unroll") for (int b_ = 0; b_ < 8; ++b_) R[a_][b_] = make_uint4(0u, 0u, 0u, 0u); }
      float acc[16];
#define PEER_V_HALF(M_, BUF_, HALF_)                                                           \
      {                                                                                                                                   \
        if (!(PROBE_SKIP & 64)) { if ((M_) + 2 < 32) PEER_V_LOAD((M_) + 2, ((BUF_) + 2) % 3) }                                              \
        if ((HALF_) == 0) { _Pragma("unroll") for (int z = 0; z < 16; ++z) acc[z] = 0.f; }                                                \
        if (!(PROBE_SKIP & 64)) _Pragma("unroll") for (int eb = 0; eb < 8; ++eb) {                                                        \
          const float c = __uint_as_float(pW[(M_) * 64 + eb * 8 + r8].y);                                                                 \
          const unsigned ww[4] = {R[BUF_][eb].x, R[BUF_][eb].y, R[BUF_][eb].z, R[BUF_][eb].w};                                            \
          _Pragma("unroll") for (int q4 = 0; q4 < 4; ++q4) {                                                                              \
            const auto f01 = __builtin_amdgcn_cvt_pk_f32_fp8((int)ww[q4], false); const auto f23 = __builtin_amdgcn_cvt_pk_f32_fp8((int)ww[q4], true); \
            acc[q4 * 4 + 0] = fmaf(c, f01[0], acc[q4 * 4 + 0]); acc[q4 * 4 + 1] = fmaf(c, f01[1], acc[q4 * 4 + 1]);                       \
            acc[q4 * 4 + 2] = fmaf(c, f23[0], acc[q4 * 4 + 2]); acc[q4 * 4 + 3] = fmaf(c, f23[1], acc[q4 * 4 + 3]);                       \
          }                                                                                                                               \
        }                                                                                                                                 \
        if ((HALF_) == 1) {                                                                                                               \
          _Pragma("unroll") for (int z = 0; z < 16; ++z) acc[z] = DPP_ADD(acc[z], 0x128);                                  \
          asm volatile("v_nop\n\tv_nop\n\tv_permlane16_swap_b32 %0, %8\n\tv_permlane16_swap_b32 %1, %9\n\tv_permlane16_swap_b32 %2, %10\n\tv_permlane16_swap_b32 %3, %11\n\t" \
                       "v_permlane16_swap_b32 %4, %12\n\tv_permlane16_swap_b32 %5, %13\n\tv_permlane16_swap_b32 %6, %14\n\tv_permlane16_swap_b32 %7, %15" \
            : "+v"(acc[0]), "+v"(acc[1]), "+v"(acc[2]), "+v"(acc[3]), "+v"(acc[4]), "+v"(acc[5]), "+v"(acc[6]), "+v"(acc[7]),                   \
              "+v"(acc[8]), "+v"(acc[9]), "+v"(acc[10]), "+v"(acc[11]), "+v"(acc[12]), "+v"(acc[13]), "+v"(acc[14]), "+v"(acc[15]));               \
          _Pragma("unroll") for (int z = 0; z < 8; ++z) acc[z] += acc[z + 8];            \
          asm volatile("v_nop\n\tv_nop\n\tv_permlane32_swap_b32 %0, %4\n\tv_permlane32_swap_b32 %1, %5\n\tv_permlane32_swap_b32 %2, %6\n\tv_permlane32_swap_b32 %3, %7" \
            : "+v"(acc[0]), "+v"(acc[1]), "+v"(acc[2]), "+v"(acc[3]), "+v"(acc[4]), "+v"(acc[5]), "+v"(acc[6]), "+v"(acc[7]));                   \
          float4 dl;                                                                                                                      \
          dl.x = acc[0] + acc[4]; dl.y = acc[1] + acc[5]; dl.z = acc[2] + acc[6]; dl.w = acc[3] + acc[7];     \
          const float4 xv = xo[((M_) >> 1) & 7];                                                                                          \
          if (((M_) >> 1) + 8 < 16) xo[((M_) >> 1) & 7] = *(const float4*)(p.outp() + (size_t)(t0 + ((M_) >> 1) + 8) * D + xoff);                  \
          const float4 xn = make_float4(xv.x + dl.x, xv.y + dl.y, xv.z + dl.z, xv.w + dl.w);                                              \
          float sq = 0.f;                                                                                                                 \
          if (wr_lane) {                                                                                                                  \
            *(float4*)(p.outp() + (size_t)(t0 + ((M_) >> 1)) * D + xoff) = xn;                                                             \
            *(uint2*)(p.xb() + (size_t)(t0 + ((M_) >> 1)) * KD + xoff) = make_uint2(pk_bf16(xn.x, xn.y), pk_bf16(xn.z, xn.w));     \
            sq = (xn.x * xn.x + xn.y * xn.y) + (xn.z * xn.z + xn.w * xn.w);                                                                \
          }                                                                                                                               \
          sq = DPP_ADD(sq, 0xB1); sq = DPP_ADD(sq, 0x4E); sq = DPP_ADD(sq, 0x141); sq = DPP_ADD(sq, 0x128); sq = sum_xor16(sq); sq = sum_xor32(sq);     \
          if (lane == 0) p.ssq1()[(size_t)(t0 + ((M_) >> 1)) * 8 + s] = sq;                                                               \
        }                                                                                                                                 \
      }
#pragma unroll
      for (int m6 = 0; m6 < 30; m6 += 6) {
        PEER_V_HALF(m6, 0, 0) PEER_V_HALF(m6 + 1, 1, 1) PEER_V_HALF(m6 + 2, 2, 0) PEER_V_HALF(m6 + 3, 0, 1) PEER_V_HALF(m6 + 4, 1, 0) PEER_V_HALF(m6 + 5, 2, 1)
      }
      PEER_V_HALF(30, 0, 0) PEER_V_HALF(31, 1, 1)
#undef PEER_V_HALF
#undef PEER_V_LOAD
    }
  }
}

#if PEER_CHECK
constexpr int CHK_N = 512;
__device__ __forceinline__ float* chk_x(const Params& p) { return (float*)(p.ws + WO_ybuf); }
__device__ __forceinline__ float* chk_m(const Params& p) { return (float*)(p.ws + WO_ybuf + (size_t)CHK_N * D * 4); }
__device__ __forceinline__ float* chk_g(const Params& p) { return (float*)(p.ws + WO_ybuf + (size_t)CHK_N * D * 4 + 4096); }
__device__ __forceinline__ void chk_save(const Params& p, int gtid, int ngt) {
  for (int i = gtid; i < CHK_N * D; i += ngt) chk_x(p)[i] = p.outp()[(size_t)(i / D) * 64 * D + (i % D)];
  for (int i = gtid; i < CHK_N * 128; i += ngt) chk_g(p)[i] = p.gates()[(size_t)(i / 128) * 64 * 128 + (i % 128)];
  if (gtid < 16) chk_m(p)[gtid] = 0.f;
}
__device__ __forceinline__ void chk_apply(const Params& p, int l, float* coef, int gw, int ngw, int lane) {
  const float* g2 = p.inp(16) + l * D;
  const float* U = p.inp(19) + (size_t)l * 16384 * D; const float* V = p.inp(20) + (size_t)l * 16384 * D;
  for (int i = gw; i < CHK_N; i += ngw) {
    const int t = i * 64;
    const float r = p.rstd()[t];
    float4 hv[4];
#pragma unroll
    for (int k = 0; k < 4; ++k) {
      float4 xv = *(const float4*)(chk_x(p) + (size_t)i * D + (lane + k * 64) * 4);
      float4 gv = *(const float4*)(g2 + (lane + k * 64) * 4);
      hv[k].x = xv.x * r * gv.x; hv[k].y = xv.y * r * gv.y; hv[k].z = xv.z * r * gv.z; hv[k].w = xv.w * r * gv.w;
    }
    LDS_FENCE();
    for (int j = 0; j < 128; ++j) {
      const int e = p.eidx()[(size_t)t * 128 + j];
      const float4* up = (const float4*)(U + (size_t)e * D);
      float dsum = 0.f;
#pragma unroll
      for (int k = 0; k < 4; ++k) { float4 uv = up[lane + k * 64]; dsum += hv[k].x * uv.x + hv[k].y * uv.y + hv[k].z * uv.z + hv[k].w * uv.w; }
      dsum = wave_sum(dsum);
      if (lane == 0) coef[j] = chk_g(p)[(size_t)i * 128 + j] * gelu_tanh(dsum);
    }
    LDS_FENCE();
    float4 acc[4];
#pragma unroll
    for (int k = 0; k < 4; ++k) acc[k] = make_float4(0.f, 0.f, 0.f, 0.f);
    for (int j = 0; j < 128; ++j) {
      const int e = p.eidx()[(size_t)t * 128 + j];
      const float c = coef[j];
      const float4* vp = (const float4*)(V + (size_t)e * D);
#pragma unroll
      for (int k = 0; k < 4; ++k) { float4 vv = vp[lane + k * 64]; acc[k].x = fmaf(c, vv.x, acc[k].x); acc[k].y = fmaf(c, vv.y, acc[k].y); acc[k].z = fmaf(c, vv.z, acc[k].z); acc[k].w = fmaf(c, vv.w, acc[k].w); }
    }
    float d2 = 0.f, r2 = 0.f;
#pragma unroll
    for (int k = 0; k < 4; ++k) {
      float4 xa = *(const float4*)(p.outp() + (size_t)t * D + (lane + k * 64) * 4);
      float4 xb4 = *(const float4*)(chk_x(p) + (size_t)i * D + (lane + k * 64) * 4);
      float e0 = (xa.x - xb4.x) - acc[k].x, e1 = (xa.y - xb4.y) - acc[k].y, e2 = (xa.z - xb4.z) - acc[k].z, e3 = (xa.w - xb4.w) - acc[k].w;
      d2 += e0 * e0 + e1 * e1 + e2 * e2 + e3 * e3;
      r2 += acc[k].x * acc[k].x + acc[k].y * acc[k].y + acc[k].z * acc[k].z + acc[k].w * acc[k].w;
    }
    d2 = wave_sum(d2); r2 = wave_sum(r2);
    if (lane == 0) { atomicAdd((unsigned long long*)&chk_m(p)[8], (unsigned long long)(d2 * 1099511627776.0f)); atomicAdd((unsigned long long*)&chk_m(p)[10], (unsigned long long)(r2 * 1099511627776.0f)); }
  }
}
__device__ __forceinline__ void chk_topk(const Params& p, int l, int gtid, int ngt) {
  const float* subk = p.inp(18) + (size_t)l * 16 * 128 * 64;
  for (int it = gtid; it < CHK_N * 8; it += ngt) {
    const int i = it >> 3, h = it & 7, t = i * 64;
    float tva[16], tvb[16]; int tia[16], tib[16];
#pragma unroll 1
    for (int c = 0; c < 2; ++c) {
      float tv[16]; int ti[16];
#pragma unroll
      for (int z = 0; z < 16; ++z) { tv[z] = -INFINITY; ti[z] = 0; }
      const bf16_t* q = p.qb() + (size_t)t * D + (2 * h + c) * 64;
      const float* kb = subk + (size_t)(2 * h + c) * 128 * 64;
#pragma unroll 1
      for (int n = 0; n < 128; ++n) {
        float sc = 0.f;
        for (int d = 0; d < 64; ++d) sc = fmaf(bf2f(q[d]), kb[n * 64 + d], sc);
        float v_ = sc; int i_ = n;
#pragma unroll
        for (int z = 0; z < 16; ++z) { bool gt = v_ > tv[z]; float a = tv[z]; int b = ti[z]; tv[z] = gt ? v_ : a; ti[z] = gt ? i_ : b; v_ = gt ? a : v_; i_ = gt ? b : i_; }
      }
#pragma unroll
      for (int z = 0; z < 16; ++z) { if (c == 0) { tva[z] = tv[z]; tia[z] = ti[z]; } else { tvb[z] = tv[z]; tib[z] = ti[z]; } }
    }
    float tv[16]; int ti[16];
#pragma unroll
    for (int z = 0; z < 16; ++z) { tv[z] = -INFINITY; ti[z] = 0; }
#pragma unroll 1
    for (int a = 0; a < 16; ++a)
#pragma unroll 1
      for (int b = 0; b < 16; ++b) {
        float av = 0.f, bv = 0.f; int ai = 0, bi = 0;
#pragma unroll
        for (int z = 0; z < 16; ++z) { if (z == a) { av = tva[z]; ai = tia[z]; } if (z == b) { bv = tvb[z]; bi = tib[z]; } }
        float v_ = av + bv; int i_ = ai * 128 + bi;
#pragma unroll
        for (int z = 0; z < 16; ++z) { bool gt = v_ > tv[z]; float x = tv[z]; int y = ti[z]; tv[z] = gt ? v_ : x; ti[z] = gt ? i_ : y; v_ = gt ? x : v_; i_ = gt ? y : i_; }
      }
    float sum = 0.f, ev[16];
#pragma unroll
    for (int z = 0; z < 16; ++z) { ev[z] = expf(tv[z] - tv[0]); sum += ev[z]; }
    int miss = 0; float gerr = 0.f;
    for (int z = 0; z < 16; ++z) {
      const int ef = p.eidx()[((size_t)t * 8 + h) * 16 + z]; const float gf = p.gates()[((size_t)t * 8 + h) * 16 + z];
      bool found = false;
#pragma unroll
      for (int y = 0; y < 16; ++y) if (ti[y] == ef) { found = true; gerr = fmaxf(gerr, fabsf(ev[y] / sum - gf)); }
      if (!found) ++miss;
    }
    atomicAdd(&chk_m(p)[3], (float)miss);
    atomicMax((int*)&chk_m(p)[4], __float_as_int(gerr));
  }
}
__device__ __forceinline__ void chk_emit(const Params& p) {
  float v = 0.f;
  if (PEER_CHECK == 1) v = sqrtf((float)((double)*(unsigned long long*)&chk_m(p)[8] / (double)*(unsigned long long*)&chk_m(p)[10]));
  if (PEER_CHECK == 2) v = chk_m(p)[3] / (float)(CHK_N * 8 * 16);
  if (PEER_CHECK == 3) v = chk_m(p)[4];
  p.outp()[0] += 1.0e4f * v + 100.0f;
}
#endif

#define XB_TMO      128
#define XB_XCNT(j)  (256  + 64 * (j))
#define XB_XSUB(j)  (1280 + 64 * (j))
#define XB_XGEN(j)  (2304 + 64 * (j))
#define XB_TOP      3328
#define XB_TOPGEN   3392
#define XCD_BAR_WORDS 3456
#define XB_SPIN_CAP (1u << 18)
#define LAS __attribute__((address_space(3)))

__device__ __forceinline__ unsigned xb_ld(unsigned* p)              { return __hip_atomic_load(p, __ATOMIC_RELAXED, __HIP_MEMORY_SCOPE_AGENT); }
__device__ __forceinline__ unsigned xb_add(unsigned* p, unsigned v) { return __hip_atomic_fetch_add(p, v, __ATOMIC_RELAXED, __HIP_MEMORY_SCOPE_AGENT); }
__device__ __forceinline__ unsigned xb_xcc_id() { return (unsigned)__builtin_amdgcn_s_getreg((3 << 11) | 20) & 0xFu; }
#define XB_SPIN(cond, bar) do { unsigned _sp = 0; while (cond) { __builtin_amdgcn_s_sleep(1); \
    if ((++_sp & 255u) == 0u) { if (xb_ld(&(bar)[XB_TMO])) break; if (_sp > XB_SPIN_CAP) { atomicAdd(&(bar)[XB_TMO], 1u); break; } } } } while (0)

struct XcdBarrier {
    unsigned* bar; unsigned x;
    volatile LAS unsigned* st;
};

__device__ __forceinline__ XcdBarrier xcd_barrier_post(unsigned* bar, volatile LAS unsigned* st) {
    XcdBarrier b; b.bar = bar; b.x = xb_xcc_id(); b.st = st;
    if (threadIdx.x == 0) (void)xb_add(&bar[XB_XCNT(b.x)], 1u);
    return b;
}
__device__ __forceinline__ void xcd_barrier_complete(unsigned* bar, unsigned x, unsigned& nloc, unsigned& nx) {
    const unsigned G = gridDim.x * gridDim.y * gridDim.z;
    unsigned sum, cnt, mine, sp = 0u;
    for (;;) {
        sum = 0u; cnt = 0u; mine = 0u;
#pragma unroll
        for (unsigned j = 0; j < 16; ++j) { const unsigned c = xb_ld(&bar[XB_XCNT(j)]); sum += c; cnt += (c > 0u) ? 1u : 0u; mine = (j == x) ? c : mine; }
        if (sum == G) break;
        __builtin_amdgcn_s_sleep(1);
        if ((++sp & 255u) == 0u) { if (xb_ld(&bar[XB_TMO])) break; if (sp > XB_SPIN_CAP) { atomicAdd(&bar[XB_TMO], 1u); break; } }
    }
    nloc = mine > 0u ? mine : 1u; nx = cnt > 0u ? cnt : 1u;
}

__device__ __forceinline__ void xcd_barrier(const XcdBarrier& b) {
    asm volatile("s_waitcnt vmcnt(0)" ::: "memory");
    __syncthreads();
    if (threadIdx.x == 0) {
        unsigned* bar = b.bar;
        __builtin_amdgcn_s_waitcnt(0);
        unsigned nloc = b.st[0], nx = b.st[1];
        if (nloc == 0u) { xcd_barrier_complete(bar, b.x, nloc, nx); b.st[0] = nloc; b.st[1] = nx; }
        const unsigned old = xb_add(&bar[XB_XSUB(b.x)], 1u);
        const unsigned gen = old / nloc;
        if (old + 1u == (gen + 1u) * nloc) {
            __builtin_amdgcn_fence(__ATOMIC_RELEASE, "agent");
            asm volatile("s_waitcnt vmcnt(0)" ::: "memory");
            const unsigned og = xb_add(&bar[XB_TOP], 1u);
            const unsigned tg = og / nx;
            if (og + 1u == (tg + 1u) * nx) xb_add(&bar[XB_TOPGEN], 1u);
            else XB_SPIN(xb_ld(&bar[XB_TOPGEN]) == tg, bar);
            __builtin_amdgcn_fence(__ATOMIC_ACQUIRE, "agent");
            xb_add(&bar[XB_XGEN(b.x)], 1u);
            asm volatile("s_waitcnt vmcnt(0)" ::: "memory");
        } else {
            XB_SPIN(xb_ld(&bar[XB_XGEN(b.x)]) == gen, bar);
            __builtin_amdgcn_fence(__ATOMIC_ACQUIRE, "agent");
            asm volatile("s_waitcnt vmcnt(0)" ::: "memory");
        }
    }
    __syncthreads();
}

__device__ __forceinline__ Params fresh(const Params& p) {
  Params q = p;
  asm volatile("" : "+s"(q.ws), "+s"(q.out_));
#pragma unroll
  for (int i = 0; i < 21; ++i) asm volatile("" : "+s"(q.in[i]));
  return q;
}
#define PHASE_IDS int tid = threadIdx.x; asm volatile("" : "+v"(tid)); int bid = blockIdx.x; asm volatile("" : "+s"(bid)); int G = gridDim.x; asm volatile("" : "+s"(G)); \
  const int lane = tid & 63, wv = tid >> 6; const int ngt = G * NTHR, ngw = G * NWAVE; \
  const int gtid = bid * NTHR + tid, gw = bid * NWAVE + wv; (void)lane; (void)wv; (void)gtid; (void)gw; (void)ngt; (void)ngw; \
  const Params q = fresh(p);
__global__ void __launch_bounds__(NTHR) mega(Params p) {
  extern __shared__ __attribute__((aligned(16))) unsigned char lds_raw[];
  cg::grid_group grid = cg::this_grid();
  float* ldsf = (float*)lds_raw;
  if (threadIdx.x == 0) { *(uint4*)(lds_raw + LDS_BYTES - 16) = make_uint4(0u, 0u, 0u, 0u); }
  __syncthreads();
  XcdBarrier xb = xcd_barrier_post(p.bar(), (volatile LAS unsigned*)(lds_raw + LDS_BYTES - 16));

  { PHASE_IDS; phase_prologue(q, gtid, ngt, gw, ngw, lane); cvt_f32_bf16(q.inp(18), q.skb(), (size_t)NL * 16 * 128 * 64 / 8, gtid, ngt);
    for (size_t i = gtid; i < (size_t)16 * 128 * 512 / 8; i += ngt) { const size_t g = i / (128 * 512 / 8), r = i % (128 * 512 / 8); ((uint4*)q.S5Wz())[g * (256 * 512 / 8) + (128 * 512 / 8) + r] = make_uint4(0u, 0u, 0u, 0u); }
    if (gtid < 256) q.qctr()[gtid] = 0;
    phase_s5_prep(q, 0, gtid, ngt); }
  grid.sync();
  { constexpr int l = 0;
    DUP(5) {
    { const Params q = fresh(p);
      EpiInProj e{q.ssq1(), q.S5A(), q.Qm(), q.Km(), q.vrow(), q.Qr(), q.Kr(), q.krow(), q.vrrow(), q.grow(),
                  q.inp(12) + l * 64, q.inp(13) + l * 64, q.cosm(), q.sinm(), q.cosr(), q.sinr()};
      run_gemm(lds_raw, q.xb(), q.Win_t() + (size_t)l * INW * KD, T, INW, KD, e); }
    xcd_barrier(xb);
    }
    DUP(1) {
    { PHASE_IDS; phase_post_pack(q, gtid, ngt); }
    { const Params q = fresh(p); EpiS5Z e{q.S5Z()};
      pg8::Gemm g{q.S5A(), q.S5Wz(), 16 * 1024, 16 * 256, 512, 640, 512}; pg8::GroupOrder So; So.init(16, 4, 1, (int)gridDim.x, (int)blockIdx.x);
      pg8::gemm_phase<EpiS5Z, pg8::GroupOrder, true, true>((PG8_LAS unsigned char*)lds_raw, g, So, e); }
    { PHASE_IDS; phase_kmean2(q, gtid, ngt); }
    xcd_barrier(xb);
    }
    DUP(2) {
    { PHASE_IDS; phase_s5_scan(q, gtid, ngt); phase_ret_kv(q, gw, ngw, lane); }
    __syncthreads();
    { PHASE_IDS; phase_moba2(q, l, lds_raw, q.qctr() + 64 + l); }
    xcd_barrier(xb);
    }
    DUP(3) {
    { const Params q = fresh(p); EpiS5Y e{q.ygb(), q.S5A(), q.inp(10) + l * 256};
      pg8::Gemm g{q.S5A(), q.S5Wy(), 16 * 1024, 16 * 512, 640, 640, 640}; pg8::GroupOrder So; So.init(16, 4, 2, (int)gridDim.x, (int)blockIdx.x);
      pg8::gemm_phase<EpiS5Y, pg8::GroupOrder, true, true>((PG8_LAS unsigned char*)lds_raw, g, So, e); }
    { PHASE_IDS; phase_ret_scan(q, gtid, ngt); }
    xcd_barrier(xb);
    }
    DUP(4) {
    { const Params q = fresh(p); EpiGlu e{q.xb(), q.ygb(), (float*)(lds_raw + 131072)};
      run_gemm(lds_raw, q.ygb(), q.Wglu_t() + (size_t)l * 65536, T, 256, 256, e); }
    { PHASE_IDS; phase_ret_out(q, gw, ngw, lane); }
    xcd_barrier(xb);
    }
    { PHASE_IDS; cvt_table_i8(q.inp(19) + (size_t)l * 16384 * D, q.U8s(), q.su(), gw, ngw, lane);
      cvt_table_fp8(q.inp(20) + (size_t)l * 16384 * D, q.V8s(), q.sv(), gw, ngw, lane); }
    __syncthreads();
    { const Params q = fresh(p); EpiResid e{q.outp(), D, q.xb2(), q.hb(), q.inp(16) + l * D, q.ssq2()};
      run_gemm(lds_raw, q.xb(), q.Wout_t() + (size_t)l * D * KD, T, D, KD, e); }
    xcd_barrier(xb);
    DUP(7) {
    { const Params q = fresh(p); EpiScaleStoreBf16 e{q.qb(), D, q.ssq2(), 16, q.rstd()};
      run_gemm(lds_raw, q.xb2(), q.Wq_t() + (size_t)l * D * KD, T, D, KD, e); }
    xcd_barrier(xb);
    }
    if (!(PROBE_SKIP & 2)) {
    DUP(8) {
    { PHASE_IDS; phase_peer_topk(q, l, gw, ngw, lane); }
    xcd_barrier(xb);
    }
    }
#if PEER_CHECK
    if (l == 0) { { PHASE_IDS; chk_save(q, gtid, ngt); } xcd_barrier(xb); { PHASE_IDS; chk_topk(q, l, gtid, ngt); } xcd_barrier(xb); }
#endif
    if (!(PROBE_SKIP & 1)) {
    { PHASE_IDS; phase_peer_u(q, q.qctr() + (l * 2 + 0) * 8, lds_raw, tid); }
    xcd_barrier(xb);
    { PHASE_IDS; phase_peer_r(q, gtid, ngt); if (l + 1 < NL) phase_s5_prep(q, l + 1, gtid, ngt); }
    xcd_barrier(xb);
    if (!(PROBE_SKIP & 32)) {
    { PHASE_IDS; phase_peer_v(q, q.qctr() + (l * 2 + 1) * 8, lds_raw, tid); }
    xcd_barrier(xb);
    }
    }
#if PEER_CHECK
    if (l == 0) { { PHASE_IDS; chk_apply(q, l, ldsf + wv * 128, gw, ngw, lane); } xcd_barrier(xb);
      if (blockIdx.x == 0 && threadIdx.x == 0) { const Params q = fresh(p); chk_emit(q); } xcd_barrier(xb); }
#endif
  }
  { constexpr int l = 1;
    DUP(5) {
    { const Params q = fresh(p);
      EpiInProj e{q.ssq1(), q.S5A(), q.Qm(), q.Km(), q.vrow(), q.Qr(), q.Kr(), q.krow(), q.vrrow(), q.grow(),
                  q.inp(12) + l * 64, q.inp(13) + l * 64, q.cosm(), q.sinm(), q.cosr(), q.sinr()};
      run_gemm(lds_raw, q.xb(), q.Win_t() + (size_t)l * INW * KD, T, INW, KD, e); }
    xcd_barrier(xb);
    }
    DUP(1) {
    { PHASE_IDS; phase_post_pack(q, gtid, ngt); }
    { const Params q = fresh(p); EpiS5Z e{q.S5Z()};
      pg8::Gemm g{q.S5A(), q.S5Wz(), 16 * 1024, 16 * 256, 512, 640, 512}; pg8::GroupOrder So; So.init(16, 4, 1, (int)gridDim.x, (int)blockIdx.x);
      pg8::gemm_phase<EpiS5Z, pg8::GroupOrder, true, true>((PG8_LAS unsigned char*)lds_raw, g, So, e); }
    { PHASE_IDS; phase_kmean2(q, gtid, ngt); }
    xcd_barrier(xb);
    }
    DUP(2) {
    { PHASE_IDS; phase_s5_scan(q, gtid, ngt); phase_ret_kv(q, gw, ngw, lane); }
    __syncthreads();
    { PHASE_IDS; phase_moba2(q, l, lds_raw, q.qctr() + 64 + l); }
    xcd_barrier(xb);
    }
    DUP(3) {
    { const Params q = fresh(p); EpiS5Y e{q.ygb(), q.S5A(), q.inp(10) + l * 256};
      pg8::Gemm g{q.S5A(), q.S5Wy(), 16 * 1024, 16 * 512, 640, 640, 640}; pg8::GroupOrder So; So.init(16, 4, 2, (int)gridDim.x, (int)blockIdx.x);
      pg8::gemm_phase<EpiS5Y, pg8::GroupOrder, true, true>((PG8_LAS unsigned char*)lds_raw, g, So, e); }
    { PHASE_IDS; phase_ret_scan(q, gtid, ngt); }
    xcd_barrier(xb);
    }
    DUP(4) {
    { const Params q = fresh(p); EpiGlu e{q.xb(), q.ygb(), (float*)(lds_raw + 131072)};
      run_gemm(lds_raw, q.ygb(), q.Wglu_t() + (size_t)l * 65536, T, 256, 256, e); }
    { PHASE_IDS; phase_ret_out(q, gw, ngw, lane); }
    xcd_barrier(xb);
    }
    { PHASE_IDS; cvt_table_i8(q.inp(19) + (size_t)l * 16384 * D, q.U8s(), q.su(), gw, ngw, lane);
      cvt_table_fp8(q.inp(20) + (size_t)l * 16384 * D, q.V8s(), q.sv(), gw, ngw, lane); }
    __syncthreads();
    { const Params q = fresh(p); EpiResid e{q.outp(), D, q.xb2(), q.hb(), q.inp(16) + l * D, q.ssq2()};
      run_gemm(lds_raw, q.xb(), q.Wout_t() + (size_t)l * D * KD, T, D, KD, e); }
    xcd_barrier(xb);
    DUP(7) {
    { const Params q = fresh(p); EpiScaleStoreBf16 e{q.qb(), D, q.ssq2(), 16, q.rstd()};
      run_gemm(lds_raw, q.xb2(), q.Wq_t() + (size_t)l * D * KD, T, D, KD, e); }
    xcd_barrier(xb);
    }
    if (!(PROBE_SKIP & 2)) {
    DUP(8) {
    { PHASE_IDS; phase_peer_topk(q, l, gw, ngw, lane); }
    xcd_barrier(xb);
    }
    }
#if PEER_CHECK
    if (l == 0) { { PHASE_IDS; chk_save(q, gtid, ngt); } xcd_barrier(xb); { PHASE_IDS; chk_topk(q, l, gtid, ngt); } xcd_barrier(xb); }
#endif
    if (!(PROBE_SKIP & 1)) {
    { PHASE_IDS; phase_peer_u(q, q.qctr() + (l * 2 + 0) * 8, lds_raw, tid); }
    xcd_barrier(xb);
    { PHASE_IDS; phase_peer_r(q, gtid, ngt); if (l + 1 < NL) phase_s5_prep(q, l + 1, gtid, ngt); }
    xcd_barrier(xb);
    if (!(PROBE_SKIP & 32)) {
    { PHASE_IDS; phase_peer_v(q, q.qctr() + (l * 2 + 1) * 8, lds_raw, tid); }
    xcd_barrier(xb);
    }
    }
#if PEER_CHECK
    if (l == 0) { { PHASE_IDS; chk_apply(q, l, ldsf + wv * 128, gw, ngw, lane); } xcd_barrier(xb);
      if (blockIdx.x == 0 && threadIdx.x == 0) { const Params q = fresh(p); chk_emit(q); } xcd_barrier(xb); }
#endif
  }
  { constexpr int l = 2;
    DUP(5) {
    { const Params q = fresh(p);
      EpiInProj e{q.ssq1(), q.S5A(), q.Qm(), q.Km(), q.vrow(), q.Qr(), q.Kr(), q.krow(), q.vrrow(), q.grow(),
                  q.inp(12) + l * 64, q.inp(13) + l * 64, q.cosm(), q.sinm(), q.cosr(), q.sinr()};
      run_gemm(lds_raw, q.xb(), q.Win_t() + (size_t)l * INW * KD, T, INW, KD, e); }
    xcd_barrier(xb);
    }
    DUP(1) {
    { PHASE_IDS; phase_post_pack(q, gtid, ngt); }
    { const Params q = fresh(p); EpiS5Z e{q.S5Z()};
      pg8::Gemm g{q.S5A(), q.S5Wz(), 16 * 1024, 16 * 256, 512, 640, 512}; pg8::GroupOrder So; So.init(16, 4, 1, (int)gridDim.x, (int)blockIdx.x);
      pg8::gemm_phase<EpiS5Z, pg8::GroupOrder, true, true>((PG8_LAS unsigned char*)lds_raw, g, So, e); }
    { PHASE_IDS; phase_kmean2(q, gtid, ngt); }
    xcd_barrier(xb);
    }
    DUP(2) {
    { PHASE_IDS; phase_s5_scan(q, gtid, ngt); phase_ret_kv(q, gw, ngw, lane); }
    __syncthreads();
    { PHASE_IDS; phase_moba2(q, l, lds_raw, q.qctr() + 64 + l); }
    xcd_barrier(xb);
    }
    DUP(3) {
    { const Params q = fresh(p); EpiS5Y e{q.ygb(), q.S5A(), q.inp(10) + l * 256};
      pg8::Gemm g{q.S5A(), q.S5Wy(), 16 * 1024, 16 * 512, 640, 640, 640}; pg8::GroupOrder So; So.init(16, 4, 2, (int)gridDim.x, (int)blockIdx.x);
      pg8::gemm_phase<EpiS5Y, pg8::GroupOrder, true, true>((PG8_LAS unsigned char*)lds_raw, g, So, e); }
    { PHASE_IDS; phase_ret_scan(q, gtid, ngt); }
    xcd_barrier(xb);
    }
    DUP(4) {
    { const Params q = fresh(p); EpiGlu e{q.xb(), q.ygb(), (float*)(lds_raw + 131072)};
      run_gemm(lds_raw, q.ygb(), q.Wglu_t() + (size_t)l * 65536, T, 256, 256, e); }
    { PHASE_IDS; phase_ret_out(q, gw, ngw, lane); }
    xcd_barrier(xb);
    }
    { PHASE_IDS; cvt_table_i8(q.inp(19) + (size_t)l * 16384 * D, q.U8s(), q.su(), gw, ngw, lane);
      cvt_table_fp8(q.inp(20) + (size_t)l * 16384 * D, q.V8s(), q.sv(), gw, ngw, lane); }
    __syncthreads();
    { const Params q = fresh(p); EpiResid e{q.outp(), D, q.xb2(), q.hb(), q.inp(16) + l * D, q.ssq2()};
      run_gemm(lds_raw, q.xb(), q.Wout_t() + (size_t)l * D * KD, T, D, KD, e); }
    xcd_barrier(xb);
    DUP(7) {
    { const Params q = fresh(p); EpiScaleStoreBf16 e{q.qb(), D, q.ssq2(), 16, q.rstd()};
      run_gemm(lds_raw, q.xb2(), q.Wq_t() + (size_t)l * D * KD, T, D, KD, e); }
    xcd_barrier(xb);
    }
    if (!(PROBE_SKIP & 2)) {
    DUP(8) {
    { PHASE_IDS; phase_peer_topk(q, l, gw, ngw, lane); }
    xcd_barrier(xb);
    }
    }
#if PEER_CHECK
    if (l == 0) { { PHASE_IDS; chk_save(q, gtid, ngt); } xcd_barrier(xb); { PHASE_IDS; chk_topk(q, l, gtid, ngt); } xcd_barrier(xb); }
#endif
    if (!(PROBE_SKIP & 1)) {
    { PHASE_IDS; phase_peer_u(q, q.qctr() + (l * 2 + 0) * 8, lds_raw, tid); }
    xcd_barrier(xb);
    { PHASE_IDS; phase_peer_r(q, gtid, ngt); if (l + 1 < NL) phase_s5_prep(q, l + 1, gtid, ngt); }
    xcd_barrier(xb);
    if (!(PROBE_SKIP & 32)) {
    { PHASE_IDS; phase_peer_v(q, q.qctr() + (l * 2 + 1) * 8, lds_raw, tid); }
    xcd_barrier(xb);
    }
    }
#if PEER_CHECK
    if (l == 0) { { PHASE_IDS; chk_apply(q, l, ldsf + wv * 128, gw, ngw, lane); } xcd_barrier(xb);
      if (blockIdx.x == 0 && threadIdx.x == 0) { const Params q = fresh(p); chk_emit(q); } xcd_barrier(xb); }
#endif
  }
  { constexpr int l = 3;
    DUP(5) {
    { const Params q = fresh(p);
      EpiInProj e{q.ssq1(), q.S5A(), q.Qm(), q.Km(), q.vrow(), q.Qr(), q.Kr(), q.krow(), q.vrrow(), q.grow(),
                  q.inp(12) + l * 64, q.inp(13) + l * 64, q.cosm(), q.sinm(), q.cosr(), q.sinr()};
      run_gemm(lds_raw, q.xb(), q.Win_t() + (size_t)l * INW * KD, T, INW, KD, e); }
    xcd_barrier(xb);
    }
    DUP(1) {
    { PHASE_IDS; phase_post_pack(q, gtid, ngt); }
    { const Params q = fresh(p); EpiS5Z e{q.S5Z()};
      pg8::Gemm g{q.S5A(), q.S5Wz(), 16 * 1024, 16 * 256, 512, 640, 512}; pg8::GroupOrder So; So.init(16, 4, 1, (int)gridDim.x, (int)blockIdx.x);
      pg8::gemm_phase<EpiS5Z, pg8::GroupOrder, true, true>((PG8_LAS unsigned char*)lds_raw, g, So, e); }
    { PHASE_IDS; phase_kmean2(q, gtid, ngt); }
    xcd_barrier(xb);
    }
    DUP(2) {
    { PHASE_IDS; phase_s5_scan(q, gtid, ngt); phase_ret_kv(q, gw, ngw, lane); }
    __syncthreads();
    { PHASE_IDS; phase_moba2(q, l, lds_raw, q.qctr() + 64 + l); }
    xcd_barrier(xb);
    }
    DUP(3) {
    { const Params q = fresh(p); EpiS5Y e{q.ygb(), q.S5A(), q.inp(10) + l * 256};
      pg8::Gemm g{q.S5A(), q.S5Wy(), 16 * 1024, 16 * 512, 640, 640, 640}; pg8::GroupOrder So; So.init(16, 4, 2, (int)gridDim.x, (int)blockIdx.x);
      pg8::gemm_phase<EpiS5Y, pg8::GroupOrder, true, true>((PG8_LAS unsigned char*)lds_raw, g, So, e); }
    { PHASE_IDS; phase_ret_scan(q, gtid, ngt); }
    xcd_barrier(xb);
    }
    DUP(4) {
    { const Params q = fresh(p); EpiGlu e{q.xb(), q.ygb(), (float*)(lds_raw + 131072)};
      run_gemm(lds_raw, q.ygb(), q.Wglu_t() + (size_t)l * 65536, T, 256, 256, e); }
    { PHASE_IDS; phase_ret_out(q, gw, ngw, lane); }
    xcd_barrier(xb);
    }
    { PHASE_IDS; cvt_table_i8(q.inp(19) + (size_t)l * 16384 * D, q.U8s(), q.su(), gw, ngw, lane);
      cvt_table_fp8(q.inp(20) + (size_t)l * 16384 * D, q.V8s(), q.sv(), gw, ngw, lane); }
    __syncthreads();
    { const Params q = fresh(p); EpiResid e{q.outp(), D, q.xb2(), q.hb(), q.inp(16) + l * D, q.ssq2()};
      run_gemm(lds_raw, q.xb(), q.Wout_t() + (size_t)l * D * KD, T, D, KD, e); }
    xcd_barrier(xb);
    DUP(7) {
    { const Params q = fresh(p); EpiScaleStoreBf16 e{q.qb(), D, q.ssq2(), 16, q.rstd()};
      run_gemm(lds_raw, q.xb2(), q.Wq_t() + (size_t)l * D * KD, T, D, KD, e); }
    xcd_barrier(xb);
    }
    if (!(PROBE_SKIP & 2)) {
    DUP(8) {
    { PHASE_IDS; phase_peer_topk(q, l, gw, ngw, lane); }
    xcd_barrier(xb);
    }
    }
#if PEER_CHECK
    if (l == 0) { { PHASE_IDS; chk_save(q, gtid, ngt); } xcd_barrier(xb); { PHASE_IDS; chk_topk(q, l, gtid, ngt); } xcd_barrier(xb); }
#endif
    if (!(PROBE_SKIP & 1)) {
    { PHASE_IDS; phase_peer_u(q, q.qctr() + (l * 2 + 0) * 8, lds_raw, tid); }
    xcd_barrier(xb);
    { PHASE_IDS; phase_peer_r(q, gtid, ngt); if (l + 1 < NL) phase_s5_prep(q, l + 1, gtid, ngt); }
    xcd_barrier(xb);
    if (!(PROBE_SKIP & 32)) {
    { PHASE_IDS; phase_peer_v(q, q.qctr() + (l * 2 + 1) * 8, lds_raw, tid); }
    xcd_barrier(xb);
    }
    }
#if PEER_CHECK
    if (l == 0) { { PHASE_IDS; chk_apply(q, l, ldsf + wv * 128, gw, ngw, lane); } xcd_barrier(xb);
      if (blockIdx.x == 0 && threadIdx.x == 0) { const Params q = fresh(p); chk_emit(q); } xcd_barrier(xb); }
#endif
  }
}

}

extern "C" void kernel_launch(void* const* d_in, const int* in_sizes, int n_in, void* d_out, int out_size, void* d_ws, size_t ws_size,
                              hipStream_t stream) {
  static int grid_blocks = 0;
  if (!grid_blocks) {
    int dev = 0, cus = 0, per_cu = 0;
    hipGetDevice(&dev);
    hipDeviceGetAttribute(&cus, hipDeviceAttributeMultiprocessorCount, dev);
    hipFuncSetAttribute((const void*)mega, hipFuncAttributeMaxDynamicSharedMemorySize, LDS_BYTES);
    hipOccupancyMaxActiveBlocksPerMultiprocessor(&per_cu, (const void*)mega, NTHR, LDS_BYTES);
    if (per_cu < 1) { fprintf(stderr, "occupancy query returned %d\n", per_cu); per_cu = 1; }
    grid_blocks = cus * 1;
    if (grid_blocks < 64) fprintf(stderr, "unexpected CU count %d\n", cus);
  }
  Params p{};
  for (int i = 0; i < 21; ++i) p.in[i] = (const GAS float*)d_in[i];
  p.out_ = (GAS float*)d_out;
  p.ws = (GAS unsigned char*)d_ws;
  if (WS_TOTAL > ws_size) { fprintf(stderr, "workspace too small: need %zu have %zu\n", (size_t)WS_TOTAL, ws_size); return; }
  hipMemsetAsync((unsigned char*)d_ws + WO_bar, 0, 16384, stream);
  void* args[] = {&p};
  hipError_t e = hipLaunchCooperativeKernel((const void*)mega, dim3(grid_blocks), dim3(NTHR), args, LDS_BYTES, stream);
  if (e != hipSuccess) fprintf(stderr, "cooperative launch failed: %s (grid %d)\n", hipGetErrorString(e), grid_blocks);
}
```

```cpp
#include <hip/hip_runtime.h>
#include <hip/hip_cooperative_groups.h>
#include <math.h>
#include <stdint.h>
#include <stdio.h>
namespace cg = cooperative_groups;

#ifndef PEER_CHECK
#define PEER_CHECK 0
#endif
#ifndef PROBE_DUP
#define PROBE_DUP 0
#endif
__device__ __forceinline__ int dup_n(int n) { asm volatile("" : "+s"(n)); return n; }
#define DUP(bit) _Pragma("unroll 1") for (int rep_ = 0, repn_ = (((PROBE_DUP >> (bit)) & 1) ? dup_n(2) : 1); rep_ < repn_; ++rep_)
#ifndef PROBE_SKIP
#define PROBE_SKIP 0
#endif
#ifndef PRECISE
#define PRECISE 0
#endif

namespace {
constexpr int NB = 8, S = 4096, D = 1024, NL = 4, T = NB * S;
constexpr int INW = 2816;
constexpr float EPS = 1e-6f;
static_assert(PRECISE == 0, "PRECISE builds are retired");
constexpr int KS = PRECISE ? 3 : 1;
constexpr int KD = D * KS;
constexpr int NTHR = 512, NWAVE = 8;
constexpr int LDS_BYTES = 131072 + 4096 + 1024;

typedef unsigned short bf16_t;
using bf16x8 = __attribute__((ext_vector_type(8))) short;
using f32x4 = __attribute__((ext_vector_type(4))) float;

__device__ __forceinline__ float wave_sum(float v) {
#pragma unroll
  for (int o = 32; o > 0; o >>= 1) v += __shfl_xor(v, o);
  return v;
}
__device__ __forceinline__ float wave_max(float v) {
#pragma unroll
  for (int o = 32; o > 0; o >>= 1) v = fmaxf(v, __shfl_xor(v, o));
  return v;
}
__device__ __forceinline__ int q_pull(int* head, int nitems, int* bc, int tid) {
  __syncthreads();
  if (tid == 0) bc[0] = atomicAdd(head, 1);
  __syncthreads();
  const int v = bc[0];
  return v < nitems ? v : -1;
}
constexpr float QSCALE = 0.125f * 1.4426950408889634f;
__device__ __forceinline__ float ret_log2g(int h) { return log2f(1.0f - exp2f(-5.0f - (float)h)); }
__device__ __forceinline__ float gelu_tanh(float x) {
  const float k0 = 0.7978845608028654f, k1 = 0.044715f;
  float u = k0 * (x + k1 * x * x * x);
  return 0.5f * x * (1.0f + tanhf(u));
}
__device__ __forceinline__ float sigmoidf_(float x) { return 1.0f / (1.0f + expf(-x)); }
__device__ __forceinline__ float fast_sigmoid(float x) { return __builtin_amdgcn_rcpf(1.0f + __builtin_amdgcn_exp2f(-1.4426950408889634f * x)); }
__device__ __forceinline__ float fast_gelu(float x) { const float u = 0.7978845608028654f * (x + 0.044715f * x * x * x); return x * fast_sigmoid(2.0f * u); }
__device__ __forceinline__ bf16_t f2bf(float f) {
  unsigned u = __float_as_uint(f);
  u += 0x7fffu + ((u >> 16) & 1u);
  return (bf16_t)(u >> 16);
}
__device__ __forceinline__ float bf2f(bf16_t h) { return __uint_as_float(((unsigned)h) << 16); }
#define LDS_FENCE() asm volatile("s_waitcnt lgkmcnt(0)" ::: "memory")
typedef __bf16 bf16x2_hw __attribute__((ext_vector_type(2)));
typedef float f32x2_hw __attribute__((ext_vector_type(2)));
__device__ __forceinline__ unsigned pk_bf16(float lo, float hi) { const f32x2_hw f = {lo, hi}; const bf16x2_hw b = __builtin_convertvector(f, bf16x2_hw); return __builtin_bit_cast(unsigned, b); }
typedef float f32x16 __attribute__((ext_vector_type(16)));

constexpr size_t al256(size_t x) { return (x + 255) & ~(size_t)255; }
constexpr size_t WO_rstd = 0;
constexpr size_t WO_cosm = WO_rstd + al256((size_t)T * 4);
constexpr size_t WO_sinm = WO_cosm + al256((size_t)S * 8 * 4);
constexpr size_t WO_cosr = WO_sinm + al256((size_t)S * 8 * 4);
constexpr size_t WO_sinr = WO_cosr + al256((size_t)S * 32 * 4);
constexpr size_t WO_kmean = WO_sinr + al256((size_t)S * 32 * 4);
constexpr size_t WO_proj = WO_kmean + al256((size_t)NB * 8 * 16 * 64 * 4);
constexpr size_t WO_ybuf = WO_proj + al256((size_t)T * INW * 4);
constexpr size_t WO_yg = WO_ybuf + al256((size_t)T * D * 4);
constexpr size_t WO_skb = WO_yg + al256((size_t)T * 256 * 4);
constexpr size_t WO_Ub = WO_skb + al256((size_t)NL * 16 * 128 * 64 * 2);
constexpr size_t WO_Vb = WO_Ub + al256((size_t)16384 * D * 2);
constexpr size_t WO_gates = WO_Vb + al256((size_t)16384 * D * 2);
constexpr size_t WO_eidx = WO_gates + al256((size_t)T * 128 * 4);
constexpr size_t WO_xb = WO_eidx + al256((size_t)T * 128 * 4);
constexpr size_t WO_Win_t = WO_xb + al256((size_t)T * KD * 2);
constexpr size_t WO_Wout_t = WO_Win_t + al256((size_t)NL * INW * KD * 2);
constexpr size_t WO_Wq_t = WO_Wout_t + al256((size_t)NL * D * KD * 2);
constexpr size_t WO_Qm = WO_Wq_t + al256((size_t)NL * D * KD * 2);
constexpr size_t WO_Km = WO_Qm + al256((size_t)T * 512 * 2);
constexpr size_t WO_Vm = WO_Km + al256((size_t)T * 512 * 2);
constexpr size_t WO_S5a32 = WO_Vm + al256((size_t)T * 512 * 2);
constexpr size_t WO_Wglu_t = WO_S5a32 + al256((size_t)16 * 64 * 2 * 4);
constexpr size_t WO_Qr = WO_Wglu_t + al256((size_t)NL * 256 * 256 * 2);
constexpr size_t WO_Kr = WO_Qr + al256((size_t)T * 256 * 2);
constexpr size_t WO_Krv = WO_Kr + al256((size_t)T * 256 * 2);
constexpr size_t WO_Vr = WO_Krv + al256((size_t)T * 256 * 2);
constexpr size_t WO_KVr = WO_Vr + al256((size_t)T * 256 * 2);
constexpr size_t WO_Rb = WO_KVr + al256((size_t)32 * 32 * 4096 * 4);
constexpr size_t WO_qctr = WO_Rb + al256((size_t)32 * 32 * 4096 * 2);
constexpr size_t WO_bar = WO_qctr + al256(1024);
constexpr size_t WO_S5Wy = WO_bar + al256(16384);
constexpr size_t WO_S5Wz = WO_S5Wy + al256((size_t)16 * 512 * 640 * 2);
constexpr size_t WO_ssq1 = WO_S5Wz + al256((size_t)16 * 256 * 512 * 2);
constexpr size_t WO_ssq2 = WO_ssq1 + al256((size_t)T * 8 * 4);
constexpr size_t WS_TOTAL = WO_ssq2 + al256((size_t)T * 16 * 4);
constexpr size_t WO_S5A = WO_gates;
constexpr size_t WO_S5Z = WO_S5A + al256((size_t)16 * 1024 * 640 * 2);
static_assert(WO_S5Z + (size_t)16 * 1024 * 128 * 4 <= WO_gates + 2 * al256((size_t)T * 128 * 4), "S5A/S5Z must fit in gates+eidx");
#define GAS __attribute__((address_space(1)))
static_assert((size_t)T * D * 2 + (size_t)T * 128 * 8 * 4 + (size_t)T * D * 2 <= (size_t)T * INW * 4, "qb + ppart + xb2 must fit in the proj region");
struct Params {
  const GAS float* in[21];
  GAS float* out_;
  GAS unsigned char* ws;
  __device__ __forceinline__ const float* inp(int i) const { return (const float*)in[i]; }
  __device__ __forceinline__ float* outp() const { return (float*)out_; }
  __device__ __forceinline__ float* rstd() const { return (float*)(ws + WO_rstd); }
  __device__ __forceinline__ float* cosm() const { return (float*)(ws + WO_cosm); }
  __device__ __forceinline__ float* sinm() const { return (float*)(ws + WO_sinm); }
  __device__ __forceinline__ float* cosr() const { return (float*)(ws + WO_cosr); }
  __device__ __forceinline__ float* sinr() const { return (float*)(ws + WO_sinr); }
  __device__ __forceinline__ float* kmean() const { return (float*)(ws + WO_kmean); }
  __device__ __forceinline__ float* proj() const { return (float*)(ws + WO_proj); }
  __device__ __forceinline__ float* ybuf() const { return (float*)(ws + WO_ybuf); }
  __device__ __forceinline__ float* yg() const { return (float*)(ws + WO_yg); }
  __device__ __forceinline__ bf16_t* skb() const { return (bf16_t*)(ws + WO_skb); }
  __device__ __forceinline__ bf16_t* Ub() const { return (bf16_t*)(ws + WO_Ub); }
  __device__ __forceinline__ bf16_t* Vb() const { return (bf16_t*)(ws + WO_Vb); }
  __device__ __forceinline__ float* gates() const { return (float*)(ws + WO_gates); }
  __device__ __forceinline__ int* eidx() const { return (int*)(ws + WO_eidx); }
  __device__ __forceinline__ bf16_t* xb() const { return (bf16_t*)(ws + WO_xb); }
  __device__ __forceinline__ bf16_t* Win_t() const { return (bf16_t*)(ws + WO_Win_t); }
  __device__ __forceinline__ bf16_t* Wout_t() const { return (bf16_t*)(ws + WO_Wout_t); }
  __device__ __forceinline__ bf16_t* Wq_t() const { return (bf16_t*)(ws + WO_Wq_t); }
  __device__ __forceinline__ bf16_t* Qm() const { return (bf16_t*)(ws + WO_Qm); }
  __device__ __forceinline__ bf16_t* Km() const { return (bf16_t*)(ws + WO_Km); }
  __device__ __forceinline__ bf16_t* Vm() const { return (bf16_t*)(ws + WO_Vm); }
  __device__ __forceinline__ bf16_t* S5A() const { return (bf16_t*)(ws + WO_S5A); }
  __device__ __forceinline__ bf16_t* S5Wy() const { return (bf16_t*)(ws + WO_S5Wy); }
  __device__ __forceinline__ bf16_t* S5Wz() const { return (bf16_t*)(ws + WO_S5Wz); }
  __device__ __forceinline__ float* S5Z() const { return (float*)(ws + WO_S5Z); }
  __device__ __forceinline__ float* S5a32() const { return (float*)(ws + WO_S5a32); }
  __device__ __forceinline__ bf16_t* Wglu_t() const { return (bf16_t*)(ws + WO_Wglu_t); }
  __device__ __forceinline__ bf16_t* ygb() const { return (bf16_t*)(ws + WO_yg); }
  __device__ __forceinline__ int* qctr() const { return (int*)(ws + WO_qctr); }
  __device__ __forceinline__ unsigned char* U8s() const { return (unsigned char*)(ws + WO_Ub); }
  __device__ __forceinline__ float* su() const { return (float*)(ws + WO_Ub + (size_t)16384 * D); }
  __device__ __forceinline__ unsigned char* V8s() const { return (unsigned char*)(ws + WO_Vb); }
  __device__ __forceinline__ float* sv() const { return (float*)(ws + WO_Vb + (size_t)16384 * D); }
  __device__ __forceinline__ bf16_t* hb() const { return (bf16_t*)(ws + WO_ybuf + ((size_t)4 << 20)); }
  __device__ __forceinline__ bf16_t* ppart() const { return (bf16_t*)(ws + WO_proj + (size_t)T * D * 2); }
  __device__ __forceinline__ bf16_t* Qr() const { return (bf16_t*)(ws + WO_Qr); }
  __device__ __forceinline__ bf16_t* Kr() const { return (bf16_t*)(ws + WO_Kr); }
  __device__ __forceinline__ bf16_t* Krv() const { return (bf16_t*)(ws + WO_Krv); }
  __device__ __forceinline__ bf16_t* Vr() const { return (bf16_t*)(ws + WO_Vr); }
  __device__ __forceinline__ float* KVr() const { return (float*)(ws + WO_KVr); }
  __device__ __forceinline__ bf16_t* Rb() const { return (bf16_t*)(ws + WO_Rb); }
  __device__ __forceinline__ unsigned* bar() const { return (unsigned*)(ws + WO_bar); }
  __device__ __forceinline__ float* ssq1() const { return (float*)(ws + WO_ssq1); }
  __device__ __forceinline__ float* ssq2() const { return (float*)(ws + WO_ssq2); }
  __device__ __forceinline__ bf16_t* xb2() const { return (bf16_t*)(ws + WO_proj + (size_t)T * D * 2 + (size_t)T * 128 * 8 * 4); }
  __device__ __forceinline__ bf16_t* vrow() const { return (bf16_t*)(ws + WO_proj); }
  __device__ __forceinline__ bf16_t* vrrow() const { return (bf16_t*)(ws + WO_proj + (size_t)T * 512 * 2); }
  __device__ __forceinline__ bf16_t* krow() const { return (bf16_t*)(ws + WO_proj + (size_t)T * 768 * 2); }
  __device__ __forceinline__ bf16_t* grow() const { return (bf16_t*)(ws + WO_proj + (size_t)T * 1024 * 2); }
  __device__ __forceinline__ bf16_t* qb() const { return (bf16_t*)(ws + WO_proj); }
};

namespace pg8 {
#define PG8_LAS __attribute__((address_space(3)))
typedef unsigned short bf16_t;
typedef short bf16x8 __attribute__((ext_vector_type(8)));
typedef float f32x4 __attribute__((ext_vector_type(4)));
typedef unsigned u32x4 __attribute__((ext_vector_type(4)));
constexpr int BM = 256, BK = 64, HALF = 128, HTB = HALF * BK * 2  , STAGE_BYTES = 8 * HTB, NXCD = 8, WGM = 8;

__host__ __device__ __forceinline__ int lds_byte(int r, int c) { const int st = (r >> 4) * 2 + (c >> 5), rr = r & 15, cc = c & 31, ob = rr * 64 + cc * 2; return st * 1024 + (ob ^ (((ob >> 9) & 1) << 5)); }
__host__ __device__ __forceinline__ void stage_rc(int b, int& R, int& C) { const int st = b / 1024, sb = b % 1024, swz = sb ^ (((sb >> 9) & 1) << 5); R = (st >> 1) * 16 + swz / 64; C = (st & 1) * 32 + (swz % 64) / 2; }
__host__ __device__ __forceinline__ int perm32(int rho) { const int n = rho >> 4, i = rho & 15; return 8 * (i >> 2) + 4 * n + (i & 3); }

struct Unit { int pm, pn; };
struct Gemm { const bf16_t* A; const bf16_t* Bt; int M, N, K, lda, ldb; };

struct StaticOrder {
    int nM, nN, nwg, G, c;
    __host__ __device__ void init(int M, int N, int G_, int c_) { nM = M / BM; nN = N / BM; nwg = nM * nN; G = G_; c = c_; }
    __host__ __device__ bool next(int i, Unit& u) const {
        const long L = (long)i * G + c; if (L >= nwg) return false;
        int wgid = (int)L; { const int q = nwg / NXCD, r = nwg % NXCD, xcd = wgid % NXCD, off = wgid / NXCD; wgid = (xcd < r ? xcd * (q + 1) : r * (q + 1) + (xcd - r) * q) + off; }
        const int nig = WGM * nN, gid = wgid / nig, fm = gid * WGM, gsz = (nM - fm) < WGM ? (nM - fm) : WGM;
        u.pm = fm + ((wgid % nig) % gsz); u.pn = (wgid % nig) / gsz; return true;
    }
    __device__ __forceinline__ void a_ready(const Unit&) const {}
    __device__ __forceinline__ void done(const Unit&) const {}
};
struct GroupOrder {
    int mt, nt_, nwg, G, c;
    __host__ __device__ void init(int ngroups, int mt__, int nt__, int G_, int c_) { mt = mt__; nt_ = nt__; nwg = ngroups * mt * nt_; G = G_; c = c_; }
    __host__ __device__ bool next(int i, Unit& u) const {
        const long L = (long)i * G + c; if (L >= nwg) return false;
        const int per = mt * nt_, gi = (int)L / per, r = (int)L % per;
        u.pm = gi * mt + r % mt; u.pn = gi * nt_ + r / mt; return true;
    }
    __device__ __forceinline__ void a_ready(const Unit&) const {}
    __device__ __forceinline__ void done(const Unit&) const {}
};
template <class Epi, class Sched, bool ALIGN_EPI = false, bool SP2 = false>
__device__ __forceinline__ void gemm_phase(PG8_LAS unsigned char* lds, const Gemm g, const Sched& S, const Epi& E) {
    int tid_ = threadIdx.x; asm volatile("" : "+v"(tid_));
    const int tid = tid_, wid = __builtin_amdgcn_readfirstlane(tid >> 6), lane = tid & 63, wr = wid >> 2, wc = wid & 3, fr = lane & 15, fq = lane >> 4;
    const int K = g.K, nt = K / BK;
    unsigned voffA[2], voffB[2];
#pragma unroll
    for (int i = 0; i < 2; ++i) { int R, C; stage_rc(tid * 16 + i * 8192, R, C); const int Rb = Epi::PERM ? ((R & ~31) + perm32(R & 31)) : R;
        voffA[i] = (unsigned)(R * g.lda + C) * 2u; voffB[i] = (unsigned)(Rb * g.ldb + C) * 2u; }
    const size_t kstep = (size_t)(BK * 2);
    const size_t hstepA = (size_t)HALF * g.lda * 2, hstepB = (size_t)HALF * g.ldb * 2;
    const size_t tstepA = 2 * hstepA, tstepB = 2 * hstepB;
    const unsigned ldsw = (unsigned)wid * 1024u;
    const int aoff = lds_byte(wr * 64 + fr, fq * 8), boff = lds_byte(wc * 32 + fr, fq * 8);
#define PG8_SA(b, h) (((b) * 2 + (h)) * HTB)
#define PG8_SB(b, h) ((4 + (b) * 2 + (h)) * HTB)
#define PG8_STAGE(bufoff, gbase, voff) do { _Pragma("unroll") for (int _i = 0; _i < 2; ++_i) \
        __builtin_amdgcn_global_load_lds((const unsigned*)((const char*)(gbase) + (voff)[_i]), (PG8_LAS unsigned*)(lds + (bufoff) + ldsw + _i * 8192), 16, 0, 0); } while (0)
#define PG8_LDA(dst, b, h) do { _Pragma("unroll") for (int m = 0; m < 4; ++m) _Pragma("unroll") for (int k = 0; k < 2; ++k) dst[m][k] = *(const PG8_LAS bf16x8*)(lds + PG8_SA(b, h) + aoff + m * 2048 + k * 1024); } while (0)
#define PG8_LDB(dst, b, h) do { _Pragma("unroll") for (int n = 0; n < 2; ++n) _Pragma("unroll") for (int k = 0; k < 2; ++k) dst[n][k] = *(const PG8_LAS bf16x8*)(lds + PG8_SB(b, h) + boff + n * 2048 + k * 1024); } while (0)
#define PG8_MMA(ai, bj, At, Bt) do { __builtin_amdgcn_s_setprio(1); _Pragma("unroll") for (int m = 0; m < 4; ++m) _Pragma("unroll") for (int n = 0; n < 2; ++n) _Pragma("unroll") for (int k = 0; k < 2; ++k) \
        acc[ai][bj][m][n] = __builtin_amdgcn_mfma_f32_16x16x32_bf16(Bt[n][k], At[m][k], acc[ai][bj][m][n], 0, 0, 0); __builtin_amdgcn_s_setprio(0); } while (0)
#define PG8_WAIT_V(n) asm volatile("s_waitcnt vmcnt(" #n ")" ::: "memory")
#define PG8_WAIT_L(n) asm volatile("s_waitcnt lgkmcnt(" #n ")" ::: "memory")
#define PG8_BAR __builtin_amdgcn_s_barrier()
#define PG8_SCHED __builtin_amdgcn_sched_barrier(0)
    Unit cur, nxt; int ui = 0;
    if (!S.next(0, cur)) return;
    f32x4 acc[2][2][4][2];
    E.init(acc, cur, wr, wc, fr, fq);
    bf16x8 At[4][2], B0[2][2], B1[2][2];
    const char* cA = (const char*)g.A + (size_t)cur.pm * tstepA; const char* cB = (const char*)g.Bt + (size_t)cur.pn * tstepB;
    S.a_ready(cur);
    if constexpr (SP2) {
        PG8_STAGE(PG8_SB(0, 0), cB, voffB); PG8_STAGE(PG8_SB(0, 1), cB + hstepB, voffB); PG8_STAGE(PG8_SA(0, 0), cA, voffA); PG8_STAGE(PG8_SA(0, 1), cA + hstepA, voffA);
        if (wr == 1) PG8_BAR;
        PG8_WAIT_V(2); PG8_BAR;
        PG8_STAGE(PG8_SB(1, 0), cB + kstep, voffB); PG8_STAGE(PG8_SA(1, 0), cA + kstep, voffA); PG8_STAGE(PG8_SB(1, 1), cB + hstepB + kstep, voffB);
        PG8_WAIT_V(6); PG8_BAR;
    } else {
        PG8_STAGE(PG8_SB(0, 0), cB, voffB); PG8_STAGE(PG8_SA(0, 0), cA, voffA); PG8_STAGE(PG8_SB(0, 1), cB + hstepB, voffB); PG8_STAGE(PG8_SA(0, 1), cA + hstepA, voffA);
        if (wr == 1) PG8_BAR;
        PG8_WAIT_V(4); PG8_BAR;
        PG8_STAGE(PG8_SB(1, 0), cB + kstep, voffB); PG8_STAGE(PG8_SA(1, 0), cA + kstep, voffA); PG8_STAGE(PG8_SB(1, 1), cB + hstepB + kstep, voffB);
        PG8_WAIT_V(6); PG8_BAR;
    }
    for (;;) {
        const bool has_next = S.next(ui + 1, nxt);
        const char* nA = has_next ? (const char*)g.A + (size_t)nxt.pm * tstepA : cA; const char* nB = has_next ? (const char*)g.Bt + (size_t)nxt.pn * tstepB : cB;
        for (int t = 0; t < nt; t += 2) {
            const bool last = (t == nt - 2);
            const char* a1 = cA + (size_t)(t + 1) * kstep;
            const char* a2 = last ? nA : cA + (size_t)(t + 2) * kstep; const char* b2 = last ? nB : cB + (size_t)(t + 2) * kstep;
            const char* a3 = a2 + kstep; const char* b3 = b2 + kstep;
            if (last && has_next) S.a_ready(nxt);
            if constexpr (SP2) {
            PG8_LDB(B0, 0, 0); PG8_LDB(B1, 0, 1); PG8_SCHED; PG8_LDA(At, 0, 0); PG8_STAGE(PG8_SA(1, 1), a1 + hstepA, voffA);
            PG8_WAIT_V(8); PG8_WAIT_L(0); PG8_BAR; PG8_MMA(0, 0, At, B0); PG8_MMA(0, 1, At, B1); PG8_BAR; PG8_SCHED;
            PG8_LDA(At, 0, 1); PG8_STAGE(PG8_SB(0, 0), b2, voffB); PG8_STAGE(PG8_SB(0, 1), b2 + hstepB, voffB); PG8_STAGE(PG8_SA(0, 0), a2, voffA);
            PG8_WAIT_V(8); PG8_WAIT_L(0); PG8_BAR; PG8_MMA(1, 0, At, B0); PG8_MMA(1, 1, At, B1); PG8_BAR; PG8_SCHED;
            PG8_LDB(B0, 1, 0); PG8_LDB(B1, 1, 1); PG8_SCHED; PG8_LDA(At, 1, 0); PG8_STAGE(PG8_SA(0, 1), a2 + hstepA, voffA);
            PG8_WAIT_V(8); PG8_WAIT_L(0); PG8_BAR; PG8_MMA(0, 0, At, B0); PG8_MMA(0, 1, At, B1); PG8_BAR; PG8_SCHED;
            PG8_LDA(At, 1, 1); PG8_STAGE(PG8_SB(1, 0), b3, voffB); PG8_STAGE(PG8_SB(1, 1), b3 + hstepB, voffB); PG8_STAGE(PG8_SA(1, 0), a3, voffA);
            PG8_WAIT_V(8); PG8_WAIT_L(0); PG8_BAR; PG8_MMA(1, 0, At, B0); PG8_MMA(1, 1, At, B1); PG8_BAR; PG8_SCHED;
            } else {
            PG8_LDB(B0, 0, 0); PG8_SCHED; PG8_LDA(At, 0, 0); PG8_STAGE(PG8_SA(1, 1), a1 + hstepA, voffA);
            PG8_WAIT_L(8); PG8_BAR; PG8_WAIT_L(0); PG8_MMA(0, 0, At, B0); PG8_BAR; PG8_SCHED;
            PG8_LDB(B1, 0, 1); PG8_STAGE(PG8_SB(0, 0), b2, voffB);
            PG8_BAR; PG8_WAIT_L(0); PG8_MMA(0, 1, At, B1); PG8_BAR;
            PG8_LDA(At, 0, 1); PG8_STAGE(PG8_SA(0, 0), a2, voffA);
            PG8_BAR; PG8_WAIT_L(0); PG8_MMA(1, 0, At, B0); PG8_BAR; PG8_SCHED;
            PG8_STAGE(PG8_SB(0, 1), b2 + hstepB, voffB);
            PG8_WAIT_V(6); PG8_BAR; PG8_MMA(1, 1, At, B1); PG8_BAR;
            PG8_LDB(B0, 1, 0); PG8_SCHED; PG8_LDA(At, 1, 0); PG8_STAGE(PG8_SA(0, 1), a2 + hstepA, voffA);
            PG8_WAIT_L(8); PG8_BAR; PG8_WAIT_L(0); PG8_MMA(0, 0, At, B0); PG8_BAR; PG8_SCHED;
            PG8_LDB(B1, 1, 1); PG8_STAGE(PG8_SB(1, 0), b3, voffB);
            PG8_BAR; PG8_WAIT_L(0); PG8_MMA(0, 1, At, B1); PG8_BAR;
            PG8_LDA(At, 1, 1); PG8_STAGE(PG8_SA(1, 0), a3, voffA);
            PG8_BAR; PG8_WAIT_L(0); PG8_MMA(1, 0, At, B0); PG8_BAR; PG8_SCHED;
            PG8_STAGE(PG8_SB(1, 1), b3 + hstepB, voffB);
            PG8_WAIT_V(6); PG8_BAR; PG8_MMA(1, 1, At, B1); PG8_BAR;
            }
        }
        if constexpr (ALIGN_EPI) { if (wr == 0) PG8_BAR; }
        if constexpr (!Epi::AFTER_DRAIN) { E(acc, cur, wr, wc, fr, fq); S.done(cur); }
        if (!has_next) break;
        E.init(acc, nxt, wr, wc, fr, fq);
        cur = nxt; cA = nA; cB = nB; ++ui;
        if constexpr (ALIGN_EPI) { if (wr == 1) PG8_BAR; }
    }
    PG8_WAIT_V(0);
    if constexpr (!ALIGN_EPI) { if (wr == 0) PG8_BAR; }
    PG8_BAR;
    if constexpr (Epi::AFTER_DRAIN) { E.fused(acc, cur, wr, wc, fr, fq, lds, wid, lane); S.done(cur); }
#undef PG8_SA
#undef PG8_SB
#undef PG8_STAGE
#undef PG8_LDA
#undef PG8_LDB
#undef PG8_MMA
#undef PG8_WAIT_V
#undef PG8_WAIT_L
#undef PG8_BAR
#undef PG8_SCHED
}
}
#define EPI_ZERO_INIT \
  __device__ __forceinline__ void init(pg8::f32x4 (&acc)[2][2][4][2], const pg8::Unit&, int, int, int, int) const { \
    _Pragma("unroll") for (int a = 0; a < 2; ++a) _Pragma("unroll") for (int b = 0; b < 2; ++b) \
    _Pragma("unroll") for (int m = 0; m < 4; ++m) _Pragma("unroll") for (int n = 0; n < 2; ++n) acc[a][b][m][n] = (pg8::f32x4){0.f, 0.f, 0.f, 0.f}; }
struct EpiResid {
  static constexpr bool PERM = true, AFTER_DRAIN = false;
  float* C; int ldc; bf16_t* xb; bf16_t* hb; const float* g2; float* parts;
  __device__ __forceinline__ void init(pg8::f32x4 (&acc)[2][2][4][2], const pg8::Unit& u, int wr, int wc, int fr, int fq) const {
#pragma unroll
    for (int ai = 0; ai < 2; ++ai)
#pragma unroll
      for (int m = 0; m < 4; ++m) {
        const int row = u.pm * 256 + ai * 128 + wr * 64 + m * 16 + fr;
#pragma unroll
        for (int bj = 0; bj < 2; ++bj)
#pragma unroll
          for (int n = 0; n < 2; ++n) {
            const int col = u.pn * 256 + bj * 128 + wc * 32 + 8 * fq + 4 * n;
            acc[ai][bj][m][n] = *(const pg8::f32x4*)(C + (size_t)row * ldc + col);
          }
      }
  }
  __device__ __forceinline__ void operator()(const pg8::f32x4 (&acc)[2][2][4][2], const pg8::Unit& u, int wr, int wc, int fr_in, int fq_in) const {
    int fr = fr_in, fq = fq_in; asm volatile("" : "+v"(fr), "+v"(fq));
    pg8::f32x4 gv[2][2];
#pragma unroll
    for (int bj = 0; bj < 2; ++bj)
#pragma unroll
      for (int n = 0; n < 2; ++n) gv[bj][n] = *(const pg8::f32x4*)(g2 + u.pn * 256 + bj * 128 + wc * 32 + 8 * fq + 4 * n);
#pragma unroll
    for (int ai = 0; ai < 2; ++ai)
#pragma unroll
      for (int m = 0; m < 4; ++m) {
        const int row = u.pm * 256 + ai * 128 + wr * 64 + m * 16 + fr;
        float ss = 0.f;
#pragma unroll
        for (int bj = 0; bj < 2; ++bj) {
          const int col = u.pn * 256 + bj * 128 + wc * 32 + 8 * fq;
          const pg8::f32x4 v0 = acc[ai][bj][m][0], v1 = acc[ai][bj][m][1];
          *(pg8::f32x4*)(C + (size_t)row * ldc + col) = v0; *(pg8::f32x4*)(C + (size_t)row * ldc + col + 4) = v1;
          *(uint4*)(xb + (size_t)row * KD + col) = make_uint4(pk_bf16(v0[0], v0[1]), pk_bf16(v0[2], v0[3]), pk_bf16(v1[0], v1[1]), pk_bf16(v1[2], v1[3]));
          const pg8::f32x4 h0 = v0 * gv[bj][0], h1 = v1 * gv[bj][1];
          *(uint4*)(hb + ((size_t)(col >> 7) * T + row) * 128 + (col & 127)) = make_uint4(pk_bf16(h0[0], h0[1]), pk_bf16(h0[2], h0[3]), pk_bf16(h1[0], h1[1]), pk_bf16(h1[2], h1[3]));
          ss += ((v0[0] * v0[0] + v0[1] * v0[1]) + (v0[2] * v0[2] + v0[3] * v0[3])) + ((v1[0] * v1[0] + v1[1] * v1[1]) + (v1[2] * v1[2] + v1[3] * v1[3]));
        }
        ss += __shfl_xor(ss, 16); ss += __shfl_xor(ss, 32);
        if (fq == 0) parts[(size_t)row * 16 + u.pn * 4 + wc] = ss;
        asm volatile("" ::: "memory");
      }
  }
};
struct EpiScaleStoreBf16 {
  static constexpr bool PERM = true, AFTER_DRAIN = false;
  bf16_t* C; int ldc; const float* parts; int nparts; float* rs_out;
  EPI_ZERO_INIT
  __device__ __forceinline__ void operator()(const pg8::f32x4 (&acc)[2][2][4][2], const pg8::Unit& u, int wr, int wc, int fr_in, int fq_in) const {
    int fr = fr_in, fq = fq_in; asm volatile("" : "+v"(fr), "+v"(fq));
#pragma unroll
    for (int ai = 0; ai < 2; ++ai)
#pragma unroll
      for (int m = 0; m < 4; ++m) {
        const int row = u.pm * 256 + ai * 128 + wr * 64 + m * 16 + fr;
        float ssum = 0.f;
        for (int i = 0; i < nparts; i += 4) { const pg8::f32x4 q4 = *(const pg8::f32x4*)(parts + (size_t)row * nparts + i); ssum += (q4[0] + q4[1]) + (q4[2] + q4[3]); }
        const float r = rsqrtf(ssum * (1.0f / (float)D) + EPS);
        if (rs_out && u.pn == 0 && wc == 0 && fq == 0) rs_out[row] = r;
#pragma unroll
        for (int bj = 0; bj < 2; ++bj) {
          const int col = u.pn * 256 + bj * 128 + wc * 32 + 8 * fq;
          const pg8::f32x4 v0 = acc[ai][bj][m][0] * r, v1 = acc[ai][bj][m][1] * r;
          *(uint4*)(C + (size_t)row * ldc + col) = make_uint4(pk_bf16(v0[0], v0[1]), pk_bf16(v0[2], v0[3]), pk_bf16(v1[0], v1[1]), pk_bf16(v1[2], v1[3]));
        }
        asm volatile("" ::: "memory");
      }
  }
};
struct EpiInProj {
  static constexpr bool PERM = true, AFTER_DRAIN = false;
  const float* parts;
  bf16_t *S5A, *Qm, *Km, *vrow, *Qr, *Kr, *krow, *vrrow, *grow;
  const float *gq, *gk, *cosm, *sinm, *cosr, *sinr;
  EPI_ZERO_INIT
  __device__ __forceinline__ void operator()(const pg8::f32x4 (&acc)[2][2][4][2], const pg8::Unit& u, int wr, int wc, int fr_in, int fq_in) const {
    int fr = fr_in, fq = fq_in; asm volatile("" : "+v"(fr), "+v"(fq));
    const int pn = u.pn;
    float gain[2][8];
    if (pn >= 1 && pn <= 4) {
      const float* gsrc = pn <= 2 ? gq : gk;
#pragma unroll
      for (int bj = 0; bj < 2; ++bj) { const pg8::f32x4 a = *(const pg8::f32x4*)(gsrc + bj * 32 + 8 * fq), b = *(const pg8::f32x4*)(gsrc + bj * 32 + 8 * fq + 4);
        gain[bj][0] = a[0]; gain[bj][1] = a[1]; gain[bj][2] = a[2]; gain[bj][3] = a[3]; gain[bj][4] = b[0]; gain[bj][5] = b[1]; gain[bj][6] = b[2]; gain[bj][7] = b[3]; }
    }
    const float l2g = ret_log2g(wc);
#pragma unroll
    for (int ai = 0; ai < 2; ++ai)
#pragma unroll
      for (int m = 0; m < 4; ++m) {
        const int t = u.pm * 256 + ai * 128 + wr * 64 + m * 16 + fr, s = t & (S - 1), b = t >> 12;
        float r;
        { const pg8::f32x4 p0 = *(const pg8::f32x4*)(parts + (size_t)t * 8), p1 = *(const pg8::f32x4*)(parts + (size_t)t * 8 + 4);
          r = rsqrtf((((p0[0] + p0[1]) + (p0[2] + p0[3])) + ((p1[0] + p1[1]) + (p1[2] + p1[3]))) * (1.0f / (float)D) + EPS); }
        float v[2][8];
#pragma unroll
        for (int bj = 0; bj < 2; ++bj)
#pragma unroll
          for (int e = 0; e < 8; ++e) v[bj][e] = acc[ai][bj][m][e >> 2][e & 3] * r;
#define PK8(x_) make_uint4(pk_bf16((x_)[0], (x_)[1]), pk_bf16((x_)[2], (x_)[3]), pk_bf16((x_)[4], (x_)[5]), pk_bf16((x_)[6], (x_)[7]))
        if (pn == 0) {
#pragma unroll
          for (int bj = 0; bj < 2; ++bj) { const int g = wc * 4 + bj * 2 + (fq >> 1);
            *(uint4*)(S5A + ((size_t)g * 1024 + (t >> 5)) * 640 + (t & 31) * 16 + 8 * (fq & 1)) = PK8(v[bj]); }
        } else if (pn <= 4) {
          const bool isk = pn >= 3; const int h = ((pn - 1) & 1) * 4 + wc, bh = b * 8 + h;
          float ss = 0.f;
#pragma unroll
          for (int bj = 0; bj < 2; ++bj)
#pragma unroll
            for (int e = 0; e < 8; ++e) ss += v[bj][e] * v[bj][e];
          ss += __shfl_xor(ss, 16); ss += __shfl_xor(ss, 32);
          const float rh = rsqrtf(ss * (1.0f / 64.0f) + EPS);
#pragma unroll
          for (int bj = 0; bj < 2; ++bj)
#pragma unroll
            for (int e = 0; e < 8; ++e) v[bj][e] *= rh * gain[bj][e];
          { const pg8::f32x4 c0 = *(const pg8::f32x4*)(cosm + s * 8), c1 = *(const pg8::f32x4*)(cosm + s * 8 + 4), s0 = *(const pg8::f32x4*)(sinm + s * 8), s1 = *(const pg8::f32x4*)(sinm + s * 8 + 4);
#pragma unroll
            for (int e = 0; e < 8; ++e) {
              const float pu = __shfl_xor(v[0][e], 16);
              const float c = e < 4 ? c0[e & 3] : c1[e & 3], sn = e < 4 ? s0[e & 3] : s1[e & 3];
              const float o = fq == 0 ? (v[0][e] * c - pu * sn) : (v[0][e] * c + pu * sn);
              v[0][e] = fq < 2 ? o : v[0][e];
            } }
          if (!isk) {
#pragma unroll
            for (int bj = 0; bj < 2; ++bj) { float q8[8];
#pragma unroll
              for (int e = 0; e < 8; ++e) q8[e] = v[bj][e] * QSCALE;
              *(uint4*)(Qm + ((size_t)bh * S + s) * 64 + bj * 32 + 8 * fq) = PK8(q8); }
          } else {
#pragma unroll
            for (int bj = 0; bj < 2; ++bj) *(uint4*)(Km + ((((size_t)bh * (S / 32) + (s >> 5)) * 8 + bj * 4 + fq) * 32 + (s & 31)) * 8) = PK8(v[bj]);
          }
        } else if (pn <= 6) {
#pragma unroll
          for (int bj = 0; bj < 2; ++bj) *(uint4*)(vrow + (size_t)t * 512 + (pn - 5) * 256 + wc * 64 + bj * 32 + 8 * fq) = PK8(v[bj]);
        } else if (pn <= 8) {
          const bool isk = pn == 8; const int bh = b * 4 + wc, pos = s & 127;
          const float sc = isk ? 0.125f * exp2f(-(float)pos * l2g) : exp2f((float)pos * l2g);
          const pg8::f32x4 c0 = *(const pg8::f32x4*)(cosr + s * 32 + 8 * fq), c1 = *(const pg8::f32x4*)(cosr + s * 32 + 8 * fq + 4);
          const pg8::f32x4 s0 = *(const pg8::f32x4*)(sinr + s * 32 + 8 * fq), s1 = *(const pg8::f32x4*)(sinr + s * 32 + 8 * fq + 4);
          float o1[8], o2[8];
#pragma unroll
          for (int e = 0; e < 8; ++e) { const float c = e < 4 ? c0[e & 3] : c1[e & 3], sn = e < 4 ? s0[e & 3] : s1[e & 3];
            o1[e] = (v[0][e] * c - v[1][e] * sn) * sc; o2[e] = (v[1][e] * c + v[0][e] * sn) * sc; }
          if (!isk) {
            *(uint4*)(Qr + ((size_t)bh * S + s) * 64 + 8 * fq) = PK8(o1); *(uint4*)(Qr + ((size_t)bh * S + s) * 64 + 32 + 8 * fq) = PK8(o2);
          } else {
            *(uint4*)(Kr + ((((size_t)bh * (S / 32) + (s >> 5)) * 8 + fq) * 32 + (s & 31)) * 8) = PK8(o1);
            *(uint4*)(Kr + ((((size_t)bh * (S / 32) + (s >> 5)) * 8 + 4 + fq) * 32 + (s & 31)) * 8) = PK8(o2);
            *(uint4*)(krow + (size_t)t * 256 + wc * 64 + 8 * fq) = PK8(o1); *(uint4*)(krow + (size_t)t * 256 + wc * 64 + 32 + 8 * fq) = PK8(o2);
          }
        } else {
          bf16_t* dst = (pn == 9 ? vrrow : grow) + (size_t)t * 256 + wc * 64 + 8 * fq;
          *(uint4*)dst = PK8(v[0]); *(uint4*)(dst + 32) = PK8(v[1]);
        }
#undef PK8
        asm volatile("" ::: "memory");
      }
  }
};
template <class Epi>
__device__ __forceinline__ void run_gemm(unsigned char* lds_raw, const bf16_t* A, const bf16_t* Bt, int M, int N, int K, const Epi& e) {
  pg8::Gemm g{A, Bt, M, N, K, K, K}; pg8::StaticOrder So; So.init(M, N, (int)gridDim.x, (int)blockIdx.x);
  pg8::gemm_phase<Epi, pg8::StaticOrder, true, true>((PG8_LAS unsigned char*)lds_raw, g, So, e);
}

template <bool HEADPERM>
__device__ __forceinline__ void transpose_items(const float* __restrict__ W, int K, int N, const float* __restrict__ g, bf16_t* __restrict__ Wt, int gw, int ngw, int lane) {
  const int nkt = K / 64, nnt = N / 64;
  for (int it = gw; it < nkt * nnt; it += ngw) {
    int kt = it % nkt, ntile = it / nkt;
    int k0 = kt * 64, n = ntile * 64 + lane;
    int ns = n;
    if (HEADPERM) { const int cp = n & 255; ns = (n & ~255) + ((cp >> 5) & 3) * 64 + (cp >> 7) * 32 + (cp & 31); }
    float v[64];
#pragma unroll
    for (int i = 0; i < 64; ++i) v[i] = W[(size_t)(k0 + i) * N + ns] * g[k0 + i];
    bf16_t* dst = Wt + (size_t)n * (K * KS) + k0;
#pragma unroll
    for (int c = 0; c < 8; ++c) {
      bf16_t hi[8], lo[8];
#pragma unroll
      for (int e = 0; e < 8; ++e) { hi[e] = f2bf(v[c * 8 + e]); lo[e] = f2bf(v[c * 8 + e] - bf2f(hi[e])); }
      uint4 ph, pl;
      ph.x = hi[0] | ((unsigned)hi[1] << 16); ph.y = hi[2] | ((unsigned)hi[3] << 16); ph.z = hi[4] | ((unsigned)hi[5] << 16); ph.w = hi[6] | ((unsigned)hi[7] << 16);
      pl.x = lo[0] | ((unsigned)lo[1] << 16); pl.y = lo[2] | ((unsigned)lo[3] << 16); pl.z = lo[4] | ((unsigned)lo[5] << 16); pl.w = lo[6] | ((unsigned)lo[7] << 16);
      *(uint4*)(dst + c * 8) = ph;
      if (PRECISE) { *(uint4*)(dst + K + c * 8) = pl; *(uint4*)(dst + 2 * K + c * 8) = ph; }
    }
  }
}


__device__ __forceinline__ void phase_prologue(const Params& p, int gtid, int ngt, int gw, int ngw, int lane) {
  for (int idx = gtid; idx < S * 40; idx += ngt) {
    int s = idx / 40, i = idx % 40;
    if (i < 8) {
      const float inv = powf(500000.0f, -(float)(2 * i) / 16.0f);
      float sn, cs; sincosf((float)s * inv, &sn, &cs);
      p.cosm()[s * 8 + i] = cs; p.sinm()[s * 8 + i] = sn;
    } else {
      const int j = i - 8;
      const float inv = powf(10000.0f, -((float)j / 31.0f));
      float sn, cs; sincosf((float)s * inv, &sn, &cs);
      p.cosr()[s * 32 + j] = cs; p.sinr()[s * 32 + j] = sn;
    }
  }
  { const float4* a = (const float4*)p.inp(0); float4* b = (float4*)p.outp();
    for (size_t i = gtid; i < (size_t)T * D / 4; i += ngt) b[i] = a[i]; }
  for (int t = gw; t < T; t += ngw) {
    const float4* xr = (const float4*)(p.inp(0) + (size_t)t * D); float ss = 0.f;
#pragma unroll
    for (int i = 0; i < 4; ++i) { const float4 v = xr[lane + i * 64]; ss += v.x * v.x + v.y * v.y + v.z * v.z + v.w * v.w;
      *(uint2*)(p.xb() + (size_t)t * KD + (lane + i * 64) * 4) = make_uint2(pk_bf16(v.x, v.y), pk_bf16(v.z, v.w)); }
    ss = wave_sum(ss);
    if (lane < 8) p.ssq1()[(size_t)t * 8 + lane] = lane == 0 ? ss : 0.f;
  }
  for (int idx = gtid; idx < NL * 65536; idx += ngt) { const int l2 = idx >> 16, n2 = (idx >> 8) & 255, k2 = idx & 255; p.Wglu_t()[idx] = f2bf(p.inp(11)[(size_t)l2 * 65536 + k2 * 256 + n2]); }
  for (int l = 0; l < NL; ++l) {
    transpose_items<true>(p.inp(2) + (size_t)l * D * INW, D, INW, p.inp(1) + l * D, p.Win_t() + (size_t)l * INW * KD, gw, ngw, lane);
    transpose_items<false>(p.inp(15) + (size_t)l * D * D, D, D, p.inp(14) + l * D, p.Wout_t() + (size_t)l * D * KD, gw, ngw, lane);
    transpose_items<false>(p.inp(17) + (size_t)l * D * D, D, D, p.inp(16) + l * D, p.Wq_t() + (size_t)l * D * KD, gw, ngw, lane);
  }
}


struct S5P { float lr, li, dt, fr, fi; };
__device__ __forceinline__ S5P s5p(const Params& p, int l, int g, int pp) {
  S5P r; r.lr = p.inp(3)[l * 1024 + g * 64 + pp]; r.li = p.inp(4)[l * 1024 + g * 64 + pp]; r.dt = expf(p.inp(5)[l * 16 + g]);
  const float mag = expf(r.lr * r.dt); float sn, cs; sincosf(r.li * r.dt, &sn, &cs);
  const float ar = mag * cs, ai = mag * sn, den = r.lr * r.lr + r.li * r.li;
  r.fr = ((ar - 1.0f) * r.lr + ai * r.li) / den; r.fi = (ai * r.lr - (ar - 1.0f) * r.li) / den;
  return r;
}
__device__ __forceinline__ void s5pow(const S5P& s, int k, float& re, float& im) {
  const float m = expf((float)k * s.lr * s.dt); float sn, cs; sincosf((float)k * s.li * s.dt, &sn, &cs); re = m * cs; im = m * sn;
}
__device__ __forceinline__ void phase_s5_prep(const Params& p, int l, int gtid, int ngt) {
  const float* b_re = p.inp(6) + l * 16384; const float* b_im = p.inp(7) + l * 16384;
  const float* c_re = p.inp(8) + l * 16384; const float* c_im = p.inp(9) + l * 16384;
  bf16_t* Wy = p.S5Wy(); bf16_t* Wz = p.S5Wz();
  for (int it = gtid; it < 16 * 32 * 256; it += ngt) {
    const int hp = it & 15, h = (it >> 4) & 15, d = (it >> 8) & 31, g = it >> 13;
    float prl, pil, frl, fil;
    { const S5P sl = s5p(p, l, g, (int)(threadIdx.x & 63)); s5pow(sl, d, prl, pil); frl = sl.fr; fil = sl.fi; }
    float acc = 0.f;
    for (int pp = 0; pp < 64; ++pp) {
      const float pr = __shfl(prl, pp), pi = __shfl(pil, pp);
      S5P s; s.fr = __shfl(frl, pp); s.fi = __shfl(fil, pp);
      const float br = b_re[(g * 64 + pp) * 16 + hp], bi = b_im[(g * 64 + pp) * 16 + hp];
      const float bbr = s.fr * br - s.fi * bi, bbi = s.fr * bi + s.fi * br;
      const float tr = pr * bbr - pi * bbi, ti = pr * bbi + pi * bbr;
      acc += c_re[(g * 16 + h) * 64 + pp] * tr - c_im[(g * 16 + h) * 64 + pp] * ti;
    }
    const bf16_t v = f2bf(acc);
    for (int jp = 0; jp + d < 32; ++jp) {
      const int j = jp + d;
      Wy[((size_t)g * 512 + j * 16 + h) * 640 + jp * 16 + hp] = v;
      if (d > 0) Wy[((size_t)g * 512 + jp * 16 + h) * 640 + j * 16 + hp] = 0;
    }
  }
  for (int it = gtid; it < 16 * 32 * 16 * 64; it += ngt) {
    const int pp = it & 63, h = (it >> 6) & 15, j = (it >> 10) & 31, g = it >> 15;
    const S5P s = s5p(p, l, g, pp);
    float pr, pi; s5pow(s, j + 1, pr, pi);
    const float cr = c_re[(g * 16 + h) * 64 + pp], ci = c_im[(g * 16 + h) * 64 + pp];
    const unsigned w = pk_bf16(cr * pr - ci * pi, -(cr * pi + ci * pr));
    *(unsigned*)(Wy + ((size_t)g * 512 + j * 16 + h) * 640 + 512 + 2 * pp) = w;
  }
  for (int it = gtid; it < 16 * 64 * 32; it += ngt) {
    const int j = it & 31, pp = (it >> 5) & 63, g = it >> 11;
    const S5P s = s5p(p, l, g, pp);
    float pr, pi; s5pow(s, 31 - j, pr, pi);
    for (int hp = 0; hp < 16; ++hp) {
      const float br = b_re[(g * 64 + pp) * 16 + hp], bi = b_im[(g * 64 + pp) * 16 + hp];
      const float bbr = s.fr * br - s.fi * bi, bbi = s.fr * bi + s.fi * br;
      Wz[((size_t)g * 256 + 2 * pp) * 512 + j * 16 + hp] = f2bf(pr * bbr - pi * bbi);
      Wz[((size_t)g * 256 + 2 * pp + 1) * 512 + j * 16 + hp] = f2bf(pr * bbi + pi * bbr);
    }
  }
  for (int it = gtid; it < 16 * 64; it += ngt) {
    const S5P s = s5p(p, l, it >> 6, it & 63);
    float pr, pi; s5pow(s, 32, pr, pi);
    p.S5a32()[it * 2] = pr; p.S5a32()[it * 2 + 1] = pi;
  }
}
__device__ __forceinline__ void phase_s5_scan(const Params& p, int gtid, int ngt) {
  for (int it = gtid; it < NB * 16 * 64; it += ngt) {
    const int pp = it & 63, g = (it >> 6) & 15, b = it >> 10;
    const float er = p.S5a32()[(g * 64 + pp) * 2], ei = p.S5a32()[(g * 64 + pp) * 2 + 1];
    float sr = 0.f, si = 0.f;
#pragma unroll 1
    for (int c0 = 0; c0 < 128; c0 += 16) {
      float2 z[16];
#pragma unroll
      for (int k = 0; k < 16; ++k) z[k] = *(const float2*)(p.S5Z() + ((size_t)g * 1024 + b * 128 + c0 + k) * 128 + 2 * pp);
#pragma unroll
      for (int k = 0; k < 16; ++k) {
        const size_t ch = (size_t)g * 1024 + b * 128 + c0 + k;
        *(unsigned*)(p.S5A() + ch * 640 + 512 + 2 * pp) = pk_bf16(sr, si);
        const float nr = er * sr - ei * si + z[k].x, ni = er * si + ei * sr + z[k].y;
        sr = nr; si = ni;
      }
    }
  }
}
struct EpiS5Z {
  static constexpr bool PERM = false, AFTER_DRAIN = false;
  float* Z;
  EPI_ZERO_INIT
  __device__ __forceinline__ void operator()(const pg8::f32x4 (&acc)[2][2][4][2], const pg8::Unit& u, int wr, int wc, int fr_in, int fq_in) const {
    int fr = fr_in, fq = fq_in; asm volatile("" : "+v"(fr), "+v"(fq));
    const int g = u.pm >> 2;
#pragma unroll
    for (int ai = 0; ai < 2; ++ai)
#pragma unroll
      for (int m = 0; m < 4; ++m) {
        const int chunk = (u.pm & 3) * 256 + ai * 128 + wr * 64 + m * 16 + fr;
#pragma unroll
        for (int n = 0; n < 2; ++n) *(pg8::f32x4*)(Z + ((size_t)g * 1024 + chunk) * 128 + wc * 32 + n * 16 + 4 * fq) = acc[ai][0][m][n];
      }
  }
};
struct EpiS5Y {
  static constexpr bool PERM = false, AFTER_DRAIN = false;
  bf16_t* ygb; const bf16_t* A; const float* dsk;
  EPI_ZERO_INIT
  __device__ __forceinline__ void operator()(const pg8::f32x4 (&acc)[2][2][4][2], const pg8::Unit& u, int wr, int wc, int fr_in, int fq_in) const {
    int fr = fr_in, fq = fq_in; asm volatile("" : "+v"(fr), "+v"(fq));
    const int g = u.pm >> 2;
#pragma unroll
    for (int ai = 0; ai < 2; ++ai)
#pragma unroll
      for (int m = 0; m < 4; ++m) {
        const int chunk = (u.pm & 3) * 256 + ai * 128 + wr * 64 + m * 16 + fr;
#pragma unroll
        for (int bj = 0; bj < 2; ++bj)
#pragma unroll
          for (int n = 0; n < 2; ++n) {
            const int col = (u.pn & 1) * 256 + bj * 128 + wc * 32 + n * 16 + 4 * fq, j = col >> 4, h = col & 15;
            const uint2 uu = *(const uint2*)(A + ((size_t)g * 1024 + chunk) * 640 + col);
            const pg8::f32x4 dv = *(const pg8::f32x4*)(dsk + g * 16 + h);
            const pg8::f32x4 v = acc[ai][bj][m][n];
            const float y0 = fast_gelu(v[0] + dv[0] * __uint_as_float(uu.x << 16)), y1 = fast_gelu(v[1] + dv[1] * __uint_as_float(uu.x & 0xffff0000u));
            const float y2 = fast_gelu(v[2] + dv[2] * __uint_as_float(uu.y << 16)), y3 = fast_gelu(v[3] + dv[3] * __uint_as_float(uu.y & 0xffff0000u));
            uint2 o; o.x = pk_bf16(y0, y1); o.y = pk_bf16(y2, y3);
            *(uint2*)(ygb + ((size_t)chunk * 32 + j) * 256 + g * 16 + h) = o;
          }
        asm volatile("" ::: "memory");
      }
  }
};
struct EpiGlu {
  static constexpr bool PERM = false, AFTER_DRAIN = false;
  bf16_t* yb; const bf16_t* ygb; float* scr;
  EPI_ZERO_INIT
  __device__ __forceinline__ void operator()(const pg8::f32x4 (&acc_)[2][2][4][2], const pg8::Unit& u, int wr, int wc, int fr_in, int fq_in) const {
    int fr = fr_in, fq = fq_in; asm volatile("" : "+v"(fr), "+v"(fq));
    pg8::f32x4 (&acc)[2][2][4][2] = const_cast<pg8::f32x4 (&)[2][2][4][2]>(acc_);
#pragma unroll
    for (int ai = 0; ai < 2; ++ai)
#pragma unroll
      for (int m = 0; m < 4; ++m) {
        const int rl = ai * 128 + wr * 64 + m * 16 + fr, row = u.pm * 256 + rl;
        float ss = 0.f;
#pragma unroll
        for (int bj = 0; bj < 2; ++bj)
#pragma unroll
          for (int n = 0; n < 2; ++n) {
            const int col = bj * 128 + wc * 32 + n * 16 + 4 * fq;
            const uint2 yy = *(const uint2*)(ygb + (size_t)row * 256 + col);
            const pg8::f32x4 z = acc[ai][bj][m][n];
            pg8::f32x4 r;
            r[0] = __uint_as_float(yy.x << 16) * fast_sigmoid(z[0]); r[1] = __uint_as_float(yy.x & 0xffff0000u) * fast_sigmoid(z[1]);
            r[2] = __uint_as_float(yy.y << 16) * fast_sigmoid(z[2]); r[3] = __uint_as_float(yy.y & 0xffff0000u) * fast_sigmoid(z[3]);
            acc[ai][bj][m][n] = r;
            ss += r[0] * r[0] + r[1] * r[1] + r[2] * r[2] + r[3] * r[3];
          }
        ss += __shfl_xor(ss, 16); ss += __shfl_xor(ss, 32);
        if (fq == 0) scr[rl * 4 + wc] = ss;
        asm volatile("" ::: "memory");
      }
    asm volatile("s_waitcnt lgkmcnt(0)" ::: "memory"); __builtin_amdgcn_s_barrier(); asm volatile("" ::: "memory");
#pragma unroll
    for (int ai = 0; ai < 2; ++ai)
#pragma unroll
      for (int m = 0; m < 4; ++m) {
        const int rl = ai * 128 + wr * 64 + m * 16 + fr, row = u.pm * 256 + rl;
        const pg8::f32x4 s4 = *(const pg8::f32x4*)(scr + rl * 4);
        const float r = rsqrtf((s4[0] + s4[1] + s4[2] + s4[3]) / 256.0f + EPS);
#pragma unroll
        for (int bj = 0; bj < 2; ++bj)
#pragma unroll
          for (int n = 0; n < 2; ++n) { const pg8::f32x4 v = acc[ai][bj][m][n] * r; *(uint2*)(yb + (size_t)row * KD + bj * 128 + wc * 32 + n * 16 + 4 * fq) = make_uint2(pk_bf16(v[0], v[1]), pk_bf16(v[2], v[3])); }
        asm volatile("" ::: "memory");
      }
    asm volatile("s_waitcnt lgkmcnt(0)" ::: "memory"); __builtin_amdgcn_s_barrier(); asm volatile("" ::: "memory");
  }
};


__device__ __forceinline__ void phase_moba2(const Params& p, int l, unsigned char* lds, int* uq) {
  constexpr int OLD = 260;
  bf16_t* Qs = (bf16_t*)lds;
  float* Oaccf = (float*)(lds + 32768);
  float* laccf = (float*)(lds + 32768 + 64 * OLD * 4);
  float* kms = laccf + 256;
  float* gat = kms + 1024;
  unsigned char* lists = (unsigned char*)(gat + 4096);
  int* cnt = (int*)(lists + 4096);
  int* items = cnt + 16;
  int* ctr = items + 160;
  unsigned* selp = (unsigned*)(ctr + 4);
  float* bq = (float*)(selp + 256);
  int* Oacc = (int*)Oaccf; int* lacc = (int*)laccf;
  float kmax = 0.f;
  { const float* gk = p.inp(13) + l * 64;
    for (int d = 0; d < 64; ++d) kmax = fmaxf(kmax, fabsf(gk[d]));
    kmax *= 8.0f * 1.01f; }
  for (;;) {
    const int u = q_pull(uq, NB * 8 * 16, (int*)(lds + 131072), threadIdx.x);
    if (u < 0) break;
    const int qblk = 15 - (u >> 6), bh = u & 63, b = bh >> 3, h = bh & 7;
    int tid = threadIdx.x; asm volatile("" : "+v"(tid));
    const int lane = tid & 63, wv = tid >> 6, n = lane & 31, hh = lane >> 5;
    __syncthreads();
    { const uint4* src = (const uint4*)(p.Qm() + ((size_t)bh * S + qblk * 256) * 64);
      uint4* dst = (uint4*)Qs;
      for (int i = tid; i < 256 * 64 * 2 / 16; i += NTHR) dst[i] = src[i]; }
    for (int i = tid; i < qblk * 64; i += NTHR) kms[i] = p.kmean()[(size_t)bh * 1024 + i];
    for (int i = tid; i < 64 * OLD; i += NTHR) Oacc[i] = 0;
    if (tid < 256) lacc[tid] = 0;
    if (tid < 16) cnt[tid] = 0;
    __syncthreads();
    { const int q = tid & 255, par = tid >> 8;
      float qv[64];
#pragma unroll
      for (int c = 0; c < 8; ++c) {
        uint4 w = *(const uint4*)(Qs + q * 64 + c * 8);
        qv[c * 8 + 0] = __uint_as_float(w.x << 16); qv[c * 8 + 1] = __uint_as_float(w.x & 0xffff0000u);
        qv[c * 8 + 2] = __uint_as_float(w.y << 16); qv[c * 8 + 3] = __uint_as_float(w.y & 0xffff0000u);
        qv[c * 8 + 4] = __uint_as_float(w.z << 16); qv[c * 8 + 5] = __uint_as_float(w.z & 0xffff0000u);
        qv[c * 8 + 6] = __uint_as_float(w.w << 16); qv[c * 8 + 7] = __uint_as_float(w.w & 0xffff0000u);
      }
      if (par == 0) { float qq = 0.f;
#pragma unroll
        for (int d = 0; d < 64; ++d) qq = fmaf(qv[d], qv[d], qq);
        bq[q] = sqrtf(qq) * kmax; }
      for (int j = par; j < qblk; j += 2) {
        float g = 0.f;
#pragma unroll
        for (int d = 0; d < 64; ++d) g = fmaf(qv[d], kms[j * 64 + d], g);
        gat[q * 16 + j] = g;
      }
    }
    __syncthreads();
    if (tid < 256) {
      float b0 = -INFINITY, b1 = -INFINITY, b2 = -INFINITY; int i0 = 0, i1 = 0, i2 = 0;
      for (int j = 0; j < qblk; ++j) {
        float g = gat[tid * 16 + j];
        if (g > b0) { b2 = b1; i2 = i1; b1 = b0; i1 = i0; b0 = g; i0 = j; }
        else if (g > b1) { b2 = b1; i2 = i1; b1 = g; i1 = j; }
        else if (g > b2) { b2 = g; i2 = j; }
      }
      const int nsel = qblk < 3 ? qblk : 3;
      selp[tid] = (unsigned)i0 | ((unsigned)i1 << 4) | ((unsigned)i2 << 8) | ((unsigned)nsel << 12);
    }
    __syncthreads();
    for (int j = wv; j < qblk; j += 8) {
      int base = 0;
      for (int c = 0; c < 4; ++c) {
        const int q = c * 64 + lane;
        const unsigned sp = selp[q];
        const int ns = sp >> 12;
        const bool f = (ns > 0 && (int)(sp & 15) == j) || (ns > 1 && (int)((sp >> 4) & 15) == j) || (ns > 2 && (int)((sp >> 8) & 15) == j);
        const unsigned long long bal = __ballot(f);
        const int pos = base + __popcll(bal & ((1ull << lane) - 1ull));
        if (f) lists[j * 256 + pos] = (unsigned char)q;
        base += __popcll(bal);
      }
      if (lane == 0) cnt[j] = base;
    }
    __syncthreads();
    if (tid == 0) {
      int ni = 0;
#pragma unroll 1
      for (int g = 7; g >= 0; --g) items[ni++] = (16 << 8) | g;
      for (int j = 0; j < qblk; ++j) { const int ng = (cnt[j] + 31) >> 5; for (int g = 0; g < ng; ++g) items[ni++] = (j << 8) | g; }
      ctr[0] = ni; ctr[1] = 0;
    }
    __syncthreads();
    const int nitems = ctr[0];
    DUP(11) {
    if (rep_ > 0) { __syncthreads(); if (tid == 0) ctr[1] = 0; __syncthreads(); }
    for (;;) {
      int it = 0;
      if (lane == 0) it = atomicAdd(&ctr[1], 1);
      it = __builtin_amdgcn_readfirstlane(it);
      if (it >= nitems) break;
      const int item = items[it];
      const int j = item >> 8, g = item & 255;
      const bool own = (j == 16);
      const int kb = own ? qblk : j;
      const int ntile = own ? (g + 1) : 8;
      int qi; bool valid;
      if (own) { qi = g * 32 + n; valid = true; }
      else { const int pos = g * 32 + n; valid = pos < cnt[j]; qi = lists[j * 256 + (valid ? pos : 0)]; }
      const bf16_t* kt0 = p.Km() + ((size_t)bh * (S / 32) + kb * 8) * 2048 + lane * 8;
      const bf16_t* vt0 = p.Vm() + ((size_t)bh * (S / 32) + kb * 8) * 2048 + lane * 8;
      f32x16 O0, O1;
#pragma unroll
      for (int r = 0; r < 16; ++r) { O0[r] = 0.f; O1[r] = 0.f; }
      float lsum = 0.f;
      const float nbq = -bq[qi];
      bf16x8 kf[3][4], vf[3][4];
#define MOBA_LOAD(KT_, BUF_) { _Pragma("unroll") for (int s = 0; s < 4; ++s) { kf[BUF_][s] = *(const bf16x8*)(kt0 + (size_t)(KT_) * 2048 + s * 512); vf[BUF_][s] = *(const bf16x8*)(vt0 + (size_t)(KT_) * 2048 + s * 512); } }
#define MOBA_STEP(KT_, BUF_)                                                                                                           \
      if ((KT_) < ntile) {                                                                                                               \
        if ((KT_) + 2 < ntile) MOBA_LOAD((KT_) + 2, ((BUF_) + 2) % 3)                                                                     \
        f32x16 X;                                                                                                                         \
        _Pragma("unroll") for (int r = 0; r < 16; ++r) X[r] = nbq;                                                                        \
        _Pragma("unroll") for (int s = 0; s < 4; ++s) X = __builtin_amdgcn_mfma_f32_32x32x16_bf16(kf[BUF_][s], *(const bf16x8*)(Qs + qi * 64 + (2 * s + hh) * 8), X, 0, 0, 0);     \
        const bool diag = own && ((KT_) == g);                                                                                            \
        unsigned pw[8];                                                                                                                   \
        _Pragma("unroll") for (int r = 0; r < 16; r += 2) {                                                                               \
          float e0 = __builtin_amdgcn_exp2f(X[r]), e1 = __builtin_amdgcn_exp2f(X[r + 1]);                                                 \
          if (diag) {                                                                                                                     \
            const int k0 = (r & 3) + 8 * (r >> 2) + 4 * hh, k1 = ((r + 1) & 3) + 8 * ((r + 1) >> 2) + 4 * hh;                             \
            e0 = (k0 <= n) ? e0 : 0.f; e1 = (k1 <= n) ? e1 : 0.f;                                                                         \
          }                                                                                                                               \
          lsum += e0 + e1;                                                                                                                \
          pw[r >> 1] = pk_bf16(e0, e1);                                                                                                   \
        }                                                                                                                                 \
        bf16x8 pf0, pf1;                                                                                                                  \
        { uint4 t0 = make_uint4(pw[0], pw[1], pw[2], pw[3]), t1 = make_uint4(pw[4], pw[5], pw[6], pw[7]);                                 \
          pf0 = *(bf16x8*)&t0; pf1 = *(bf16x8*)&t1; }                                                                                     \
        O0 = __builtin_amdgcn_mfma_f32_32x32x16_bf16(vf[BUF_][0], pf0, O0, 0, 0, 0);                                                      \
        O0 = __builtin_amdgcn_mfma_f32_32x32x16_bf16(vf[BUF_][1], pf1, O0, 0, 0, 0);                                                      \
        O1 = __builtin_amdgcn_mfma_f32_32x32x16_bf16(vf[BUF_][2], pf0, O1, 0, 0, 0);                                                      \
        O1 = __builtin_amdgcn_mfma_f32_32x32x16_bf16(vf[BUF_][3], pf1, O1, 0, 0, 0);                                                      \
      }
      MOBA_LOAD(0, 0)
      if (ntile > 1) MOBA_LOAD(1, 1)
#pragma unroll 1
      for (int kt3 = 0; kt3 < ntile; kt3 += 3) {
        MOBA_STEP(kt3, 0) MOBA_STEP(kt3 + 1, 1) MOBA_STEP(kt3 + 2, 2)
      }
#undef MOBA_STEP
#undef MOBA_LOAD
      lsum += __shfl_xor(lsum, 32);
      if (valid) {
        if (hh == 0) atomicAdd(&lacc[qi], __float2int_rn(lsum * 1048576.0f));
#pragma unroll
        for (int r = 0; r < 16; ++r) {
          const int dim = (r & 3) + 8 * (r >> 2) + 4 * hh;
          atomicAdd(&Oacc[dim * OLD + qi], __float2int_rn(O0[r] * 1048576.0f));
          atomicAdd(&Oacc[(dim + 32) * OLD + qi], __float2int_rn(O1[r] * 1048576.0f));
        }
      }
    }
    }
    __syncthreads();
    { const int q = tid >> 1, half = tid & 1;
      const float inv = 1.0f / (float)lacc[q];
      float o[32], ss = 0.f;
#pragma unroll
      for (int d = 0; d < 32; ++d) { o[d] = (float)Oacc[(half * 32 + d) * OLD + q] * inv; ss += o[d] * o[d]; }
      ss += __shfl_xor(ss, 1);
      const float r = rsqrtf(ss / 64.0f + EPS);
      bf16_t* dst = p.xb() + (size_t)(b * S + qblk * 256 + q) * KD + 256 + h * 64 + half * 32;
#pragma unroll
      for (int d = 0; d < 32; d += 8) *(uint4*)(dst + d) = make_uint4(pk_bf16(o[d] * r, o[d + 1] * r), pk_bf16(o[d + 2] * r, o[d + 3] * r), pk_bf16(o[d + 4] * r, o[d + 5] * r), pk_bf16(o[d + 6] * r, o[d + 7] * r));
    }
  }
}


__device__ __forceinline__ void phase_ret_kv(const Params& p, int gw, int ngw, int lane) {
  const int n = lane & 31, hh = lane >> 5;
  for (int w = gw; w < NB * 4 * 32; w += ngw) {
    const int bh = w >> 5, cn = w & 31;
    const bf16_t* vt = p.Vr() + ((size_t)bh * (S / 32) + cn * 4) * 2048 + lane * 8;
    const bf16_t* kt = p.Krv() + ((size_t)bh * (S / 32) + cn * 4) * 2048 + lane * 8;
    f32x16 acc[2][2];
#pragma unroll
    for (int a = 0; a < 2; ++a)
#pragma unroll
      for (int b2 = 0; b2 < 2; ++b2)
#pragma unroll
        for (int r = 0; r < 16; ++r) acc[a][b2][r] = 0.f;
#pragma unroll 1
    for (int tl = 0; tl < 4; ++tl)
#pragma unroll
      for (int ks = 0; ks < 2; ++ks) {
        bf16x8 vf[2], kf[2];
#pragma unroll
        for (int x = 0; x < 2; ++x) { vf[x] = *(const bf16x8*)(vt + tl * 2048 + (x * 2 + ks) * 512); kf[x] = *(const bf16x8*)(kt + tl * 2048 + (x * 2 + ks) * 512); }
#pragma unroll
        for (int mb = 0; mb < 2; ++mb)
#pragma unroll
          for (int nb = 0; nb < 2; ++nb) acc[mb][nb] = __builtin_amdgcn_mfma_f32_32x32x16_bf16(vf[mb], kf[nb], acc[mb][nb], 0, 0, 0);
      }
    float* dst = p.KVr() + ((size_t)bh * 32 + cn) * 4096;
#pragma unroll
    for (int mb = 0; mb < 2; ++mb)
#pragma unroll
      for (int nb = 0; nb < 2; ++nb)
#pragma unroll
        for (int r = 0; r < 16; ++r) dst[(mb * 32 + (r & 3) + 8 * (r >> 2) + 4 * hh) * 64 + nb * 32 + n] = acc[mb][nb][r];
  }
}
__device__ __forceinline__ void phase_ret_scan(const Params& p, int gtid, int ngt) {
  for (int it = gtid; it < NB * 4 * 4096; it += ngt) {
    const int e = it & 4095, bh = it >> 12, h = bh & 3;
    const float l2g = ret_log2g(h), g1 = exp2f(l2g), g127 = exp2f(127.0f * l2g), g128 = exp2f(128.0f * l2g);
    float R = 0.f; float kv[32];
#pragma unroll
    for (int cn = 0; cn < 32; ++cn) kv[cn] = p.KVr()[((size_t)bh * 32 + cn) * 4096 + e];
#pragma unroll
    for (int cn = 0; cn < 32; ++cn) {
      p.Rb()[((size_t)bh * 32 + cn) * 4096 + e] = f2bf(g1 * R);
      R = g128 * R + g127 * kv[cn];
    }
  }
}
__device__ __forceinline__ void phase_ret_out(const Params& p, int gw, int ngw, int lane) {
  const int n = lane & 31, hh = lane >> 5;
  for (int w = gw; w < NB * 4 * 32 * 4; w += ngw) {
    const int qg = 3 - (w & 3), cn = (w >> 2) & 31, bh = w >> 7, b = bh >> 2, h = bh & 3;
    const int s0 = cn * 128 + qg * 32;
    bf16x8 qf[4];
#pragma unroll
    for (int s = 0; s < 4; ++s) qf[s] = *(const bf16x8*)(p.Qr() + ((size_t)bh * S + s0 + n) * 64 + (2 * s + hh) * 8);
    f32x16 O0, O1;
#pragma unroll
    for (int r = 0; r < 16; ++r) { O0[r] = 0.f; O1[r] = 0.f; }
    { const bf16_t* rb = p.Rb() + ((size_t)bh * 32 + cn) * 4096 + (size_t)n * 64 + hh * 8;
#pragma unroll
      for (int s = 0; s < 4; ++s) {
        const bf16x8 r0 = *(const bf16x8*)(rb + s * 16), r1 = *(const bf16x8*)(rb + 32 * 64 + s * 16);
        O0 = __builtin_amdgcn_mfma_f32_32x32x16_bf16(r0, qf[s], O0, 0, 0, 0);
        O1 = __builtin_amdgcn_mfma_f32_32x32x16_bf16(r1, qf[s], O1, 0, 0, 0);
      } }
    const bf16_t* kt0 = p.Kr() + ((size_t)bh * (S / 32) + cn * 4) * 2048 + lane * 8;
    const bf16_t* vt0 = p.Vr() + ((size_t)bh * (S / 32) + cn * 4) * 2048 + lane * 8;
    for (int kt = 0; kt <= qg; ++kt) {
      bf16x8 kf[4], vf[4];
#pragma unroll
      for (int s = 0; s < 4; ++s) { kf[s] = *(const bf16x8*)(kt0 + (size_t)kt * 2048 + s * 512); vf[s] = *(const bf16x8*)(vt0 + (size_t)kt * 2048 + s * 512); }
      f32x16 X;
#pragma unroll
      for (int r = 0; r < 16; ++r) X[r] = 0.f;
#pragma unroll
      for (int s = 0; s < 4; ++s) X = __builtin_amdgcn_mfma_f32_32x32x16_bf16(kf[s], qf[s], X, 0, 0, 0);
      const bool diag = (kt == qg);
      unsigned pw[8];
#pragma unroll
      for (int r = 0; r < 16; r += 2) {
        float e0 = X[r], e1 = X[r + 1];
        if (diag) {
          const int k0 = (r & 3) + 8 * (r >> 2) + 4 * hh, k1 = ((r + 1) & 3) + 8 * ((r + 1) >> 2) + 4 * hh;
          e0 = (k0 <= n) ? e0 : 0.f; e1 = (k1 <= n) ? e1 : 0.f;
        }
        pw[r >> 1] = pk_bf16(e0, e1);
      }
      bf16x8 pf0, pf1;
      { uint4 t0 = make_uint4(pw[0], pw[1], pw[2], pw[3]), t1 = make_uint4(pw[4], pw[5], pw[6], pw[7]);
        pf0 = *(bf16x8*)&t0; pf1 = *(bf16x8*)&t1; }
      O0 = __builtin_amdgcn_mfma_f32_32x32x16_bf16(vf[0], pf0, O0, 0, 0, 0);
      O0 = __builtin_amdgcn_mfma_f32_32x32x16_bf16(vf[1], pf1, O0, 0, 0, 0);
      O1 = __builtin_amdgcn_mfma_f32_32x32x16_bf16(vf[2], pf0, O1, 0, 0, 0);
      O1 = __builtin_amdgcn_mfma_f32_32x32x16_bf16(vf[3], pf1, O1, 0, 0, 0);
    }
    float ss = 0.f;
#pragma unroll
    for (int r = 0; r < 16; ++r) ss += O0[r] * O0[r] + O1[r] * O1[r];
    ss += __shfl_xor(ss, 32);
    const float rn = rsqrtf(ss / 64.0f + EPS);
    const size_t t = (size_t)b * S + s0 + n;
    const bf16_t* gp = p.grow() + t * 256 + h * 64;
    bf16_t* yo = p.xb() + t * KD + 768 + h * 64;
#pragma unroll
    for (int q4 = 0; q4 < 4; ++q4) {
#pragma unroll
      for (int mb = 0; mb < 2; ++mb) {
        const int d0 = mb * 32 + 8 * q4 + 4 * hh;
        const uint2 gw2 = *(const uint2*)(gp + d0); const float4 g = make_float4(__uint_as_float(gw2.x << 16), __uint_as_float(gw2.x & 0xffff0000u), __uint_as_float(gw2.y << 16), __uint_as_float(gw2.y & 0xffff0000u));
        float4 o;
        const f32x16& Oa = mb ? O1 : O0;
        o.x = Oa[q4 * 4 + 0] * rn * g.x * fast_sigmoid(g.x); o.y = Oa[q4 * 4 + 1] * rn * g.y * fast_sigmoid(g.y);
        o.z = Oa[q4 * 4 + 2] * rn * g.z * fast_sigmoid(g.z); o.w = Oa[q4 * 4 + 3] * rn * g.w * fast_sigmoid(g.w);
        *(uint2*)(yo + d0) = make_uint2(pk_bf16(o.x, o.y), pk_bf16(o.z, o.w));
      }
    }
  }
}

__device__ __forceinline__ void phase_post_pack(const Params& p, int gtid, int ngt) {
  for (int idx = gtid; idx < NB * 8 * (S / 32) * 256; idx += ngt) {
    const int ln = idx & 63, ks = (idx >> 6) & 1, mb = (idx >> 7) & 1, tile = (idx >> 8) % (S / 32), bh = idx / (256 * (S / 32));
    const int b = bh >> 3, h = bh & 7, hh = ln >> 5, delta = mb * 32 + (ln & 31);
    bf16_t v[8];
#pragma unroll
    for (int j = 0; j < 8; ++j) { const int kappa = 16 * ks + 8 * (j >> 2) + 4 * hh + (j & 3), s = tile * 32 + kappa; v[j] = p.vrow()[(size_t)(b * S + s) * 512 + h * 64 + delta]; }
    *(uint4*)(p.Vm() + (size_t)idx * 8) = make_uint4(v[0] | ((unsigned)v[1] << 16), v[2] | ((unsigned)v[3] << 16), v[4] | ((unsigned)v[5] << 16), v[6] | ((unsigned)v[7] << 16));
  }
  for (int idx = gtid; idx < 2 * NB * 4 * (S / 32) * 256; idx += ngt) {
    const int ln = idx & 63, ks = (idx >> 6) & 1, blk = (idx >> 7) & 1, tile = (idx >> 8) % (S / 32), rest = idx / (256 * (S / 32)), bh = rest % (NB * 4), which = rest / (NB * 4);
    const int b = bh >> 2, h = bh & 3, hh = ln >> 5, delta = blk * 32 + (ln & 31);
    const bf16_t* srcp = which ? p.krow() : p.vrrow();
    bf16_t v[8];
#pragma unroll
    for (int j = 0; j < 8; ++j) { const int kappa = 16 * ks + 8 * (j >> 2) + 4 * hh + (j & 3), s = tile * 32 + kappa; v[j] = srcp[(size_t)(b * S + s) * 256 + h * 64 + delta]; }
    *(uint4*)((which ? p.Krv() : p.Vr()) + ((size_t)(idx % (NB * 4 * (S / 32) * 256))) * 8) = make_uint4(v[0] | ((unsigned)v[1] << 16), v[2] | ((unsigned)v[3] << 16), v[4] | ((unsigned)v[5] << 16), v[6] | ((unsigned)v[7] << 16));
  }
}
__device__ __forceinline__ void phase_kmean2(const Params& p, int gtid, int ngt) {
  for (int idx = gtid; idx < NB * 8 * 16 * 64; idx += ngt) {
    const int d = idx & 63, j = (idx >> 6) & 15, bh = idx >> 10, c = d >> 3, dj = d & 7;
    float acc = 0.f;
    for (int tl = 0; tl < 8; ++tl) {
      const bf16_t* kp = p.Km() + (((size_t)bh * (S / 32) + j * 8 + tl) * 8 + c) * 256 + dj;
#pragma unroll 8
      for (int key = 0; key < 32; ++key) acc += bf2f(kp[key * 8]);
    }
    p.kmean()[idx] = acc * (1.0f / 256.0f);
  }
}

__device__ __forceinline__ void cvt_f32_bf16(const float* __restrict__ src, bf16_t* __restrict__ dst, size_t n8, int gtid, int ngt) {
  for (size_t i = gtid; i < n8; i += ngt) {
    float4 a = *(const float4*)(src + i * 8), b4 = *(const float4*)(src + i * 8 + 4);
    uint4 o; o.x = pk_bf16(a.x, a.y); o.y = pk_bf16(a.z, a.w); o.z = pk_bf16(b4.x, b4.y); o.w = pk_bf16(b4.z, b4.w);
    *(uint4*)(dst + i * 8) = o;
  }
}
__device__ __forceinline__ int f2key(float f) { int b = __float_as_int(f); return b ^ ((b >> 31) & 0x7fffffff); }
__device__ __forceinline__ float key2f(int k) { return __int_as_float(k ^ ((k >> 31) & 0x7fffffff)); }
#define CASD(a_, b_) { int mx_ = max(a_, b_), mn_ = min(a_, b_); a_ = mx_; b_ = mn_; }
__device__ __forceinline__ void sort16_desc(int (&v)[16]) {
#pragma unroll
  for (int k = 2; k <= 16; k <<= 1)
#pragma unroll
    for (int j = k >> 1; j > 0; j >>= 1)
#pragma unroll
      for (int i = 0; i < 16; ++i) { const int l2 = i ^ j; if (l2 > i) { if ((i & k) == 0) CASD(v[i], v[l2]) else CASD(v[l2], v[i]) } }
}
__device__ __forceinline__ void merge_top16(int (&a)[16], const int (&b)[16]) {
#pragma unroll
  for (int i = 0; i < 16; ++i) a[i] = max(a[i], b[15 - i]);
#pragma unroll
  for (int j = 8; j > 0; j >>= 1)
#pragma unroll
    for (int i = 0; i < 16; ++i) { const int l2 = i ^ j; if (l2 > i) CASD(a[i], a[l2]) }
}
__device__ __forceinline__ int lut4(int w0, int w1, int w2, int w3, int i) {
  const int w = i >> 2; const int d = (w == 0) ? w0 : (w == 1) ? w1 : (w == 2) ? w2 : w3;
  return (d >> ((i & 3) * 8)) & 127;
}

__device__ __forceinline__ void phase_peer_topk(const Params& p, int l, int gw, int ngw, int lane) {
  const int n = lane & 31, hh = lane >> 5;
  const bf16_t* skl = p.skb() + (size_t)l * 16 * 128 * 64;
  for (int w = gw; w < (T / 32) * 8; w += ngw) {
    const int tg = w >> 3, h = w & 7, t = tg * 32 + n;
    int L0[16], L1[16];
#pragma unroll
    for (int c = 0; c < 2; ++c) {
      const int hc = 2 * h + c;
      bf16x8 qf[4];
#pragma unroll
      for (int s = 0; s < 4; ++s) qf[s] = *(const bf16x8*)(p.qb() + (size_t)t * D + hc * 64 + 16 * s + 8 * hh);
      int A[16], Bq[16];
#pragma unroll
      for (int mb = 0; mb < 4; ++mb) {
        f32x16 X;
#pragma unroll
        for (int r = 0; r < 16; ++r) X[r] = 0.f;
#pragma unroll
        for (int s = 0; s < 4; ++s) {
          const bf16x8 kf = *(const bf16x8*)(skl + ((size_t)(hc * 128 + mb * 32 + n)) * 64 + 16 * s + 8 * hh);
          X = __builtin_amdgcn_mfma_f32_32x32x16_bf16(kf, qf[s], X, 0, 0, 0);
        }
        int Gk[16];
#pragma unroll
        for (int r = 0; r < 16; ++r) Gk[r] = (f2key(X[r]) & ~127) | (mb * 32 + (r & 3) + 8 * (r >> 2) + 4 * hh);
        sort16_desc(Gk);
        if (mb == 0) {
#pragma unroll
          for (int r = 0; r < 16; ++r) A[r] = Gk[r];
        } else merge_top16(A, Gk);
      }
#pragma unroll
      for (int r = 0; r < 16; ++r) Bq[r] = __shfl_xor(A[r], 32);
      merge_top16(A, Bq);
#pragma unroll
      for (int r = 0; r < 16; ++r) { if (c == 0) L0[r] = A[r]; else L1[r] = A[r]; }
    }
    float av[16], bv[16];
#pragma unroll
    for (int r = 0; r < 16; ++r) { av[r] = key2f(L0[r] & ~127); bv[r] = key2f(L1[r] & ~127); }
#define CAND(i_, j_) ((f2key(av[i_] + bv[j_]) & ~255) | ((i_) << 4) | (j_))
    int R[16], G1[16], G2[16];
#pragma unroll
    for (int j = 0; j < 16; ++j) R[j] = CAND(0, j);
    G1[0] = CAND(1, 0); G1[1] = CAND(1, 1); G1[2] = CAND(1, 2); G1[3] = CAND(1, 3); G1[4] = CAND(1, 4); G1[5] = CAND(1, 5); G1[6] = CAND(1, 6); G1[7] = CAND(1, 7);
    G1[8] = CAND(2, 0); G1[9] = CAND(2, 1); G1[10] = CAND(2, 2); G1[11] = CAND(2, 3); G1[12] = CAND(2, 4); G1[13] = CAND(3, 0); G1[14] = CAND(3, 1); G1[15] = CAND(3, 2);
    G2[0] = CAND(3, 3); G2[1] = CAND(4, 0); G2[2] = CAND(4, 1); G2[3] = CAND(4, 2); G2[4] = CAND(5, 0); G2[5] = CAND(5, 1); G2[6] = CAND(6, 0); G2[7] = CAND(6, 1);
    G2[8] = CAND(7, 0); G2[9] = CAND(7, 1); G2[10] = CAND(8, 0); G2[11] = CAND(9, 0); G2[12] = CAND(10, 0); G2[13] = CAND(11, 0); G2[14] = CAND(12, 0); G2[15] = CAND(13, 0);
    sort16_desc(G1); merge_top16(R, G1);
    sort16_desc(G2); merge_top16(R, G2);
    { int x0 = CAND(14, 0), x1 = CAND(15, 0);
#pragma unroll
      for (int i = 0; i < 16; ++i) CASD(R[i], x0)
#pragma unroll
      for (int i = 0; i < 16; ++i) CASD(R[i], x1)
    }
#undef CAND
    int pa0 = 0, pa1 = 0, pa2 = 0, pa3 = 0, pb0 = 0, pb1 = 0, pb2 = 0, pb3 = 0;
#pragma unroll
    for (int q = 0; q < 4; ++q) {
      pa0 |= (L0[q] & 127) << (8 * q); pa1 |= (L0[4 + q] & 127) << (8 * q); pa2 |= (L0[8 + q] & 127) << (8 * q); pa3 |= (L0[12 + q] & 127) << (8 * q);
      pb0 |= (L1[q] & 127) << (8 * q); pb1 |= (L1[4 + q] & 127) << (8 * q); pb2 |= (L1[8 + q] & 127) << (8 * q); pb3 |= (L1[12 + q] & 127) << (8 * q);
    }
    float ev[16], sum = 0.f; int ei[16];
    const float mx = key2f(R[0] & ~255);
#pragma unroll
    for (int z = 0; z < 16; ++z) {
      const float v = key2f(R[z] & ~255);
      ev[z] = __expf(v - mx); sum += ev[z];
      const int pay = R[z] & 255;
      ei[z] = lut4(pa0, pa1, pa2, pa3, pay >> 4) * 128 + lut4(pb0, pb1, pb2, pb3, pay & 15);
    }
    const float inv = 1.0f / sum;
    if (hh == 0) {
      float* go = p.gates() + ((size_t)t * 8 + h) * 16; int* eo = p.eidx() + ((size_t)t * 8 + h) * 16;
#pragma unroll
      for (int z = 0; z < 16; z += 4) {
        *(float4*)(go + z) = make_float4(ev[z] * inv, ev[z + 1] * inv, ev[z + 2] * inv, ev[z + 3] * inv);
        *(int4*)(eo + z) = make_int4(ei[z], ei[z + 1], ei[z + 2], ei[z + 3]);
      }
    }
  }
}


typedef int v8i __attribute__((ext_vector_type(8)));
__device__ __forceinline__ unsigned xcc_id() { return (unsigned)__builtin_amdgcn_s_getreg((3 << 11) | 20) & 7u; }
__device__ __forceinline__ float pow2_scale(float amax) {
  if (!(amax > 0.f)) return 1.0f;
  const int e = (int)floorf(log2f(240.0f / amax));
  return exp2f((float)(e < 60 ? (e > -60 ? e : -60) : 60));
}
__device__ __forceinline__ unsigned pack4_fp8(float a, float b, float c, float d) {
  int v = __builtin_amdgcn_cvt_pk_fp8_f32(a, b, 0, false);
  v = __builtin_amdgcn_cvt_pk_fp8_f32(c, d, v, true);
  return (unsigned)v;
}
__device__ __forceinline__ void cvt_table_i8(const float* __restrict__ src, unsigned char* __restrict__ dst, float* __restrict__ scl, int gw, int ngw, int lane) {
  for (int e0 = gw; e0 < 16384; e0 += 2 * ngw) {
    float4 v[2][4];
#pragma unroll
    for (int u = 0; u < 2; ++u) { const int e = (e0 + u * ngw < 16384) ? e0 + u * ngw : e0;
#pragma unroll
      for (int k = 0; k < 4; ++k) v[u][k] = *(const float4*)(src + (size_t)e * D + k * 256 + lane * 4); }
#pragma unroll
    for (int u = 0; u < 2; ++u) {
      const int e = e0 + u * ngw;
      if (e < 16384) {
        float am = 0.f;
#pragma unroll
        for (int k = 0; k < 4; ++k) am = fmaxf(am, fmaxf(fmaxf(fabsf(v[u][k].x), fabsf(v[u][k].y)), fmaxf(fabsf(v[u][k].z), fabsf(v[u][k].w))));
        am = wave_max(am);
        const float s = am > 0.f ? 127.0f / am : 1.0f;
        if (lane == 0) scl[e] = s;
#pragma unroll
        for (int k = 0; k < 4; ++k) {
          const int slice = 2 * k + (lane >> 5), off = (lane & 31) * 4;
          const unsigned w = (unsigned)(__float2int_rn(v[u][k].x * s) & 255) | ((unsigned)(__float2int_rn(v[u][k].y * s) & 255) << 8) |
                             ((unsigned)(__float2int_rn(v[u][k].z * s) & 255) << 16) | ((unsigned)(__float2int_rn(v[u][k].w * s) & 255) << 24);
          *(unsigned*)(dst + ((size_t)slice * 16384 + e) * 128 + off) = w;
        }
      }
    }
  }
}
__device__ __forceinline__ void cvt_table_fp8(const float* __restrict__ src, unsigned char* __restrict__ dst, float* __restrict__ scl, int gw, int ngw, int lane) {
  for (int e0 = gw; e0 < 16384; e0 += 2 * ngw) {
    float4 v[2][4];
#pragma unroll
    for (int u = 0; u < 2; ++u) { const int e = (e0 + u * ngw < 16384) ? e0 + u * ngw : e0;
#pragma unroll
      for (int k = 0; k < 4; ++k) v[u][k] = *(const float4*)(src + (size_t)e * D + k * 256 + lane * 4); }
#pragma unroll
    for (int u = 0; u < 2; ++u) {
      const int e = e0 + u * ngw;
      if (e < 16384) {
        float am = 0.f;
#pragma unroll
        for (int k = 0; k < 4; ++k) am = fmaxf(am, fmaxf(fmaxf(fabsf(v[u][k].x), fabsf(v[u][k].y)), fmaxf(fabsf(v[u][k].z), fabsf(v[u][k].w))));
        am = wave_max(am);
        const float s = pow2_scale(am);
        if (lane == 0) scl[e] = s;
#pragma unroll
        for (int k = 0; k < 4; ++k) {
          const int slice = 2 * k + (lane >> 5), off = (lane & 31) * 4;
          *(unsigned*)(dst + ((size_t)slice * 16384 + e) * 128 + off) = pack4_fp8(v[u][k].x * s, v[u][k].y * s, v[u][k].z * s, v[u][k].w * s);
        }
      }
    }
  }
}
#define DPP_ADD(v_, ctrl_) ((v_) + __builtin_bit_cast(float, __builtin_amdgcn_update_dpp(0, __builtin_bit_cast(int, (v_)), (ctrl_), 0xF, 0xF, true)))
__device__ __forceinline__ float sum_xor16(float x) { float a = x, b = x; asm volatile("v_nop\n\tv_nop\n\tv_permlane16_swap_b32 %0, %1" : "+v"(a), "+v"(b)); return a + b; }
__device__ __forceinline__ float sum_xor32(float x) { float a = x, b = x; asm volatile("v_nop\n\tv_nop\n\tv_permlane32_swap_b32 %0, %1" : "+v"(a), "+v"(b)); return a + b; }
constexpr int PEER_TILE = 128;
__device__ __forceinline__ void phase_peer_u(const Params& p, int* heads, unsigned char* lds, int tid) {
  const int lane = tid & 63, wv = tid >> 6, r8 = lane >> 3, c8 = lane & 7;
  int* bc = (int*)lds;
  int* eW = (int*)(lds + 1024 + wv * 12288);
  bf16_t* hW = (bf16_t*)(lds + 1024 + wv * 12288 + 8192);
  const int myx = (int)xcc_id();
  for (int pass = 0; pass < 8; ++pass) {
    const int s = (myx + pass) & 7;
    const unsigned char* Us = p.U8s() + (size_t)s * 16384 * 128 + c8 * 16;
    for (;;) {
      const int item = q_pull(heads + s, T / PEER_TILE, bc, tid);
      if (item < 0) break;
      const int t0 = item * PEER_TILE + wv * 16;
      LDS_FENCE();
      { uint2 ev[16];
        const bf16_t* hsrc = p.hb() + ((size_t)s * T + t0) * 128 + lane * 8;
#pragma unroll
        for (int k = 0; k < 16; ++k) ev[k] = *(const uint2*)(p.eidx() + (size_t)(t0 + k) * 128 + lane * 2);
        const uint4 hq0 = *(const uint4*)(hsrc), hq1 = *(const uint4*)(hsrc + 512), hq2 = *(const uint4*)(hsrc + 1024), hq3 = *(const uint4*)(hsrc + 1536);
#pragma unroll
        for (int k = 0; k < 16; ++k) *(uint2*)(eW + k * 128 + lane * 2) = ev[k];
        *(uint4*)(hW + lane * 8) = hq0; *(uint4*)(hW + 512 + lane * 8) = hq1; *(uint4*)(hW + 1024 + lane * 8) = hq2; *(uint4*)(hW + 1536 + lane * 8) = hq3; }
      LDS_FENCE();
      uint4 R[4][8];
#define PEER_U_LOAD(M_, BUF_) { _Pragma("unroll") for (int eb = 0; eb < 8; ++eb) R[BUF_][eb] = *(const uint4*)(Us + (size_t)eW[(M_) * 64 + eb * 8 + r8] * 128); }
      if (!(PROBE_SKIP & 128)) { PEER_U_LOAD(0, 0) PEER_U_LOAD(1, 1) PEER_U_LOAD(2, 2) } else { _Pragma("unroll") for (int a_ = 0; a_ < 4; ++a_) _Pragma("unroll") for (int b_ = 0; b_ < 8; ++b_) R[a_][b_] = make_uint4(0u, 0u, 0u, 0u); }
      int hq[4]; float hinv = 0.f; float res0 = 0.f, res1 = 0.f;
#define PEER_U_LOADH(TOK_) { const bf16_t* hp = hW + (TOK_) * 128 + c8 * 16; const uint4 a = *(const uint4*)hp, b4 = *(const uint4*)(hp + 8); \
        const unsigned w8[8] = {a.x, a.y, a.z, a.w, b4.x, b4.y, b4.z, b4.w}; float hv[16]; float am = 0.f;                               \
        _Pragma("unroll") for (int z = 0; z < 8; ++z) { hv[2 * z] = __uint_as_float(w8[z] << 16); hv[2 * z + 1] = __uint_as_float(w8[z] & 0xffff0000u); \
          am = fmaxf(am, fmaxf(fabsf(hv[2 * z]), fabsf(hv[2 * z + 1]))); }                                                                \
        am = fmaxf(am, __builtin_bit_cast(float, __builtin_amdgcn_update_dpp(0, __builtin_bit_cast(int, am), 0xB1, 0xF, 0xF, true)));     \
        am = fmaxf(am, __builtin_bit_cast(float, __builtin_amdgcn_update_dpp(0, __builtin_bit_cast(int, am), 0x4E, 0xF, 0xF, true)));     \
        am = fmaxf(am, __builtin_bit_cast(float, __builtin_amdgcn_update_dpp(0, __builtin_bit_cast(int, am), 0x141, 0xF, 0xF, true)));    \
        const float hs = am > 0.f ? 127.0f / am : 1.0f; hinv = am > 0.f ? am * (1.0f / 127.0f) : 1.0f;                                    \
        _Pragma("unroll") for (int z = 0; z < 4; ++z) hq[z] = (__float2int_rn(hv[4 * z] * hs) & 255) | ((__float2int_rn(hv[4 * z + 1] * hs) & 255) << 8) | \
                                                               ((__float2int_rn(hv[4 * z + 2] * hs) & 255) << 16) | (__float2int_rn(hv[4 * z + 3] * hs) << 24); }
      PEER_U_LOADH(0)
#define PEER_U_HALF(M_, BUF_, HALF_)                                                                           \
      {                                                                                                                                   \
        if (!(PROBE_SKIP & 128)) { if ((M_) + 3 < 32) PEER_U_LOAD((M_) + 3, ((BUF_) + 3) & 3) }                                             \
        if (!(PROBE_SKIP & 128)) _Pragma("unroll") for (int eb = 0; eb < 8; ++eb) {                                                       \
          int di = __builtin_amdgcn_sdot4((int)R[BUF_][eb].x, hq[0], 0, false);                                                           \
          di = __builtin_amdgcn_sdot4((int)R[BUF_][eb].y, hq[1], di, false);                                                              \
          di = __builtin_amdgcn_sdot4((int)R[BUF_][eb].z, hq[2], di, false);                                                              \
          di = __builtin_amdgcn_sdot4((int)R[BUF_][eb].w, hq[3], di, false);                                                              \
          di += __builtin_amdgcn_update_dpp(0, di, 0xB1, 0xF, 0xF, true); di += __builtin_amdgcn_update_dpp(0, di, 0x4E, 0xF, 0xF, true);   \
          di += __builtin_amdgcn_update_dpp(0, di, 0x141, 0xF, 0xF, true);     \
          const float d = (float)di * hinv;                                                                                               \
          if ((HALF_) == 0) { if (c8 == eb) res0 = d; } else { if (c8 == eb) res1 = d; }                                                  \
        }                                                                                                                                 \
        if ((HALF_) == 1) {                                                                                                               \
          bf16_t* po = p.ppart() + ((size_t)s * T + t0 + ((M_) >> 1)) * 128;                                                              \
          po[c8 * 8 + r8] = f2bf(res0); po[64 + c8 * 8 + r8] = f2bf(res1);                                                                \
          if ((M_) + 1 < 32) PEER_U_LOADH(((M_) >> 1) + 1)                                                                                \
        }                                                                                                                                 \
      }
#pragma unroll
      for (int m4 = 0; m4 < 32; m4 += 4) {
        PEER_U_HALF(m4, 0, 0) PEER_U_HALF(m4 + 1, 1, 1) PEER_U_HALF(m4 + 2, 2, 0) PEER_U_HALF(m4 + 3, 3, 1)
      }
#undef PEER_U_HALF
#undef PEER_U_LOADH
#undef PEER_U_LOAD
    }
  }
}
__device__ __forceinline__ void phase_peer_r(const Params& p, int gtid, int ngt) {
  for (int idx0 = gtid; idx0 < T * 128; idx0 += 4 * ngt) {
    float d[4]; int e[4]; float su_[4], sv_[4], g_[4]; bool ok[4];
#pragma unroll
    for (int u = 0; u < 4; ++u) { const int idx = idx0 + u * ngt; ok[u] = idx < T * 128; const int ix = ok[u] ? idx : 0;
      e[u] = p.eidx()[ix]; g_[u] = p.gates()[ix]; float a = 0.f;
#pragma unroll
      for (int s = 0; s < 8; ++s) a += bf2f(p.ppart()[(size_t)s * T * 128 + ix]);
      d[u] = a; }
#pragma unroll
    for (int u = 0; u < 4; ++u) { su_[u] = p.su()[e[u]]; sv_[u] = p.sv()[e[u]]; }
#pragma unroll
    for (int u = 0; u < 4; ++u) if (ok[u]) p.gates()[idx0 + u * ngt] = g_[u] * gelu_tanh(d[u] * p.rstd()[(idx0 + u * ngt) >> 7] / su_[u]) / sv_[u];
  }
}
__device__ __forceinline__ void phase_peer_v(const Params& p, int* heads, unsigned char* lds, int tid) {
  const int lane = tid & 63, wv = tid >> 6, r8 = lane >> 3, c8 = lane & 7;
  int* bc = (int*)lds;
  uint2* pW = (uint2*)(lds + 1024 + wv * 16384);
  const int myx = (int)xcc_id();
  for (int pass = 0; pass < 8; ++pass) {
    const int s = (myx + pass) & 7;
    const unsigned char* Vs = p.V8s() + (size_t)s * 16384 * 128 + c8 * 16;
    for (;;) {
      const int item = q_pull(heads + s, T / PEER_TILE, bc, tid);
      if (item < 0) break;
      const int t0 = item * PEER_TILE + wv * 16;
      LDS_FENCE();
      { uint2 e2[16], g2[16];
#pragma unroll
        for (int k = 0; k < 16; ++k) { e2[k] = *(const uint2*)(p.eidx() + (size_t)(t0 + k) * 128 + lane * 2); g2[k] = *(const uint2*)(p.gates() + (size_t)(t0 + k) * 128 + lane * 2); }
#pragma unroll
        for (int k = 0; k < 16; ++k) *(uint4*)(pW + k * 128 + lane * 2) = make_uint4(e2[k].x, g2[k].x, e2[k].y, g2[k].y); }
      LDS_FENCE();
      const int rowk = lane >> 4, prow = ((rowk & 1) << 1) | (rowk >> 1);
      const bool wr_lane = (lane & 8) == 0;
      const int xoff = s * 128 + c8 * 16 + prow * 4;
      float4 xo[8];
#pragma unroll
      for (int k = 0; k < 8; ++k) xo[k] = *(const float4*)(p.outp() + (size_t)(t0 + k) * D + xoff);
      uint4 R[3][8];
#define PEER_V_LOAD(M_, BUF_) { _Pragma("unroll") for (int eb = 0; eb < 8; ++eb) R[BUF_][eb] = *(const uint4*)(Vs + (size_t)pW[(M_) * 64 + eb * 8 + r8].x * 128); }
      if (!(PROBE_SKIP & 64)) { PEER_V_LOAD(0, 0) PEER_V_LOAD(1, 1) } else { _Pragma("unroll") for (int a_ = 0; a_ < 3; ++a_) _Pragma("unroll") for (int b_ = 0; b_ < 8; ++b_) R[a_][b_] = make_uint4(0u, 0u, 0u, 0u); }
      float acc[16];
#define PEER_V_HALF(M_, BUF_, HALF_)                                                           \
      {                                                                                                                                   \
        if (!(PROBE_SKIP & 64)) { if ((M_) + 2 < 32) PEER_V_LOAD((M_) + 2, ((BUF_) + 2) % 3) }                                              \
        if ((HALF_) == 0) { _Pragma("unroll") for (int z = 0; z < 16; ++z) acc[z] = 0.f; }                                                \
        if (!(PROBE_SKIP & 64)) _Pragma("unroll") for (int eb = 0; eb < 8; ++eb) {                                                        \
          const float c = __uint_as_float(pW[(M_) * 64 + eb * 8 + r8].y);                                                                 \
          const unsigned ww[4] = {R[BUF_][eb].x, R[BUF_][eb].y, R[BUF_][eb].z, R[BUF_][eb].w};                                            \
          _Pragma("unroll") for (int q4 = 0; q4 < 4; ++q4) {                                                                              \
            const auto f01 = __builtin_amdgcn_cvt_pk_f32_fp8((int)ww[q4], false); const auto f23 = __builtin_amdgcn_cvt_pk_f32_fp8((int)ww[q4], true); \
            acc[q4 * 4 + 0] = fmaf(c, f01[0], acc[q4 * 4 + 0]); acc[q4 * 4 + 1] = fmaf(c, f01[1], acc[q4 * 4 + 1]);                       \
            acc[q4 * 4 + 2] = fmaf(c, f23[0], acc[q4 * 4 + 2]); acc[q4 * 4 + 3] = fmaf(c, f23[1], acc[q4 * 4 + 3]);                       \
          }                                                                                                                               \
        }                                                                                                                                 \
        if ((HALF_) == 1) {                                                                                                               \
          _Pragma("unroll") for (int z = 0; z < 16; ++z) acc[z] = DPP_ADD(acc[z], 0x128);                                  \
          asm volatile("v_nop\n\tv_nop\n\tv_permlane16_swap_b32 %0, %8\n\tv_permlane16_swap_b32 %1, %9\n\tv_permlane16_swap_b32 %2, %10\n\tv_permlane16_swap_b32 %3, %11\n\t" \
                       "v_permlane16_swap_b32 %4, %12\n\tv_permlane16_swap_b32 %5, %13\n\tv_permlane16_swap_b32 %6, %14\n\tv_permlane16_swap_b32 %7, %15" \
            : "+v"(acc[0]), "+v"(acc[1]), "+v"(acc[2]), "+v"(acc[3]), "+v"(acc[4]), "+v"(acc[5]), "+v"(acc[6]), "+v"(acc[7]),                   \
              "+v"(acc[8]), "+v"(acc[9]), "+v"(acc[10]), "+v"(acc[11]), "+v"(acc[12]), "+v"(acc[13]), "+v"(acc[14]), "+v"(acc[15]));               \
          _Pragma("unroll") for (int z = 0; z < 8; ++z) acc[z] += acc[z + 8];            \
          asm volatile("v_nop\n\tv_nop\n\tv_permlane32_swap_b32 %0, %4\n\tv_permlane32_swap_b32 %1, %5\n\tv_permlane32_swap_b32 %2, %6\n\tv_permlane32_swap_b32 %3, %7" \
            : "+v"(acc[0]), "+v"(acc[1]), "+v"(acc[2]), "+v"(acc[3]), "+v"(acc[4]), "+v"(acc[5]), "+v"(acc[6]), "+v"(acc[7]));                   \
          float4 dl;                                                                                                                      \
          dl.x = acc[0] + acc[4]; dl.y = acc[1] + acc[5]; dl.z = acc[2] + acc[6]; dl.w = acc[3] + acc[7];     \
          const float4 xv = xo[((M_) >> 1) & 7];                                                                                          \
          if (((M_) >> 1) + 8 < 16) xo[((M_) >> 1) & 7] = *(const float4*)(p.outp() + (size_t)(t0 + ((M_) >> 1) + 8) * D + xoff);                  \
          const float4 xn = make_float4(xv.x + dl.x, xv.y + dl.y, xv.z + dl.z, xv.w + dl.w);                                              \
          float sq = 0.f;                                                                                                                 \
          if (wr_lane) {                                                                                                                  \
            *(float4*)(p.outp() + (size_t)(t0 + ((M_) >> 1)) * D + xoff) = xn;                                                             \
            *(uint2*)(p.xb() + (size_t)(t0 + ((M_) >> 1)) * KD + xoff) = make_uint2(pk_bf16(xn.x, xn.y), pk_bf16(xn.z, xn.w));     \
            sq = (xn.x * xn.x + xn.y * xn.y) + (xn.z * xn.z + xn.w * xn.w);                                                                \
          }                                                                                                                               \
          sq = DPP_ADD(sq, 0xB1); sq = DPP_ADD(sq, 0x4E); sq = DPP_ADD(sq, 0x141); sq = DPP_ADD(sq, 0x128); sq = sum_xor16(sq); sq = sum_xor32(sq);     \
          if (lane == 0) p.ssq1()[(size_t)(t0 + ((M_) >> 1)) * 8 + s] = sq;                                                               \
        }                                                                                                                                 \
      }
#pragma unroll
      for (int m6 = 0; m6 < 30; m6 += 6) {
        PEER_V_HALF(m6, 0, 0) PEER_V_HALF(m6 + 1, 1, 1) PEER_V_HALF(m6 + 2, 2, 0) PEER_V_HALF(m6 + 3, 0, 1) PEER_V_HALF(m6 + 4, 1, 0) PEER_V_HALF(m6 + 5, 2, 1)
      }
      PEER_V_HALF(30, 0, 0) PEER_V_HALF(31, 1, 1)
#undef PEER_V_HALF
#undef PEER_V_LOAD
    }
  }
}

#if PEER_CHECK
constexpr int CHK_N = 512;
__device__ __forceinline__ float* chk_x(const Params& p) { return (float*)(p.ws + WO_ybuf); }
__device__ __forceinline__ float* chk_m(const Params& p) { return (float*)(p.ws + WO_ybuf + (size_t)CHK_N * D * 4); }
__device__ __forceinline__ float* chk_g(const Params& p) { return (float*)(p.ws + WO_ybuf + (size_t)CHK_N * D * 4 + 4096); }
__device__ __forceinline__ void chk_save(const Params& p, int gtid, int ngt) {
  for (int i = gtid; i < CHK_N * D; i += ngt) chk_x(p)[i] = p.outp()[(size_t)(i / D) * 64 * D + (i % D)];
  for (int i = gtid; i < CHK_N * 128; i += ngt) chk_g(p)[i] = p.gates()[(size_t)(i / 128) * 64 * 128 + (i % 128)];
  if (gtid < 16) chk_m(p)[gtid] = 0.f;
}
__device__ __forceinline__ void chk_apply(const Params& p, int l, float* coef, int gw, int ngw, int lane) {
  const float* g2 = p.inp(16) + l * D;
  const float* U = p.inp(19) + (size_t)l * 16384 * D; const float* V = p.inp(20) + (size_t)l * 16384 * D;
  for (int i = gw; i < CHK_N; i += ngw) {
    const int t = i * 64;
    const float r = p.rstd()[t];
    float4 hv[4];
#pragma unroll
    for (int k = 0; k < 4; ++k) {
      float4 xv = *(const float4*)(chk_x(p) + (size_t)i * D + (lane + k * 64) * 4);
      float4 gv = *(const float4*)(g2 + (lane + k * 64) * 4);
      hv[k].x = xv.x * r * gv.x; hv[k].y = xv.y * r * gv.y; hv[k].z = xv.z * r * gv.z; hv[k].w = xv.w * r * gv.w;
    }
    LDS_FENCE();
    for (int j = 0; j < 128; ++j) {
      const int e = p.eidx()[(size_t)t * 128 + j];
      const float4* up = (const float4*)(U + (size_t)e * D);
      float dsum = 0.f;
#pragma unroll
      for (int k = 0; k < 4; ++k) { float4 uv = up[lane + k * 64]; dsum += hv[k].x * uv.x + hv[k].y * uv.y + hv[k].z * uv.z + hv[k].w * uv.w; }
      dsum = wave_sum(dsum);
      if (lane == 0) coef[j] = chk_g(p)[(size_t)i * 128 + j] * gelu_tanh(dsum);
    }
    LDS_FENCE();
    float4 acc[4];
#pragma unroll
    for (int k = 0; k < 4; ++k) acc[k] = make_float4(0.f, 0.f, 0.f, 0.f);
    for (int j = 0; j < 128; ++j) {
      const int e = p.eidx()[(size_t)t * 128 + j];
      const float c = coef[j];
      const float4* vp = (const float4*)(V + (size_t)e * D);
#pragma unroll
      for (int k = 0; k < 4; ++k) { float4 vv = vp[lane + k * 64]; acc[k].x = fmaf(c, vv.x, acc[k].x); acc[k].y = fmaf(c, vv.y, acc[k].y); acc[k].z = fmaf(c, vv.z, acc[k].z); acc[k].w = fmaf(c, vv.w, acc[k].w); }
    }
    float d2 = 0.f, r2 = 0.f;
#pragma unroll
    for (int k = 0; k < 4; ++k) {
      float4 xa = *(const float4*)(p.outp() + (size_t)t * D + (lane + k * 64) * 4);
      float4 xb4 = *(const float4*)(chk_x(p) + (size_t)i * D + (lane + k * 64) * 4);
      float e0 = (xa.x - xb4.x) - acc[k].x, e1 = (xa.y - xb4.y) - acc[k].y, e2 = (xa.z - xb4.z) - acc[k].z, e3 = (xa.w - xb4.w) - acc[k].w;
      d2 += e0 * e0 + e1 * e1 + e2 * e2 + e3 * e3;
      r2 += acc[k].x * acc[k].x + acc[k].y * acc[k].y + acc[k].z * acc[k].z + acc[k].w * acc[k].w;
    }
    d2 = wave_sum(d2); r2 = wave_sum(r2);
    if (lane == 0) { atomicAdd((unsigned long long*)&chk_m(p)[8], (unsigned long long)(d2 * 1099511627776.0f)); atomicAdd((unsigned long long*)&chk_m(p)[10], (unsigned long long)(r2 * 1099511627776.0f)); }
  }
}
__device__ __forceinline__ void chk_topk(const Params& p, int l, int gtid, int ngt) {
  const float* subk = p.inp(18) + (size_t)l * 16 * 128 * 64;
  for (int it = gtid; it < CHK_N * 8; it += ngt) {
    const int i = it >> 3, h = it & 7, t = i * 64;
    float tva[16], tvb[16]; int tia[16], tib[16];
#pragma unroll 1
    for (int c = 0; c < 2; ++c) {
      float tv[16]; int ti[16];
#pragma unroll
      for (int z = 0; z < 16; ++z) { tv[z] = -INFINITY; ti[z] = 0; }
      const bf16_t* q = p.qb() + (size_t)t * D + (2 * h + c) * 64;
      const float* kb = subk + (size_t)(2 * h + c) * 128 * 64;
#pragma unroll 1
      for (int n = 0; n < 128; ++n) {
        float sc = 0.f;
        for (int d = 0; d < 64; ++d) sc = fmaf(bf2f(q[d]), kb[n * 64 + d], sc);
        float v_ = sc; int i_ = n;
#pragma unroll
        for (int z = 0; z < 16; ++z) { bool gt = v_ > tv[z]; float a = tv[z]; int b = ti[z]; tv[z] = gt ? v_ : a; ti[z] = gt ? i_ : b; v_ = gt ? a : v_; i_ = gt ? b : i_; }
      }
#pragma unroll
      for (int z = 0; z < 16; ++z) { if (c == 0) { tva[z] = tv[z]; tia[z] = ti[z]; } else { tvb[z] = tv[z]; tib[z] = ti[z]; } }
    }
    float tv[16]; int ti[16];
#pragma unroll
    for (int z = 0; z < 16; ++z) { tv[z] = -INFINITY; ti[z] = 0; }
#pragma unroll 1
    for (int a = 0; a < 16; ++a)
#pragma unroll 1
      for (int b = 0; b < 16; ++b) {
        float av = 0.f, bv = 0.f; int ai = 0, bi = 0;
#pragma unroll
        for (int z = 0; z < 16; ++z) { if (z == a) { av = tva[z]; ai = tia[z]; } if (z == b) { bv = tvb[z]; bi = tib[z]; } }
        float v_ = av + bv; int i_ = ai * 128 + bi;
#pragma unroll
        for (int z = 0; z < 16; ++z) { bool gt = v_ > tv[z]; float x = tv[z]; int y = ti[z]; tv[z] = gt ? v_ : x; ti[z] = gt ? i_ : y; v_ = gt ? x : v_; i_ = gt ? y : i_; }
      }
    float sum = 0.f, ev[16];
#pragma unroll
    for (int z = 0; z < 16; ++z) { ev[z] = expf(tv[z] - tv[0]); sum += ev[z]; }
    int miss = 0; float gerr = 0.f;
    for (int z = 0; z < 16; ++z) {
      const int ef = p.eidx()[((size_t)t * 8 + h) * 16 + z]; const float gf = p.gates()[((size_t)t * 8 + h) * 16 + z];
      bool found = false;
#pragma unroll
      for (int y = 0; y < 16; ++y) if (ti[y] == ef) { found = true; gerr = fmaxf(gerr, fabsf(ev[y] / sum - gf)); }
      if (!found) ++miss;
    }
    atomicAdd(&chk_m(p)[3], (float)miss);
    atomicMax((int*)&chk_m(p)[4], __float_as_int(gerr));
  }
}
__device__ __forceinline__ void chk_emit(const Params& p) {
  float v = 0.f;
  if (PEER_CHECK == 1) v = sqrtf((float)((double)*(unsigned long long*)&chk_m(p)[8] / (double)*(unsigned long long*)&chk_m(p)[10]));
  if (PEER_CHECK == 2) v = chk_m(p)[3] / (float)(CHK_N * 8 * 16);
  if (PEER_CHECK == 3) v = chk_m(p)[4];
  p.outp()[0] += 1.0e4f * v + 100.0f;
}
#endif

#define XB_TMO      128
#define XB_XCNT(j)  (256  + 64 * (j))
#define XB_XSUB(j)  (1280 + 64 * (j))
#define XB_XGEN(j)  (2304 + 64 * (j))
#define XB_TOP      3328
#define XB_TOPGEN   3392
#define XCD_BAR_WORDS 3456
#define XB_SPIN_CAP (1u << 18)
#define LAS __attribute__((address_space(3)))

__device__ __forceinline__ unsigned xb_ld(unsigned* p)              { return __hip_atomic_load(p, __ATOMIC_RELAXED, __HIP_MEMORY_SCOPE_AGENT); }
__device__ __forceinline__ unsigned xb_add(unsigned* p, unsigned v) { return __hip_atomic_fetch_add(p, v, __ATOMIC_RELAXED, __HIP_MEMORY_SCOPE_AGENT); }
__device__ __forceinline__ unsigned xb_xcc_id() { return (unsigned)__builtin_amdgcn_s_getreg((3 << 11) | 20) & 0xFu; }
#define XB_SPIN(cond, bar) do { unsigned _sp = 0; while (cond) { __builtin_amdgcn_s_sleep(1); \
    if ((++_sp & 255u) == 0u) { if (xb_ld(&(bar)[XB_TMO])) break; if (_sp > XB_SPIN_CAP) { atomicAdd(&(bar)[XB_TMO], 1u); break; } } } } while (0)

struct XcdBarrier {
    unsigned* bar; unsigned x;
    volatile LAS unsigned* st;
};

__device__ __forceinline__ XcdBarrier xcd_barrier_post(unsigned* bar, volatile LAS unsigned* st) {
    XcdBarrier b; b.bar = bar; b.x = xb_xcc_id(); b.st = st;
    if (threadIdx.x == 0) (void)xb_add(&bar[XB_XCNT(b.x)], 1u);
    return b;
}
__device__ __forceinline__ void xcd_barrier_complete(unsigned* bar, unsigned x, unsigned& nloc, unsigned& nx) {
    const unsigned G = gridDim.x * gridDim.y * gridDim.z;
    unsigned sum, cnt, mine, sp = 0u;
    for (;;) {
        sum = 0u; cnt = 0u; mine = 0u;
#pragma unroll
        for (unsigned j = 0; j < 16; ++j) { const unsigned c = xb_ld(&bar[XB_XCNT(j)]); sum += c; cnt += (c > 0u) ? 1u : 0u; mine = (j == x) ? c : mine; }
        if (sum == G) break;
        __builtin_amdgcn_s_sleep(1);
        if ((++sp & 255u) == 0u) { if (xb_ld(&bar[XB_TMO])) break; if (sp > XB_SPIN_CAP) { atomicAdd(&bar[XB_TMO], 1u); break; } }
    }
    nloc = mine > 0u ? mine : 1u; nx = cnt > 0u ? cnt : 1u;
}

__device__ __forceinline__ void xcd_barrier(const XcdBarrier& b) {
    asm volatile("s_waitcnt vmcnt(0)" ::: "memory");
    __syncthreads();
    if (threadIdx.x == 0) {
        unsigned* bar = b.bar;
        __builtin_amdgcn_s_waitcnt(0);
        unsigned nloc = b.st[0], nx = b.st[1];
        if (nloc == 0u) { xcd_barrier_complete(bar, b.x, nloc, nx); b.st[0] = nloc; b.st[1] = nx; }
        const unsigned old = xb_add(&bar[XB_XSUB(b.x)], 1u);
        const unsigned gen = old / nloc;
        if (old + 1u == (gen + 1u) * nloc) {
            __builtin_amdgcn_fence(__ATOMIC_RELEASE, "agent");
            asm volatile("s_waitcnt vmcnt(0)" ::: "memory");
            const unsigned og = xb_add(&bar[XB_TOP], 1u);
            const unsigned tg = og / nx;
            if (og + 1u == (tg + 1u) * nx) xb_add(&bar[XB_TOPGEN], 1u);
            else XB_SPIN(xb_ld(&bar[XB_TOPGEN]) == tg, bar);
            __builtin_amdgcn_fence(__ATOMIC_ACQUIRE, "agent");
            xb_add(&bar[XB_XGEN(b.x)], 1u);
            asm volatile("s_waitcnt vmcnt(0)" ::: "memory");
        } else {
            XB_SPIN(xb_ld(&bar[XB_XGEN(b.x)]) == gen, bar);
            __builtin_amdgcn_fence(__ATOMIC_ACQUIRE, "agent");
            asm volatile("s_waitcnt vmcnt(0)" ::: "memory");
        }
    }
    __syncthreads();
}

__device__ __forceinline__ Params fresh(const Params& p) {
  Params q = p;
  asm volatile("" : "+s"(q.ws), "+s"(q.out_));
#pragma unroll
  for (int i = 0; i < 21; ++i) asm volatile("" : "+s"(q.in[i]));
  return q;
}
#define PHASE_IDS int tid = threadIdx.x; asm volatile("" : "+v"(tid)); int bid = blockIdx.x; asm volatile("" : "+s"(bid)); int G = gridDim.x; asm volatile("" : "+s"(G)); \
  const int lane = tid & 63, wv = tid >> 6; const int ngt = G * NTHR, ngw = G * NWAVE; \
  const int gtid = bid * NTHR + tid, gw = bid * NWAVE + wv; (void)lane; (void)wv; (void)gtid; (void)gw; (void)ngt; (void)ngw; \
  const Params q = fresh(p);
__global__ void __launch_bounds__(NTHR) mega(Params p) {
  extern __shared__ __attribute__((aligned(16))) unsigned char lds_raw[];
  cg::grid_group grid = cg::this_grid();
  float* ldsf = (float*)lds_raw;
  if (threadIdx.x == 0) { *(uint4*)(lds_raw + LDS_BYTES - 16) = make_uint4(0u, 0u, 0u, 0u); }
  __syncthreads();
  XcdBarrier xb = xcd_barrier_post(p.bar(), (volatile LAS unsigned*)(lds_raw + LDS_BYTES - 16));

  { PHASE_IDS; phase_prologue(q, gtid, ngt, gw, ngw, lane); cvt_f32_bf16(q.inp(18), q.skb(), (size_t)NL * 16 * 128 * 64 / 8, gtid, ngt);
    for (size_t i = gtid; i < (size_t)16 * 128 * 512 / 8; i += ngt) { const size_t g = i / (128 * 512 / 8), r = i % (128 * 512 / 8); ((uint4*)q.S5Wz())[g * (256 * 512 / 8) + (128 * 512 / 8) + r] = make_uint4(0u, 0u, 0u, 0u); }
    if (gtid < 256) q.qctr()[gtid] = 0;
    phase_s5_prep(q, 0, gtid, ngt); }
  grid.sync();
  { constexpr int l = 0;
    DUP(5) {
    { const Params q = fresh(p);
      EpiInProj e{q.ssq1(), q.S5A(), q.Qm(), q.Km(), q.vrow(), q.Qr(), q.Kr(), q.krow(), q.vrrow(), q.grow(),
                  q.inp(12) + l * 64, q.inp(13) + l * 64, q.cosm(), q.sinm(), q.cosr(), q.sinr()};
      run_gemm(lds_raw, q.xb(), q.Win_t() + (size_t)l * INW * KD, T, INW, KD, e); }
    xcd_barrier(xb);
    }
    DUP(1) {
    { PHASE_IDS; phase_post_pack(q, gtid, ngt); }
    { const Params q = fresh(p); EpiS5Z e{q.S5Z()};
      pg8::Gemm g{q.S5A(), q.S5Wz(), 16 * 1024, 16 * 256, 512, 640, 512}; pg8::GroupOrder So; So.init(16, 4, 1, (int)gridDim.x, (int)blockIdx.x);
      pg8::gemm_phase<EpiS5Z, pg8::GroupOrder, true, true>((PG8_LAS unsigned char*)lds_raw, g, So, e); }
    { PHASE_IDS; phase_kmean2(q, gtid, ngt); }
    xcd_barrier(xb);
    }
    DUP(2) {
    { PHASE_IDS; phase_s5_scan(q, gtid, ngt); phase_ret_kv(q, gw, ngw, lane); }
    __syncthreads();
    { PHASE_IDS; phase_moba2(q, l, lds_raw, q.qctr() + 64 + l); }
    xcd_barrier(xb);
    }
    DUP(3) {
    { const Params q = fresh(p); EpiS5Y e{q.ygb(), q.S5A(), q.inp(10) + l * 256};
      pg8::Gemm g{q.S5A(), q.S5Wy(), 16 * 1024, 16 * 512, 640, 640, 640}; pg8::GroupOrder So; So.init(16, 4, 2, (int)gridDim.x, (int)blockIdx.x);
      pg8::gemm_phase<EpiS5Y, pg8::GroupOrder, true, true>((PG8_LAS unsigned char*)lds_raw, g, So, e); }
    { PHASE_IDS; phase_ret_scan(q, gtid, ngt); }
    xcd_barrier(xb);
    }
    DUP(4) {
    { const Params q = fresh(p); EpiGlu e{q.xb(), q.ygb(), (float*)(lds_raw + 131072)};
      run_gemm(lds_raw, q.ygb(), q.Wglu_t() + (size_t)l * 65536, T, 256, 256, e); }
    { PHASE_IDS; phase_ret_out(q, gw, ngw, lane); }
    xcd_barrier(xb);
    }
    { PHASE_IDS; cvt_table_i8(q.inp(19) + (size_t)l * 16384 * D, q.U8s(), q.su(), gw, ngw, lane);
      cvt_table_fp8(q.inp(20) + (size_t)l * 16384 * D, q.V8s(), q.sv(), gw, ngw, lane); }
    __syncthreads();
    { const Params q = fresh(p); EpiResid e{q.outp(), D, q.xb2(), q.hb(), q.inp(16) + l * D, q.ssq2()};
      run_gemm(lds_raw, q.xb(), q.Wout_t() + (size_t)l * D * KD, T, D, KD, e); }
    xcd_barrier(xb);
    DUP(7) {
    { const Params q = fresh(p); EpiScaleStoreBf16 e{q.qb(), D, q.ssq2(), 16, q.rstd()};
      run_gemm(lds_raw, q.xb2(), q.Wq_t() + (size_t)l * D * KD, T, D, KD, e); }
    xcd_barrier(xb);
    }
    if (!(PROBE_SKIP & 2)) {
    DUP(8) {
    { PHASE_IDS; phase_peer_topk(q, l, gw, ngw, lane); }
    xcd_barrier(xb);
    }
    }
#if PEER_CHECK
    if (l == 0) { { PHASE_IDS; chk_save(q, gtid, ngt); } xcd_barrier(xb); { PHASE_IDS; chk_topk(q, l, gtid, ngt); } xcd_barrier(xb); }
#endif
    if (!(PROBE_SKIP & 1)) {
    { PHASE_IDS; phase_peer_u(q, q.qctr() + (l * 2 + 0) * 8, lds_raw, tid); }
    xcd_barrier(xb);
    { PHASE_IDS; phase_peer_r(q, gtid, ngt); if (l + 1 < NL) phase_s5_prep(q, l + 1, gtid, ngt); }
    xcd_barrier(xb);
    if (!(PROBE_SKIP & 32)) {
    { PHASE_IDS; phase_peer_v(q, q.qctr() + (l * 2 + 1) * 8, lds_raw, tid); }
    xcd_barrier(xb);
    }
    }
#if PEER_CHECK
    if (l == 0) { { PHASE_IDS; chk_apply(q, l, ldsf + wv * 128, gw, ngw, lane); } xcd_barrier(xb);
      if (blockIdx.x == 0 && threadIdx.x == 0) { const Params q = fresh(p); chk_emit(q); } xcd_barrier(xb); }
#endif
  }
  { constexpr int l = 1;
    DUP(5) {
    { const Params q = fresh(p);
      EpiInProj e{q.ssq1(), q.S5A(), q.Qm(), q.Km(), q.vrow(), q.Qr(), q.Kr(), q.krow(), q.vrrow(), q.grow(),
                  q.inp(12) + l * 64, q.inp(13) + l * 64, q.cosm(), q.sinm(), q.cosr(), q.sinr()};
      run_gemm(lds_raw, q.xb(), q.Win_t() + (size_t)l * INW * KD, T, INW, KD, e); }
    xcd_barrier(xb);
    }
    DUP(1) {
    { PHASE_IDS; phase_post_pack(q, gtid, ngt); }
    { const Params q = fresh(p); EpiS5Z e{q.S5Z()};
      pg8::Gemm g{q.S5A(), q.S5Wz(), 16 * 1024, 16 * 256, 512, 640, 512}; pg8::GroupOrder So; So.init(16, 4, 1, (int)gridDim.x, (int)blockIdx.x);
      pg8::gemm_phase<EpiS5Z, pg8::GroupOrder, true, true>((PG8_LAS unsigned char*)lds_raw, g, So, e); }
    { PHASE_IDS; phase_kmean2(q, gtid, ngt); }
    xcd_barrier(xb);
    }
    DUP(2) {
    { PHASE_IDS; phase_s5_scan(q, gtid, ngt); phase_ret_kv(q, gw, ngw, lane); }
    __syncthreads();
    { PHASE_IDS; phase_moba2(q, l, lds_raw, q.qctr() + 64 + l); }
    xcd_barrier(xb);
    }
    DUP(3) {
    { const Params q = fresh(p); EpiS5Y e{q.ygb(), q.S5A(), q.inp(10) + l * 256};
      pg8::Gemm g{q.S5A(), q.S5Wy(), 16 * 1024, 16 * 512, 640, 640, 640}; pg8::GroupOrder So; So.init(16, 4, 2, (int)gridDim.x, (int)blockIdx.x);
      pg8::gemm_phase<EpiS5Y, pg8::GroupOrder, true, true>((PG8_LAS unsigned char*)lds_raw, g, So, e); }
    { PHASE_IDS; phase_ret_scan(q, gtid, ngt); }
    xcd_barrier(xb);
    }
    DUP(4) {
    { const Params q = fresh(p); EpiGlu e{q.xb(), q.ygb(), (float*)(lds_raw + 131072)};
      run_gemm(lds_raw, q.ygb(), q.Wglu_t() + (size_t)l * 65536, T, 256, 256, e); }
    { PHASE_IDS; phase_ret_out(q, gw, ngw, lane); }
    xcd_barrier(xb);
    }
    { PHASE_IDS; cvt_table_i8(q.inp(19) + (size_t)l * 16384 * D, q.U8s(), q.su(), gw, ngw, lane);
      cvt_table_fp8(q.inp(20) + (size_t)l * 16384 * D, q.V8s(), q.sv(), gw, ngw, lane); }
    __syncthreads();
    { const Params q = fresh(p); EpiResid e{q.outp(), D, q.xb2(), q.hb(), q.inp(16) + l * D, q.ssq2()};
      run_gemm(lds_raw, q.xb(), q.Wout_t() + (size_t)l * D * KD, T, D, KD, e); }
    xcd_barrier(xb);
    DUP(7) {
    { const Params q = fresh(p); EpiScaleStoreBf16 e{q.qb(), D, q.ssq2(), 16, q.rstd()};
      run_gemm(lds_raw, q.xb2(), q.Wq_t() + (size_t)l * D * KD, T, D, KD, e); }
    xcd_barrier(xb);
    }
    if (!(PROBE_SKIP & 2)) {
    DUP(8) {
    { PHASE_IDS; phase_peer_topk(q, l, gw, ngw, lane); }
    xcd_barrier(xb);
    }
    }
#if PEER_CHECK
    if (l == 0) { { PHASE_IDS; chk_save(q, gtid, ngt); } xcd_barrier(xb); { PHASE_IDS; chk_topk(q, l, gtid, ngt); } xcd_barrier(xb); }
#endif
    if (!(PROBE_SKIP & 1)) {
    { PHASE_IDS; phase_peer_u(q, q.qctr() + (l * 2 + 0) * 8, lds_raw, tid); }
    xcd_barrier(xb);
    { PHASE_IDS; phase_peer_r(q, gtid, ngt); if (l + 1 < NL) phase_s5_prep(q, l + 1, gtid, ngt); }
    xcd_barrier(xb);
    if (!(PROBE_SKIP & 32)) {
    { PHASE_IDS; phase_peer_v(q, q.qctr() + (l * 2 + 1) * 8, lds_raw, tid); }
    xcd_barrier(xb);
    }
    }
#if PEER_CHECK
    if (l == 0) { { PHASE_IDS; chk_apply(q, l, ldsf + wv * 128, gw, ngw, lane); } xcd_barrier(xb);
      if (blockIdx.x == 0 && threadIdx.x == 0) { const Params q = fresh(p); chk_emit(q); } xcd_barrier(xb); }
#endif
  }
  { constexpr int l = 2;
    DUP(5) {
    { const Params q = fresh(p);
      EpiInProj e{q.ssq1(), q.S5A(), q.Qm(), q.Km(), q.vrow(), q.Qr(), q.Kr(), q.krow(), q.vrrow(), q.grow(),
                  q.inp(12) + l * 64, q.inp(13) + l * 64, q.cosm(), q.sinm(), q.cosr(), q.sinr()};
      run_gemm(lds_raw, q.xb(), q.Win_t() + (size_t)l * INW * KD, T, INW, KD, e); }
    xcd_barrier(xb);
    }
    DUP(1) {
    { PHASE_IDS; phase_post_pack(q, gtid, ngt); }
    { const Params q = fresh(p); EpiS5Z e{q.S5Z()};
      pg8::Gemm g{q.S5A(), q.S5Wz(), 16 * 1024, 16 * 256, 512, 640, 512}; pg8::GroupOrder So; So.init(16, 4, 1, (int)gridDim.x, (int)blockIdx.x);
      pg8::gemm_phase<EpiS5Z, pg8::GroupOrder, true, true>((PG8_LAS unsigned char*)lds_raw, g, So, e); }
    { PHASE_IDS; phase_kmean2(q, gtid, ngt); }
    xcd_barrier(xb);
    }
    DUP(2) {
    { PHASE_IDS; phase_s5_scan(q, gtid, ngt); phase_ret_kv(q, gw, ngw, lane); }
    __syncthreads();
    { PHASE_IDS; phase_moba2(q, l, lds_raw, q.qctr() + 64 + l); }
    xcd_barrier(xb);
    }
    DUP(3) {
    { const Params q = fresh(p); EpiS5Y e{q.ygb(), q.S5A(), q.inp(10) + l * 256};
      pg8::Gemm g{q.S5A(), q.S5Wy(), 16 * 1024, 16 * 512, 640, 640, 640}; pg8::GroupOrder So; So.init(16, 4, 2, (int)gridDim.x, (int)blockIdx.x);
      pg8::gemm_phase<EpiS5Y, pg8::GroupOrder, true, true>((PG8_LAS unsigned char*)lds_raw, g, So, e); }
    { PHASE_IDS; phase_ret_scan(q, gtid, ngt); }
    xcd_barrier(xb);
    }
    DUP(4) {
    { const Params q = fresh(p); EpiGlu e{q.xb(), q.ygb(), (float*)(lds_raw + 131072)};
      run_gemm(lds_raw, q.ygb(), q.Wglu_t() + (size_t)l * 65536, T, 256, 256, e); }
    { PHASE_IDS; phase_ret_out(q, gw, ngw, lane); }
    xcd_barrier(xb);
    }
    { PHASE_IDS; cvt_table_i8(q.inp(19) + (size_t)l * 16384 * D, q.U8s(), q.su(), gw, ngw, lane);
      cvt_table_fp8(q.inp(20) + (size_t)l * 16384 * D, q.V8s(), q.sv(), gw, ngw, lane); }
    __syncthreads();
    { const Params q = fresh(p); EpiResid e{q.outp(), D, q.xb2(), q.hb(), q.inp(16) + l * D, q.ssq2()};
      run_gemm(lds_raw, q.xb(), q.Wout_t() + (size_t)l * D * KD, T, D, KD, e); }
    xcd_barrier(xb);
    DUP(7) {
    { const Params q = fresh(p); EpiScaleStoreBf16 e{q.qb(), D, q.ssq2(), 16, q.rstd()};
      run_gemm(lds_raw, q.xb2(), q.Wq_t() + (size_t)l * D * KD, T, D, KD, e); }
    xcd_barrier(xb);
    }
    if (!(PROBE_SKIP & 2)) {
    DUP(8) {
    { PHASE_IDS; phase_peer_topk(q, l, gw, ngw, lane); }
    xcd_barrier(xb);
    }
    }
#if PEER_CHECK
    if (l == 0) { { PHASE_IDS; chk_save(q, gtid, ngt); } xcd_barrier(xb); { PHASE_IDS; chk_topk(q, l, gtid, ngt); } xcd_barrier(xb); }
#endif
    if (!(PROBE_SKIP & 1)) {
    { PHASE_IDS; phase_peer_u(q, q.qctr() + (l * 2 + 0) * 8, lds_raw, tid); }
    xcd_barrier(xb);
    { PHASE_IDS; phase_peer_r(q, gtid, ngt); if (l + 1 < NL) phase_s5_prep(q, l + 1, gtid, ngt); }
    xcd_barrier(xb);
    if (!(PROBE_SKIP & 32)) {
    { PHASE_IDS; phase_peer_v(q, q.qctr() + (l * 2 + 1) * 8, lds_raw, tid); }
    xcd_barrier(xb);
    }
    }
#if PEER_CHECK
    if (l == 0) { { PHASE_IDS; chk_apply(q, l, ldsf + wv * 128, gw, ngw, lane); } xcd_barrier(xb);
      if (blockIdx.x == 0 && threadIdx.x == 0) { const Params q = fresh(p); chk_emit(q); } xcd_barrier(xb); }
#endif
  }
  { constexpr int l = 3;
    DUP(5) {
    { const Params q = fresh(p);
      EpiInProj e{q.ssq1(), q.S5A(), q.Qm(), q.Km(), q.vrow(), q.Qr(), q.Kr(), q.krow(), q.vrrow(), q.grow(),
                  q.inp(12) + l * 64, q.inp(13) + l * 64, q.cosm(), q.sinm(), q.cosr(), q.sinr()};
      run_gemm(lds_raw, q.xb(), q.Win_t() + (size_t)l * INW * KD, T, INW, KD, e); }
    xcd_barrier(xb);
    }
    DUP(1) {
    { PHASE_IDS; phase_post_pack(q, gtid, ngt); }
    { const Params q = fresh(p); EpiS5Z e{q.S5Z()};
      pg8::Gemm g{q.S5A(), q.S5Wz(), 16 * 1024, 16 * 256, 512, 640, 512}; pg8::GroupOrder So; So.init(16, 4, 1, (int)gridDim.x, (int)blockIdx.x);
      pg8::gemm_phase<EpiS5Z, pg8::GroupOrder, true, true>((PG8_LAS unsigned char*)lds_raw, g, So, e); }
    { PHASE_IDS; phase_kmean2(q, gtid, ngt); }
    xcd_barrier(xb);
    }
    DUP(2) {
    { PHASE_IDS; phase_s5_scan(q, gtid, ngt); phase_ret_kv(q, gw, ngw, lane); }
    __syncthreads();
    { PHASE_IDS; phase_moba2(q, l, lds_raw, q.qctr() + 64 + l); }
    xcd_barrier(xb);
    }
    DUP(3) {
    { const Params q = fresh(p); EpiS5Y e{q.ygb(), q.S5A(), q.inp(10) + l * 256};
      pg8::Gemm g{q.S5A(), q.S5Wy(), 16 * 1024, 16 * 512, 640, 640, 640}; pg8::GroupOrder So; So.init(16, 4, 2, (int)gridDim.x, (int)blockIdx.x);
      pg8::gemm_phase<EpiS5Y, pg8::GroupOrder, true, true>((PG8_LAS unsigned char*)lds_raw, g, So, e); }
    { PHASE_IDS; phase_ret_scan(q, gtid, ngt); }
    xcd_barrier(xb);
    }
    DUP(4) {
    { const Params q = fresh(p); EpiGlu e{q.xb(), q.ygb(), (float*)(lds_raw + 131072)};
      run_gemm(lds_raw, q.ygb(), q.Wglu_t() + (size_t)l * 65536, T, 256, 256, e); }
    { PHASE_IDS; phase_ret_out(q, gw, ngw, lane); }
    xcd_barrier(xb);
    }
    { PHASE_IDS; cvt_table_i8(q.inp(19) + (size_t)l * 16384 * D, q.U8s(), q.su(), gw, ngw, lane);
      cvt_table_fp8(q.inp(20) + (size_t)l * 16384 * D, q.V8s(), q.sv(), gw, ngw, lane); }
    __syncthreads();
    { const Params q = fresh(p); EpiResid e{q.outp(), D, q.xb2(), q.hb(), q.inp(16) + l * D, q.ssq2()};
      run_gemm(lds_raw, q.xb(), q.Wout_t() + (size_t)l * D * KD, T, D, KD, e); }
    xcd_barrier(xb);
    DUP(7) {
    { const Params q = fresh(p); EpiScaleStoreBf16 e{q.qb(), D, q.ssq2(), 16, q.rstd()};
      run_gemm(lds_raw, q.xb2(), q.Wq_t() + (size_t)l * D * KD, T, D, KD, e); }
    xcd_barrier(xb);
    }
    if (!(PROBE_SKIP & 2)) {
    DUP(8) {
    { PHASE_IDS; phase_peer_topk(q, l, gw, ngw, lane); }
    xcd_barrier(xb);
    }
    }
#if PEER_CHECK
    if (l == 0) { { PHASE_IDS; chk_save(q, gtid, ngt); } xcd_barrier(xb); { PHASE_IDS; chk_topk(q, l, gtid, ngt); } xcd_barrier(xb); }
#endif
    if (!(PROBE_SKIP & 1)) {
    { PHASE_IDS; phase_peer_u(q, q.qctr() + (l * 2 + 0) * 8, lds_raw, tid); }
    xcd_barrier(xb);
    { PHASE_IDS; phase_peer_r(q, gtid, ngt); if (l + 1 < NL) phase_s5_prep(q, l + 1, gtid, ngt); }
    xcd_barrier(xb);
    if (!(PROBE_SKIP & 32)) {
    { PHASE_IDS; phase_peer_v(q, q.qctr() + (l * 2 + 1) * 8, lds_raw, tid); }
    xcd_barrier(xb);
    }
    }
#if PEER_CHECK
    if (l == 0) { { PHASE_IDS; chk_apply(q, l, ldsf + wv * 128, gw, ngw, lane); } xcd_barrier(xb);
      if (blockIdx.x == 0 && threadIdx.x == 0) { const Params q = fresh(p); chk_emit(q); } xcd_barrier(xb); }
#endif
  }
}

}

extern "C" void kernel_launch(void* const* d_in, const int* in_sizes, int n_in, void* d_out, int out_size, void* d_ws, size_t ws_size,
                              hipStream_t stream) {
  static int grid_blocks = 0;
  if (!grid_blocks) {
    int dev = 0, cus = 0, per_cu = 0;
    hipGetDevice(&dev);
    hipDeviceGetAttribute(&cus, hipDeviceAttributeMultiprocessorCount, dev);
    hipFuncSetAttribute((const void*)mega, hipFuncAttributeMaxDynamicSharedMemorySize, LDS_BYTES);
    hipOccupancyMaxActiveBlocksPerMultiprocessor(&per_cu, (const void*)mega, NTHR, LDS_BYTES);
    if (per_cu < 1) { fprintf(stderr, "occupancy query returned %d\n", per_cu); per_cu = 1; }
    grid_blocks = cus * 1;
    if (grid_blocks < 64) fprintf(stderr, "unexpected CU count %d\n", cus);
  }
  Params p{};
  for (int i = 0; i < 21; ++i) p.in[i] = (const GAS float*)d_in[i];
  p.out_ = (GAS float*)d_out;
  p.ws = (GAS unsigned char*)d_ws;
  if (WS_TOTAL > ws_size) { fprintf(stderr, "workspace too small: need %zu have %zu\n", (size_t)WS_TOTAL, ws_size); return; }
  hipMemsetAsync((unsigned char*)d_ws + WO_bar, 0, 16384, stream);
  void* args[] = {&p};
  hipError_t e = hipLaunchCooperativeKernel((const void*)mega, dim3(grid_blocks), dim3(NTHR), args, LDS_BYTES, stream);
  if (e != hipSuccess) fprintf(stderr, "cooperative launch failed: %s (grid %d)\n", hipGetErrorString(e), grid_blocks);
}
```

```cpp
#include <hip/hip_runtime.h>
#include <hip/hip_cooperative_groups.h>
#include <math.h>
#include <stdint.h>
#include <stdio.h>
namespace cg = cooperative_groups;

#ifndef PEER_CHECK
#define PEER_CHECK 0
#endif
#ifndef PROBE_DUP
#define PROBE_DUP 0
#endif
__device__ __forceinline__ int dup_n(int n) { asm volatile("" : "+s"(n)); return n; }
#define DUP(bit) _Pragma("unroll 1") for (int rep_ = 0, repn_ = (((PROBE_DUP >> (bit)) & 1) ? dup_n(2) : 1); rep_ < repn_; ++rep_)
#ifndef PROBE_SKIP
#define PROBE_SKIP 0
#endif
#ifndef PRECISE
#define PRECISE 0
#endif

namespace {
constexpr int NB = 8, S = 4096, D = 1024, NL = 4, T = NB * S;
constexpr int INW = 2816;
constexpr float EPS = 1e-6f;
static_assert(PRECISE == 0, "PRECISE builds are retired");
constexpr int KS = PRECISE ? 3 : 1;
constexpr int KD = D * KS;
constexpr int NTHR = 512, NWAVE = 8;
constexpr int LDS_BYTES = 131072 + 4096 + 1024;

typedef unsigned short bf16_t;
using bf16x8 = __attribute__((ext_vector_type(8))) short;
using f32x4 = __attribute__((ext_vector_type(4))) float;

__device__ __forceinline__ float wave_sum(float v) {
#pragma unroll
  for (int o = 32; o > 0; o >>= 1) v += __shfl_xor(v, o);
  return v;
}
__device__ __forceinline__ float wave_max(float v) {
#pragma unroll
  for (int o = 32; o > 0; o >>= 1) v = fmaxf(v, __shfl_xor(v, o));
  return v;
}
__device__ __forceinline__ int q_pull(int* head, int nitems, int* bc, int tid) {
  __syncthreads();
  if (tid == 0) bc[0] = atomicAdd(head, 1);
  __syncthreads();
  const int v = bc[0];
  return v < nitems ? v : -1;
}
constexpr float QSCALE = 0.125f * 1.4426950408889634f;
__device__ __forceinline__ float ret_log2g(int h) { return log2f(1.0f - exp2f(-5.0f - (float)h)); }
__device__ __forceinline__ float gelu_tanh(float x) {
  const float k0 = 0.7978845608028654f, k1 = 0.044715f;
  float u = k0 * (x + k1 * x * x * x);
  return 0.5f * x * (1.0f + tanhf(u));
}
__device__ __forceinline__ float sigmoidf_(float x) { return 1.0f / (1.0f + expf(-x)); }
__device__ __forceinline__ float fast_sigmoid(float x) { return __builtin_amdgcn_rcpf(1.0f + __builtin_amdgcn_exp2f(-1.4426950408889634f * x)); }
__device__ __forceinline__ float fast_gelu(float x) { const float u = 0.7978845608028654f * (x + 0.044715f * x * x * x); return x * fast_sigmoid(2.0f * u); }
__device__ __forceinline__ bf16_t f2bf(float f) {
  unsigned u = __float_as_uint(f);
  u += 0x7fffu + ((u >> 16) & 1u);
  return (bf16_t)(u >> 16);
}
__device__ __forceinline__ float bf2f(bf16_t h) { return __uint_as_float(((unsigned)h) << 16); }
#define LDS_FENCE() asm volatile("s_waitcnt lgkmcnt(0)" ::: "memory")
typedef __bf16 bf16x2_hw __attribute__((ext_vector_type(2)));
typedef float f32x2_hw __attribute__((ext_vector_type(2)));
__device__ __forceinline__ unsigned pk_bf16(float lo, float hi) { const f32x2_hw f = {lo, hi}; const bf16x2_hw b = __builtin_convertvector(f, bf16x2_hw); return __builtin_bit_cast(unsigned, b); }
typedef float f32x16 __attribute__((ext_vector_type(16)));

constexpr size_t al256(size_t x) { return (x + 255) & ~(size_t)255; }
constexpr size_t WO_rstd = 0;
constexpr size_t WO_cosm = WO_rstd + al256((size_t)T * 4);
constexpr size_t WO_sinm = WO_cosm + al256((size_t)S * 8 * 4);
constexpr size_t WO_cosr = WO_sinm + al256((size_t)S * 8 * 4);
constexpr size_t WO_sinr = WO_cosr + al256((size_t)S * 32 * 4);
constexpr size_t WO_kmean = WO_sinr + al256((size_t)S * 32 * 4);
constexpr size_t WO_proj = WO_kmean + al256((size_t)NB * 8 * 16 * 64 * 4);
constexpr size_t WO_ybuf = WO_proj + al256((size_t)T * INW * 4);
constexpr size_t WO_yg = WO_ybuf + al256((size_t)T * D * 4);
constexpr size_t WO_skb = WO_yg + al256((size_t)T * 256 * 4);
constexpr size_t WO_Ub = WO_skb + al256((size_t)NL * 16 * 128 * 64 * 2);
constexpr size_t WO_Vb = WO_Ub + al256((size_t)16384 * D * 2);
constexpr size_t WO_gates = WO_Vb + al256((size_t)16384 * D * 2);
constexpr size_t WO_eidx = WO_gates + al256((size_t)T * 128 * 4);
constexpr size_t WO_xb = WO_eidx + al256((size_t)T * 128 * 4);
constexpr size_t WO_Win_t = WO_xb + al256((size_t)T * KD * 2);
constexpr size_t WO_Wout_t = WO_Win_t + al256((size_t)NL * INW * KD * 2);
constexpr size_t WO_Wq_t = WO_Wout_t + al256((size_t)NL * D * KD * 2);
constexpr size_t WO_Qm = WO_Wq_t + al256((size_t)NL * D * KD * 2);
constexpr size_t WO_Km = WO_Qm + al256((size_t)T * 512 * 2);
constexpr size_t WO_Vm = WO_Km + al256((size_t)T * 512 * 2);
constexpr size_t WO_S5a32 = WO_Vm + al256((size_t)T * 512 * 2);
constexpr size_t WO_Wglu_t = WO_S5a32 + al256((size_t)16 * 64 * 2 * 4);
constexpr size_t WO_Qr = WO_Wglu_t + al256((size_t)NL * 256 * 256 * 2);
constexpr size_t WO_Kr = WO_Qr + al256((size_t)T * 256 * 2);
constexpr size_t WO_Krv = WO_Kr + al256((size_t)T * 256 * 2);
constexpr size_t WO_Vr = WO_Krv + al256((size_t)T * 256 * 2);
constexpr size_t WO_KVr = WO_Vr + al256((size_t)T * 256 * 2);
constexpr size_t WO_Rb = WO_KVr + al256((size_t)32 * 32 * 4096 * 4);
constexpr size_t WO_qctr = WO_Rb + al256((size_t)32 * 32 * 4096 * 2);
constexpr size_t WO_bar = WO_qctr + al256(1024);
constexpr size_t WO_S5Wy = WO_bar + al256(16384);
constexpr size_t WO_S5Wz = WO_S5Wy + al256((size_t)16 * 512 * 640 * 2);
constexpr size_t WO_ssq1 = WO_S5Wz + al256((size_t)16 * 256 * 512 * 2);
constexpr size_t WO_ssq2 = WO_ssq1 + al256((size_t)T * 8 * 4);
constexpr size_t WS_TOTAL = WO_ssq2 + al256((size_t)T * 16 * 4);
constexpr size_t WO_S5A = WO_gates;
constexpr size_t WO_S5Z = WO_S5A + al256((size_t)16 * 1024 * 640 * 2);
static_assert(WO_S5Z + (size_t)16 * 1024 * 128 * 4 <= WO_gates + 2 * al256((size_t)T * 128 * 4), "S5A/S5Z must fit in gates+eidx");
#define GAS __attribute__((address_space(1)))
static_assert((size_t)T * D * 2 + (size_t)T * 128 * 8 * 4 + (size_t)T * D * 2 <= (size_t)T * INW * 4, "qb + ppart + xb2 must fit in the proj region");
struct Params {
  const GAS float* in[21];
  GAS float* out_;
  GAS unsigned char* ws;
  __device__ __forceinline__ const float* inp(int i) const { return (const float*)in[i]; }
  __device__ __forceinline__ float* outp() const { return (float*)out_; }
  __device__ __forceinline__ float* rstd() const { return (float*)(ws + WO_rstd); }
  __device__ __forceinline__ float* cosm() const { return (float*)(ws + WO_cosm); }
  __device__ __forceinline__ float* sinm() const { return (float*)(ws + WO_sinm); }
  __device__ __forceinline__ float* cosr() const { return (float*)(ws + WO_cosr); }
  __device__ __forceinline__ float* sinr() const { return (float*)(ws + WO_sinr); }
  __device__ __forceinline__ float* kmean() const { return (float*)(ws + WO_kmean); }
  __device__ __forceinline__ float* proj() const { return (float*)(ws + WO_proj); }
  __device__ __forceinline__ float* ybuf() const { return (float*)(ws + WO_ybuf); }
  __device__ __forceinline__ float* yg() const { return (float*)(ws + WO_yg); }
  __device__ __forceinline__ bf16_t* skb() const { return (bf16_t*)(ws + WO_skb); }
  __device__ __forceinline__ bf16_t* Ub() const { return (bf16_t*)(ws + WO_Ub); }
  __device__ __forceinline__ bf16_t* Vb() const { return (bf16_t*)(ws + WO_Vb); }
  __device__ __forceinline__ float* gates() const { return (float*)(ws + WO_gates); }
  __device__ __forceinline__ int* eidx() const { return (int*)(ws + WO_eidx); }
  __device__ __forceinline__ bf16_t* xb() const { return (bf16_t*)(ws + WO_xb); }
  __device__ __forceinline__ bf16_t* Win_t() const { return (bf16_t*)(ws + WO_Win_t); }
  __device__ __forceinline__ bf16_t* Wout_t() const { return (bf16_t*)(ws + WO_Wout_t); }
  __device__ __forceinline__ bf16_t* Wq_t() const { return (bf16_t*)(ws + WO_Wq_t); }
  __device__ __forceinline__ bf16_t* Qm() const { return (bf16_t*)(ws + WO_Qm); }
  __device__ __forceinline__ bf16_t* Km() const { return (bf16_t*)(ws + WO_Km); }
  __device__ __forceinline__ bf16_t* Vm() const { return (bf16_t*)(ws + WO_Vm); }
  __device__ __forceinline__ bf16_t* S5A() const { return (bf16_t*)(ws + WO_S5A); }
  __device__ __forceinline__ bf16_t* S5Wy() const { return (bf16_t*)(ws + WO_S5Wy); }
  __device__ __forceinline__ bf16_t* S5Wz() const { return (bf16_t*)(ws + WO_S5Wz); }
  __device__ __forceinline__ float* S5Z() const { return (float*)(ws + WO_S5Z); }
  __device__ __forceinline__ float* S5a32() const { return (float*)(ws + WO_S5a32); }
  __device__ __forceinline__ bf16_t* Wglu_t() const { return (bf16_t*)(ws + WO_Wglu_t); }
  __device__ __forceinline__ bf16_t* ygb() const { return (bf16_t*)(ws + WO_yg); }
  __device__ __forceinline__ int* qctr() const { return (int*)(ws + WO_qctr); }
  __device__ __forceinline__ unsigned char* U8s() const { return (unsigned char*)(ws + WO_Ub); }
  __device__ __forceinline__ float* su() const { return (float*)(ws + WO_Ub + (size_t)16384 * D); }
  __device__ __forceinline__ unsigned char* V8s() const { return (unsigned char*)(ws + WO_Vb); }
  __device__ __forceinline__ float* sv() const { return (float*)(ws + WO_Vb + (size_t)16384 * D); }
  __device__ __forceinline__ bf16_t* hb() const { return (bf16_t*)(ws + WO_ybuf + ((size_t)4 << 20)); }
  __device__ __forceinline__ bf16_t* ppart() const { return (bf16_t*)(ws + WO_proj + (size_t)T * D * 2); }
  __device__ __forceinline__ bf16_t* Qr() const { return (bf16_t*)(ws + WO_Qr); }
  __device__ __forceinline__ bf16_t* Kr() const { return (bf16_t*)(ws + WO_Kr); }
  __device__ __forceinline__ bf16_t* Krv() const { return (bf16_t*)(ws + WO_Krv); }
  __device__ __forceinline__ bf16_t* Vr() const { return (bf16_t*)(ws + WO_Vr); }
  __device__ __forceinline__ float* KVr() const { return (float*)(ws + WO_KVr); }
  __device__ __forceinline__ bf16_t* Rb() const { return (bf16_t*)(ws + WO_Rb); }
  __device__ __forceinline__ unsigned* bar() const { return (unsigned*)(ws + WO_bar); }
  __device__ __forceinline__ float* ssq1() const { return (float*)(ws + WO_ssq1); }
  __device__ __forceinline__ float* ssq2() const { return (float*)(ws + WO_ssq2); }
  __device__ __forceinline__ bf16_t* xb2() const { return (bf16_t*)(ws + WO_proj + (size_t)T * D * 2 + (size_t)T * 128 * 8 * 4); }
  __device__ __forceinline__ bf16_t* vrow() const { return (bf16_t*)(ws + WO_proj); }
  __device__ __forceinline__ bf16_t* vrrow() const { return (bf16_t*)(ws + WO_proj + (size_t)T * 512 * 2); }
  __device__ __forceinline__ bf16_t* krow() const { return (bf16_t*)(ws + WO_proj + (size_t)T * 768 * 2); }
  __device__ __forceinline__ bf16_t* grow() const { return (bf16_t*)(ws + WO_proj + (size_t)T * 1024 * 2); }
  __device__ __forceinline__ bf16_t* qb() const { return (bf16_t*)(ws + WO_proj); }
};

namespace pg8 {
#define PG8_LAS __attribute__((address_space(3)))
typedef unsigned short bf16_t;
typedef short bf16x8 __attribute__((ext_vector_type(8)));
typedef float f32x4 __attribute__((ext_vector_type(4)));
typedef unsigned u32x4 __attribute__((ext_vector_type(4)));
constexpr int BM = 256, BK = 64, HALF = 128, HTB = HALF * BK * 2  , STAGE_BYTES = 8 * HTB, NXCD = 8, WGM = 8;

__host__ __device__ __forceinline__ int lds_byte(int r, int c) { const int st = (r >> 4) * 2 + (c >> 5), rr = r & 15, cc = c & 31, ob = rr * 64 + cc * 2; return st * 1024 + (ob ^ (((ob >> 9) & 1) << 5)); }
__host__ __device__ __forceinline__ void stage_rc(int b, int& R, int& C) { const int st = b / 1024, sb = b % 1024, swz = sb ^ (((sb >> 9) & 1) << 5); R = (st >> 1) * 16 + swz / 64; C = (st & 1) * 32 + (swz % 64) / 2; }
__host__ __device__ __forceinline__ int perm32(int rho) { const int n = rho >> 4, i = rho & 15; return 8 * (i >> 2) + 4 * n + (i & 3); }

struct Unit { int pm, pn; };
struct Gemm { const bf16_t* A; const bf16_t* Bt; int M, N, K, lda, ldb; };

struct StaticOrder {
    int nM, nN, nwg, G, c;
    __host__ __device__ void init(int M, int N, int G_, int c_) { nM = M / BM; nN = N / BM; nwg = nM * nN; G = G_; c = c_; }
    __host__ __device__ bool next(int i, Unit& u) const {
        const long L = (long)i * G + c; if (L >= nwg) return false;
        int wgid = (int)L; { const int q = nwg / NXCD, r = nwg % NXCD, xcd = wgid % NXCD, off = wgid / NXCD; wgid = (xcd < r ? xcd * (q + 1) : r * (q + 1) + (xcd - r) * q) + off; }
        const int nig = WGM * nN, gid = wgid / nig, fm = gid * WGM, gsz = (nM - fm) < WGM ? (nM - fm) : WGM;
        u.pm = fm + ((wgid % nig) % gsz); u.pn = (wgid % nig) / gsz; return true;
    }
    __device__ __forceinline__ void a_ready(const Unit&) const {}
    __device__ __forceinline__ void done(const Unit&) const {}
};
struct GroupOrder {
    int mt, nt_, nwg, G, c;
    __host__ __device__ void init(int ngroups, int mt__, int nt__, int G_, int c_) { mt = mt__; nt_ = nt__; nwg = ngroups * mt * nt_; G = G_; c = c_; }
    __host__ __device__ bool next(int i, Unit& u) const {
        const long L = (long)i * G + c; if (L >= nwg) return false;
        const int per = mt * nt_, gi = (int)L / per, r = (int)L % per;
        u.pm = gi * mt + r % mt; u.pn = gi * nt_ + r / mt; return true;
    }
    __device__ __forceinline__ void a_ready(const Unit&) const {}
    __device__ __forceinline__ void done(const Unit&) const {}
};
template <class Epi, class Sched, bool ALIGN_EPI = false, bool SP2 = false>
__device__ __forceinline__ void gemm_phase(PG8_LAS unsigned char* lds, const Gemm g, const Sched& S, const Epi& E) {
    int tid_ = threadIdx.x; asm volatile("" : "+v"(tid_));
    const int tid = tid_, wid = __builtin_amdgcn_readfirstlane(tid >> 6), lane = tid & 63, wr = wid >> 2, wc = wid & 3, fr = lane & 15, fq = lane >> 4;
    const int K = g.K, nt = K / BK;
    unsigned voffA[2], voffB[2];
#pragma unroll
    for (int i = 0; i < 2; ++i) { int R, C; stage_rc(tid * 16 + i * 8192, R, C); const int Rb = Epi::PERM ? ((R & ~31) + perm32(R & 31)) : R;
        voffA[i] = (unsigned)(R * g.lda + C) * 2u; voffB[i] = (unsigned)(Rb * g.ldb + C) * 2u; }
    const size_t kstep = (size_t)(BK * 2);
    const size_t hstepA = (size_t)HALF * g.lda * 2, hstepB = (size_t)HALF * g.ldb * 2;
    const size_t tstepA = 2 * hstepA, tstepB = 2 * hstepB;
    const unsigned ldsw = (unsigned)wid * 1024u;
    const int aoff = lds_byte(wr * 64 + fr, fq * 8), boff = lds_byte(wc * 32 + fr, fq * 8);
#define PG8_SA(b, h) (((b) * 2 + (h)) * HTB)
#define PG8_SB(b, h) ((4 + (b) * 2 + (h)) * HTB)
#define PG8_STAGE(bufoff, gbase, voff) do { _Pragma("unroll") for (int _i = 0; _i < 2; ++_i) \
        __builtin_amdgcn_global_load_lds((const unsigned*)((const char*)(gbase) + (voff)[_i]), (PG8_LAS unsigned*)(lds + (bufoff) + ldsw + _i * 8192), 16, 0, 0); } while (0)
#define PG8_LDA(dst, b, h) do { _Pragma("unroll") for (int m = 0; m < 4; ++m) _Pragma("unroll") for (int k = 0; k < 2; ++k) dst[m][k] = *(const PG8_LAS bf16x8*)(lds + PG8_SA(b, h) + aoff + m * 2048 + k * 1024); } while (0)
#define PG8_LDB(dst, b, h) do { _Pragma("unroll") for (int n = 0; n < 2; ++n) _Pragma("unroll") for (int k = 0; k < 2; ++k) dst[n][k] = *(const PG8_LAS bf16x8*)(lds + PG8_SB(b, h) + boff + n * 2048 + k * 1024); } while (0)
#define PG8_MMA(ai, bj, At, Bt) do { __builtin_amdgcn_s_setprio(1); _Pragma("unroll") for (int m = 0; m < 4; ++m) _Pragma("unroll") for (int n = 0; n < 2; ++n) _Pragma("unroll") for (int k = 0; k < 2; ++k) \
        acc[ai][bj][m][n] = __builtin_amdgcn_mfma_f32_16x16x32_bf16(Bt[n][k], At[m][k], acc[ai][bj][m][n], 0, 0, 0); __builtin_amdgcn_s_setprio(0); } while (0)
#define PG8_WAIT_V(n) asm volatile("s_waitcnt vmcnt(" #n ")" ::: "memory")
#define PG8_WAIT_L(n) asm volatile("s_waitcnt lgkmcnt(" #n ")" ::: "memory")
#define PG8_BAR __builtin_amdgcn_s_barrier()
#define PG8_SCHED __builtin_amdgcn_sched_barrier(0)
    Unit cur, nxt; int ui = 0;
    if (!S.next(0, cur)) return;
    f32x4 acc[2][2][4][2];
    E.init(acc, cur, wr, wc, fr, fq);
    bf16x8 At[4][2], B0[2][2], B1[2][2];
    const char* cA = (const char*)g.A + (size_t)cur.pm * tstepA; const char* cB = (const char*)g.Bt + (size_t)cur.pn * tstepB;
    S.a_ready(cur);
    if constexpr (SP2) {
        PG8_STAGE(PG8_SB(0, 0), cB, voffB); PG8_STAGE(PG8_SB(0, 1), cB + hstepB, voffB); PG8_STAGE(PG8_SA(0, 0), cA, voffA); PG8_STAGE(PG8_SA(0, 1), cA + hstepA, voffA);
        if (wr == 1) PG8_BAR;
        PG8_WAIT_V(2); PG8_BAR;
        PG8_STAGE(PG8_SB(1, 0), cB + kstep, voffB); PG8_STAGE(PG8_SA(1, 0), cA + kstep, voffA); PG8_STAGE(PG8_SB(1, 1), cB + hstepB + kstep, voffB);
        PG8_WAIT_V(6); PG8_BAR;
    } else {
        PG8_STAGE(PG8_SB(0, 0), cB, voffB); PG8_STAGE(PG8_SA(0, 0), cA, voffA); PG8_STAGE(PG8_SB(0, 1), cB + hstepB, voffB); PG8_STAGE(PG8_SA(0, 1), cA + hstepA, voffA);
        if (wr == 1) PG8_BAR;
        PG8_WAIT_V(4); PG8_BAR;
        PG8_STAGE(PG8_SB(1, 0), cB + kstep, voffB); PG8_STAGE(PG8_SA(1, 0), cA + kstep, voffA); PG8_STAGE(PG8_SB(1, 1), cB + hstepB + kstep, voffB);
        PG8_WAIT_V(6); PG8_BAR;
    }
    for (;;) {
        const bool has_next = S.next(ui + 1, nxt);
        const char* nA = has_next ? (const char*)g.A + (size_t)nxt.pm * tstepA : cA; const char* nB = has_next ? (const char*)g.Bt + (size_t)nxt.pn * tstepB : cB;
        for (int t = 0; t < nt; t += 2) {
            const bool last = (t == nt - 2);
            const char* a1 = cA + (size_t)(t + 1) * kstep;
            const char* a2 = last ? nA : cA + (size_t)(t + 2) * kstep; const char* b2 = last ? nB : cB + (size_t)(t + 2) * kstep;
            const char* a3 = a2 + kstep; const char* b3 = b2 + kstep;
            if (last && has_next) S.a_ready(nxt);
            if constexpr (SP2) {
            PG8_LDB(B0, 0, 0); PG8_LDB(B1, 0, 1); PG8_SCHED; PG8_LDA(At, 0, 0); PG8_STAGE(PG8_SA(1, 1), a1 + hstepA, voffA);
            PG8_WAIT_V(8); PG8_WAIT_L(0); PG8_BAR; PG8_MMA(0, 0, At, B0); PG8_MMA(0, 1, At, B1); PG8_BAR; PG8_SCHED;
            PG8_LDA(At, 0, 1); PG8_STAGE(PG8_SB(0, 0), b2, voffB); PG8_STAGE(PG8_SB(0, 1), b2 + hstepB, voffB); PG8_STAGE(PG8_SA(0, 0), a2, voffA);
            PG8_WAIT_V(8); PG8_WAIT_L(0); PG8_BAR; PG8_MMA(1, 0, At, B0); PG8_MMA(1, 1, At, B1); PG8_BAR; PG8_SCHED;
            PG8_LDB(B0, 1, 0); PG8_LDB(B1, 1, 1); PG8_SCHED; PG8_LDA(At, 1, 0); PG8_STAGE(PG8_SA(0, 1), a2 + hstepA, voffA);
            PG8_WAIT_V(8); PG8_WAIT_L(0); PG8_BAR; PG8_MMA(0, 0, At, B0); PG8_MMA(0, 1, At, B1); PG8_BAR; PG8_SCHED;
            PG8_LDA(At, 1, 1); PG8_STAGE(PG8_SB(1, 0), b3, voffB); PG8_STAGE(PG8_SB(1, 1), b3 + hstepB, voffB); PG8_STAGE(PG8_SA(1, 0), a3, voffA);
            PG8_WAIT_V(8); PG8_WAIT_L(0); PG8_BAR; PG8_MMA(1, 0, At, B0); PG8_MMA(1, 1, At, B1); PG8_BAR; PG8_SCHED;
            } else {
            PG8_LDB(B0, 0, 0); PG8_SCHED; PG8_LDA(At, 0, 0); PG8_STAGE(PG8_SA(1, 1), a1 + hstepA, voffA);
            PG8_WAIT_L(8); PG8_BAR; PG8_WAIT_L(0); PG8_MMA(0, 0, At, B0); PG8_BAR; PG8_SCHED;
            PG8_LDB(B1, 0, 1); PG8_STAGE(PG8_SB(0, 0), b2, voffB);
            PG8_BAR; PG8_WAIT_L(0); PG8_MMA(0, 1, At, B1); PG8_BAR;
            PG8_LDA(At, 0, 1); PG8_STAGE(PG8_SA(0, 0), a2, voffA);
            PG8_BAR; PG8_WAIT_L(0); PG8_MMA(1, 0, At, B0); PG8_BAR; PG8_SCHED;
            PG8_STAGE(PG8_SB(0, 1), b2 + hstepB, voffB);
            PG8_WAIT_V(6); PG8_BAR; PG8_MMA(1, 1, At, B1); PG8_BAR;
            PG8_LDB(B0, 1, 0); PG8_SCHED; PG8_LDA(At, 1, 0); PG8_STAGE(PG8_SA(0, 1), a2 + hstepA, voffA);
            PG8_WAIT_L(8); PG8_BAR; PG8_WAIT_L(0); PG8_MMA(0, 0, At, B0); PG8_BAR; PG8_SCHED;
            PG8_LDB(B1, 1, 1); PG8_STAGE(PG8_SB(1, 0), b3, voffB);
            PG8_BAR; PG8_WAIT_L(0); PG8_MMA(0, 1, At, B1); PG8_BAR;
            PG8_LDA(At, 1, 1); PG8_STAGE(PG8_SA(1, 0), a3, voffA);
            PG8_BAR; PG8_WAIT_L(0); PG8_MMA(1, 0, At, B0); PG8_BAR; PG8_SCHED;
            PG8_STAGE(PG8_SB(1, 1), b3 + hstepB, voffB);
            PG8_WAIT_V(6); PG8_BAR; PG8_MMA(1, 1, At, B1); PG8_BAR;
            }
        }
        if constexpr (ALIGN_EPI) { if (wr == 0) PG8_BAR; }
        if constexpr (!Epi::AFTER_DRAIN) { E(acc, cur, wr, wc, fr, fq); S.done(cur); }
        if (!has_next) break;
        E.init(acc, nxt, wr, wc, fr, fq);
        cur = nxt; cA = nA; cB = nB; ++ui;
        if constexpr (ALIGN_EPI) { if (wr == 1) PG8_BAR; }
    }
    PG8_WAIT_V(0);
    if constexpr (!ALIGN_EPI) { if (wr == 0) PG8_BAR; }
    PG8_BAR;
    if constexpr (Epi::AFTER_DRAIN) { E.fused(acc, cur, wr, wc, fr, fq, lds, wid, lane); S.done(cur); }
#undef PG8_SA
#undef PG8_SB
#undef PG8_STAGE
#undef PG8_LDA
#undef PG8_LDB
#undef PG8_MMA
#undef PG8_WAIT_V
#undef PG8_WAIT_L
#undef PG8_BAR
#undef PG8_SCHED
}
}
#define EPI_ZERO_INIT \
  __device__ __forceinline__ void init(pg8::f32x4 (&acc)[2][2][4][2], const pg8::Unit&, int, int, int, int) const { \
    _Pragma("unroll") for (int a = 0; a < 2; ++a) _Pragma("unroll") for (int b = 0; b < 2; ++b) \
    _Pragma("unroll") for (int m = 0; m < 4; ++m) _Pragma("unroll") for (int n = 0; n < 2; ++n) acc[a][b][m][n] = (pg8::f32x4){0.f, 0.f, 0.f, 0.f}; }
struct EpiResid {
  static constexpr bool PERM = true, AFTER_DRAIN = false;
  float* C; int ldc; bf16_t* xb; bf16_t* hb; const float* g2; float* parts; const float* Cin;
  __device__ __forceinline__ void init(pg8::f32x4 (&acc)[2][2][4][2], const pg8::Unit& u, int wr, int wc, int fr, int fq) const {
#pragma unroll
    for (int ai = 0; ai < 2; ++ai)
#pragma unroll
      for (int m = 0; m < 4; ++m) {
        const int row = u.pm * 256 + ai * 128 + wr * 64 + m * 16 + fr;
#pragma unroll
        for (int bj = 0; bj < 2; ++bj)
#pragma unroll
          for (int n = 0; n < 2; ++n) {
            const int col = u.pn * 256 + bj * 128 + wc * 32 + 8 * fq + 4 * n;
            acc[ai][bj][m][n] = *(const pg8::f32x4*)(Cin + (size_t)row * ldc + col);
          }
      }
  }
  __device__ __forceinline__ void operator()(const pg8::f32x4 (&acc)[2][2][4][2], const pg8::Unit& u, int wr, int wc, int fr_in, int fq_in) const {
    int fr = fr_in, fq = fq_in; asm volatile("" : "+v"(fr), "+v"(fq));
    pg8::f32x4 gv[2][2];
#pragma unroll
    for (int bj = 0; bj < 2; ++bj)
#pragma unroll
      for (int n = 0; n < 2; ++n) gv[bj][n] = *(const pg8::f32x4*)(g2 + u.pn * 256 + bj * 128 + wc * 32 + 8 * fq + 4 * n);
#pragma unroll
    for (int ai = 0; ai < 2; ++ai)
#pragma unroll
      for (int m = 0; m < 4; ++m) {
        const int row = u.pm * 256 + ai * 128 + wr * 64 + m * 16 + fr;
        float ss = 0.f;
#pragma unroll
        for (int bj = 0; bj < 2; ++bj) {
          const int col = u.pn * 256 + bj * 128 + wc * 32 + 8 * fq;
          const pg8::f32x4 v0 = acc[ai][bj][m][0], v1 = acc[ai][bj][m][1];
          *(pg8::f32x4*)(C + (size_t)row * ldc + col) = v0; *(pg8::f32x4*)(C + (size_t)row * ldc + col + 4) = v1;
          *(uint4*)(xb + (size_t)row * KD + col) = make_uint4(pk_bf16(v0[0], v0[1]), pk_bf16(v0[2], v0[3]), pk_bf16(v1[0], v1[1]), pk_bf16(v1[2], v1[3]));
          const pg8::f32x4 h0 = v0 * gv[bj][0], h1 = v1 * gv[bj][1];
          *(uint4*)(hb + ((size_t)(col >> 7) * T + row) * 128 + (col & 127)) = make_uint4(pk_bf16(h0[0], h0[1]), pk_bf16(h0[2], h0[3]), pk_bf16(h1[0], h1[1]), pk_bf16(h1[2], h1[3]));
          ss += ((v0[0] * v0[0] + v0[1] * v0[1]) + (v0[2] * v0[2] + v0[3] * v0[3])) + ((v1[0] * v1[0] + v1[1] * v1[1]) + (v1[2] * v1[2] + v1[3] * v1[3]));
        }
        ss += __shfl_xor(ss, 16); ss += __shfl_xor(ss, 32);
        if (fq == 0) parts[(size_t)row * 16 + u.pn * 4 + wc] = ss;
        asm volatile("" ::: "memory");
      }
  }
};
struct EpiScaleStoreBf16 {
  static constexpr bool PERM = true, AFTER_DRAIN = false;
  bf16_t* C; int ldc; const float* parts; int nparts; float* rs_out;
  EPI_ZERO_INIT
  __device__ __forceinline__ void operator()(const pg8::f32x4 (&acc)[2][2][4][2], const pg8::Unit& u, int wr, int wc, int fr_in, int fq_in) const {
    int fr = fr_in, fq = fq_in; asm volatile("" : "+v"(fr), "+v"(fq));
#pragma unroll
    for (int ai = 0; ai < 2; ++ai)
#pragma unroll
      for (int m = 0; m < 4; ++m) {
        const int row = u.pm * 256 + ai * 128 + wr * 64 + m * 16 + fr;
        float ssum = 0.f;
        for (int i = 0; i < nparts; i += 4) { const pg8::f32x4 q4 = *(const pg8::f32x4*)(parts + (size_t)row * nparts + i); ssum += (q4[0] + q4[1]) + (q4[2] + q4[3]); }
        const float r = rsqrtf(ssum * (1.0f / (float)D) + EPS);
        if (rs_out && u.pn == 0 && wc == 0 && fq == 0) rs_out[row] = r;
#pragma unroll
        for (int bj = 0; bj < 2; ++bj) {
          const int col = u.pn * 256 + bj * 128 + wc * 32 + 8 * fq;
          const pg8::f32x4 v0 = acc[ai][bj][m][0] * r, v1 = acc[ai][bj][m][1] * r;
          *(uint4*)(C + (size_t)row * ldc + col) = make_uint4(pk_bf16(v0[0], v0[1]), pk_bf16(v0[2], v0[3]), pk_bf16(v1[0], v1[1]), pk_bf16(v1[2], v1[3]));
        }
        asm volatile("" ::: "memory");
      }
  }
};
struct EpiInProj {
  static constexpr bool PERM = true, AFTER_DRAIN = false;
  const float* parts;
  bf16_t *S5A, *Qm, *Km, *vrow, *Qr, *Kr, *krow, *vrrow, *grow;
  const float *gq, *gk, *cosm, *sinm, *cosr, *sinr;
  EPI_ZERO_INIT
  __device__ __forceinline__ void operator()(const pg8::f32x4 (&acc)[2][2][4][2], const pg8::Unit& u, int wr, int wc, int fr_in, int fq_in) const {
    int fr = fr_in, fq = fq_in; asm volatile("" : "+v"(fr), "+v"(fq));
    const int pn = u.pn;
    float gain[2][8];
    if (pn >= 1 && pn <= 4) {
      const float* gsrc = pn <= 2 ? gq : gk;
#pragma unroll
      for (int bj = 0; bj < 2; ++bj) { const pg8::f32x4 a = *(const pg8::f32x4*)(gsrc + bj * 32 + 8 * fq), b = *(const pg8::f32x4*)(gsrc + bj * 32 + 8 * fq + 4);
        gain[bj][0] = a[0]; gain[bj][1] = a[1]; gain[bj][2] = a[2]; gain[bj][3] = a[3]; gain[bj][4] = b[0]; gain[bj][5] = b[1]; gain[bj][6] = b[2]; gain[bj][7] = b[3]; }
    }
    const float l2g = ret_log2g(wc);
#pragma unroll
    for (int ai = 0; ai < 2; ++ai)
#pragma unroll
      for (int m = 0; m < 4; ++m) {
        const int t = u.pm * 256 + ai * 128 + wr * 64 + m * 16 + fr, s = t & (S - 1), b = t >> 12;
        float r;
        { const pg8::f32x4 p0 = *(const pg8::f32x4*)(parts + (size_t)t * 8), p1 = *(const pg8::f32x4*)(parts + (size_t)t * 8 + 4);
          r = rsqrtf((((p0[0] + p0[1]) + (p0[2] + p0[3])) + ((p1[0] + p1[1]) + (p1[2] + p1[3]))) * (1.0f / (float)D) + EPS); }
        float v[2][8];
#pragma unroll
        for (int bj = 0; bj < 2; ++bj)
#pragma unroll
          for (int e = 0; e < 8; ++e) v[bj][e] = acc[ai][bj][m][e >> 2][e & 3] * r;
#define PK8(x_) make_uint4(pk_bf16((x_)[0], (x_)[1]), pk_bf16((x_)[2], (x_)[3]), pk_bf16((x_)[4], (x_)[5]), pk_bf16((x_)[6], (x_)[7]))
        if (pn == 0) {
#pragma unroll
          for (int bj = 0; bj < 2; ++bj) { const int g = wc * 4 + bj * 2 + (fq >> 1);
            *(uint4*)(S5A + ((size_t)g * 1024 + (t >> 5)) * 640 + (t & 31) * 16 + 8 * (fq & 1)) = PK8(v[bj]); }
        } else if (pn <= 4) {
          const bool isk = pn >= 3; const int h = ((pn - 1) & 1) * 4 + wc, bh = b * 8 + h;
          float ss = 0.f;
#pragma unroll
          for (int bj = 0; bj < 2; ++bj)
#pragma unroll
            for (int e = 0; e < 8; ++e) ss += v[bj][e] * v[bj][e];
          ss += __shfl_xor(ss, 16); ss += __shfl_xor(ss, 32);
          const float rh = rsqrtf(ss * (1.0f / 64.0f) + EPS);
#pragma unroll
          for (int bj = 0; bj < 2; ++bj)
#pragma unroll
            for (int e = 0; e < 8; ++e) v[bj][e] *= rh * gain[bj][e];
          { const pg8::f32x4 c0 = *(const pg8::f32x4*)(cosm + s * 8), c1 = *(const pg8::f32x4*)(cosm + s * 8 + 4), s0 = *(const pg8::f32x4*)(sinm + s * 8), s1 = *(const pg8::f32x4*)(sinm + s * 8 + 4);
#pragma unroll
            for (int e = 0; e < 8; ++e) {
              const float pu = __shfl_xor(v[0][e], 16);
              const float c = e < 4 ? c0[e & 3] : c1[e & 3], sn = e < 4 ? s0[e & 3] : s1[e & 3];
              const float o = fq == 0 ? (v[0][e] * c - pu * sn) : (v[0][e] * c + pu * sn);
              v[0][e] = fq < 2 ? o : v[0][e];
            } }
          if (!isk) {
#pragma unroll
            for (int bj = 0; bj < 2; ++bj) { float q8[8];
#pragma unroll
              for (int e = 0; e < 8; ++e) q8[e] = v[bj][e] * QSCALE;
              *(uint4*)(Qm + ((size_t)bh * S + s) * 64 + bj * 32 + 8 * fq) = PK8(q8); }
          } else {
#pragma unroll
            for (int bj = 0; bj < 2; ++bj) *(uint4*)(Km + ((((size_t)bh * (S / 32) + (s >> 5)) * 8 + bj * 4 + fq) * 32 + (s & 31)) * 8) = PK8(v[bj]);
          }
        } else if (pn <= 6) {
#pragma unroll
          for (int bj = 0; bj < 2; ++bj) *(uint4*)(vrow + (size_t)t * 512 + (pn - 5) * 256 + wc * 64 + bj * 32 + 8 * fq) = PK8(v[bj]);
        } else if (pn <= 8) {
          const bool isk = pn == 8; const int bh = b * 4 + wc, pos = s & 127;
          const float sc = isk ? 0.125f * exp2f(-(float)pos * l2g) : exp2f((float)pos * l2g);
          const pg8::f32x4 c0 = *(const pg8::f32x4*)(cosr + s * 32 + 8 * fq), c1 = *(const pg8::f32x4*)(cosr + s * 32 + 8 * fq + 4);
          const pg8::f32x4 s0 = *(const pg8::f32x4*)(sinr + s * 32 + 8 * fq), s1 = *(const pg8::f32x4*)(sinr + s * 32 + 8 * fq + 4);
          float o1[8], o2[8];
#pragma unroll
          for (int e = 0; e < 8; ++e) { const float c = e < 4 ? c0[e & 3] : c1[e & 3], sn = e < 4 ? s0[e & 3] : s1[e & 3];
            o1[e] = (v[0][e] * c - v[1][e] * sn) * sc; o2[e] = (v[1][e] * c + v[0][e] * sn) * sc; }
          if (!isk) {
            *(uint4*)(Qr + ((size_t)bh * S + s) * 64 + 8 * fq) = PK8(o1); *(uint4*)(Qr + ((size_t)bh * S + s) * 64 + 32 + 8 * fq) = PK8(o2);
          } else {
            *(uint4*)(Kr + ((((size_t)bh * (S / 32) + (s >> 5)) * 8 + fq) * 32 + (s & 31)) * 8) = PK8(o1);
            *(uint4*)(Kr + ((((size_t)bh * (S / 32) + (s >> 5)) * 8 + 4 + fq) * 32 + (s & 31)) * 8) = PK8(o2);
            *(uint4*)(krow + (size_t)t * 256 + wc * 64 + 8 * fq) = PK8(o1); *(uint4*)(krow + (size_t)t * 256 + wc * 64 + 32 + 8 * fq) = PK8(o2);
          }
        } else {
          bf16_t* dst = (pn == 9 ? vrrow : grow) + (size_t)t * 256 + wc * 64 + 8 * fq;
          *(uint4*)dst = PK8(v[0]); *(uint4*)(dst + 32) = PK8(v[1]);
        }
#undef PK8
        asm volatile("" ::: "memory");
      }
  }
};
template <class Epi>
__device__ __forceinline__ void run_gemm(unsigned char* lds_raw, const bf16_t* A, const bf16_t* Bt, int M, int N, int K, const Epi& e) {
  pg8::Gemm g{A, Bt, M, N, K, K, K}; pg8::StaticOrder So; So.init(M, N, (int)gridDim.x, (int)blockIdx.x);
  pg8::gemm_phase<Epi, pg8::StaticOrder, true, true>((PG8_LAS unsigned char*)lds_raw, g, So, e);
}

template <bool HEADPERM>
__device__ __forceinline__ void transpose_items(const float* __restrict__ W, int K, int N, const float* __restrict__ g, bf16_t* __restrict__ Wt, int gw, int ngw, int lane) {
  const int nkt = K / 64, nnt = N / 64;
  for (int it = gw; it < nkt * nnt; it += ngw) {
    int kt = it % nkt, ntile = it / nkt;
    int k0 = kt * 64, n = ntile * 64 + lane;
    int ns = n;
    if (HEADPERM) { const int cp = n & 255; ns = (n & ~255) + ((cp >> 5) & 3) * 64 + (cp >> 7) * 32 + (cp & 31); }
    float v[64];
#pragma unroll
    for (int i = 0; i < 64; ++i) v[i] = W[(size_t)(k0 + i) * N + ns] * g[k0 + i];
    bf16_t* dst = Wt + (size_t)n * (K * KS) + k0;
#pragma unroll
    for (int c = 0; c < 8; ++c) {
      bf16_t hi[8], lo[8];
#pragma unroll
      for (int e = 0; e < 8; ++e) { hi[e] = f2bf(v[c * 8 + e]); lo[e] = f2bf(v[c * 8 + e] - bf2f(hi[e])); }
      uint4 ph, pl;
      ph.x = hi[0] | ((unsigned)hi[1] << 16); ph.y = hi[2] | ((unsigned)hi[3] << 16); ph.z = hi[4] | ((unsigned)hi[5] << 16); ph.w = hi[6] | ((unsigned)hi[7] << 16);
      pl.x = lo[0] | ((unsigned)lo[1] << 16); pl.y = lo[2] | ((unsigned)lo[3] << 16); pl.z = lo[4] | ((unsigned)lo[5] << 16); pl.w = lo[6] | ((unsigned)lo[7] << 16);
      *(uint4*)(dst + c * 8) = ph;
      if (PRECISE) { *(uint4*)(dst + K + c * 8) = pl; *(uint4*)(dst + 2 * K + c * 8) = ph; }
    }
  }
}


__device__ __forceinline__ void phase_prologue(const Params& p, int gtid, int ngt, int gw, int ngw, int lane) {
  for (int idx = gtid; idx < S * 40; idx += ngt) {
    int s = idx / 40, i = idx % 40;
    if (i < 8) {
      const float inv = powf(500000.0f, -(float)(2 * i) / 16.0f);
      float sn, cs; sincosf((float)s * inv, &sn, &cs);
      p.cosm()[s * 8 + i] = cs; p.sinm()[s * 8 + i] = sn;
    } else {
      const int j = i - 8;
      const float inv = powf(10000.0f, -((float)j / 31.0f));
      float sn, cs; sincosf((float)s * inv, &sn, &cs);
      p.cosr()[s * 32 + j] = cs; p.sinr()[s * 32 + j] = sn;
    }
  }
  for (int t = gw; t < T; t += ngw) {
    const float4* xr = (const float4*)(p.inp(0) + (size_t)t * D); float ss = 0.f;
#pragma unroll
    for (int i = 0; i < 4; ++i) { const float4 v = xr[lane + i * 64]; ss += v.x * v.x + v.y * v.y + v.z * v.z + v.w * v.w;
      *(uint2*)(p.xb() + (size_t)t * KD + (lane + i * 64) * 4) = make_uint2(pk_bf16(v.x, v.y), pk_bf16(v.z, v.w)); }
    ss = wave_sum(ss);
    if (lane < 8) p.ssq1()[(size_t)t * 8 + lane] = lane == 0 ? ss : 0.f;
  }
  for (int idx = gtid; idx < NL * 65536; idx += ngt) { const int l2 = idx >> 16, n2 = (idx >> 8) & 255, k2 = idx & 255; p.Wglu_t()[idx] = f2bf(p.inp(11)[(size_t)l2 * 65536 + k2 * 256 + n2]); }
  for (int l = 0; l < NL; ++l) {
    transpose_items<true>(p.inp(2) + (size_t)l * D * INW, D, INW, p.inp(1) + l * D, p.Win_t() + (size_t)l * INW * KD, gw, ngw, lane);
    transpose_items<false>(p.inp(15) + (size_t)l * D * D, D, D, p.inp(14) + l * D, p.Wout_t() + (size_t)l * D * KD, gw, ngw, lane);
    transpose_items<false>(p.inp(17) + (size_t)l * D * D, D, D, p.inp(16) + l * D, p.Wq_t() + (size_t)l * D * KD, gw, ngw, lane);
  }
}


struct S5P { float lr, li, dt, fr, fi; };
__device__ __forceinline__ S5P s5p(const Params& p, int l, int g, int pp) {
  S5P r; r.lr = p.inp(3)[l * 1024 + g * 64 + pp]; r.li = p.inp(4)[l * 1024 + g * 64 + pp]; r.dt = expf(p.inp(5)[l * 16 + g]);
  const float mag = expf(r.lr * r.dt); float sn, cs; sincosf(r.li * r.dt, &sn, &cs);
  const float ar = mag * cs, ai = mag * sn, den = r.lr * r.lr + r.li * r.li;
  r.fr = ((ar - 1.0f) * r.lr + ai * r.li) / den; r.fi = (ai * r.lr - (ar - 1.0f) * r.li) / den;
  return r;
}
__device__ __forceinline__ void s5pow(const S5P& s, int k, float& re, float& im) {
  const float m = expf((float)k * s.lr * s.dt); float sn, cs; sincosf((float)k * s.li * s.dt, &sn, &cs); re = m * cs; im = m * sn;
}
__device__ __forceinline__ void phase_s5_prep(const Params& p, int l, int gtid, int ngt) {
  const float* b_re = p.inp(6) + l * 16384; const float* b_im = p.inp(7) + l * 16384;
  const float* c_re = p.inp(8) + l * 16384; const float* c_im = p.inp(9) + l * 16384;
  bf16_t* Wy = p.S5Wy(); bf16_t* Wz = p.S5Wz();
  for (int it = gtid; it < 16 * 32 * 256; it += ngt) {
    const int hp = it & 15, h = (it >> 4) & 15, d = (it >> 8) & 31, g = it >> 13;
    float prl, pil, frl, fil;
    { const S5P sl = s5p(p, l, g, (int)(threadIdx.x & 63)); s5pow(sl, d, prl, pil); frl = sl.fr; fil = sl.fi; }
    float acc = 0.f;
    for (int pp = 0; pp < 64; ++pp) {
      const float pr = __shfl(prl, pp), pi = __shfl(pil, pp);
      S5P s; s.fr = __shfl(frl, pp); s.fi = __shfl(fil, pp);
      const float br = b_re[(g * 64 + pp) * 16 + hp], bi = b_im[(g * 64 + pp) * 16 + hp];
      const float bbr = s.fr * br - s.fi * bi, bbi = s.fr * bi + s.fi * br;
      const float tr = pr * bbr - pi * bbi, ti = pr * bbi + pi * bbr;
      acc += c_re[(g * 16 + h) * 64 + pp] * tr - c_im[(g * 16 + h) * 64 + pp] * ti;
    }
    const bf16_t v = f2bf(acc);
    for (int jp = 0; jp + d < 32; ++jp) {
      const int j = jp + d;
      Wy[((size_t)g * 512 + j * 16 + h) * 640 + jp * 16 + hp] = v;
      if (d > 0) Wy[((size_t)g * 512 + jp * 16 + h) * 640 + j * 16 + hp] = 0;
    }
  }
  for (int it = gtid; it < 16 * 32 * 16 * 64; it += ngt) {
    const int pp = it & 63, h = (it >> 6) & 15, j = (it >> 10) & 31, g = it >> 15;
    const S5P s = s5p(p, l, g, pp);
    float pr, pi; s5pow(s, j + 1, pr, pi);
    const float cr = c_re[(g * 16 + h) * 64 + pp], ci = c_im[(g * 16 + h) * 64 + pp];
    const unsigned w = pk_bf16(cr * pr - ci * pi, -(cr * pi + ci * pr));
    *(unsigned*)(Wy + ((size_t)g * 512 + j * 16 + h) * 640 + 512 + 2 * pp) = w;
  }
  for (int it = gtid; it < 16 * 64 * 32; it += ngt) {
    const int j = it & 31, pp = (it >> 5) & 63, g = it >> 11;
    const S5P s = s5p(p, l, g, pp);
    float pr, pi; s5pow(s, 31 - j, pr, pi);
    for (int hp = 0; hp < 16; ++hp) {
      const float br = b_re[(g * 64 + pp) * 16 + hp], bi = b_im[(g * 64 + pp) * 16 + hp];
      const float bbr = s.fr * br - s.fi * bi, bbi = s.fr * bi + s.fi * br;
      Wz[((size_t)g * 256 + 2 * pp) * 512 + j * 16 + hp] = f2bf(pr * bbr - pi * bbi);
      Wz[((size_t)g * 256 + 2 * pp + 1) * 512 + j * 16 + hp] = f2bf(pr * bbi + pi * bbr);
    }
  }
  for (int it = gtid; it < 16 * 64; it += ngt) {
    const S5P s = s5p(p, l, it >> 6, it & 63);
    float pr, pi; s5pow(s, 32, pr, pi);
    p.S5a32()[it * 2] = pr; p.S5a32()[it * 2 + 1] = pi;
  }
}
__device__ __forceinline__ void phase_s5_scan(const Params& p, int gtid, int ngt) {
  for (int it = gtid; it < NB * 16 * 64; it += ngt) {
    const int pp = it & 63, g = (it >> 6) & 15, b = it >> 10;
    const float er = p.S5a32()[(g * 64 + pp) * 2], ei = p.S5a32()[(g * 64 + pp) * 2 + 1];
    float sr = 0.f, si = 0.f;
#pragma unroll 1
    for (int c0 = 0; c0 < 128; c0 += 16) {
      float2 z[16];
#pragma unroll
      for (int k = 0; k < 16; ++k) z[k] = *(const float2*)(p.S5Z() + ((size_t)g * 1024 + b * 128 + c0 + k) * 128 + 2 * pp);
#pragma unroll
      for (int k = 0; k < 16; ++k) {
        const size_t ch = (size_t)g * 1024 + b * 128 + c0 + k;
        *(unsigned*)(p.S5A() + ch * 640 + 512 + 2 * pp) = pk_bf16(sr, si);
        const float nr = er * sr - ei * si + z[k].x, ni = er * si + ei * sr + z[k].y;
        sr = nr; si = ni;
      }
    }
  }
}
struct EpiS5Z {
  static constexpr bool PERM = false, AFTER_DRAIN = false;
  float* Z;
  EPI_ZERO_INIT
  __device__ __forceinline__ void operator()(const pg8::f32x4 (&acc)[2][2][4][2], const pg8::Unit& u, int wr, int wc, int fr_in, int fq_in) const {
    int fr = fr_in, fq = fq_in; asm volatile("" : "+v"(fr), "+v"(fq));
    const int g = u.pm >> 2;
#pragma unroll
    for (int ai = 0; ai < 2; ++ai)
#pragma unroll
      for (int m = 0; m < 4; ++m) {
        const int chunk = (u.pm & 3) * 256 + ai * 128 + wr * 64 + m * 16 + fr;
#pragma unroll
        for (int n = 0; n < 2; ++n) *(pg8::f32x4*)(Z + ((size_t)g * 1024 + chunk) * 128 + wc * 32 + n * 16 + 4 * fq) = acc[ai][0][m][n];
      }
  }
};
struct EpiS5Y {
  static constexpr bool PERM = false, AFTER_DRAIN = false;
  bf16_t* ygb; const bf16_t* A; const float* dsk;
  EPI_ZERO_INIT
  __device__ __forceinline__ void operator()(const pg8::f32x4 (&acc)[2][2][4][2], const pg8::Unit& u, int wr, int wc, int fr_in, int fq_in) const {
    int fr = fr_in, fq = fq_in; asm volatile("" : "+v"(fr), "+v"(fq));
    const int g = u.pm >> 2;
#pragma unroll
    for (int ai = 0; ai < 2; ++ai)
#pragma unroll
      for (int m = 0; m < 4; ++m) {
        const int chunk = (u.pm & 3) * 256 + ai * 128 + wr * 64 + m * 16 + fr;
#pragma unroll
        for (int bj = 0; bj < 2; ++bj)
#pragma unroll
          for (int n = 0; n < 2; ++n) {
            const int col = (u.pn & 1) * 256 + bj * 128 + wc * 32 + n * 16 + 4 * fq, j = col >> 4, h = col & 15;
            const uint2 uu = *(const uint2*)(A + ((size_t)g * 1024 + chunk) * 640 + col);
            const pg8::f32x4 dv = *(const pg8::f32x4*)(dsk + g * 16 + h);
            const pg8::f32x4 v = acc[ai][bj][m][n];
            const float y0 = fast_gelu(v[0] + dv[0] * __uint_as_float(uu.x << 16)), y1 = fast_gelu(v[1] + dv[1] * __uint_as_float(uu.x & 0xffff0000u));
            const float y2 = fast_gelu(v[2] + dv[2] * __uint_as_float(uu.y << 16)), y3 = fast_gelu(v[3] + dv[3] * __uint_as_float(uu.y & 0xffff0000u));
            uint2 o; o.x = pk_bf16(y0, y1); o.y = pk_bf16(y2, y3);
            *(uint2*)(ygb + ((size_t)chunk * 32 + j) * 256 + g * 16 + h) = o;
          }
        asm volatile("" ::: "memory");
      }
  }
};
struct EpiGlu {
  static constexpr bool PERM = false, AFTER_DRAIN = false;
  bf16_t* yb; const bf16_t* ygb; float* scr;
  EPI_ZERO_INIT
  __device__ __forceinline__ void operator()(const pg8::f32x4 (&acc_)[2][2][4][2], const pg8::Unit& u, int wr, int wc, int fr_in, int fq_in) const {
    int fr = fr_in, fq = fq_in; asm volatile("" : "+v"(fr), "+v"(fq));
    pg8::f32x4 (&acc)[2][2][4][2] = const_cast<pg8::f32x4 (&)[2][2][4][2]>(acc_);
#pragma unroll
    for (int ai = 0; ai < 2; ++ai)
#pragma unroll
      for (int m = 0; m < 4; ++m) {
        const int rl = ai * 128 + wr * 64 + m * 16 + fr, row = u.pm * 256 + rl;
        float ss = 0.f;
#pragma unroll
        for (int bj = 0; bj < 2; ++bj)
#pragma unroll
          for (int n = 0; n < 2; ++n) {
            const int col = bj * 128 + wc * 32 + n * 16 + 4 * fq;
            const uint2 yy = *(const uint2*)(ygb + (size_t)row * 256 + col);
            const pg8::f32x4 z = acc[ai][bj][m][n];
            pg8::f32x4 r;
            r[0] = __uint_as_float(yy.x << 16) * fast_sigmoid(z[0]); r[1] = __uint_as_float(yy.x & 0xffff0000u) * fast_sigmoid(z[1]);
            r[2] = __uint_as_float(yy.y << 16) * fast_sigmoid(z[2]); r[3] = __uint_as_float(yy.y & 0xffff0000u) * fast_sigmoid(z[3]);
            acc[ai][bj][m][n] = r;
            ss += r[0] * r[0] + r[1] * r[1] + r[2] * r[2] + r[3] * r[3];
          }
        ss += __shfl_xor(ss, 16); ss += __shfl_xor(ss, 32);
        if (fq == 0) scr[rl * 4 + wc] = ss;
        asm volatile("" ::: "memory");
      }
    asm volatile("s_waitcnt lgkmcnt(0)" ::: "memory"); __builtin_amdgcn_s_barrier(); asm volatile("" ::: "memory");
#pragma unroll
    for (int ai = 0; ai < 2; ++ai)
#pragma unroll
      for (int m = 0; m < 4; ++m) {
        const int rl = ai * 128 + wr * 64 + m * 16 + fr, row = u.pm * 256 + rl;
        const pg8::f32x4 s4 = *(const pg8::f32x4*)(scr + rl * 4);
        const float r = rsqrtf((s4[0] + s4[1] + s4[2] + s4[3]) / 256.0f + EPS);
#pragma unroll
        for (int bj = 0; bj < 2; ++bj)
#pragma unroll
          for (int n = 0; n < 2; ++n) { const pg8::f32x4 v = acc[ai][bj][m][n] * r; *(uint2*)(yb + (size_t)row * KD + bj * 128 + wc * 32 + n * 16 + 4 * fq) = make_uint2(pk_bf16(v[0], v[1]), pk_bf16(v[2], v[3])); }
        asm volatile("" ::: "memory");
      }
    asm volatile("s_waitcnt lgkmcnt(0)" ::: "memory"); __builtin_amdgcn_s_barrier(); asm volatile("" ::: "memory");
  }
};


__device__ __forceinline__ void phase_moba2(const Params& p, int l, unsigned char* lds, int* uq) {
  constexpr int OLD = 260;
  bf16_t* Qs = (bf16_t*)lds;
  float* Oaccf = (float*)(lds + 32768);
  float* laccf = (float*)(lds + 32768 + 64 * OLD * 4);
  float* kms = laccf + 256;
  float* gat = kms + 1024;
  unsigned char* lists = (unsigned char*)(gat + 4096);
  int* cnt = (int*)(lists + 4096);
  int* items = cnt + 16;
  int* ctr = items + 160;
  unsigned* selp = (unsigned*)(ctr + 4);
  float* bq = (float*)(selp + 256);
  int* Oacc = (int*)Oaccf; int* lacc = (int*)laccf;
  float kmax = 0.f;
  { const float* gk = p.inp(13) + l * 64;
    for (int d = 0; d < 64; ++d) kmax = fmaxf(kmax, fabsf(gk[d]));
    kmax *= 8.0f * 1.01f; }
  for (;;) {
    const int u = q_pull(uq, NB * 8 * 16, (int*)(lds + 131072), threadIdx.x);
    if (u < 0) break;
    const int qblk = 15 - (u >> 6), bh = u & 63, b = bh >> 3, h = bh & 7;
    int tid = threadIdx.x; asm volatile("" : "+v"(tid));
    const int lane = tid & 63, wv = tid >> 6, n = lane & 31, hh = lane >> 5;
    __syncthreads();
    { const uint4* src = (const uint4*)(p.Qm() + ((size_t)bh * S + qblk * 256) * 64);
      uint4* dst = (uint4*)Qs;
      for (int i = tid; i < 256 * 64 * 2 / 16; i += NTHR) dst[i] = src[i]; }
    for (int i = tid; i < qblk * 64; i += NTHR) kms[i] = p.kmean()[(size_t)bh * 1024 + i];
    for (int i = tid; i < 64 * OLD; i += NTHR) Oacc[i] = 0;
    if (tid < 256) lacc[tid] = 0;
    if (tid < 16) cnt[tid] = 0;
    __syncthreads();
    { const int q = tid & 255, par = tid >> 8;
      float qv[64];
#pragma unroll
      for (int c = 0; c < 8; ++c) {
        uint4 w = *(const uint4*)(Qs + q * 64 + c * 8);
        qv[c * 8 + 0] = __uint_as_float(w.x << 16); qv[c * 8 + 1] = __uint_as_float(w.x & 0xffff0000u);
        qv[c * 8 + 2] = __uint_as_float(w.y << 16); qv[c * 8 + 3] = __uint_as_float(w.y & 0xffff0000u);
        qv[c * 8 + 4] = __uint_as_float(w.z << 16); qv[c * 8 + 5] = __uint_as_float(w.z & 0xffff0000u);
        qv[c * 8 + 6] = __uint_as_float(w.w << 16); qv[c * 8 + 7] = __uint_as_float(w.w & 0xffff0000u);
      }
      if (par == 0) { float qq = 0.f;
#pragma unroll
        for (int d = 0; d < 64; ++d) qq = fmaf(qv[d], qv[d], qq);
        bq[q] = sqrtf(qq) * kmax; }
      for (int j = par; j < qblk; j += 2) {
        float g = 0.f;
#pragma unroll
        for (int d = 0; d < 64; ++d) g = fmaf(qv[d], kms[j * 64 + d], g);
        gat[q * 16 + j] = g;
      }
    }
    __syncthreads();
    if (tid < 256) {
      float b0 = -INFINITY, b1 = -INFINITY, b2 = -INFINITY; int i0 = 0, i1 = 0, i2 = 0;
      for (int j = 0; j < qblk; ++j) {
        float g = gat[tid * 16 + j];
        if (g > b0) { b2 = b1; i2 = i1; b1 = b0; i1 = i0; b0 = g; i0 = j; }
        else if (g > b1) { b2 = b1; i2 = i1; b1 = g; i1 = j; }
        else if (g > b2) { b2 = g; i2 = j; }
      }
      const int nsel = qblk < 3 ? qblk : 3;
      selp[tid] = (unsigned)i0 | ((unsigned)i1 << 4) | ((unsigned)i2 << 8) | ((unsigned)nsel << 12);
    }
    __syncthreads();
    for (int j = wv; j < qblk; j += 8) {
      int base = 0;
      for (int c = 0; c < 4; ++c) {
        const int q = c * 64 + lane;
        const unsigned sp = selp[q];
        const int ns = sp >> 12;
        const bool f = (ns > 0 && (int)(sp & 15) == j) || (ns > 1 && (int)((sp >> 4) & 15) == j) || (ns > 2 && (int)((sp >> 8) & 15) == j);
        const unsigned long long bal = __ballot(f);
        const int pos = base + __popcll(bal & ((1ull << lane) - 1ull));
        if (f) lists[j * 256 + pos] = (unsigned char)q;
        base += __popcll(bal);
      }
      if (lane == 0) cnt[j] = base;
    }
    __syncthreads();
    if (tid == 0) {
      int ni = 0;
#pragma unroll 1
      for (int g = 7; g >= 0; --g) items[ni++] = (16 << 8) | g;
      for (int j = 0; j < qblk; ++j) { const int ng = (cnt[j] + 31) >> 5; for (int g = 0; g < ng; ++g) items[ni++] = (j << 8) | g; }
      ctr[0] = ni; ctr[1] = 0;
    }
    __syncthreads();
    const int nitems = ctr[0];
    DUP(11) {
    if (rep_ > 0) { __syncthreads(); if (tid == 0) ctr[1] = 0; __syncthreads(); }
    for (;;) {
      int it = 0;
      if (lane == 0) it = atomicAdd(&ctr[1], 1);
      it = __builtin_amdgcn_readfirstlane(it);
      if (it >= nitems) break;
      const int item = items[it];
      const int j = item >> 8, g = item & 255;
      const bool own = (j == 16);
      const int kb = own ? qblk : j;
      const int ntile = own ? (g + 1) : 8;
      int qi; bool valid;
      if (own) { qi = g * 32 + n; valid = true; }
      else { const int pos = g * 32 + n; valid = pos < cnt[j]; qi = lists[j * 256 + (valid ? pos : 0)]; }
      const bf16_t* kt0 = p.Km() + ((size_t)bh * (S / 32) + kb * 8) * 2048 + lane * 8;
      const bf16_t* vt0 = p.Vm() + ((size_t)bh * (S / 32) + kb * 8) * 2048 + lane * 8;
      f32x16 O0, O1;
#pragma unroll
      for (int r = 0; r < 16; ++r) { O0[r] = 0.f; O1[r] = 0.f; }
      float lsum = 0.f;
      const float nbq = -bq[qi];
      bf16x8 kf[3][4], vf[3][4];
#define MOBA_LOAD(KT_, BUF_) { _Pragma("unroll") for (int s = 0; s < 4; ++s) { kf[BUF_][s] = *(const bf16x8*)(kt0 + (size_t)(KT_) * 2048 + s * 512); vf[BUF_][s] = *(const bf16x8*)(vt0 + (size_t)(KT_) * 2048 + s * 512); } }
#define MOBA_STEP(KT_, BUF_)                                                                                                           \
      if ((KT_) < ntile) {                                                                                                               \
        if ((KT_) + 2 < ntile) MOBA_LOAD((KT_) + 2, ((BUF_) + 2) % 3)                                                                     \
        f32x16 X;                                                                                                                         \
        _Pragma("unroll") for (int r = 0; r < 16; ++r) X[r] = nbq;                                                                        \
        _Pragma("unroll") for (int s = 0; s < 4; ++s) X = __builtin_amdgcn_mfma_f32_32x32x16_bf16(kf[BUF_][s], *(const bf16x8*)(Qs + qi * 64 + (2 * s + hh) * 8), X, 0, 0, 0);     \
        const bool diag = own && ((KT_) == g);                                                                                            \
        unsigned pw[8];                                                                                                                   \
        _Pragma("unroll") for (int r = 0; r < 16; r += 2) {                                                                               \
          float e0 = __builtin_amdgcn_exp2f(X[r]), e1 = __builtin_amdgcn_exp2f(X[r + 1]);                                                 \
          if (diag) {                                                                                                                     \
            const int k0 = (r & 3) + 8 * (r >> 2) + 4 * hh, k1 = ((r + 1) & 3) + 8 * ((r + 1) >> 2) + 4 * hh;                             \
            e0 = (k0 <= n) ? e0 : 0.f; e1 = (k1 <= n) ? e1 : 0.f;                                                                         \
          }                                                                                                                               \
          lsum += e0 + e1;                                                                                                                \
          pw[r >> 1] = pk_bf16(e0, e1);                                                                                                   \
        }                                                                                                                                 \
        bf16x8 pf0, pf1;                                                                                                                  \
        { uint4 t0 = make_uint4(pw[0], pw[1], pw[2], pw[3]), t1 = make_uint4(pw[4], pw[5], pw[6], pw[7]);                                 \
          pf0 = *(bf16x8*)&t0; pf1 = *(bf16x8*)&t1; }                                                                                     \
        O0 = __builtin_amdgcn_mfma_f32_32x32x16_bf16(vf[BUF_][0], pf0, O0, 0, 0, 0);                                                      \
        O0 = __builtin_amdgcn_mfma_f32_32x32x16_bf16(vf[BUF_][1], pf1, O0, 0, 0, 0);                                                      \
        O1 = __builtin_amdgcn_mfma_f32_32x32x16_bf16(vf[BUF_][2], pf0, O1, 0, 0, 0);                                                      \
        O1 = __builtin_amdgcn_mfma_f32_32x32x16_bf16(vf[BUF_][3], pf1, O1, 0, 0, 0);                                                      \
      }
      MOBA_LOAD(0, 0)
      if (ntile > 1) MOBA_LOAD(1, 1)
#pragma unroll 1
      for (int kt3 = 0; kt3 < ntile; kt3 += 3) {
        MOBA_STEP(kt3, 0) MOBA_STEP(kt3 + 1, 1) MOBA_STEP(kt3 + 2, 2)
      }
#undef MOBA_STEP
#undef MOBA_LOAD
      lsum += __shfl_xor(lsum, 32);
      if (valid) {
        if (hh == 0) atomicAdd(&lacc[qi], __float2int_rn(lsum * 1048576.0f));
#pragma unroll
        for (int r = 0; r < 16; ++r) {
          const int dim = (r & 3) + 8 * (r >> 2) + 4 * hh;
          atomicAdd(&Oacc[dim * OLD + qi], __float2int_rn(O0[r] * 1048576.0f));
          atomicAdd(&Oacc[(dim + 32) * OLD + qi], __float2int_rn(O1[r] * 1048576.0f));
        }
      }
    }
    }
    __syncthreads();
    { const int q = tid >> 1, half = tid & 1;
      const float inv = 1.0f / (float)lacc[q];
      float o[32], ss = 0.f;
#pragma unroll
      for (int d = 0; d < 32; ++d) { o[d] = (float)Oacc[(half * 32 + d) * OLD + q] * inv; ss += o[d] * o[d]; }
      ss += __shfl_xor(ss, 1);
      const float r = rsqrtf(ss / 64.0f + EPS);
      bf16_t* dst = p.xb() + (size_t)(b * S + qblk * 256 + q) * KD + 256 + h * 64 + half * 32;
#pragma unroll
      for (int d = 0; d < 32; d += 8) *(uint4*)(dst + d) = make_uint4(pk_bf16(o[d] * r, o[d + 1] * r), pk_bf16(o[d + 2] * r, o[d + 3] * r), pk_bf16(o[d + 4] * r, o[d + 5] * r), pk_bf16(o[d + 6] * r, o[d + 7] * r));
    }
  }
}


__device__ __forceinline__ void phase_ret_kv(const Params& p, int gw, int ngw, int lane) {
  const int n = lane & 31, hh = lane >> 5;
  for (int w = gw; w < NB * 4 * 32; w += ngw) {
    const int bh = w >> 5, cn = w & 31;
    const bf16_t* vt = p.Vr() + ((size_t)bh * (S / 32) + cn * 4) * 2048 + lane * 8;
    const bf16_t* kt = p.Krv() + ((size_t)bh * (S / 32) + cn * 4) * 2048 + lane * 8;
    f32x16 acc[2][2];
#pragma unroll
    for (int a = 0; a < 2; ++a)
#pragma unroll
      for (int b2 = 0; b2 < 2; ++b2)
#pragma unroll
        for (int r = 0; r < 16; ++r) acc[a][b2][r] = 0.f;
#pragma unroll 1
    for (int tl = 0; tl < 4; ++tl)
#pragma unroll
      for (int ks = 0; ks < 2; ++ks) {
        bf16x8 vf[2], kf[2];
#pragma unroll
        for (int x = 0; x < 2; ++x) { vf[x] = *(const bf16x8*)(vt + tl * 2048 + (x * 2 + ks) * 512); kf[x] = *(const bf16x8*)(kt + tl * 2048 + (x * 2 + ks) * 512); }
#pragma unroll
        for (int mb = 0; mb < 2; ++mb)
#pragma unroll
          for (int nb = 0; nb < 2; ++nb) acc[mb][nb] = __builtin_amdgcn_mfma_f32_32x32x16_bf16(vf[mb], kf[nb], acc[mb][nb], 0, 0, 0);
      }
    float* dst = p.KVr() + ((size_t)bh * 32 + cn) * 4096;
#pragma unroll
    for (int mb = 0; mb < 2; ++mb)
#pragma unroll
      for (int nb = 0; nb < 2; ++nb)
#pragma unroll
        for (int r = 0; r < 16; ++r) dst[(mb * 32 + (r & 3) + 8 * (r >> 2) + 4 * hh) * 64 + nb * 32 + n] = acc[mb][nb][r];
  }
}
__device__ __forceinline__ void phase_ret_scan(const Params& p, int gtid, int ngt) {
  for (int it = gtid; it < NB * 4 * 4096; it += ngt) {
    const int e = it & 4095, bh = it >> 12, h = bh & 3;
    const float l2g = ret_log2g(h), g1 = exp2f(l2g), g127 = exp2f(127.0f * l2g), g128 = exp2f(128.0f * l2g);
    float R = 0.f; float kv[32];
#pragma unroll
    for (int cn = 0; cn < 32; ++cn) kv[cn] = p.KVr()[((size_t)bh * 32 + cn) * 4096 + e];
#pragma unroll
    for (int cn = 0; cn < 32; ++cn) {
      p.Rb()[((size_t)bh * 32 + cn) * 4096 + e] = f2bf(g1 * R);
      R = g128 * R + g127 * kv[cn];
    }
  }
}
__device__ __forceinline__ void phase_ret_out(const Params& p, int gw, int ngw, int lane) {
  const int n = lane & 31, hh = lane >> 5;
  for (int w = gw; w < NB * 4 * 32 * 4; w += ngw) {
    const int qg = 3 - (w & 3), cn = (w >> 2) & 31, bh = w >> 7, b = bh >> 2, h = bh & 3;
    const int s0 = cn * 128 + qg * 32;
    bf16x8 qf[4];
#pragma unroll
    for (int s = 0; s < 4; ++s) qf[s] = *(const bf16x8*)(p.Qr() + ((size_t)bh * S + s0 + n) * 64 + (2 * s + hh) * 8);
    f32x16 O0, O1;
#pragma unroll
    for (int r = 0; r < 16; ++r) { O0[r] = 0.f; O1[r] = 0.f; }
    { const bf16_t* rb = p.Rb() + ((size_t)bh * 32 + cn) * 4096 + (size_t)n * 64 + hh * 8;
#pragma unroll
      for (int s = 0; s < 4; ++s) {
        const bf16x8 r0 = *(const bf16x8*)(rb + s * 16), r1 = *(const bf16x8*)(rb + 32 * 64 + s * 16);
        O0 = __builtin_amdgcn_mfma_f32_32x32x16_bf16(r0, qf[s], O0, 0, 0, 0);
        O1 = __builtin_amdgcn_mfma_f32_32x32x16_bf16(r1, qf[s], O1, 0, 0, 0);
      } }
    const bf16_t* kt0 = p.Kr() + ((size_t)bh * (S / 32) + cn * 4) * 2048 + lane * 8;
    const bf16_t* vt0 = p.Vr() + ((size_t)bh * (S / 32) + cn * 4) * 2048 + lane * 8;
    for (int kt = 0; kt <= qg; ++kt) {
      bf16x8 kf[4], vf[4];
#pragma unroll
      for (int s = 0; s < 4; ++s) { kf[s] = *(const bf16x8*)(kt0 + (size_t)kt * 2048 + s * 512); vf[s] = *(const bf16x8*)(vt0 + (size_t)kt * 2048 + s * 512); }
      f32x16 X;
#pragma unroll
      for (int r = 0; r < 16; ++r) X[r] = 0.f;
#pragma unroll
      for (int s = 0; s < 4; ++s) X = __builtin_amdgcn_mfma_f32_32x32x16_bf16(kf[s], qf[s], X, 0, 0, 0);
      const bool diag = (kt == qg);
      unsigned pw[8];
#pragma unroll
      for (int r = 0; r < 16; r += 2) {
        float e0 = X[r], e1 = X[r + 1];
        if (diag) {
          const int k0 = (r & 3) + 8 * (r >> 2) + 4 * hh, k1 = ((r + 1) & 3) + 8 * ((r + 1) >> 2) + 4 * hh;
          e0 = (k0 <= n) ? e0 : 0.f; e1 = (k1 <= n) ? e1 : 0.f;
        }
        pw[r >> 1] = pk_bf16(e0, e1);
      }
      bf16x8 pf0, pf1;
      { uint4 t0 = make_uint4(pw[0], pw[1], pw[2], pw[3]), t1 = make_uint4(pw[4], pw[5], pw[6], pw[7]);
        pf0 = *(bf16x8*)&t0; pf1 = *(bf16x8*)&t1; }
      O0 = __builtin_amdgcn_mfma_f32_32x32x16_bf16(vf[0], pf0, O0, 0, 0, 0);
      O0 = __builtin_amdgcn_mfma_f32_32x32x16_bf16(vf[1], pf1, O0, 0, 0, 0);
      O1 = __builtin_amdgcn_mfma_f32_32x32x16_bf16(vf[2], pf0, O1, 0, 0, 0);
      O1 = __builtin_amdgcn_mfma_f32_32x32x16_bf16(vf[3], pf1, O1, 0, 0, 0);
    }
    float ss = 0.f;
#pragma unroll
    for (int r = 0; r < 16; ++r) ss += O0[r] * O0[r] + O1[r] * O1[r];
    ss += __shfl_xor(ss, 32);
    const float rn = rsqrtf(ss / 64.0f + EPS);
    const size_t t = (size_t)b * S + s0 + n;
    const bf16_t* gp = p.grow() + t * 256 + h * 64;
    bf16_t* yo = p.xb() + t * KD + 768 + h * 64;
#pragma unroll
    for (int q4 = 0; q4 < 4; ++q4) {
#pragma unroll
      for (int mb = 0; mb < 2; ++mb) {
        const int d0 = mb * 32 + 8 * q4 + 4 * hh;
        const uint2 gw2 = *(const uint2*)(gp + d0); const float4 g = make_float4(__uint_as_float(gw2.x << 16), __uint_as_float(gw2.x & 0xffff0000u), __uint_as_float(gw2.y << 16), __uint_as_float(gw2.y & 0xffff0000u));
        float4 o;
        const f32x16& Oa = mb ? O1 : O0;
        o.x = Oa[q4 * 4 + 0] * rn * g.x * fast_sigmoid(g.x); o.y = Oa[q4 * 4 + 1] * rn * g.y * fast_sigmoid(g.y);
        o.z = Oa[q4 * 4 + 2] * rn * g.z * fast_sigmoid(g.z); o.w = Oa[q4 * 4 + 3] * rn * g.w * fast_sigmoid(g.w);
        *(uint2*)(yo + d0) = make_uint2(pk_bf16(o.x, o.y), pk_bf16(o.z, o.w));
      }
    }
  }
}

__device__ __forceinline__ void phase_post_pack(const Params& p, int gtid, int ngt) {
  for (int idx0 = gtid; idx0 < NB * 8 * (S / 32) * 256; idx0 += 4 * ngt) {
    bf16_t v[4][8]; bool ok[4];
#pragma unroll
    for (int u = 0; u < 4; ++u) { const int idx_ = idx0 + u * ngt; ok[u] = idx_ < NB * 8 * (S / 32) * 256; const int idx = ok[u] ? idx_ : 0;
      const int ln = idx & 63, ks = (idx >> 6) & 1, mb = (idx >> 7) & 1, tile = (idx >> 8) % (S / 32), bh = idx / (256 * (S / 32));
      const int b = bh >> 3, h = bh & 7, hh = ln >> 5, delta = mb * 32 + (ln & 31);
#pragma unroll
      for (int j = 0; j < 8; ++j) { const int kappa = 16 * ks + 8 * (j >> 2) + 4 * hh + (j & 3), s = tile * 32 + kappa; v[u][j] = p.vrow()[(size_t)(b * S + s) * 512 + h * 64 + delta]; } }
#pragma unroll
    for (int u = 0; u < 4; ++u) if (ok[u])
      *(uint4*)(p.Vm() + (size_t)(idx0 + u * ngt) * 8) = make_uint4(v[u][0] | ((unsigned)v[u][1] << 16), v[u][2] | ((unsigned)v[u][3] << 16), v[u][4] | ((unsigned)v[u][5] << 16), v[u][6] | ((unsigned)v[u][7] << 16));
  }
  for (int idx0 = gtid; idx0 < 2 * NB * 4 * (S / 32) * 256; idx0 += 4 * ngt) {
    bf16_t v[4][8]; bool ok[4];
#pragma unroll
    for (int u = 0; u < 4; ++u) { const int idx_ = idx0 + u * ngt; ok[u] = idx_ < 2 * NB * 4 * (S / 32) * 256; const int idx = ok[u] ? idx_ : 0;
      const int ln = idx & 63, ks = (idx >> 6) & 1, blk = (idx >> 7) & 1, tile = (idx >> 8) % (S / 32), rest = idx / (256 * (S / 32)), bh = rest % (NB * 4), which = rest / (NB * 4);
      const int b = bh >> 2, h = bh & 3, hh = ln >> 5, delta = blk * 32 + (ln & 31);
      const bf16_t* srcp = which ? p.krow() : p.vrrow();
#pragma unroll
      for (int j = 0; j < 8; ++j) { const int kappa = 16 * ks + 8 * (j >> 2) + 4 * hh + (j & 3), s = tile * 32 + kappa; v[u][j] = srcp[(size_t)(b * S + s) * 256 + h * 64 + delta]; } }
#pragma unroll
    for (int u = 0; u < 4; ++u) if (ok[u]) { const int idx = idx0 + u * ngt; const int which = (idx / (256 * (S / 32))) / (NB * 4);
      *(uint4*)((which ? p.Krv() : p.Vr()) + ((size_t)(idx % (NB * 4 * (S / 32) * 256))) * 8) = make_uint4(v[u][0] | ((unsigned)v[u][1] << 16), v[u][2] | ((unsigned)v[u][3] << 16), v[u][4] | ((unsigned)v[u][5] << 16), v[u][6] | ((unsigned)v[u][7] << 16)); }
  }
}
__device__ __forceinline__ void phase_kmean2(const Params& p, int gtid, int ngt) {
  const int lane = gtid & 63, half = lane >> 5;
  for (int w = gtid >> 6; w < NB * 8 * 16; w += ngt >> 6) {
    const int j = w & 15, bh = w >> 4;
    const bf16_t* kp = p.Km() + ((size_t)bh * (S / 32) + j * 8) * 2048 + lane * 8;
    float acc[4][8];
#pragma unroll
    for (int i = 0; i < 4; ++i)
#pragma unroll
      for (int e = 0; e < 8; ++e) acc[i][e] = 0.f;
#pragma unroll
    for (int t2 = 0; t2 < 8; t2 += 2) {
      uint4 r[2][4];
#pragma unroll
      for (int tt = 0; tt < 2; ++tt)
#pragma unroll
        for (int i = 0; i < 4; ++i) r[tt][i] = *(const uint4*)(kp + (size_t)(t2 + tt) * 2048 + i * 512);
#pragma unroll
      for (int tt = 0; tt < 2; ++tt)
#pragma unroll
        for (int i = 0; i < 4; ++i) { const unsigned w4[4] = {r[tt][i].x, r[tt][i].y, r[tt][i].z, r[tt][i].w};
#pragma unroll
          for (int q = 0; q < 4; ++q) { acc[i][2 * q] += __uint_as_float(w4[q] << 16); acc[i][2 * q + 1] += __uint_as_float(w4[q] & 0xffff0000u); } }
    }
#pragma unroll
    for (int i = 0; i < 4; ++i)
#pragma unroll
      for (int e = 0; e < 8; ++e) { float a = acc[i][e];
        a += __shfl_xor(a, 1); a += __shfl_xor(a, 2); a += __shfl_xor(a, 4); a += __shfl_xor(a, 8); a += __shfl_xor(a, 16); acc[i][e] = a; }
    if ((lane & 31) == 0) {
#pragma unroll
      for (int i = 0; i < 4; ++i) { float* dst = p.kmean() + (size_t)w * 64 + (2 * i + half) * 8;
        *(float4*)dst = make_float4(acc[i][0] * (1.0f / 256.0f), acc[i][1] * (1.0f / 256.0f), acc[i][2] * (1.0f / 256.0f), acc[i][3] * (1.0f / 256.0f));
        *(float4*)(dst + 4) = make_float4(acc[i][4] * (1.0f / 256.0f), acc[i][5] * (1.0f / 256.0f), acc[i][6] * (1.0f / 256.0f), acc[i][7] * (1.0f / 256.0f)); }
    }
  }
}

__device__ __forceinline__ void cvt_f32_bf16(const float* __restrict__ src, bf16_t* __restrict__ dst, size_t n8, int gtid, int ngt) {
  for (size_t i = gtid; i < n8; i += ngt) {
    float4 a = *(const float4*)(src + i * 8), b4 = *(const float4*)(src + i * 8 + 4);
    uint4 o; o.x = pk_bf16(a.x, a.y); o.y = pk_bf16(a.z, a.w); o.z = pk_bf16(b4.x, b4.y); o.w = pk_bf16(b4.z, b4.w);
    *(uint4*)(dst + i * 8) = o;
  }
}
__device__ __forceinline__ int f2key(float f) { int b = __float_as_int(f); return b ^ ((b >> 31) & 0x7fffffff); }
__device__ __forceinline__ float key2f(int k) { return __int_as_float(k ^ ((k >> 31) & 0x7fffffff)); }
#define CASD(a_, b_) { int mx_ = max(a_, b_), mn_ = min(a_, b_); a_ = mx_; b_ = mn_; }
__device__ __forceinline__ void sort16_desc(int (&v)[16]) {
#pragma unroll
  for (int k = 2; k <= 16; k <<= 1)
#pragma unroll
    for (int j = k >> 1; j > 0; j >>= 1)
#pragma unroll
      for (int i = 0; i < 16; ++i) { const int l2 = i ^ j; if (l2 > i) { if ((i & k) == 0) CASD(v[i], v[l2]) else CASD(v[l2], v[i]) } }
}
__device__ __forceinline__ void merge_top16(int (&a)[16], const int (&b)[16]) {
#pragma unroll
  for (int i = 0; i < 16; ++i) a[i] = max(a[i], b[15 - i]);
#pragma unroll
  for (int j = 8; j > 0; j >>= 1)
#pragma unroll
    for (int i = 0; i < 16; ++i) { const int l2 = i ^ j; if (l2 > i) CASD(a[i], a[l2]) }
}
__device__ __forceinline__ int lut4(int w0, int w1, int w2, int w3, int i) {
  const int w = i >> 2; const int d = (w == 0) ? w0 : (w == 1) ? w1 : (w == 2) ? w2 : w3;
  return (d >> ((i & 3) * 8)) & 127;
}

__device__ __forceinline__ void phase_peer_topk(const Params& p, int l, int gw, int ngw, int lane) {
  const int n = lane & 31, hh = lane >> 5;
  const bf16_t* skl = p.skb() + (size_t)l * 16 * 128 * 64;
  for (int w = gw; w < (T / 32) * 8; w += ngw) {
    const int tg = w >> 3, h = w & 7, t = tg * 32 + n;
    int L0[16], L1[16];
#pragma unroll
    for (int c = 0; c < 2; ++c) {
      const int hc = 2 * h + c;
      bf16x8 qf[4];
#pragma unroll
      for (int s = 0; s < 4; ++s) qf[s] = *(const bf16x8*)(p.qb() + (size_t)t * D + hc * 64 + 16 * s + 8 * hh);
      int A[16], Bq[16];
#pragma unroll
      for (int mb = 0; mb < 4; ++mb) {
        f32x16 X;
#pragma unroll
        for (int r = 0; r < 16; ++r) X[r] = 0.f;
#pragma unroll
        for (int s = 0; s < 4; ++s) {
          const bf16x8 kf = *(const bf16x8*)(skl + ((size_t)(hc * 128 + mb * 32 + n)) * 64 + 16 * s + 8 * hh);
          X = __builtin_amdgcn_mfma_f32_32x32x16_bf16(kf, qf[s], X, 0, 0, 0);
        }
        int Gk[16];
#pragma unroll
        for (int r = 0; r < 16; ++r) Gk[r] = (f2key(X[r]) & ~127) | (mb * 32 + (r & 3) + 8 * (r >> 2) + 4 * hh);
        sort16_desc(Gk);
        if (mb == 0) {
#pragma unroll
          for (int r = 0; r < 16; ++r) A[r] = Gk[r];
        } else merge_top16(A, Gk);
      }
#pragma unroll
      for (int r = 0; r < 16; ++r) Bq[r] = __shfl_xor(A[r], 32);
      merge_top16(A, Bq);
#pragma unroll
      for (int r = 0; r < 16; ++r) { if (c == 0) L0[r] = A[r]; else L1[r] = A[r]; }
    }
    float av[16], bv[16];
#pragma unroll
    for (int r = 0; r < 16; ++r) { av[r] = key2f(L0[r] & ~127); bv[r] = key2f(L1[r] & ~127); }
#define CAND(i_, j_) ((f2key(av[i_] + bv[j_]) & ~255) | ((i_) << 4) | (j_))
    int R[16], G1[16], G2[16];
#pragma unroll
    for (int j = 0; j < 16; ++j) R[j] = CAND(0, j);
    G1[0] = CAND(1, 0); G1[1] = CAND(1, 1); G1[2] = CAND(1, 2); G1[3] = CAND(1, 3); G1[4] = CAND(1, 4); G1[5] = CAND(1, 5); G1[6] = CAND(1, 6); G1[7] = CAND(1, 7);
    G1[8] = CAND(2, 0); G1[9] = CAND(2, 1); G1[10] = CAND(2, 2); G1[11] = CAND(2, 3); G1[12] = CAND(2, 4); G1[13] = CAND(3, 0); G1[14] = CAND(3, 1); G1[15] = CAND(3, 2);
    G2[0] = CAND(3, 3); G2[1] = CAND(4, 0); G2[2] = CAND(4, 1); G2[3] = CAND(4, 2); G2[4] = CAND(5, 0); G2[5] = CAND(5, 1); G2[6] = CAND(6, 0); G2[7] = CAND(6, 1);
    G2[8] = CAND(7, 0); G2[9] = CAND(7, 1); G2[10] = CAND(8, 0); G2[11] = CAND(9, 0); G2[12] = CAND(10, 0); G2[13] = CAND(11, 0); G2[14] = CAND(12, 0); G2[15] = CAND(13, 0);
    sort16_desc(G1); merge_top16(R, G1);
    sort16_desc(G2); merge_top16(R, G2);
    { int x0 = CAND(14, 0), x1 = CAND(15, 0);
#pragma unroll
      for (int i = 0; i < 16; ++i) CASD(R[i], x0)
#pragma unroll
      for (int i = 0; i < 16; ++i) CASD(R[i], x1)
    }
#undef CAND
    int pa0 = 0, pa1 = 0, pa2 = 0, pa3 = 0, pb0 = 0, pb1 = 0, pb2 = 0, pb3 = 0;
#pragma unroll
    for (int q = 0; q < 4; ++q) {
      pa0 |= (L0[q] & 127) << (8 * q); pa1 |= (L0[4 + q] & 127) << (8 * q); pa2 |= (L0[8 + q] & 127) << (8 * q); pa3 |= (L0[12 + q] & 127) << (8 * q);
      pb0 |= (L1[q] & 127) << (8 * q); pb1 |= (L1[4 + q] & 127) << (8 * q); pb2 |= (L1[8 + q] & 127) << (8 * q); pb3 |= (L1[12 + q] & 127) << (8 * q);
    }
    float ev[16], sum = 0.f; int ei[16];
    const float mx = key2f(R[0] & ~255);
#pragma unroll
    for (int z = 0; z < 16; ++z) {
      const float v = key2f(R[z] & ~255);
      ev[z] = __expf(v - mx); sum += ev[z];
      const int pay = R[z] & 255;
      ei[z] = lut4(pa0, pa1, pa2, pa3, pay >> 4) * 128 + lut4(pb0, pb1, pb2, pb3, pay & 15);
    }
    const float inv = 1.0f / sum;
    if (hh == 0) {
      float* go = p.gates() + ((size_t)t * 8 + h) * 16; int* eo = p.eidx() + ((size_t)t * 8 + h) * 16;
#pragma unroll
      for (int z = 0; z < 16; z += 4) {
        *(float4*)(go + z) = make_float4(ev[z] * inv, ev[z + 1] * inv, ev[z + 2] * inv, ev[z + 3] * inv);
        *(int4*)(eo + z) = make_int4(ei[z], ei[z + 1], ei[z + 2], ei[z + 3]);
      }
    }
  }
}


typedef int v8i __attribute__((ext_vector_type(8)));
__device__ __forceinline__ unsigned xcc_id() { return (unsigned)__builtin_amdgcn_s_getreg((3 << 11) | 20) & 7u; }
__device__ __forceinline__ float pow2_scale(float amax) {
  if (!(amax > 0.f)) return 1.0f;
  const int e = (int)floorf(log2f(240.0f / amax));
  return exp2f((float)(e < 60 ? (e > -60 ? e : -60) : 60));
}
__device__ __forceinline__ unsigned pack4_fp8(float a, float b, float c, float d) {
  int v = __builtin_amdgcn_cvt_pk_fp8_f32(a, b, 0, false);
  v = __builtin_amdgcn_cvt_pk_fp8_f32(c, d, v, true);
  return (unsigned)v;
}
__device__ __forceinline__ void cvt_table_i8(const float* __restrict__ src, unsigned char* __restrict__ dst, float* __restrict__ scl, int gw, int ngw, int lane) {
  for (int e0 = gw; e0 < 16384; e0 += 2 * ngw) {
    float4 v[2][4];
#pragma unroll
    for (int u = 0; u < 2; ++u) { const int e = (e0 + u * ngw < 16384) ? e0 + u * ngw : e0;
#pragma unroll
      for (int k = 0; k < 4; ++k) v[u][k] = *(const float4*)(src + (size_t)e * D + k * 256 + lane * 4); }
#pragma unroll
    for (int u = 0; u < 2; ++u) {
      const int e = e0 + u * ngw;
      if (e < 16384) {
        float am = 0.f;
#pragma unroll
        for (int k = 0; k < 4; ++k) am = fmaxf(am, fmaxf(fmaxf(fabsf(v[u][k].x), fabsf(v[u][k].y)), fmaxf(fabsf(v[u][k].z), fabsf(v[u][k].w))));
        am = wave_max(am);
        const float s = am > 0.f ? 127.0f / am : 1.0f;
        if (lane == 0) scl[e] = s;
#pragma unroll
        for (int k = 0; k < 4; ++k) {
          const int slice = 2 * k + (lane >> 5), off = (lane & 31) * 4;
          const unsigned w = (unsigned)(__float2int_rn(v[u][k].x * s) & 255) | ((unsigned)(__float2int_rn(v[u][k].y * s) & 255) << 8) |
                             ((unsigned)(__float2int_rn(v[u][k].z * s) & 255) << 16) | ((unsigned)(__float2int_rn(v[u][k].w * s) & 255) << 24);
          *(unsigned*)(dst + ((size_t)slice * 16384 + e) * 128 + off) = w;
        }
      }
    }
  }
}
__device__ __forceinline__ void cvt_table_fp8(const float* __restrict__ src, unsigned char* __restrict__ dst, float* __restrict__ scl, int gw, int ngw, int lane) {
  for (int e0 = gw; e0 < 16384; e0 += 2 * ngw) {
    float4 v[2][4];
#pragma unroll
    for (int u = 0; u < 2; ++u) { const int e = (e0 + u * ngw < 16384) ? e0 + u * ngw : e0;
#pragma unroll
      for (int k = 0; k < 4; ++k) v[u][k] = *(const float4*)(src + (size_t)e * D + k * 256 + lane * 4); }
#pragma unroll
    for (int u = 0; u < 2; ++u) {
      const int e = e0 + u * ngw;
      if (e < 16384) {
        float am = 0.f;
#pragma unroll
        for (int k = 0; k < 4; ++k) am = fmaxf(am, fmaxf(fmaxf(fabsf(v[u][k].x), fabsf(v[u][k].y)), fmaxf(fabsf(v[u][k].z), fabsf(v[u][k].w))));
        am = wave_max(am);
        const float s = pow2_scale(am);
        if (lane == 0) scl[e] = s;
#pragma unroll
        for (int k = 0; k < 4; ++k) {
          const int slice = 2 * k + (lane >> 5), off = (lane & 31) * 4;
          *(unsigned*)(dst + ((size_t)slice * 16384 + e) * 128 + off) = pack4_fp8(v[u][k].x * s, v[u][k].y * s, v[u][k].z * s, v[u][k].w * s);
        }
      }
    }
  }
}
#define DPP_ADD(v_, ctrl_) ((v_) + __builtin_bit_cast(float, __builtin_amdgcn_update_dpp(0, __builtin_bit_cast(int, (v_)), (ctrl_), 0xF, 0xF, true)))
__device__ __forceinline__ float sum_xor16(float x) { float a = x, b = x; asm volatile("v_nop\n\tv_nop\n\tv_permlane16_swap_b32 %0, %1" : "+v"(a), "+v"(b)); return a + b; }
__device__ __forceinline__ float sum_xor32(float x) { float a = x, b = x; asm volatile("v_nop\n\tv_nop\n\tv_permlane32_swap_b32 %0, %1" : "+v"(a), "+v"(b)); return a + b; }
constexpr int PEER_TILE = 128;
__device__ __forceinline__ void phase_peer_u(const Params& p, int* heads, unsigned char* lds, int tid) {
  const int lane = tid & 63, wv = tid >> 6, r8 = lane >> 3, c8 = lane & 7;
  int* bc = (int*)lds;
  int* eW = (int*)(lds + 1024 + wv * 12288);
  bf16_t* hW = (bf16_t*)(lds + 1024 + wv * 12288 + 8192);
  {
    const int s = (int)blockIdx.x & 7, nbs = ((int)gridDim.x - s + 7) >> 3;
    const unsigned char* Us = p.U8s() + (size_t)s * 16384 * 128 + c8 * 16;
    const int item0 = ((int)blockIdx.x >> 3) * NWAVE + __builtin_amdgcn_readfirstlane(wv), istep = nbs * NWAVE;
    uint2 ev[16]; uint4 hq0, hq1, hq2, hq3;
#define PEER_U_STAGE_E(T0_) { _Pragma("unroll") for (int k = 0; k < 16; ++k) ev[k] = *(const uint2*)(p.eidx() + (size_t)((T0_) + k) * 128 + lane * 2); }
#define PEER_U_STAGE_H(T0_) { const bf16_t* hsrc = p.hb() + ((size_t)s * T + (T0_)) * 128 + lane * 8;     \
        hq0 = *(const uint4*)(hsrc); hq1 = *(const uint4*)(hsrc + 512); hq2 = *(const uint4*)(hsrc + 1024); hq3 = *(const uint4*)(hsrc + 1536); }
    if (item0 < T / 16) { PEER_U_STAGE_E(item0 * 16) PEER_U_STAGE_H(item0 * 16) }
    for (int item = item0; item < T / 16; item += istep) {
      const int t0 = item * 16, t1 = t0 + istep * 16; const bool more = item + istep < T / 16;
      LDS_FENCE();
      {
#pragma unroll
        for (int k = 0; k < 16; ++k) *(uint2*)(eW + k * 128 + lane * 2) = ev[k];
        *(uint4*)(hW + lane * 8) = hq0; *(uint4*)(hW + 512 + lane * 8) = hq1; *(uint4*)(hW + 1024 + lane * 8) = hq2; *(uint4*)(hW + 1536 + lane * 8) = hq3; }
      LDS_FENCE();
      uint4 R[4][8];
#define PEER_U_LOAD(M_, BUF_) { _Pragma("unroll") for (int eb = 0; eb < 8; ++eb) R[BUF_][eb] = *(const uint4*)(Us + (size_t)eW[(M_) * 64 + eb * 8 + r8] * 128); }
      if (!(PROBE_SKIP & 128)) { PEER_U_LOAD(0, 0) PEER_U_LOAD(1, 1) PEER_U_LOAD(2, 2) } else { _Pragma("unroll") for (int a_ = 0; a_ < 4; ++a_) _Pragma("unroll") for (int b_ = 0; b_ < 8; ++b_) R[a_][b_] = make_uint4(0u, 0u, 0u, 0u); }
      int hq[4]; float hinv = 0.f; float res0 = 0.f, res1 = 0.f;
#define PEER_U_LOADH(TOK_) { const bf16_t* hp = hW + (TOK_) * 128 + c8 * 16; const uint4 a = *(const uint4*)hp, b4 = *(const uint4*)(hp + 8); \
        const unsigned w8[8] = {a.x, a.y, a.z, a.w, b4.x, b4.y, b4.z, b4.w}; float hv[16]; float am = 0.f;                               \
        _Pragma("unroll") for (int z = 0; z < 8; ++z) { hv[2 * z] = __uint_as_float(w8[z] << 16); hv[2 * z + 1] = __uint_as_float(w8[z] & 0xffff0000u); \
          am = fmaxf(am, fmaxf(fabsf(hv[2 * z]), fabsf(hv[2 * z + 1]))); }                                                                \
        am = fmaxf(am, __builtin_bit_cast(float, __builtin_amdgcn_update_dpp(0, __builtin_bit_cast(int, am), 0xB1, 0xF, 0xF, true)));     \
        am = fmaxf(am, __builtin_bit_cast(float, __builtin_amdgcn_update_dpp(0, __builtin_bit_cast(int, am), 0x4E, 0xF, 0xF, true)));     \
        am = fmaxf(am, __builtin_bit_cast(float, __builtin_amdgcn_update_dpp(0, __builtin_bit_cast(int, am), 0x141, 0xF, 0xF, true)));    \
        const float hs = am > 0.f ? 127.0f / am : 1.0f; hinv = am > 0.f ? am * (1.0f / 127.0f) : 1.0f;                                    \
        _Pragma("unroll") for (int z = 0; z < 4; ++z) hq[z] = (__float2int_rn(hv[4 * z] * hs) & 255) | ((__float2int_rn(hv[4 * z + 1] * hs) & 255) << 8) | \
                                                               ((__float2int_rn(hv[4 * z + 2] * hs) & 255) << 16) | (__float2int_rn(hv[4 * z + 3] * hs) << 24); }
      PEER_U_LOADH(0)
#define PEER_U_HALF(M_, BUF_, HALF_)                                                                           \
      {                                                                                                                                   \
        if (!(PROBE_SKIP & 128)) { if ((M_) + 3 < 32) PEER_U_LOAD((M_) + 3, ((BUF_) + 3) & 3) }                                             \
        if ((M_) == 29 && more) PEER_U_STAGE_E(t1)                                                                                          \
        if ((M_) == 30 && more) PEER_U_STAGE_H(t1)                                                                                          \
        if (!(PROBE_SKIP & 128)) _Pragma("unroll") for (int eb = 0; eb < 8; ++eb) {                                                       \
          int di = __builtin_amdgcn_sdot4((int)R[BUF_][eb].x, hq[0], 0, false);                                                           \
          di = __builtin_amdgcn_sdot4((int)R[BUF_][eb].y, hq[1], di, false);                                                              \
          di = __builtin_amdgcn_sdot4((int)R[BUF_][eb].z, hq[2], di, false);                                                              \
          di = __builtin_amdgcn_sdot4((int)R[BUF_][eb].w, hq[3], di, false);                                                              \
          di += __builtin_amdgcn_update_dpp(0, di, 0xB1, 0xF, 0xF, true); di += __builtin_amdgcn_update_dpp(0, di, 0x4E, 0xF, 0xF, true);   \
          di += __builtin_amdgcn_update_dpp(0, di, 0x141, 0xF, 0xF, true);     \
          const float d = (float)di * hinv;                                                                                               \
          if ((HALF_) == 0) { if (c8 == eb) res0 = d; } else { if (c8 == eb) res1 = d; }                                                  \
        }                                                                                                                                 \
        if ((HALF_) == 1) {                                                                                                               \
          bf16_t* po = p.ppart() + ((size_t)s * T + t0 + ((M_) >> 1)) * 128;                                                              \
          po[c8 * 8 + r8] = f2bf(res0); po[64 + c8 * 8 + r8] = f2bf(res1);                                                                \
          if ((M_) + 1 < 32) PEER_U_LOADH(((M_) >> 1) + 1)                                                                                \
        }                                                                                                                                 \
      }
#pragma unroll
      for (int m4 = 0; m4 < 32; m4 += 4) {
        PEER_U_HALF(m4, 0, 0) PEER_U_HALF(m4 + 1, 1, 1) PEER_U_HALF(m4 + 2, 2, 0) PEER_U_HALF(m4 + 3, 3, 1)
      }
#undef PEER_U_HALF
#undef PEER_U_LOADH
#undef PEER_U_LOAD
#undef PEER_U_STAGE_E
#undef PEER_U_STAGE_H
    }
  }
}
__device__ __forceinline__ void phase_peer_r(const Params& p, int gtid, int ngt) {
  for (int g0 = gtid; g0 < T * 128 / 8; g0 += 2 * ngt) {
    uint4 pp[2][8]; uint4 ev[2][2]; float4 gv[2][2]; float su_[2][8], sv_[2][8]; float rs[2]; bool ok[2];
#pragma unroll
    for (int u = 0; u < 2; ++u) { const int g = g0 + u * ngt; ok[u] = g < T * 128 / 8; const size_t ix = ok[u] ? (size_t)g * 8 : 0;
#pragma unroll
      for (int s = 0; s < 8; ++s) pp[u][s] = *(const uint4*)(p.ppart() + (size_t)s * T * 128 + ix);
      ev[u][0] = *(const uint4*)(p.eidx() + ix); ev[u][1] = *(const uint4*)(p.eidx() + ix + 4);
      gv[u][0] = *(const float4*)(p.gates() + ix); gv[u][1] = *(const float4*)(p.gates() + ix + 4);
      rs[u] = p.rstd()[ix >> 7]; }
#pragma unroll
    for (int u = 0; u < 2; ++u) { const int e8[8] = {(int)ev[u][0].x, (int)ev[u][0].y, (int)ev[u][0].z, (int)ev[u][0].w, (int)ev[u][1].x, (int)ev[u][1].y, (int)ev[u][1].z, (int)ev[u][1].w};
#pragma unroll
      for (int k = 0; k < 8; ++k) { su_[u][k] = p.su()[e8[k]]; sv_[u][k] = p.sv()[e8[k]]; } }
#pragma unroll
    for (int u = 0; u < 2; ++u) if (ok[u]) {
      float d[8];
#pragma unroll
      for (int k = 0; k < 8; ++k) d[k] = 0.f;
#pragma unroll
      for (int s = 0; s < 8; ++s) { const unsigned w[4] = {pp[u][s].x, pp[u][s].y, pp[u][s].z, pp[u][s].w};
#pragma unroll
        for (int q = 0; q < 4; ++q) { d[2 * q] += __uint_as_float(w[q] << 16); d[2 * q + 1] += __uint_as_float(w[q] & 0xffff0000u); } }
      const float gg[8] = {gv[u][0].x, gv[u][0].y, gv[u][0].z, gv[u][0].w, gv[u][1].x, gv[u][1].y, gv[u][1].z, gv[u][1].w};
      float o[8];
#pragma unroll
      for (int k = 0; k < 8; ++k) o[k] = gg[k] * gelu_tanh(d[k] * rs[u] / su_[u][k]) / sv_[u][k];
      float* dst = p.gates() + (size_t)(g0 + u * ngt) * 8;
      *(float4*)dst = make_float4(o[0], o[1], o[2], o[3]); *(float4*)(dst + 4) = make_float4(o[4], o[5], o[6], o[7]);
    }
  }
}
__device__ __forceinline__ void phase_peer_v(const Params& p, int* heads, unsigned char* lds, int tid) {
  const int lane = tid & 63, wv = tid >> 6, r8 = lane >> 3, c8 = lane & 7;
  int* bc = (int*)lds;
  uint2* pW = (uint2*)(lds + 1024 + wv * 16384);
  {
    const int s = (int)blockIdx.x & 7, nbs = ((int)gridDim.x - s + 7) >> 3;
    const unsigned char* Vs = p.V8s() + (size_t)s * 16384 * 128 + c8 * 16;
    const int item0 = ((int)blockIdx.x >> 3) * NWAVE + __builtin_amdgcn_readfirstlane(wv), istep = nbs * NWAVE;
    uint2 e2[16], g2[16];
#define PEER_V_STAGE_E(T0_) { _Pragma("unroll") for (int k = 0; k < 16; ++k) e2[k] = *(const uint2*)(p.eidx() + (size_t)((T0_) + k) * 128 + lane * 2); }
#define PEER_V_STAGE_G(T0_) { _Pragma("unroll") for (int k = 0; k < 16; ++k) g2[k] = *(const uint2*)(p.gates() + (size_t)((T0_) + k) * 128 + lane * 2); }
    if (item0 < T / 16) { PEER_V_STAGE_E(item0 * 16) PEER_V_STAGE_G(item0 * 16) }
    for (int item = item0; item < T / 16; item += istep) {
      const int t0 = item * 16, t1 = t0 + istep * 16; const bool more = item + istep < T / 16;
      LDS_FENCE();
      {
#pragma unroll
        for (int k = 0; k < 16; ++k) *(uint4*)(pW + k * 128 + lane * 2) = make_uint4(e2[k].x, g2[k].x, e2[k].y, g2[k].y); }
      LDS_FENCE();
      const int rowk = lane >> 4, prow = ((rowk & 1) << 1) | (rowk >> 1);
      const bool wr_lane = (lane & 8) == 0;
      const int xoff = s * 128 + c8 * 16 + prow * 4;
      float4 xo[8];
#pragma unroll
      for (int k = 0; k < 8; ++k) xo[k] = *(const float4*)(p.outp() + (size_t)(t0 + k) * D + xoff);
      uint4 R[3][8];
#define PEER_V_LOAD(M_, BUF_) { _Pragma("unroll") for (int eb = 0; eb < 8; ++eb) R[BUF_][eb] = *(const uint4*)(Vs + (size_t)pW[(M_) * 64 + eb * 8 + r8].x * 128); }
      if (!(PROBE_SKIP & 64)) { PEER_V_LOAD(0, 0) PEER_V_LOAD(1, 1) } else { _Pragma("unroll") for (int a_ = 0; a_ < 3; ++a_) _Pragma("unroll") for (int b_ = 0; b_ < 8; ++b_) R[a_][b_] = make_uint4(0u, 0u, 0u, 0u); }
      float acc[16];
#define PEER_V_HALF(M_, BUF_, HALF_)                                                           \
      {                                                                                                                                   \
        if (!(PROBE_SKIP & 64)) { if ((M_) + 2 < 32) PEER_V_LOAD((M_) + 2, ((BUF_) + 2) % 3) }                                              \
        if ((M_) == 30 && more) PEER_V_STAGE_E(t1)                                                                                          \
        if ((M_) == 31 && more) PEER_V_STAGE_G(t1)                                                                                          \
        if ((HALF_) == 0) { _Pragma("unroll") for (int z = 0; z < 16; ++z) acc[z] = 0.f; }                                                \
        if (!(PROBE_SKIP & 64)) _Pragma("unroll") for (int eb = 0; eb < 8; ++eb) {                                                        \
          const float c = __uint_as_float(pW[(M_) * 64 + eb * 8 + r8].y);                                                                 \
          const unsigned ww[4] = {R[BUF_][eb].x, R[BUF_][eb].y, R[BUF_][eb].z, R[BUF_][eb].w};                                            \
          _Pragma("unroll") for (int q4 = 0; q4 < 4; ++q4) {                                                                              \
            const auto f01 = __builtin_amdgcn_cvt_pk_f32_fp8((int)ww[q4], false); const auto f23 = __builtin_amdgcn_cvt_pk_f32_fp8((int)ww[q4], true); \
            acc[q4 * 4 + 0] = fmaf(c, f01[0], acc[q4 * 4 + 0]); acc[q4 * 4 + 1] = fmaf(c, f01[1], acc[q4 * 4 + 1]);                       \
            acc[q4 * 4 + 2] = fmaf(c, f23[0], acc[q4 * 4 + 2]); acc[q4 * 4 + 3] = fmaf(c, f23[1], acc[q4 * 4 + 3]);                       \
          }                                                                                                                               \
        }                                                                                                                                 \
        if ((HALF_) == 1) {                                                                                                               \
          _Pragma("unroll") for (int z = 0; z < 16; ++z) acc[z] = DPP_ADD(acc[z], 0x128);                                  \
          asm volatile("v_nop\n\tv_nop\n\tv_permlane16_swap_b32 %0, %8\n\tv_permlane16_swap_b32 %1, %9\n\tv_permlane16_swap_b32 %2, %10\n\tv_permlane16_swap_b32 %3, %11\n\t" \
                       "v_permlane16_swap_b32 %4, %12\n\tv_permlane16_swap_b32 %5, %13\n\tv_permlane16_swap_b32 %6, %14\n\tv_permlane16_swap_b32 %7, %15" \
            : "+v"(acc[0]), "+v"(acc[1]), "+v"(acc[2]), "+v"(acc[3]), "+v"(acc[4]), "+v"(acc[5]), "+v"(acc[6]), "+v"(acc[7]),                   \
              "+v"(acc[8]), "+v"(acc[9]), "+v"(acc[10]), "+v"(acc[11]), "+v"(acc[12]), "+v"(acc[13]), "+v"(acc[14]), "+v"(acc[15]));               \
          _Pragma("unroll") for (int z = 0; z < 8; ++z) acc[z] += acc[z + 8];            \
          asm volatile("v_nop\n\tv_nop\n\tv_permlane32_swap_b32 %0, %4\n\tv_permlane32_swap_b32 %1, %5\n\tv_permlane32_swap_b32 %2, %6\n\tv_permlane32_swap_b32 %3, %7" \
            : "+v"(acc[0]), "+v"(acc[1]), "+v"(acc[2]), "+v"(acc[3]), "+v"(acc[4]), "+v"(acc[5]), "+v"(acc[6]), "+v"(acc[7]));                   \
          float4 dl;                                                                                                                      \
          dl.x = acc[0] + acc[4]; dl.y = acc[1] + acc[5]; dl.z = acc[2] + acc[6]; dl.w = acc[3] + acc[7];     \
          const float4 xv = xo[((M_) >> 1) & 7];                                                                                          \
          if (((M_) >> 1) + 8 < 16) xo[((M_) >> 1) & 7] = *(const float4*)(p.outp() + (size_t)(t0 + ((M_) >> 1) + 8) * D + xoff);                  \
          const float4 xn = make_float4(xv.x + dl.x, xv.y + dl.y, xv.z + dl.z, xv.w + dl.w);                                              \
          float sq = 0.f;                                                                                                                 \
          if (wr_lane) {                                                                                                                  \
            *(float4*)(p.outp() + (size_t)(t0 + ((M_) >> 1)) * D + xoff) = xn;                                                             \
            *(uint2*)(p.xb() + (size_t)(t0 + ((M_) >> 1)) * KD + xoff) = make_uint2(pk_bf16(xn.x, xn.y), pk_bf16(xn.z, xn.w));     \
            sq = (xn.x * xn.x + xn.y * xn.y) + (xn.z * xn.z + xn.w * xn.w);                                                                \
          }                                                                                                                               \
          sq = DPP_ADD(sq, 0xB1); sq = DPP_ADD(sq, 0x4E); sq = DPP_ADD(sq, 0x141); sq = DPP_ADD(sq, 0x128); sq = sum_xor16(sq); sq = sum_xor32(sq);     \
          if (lane == 0) p.ssq1()[(size_t)(t0 + ((M_) >> 1)) * 8 + s] = sq;                                                               \
        }                                                                                                                                 \
      }
#pragma unroll
      for (int m6 = 0; m6 < 30; m6 += 6) {
        PEER_V_HALF(m6, 0, 0) PEER_V_HALF(m6 + 1, 1, 1) PEER_V_HALF(m6 + 2, 2, 0) PEER_V_HALF(m6 + 3, 0, 1) PEER_V_HALF(m6 + 4, 1, 0) PEER_V_HALF(m6 + 5, 2, 1)
      }
      PEER_V_HALF(30, 0, 0) PEER_V_HALF(31, 1, 1)
#undef PEER_V_HALF
#undef PEER_V_LOAD
#undef PEER_V_STAGE_E
#undef PEER_V_STAGE_G
    }
  }
}

#if PEER_CHECK
constexpr int CHK_N = 512;
__device__ __forceinline__ float* chk_x(const Params& p) { return (float*)(p.ws + WO_ybuf); }
__device__ __forceinline__ float* chk_m(const Params& p) { return (float*)(p.ws + WO_ybuf + (size_t)CHK_N * D * 4); }
__device__ __forceinline__ float* chk_g(const Params& p) { return (float*)(p.ws + WO_ybuf + (size_t)CHK_N * D * 4 + 4096); }
__device__ __forceinline__ void chk_save(const Params& p, int gtid, int ngt) {
  for (int i = gtid; i < CHK_N * D; i += ngt) chk_x(p)[i] = p.outp()[(size_t)(i / D) * 64 * D + (i % D)];
  for (int i = gtid; i < CHK_N * 128; i += ngt) chk_g(p)[i] = p.gates()[(size_t)(i / 128) * 64 * 128 + (i % 128)];
  if (gtid < 16) chk_m(p)[gtid] = 0.f;
}
__device__ __forceinline__ void chk_apply(const Params& p, int l, float* coef, int gw, int ngw, int lane) {
  const float* g2 = p.inp(16) + l * D;
  const float* U = p.inp(19) + (size_t)l * 16384 * D; const float* V = p.inp(20) + (size_t)l * 16384 * D;
  for (int i = gw; i < CHK_N; i += ngw) {
    const int t = i * 64;
    const float r = p.rstd()[t];
    float4 hv[4];
#pragma unroll
    for (int k = 0; k < 4; ++k) {
      float4 xv = *(const float4*)(chk_x(p) + (size_t)i * D + (lane + k * 64) * 4);
      float4 gv = *(const float4*)(g2 + (lane + k * 64) * 4);
      hv[k].x = xv.x * r * gv.x; hv[k].y = xv.y * r * gv.y; hv[k].z = xv.z * r * gv.z; hv[k].w = xv.w * r * gv.w;
    }
    LDS_FENCE();
    for (int j = 0; j < 128; ++j) {
      const int e = p.eidx()[(size_t)t * 128 + j];
      const float4* up = (const float4*)(U + (size_t)e * D);
      float dsum = 0.f;
#pragma unroll
      for (int k = 0; k < 4; ++k) { float4 uv = up[lane + k * 64]; dsum += hv[k].x * uv.x + hv[k].y * uv.y + hv[k].z * uv.z + hv[k].w * uv.w; }
      dsum = wave_sum(dsum);
      if (lane == 0) coef[j] = chk_g(p)[(size_t)i * 128 + j] * gelu_tanh(dsum);
    }
    LDS_FENCE();
    float4 acc[4];
#pragma unroll
    for (int k = 0; k < 4; ++k) acc[k] = make_float4(0.f, 0.f, 0.f, 0.f);
    for (int j = 0; j < 128; ++j) {
      const int e = p.eidx()[(size_t)t * 128 + j];
      const float c = coef[j];
      const float4* vp = (const float4*)(V + (size_t)e * D);
#pragma unroll
      for (int k = 0; k < 4; ++k) { float4 vv = vp[lane + k * 64]; acc[k].x = fmaf(c, vv.x, acc[k].x); acc[k].y = fmaf(c, vv.y, acc[k].y); acc[k].z = fmaf(c, vv.z, acc[k].z); acc[k].w = fmaf(c, vv.w, acc[k].w); }
    }
    float d2 = 0.f, r2 = 0.f;
#pragma unroll
    for (int k = 0; k < 4; ++k) {
      float4 xa = *(const float4*)(p.outp() + (size_t)t * D + (lane + k * 64) * 4);
      float4 xb4 = *(const float4*)(chk_x(p) + (size_t)i * D + (lane + k * 64) * 4);
      float e0 = (xa.x - xb4.x) - acc[k].x, e1 = (xa.y - xb4.y) - acc[k].y, e2 = (xa.z - xb4.z) - acc[k].z, e3 = (xa.w - xb4.w) - acc[k].w;
      d2 += e0 * e0 + e1 * e1 + e2 * e2 + e3 * e3;
      r2 += acc[k].x * acc[k].x + acc[k].y * acc[k].y + acc[k].z * acc[k].z + acc[k].w * acc[k].w;
    }
    d2 = wave_sum(d2); r2 = wave_sum(r2);
    if (lane == 0) { atomicAdd((unsigned long long*)&chk_m(p)[8], (unsigned long long)(d2 * 1099511627776.0f)); atomicAdd((unsigned long long*)&chk_m(p)[10], (unsigned long long)(r2 * 1099511627776.0f)); }
  }
}
__device__ __forceinline__ void chk_topk(const Params& p, int l, int gtid, int ngt) {
  const float* subk = p.inp(18) + (size_t)l * 16 * 128 * 64;
  for (int it = gtid; it < CHK_N * 8; it += ngt) {
    const int i = it >> 3, h = it & 7, t = i * 64;
    float tva[16], tvb[16]; int tia[16], tib[16];
#pragma unroll 1
    for (int c = 0; c < 2; ++c) {
      float tv[16]; int ti[16];
#pragma unroll
      for (int z = 0; z < 16; ++z) { tv[z] = -INFINITY; ti[z] = 0; }
      const bf16_t* q = p.qb() + (size_t)t * D + (2 * h + c) * 64;
      const float* kb = subk + (size_t)(2 * h + c) * 128 * 64;
#pragma unroll 1
      for (int n = 0; n < 128; ++n) {
        float sc = 0.f;
        for (int d = 0; d < 64; ++d) sc = fmaf(bf2f(q[d]), kb[n * 64 + d], sc);
        float v_ = sc; int i_ = n;
#pragma unroll
        for (int z = 0; z < 16; ++z) { bool gt = v_ > tv[z]; float a = tv[z]; int b = ti[z]; tv[z] = gt ? v_ : a; ti[z] = gt ? i_ : b; v_ = gt ? a : v_; i_ = gt ? b : i_; }
      }
#pragma unroll
      for (int z = 0; z < 16; ++z) { if (c == 0) { tva[z] = tv[z]; tia[z] = ti[z]; } else { tvb[z] = tv[z]; tib[z] = ti[z]; } }
    }
    float tv[16]; int ti[16];
#pragma unroll
    for (int z = 0; z < 16; ++z) { tv[z] = -INFINITY; ti[z] = 0; }
#pragma unroll 1
    for (int a = 0; a < 16; ++a)
#pragma unroll 1
      for (int b = 0; b < 16; ++b) {
        float av = 0.f, bv = 0.f; int ai = 0, bi = 0;
#pragma unroll
        for (int z = 0; z < 16; ++z) { if (z == a) { av = tva[z]; ai = tia[z]; } if (z == b) { bv = tvb[z]; bi = tib[z]; } }
        float v_ = av + bv; int i_ = ai * 128 + bi;
#pragma unroll
        for (int z = 0; z < 16; ++z) { bool gt = v_ > tv[z]; float x = tv[z]; int y = ti[z]; tv[z] = gt ? v_ : x; ti[z] = gt ? i_ : y; v_ = gt ? x : v_; i_ = gt ? y : i_; }
      }
    float sum = 0.f, ev[16];
#pragma unroll
    for (int z = 0; z < 16; ++z) { ev[z] = expf(tv[z] - tv[0]); sum += ev[z]; }
    int miss = 0; float gerr = 0.f;
    for (int z = 0; z < 16; ++z) {
      const int ef = p.eidx()[((size_t)t * 8 + h) * 16 + z]; const float gf = p.gates()[((size_t)t * 8 + h) * 16 + z];
      bool found = false;
#pragma unroll
      for (int y = 0; y < 16; ++y) if (ti[y] == ef) { found = true; gerr = fmaxf(gerr, fabsf(ev[y] / sum - gf)); }
      if (!found) ++miss;
    }
    atomicAdd(&chk_m(p)[3], (float)miss);
    atomicMax((int*)&chk_m(p)[4], __float_as_int(gerr));
  }
}
__device__ __forceinline__ void chk_emit(const Params& p) {
  float v = 0.f;
  if (PEER_CHECK == 1) v = sqrtf((float)((double)*(unsigned long long*)&chk_m(p)[8] / (double)*(unsigned long long*)&chk_m(p)[10]));
  if (PEER_CHECK == 2) v = chk_m(p)[3] / (float)(CHK_N * 8 * 16);
  if (PEER_CHECK == 3) v = chk_m(p)[4];
  p.outp()[0] += 1.0e4f * v + 100.0f;
}
#endif

#define XB_TMO      128
#define XB_XCNT(j)  (256  + 64 * (j))
#define XB_XSUB(j)  (1280 + 64 * (j))
#define XB_XGEN(j)  (2304 + 64 * (j))
#define XB_TOP      3328
#define XB_TOPGEN   3392
#define XCD_BAR_WORDS 3456
#define XB_SPIN_CAP (1u << 18)
#define LAS __attribute__((address_space(3)))

__device__ __forceinline__ unsigned xb_ld(unsigned* p)              { return __hip_atomic_load(p, __ATOMIC_RELAXED, __HIP_MEMORY_SCOPE_AGENT); }
__device__ __forceinline__ unsigned xb_add(unsigned* p, unsigned v) { return __hip_atomic_fetch_add(p, v, __ATOMIC_RELAXED, __HIP_MEMORY_SCOPE_AGENT); }
__device__ __forceinline__ unsigned xb_xcc_id() { return (unsigned)__builtin_amdgcn_s_getreg((3 << 11) | 20) & 0xFu; }
#define XB_SPIN(cond, bar) do { unsigned _sp = 0; while (cond) { __builtin_amdgcn_s_sleep(1); \
    if ((++_sp & 255u) == 0u) { if (xb_ld(&(bar)[XB_TMO])) break; if (_sp > XB_SPIN_CAP) { atomicAdd(&(bar)[XB_TMO], 1u); break; } } } } while (0)

struct XcdBarrier {
    unsigned* bar; unsigned x;
    volatile LAS unsigned* st;
};

__device__ __forceinline__ XcdBarrier xcd_barrier_post(unsigned* bar, volatile LAS unsigned* st) {
    XcdBarrier b; b.bar = bar; b.x = xb_xcc_id(); b.st = st;
    if (threadIdx.x == 0) (void)xb_add(&bar[XB_XCNT(b.x)], 1u);
    return b;
}
__device__ __forceinline__ void xcd_barrier_complete(unsigned* bar, unsigned x, unsigned& nloc, unsigned& nx) {
    const unsigned G = gridDim.x * gridDim.y * gridDim.z;
    unsigned sum, cnt, mine, sp = 0u;
    for (;;) {
        sum = 0u; cnt = 0u; mine = 0u;
#pragma unroll
        for (unsigned j = 0; j < 16; ++j) { const unsigned c = xb_ld(&bar[XB_XCNT(j)]); sum += c; cnt += (c > 0u) ? 1u : 0u; mine = (j == x) ? c : mine; }
        if (sum == G) break;
        __builtin_amdgcn_s_sleep(1);
        if ((++sp & 255u) == 0u) { if (xb_ld(&bar[XB_TMO])) break; if (sp > XB_SPIN_CAP) { atomicAdd(&bar[XB_TMO], 1u); break; } }
    }
    nloc = mine > 0u ? mine : 1u; nx = cnt > 0u ? cnt : 1u;
}

__device__ __forceinline__ void xcd_barrier(const XcdBarrier& b) {
    asm volatile("s_waitcnt vmcnt(0)" ::: "memory");
    __syncthreads();
    if (threadIdx.x == 0) {
        unsigned* bar = b.bar;
        __builtin_amdgcn_s_waitcnt(0);
        unsigned nloc = b.st[0], nx = b.st[1];
        if (nloc == 0u) { xcd_barrier_complete(bar, b.x, nloc, nx); b.st[0] = nloc; b.st[1] = nx; }
        const unsigned old = xb_add(&bar[XB_XSUB(b.x)], 1u);
        const unsigned gen = old / nloc;
        if (old + 1u == (gen + 1u) * nloc) {
            __builtin_amdgcn_fence(__ATOMIC_RELEASE, "agent");
            asm volatile("s_waitcnt vmcnt(0)" ::: "memory");
            const unsigned og = xb_add(&bar[XB_TOP], 1u);
            const unsigned tg = og / nx;
            if (og + 1u == (tg + 1u) * nx) xb_add(&bar[XB_TOPGEN], 1u);
            else XB_SPIN(xb_ld(&bar[XB_TOPGEN]) == tg, bar);
            __builtin_amdgcn_fence(__ATOMIC_ACQUIRE, "agent");
            xb_add(&bar[XB_XGEN(b.x)], 1u);
            asm volatile("s_waitcnt vmcnt(0)" ::: "memory");
        } else {
            XB_SPIN(xb_ld(&bar[XB_XGEN(b.x)]) == gen, bar);
            __builtin_amdgcn_fence(__ATOMIC_ACQUIRE, "agent");
            asm volatile("s_waitcnt vmcnt(0)" ::: "memory");
        }
    }
    __syncthreads();
}

__device__ __forceinline__ Params fresh(const Params& p) {
  Params q = p;
  asm volatile("" : "+s"(q.ws), "+s"(q.out_));
#pragma unroll
  for (int i = 0; i < 21; ++i) asm volatile("" : "+s"(q.in[i]));
  return q;
}
#define PHASE_IDS int tid = threadIdx.x; asm volatile("" : "+v"(tid)); int bid = blockIdx.x; asm volatile("" : "+s"(bid)); int G = gridDim.x; asm volatile("" : "+s"(G)); \
  const int lane = tid & 63, wv = tid >> 6; const int ngt = G * NTHR, ngw = G * NWAVE; \
  const int gtid = bid * NTHR + tid, gw = bid * NWAVE + wv; (void)lane; (void)wv; (void)gtid; (void)gw; (void)ngt; (void)ngw; \
  const Params q = fresh(p);
__global__ void __launch_bounds__(NTHR) mega(Params p) {
  extern __shared__ __attribute__((aligned(16))) unsigned char lds_raw[];
  cg::grid_group grid = cg::this_grid();
  float* ldsf = (float*)lds_raw;
  if (threadIdx.x == 0) { *(uint4*)(lds_raw + LDS_BYTES - 16) = make_uint4(0u, 0u, 0u, 0u); }
  __syncthreads();
  XcdBarrier xb = xcd_barrier_post(p.bar(), (volatile LAS unsigned*)(lds_raw + LDS_BYTES - 16));

  { PHASE_IDS; phase_prologue(q, gtid, ngt, gw, ngw, lane); cvt_f32_bf16(q.inp(18), q.skb(), (size_t)NL * 16 * 128 * 64 / 8, gtid, ngt);
    for (size_t i = gtid; i < (size_t)16 * 128 * 512 / 8; i += ngt) { const size_t g = i / (128 * 512 / 8), r = i % (128 * 512 / 8); ((uint4*)q.S5Wz())[g * (256 * 512 / 8) + (128 * 512 / 8) + r] = make_uint4(0u, 0u, 0u, 0u); }
    if (gtid < 256) q.qctr()[gtid] = 0;
    phase_s5_prep(q, 0, gtid, ngt); }
  grid.sync();
  { constexpr int l = 0;
    DUP(5) {
    { const Params q = fresh(p);
      EpiInProj e{q.ssq1(), q.S5A(), q.Qm(), q.Km(), q.vrow(), q.Qr(), q.Kr(), q.krow(), q.vrrow(), q.grow(),
                  q.inp(12) + l * 64, q.inp(13) + l * 64, q.cosm(), q.sinm(), q.cosr(), q.sinr()};
      run_gemm(lds_raw, q.xb(), q.Win_t() + (size_t)l * INW * KD, T, INW, KD, e); }
    { PHASE_IDS;
      const int ntile = (T / 256) * (INW / 256), nlast = ntile - ((ntile + G - 1) / G - 1) * G;
      if (2 * nlast <= G && bid >= nlast) cvt_table_i8(q.inp(19) + (size_t)l * 16384 * D, q.U8s(), q.su(), gw - nlast * NWAVE, ngw - nlast * NWAVE, lane); }
    xcd_barrier(xb);
    }
    DUP(1) {
    { PHASE_IDS; const bool split = G >= 128; const int g2 = split ? gtid - 64 * NTHR : gtid, n2 = split ? ngt - 64 * NTHR : ngt;
      if (!split || bid >= 64) { phase_post_pack(q, g2, n2); phase_kmean2(q, g2, n2); } }
    { const Params q = fresh(p); EpiS5Z e{q.S5Z()};
      pg8::Gemm g{q.S5A(), q.S5Wz(), 16 * 1024, 16 * 256, 512, 640, 512}; pg8::GroupOrder So; So.init(16, 4, 1, (int)gridDim.x, (int)blockIdx.x);
      pg8::gemm_phase<EpiS5Z, pg8::GroupOrder, true, true>((PG8_LAS unsigned char*)lds_raw, g, So, e); }
    xcd_barrier(xb);
    }
    DUP(2) {
    { PHASE_IDS; phase_s5_scan(q, gtid, ngt); phase_ret_kv(q, gw, ngw, lane); }
    __syncthreads();
    { PHASE_IDS; phase_moba2(q, l, lds_raw, q.qctr() + 64 + l); }
    xcd_barrier(xb);
    }
    DUP(3) {
    { const Params q = fresh(p); EpiS5Y e{q.ygb(), q.S5A(), q.inp(10) + l * 256};
      pg8::Gemm g{q.S5A(), q.S5Wy(), 16 * 1024, 16 * 512, 640, 640, 640}; pg8::GroupOrder So; So.init(16, 4, 2, (int)gridDim.x, (int)blockIdx.x);
      pg8::gemm_phase<EpiS5Y, pg8::GroupOrder, true, true>((PG8_LAS unsigned char*)lds_raw, g, So, e); }
    { PHASE_IDS; phase_ret_scan(q, gtid, ngt); }
    xcd_barrier(xb);
    }
    DUP(4) {
    { const Params q = fresh(p); EpiGlu e{q.xb(), q.ygb(), (float*)(lds_raw + 131072)};
      run_gemm(lds_raw, q.ygb(), q.Wglu_t() + (size_t)l * 65536, T, 256, 256, e); }
    { PHASE_IDS; phase_ret_out(q, gw, ngw, lane); }
    xcd_barrier(xb);
    }
    { PHASE_IDS; const int ntile = (T / 256) * (INW / 256), nlast = ntile - ((ntile + G - 1) / G - 1) * G;
      if (!(2 * nlast <= G)) cvt_table_i8(q.inp(19) + (size_t)l * 16384 * D, q.U8s(), q.su(), gw, ngw, lane);
      cvt_table_fp8(q.inp(20) + (size_t)l * 16384 * D, q.V8s(), q.sv(), gw, ngw, lane); }
    __syncthreads();
    { const Params q = fresh(p); EpiResid e{q.outp(), D, q.xb2(), q.hb(), q.inp(16) + l * D, q.ssq2(), l == 0 ? q.inp(0) : (const float*)q.outp()};
      run_gemm(lds_raw, q.xb(), q.Wout_t() + (size_t)l * D * KD, T, D, KD, e); }
    xcd_barrier(xb);
    DUP(7) {
    { const Params q = fresh(p); EpiScaleStoreBf16 e{q.qb(), D, q.ssq2(), 16, q.rstd()};
      run_gemm(lds_raw, q.xb2(), q.Wq_t() + (size_t)l * D * KD, T, D, KD, e); }
    xcd_barrier(xb);
    }
    if (!(PROBE_SKIP & 2)) {
    DUP(8) {
    { PHASE_IDS; phase_peer_topk(q, l, gw, ngw, lane); }
    xcd_barrier(xb);
    }
    }
#if PEER_CHECK
    if (l == 0) { { PHASE_IDS; chk_save(q, gtid, ngt); } xcd_barrier(xb); { PHASE_IDS; chk_topk(q, l, gtid, ngt); } xcd_barrier(xb); }
#endif
    if (!(PROBE_SKIP & 1)) {
    { PHASE_IDS; phase_peer_u(q, q.qctr() + (l * 2 + 0) * 8, lds_raw, tid); }
    xcd_barrier(xb);
    { PHASE_IDS; phase_peer_r(q, gtid, ngt); if (l + 1 < NL) phase_s5_prep(q, l + 1, gtid, ngt); }
    xcd_barrier(xb);
    if (!(PROBE_SKIP & 32)) {
    { PHASE_IDS; phase_peer_v(q, q.qctr() + (l * 2 + 1) * 8, lds_raw, tid); }
    xcd_barrier(xb);
    }
    }
#if PEER_CHECK
    if (l == 0) { { PHASE_IDS; chk_apply(q, l, ldsf + wv * 128, gw, ngw, lane); } xcd_barrier(xb);
      if (blockIdx.x == 0 && threadIdx.x == 0) { const Params q = fresh(p); chk_emit(q); } xcd_barrier(xb); }
#endif
  }
  { constexpr int l = 1;
    DUP(5) {
    { const Params q = fresh(p);
      EpiInProj e{q.ssq1(), q.S5A(), q.Qm(), q.Km(), q.vrow(), q.Qr(), q.Kr(), q.krow(), q.vrrow(), q.grow(),
                  q.inp(12) + l * 64, q.inp(13) + l * 64, q.cosm(), q.sinm(), q.cosr(), q.sinr()};
      run_gemm(lds_raw, q.xb(), q.Win_t() + (size_t)l * INW * KD, T, INW, KD, e); }
    { PHASE_IDS;
      const int ntile = (T / 256) * (INW / 256), nlast = ntile - ((ntile + G - 1) / G - 1) * G;
      if (2 * nlast <= G && bid >= nlast) cvt_table_i8(q.inp(19) + (size_t)l * 16384 * D, q.U8s(), q.su(), gw - nlast * NWAVE, ngw - nlast * NWAVE, lane); }
    xcd_barrier(xb);
    }
    DUP(1) {
    { PHASE_IDS; const bool split = G >= 128; const int g2 = split ? gtid - 64 * NTHR : gtid, n2 = split ? ngt - 64 * NTHR : ngt;
      if (!split || bid >= 64) { phase_post_pack(q, g2, n2); phase_kmean2(q, g2, n2); } }
    { const Params q = fresh(p); EpiS5Z e{q.S5Z()};
      pg8::Gemm g{q.S5A(), q.S5Wz(), 16 * 1024, 16 * 256, 512, 640, 512}; pg8::GroupOrder So; So.init(16, 4, 1, (int)gridDim.x, (int)blockIdx.x);
      pg8::gemm_phase<EpiS5Z, pg8::GroupOrder, true, true>((PG8_LAS unsigned char*)lds_raw, g, So, e); }
    xcd_barrier(xb);
    }
    DUP(2) {
    { PHASE_IDS; phase_s5_scan(q, gtid, ngt); phase_ret_kv(q, gw, ngw, lane); }
    __syncthreads();
    { PHASE_IDS; phase_moba2(q, l, lds_raw, q.qctr() + 64 + l); }
    xcd_barrier(xb);
    }
    DUP(3) {
    { const Params q = fresh(p); EpiS5Y e{q.ygb(), q.S5A(), q.inp(10) + l * 256};
      pg8::Gemm g{q.S5A(), q.S5Wy(), 16 * 1024, 16 * 512, 640, 640, 640}; pg8::GroupOrder So; So.init(16, 4, 2, (int)gridDim.x, (int)blockIdx.x);
      pg8::gemm_phase<EpiS5Y, pg8::GroupOrder, true, true>((PG8_LAS unsigned char*)lds_raw, g, So, e); }
    { PHASE_IDS; phase_ret_scan(q, gtid, ngt); }
    xcd_barrier(xb);
    }
    DUP(4) {
    { const Params q = fresh(p); EpiGlu e{q.xb(), q.ygb(), (float*)(lds_raw + 131072)};
      run_gemm(lds_raw, q.ygb(), q.Wglu_t() + (size_t)l * 65536, T, 256, 256, e); }
    { PHASE_IDS; phase_ret_out(q, gw, ngw, lane); }
    xcd_barrier(xb);
    }
    { PHASE_IDS; const int ntile = (T / 256) * (INW / 256), nlast = ntile - ((ntile + G - 1) / G - 1) * G;
      if (!(2 * nlast <= G)) cvt_table_i8(q.inp(19) + (size_t)l * 16384 * D, q.U8s(), q.su(), gw, ngw, lane);
      cvt_table_fp8(q.inp(20) + (size_t)l * 16384 * D, q.V8s(), q.sv(), gw, ngw, lane); }
    __syncthreads();
    { const Params q = fresh(p); EpiResid e{q.outp(), D, q.xb2(), q.hb(), q.inp(16) + l * D, q.ssq2(), l == 0 ? q.inp(0) : (const float*)q.outp()};
      run_gemm(lds_raw, q.xb(), q.Wout_t() + (size_t)l * D * KD, T, D, KD, e); }
    xcd_barrier(xb);
    DUP(7) {
    { const Params q = fresh(p); EpiScaleStoreBf16 e{q.qb(), D, q.ssq2(), 16, q.rstd()};
      run_gemm(lds_raw, q.xb2(), q.Wq_t() + (size_t)l * D * KD, T, D, KD, e); }
    xcd_barrier(xb);
    }
    if (!(PROBE_SKIP & 2)) {
    DUP(8) {
    { PHASE_IDS; phase_peer_topk(q, l, gw, ngw, lane); }
    xcd_barrier(xb);
    }
    }
#if PEER_CHECK
    if (l == 0) { { PHASE_IDS; chk_save(q, gtid, ngt); } xcd_barrier(xb); { PHASE_IDS; chk_topk(q, l, gtid, ngt); } xcd_barrier(xb); }
#endif
    if (!(PROBE_SKIP & 1)) {
    { PHASE_IDS; phase_peer_u(q, q.qctr() + (l * 2 + 0) * 8, lds_raw, tid); }
    xcd_barrier(xb);
    { PHASE_IDS; phase_peer_r(q, gtid, ngt); if (l + 1 < NL) phase_s5_prep(q, l + 1, gtid, ngt); }
    xcd_barrier(xb);
    if (!(PROBE_SKIP & 32)) {
    { PHASE_IDS; phase_peer_v(q, q.qctr() + (l * 2 + 1) * 8, lds_raw, tid); }
    xcd_barrier(xb);
    }
    }
#if PEER_CHECK
    if (l == 0) { { PHASE_IDS; chk_apply(q, l, ldsf + wv * 128, gw, ngw, lane); } xcd_barrier(xb);
      if (blockIdx.x == 0 && threadIdx.x == 0) { const Params q = fresh(p); chk_emit(q); } xcd_barrier(xb); }
#endif
  }
  { constexpr int l = 2;
    DUP(5) {
    { const Params q = fresh(p);
      EpiInProj e{q.ssq1(), q.S5A(), q.Qm(), q.Km(), q.vrow(), q.Qr(), q.Kr(), q.krow(), q.vrrow(), q.grow(),
                  q.inp(12) + l * 64, q.inp(13) + l * 64, q.cosm(), q.sinm(), q.cosr(), q.sinr()};
      run_gemm(lds_raw, q.xb(), q.Win_t() + (size_t)l * INW * KD, T, INW, KD, e); }
    { PHASE_IDS;
      const int ntile = (T / 256) * (INW / 256), nlast = ntile - ((ntile + G - 1) / G - 1) * G;
      if (2 * nlast <= G && bid >= nlast) cvt_table_i8(q.inp(19) + (size_t)l * 16384 * D, q.U8s(), q.su(), gw - nlast * NWAVE, ngw - nlast * NWAVE, lane); }
    xcd_barrier(xb);
    }
    DUP(1) {
    { PHASE_IDS; const bool split = G >= 128; const int g2 = split ? gtid - 64 * NTHR : gtid, n2 = split ? ngt - 64 * NTHR : ngt;
      if (!split || bid >= 64) { phase_post_pack(q, g2, n2); phase_kmean2(q, g2, n2); } }
    { const Params q = fresh(p); EpiS5Z e{q.S5Z()};
      pg8::Gemm g{q.S5A(), q.S5Wz(), 16 * 1024, 16 * 256, 512, 640, 512}; pg8::GroupOrder So; So.init(16, 4, 1, (int)gridDim.x, (int)blockIdx.x);
      pg8::gemm_phase<EpiS5Z, pg8::GroupOrder, true, true>((PG8_LAS unsigned char*)lds_raw, g, So, e); }
    xcd_barrier(xb);
    }
    DUP(2) {
    { PHASE_IDS; phase_s5_scan(q, gtid, ngt); phase_ret_kv(q, gw, ngw, lane); }
    __syncthreads();
    { PHASE_IDS; phase_moba2(q, l, lds_raw, q.qctr() + 64 + l); }
    xcd_barrier(xb);
    }
    DUP(3) {
    { const Params q = fresh(p); EpiS5Y e{q.ygb(), q.S5A(), q.inp(10) + l * 256};
      pg8::Gemm g{q.S5A(), q.S5Wy(), 16 * 1024, 16 * 512, 640, 640, 640}; pg8::GroupOrder So; So.init(16, 4, 2, (int)gridDim.x, (int)blockIdx.x);
      pg8::gemm_phase<EpiS5Y, pg8::GroupOrder, true, true>((PG8_LAS unsigned char*)lds_raw, g, So, e); }
    { PHASE_IDS; phase_ret_scan(q, gtid, ngt); }
    xcd_barrier(xb);
    }
    DUP(4) {
    { const Params q = fresh(p); EpiGlu e{q.xb(), q.ygb(), (float*)(lds_raw + 131072)};
      run_gemm(lds_raw, q.ygb(), q.Wglu_t() + (size_t)l * 65536, T, 256, 256, e); }
    { PHASE_IDS; phase_ret_out(q, gw, ngw, lane); }
    xcd_barrier(xb);
    }
    { PHASE_IDS; const int ntile = (T / 256) * (INW / 256), nlast = ntile - ((ntile + G - 1) / G - 1) * G;
      if (!(2 * nlast <= G)) cvt_table_i8(q.inp(19) + (size_t)l * 16384 * D, q.U8s(), q.su(), gw, ngw, lane);
      cvt_table_fp8(q.inp(20) + (size_t)l * 16384 * D, q.V8s(), q.sv(), gw, ngw, lane); }
    __syncthreads();
    { const Params q = fresh(p); EpiResid e{q.outp(), D, q.xb2(), q.hb(), q.inp(16) + l * D, q.ssq2(), l == 0 ? q.inp(0) : (const float*)q.outp()};
      run_gemm(lds_raw, q.xb(), q.Wout_t() + (size_t)l * D * KD, T, D, KD, e); }
    xcd_barrier(xb);
    DUP(7) {
    { const Params q = fresh(p); EpiScaleStoreBf16 e{q.qb(), D, q.ssq2(), 16, q.rstd()};
      run_gemm(lds_raw, q.xb2(), q.Wq_t() + (size_t)l * D * KD, T, D, KD, e); }
    xcd_barrier(xb);
    }
    if (!(PROBE_SKIP & 2)) {
    DUP(8) {
    { PHASE_IDS; phase_peer_topk(q, l, gw, ngw, lane); }
    xcd_barrier(xb);
    }
    }
#if PEER_CHECK
    if (l == 0) { { PHASE_IDS; chk_save(q, gtid, ngt); } xcd_barrier(xb); { PHASE_IDS; chk_topk(q, l, gtid, ngt); } xcd_barrier(xb); }
#endif
    if (!(PROBE_SKIP & 1)) {
    { PHASE_IDS; phase_peer_u(q, q.qctr() + (l * 2 + 0) * 8, lds_raw, tid); }
    xcd_barrier(xb);
    { PHASE_IDS; phase_peer_r(q, gtid, ngt); if (l + 1 < NL) phase_s5_prep(q, l + 1, gtid, ngt); }
    xcd_barrier(xb);
    if (!(PROBE_SKIP & 32)) {
    { PHASE_IDS; phase_peer_v(q, q.qctr() + (l * 2 + 1) * 8, lds_raw, tid); }
    xcd_barrier(xb);
    }
    }
#if PEER_CHECK
    if (l == 0) { { PHASE_IDS; chk_apply(q, l, ldsf + wv * 128, gw, ngw, lane); } xcd_barrier(xb);
      if (blockIdx.x == 0 && threadIdx.x == 0) { const Params q = fresh(p); chk_emit(q); } xcd_barrier(xb); }
#endif
  }
  { constexpr int l = 3;
    DUP(5) {
    { const Params q = fresh(p);
      EpiInProj e{q.ssq1(), q.S5A(), q.Qm(), q.Km(), q.vrow(), q.Qr(), q.Kr(), q.krow(), q.vrrow(), q.grow(),
                  q.inp(12) + l * 64, q.inp(13) + l * 64, q.cosm(), q.sinm(), q.cosr(), q.sinr()};
      run_gemm(lds_raw, q.xb(), q.Win_t() + (size_t)l * INW * KD, T, INW, KD, e); }
    { PHASE_IDS;
      const int ntile = (T / 256) * (INW / 256), nlast = ntile - ((ntile + G - 1) / G - 1) * G;
      if (2 * nlast <= G && bid >= nlast) cvt_table_i8(q.inp(19) + (size_t)l * 16384 * D, q.U8s(), q.su(), gw - nlast * NWAVE, ngw - nlast * NWAVE, lane); }
    xcd_barrier(xb);
    }
    DUP(1) {
    { PHASE_IDS; const bool split = G >= 128; const int g2 = split ? gtid - 64 * NTHR : gtid, n2 = split ? ngt - 64 * NTHR : ngt;
      if (!split || bid >= 64) { phase_post_pack(q, g2, n2); phase_kmean2(q, g2, n2); } }
    { const Params q = fresh(p); EpiS5Z e{q.S5Z()};
      pg8::Gemm g{q.S5A(), q.S5Wz(), 16 * 1024, 16 * 256, 512, 640, 512}; pg8::GroupOrder So; So.init(16, 4, 1, (int)gridDim.x, (int)blockIdx.x);
      pg8::gemm_phase<EpiS5Z, pg8::GroupOrder, true, true>((PG8_LAS unsigned char*)lds_raw, g, So, e); }
    xcd_barrier(xb);
    }
    DUP(2) {
    { PHASE_IDS; phase_s5_scan(q, gtid, ngt); phase_ret_kv(q, gw, ngw, lane); }
    __syncthreads();
    { PHASE_IDS; phase_moba2(q, l, lds_raw, q.qctr() + 64 + l); }
    xcd_barrier(xb);
    }
    DUP(3) {
    { const Params q = fresh(p); EpiS5Y e{q.ygb(), q.S5A(), q.inp(10) + l * 256};
      pg8::Gemm g{q.S5A(), q.S5Wy(), 16 * 1024, 16 * 512, 640, 640, 640}; pg8::GroupOrder So; So.init(16, 4, 2, (int)gridDim.x, (int)blockIdx.x);
      pg8::gemm_phase<EpiS5Y, pg8::GroupOrder, true, true>((PG8_LAS unsigned char*)lds_raw, g, So, e); }
    { PHASE_IDS; phase_ret_scan(q, gtid, ngt); }
    xcd_barrier(xb);
    }
    DUP(4) {
    { const Params q = fresh(p); EpiGlu e{q.xb(), q.ygb(), (float*)(lds_raw + 131072)};
      run_gemm(lds_raw, q.ygb(), q.Wglu_t() + (size_t)l * 65536, T, 256, 256, e); }
    { PHASE_IDS; phase_ret_out(q, gw, ngw, lane); }
    xcd_barrier(xb);
    }
    { PHASE_IDS; const int ntile = (T / 256) * (INW / 256), nlast = ntile - ((ntile + G - 1) / G - 1) * G;
      if (!(2 * nlast <= G)) cvt_table_i8(q.inp(19) + (size_t)l * 16384 * D, q.U8s(), q.su(), gw, ngw, lane);
      cvt_table_fp8(q.inp(20) + (size_t)l * 16384 * D, q.V8s(), q.sv(), gw, ngw, lane); }
    __syncthreads();
    { const Params q = fresh(p); EpiResid e{q.outp(), D, q.xb2(), q.hb(), q.inp(16) + l * D, q.ssq2(), l == 0 ? q.inp(0) : (const float*)q.outp()};
      run_gemm(lds_raw, q.xb(), q.Wout_t() + (size_t)l * D * KD, T, D, KD, e); }
    xcd_barrier(xb);
    DUP(7) {
    { const Params q = fresh(p); EpiScaleStoreBf16 e{q.qb(), D, q.ssq2(), 16, q.rstd()};
      run_gemm(lds_raw, q.xb2(), q.Wq_t() + (size_t)l * D * KD, T, D, KD, e); }
    xcd_barrier(xb);
    }
    if (!(PROBE_SKIP & 2)) {
    DUP(8) {
    { PHASE_IDS; phase_peer_topk(q, l, gw, ngw, lane); }
    xcd_barrier(xb);
    }
    }
#if PEER_CHECK
    if (l == 0) { { PHASE_IDS; chk_save(q, gtid, ngt); } xcd_barrier(xb); { PHASE_IDS; chk_topk(q, l, gtid, ngt); } xcd_barrier(xb); }
#endif
    if (!(PROBE_SKIP & 1)) {
    { PHASE_IDS; phase_peer_u(q, q.qctr() + (l * 2 + 0) * 8, lds_raw, tid); }
    xcd_barrier(xb);
    { PHASE_IDS; phase_peer_r(q, gtid, ngt); if (l + 1 < NL) phase_s5_prep(q, l + 1, gtid, ngt); }
    xcd_barrier(xb);
    if (!(PROBE_SKIP & 32)) {
    { PHASE_IDS; phase_peer_v(q, q.qctr() + (l * 2 + 1) * 8, lds_raw, tid); }
    xcd_barrier(xb);
    }
    }
#if PEER_CHECK
    if (l == 0) { { PHASE_IDS; chk_apply(q, l, ldsf + wv * 128, gw, ngw, lane); } xcd_barrier(xb);
      if (blockIdx.x == 0 && threadIdx.x == 0) { const Params q = fresh(p); chk_emit(q); } xcd_barrier(xb); }
#endif
  }
}

}

extern "C" void kernel_launch(void* const* d_in, const int* in_sizes, int n_in, void* d_out, int out_size, void* d_ws, size_t ws_size,
                              hipStream_t stream) {
  static int grid_blocks = 0;
  if (!grid_blocks) {
    int dev = 0, cus = 0, per_cu = 0;
    hipGetDevice(&dev);
    hipDeviceGetAttribute(&cus, hipDeviceAttributeMultiprocessorCount, dev);
    hipFuncSetAttribute((const void*)mega, hipFuncAttributeMaxDynamicSharedMemorySize, LDS_BYTES);
    hipOccupancyMaxActiveBlocksPerMultiprocessor(&per_cu, (const void*)mega, NTHR, LDS_BYTES);
    if (per_cu < 1) { fprintf(stderr, "occupancy query returned %d\n", per_cu); per_cu = 1; }
    grid_blocks = cus * 1;
    if (grid_blocks < 64) fprintf(stderr, "unexpected CU count %d\n", cus);
  }
  Params p{};
  for (int i = 0; i < 21; ++i) p.in[i] = (const GAS float*)d_in[i];
  p.out_ = (GAS float*)d_out;
  p.ws = (GAS unsigned char*)d_ws;
  if (WS_TOTAL > ws_size) { fprintf(stderr, "workspace too small: need %zu have %zu\n", (size_t)WS_TOTAL, ws_size); return; }
  hipMemsetAsync((unsigned char*)d_ws + WO_bar, 0, 16384, stream);
  void* args[] = {&p};
  hipError_t e = hipLaunchCooperativeKernel((const void*)mega, dim3(grid_blocks), dim3(NTHR), args, LDS_BYTES, stream);
  if (e != hipSuccess) fprintf(stderr, "cooperative launch failed: %s (grid %d)\n", hipGetErrorString(e), grid_blocks);
}
```

```cpp
#include <hip/hip_runtime.h>
#include <hip/hip_cooperative_groups.h>
#include <math.h>
#include <stdint.h>
#include <stdio.h>
namespace cg = cooperative_groups;

#ifndef PEER_CHECK
#define PEER_CHECK 0
#endif
#ifndef PROBE_DUP
#define PROBE_DUP 0
#endif
__device__ __forceinline__ int dup_n(int n) { asm volatile("" : "+s"(n)); return n; }
#define DUP(bit) _Pragma("unroll 1") for (int rep_ = 0, repn_ = (((PROBE_DUP >> (bit)) & 1) ? dup_n(2) : 1); rep_ < repn_; ++rep_)
#ifndef PROBE_SKIP
#define PROBE_SKIP 0
#endif
#ifndef PRECISE
#define PRECISE 0
#endif

namespace {
constexpr int NB = 8, S = 4096, D = 1024, NL = 4, T = NB * S;
constexpr int INW = 2816;
constexpr float EPS = 1e-6f;
static_assert(PRECISE == 0, "PRECISE builds are retired");
constexpr int KS = PRECISE ? 3 : 1;
constexpr int KD = D * KS;
constexpr int NTHR = 512, NWAVE = 8;
constexpr int LDS_BYTES = 131072 + 4096 + 1024;

typedef unsigned short bf16_t;
using bf16x8 = __attribute__((ext_vector_type(8))) short;
using f32x4 = __attribute__((ext_vector_type(4))) float;

__device__ __forceinline__ float wave_sum(float v) {
#pragma unroll
  for (int o = 32; o > 0; o >>= 1) v += __shfl_xor(v, o);
  return v;
}
__device__ __forceinline__ float wave_max(float v) {
#pragma unroll
  for (int o = 32; o > 0; o >>= 1) v = fmaxf(v, __shfl_xor(v, o));
  return v;
}
__device__ __forceinline__ int q_pull(int* head, int nitems, int* bc, int tid) {
  __syncthreads();
  if (tid == 0) bc[0] = atomicAdd(head, 1);
  __syncthreads();
  const int v = bc[0];
  return v < nitems ? v : -1;
}
constexpr float QSCALE = 0.125f * 1.4426950408889634f;
__device__ __forceinline__ float ret_log2g(int h) { return log2f(1.0f - exp2f(-5.0f - (float)h)); }
__device__ __forceinline__ float gelu_tanh(float x) {
  const float k0 = 0.7978845608028654f, k1 = 0.044715f;
  float u = k0 * (x + k1 * x * x * x);
  return 0.5f * x * (1.0f + tanhf(u));
}
__device__ __forceinline__ float sigmoidf_(float x) { return 1.0f / (1.0f + expf(-x)); }
__device__ __forceinline__ float fast_sigmoid(float x) { return __builtin_amdgcn_rcpf(1.0f + __builtin_amdgcn_exp2f(-1.4426950408889634f * x)); }
__device__ __forceinline__ float fast_gelu(float x) { const float u = 0.7978845608028654f * (x + 0.044715f * x * x * x); return x * fast_sigmoid(2.0f * u); }
__device__ __forceinline__ bf16_t f2bf(float f) {
  unsigned u = __float_as_uint(f);
  u += 0x7fffu + ((u >> 16) & 1u);
  return (bf16_t)(u >> 16);
}
__device__ __forceinline__ float bf2f(bf16_t h) { return __uint_as_float(((unsigned)h) << 16); }
#define LDS_FENCE() asm volatile("s_waitcnt lgkmcnt(0)" ::: "memory")
typedef __bf16 bf16x2_hw __attribute__((ext_vector_type(2)));
typedef float f32x2_hw __attribute__((ext_vector_type(2)));
__device__ __forceinline__ unsigned pk_bf16(float lo, float hi) { const f32x2_hw f = {lo, hi}; const bf16x2_hw b = __builtin_convertvector(f, bf16x2_hw); return __builtin_bit_cast(unsigned, b); }
typedef float f32x16 __attribute__((ext_vector_type(16)));

constexpr size_t al256(size_t x) { return (x + 255) & ~(size_t)255; }
constexpr size_t WO_rstd = 0;
constexpr size_t WO_cosm = WO_rstd + al256((size_t)T * 4);
constexpr size_t WO_sinm = WO_cosm + al256((size_t)S * 8 * 4);
constexpr size_t WO_cosr = WO_sinm + al256((size_t)S * 8 * 4);
constexpr size_t WO_sinr = WO_cosr + al256((size_t)S * 32 * 4);
constexpr size_t WO_kmean = WO_sinr + al256((size_t)S * 32 * 4);
constexpr size_t WO_proj = WO_kmean + al256((size_t)NB * 8 * 16 * 64 * 4);
constexpr size_t WO_ybuf = WO_proj + al256((size_t)T * INW * 4);
constexpr size_t WO_yg = WO_ybuf + al256((size_t)T * D * 4);
constexpr size_t WO_skb = WO_yg + al256((size_t)T * 256 * 4);
constexpr size_t WO_Ub = WO_skb + al256((size_t)NL * 16 * 128 * 64 * 2);
constexpr size_t WO_Vb = WO_Ub + al256((size_t)16384 * D * 2);
constexpr size_t WO_gates = WO_Vb + al256((size_t)16384 * D * 2);
constexpr size_t WO_eidx = WO_gates + al256((size_t)T * 128 * 4);
constexpr size_t WO_xb = WO_eidx + al256((size_t)T * 128 * 4);
constexpr size_t WO_Win_t = WO_xb + al256((size_t)T * KD * 2);
constexpr size_t WO_Wout_t = WO_Win_t + al256((size_t)NL * INW * KD * 2);
constexpr size_t WO_Wq_t = WO_Wout_t + al256((size_t)NL * D * KD * 2);
constexpr size_t WO_Qm = WO_Wq_t + al256((size_t)NL * D * KD * 2);
constexpr size_t WO_Km = WO_Qm + al256((size_t)T * 512 * 2);
constexpr size_t WO_Vm = WO_Km + al256((size_t)T * 512 * 2);
constexpr size_t WO_S5a32 = WO_Vm + al256((size_t)T * 512 * 2);
constexpr size_t WO_Wglu_t = WO_S5a32 + al256((size_t)16 * 64 * 2 * 4);
constexpr size_t WO_Qr = WO_Wglu_t + al256((size_t)NL * 256 * 256 * 2);
constexpr size_t WO_Kr = WO_Qr + al256((size_t)T * 256 * 2);
constexpr size_t WO_Krv = WO_Kr + al256((size_t)T * 256 * 2);
constexpr size_t WO_Vr = WO_Krv + al256((size_t)T * 256 * 2);
constexpr size_t WO_KVr = WO_Vr + al256((size_t)T * 256 * 2);
constexpr size_t WO_Rb = WO_KVr + al256((size_t)32 * 32 * 4096 * 4);
constexpr size_t WO_qctr = WO_Rb + al256((size_t)32 * 32 * 4096 * 2);
constexpr size_t WO_bar = WO_qctr + al256(1024);
constexpr size_t WO_S5Wy = WO_bar + al256(16384);
constexpr size_t WO_S5Wz = WO_S5Wy + al256((size_t)16 * 512 * 640 * 2);
constexpr size_t WO_ssq1 = WO_S5Wz + al256((size_t)16 * 256 * 512 * 2);
constexpr size_t WO_ssq2 = WO_ssq1 + al256((size_t)T * 8 * 4);
constexpr size_t WS_TOTAL = WO_ssq2 + al256((size_t)T * 16 * 4);
constexpr size_t WO_S5A = WO_gates;
constexpr size_t WO_S5Z = WO_S5A + al256((size_t)16 * 1024 * 640 * 2);
static_assert(WO_S5Z + (size_t)16 * 1024 * 128 * 4 <= WO_gates + 2 * al256((size_t)T * 128 * 4), "S5A/S5Z must fit in gates+eidx");
#define GAS __attribute__((address_space(1)))
static_assert((size_t)T * D * 2 + (size_t)T * 128 * 8 * 4 + (size_t)T * D * 2 <= (size_t)T * INW * 4, "qb + ppart + xb2 must fit in the proj region");
struct Params {
  const GAS float* in[21];
  GAS float* out_;
  GAS unsigned char* ws;
  __device__ __forceinline__ const float* inp(int i) const { return (const float*)in[i]; }
  __device__ __forceinline__ float* outp() const { return (float*)out_; }
  __device__ __forceinline__ float* rstd() const { return (float*)(ws + WO_rstd); }
  __device__ __forceinline__ float* cosm() const { return (float*)(ws + WO_cosm); }
  __device__ __forceinline__ float* sinm() const { return (float*)(ws + WO_sinm); }
  __device__ __forceinline__ float* cosr() const { return (float*)(ws + WO_cosr); }
  __device__ __forceinline__ float* sinr() const { return (float*)(ws + WO_sinr); }
  __device__ __forceinline__ float* kmean() const { return (float*)(ws + WO_kmean); }
  __device__ __forceinline__ float* proj() const { return (float*)(ws + WO_proj); }
  __device__ __forceinline__ float* ybuf() const { return (float*)(ws + WO_ybuf); }
  __device__ __forceinline__ float* yg() const { return (float*)(ws + WO_yg); }
  __device__ __forceinline__ bf16_t* skb() const { return (bf16_t*)(ws + WO_skb); }
  __device__ __forceinline__ bf16_t* Ub() const { return (bf16_t*)(ws + WO_Ub); }
  __device__ __forceinline__ bf16_t* Vb() const { return (bf16_t*)(ws + WO_Vb); }
  __device__ __forceinline__ float* gates() const { return (float*)(ws + WO_gates); }
  __device__ __forceinline__ int* eidx() const { return (int*)(ws + WO_eidx); }
  __device__ __forceinline__ bf16_t* xb() const { return (bf16_t*)(ws + WO_xb); }
  __device__ __forceinline__ bf16_t* Win_t() const { return (bf16_t*)(ws + WO_Win_t); }
  __device__ __forceinline__ bf16_t* Wout_t() const { return (bf16_t*)(ws + WO_Wout_t); }
  __device__ __forceinline__ bf16_t* Wq_t() const { return (bf16_t*)(ws + WO_Wq_t); }
  __device__ __forceinline__ bf16_t* Qm() const { return (bf16_t*)(ws + WO_Qm); }
  __device__ __forceinline__ bf16_t* Km() const { return (bf16_t*)(ws + WO_Km); }
  __device__ __forceinline__ bf16_t* Vm() const { return (bf16_t*)(ws + WO_Vm); }
  __device__ __forceinline__ bf16_t* S5A() const { return (bf16_t*)(ws + WO_S5A); }
  __device__ __forceinline__ bf16_t* S5Wy() const { return (bf16_t*)(ws + WO_S5Wy); }
  __device__ __forceinline__ bf16_t* S5Wz() const { return (bf16_t*)(ws + WO_S5Wz); }
  __device__ __forceinline__ float* S5Z() const { return (float*)(ws + WO_S5Z); }
  __device__ __forceinline__ float* S5a32() const { return (float*)(ws + WO_S5a32); }
  __device__ __forceinline__ bf16_t* Wglu_t() const { return (bf16_t*)(ws + WO_Wglu_t); }
  __device__ __forceinline__ bf16_t* ygb() const { return (bf16_t*)(ws + WO_yg); }
  __device__ __forceinline__ int* qctr() const { return (int*)(ws + WO_qctr); }
  __device__ __forceinline__ unsigned char* U8s() const { return (unsigned char*)(ws + WO_Ub); }
  __device__ __forceinline__ float* su() const { return (float*)(ws + WO_Ub + (size_t)16384 * D); }
  __device__ __forceinline__ unsigned char* V8s() const { return (unsigned char*)(ws + WO_Vb); }
  __device__ __forceinline__ float* sv() const { return (float*)(ws + WO_Vb + (size_t)16384 * D); }
  __device__ __forceinline__ bf16_t* hb() const { return (bf16_t*)(ws + WO_ybuf + ((size_t)4 << 20)); }
  __device__ __forceinline__ bf16_t* ppart() const { return (bf16_t*)(ws + WO_proj + (size_t)T * D * 2); }
  __device__ __forceinline__ bf16_t* Qr() const { return (bf16_t*)(ws + WO_Qr); }
  __device__ __forceinline__ bf16_t* Kr() const { return (bf16_t*)(ws + WO_Kr); }
  __device__ __forceinline__ bf16_t* Krv() const { return (bf16_t*)(ws + WO_Krv); }
  __device__ __forceinline__ bf16_t* Vr() const { return (bf16_t*)(ws + WO_Vr); }
  __device__ __forceinline__ float* KVr() const { return (float*)(ws + WO_KVr); }
  __device__ __forceinline__ bf16_t* Rb() const { return (bf16_t*)(ws + WO_Rb); }
  __device__ __forceinline__ unsigned* bar() const { return (unsigned*)(ws + WO_bar); }
  __device__ __forceinline__ float* ssq1() const { return (float*)(ws + WO_ssq1); }
  __device__ __forceinline__ float* ssq2() const { return (float*)(ws + WO_ssq2); }
  __device__ __forceinline__ bf16_t* xb2() const { return (bf16_t*)(ws + WO_proj + (size_t)T * D * 2 + (size_t)T * 128 * 8 * 4); }
  __device__ __forceinline__ bf16_t* vrow() const { return (bf16_t*)(ws + WO_proj); }
  __device__ __forceinline__ bf16_t* vrrow() const { return (bf16_t*)(ws + WO_proj + (size_t)T * 512 * 2); }
  __device__ __forceinline__ bf16_t* krow() const { return (bf16_t*)(ws + WO_proj + (size_t)T * 768 * 2); }
  __device__ __forceinline__ bf16_t* grow() const { return (bf16_t*)(ws + WO_proj + (size_t)T * 1024 * 2); }
  __device__ __forceinline__ bf16_t* qb() const { return (bf16_t*)(ws + WO_proj); }
};

namespace pg8 {
#define PG8_LAS __attribute__((address_space(3)))
typedef unsigned short bf16_t;
typedef short bf16x8 __attribute__((ext_vector_type(8)));
typedef float f32x4 __attribute__((ext_vector_type(4)));
typedef unsigned u32x4 __attribute__((ext_vector_type(4)));
constexpr int BM = 256, BK = 64, HALF = 128, HTB = HALF * BK * 2  , STAGE_BYTES = 8 * HTB, NXCD = 8, WGM = 8;

__host__ __device__ __forceinline__ int lds_byte(int r, int c) { const int st = (r >> 4) * 2 + (c >> 5), rr = r & 15, cc = c & 31, ob = rr * 64 + cc * 2; return st * 1024 + (ob ^ (((ob >> 9) & 1) << 5)); }
__host__ __device__ __forceinline__ void stage_rc(int b, int& R, int& C) { const int st = b / 1024, sb = b % 1024, swz = sb ^ (((sb >> 9) & 1) << 5); R = (st >> 1) * 16 + swz / 64; C = (st & 1) * 32 + (swz % 64) / 2; }
__host__ __device__ __forceinline__ int perm32(int rho) { const int n = rho >> 4, i = rho & 15; return 8 * (i >> 2) + 4 * n + (i & 3); }

struct Unit { int pm, pn; };
struct Gemm { const bf16_t* A; const bf16_t* Bt; int M, N, K, lda, ldb; };

struct StaticOrder {
    int nM, nN, nwg, G, c;
    __host__ __device__ void init(int M, int N, int G_, int c_) { nM = M / BM; nN = N / BM; nwg = nM * nN; G = G_; c = c_; }
    __host__ __device__ bool next(int i, Unit& u) const {
        const long L = (long)i * G + c; if (L >= nwg) return false;
        int wgid = (int)L; { const int q = nwg / NXCD, r = nwg % NXCD, xcd = wgid % NXCD, off = wgid / NXCD; wgid = (xcd < r ? xcd * (q + 1) : r * (q + 1) + (xcd - r) * q) + off; }
        const int nig = WGM * nN, gid = wgid / nig, fm = gid * WGM, gsz = (nM - fm) < WGM ? (nM - fm) : WGM;
        u.pm = fm + ((wgid % nig) % gsz); u.pn = (wgid % nig) / gsz; return true;
    }
    __device__ __forceinline__ void a_ready(const Unit&) const {}
    __device__ __forceinline__ void done(const Unit&) const {}
};
struct GroupOrder {
    int mt, nt_, nwg, G, c;
    __host__ __device__ void init(int ngroups, int mt__, int nt__, int G_, int c_) { mt = mt__; nt_ = nt__; nwg = ngroups * mt * nt_; G = G_; c = c_; }
    __host__ __device__ bool next(int i, Unit& u) const {
        const long L = (long)i * G + c; if (L >= nwg) return false;
        const int per = mt * nt_, gi = (int)L / per, r = (int)L % per;
        u.pm = gi * mt + r % mt; u.pn = gi * nt_ + r / mt; return true;
    }
    __device__ __forceinline__ void a_ready(const Unit&) const {}
    __device__ __forceinline__ void done(const Unit&) const {}
};
template <class Epi, class Sched, bool ALIGN_EPI = false, bool SP2 = false>
__device__ __forceinline__ void gemm_phase(PG8_LAS unsigned char* lds, const Gemm g, const Sched& S, const Epi& E) {
    int tid_ = threadIdx.x; asm volatile("" : "+v"(tid_));
    const int tid = tid_, wid = __builtin_amdgcn_readfirstlane(tid >> 6), lane = tid & 63, wr = wid >> 2, wc = wid & 3, fr = lane & 15, fq = lane >> 4;
    const int K = g.K, nt = K / BK;
    unsigned voffA[2], voffB[2];
#pragma unroll
    for (int i = 0; i < 2; ++i) { int R, C; stage_rc(tid * 16 + i * 8192, R, C); const int Rb = Epi::PERM ? ((R & ~31) + perm32(R & 31)) : R;
        voffA[i] = (unsigned)(R * g.lda + C) * 2u; voffB[i] = (unsigned)(Rb * g.ldb + C) * 2u; }
    const size_t kstep = (size_t)(BK * 2);
    const size_t hstepA = (size_t)HALF * g.lda * 2, hstepB = (size_t)HALF * g.ldb * 2;
    const size_t tstepA = 2 * hstepA, tstepB = 2 * hstepB;
    const unsigned ldsw = (unsigned)wid * 1024u;
    const int aoff = lds_byte(wr * 64 + fr, fq * 8), boff = lds_byte(wc * 32 + fr, fq * 8);
#define PG8_SA(b, h) (((b) * 2 + (h)) * HTB)
#define PG8_SB(b, h) ((4 + (b) * 2 + (h)) * HTB)
#define PG8_STAGE(bufoff, gbase, voff) do { _Pragma("unroll") for (int _i = 0; _i < 2; ++_i) \
        __builtin_amdgcn_global_load_lds((const unsigned*)((const char*)(gbase) + (voff)[_i]), (PG8_LAS unsigned*)(lds + (bufoff) + ldsw + _i * 8192), 16, 0, 0); } while (0)
#define PG8_LDA(dst, b, h) do { _Pragma("unroll") for (int m = 0; m < 4; ++m) _Pragma("unroll") for (int k = 0; k < 2; ++k) dst[m][k] = *(const PG8_LAS bf16x8*)(lds + PG8_SA(b, h) + aoff + m * 2048 + k * 1024); } while (0)
#define PG8_LDB(dst, b, h) do { _Pragma("unroll") for (int n = 0; n < 2; ++n) _Pragma("unroll") for (int k = 0; k < 2; ++k) dst[n][k] = *(const PG8_LAS bf16x8*)(lds + PG8_SB(b, h) + boff + n * 2048 + k * 1024); } while (0)
#define PG8_MMA(ai, bj, At, Bt) do { __builtin_amdgcn_s_setprio(1); _Pragma("unroll") for (int m = 0; m < 4; ++m) _Pragma("unroll") for (int n = 0; n < 2; ++n) _Pragma("unroll") for (int k = 0; k < 2; ++k) \
        acc[ai][bj][m][n] = __builtin_amdgcn_mfma_f32_16x16x32_bf16(Bt[n][k], At[m][k], acc[ai][bj][m][n], 0, 0, 0); __builtin_amdgcn_s_setprio(0); } while (0)
#define PG8_WAIT_V(n) asm volatile("s_waitcnt vmcnt(" #n ")" ::: "memory")
#define PG8_WAIT_L(n) asm volatile("s_waitcnt lgkmcnt(" #n ")" ::: "memory")
#define PG8_BAR __builtin_amdgcn_s_barrier()
#define PG8_SCHED __builtin_amdgcn_sched_barrier(0)
    Unit cur, nxt; int ui = 0;
    if (!S.next(0, cur)) return;
    f32x4 acc[2][2][4][2];
    E.init(acc, cur, wr, wc, fr, fq);
    bf16x8 At[4][2], B0[2][2], B1[2][2];
    const char* cA = (const char*)g.A + (size_t)cur.pm * tstepA; const char* cB = (const char*)g.Bt + (size_t)cur.pn * tstepB;
    S.a_ready(cur);
    if constexpr (SP2) {
        PG8_STAGE(PG8_SB(0, 0), cB, voffB); PG8_STAGE(PG8_SB(0, 1), cB + hstepB, voffB); PG8_STAGE(PG8_SA(0, 0), cA, voffA); PG8_STAGE(PG8_SA(0, 1), cA + hstepA, voffA);
        if (wr == 1) PG8_BAR;
        PG8_WAIT_V(2); PG8_BAR;
        PG8_STAGE(PG8_SB(1, 0), cB + kstep, voffB); PG8_STAGE(PG8_SA(1, 0), cA + kstep, voffA); PG8_STAGE(PG8_SB(1, 1), cB + hstepB + kstep, voffB);
        PG8_WAIT_V(6); PG8_BAR;
    } else {
        PG8_STAGE(PG8_SB(0, 0), cB, voffB); PG8_STAGE(PG8_SA(0, 0), cA, voffA); PG8_STAGE(PG8_SB(0, 1), cB + hstepB, voffB); PG8_STAGE(PG8_SA(0, 1), cA + hstepA, voffA);
        if (wr == 1) PG8_BAR;
        PG8_WAIT_V(4); PG8_BAR;
        PG8_STAGE(PG8_SB(1, 0), cB + kstep, voffB); PG8_STAGE(PG8_SA(1, 0), cA + kstep, voffA); PG8_STAGE(PG8_SB(1, 1), cB + hstepB + kstep, voffB);
        PG8_WAIT_V(6); PG8_BAR;
    }
    for (;;) {
        const bool has_next = S.next(ui + 1, nxt);
        const char* nA = has_next ? (const char*)g.A + (size_t)nxt.pm * tstepA : cA; const char* nB = has_next ? (const char*)g.Bt + (size_t)nxt.pn * tstepB : cB;
        for (int t = 0; t < nt; t += 2) {
            const bool last = (t == nt - 2);
            const char* a1 = cA + (size_t)(t + 1) * kstep;
            const char* a2 = last ? nA : cA + (size_t)(t + 2) * kstep; const char* b2 = last ? nB : cB + (size_t)(t + 2) * kstep;
            const char* a3 = a2 + kstep; const char* b3 = b2 + kstep;
            if (last && has_next) S.a_ready(nxt);
            if constexpr (SP2) {
            PG8_LDB(B0, 0, 0); PG8_LDB(B1, 0, 1); PG8_SCHED; PG8_LDA(At, 0, 0); PG8_STAGE(PG8_SA(1, 1), a1 + hstepA, voffA);
            PG8_WAIT_V(8); PG8_WAIT_L(0); PG8_BAR; PG8_MMA(0, 0, At, B0); PG8_MMA(0, 1, At, B1); PG8_BAR; PG8_SCHED;
            PG8_LDA(At, 0, 1); PG8_STAGE(PG8_SB(0, 0), b2, voffB); PG8_STAGE(PG8_SB(0, 1), b2 + hstepB, voffB); PG8_STAGE(PG8_SA(0, 0), a2, voffA);
            PG8_WAIT_V(8); PG8_WAIT_L(0); PG8_BAR; PG8_MMA(1, 0, At, B0); PG8_MMA(1, 1, At, B1); PG8_BAR; PG8_SCHED;
            PG8_LDB(B0, 1, 0); PG8_LDB(B1, 1, 1); PG8_SCHED; PG8_LDA(At, 1, 0); PG8_STAGE(PG8_SA(0, 1), a2 + hstepA, voffA);
            PG8_WAIT_V(8); PG8_WAIT_L(0); PG8_BAR; PG8_MMA(0, 0, At, B0); PG8_MMA(0, 1, At, B1); PG8_BAR; PG8_SCHED;
            PG8_LDA(At, 1, 1); PG8_STAGE(PG8_SB(1, 0), b3, voffB); PG8_STAGE(PG8_SB(1, 1), b3 + hstepB, voffB); PG8_STAGE(PG8_SA(1, 0), a3, voffA);
            PG8_WAIT_V(8); PG8_WAIT_L(0); PG8_BAR; PG8_MMA(1, 0, At, B0); PG8_MMA(1, 1, At, B1); PG8_BAR; PG8_SCHED;
            } else {
            PG8_LDB(B0, 0, 0); PG8_SCHED; PG8_LDA(At, 0, 0); PG8_STAGE(PG8_SA(1, 1), a1 + hstepA, voffA);
            PG8_WAIT_L(8); PG8_BAR; PG8_WAIT_L(0); PG8_MMA(0, 0, At, B0); PG8_BAR; PG8_SCHED;
            PG8_LDB(B1, 0, 1); PG8_STAGE(PG8_SB(0, 0), b2, voffB);
            PG8_BAR; PG8_WAIT_L(0); PG8_MMA(0, 1, At, B1); PG8_BAR;
            PG8_LDA(At, 0, 1); PG8_STAGE(PG8_SA(0, 0), a2, voffA);
            PG8_BAR; PG8_WAIT_L(0); PG8_MMA(1, 0, At, B0); PG8_BAR; PG8_SCHED;
            PG8_STAGE(PG8_SB(0, 1), b2 + hstepB, voffB);
            PG8_WAIT_V(6); PG8_BAR; PG8_MMA(1, 1, At, B1); PG8_BAR;
            PG8_LDB(B0, 1, 0); PG8_SCHED; PG8_LDA(At, 1, 0); PG8_STAGE(PG8_SA(0, 1), a2 + hstepA, voffA);
            PG8_WAIT_L(8); PG8_BAR; PG8_WAIT_L(0); PG8_MMA(0, 0, At, B0); PG8_BAR; PG8_SCHED;
            PG8_LDB(B1, 1, 1); PG8_STAGE(PG8_SB(1, 0), b3, voffB);
            PG8_BAR; PG8_WAIT_L(0); PG8_MMA(0, 1, At, B1); PG8_BAR;
            PG8_LDA(At, 1, 1); PG8_STAGE(PG8_SA(1, 0), a3, voffA);
            PG8_BAR; PG8_WAIT_L(0); PG8_MMA(1, 0, At, B0); PG8_BAR; PG8_SCHED;
            PG8_STAGE(PG8_SB(1, 1), b3 + hstepB, voffB);
            PG8_WAIT_V(6); PG8_BAR; PG8_MMA(1, 1, At, B1); PG8_BAR;
            }
        }
        if constexpr (ALIGN_EPI) { if (wr == 0) PG8_BAR; }
        if constexpr (!Epi::AFTER_DRAIN) { E(acc, cur, wr, wc, fr, fq); S.done(cur); }
        if (!has_next) break;
        E.init(acc, nxt, wr, wc, fr, fq);
        cur = nxt; cA = nA; cB = nB; ++ui;
        if constexpr (ALIGN_EPI) { if (wr == 1) PG8_BAR; }
    }
    PG8_WAIT_V(0);
    if constexpr (!ALIGN_EPI) { if (wr == 0) PG8_BAR; }
    PG8_BAR;
    if constexpr (Epi::AFTER_DRAIN) { E.fused(acc, cur, wr, wc, fr, fq, lds, wid, lane); S.done(cur); }
#undef PG8_SA
#undef PG8_SB
#undef PG8_STAGE
#undef PG8_LDA
#undef PG8_LDB
#undef PG8_MMA
#undef PG8_WAIT_V
#undef PG8_WAIT_L
#undef PG8_BAR
#undef PG8_SCHED
}
}
#define EPI_ZERO_INIT \
  __device__ __forceinline__ void init(pg8::f32x4 (&acc)[2][2][4][2], const pg8::Unit&, int, int, int, int) const { \
    _Pragma("unroll") for (int a = 0; a < 2; ++a) _Pragma("unroll") for (int b = 0; b < 2; ++b) \
    _Pragma("unroll") for (int m = 0; m < 4; ++m) _Pragma("unroll") for (int n = 0; n < 2; ++n) acc[a][b][m][n] = (pg8::f32x4){0.f, 0.f, 0.f, 0.f}; }
struct EpiResid {
  static constexpr bool PERM = true, AFTER_DRAIN = false;
  float* C; int ldc; bf16_t* xb; bf16_t* hb; const float* g2; float* parts; const float* Cin;
  __device__ __forceinline__ void init(pg8::f32x4 (&acc)[2][2][4][2], const pg8::Unit& u, int wr, int wc, int fr, int fq) const {
#pragma unroll
    for (int ai = 0; ai < 2; ++ai)
#pragma unroll
      for (int m = 0; m < 4; ++m) {
        const int row = u.pm * 256 + ai * 128 + wr * 64 + m * 16 + fr;
#pragma unroll
        for (int bj = 0; bj < 2; ++bj)
#pragma unroll
          for (int n = 0; n < 2; ++n) {
            const int col = u.pn * 256 + bj * 128 + wc * 32 + 8 * fq + 4 * n;
            acc[ai][bj][m][n] = *(const pg8::f32x4*)(Cin + (size_t)row * ldc + col);
          }
      }
  }
  __device__ __forceinline__ void operator()(const pg8::f32x4 (&acc)[2][2][4][2], const pg8::Unit& u, int wr, int wc, int fr_in, int fq_in) const {
    int fr = fr_in, fq = fq_in; asm volatile("" : "+v"(fr), "+v"(fq));
    pg8::f32x4 gv[2][2];
#pragma unroll
    for (int bj = 0; bj < 2; ++bj)
#pragma unroll
      for (int n = 0; n < 2; ++n) gv[bj][n] = *(const pg8::f32x4*)(g2 + u.pn * 256 + bj * 128 + wc * 32 + 8 * fq + 4 * n);
#pragma unroll
    for (int ai = 0; ai < 2; ++ai)
#pragma unroll
      for (int m = 0; m < 4; ++m) {
        const int row = u.pm * 256 + ai * 128 + wr * 64 + m * 16 + fr;
        float ss = 0.f;
#pragma unroll
        for (int bj = 0; bj < 2; ++bj) {
          const int col = u.pn * 256 + bj * 128 + wc * 32 + 8 * fq;
          const pg8::f32x4 v0 = acc[ai][bj][m][0], v1 = acc[ai][bj][m][1];
          *(pg8::f32x4*)(C + (size_t)row * ldc + col) = v0; *(pg8::f32x4*)(C + (size_t)row * ldc + col + 4) = v1;
          *(uint4*)(xb + (size_t)row * KD + col) = make_uint4(pk_bf16(v0[0], v0[1]), pk_bf16(v0[2], v0[3]), pk_bf16(v1[0], v1[1]), pk_bf16(v1[2], v1[3]));
          const pg8::f32x4 h0 = v0 * gv[bj][0], h1 = v1 * gv[bj][1];
          *(uint4*)(hb + ((size_t)(col >> 7) * T + row) * 128 + (col & 127)) = make_uint4(pk_bf16(h0[0], h0[1]), pk_bf16(h0[2], h0[3]), pk_bf16(h1[0], h1[1]), pk_bf16(h1[2], h1[3]));
          ss += ((v0[0] * v0[0] + v0[1] * v0[1]) + (v0[2] * v0[2] + v0[3] * v0[3])) + ((v1[0] * v1[0] + v1[1] * v1[1]) + (v1[2] * v1[2] + v1[3] * v1[3]));
        }
        ss += __shfl_xor(ss, 16); ss += __shfl_xor(ss, 32);
        if (fq == 0) parts[(size_t)row * 16 + u.pn * 4 + wc] = ss;
        asm volatile("" ::: "memory");
      }
  }
};
struct EpiScaleStoreBf16 {
  static constexpr bool PERM = true, AFTER_DRAIN = false;
  bf16_t* C; int ldc; const float* parts; int nparts; float* rs_out;
  EPI_ZERO_INIT
  __device__ __forceinline__ void operator()(const pg8::f32x4 (&acc)[2][2][4][2], const pg8::Unit& u, int wr, int wc, int fr_in, int fq_in) const {
    int fr = fr_in, fq = fq_in; asm volatile("" : "+v"(fr), "+v"(fq));
#pragma unroll
    for (int ai = 0; ai < 2; ++ai)
#pragma unroll
      for (int m = 0; m < 4; ++m) {
        const int row = u.pm * 256 + ai * 128 + wr * 64 + m * 16 + fr;
        float ssum = 0.f;
        for (int i = 0; i < nparts; i += 4) { const pg8::f32x4 q4 = *(const pg8::f32x4*)(parts + (size_t)row * nparts + i); ssum += (q4[0] + q4[1]) + (q4[2] + q4[3]); }
        const float r = rsqrtf(ssum * (1.0f / (float)D) + EPS);
        if (rs_out && u.pn == 0 && wc == 0 && fq == 0) rs_out[row] = r;
#pragma unroll
        for (int bj = 0; bj < 2; ++bj) {
          const int col = u.pn * 256 + bj * 128 + wc * 32 + 8 * fq;
          const pg8::f32x4 v0 = acc[ai][bj][m][0] * r, v1 = acc[ai][bj][m][1] * r;
          *(uint4*)(C + (size_t)row * ldc + col) = make_uint4(pk_bf16(v0[0], v0[1]), pk_bf16(v0[2], v0[3]), pk_bf16(v1[0], v1[1]), pk_bf16(v1[2], v1[3]));
        }
        asm volatile("" ::: "memory");
      }
  }
};
struct EpiInProj {
  static constexpr bool PERM = true, AFTER_DRAIN = false;
  const float* parts;
  bf16_t *S5A, *Qm, *Km, *vrow, *Qr, *Kr, *krow, *vrrow, *grow;
  const float *gq, *gk, *cosm, *sinm, *cosr, *sinr;
  EPI_ZERO_INIT
  __device__ __forceinline__ void operator()(const pg8::f32x4 (&acc)[2][2][4][2], const pg8::Unit& u, int wr, int wc, int fr_in, int fq_in) const {
    int fr = fr_in, fq = fq_in; asm volatile("" : "+v"(fr), "+v"(fq));
    const int pn = u.pn;
    float gain[2][8];
    if (pn >= 1 && pn <= 4) {
      const float* gsrc = pn <= 2 ? gq : gk;
#pragma unroll
      for (int bj = 0; bj < 2; ++bj) { const pg8::f32x4 a = *(const pg8::f32x4*)(gsrc + bj * 32 + 8 * fq), b = *(const pg8::f32x4*)(gsrc + bj * 32 + 8 * fq + 4);
        gain[bj][0] = a[0]; gain[bj][1] = a[1]; gain[bj][2] = a[2]; gain[bj][3] = a[3]; gain[bj][4] = b[0]; gain[bj][5] = b[1]; gain[bj][6] = b[2]; gain[bj][7] = b[3]; }
    }
    const float l2g = ret_log2g(wc);
#pragma unroll
    for (int ai = 0; ai < 2; ++ai)
#pragma unroll
      for (int m = 0; m < 4; ++m) {
        const int t = u.pm * 256 + ai * 128 + wr * 64 + m * 16 + fr, s = t & (S - 1), b = t >> 12;
        float r;
        { const pg8::f32x4 p0 = *(const pg8::f32x4*)(parts + (size_t)t * 8), p1 = *(const pg8::f32x4*)(parts + (size_t)t * 8 + 4);
          r = rsqrtf((((p0[0] + p0[1]) + (p0[2] + p0[3])) + ((p1[0] + p1[1]) + (p1[2] + p1[3]))) * (1.0f / (float)D) + EPS); }
        float v[2][8];
#pragma unroll
        for (int bj = 0; bj < 2; ++bj)
#pragma unroll
          for (int e = 0; e < 8; ++e) v[bj][e] = acc[ai][bj][m][e >> 2][e & 3] * r;
#define PK8(x_) make_uint4(pk_bf16((x_)[0], (x_)[1]), pk_bf16((x_)[2], (x_)[3]), pk_bf16((x_)[4], (x_)[5]), pk_bf16((x_)[6], (x_)[7]))
        if (pn == 0) {
#pragma unroll
          for (int bj = 0; bj < 2; ++bj) { const int g = wc * 4 + bj * 2 + (fq >> 1);
            *(uint4*)(S5A + ((size_t)g * 1024 + (t >> 5)) * 640 + (t & 31) * 16 + 8 * (fq & 1)) = PK8(v[bj]); }
        } else if (pn <= 4) {
          const bool isk = pn >= 3; const int h = ((pn - 1) & 1) * 4 + wc, bh = b * 8 + h;
          float ss = 0.f;
#pragma unroll
          for (int bj = 0; bj < 2; ++bj)
#pragma unroll
            for (int e = 0; e < 8; ++e) ss += v[bj][e] * v[bj][e];
          ss += __shfl_xor(ss, 16); ss += __shfl_xor(ss, 32);
          const float rh = rsqrtf(ss * (1.0f / 64.0f) + EPS);
#pragma unroll
          for (int bj = 0; bj < 2; ++bj)
#pragma unroll
            for (int e = 0; e < 8; ++e) v[bj][e] *= rh * gain[bj][e];
          { const pg8::f32x4 c0 = *(const pg8::f32x4*)(cosm + s * 8), c1 = *(const pg8::f32x4*)(cosm + s * 8 + 4), s0 = *(const pg8::f32x4*)(sinm + s * 8), s1 = *(const pg8::f32x4*)(sinm + s * 8 + 4);
#pragma unroll
            for (int e = 0; e < 8; ++e) {
              const float pu = __shfl_xor(v[0][e], 16);
              const float c = e < 4 ? c0[e & 3] : c1[e & 3], sn = e < 4 ? s0[e & 3] : s1[e & 3];
              const float o = fq == 0 ? (v[0][e] * c - pu * sn) : (v[0][e] * c + pu * sn);
              v[0][e] = fq < 2 ? o : v[0][e];
            } }
          if (!isk) {
#pragma unroll
            for (int bj = 0; bj < 2; ++bj) { float q8[8];
#pragma unroll
              for (int e = 0; e < 8; ++e) q8[e] = v[bj][e] * QSCALE;
              *(uint4*)(Qm + ((size_t)bh * S + s) * 64 + bj * 32 + 8 * fq) = PK8(q8); }
          } else {
#pragma unroll
            for (int bj = 0; bj < 2; ++bj) *(uint4*)(Km + ((((size_t)bh * (S / 32) + (s >> 5)) * 8 + bj * 4 + fq) * 32 + (s & 31)) * 8) = PK8(v[bj]);
          }
        } else if (pn <= 6) {
#pragma unroll
          for (int bj = 0; bj < 2; ++bj) *(uint4*)(vrow + (size_t)t * 512 + (pn - 5) * 256 + wc * 64 + bj * 32 + 8 * fq) = PK8(v[bj]);
        } else if (pn <= 8) {
          const bool isk = pn == 8; const int bh = b * 4 + wc, pos = s & 127;
          const float sc = isk ? 0.125f * exp2f(-(float)pos * l2g) : exp2f((float)pos * l2g);
          const pg8::f32x4 c0 = *(const pg8::f32x4*)(cosr + s * 32 + 8 * fq), c1 = *(const pg8::f32x4*)(cosr + s * 32 + 8 * fq + 4);
          const pg8::f32x4 s0 = *(const pg8::f32x4*)(sinr + s * 32 + 8 * fq), s1 = *(const pg8::f32x4*)(sinr + s * 32 + 8 * fq + 4);
          float o1[8], o2[8];
#pragma unroll
          for (int e = 0; e < 8; ++e) { const float c = e < 4 ? c0[e & 3] : c1[e & 3], sn = e < 4 ? s0[e & 3] : s1[e & 3];
            o1[e] = (v[0][e] * c - v[1][e] * sn) * sc; o2[e] = (v[1][e] * c + v[0][e] * sn) * sc; }
          if (!isk) {
            *(uint4*)(Qr + ((size_t)bh * S + s) * 64 + 8 * fq) = PK8(o1); *(uint4*)(Qr + ((size_t)bh * S + s) * 64 + 32 + 8 * fq) = PK8(o2);
          } else {
            *(uint4*)(Kr + ((((size_t)bh * (S / 32) + (s >> 5)) * 8 + fq) * 32 + (s & 31)) * 8) = PK8(o1);
            *(uint4*)(Kr + ((((size_t)bh * (S / 32) + (s >> 5)) * 8 + 4 + fq) * 32 + (s & 31)) * 8) = PK8(o2);
            *(uint4*)(krow + (size_t)t * 256 + wc * 64 + 8 * fq) = PK8(o1); *(uint4*)(krow + (size_t)t * 256 + wc * 64 + 32 + 8 * fq) = PK8(o2);
          }
        } else {
          bf16_t* dst = (pn == 9 ? vrrow : grow) + (size_t)t * 256 + wc * 64 + 8 * fq;
          *(uint4*)dst = PK8(v[0]); *(uint4*)(dst + 32) = PK8(v[1]);
        }
#undef PK8
        asm volatile("" ::: "memory");
      }
  }
};
template <class Epi>
__device__ __forceinline__ void run_gemm(unsigned char* lds_raw, const bf16_t* A, const bf16_t* Bt, int M, int N, int K, const Epi& e) {
  pg8::Gemm g{A, Bt, M, N, K, K, K}; pg8::StaticOrder So; So.init(M, N, (int)gridDim.x, (int)blockIdx.x);
  pg8::gemm_phase<Epi, pg8::StaticOrder, true, true>((PG8_LAS unsigned char*)lds_raw, g, So, e);
}

template <bool HEADPERM>
__device__ __forceinline__ void transpose_items(const float* __restrict__ W, int K, int N, const float* __restrict__ g, bf16_t* __restrict__ Wt, int gw, int ngw, int lane) {
  const int nkt = K / 64, nnt = N / 64;
  for (int it = gw; it < nkt * nnt; it += ngw) {
    int kt = it % nkt, ntile = it / nkt;
    int k0 = kt * 64, n = ntile * 64 + lane;
    int ns = n;
    if (HEADPERM) { const int cp = n & 255; ns = (n & ~255) + ((cp >> 5) & 3) * 64 + (cp >> 7) * 32 + (cp & 31); }
    float v[64];
#pragma unroll
    for (int i = 0; i < 64; ++i) v[i] = W[(size_t)(k0 + i) * N + ns] * g[k0 + i];
    bf16_t* dst = Wt + (size_t)n * (K * KS) + k0;
#pragma unroll
    for (int c = 0; c < 8; ++c) {
      bf16_t hi[8], lo[8];
#pragma unroll
      for (int e = 0; e < 8; ++e) { hi[e] = f2bf(v[c * 8 + e]); lo[e] = f2bf(v[c * 8 + e] - bf2f(hi[e])); }
      uint4 ph, pl;
      ph.x = hi[0] | ((unsigned)hi[1] << 16); ph.y = hi[2] | ((unsigned)hi[3] << 16); ph.z = hi[4] | ((unsigned)hi[5] << 16); ph.w = hi[6] | ((unsigned)hi[7] << 16);
      pl.x = lo[0] | ((unsigned)lo[1] << 16); pl.y = lo[2] | ((unsigned)lo[3] << 16); pl.z = lo[4] | ((unsigned)lo[5] << 16); pl.w = lo[6] | ((unsigned)lo[7] << 16);
      *(uint4*)(dst + c * 8) = ph;
      if (PRECISE) { *(uint4*)(dst + K + c * 8) = pl; *(uint4*)(dst + 2 * K + c * 8) = ph; }
    }
  }
}


__device__ __forceinline__ void phase_prologue(const Params& p, int gtid, int ngt, int gw, int ngw, int lane) {
  for (int idx = gtid; idx < S * 40; idx += ngt) {
    int s = idx / 40, i = idx % 40;
    if (i < 8) {
      const float inv = powf(500000.0f, -(float)(2 * i) / 16.0f);
      float sn, cs; sincosf((float)s * inv, &sn, &cs);
      p.cosm()[s * 8 + i] = cs; p.sinm()[s * 8 + i] = sn;
    } else {
      const int j = i - 8;
      const float inv = powf(10000.0f, -((float)j / 31.0f));
      float sn, cs; sincosf((float)s * inv, &sn, &cs);
      p.cosr()[s * 32 + j] = cs; p.sinr()[s * 32 + j] = sn;
    }
  }
  for (int t = gw; t < T; t += ngw) {
    const float4* xr = (const float4*)(p.inp(0) + (size_t)t * D); float ss = 0.f;
#pragma unroll
    for (int i = 0; i < 4; ++i) { const float4 v = xr[lane + i * 64]; ss += v.x * v.x + v.y * v.y + v.z * v.z + v.w * v.w;
      *(uint2*)(p.xb() + (size_t)t * KD + (lane + i * 64) * 4) = make_uint2(pk_bf16(v.x, v.y), pk_bf16(v.z, v.w)); }
    ss = wave_sum(ss);
    if (lane < 8) p.ssq1()[(size_t)t * 8 + lane] = lane == 0 ? ss : 0.f;
  }
  for (int idx = gtid; idx < NL * 65536; idx += ngt) { const int l2 = idx >> 16, n2 = (idx >> 8) & 255, k2 = idx & 255; p.Wglu_t()[idx] = f2bf(p.inp(11)[(size_t)l2 * 65536 + k2 * 256 + n2]); }
  for (int l = 0; l < NL; ++l) {
    transpose_items<true>(p.inp(2) + (size_t)l * D * INW, D, INW, p.inp(1) + l * D, p.Win_t() + (size_t)l * INW * KD, gw, ngw, lane);
    transpose_items<false>(p.inp(15) + (size_t)l * D * D, D, D, p.inp(14) + l * D, p.Wout_t() + (size_t)l * D * KD, gw, ngw, lane);
    transpose_items<false>(p.inp(17) + (size_t)l * D * D, D, D, p.inp(16) + l * D, p.Wq_t() + (size_t)l * D * KD, gw, ngw, lane);
  }
}


struct S5P { float lr, li, dt, fr, fi; };
__device__ __forceinline__ S5P s5p(const Params& p, int l, int g, int pp) {
  S5P r; r.lr = p.inp(3)[l * 1024 + g * 64 + pp]; r.li = p.inp(4)[l * 1024 + g * 64 + pp]; r.dt = expf(p.inp(5)[l * 16 + g]);
  const float mag = expf(r.lr * r.dt); float sn, cs; sincosf(r.li * r.dt, &sn, &cs);
  const float ar = mag * cs, ai = mag * sn, den = r.lr * r.lr + r.li * r.li;
  r.fr = ((ar - 1.0f) * r.lr + ai * r.li) / den; r.fi = (ai * r.lr - (ar - 1.0f) * r.li) / den;
  return r;
}
__device__ __forceinline__ void s5pow(const S5P& s, int k, float& re, float& im) {
  const float m = expf((float)k * s.lr * s.dt); float sn, cs; sincosf((float)k * s.li * s.dt, &sn, &cs); re = m * cs; im = m * sn;
}
__device__ __forceinline__ void phase_s5_prep(const Params& p, int l, int gtid, int ngt) {
  const float* b_re = p.inp(6) + l * 16384; const float* b_im = p.inp(7) + l * 16384;
  const float* c_re = p.inp(8) + l * 16384; const float* c_im = p.inp(9) + l * 16384;
  bf16_t* Wy = p.S5Wy(); bf16_t* Wz = p.S5Wz();
  for (int it = gtid; it < 16 * 32 * 256; it += ngt) {
    const int hp = it & 15, h = (it >> 4) & 15, d = (it >> 8) & 31, g = it >> 13;
    float prl, pil, frl, fil;
    { const S5P sl = s5p(p, l, g, (int)(threadIdx.x & 63)); s5pow(sl, d, prl, pil); frl = sl.fr; fil = sl.fi; }
    float acc = 0.f;
    for (int pp = 0; pp < 64; ++pp) {
      const float pr = __shfl(prl, pp), pi = __shfl(pil, pp);
      S5P s; s.fr = __shfl(frl, pp); s.fi = __shfl(fil, pp);
      const float br = b_re[(g * 64 + pp) * 16 + hp], bi = b_im[(g * 64 + pp) * 16 + hp];
      const float bbr = s.fr * br - s.fi * bi, bbi = s.fr * bi + s.fi * br;
      const float tr = pr * bbr - pi * bbi, ti = pr * bbi + pi * bbr;
      acc += c_re[(g * 16 + h) * 64 + pp] * tr - c_im[(g * 16 + h) * 64 + pp] * ti;
    }
    const bf16_t v = f2bf(acc);
    for (int jp = 0; jp + d < 32; ++jp) {
      const int j = jp + d;
      Wy[((size_t)g * 512 + j * 16 + h) * 640 + jp * 16 + hp] = v;
      if (d > 0) Wy[((size_t)g * 512 + jp * 16 + h) * 640 + j * 16 + hp] = 0;
    }
  }
  for (int it = gtid; it < 16 * 32 * 16 * 64; it += ngt) {
    const int pp = it & 63, h = (it >> 6) & 15, j = (it >> 10) & 31, g = it >> 15;
    const S5P s = s5p(p, l, g, pp);
    float pr, pi; s5pow(s, j + 1, pr, pi);
    const float cr = c_re[(g * 16 + h) * 64 + pp], ci = c_im[(g * 16 + h) * 64 + pp];
    const unsigned w = pk_bf16(cr * pr - ci * pi, -(cr * pi + ci * pr));
    *(unsigned*)(Wy + ((size_t)g * 512 + j * 16 + h) * 640 + 512 + 2 * pp) = w;
  }
  for (int it = gtid; it < 16 * 64 * 32; it += ngt) {
    const int j = it & 31, pp = (it >> 5) & 63, g = it >> 11;
    const S5P s = s5p(p, l, g, pp);
    float pr, pi; s5pow(s, 31 - j, pr, pi);
    for (int hp = 0; hp < 16; ++hp) {
      const float br = b_re[(g * 64 + pp) * 16 + hp], bi = b_im[(g * 64 + pp) * 16 + hp];
      const float bbr = s.fr * br - s.fi * bi, bbi = s.fr * bi + s.fi * br;
      Wz[((size_t)g * 256 + 2 * pp) * 512 + j * 16 + hp] = f2bf(pr * bbr - pi * bbi);
      Wz[((size_t)g * 256 + 2 * pp + 1) * 512 + j * 16 + hp] = f2bf(pr * bbi + pi * bbr);
    }
  }
  for (int it = gtid; it < 16 * 64; it += ngt) {
    const S5P s = s5p(p, l, it >> 6, it & 63);
    float pr, pi; s5pow(s, 32, pr, pi);
    p.S5a32()[it * 2] = pr; p.S5a32()[it * 2 + 1] = pi;
  }
}
__device__ __forceinline__ void phase_s5_scan(const Params& p, int gtid, int ngt) {
  for (int it = gtid; it < NB * 16 * 64; it += ngt) {
    const int pp = it & 63, g = (it >> 6) & 15, b = it >> 10;
    const float er = p.S5a32()[(g * 64 + pp) * 2], ei = p.S5a32()[(g * 64 + pp) * 2 + 1];
    float sr = 0.f, si = 0.f;
#pragma unroll 1
    for (int c0 = 0; c0 < 128; c0 += 16) {
      float2 z[16];
#pragma unroll
      for (int k = 0; k < 16; ++k) z[k] = *(const float2*)(p.S5Z() + ((size_t)g * 1024 + b * 128 + c0 + k) * 128 + 2 * pp);
#pragma unroll
      for (int k = 0; k < 16; ++k) {
        const size_t ch = (size_t)g * 1024 + b * 128 + c0 + k;
        *(unsigned*)(p.S5A() + ch * 640 + 512 + 2 * pp) = pk_bf16(sr, si);
        const float nr = er * sr - ei * si + z[k].x, ni = er * si + ei * sr + z[k].y;
        sr = nr; si = ni;
      }
    }
  }
}
struct EpiS5Z {
  static constexpr bool PERM = false, AFTER_DRAIN = false;
  float* Z;
  EPI_ZERO_INIT
  __device__ __forceinline__ void operator()(const pg8::f32x4 (&acc)[2][2][4][2], const pg8::Unit& u, int wr, int wc, int fr_in, int fq_in) const {
    int fr = fr_in, fq = fq_in; asm volatile("" : "+v"(fr), "+v"(fq));
    const int g = u.pm >> 2;
#pragma unroll
    for (int ai = 0; ai < 2; ++ai)
#pragma unroll
      for (int m = 0; m < 4; ++m) {
        const int chunk = (u.pm & 3) * 256 + ai * 128 + wr * 64 + m * 16 + fr;
#pragma unroll
        for (int n = 0; n < 2; ++n) *(pg8::f32x4*)(Z + ((size_t)g * 1024 + chunk) * 128 + wc * 32 + n * 16 + 4 * fq) = acc[ai][0][m][n];
      }
  }
};
struct EpiS5Y {
  static constexpr bool PERM = false, AFTER_DRAIN = false;
  bf16_t* ygb; const bf16_t* A; const float* dsk;
  EPI_ZERO_INIT
  __device__ __forceinline__ void operator()(const pg8::f32x4 (&acc)[2][2][4][2], const pg8::Unit& u, int wr, int wc, int fr_in, int fq_in) const {
    int fr = fr_in, fq = fq_in; asm volatile("" : "+v"(fr), "+v"(fq));
    const int g = u.pm >> 2;
#pragma unroll
    for (int ai = 0; ai < 2; ++ai)
#pragma unroll
      for (int m = 0; m < 4; ++m) {
        const int chunk = (u.pm & 3) * 256 + ai * 128 + wr * 64 + m * 16 + fr;
#pragma unroll
        for (int bj = 0; bj < 2; ++bj)
#pragma unroll
          for (int n = 0; n < 2; ++n) {
            const int col = (u.pn & 1) * 256 + bj * 128 + wc * 32 + n * 16 + 4 * fq, j = col >> 4, h = col & 15;
            const uint2 uu = *(const uint2*)(A + ((size_t)g * 1024 + chunk) * 640 + col);
            const pg8::f32x4 dv = *(const pg8::f32x4*)(dsk + g * 16 + h);
            const pg8::f32x4 v = acc[ai][bj][m][n];
            const float y0 = fast_gelu(v[0] + dv[0] * __uint_as_float(uu.x << 16)), y1 = fast_gelu(v[1] + dv[1] * __uint_as_float(uu.x & 0xffff0000u));
            const float y2 = fast_gelu(v[2] + dv[2] * __uint_as_float(uu.y << 16)), y3 = fast_gelu(v[3] + dv[3] * __uint_as_float(uu.y & 0xffff0000u));
            uint2 o; o.x = pk_bf16(y0, y1); o.y = pk_bf16(y2, y3);
            *(uint2*)(ygb + ((size_t)chunk * 32 + j) * 256 + g * 16 + h) = o;
          }
        asm volatile("" ::: "memory");
      }
  }
};
struct EpiGlu {
  static constexpr bool PERM = false, AFTER_DRAIN = false;
  bf16_t* yb; const bf16_t* ygb; float* scr;
  EPI_ZERO_INIT
  __device__ __forceinline__ void operator()(const pg8::f32x4 (&acc_)[2][2][4][2], const pg8::Unit& u, int wr, int wc, int fr_in, int fq_in) const {
    int fr = fr_in, fq = fq_in; asm volatile("" : "+v"(fr), "+v"(fq));
    pg8::f32x4 (&acc)[2][2][4][2] = const_cast<pg8::f32x4 (&)[2][2][4][2]>(acc_);
#pragma unroll
    for (int ai = 0; ai < 2; ++ai)
#pragma unroll
      for (int m = 0; m < 4; ++m) {
        const int rl = ai * 128 + wr * 64 + m * 16 + fr, row = u.pm * 256 + rl;
        float ss = 0.f;
#pragma unroll
        for (int bj = 0; bj < 2; ++bj)
#pragma unroll
          for (int n = 0; n < 2; ++n) {
            const int col = bj * 128 + wc * 32 + n * 16 + 4 * fq;
            const uint2 yy = *(const uint2*)(ygb + (size_t)row * 256 + col);
            const pg8::f32x4 z = acc[ai][bj][m][n];
            pg8::f32x4 r;
            r[0] = __uint_as_float(yy.x << 16) * fast_sigmoid(z[0]); r[1] = __uint_as_float(yy.x & 0xffff0000u) * fast_sigmoid(z[1]);
            r[2] = __uint_as_float(yy.y << 16) * fast_sigmoid(z[2]); r[3] = __uint_as_float(yy.y & 0xffff0000u) * fast_sigmoid(z[3]);
            acc[ai][bj][m][n] = r;
            ss += r[0] * r[0] + r[1] * r[1] + r[2] * r[2] + r[3] * r[3];
          }
        ss += __shfl_xor(ss, 16); ss += __shfl_xor(ss, 32);
        if (fq == 0) scr[rl * 4 + wc] = ss;
        asm volatile("" ::: "memory");
      }
    asm volatile("s_waitcnt lgkmcnt(0)" ::: "memory"); __builtin_amdgcn_s_barrier(); asm volatile("" ::: "memory");
#pragma unroll
    for (int ai = 0; ai < 2; ++ai)
#pragma unroll
      for (int m = 0; m < 4; ++m) {
        const int rl = ai * 128 + wr * 64 + m * 16 + fr, row = u.pm * 256 + rl;
        const pg8::f32x4 s4 = *(const pg8::f32x4*)(scr + rl * 4);
        const float r = rsqrtf((s4[0] + s4[1] + s4[2] + s4[3]) / 256.0f + EPS);
#pragma unroll
        for (int bj = 0; bj < 2; ++bj)
#pragma unroll
          for (int n = 0; n < 2; ++n) { const pg8::f32x4 v = acc[ai][bj][m][n] * r; *(uint2*)(yb + (size_t)row * KD + bj * 128 + wc * 32 + n * 16 + 4 * fq) = make_uint2(pk_bf16(v[0], v[1]), pk_bf16(v[2], v[3])); }
        asm volatile("" ::: "memory");
      }
    asm volatile("s_waitcnt lgkmcnt(0)" ::: "memory"); __builtin_amdgcn_s_barrier(); asm volatile("" ::: "memory");
  }
};


__device__ __forceinline__ void phase_moba2(const Params& p, int l, unsigned char* lds, int* uq) {
  constexpr int OLD = 260;
  bf16_t* Qs = (bf16_t*)lds;
  float* Oaccf = (float*)(lds + 32768);
  float* laccf = (float*)(lds + 32768 + 64 * OLD * 4);
  float* kms = laccf + 256;
  float* gat = kms + 1024;
  unsigned char* lists = (unsigned char*)(gat + 4096);
  int* cnt = (int*)(lists + 4096);
  int* items = cnt + 16;
  int* ctr = items + 160;
  unsigned* selp = (unsigned*)(ctr + 4);
  float* bq = (float*)(selp + 256);
  int* Oacc = (int*)Oaccf; int* lacc = (int*)laccf;
  float kmax = 0.f;
  { const float* gk = p.inp(13) + l * 64;
    for (int d = 0; d < 64; ++d) kmax = fmaxf(kmax, fabsf(gk[d]));
    kmax *= 8.0f * 1.01f; }
  for (;;) {
    const int u = q_pull(uq, NB * 8 * 16, (int*)(lds + 131072), threadIdx.x);
    if (u < 0) break;
    const int qblk = 15 - (u >> 6), bh = u & 63, b = bh >> 3, h = bh & 7;
    int tid = threadIdx.x; asm volatile("" : "+v"(tid));
    const int lane = tid & 63, wv = tid >> 6, n = lane & 31, hh = lane >> 5;
    __syncthreads();
    { const uint4* src = (const uint4*)(p.Qm() + ((size_t)bh * S + qblk * 256) * 64);
      uint4* dst = (uint4*)Qs;
      for (int i = tid; i < 256 * 64 * 2 / 16; i += NTHR) dst[i] = src[i]; }
    for (int i = tid; i < qblk * 64; i += NTHR) kms[i] = p.kmean()[(size_t)bh * 1024 + i];
    for (int i = tid; i < 64 * OLD; i += NTHR) Oacc[i] = 0;
    if (tid < 256) lacc[tid] = 0;
    if (tid < 16) cnt[tid] = 0;
    __syncthreads();
    { const int q = tid & 255, par = tid >> 8;
      float qv[64];
#pragma unroll
      for (int c = 0; c < 8; ++c) {
        uint4 w = *(const uint4*)(Qs + q * 64 + c * 8);
        qv[c * 8 + 0] = __uint_as_float(w.x << 16); qv[c * 8 + 1] = __uint_as_float(w.x & 0xffff0000u);
        qv[c * 8 + 2] = __uint_as_float(w.y << 16); qv[c * 8 + 3] = __uint_as_float(w.y & 0xffff0000u);
        qv[c * 8 + 4] = __uint_as_float(w.z << 16); qv[c * 8 + 5] = __uint_as_float(w.z & 0xffff0000u);
        qv[c * 8 + 6] = __uint_as_float(w.w << 16); qv[c * 8 + 7] = __uint_as_float(w.w & 0xffff0000u);
      }
      if (par == 0) { float qq = 0.f;
#pragma unroll
        for (int d = 0; d < 64; ++d) qq = fmaf(qv[d], qv[d], qq);
        bq[q] = sqrtf(qq) * kmax; }
      for (int j = par; j < qblk; j += 2) {
        float g = 0.f;
#pragma unroll
        for (int d = 0; d < 64; ++d) g = fmaf(qv[d], kms[j * 64 + d], g);
        gat[q * 16 + j] = g;
      }
    }
    __syncthreads();
    if (tid < 256) {
      float b0 = -INFINITY, b1 = -INFINITY, b2 = -INFINITY; int i0 = 0, i1 = 0, i2 = 0;
      for (int j = 0; j < qblk; ++j) {
        float g = gat[tid * 16 + j];
        if (g > b0) { b2 = b1; i2 = i1; b1 = b0; i1 = i0; b0 = g; i0 = j; }
        else if (g > b1) { b2 = b1; i2 = i1; b1 = g; i1 = j; }
        else if (g > b2) { b2 = g; i2 = j; }
      }
      const int nsel = qblk < 3 ? qblk : 3;
      selp[tid] = (unsigned)i0 | ((unsigned)i1 << 4) | ((unsigned)i2 << 8) | ((unsigned)nsel << 12);
    }
    __syncthreads();
    for (int j = wv; j < qblk; j += 8) {
      int base = 0;
      for (int c = 0; c < 4; ++c) {
        const int q = c * 64 + lane;
        const unsigned sp = selp[q];
        const int ns = sp >> 12;
        const bool f = (ns > 0 && (int)(sp & 15) == j) || (ns > 1 && (int)((sp >> 4) & 15) == j) || (ns > 2 && (int)((sp >> 8) & 15) == j);
        const unsigned long long bal = __ballot(f);
        const int pos = base + __popcll(bal & ((1ull << lane) - 1ull));
        if (f) lists[j * 256 + pos] = (unsigned char)q;
        base += __popcll(bal);
      }
      if (lane == 0) cnt[j] = base;
    }
    __syncthreads();
    if (tid == 0) {
      int ni = 0;
#pragma unroll 1
      for (int g = 7; g >= 0; --g) items[ni++] = (16 << 8) | g;
      for (int j = 0; j < qblk; ++j) { const int ng = (cnt[j] + 31) >> 5; for (int g = 0; g < ng; ++g) items[ni++] = (j << 8) | g; }
      ctr[0] = ni; ctr[1] = 0;
    }
    __syncthreads();
    const int nitems = ctr[0];
    DUP(11) {
    if (rep_ > 0) { __syncthreads(); if (tid == 0) ctr[1] = 0; __syncthreads(); }
    for (;;) {
      int it = 0;
      if (lane == 0) it = atomicAdd(&ctr[1], 1);
      it = __builtin_amdgcn_readfirstlane(it);
      if (it >= nitems) break;
      const int item = items[it];
      const int j = item >> 8, g = item & 255;
      const bool own = (j == 16);
      const int kb = own ? qblk : j;
      const int ntile = own ? (g + 1) : 8;
      int qi; bool valid;
      if (own) { qi = g * 32 + n; valid = true; }
      else { const int pos = g * 32 + n; valid = pos < cnt[j]; qi = lists[j * 256 + (valid ? pos : 0)]; }
      const bf16_t* kt0 = p.Km() + ((size_t)bh * (S / 32) + kb * 8) * 2048 + lane * 8;
      const bf16_t* vt0 = p.Vm() + ((size_t)bh * (S / 32) + kb * 8) * 2048 + lane * 8;
      f32x16 O0, O1;
#pragma unroll
      for (int r = 0; r < 16; ++r) { O0[r] = 0.f; O1[r] = 0.f; }
      float lsum = 0.f;
      const float nbq = -bq[qi];
      bf16x8 kf[3][4], vf[3][4];
#define MOBA_LOAD(KT_, BUF_) { _Pragma("unroll") for (int s = 0; s < 4; ++s) { kf[BUF_][s] = *(const bf16x8*)(kt0 + (size_t)(KT_) * 2048 + s * 512); vf[BUF_][s] = *(const bf16x8*)(vt0 + (size_t)(KT_) * 2048 + s * 512); } }
#define MOBA_STEP(KT_, BUF_)                                                                                                           \
      if ((KT_) < ntile) {                                                                                                               \
        if ((KT_) + 2 < ntile) MOBA_LOAD((KT_) + 2, ((BUF_) + 2) % 3)                                                                     \
        f32x16 X;                                                                                                                         \
        _Pragma("unroll") for (int r = 0; r < 16; ++r) X[r] = nbq;                                                                        \
        _Pragma("unroll") for (int s = 0; s < 4; ++s) X = __builtin_amdgcn_mfma_f32_32x32x16_bf16(kf[BUF_][s], *(const bf16x8*)(Qs + qi * 64 + (2 * s + hh) * 8), X, 0, 0, 0);     \
        const bool diag = own && ((KT_) == g);                                                                                            \
        unsigned pw[8];                                                                                                                   \
        _Pragma("unroll") for (int r = 0; r < 16; r += 2) {                                                                               \
          float e0 = __builtin_amdgcn_exp2f(X[r]), e1 = __builtin_amdgcn_exp2f(X[r + 1]);                                                 \
          if (diag) {                                                                                                                     \
            const int k0 = (r & 3) + 8 * (r >> 2) + 4 * hh, k1 = ((r + 1) & 3) + 8 * ((r + 1) >> 2) + 4 * hh;                             \
            e0 = (k0 <= n) ? e0 : 0.f; e1 = (k1 <= n) ? e1 : 0.f;                                                                         \
          }                                                                                                                               \
          lsum += e0 + e1;                                                                                                                \
          pw[r >> 1] = pk_bf16(e0, e1);                                                                                                   \
        }                                                                                                                                 \
        bf16x8 pf0, pf1;                                                                                                                  \
        { uint4 t0 = make_uint4(pw[0], pw[1], pw[2], pw[3]), t1 = make_uint4(pw[4], pw[5], pw[6], pw[7]);                                 \
          pf0 = *(bf16x8*)&t0; pf1 = *(bf16x8*)&t1; }                                                                                     \
        O0 = __builtin_amdgcn_mfma_f32_32x32x16_bf16(vf[BUF_][0], pf0, O0, 0, 0, 0);                                                      \
        O0 = __builtin_amdgcn_mfma_f32_32x32x16_bf16(vf[BUF_][1], pf1, O0, 0, 0, 0);                                                      \
        O1 = __builtin_amdgcn_mfma_f32_32x32x16_bf16(vf[BUF_][2], pf0, O1, 0, 0, 0);                                                      \
        O1 = __builtin_amdgcn_mfma_f32_32x32x16_bf16(vf[BUF_][3], pf1, O1, 0, 0, 0);                                                      \
      }
      MOBA_LOAD(0, 0)
      if (ntile > 1) MOBA_LOAD(1, 1)
#pragma unroll 1
      for (int kt3 = 0; kt3 < ntile; kt3 += 3) {
        MOBA_STEP(kt3, 0) MOBA_STEP(kt3 + 1, 1) MOBA_STEP(kt3 + 2, 2)
      }
#undef MOBA_STEP
#undef MOBA_LOAD
      lsum += __shfl_xor(lsum, 32);
      if (valid) {
        if (hh == 0) atomicAdd(&lacc[qi], __float2int_rn(lsum * 1048576.0f));
#pragma unroll
        for (int r = 0; r < 16; ++r) {
          const int dim = (r & 3) + 8 * (r >> 2) + 4 * hh;
          atomicAdd(&Oacc[dim * OLD + qi], __float2int_rn(O0[r] * 1048576.0f));
          atomicAdd(&Oacc[(dim + 32) * OLD + qi], __float2int_rn(O1[r] * 1048576.0f));
        }
      }
    }
    }
    __syncthreads();
    { const int q = tid >> 1, half = tid & 1;
      const float inv = 1.0f / (float)lacc[q];
      float o[32], ss = 0.f;
#pragma unroll
      for (int d = 0; d < 32; ++d) { o[d] = (float)Oacc[(half * 32 + d) * OLD + q] * inv; ss += o[d] * o[d]; }
      ss += __shfl_xor(ss, 1);
      const float r = rsqrtf(ss / 64.0f + EPS);
      bf16_t* dst = p.xb() + (size_t)(b * S + qblk * 256 + q) * KD + 256 + h * 64 + half * 32;
#pragma unroll
      for (int d = 0; d < 32; d += 8) *(uint4*)(dst + d) = make_uint4(pk_bf16(o[d] * r, o[d + 1] * r), pk_bf16(o[d + 2] * r, o[d + 3] * r), pk_bf16(o[d + 4] * r, o[d + 5] * r), pk_bf16(o[d + 6] * r, o[d + 7] * r));
    }
  }
}


__device__ __forceinline__ void phase_ret_kv(const Params& p, int gw, int ngw, int lane) {
  const int n = lane & 31, hh = lane >> 5;
  for (int w = gw; w < NB * 4 * 32; w += ngw) {
    const int bh = w >> 5, cn = w & 31;
    const bf16_t* vt = p.Vr() + ((size_t)bh * (S / 32) + cn * 4) * 2048 + lane * 8;
    const bf16_t* kt = p.Krv() + ((size_t)bh * (S / 32) + cn * 4) * 2048 + lane * 8;
    f32x16 acc[2][2];
#pragma unroll
    for (int a = 0; a < 2; ++a)
#pragma unroll
      for (int b2 = 0; b2 < 2; ++b2)
#pragma unroll
        for (int r = 0; r < 16; ++r) acc[a][b2][r] = 0.f;
#pragma unroll 1
    for (int tl = 0; tl < 4; ++tl)
#pragma unroll
      for (int ks = 0; ks < 2; ++ks) {
        bf16x8 vf[2], kf[2];
#pragma unroll
        for (int x = 0; x < 2; ++x) { vf[x] = *(const bf16x8*)(vt + tl * 2048 + (x * 2 + ks) * 512); kf[x] = *(const bf16x8*)(kt + tl * 2048 + (x * 2 + ks) * 512); }
#pragma unroll
        for (int mb = 0; mb < 2; ++mb)
#pragma unroll
          for (int nb = 0; nb < 2; ++nb) acc[mb][nb] = __builtin_amdgcn_mfma_f32_32x32x16_bf16(vf[mb], kf[nb], acc[mb][nb], 0, 0, 0);
      }
    float* dst = p.KVr() + ((size_t)bh * 32 + cn) * 4096;
#pragma unroll
    for (int mb = 0; mb < 2; ++mb)
#pragma unroll
      for (int nb = 0; nb < 2; ++nb)
#pragma unroll
        for (int r = 0; r < 16; ++r) dst[(mb * 32 + (r & 3) + 8 * (r >> 2) + 4 * hh) * 64 + nb * 32 + n] = acc[mb][nb][r];
  }
}
__device__ __forceinline__ void phase_ret_scan(const Params& p, int gtid, int ngt) {
  for (int it = gtid; it < NB * 4 * 4096; it += ngt) {
    const int e = it & 4095, bh = it >> 12, h = bh & 3;
    const float l2g = ret_log2g(h), g1 = exp2f(l2g), g127 = exp2f(127.0f * l2g), g128 = exp2f(128.0f * l2g);
    float R = 0.f; float kv[32];
#pragma unroll
    for (int cn = 0; cn < 32; ++cn) kv[cn] = p.KVr()[((size_t)bh * 32 + cn) * 4096 + e];
#pragma unroll
    for (int cn = 0; cn < 32; ++cn) {
      p.Rb()[((size_t)bh * 32 + cn) * 4096 + e] = f2bf(g1 * R);
      R = g128 * R + g127 * kv[cn];
    }
  }
}
__device__ __forceinline__ void phase_ret_out(const Params& p, int gw, int ngw, int lane) {
  const int n = lane & 31, hh = lane >> 5;
  for (int w = gw; w < NB * 4 * 32 * 4; w += ngw) {
    const int qg = 3 - (w & 3), cn = (w >> 2) & 31, bh = w >> 7, b = bh >> 2, h = bh & 3;
    const int s0 = cn * 128 + qg * 32;
    bf16x8 qf[4];
#pragma unroll
    for (int s = 0; s < 4; ++s) qf[s] = *(const bf16x8*)(p.Qr() + ((size_t)bh * S + s0 + n) * 64 + (2 * s + hh) * 8);
    f32x16 O0, O1;
#pragma unroll
    for (int r = 0; r < 16; ++r) { O0[r] = 0.f; O1[r] = 0.f; }
    { const bf16_t* rb = p.Rb() + ((size_t)bh * 32 + cn) * 4096 + (size_t)n * 64 + hh * 8;
#pragma unroll
      for (int s = 0; s < 4; ++s) {
        const bf16x8 r0 = *(const bf16x8*)(rb + s * 16), r1 = *(const bf16x8*)(rb + 32 * 64 + s * 16);
        O0 = __builtin_amdgcn_mfma_f32_32x32x16_bf16(r0, qf[s], O0, 0, 0, 0);
        O1 = __builtin_amdgcn_mfma_f32_32x32x16_bf16(r1, qf[s], O1, 0, 0, 0);
      } }
    const bf16_t* kt0 = p.Kr() + ((size_t)bh * (S / 32) + cn * 4) * 2048 + lane * 8;
    const bf16_t* vt0 = p.Vr() + ((size_t)bh * (S / 32) + cn * 4) * 2048 + lane * 8;
    for (int kt = 0; kt <= qg; ++kt) {
      bf16x8 kf[4], vf[4];
#pragma unroll
      for (int s = 0; s < 4; ++s) { kf[s] = *(const bf16x8*)(kt0 + (size_t)kt * 2048 + s * 512); vf[s] = *(const bf16x8*)(vt0 + (size_t)kt * 2048 + s * 512); }
      f32x16 X;
#pragma unroll
      for (int r = 0; r < 16; ++r) X[r] = 0.f;
#pragma unroll
      for (int s = 0; s < 4; ++s) X = __builtin_amdgcn_mfma_f32_32x32x16_bf16(kf[s], qf[s], X, 0, 0, 0);
      const bool diag = (kt == qg);
      unsigned pw[8];
#pragma unroll
      for (int r = 0; r < 16; r += 2) {
        float e0 = X[r], e1 = X[r + 1];
        if (diag) {
          const int k0 = (r & 3) + 8 * (r >> 2) + 4 * hh, k1 = ((r + 1) & 3) + 8 * ((r + 1) >> 2) + 4 * hh;
          e0 = (k0 <= n) ? e0 : 0.f; e1 = (k1 <= n) ? e1 : 0.f;
        }
        pw[r >> 1] = pk_bf16(e0, e1);
      }
      bf16x8 pf0, pf1;
      { uint4 t0 = make_uint4(pw[0], pw[1], pw[2], pw[3]), t1 = make_uint4(pw[4], pw[5], pw[6], pw[7]);
        pf0 = *(bf16x8*)&t0; pf1 = *(bf16x8*)&t1; }
      O0 = __builtin_amdgcn_mfma_f32_32x32x16_bf16(vf[0], pf0, O0, 0, 0, 0);
      O0 = __builtin_amdgcn_mfma_f32_32x32x16_bf16(vf[1], pf1, O0, 0, 0, 0);
      O1 = __builtin_amdgcn_mfma_f32_32x32x16_bf16(vf[2], pf0, O1, 0, 0, 0);
      O1 = __builtin_amdgcn_mfma_f32_32x32x16_bf16(vf[3], pf1, O1, 0, 0, 0);
    }
    float ss = 0.f;
#pragma unroll
    for (int r = 0; r < 16; ++r) ss += O0[r] * O0[r] + O1[r] * O1[r];
    ss += __shfl_xor(ss, 32);
    const float rn = rsqrtf(ss / 64.0f + EPS);
    const size_t t = (size_t)b * S + s0 + n;
    const bf16_t* gp = p.grow() + t * 256 + h * 64;
    bf16_t* yo = p.xb() + t * KD + 768 + h * 64;
#pragma unroll
    for (int q4 = 0; q4 < 4; ++q4) {
#pragma unroll
      for (int mb = 0; mb < 2; ++mb) {
        const int d0 = mb * 32 + 8 * q4 + 4 * hh;
        const uint2 gw2 = *(const uint2*)(gp + d0); const float4 g = make_float4(__uint_as_float(gw2.x << 16), __uint_as_float(gw2.x & 0xffff0000u), __uint_as_float(gw2.y << 16), __uint_as_float(gw2.y & 0xffff0000u));
        float4 o;
        const f32x16& Oa = mb ? O1 : O0;
        o.x = Oa[q4 * 4 + 0] * rn * g.x * fast_sigmoid(g.x); o.y = Oa[q4 * 4 + 1] * rn * g.y * fast_sigmoid(g.y);
        o.z = Oa[q4 * 4 + 2] * rn * g.z * fast_sigmoid(g.z); o.w = Oa[q4 * 4 + 3] * rn * g.w * fast_sigmoid(g.w);
        *(uint2*)(yo + d0) = make_uint2(pk_bf16(o.x, o.y), pk_bf16(o.z, o.w));
      }
    }
  }
}

__device__ __forceinline__ void phase_post_pack(const Params& p, int gtid, int ngt) {
  for (int idx0 = gtid; idx0 < NB * 8 * (S / 32) * 256; idx0 += 4 * ngt) {
    bf16_t v[4][8]; bool ok[4];
#pragma unroll
    for (int u = 0; u < 4; ++u) { const int idx_ = idx0 + u * ngt; ok[u] = idx_ < NB * 8 * (S / 32) * 256; const int idx = ok[u] ? idx_ : 0;
      const int ln = idx & 63, ks = (idx >> 6) & 1, mb = (idx >> 7) & 1, tile = (idx >> 8) % (S / 32), bh = idx / (256 * (S / 32));
      const int b = bh >> 3, h = bh & 7, hh = ln >> 5, delta = mb * 32 + (ln & 31);
#pragma unroll
      for (int j = 0; j < 8; ++j) { const int kappa = 16 * ks + 8 * (j >> 2) + 4 * hh + (j & 3), s = tile * 32 + kappa; v[u][j] = p.vrow()[(size_t)(b * S + s) * 512 + h * 64 + delta]; } }
#pragma unroll
    for (int u = 0; u < 4; ++u) if (ok[u])
      *(uint4*)(p.Vm() + (size_t)(idx0 + u * ngt) * 8) = make_uint4(v[u][0] | ((unsigned)v[u][1] << 16), v[u][2] | ((unsigned)v[u][3] << 16), v[u][4] | ((unsigned)v[u][5] << 16), v[u][6] | ((unsigned)v[u][7] << 16));
  }
  for (int idx0 = gtid; idx0 < 2 * NB * 4 * (S / 32) * 256; idx0 += 4 * ngt) {
    bf16_t v[4][8]; bool ok[4];
#pragma unroll
    for (int u = 0; u < 4; ++u) { const int idx_ = idx0 + u * ngt; ok[u] = idx_ < 2 * NB * 4 * (S / 32) * 256; const int idx = ok[u] ? idx_ : 0;
      const int ln = idx & 63, ks = (idx >> 6) & 1, blk = (idx >> 7) & 1, tile = (idx >> 8) % (S / 32), rest = idx / (256 * (S / 32)), bh = rest % (NB * 4), which = rest / (NB * 4);
      const int b = bh >> 2, h = bh & 3, hh = ln >> 5, delta = blk * 32 + (ln & 31);
      const bf16_t* srcp = which ? p.krow() : p.vrrow();
#pragma unroll
      for (int j = 0; j < 8; ++j) { const int kappa = 16 * ks + 8 * (j >> 2) + 4 * hh + (j & 3), s = tile * 32 + kappa; v[u][j] = srcp[(size_t)(b * S + s) * 256 + h * 64 + delta]; } }
#pragma unroll
    for (int u = 0; u < 4; ++u) if (ok[u]) { const int idx = idx0 + u * ngt; const int which = (idx / (256 * (S / 32))) / (NB * 4);
      *(uint4*)((which ? p.Krv() : p.Vr()) + ((size_t)(idx % (NB * 4 * (S / 32) * 256))) * 8) = make_uint4(v[u][0] | ((unsigned)v[u][1] << 16), v[u][2] | ((unsigned)v[u][3] << 16), v[u][4] | ((unsigned)v[u][5] << 16), v[u][6] | ((unsigned)v[u][7] << 16)); }
  }
}
__device__ __forceinline__ void phase_kmean2(const Params& p, int gtid, int ngt) {
  const int lane = gtid & 63, half = lane >> 5;
  for (int w = gtid >> 6; w < NB * 8 * 16; w += ngt >> 6) {
    const int j = w & 15, bh = w >> 4;
    const bf16_t* kp = p.Km() + ((size_t)bh * (S / 32) + j * 8) * 2048 + lane * 8;
    float acc[4][8];
#pragma unroll
    for (int i = 0; i < 4; ++i)
#pragma unroll
      for (int e = 0; e < 8; ++e) acc[i][e] = 0.f;
#pragma unroll
    for (int t2 = 0; t2 < 8; t2 += 2) {
      uint4 r[2][4];
#pragma unroll
      for (int tt = 0; tt < 2; ++tt)
#pragma unroll
        for (int i = 0; i < 4; ++i) r[tt][i] = *(const uint4*)(kp + (size_t)(t2 + tt) * 2048 + i * 512);
#pragma unroll
      for (int tt = 0; tt < 2; ++tt)
#pragma unroll
        for (int i = 0; i < 4; ++i) { const unsigned w4[4] = {r[tt][i].x, r[tt][i].y, r[tt][i].z, r[tt][i].w};
#pragma unroll
          for (int q = 0; q < 4; ++q) { acc[i][2 * q] += __uint_as_float(w4[q] << 16); acc[i][2 * q + 1] += __uint_as_float(w4[q] & 0xffff0000u); } }
    }
#pragma unroll
    for (int i = 0; i < 4; ++i)
#pragma unroll
      for (int e = 0; e < 8; ++e) { float a = acc[i][e];
        a += __shfl_xor(a, 1); a += __shfl_xor(a, 2); a += __shfl_xor(a, 4); a += __shfl_xor(a, 8); a += __shfl_xor(a, 16); acc[i][e] = a; }
    if ((lane & 31) == 0) {
#pragma unroll
      for (int i = 0; i < 4; ++i) { float* dst = p.kmean() + (size_t)w * 64 + (2 * i + half) * 8;
        *(float4*)dst = make_float4(acc[i][0] * (1.0f / 256.0f), acc[i][1] * (1.0f / 256.0f), acc[i][2] * (1.0f / 256.0f), acc[i][3] * (1.0f / 256.0f));
        *(float4*)(dst + 4) = make_float4(acc[i][4] * (1.0f / 256.0f), acc[i][5] * (1.0f / 256.0f), acc[i][6] * (1.0f / 256.0f), acc[i][7] * (1.0f / 256.0f)); }
    }
  }
}

__device__ __forceinline__ void cvt_f32_bf16(const float* __restrict__ src, bf16_t* __restrict__ dst, size_t n8, int gtid, int ngt) {
  for (size_t i = gtid; i < n8; i += ngt) {
    float4 a = *(const float4*)(src + i * 8), b4 = *(const float4*)(src + i * 8 + 4);
    uint4 o; o.x = pk_bf16(a.x, a.y); o.y = pk_bf16(a.z, a.w); o.z = pk_bf16(b4.x, b4.y); o.w = pk_bf16(b4.z, b4.w);
    *(uint4*)(dst + i * 8) = o;
  }
}
__device__ __forceinline__ int f2key(float f) { int b = __float_as_int(f); return b ^ ((b >> 31) & 0x7fffffff); }
__device__ __forceinline__ float key2f(int k) { return __int_as_float(k ^ ((k >> 31) & 0x7fffffff)); }
#define CASD(a_, b_) { int mx_ = max(a_, b_), mn_ = min(a_, b_); a_ = mx_; b_ = mn_; }
__device__ __forceinline__ void sort16_desc(int (&v)[16]) {
#pragma unroll
  for (int k = 2; k <= 16; k <<= 1)
#pragma unroll
    for (int j = k >> 1; j > 0; j >>= 1)
#pragma unroll
      for (int i = 0; i < 16; ++i) { const int l2 = i ^ j; if (l2 > i) { if ((i & k) == 0) CASD(v[i], v[l2]) else CASD(v[l2], v[i]) } }
}
__device__ __forceinline__ void merge_top16(int (&a)[16], const int (&b)[16]) {
#pragma unroll
  for (int i = 0; i < 16; ++i) a[i] = max(a[i], b[15 - i]);
#pragma unroll
  for (int j = 8; j > 0; j >>= 1)
#pragma unroll
    for (int i = 0; i < 16; ++i) { const int l2 = i ^ j; if (l2 > i) CASD(a[i], a[l2]) }
}
__device__ __forceinline__ int lut4(int w0, int w1, int w2, int w3, int i) {
  const int w = i >> 2; const int d = (w == 0) ? w0 : (w == 1) ? w1 : (w == 2) ? w2 : w3;
  return (d >> ((i & 3) * 8)) & 127;
}

__device__ __forceinline__ void phase_peer_topk(const Params& p, int l, int gw, int ngw, int lane) {
  const int n = lane & 31, hh = lane >> 5;
  const bf16_t* skl = p.skb() + (size_t)l * 16 * 128 * 64;
  for (int w = gw; w < (T / 32) * 8; w += ngw) {
    const int tg = w >> 3, h = w & 7, t = tg * 32 + n;
    int L0[16], L1[16];
#pragma unroll
    for (int c = 0; c < 2; ++c) {
      const int hc = 2 * h + c;
      bf16x8 qf[4];
#pragma unroll
      for (int s = 0; s < 4; ++s) qf[s] = *(const bf16x8*)(p.qb() + (size_t)t * D + hc * 64 + 16 * s + 8 * hh);
      int A[16], Bq[16];
#pragma unroll
      for (int mb = 0; mb < 4; ++mb) {
        f32x16 X;
#pragma unroll
        for (int r = 0; r < 16; ++r) X[r] = 0.f;
#pragma unroll
        for (int s = 0; s < 4; ++s) {
          const bf16x8 kf = *(const bf16x8*)(skl + ((size_t)(hc * 128 + mb * 32 + n)) * 64 + 16 * s + 8 * hh);
          X = __builtin_amdgcn_mfma_f32_32x32x16_bf16(kf, qf[s], X, 0, 0, 0);
        }
        int Gk[16];
#pragma unroll
        for (int r = 0; r < 16; ++r) Gk[r] = (f2key(X[r]) & ~127) | (mb * 32 + (r & 3) + 8 * (r >> 2) + 4 * hh);
        sort16_desc(Gk);
        if (mb == 0) {
#pragma unroll
          for (int r = 0; r < 16; ++r) A[r] = Gk[r];
        } else merge_top16(A, Gk);
      }
#pragma unroll
      for (int r = 0; r < 16; ++r) Bq[r] = __shfl_xor(A[r], 32);
      merge_top16(A, Bq);
#pragma unroll
      for (int r = 0; r < 16; ++r) { if (c == 0) L0[r] = A[r]; else L1[r] = A[r]; }
    }
    float av[16], bv[16];
#pragma unroll
    for (int r = 0; r < 16; ++r) { av[r] = key2f(L0[r] & ~127); bv[r] = key2f(L1[r] & ~127); }
#define CAND(i_, j_) ((f2key(av[i_] + bv[j_]) & ~255) | ((i_) << 4) | (j_))
    int R[16], G1[16], G2[16];
#pragma unroll
    for (int j = 0; j < 16; ++j) R[j] = CAND(0, j);
    G1[0] = CAND(1, 0); G1[1] = CAND(1, 1); G1[2] = CAND(1, 2); G1[3] = CAND(1, 3); G1[4] = CAND(1, 4); G1[5] = CAND(1, 5); G1[6] = CAND(1, 6); G1[7] = CAND(1, 7);
    G1[8] = CAND(2, 0); G1[9] = CAND(2, 1); G1[10] = CAND(2, 2); G1[11] = CAND(2, 3); G1[12] = CAND(2, 4); G1[13] = CAND(3, 0); G1[14] = CAND(3, 1); G1[15] = CAND(3, 2);
    G2[0] = CAND(3, 3); G2[1] = CAND(4, 0); G2[2] = CAND(4, 1); G2[3] = CAND(4, 2); G2[4] = CAND(5, 0); G2[5] = CAND(5, 1); G2[6] = CAND(6, 0); G2[7] = CAND(6, 1);
    G2[8] = CAND(7, 0); G2[9] = CAND(7, 1); G2[10] = CAND(8, 0); G2[11] = CAND(9, 0); G2[12] = CAND(10, 0); G2[13] = CAND(11, 0); G2[14] = CAND(12, 0); G2[15] = CAND(13, 0);
    sort16_desc(G1); merge_top16(R, G1);
    sort16_desc(G2); merge_top16(R, G2);
    { int x0 = CAND(14, 0), x1 = CAND(15, 0);
#pragma unroll
      for (int i = 0; i < 16; ++i) CASD(R[i], x0)
#pragma unroll
      for (int i = 0; i < 16; ++i) CASD(R[i], x1)
    }
#undef CAND
    int pa0 = 0, pa1 = 0, pa2 = 0, pa3 = 0, pb0 = 0, pb1 = 0, pb2 = 0, pb3 = 0;
#pragma unroll
    for (int q = 0; q < 4; ++q) {
      pa0 |= (L0[q] & 127) << (8 * q); pa1 |= (L0[4 + q] & 127) << (8 * q); pa2 |= (L0[8 + q] & 127) << (8 * q); pa3 |= (L0[12 + q] & 127) << (8 * q);
      pb0 |= (L1[q] & 127) << (8 * q); pb1 |= (L1[4 + q] & 127) << (8 * q); pb2 |= (L1[8 + q] & 127) << (8 * q); pb3 |= (L1[12 + q] & 127) << (8 * q);
    }
    float ev[16], sum = 0.f; int ei[16];
    const float mx = key2f(R[0] & ~255);
#pragma unroll
    for (int z = 0; z < 16; ++z) {
      const float v = key2f(R[z] & ~255);
      ev[z] = __expf(v - mx); sum += ev[z];
      const int pay = R[z] & 255;
      ei[z] = lut4(pa0, pa1, pa2, pa3, pay >> 4) * 128 + lut4(pb0, pb1, pb2, pb3, pay & 15);
    }
    const float inv = 1.0f / sum;
    if (hh == 0) {
      float* go = p.gates() + ((size_t)t * 8 + h) * 16; int* eo = p.eidx() + ((size_t)t * 8 + h) * 16;
#pragma unroll
      for (int z = 0; z < 16; z += 4) {
        *(float4*)(go + z) = make_float4(ev[z] * inv, ev[z + 1] * inv, ev[z + 2] * inv, ev[z + 3] * inv);
        *(int4*)(eo + z) = make_int4(ei[z], ei[z + 1], ei[z + 2], ei[z + 3]);
      }
    }
  }
}


typedef int v8i __attribute__((ext_vector_type(8)));
__device__ __forceinline__ unsigned xcc_id() { return (unsigned)__builtin_amdgcn_s_getreg((3 << 11) | 20) & 7u; }
__device__ __forceinline__ float pow2_scale(float amax) {
  if (!(amax > 0.f)) return 1.0f;
  const int e = (int)floorf(log2f(240.0f / amax));
  return exp2f((float)(e < 60 ? (e > -60 ? e : -60) : 60));
}
__device__ __forceinline__ unsigned pack4_fp8(float a, float b, float c, float d) {
  int v = __builtin_amdgcn_cvt_pk_fp8_f32(a, b, 0, false);
  v = __builtin_amdgcn_cvt_pk_fp8_f32(c, d, v, true);
  return (unsigned)v;
}
__device__ __forceinline__ void cvt_table_i8(const float* __restrict__ src, unsigned char* __restrict__ dst, float* __restrict__ scl, int gw, int ngw, int lane) {
  for (int e0 = gw; e0 < 16384; e0 += 2 * ngw) {
    float4 v[2][4];
#pragma unroll
    for (int u = 0; u < 2; ++u) { const int e = (e0 + u * ngw < 16384) ? e0 + u * ngw : e0;
#pragma unroll
      for (int k = 0; k < 4; ++k) v[u][k] = *(const float4*)(src + (size_t)e * D + k * 256 + lane * 4); }
#pragma unroll
    for (int u = 0; u < 2; ++u) {
      const int e = e0 + u * ngw;
      if (e < 16384) {
        float am = 0.f;
#pragma unroll
        for (int k = 0; k < 4; ++k) am = fmaxf(am, fmaxf(fmaxf(fabsf(v[u][k].x), fabsf(v[u][k].y)), fmaxf(fabsf(v[u][k].z), fabsf(v[u][k].w))));
        am = wave_max(am);
        const float s = am > 0.f ? 127.0f / am : 1.0f;
        if (lane == 0) scl[e] = s;
#pragma unroll
        for (int k = 0; k < 4; ++k) {
          const int slice = 2 * k + (lane >> 5), off = (lane & 31) * 4;
          const unsigned w = (unsigned)(__float2int_rn(v[u][k].x * s) & 255) | ((unsigned)(__float2int_rn(v[u][k].y * s) & 255) << 8) |
                             ((unsigned)(__float2int_rn(v[u][k].z * s) & 255) << 16) | ((unsigned)(__float2int_rn(v[u][k].w * s) & 255) << 24);
          *(unsigned*)(dst + ((size_t)slice * 16384 + e) * 128 + off) = w;
        }
      }
    }
  }
}
__device__ __forceinline__ void cvt_table_fp8(const float* __restrict__ src, unsigned char* __restrict__ dst, float* __restrict__ scl, int gw, int ngw, int lane) {
  for (int e0 = gw; e0 < 16384; e0 += 2 * ngw) {
    float4 v[2][4];
#pragma unroll
    for (int u = 0; u < 2; ++u) { const int e = (e0 + u * ngw < 16384) ? e0 + u * ngw : e0;
#pragma unroll
      for (int k = 0; k < 4; ++k) v[u][k] = *(const float4*)(src + (size_t)e * D + k * 256 + lane * 4); }
#pragma unroll
    for (int u = 0; u < 2; ++u) {
      const int e = e0 + u * ngw;
      if (e < 16384) {
        float am = 0.f;
#pragma unroll
        for (int k = 0; k < 4; ++k) am = fmaxf(am, fmaxf(fmaxf(fabsf(v[u][k].x), fabsf(v[u][k].y)), fmaxf(fabsf(v[u][k].z), fabsf(v[u][k].w))));
        am = wave_max(am);
        const float s = pow2_scale(am);
        if (lane == 0) scl[e] = s;
#pragma unroll
        for (int k = 0; k < 4; ++k) {
          const int slice = 2 * k + (lane >> 5), off = (lane & 31) * 4;
          *(unsigned*)(dst + ((size_t)slice * 16384 + e) * 128 + off) = pack4_fp8(v[u][k].x * s, v[u][k].y * s, v[u][k].z * s, v[u][k].w * s);
        }
      }
    }
  }
}
#define DPP_ADD(v_, ctrl_) ((v_) + __builtin_bit_cast(float, __builtin_amdgcn_update_dpp(0, __builtin_bit_cast(int, (v_)), (ctrl_), 0xF, 0xF, true)))
__device__ __forceinline__ float sum_xor16(float x) { float a = x, b = x; asm volatile("v_nop\n\tv_nop\n\tv_permlane16_swap_b32 %0, %1" : "+v"(a), "+v"(b)); return a + b; }
__device__ __forceinline__ float sum_xor32(float x) { float a = x, b = x; asm volatile("v_nop\n\tv_nop\n\tv_permlane32_swap_b32 %0, %1" : "+v"(a), "+v"(b)); return a + b; }
constexpr int PEER_TILE = 128;
__device__ __forceinline__ void phase_peer_u(const Params& p, int* heads, unsigned char* lds, int tid) {
  const int lane = tid & 63, wv = tid >> 6, r8 = lane >> 3, c8 = lane & 7;
  int* bc = (int*)lds;
  int* eW = (int*)(lds + 1024 + wv * 12288);
  bf16_t* hW = (bf16_t*)(lds + 1024 + wv * 12288 + 8192);
  {
    const int s = (int)blockIdx.x & 7, nbs = ((int)gridDim.x - s + 7) >> 3;
    const unsigned char* Us = p.U8s() + (size_t)s * 16384 * 128 + c8 * 16;
    const int item0 = ((int)blockIdx.x >> 3) * NWAVE + __builtin_amdgcn_readfirstlane(wv), istep = nbs * NWAVE;
    uint2 ev[16]; uint4 hq0, hq1, hq2, hq3;
#define PEER_U_STAGE_E(T0_) { _Pragma("unroll") for (int k = 0; k < 16; ++k) ev[k] = *(const uint2*)(p.eidx() + (size_t)((T0_) + k) * 128 + lane * 2); }
#define PEER_U_STAGE_H(T0_) { const bf16_t* hsrc = p.hb() + ((size_t)s * T + (T0_)) * 128 + lane * 8;     \
        hq0 = *(const uint4*)(hsrc); hq1 = *(const uint4*)(hsrc + 512); hq2 = *(const uint4*)(hsrc + 1024); hq3 = *(const uint4*)(hsrc + 1536); }
    if (item0 < T / 16) { PEER_U_STAGE_E(item0 * 16) PEER_U_STAGE_H(item0 * 16) }
    for (int item = item0; item < T / 16; item += istep) {
      const int t0 = item * 16, t1 = t0 + istep * 16; const bool more = item + istep < T / 16;
      LDS_FENCE();
      {
#pragma unroll
        for (int k = 0; k < 16; ++k) *(uint2*)(eW + k * 128 + lane * 2) = ev[k];
        *(uint4*)(hW + lane * 8) = hq0; *(uint4*)(hW + 512 + lane * 8) = hq1; *(uint4*)(hW + 1024 + lane * 8) = hq2; *(uint4*)(hW + 1536 + lane * 8) = hq3; }
      LDS_FENCE();
      uint4 R[4][8];
#define PEER_U_LOAD(M_, BUF_) { _Pragma("unroll") for (int eb = 0; eb < 8; ++eb) R[BUF_][eb] = *(const uint4*)(Us + (size_t)eW[(M_) * 64 + eb * 8 + r8] * 128); }
      if (!(PROBE_SKIP & 128)) { PEER_U_LOAD(0, 0) PEER_U_LOAD(1, 1) PEER_U_LOAD(2, 2) } else { _Pragma("unroll") for (int a_ = 0; a_ < 4; ++a_) _Pragma("unroll") for (int b_ = 0; b_ < 8; ++b_) R[a_][b_] = make_uint4(0u, 0u, 0u, 0u); }
      int hq[4]; float hinv = 0.f; float res0 = 0.f, res1 = 0.f;
#define PEER_U_LOADH(TOK_) { const bf16_t* hp = hW + (TOK_) * 128 + c8 * 16; const uint4 a = *(const uint4*)hp, b4 = *(const uint4*)(hp + 8); \
        const unsigned w8[8] = {a.x, a.y, a.z, a.w, b4.x, b4.y, b4.z, b4.w}; float hv[16]; float am = 0.f;                               \
        _Pragma("unroll") for (int z = 0; z < 8; ++z) { hv[2 * z] = __uint_as_float(w8[z] << 16); hv[2 * z + 1] = __uint_as_float(w8[z] & 0xffff0000u); \
          am = fmaxf(am, fmaxf(fabsf(hv[2 * z]), fabsf(hv[2 * z + 1]))); }                                                                \
        am = fmaxf(am, __builtin_bit_cast(float, __builtin_amdgcn_update_dpp(0, __builtin_bit_cast(int, am), 0xB1, 0xF, 0xF, true)));     \
        am = fmaxf(am, __builtin_bit_cast(float, __builtin_amdgcn_update_dpp(0, __builtin_bit_cast(int, am), 0x4E, 0xF, 0xF, true)));     \
        am = fmaxf(am, __builtin_bit_cast(float, __builtin_amdgcn_update_dpp(0, __builtin_bit_cast(int, am), 0x141, 0xF, 0xF, true)));    \
        const float hs = am > 0.f ? 127.0f / am : 1.0f; hinv = am > 0.f ? am * (1.0f / 127.0f) : 1.0f;                                    \
        _Pragma("unroll") for (int z = 0; z < 4; ++z) hq[z] = (__float2int_rn(hv[4 * z] * hs) & 255) | ((__float2int_rn(hv[4 * z + 1] * hs) & 255) << 8) | \
                                                               ((__float2int_rn(hv[4 * z + 2] * hs) & 255) << 16) | (__float2int_rn(hv[4 * z + 3] * hs) << 24); }
      PEER_U_LOADH(0)
#define PEER_U_HALF(M_, BUF_, HALF_)                                                                           \
      {                                                                                                                                   \
        if (!(PROBE_SKIP & 128)) { if ((M_) + 3 < 32) PEER_U_LOAD((M_) + 3, ((BUF_) + 3) & 3) }                                             \
        if ((M_) == 29 && more) PEER_U_STAGE_E(t1)                                                                                          \
        if ((M_) == 30 && more) PEER_U_STAGE_H(t1)                                                                                          \
        if (!(PROBE_SKIP & 128)) _Pragma("unroll") for (int eb = 0; eb < 8; ++eb) {                                                       \
          int di = __builtin_amdgcn_sdot4((int)R[BUF_][eb].x, hq[0], 0, false);                                                           \
          di = __builtin_amdgcn_sdot4((int)R[BUF_][eb].y, hq[1], di, false);                                                              \
          di = __builtin_amdgcn_sdot4((int)R[BUF_][eb].z, hq[2], di, false);                                                              \
          di = __builtin_amdgcn_sdot4((int)R[BUF_][eb].w, hq[3], di, false);                                                              \
          di += __builtin_amdgcn_update_dpp(0, di, 0xB1, 0xF, 0xF, true); di += __builtin_amdgcn_update_dpp(0, di, 0x4E, 0xF, 0xF, true);   \
          di += __builtin_amdgcn_update_dpp(0, di, 0x141, 0xF, 0xF, true);     \
          const float d = (float)di * hinv;                                                                                               \
          if ((HALF_) == 0) { if (c8 == eb) res0 = d; } else { if (c8 == eb) res1 = d; }                                                  \
        }                                                                                                                                 \
        if ((HALF_) == 1) {                                                                                                               \
          bf16_t* po = p.ppart() + ((size_t)s * T + t0 + ((M_) >> 1)) * 128;                                                              \
          po[c8 * 8 + r8] = f2bf(res0); po[64 + c8 * 8 + r8] = f2bf(res1);                                                                \
          if ((M_) + 1 < 32) PEER_U_LOADH(((M_) >> 1) + 1)                                                                                \
        }                                                                                                                                 \
      }
#pragma unroll
      for (int m4 = 0; m4 < 32; m4 += 4) {
        PEER_U_HALF(m4, 0, 0) PEER_U_HALF(m4 + 1, 1, 1) PEER_U_HALF(m4 + 2, 2, 0) PEER_U_HALF(m4 + 3, 3, 1)
      }
#undef PEER_U_HALF
#undef PEER_U_LOADH
#undef PEER_U_LOAD
#undef PEER_U_STAGE_E
#undef PEER_U_STAGE_H
    }
  }
}
__device__ __forceinline__ void phase_peer_r(const Params& p, int gtid, int ngt) {
  for (int g0 = gtid; g0 < T * 128 / 8; g0 += 2 * ngt) {
    uint4 pp[2][8]; uint4 ev[2][2]; float4 gv[2][2]; float su_[2][8], sv_[2][8]; float rs[2]; bool ok[2];
#pragma unroll
    for (int u = 0; u < 2; ++u) { const int g = g0 + u * ngt; ok[u] = g < T * 128 / 8; const size_t ix = ok[u] ? (size_t)g * 8 : 0;
#pragma unroll
      for (int s = 0; s < 8; ++s) pp[u][s] = *(const uint4*)(p.ppart() + (size_t)s * T * 128 + ix);
      ev[u][0] = *(const uint4*)(p.eidx() + ix); ev[u][1] = *(const uint4*)(p.eidx() + ix + 4);
      gv[u][0] = *(const float4*)(p.gates() + ix); gv[u][1] = *(const float4*)(p.gates() + ix + 4);
      rs[u] = p.rstd()[ix >> 7]; }
#pragma unroll
    for (int u = 0; u < 2; ++u) { const int e8[8] = {(int)ev[u][0].x, (int)ev[u][0].y, (int)ev[u][0].z, (int)ev[u][0].w, (int)ev[u][1].x, (int)ev[u][1].y, (int)ev[u][1].z, (int)ev[u][1].w};
#pragma unroll
      for (int k = 0; k < 8; ++k) { su_[u][k] = p.su()[e8[k]]; sv_[u][k] = p.sv()[e8[k]]; } }
#pragma unroll
    for (int u = 0; u < 2; ++u) if (ok[u]) {
      float d[8];
#pragma unroll
      for (int k = 0; k < 8; ++k) d[k] = 0.f;
#pragma unroll
      for (int s = 0; s < 8; ++s) { const unsigned w[4] = {pp[u][s].x, pp[u][s].y, pp[u][s].z, pp[u][s].w};
#pragma unroll
        for (int q = 0; q < 4; ++q) { d[2 * q] += __uint_as_float(w[q] << 16); d[2 * q + 1] += __uint_as_float(w[q] & 0xffff0000u); } }
      const float gg[8] = {gv[u][0].x, gv[u][0].y, gv[u][0].z, gv[u][0].w, gv[u][1].x, gv[u][1].y, gv[u][1].z, gv[u][1].w};
      float o[8];
#pragma unroll
      for (int k = 0; k < 8; ++k) o[k] = gg[k] * gelu_tanh(d[k] * rs[u] / su_[u][k]) / sv_[u][k];
      float* dst = p.gates() + (size_t)(g0 + u * ngt) * 8;
      *(float4*)dst = make_float4(o[0], o[1], o[2], o[3]); *(float4*)(dst + 4) = make_float4(o[4], o[5], o[6], o[7]);
    }
  }
}
__device__ __forceinline__ void phase_peer_v(const Params& p, int* heads, unsigned char* lds, int tid) {
  const int lane = tid & 63, wv = tid >> 6, r8 = lane >> 3, c8 = lane & 7;
  int* bc = (int*)lds;
  uint2* pW = (uint2*)(lds + 1024 + wv * 16384);
  {
    const int s = (int)blockIdx.x & 7, nbs = ((int)gridDim.x - s + 7) >> 3;
    const unsigned char* Vs = p.V8s() + (size_t)s * 16384 * 128 + c8 * 16;
    const int item0 = ((int)blockIdx.x >> 3) * NWAVE + __builtin_amdgcn_readfirstlane(wv), istep = nbs * NWAVE;
    uint2 e2[16], g2[16];
#define PEER_V_STAGE_E(T0_) { _Pragma("unroll") for (int k = 0; k < 16; ++k) e2[k] = *(const uint2*)(p.eidx() + (size_t)((T0_) + k) * 128 + lane * 2); }
#define PEER_V_STAGE_G(T0_) { _Pragma("unroll") for (int k = 0; k < 16; ++k) g2[k] = *(const uint2*)(p.gates() + (size_t)((T0_) + k) * 128 + lane * 2); }
    if (item0 < T / 16) { PEER_V_STAGE_E(item0 * 16) PEER_V_STAGE_G(item0 * 16) }
    for (int item = item0; item < T / 16; item += istep) {
      const int t0 = item * 16, t1 = t0 + istep * 16; const bool more = item + istep < T / 16;
      LDS_FENCE();
      {
#pragma unroll
        for (int k = 0; k < 16; ++k) *(uint4*)(pW + k * 128 + lane * 2) = make_uint4(e2[k].x, g2[k].x, e2[k].y, g2[k].y); }
      LDS_FENCE();
      const int rowk = lane >> 4, prow = ((rowk & 1) << 1) | (rowk >> 1);
      const bool wr_lane = (lane & 8) == 0;
      const int xoff = s * 128 + c8 * 16 + prow * 4;
      float4 xo[8];
#pragma unroll
      for (int k = 0; k < 8; ++k) xo[k] = *(const float4*)(p.outp() + (size_t)(t0 + k) * D + xoff);
      uint4 R[3][8];
#define PEER_V_LOAD(M_, BUF_) { _Pragma("unroll") for (int eb = 0; eb < 8; ++eb) R[BUF_][eb] = *(const uint4*)(Vs + (size_t)pW[(M_) * 64 + eb * 8 + r8].x * 128); }
      if (!(PROBE_SKIP & 64)) { PEER_V_LOAD(0, 0) PEER_V_LOAD(1, 1) } else { _Pragma("unroll") for (int a_ = 0; a_ < 3; ++a_) _Pragma("unroll") for (int b_ = 0; b_ < 8; ++b_) R[a_][b_] = make_uint4(0u, 0u, 0u, 0u); }
      float acc[16];
#define PEER_V_HALF(M_, BUF_, HALF_)                                                           \
      {                                                                                                                                   \
        if (!(PROBE_SKIP & 64)) { if ((M_) + 2 < 32) PEER_V_LOAD((M_) + 2, ((BUF_) + 2) % 3) }                                              \
        if ((M_) == 30 && more) PEER_V_STAGE_E(t1)                                                                                          \
        if ((M_) == 31 && more) PEER_V_STAGE_G(t1)                                                                                          \
        if ((HALF_) == 0) { _Pragma("unroll") for (int z = 0; z < 16; ++z) acc[z] = 0.f; }                                                \
        if (!(PROBE_SKIP & 64)) _Pragma("unroll") for (int eb = 0; eb < 8; ++eb) {                                                        \
          const float c = __uint_as_float(pW[(M_) * 64 + eb * 8 + r8].y);                                                                 \
          const unsigned ww[4] = {R[BUF_][eb].x, R[BUF_][eb].y, R[BUF_][eb].z, R[BUF_][eb].w};                                            \
          _Pragma("unroll") for (int q4 = 0; q4 < 4; ++q4) {                                                                              \
            const auto f01 = __builtin_amdgcn_cvt_pk_f32_fp8((int)ww[q4], false); const auto f23 = __builtin_amdgcn_cvt_pk_f32_fp8((int)ww[q4], true); \
            acc[q4 * 4 + 0] = fmaf(c, f01[0], acc[q4 * 4 + 0]); acc[q4 * 4 + 1] = fmaf(c, f01[1], acc[q4 * 4 + 1]);                       \
            acc[q4 * 4 + 2] = fmaf(c, f23[0], acc[q4 * 4 + 2]); acc[q4 * 4 + 3] = fmaf(c, f23[1], acc[q4 * 4 + 3]);                       \
          }                                                                                                                               \
        }                                                                                                                                 \
        if ((HALF_) == 1) {                                                                                                               \
          _Pragma("unroll") for (int z = 0; z < 16; ++z) acc[z] = DPP_ADD(acc[z], 0x128);                                  \
          asm volatile("v_nop\n\tv_nop\n\tv_permlane16_swap_b32 %0, %8\n\tv_permlane16_swap_b32 %1, %9\n\tv_permlane16_swap_b32 %2, %10\n\tv_permlane16_swap_b32 %3, %11\n\t" \
                       "v_permlane16_swap_b32 %4, %12\n\tv_permlane16_swap_b32 %5, %13\n\tv_permlane16_swap_b32 %6, %14\n\tv_permlane16_swap_b32 %7, %15" \
            : "+v"(acc[0]), "+v"(acc[1]), "+v"(acc[2]), "+v"(acc[3]), "+v"(acc[4]), "+v"(acc[5]), "+v"(acc[6]), "+v"(acc[7]),                   \
              "+v"(acc[8]), "+v"(acc[9]), "+v"(acc[10]), "+v"(acc[11]), "+v"(acc[12]), "+v"(acc[13]), "+v"(acc[14]), "+v"(acc[15]));               \
          _Pragma("unroll") for (int z = 0; z < 8; ++z) acc[z] += acc[z + 8];            \
          asm volatile("v_nop\n\tv_nop\n\tv_permlane32_swap_b32 %0, %4\n\tv_permlane32_swap_b32 %1, %5\n\tv_permlane32_swap_b32 %2, %6\n\tv_permlane32_swap_b32 %3, %7" \
            : "+v"(acc[0]), "+v"(acc[1]), "+v"(acc[2]), "+v"(acc[3]), "+v"(acc[4]), "+v"(acc[5]), "+v"(acc[6]), "+v"(acc[7]));                   \
          float4 dl;                                                                                                                      \
          dl.x = acc[0] + acc[4]; dl.y = acc[1] + acc[5]; dl.z = acc[2] + acc[6]; dl.w = acc[3] + acc[7];     \
          const float4 xv = xo[((M_) >> 1) & 7];                                                                                          \
          if (((M_) >> 1) + 8 < 16) xo[((M_) >> 1) & 7] = *(const float4*)(p.outp() + (size_t)(t0 + ((M_) >> 1) + 8) * D + xoff);                  \
          const float4 xn = make_float4(xv.x + dl.x, xv.y + dl.y, xv.z + dl.z, xv.w + dl.w);                                              \
          float sq = 0.f;                                                                                                                 \
          if (wr_lane) {                                                                                                                  \
            *(float4*)(p.outp() + (size_t)(t0 + ((M_) >> 1)) * D + xoff) = xn;                                                             \
            *(uint2*)(p.xb() + (size_t)(t0 + ((M_) >> 1)) * KD + xoff) = make_uint2(pk_bf16(xn.x, xn.y), pk_bf16(xn.z, xn.w));     \
            sq = (xn.x * xn.x + xn.y * xn.y) + (xn.z * xn.z + xn.w * xn.w);                                                                \
          }                                                                                                                               \
          sq = DPP_ADD(sq, 0xB1); sq = DPP_ADD(sq, 0x4E); sq = DPP_ADD(sq, 0x141); sq = DPP_ADD(sq, 0x128); sq = sum_xor16(sq); sq = sum_xor32(sq);     \
          if (lane == 0) p.ssq1()[(size_t)(t0 + ((M_) >> 1)) * 8 + s] = sq;                                                               \
        }                                                                                                                                 \
      }
#pragma unroll
      for (int m6 = 0; m6 < 30; m6 += 6) {
        PEER_V_HALF(m6, 0, 0) PEER_V_HALF(m6 + 1, 1, 1) PEER_V_HALF(m6 + 2, 2, 0) PEER_V_HALF(m6 + 3, 0, 1) PEER_V_HALF(m6 + 4, 1, 0) PEER_V_HALF(m6 + 5, 2, 1)
      }
      PEER_V_HALF(30, 0, 0) PEER_V_HALF(31, 1, 1)
#undef PEER_V_HALF
#undef PEER_V_LOAD
#undef PEER_V_STAGE_E
#undef PEER_V_STAGE_G
    }
  }
}

#if PEER_CHECK
constexpr int CHK_N = 512;
__device__ __forceinline__ float* chk_x(const Params& p) { return (float*)(p.ws + WO_ybuf); }
__device__ __forceinline__ float* chk_m(const Params& p) { return (float*)(p.ws + WO_ybuf + (size_t)CHK_N * D * 4); }
__device__ __forceinline__ float* chk_g(const Params& p) { return (float*)(p.ws + WO_ybuf + (size_t)CHK_N * D * 4 + 4096); }
__device__ __forceinline__ void chk_save(const Params& p, int gtid, int ngt) {
  for (int i = gtid; i < CHK_N * D; i += ngt) chk_x(p)[i] = p.outp()[(size_t)(i / D) * 64 * D + (i % D)];
  for (int i = gtid; i < CHK_N * 128; i += ngt) chk_g(p)[i] = p.gates()[(size_t)(i / 128) * 64 * 128 + (i % 128)];
  if (gtid < 16) chk_m(p)[gtid] = 0.f;
}
__device__ __forceinline__ void chk_apply(const Params& p, int l, float* coef, int gw, int ngw, int lane) {
  const float* g2 = p.inp(16) + l * D;
  const float* U = p.inp(19) + (size_t)l * 16384 * D; const float* V = p.inp(20) + (size_t)l * 16384 * D;
  for (int i = gw; i < CHK_N; i += ngw) {
    const int t = i * 64;
    const float r = p.rstd()[t];
    float4 hv[4];
#pragma unroll
    for (int k = 0; k < 4; ++k) {
      float4 xv = *(const float4*)(chk_x(p) + (size_t)i * D + (lane + k * 64) * 4);
      float4 gv = *(const float4*)(g2 + (lane + k * 64) * 4);
      hv[k].x = xv.x * r * gv.x; hv[k].y = xv.y * r * gv.y; hv[k].z = xv.z * r * gv.z; hv[k].w = xv.w * r * gv.w;
    }
    LDS_FENCE();
    for (int j = 0; j < 128; ++j) {
      const int e = p.eidx()[(size_t)t * 128 + j];
      const float4* up = (const float4*)(U + (size_t)e * D);
      float dsum = 0.f;
#pragma unroll
      for (int k = 0; k < 4; ++k) { float4 uv = up[lane + k * 64]; dsum += hv[k].x * uv.x + hv[k].y * uv.y + hv[k].z * uv.z + hv[k].w * uv.w; }
      dsum = wave_sum(dsum);
      if (lane == 0) coef[j] = chk_g(p)[(size_t)i * 128 + j] * gelu_tanh(dsum);
    }
    LDS_FENCE();
    float4 acc[4];
#pragma unroll
    for (int k = 0; k < 4; ++k) acc[k] = make_float4(0.f, 0.f, 0.f, 0.f);
    for (int j = 0; j < 128; ++j) {
      const int e = p.eidx()[(size_t)t * 128 + j];
      const float c = coef[j];
      const float4* vp = (const float4*)(V + (size_t)e * D);
#pragma unroll
      for (int k = 0; k < 4; ++k) { float4 vv = vp[lane + k * 64]; acc[k].x = fmaf(c, vv.x, acc[k].x); acc[k].y = fmaf(c, vv.y, acc[k].y); acc[k].z = fmaf(c, vv.z, acc[k].z); acc[k].w = fmaf(c, vv.w, acc[k].w); }
    }
    float d2 = 0.f, r2 = 0.f;
#pragma unroll
    for (int k = 0; k < 4; ++k) {
      float4 xa = *(const float4*)(p.outp() + (size_t)t * D + (lane + k * 64) * 4);
      float4 xb4 = *(const float4*)(chk_x(p) + (size_t)i * D + (lane + k * 64) * 4);
      float e0 = (xa.x - xb4.x) - acc[k].x, e1 = (xa.y - xb4.y) - acc[k].y, e2 = (xa.z - xb4.z) - acc[k].z, e3 = (xa.w - xb4.w) - acc[k].w;
      d2 += e0 * e0 + e1 * e1 + e2 * e2 + e3 * e3;
      r2 += acc[k].x * acc[k].x + acc[k].y * acc[k].y + acc[k].z * acc[k].z + acc[k].w * acc[k].w;
    }
    d2 = wave_sum(d2); r2 = wave_sum(r2);
    if (lane == 0) { atomicAdd((unsigned long long*)&chk_m(p)[8], (unsigned long long)(d2 * 1099511627776.0f)); atomicAdd((unsigned long long*)&chk_m(p)[10], (unsigned long long)(r2 * 1099511627776.0f)); }
  }
}
__device__ __forceinline__ void chk_topk(const Params& p, int l, int gtid, int ngt) {
  const float* subk = p.inp(18) + (size_t)l * 16 * 128 * 64;
  for (int it = gtid; it < CHK_N * 8; it += ngt) {
    const int i = it >> 3, h = it & 7, t = i * 64;
    float tva[16], tvb[16]; int tia[16], tib[16];
#pragma unroll 1
    for (int c = 0; c < 2; ++c) {
      float tv[16]; int ti[16];
#pragma unroll
      for (int z = 0; z < 16; ++z) { tv[z] = -INFINITY; ti[z] = 0; }
      const bf16_t* q = p.qb() + (size_t)t * D + (2 * h + c) * 64;
      const float* kb = subk + (size_t)(2 * h + c) * 128 * 64;
#pragma unroll 1
      for (int n = 0; n < 128; ++n) {
        float sc = 0.f;
        for (int d = 0; d < 64; ++d) sc = fmaf(bf2f(q[d]), kb[n * 64 + d], sc);
        float v_ = sc; int i_ = n;
#pragma unroll
        for (int z = 0; z < 16; ++z) { bool gt = v_ > tv[z]; float a = tv[z]; int b = ti[z]; tv[z] = gt ? v_ : a; ti[z] = gt ? i_ : b; v_ = gt ? a : v_; i_ = gt ? b : i_; }
      }
#pragma unroll
      for (int z = 0; z < 16; ++z) { if (c == 0) { tva[z] = tv[z]; tia[z] = ti[z]; } else { tvb[z] = tv[z]; tib[z] = ti[z]; } }
    }
    float tv[16]; int ti[16];
#pragma unroll
    for (int z = 0; z < 16; ++z) { tv[z] = -INFINITY; ti[z] = 0; }
#pragma unroll 1
    for (int a = 0; a < 16; ++a)
#pragma unroll 1
      for (int b = 0; b < 16; ++b) {
        float av = 0.f, bv = 0.f; int ai = 0, bi = 0;
#pragma unroll
        for (int z = 0; z < 16; ++z) { if (z == a) { av = tva[z]; ai = tia[z]; } if (z == b) { bv = tvb[z]; bi = tib[z]; } }
        float v_ = av + bv; int i_ = ai * 128 + bi;
#pragma unroll
        for (int z = 0; z < 16; ++z) { bool gt = v_ > tv[z]; float x = tv[z]; int y = ti[z]; tv[z] = gt ? v_ : x; ti[z] = gt ? i_ : y; v_ = gt ? x : v_; i_ = gt ? y : i_; }
      }
    float sum = 0.f, ev[16];
#pragma unroll
    for (int z = 0; z < 16; ++z) { ev[z] = expf(tv[z] - tv[0]); sum += ev[z]; }
    int miss = 0; float gerr = 0.f;
    for (int z = 0; z < 16; ++z) {
      const int ef = p.eidx()[((size_t)t * 8 + h) * 16 + z]; const float gf = p.gates()[((size_t)t * 8 + h) * 16 + z];
      bool found = false;
#pragma unroll
      for (int y = 0; y < 16; ++y) if (ti[y] == ef) { found = true; gerr = fmaxf(gerr, fabsf(ev[y] / sum - gf)); }
      if (!found) ++miss;
    }
    atomicAdd(&chk_m(p)[3], (float)miss);
    atomicMax((int*)&chk_m(p)[4], __float_as_int(gerr));
  }
}
__device__ __forceinline__ void chk_emit(const Params& p) {
  float v = 0.f;
  if (PEER_CHECK == 1) v = sqrtf((float)((double)*(unsigned long long*)&chk_m(p)[8] / (double)*(unsigned long long*)&chk_m(p)[10]));
  if (PEER_CHECK == 2) v = chk_m(p)[3] / (float)(CHK_N * 8 * 16);
  if (PEER_CHECK == 3) v = chk_m(p)[4];
  p.outp()[0] += 1.0e4f * v + 100.0f;
}
#endif

#define XB_TMO      128
#define XB_XCNT(j)  (256  + 64 * (j))
#define XB_XSUB(j)  (1280 + 64 * (j))
#define XB_XGEN(j)  (2304 + 64 * (j))
#define XB_TOP      3328
#define XB_TOPGEN   3392
#define XCD_BAR_WORDS 3456
#define XB_SPIN_CAP (1u << 18)
#define LAS __attribute__((address_space(3)))

__device__ __forceinline__ unsigned xb_ld(unsigned* p)              { return __hip_atomic_load(p, __ATOMIC_RELAXED, __HIP_MEMORY_SCOPE_AGENT); }
__device__ __forceinline__ unsigned xb_add(unsigned* p, unsigned v) { return __hip_atomic_fetch_add(p, v, __ATOMIC_RELAXED, __HIP_MEMORY_SCOPE_AGENT); }
__device__ __forceinline__ unsigned xb_xcc_id() { return (unsigned)__builtin_amdgcn_s_getreg((3 << 11) | 20) & 0xFu; }
#define XB_SPIN(cond, bar) do { unsigned _sp = 0; while (cond) { __builtin_amdgcn_s_sleep(1); \
    if ((++_sp & 255u) == 0u) { if (xb_ld(&(bar)[XB_TMO])) break; if (_sp > XB_SPIN_CAP) { atomicAdd(&(bar)[XB_TMO], 1u); break; } } } } while (0)

struct XcdBarrier {
    unsigned* bar; unsigned x;
    volatile LAS unsigned* st;
};

__device__ __forceinline__ XcdBarrier xcd_barrier_post(unsigned* bar, volatile LAS unsigned* st) {
    XcdBarrier b; b.bar = bar; b.x = xb_xcc_id(); b.st = st;
    if (threadIdx.x == 0) (void)xb_add(&bar[XB_XCNT(b.x)], 1u);
    return b;
}
__device__ __forceinline__ void xcd_barrier_complete(unsigned* bar, unsigned x, unsigned& nloc, unsigned& nx) {
    const unsigned G = gridDim.x * gridDim.y * gridDim.z;
    unsigned sum, cnt, mine, sp = 0u;
    for (;;) {
        sum = 0u; cnt = 0u; mine = 0u;
#pragma unroll
        for (unsigned j = 0; j < 16; ++j) { const unsigned c = xb_ld(&bar[XB_XCNT(j)]); sum += c; cnt += (c > 0u) ? 1u : 0u; mine = (j == x) ? c : mine; }
        if (sum == G) break;
        __builtin_amdgcn_s_sleep(1);
        if ((++sp & 255u) == 0u) { if (xb_ld(&bar[XB_TMO])) break; if (sp > XB_SPIN_CAP) { atomicAdd(&bar[XB_TMO], 1u); break; } }
    }
    nloc = mine > 0u ? mine : 1u; nx = cnt > 0u ? cnt : 1u;
}

__device__ __forceinline__ void xcd_barrier(const XcdBarrier& b) {
    asm volatile("s_waitcnt vmcnt(0)" ::: "memory");
    __syncthreads();
    if (threadIdx.x == 0) {
        unsigned* bar = b.bar;
        __builtin_amdgcn_s_waitcnt(0);
        unsigned nloc = b.st[0], nx = b.st[1];
        if (nloc == 0u) { xcd_barrier_complete(bar, b.x, nloc, nx); b.st[0] = nloc; b.st[1] = nx; }
        const unsigned old = xb_add(&bar[XB_XSUB(b.x)], 1u);
        const unsigned gen = old / nloc;
        if (old + 1u == (gen + 1u) * nloc) {
            __builtin_amdgcn_fence(__ATOMIC_RELEASE, "agent");
            asm volatile("s_waitcnt vmcnt(0)" ::: "memory");
            const unsigned og = xb_add(&bar[XB_TOP], 1u);
            const unsigned tg = og / nx;
            if (og + 1u == (tg + 1u) * nx) xb_add(&bar[XB_TOPGEN], 1u);
            else XB_SPIN(xb_ld(&bar[XB_TOPGEN]) == tg, bar);
            __builtin_amdgcn_fence(__ATOMIC_ACQUIRE, "agent");
            xb_add(&bar[XB_XGEN(b.x)], 1u);
            asm volatile("s_waitcnt vmcnt(0)" ::: "memory");
        } else {
            XB_SPIN(xb_ld(&bar[XB_XGEN(b.x)]) == gen, bar);
            __builtin_amdgcn_fence(__ATOMIC_ACQUIRE, "agent");
            asm volatile("s_waitcnt vmcnt(0)" ::: "memory");
        }
    }
    __syncthreads();
}

__device__ __forceinline__ Params fresh(const Params& p) {
  Params q = p;
  asm volatile("" : "+s"(q.ws), "+s"(q.out_));
#pragma unroll
  for (int i = 0; i < 21; ++i) asm volatile("" : "+s"(q.in[i]));
  return q;
}
#define PHASE_IDS int tid = threadIdx.x; asm volatile("" : "+v"(tid)); int bid = blockIdx.x; asm volatile("" : "+s"(bid)); int G = gridDim.x; asm volatile("" : "+s"(G)); \
  const int lane = tid & 63, wv = tid >> 6; const int ngt = G * NTHR, ngw = G * NWAVE; \
  const int gtid = bid * NTHR + tid, gw = bid * NWAVE + wv; (void)lane; (void)wv; (void)gtid; (void)gw; (void)ngt; (void)ngw; \
  const Params q = fresh(p);
__global__ void __launch_bounds__(NTHR) mega(Params p) {
  extern __shared__ __attribute__((aligned(16))) unsigned char lds_raw[];
  cg::grid_group grid = cg::this_grid();
  float* ldsf = (float*)lds_raw;
  if (threadIdx.x == 0) { *(uint4*)(lds_raw + LDS_BYTES - 16) = make_uint4(0u, 0u, 0u, 0u); }
  __syncthreads();
  XcdBarrier xb = xcd_barrier_post(p.bar(), (volatile LAS unsigned*)(lds_raw + LDS_BYTES - 16));

  { PHASE_IDS; phase_prologue(q, gtid, ngt, gw, ngw, lane); cvt_f32_bf16(q.inp(18), q.skb(), (size_t)NL * 16 * 128 * 64 / 8, gtid, ngt);
    for (size_t i = gtid; i < (size_t)16 * 128 * 512 / 8; i += ngt) { const size_t g = i / (128 * 512 / 8), r = i % (128 * 512 / 8); ((uint4*)q.S5Wz())[g * (256 * 512 / 8) + (128 * 512 / 8) + r] = make_uint4(0u, 0u, 0u, 0u); }
    if (gtid < 256) q.qctr()[gtid] = 0;
    phase_s5_prep(q, 0, gtid, ngt); }
  grid.sync();
  { constexpr int l = 0;
    DUP(5) {
    { const Params q = fresh(p);
      EpiInProj e{q.ssq1(), q.S5A(), q.Qm(), q.Km(), q.vrow(), q.Qr(), q.Kr(), q.krow(), q.vrrow(), q.grow(),
                  q.inp(12) + l * 64, q.inp(13) + l * 64, q.cosm(), q.sinm(), q.cosr(), q.sinr()};
      run_gemm(lds_raw, q.xb(), q.Win_t() + (size_t)l * INW * KD, T, INW, KD, e); }
    { PHASE_IDS;
      const int ntile = (T / 256) * (INW / 256), nlast = ntile - ((ntile + G - 1) / G - 1) * G;
      if (2 * nlast <= G && bid >= nlast) cvt_table_i8(q.inp(19) + (size_t)l * 16384 * D, q.U8s(), q.su(), gw - nlast * NWAVE, ngw - nlast * NWAVE, lane); }
    xcd_barrier(xb);
    }
    DUP(1) {
    { PHASE_IDS; const bool split = G >= 128; const int g2 = split ? gtid - 64 * NTHR : gtid, n2 = split ? ngt - 64 * NTHR : ngt;
      if (!split || bid >= 64) { phase_post_pack(q, g2, n2); phase_kmean2(q, g2, n2); } }
    { const Params q = fresh(p); EpiS5Z e{q.S5Z()};
      pg8::Gemm g{q.S5A(), q.S5Wz(), 16 * 1024, 16 * 256, 512, 640, 512}; pg8::GroupOrder So; So.init(16, 4, 1, (int)gridDim.x, (int)blockIdx.x);
      pg8::gemm_phase<EpiS5Z, pg8::GroupOrder, true, true>((PG8_LAS unsigned char*)lds_raw, g, So, e); }
    xcd_barrier(xb);
    }
    DUP(2) {
    { PHASE_IDS; phase_s5_scan(q, gtid, ngt); phase_ret_kv(q, gw, ngw, lane); }
    __syncthreads();
    { PHASE_IDS; phase_moba2(q, l, lds_raw, q.qctr() + 64 + l); }
    xcd_barrier(xb);
    }
    DUP(3) {
    { const Params q = fresh(p); EpiS5Y e{q.ygb(), q.S5A(), q.inp(10) + l * 256};
      pg8::Gemm g{q.S5A(), q.S5Wy(), 16 * 1024, 16 * 512, 640, 640, 640}; pg8::GroupOrder So; So.init(16, 4, 2, (int)gridDim.x, (int)blockIdx.x);
      pg8::gemm_phase<EpiS5Y, pg8::GroupOrder, true, true>((PG8_LAS unsigned char*)lds_raw, g, So, e); }
    { PHASE_IDS; phase_ret_scan(q, gtid, ngt);
      if (G >= 256 && bid >= 128) cvt_table_fp8(q.inp(20) + (size_t)l * 16384 * D, q.V8s(), q.sv(), gw - 128 * NWAVE, ngw - 128 * NWAVE, lane); }
    xcd_barrier(xb);
    }
    DUP(4) {
    { const Params q = fresh(p); EpiGlu e{q.xb(), q.ygb(), (float*)(lds_raw + 131072)};
      run_gemm(lds_raw, q.ygb(), q.Wglu_t() + (size_t)l * 65536, T, 256, 256, e); }
    { PHASE_IDS; phase_ret_out(q, gw, ngw, lane); }
    xcd_barrier(xb);
    }
    { PHASE_IDS; const int ntile = (T / 256) * (INW / 256), nlast = ntile - ((ntile + G - 1) / G - 1) * G;
      if (!(2 * nlast <= G)) cvt_table_i8(q.inp(19) + (size_t)l * 16384 * D, q.U8s(), q.su(), gw, ngw, lane);
      if (!(G >= 256)) cvt_table_fp8(q.inp(20) + (size_t)l * 16384 * D, q.V8s(), q.sv(), gw, ngw, lane); }
    __syncthreads();
    { const Params q = fresh(p); EpiResid e{q.outp(), D, q.xb2(), q.hb(), q.inp(16) + l * D, q.ssq2(), l == 0 ? q.inp(0) : (const float*)q.outp()};
      run_gemm(lds_raw, q.xb(), q.Wout_t() + (size_t)l * D * KD, T, D, KD, e); }
    xcd_barrier(xb);
    DUP(7) {
    { const Params q = fresh(p); EpiScaleStoreBf16 e{q.qb(), D, q.ssq2(), 16, q.rstd()};
      run_gemm(lds_raw, q.xb2(), q.Wq_t() + (size_t)l * D * KD, T, D, KD, e); }
    xcd_barrier(xb);
    }
    if (!(PROBE_SKIP & 2)) {
    DUP(8) {
    { PHASE_IDS; phase_peer_topk(q, l, gw, ngw, lane); }
    xcd_barrier(xb);
    }
    }
#if PEER_CHECK
    if (l == 0) { { PHASE_IDS; chk_save(q, gtid, ngt); } xcd_barrier(xb); { PHASE_IDS; chk_topk(q, l, gtid, ngt); } xcd_barrier(xb); }
#endif
    if (!(PROBE_SKIP & 1)) {
    { PHASE_IDS; phase_peer_u(q, q.qctr() + (l * 2 + 0) * 8, lds_raw, tid); }
    xcd_barrier(xb);
    { PHASE_IDS; phase_peer_r(q, gtid, ngt); if (l + 1 < NL) phase_s5_prep(q, l + 1, gtid, ngt); }
    xcd_barrier(xb);
    if (!(PROBE_SKIP & 32)) {
    { PHASE_IDS; phase_peer_v(q, q.qctr() + (l * 2 + 1) * 8, lds_raw, tid); }
    xcd_barrier(xb);
    }
    }
#if PEER_CHECK
    if (l == 0) { { PHASE_IDS; chk_apply(q, l, ldsf + wv * 128, gw, ngw, lane); } xcd_barrier(xb);
      if (blockIdx.x == 0 && threadIdx.x == 0) { const Params q = fresh(p); chk_emit(q); } xcd_barrier(xb); }
#endif
  }
  { constexpr int l = 1;
    DUP(5) {
    { const Params q = fresh(p);
      EpiInProj e{q.ssq1(), q.S5A(), q.Qm(), q.Km(), q.vrow(), q.Qr(), q.Kr(), q.krow(), q.vrrow(), q.grow(),
                  q.inp(12) + l * 64, q.inp(13) + l * 64, q.cosm(), q.sinm(), q.cosr(), q.sinr()};
      run_gemm(lds_raw, q.xb(), q.Win_t() + (size_t)l * INW * KD, T, INW, KD, e); }
    { PHASE_IDS;
      const int ntile = (T / 256) * (INW / 256), nlast = ntile - ((ntile + G - 1) / G - 1) * G;
      if (2 * nlast <= G && bid >= nlast) cvt_table_i8(q.inp(19) + (size_t)l * 16384 * D, q.U8s(), q.su(), gw - nlast * NWAVE, ngw - nlast * NWAVE, lane); }
    xcd_barrier(xb);
    }
    DUP(1) {
    { PHASE_IDS; const bool split = G >= 128; const int g2 = split ? gtid - 64 * NTHR : gtid, n2 = split ? ngt - 64 * NTHR : ngt;
      if (!split || bid >= 64) { phase_post_pack(q, g2, n2); phase_kmean2(q, g2, n2); } }
    { const Params q = fresh(p); EpiS5Z e{q.S5Z()};
      pg8::Gemm g{q.S5A(), q.S5Wz(), 16 * 1024, 16 * 256, 512, 640, 512}; pg8::GroupOrder So; So.init(16, 4, 1, (int)gridDim.x, (int)blockIdx.x);
      pg8::gemm_phase<EpiS5Z, pg8::GroupOrder, true, true>((PG8_LAS unsigned char*)lds_raw, g, So, e); }
    xcd_barrier(xb);
    }
    DUP(2) {
    { PHASE_IDS; phase_s5_scan(q, gtid, ngt); phase_ret_kv(q, gw, ngw, lane); }
    __syncthreads();
    { PHASE_IDS; phase_moba2(q, l, lds_raw, q.qctr() + 64 + l); }
    xcd_barrier(xb);
    }
    DUP(3) {
    { const Params q = fresh(p); EpiS5Y e{q.ygb(), q.S5A(), q.inp(10) + l * 256};
      pg8::Gemm g{q.S5A(), q.S5Wy(), 16 * 1024, 16 * 512, 640, 640, 640}; pg8::GroupOrder So; So.init(16, 4, 2, (int)gridDim.x, (int)blockIdx.x);
      pg8::gemm_phase<EpiS5Y, pg8::GroupOrder, true, true>((PG8_LAS unsigned char*)lds_raw, g, So, e); }
    { PHASE_IDS; phase_ret_scan(q, gtid, ngt);
      if (G >= 256 && bid >= 128) cvt_table_fp8(q.inp(20) + (size_t)l * 16384 * D, q.V8s(), q.sv(), gw - 128 * NWAVE, ngw - 128 * NWAVE, lane); }
    xcd_barrier(xb);
    }
    DUP(4) {
    { const Params q = fresh(p); EpiGlu e{q.xb(), q.ygb(), (float*)(lds_raw + 131072)};
      run_gemm(lds_raw, q.ygb(), q.Wglu_t() + (size_t)l * 65536, T, 256, 256, e); }
    { PHASE_IDS; phase_ret_out(q, gw, ngw, lane); }
    xcd_barrier(xb);
    }
    { PHASE_IDS; const int ntile = (T / 256) * (INW / 256), nlast = ntile - ((ntile + G - 1) / G - 1) * G;
      if (!(2 * nlast <= G)) cvt_table_i8(q.inp(19) + (size_t)l * 16384 * D, q.U8s(), q.su(), gw, ngw, lane);
      if (!(G >= 256)) cvt_table_fp8(q.inp(20) + (size_t)l * 16384 * D, q.V8s(), q.sv(), gw, ngw, lane); }
    __syncthreads();
    { const Params q = fresh(p); EpiResid e{q.outp(), D, q.xb2(), q.hb(), q.inp(16) + l * D, q.ssq2(), l == 0 ? q.inp(0) : (const float*)q.outp()};
      run_gemm(lds_raw, q.xb(), q.Wout_t() + (size_t)l * D * KD, T, D, KD, e); }
    xcd_barrier(xb);
    DUP(7) {
    { const Params q = fresh(p); EpiScaleStoreBf16 e{q.qb(), D, q.ssq2(), 16, q.rstd()};
      run_gemm(lds_raw, q.xb2(), q.Wq_t() + (size_t)l * D * KD, T, D, KD, e); }
    xcd_barrier(xb);
    }
    if (!(PROBE_SKIP & 2)) {
    DUP(8) {
    { PHASE_IDS; phase_peer_topk(q, l, gw, ngw, lane); }
    xcd_barrier(xb);
    }
    }
#if PEER_CHECK
    if (l == 0) { { PHASE_IDS; chk_save(q, gtid, ngt); } xcd_barrier(xb); { PHASE_IDS; chk_topk(q, l, gtid, ngt); } xcd_barrier(xb); }
#endif
    if (!(PROBE_SKIP & 1)) {
    { PHASE_IDS; phase_peer_u(q, q.qctr() + (l * 2 + 0) * 8, lds_raw, tid); }
    xcd_barrier(xb);
    { PHASE_IDS; phase_peer_r(q, gtid, ngt); if (l + 1 < NL) phase_s5_prep(q, l + 1, gtid, ngt); }
    xcd_barrier(xb);
    if (!(PROBE_SKIP & 32)) {
    { PHASE_IDS; phase_peer_v(q, q.qctr() + (l * 2 + 1) * 8, lds_raw, tid); }
    xcd_barrier(xb);
    }
    }
#if PEER_CHECK
    if (l == 0) { { PHASE_IDS; chk_apply(q, l, ldsf + wv * 128, gw, ngw, lane); } xcd_barrier(xb);
      if (blockIdx.x == 0 && threadIdx.x == 0) { const Params q = fresh(p); chk_emit(q); } xcd_barrier(xb); }
#endif
  }
  { constexpr int l = 2;
    DUP(5) {
    { const Params q = fresh(p);
      EpiInProj e{q.ssq1(), q.S5A(), q.Qm(), q.Km(), q.vrow(), q.Qr(), q.Kr(), q.krow(), q.vrrow(), q.grow(),
                  q.inp(12) + l * 64, q.inp(13) + l * 64, q.cosm(), q.sinm(), q.cosr(), q.sinr()};
      run_gemm(lds_raw, q.xb(), q.Win_t() + (size_t)l * INW * KD, T, INW, KD, e); }
    { PHASE_IDS;
      const int ntile = (T / 256) * (INW / 256), nlast = ntile - ((ntile + G - 1) / G - 1) * G;
      if (2 * nlast <= G && bid >= nlast) cvt_table_i8(q.inp(19) + (size_t)l * 16384 * D, q.U8s(), q.su(), gw - nlast * NWAVE, ngw - nlast * NWAVE, lane); }
    xcd_barrier(xb);
    }
    DUP(1) {
    { PHASE_IDS; const bool split = G >= 128; const int g2 = split ? gtid - 64 * NTHR : gtid, n2 = split ? ngt - 64 * NTHR : ngt;
      if (!split || bid >= 64) { phase_post_pack(q, g2, n2); phase_kmean2(q, g2, n2); } }
    { const Params q = fresh(p); EpiS5Z e{q.S5Z()};
      pg8::Gemm g{q.S5A(), q.S5Wz(), 16 * 1024, 16 * 256, 512, 640, 512}; pg8::GroupOrder So; So.init(16, 4, 1, (int)gridDim.x, (int)blockIdx.x);
      pg8::gemm_phase<EpiS5Z, pg8::GroupOrder, true, true>((PG8_LAS unsigned char*)lds_raw, g, So, e); }
    xcd_barrier(xb);
    }
    DUP(2) {
    { PHASE_IDS; phase_s5_scan(q, gtid, ngt); phase_ret_kv(q, gw, ngw, lane); }
    __syncthreads();
    { PHASE_IDS; phase_moba2(q, l, lds_raw, q.qctr() + 64 + l); }
    xcd_barrier(xb);
    }
    DUP(3) {
    { const Params q = fresh(p); EpiS5Y e{q.ygb(), q.S5A(), q.inp(10) + l * 256};
      pg8::Gemm g{q.S5A(), q.S5Wy(), 16 * 1024, 16 * 512, 640, 640, 640}; pg8::GroupOrder So; So.init(16, 4, 2, (int)gridDim.x, (int)blockIdx.x);
      pg8::gemm_phase<EpiS5Y, pg8::GroupOrder, true, true>((PG8_LAS unsigned char*)lds_raw, g, So, e); }
    { PHASE_IDS; phase_ret_scan(q, gtid, ngt);
      if (G >= 256 && bid >= 128) cvt_table_fp8(q.inp(20) + (size_t)l * 16384 * D, q.V8s(), q.sv(), gw - 128 * NWAVE, ngw - 128 * NWAVE, lane); }
    xcd_barrier(xb);
    }
    DUP(4) {
    { const Params q = fresh(p); EpiGlu e{q.xb(), q.ygb(), (float*)(lds_raw + 131072)};
      run_gemm(lds_raw, q.ygb(), q.Wglu_t() + (size_t)l * 65536, T, 256, 256, e); }
    { PHASE_IDS; phase_ret_out(q, gw, ngw, lane); }
    xcd_barrier(xb);
    }
    { PHASE_IDS; const int ntile = (T / 256) * (INW / 256), nlast = ntile - ((ntile + G - 1) / G - 1) * G;
      if (!(2 * nlast <= G)) cvt_table_i8(q.inp(19) + (size_t)l * 16384 * D, q.U8s(), q.su(), gw, ngw, lane);
      if (!(G >= 256)) cvt_table_fp8(q.inp(20) + (size_t)l * 16384 * D, q.V8s(), q.sv(), gw, ngw, lane); }
    __syncthreads();
    { const Params q = fresh(p); EpiResid e{q.outp(), D, q.xb2(), q.hb(), q.inp(16) + l * D, q.ssq2(), l == 0 ? q.inp(0) : (const float*)q.outp()};
      run_gemm(lds_raw, q.xb(), q.Wout_t() + (size_t)l * D * KD, T, D, KD, e); }
    xcd_barrier(xb);
    DUP(7) {
    { const Params q = fresh(p); EpiScaleStoreBf16 e{q.qb(), D, q.ssq2(), 16, q.rstd()};
      run_gemm(lds_raw, q.xb2(), q.Wq_t() + (size_t)l * D * KD, T, D, KD, e); }
    xcd_barrier(xb);
    }
    if (!(PROBE_SKIP & 2)) {
    DUP(8) {
    { PHASE_IDS; phase_peer_topk(q, l, gw, ngw, lane); }
    xcd_barrier(xb);
    }
    }
#if PEER_CHECK
    if (l == 0) { { PHASE_IDS; chk_save(q, gtid, ngt); } xcd_barrier(xb); { PHASE_IDS; chk_topk(q, l, gtid, ngt); } xcd_barrier(xb); }
#endif
    if (!(PROBE_SKIP & 1)) {
    { PHASE_IDS; phase_peer_u(q, q.qctr() + (l * 2 + 0) * 8, lds_raw, tid); }
    xcd_barrier(xb);
    { PHASE_IDS; phase_peer_r(q, gtid, ngt); if (l + 1 < NL) phase_s5_prep(q, l + 1, gtid, ngt); }
    xcd_barrier(xb);
    if (!(PROBE_SKIP & 32)) {
    { PHASE_IDS; phase_peer_v(q, q.qctr() + (l * 2 + 1) * 8, lds_raw, tid); }
    xcd_barrier(xb);
    }
    }
#if PEER_CHECK
    if (l == 0) { { PHASE_IDS; chk_apply(q, l, ldsf + wv * 128, gw, ngw, lane); } xcd_barrier(xb);
      if (blockIdx.x == 0 && threadIdx.x == 0) { const Params q = fresh(p); chk_emit(q); } xcd_barrier(xb); }
#endif
  }
  { constexpr int l = 3;
    DUP(5) {
    { const Params q = fresh(p);
      EpiInProj e{q.ssq1(), q.S5A(), q.Qm(), q.Km(), q.vrow(), q.Qr(), q.Kr(), q.krow(), q.vrrow(), q.grow(),
                  q.inp(12) + l * 64, q.inp(13) + l * 64, q.cosm(), q.sinm(), q.cosr(), q.sinr()};
      run_gemm(lds_raw, q.xb(), q.Win_t() + (size_t)l * INW * KD, T, INW, KD, e); }
    { PHASE_IDS;
      const int ntile = (T / 256) * (INW / 256), nlast = ntile - ((ntile + G - 1) / G - 1) * G;
      if (2 * nlast <= G && bid >= nlast) cvt_table_i8(q.inp(19) + (size_t)l * 16384 * D, q.U8s(), q.su(), gw - nlast * NWAVE, ngw - nlast * NWAVE, lane); }
    xcd_barrier(xb);
    }
    DUP(1) {
    { PHASE_IDS; const bool split = G >= 128; const int g2 = split ? gtid - 64 * NTHR : gtid, n2 = split ? ngt - 64 * NTHR : ngt;
      if (!split || bid >= 64) { phase_post_pack(q, g2, n2); phase_kmean2(q, g2, n2); } }
    { const Params q = fresh(p); EpiS5Z e{q.S5Z()};
      pg8::Gemm g{q.S5A(), q.S5Wz(), 16 * 1024, 16 * 256, 512, 640, 512}; pg8::GroupOrder So; So.init(16, 4, 1, (int)gridDim.x, (int)blockIdx.x);
      pg8::gemm_phase<EpiS5Z, pg8::GroupOrder, true, true>((PG8_LAS unsigned char*)lds_raw, g, So, e); }
    xcd_barrier(xb);
    }
    DUP(2) {
    { PHASE_IDS; phase_s5_scan(q, gtid, ngt); phase_ret_kv(q, gw, ngw, lane); }
    __syncthreads();
    { PHASE_IDS; phase_moba2(q, l, lds_raw, q.qctr() + 64 + l); }
    xcd_barrier(xb);
    }
    DUP(3) {
    { const Params q = fresh(p); EpiS5Y e{q.ygb(), q.S5A(), q.inp(10) + l * 256};
      pg8::Gemm g{q.S5A(), q.S5Wy(), 16 * 1024, 16 * 512, 640, 640, 640}; pg8::GroupOrder So; So.init(16, 4, 2, (int)gridDim.x, (int)blockIdx.x);
      pg8::gemm_phase<EpiS5Y, pg8::GroupOrder, true, true>((PG8_LAS unsigned char*)lds_raw, g, So, e); }
    { PHASE_IDS; phase_ret_scan(q, gtid, ngt);
      if (G >= 256 && bid >= 128) cvt_table_fp8(q.inp(20) + (size_t)l * 16384 * D, q.V8s(), q.sv(), gw - 128 * NWAVE, ngw - 128 * NWAVE, lane); }
    xcd_barrier(xb);
    }
    DUP(4) {
    { const Params q = fresh(p); EpiGlu e{q.xb(), q.ygb(), (float*)(lds_raw + 131072)};
      run_gemm(lds_raw, q.ygb(), q.Wglu_t() + (size_t)l * 65536, T, 256, 256, e); }
    { PHASE_IDS; phase_ret_out(q, gw, ngw, lane); }
    xcd_barrier(xb);
    }
    { PHASE_IDS; const int ntile = (T / 256) * (INW / 256), nlast = ntile - ((ntile + G - 1) / G - 1) * G;
      if (!(2 * nlast <= G)) cvt_table_i8(q.inp(19) + (size_t)l * 16384 * D, q.U8s(), q.su(), gw, ngw, lane);
      if (!(G >= 256)) cvt_table_fp8(q.inp(20) + (size_t)l * 16384 * D, q.V8s(), q.sv(), gw, ngw, lane); }
    __syncthreads();
    { const Params q = fresh(p); EpiResid e{q.outp(), D, q.xb2(), q.hb(), q.inp(16) + l * D, q.ssq2(), l == 0 ? q.inp(0) : (const float*)q.outp()};
      run_gemm(lds_raw, q.xb(), q.Wout_t() + (size_t)l * D * KD, T, D, KD, e); }
    xcd_barrier(xb);
    DUP(7) {
    { const Params q = fresh(p); EpiScaleStoreBf16 e{q.qb(), D, q.ssq2(), 16, q.rstd()};
      run_gemm(lds_raw, q.xb2(), q.Wq_t() + (size_t)l * D * KD, T, D, KD, e); }
    xcd_barrier(xb);
    }
    if (!(PROBE_SKIP & 2)) {
    DUP(8) {
    { PHASE_IDS; phase_peer_topk(q, l, gw, ngw, lane); }
    xcd_barrier(xb);
    }
    }
#if PEER_CHECK
    if (l == 0) { { PHASE_IDS; chk_save(q, gtid, ngt); } xcd_barrier(xb); { PHASE_IDS; chk_topk(q, l, gtid, ngt); } xcd_barrier(xb); }
#endif
    if (!(PROBE_SKIP & 1)) {
    { PHASE_IDS; phase_peer_u(q, q.qctr() + (l * 2 + 0) * 8, lds_raw, tid); }
    xcd_barrier(xb);
    { PHASE_IDS; phase_peer_r(q, gtid, ngt); if (l + 1 < NL) phase_s5_prep(q, l + 1, gtid, ngt); }
    xcd_barrier(xb);
    if (!(PROBE_SKIP & 32)) {
    { PHASE_IDS; phase_peer_v(q, q.qctr() + (l * 2 + 1) * 8, lds_raw, tid); }
    xcd_barrier(xb);
    }
    }
#if PEER_CHECK
    if (l == 0) { { PHASE_IDS; chk_apply(q, l, ldsf + wv * 128, gw, ngw, lane); } xcd_barrier(xb);
      if (blockIdx.x == 0 && threadIdx.x == 0) { const Params q = fresh(p); chk_emit(q); } xcd_barrier(xb); }
#endif
  }
}

}

extern "C" void kernel_launch(void* const* d_in, const int* in_sizes, int n_in, void* d_out, int out_size, void* d_ws, size_t ws_size,
                              hipStream_t stream) {
  static int grid_blocks = 0;
  if (!grid_blocks) {
    int dev = 0, cus = 0, per_cu = 0;
    hipGetDevice(&dev);
    hipDeviceGetAttribute(&cus, hipDeviceAttributeMultiprocessorCount, dev);
    hipFuncSetAttribute((const void*)mega, hipFuncAttributeMaxDynamicSharedMemorySize, LDS_BYTES);
    hipOccupancyMaxActiveBlocksPerMultiprocessor(&per_cu, (const void*)mega, NTHR, LDS_BYTES);
    if (per_cu < 1) { fprintf(stderr, "occupancy query returned %d\n", per_cu); per_cu = 1; }
    grid_blocks = cus * 1;
    if (grid_blocks < 64) fprintf(stderr, "unexpected CU count %d\n", cus);
  }
  Params p{};
  for (int i = 0; i < 21; ++i) p.in[i] = (const GAS float*)d_in[i];
  p.out_ = (GAS float*)d_out;
  p.ws = (GAS unsigned char*)d_ws;
  if (WS_TOTAL > ws_size) { fprintf(stderr, "workspace too small: need %zu have %zu\n", (size_t)WS_TOTAL, ws_size); return; }
  hipMemsetAsync((unsigned char*)d_ws + WO_bar, 0, 16384, stream);
  void* args[] = {&p};
  hipError_t e = hipLaunchCooperativeKernel((const void*)mega, dim3(grid_blocks), dim3(NTHR), args, LDS_BYTES, stream);
  if (e != hipSuccess) fprintf(stderr, "cooperative launch failed: %s (grid %d)\n", hipGetErrorString(e), grid_blocks);
}
```

```cpp
#include <hip/hip_runtime.h>
#include <hip/hip_cooperative_groups.h>
#include <math.h>
#include <stdint.h>
#include <stdio.h>
namespace cg = cooperative_groups;

#ifndef PEER_CHECK
#define PEER_CHECK 0
#endif
#ifndef PROBE_DUP
#define PROBE_DUP 0
#endif
__device__ __forceinline__ int dup_n(int n) { asm volatile("" : "+s"(n)); return n; }
#define DUP(bit) _Pragma("unroll 1") for (int rep_ = 0, repn_ = (((PROBE_DUP >> (bit)) & 1) ? dup_n(2) : 1); rep_ < repn_; ++rep_)
#ifndef PROBE_SKIP
#define PROBE_SKIP 0
#endif
#ifndef PRECISE
#define PRECISE 0
#endif

namespace {
constexpr int NB = 8, S = 4096, D = 1024, NL = 4, T = NB * S;
constexpr int INW = 2816;
constexpr float EPS = 1e-6f;
static_assert(PRECISE == 0, "PRECISE builds are retired");
constexpr int KS = PRECISE ? 3 : 1;
constexpr int KD = D * KS;
constexpr int NTHR = 512, NWAVE = 8;
constexpr int LDS_BYTES = 131072 + 4096 + 1024;

typedef unsigned short bf16_t;
using bf16x8 = __attribute__((ext_vector_type(8))) short;
using f32x4 = __attribute__((ext_vector_type(4))) float;

__device__ __forceinline__ float wave_sum(float v) {
#pragma unroll
  for (int o = 32; o > 0; o >>= 1) v += __shfl_xor(v, o);
  return v;
}
__device__ __forceinline__ float wave_max(float v) {
#pragma unroll
  for (int o = 32; o > 0; o >>= 1) v = fmaxf(v, __shfl_xor(v, o));
  return v;
}
__device__ __forceinline__ int q_pull(int* head, int nitems, int* bc, int tid) {
  __syncthreads();
  if (tid == 0) bc[0] = atomicAdd(head, 1);
  __syncthreads();
  const int v = bc[0];
  return v < nitems ? v : -1;
}
constexpr float QSCALE = 0.125f * 1.4426950408889634f;
__device__ __forceinline__ float ret_log2g(int h) { return log2f(1.0f - exp2f(-5.0f - (float)h)); }
__device__ __forceinline__ float gelu_tanh(float x) {
  const float k0 = 0.7978845608028654f, k1 = 0.044715f;
  float u = k0 * (x + k1 * x * x * x);
  return 0.5f * x * (1.0f + tanhf(u));
}
__device__ __forceinline__ float sigmoidf_(float x) { return 1.0f / (1.0f + expf(-x)); }
__device__ __forceinline__ float fast_sigmoid(float x) { return __builtin_amdgcn_rcpf(1.0f + __builtin_amdgcn_exp2f(-1.4426950408889634f * x)); }
__device__ __forceinline__ float fast_gelu(float x) { const float u = 0.7978845608028654f * (x + 0.044715f * x * x * x); return x * fast_sigmoid(2.0f * u); }
__device__ __forceinline__ bf16_t f2bf(float f) {
  unsigned u = __float_as_uint(f);
  u += 0x7fffu + ((u >> 16) & 1u);
  return (bf16_t)(u >> 16);
}
__device__ __forceinline__ float bf2f(bf16_t h) { return __uint_as_float(((unsigned)h) << 16); }
#define LDS_FENCE() asm volatile("s_waitcnt lgkmcnt(0)" ::: "memory")
typedef __bf16 bf16x2_hw __attribute__((ext_vector_type(2)));
typedef float f32x2_hw __attribute__((ext_vector_type(2)));
__device__ __forceinline__ unsigned pk_bf16(float lo, float hi) { const f32x2_hw f = {lo, hi}; const bf16x2_hw b = __builtin_convertvector(f, bf16x2_hw); return __builtin_bit_cast(unsigned, b); }
typedef float f32x16 __attribute__((ext_vector_type(16)));

constexpr size_t al256(size_t x) { return (x + 255) & ~(size_t)255; }
constexpr size_t WO_rstd = 0;
constexpr size_t WO_cosm = WO_rstd + al256((size_t)T * 4);
constexpr size_t WO_sinm = WO_cosm + al256((size_t)S * 8 * 4);
constexpr size_t WO_cosr = WO_sinm + al256((size_t)S * 8 * 4);
constexpr size_t WO_sinr = WO_cosr + al256((size_t)S * 32 * 4);
constexpr size_t WO_kmean = WO_sinr + al256((size_t)S * 32 * 4);
constexpr size_t WO_proj = WO_kmean + al256((size_t)NB * 8 * 16 * 64 * 4);
constexpr size_t WO_ybuf = WO_proj + al256((size_t)T * INW * 4);
constexpr size_t WO_yg = WO_ybuf + al256((size_t)T * D * 4);
constexpr size_t WO_skb = WO_yg + al256((size_t)T * 256 * 4);
constexpr size_t WO_Ub = WO_skb + al256((size_t)NL * 16 * 128 * 64 * 2);
constexpr size_t WO_Vb = WO_Ub + al256((size_t)16384 * D * 2);
constexpr size_t WO_gates = WO_Vb + al256((size_t)16384 * D * 2);
constexpr size_t WO_eidx = WO_gates + al256((size_t)T * 128 * 4);
constexpr size_t WO_xb = WO_eidx + al256((size_t)T * 128 * 4);
constexpr size_t WO_Win_t = WO_xb + al256((size_t)T * KD * 2);
constexpr size_t WO_Wout_t = WO_Win_t + al256((size_t)NL * INW * KD * 2);
constexpr size_t WO_Wq_t = WO_Wout_t + al256((size_t)NL * D * KD * 2);
constexpr size_t WO_Qm = WO_Wq_t + al256((size_t)NL * D * KD * 2);
constexpr size_t WO_Km = WO_Qm + al256((size_t)T * 512 * 2);
constexpr size_t WO_Vm = WO_Km + al256((size_t)T * 512 * 2);
constexpr size_t WO_S5a32 = WO_Vm + al256((size_t)T * 512 * 2);
constexpr size_t WO_Wglu_t = WO_S5a32 + al256((size_t)16 * 64 * 2 * 4);
constexpr size_t WO_Qr = WO_Wglu_t + al256((size_t)NL * 256 * 256 * 2);
constexpr size_t WO_Kr = WO_Qr + al256((size_t)T * 256 * 2);
constexpr size_t WO_Krv = WO_Kr + al256((size_t)T * 256 * 2);
constexpr size_t WO_Vr = WO_Krv + al256((size_t)T * 256 * 2);
constexpr size_t WO_KVr = WO_Vr + al256((size_t)T * 256 * 2);
constexpr size_t WO_Rb = WO_KVr + al256((size_t)32 * 32 * 4096 * 4);
constexpr size_t WO_qctr = WO_Rb + al256((size_t)32 * 32 * 4096 * 2);
constexpr size_t WO_bar = WO_qctr + al256(1024);
constexpr size_t WO_S5Wy = WO_bar + al256(16384);
constexpr size_t WO_S5Wz = WO_S5Wy + al256((size_t)16 * 512 * 640 * 2);
constexpr size_t WO_ssq1 = WO_S5Wz + al256((size_t)16 * 256 * 512 * 2);
constexpr size_t WO_ssq2 = WO_ssq1 + al256((size_t)T * 8 * 4);
constexpr size_t WS_TOTAL = WO_ssq2 + al256((size_t)T * 16 * 4);
constexpr size_t WO_S5A = WO_gates;
constexpr size_t WO_S5Z = WO_S5A + al256((size_t)16 * 1024 * 640 * 2);
static_assert(WO_S5Z + (size_t)16 * 1024 * 128 * 4 <= WO_gates + 2 * al256((size_t)T * 128 * 4), "S5A/S5Z must fit in gates+eidx");
#define GAS __attribute__((address_space(1)))
static_assert((size_t)T * D * 2 + (size_t)T * 128 * 8 * 4 + (size_t)T * D * 2 <= (size_t)T * INW * 4, "qb + ppart + xb2 must fit in the proj region");
struct Params {
  const GAS float* in[21];
  GAS float* out_;
  GAS unsigned char* ws;
  __device__ __forceinline__ const float* inp(int i) const { return (const float*)in[i]; }
  __device__ __forceinline__ float* outp() const { return (float*)out_; }
  __device__ __forceinline__ float* rstd() const { return (float*)(ws + WO_rstd); }
  __device__ __forceinline__ float* cosm() const { return (float*)(ws + WO_cosm); }
  __device__ __forceinline__ float* sinm() const { return (float*)(ws + WO_sinm); }
  __device__ __forceinline__ float* cosr() const { return (float*)(ws + WO_cosr); }
  __device__ __forceinline__ float* sinr() const { return (float*)(ws + WO_sinr); }
  __device__ __forceinline__ float* kmean() const { return (float*)(ws + WO_kmean); }
  __device__ __forceinline__ float* proj() const { return (float*)(ws + WO_proj); }
  __device__ __forceinline__ float* ybuf() const { return (float*)(ws + WO_ybuf); }
  __device__ __forceinline__ float* yg() const { return (float*)(ws + WO_yg); }
  __device__ __forceinline__ bf16_t* skb() const { return (bf16_t*)(ws + WO_skb); }
  __device__ __forceinline__ bf16_t* Ub() const { return (bf16_t*)(ws + WO_Ub); }
  __device__ __forceinline__ bf16_t* Vb() const { return (bf16_t*)(ws + WO_Vb); }
  __device__ __forceinline__ float* gates() const { return (float*)(ws + WO_gates); }
  __device__ __forceinline__ int* eidx() const { return (int*)(ws + WO_eidx); }
  __device__ __forceinline__ bf16_t* xb() const { return (bf16_t*)(ws + WO_xb); }
  __device__ __forceinline__ bf16_t* Win_t() const { return (bf16_t*)(ws + WO_Win_t); }
  __device__ __forceinline__ bf16_t* Wout_t() const { return (bf16_t*)(ws + WO_Wout_t); }
  __device__ __forceinline__ bf16_t* Wq_t() const { return (bf16_t*)(ws + WO_Wq_t); }
  __device__ __forceinline__ bf16_t* Qm() const { return (bf16_t*)(ws + WO_Qm); }
  __device__ __forceinline__ bf16_t* Km() const { return (bf16_t*)(ws + WO_Km); }
  __device__ __forceinline__ bf16_t* Vm() const { return (bf16_t*)(ws + WO_Vm); }
  __device__ __forceinline__ bf16_t* S5A() const { return (bf16_t*)(ws + WO_S5A); }
  __device__ __forceinline__ bf16_t* S5Wy() const { return (bf16_t*)(ws + WO_S5Wy); }
  __device__ __forceinline__ bf16_t* S5Wz() const { return (bf16_t*)(ws + WO_S5Wz); }
  __device__ __forceinline__ float* S5Z() const { return (float*)(ws + WO_S5Z); }
  __device__ __forceinline__ float* S5a32() const { return (float*)(ws + WO_S5a32); }
  __device__ __forceinline__ bf16_t* Wglu_t() const { return (bf16_t*)(ws + WO_Wglu_t); }
  __device__ __forceinline__ bf16_t* ygb() const { return (bf16_t*)(ws + WO_yg); }
  __device__ __forceinline__ int* qctr() const { return (int*)(ws + WO_qctr); }
  __device__ __forceinline__ unsigned char* U8s() const { return (unsigned char*)(ws + WO_Ub); }
  __device__ __forceinline__ float* su() const { return (float*)(ws + WO_Ub + (size_t)16384 * D); }
  __device__ __forceinline__ unsigned char* V8s() const { return (unsigned char*)(ws + WO_Vb); }
  __device__ __forceinline__ float* sv() const { return (float*)(ws + WO_Vb + (size_t)16384 * D); }
  __device__ __forceinline__ bf16_t* hb() const { return (bf16_t*)(ws + WO_ybuf + ((size_t)4 << 20)); }
  __device__ __forceinline__ bf16_t* ppart() const { return (bf16_t*)(ws + WO_proj + (size_t)T * D * 2); }
  __device__ __forceinline__ bf16_t* Qr() const { return (bf16_t*)(ws + WO_Qr); }
  __device__ __forceinline__ bf16_t* Kr() const { return (bf16_t*)(ws + WO_Kr); }
  __device__ __forceinline__ bf16_t* Krv() const { return (bf16_t*)(ws + WO_Krv); }
  __device__ __forceinline__ bf16_t* Vr() const { return (bf16_t*)(ws + WO_Vr); }
  __device__ __forceinline__ float* KVr() const { return (float*)(ws + WO_KVr); }
  __device__ __forceinline__ bf16_t* Rb() const { return (bf16_t*)(ws + WO_Rb); }
  __device__ __forceinline__ unsigned* bar() const { return (unsigned*)(ws + WO_bar); }
  __device__ __forceinline__ float* ssq1() const { return (float*)(ws + WO_ssq1); }
  __device__ __forceinline__ float* ssq2() const { return (float*)(ws + WO_ssq2); }
  __device__ __forceinline__ bf16_t* xb2() const { return (bf16_t*)(ws + WO_proj + (size_t)T * D * 2 + (size_t)T * 128 * 8 * 4); }
  __device__ __forceinline__ bf16_t* vrow() const { return (bf16_t*)(ws + WO_proj); }
  __device__ __forceinline__ bf16_t* vrrow() const { return (bf16_t*)(ws + WO_proj + (size_t)T * 512 * 2); }
  __device__ __forceinline__ bf16_t* krow() const { return (bf16_t*)(ws + WO_proj + (size_t)T * 768 * 2); }
  __device__ __forceinline__ bf16_t* grow() const { return (bf16_t*)(ws + WO_proj + (size_t)T * 1024 * 2); }
  __device__ __forceinline__ bf16_t* qb() const { return (bf16_t*)(ws + WO_proj); }
};

namespace pg8 {
#define PG8_LAS __attribute__((address_space(3)))
typedef unsigned short bf16_t;
typedef short bf16x8 __attribute__((ext_vector_type(8)));
typedef float f32x4 __attribute__((ext_vector_type(4)));
typedef unsigned u32x4 __attribute__((ext_vector_type(4)));
constexpr int BM = 256, BK = 64, HALF = 128, HTB = HALF * BK * 2  , STAGE_BYTES = 8 * HTB, NXCD = 8, WGM = 8;

__host__ __device__ __forceinline__ int lds_byte(int r, int c) { const int st = (r >> 4) * 2 + (c >> 5), rr = r & 15, cc = c & 31, ob = rr * 64 + cc * 2; return st * 1024 + (ob ^ (((ob >> 9) & 1) << 5)); }
__host__ __device__ __forceinline__ void stage_rc(int b, int& R, int& C) { const int st = b / 1024, sb = b % 1024, swz = sb ^ (((sb >> 9) & 1) << 5); R = (st >> 1) * 16 + swz / 64; C = (st & 1) * 32 + (swz % 64) / 2; }
__host__ __device__ __forceinline__ int perm32(int rho) { const int n = rho >> 4, i = rho & 15; return 8 * (i >> 2) + 4 * n + (i & 3); }

struct Unit { int pm, pn; };
struct Gemm { const bf16_t* A; const bf16_t* Bt; int M, N, K, lda, ldb; };

struct StaticOrder {
    int nM, nN, nwg, G, c;
    __host__ __device__ void init(int M, int N, int G_, int c_) { nM = M / BM; nN = N / BM; nwg = nM * nN; G = G_; c = c_; }
    __host__ __device__ bool next(int i, Unit& u) const {
        const long L = (long)i * G + c; if (L >= nwg) return false;
        int wgid = (int)L; { const int q = nwg / NXCD, r = nwg % NXCD, xcd = wgid % NXCD, off = wgid / NXCD; wgid = (xcd < r ? xcd * (q + 1) : r * (q + 1) + (xcd - r) * q) + off; }
        const int nig = WGM * nN, gid = wgid / nig, fm = gid * WGM, gsz = (nM - fm) < WGM ? (nM - fm) : WGM;
        u.pm = fm + ((wgid % nig) % gsz); u.pn = (wgid % nig) / gsz; return true;
    }
    __device__ __forceinline__ void a_ready(const Unit&) const {}
    __device__ __forceinline__ void done(const Unit&) const {}
};
struct GroupOrder {
    int mt, nt_, nwg, G, c;
    __host__ __device__ void init(int ngroups, int mt__, int nt__, int G_, int c_) { mt = mt__; nt_ = nt__; nwg = ngroups * mt * nt_; G = G_; c = c_; }
    __host__ __device__ bool next(int i, Unit& u) const {
        const long L = (long)i * G + c; if (L >= nwg) return false;
        const int per = mt * nt_, gi = (int)L / per, r = (int)L % per;
        u.pm = gi * mt + r % mt; u.pn = gi * nt_ + r / mt; return true;
    }
    __device__ __forceinline__ void a_ready(const Unit&) const {}
    __device__ __forceinline__ void done(const Unit&) const {}
};
template <class Epi, class Sched, bool ALIGN_EPI = false, bool SP2 = false>
__device__ __forceinline__ void gemm_phase(PG8_LAS unsigned char* lds, const Gemm g, const Sched& S, const Epi& E) {
    int tid_ = threadIdx.x; asm volatile("" : "+v"(tid_));
    const int tid = tid_, wid = __builtin_amdgcn_readfirstlane(tid >> 6), lane = tid & 63, wr = wid >> 2, wc = wid & 3, fr = lane & 15, fq = lane >> 4;
    const int K = g.K, nt = K / BK;
    unsigned voffA[2], voffB[2];
#pragma unroll
    for (int i = 0; i < 2; ++i) { int R, C; stage_rc(tid * 16 + i * 8192, R, C); const int Rb = Epi::PERM ? ((R & ~31) + perm32(R & 31)) : R;
        voffA[i] = (unsigned)(R * g.lda + C) * 2u; voffB[i] = (unsigned)(Rb * g.ldb + C) * 2u; }
    const size_t kstep = (size_t)(BK * 2);
    const size_t hstepA = (size_t)HALF * g.lda * 2, hstepB = (size_t)HALF * g.ldb * 2;
    const size_t tstepA = 2 * hstepA, tstepB = 2 * hstepB;
    const unsigned ldsw = (unsigned)wid * 1024u;
    const int aoff = lds_byte(wr * 64 + fr, fq * 8), boff = lds_byte(wc * 32 + fr, fq * 8);
#define PG8_SA(b, h) (((b) * 2 + (h)) * HTB)
#define PG8_SB(b, h) ((4 + (b) * 2 + (h)) * HTB)
#define PG8_STAGE(bufoff, gbase, voff) do { _Pragma("unroll") for (int _i = 0; _i < 2; ++_i) \
        __builtin_amdgcn_global_load_lds((const unsigned*)((const char*)(gbase) + (voff)[_i]), (PG8_LAS unsigned*)(lds + (bufoff) + ldsw + _i * 8192), 16, 0, 0); } while (0)
#define PG8_LDA(dst, b, h) do { _Pragma("unroll") for (int m = 0; m < 4; ++m) _Pragma("unroll") for (int k = 0; k < 2; ++k) dst[m][k] = *(const PG8_LAS bf16x8*)(lds + PG8_SA(b, h) + aoff + m * 2048 + k * 1024); } while (0)
#define PG8_LDB(dst, b, h) do { _Pragma("unroll") for (int n = 0; n < 2; ++n) _Pragma("unroll") for (int k = 0; k < 2; ++k) dst[n][k] = *(const PG8_LAS bf16x8*)(lds + PG8_SB(b, h) + boff + n * 2048 + k * 1024); } while (0)
#define PG8_MMA(ai, bj, At, Bt) do { __builtin_amdgcn_s_setprio(1); _Pragma("unroll") for (int m = 0; m < 4; ++m) _Pragma("unroll") for (int n = 0; n < 2; ++n) _Pragma("unroll") for (int k = 0; k < 2; ++k) \
        acc[ai][bj][m][n] = __builtin_amdgcn_mfma_f32_16x16x32_bf16(Bt[n][k], At[m][k], acc[ai][bj][m][n], 0, 0, 0); __builtin_amdgcn_s_setprio(0); } while (0)
#define PG8_WAIT_V(n) asm volatile("s_waitcnt vmcnt(" #n ")" ::: "memory")
#define PG8_WAIT_L(n) asm volatile("s_waitcnt lgkmcnt(" #n ")" ::: "memory")
#define PG8_BAR __builtin_amdgcn_s_barrier()
#define PG8_SCHED __builtin_amdgcn_sched_barrier(0)
    Unit cur, nxt; int ui = 0;
    if (!S.next(0, cur)) return;
    f32x4 acc[2][2][4][2];
    E.init(acc, cur, wr, wc, fr, fq);
    bf16x8 At[4][2], B0[2][2], B1[2][2];
    const char* cA = (const char*)g.A + (size_t)cur.pm * tstepA; const char* cB = (const char*)g.Bt + (size_t)cur.pn * tstepB;
    S.a_ready(cur);
    if constexpr (SP2) {
        PG8_STAGE(PG8_SB(0, 0), cB, voffB); PG8_STAGE(PG8_SB(0, 1), cB + hstepB, voffB); PG8_STAGE(PG8_SA(0, 0), cA, voffA); PG8_STAGE(PG8_SA(0, 1), cA + hstepA, voffA);
        if (wr == 1) PG8_BAR;
        PG8_WAIT_V(2); PG8_BAR;
        PG8_STAGE(PG8_SB(1, 0), cB + kstep, voffB); PG8_STAGE(PG8_SA(1, 0), cA + kstep, voffA); PG8_STAGE(PG8_SB(1, 1), cB + hstepB + kstep, voffB);
        PG8_WAIT_V(6); PG8_BAR;
    } else {
        PG8_STAGE(PG8_SB(0, 0), cB, voffB); PG8_STAGE(PG8_SA(0, 0), cA, voffA); PG8_STAGE(PG8_SB(0, 1), cB + hstepB, voffB); PG8_STAGE(PG8_SA(0, 1), cA + hstepA, voffA);
        if (wr == 1) PG8_BAR;
        PG8_WAIT_V(4); PG8_BAR;
        PG8_STAGE(PG8_SB(1, 0), cB + kstep, voffB); PG8_STAGE(PG8_SA(1, 0), cA + kstep, voffA); PG8_STAGE(PG8_SB(1, 1), cB + hstepB + kstep, voffB);
        PG8_WAIT_V(6); PG8_BAR;
    }
    for (;;) {
        const bool has_next = S.next(ui + 1, nxt);
        const char* nA = has_next ? (const char*)g.A + (size_t)nxt.pm * tstepA : cA; const char* nB = has_next ? (const char*)g.Bt + (size_t)nxt.pn * tstepB : cB;
        for (int t = 0; t < nt; t += 2) {
            const bool last = (t == nt - 2);
            const char* a1 = cA + (size_t)(t + 1) * kstep;
            const char* a2 = last ? nA : cA + (size_t)(t + 2) * kstep; const char* b2 = last ? nB : cB + (size_t)(t + 2) * kstep;
            const char* a3 = a2 + kstep; const char* b3 = b2 + kstep;
            if (last && has_next) S.a_ready(nxt);
            if constexpr (SP2) {
            PG8_LDB(B0, 0, 0); PG8_LDB(B1, 0, 1); PG8_SCHED; PG8_LDA(At, 0, 0); PG8_STAGE(PG8_SA(1, 1), a1 + hstepA, voffA);
            PG8_WAIT_V(8); PG8_WAIT_L(0); PG8_BAR; PG8_MMA(0, 0, At, B0); PG8_MMA(0, 1, At, B1); PG8_BAR; PG8_SCHED;
            PG8_LDA(At, 0, 1); PG8_STAGE(PG8_SB(0, 0), b2, voffB); PG8_STAGE(PG8_SB(0, 1), b2 + hstepB, voffB); PG8_STAGE(PG8_SA(0, 0), a2, voffA);
            PG8_WAIT_V(8); PG8_WAIT_L(0); PG8_BAR; PG8_MMA(1, 0, At, B0); PG8_MMA(1, 1, At, B1); PG8_BAR; PG8_SCHED;
            PG8_LDB(B0, 1, 0); PG8_LDB(B1, 1, 1); PG8_SCHED; PG8_LDA(At, 1, 0); PG8_STAGE(PG8_SA(0, 1), a2 + hstepA, voffA);
            PG8_WAIT_V(8); PG8_WAIT_L(0); PG8_BAR; PG8_MMA(0, 0, At, B0); PG8_MMA(0, 1, At, B1); PG8_BAR; PG8_SCHED;
            PG8_LDA(At, 1, 1); PG8_STAGE(PG8_SB(1, 0), b3, voffB); PG8_STAGE(PG8_SB(1, 1), b3 + hstepB, voffB); PG8_STAGE(PG8_SA(1, 0), a3, voffA);
            PG8_WAIT_V(8); PG8_WAIT_L(0); PG8_BAR; PG8_MMA(1, 0, At, B0); PG8_MMA(1, 1, At, B1); PG8_BAR; PG8_SCHED;
            } else {
            PG8_LDB(B0, 0, 0); PG8_SCHED; PG8_LDA(At, 0, 0); PG8_STAGE(PG8_SA(1, 1), a1 + hstepA, voffA);
            PG8_WAIT_L(8); PG8_BAR; PG8_WAIT_L(0); PG8_MMA(0, 0, At, B0); PG8_BAR; PG8_SCHED;
            PG8_LDB(B1, 0, 1); PG8_STAGE(PG8_SB(0, 0), b2, voffB);
            PG8_BAR; PG8_WAIT_L(0); PG8_MMA(0, 1, At, B1); PG8_BAR;
            PG8_LDA(At, 0, 1); PG8_STAGE(PG8_SA(0, 0), a2, voffA);
            PG8_BAR; PG8_WAIT_L(0); PG8_MMA(1, 0, At, B0); PG8_BAR; PG8_SCHED;
            PG8_STAGE(PG8_SB(0, 1), b2 + hstepB, voffB);
            PG8_WAIT_V(6); PG8_BAR; PG8_MMA(1, 1, At, B1); PG8_BAR;
            PG8_LDB(B0, 1, 0); PG8_SCHED; PG8_LDA(At, 1, 0); PG8_STAGE(PG8_SA(0, 1), a2 + hstepA, voffA);
            PG8_WAIT_L(8); PG8_BAR; PG8_WAIT_L(0); PG8_MMA(0, 0, At, B0); PG8_BAR; PG8_SCHED;
            PG8_LDB(B1, 1, 1); PG8_STAGE(PG8_SB(1, 0), b3, voffB);
            PG8_BAR; PG8_WAIT_L(0); PG8_MMA(0, 1, At, B1); PG8_BAR;
            PG8_LDA(At, 1, 1); PG8_STAGE(PG8_SA(1, 0), a3, voffA);
            PG8_BAR; PG8_WAIT_L(0); PG8_MMA(1, 0, At, B0); PG8_BAR; PG8_SCHED;
            PG8_STAGE(PG8_SB(1, 1), b3 + hstepB, voffB);
            PG8_WAIT_V(6); PG8_BAR; PG8_MMA(1, 1, At, B1); PG8_BAR;
            }
        }
        if constexpr (ALIGN_EPI) { if (wr == 0) PG8_BAR; }
        if constexpr (!Epi::AFTER_DRAIN) { E(acc, cur, wr, wc, fr, fq); S.done(cur); }
        if (!has_next) break;
        E.init(acc, nxt, wr, wc, fr, fq);
        cur = nxt; cA = nA; cB = nB; ++ui;
        if constexpr (ALIGN_EPI) { if (wr == 1) PG8_BAR; }
    }
    PG8_WAIT_V(0);
    if constexpr (!ALIGN_EPI) { if (wr == 0) PG8_BAR; }
    PG8_BAR;
    if constexpr (Epi::AFTER_DRAIN) { E.fused(acc, cur, wr, wc, fr, fq, lds, wid, lane); S.done(cur); }
#undef PG8_SA
#undef PG8_SB
#undef PG8_STAGE
#undef PG8_LDA
#undef PG8_LDB
#undef PG8_MMA
#undef PG8_WAIT_V
#undef PG8_WAIT_L
#undef PG8_BAR
#undef PG8_SCHED
}
}
#define EPI_ZERO_INIT \
  __device__ __forceinline__ void init(pg8::f32x4 (&acc)[2][2][4][2], const pg8::Unit&, int, int, int, int) const { \
    _Pragma("unroll") for (int a = 0; a < 2; ++a) _Pragma("unroll") for (int b = 0; b < 2; ++b) \
    _Pragma("unroll") for (int m = 0; m < 4; ++m) _Pragma("unroll") for (int n = 0; n < 2; ++n) acc[a][b][m][n] = (pg8::f32x4){0.f, 0.f, 0.f, 0.f}; }
struct EpiResid {
  static constexpr bool PERM = true, AFTER_DRAIN = false;
  float* C; int ldc; bf16_t* xb; bf16_t* hb; const float* g2; float* parts; const float* Cin;
  __device__ __forceinline__ void init(pg8::f32x4 (&acc)[2][2][4][2], const pg8::Unit& u, int wr, int wc, int fr, int fq) const {
#pragma unroll
    for (int ai = 0; ai < 2; ++ai)
#pragma unroll
      for (int m = 0; m < 4; ++m) {
        const int row = u.pm * 256 + ai * 128 + wr * 64 + m * 16 + fr;
#pragma unroll
        for (int bj = 0; bj < 2; ++bj)
#pragma unroll
          for (int n = 0; n < 2; ++n) {
            const int col = u.pn * 256 + bj * 128 + wc * 32 + 8 * fq + 4 * n;
            acc[ai][bj][m][n] = *(const pg8::f32x4*)(Cin + (size_t)row * ldc + col);
          }
      }
  }
  __device__ __forceinline__ void operator()(const pg8::f32x4 (&acc)[2][2][4][2], const pg8::Unit& u, int wr, int wc, int fr_in, int fq_in) const {
    int fr = fr_in, fq = fq_in; asm volatile("" : "+v"(fr), "+v"(fq));
    pg8::f32x4 gv[2][2];
#pragma unroll
    for (int bj = 0; bj < 2; ++bj)
#pragma unroll
      for (int n = 0; n < 2; ++n) gv[bj][n] = *(const pg8::f32x4*)(g2 + u.pn * 256 + bj * 128 + wc * 32 + 8 * fq + 4 * n);
#pragma unroll
    for (int ai = 0; ai < 2; ++ai)
#pragma unroll
      for (int m = 0; m < 4; ++m) {
        const int row = u.pm * 256 + ai * 128 + wr * 64 + m * 16 + fr;
        float ss = 0.f;
#pragma unroll
        for (int bj = 0; bj < 2; ++bj) {
          const int col = u.pn * 256 + bj * 128 + wc * 32 + 8 * fq;
          const pg8::f32x4 v0 = acc[ai][bj][m][0], v1 = acc[ai][bj][m][1];
          *(pg8::f32x4*)(C + (size_t)row * ldc + col) = v0; *(pg8::f32x4*)(C + (size_t)row * ldc + col + 4) = v1;
          *(uint4*)(xb + (size_t)row * KD + col) = make_uint4(pk_bf16(v0[0], v0[1]), pk_bf16(v0[2], v0[3]), pk_bf16(v1[0], v1[1]), pk_bf16(v1[2], v1[3]));
          const pg8::f32x4 h0 = v0 * gv[bj][0], h1 = v1 * gv[bj][1];
          *(uint4*)(hb + ((size_t)(col >> 7) * T + row) * 128 + (col & 127)) = make_uint4(pk_bf16(h0[0], h0[1]), pk_bf16(h0[2], h0[3]), pk_bf16(h1[0], h1[1]), pk_bf16(h1[2], h1[3]));
          ss += ((v0[0] * v0[0] + v0[1] * v0[1]) + (v0[2] * v0[2] + v0[3] * v0[3])) + ((v1[0] * v1[0] + v1[1] * v1[1]) + (v1[2] * v1[2] + v1[3] * v1[3]));
        }
        ss += __shfl_xor(ss, 16); ss += __shfl_xor(ss, 32);
        if (fq == 0) parts[(size_t)row * 16 + u.pn * 4 + wc] = ss;
        asm volatile("" ::: "memory");
      }
  }
};
struct EpiScaleStoreBf16 {
  static constexpr bool PERM = true, AFTER_DRAIN = false;
  bf16_t* C; int ldc; const float* parts; int nparts; float* rs_out;
  EPI_ZERO_INIT
  __device__ __forceinline__ void operator()(const pg8::f32x4 (&acc)[2][2][4][2], const pg8::Unit& u, int wr, int wc, int fr_in, int fq_in) const {
    int fr = fr_in, fq = fq_in; asm volatile("" : "+v"(fr), "+v"(fq));
#pragma unroll
    for (int ai = 0; ai < 2; ++ai)
#pragma unroll
      for (int m = 0; m < 4; ++m) {
        const int row = u.pm * 256 + ai * 128 + wr * 64 + m * 16 + fr;
        float ssum = 0.f;
        for (int i = 0; i < nparts; i += 4) { const pg8::f32x4 q4 = *(const pg8::f32x4*)(parts + (size_t)row * nparts + i); ssum += (q4[0] + q4[1]) + (q4[2] + q4[3]); }
        const float r = rsqrtf(ssum * (1.0f / (float)D) + EPS);
        if (rs_out && u.pn == 0 && wc == 0 && fq == 0) rs_out[row] = r;
#pragma unroll
        for (int bj = 0; bj < 2; ++bj) {
          const int col = u.pn * 256 + bj * 128 + wc * 32 + 8 * fq;
          const pg8::f32x4 v0 = acc[ai][bj][m][0] * r, v1 = acc[ai][bj][m][1] * r;
          *(uint4*)(C + (size_t)row * ldc + col) = make_uint4(pk_bf16(v0[0], v0[1]), pk_bf16(v0[2], v0[3]), pk_bf16(v1[0], v1[1]), pk_bf16(v1[2], v1[3]));
        }
        asm volatile("" ::: "memory");
      }
  }
};
struct EpiInProj {
  static constexpr bool PERM = true, AFTER_DRAIN = false;
  const float* parts;
  bf16_t *S5A, *Qm, *Km, *vrow, *Qr, *Kr, *krow, *vrrow, *grow;
  const float *gq, *gk, *cosm, *sinm, *cosr, *sinr;
  EPI_ZERO_INIT
  __device__ __forceinline__ void operator()(const pg8::f32x4 (&acc)[2][2][4][2], const pg8::Unit& u, int wr, int wc, int fr_in, int fq_in) const {
    int fr = fr_in, fq = fq_in; asm volatile("" : "+v"(fr), "+v"(fq));
    const int pn = u.pn;
    float gain[2][8];
    if (pn >= 1 && pn <= 4) {
      const float* gsrc = pn <= 2 ? gq : gk;
#pragma unroll
      for (int bj = 0; bj < 2; ++bj) { const pg8::f32x4 a = *(const pg8::f32x4*)(gsrc + bj * 32 + 8 * fq), b = *(const pg8::f32x4*)(gsrc + bj * 32 + 8 * fq + 4);
        gain[bj][0] = a[0]; gain[bj][1] = a[1]; gain[bj][2] = a[2]; gain[bj][3] = a[3]; gain[bj][4] = b[0]; gain[bj][5] = b[1]; gain[bj][6] = b[2]; gain[bj][7] = b[3]; }
    }
    const float l2g = ret_log2g(wc);
#pragma unroll
    for (int ai = 0; ai < 2; ++ai)
#pragma unroll
      for (int m = 0; m < 4; ++m) {
        const int t = u.pm * 256 + ai * 128 + wr * 64 + m * 16 + fr, s = t & (S - 1), b = t >> 12;
        float r;
        { const pg8::f32x4 p0 = *(const pg8::f32x4*)(parts + (size_t)t * 8), p1 = *(const pg8::f32x4*)(parts + (size_t)t * 8 + 4);
          r = rsqrtf((((p0[0] + p0[1]) + (p0[2] + p0[3])) + ((p1[0] + p1[1]) + (p1[2] + p1[3]))) * (1.0f / (float)D) + EPS); }
        float v[2][8];
#pragma unroll
        for (int bj = 0; bj < 2; ++bj)
#pragma unroll
          for (int e = 0; e < 8; ++e) v[bj][e] = acc[ai][bj][m][e >> 2][e & 3] * r;
#define PK8(x_) make_uint4(pk_bf16((x_)[0], (x_)[1]), pk_bf16((x_)[2], (x_)[3]), pk_bf16((x_)[4], (x_)[5]), pk_bf16((x_)[6], (x_)[7]))
        if (pn == 0) {
#pragma unroll
          for (int bj = 0; bj < 2; ++bj) { const int g = wc * 4 + bj * 2 + (fq >> 1);
            *(uint4*)(S5A + ((size_t)g * 1024 + (t >> 5)) * 640 + (t & 31) * 16 + 8 * (fq & 1)) = PK8(v[bj]); }
        } else if (pn <= 4) {
          const bool isk = pn >= 3; const int h = ((pn - 1) & 1) * 4 + wc, bh = b * 8 + h;
          float ss = 0.f;
#pragma unroll
          for (int bj = 0; bj < 2; ++bj)
#pragma unroll
            for (int e = 0; e < 8; ++e) ss += v[bj][e] * v[bj][e];
          ss += __shfl_xor(ss, 16); ss += __shfl_xor(ss, 32);
          const float rh = rsqrtf(ss * (1.0f / 64.0f) + EPS);
#pragma unroll
          for (int bj = 0; bj < 2; ++bj)
#pragma unroll
            for (int e = 0; e < 8; ++e) v[bj][e] *= rh * gain[bj][e];
          { const pg8::f32x4 c0 = *(const pg8::f32x4*)(cosm + s * 8), c1 = *(const pg8::f32x4*)(cosm + s * 8 + 4), s0 = *(const pg8::f32x4*)(sinm + s * 8), s1 = *(const pg8::f32x4*)(sinm + s * 8 + 4);
#pragma unroll
            for (int e = 0; e < 8; ++e) {
              const float pu = __shfl_xor(v[0][e], 16);
              const float c = e < 4 ? c0[e & 3] : c1[e & 3], sn = e < 4 ? s0[e & 3] : s1[e & 3];
              const float o = fq == 0 ? (v[0][e] * c - pu * sn) : (v[0][e] * c + pu * sn);
              v[0][e] = fq < 2 ? o : v[0][e];
            } }
          if (!isk) {
#pragma unroll
            for (int bj = 0; bj < 2; ++bj) { float q8[8];
#pragma unroll
              for (int e = 0; e < 8; ++e) q8[e] = v[bj][e] * QSCALE;
              *(uint4*)(Qm + ((size_t)bh * S + s) * 64 + bj * 32 + 8 * fq) = PK8(q8); }
          } else {
#pragma unroll
            for (int bj = 0; bj < 2; ++bj) *(uint4*)(Km + ((((size_t)bh * (S / 32) + (s >> 5)) * 8 + bj * 4 + fq) * 32 + (s & 31)) * 8) = PK8(v[bj]);
          }
        } else if (pn <= 6) {
#pragma unroll
          for (int bj = 0; bj < 2; ++bj) *(uint4*)(vrow + (size_t)t * 512 + (pn - 5) * 256 + wc * 64 + bj * 32 + 8 * fq) = PK8(v[bj]);
        } else if (pn <= 8) {
          const bool isk = pn == 8; const int bh = b * 4 + wc, pos = s & 127;
          const float sc = isk ? 0.125f * exp2f(-(float)pos * l2g) : exp2f((float)pos * l2g);
          const pg8::f32x4 c0 = *(const pg8::f32x4*)(cosr + s * 32 + 8 * fq), c1 = *(const pg8::f32x4*)(cosr + s * 32 + 8 * fq + 4);
          const pg8::f32x4 s0 = *(const pg8::f32x4*)(sinr + s * 32 + 8 * fq), s1 = *(const pg8::f32x4*)(sinr + s * 32 + 8 * fq + 4);
          float o1[8], o2[8];
#pragma unroll
          for (int e = 0; e < 8; ++e) { const float c = e < 4 ? c0[e & 3] : c1[e & 3], sn = e < 4 ? s0[e & 3] : s1[e & 3];
            o1[e] = (v[0][e] * c - v[1][e] * sn) * sc; o2[e] = (v[1][e] * c + v[0][e] * sn) * sc; }
          if (!isk) {
            *(uint4*)(Qr + ((size_t)bh * S + s) * 64 + 8 * fq) = PK8(o1); *(uint4*)(Qr + ((size_t)bh * S + s) * 64 + 32 + 8 * fq) = PK8(o2);
          } else {
            *(uint4*)(Kr + ((((size_t)bh * (S / 32) + (s >> 5)) * 8 + fq) * 32 + (s & 31)) * 8) = PK8(o1);
            *(uint4*)(Kr + ((((size_t)bh * (S / 32) + (s >> 5)) * 8 + 4 + fq) * 32 + (s & 31)) * 8) = PK8(o2);
            *(uint4*)(krow + (size_t)t * 256 + wc * 64 + 8 * fq) = PK8(o1); *(uint4*)(krow + (size_t)t * 256 + wc * 64 + 32 + 8 * fq) = PK8(o2);
          }
        } else {
          bf16_t* dst = (pn == 9 ? vrrow : grow) + (size_t)t * 256 + wc * 64 + 8 * fq;
          *(uint4*)dst = PK8(v[0]); *(uint4*)(dst + 32) = PK8(v[1]);
        }
#undef PK8
        asm volatile("" ::: "memory");
      }
  }
};
template <class Epi>
__device__ __forceinline__ void run_gemm(unsigned char* lds_raw, const bf16_t* A, const bf16_t* Bt, int M, int N, int K, const Epi& e) {
  pg8::Gemm g{A, Bt, M, N, K, K, K}; pg8::StaticOrder So; So.init(M, N, (int)gridDim.x, (int)blockIdx.x);
  pg8::gemm_phase<Epi, pg8::StaticOrder, true, true>((PG8_LAS unsigned char*)lds_raw, g, So, e);
}

template <bool HEADPERM>
__device__ __forceinline__ void transpose_items(const float* __restrict__ W, int K, int N, const float* __restrict__ g, bf16_t* __restrict__ Wt, int gw, int ngw, int lane) {
  const int nkt = K / 64, nnt = N / 64;
  for (int it = gw; it < nkt * nnt; it += ngw) {
    int kt = it % nkt, ntile = it / nkt;
    int k0 = kt * 64, n = ntile * 64 + lane;
    int ns = n;
    if (HEADPERM) { const int cp = n & 255; ns = (n & ~255) + ((cp >> 5) & 3) * 64 + (cp >> 7) * 32 + (cp & 31); }
    float v[64];
#pragma unroll
    for (int i = 0; i < 64; ++i) v[i] = W[(size_t)(k0 + i) * N + ns] * g[k0 + i];
    bf16_t* dst = Wt + (size_t)n * (K * KS) + k0;
#pragma unroll
    for (int c = 0; c < 8; ++c) {
      bf16_t hi[8], lo[8];
#pragma unroll
      for (int e = 0; e < 8; ++e) { hi[e] = f2bf(v[c * 8 + e]); lo[e] = f2bf(v[c * 8 + e] - bf2f(hi[e])); }
      uint4 ph, pl;
      ph.x = hi[0] | ((unsigned)hi[1] << 16); ph.y = hi[2] | ((unsigned)hi[3] << 16); ph.z = hi[4] | ((unsigned)hi[5] << 16); ph.w = hi[6] | ((unsigned)hi[7] << 16);
      pl.x = lo[0] | ((unsigned)lo[1] << 16); pl.y = lo[2] | ((unsigned)lo[3] << 16); pl.z = lo[4] | ((unsigned)lo[5] << 16); pl.w = lo[6] | ((unsigned)lo[7] << 16);
      *(uint4*)(dst + c * 8) = ph;
      if (PRECISE) { *(uint4*)(dst + K + c * 8) = pl; *(uint4*)(dst + 2 * K + c * 8) = ph; }
    }
  }
}


__device__ __forceinline__ void phase_prologue(const Params& p, int gtid, int ngt, int gw, int ngw, int lane) {
  for (int idx = gtid; idx < S * 40; idx += ngt) {
    int s = idx / 40, i = idx % 40;
    if (i < 8) {
      const float inv = powf(500000.0f, -(float)(2 * i) / 16.0f);
      float sn, cs; sincosf((float)s * inv, &sn, &cs);
      p.cosm()[s * 8 + i] = cs; p.sinm()[s * 8 + i] = sn;
    } else {
      const int j = i - 8;
      const float inv = powf(10000.0f, -((float)j / 31.0f));
      float sn, cs; sincosf((float)s * inv, &sn, &cs);
      p.cosr()[s * 32 + j] = cs; p.sinr()[s * 32 + j] = sn;
    }
  }
  for (int t = gw; t < T; t += ngw) {
    const float4* xr = (const float4*)(p.inp(0) + (size_t)t * D); float ss = 0.f;
#pragma unroll
    for (int i = 0; i < 4; ++i) { const float4 v = xr[lane + i * 64]; ss += v.x * v.x + v.y * v.y + v.z * v.z + v.w * v.w;
      *(uint2*)(p.xb() + (size_t)t * KD + (lane + i * 64) * 4) = make_uint2(pk_bf16(v.x, v.y), pk_bf16(v.z, v.w)); }
    ss = wave_sum(ss);
    if (lane < 8) p.ssq1()[(size_t)t * 8 + lane] = lane == 0 ? ss : 0.f;
  }
  for (int idx = gtid; idx < NL * 65536; idx += ngt) { const int l2 = idx >> 16, n2 = (idx >> 8) & 255, k2 = idx & 255; p.Wglu_t()[idx] = f2bf(p.inp(11)[(size_t)l2 * 65536 + k2 * 256 + n2]); }
  for (int l = 0; l < NL; ++l) {
    transpose_items<true>(p.inp(2) + (size_t)l * D * INW, D, INW, p.inp(1) + l * D, p.Win_t() + (size_t)l * INW * KD, gw, ngw, lane);
    transpose_items<false>(p.inp(15) + (size_t)l * D * D, D, D, p.inp(14) + l * D, p.Wout_t() + (size_t)l * D * KD, gw, ngw, lane);
    transpose_items<false>(p.inp(17) + (size_t)l * D * D, D, D, p.inp(16) + l * D, p.Wq_t() + (size_t)l * D * KD, gw, ngw, lane);
  }
}


struct S5P { float lr, li, dt, fr, fi; };
__device__ __forceinline__ S5P s5p(const Params& p, int l, int g, int pp) {
  S5P r; r.lr = p.inp(3)[l * 1024 + g * 64 + pp]; r.li = p.inp(4)[l * 1024 + g * 64 + pp]; r.dt = expf(p.inp(5)[l * 16 + g]);
  const float mag = expf(r.lr * r.dt); float sn, cs; sincosf(r.li * r.dt, &sn, &cs);
  const float ar = mag * cs, ai = mag * sn, den = r.lr * r.lr + r.li * r.li;
  r.fr = ((ar - 1.0f) * r.lr + ai * r.li) / den; r.fi = (ai * r.lr - (ar - 1.0f) * r.li) / den;
  return r;
}
__device__ __forceinline__ void s5pow(const S5P& s, int k, float& re, float& im) {
  const float m = expf((float)k * s.lr * s.dt); float sn, cs; sincosf((float)k * s.li * s.dt, &sn, &cs); re = m * cs; im = m * sn;
}
__device__ __forceinline__ void phase_s5_prep(const Params& p, int l, int gtid, int ngt) {
  const float* b_re = p.inp(6) + l * 16384; const float* b_im = p.inp(7) + l * 16384;
  const float* c_re = p.inp(8) + l * 16384; const float* c_im = p.inp(9) + l * 16384;
  bf16_t* Wy = p.S5Wy(); bf16_t* Wz = p.S5Wz();
  for (int it = gtid; it < 16 * 32 * 256; it += ngt) {
    const int hp = it & 15, h = (it >> 4) & 15, d = (it >> 8) & 31, g = it >> 13;
    float prl, pil, frl, fil;
    { const S5P sl = s5p(p, l, g, (int)(threadIdx.x & 63)); s5pow(sl, d, prl, pil); frl = sl.fr; fil = sl.fi; }
    float acc = 0.f;
    for (int pp = 0; pp < 64; ++pp) {
      const float pr = __shfl(prl, pp), pi = __shfl(pil, pp);
      S5P s; s.fr = __shfl(frl, pp); s.fi = __shfl(fil, pp);
      const float br = b_re[(g * 64 + pp) * 16 + hp], bi = b_im[(g * 64 + pp) * 16 + hp];
      const float bbr = s.fr * br - s.fi * bi, bbi = s.fr * bi + s.fi * br;
      const float tr = pr * bbr - pi * bbi, ti = pr * bbi + pi * bbr;
      acc += c_re[(g * 16 + h) * 64 + pp] * tr - c_im[(g * 16 + h) * 64 + pp] * ti;
    }
    const bf16_t v = f2bf(acc);
    for (int jp = 0; jp + d < 32; ++jp) {
      const int j = jp + d;
      Wy[((size_t)g * 512 + j * 16 + h) * 640 + jp * 16 + hp] = v;
      if (d > 0) Wy[((size_t)g * 512 + jp * 16 + h) * 640 + j * 16 + hp] = 0;
    }
  }
  for (int it = gtid; it < 16 * 32 * 16 * 64; it += ngt) {
    const int pp = it & 63, h = (it >> 6) & 15, j = (it >> 10) & 31, g = it >> 15;
    const S5P s = s5p(p, l, g, pp);
    float pr, pi; s5pow(s, j + 1, pr, pi);
    const float cr = c_re[(g * 16 + h) * 64 + pp], ci = c_im[(g * 16 + h) * 64 + pp];
    const unsigned w = pk_bf16(cr * pr - ci * pi, -(cr * pi + ci * pr));
    *(unsigned*)(Wy + ((size_t)g * 512 + j * 16 + h) * 640 + 512 + 2 * pp) = w;
  }
  for (int it = gtid; it < 16 * 64 * 32; it += ngt) {
    const int j = it & 31, pp = (it >> 5) & 63, g = it >> 11;
    const S5P s = s5p(p, l, g, pp);
    float pr, pi; s5pow(s, 31 - j, pr, pi);
    for (int hp = 0; hp < 16; ++hp) {
      const float br = b_re[(g * 64 + pp) * 16 + hp], bi = b_im[(g * 64 + pp) * 16 + hp];
      const float bbr = s.fr * br - s.fi * bi, bbi = s.fr * bi + s.fi * br;
      Wz[((size_t)g * 256 + 2 * pp) * 512 + j * 16 + hp] = f2bf(pr * bbr - pi * bbi);
      Wz[((size_t)g * 256 + 2 * pp + 1) * 512 + j * 16 + hp] = f2bf(pr * bbi + pi * bbr);
    }
  }
  for (int it = gtid; it < 16 * 64; it += ngt) {
    const S5P s = s5p(p, l, it >> 6, it & 63);
    float pr, pi; s5pow(s, 32, pr, pi);
    p.S5a32()[it * 2] = pr; p.S5a32()[it * 2 + 1] = pi;
  }
}
__device__ __forceinline__ void phase_s5_scan(const Params& p, int gtid, int ngt) {
  for (int it = gtid; it < NB * 16 * 64; it += ngt) {
    const int pp = it & 63, g = (it >> 6) & 15, b = it >> 10;
    const float er = p.S5a32()[(g * 64 + pp) * 2], ei = p.S5a32()[(g * 64 + pp) * 2 + 1];
    float sr = 0.f, si = 0.f;
#pragma unroll 1
    for (int c0 = 0; c0 < 128; c0 += 16) {
      float2 z[16];
#pragma unroll
      for (int k = 0; k < 16; ++k) z[k] = *(const float2*)(p.S5Z() + ((size_t)g * 1024 + b * 128 + c0 + k) * 128 + 2 * pp);
#pragma unroll
      for (int k = 0; k < 16; ++k) {
        const size_t ch = (size_t)g * 1024 + b * 128 + c0 + k;
        *(unsigned*)(p.S5A() + ch * 640 + 512 + 2 * pp) = pk_bf16(sr, si);
        const float nr = er * sr - ei * si + z[k].x, ni = er * si + ei * sr + z[k].y;
        sr = nr; si = ni;
      }
    }
  }
}
struct EpiS5Z {
  static constexpr bool PERM = false, AFTER_DRAIN = false;
  float* Z;
  EPI_ZERO_INIT
  __device__ __forceinline__ void operator()(const pg8::f32x4 (&acc)[2][2][4][2], const pg8::Unit& u, int wr, int wc, int fr_in, int fq_in) const {
    int fr = fr_in, fq = fq_in; asm volatile("" : "+v"(fr), "+v"(fq));
    const int g = u.pm >> 2;
#pragma unroll
    for (int ai = 0; ai < 2; ++ai)
#pragma unroll
      for (int m = 0; m < 4; ++m) {
        const int chunk = (u.pm & 3) * 256 + ai * 128 + wr * 64 + m * 16 + fr;
#pragma unroll
        for (int n = 0; n < 2; ++n) *(pg8::f32x4*)(Z + ((size_t)g * 1024 + chunk) * 128 + wc * 32 + n * 16 + 4 * fq) = acc[ai][0][m][n];
      }
  }
};
struct EpiS5Y {
  static constexpr bool PERM = false, AFTER_DRAIN = false;
  bf16_t* ygb; const bf16_t* A; const float* dsk;
  EPI_ZERO_INIT
  __device__ __forceinline__ void operator()(const pg8::f32x4 (&acc)[2][2][4][2], const pg8::Unit& u, int wr, int wc, int fr_in, int fq_in) const {
    int fr = fr_in, fq = fq_in; asm volatile("" : "+v"(fr), "+v"(fq));
    const int g = u.pm >> 2;
#pragma unroll
    for (int ai = 0; ai < 2; ++ai)
#pragma unroll
      for (int m = 0; m < 4; ++m) {
        const int chunk = (u.pm & 3) * 256 + ai * 128 + wr * 64 + m * 16 + fr;
#pragma unroll
        for (int bj = 0; bj < 2; ++bj)
#pragma unroll
          for (int n = 0; n < 2; ++n) {
            const int col = (u.pn & 1) * 256 + bj * 128 + wc * 32 + n * 16 + 4 * fq, j = col >> 4, h = col & 15;
            const uint2 uu = *(const uint2*)(A + ((size_t)g * 1024 + chunk) * 640 + col);
            const pg8::f32x4 dv = *(const pg8::f32x4*)(dsk + g * 16 + h);
            const pg8::f32x4 v = acc[ai][bj][m][n];
            const float y0 = fast_gelu(v[0] + dv[0] * __uint_as_float(uu.x << 16)), y1 = fast_gelu(v[1] + dv[1] * __uint_as_float(uu.x & 0xffff0000u));
            const float y2 = fast_gelu(v[2] + dv[2] * __uint_as_float(uu.y << 16)), y3 = fast_gelu(v[3] + dv[3] * __uint_as_float(uu.y & 0xffff0000u));
            uint2 o; o.x = pk_bf16(y0, y1); o.y = pk_bf16(y2, y3);
            *(uint2*)(ygb + ((size_t)chunk * 32 + j) * 256 + g * 16 + h) = o;
          }
        asm volatile("" ::: "memory");
      }
  }
};
struct EpiGlu {
  static constexpr bool PERM = false, AFTER_DRAIN = false;
  bf16_t* yb; const bf16_t* ygb; float* scr;
  EPI_ZERO_INIT
  __device__ __forceinline__ void operator()(const pg8::f32x4 (&acc_)[2][2][4][2], const pg8::Unit& u, int wr, int wc, int fr_in, int fq_in) const {
    int fr = fr_in, fq = fq_in; asm volatile("" : "+v"(fr), "+v"(fq));
    pg8::f32x4 (&acc)[2][2][4][2] = const_cast<pg8::f32x4 (&)[2][2][4][2]>(acc_);
#pragma unroll
    for (int ai = 0; ai < 2; ++ai)
#pragma unroll
      for (int m = 0; m < 4; ++m) {
        const int rl = ai * 128 + wr * 64 + m * 16 + fr, row = u.pm * 256 + rl;
        float ss = 0.f;
#pragma unroll
        for (int bj = 0; bj < 2; ++bj)
#pragma unroll
          for (int n = 0; n < 2; ++n) {
            const int col = bj * 128 + wc * 32 + n * 16 + 4 * fq;
            const uint2 yy = *(const uint2*)(ygb + (size_t)row * 256 + col);
            const pg8::f32x4 z = acc[ai][bj][m][n];
            pg8::f32x4 r;
            r[0] = __uint_as_float(yy.x << 16) * fast_sigmoid(z[0]); r[1] = __uint_as_float(yy.x & 0xffff0000u) * fast_sigmoid(z[1]);
            r[2] = __uint_as_float(yy.y << 16) * fast_sigmoid(z[2]); r[3] = __uint_as_float(yy.y & 0xffff0000u) * fast_sigmoid(z[3]);
            acc[ai][bj][m][n] = r;
            ss += r[0] * r[0] + r[1] * r[1] + r[2] * r[2] + r[3] * r[3];
          }
        ss += __shfl_xor(ss, 16); ss += __shfl_xor(ss, 32);
        if (fq == 0) scr[rl * 4 + wc] = ss;
        asm volatile("" ::: "memory");
      }
    asm volatile("s_waitcnt lgkmcnt(0)" ::: "memory"); __builtin_amdgcn_s_barrier(); asm volatile("" ::: "memory");
#pragma unroll
    for (int ai = 0; ai < 2; ++ai)
#pragma unroll
      for (int m = 0; m < 4; ++m) {
        const int rl = ai * 128 + wr * 64 + m * 16 + fr, row = u.pm * 256 + rl;
        const pg8::f32x4 s4 = *(const pg8::f32x4*)(scr + rl * 4);
        const float r = rsqrtf((s4[0] + s4[1] + s4[2] + s4[3]) / 256.0f + EPS);
#pragma unroll
        for (int bj = 0; bj < 2; ++bj)
#pragma unroll
          for (int n = 0; n < 2; ++n) { const pg8::f32x4 v = acc[ai][bj][m][n] * r; *(uint2*)(yb + (size_t)row * KD + bj * 128 + wc * 32 + n * 16 + 4 * fq) = make_uint2(pk_bf16(v[0], v[1]), pk_bf16(v[2], v[3])); }
        asm volatile("" ::: "memory");
      }
    asm volatile("s_waitcnt lgkmcnt(0)" ::: "memory"); __builtin_amdgcn_s_barrier(); asm volatile("" ::: "memory");
  }
};


__device__ __forceinline__ void phase_moba2(const Params& p, int l, unsigned char* lds, int* uq) {
  constexpr int OLD = 260;
  bf16_t* Qs = (bf16_t*)lds;
  float* Oaccf = (float*)(lds + 32768);
  float* laccf = (float*)(lds + 32768 + 64 * OLD * 4);
  float* kms = laccf + 256;
  float* gat = kms + 1024;
  unsigned char* lists = (unsigned char*)(gat + 4096);
  int* cnt = (int*)(lists + 4096);
  int* items = cnt + 16;
  int* ctr = items + 160;
  unsigned* selp = (unsigned*)(ctr + 4);
  float* bq = (float*)(selp + 256);
  int* Oacc = (int*)Oaccf; int* lacc = (int*)laccf;
  float kmax = 0.f;
  { const float* gk = p.inp(13) + l * 64;
    for (int d = 0; d < 64; ++d) kmax = fmaxf(kmax, fabsf(gk[d]));
    kmax *= 8.0f * 1.01f; }
  for (;;) {
    const int u = q_pull(uq, NB * 8 * 16, (int*)(lds + 131072), threadIdx.x);
    if (u < 0) break;
    const int qblk = 15 - (u >> 6), bh = u & 63, b = bh >> 3, h = bh & 7;
    int tid = threadIdx.x; asm volatile("" : "+v"(tid));
    const int lane = tid & 63, wv = tid >> 6, n = lane & 31, hh = lane >> 5;
    __syncthreads();
    { const uint4* src = (const uint4*)(p.Qm() + ((size_t)bh * S + qblk * 256) * 64);
      uint4* dst = (uint4*)Qs;
      for (int i = tid; i < 256 * 64 * 2 / 16; i += NTHR) dst[i] = src[i]; }
    for (int i = tid; i < qblk * 64; i += NTHR) kms[i] = p.kmean()[(size_t)bh * 1024 + i];
    for (int i = tid; i < 64 * OLD; i += NTHR) Oacc[i] = 0;
    if (tid < 256) lacc[tid] = 0;
    if (tid < 16) cnt[tid] = 0;
    __syncthreads();
    { const int q = tid & 255, par = tid >> 8;
      float qv[64];
#pragma unroll
      for (int c = 0; c < 8; ++c) {
        uint4 w = *(const uint4*)(Qs + q * 64 + c * 8);
        qv[c * 8 + 0] = __uint_as_float(w.x << 16); qv[c * 8 + 1] = __uint_as_float(w.x & 0xffff0000u);
        qv[c * 8 + 2] = __uint_as_float(w.y << 16); qv[c * 8 + 3] = __uint_as_float(w.y & 0xffff0000u);
        qv[c * 8 + 4] = __uint_as_float(w.z << 16); qv[c * 8 + 5] = __uint_as_float(w.z & 0xffff0000u);
        qv[c * 8 + 6] = __uint_as_float(w.w << 16); qv[c * 8 + 7] = __uint_as_float(w.w & 0xffff0000u);
      }
      if (par == 0) { float qq = 0.f;
#pragma unroll
        for (int d = 0; d < 64; ++d) qq = fmaf(qv[d], qv[d], qq);
        bq[q] = sqrtf(qq) * kmax; }
      for (int j = par; j < qblk; j += 2) {
        float g = 0.f;
#pragma unroll
        for (int d = 0; d < 64; ++d) g = fmaf(qv[d], kms[j * 64 + d], g);
        gat[q * 16 + j] = g;
      }
    }
    __syncthreads();
    if (tid < 256) {
      float b0 = -INFINITY, b1 = -INFINITY, b2 = -INFINITY; int i0 = 0, i1 = 0, i2 = 0;
      for (int j = 0; j < qblk; ++j) {
        float g = gat[tid * 16 + j];
        if (g > b0) { b2 = b1; i2 = i1; b1 = b0; i1 = i0; b0 = g; i0 = j; }
        else if (g > b1) { b2 = b1; i2 = i1; b1 = g; i1 = j; }
        else if (g > b2) { b2 = g; i2 = j; }
      }
      const int nsel = qblk < 3 ? qblk : 3;
      selp[tid] = (unsigned)i0 | ((unsigned)i1 << 4) | ((unsigned)i2 << 8) | ((unsigned)nsel << 12);
    }
    __syncthreads();
    for (int j = wv; j < qblk; j += 8) {
      int base = 0;
      for (int c = 0; c < 4; ++c) {
        const int q = c * 64 + lane;
        const unsigned sp = selp[q];
        const int ns = sp >> 12;
        const bool f = (ns > 0 && (int)(sp & 15) == j) || (ns > 1 && (int)((sp >> 4) & 15) == j) || (ns > 2 && (int)((sp >> 8) & 15) == j);
        const unsigned long long bal = __ballot(f);
        const int pos = base + __popcll(bal & ((1ull << lane) - 1ull));
        if (f) lists[j * 256 + pos] = (unsigned char)q;
        base += __popcll(bal);
      }
      if (lane == 0) cnt[j] = base;
    }
    __syncthreads();
    if (tid == 0) {
      int ni = 0;
#pragma unroll 1
      for (int g = 7; g >= 0; --g) items[ni++] = (16 << 8) | g;
      for (int j = 0; j < qblk; ++j) { const int ng = (cnt[j] + 31) >> 5; for (int g = 0; g < ng; ++g) items[ni++] = (j << 8) | g; }
      ctr[0] = ni; ctr[1] = 0;
    }
    __syncthreads();
    const int nitems = ctr[0];
    DUP(11) {
    if (rep_ > 0) { __syncthreads(); if (tid == 0) ctr[1] = 0; __syncthreads(); }
    for (;;) {
      int it = 0;
      if (lane == 0) it = atomicAdd(&ctr[1], 1);
      it = __builtin_amdgcn_readfirstlane(it);
      if (it >= nitems) break;
      const int item = items[it];
      const int j = item >> 8, g = item & 255;
      const bool own = (j == 16);
      const int kb = own ? qblk : j;
      const int ntile = own ? (g + 1) : 8;
      int qi; bool valid;
      if (own) { qi = g * 32 + n; valid = true; }
      else { const int pos = g * 32 + n; valid = pos < cnt[j]; qi = lists[j * 256 + (valid ? pos : 0)]; }
      const bf16_t* kt0 = p.Km() + ((size_t)bh * (S / 32) + kb * 8) * 2048 + lane * 8;
      const bf16_t* vt0 = p.Vm() + ((size_t)bh * (S / 32) + kb * 8) * 2048 + lane * 8;
      f32x16 O0, O1;
#pragma unroll
      for (int r = 0; r < 16; ++r) { O0[r] = 0.f; O1[r] = 0.f; }
      float lsum = 0.f;
      const float nbq = -bq[qi];
      bf16x8 kf[3][4], vf[3][4];
#define MOBA_LOAD(KT_, BUF_) { _Pragma("unroll") for (int s = 0; s < 4; ++s) { kf[BUF_][s] = *(const bf16x8*)(kt0 + (size_t)(KT_) * 2048 + s * 512); vf[BUF_][s] = *(const bf16x8*)(vt0 + (size_t)(KT_) * 2048 + s * 512); } }
#define MOBA_STEP(KT_, BUF_)                                                                                                           \
      if ((KT_) < ntile) {                                                                                                               \
        if ((KT_) + 2 < ntile) MOBA_LOAD((KT_) + 2, ((BUF_) + 2) % 3)                                                                     \
        f32x16 X;                                                                                                                         \
        _Pragma("unroll") for (int r = 0; r < 16; ++r) X[r] = nbq;                                                                        \
        _Pragma("unroll") for (int s = 0; s < 4; ++s) X = __builtin_amdgcn_mfma_f32_32x32x16_bf16(kf[BUF_][s], *(const bf16x8*)(Qs + qi * 64 + (2 * s + hh) * 8), X, 0, 0, 0);     \
        const bool diag = own && ((KT_) == g);                                                                                            \
        unsigned pw[8];                                                                                                                   \
        _Pragma("unroll") for (int r = 0; r < 16; r += 2) {                                                                               \
          float e0 = __builtin_amdgcn_exp2f(X[r]), e1 = __builtin_amdgcn_exp2f(X[r + 1]);                                                 \
          if (diag) {                                                                                                                     \
            const int k0 = (r & 3) + 8 * (r >> 2) + 4 * hh, k1 = ((r + 1) & 3) + 8 * ((r + 1) >> 2) + 4 * hh;                             \
            e0 = (k0 <= n) ? e0 : 0.f; e1 = (k1 <= n) ? e1 : 0.f;                                                                         \
          }                                                                                                                               \
          lsum += e0 + e1;                                                                                                                \
          pw[r >> 1] = pk_bf16(e0, e1);                                                                                                   \
        }                                                                                                                                 \
        bf16x8 pf0, pf1;                                                                                                                  \
        { uint4 t0 = make_uint4(pw[0], pw[1], pw[2], pw[3]), t1 = make_uint4(pw[4], pw[5], pw[6], pw[7]);                                 \
          pf0 = *(bf16x8*)&t0; pf1 = *(bf16x8*)&t1; }                                                                                     \
        O0 = __builtin_amdgcn_mfma_f32_32x32x16_bf16(vf[BUF_][0], pf0, O0, 0, 0, 0);                                                      \
        O0 = __builtin_amdgcn_mfma_f32_32x32x16_bf16(vf[BUF_][1], pf1, O0, 0, 0, 0);                                                      \
        O1 = __builtin_amdgcn_mfma_f32_32x32x16_bf16(vf[BUF_][2], pf0, O1, 0, 0, 0);                                                      \
        O1 = __builtin_amdgcn_mfma_f32_32x32x16_bf16(vf[BUF_][3], pf1, O1, 0, 0, 0);                                                      \
      }
      MOBA_LOAD(0, 0)
      if (ntile > 1) MOBA_LOAD(1, 1)
#pragma unroll 1
      for (int kt3 = 0; kt3 < ntile; kt3 += 3) {
        MOBA_STEP(kt3, 0) MOBA_STEP(kt3 + 1, 1) MOBA_STEP(kt3 + 2, 2)
      }
#undef MOBA_STEP
#undef MOBA_LOAD
      lsum += __shfl_xor(lsum, 32);
      if (valid) {
        if (hh == 0) atomicAdd(&lacc[qi], __float2int_rn(lsum * 1048576.0f));
#pragma unroll
        for (int r = 0; r < 16; ++r) {
          const int dim = (r & 3) + 8 * (r >> 2) + 4 * hh;
          atomicAdd(&Oacc[dim * OLD + qi], __float2int_rn(O0[r] * 1048576.0f));
          atomicAdd(&Oacc[(dim + 32) * OLD + qi], __float2int_rn(O1[r] * 1048576.0f));
        }
      }
    }
    }
    __syncthreads();
    { const int q = tid >> 1, half = tid & 1;
      const float inv = 1.0f / (float)lacc[q];
      float o[32], ss = 0.f;
#pragma unroll
      for (int d = 0; d < 32; ++d) { o[d] = (float)Oacc[(half * 32 + d) * OLD + q] * inv; ss += o[d] * o[d]; }
      ss += __shfl_xor(ss, 1);
      const float r = rsqrtf(ss / 64.0f + EPS);
      bf16_t* dst = p.xb() + (size_t)(b * S + qblk * 256 + q) * KD + 256 + h * 64 + half * 32;
#pragma unroll
      for (int d = 0; d < 32; d += 8) *(uint4*)(dst + d) = make_uint4(pk_bf16(o[d] * r, o[d + 1] * r), pk_bf16(o[d + 2] * r, o[d + 3] * r), pk_bf16(o[d + 4] * r, o[d + 5] * r), pk_bf16(o[d + 6] * r, o[d + 7] * r));
    }
  }
}


__device__ __forceinline__ void phase_ret_kv(const Params& p, int gw, int ngw, int lane) {
  const int n = lane & 31, hh = lane >> 5;
  for (int w = gw; w < NB * 4 * 32; w += ngw) {
    const int bh = w >> 5, cn = w & 31;
    const bf16_t* vt = p.Vr() + ((size_t)bh * (S / 32) + cn * 4) * 2048 + lane * 8;
    const bf16_t* kt = p.Krv() + ((size_t)bh * (S / 32) + cn * 4) * 2048 + lane * 8;
    f32x16 acc[2][2];
#pragma unroll
    for (int a = 0; a < 2; ++a)
#pragma unroll
      for (int b2 = 0; b2 < 2; ++b2)
#pragma unroll
        for (int r = 0; r < 16; ++r) acc[a][b2][r] = 0.f;
#pragma unroll 1
    for (int tl = 0; tl < 4; ++tl)
#pragma unroll
      for (int ks = 0; ks < 2; ++ks) {
        bf16x8 vf[2], kf[2];
#pragma unroll
        for (int x = 0; x < 2; ++x) { vf[x] = *(const bf16x8*)(vt + tl * 2048 + (x * 2 + ks) * 512); kf[x] = *(const bf16x8*)(kt + tl * 2048 + (x * 2 + ks) * 512); }
#pragma unroll
        for (int mb = 0; mb < 2; ++mb)
#pragma unroll
          for (int nb = 0; nb < 2; ++nb) acc[mb][nb] = __builtin_amdgcn_mfma_f32_32x32x16_bf16(vf[mb], kf[nb], acc[mb][nb], 0, 0, 0);
      }
    float* dst = p.KVr() + ((size_t)bh * 32 + cn) * 4096;
#pragma unroll
    for (int mb = 0; mb < 2; ++mb)
#pragma unroll
      for (int nb = 0; nb < 2; ++nb)
#pragma unroll
        for (int r = 0; r < 16; ++r) dst[(mb * 32 + (r & 3) + 8 * (r >> 2) + 4 * hh) * 64 + nb * 32 + n] = acc[mb][nb][r];
  }
}
__device__ __forceinline__ void phase_ret_scan(const Params& p, int gtid, int ngt) {
  for (int it = gtid; it < NB * 4 * 4096; it += ngt) {
    const int e = it & 4095, bh = it >> 12, h = bh & 3;
    const float l2g = ret_log2g(h), g1 = exp2f(l2g), g127 = exp2f(127.0f * l2g), g128 = exp2f(128.0f * l2g);
    float R = 0.f; float kv[32];
#pragma unroll
    for (int cn = 0; cn < 32; ++cn) kv[cn] = p.KVr()[((size_t)bh * 32 + cn) * 4096 + e];
#pragma unroll
    for (int cn = 0; cn < 32; ++cn) {
      p.Rb()[((size_t)bh * 32 + cn) * 4096 + e] = f2bf(g1 * R);
      R = g128 * R + g127 * kv[cn];
    }
  }
}
__device__ __forceinline__ void phase_ret_out(const Params& p, int gw, int ngw, int lane) {
  const int n = lane & 31, hh = lane >> 5;
  for (int w = gw; w < NB * 4 * 32 * 4; w += ngw) {
    const int qg = 3 - (w & 3), cn = (w >> 2) & 31, bh = w >> 7, b = bh >> 2, h = bh & 3;
    const int s0 = cn * 128 + qg * 32;
    bf16x8 qf[4];
#pragma unroll
    for (int s = 0; s < 4; ++s) qf[s] = *(const bf16x8*)(p.Qr() + ((size_t)bh * S + s0 + n) * 64 + (2 * s + hh) * 8);
    f32x16 O0, O1;
#pragma unroll
    for (int r = 0; r < 16; ++r) { O0[r] = 0.f; O1[r] = 0.f; }
    { const bf16_t* rb = p.Rb() + ((size_t)bh * 32 + cn) * 4096 + (size_t)n * 64 + hh * 8;
#pragma unroll
      for (int s = 0; s < 4; ++s) {
        const bf16x8 r0 = *(const bf16x8*)(rb + s * 16), r1 = *(const bf16x8*)(rb + 32 * 64 + s * 16);
        O0 = __builtin_amdgcn_mfma_f32_32x32x16_bf16(r0, qf[s], O0, 0, 0, 0);
        O1 = __builtin_amdgcn_mfma_f32_32x32x16_bf16(r1, qf[s], O1, 0, 0, 0);
      } }
    const bf16_t* kt0 = p.Kr() + ((size_t)bh * (S / 32) + cn * 4) * 2048 + lane * 8;
    const bf16_t* vt0 = p.Vr() + ((size_t)bh * (S / 32) + cn * 4) * 2048 + lane * 8;
    for (int kt = 0; kt <= qg; ++kt) {
      bf16x8 kf[4], vf[4];
#pragma unroll
      for (int s = 0; s < 4; ++s) { kf[s] = *(const bf16x8*)(kt0 + (size_t)kt * 2048 + s * 512); vf[s] = *(const bf16x8*)(vt0 + (size_t)kt * 2048 + s * 512); }
      f32x16 X;
#pragma unroll
      for (int r = 0; r < 16; ++r) X[r] = 0.f;
#pragma unroll
      for (int s = 0; s < 4; ++s) X = __builtin_amdgcn_mfma_f32_32x32x16_bf16(kf[s], qf[s], X, 0, 0, 0);
      const bool diag = (kt == qg);
      unsigned pw[8];
#pragma unroll
      for (int r = 0; r < 16; r += 2) {
        float e0 = X[r], e1 = X[r + 1];
        if (diag) {
          const int k0 = (r & 3) + 8 * (r >> 2) + 4 * hh, k1 = ((r + 1) & 3) + 8 * ((r + 1) >> 2) + 4 * hh;
          e0 = (k0 <= n) ? e0 : 0.f; e1 = (k1 <= n) ? e1 : 0.f;
        }
        pw[r >> 1] = pk_bf16(e0, e1);
      }
      bf16x8 pf0, pf1;
      { uint4 t0 = make_uint4(pw[0], pw[1], pw[2], pw[3]), t1 = make_uint4(pw[4], pw[5], pw[6], pw[7]);
        pf0 = *(bf16x8*)&t0; pf1 = *(bf16x8*)&t1; }
      O0 = __builtin_amdgcn_mfma_f32_32x32x16_bf16(vf[0], pf0, O0, 0, 0, 0);
      O0 = __builtin_amdgcn_mfma_f32_32x32x16_bf16(vf[1], pf1, O0, 0, 0, 0);
      O1 = __builtin_amdgcn_mfma_f32_32x32x16_bf16(vf[2], pf0, O1, 0, 0, 0);
      O1 = __builtin_amdgcn_mfma_f32_32x32x16_bf16(vf[3], pf1, O1, 0, 0, 0);
    }
    float ss = 0.f;
#pragma unroll
    for (int r = 0; r < 16; ++r) ss += O0[r] * O0[r] + O1[r] * O1[r];
    ss += __shfl_xor(ss, 32);
    const float rn = rsqrtf(ss / 64.0f + EPS);
    const size_t t = (size_t)b * S + s0 + n;
    const bf16_t* gp = p.grow() + t * 256 + h * 64;
    bf16_t* yo = p.xb() + t * KD + 768 + h * 64;
#pragma unroll
    for (int q4 = 0; q4 < 4; ++q4) {
#pragma unroll
      for (int mb = 0; mb < 2; ++mb) {
        const int d0 = mb * 32 + 8 * q4 + 4 * hh;
        const uint2 gw2 = *(const uint2*)(gp + d0); const float4 g = make_float4(__uint_as_float(gw2.x << 16), __uint_as_float(gw2.x & 0xffff0000u), __uint_as_float(gw2.y << 16), __uint_as_float(gw2.y & 0xffff0000u));
        float4 o;
        const f32x16& Oa = mb ? O1 : O0;
        o.x = Oa[q4 * 4 + 0] * rn * g.x * fast_sigmoid(g.x); o.y = Oa[q4 * 4 + 1] * rn * g.y * fast_sigmoid(g.y);
        o.z = Oa[q4 * 4 + 2] * rn * g.z * fast_sigmoid(g.z); o.w = Oa[q4 * 4 + 3] * rn * g.w * fast_sigmoid(g.w);
        *(uint2*)(yo + d0) = make_uint2(pk_bf16(o.x, o.y), pk_bf16(o.z, o.w));
      }
    }
  }
}

__device__ __forceinline__ void phase_post_pack(const Params& p, int gtid, int ngt) {
  for (int idx0 = gtid; idx0 < NB * 8 * (S / 32) * 256; idx0 += 4 * ngt) {
    bf16_t v[4][8]; bool ok[4];
#pragma unroll
    for (int u = 0; u < 4; ++u) { const int idx_ = idx0 + u * ngt; ok[u] = idx_ < NB * 8 * (S / 32) * 256; const int idx = ok[u] ? idx_ : 0;
      const int ln = idx & 63, ks = (idx >> 6) & 1, mb = (idx >> 7) & 1, tile = (idx >> 8) % (S / 32), bh = idx / (256 * (S / 32));
      const int b = bh >> 3, h = bh & 7, hh = ln >> 5, delta = mb * 32 + (ln & 31);
#pragma unroll
      for (int j = 0; j < 8; ++j) { const int kappa = 16 * ks + 8 * (j >> 2) + 4 * hh + (j & 3), s = tile * 32 + kappa; v[u][j] = p.vrow()[(size_t)(b * S + s) * 512 + h * 64 + delta]; } }
#pragma unroll
    for (int u = 0; u < 4; ++u) if (ok[u])
      *(uint4*)(p.Vm() + (size_t)(idx0 + u * ngt) * 8) = make_uint4(v[u][0] | ((unsigned)v[u][1] << 16), v[u][2] | ((unsigned)v[u][3] << 16), v[u][4] | ((unsigned)v[u][5] << 16), v[u][6] | ((unsigned)v[u][7] << 16));
  }
  for (int idx0 = gtid; idx0 < 2 * NB * 4 * (S / 32) * 256; idx0 += 4 * ngt) {
    bf16_t v[4][8]; bool ok[4];
#pragma unroll
    for (int u = 0; u < 4; ++u) { const int idx_ = idx0 + u * ngt; ok[u] = idx_ < 2 * NB * 4 * (S / 32) * 256; const int idx = ok[u] ? idx_ : 0;
      const int ln = idx & 63, ks = (idx >> 6) & 1, blk = (idx >> 7) & 1, tile = (idx >> 8) % (S / 32), rest = idx / (256 * (S / 32)), bh = rest % (NB * 4), which = rest / (NB * 4);
      const int b = bh >> 2, h = bh & 3, hh = ln >> 5, delta = blk * 32 + (ln & 31);
      const bf16_t* srcp = which ? p.krow() : p.vrrow();
#pragma unroll
      for (int j = 0; j < 8; ++j) { const int kappa = 16 * ks + 8 * (j >> 2) + 4 * hh + (j & 3), s = tile * 32 + kappa; v[u][j] = srcp[(size_t)(b * S + s) * 256 + h * 64 + delta]; } }
#pragma unroll
    for (int u = 0; u < 4; ++u) if (ok[u]) { const int idx = idx0 + u * ngt; const int which = (idx / (256 * (S / 32))) / (NB * 4);
      *(uint4*)((which ? p.Krv() : p.Vr()) + ((size_t)(idx % (NB * 4 * (S / 32) * 256))) * 8) = make_uint4(v[u][0] | ((unsigned)v[u][1] << 16), v[u][2] | ((unsigned)v[u][3] << 16), v[u][4] | ((unsigned)v[u][5] << 16), v[u][6] | ((unsigned)v[u][7] << 16)); }
  }
}
__device__ __forceinline__ void phase_kmean2(const Params& p, int gtid, int ngt) {
  const int lane = gtid & 63, half = lane >> 5;
  for (int w = gtid >> 6; w < NB * 8 * 16; w += ngt >> 6) {
    const int j = w & 15, bh = w >> 4;
    const bf16_t* kp = p.Km() + ((size_t)bh * (S / 32) + j * 8) * 2048 + lane * 8;
    float acc[4][8];
#pragma unroll
    for (int i = 0; i < 4; ++i)
#pragma unroll
      for (int e = 0; e < 8; ++e) acc[i][e] = 0.f;
#pragma unroll
    for (int t2 = 0; t2 < 8; t2 += 2) {
      uint4 r[2][4];
#pragma unroll
      for (int tt = 0; tt < 2; ++tt)
#pragma unroll
        for (int i = 0; i < 4; ++i) r[tt][i] = *(const uint4*)(kp + (size_t)(t2 + tt) * 2048 + i * 512);
#pragma unroll
      for (int tt = 0; tt < 2; ++tt)
#pragma unroll
        for (int i = 0; i < 4; ++i) { const unsigned w4[4] = {r[tt][i].x, r[tt][i].y, r[tt][i].z, r[tt][i].w};
#pragma unroll
          for (int q = 0; q < 4; ++q) { acc[i][2 * q] += __uint_as_float(w4[q] << 16); acc[i][2 * q + 1] += __uint_as_float(w4[q] & 0xffff0000u); } }
    }
#pragma unroll
    for (int i = 0; i < 4; ++i)
#pragma unroll
      for (int e = 0; e < 8; ++e) { float a = acc[i][e];
        a += __shfl_xor(a, 1); a += __shfl_xor(a, 2); a += __shfl_xor(a, 4); a += __shfl_xor(a, 8); a += __shfl_xor(a, 16); acc[i][e] = a; }
    if ((lane & 31) == 0) {
#pragma unroll
      for (int i = 0; i < 4; ++i) { float* dst = p.kmean() + (size_t)w * 64 + (2 * i + half) * 8;
        *(float4*)dst = make_float4(acc[i][0] * (1.0f / 256.0f), acc[i][1] * (1.0f / 256.0f), acc[i][2] * (1.0f / 256.0f), acc[i][3] * (1.0f / 256.0f));
        *(float4*)(dst + 4) = make_float4(acc[i][4] * (1.0f / 256.0f), acc[i][5] * (1.0f / 256.0f), acc[i][6] * (1.0f / 256.0f), acc[i][7] * (1.0f / 256.0f)); }
    }
  }
}

__device__ __forceinline__ void cvt_f32_bf16(const float* __restrict__ src, bf16_t* __restrict__ dst, size_t n8, int gtid, int ngt) {
  for (size_t i = gtid; i < n8; i += ngt) {
    float4 a = *(const float4*)(src + i * 8), b4 = *(const float4*)(src + i * 8 + 4);
    uint4 o; o.x = pk_bf16(a.x, a.y); o.y = pk_bf16(a.z, a.w); o.z = pk_bf16(b4.x, b4.y); o.w = pk_bf16(b4.z, b4.w);
    *(uint4*)(dst + i * 8) = o;
  }
}
__device__ __forceinline__ int f2key(float f) { int b = __float_as_int(f); return b ^ ((b >> 31) & 0x7fffffff); }
__device__ __forceinline__ float key2f(int k) { return __int_as_float(k ^ ((k >> 31) & 0x7fffffff)); }
#define CASD(a_, b_) { int mx_ = max(a_, b_), mn_ = min(a_, b_); a_ = mx_; b_ = mn_; }
__device__ __forceinline__ void sort16_desc(int (&v)[16]) {
#pragma unroll
  for (int k = 2; k <= 16; k <<= 1)
#pragma unroll
    for (int j = k >> 1; j > 0; j >>= 1)
#pragma unroll
      for (int i = 0; i < 16; ++i) { const int l2 = i ^ j; if (l2 > i) { if ((i & k) == 0) CASD(v[i], v[l2]) else CASD(v[l2], v[i]) } }
}
__device__ __forceinline__ void merge_top16(int (&a)[16], const int (&b)[16]) {
#pragma unroll
  for (int i = 0; i < 16; ++i) a[i] = max(a[i], b[15 - i]);
#pragma unroll
  for (int j = 8; j > 0; j >>= 1)
#pragma unroll
    for (int i = 0; i < 16; ++i) { const int l2 = i ^ j; if (l2 > i) CASD(a[i], a[l2]) }
}
__device__ __forceinline__ int lut4(int w0, int w1, int w2, int w3, int i) {
  const int w = i >> 2; const int d = (w == 0) ? w0 : (w == 1) ? w1 : (w == 2) ? w2 : w3;
  return (d >> ((i & 3) * 8)) & 127;
}

__device__ __forceinline__ void phase_peer_topk(const Params& p, int l, int gw, int ngw, int lane) {
  const int n = lane & 31, hh = lane >> 5;
  const bf16_t* skl = p.skb() + (size_t)l * 16 * 128 * 64;
  for (int w = gw; w < (T / 32) * 8; w += ngw) {
    const int tg = w >> 3, h = w & 7, t = tg * 32 + n;
    int L0[16], L1[16];
#pragma unroll
    for (int c = 0; c < 2; ++c) {
      const int hc = 2 * h + c;
      bf16x8 qf[4];
#pragma unroll
      for (int s = 0; s < 4; ++s) qf[s] = *(const bf16x8*)(p.qb() + (size_t)t * D + hc * 64 + 16 * s + 8 * hh);
      int A[16], Bq[16];
#pragma unroll
      for (int mb = 0; mb < 4; ++mb) {
        f32x16 X;
#pragma unroll
        for (int r = 0; r < 16; ++r) X[r] = 0.f;
#pragma unroll
        for (int s = 0; s < 4; ++s) {
          const bf16x8 kf = *(const bf16x8*)(skl + ((size_t)(hc * 128 + mb * 32 + n)) * 64 + 16 * s + 8 * hh);
          X = __builtin_amdgcn_mfma_f32_32x32x16_bf16(kf, qf[s], X, 0, 0, 0);
        }
        int Gk[16];
#pragma unroll
        for (int r = 0; r < 16; ++r) Gk[r] = (f2key(X[r]) & ~127) | (mb * 32 + (r & 3) + 8 * (r >> 2) + 4 * hh);
        sort16_desc(Gk);
        if (mb == 0) {
#pragma unroll
          for (int r = 0; r < 16; ++r) A[r] = Gk[r];
        } else merge_top16(A, Gk);
      }
#pragma unroll
      for (int r = 0; r < 16; ++r) Bq[r] = __shfl_xor(A[r], 32);
      merge_top16(A, Bq);
#pragma unroll
      for (int r = 0; r < 16; ++r) { if (c == 0) L0[r] = A[r]; else L1[r] = A[r]; }
    }
    float av[16], bv[16];
#pragma unroll
    for (int r = 0; r < 16; ++r) { av[r] = key2f(L0[r] & ~127); bv[r] = key2f(L1[r] & ~127); }
#define CAND(i_, j_) ((f2key(av[i_] + bv[j_]) & ~255) | ((i_) << 4) | (j_))
    int R[16], G1[16], G2[16];
#pragma unroll
    for (int j = 0; j < 16; ++j) R[j] = CAND(0, j);
    G1[0] = CAND(1, 0); G1[1] = CAND(1, 1); G1[2] = CAND(1, 2); G1[3] = CAND(1, 3); G1[4] = CAND(1, 4); G1[5] = CAND(1, 5); G1[6] = CAND(1, 6); G1[7] = CAND(1, 7);
    G1[8] = CAND(2, 0); G1[9] = CAND(2, 1); G1[10] = CAND(2, 2); G1[11] = CAND(2, 3); G1[12] = CAND(2, 4); G1[13] = CAND(3, 0); G1[14] = CAND(3, 1); G1[15] = CAND(3, 2);
    G2[0] = CAND(3, 3); G2[1] = CAND(4, 0); G2[2] = CAND(4, 1); G2[3] = CAND(4, 2); G2[4] = CAND(5, 0); G2[5] = CAND(5, 1); G2[6] = CAND(6, 0); G2[7] = CAND(6, 1);
    G2[8] = CAND(7, 0); G2[9] = CAND(7, 1); G2[10] = CAND(8, 0); G2[11] = CAND(9, 0); G2[12] = CAND(10, 0); G2[13] = CAND(11, 0); G2[14] = CAND(12, 0); G2[15] = CAND(13, 0);
    sort16_desc(G1); merge_top16(R, G1);
    sort16_desc(G2); merge_top16(R, G2);
    { int x0 = CAND(14, 0), x1 = CAND(15, 0);
#pragma unroll
      for (int i = 0; i < 16; ++i) CASD(R[i], x0)
#pragma unroll
      for (int i = 0; i < 16; ++i) CASD(R[i], x1)
    }
#undef CAND
    int pa0 = 0, pa1 = 0, pa2 = 0, pa3 = 0, pb0 = 0, pb1 = 0, pb2 = 0, pb3 = 0;
#pragma unroll
    for (int q = 0; q < 4; ++q) {
      pa0 |= (L0[q] & 127) << (8 * q); pa1 |= (L0[4 + q] & 127) << (8 * q); pa2 |= (L0[8 + q] & 127) << (8 * q); pa3 |= (L0[12 + q] & 127) << (8 * q);
      pb0 |= (L1[q] & 127) << (8 * q); pb1 |= (L1[4 + q] & 127) << (8 * q); pb2 |= (L1[8 + q] & 127) << (8 * q); pb3 |= (L1[12 + q] & 127) << (8 * q);
    }
    float ev[16], sum = 0.f; int ei[16];
    const float mx = key2f(R[0] & ~255);
#pragma unroll
    for (int z = 0; z < 16; ++z) {
      const float v = key2f(R[z] & ~255);
      ev[z] = __expf(v - mx); sum += ev[z];
      const int pay = R[z] & 255;
      ei[z] = lut4(pa0, pa1, pa2, pa3, pay >> 4) * 128 + lut4(pb0, pb1, pb2, pb3, pay & 15);
    }
    const float inv = 1.0f / sum;
    if (hh == 0) {
      float* go = p.gates() + ((size_t)t * 8 + h) * 16; int* eo = p.eidx() + ((size_t)t * 8 + h) * 16;
#pragma unroll
      for (int z = 0; z < 16; z += 4) {
        *(float4*)(go + z) = make_float4(ev[z] * inv, ev[z + 1] * inv, ev[z + 2] * inv, ev[z + 3] * inv);
        *(int4*)(eo + z) = make_int4(ei[z], ei[z + 1], ei[z + 2], ei[z + 3]);
      }
    }
  }
}


typedef int v8i __attribute__((ext_vector_type(8)));
__device__ __forceinline__ unsigned xcc_id() { return (unsigned)__builtin_amdgcn_s_getreg((3 << 11) | 20) & 7u; }
__device__ __forceinline__ float pow2_scale(float amax) {
  if (!(amax > 0.f)) return 1.0f;
  const int e = (int)floorf(log2f(240.0f / amax));
  return exp2f((float)(e < 60 ? (e > -60 ? e : -60) : 60));
}
__device__ __forceinline__ unsigned pack4_fp8(float a, float b, float c, float d) {
  int v = __builtin_amdgcn_cvt_pk_fp8_f32(a, b, 0, false);
  v = __builtin_amdgcn_cvt_pk_fp8_f32(c, d, v, true);
  return (unsigned)v;
}
__device__ __forceinline__ void cvt_table_i8(const float* __restrict__ src, unsigned char* __restrict__ dst, float* __restrict__ scl, int gw, int ngw, int lane) {
  for (int e0 = gw; e0 < 16384; e0 += 2 * ngw) {
    float4 v[2][4];
#pragma unroll
    for (int u = 0; u < 2; ++u) { const int e = (e0 + u * ngw < 16384) ? e0 + u * ngw : e0;
#pragma unroll
      for (int k = 0; k < 4; ++k) v[u][k] = *(const float4*)(src + (size_t)e * D + k * 256 + lane * 4); }
#pragma unroll
    for (int u = 0; u < 2; ++u) {
      const int e = e0 + u * ngw;
      if (e < 16384) {
        float am = 0.f;
#pragma unroll
        for (int k = 0; k < 4; ++k) am = fmaxf(am, fmaxf(fmaxf(fabsf(v[u][k].x), fabsf(v[u][k].y)), fmaxf(fabsf(v[u][k].z), fabsf(v[u][k].w))));
        am = wave_max(am);
        const float s = am > 0.f ? 127.0f / am : 1.0f;
        if (lane == 0) scl[e] = s;
#pragma unroll
        for (int k = 0; k < 4; ++k) {
          const int slice = 2 * k + (lane >> 5), off = (lane & 31) * 4;
          const unsigned w = (unsigned)(__float2int_rn(v[u][k].x * s) & 255) | ((unsigned)(__float2int_rn(v[u][k].y * s) & 255) << 8) |
                             ((unsigned)(__float2int_rn(v[u][k].z * s) & 255) << 16) | ((unsigned)(__float2int_rn(v[u][k].w * s) & 255) << 24);
          *(unsigned*)(dst + ((size_t)slice * 16384 + e) * 128 + off) = w;
        }
      }
    }
  }
}
__device__ __forceinline__ void cvt_table_fp8(const float* __restrict__ src, unsigned char* __restrict__ dst, float* __restrict__ scl, int gw, int ngw, int lane) {
  for (int e0 = gw; e0 < 16384; e0 += 2 * ngw) {
    float4 v[2][4];
#pragma unroll
    for (int u = 0; u < 2; ++u) { const int e = (e0 + u * ngw < 16384) ? e0 + u * ngw : e0;
#pragma unroll
      for (int k = 0; k < 4; ++k) v[u][k] = *(const float4*)(src + (size_t)e * D + k * 256 + lane * 4); }
#pragma unroll
    for (int u = 0; u < 2; ++u) {
      const int e = e0 + u * ngw;
      if (e < 16384) {
        float am = 0.f;
#pragma unroll
        for (int k = 0; k < 4; ++k) am = fmaxf(am, fmaxf(fmaxf(fabsf(v[u][k].x), fabsf(v[u][k].y)), fmaxf(fabsf(v[u][k].z), fabsf(v[u][k].w))));
        am = wave_max(am);
        const float s = pow2_scale(am);
        if (lane == 0) scl[e] = s;
#pragma unroll
        for (int k = 0; k < 4; ++k) {
          const int slice = 2 * k + (lane >> 5), off = (lane & 31) * 4;
          *(unsigned*)(dst + ((size_t)slice * 16384 + e) * 128 + off) = pack4_fp8(v[u][k].x * s, v[u][k].y * s, v[u][k].z * s, v[u][k].w * s);
        }
      }
    }
  }
}
#define DPP_ADD(v_, ctrl_) ((v_) + __builtin_bit_cast(float, __builtin_amdgcn_update_dpp(0, __builtin_bit_cast(int, (v_)), (ctrl_), 0xF, 0xF, true)))
__device__ __forceinline__ float sum_xor16(float x) { float a = x, b = x; asm volatile("v_nop\n\tv_nop\n\tv_permlane16_swap_b32 %0, %1" : "+v"(a), "+v"(b)); return a + b; }
__device__ __forceinline__ float sum_xor32(float x) { float a = x, b = x; asm volatile("v_nop\n\tv_nop\n\tv_permlane32_swap_b32 %0, %1" : "+v"(a), "+v"(b)); return a + b; }
constexpr int PEER_TILE = 128;
__device__ __forceinline__ void phase_peer_u(const Params& p, int* heads, unsigned char* lds, int tid) {
  const int lane = tid & 63, wv = tid >> 6, r8 = lane >> 3, c8 = lane & 7;
  int* bc = (int*)lds;
  int* eW = (int*)(lds + 1024 + wv * 12288);
  bf16_t* hW = (bf16_t*)(lds + 1024 + wv * 12288 + 8192);
  {
    const int s = (int)blockIdx.x & 7, nbs = ((int)gridDim.x - s + 7) >> 3;
    const unsigned char* Us = p.U8s() + (size_t)s * 16384 * 128 + c8 * 16;
    const int item0 = ((int)blockIdx.x >> 3) * NWAVE + __builtin_amdgcn_readfirstlane(wv), istep = nbs * NWAVE;
    uint2 ev[16]; uint4 hq0, hq1, hq2, hq3;
#define PEER_U_STAGE_E(T0_) { _Pragma("unroll") for (int k = 0; k < 16; ++k) ev[k] = *(const uint2*)(p.eidx() + (size_t)((T0_) + k) * 128 + lane * 2); }
#define PEER_U_STAGE_H(T0_) { const bf16_t* hsrc = p.hb() + ((size_t)s * T + (T0_)) * 128 + lane * 8;     \
        hq0 = *(const uint4*)(hsrc); hq1 = *(const uint4*)(hsrc + 512); hq2 = *(const uint4*)(hsrc + 1024); hq3 = *(const uint4*)(hsrc + 1536); }
    if (item0 < T / 16) { PEER_U_STAGE_E(item0 * 16) PEER_U_STAGE_H(item0 * 16) }
    for (int item = item0; item < T / 16; item += istep) {
      const int t0 = item * 16, t1 = t0 + istep * 16; const bool more = item + istep < T / 16;
      LDS_FENCE();
      {
#pragma unroll
        for (int k = 0; k < 16; ++k) *(uint2*)(eW + k * 128 + lane * 2) = ev[k];
        *(uint4*)(hW + lane * 8) = hq0; *(uint4*)(hW + 512 + lane * 8) = hq1; *(uint4*)(hW + 1024 + lane * 8) = hq2; *(uint4*)(hW + 1536 + lane * 8) = hq3; }
      LDS_FENCE();
      uint4 R[4][8];
#define PEER_U_LOAD(M_, BUF_) { _Pragma("unroll") for (int eb = 0; eb < 8; ++eb) R[BUF_][eb] = *(const uint4*)(Us + (size_t)eW[(M_) * 64 + eb * 8 + r8] * 128); }
      if (!(PROBE_SKIP & 128)) { PEER_U_LOAD(0, 0) PEER_U_LOAD(1, 1) PEER_U_LOAD(2, 2) } else { _Pragma("unroll") for (int a_ = 0; a_ < 4; ++a_) _Pragma("unroll") for (int b_ = 0; b_ < 8; ++b_) R[a_][b_] = make_uint4(0u, 0u, 0u, 0u); }
      int hq[4]; float hinv = 0.f; float res0 = 0.f, res1 = 0.f;
#define PEER_U_LOADH(TOK_) { const bf16_t* hp = hW + (TOK_) * 128 + c8 * 16; const uint4 a = *(const uint4*)hp, b4 = *(const uint4*)(hp + 8); \
        const unsigned w8[8] = {a.x, a.y, a.z, a.w, b4.x, b4.y, b4.z, b4.w}; float hv[16]; float am = 0.f;                               \
        _Pragma("unroll") for (int z = 0; z < 8; ++z) { hv[2 * z] = __uint_as_float(w8[z] << 16); hv[2 * z + 1] = __uint_as_float(w8[z] & 0xffff0000u); \
          am = fmaxf(am, fmaxf(fabsf(hv[2 * z]), fabsf(hv[2 * z + 1]))); }                                                                \
        am = fmaxf(am, __builtin_bit_cast(float, __builtin_amdgcn_update_dpp(0, __builtin_bit_cast(int, am), 0xB1, 0xF, 0xF, true)));     \
        am = fmaxf(am, __builtin_bit_cast(float, __builtin_amdgcn_update_dpp(0, __builtin_bit_cast(int, am), 0x4E, 0xF, 0xF, true)));     \
        am = fmaxf(am, __builtin_bit_cast(float, __builtin_amdgcn_update_dpp(0, __builtin_bit_cast(int, am), 0x141, 0xF, 0xF, true)));    \
        const float hs = am > 0.f ? 127.0f / am : 1.0f; hinv = am > 0.f ? am * (1.0f / 127.0f) : 1.0f;                                    \
        _Pragma("unroll") for (int z = 0; z < 4; ++z) hq[z] = (__float2int_rn(hv[4 * z] * hs) & 255) | ((__float2int_rn(hv[4 * z + 1] * hs) & 255) << 8) | \
                                                               ((__float2int_rn(hv[4 * z + 2] * hs) & 255) << 16) | (__float2int_rn(hv[4 * z + 3] * hs) << 24); }
      PEER_U_LOADH(0)
#define PEER_U_HALF(M_, BUF_, HALF_)                                                                           \
      {                                                                                                                                   \
        if (!(PROBE_SKIP & 128)) { if ((M_) + 3 < 32) PEER_U_LOAD((M_) + 3, ((BUF_) + 3) & 3) }                                             \
        if ((M_) == 29 && more) PEER_U_STAGE_E(t1)                                                                                          \
        if ((M_) == 30 && more) PEER_U_STAGE_H(t1)                                                                                          \
        if (!(PROBE_SKIP & 128)) _Pragma("unroll") for (int eb = 0; eb < 8; ++eb) {                                                       \
          int di = __builtin_amdgcn_sdot4((int)R[BUF_][eb].x, hq[0], 0, false);                                                           \
          di = __builtin_amdgcn_sdot4((int)R[BUF_][eb].y, hq[1], di, false);                                                              \
          di = __builtin_amdgcn_sdot4((int)R[BUF_][eb].z, hq[2], di, false);                                                              \
          di = __builtin_amdgcn_sdot4((int)R[BUF_][eb].w, hq[3], di, false);                                                              \
          di += __builtin_amdgcn_update_dpp(0, di, 0xB1, 0xF, 0xF, true); di += __builtin_amdgcn_update_dpp(0, di, 0x4E, 0xF, 0xF, true);   \
          di += __builtin_amdgcn_update_dpp(0, di, 0x141, 0xF, 0xF, true);     \
          const float d = (float)di * hinv;                                                                                               \
          if ((HALF_) == 0) { if (c8 == eb) res0 = d; } else { if (c8 == eb) res1 = d; }                                                  \
        }                                                                                                                                 \
        if ((HALF_) == 1) {                                                                                                               \
          bf16_t* po = p.ppart() + ((size_t)s * T + t0 + ((M_) >> 1)) * 128;                                                              \
          po[c8 * 8 + r8] = f2bf(res0); po[64 + c8 * 8 + r8] = f2bf(res1);                                                                \
          if ((M_) + 1 < 32) PEER_U_LOADH(((M_) >> 1) + 1)                                                                                \
        }                                                                                                                                 \
      }
#pragma unroll
      for (int m4 = 0; m4 < 32; m4 += 4) {
        PEER_U_HALF(m4, 0, 0) PEER_U_HALF(m4 + 1, 1, 1) PEER_U_HALF(m4 + 2, 2, 0) PEER_U_HALF(m4 + 3, 3, 1)
      }
#undef PEER_U_HALF
#undef PEER_U_LOADH
#undef PEER_U_LOAD
#undef PEER_U_STAGE_E
#undef PEER_U_STAGE_H
    }
  }
}
__device__ __forceinline__ void phase_peer_r(const Params& p, int gtid, int ngt) {
  for (int g0 = gtid; g0 < T * 128 / 8; g0 += 2 * ngt) {
    uint4 pp[2][8]; uint4 ev[2][2]; float4 gv[2][2]; float su_[2][8], sv_[2][8]; float rs[2]; bool ok[2];
#pragma unroll
    for (int u = 0; u < 2; ++u) { const int g = g0 + u * ngt; ok[u] = g < T * 128 / 8; const size_t ix = ok[u] ? (size_t)g * 8 : 0;
#pragma unroll
      for (int s = 0; s < 8; ++s) pp[u][s] = *(const uint4*)(p.ppart() + (size_t)s * T * 128 + ix);
      ev[u][0] = *(const uint4*)(p.eidx() + ix); ev[u][1] = *(const uint4*)(p.eidx() + ix + 4);
      gv[u][0] = *(const float4*)(p.gates() + ix); gv[u][1] = *(const float4*)(p.gates() + ix + 4);
      rs[u] = p.rstd()[ix >> 7]; }
#pragma unroll
    for (int u = 0; u < 2; ++u) { const int e8[8] = {(int)ev[u][0].x, (int)ev[u][0].y, (int)ev[u][0].z, (int)ev[u][0].w, (int)ev[u][1].x, (int)ev[u][1].y, (int)ev[u][1].z, (int)ev[u][1].w};
#pragma unroll
      for (int k = 0; k < 8; ++k) { su_[u][k] = p.su()[e8[k]]; sv_[u][k] = p.sv()[e8[k]]; } }
#pragma unroll
    for (int u = 0; u < 2; ++u) if (ok[u]) {
      float d[8];
#pragma unroll
      for (int k = 0; k < 8; ++k) d[k] = 0.f;
#pragma unroll
      for (int s = 0; s < 8; ++s) { const unsigned w[4] = {pp[u][s].x, pp[u][s].y, pp[u][s].z, pp[u][s].w};
#pragma unroll
        for (int q = 0; q < 4; ++q) { d[2 * q] += __uint_as_float(w[q] << 16); d[2 * q + 1] += __uint_as_float(w[q] & 0xffff0000u); } }
      const float gg[8] = {gv[u][0].x, gv[u][0].y, gv[u][0].z, gv[u][0].w, gv[u][1].x, gv[u][1].y, gv[u][1].z, gv[u][1].w};
      float o[8];
#pragma unroll
      for (int k = 0; k < 8; ++k) o[k] = gg[k] * gelu_tanh(d[k] * rs[u] / su_[u][k]) / sv_[u][k];
      float* dst = p.gates() + (size_t)(g0 + u * ngt) * 8;
      *(float4*)dst = make_float4(o[0], o[1], o[2], o[3]); *(float4*)(dst + 4) = make_float4(o[4], o[5], o[6], o[7]);
    }
  }
}
__device__ __forceinline__ void phase_peer_v(const Params& p, int* heads, unsigned char* lds, int tid) {
  const int lane = tid & 63, wv = tid >> 6, r8 = lane >> 3, c8 = lane & 7;
  int* bc = (int*)lds;
  uint2* pW = (uint2*)(lds + 1024 + wv * 16384);
  {
    const int s = (int)blockIdx.x & 7, nbs = ((int)gridDim.x - s + 7) >> 3;
    const unsigned char* Vs = p.V8s() + (size_t)s * 16384 * 128 + c8 * 16;
    const int item0 = ((int)blockIdx.x >> 3) * NWAVE + __builtin_amdgcn_readfirstlane(wv), istep = nbs * NWAVE;
    uint2 e2[16], g2[16];
#define PEER_V_STAGE_E(T0_) { _Pragma("unroll") for (int k = 0; k < 16; ++k) e2[k] = *(const uint2*)(p.eidx() + (size_t)((T0_) + k) * 128 + lane * 2); }
#define PEER_V_STAGE_G(T0_) { _Pragma("unroll") for (int k = 0; k < 16; ++k) g2[k] = *(const uint2*)(p.gates() + (size_t)((T0_) + k) * 128 + lane * 2); }
    if (item0 < T / 16) { PEER_V_STAGE_E(item0 * 16) PEER_V_STAGE_G(item0 * 16) }
    for (int item = item0; item < T / 16; item += istep) {
      const int t0 = item * 16, t1 = t0 + istep * 16; const bool more = item + istep < T / 16;
      LDS_FENCE();
      {
#pragma unroll
        for (int k = 0; k < 16; ++k) *(uint4*)(pW + k * 128 + lane * 2) = make_uint4(e2[k].x, g2[k].x, e2[k].y, g2[k].y); }
      LDS_FENCE();
      const int rowk = lane >> 4, prow = ((rowk & 1) << 1) | (rowk >> 1);
      const bool wr_lane = (lane & 8) == 0;
      const int xoff = s * 128 + c8 * 16 + prow * 4;
      float4 xo[8];
#pragma unroll
      for (int k = 0; k < 8; ++k) xo[k] = *(const float4*)(p.outp() + (size_t)(t0 + k) * D + xoff);
      uint4 R[3][8];
#define PEER_V_LOAD(M_, BUF_) { _Pragma("unroll") for (int eb = 0; eb < 8; ++eb) R[BUF_][eb] = *(const uint4*)(Vs + (size_t)pW[(M_) * 64 + eb * 8 + r8].x * 128); }
      if (!(PROBE_SKIP & 64)) { PEER_V_LOAD(0, 0) PEER_V_LOAD(1, 1) } else { _Pragma("unroll") for (int a_ = 0; a_ < 3; ++a_) _Pragma("unroll") for (int b_ = 0; b_ < 8; ++b_) R[a_][b_] = make_uint4(0u, 0u, 0u, 0u); }
      float acc[16];
#define PEER_V_HALF(M_, BUF_, HALF_)                                                           \
      {                                                                                                                                   \
        if (!(PROBE_SKIP & 64)) { if ((M_) + 2 < 32) PEER_V_LOAD((M_) + 2, ((BUF_) + 2) % 3) }                                              \
        if ((M_) == 30 && more) PEER_V_STAGE_E(t1)                                                                                          \
        if ((M_) == 31 && more) PEER_V_STAGE_G(t1)                                                                                          \
        if ((HALF_) == 0) { _Pragma("unroll") for (int z = 0; z < 16; ++z) acc[z] = 0.f; }                                                \
        if (!(PROBE_SKIP & 64)) _Pragma("unroll") for (int eb = 0; eb < 8; ++eb) {                                                        \
          const float c = __uint_as_float(pW[(M_) * 64 + eb * 8 + r8].y);                                                                 \
          const unsigned ww[4] = {R[BUF_][eb].x, R[BUF_][eb].y, R[BUF_][eb].z, R[BUF_][eb].w};                                            \
          _Pragma("unroll") for (int q4 = 0; q4 < 4; ++q4) {                                                                              \
            const auto f01 = __builtin_amdgcn_cvt_pk_f32_fp8((int)ww[q4], false); const auto f23 = __builtin_amdgcn_cvt_pk_f32_fp8((int)ww[q4], true); \
            acc[q4 * 4 + 0] = fmaf(c, f01[0], acc[q4 * 4 + 0]); acc[q4 * 4 + 1] = fmaf(c, f01[1], acc[q4 * 4 + 1]);                       \
            acc[q4 * 4 + 2] = fmaf(c, f23[0], acc[q4 * 4 + 2]); acc[q4 * 4 + 3] = fmaf(c, f23[1], acc[q4 * 4 + 3]);                       \
          }                                                                                                                               \
        }                                                                                                                                 \
        if ((HALF_) == 1) {                                                                                                               \
          _Pragma("unroll") for (int z = 0; z < 16; ++z) acc[z] = DPP_ADD(acc[z], 0x128);                                  \
          asm volatile("v_nop\n\tv_nop\n\tv_permlane16_swap_b32 %0, %8\n\tv_permlane16_swap_b32 %1, %9\n\tv_permlane16_swap_b32 %2, %10\n\tv_permlane16_swap_b32 %3, %11\n\t" \
                       "v_permlane16_swap_b32 %4, %12\n\tv_permlane16_swap_b32 %5, %13\n\tv_permlane16_swap_b32 %6, %14\n\tv_permlane16_swap_b32 %7, %15" \
            : "+v"(acc[0]), "+v"(acc[1]), "+v"(acc[2]), "+v"(acc[3]), "+v"(acc[4]), "+v"(acc[5]), "+v"(acc[6]), "+v"(acc[7]),                   \
              "+v"(acc[8]), "+v"(acc[9]), "+v"(acc[10]), "+v"(acc[11]), "+v"(acc[12]), "+v"(acc[13]), "+v"(acc[14]), "+v"(acc[15]));               \
          _Pragma("unroll") for (int z = 0; z < 8; ++z) acc[z] += acc[z + 8];            \
          asm volatile("v_nop\n\tv_nop\n\tv_permlane32_swap_b32 %0, %4\n\tv_permlane32_swap_b32 %1, %5\n\tv_permlane32_swap_b32 %2, %6\n\tv_permlane32_swap_b32 %3, %7" \
            : "+v"(acc[0]), "+v"(acc[1]), "+v"(acc[2]), "+v"(acc[3]), "+v"(acc[4]), "+v"(acc[5]), "+v"(acc[6]), "+v"(acc[7]));                   \
          float4 dl;                                                                                                                      \
          dl.x = acc[0] + acc[4]; dl.y = acc[1] + acc[5]; dl.z = acc[2] + acc[6]; dl.w = acc[3] + acc[7];     \
          const float4 xv = xo[((M_) >> 1) & 7];                                                                                          \
          if (((M_) >> 1) + 8 < 16) xo[((M_) >> 1) & 7] = *(const float4*)(p.outp() + (size_t)(t0 + ((M_) >> 1) + 8) * D + xoff);                  \
          const float4 xn = make_float4(xv.x + dl.x, xv.y + dl.y, xv.z + dl.z, xv.w + dl.w);                                              \
          float sq = 0.f;                                                                                                                 \
          if (wr_lane) {                                                                                                                  \
            *(float4*)(p.outp() + (size_t)(t0 + ((M_) >> 1)) * D + xoff) = xn;                                                             \
            *(uint2*)(p.xb() + (size_t)(t0 + ((M_) >> 1)) * KD + xoff) = make_uint2(pk_bf16(xn.x, xn.y), pk_bf16(xn.z, xn.w));     \
            sq = (xn.x * xn.x + xn.y * xn.y) + (xn.z * xn.z + xn.w * xn.w);                                                                \
          }                                                                                                                               \
          sq = DPP_ADD(sq, 0xB1); sq = DPP_ADD(sq, 0x4E); sq = DPP_ADD(sq, 0x141); sq = DPP_ADD(sq, 0x128); sq = sum_xor16(sq); sq = sum_xor32(sq);     \
          if (lane == 0) p.ssq1()[(size_t)(t0 + ((M_) >> 1)) * 8 + s] = sq;                                                               \
        }                                                                                                                                 \
      }
#pragma unroll
      for (int m6 = 0; m6 < 30; m6 += 6) {
        PEER_V_HALF(m6, 0, 0) PEER_V_HALF(m6 + 1, 1, 1) PEER_V_HALF(m6 + 2, 2, 0) PEER_V_HALF(m6 + 3, 0, 1) PEER_V_HALF(m6 + 4, 1, 0) PEER_V_HALF(m6 + 5, 2, 1)
      }
      PEER_V_HALF(30, 0, 0) PEER_V_HALF(31, 1, 1)
#undef PEER_V_HALF
#undef PEER_V_LOAD
#undef PEER_V_STAGE_E
#undef PEER_V_STAGE_G
    }
  }
}

#if PEER_CHECK
constexpr int CHK_N = 512;
__device__ __forceinline__ float* chk_x(const Params& p) { return (float*)(p.ws + WO_ybuf); }
__device__ __forceinline__ float* chk_m(const Params& p) { return (float*)(p.ws + WO_ybuf + (size_t)CHK_N * D * 4); }
__device__ __forceinline__ float* chk_g(const Params& p) { return (float*)(p.ws + WO_ybuf + (size_t)CHK_N * D * 4 + 4096); }
__device__ __forceinline__ void chk_save(const Params& p, int gtid, int ngt) {
  for (int i = gtid; i < CHK_N * D; i += ngt) chk_x(p)[i] = p.outp()[(size_t)(i / D) * 64 * D + (i % D)];
  for (int i = gtid; i < CHK_N * 128; i += ngt) chk_g(p)[i] = p.gates()[(size_t)(i / 128) * 64 * 128 + (i % 128)];
  if (gtid < 16) chk_m(p)[gtid] = 0.f;
}
__device__ __forceinline__ void chk_apply(const Params& p, int l, float* coef, int gw, int ngw, int lane) {
  const float* g2 = p.inp(16) + l * D;
  const float* U = p.inp(19) + (size_t)l * 16384 * D; const float* V = p.inp(20) + (size_t)l * 16384 * D;
  for (int i = gw; i < CHK_N; i += ngw) {
    const int t = i * 64;
    const float r = p.rstd()[t];
    float4 hv[4];
#pragma unroll
    for (int k = 0; k < 4; ++k) {
      float4 xv = *(const float4*)(chk_x(p) + (size_t)i * D + (lane + k * 64) * 4);
      float4 gv = *(const float4*)(g2 + (lane + k * 64) * 4);
      hv[k].x = xv.x * r * gv.x; hv[k].y = xv.y * r * gv.y; hv[k].z = xv.z * r * gv.z; hv[k].w = xv.w * r * gv.w;
    }
    LDS_FENCE();
    for (int j = 0; j < 128; ++j) {
      const int e = p.eidx()[(size_t)t * 128 + j];
      const float4* up = (const float4*)(U + (size_t)e * D);
      float dsum = 0.f;
#pragma unroll
      for (int k = 0; k < 4; ++k) { float4 uv = up[lane + k * 64]; dsum += hv[k].x * uv.x + hv[k].y * uv.y + hv[k].z * uv.z + hv[k].w * uv.w; }
      dsum = wave_sum(dsum);
      if (lane == 0) coef[j] = chk_g(p)[(size_t)i * 128 + j] * gelu_tanh(dsum);
    }
    LDS_FENCE();
    float4 acc[4];
#pragma unroll
    for (int k = 0; k < 4; ++k) acc[k] = make_float4(0.f, 0.f, 0.f, 0.f);
    for (int j = 0; j < 128; ++j) {
      const int e = p.eidx()[(size_t)t * 128 + j];
      const float c = coef[j];
      const float4* vp = (const float4*)(V + (size_t)e * D);
#pragma unroll
      for (int k = 0; k < 4; ++k) { float4 vv = vp[lane + k * 64]; acc[k].x = fmaf(c, vv.x, acc[k].x); acc[k].y = fmaf(c, vv.y, acc[k].y); acc[k].z = fmaf(c, vv.z, acc[k].z); acc[k].w = fmaf(c, vv.w, acc[k].w); }
    }
    float d2 = 0.f, r2 = 0.f;
#pragma unroll
    for (int k = 0; k < 4; ++k) {
      float4 xa = *(const float4*)(p.outp() + (size_t)t * D + (lane + k * 64) * 4);
      float4 xb4 = *(const float4*)(chk_x(p) + (size_t)i * D + (lane + k * 64) * 4);
      float e0 = (xa.x - xb4.x) - acc[k].x, e1 = (xa.y - xb4.y) - acc[k].y, e2 = (xa.z - xb4.z) - acc[k].z, e3 = (xa.w - xb4.w) - acc[k].w;
      d2 += e0 * e0 + e1 * e1 + e2 * e2 + e3 * e3;
      r2 += acc[k].x * acc[k].x + acc[k].y * acc[k].y + acc[k].z * acc[k].z + acc[k].w * acc[k].w;
    }
    d2 = wave_sum(d2); r2 = wave_sum(r2);
    if (lane == 0) { atomicAdd((unsigned long long*)&chk_m(p)[8], (unsigned long long)(d2 * 1099511627776.0f)); atomicAdd((unsigned long long*)&chk_m(p)[10], (unsigned long long)(r2 * 1099511627776.0f)); }
  }
}
__device__ __forceinline__ void chk_topk(const Params& p, int l, int gtid, int ngt) {
  const float* subk = p.inp(18) + (size_t)l * 16 * 128 * 64;
  for (int it = gtid; it < CHK_N * 8; it += ngt) {
    const int i = it >> 3, h = it & 7, t = i * 64;
    float tva[16], tvb[16]; int tia[16], tib[16];
#pragma unroll 1
    for (int c = 0; c < 2; ++c) {
      float tv[16]; int ti[16];
#pragma unroll
      for (int z = 0; z < 16; ++z) { tv[z] = -INFINITY; ti[z] = 0; }
      const bf16_t* q = p.qb() + (size_t)t * D + (2 * h + c) * 64;
      const float* kb = subk + (size_t)(2 * h + c) * 128 * 64;
#pragma unroll 1
      for (int n = 0; n < 128; ++n) {
        float sc = 0.f;
        for (int d = 0; d < 64; ++d) sc = fmaf(bf2f(q[d]), kb[n * 64 + d], sc);
        float v_ = sc; int i_ = n;
#pragma unroll
        for (int z = 0; z < 16; ++z) { bool gt = v_ > tv[z]; float a = tv[z]; int b = ti[z]; tv[z] = gt ? v_ : a; ti[z] = gt ? i_ : b; v_ = gt ? a : v_; i_ = gt ? b : i_; }
      }
#pragma unroll
      for (int z = 0; z < 16; ++z) { if (c == 0) { tva[z] = tv[z]; tia[z] = ti[z]; } else { tvb[z] = tv[z]; tib[z] = ti[z]; } }
    }
    float tv[16]; int ti[16];
#pragma unroll
    for (int z = 0; z < 16; ++z) { tv[z] = -INFINITY; ti[z] = 0; }
#pragma unroll 1
    for (int a = 0; a < 16; ++a)
#pragma unroll 1
      for (int b = 0; b < 16; ++b) {
        float av = 0.f, bv = 0.f; int ai = 0, bi = 0;
#pragma unroll
        for (int z = 0; z < 16; ++z) { if (z == a) { av = tva[z]; ai = tia[z]; } if (z == b) { bv = tvb[z]; bi = tib[z]; } }
        float v_ = av + bv; int i_ = ai * 128 + bi;
#pragma unroll
        for (int z = 0; z < 16; ++z) { bool gt = v_ > tv[z]; float x = tv[z]; int y = ti[z]; tv[z] = gt ? v_ : x; ti[z] = gt ? i_ : y; v_ = gt ? x : v_; i_ = gt ? y : i_; }
      }
    float sum = 0.f, ev[16];
#pragma unroll
    for (int z = 0; z < 16; ++z) { ev[z] = expf(tv[z] - tv[0]); sum += ev[z]; }
    int miss = 0; float gerr = 0.f;
    for (int z = 0; z < 16; ++z) {
      const int ef = p.eidx()[((size_t)t * 8 + h) * 16 + z]; const float gf = p.gates()[((size_t)t * 8 + h) * 16 + z];
      bool found = false;
#pragma unroll
      for (int y = 0; y < 16; ++y) if (ti[y] == ef) { found = true; gerr = fmaxf(gerr, fabsf(ev[y] / sum - gf)); }
      if (!found) ++miss;
    }
    atomicAdd(&chk_m(p)[3], (float)miss);
    atomicMax((int*)&chk_m(p)[4], __float_as_int(gerr));
  }
}
__device__ __forceinline__ void chk_emit(const Params& p) {
  float v = 0.f;
  if (PEER_CHECK == 1) v = sqrtf((float)((double)*(unsigned long long*)&chk_m(p)[8] / (double)*(unsigned long long*)&chk_m(p)[10]));
  if (PEER_CHECK == 2) v = chk_m(p)[3] / (float)(CHK_N * 8 * 16);
  if (PEER_CHECK == 3) v = chk_m(p)[4];
  p.outp()[0] += 1.0e4f * v + 100.0f;
}
#endif

#define XB_TMO      128
#define XB_XCNT(j)  (256  + 64 * (j))
#define XB_XSUB(j)  (1280 + 64 * (j))
#define XB_XGEN(j)  (2304 + 64 * (j))
#define XB_TOP      3328
#define XB_TOPGEN   3392
#define XCD_BAR_WORDS 3456
#define XB_SPIN_CAP (1u << 18)
#define LAS __attribute__((address_space(3)))

__device__ __forceinline__ unsigned xb_ld(unsigned* p)              { return __hip_atomic_load(p, __ATOMIC_RELAXED, __HIP_MEMORY_SCOPE_AGENT); }
__device__ __forceinline__ unsigned xb_add(unsigned* p, unsigned v) { return __hip_atomic_fetch_add(p, v, __ATOMIC_RELAXED, __HIP_MEMORY_SCOPE_AGENT); }
__device__ __forceinline__ unsigned xb_xcc_id() { return (unsigned)__builtin_amdgcn_s_getreg((3 << 11) | 20) & 0xFu; }
#define XB_SPIN(cond, bar) do { unsigned _sp = 0; while (cond) { __builtin_amdgcn_s_sleep(1); \
    if ((++_sp & 255u) == 0u) { if (xb_ld(&(bar)[XB_TMO])) break; if (_sp > XB_SPIN_CAP) { atomicAdd(&(bar)[XB_TMO], 1u); break; } } } } while (0)

struct XcdBarrier {
    unsigned* bar; unsigned x;
    volatile LAS unsigned* st;
};

__device__ __forceinline__ XcdBarrier xcd_barrier_post(unsigned* bar, volatile LAS unsigned* st) {
    XcdBarrier b; b.bar = bar; b.x = xb_xcc_id(); b.st = st;
    if (threadIdx.x == 0) (void)xb_add(&bar[XB_XCNT(b.x)], 1u);
    return b;
}
__device__ __forceinline__ void xcd_barrier_complete(unsigned* bar, unsigned x, unsigned& nloc, unsigned& nx) {
    const unsigned G = gridDim.x * gridDim.y * gridDim.z;
    unsigned sum, cnt, mine, sp = 0u;
    for (;;) {
        sum = 0u; cnt = 0u; mine = 0u;
#pragma unroll
        for (unsigned j = 0; j < 16; ++j) { const unsigned c = xb_ld(&bar[XB_XCNT(j)]); sum += c; cnt += (c > 0u) ? 1u : 0u; mine = (j == x) ? c : mine; }
        if (sum == G) break;
        __builtin_amdgcn_s_sleep(1);
        if ((++sp & 255u) == 0u) { if (xb_ld(&bar[XB_TMO])) break; if (sp > XB_SPIN_CAP) { atomicAdd(&bar[XB_TMO], 1u); break; } }
    }
    nloc = mine > 0u ? mine : 1u; nx = cnt > 0u ? cnt : 1u;
}

__device__ __forceinline__ void xcd_barrier(const XcdBarrier& b) {
    asm volatile("s_waitcnt vmcnt(0)" ::: "memory");
    __syncthreads();
    if (threadIdx.x == 0) {
        unsigned* bar = b.bar;
        __builtin_amdgcn_s_waitcnt(0);
        unsigned nloc = b.st[0], nx = b.st[1];
        if (nloc == 0u) { xcd_barrier_complete(bar, b.x, nloc, nx); b.st[0] = nloc; b.st[1] = nx; }
        const unsigned old = xb_add(&bar[XB_XSUB(b.x)], 1u);
        const unsigned gen = old / nloc;
        if (old + 1u == (gen + 1u) * nloc) {
            __builtin_amdgcn_fence(__ATOMIC_RELEASE, "agent");
            asm volatile("s_waitcnt vmcnt(0)" ::: "memory");
            const unsigned og = xb_add(&bar[XB_TOP], 1u);
            const unsigned tg = og / nx;
            if (og + 1u == (tg + 1u) * nx) xb_add(&bar[XB_TOPGEN], 1u);
            else XB_SPIN(xb_ld(&bar[XB_TOPGEN]) == tg, bar);
            __builtin_amdgcn_fence(__ATOMIC_ACQUIRE, "agent");
            xb_add(&bar[XB_XGEN(b.x)], 1u);
            asm volatile("s_waitcnt vmcnt(0)" ::: "memory");
        } else {
            XB_SPIN(xb_ld(&bar[XB_XGEN(b.x)]) == gen, bar);
            __builtin_amdgcn_fence(__ATOMIC_ACQUIRE, "agent");
            asm volatile("s_waitcnt vmcnt(0)" ::: "memory");
        }
    }
    __syncthreads();
}

__device__ __forceinline__ Params fresh(const Params& p) {
  Params q = p;
  asm volatile("" : "+s"(q.ws), "+s"(q.out_));
#pragma unroll
  for (int i = 0; i < 21; ++i) asm volatile("" : "+s"(q.in[i]));
  return q;
}
#define PHASE_IDS int tid = threadIdx.x; asm volatile("" : "+v"(tid)); int bid = blockIdx.x; asm volatile("" : "+s"(bid)); int G = gridDim.x; asm volatile("" : "+s"(G)); \
  const int lane = tid & 63, wv = tid >> 6; const int ngt = G * NTHR, ngw = G * NWAVE; \
  const int gtid = bid * NTHR + tid, gw = bid * NWAVE + wv; (void)lane; (void)wv; (void)gtid; (void)gw; (void)ngt; (void)ngw; \
  const Params q = fresh(p);
__global__ void __launch_bounds__(NTHR) mega(Params p) {
  extern __shared__ __attribute__((aligned(16))) unsigned char lds_raw[];
  cg::grid_group grid = cg::this_grid();
  float* ldsf = (float*)lds_raw;
  if (threadIdx.x == 0) { *(uint4*)(lds_raw + LDS_BYTES - 16) = make_uint4(0u, 0u, 0u, 0u); }
  __syncthreads();
  XcdBarrier xb = xcd_barrier_post(p.bar(), (volatile LAS unsigned*)(lds_raw + LDS_BYTES - 16));

  { PHASE_IDS; phase_prologue(q, gtid, ngt, gw, ngw, lane); cvt_f32_bf16(q.inp(18), q.skb(), (size_t)NL * 16 * 128 * 64 / 8, gtid, ngt);
    for (size_t i = gtid; i < (size_t)16 * 128 * 512 / 8; i += ngt) { const size_t g = i / (128 * 512 / 8), r = i % (128 * 512 / 8); ((uint4*)q.S5Wz())[g * (256 * 512 / 8) + (128 * 512 / 8) + r] = make_uint4(0u, 0u, 0u, 0u); }
    if (gtid < 256) q.qctr()[gtid] = 0;
    phase_s5_prep(q, 0, gtid, ngt); }
  grid.sync();
  { constexpr int l = 0;
    DUP(5) {
    { const Params q = fresh(p);
      EpiInProj e{q.ssq1(), q.S5A(), q.Qm(), q.Km(), q.vrow(), q.Qr(), q.Kr(), q.krow(), q.vrrow(), q.grow(),
                  q.inp(12) + l * 64, q.inp(13) + l * 64, q.cosm(), q.sinm(), q.cosr(), q.sinr()};
      run_gemm(lds_raw, q.xb(), q.Win_t() + (size_t)l * INW * KD, T, INW, KD, e); }
    { PHASE_IDS;
      const int ntile = (T / 256) * (INW / 256), nlast = ntile - ((ntile + G - 1) / G - 1) * G;
      (void)nlast; }
    xcd_barrier(xb);
    }
    DUP(1) {
    { PHASE_IDS; const bool split = G >= 128; const int g2 = split ? gtid - 64 * NTHR : gtid, n2 = split ? ngt - 64 * NTHR : ngt;
      if (!split || bid >= 64) { phase_post_pack(q, g2, n2); phase_kmean2(q, g2, n2); } }
    { const Params q = fresh(p); EpiS5Z e{q.S5Z()};
      pg8::Gemm g{q.S5A(), q.S5Wz(), 16 * 1024, 16 * 256, 512, 640, 512}; pg8::GroupOrder So; So.init(16, 4, 1, (int)gridDim.x, (int)blockIdx.x);
      pg8::gemm_phase<EpiS5Z, pg8::GroupOrder, true, true>((PG8_LAS unsigned char*)lds_raw, g, So, e); }
    xcd_barrier(xb);
    }
    DUP(2) {
    { PHASE_IDS; phase_s5_scan(q, gtid, ngt); phase_ret_kv(q, gw, ngw, lane); }
    __syncthreads();
    { PHASE_IDS; phase_moba2(q, l, lds_raw, q.qctr() + 64 + l); }
    xcd_barrier(xb);
    }
    DUP(3) {
    { const Params q = fresh(p); EpiS5Y e{q.ygb(), q.S5A(), q.inp(10) + l * 256};
      pg8::Gemm g{q.S5A(), q.S5Wy(), 16 * 1024, 16 * 512, 640, 640, 640}; pg8::GroupOrder So; So.init(16, 4, 2, (int)gridDim.x, (int)blockIdx.x);
      pg8::gemm_phase<EpiS5Y, pg8::GroupOrder, true, true>((PG8_LAS unsigned char*)lds_raw, g, So, e); }
    { PHASE_IDS; phase_ret_scan(q, gtid, ngt);
      if (G >= 256 && bid >= 128) cvt_table_fp8(q.inp(20) + (size_t)l * 16384 * D, q.V8s(), q.sv(), gw - 128 * NWAVE, ngw - 128 * NWAVE, lane); }
    xcd_barrier(xb);
    }
    DUP(4) {
    { const Params q = fresh(p); EpiGlu e{q.xb(), q.ygb(), (float*)(lds_raw + 131072)};
      run_gemm(lds_raw, q.ygb(), q.Wglu_t() + (size_t)l * 65536, T, 256, 256, e); }
    { PHASE_IDS; phase_ret_out(q, gw, ngw, lane);
      if (G >= 256 && bid >= 128) cvt_table_i8(q.inp(19) + (size_t)l * 16384 * D, q.U8s(), q.su(), gw - 128 * NWAVE, ngw - 128 * NWAVE, lane); }
    xcd_barrier(xb);
    }
    { PHASE_IDS; const int ntile = (T / 256) * (INW / 256), nlast = ntile - ((ntile + G - 1) / G - 1) * G;
      (void)nlast; if (!(G >= 256)) cvt_table_i8(q.inp(19) + (size_t)l * 16384 * D, q.U8s(), q.su(), gw, ngw, lane);
      if (!(G >= 256)) cvt_table_fp8(q.inp(20) + (size_t)l * 16384 * D, q.V8s(), q.sv(), gw, ngw, lane); }
    __syncthreads();
    { const Params q = fresh(p); EpiResid e{q.outp(), D, q.xb2(), q.hb(), q.inp(16) + l * D, q.ssq2(), l == 0 ? q.inp(0) : (const float*)q.outp()};
      run_gemm(lds_raw, q.xb(), q.Wout_t() + (size_t)l * D * KD, T, D, KD, e); }
    xcd_barrier(xb);
    DUP(7) {
    { const Params q = fresh(p); EpiScaleStoreBf16 e{q.qb(), D, q.ssq2(), 16, q.rstd()};
      run_gemm(lds_raw, q.xb2(), q.Wq_t() + (size_t)l * D * KD, T, D, KD, e); }
    xcd_barrier(xb);
    }
    if (!(PROBE_SKIP & 2)) {
    DUP(8) {
    { PHASE_IDS; phase_peer_topk(q, l, gw, ngw, lane); }
    xcd_barrier(xb);
    }
    }
#if PEER_CHECK
    if (l == 0) { { PHASE_IDS; chk_save(q, gtid, ngt); } xcd_barrier(xb); { PHASE_IDS; chk_topk(q, l, gtid, ngt); } xcd_barrier(xb); }
#endif
    if (!(PROBE_SKIP & 1)) {
    { PHASE_IDS; phase_peer_u(q, q.qctr() + (l * 2 + 0) * 8, lds_raw, tid); }
    xcd_barrier(xb);
    { PHASE_IDS; phase_peer_r(q, gtid, ngt); if (l + 1 < NL) phase_s5_prep(q, l + 1, gtid, ngt); }
    xcd_barrier(xb);
    if (!(PROBE_SKIP & 32)) {
    { PHASE_IDS; phase_peer_v(q, q.qctr() + (l * 2 + 1) * 8, lds_raw, tid); }
    xcd_barrier(xb);
    }
    }
#if PEER_CHECK
    if (l == 0) { { PHASE_IDS; chk_apply(q, l, ldsf + wv * 128, gw, ngw, lane); } xcd_barrier(xb);
      if (blockIdx.x == 0 && threadIdx.x == 0) { const Params q = fresh(p); chk_emit(q); } xcd_barrier(xb); }
#endif
  }
  { constexpr int l = 1;
    DUP(5) {
    { const Params q = fresh(p);
      EpiInProj e{q.ssq1(), q.S5A(), q.Qm(), q.Km(), q.vrow(), q.Qr(), q.Kr(), q.krow(), q.vrrow(), q.grow(),
                  q.inp(12) + l * 64, q.inp(13) + l * 64, q.cosm(), q.sinm(), q.cosr(), q.sinr()};
      run_gemm(lds_raw, q.xb(), q.Win_t() + (size_t)l * INW * KD, T, INW, KD, e); }
    { PHASE_IDS;
      const int ntile = (T / 256) * (INW / 256), nlast = ntile - ((ntile + G - 1) / G - 1) * G;
      (void)nlast; }
    xcd_barrier(xb);
    }
    DUP(1) {
    { PHASE_IDS; const bool split = G >= 128; const int g2 = split ? gtid - 64 * NTHR : gtid, n2 = split ? ngt - 64 * NTHR : ngt;
      if (!split || bid >= 64) { phase_post_pack(q, g2, n2); phase_kmean2(q, g2, n2); } }
    { const Params q = fresh(p); EpiS5Z e{q.S5Z()};
      pg8::Gemm g{q.S5A(), q.S5Wz(), 16 * 1024, 16 * 256, 512, 640, 512}; pg8::GroupOrder So; So.init(16, 4, 1, (int)gridDim.x, (int)blockIdx.x);
      pg8::gemm_phase<EpiS5Z, pg8::GroupOrder, true, true>((PG8_LAS unsigned char*)lds_raw, g, So, e); }
    xcd_barrier(xb);
    }
    DUP(2) {
    { PHASE_IDS; phase_s5_scan(q, gtid, ngt); phase_ret_kv(q, gw, ngw, lane); }
    __syncthreads();
    { PHASE_IDS; phase_moba2(q, l, lds_raw, q.qctr() + 64 + l); }
    xcd_barrier(xb);
    }
    DUP(3) {
    { const Params q = fresh(p); EpiS5Y e{q.ygb(), q.S5A(), q.inp(10) + l * 256};
      pg8::Gemm g{q.S5A(), q.S5Wy(), 16 * 1024, 16 * 512, 640, 640, 640}; pg8::GroupOrder So; So.init(16, 4, 2, (int)gridDim.x, (int)blockIdx.x);
      pg8::gemm_phase<EpiS5Y, pg8::GroupOrder, true, true>((PG8_LAS unsigned char*)lds_raw, g, So, e); }
    { PHASE_IDS; phase_ret_scan(q, gtid, ngt);
      if (G >= 256 && bid >= 128) cvt_table_fp8(q.inp(20) + (size_t)l * 16384 * D, q.V8s(), q.sv(), gw - 128 * NWAVE, ngw - 128 * NWAVE, lane); }
    xcd_barrier(xb);
    }
    DUP(4) {
    { const Params q = fresh(p); EpiGlu e{q.xb(), q.ygb(), (float*)(lds_raw + 131072)};
      run_gemm(lds_raw, q.ygb(), q.Wglu_t() + (size_t)l * 65536, T, 256, 256, e); }
    { PHASE_IDS; phase_ret_out(q, gw, ngw, lane);
      if (G >= 256 && bid >= 128) cvt_table_i8(q.inp(19) + (size_t)l * 16384 * D, q.U8s(), q.su(), gw - 128 * NWAVE, ngw - 128 * NWAVE, lane); }
    xcd_barrier(xb);
    }
    { PHASE_IDS; const int ntile = (T / 256) * (INW / 256), nlast = ntile - ((ntile + G - 1) / G - 1) * G;
      (void)nlast; if (!(G >= 256)) cvt_table_i8(q.inp(19) + (size_t)l * 16384 * D, q.U8s(), q.su(), gw, ngw, lane);
      if (!(G >= 256)) cvt_table_fp8(q.inp(20) + (size_t)l * 16384 * D, q.V8s(), q.sv(), gw, ngw, lane); }
    __syncthreads();
    { const Params q = fresh(p); EpiResid e{q.outp(), D, q.xb2(), q.hb(), q.inp(16) + l * D, q.ssq2(), l == 0 ? q.inp(0) : (const float*)q.outp()};
      run_gemm(lds_raw, q.xb(), q.Wout_t() + (size_t)l * D * KD, T, D, KD, e); }
    xcd_barrier(xb);
    DUP(7) {
    { const Params q = fresh(p); EpiScaleStoreBf16 e{q.qb(), D, q.ssq2(), 16, q.rstd()};
      run_gemm(lds_raw, q.xb2(), q.Wq_t() + (size_t)l * D * KD, T, D, KD, e); }
    xcd_barrier(xb);
    }
    if (!(PROBE_SKIP & 2)) {
    DUP(8) {
    { PHASE_IDS; phase_peer_topk(q, l, gw, ngw, lane); }
    xcd_barrier(xb);
    }
    }
#if PEER_CHECK
    if (l == 0) { { PHASE_IDS; chk_save(q, gtid, ngt); } xcd_barrier(xb); { PHASE_IDS; chk_topk(q, l, gtid, ngt); } xcd_barrier(xb); }
#endif
    if (!(PROBE_SKIP & 1)) {
    { PHASE_IDS; phase_peer_u(q, q.qctr() + (l * 2 + 0) * 8, lds_raw, tid); }
    xcd_barrier(xb);
    { PHASE_IDS; phase_peer_r(q, gtid, ngt); if (l + 1 < NL) phase_s5_prep(q, l + 1, gtid, ngt); }
    xcd_barrier(xb);
    if (!(PROBE_SKIP & 32)) {
    { PHASE_IDS; phase_peer_v(q, q.qctr() + (l * 2 + 1) * 8, lds_raw, tid); }
    xcd_barrier(xb);
    }
    }
#if PEER_CHECK
    if (l == 0) { { PHASE_IDS; chk_apply(q, l, ldsf + wv * 128, gw, ngw, lane); } xcd_barrier(xb);
      if (blockIdx.x == 0 && threadIdx.x == 0) { const Params q = fresh(p); chk_emit(q); } xcd_barrier(xb); }
#endif
  }
  { constexpr int l = 2;
    DUP(5) {
    { const Params q = fresh(p);
      EpiInProj e{q.ssq1(), q.S5A(), q.Qm(), q.Km(), q.vrow(), q.Qr(), q.Kr(), q.krow(), q.vrrow(), q.grow(),
                  q.inp(12) + l * 64, q.inp(13) + l * 64, q.cosm(), q.sinm(), q.cosr(), q.sinr()};
      run_gemm(lds_raw, q.xb(), q.Win_t() + (size_t)l * INW * KD, T, INW, KD, e); }
    { PHASE_IDS;
      const int ntile = (T / 256) * (INW / 256), nlast = ntile - ((ntile + G - 1) / G - 1) * G;
      (void)nlast; }
    xcd_barrier(xb);
    }
    DUP(1) {
    { PHASE_IDS; const bool split = G >= 128; const int g2 = split ? gtid - 64 * NTHR : gtid, n2 = split ? ngt - 64 * NTHR : ngt;
      if (!split || bid >= 64) { phase_post_pack(q, g2, n2); phase_kmean2(q, g2, n2); } }
    { const Params q = fresh(p); EpiS5Z e{q.S5Z()};
      pg8::Gemm g{q.S5A(), q.S5Wz(), 16 * 1024, 16 * 256, 512, 640, 512}; pg8::GroupOrder So; So.init(16, 4, 1, (int)gridDim.x, (int)blockIdx.x);
      pg8::gemm_phase<EpiS5Z, pg8::GroupOrder, true, true>((PG8_LAS unsigned char*)lds_raw, g, So, e); }
    xcd_barrier(xb);
    }
    DUP(2) {
    { PHASE_IDS; phase_s5_scan(q, gtid, ngt); phase_ret_kv(q, gw, ngw, lane); }
    __syncthreads();
    { PHASE_IDS; phase_moba2(q, l, lds_raw, q.qctr() + 64 + l); }
    xcd_barrier(xb);
    }
    DUP(3) {
    { const Params q = fresh(p); EpiS5Y e{q.ygb(), q.S5A(), q.inp(10) + l * 256};
      pg8::Gemm g{q.S5A(), q.S5Wy(), 16 * 1024, 16 * 512, 640, 640, 640}; pg8::GroupOrder So; So.init(16, 4, 2, (int)gridDim.x, (int)blockIdx.x);
      pg8::gemm_phase<EpiS5Y, pg8::GroupOrder, true, true>((PG8_LAS unsigned char*)lds_raw, g, So, e); }
    { PHASE_IDS; phase_ret_scan(q, gtid, ngt);
      if (G >= 256 && bid >= 128) cvt_table_fp8(q.inp(20) + (size_t)l * 16384 * D, q.V8s(), q.sv(), gw - 128 * NWAVE, ngw - 128 * NWAVE, lane); }
    xcd_barrier(xb);
    }
    DUP(4) {
    { const Params q = fresh(p); EpiGlu e{q.xb(), q.ygb(), (float*)(lds_raw + 131072)};
      run_gemm(lds_raw, q.ygb(), q.Wglu_t() + (size_t)l * 65536, T, 256, 256, e); }
    { PHASE_IDS; phase_ret_out(q, gw, ngw, lane);
      if (G >= 256 && bid >= 128) cvt_table_i8(q.inp(19) + (size_t)l * 16384 * D, q.U8s(), q.su(), gw - 128 * NWAVE, ngw - 128 * NWAVE, lane); }
    xcd_barrier(xb);
    }
    { PHASE_IDS; const int ntile = (T / 256) * (INW / 256), nlast = ntile - ((ntile + G - 1) / G - 1) * G;
      (void)nlast; if (!(G >= 256)) cvt_table_i8(q.inp(19) + (size_t)l * 16384 * D, q.U8s(), q.su(), gw, ngw, lane);
      if (!(G >= 256)) cvt_table_fp8(q.inp(20) + (size_t)l * 16384 * D, q.V8s(), q.sv(), gw, ngw, lane); }
    __syncthreads();
    { const Params q = fresh(p); EpiResid e{q.outp(), D, q.xb2(), q.hb(), q.inp(16) + l * D, q.ssq2(), l == 0 ? q.inp(0) : (const float*)q.outp()};
      run_gemm(lds_raw, q.xb(), q.Wout_t() + (size_t)l * D * KD, T, D, KD, e); }
    xcd_barrier(xb);
    DUP(7) {
    { const Params q = fresh(p); EpiScaleStoreBf16 e{q.qb(), D, q.ssq2(), 16, q.rstd()};
      run_gemm(lds_raw, q.xb2(), q.Wq_t() + (size_t)l * D * KD, T, D, KD, e); }
    xcd_barrier(xb);
    }
    if (!(PROBE_SKIP & 2)) {
    DUP(8) {
    { PHASE_IDS; phase_peer_topk(q, l, gw, ngw, lane); }
    xcd_barrier(xb);
    }
    }
#if PEER_CHECK
    if (l == 0) { { PHASE_IDS; chk_save(q, gtid, ngt); } xcd_barrier(xb); { PHASE_IDS; chk_topk(q, l, gtid, ngt); } xcd_barrier(xb); }
#endif
    if (!(PROBE_SKIP & 1)) {
    { PHASE_IDS; phase_peer_u(q, q.qctr() + (l * 2 + 0) * 8, lds_raw, tid); }
    xcd_barrier(xb);
    { PHASE_IDS; phase_peer_r(q, gtid, ngt); if (l + 1 < NL) phase_s5_prep(q, l + 1, gtid, ngt); }
    xcd_barrier(xb);
    if (!(PROBE_SKIP & 32)) {
    { PHASE_IDS; phase_peer_v(q, q.qctr() + (l * 2 + 1) * 8, lds_raw, tid); }
    xcd_barrier(xb);
    }
    }
#if PEER_CHECK
    if (l == 0) { { PHASE_IDS; chk_apply(q, l, ldsf + wv * 128, gw, ngw, lane); } xcd_barrier(xb);
      if (blockIdx.x == 0 && threadIdx.x == 0) { const Params q = fresh(p); chk_emit(q); } xcd_barrier(xb); }
#endif
  }
  { constexpr int l = 3;
    DUP(5) {
    { const Params q = fresh(p);
      EpiInProj e{q.ssq1(), q.S5A(), q.Qm(), q.Km(), q.vrow(), q.Qr(), q.Kr(), q.krow(), q.vrrow(), q.grow(),
                  q.inp(12) + l * 64, q.inp(13) + l * 64, q.cosm(), q.sinm(), q.cosr(), q.sinr()};
      run_gemm(lds_raw, q.xb(), q.Win_t() + (size_t)l * INW * KD, T, INW, KD, e); }
    { PHASE_IDS;
      const int ntile = (T / 256) * (INW / 256), nlast = ntile - ((ntile + G - 1) / G - 1) * G;
      (void)nlast; }
    xcd_barrier(xb);
    }
    DUP(1) {
    { PHASE_IDS; const bool split = G >= 128; const int g2 = split ? gtid - 64 * NTHR : gtid, n2 = split ? ngt - 64 * NTHR : ngt;
      if (!split || bid >= 64) { phase_post_pack(q, g2, n2); phase_kmean2(q, g2, n2); } }
    { const Params q = fresh(p); EpiS5Z e{q.S5Z()};
      pg8::Gemm g{q.S5A(), q.S5Wz(), 16 * 1024, 16 * 256, 512, 640, 512}; pg8::GroupOrder So; So.init(16, 4, 1, (int)gridDim.x, (int)blockIdx.x);
      pg8::gemm_phase<EpiS5Z, pg8::GroupOrder, true, true>((PG8_LAS unsigned char*)lds_raw, g, So, e); }
    xcd_barrier(xb);
    }
    DUP(2) {
    { PHASE_IDS; phase_s5_scan(q, gtid, ngt); phase_ret_kv(q, gw, ngw, lane); }
    __syncthreads();
    { PHASE_IDS; phase_moba2(q, l, lds_raw, q.qctr() + 64 + l); }
    xcd_barrier(xb);
    }
    DUP(3) {
    { const Params q = fresh(p); EpiS5Y e{q.ygb(), q.S5A(), q.inp(10) + l * 256};
      pg8::Gemm g{q.S5A(), q.S5Wy(), 16 * 1024, 16 * 512, 640, 640, 640}; pg8::GroupOrder So; So.init(16, 4, 2, (int)gridDim.x, (int)blockIdx.x);
      pg8::gemm_phase<EpiS5Y, pg8::GroupOrder, true, true>((PG8_LAS unsigned char*)lds_raw, g, So, e); }
    { PHASE_IDS; phase_ret_scan(q, gtid, ngt);
      if (G >= 256 && bid >= 128) cvt_table_fp8(q.inp(20) + (size_t)l * 16384 * D, q.V8s(), q.sv(), gw - 128 * NWAVE, ngw - 128 * NWAVE, lane); }
    xcd_barrier(xb);
    }
    DUP(4) {
    { const Params q = fresh(p); EpiGlu e{q.xb(), q.ygb(), (float*)(lds_raw + 131072)};
      run_gemm(lds_raw, q.ygb(), q.Wglu_t() + (size_t)l * 65536, T, 256, 256, e); }
    { PHASE_IDS; phase_ret_out(q, gw, ngw, lane);
      if (G >= 256 && bid >= 128) cvt_table_i8(q.inp(19) + (size_t)l * 16384 * D, q.U8s(), q.su(), gw - 128 * NWAVE, ngw - 128 * NWAVE, lane); }
    xcd_barrier(xb);
    }
    { PHASE_IDS; const int ntile = (T / 256) * (INW / 256), nlast = ntile - ((ntile + G - 1) / G - 1) * G;
      (void)nlast; if (!(G >= 256)) cvt_table_i8(q.inp(19) + (size_t)l * 16384 * D, q.U8s(), q.su(), gw, ngw, lane);
      if (!(G >= 256)) cvt_table_fp8(q.inp(20) + (size_t)l * 16384 * D, q.V8s(), q.sv(), gw, ngw, lane); }
    __syncthreads();
    { const Params q = fresh(p); EpiResid e{q.outp(), D, q.xb2(), q.hb(), q.inp(16) + l * D, q.ssq2(), l == 0 ? q.inp(0) : (const float*)q.outp()};
      run_gemm(lds_raw, q.xb(), q.Wout_t() + (size_t)l * D * KD, T, D, KD, e); }
    xcd_barrier(xb);
    DUP(7) {
    { const Params q = fresh(p); EpiScaleStoreBf16 e{q.qb(), D, q.ssq2(), 16, q.rstd()};
      run_gemm(lds_raw, q.xb2(), q.Wq_t() + (size_t)l * D * KD, T, D, KD, e); }
    xcd_barrier(xb);
    }
    if (!(PROBE_SKIP & 2)) {
    DUP(8) {
    { PHASE_IDS; phase_peer_topk(q, l, gw, ngw, lane); }
    xcd_barrier(xb);
    }
    }
#if PEER_CHECK
    if (l == 0) { { PHASE_IDS; chk_save(q, gtid, ngt); } xcd_barrier(xb); { PHASE_IDS; chk_topk(q, l, gtid, ngt); } xcd_barrier(xb); }
#endif
    if (!(PROBE_SKIP & 1)) {
    { PHASE_IDS; phase_peer_u(q, q.qctr() + (l * 2 + 0) * 8, lds_raw, tid); }
    xcd_barrier(xb);
    { PHASE_IDS; phase_peer_r(q, gtid, ngt); if (l + 1 < NL) phase_s5_prep(q, l + 1, gtid, ngt); }
    xcd_barrier(xb);
    if (!(PROBE_SKIP & 32)) {
    { PHASE_IDS; phase_peer_v(q, q.qctr() + (l * 2 + 1) * 8, lds_raw, tid); }
    xcd_barrier(xb);
    }
    }
#if PEER_CHECK
    if (l == 0) { { PHASE_IDS; chk_apply(q, l, ldsf + wv * 128, gw, ngw, lane); } xcd_barrier(xb);
      if (blockIdx.x == 0 && threadIdx.x == 0) { const Params q = fresh(p); chk_emit(q); } xcd_barrier(xb); }
#endif
  }
}

}

extern "C" void kernel_launch(void* const* d_in, const int* in_sizes, int n_in, void* d_out, int out_size, void* d_ws, size_t ws_size,
                              hipStream_t stream) {
  static int grid_blocks = 0;
  if (!grid_blocks) {
    int dev = 0, cus = 0, per_cu = 0;
    hipGetDevice(&dev);
    hipDeviceGetAttribute(&cus, hipDeviceAttributeMultiprocessorCount, dev);
    hipFuncSetAttribute((const void*)mega, hipFuncAttributeMaxDynamicSharedMemorySize, LDS_BYTES);
    hipOccupancyMaxActiveBlocksPerMultiprocessor(&per_cu, (const void*)mega, NTHR, LDS_BYTES);
    if (per_cu < 1) { fprintf(stderr, "occupancy query returned %d\n", per_cu); per_cu = 1; }
    grid_blocks = cus * 1;
    if (grid_blocks < 64) fprintf(stderr, "unexpected CU count %d\n", cus);
  }
  Params p{};
  for (int i = 0; i < 21; ++i) p.in[i] = (const GAS float*)d_in[i];
  p.out_ = (GAS float*)d_out;
  p.ws = (GAS unsigned char*)d_ws;
  if (WS_TOTAL > ws_size) { fprintf(stderr, "workspace too small: need %zu have %zu\n", (size_t)WS_TOTAL, ws_size); return; }
  hipMemsetAsync((unsigned char*)d_ws + WO_bar, 0, 16384, stream);
  void* args[] = {&p};
  hipError_t e = hipLaunchCooperativeKernel((const void*)mega, dim3(grid_blocks), dim3(NTHR), args, LDS_BYTES, stream);
  if (e != hipSuccess) fprintf(stderr, "cooperative launch failed: %s (grid %d)\n", hipGetErrorString(e), grid_blocks);
}
```
